# Optimizing an MI355X kernel written in HIP

```python
import math
import jax, jax.numpy as jnp
from jax import lax
import numpy as np

D_MODEL = 1024
BATCH = 2
SEQ = 8192
DEPTH = 4

N_MIXERS = 2
N_HY_LAYERS = (DEPTH + 1) // 2
N_AT_LAYERS = DEPTH // 2
HEAD_DIM = 64
D_MIX = D_MODEL
MEM_LEN = 256
MEM_HEADS = 4
D_MEM = MEM_HEADS * HEAD_DIM
D_MAIN = D_MIX - D_MEM
N_Q_HEADS = D_MAIN // HEAD_DIM
N_KV_HEADS = 4
GQA_GROUP = N_Q_HEADS // N_KV_HEADS
Q_BLOCK = 128
GRID_W = 64
ROPE_THETA = 10000.0
ROPE_AXIS_DIM = HEAD_DIM // 2
HY_ORDER = 2
HY_SHORT = 3
HY_BANDS = 16
HY_EMB = 1 + 2 * HY_BANDS
HY_FILT = 64
HY_DECAY_TARGET = 1e-2
HY_FAST_PCT = 0.3
HY_SLOW_PCT = 1.5
N_EXPERTS = 16
EC_CAPACITY_FACTOR = 2
EXPERT_FF = 768
NORM_EPS = 1e-6
D_IN_HY = 3 * D_MAIN + D_MEM
D_IN_AT = D_MAIN + 2 * N_KV_HEADS * HEAD_DIM + D_MEM

kernel_name = 'hybrid_hyena_gqa_ec_moe_encoder'


def rms_norm(x, g):
    xf = x.astype(jnp.float32)
    y = xf * lax.rsqrt(jnp.mean(xf * xf, axis=-1, keepdims=True) + NORM_EPS)
    return (y * g.astype(jnp.float32)).astype(x.dtype)


def hyena_filters(L, w1, b1, w2, b2, w3, freq):
    f32 = jnp.float32
    t = jnp.linspace(0.0, 1.0, L, dtype=f32)[:, None]
    w = (2.0 * math.pi) * jnp.arange(L, dtype=f32)[:, None] / L
    bands = jnp.linspace(1e-4, HY_BANDS - 1, HY_BANDS, dtype=f32)[None, :]
    feats = jnp.concatenate([t, jnp.cos(bands * w), -jnp.sin(bands * w)], axis=-1)
    fr = freq.astype(f32)
    h = jnp.sin(fr * (feats @ w1.astype(f32) + b1.astype(f32)))
    h = jnp.sin(fr * (h @ w2.astype(f32) + b2.astype(f32)))
    h = (h @ w3.astype(f32)).reshape(L, HY_ORDER, 2, D_MAIN)
    max_decay = math.log(HY_DECAY_TARGET) / HY_FAST_PCT
    min_decay = math.log(HY_DECAY_TARGET) / HY_SLOW_PCT
    deltas = jnp.linspace(min_decay, max_decay, D_MAIN, dtype=f32)
    h = h * jnp.exp(-t[:, :, None, None] * jnp.abs(deltas))
    h = h / (jnp.sum(jnp.abs(h), axis=(0, 2), keepdims=True) + 1e-6)
    hf, hb = h[:, :, 0], h[:, :, 1]
    zero = jnp.zeros_like(hf[:1])
    return jnp.concatenate([hf[:1] + hb[:1], hf[1:], zero, hb[1:][::-1]], axis=0)


def long_conv(z, k_fft):
    T = z.shape[1]
    Z = jnp.fft.rfft(z, n=2 * T, axis=1)
    return jnp.fft.irfft(Z * k_fft[None], n=2 * T, axis=1)[:, :T]


def hyena_mixer(u, short_w, k_fft, skip):
    T = u.shape[1]
    pad = HY_SHORT // 2
    up = jnp.pad(u, ((0, 0), (pad, pad), (0, 0)))
    uc = sum(up[:, j:j + T] * short_w[j] for j in range(HY_SHORT))
    x1, x2, v = jnp.split(uc, 3, axis=-1)
    z = v.astype(jnp.float32)
    for o, gate in enumerate((x1, x2)):
        z = gate.astype(jnp.float32) * (long_conv(z, k_fft[:, o]) + skip[o].astype(jnp.float32) * z)
    return z.astype(u.dtype)


def axial_rope_tables(T):
    rows = T // GRID_W
    pos_row = jnp.repeat(jnp.arange(rows), GRID_W).astype(jnp.float32)
    pos_col = jnp.tile(jnp.arange(GRID_W), rows).astype(jnp.float32)
    inv = 1.0 / (ROPE_THETA ** (jnp.arange(0, ROPE_AXIS_DIM, 2, dtype=jnp.float32) / ROPE_AXIS_DIM))
    ang = jnp.stack([pos_row[:, None] * inv, pos_col[:, None] * inv], axis=1)
    return jnp.cos(ang), jnp.sin(ang)


def apply_axial_rope(x, cos, sin):
    B, T, H, Dh = x.shape
    nf = ROPE_AXIS_DIM // 2
    xr = x.astype(jnp.float32).reshape(B, T, H, 2, 2, nf)
    c = cos[None, :, None]
    s = sin[None, :, None]
    xa, xb = xr[..., 0, :], xr[..., 1, :]
    out = jnp.stack([xa * c - xb * s, xa * s + xb * c], axis=-2)
    return out.reshape(B, T, H, Dh).astype(x.dtype)


def blocked_gqa(q, k, v):
    B, T, Hq, Dh = q.shape
    nb = T // Q_BLOCK
    qb = q.reshape(B, nb, Q_BLOCK, N_KV_HEADS, GQA_GROUP, Dh).transpose(1, 0, 2, 3, 4, 5)
    scale = Dh ** -0.5

    def one_block(qblk):
        s = jnp.einsum('bqhgd,bkhd->bhgqk', qblk, k).astype(jnp.float32) * scale
        p = jax.nn.softmax(s, axis=-1).astype(v.dtype)
        return jnp.einsum('bhgqk,bkhd->bqhgd', p, v)

    o = lax.map(one_block, qb)
    return o.transpose(1, 0, 2, 3, 4, 5).reshape(B, T, Hq * Dh)


def memory_cross_attn(cq, mem_n, w_kv):
    B, T, _ = cq.shape
    M = mem_n.shape[1]
    q = cq.reshape(B, T, MEM_HEADS, HEAD_DIM)
    mk, mv = jnp.split(mem_n @ w_kv, 2, axis=-1)
    mk = mk.reshape(B, M, MEM_HEADS, HEAD_DIM)
    mv = mv.reshape(B, M, MEM_HEADS, HEAD_DIM)
    s = jnp.einsum('bqhd,bmhd->bhqm', q, mk).astype(jnp.float32) * (HEAD_DIM ** -0.5)
    p = jax.nn.softmax(s, axis=-1).astype(mv.dtype)
    return jnp.einsum('bhqm,bmhd->bqhd', p, mv).reshape(B, T, D_MEM)


def expert_choice_ffn(xn, w_router, w_gate, w_up, w_down):
    B, T, D = xn.shape
    cap = EC_CAPACITY_FACTOR * T // N_EXPERTS
    aff = jax.nn.softmax((xn @ w_router).astype(jnp.float32), axis=-1)
    g, idx = lax.top_k(jnp.swapaxes(aff, 1, 2), cap)
    bidx = jnp.arange(B)[:, None, None]
    xg = xn[bidx, idx]
    hid = jax.nn.silu(jnp.einsum('becd,edf->becf', xg, w_gate)) * jnp.einsum('becd,edf->becf', xg, w_up)
    y = jnp.einsum('becf,efd->becd', hid, w_down) * g[..., None].astype(xn.dtype)
    return jnp.zeros_like(xn).at[bidx, idx].add(y)


def setup_inputs(seed: int = 0) -> dict:
    key = jax.random.key(seed)
    ks = iter(jax.random.split(key, 32))

    def nrm(shape, scale):
        return jax.random.normal(next(ks), shape, jnp.float32) * scale

    def gain(shape):
        return 1.0 + nrm(shape, 0.02)

    D = D_MODEL
    return {
        'x': nrm((BATCH, SEQ, D), 1.0),
        'mem': nrm((BATCH, MEM_LEN, D), 1.0),
        'mix_norm_g': gain((DEPTH, D)),
        'ffn_norm_g': gain((DEPTH, D)),
        'mem_norm_g': gain((D,)),
        'final_norm_g': gain((D,)),
        'w_mem_kv': nrm((DEPTH, D, 2 * D_MEM), D ** -0.5),
        'w_out': nrm((DEPTH, D_MIX, D), D_MIX ** -0.5),
        'hy_w_in': nrm((N_HY_LAYERS, D, D_IN_HY), D ** -0.5),
        'hy_short_w': nrm((N_HY_LAYERS, HY_SHORT, 3 * D_MAIN), HY_SHORT ** -0.5),
        'hy_filt_w1': nrm((N_HY_LAYERS, HY_EMB, HY_FILT), HY_EMB ** -0.5),
        'hy_filt_b1': nrm((N_HY_LAYERS, HY_FILT), 0.02),
        'hy_filt_w2': nrm((N_HY_LAYERS, HY_FILT, HY_FILT), HY_FILT ** -0.5),
        'hy_filt_b2': nrm((N_HY_LAYERS, HY_FILT), 0.02),
        'hy_filt_w3': nrm((N_HY_LAYERS, HY_FILT, HY_ORDER * 2 * D_MAIN), HY_FILT ** -0.5),
        'hy_filt_freq': gain((N_HY_LAYERS, HY_FILT)),
        'hy_skip': nrm((N_HY_LAYERS, HY_ORDER, D_MAIN), 1.0),
        'at_w_in': nrm((N_AT_LAYERS, D, D_IN_AT), D ** -0.5),
        'at_q_norm_g': gain((N_AT_LAYERS, HEAD_DIM)),
        'at_k_norm_g': gain((N_AT_LAYERS, HEAD_DIM)),
        'router_w': nrm((DEPTH, D, N_EXPERTS), D ** -0.5),
        'exp_w_gate': nrm((DEPTH, N_EXPERTS, D, EXPERT_FF), D ** -0.5),
        'exp_w_up': nrm((DEPTH, N_EXPERTS, D, EXPERT_FF), D ** -0.5),
        'exp_w_down': nrm((DEPTH, N_EXPERTS, EXPERT_FF, D), EXPERT_FF ** -0.5),
    }


def reference(x, mem, mix_norm_g, ffn_norm_g, mem_norm_g, final_norm_g, w_mem_kv, w_out,
              hy_w_in, hy_short_w, hy_filt_w1, hy_filt_b1, hy_filt_w2, hy_filt_b2, hy_filt_w3,
              hy_filt_freq, hy_skip, at_w_in, at_q_norm_g, at_k_norm_g,
              router_w, exp_w_gate, exp_w_up, exp_w_down):
    B, T, _ = x.shape
    cos, sin = axial_rope_tables(T)
    mem_n = rms_norm(mem, mem_norm_g)
    h = x
    for i in range(DEPTH):
        j = i // N_MIXERS
        u = rms_norm(h, mix_norm_g[i])
        if i % N_MIXERS == 0:
            proj = u @ hy_w_in[j]
            main_in, cq = proj[..., :3 * D_MAIN], proj[..., 3 * D_MAIN:]
            k_taps = hyena_filters(T, hy_filt_w1[j], hy_filt_b1[j], hy_filt_w2[j], hy_filt_b2[j],
                                   hy_filt_w3[j], hy_filt_freq[j])
            k_fft = jnp.fft.rfft(k_taps, axis=0)
            main = hyena_mixer(main_in, hy_short_w[j], k_fft, hy_skip[j])
        else:
            proj = u @ at_w_in[j]
            o1 = D_MAIN
            o2 = o1 + N_KV_HEADS * HEAD_DIM
            o3 = o2 + N_KV_HEADS * HEAD_DIM
            q = proj[..., :o1].reshape(B, T, N_Q_HEADS, HEAD_DIM)
            kk = proj[..., o1:o2].reshape(B, T, N_KV_HEADS, HEAD_DIM)
            vv = proj[..., o2:o3].reshape(B, T, N_KV_HEADS, HEAD_DIM)
            cq = proj[..., o3:]
            q = apply_axial_rope(rms_norm(q, at_q_norm_g[j]), cos, sin)
            kk = apply_axial_rope(rms_norm(kk, at_k_norm_g[j]), cos, sin)
            main = blocked_gqa(q, kk, vv)
        cross = memory_cross_attn(cq, mem_n, w_mem_kv[i])
        h = h + jnp.concatenate([main, cross], axis=-1) @ w_out[i]
        h = h + expert_choice_ffn(rms_norm(h, ffn_norm_g[i]), router_w[i],
                                  exp_w_gate[i], exp_w_up[i], exp_w_down[i])
    return rms_norm(h, final_norm_g)
```

```cpp
#include <hip/hip_runtime.h>
#include <hip/hip_cooperative_groups.h>
#include <hip/hip_bf16.h>
#include <cmath>
#include <cstdio>
#include <cstdint>
namespace cg = cooperative_groups;

constexpr int BATCH = 2, SEQ = 8192, DM = 1024, DEPTH = 4, M_TOK = BATCH * SEQ;
constexpr int HD = 64, MEM_LEN = 256, D_MEM = 256, D_MAIN = 768, NQH = 12, NKVH = 4;
constexpr int D_IN_HY = 2560, D_IN_AT = 1536;
constexpr int NEXP = 16, CAP = 1024, EFF = 768, NGRP = BATCH * NEXP, XROWS = NGRP * CAP;
constexpr int HY_EMB = 33, HY_FILT = 64, FCOLS = 4 * D_MAIN;
constexpr float NORM_EPS = 1e-6f;
constexpr float W8_SCALE = 32.0f;
constexpr float ATT_C2 = 0.125f * 1.4426950408889634f;

constexpr size_t MiB = 1u << 20;
constexpr size_t WS_CTL = 0;
constexpr size_t WS_WHY = 2 * MiB;
constexpr size_t WS_WAT = 12 * MiB;
constexpr size_t WS_WOUT = 18 * MiB;
constexpr size_t WS_WMKV = 26 * MiB;
constexpr size_t WS_W1 = 32 * MiB;
constexpr size_t WS_W2 = 224 * MiB;
constexpr size_t WS_U = 320 * MiB;
constexpr size_t WS_PROJ = 352 * MiB;
constexpr size_t WS_CQ = WS_PROJ + 72 * MiB;
constexpr size_t WS_MIX = 432 * MiB;
constexpr size_t WS_MIXT = 464 * MiB;
constexpr size_t WS_AFF = 488 * MiB;
constexpr size_t WS_IDX = 489 * MiB;
constexpr size_t WS_GATE = WS_IDX + 128 * 1024;
constexpr size_t WS_POS = 490 * MiB;
constexpr size_t WS_XG = 492 * MiB;
constexpr size_t WS_HID = 556 * MiB;
constexpr size_t WS_TAPS = WS_XG;
constexpr size_t WS_Y = 604 * MiB;
constexpr size_t WS_FFTX = WS_Y;
constexpr size_t WS_H2 = 668 * MiB;
constexpr size_t WS_MEMN = 672 * MiB;
constexpr size_t WS_MKV = 673 * MiB;
constexpr size_t WS_END = 676 * MiB;

constexpr int LDS_RING = 0;
constexpr int LDS_MISC = 132 * 1024;
constexpr int LDS_BYTES = 140 * 1024;
constexpr int NTHREADS = 512, NWAVES = 8;

#define GAS __attribute__((address_space(1)))
#define LAS __attribute__((address_space(3)))
typedef unsigned short bf16;
typedef unsigned v4u __attribute__((ext_vector_type(4)));
typedef unsigned v2u __attribute__((ext_vector_type(2)));
typedef float f32x4 __attribute__((ext_vector_type(4)));
typedef float f32x2 __attribute__((ext_vector_type(2)));
__device__ __forceinline__ unsigned f2bf(float f) { unsigned u = __builtin_bit_cast(unsigned, f); return (u + 0x7fffu + ((u >> 16) & 1u)) >> 16; }
__device__ __forceinline__ unsigned pk2(float lo, float hi) { return f2bf(lo) | (f2bf(hi) << 16); }
__device__ __forceinline__ float bf2f(unsigned short h) { return __builtin_bit_cast(float, (unsigned)h << 16); }
__device__ __forceinline__ float bflo(unsigned w) { return __builtin_bit_cast(float, w << 16); }
__device__ __forceinline__ float bfhi(unsigned w) { return __builtin_bit_cast(float, w & 0xffff0000u); }
__device__ __forceinline__ float wave_sum(float v) {
#pragma unroll
    for (int o = 1; o < 64; o <<= 1) v += __shfl_xor(v, o);
    return v;
}
__device__ __forceinline__ int opaque_tid() { int t = threadIdx.x; asm volatile("" : "+v"(t)); return t; }
#define MK_PER_PHASE 0
#define XB_TMO      128
#define XB_XCNT(j)  (256  + 64 * (j))
#define XB_XSUB(j)  (1280 + 64 * (j))
#define XB_XGEN(j)  (2304 + 64 * (j))
#define XB_TOP      3328
#define XB_TOPGEN   3392
#define XCD_BAR_WORDS 3456
#define XB_SPIN_CAP (1u << 18)

__device__ __forceinline__ unsigned xb_ld(unsigned* p)              { return __hip_atomic_load(p, __ATOMIC_RELAXED, __HIP_MEMORY_SCOPE_AGENT); }
__device__ __forceinline__ unsigned xb_add(unsigned* p, unsigned v) { return __hip_atomic_fetch_add(p, v, __ATOMIC_RELAXED, __HIP_MEMORY_SCOPE_AGENT); }
__device__ __forceinline__ unsigned xb_xcc_id() { return (unsigned)__builtin_amdgcn_s_getreg((3 << 11) | 20) & 0xFu; }
#define XB_SPIN(cond, bar) do { unsigned _sp = 0; while (cond) { __builtin_amdgcn_s_sleep(1); \
    if ((++_sp & 255u) == 0u) { if (xb_ld(&(bar)[XB_TMO])) break; if (_sp > XB_SPIN_CAP) { atomicAdd(&(bar)[XB_TMO], 1u); break; } } } } while (0)

struct XcdBarrier {
    unsigned* bar; unsigned x;
    volatile LAS unsigned* st;
};

__device__ __forceinline__ XcdBarrier xcd_barrier_post(unsigned* bar, volatile LAS unsigned* st) {
    XcdBarrier b; b.bar = bar; b.x = xb_xcc_id(); b.st = st;
    if (threadIdx.x == 0) (void)xb_add(&bar[XB_XCNT(b.x)], 1u);
    return b;
}
__device__ __forceinline__ void xcd_barrier_complete(unsigned* bar, unsigned x, unsigned& nloc, unsigned& nx) {
    const unsigned G = gridDim.x * gridDim.y * gridDim.z;
    unsigned sum, cnt, mine, sp = 0u;
    for (;;) {
        sum = 0u; cnt = 0u; mine = 0u;
#pragma unroll
        for (unsigned j = 0; j < 16; ++j) { const unsigned c = xb_ld(&bar[XB_XCNT(j)]); sum += c; cnt += (c > 0u) ? 1u : 0u; mine = (j == x) ? c : mine; }
        if (sum == G) break;
        __builtin_amdgcn_s_sleep(1);
        if ((++sp & 255u) == 0u) { if (xb_ld(&bar[XB_TMO])) break; if (sp > XB_SPIN_CAP) { atomicAdd(&bar[XB_TMO], 1u); break; } }
    }
    nloc = mine > 0u ? mine : 1u; nx = cnt > 0u ? cnt : 1u;
}

__device__ __forceinline__ void xcd_barrier(const XcdBarrier& b) {
    asm volatile("s_waitcnt vmcnt(0)" ::: "memory");
    __syncthreads();
    if (threadIdx.x == 0) {
        unsigned* bar = b.bar;
        __builtin_amdgcn_s_waitcnt(0);
        unsigned nloc = b.st[0], nx = b.st[1];
        if (nloc == 0u) { xcd_barrier_complete(bar, b.x, nloc, nx); b.st[0] = nloc; b.st[1] = nx; }
        const unsigned old = xb_add(&bar[XB_XSUB(b.x)], 1u);
        const unsigned gen = old / nloc;
        if (old + 1u == (gen + 1u) * nloc) {
            __builtin_amdgcn_fence(__ATOMIC_RELEASE, "agent");
            asm volatile("s_waitcnt vmcnt(0)" ::: "memory");
            const unsigned og = xb_add(&bar[XB_TOP], 1u);
            const unsigned tg = og / nx;
            if (og + 1u == (tg + 1u) * nx) xb_add(&bar[XB_TOPGEN], 1u);
            else XB_SPIN(xb_ld(&bar[XB_TOPGEN]) == tg, bar);
            __builtin_amdgcn_fence(__ATOMIC_ACQUIRE, "agent");
            xb_add(&bar[XB_XGEN(b.x)], 1u);
            asm volatile("s_waitcnt vmcnt(0)" ::: "memory");
        } else {
            XB_SPIN(xb_ld(&bar[XB_XGEN(b.x)]) == gen, bar);
            __builtin_amdgcn_fence(__ATOMIC_ACQUIRE, "agent");
            asm volatile("s_waitcnt vmcnt(0)" ::: "memory");
        }
    }
    __syncthreads();
}
namespace pg8 {
#define PG8_LAS __attribute__((address_space(3)))
typedef unsigned short bf16_t;
typedef short bf16x8 __attribute__((ext_vector_type(8)));
typedef float f32x4 __attribute__((ext_vector_type(4)));
typedef unsigned u32x4 __attribute__((ext_vector_type(4)));
constexpr int BM = 256, BK = 64, HALF = 128, HTB = HALF * BK * 2  , STAGE_BYTES = 8 * HTB, NXCD = 8, WGM = 8;

__host__ __device__ __forceinline__ int lds_byte(int r, int c) { const int st = (r >> 4) * 2 + (c >> 5), rr = r & 15, cc = c & 31, ob = rr * 64 + cc * 2; return st * 1024 + (ob ^ (((ob >> 9) & 1) << 5)); }
__host__ __device__ __forceinline__ void stage_rc(int b, int& R, int& C) { const int st = b / 1024, sb = b % 1024, swz = sb ^ (((sb >> 9) & 1) << 5); R = (st >> 1) * 16 + swz / 64; C = (st & 1) * 32 + (swz % 64) / 2; }
__host__ __device__ __forceinline__ int perm32(int rho) { const int n = rho >> 4, i = rho & 15; return 8 * (i >> 2) + 4 * n + (i & 3); }

struct Unit { int pm, pn; };
struct Gemm { const bf16_t* A; const bf16_t* Bt; int M, N, K; int gdiv, gmod; size_t gstride; };

struct StaticOrder {
    int nM, nN, nwg, G, c;
    __host__ __device__ void init(int M, int N, int G_, int c_) { nM = M / BM; nN = N / BM; nwg = nM * nN; G = G_; c = c_; }
    __host__ __device__ bool next(int i, Unit& u) const {
        const long L = (long)i * G + c; if (L >= nwg) return false;
        int wgid = (int)L; { const int q = nwg / NXCD, r = nwg % NXCD, xcd = wgid % NXCD, off = wgid / NXCD; wgid = (xcd < r ? xcd * (q + 1) : r * (q + 1) + (xcd - r) * q) + off; }
        const int nig = WGM * nN, gid = wgid / nig, fm = gid * WGM, gsz = (nM - fm) < WGM ? (nM - fm) : WGM;
        u.pm = fm + ((wgid % nig) % gsz); u.pn = (wgid % nig) / gsz; return true;
    }
    __device__ __forceinline__ void a_ready(const Unit&) const {}
    __device__ __forceinline__ void done(const Unit&) const {}
};


__device__ __forceinline__ unsigned cvt_pk_bf16(float lo, float hi) { unsigned r; asm volatile("v_cvt_pk_bf16_f32 %0, %1, %2" : "=v"(r) : "v"(lo), "v"(hi)); return r; }
typedef unsigned u32x2 __attribute__((ext_vector_type(2)));
struct EpiRowBf16 {
    static constexpr bool PERM = false, AFTER_DRAIN = false;
    bf16_t* O; int ldc; int sc_pn; float sc;
    __device__ __forceinline__ void operator()(const f32x4 (&acc)[2][2][4][2], const Unit& u, int wr, int wc, int fr, int fq) const {
        const float s = (u.pn == sc_pn) ? sc : 1.f;
        const int row0 = u.pm * BM + wr * 64 + fr, col0 = u.pn * BM + wc * 32 + 4 * fq;
#pragma unroll
        for (int ai = 0; ai < 2; ++ai)
#pragma unroll
            for (int m = 0; m < 4; ++m) { bf16_t* rowp = O + (size_t)(row0 + ai * HALF + m * 16) * ldc + col0;
#pragma unroll
                for (int bj = 0; bj < 2; ++bj)
#pragma unroll
                    for (int n = 0; n < 2; ++n) { const f32x4 v = acc[ai][bj][m][n] * s; u32x2 w; w.x = cvt_pk_bf16(v[0], v[1]); w.y = cvt_pk_bf16(v[2], v[3]);
                        *(u32x2*)(rowp + bj * HALF + n * 16) = w; } }
    }
};
struct EpiHyIn {
    static constexpr bool PERM = false, AFTER_DRAIN = false;
    bf16_t* OT; int ldt; int tp_tiles; bf16_t* CQ; float sc;
    __device__ __forceinline__ void operator()(const f32x4 (&acc)[2][2][4][2], const Unit& u, int wr, int wc, int fr, int fq) const {
        const int row0 = u.pm * BM + wr * 64 + fr;
        if (u.pn < tp_tiles) {
            const int col0 = u.pn * BM + wc * 32 + 4 * fq;
#pragma unroll
            for (int ai = 0; ai < 2; ++ai)
#pragma unroll
                for (int m = 0; m < 4; ++m) { const int row = row0 + ai * HALF + m * 16;
#pragma unroll
                    for (int bj = 0; bj < 2; ++bj)
#pragma unroll
                        for (int n = 0; n < 2; ++n) { const f32x4 v = acc[ai][bj][m][n]; const unsigned w0 = cvt_pk_bf16(v[0], v[1]), w1 = cvt_pk_bf16(v[2], v[3]);
                            bf16_t* p = OT + (size_t)(col0 + bj * HALF + n * 16) * ldt + row;
                            p[0] = (bf16_t)(w0 & 0xffffu); p[(size_t)ldt] = (bf16_t)(w0 >> 16); p[(size_t)2 * ldt] = (bf16_t)(w1 & 0xffffu); p[(size_t)3 * ldt] = (bf16_t)(w1 >> 16); } }
        } else {
            const int col0 = wc * 32 + 4 * fq;
#pragma unroll
            for (int ai = 0; ai < 2; ++ai)
#pragma unroll
                for (int m = 0; m < 4; ++m) { bf16_t* rowp = CQ + (size_t)(row0 + ai * HALF + m * 16) * 256 + col0;
#pragma unroll
                    for (int bj = 0; bj < 2; ++bj)
#pragma unroll
                        for (int n = 0; n < 2; ++n) { const f32x4 v = acc[ai][bj][m][n] * sc; u32x2 w; w.x = cvt_pk_bf16(v[0], v[1]); w.y = cvt_pk_bf16(v[2], v[3]);
                            *(u32x2*)(rowp + bj * HALF + n * 16) = w; } }
        }
    }
};
struct EpiAtIn {
    static constexpr bool PERM = false, AFTER_DRAIN = false;
    bf16_t* O; int ldc; const float* gq; const float* gk; float csc; float eps; int seq_mask;
    __device__ __forceinline__ void operator()(const f32x4 (&acc)[2][2][4][2], const Unit& u, int wr, int wc, int fr, int fq) const {
        const int row0 = u.pm * BM + wr * 64 + fr, colb = u.pn * BM + wc * 64 + 4 * fq;
        if (u.pn <= 3) {
            const float* gp = (u.pn == 3 ? gk : gq) + 4 * fq; const float osc = (u.pn == 3) ? 1.f : csc;
            float invr[4];
#pragma unroll
            for (int q = 0; q < 4; ++q) invr[q] = exp2f(-(float)(4 * fq + q) * (13.287712379549449f / 16.0f)) * 0.15915494309189535f;
#pragma unroll
            for (int ai = 0; ai < 2; ++ai)
#pragma unroll
                for (int m = 0; m < 4; ++m) {
                    const int row = row0 + ai * HALF + m * 16; int t = row & seq_mask; asm volatile("" : "+v"(t));
                    float ss = 0.f;
#pragma unroll
                    for (int bj = 0; bj < 2; ++bj)
#pragma unroll
                        for (int n = 0; n < 2; ++n) { const f32x4 x = acc[ai][bj][m][n]; ss += (x[0] * x[0] + x[1] * x[1]) + (x[2] * x[2] + x[3] * x[3]); }
                    ss += __shfl_xor(ss, 16); ss += __shfl_xor(ss, 32);
                    const float rs = osc * __builtin_amdgcn_rsqf(ss * (1.0f / 64.0f) + eps);
                    bf16_t* rowp = O + (size_t)row * ldc + colb;
#pragma unroll
                    for (int bj = 0; bj < 2; ++bj) {
                        const float pos = (float)(bj == 0 ? (t >> 6) : (t & 63));
                        const f32x4 xa = acc[ai][bj][m][0] * rs * *(const f32x4*)(gp + 32 * bj), xb = acc[ai][bj][m][1] * rs * *(const f32x4*)(gp + 32 * bj + 16);
                        f32x4 oa, ob;
#pragma unroll
                        for (int q = 0; q < 4; ++q) { const float rev = pos * invr[q]; const float c = __builtin_amdgcn_cosf(rev), s = __builtin_amdgcn_sinf(rev);
                            oa[q] = xa[q] * c - xb[q] * s; ob[q] = xa[q] * s + xb[q] * c; }
                        u32x2 w; w.x = cvt_pk_bf16(oa[0], oa[1]); w.y = cvt_pk_bf16(oa[2], oa[3]); *(u32x2*)(rowp + 32 * bj) = w;
                        w.x = cvt_pk_bf16(ob[0], ob[1]); w.y = cvt_pk_bf16(ob[2], ob[3]); *(u32x2*)(rowp + 32 * bj + 16) = w;
                    }
                    asm volatile("" ::: "memory");
                }
        } else {
            const float s = (u.pn == 5) ? csc : 1.f;
#pragma unroll
            for (int ai = 0; ai < 2; ++ai)
#pragma unroll
                for (int m = 0; m < 4; ++m) { bf16_t* rowp = O + (size_t)(row0 + ai * HALF + m * 16) * ldc + colb;
#pragma unroll
                    for (int bj = 0; bj < 2; ++bj)
#pragma unroll
                        for (int n = 0; n < 2; ++n) { const f32x4 v = acc[ai][bj][m][n] * s; u32x2 w; w.x = cvt_pk_bf16(v[0], v[1]); w.y = cvt_pk_bf16(v[2], v[3]);
                            *(u32x2*)(rowp + 32 * bj + 16 * n) = w; } }
        }
    }
};
struct EpiResF32 {
    static constexpr bool PERM = false, AFTER_DRAIN = false;
    const float* res; float* out; int ldc;
    __device__ __forceinline__ void operator()(const f32x4 (&acc)[2][2][4][2], const Unit& u, int wr, int wc, int fr, int fq) const {
        const int row0 = u.pm * BM + wr * 64 + fr, col0 = u.pn * BM + wc * 32 + 4 * fq;
#pragma unroll
        for (int ai = 0; ai < 2; ++ai)
#pragma unroll
            for (int m = 0; m < 4; ++m) { const size_t off = (size_t)(row0 + ai * HALF + m * 16) * ldc + col0;
#pragma unroll
                for (int bj = 0; bj < 2; ++bj)
#pragma unroll
                    for (int n = 0; n < 2; ++n) { const f32x4 r = *(const f32x4*)(res + off + bj * HALF + n * 16); *(f32x4*)(out + off + bj * HALF + n * 16) = r + acc[ai][bj][m][n]; } }
    }
};
struct EpiSwiGLU {
    static constexpr bool PERM = false, AFTER_DRAIN = false;
    bf16_t* O; int ldc;
    __device__ __forceinline__ void operator()(const f32x4 (&acc)[2][2][4][2], const Unit& u, int wr, int wc, int fr, int fq) const {
        const int row0 = u.pm * BM + wr * 64 + fr, col0 = u.pn * HALF + wc * 32 + 4 * fq;
#pragma unroll
        for (int ai = 0; ai < 2; ++ai)
#pragma unroll
            for (int m = 0; m < 4; ++m) { bf16_t* rowp = O + (size_t)(row0 + ai * HALF + m * 16) * ldc + col0;
#pragma unroll
                for (int n = 0; n < 2; ++n) { const f32x4 g = acc[ai][0][m][n], up = acc[ai][1][m][n]; f32x4 h;
#pragma unroll
                    for (int q = 0; q < 4; ++q) h[q] = g[q] * up[q] * __builtin_amdgcn_rcpf(1.f + __expf(-g[q]));
                    u32x2 w; w.x = cvt_pk_bf16(h[0], h[1]); w.y = cvt_pk_bf16(h[2], h[3]); *(u32x2*)(rowp + n * 16) = w; } }
    }
};
struct EpiSwiGLU8 {
    static constexpr bool PERM = false, AFTER_DRAIN = false;
    unsigned char* O; int ldc; float wsc;
    __device__ __forceinline__ void operator()(const f32x4 (&acc)[2][2][4][2], const Unit& u, int wr, int wc, int fr, int fq) const {
        const int row0 = u.pm * BM + wr * 64 + fr, col0 = u.pn * HALF + wc * 32 + 4 * fq;
#pragma unroll
        for (int ai = 0; ai < 2; ++ai)
#pragma unroll
            for (int m = 0; m < 4; ++m) { unsigned char* rowp = O + (size_t)(row0 + ai * HALF + m * 16) * ldc + col0;
#pragma unroll
                for (int n = 0; n < 2; ++n) { const f32x4 g = acc[ai][0][m][n] * wsc, up = acc[ai][1][m][n] * wsc; f32x4 h;
#pragma unroll
                    for (int q = 0; q < 4; ++q) h[q] = g[q] * up[q] * __builtin_amdgcn_rcpf(1.f + __expf(-g[q]));
                    unsigned w = 0; w = __builtin_amdgcn_cvt_pk_fp8_f32(h[0], h[1], w, false); w = __builtin_amdgcn_cvt_pk_fp8_f32(h[2], h[3], w, true); *(unsigned*)(rowp + n * 16) = w; } }
    }
};
struct EpiDown {
    static constexpr bool PERM = false, AFTER_DRAIN = false;
    bf16_t* O; int ldc; const float* gate; float wsc;
    __device__ __forceinline__ void operator()(const f32x4 (&acc)[2][2][4][2], const Unit& u, int wr, int wc, int fr, int fq) const {
        const int row0 = u.pm * BM + wr * 64 + fr, col0 = u.pn * BM + wc * 32 + 4 * fq;
#pragma unroll
        for (int ai = 0; ai < 2; ++ai)
#pragma unroll
            for (int m = 0; m < 4; ++m) { const int row = row0 + ai * HALF + m * 16; const float gs = gate[row] * wsc; bf16_t* rowp = O + (size_t)row * ldc + col0;
#pragma unroll
                for (int bj = 0; bj < 2; ++bj)
#pragma unroll
                    for (int n = 0; n < 2; ++n) { const f32x4 v = acc[ai][bj][m][n] * gs; u32x2 w; w.x = cvt_pk_bf16(v[0], v[1]); w.y = cvt_pk_bf16(v[2], v[3]);
                        *(u32x2*)(rowp + bj * HALF + n * 16) = w; } }
    }
};
template <class Epi, class Sched, bool ALIGN_EPI = false, bool SP2 = false, bool GATHER = false, bool FP8 = false>
__device__ __forceinline__ void gemm_phase(PG8_LAS unsigned char* lds, const Gemm g, const Sched& S, const Epi& E, const int* gidx = nullptr) {
    const int tid = opaque_tid(), wid = __builtin_amdgcn_readfirstlane(tid >> 6), lane = tid & 63, wr = wid >> 2, wc = wid & 3, fr = lane & 15, fq = lane >> 4;
    const int K = g.K, nt = K / BK;
    unsigned voffA[2], voffB[2];
#pragma unroll
    for (int i = 0; i < 2; ++i) { int R, C; stage_rc(tid * 16 + i * 8192, R, C); const int Rb = Epi::PERM ? ((R & ~31) + perm32(R & 31)) : R;
        voffA[i] = (unsigned)(R * K + C) * 2u; voffB[i] = (unsigned)(Rb * K + C) * 2u; }
    const size_t kstep = (size_t)(BK * 2);
    const size_t hstep = (size_t)HALF * K * 2;
    const size_t tstep = 2 * hstep;
    const unsigned ldsw = (unsigned)wid * 1024u;
    const int aoff = lds_byte(wr * 64 + fr, fq * 8), boff = lds_byte(wc * 32 + fr, fq * 8);
#define PG8_SA(b, h) (((b) * 2 + (h)) * HTB)
#define PG8_SB(b, h) ((4 + (b) * 2 + (h)) * HTB)
#define PG8_STAGE(bufoff, gbase, voff) do { _Pragma("unroll") for (int _i = 0; _i < 2; ++_i) \
        __builtin_amdgcn_global_load_lds((const unsigned*)((const char*)(gbase) + (voff)[_i]), (PG8_LAS unsigned*)(lds + (bufoff) + ldsw + _i * 8192), 16, 0, 0); } while (0)
#define PG8_LDA(dst, b, h) do { _Pragma("unroll") for (int m = 0; m < 4; ++m) { if constexpr (FP8) { const v4i_ lo_ = *(const PG8_LAS v4i_*)(lds + PG8_SA(b, h) + aoff + m * 2048), hi_ = *(const PG8_LAS v4i_*)(lds + PG8_SA(b, h) + aoff + m * 2048 + 1024); \
        dst##8[m] = __builtin_shufflevector(lo_, hi_, 0, 1, 2, 3, 4, 5, 6, 7); } else { _Pragma("unroll") for (int k = 0; k < 2; ++k) dst[m][k] = *(const PG8_LAS bf16x8*)(lds + PG8_SA(b, h) + aoff + m * 2048 + k * 1024); } } } while (0)
#define PG8_LDB(dst, b, h) do { _Pragma("unroll") for (int n = 0; n < 2; ++n) { if constexpr (FP8) { const v4i_ lo_ = *(const PG8_LAS v4i_*)(lds + PG8_SB(b, h) + boff + n * 2048), hi_ = *(const PG8_LAS v4i_*)(lds + PG8_SB(b, h) + boff + n * 2048 + 1024); \
        dst##8[n] = __builtin_shufflevector(lo_, hi_, 0, 1, 2, 3, 4, 5, 6, 7); } else { _Pragma("unroll") for (int k = 0; k < 2; ++k) dst[n][k] = *(const PG8_LAS bf16x8*)(lds + PG8_SB(b, h) + boff + n * 2048 + k * 1024); } } } while (0)
#define PG8_MMA(ai, bj, At, Bt) do { __builtin_amdgcn_s_setprio(1); _Pragma("unroll") for (int m = 0; m < 4; ++m) _Pragma("unroll") for (int n = 0; n < 2; ++n) { \
        if constexpr (FP8) asm volatile("v_mfma_scale_f32_16x16x128_f8f6f4 %0, %1, %2, %0, %3, %3 op_sel_hi:[0,0,0]" : "+v"(acc[ai][bj][m][n]) : "v"(Bt##8[n]), "v"(At##8[m]), "v"(sc127_));   \
        else { _Pragma("unroll") for (int k = 0; k < 2; ++k) acc[ai][bj][m][n] = __builtin_amdgcn_mfma_f32_16x16x32_bf16(Bt[n][k], At[m][k], acc[ai][bj][m][n], 0, 0, 0); } } \
        __builtin_amdgcn_s_setprio(0); } while (0)
#define PG8_WAIT_V(n) asm volatile("s_waitcnt vmcnt(" #n ")" ::: "memory")
#define PG8_WAIT_L(n) asm volatile("s_waitcnt lgkmcnt(" #n ")" ::: "memory")
#define PG8_BAR __builtin_amdgcn_s_barrier()
#define PG8_SCHED __builtin_amdgcn_sched_barrier(0)
    Unit cur, nxt; int ui = 0;
    if (!S.next(0, cur)) return;
    f32x4 acc[2][2][4][2];
#pragma unroll
    for (int a = 0; a < 2; ++a)
#pragma unroll
        for (int b = 0; b < 2; ++b)
#pragma unroll
            for (int m = 0; m < 4; ++m)
#pragma unroll
                for (int n = 0; n < 2; ++n) acc[a][b][m][n] = (f32x4){0.f, 0.f, 0.f, 0.f};
    typedef int v8i_ __attribute__((ext_vector_type(8))); typedef int v4i_ __attribute__((ext_vector_type(4)));
    const int sc127_ = 127;
    bf16x8 At[4][2], B0[2][2], B1[2][2]; v8i_ At8[4], B08[2], B18[2];
    static_assert(SP2, "this copy of the body keeps only the SP2 K-loop up to date");
    int rA[2]; { int R_, C_; stage_rc(tid * 16, R_, C_); rA[0] = R_; stage_rc(tid * 16 + 8192, R_, C_); rA[1] = R_; }
    unsigned cv0[2], cv1[2], nv0[2], nv1[2];
    unsigned vh1[2]; vh1[0] = voffA[0] + (unsigned)hstep; vh1[1] = voffA[1] + (unsigned)hstep;
#define PG8_CV0 (GATHER ? cv0 : voffA)
#define PG8_CV1 (GATHER ? cv1 : vh1)
#define PG8_SV0 (GATHER ? sv0 : voffA)
#define PG8_SV1 (GATHER ? sv1 : vh1)
#define PG8_ROWOFF(dst0, dst1, unit) do { _Pragma("unroll") for (int i_ = 0; i_ < 2; ++i_) { \
        if constexpr (GATHER) { const int c2_ = (int)(voffA[i_] - (unsigned)(rA[i_] * K) * 2u); \
            dst0[i_] = (unsigned)gidx[(unit).pm * BM + rA[i_]] * (unsigned)(K * 2) + (unsigned)c2_; dst1[i_] = (unsigned)gidx[(unit).pm * BM + HALF + rA[i_]] * (unsigned)(K * 2) + (unsigned)c2_; } \
        else { dst0[i_] = voffA[i_]; dst1[i_] = voffA[i_] + (unsigned)hstep; } } } while (0)
    if constexpr (GATHER) PG8_ROWOFF(cv0, cv1, cur);
    const char* cA = GATHER ? (const char*)g.A : (const char*)g.A + (size_t)cur.pm * tstep; const char* cB = (const char*)g.Bt + (size_t)((cur.pm / g.gdiv) % g.gmod) * g.gstride + (size_t)cur.pn * tstep;
    S.a_ready(cur);
    if constexpr (SP2) {
        PG8_STAGE(PG8_SB(0, 0), cB, voffB); PG8_STAGE(PG8_SB(0, 1), cB + hstep, voffB); PG8_STAGE(PG8_SA(0, 0), cA, PG8_CV0); PG8_STAGE(PG8_SA(0, 1), cA, PG8_CV1);
        if (wr == 1) PG8_BAR;
        PG8_WAIT_V(2); PG8_BAR;
        PG8_STAGE(PG8_SB(1, 0), cB + kstep, voffB); PG8_STAGE(PG8_SA(1, 0), cA + kstep, PG8_CV0); PG8_STAGE(PG8_SB(1, 1), cB + hstep + kstep, voffB);
        PG8_WAIT_V(6); PG8_BAR;
    } else {
        PG8_STAGE(PG8_SB(0, 0), cB, voffB); PG8_STAGE(PG8_SA(0, 0), cA, voffA); PG8_STAGE(PG8_SB(0, 1), cB + hstep, voffB); PG8_STAGE(PG8_SA(0, 1), cA + hstep, voffA);
        if (wr == 1) PG8_BAR;
        PG8_WAIT_V(4); PG8_BAR;
        PG8_STAGE(PG8_SB(1, 0), cB + kstep, voffB); PG8_STAGE(PG8_SA(1, 0), cA + kstep, voffA); PG8_STAGE(PG8_SB(1, 1), cB + hstep + kstep, voffB);
        PG8_WAIT_V(6); PG8_BAR;
    }
    for (;;) {
        const bool has_next = S.next(ui + 1, nxt);
        if constexpr (GATHER) { if (has_next) PG8_ROWOFF(nv0, nv1, nxt); else { nv0[0] = cv0[0]; nv0[1] = cv0[1]; nv1[0] = cv1[0]; nv1[1] = cv1[1]; } }
        const char* nA = GATHER ? (const char*)g.A : (has_next ? (const char*)g.A + (size_t)nxt.pm * tstep : cA); const char* nB = has_next ? (const char*)g.Bt + (size_t)((nxt.pm / g.gdiv) % g.gmod) * g.gstride + (size_t)nxt.pn * tstep : cB;
        for (int t = 0; t < nt; t += 2) {
            const bool last = (t == nt - 2);
            unsigned sv0[2], sv1[2]; if constexpr (GATHER) { sv0[0] = last ? nv0[0] : cv0[0]; sv0[1] = last ? nv0[1] : cv0[1]; sv1[0] = last ? nv1[0] : cv1[0]; sv1[1] = last ? nv1[1] : cv1[1]; }
            const char* a1 = cA + (size_t)(t + 1) * kstep;
            const char* a2 = last ? nA : cA + (size_t)(t + 2) * kstep; const char* b2 = last ? nB : cB + (size_t)(t + 2) * kstep;
            const char* a3 = a2 + kstep; const char* b3 = b2 + kstep;
            if (last && has_next) S.a_ready(nxt);
            if constexpr (SP2) {
            PG8_LDB(B0, 0, 0); PG8_LDB(B1, 0, 1); PG8_SCHED; PG8_LDA(At, 0, 0); PG8_STAGE(PG8_SA(1, 1), a1, PG8_CV1);
            PG8_WAIT_V(8); PG8_WAIT_L(0); PG8_BAR; PG8_MMA(0, 0, At, B0); PG8_MMA(0, 1, At, B1); PG8_BAR; PG8_SCHED;
            PG8_LDA(At, 0, 1); PG8_STAGE(PG8_SB(0, 0), b2, voffB); PG8_STAGE(PG8_SB(0, 1), b2 + hstep, voffB); PG8_STAGE(PG8_SA(0, 0), a2, PG8_SV0);
            PG8_WAIT_V(8); PG8_WAIT_L(0); PG8_BAR; PG8_MMA(1, 0, At, B0); PG8_MMA(1, 1, At, B1); PG8_BAR; PG8_SCHED;
            PG8_LDB(B0, 1, 0); PG8_LDB(B1, 1, 1); PG8_SCHED; PG8_LDA(At, 1, 0); PG8_STAGE(PG8_SA(0, 1), a2, PG8_SV1);
            PG8_WAIT_V(8); PG8_WAIT_L(0); PG8_BAR; PG8_MMA(0, 0, At, B0); PG8_MMA(0, 1, At, B1); PG8_BAR; PG8_SCHED;
            PG8_LDA(At, 1, 1); PG8_STAGE(PG8_SB(1, 0), b3, voffB); PG8_STAGE(PG8_SB(1, 1), b3 + hstep, voffB); PG8_STAGE(PG8_SA(1, 0), a3, PG8_SV0);
            PG8_WAIT_V(8); PG8_WAIT_L(0); PG8_BAR; PG8_MMA(1, 0, At, B0); PG8_MMA(1, 1, At, B1); PG8_BAR; PG8_SCHED;
            } else {
            PG8_LDB(B0, 0, 0); PG8_SCHED; PG8_LDA(At, 0, 0); PG8_STAGE(PG8_SA(1, 1), a1 + hstep, voffA);
            PG8_WAIT_L(8); PG8_BAR; PG8_WAIT_L(0); PG8_MMA(0, 0, At, B0); PG8_BAR; PG8_SCHED;
            PG8_LDB(B1, 0, 1); PG8_STAGE(PG8_SB(0, 0), b2, voffB);
            PG8_BAR; PG8_WAIT_L(0); PG8_MMA(0, 1, At, B1); PG8_BAR;
            PG8_LDA(At, 0, 1); PG8_STAGE(PG8_SA(0, 0), a2, voffA);
            PG8_BAR; PG8_WAIT_L(0); PG8_MMA(1, 0, At, B0); PG8_BAR; PG8_SCHED;
            PG8_STAGE(PG8_SB(0, 1), b2 + hstep, voffB);
            PG8_WAIT_V(6); PG8_BAR; PG8_MMA(1, 1, At, B1); PG8_BAR;
            PG8_LDB(B0, 1, 0); PG8_SCHED; PG8_LDA(At, 1, 0); PG8_STAGE(PG8_SA(0, 1), a2 + hstep, voffA);
            PG8_WAIT_L(8); PG8_BAR; PG8_WAIT_L(0); PG8_MMA(0, 0, At, B0); PG8_BAR; PG8_SCHED;
            PG8_LDB(B1, 1, 1); PG8_STAGE(PG8_SB(1, 0), b3, voffB);
            PG8_BAR; PG8_WAIT_L(0); PG8_MMA(0, 1, At, B1); PG8_BAR;
            PG8_LDA(At, 1, 1); PG8_STAGE(PG8_SA(1, 0), a3, voffA);
            PG8_BAR; PG8_WAIT_L(0); PG8_MMA(1, 0, At, B0); PG8_BAR; PG8_SCHED;
            PG8_STAGE(PG8_SB(1, 1), b3 + hstep, voffB);
            PG8_WAIT_V(6); PG8_BAR; PG8_MMA(1, 1, At, B1); PG8_BAR;
            }
        }
        if constexpr (ALIGN_EPI) { if (wr == 0) PG8_BAR; }
        if constexpr (!Epi::AFTER_DRAIN) { E(acc, cur, wr, wc, fr, fq); S.done(cur); }
        if (!has_next) break;
#pragma unroll
        for (int a = 0; a < 2; ++a)
#pragma unroll
            for (int b = 0; b < 2; ++b)
#pragma unroll
                for (int m = 0; m < 4; ++m)
#pragma unroll
                    for (int n = 0; n < 2; ++n) acc[a][b][m][n] = (f32x4){0.f, 0.f, 0.f, 0.f};
        cur = nxt; cA = nA; cB = nB; ++ui; if constexpr (GATHER) { cv0[0] = nv0[0]; cv0[1] = nv0[1]; cv1[0] = nv1[0]; cv1[1] = nv1[1]; }
        if constexpr (ALIGN_EPI) { if (wr == 1) PG8_BAR; }
    }
    PG8_WAIT_V(0);
    if constexpr (!ALIGN_EPI) { if (wr == 0) PG8_BAR; }
    PG8_BAR;
    if constexpr (Epi::AFTER_DRAIN) { E.fused(acc, cur, wr, wc, fr, fq, lds, wid, lane); S.done(cur); }
#undef PG8_ROWOFF
#undef PG8_CV0
#undef PG8_CV1
#undef PG8_SV0
#undef PG8_SV1
#undef PG8_SA
#undef PG8_SB
#undef PG8_STAGE
#undef PG8_LDA
#undef PG8_LDB
#undef PG8_MMA
#undef PG8_WAIT_V
#undef PG8_WAIT_L
#undef PG8_BAR
#undef PG8_SCHED
}
}
namespace attn_body {
using bf16=__hip_bfloat16;
using bf16x8=__attribute__((ext_vector_type(8)))short;
using s16x4=__attribute__((ext_vector_type(4)))short;
using f32x16=__attribute__((ext_vector_type(16)))float;
using u32x4=__attribute__((ext_vector_type(4)))unsigned;
constexpr int D=64;
constexpr int NW=8,QBLK=32,QB=QBLK*NW,KVBLK=64;
__device__ __forceinline__ int crow(int r,int hi){return (r&3)+8*(r>>2)+4*hi;}
#define SBAR() __builtin_amdgcn_sched_barrier(0)
__device__ __forceinline__ void cmask(f32x16&p0,f32x16&p1,int jb,int qrel,int hi){
  const float NEG=-INFINITY; int kb=64*jb+4*hi;
  #pragma unroll
  for(int r=0;r<16;++r){int kv=kb+(r&3)+8*(r>>2); if(kv>qrel)p0[r]=NEG; if(kv+32>qrel)p1[r]=NEG;}
}

constexpr int NSLOT=3, SLOTB=8192;
constexpr int LDS_K=0, LDS_V=NSLOT*SLOTB, LDS_WS=2*NSLOT*SLOTB, LDS_OST=LDS_WS+NW*64*4, LDS_BYTES=LDS_OST+NW*4096;
constexpr float C2=0.125f*1.4426950408889634f;
__device__ __forceinline__ void glds16(const void*gsrc,unsigned lds_dst){unsigned keep;
  asm volatile("s_mov_b32 %0, m0\n\ts_mov_b32 m0, %2\n\ts_nop 0\n\tglobal_load_lds_dwordx4 %1, off\n\ts_mov_b32 m0, %0":"=&s"(keep):"v"(gsrc),"s"(lds_dst):"memory");}
__device__ __forceinline__ float max3f(float a,float b,float c){float r;asm("v_max3_f32 %0, %1, %2, %3":"=v"(r):"v"(a),"v"(b),"v"(c));return r;}
__device__ __forceinline__ float max2f(float a,float b){float r;asm("v_max_f32_e32 %0, %1, %2":"=v"(r):"v"(a),"v"(b));return r;}
__device__ __forceinline__ float fadd_s(float a,float b){float r;asm("v_add_f32_e32 %0, %1, %2":"=v"(r):"v"(a),"v"(b));return r;}
__device__ __forceinline__ float fsub_s(float a,float b){float r;asm("v_sub_f32_e32 %0, %1, %2":"=v"(r):"v"(a),"v"(b));return r;}
typedef float f32x2_t __attribute__((ext_vector_type(2))); typedef __bf16 bf16x2_t __attribute__((ext_vector_type(2)));
__device__ __forceinline__ unsigned cvtpk_s(float lo,float hi){f32x2_t v={lo,hi};bf16x2_t b=__builtin_convertvector(v,bf16x2_t);return __builtin_bit_cast(unsigned,b);}
#define WAIT_BAR(N) asm volatile("s_waitcnt vmcnt(" #N ") lgkmcnt(0)\n\ts_barrier":::"memory")

__device__ __forceinline__ void qkt(f32x16&p0,f32x16&p1,const char*Kslot,const bf16x8*qr,const f32x16&negm,int r32,int hi){
  const char*kb=Kslot+hi*1024+r32*16;
  #pragma unroll
  for(int d0=0;d0<4;++d0){
    const bf16x8 b0=*reinterpret_cast<const bf16x8*>(kb+d0*2048);
    const bf16x8 b1=*reinterpret_cast<const bf16x8*>(kb+d0*2048+512);
    if(d0==0){p0=__builtin_amdgcn_mfma_f32_32x32x16_bf16(b0,qr[0],negm,0,0,0);p1=__builtin_amdgcn_mfma_f32_32x32x16_bf16(b1,qr[0],negm,0,0,0);}
    else{p0=__builtin_amdgcn_mfma_f32_32x32x16_bf16(b0,qr[d0],p0,0,0,0);p1=__builtin_amdgcn_mfma_f32_32x32x16_bf16(b1,qr[d0],p1,0,0,0);}}
}
typedef __attribute__((address_space(3))) const char* lds_cptr;
typedef short v4i16_t __attribute__((ext_vector_type(4)));
__device__ __forceinline__ void kload8(bf16x8*kf,lds_cptr kp){
  kf[0]=*(const __attribute__((address_space(3))) bf16x8*)(kp);      kf[1]=*(const __attribute__((address_space(3))) bf16x8*)(kp+512);
  kf[2]=*(const __attribute__((address_space(3))) bf16x8*)(kp+2048); kf[3]=*(const __attribute__((address_space(3))) bf16x8*)(kp+2560);
  kf[4]=*(const __attribute__((address_space(3))) bf16x8*)(kp+4096); kf[5]=*(const __attribute__((address_space(3))) bf16x8*)(kp+4608);
  kf[6]=*(const __attribute__((address_space(3))) bf16x8*)(kp+6144); kf[7]=*(const __attribute__((address_space(3))) bf16x8*)(kp+6656);
}
__device__ __forceinline__ void kload2(bf16x8*kf,lds_cptr kp,int j){ kf[2*j]=*(const __attribute__((address_space(3))) bf16x8*)(kp+j*2048); kf[2*j+1]=*(const __attribute__((address_space(3))) bf16x8*)(kp+j*2048+512); }
__device__ __forceinline__ s16x4 vtr(lds_cptr p){ return __builtin_bit_cast(s16x4,__builtin_amdgcn_ds_read_tr16_b64_v4i16((__attribute__((address_space(3))) v4i16_t*)p)); }
__device__ __forceinline__ float rowmax(const f32x16&p0,const f32x16&p1){
  float a=max3f(p0[0],p0[1],p1[0]),b=max3f(p0[2],p0[3],p1[1]);a=max3f(a,p1[2],p1[3]);
  #pragma unroll
  for(int r=4;r<16;r+=4){a=max3f(a,p0[r],p0[r+1]);b=max3f(b,p0[r+2],p0[r+3]);a=max3f(a,p1[r],p1[r+1]);b=max3f(b,p1[r+2],p1[r+3]);}
  const float m=max2f(a,b);
  auto rr=__builtin_amdgcn_permlane32_swap(__float_as_uint(m),__float_as_uint(m),false,false);
  return max2f(__uint_as_float(rr[0]),__uint_as_float(rr[1]));
}
__device__ __forceinline__ void pv(f32x16*o,int vb,bf16x8 pa0,bf16x8 pa1,bf16x8 pa2,bf16x8 pa3){
  #pragma unroll
  for(int d0=0;d0<2;++d0){s16x4 lo[4],hi[4];
    #pragma unroll
    for(int ks=0;ks<4;++ks){
      asm volatile("ds_read_b64_tr_b16 %0,%1 offset:%c2":"=&v"(lo[ks]):"v"(vb),"i"(d0*4096+ks*1024):"memory");
      asm volatile("ds_read_b64_tr_b16 %0,%1 offset:%c2":"=&v"(hi[ks]):"v"(vb),"i"(d0*4096+ks*1024+512):"memory");}
    asm volatile("s_waitcnt lgkmcnt(0)":::"memory");SBAR();
    #define PK(k) (bf16x8){lo[k][0],lo[k][1],lo[k][2],lo[k][3],hi[k][0],hi[k][1],hi[k][2],hi[k][3]}
    o[d0]=__builtin_amdgcn_mfma_f32_32x32x16_bf16(pa0,PK(0),o[d0],0,0,0);
    o[d0]=__builtin_amdgcn_mfma_f32_32x32x16_bf16(pa1,PK(1),o[d0],0,0,0);
    o[d0]=__builtin_amdgcn_mfma_f32_32x32x16_bf16(pa2,PK(2),o[d0],0,0,0);
    o[d0]=__builtin_amdgcn_mfma_f32_32x32x16_bf16(pa3,PK(3),o[d0],0,0,0);
    #undef PK
  }
}

#ifndef ATTN_STORE16
#define ATTN_STORE16(p,v) (*(u32x4*)(p)=(v))
#endif
template<int THRL,int QP,int KP,int OP> __device__ __forceinline__ void attn_unit(const bf16*Qu,const bf16*__restrict__ Kh,const bf16*__restrict__ Vh,bf16*Ou,const int NT,char*shm){
  const int tid=opaque_tid(),lane=tid&63,r32=lane&31,hi=lane>>5; const int wid=__builtin_amdgcn_readfirstlane(tid>>6);
  const bf16*Qw=Qu+(long)(wid*QBLK)*QP;
  const unsigned lds0=(unsigned)(uintptr_t)shm;
  float*wsf=(float*)(shm+LDS_WS)+wid*64;
  const bf16*ksrc=Kh+(long)lane*KP+wid*8;
  const bf16*vsrc=Vh+(long)(16*(wid&3)+(lane>>2))*KP+(wid>>2)*32+(lane&3)*8;
  const unsigned kdst=lds0+LDS_K+wid*1024, vdst=lds0+LDS_V+wid*1024;
  #define DMA_K(t,slot) glds16(ksrc+(long)(t)*KVBLK*KP,(unsigned)__builtin_amdgcn_readfirstlane(kdst+(slot)))
  #define DMA_V(t,slot) glds16(vsrc+(long)(t)*KVBLK*KP,(unsigned)__builtin_amdgcn_readfirstlane(vdst+(slot)))
  const int vb0=(int)(lds0+LDS_V)+((lane>>4)&1)*32+(lane&3)*8+(4*hi+((lane&15)>>2))*64;
  const char*Kbase=shm+LDS_K; bf16x8 kf[8];
  const lds_cptr shm3=(lds_cptr)shm; const lds_cptr kp0=shm3+LDS_K+hi*1024+r32*16; const lds_cptr vp0=shm3+LDS_V+((lane>>4)&1)*32+(lane&3)*8+(4*hi+((lane&15)>>2))*64;
  DMA_K(0,0);DMA_V(0,0);DMA_K(1,SLOTB);
  bf16x8 qr[4];
  #pragma unroll
  for(int d0=0;d0<4;++d0)qr[d0]=*reinterpret_cast<const bf16x8*>(&Qw[(long)r32*QP+d0*16+hi*8]);
  float mhat=0.f,l_reg=0.f;f32x16 o[2];o[0]=f32x16{};o[1]=f32x16{};f32x16 negm=f32x16{};asm volatile("":"+v"(negm));
  #define CMASK(P0,P1,t) do{}while(0)
  bool resc=false;
  #define START(P0,P1) do{ const float rm=rowmax(P0,P1); resc=false; \
    { const float dl=rm; mhat=fadd_s(mhat,dl); \
      _Pragma("unroll") for(int r=0;r<16;++r){P0[r]=fsub_s(P0[r],dl);P1[r]=fsub_s(P1[r],dl);} \
      _Pragma("unroll") for(int r=0;r<16;++r)negm[r]=-mhat; asm volatile("":"+v"(negm)); } \
    _Pragma("unroll") for(int r=0;r<16;++r)P0[r]=__builtin_amdgcn_exp2f(P0[r]); }while(0)
  #define RESC() do{ if(resc){ asm volatile("s_waitcnt lgkmcnt(0)":::"memory"); \
      _Pragma("unroll") for(int d_=0;d_<2;++d_) _Pragma("unroll") for(int r=0;r<16;++r)o[d_][r]*=wsf[crow(r,hi)]; } }while(0)
  f32x16 pA0,pA1,pB0,pB1;
  int sl_prev=0,sl_cur=0,sl_next=SLOTB;
  #define ROT() do{sl_prev=sl_cur;sl_cur=sl_next;sl_next=(sl_next==(NSLOT-1)*SLOTB)?0:sl_next+SLOTB;}while(0)
  DMA_K(2,2*SLOTB);
  WAIT_BAR(3);
  qkt(pA0,pA1,Kbase,qr,negm,r32,hi);asm volatile("s_nop 15\n\ts_nop 7":"+v"(pA0),"+v"(pA1));CMASK(pA0,pA1,0);
  START(pA0,pA1);
  _Pragma("unroll") for(int r=0;r<16;++r)pA1[r]=__builtin_amdgcn_exp2f(pA1[r]);
  WAIT_BAR(0);
  DMA_K(3,0);DMA_V(1,SLOTB);
  ROT();
  kload8(kf,kp0+sl_cur);
  WAIT_BAR(2);
  s16x4 vlo[8],vhi[8]; u32x4 pw0,pw1,pw2,pw3;
  #define PKW(P,B) cvtpk_s(P[B],P[B+1])
  #define PAF(k) __builtin_bit_cast(bf16x8,pw##k)
  #define VFR(i) (bf16x8){vlo[i][0],vlo[i][1],vlo[i][2],vlo[i][3],vhi[i][0],vhi[i][1],vhi[i][2],vhi[i][3]}
  #define PIN(x) asm volatile("":"+v"(x))
  #define MX3(a,b,c) __builtin_fmaxf(__builtin_fmaxf((a),(b)),(c))
  #define GAPA(MF,A0,A1,A2,A3,W0,W1,PW) do{ MF; sacc+=A0; sacc+=A1; sacc+=A2; sacc+=A3; PIN(sacc); W0; W1; PIN(PW); SBAR(); }while(0)
  #define EX(v) __builtin_amdgcn_exp2f(v)
  #define GAPB(MF,X,B) do{ MF; X[B]=EX(X[B]); X[B+1]=EX(X[B+1]); X[B+2]=EX(X[B+2]); X[B+3]=EX(X[B+3]); PIN(X); SBAR(); }while(0)
  #define VRD(i) do{ vlo[i]=vtr(vp_+(((i)>>2)*4096+((i)&3)*1024)); vhi[i]=vtr(vp_+(((i)>>2)*4096+((i)&3)*1024+512)); }while(0)
  #define KRD(G,j) do{ if(G){ kload2(kf,kp0+sl_next,j); SBAR(); } }while(0)
  #define STEP(C0,C1,P0,P1,t,GK,GV,GL) do{ SBAR(); \
    const lds_cptr vp_=vp0+sl_prev; \
    VRD(0); SBAR(); float sacc=(P0[0]+P0[1]); \
    GAPA(C0=__builtin_amdgcn_mfma_f32_32x32x16_bf16(kf[0],qr[0],negm,0,0,0), P0[2],P0[3],P0[4],P0[5],     pw0[0]=PKW(P0,0), pw0[1]=PKW(P0,2), pw0); \
    VRD(4); SBAR(); GAPA(C1=__builtin_amdgcn_mfma_f32_32x32x16_bf16(kf[1],qr[0],negm,0,0,0), P0[6],P0[7],P0[8],P0[9],     pw0[2]=PKW(P0,4), pw0[3]=PKW(P0,6), pw0); \
    VRD(1); SBAR(); GAPA(C0=__builtin_amdgcn_mfma_f32_32x32x16_bf16(kf[2],qr[1],C0,0,0,0),   P0[10],P0[11],P0[12],P0[13], pw1[0]=PKW(P0,8), pw1[1]=PKW(P0,10), pw1); \
    VRD(5); SBAR(); GAPA(C1=__builtin_amdgcn_mfma_f32_32x32x16_bf16(kf[3],qr[1],C1,0,0,0),   P0[14],P0[15],P1[0],P1[1],   pw1[2]=PKW(P0,12),pw1[3]=PKW(P0,14), pw1); \
    VRD(2); SBAR(); GAPA(C0=__builtin_amdgcn_mfma_f32_32x32x16_bf16(kf[4],qr[2],C0,0,0,0),   P1[2],P1[3],P1[4],P1[5],     pw2[0]=PKW(P1,0), pw2[1]=PKW(P1,2), pw2); \
    VRD(6); SBAR(); GAPA(C1=__builtin_amdgcn_mfma_f32_32x32x16_bf16(kf[5],qr[2],C1,0,0,0),   P1[6],P1[7],P1[8],P1[9],     pw2[2]=PKW(P1,4), pw2[3]=PKW(P1,6), pw2); \
    VRD(3); SBAR(); GAPA(C0=__builtin_amdgcn_mfma_f32_32x32x16_bf16(kf[6],qr[3],C0,0,0,0),   P1[10],P1[11],P1[12],P1[13], pw3[0]=PKW(P1,8), pw3[1]=PKW(P1,10), pw3); \
    VRD(7); SBAR(); GAPA(C1=__builtin_amdgcn_mfma_f32_32x32x16_bf16(kf[7],qr[3],C1,0,0,0),   P1[14],P1[15],0.f,0.f,       pw3[2]=PKW(P1,12),pw3[3]=PKW(P1,14), pw3); \
    l_reg+=sacc; \
    if(GK){DMA_K((t)+3,sl_cur);} if(GV){DMA_V((t)+1,sl_next);} \
    CMASK(C0,C1,t); \
    { float a=MX3(C0[0],C0[1],C1[0]),b=MX3(C0[2],C0[3],C1[1]); a=MX3(a,C1[2],C1[3]); \
      _Pragma("unroll") for(int r=4;r<16;r+=4){a=MX3(a,C0[r],C0[r+1]);b=MX3(b,C0[r+2],C0[r+3]);a=MX3(a,C1[r],C1[r+1]);b=MX3(b,C1[r+2],C1[r+3]);} \
      float rm=__builtin_fmaxf(a,b); { auto rr=__builtin_amdgcn_permlane32_swap(__float_as_uint(rm),__float_as_uint(rm),false,false); rm=__builtin_fmaxf(__uint_as_float(rr[0]),__uint_as_float(rr[1])); } \
      resc=false; \
      if(__builtin_expect(__any(rm>(float)THRL),0)){ const float dl=__builtin_fmaxf(rm,0.f); mhat+=dl; \
        _Pragma("unroll") for(int r=0;r<16;++r){C0[r]-=dl;C1[r]-=dl;} \
        _Pragma("unroll") for(int r=0;r<16;++r)negm[r]=-mhat; asm volatile("":"+v"(negm)); \
        const float f=__builtin_amdgcn_exp2f(-dl); l_reg*=f; if(hi==0)wsf[r32]=f; resc=true; } } \
    SBAR(); \
    GAPB(o[0]=__builtin_amdgcn_mfma_f32_32x32x16_bf16(PAF(0),VFR(0),o[0],0,0,0), C0,0); \
    GAPB(o[1]=__builtin_amdgcn_mfma_f32_32x32x16_bf16(PAF(0),VFR(4),o[1],0,0,0), C0,4); \
    KRD(GL,0); GAPB(o[0]=__builtin_amdgcn_mfma_f32_32x32x16_bf16(PAF(1),VFR(1),o[0],0,0,0), C0,8); \
    KRD(GL,1); GAPB(o[1]=__builtin_amdgcn_mfma_f32_32x32x16_bf16(PAF(1),VFR(5),o[1],0,0,0), C0,12); \
    KRD(GL,2); GAPB(o[0]=__builtin_amdgcn_mfma_f32_32x32x16_bf16(PAF(2),VFR(2),o[0],0,0,0), C1,0); \
    KRD(GL,3); GAPB(o[1]=__builtin_amdgcn_mfma_f32_32x32x16_bf16(PAF(2),VFR(6),o[1],0,0,0), C1,4); \
    GAPB(o[0]=__builtin_amdgcn_mfma_f32_32x32x16_bf16(PAF(3),VFR(3),o[0],0,0,0), C1,8); \
    GAPB(o[1]=__builtin_amdgcn_mfma_f32_32x32x16_bf16(PAF(3),VFR(7),o[1],0,0,0), C1,12); \
    }while(0)
  int t=1;
  #undef CMASK
  #define CMASK(P0,P1,t) do{}while(0)
  for(;t+5<NT;t+=2){
    STEP(pB0,pB1,pA0,pA1,t,true,true,true);     WAIT_BAR(2); RESC(); ROT();
    STEP(pA0,pA1,pB0,pB1,t+1,true,true,true);   WAIT_BAR(2); RESC(); ROT();
  }
  #undef CMASK
  #define CMASK(P0,P1,t) do{}while(0)
  #define ENDW(tt) do{ if((tt)+3<NT){WAIT_BAR(2);} else if((tt)+2<NT){WAIT_BAR(1);} else {WAIT_BAR(0);} }while(0)
  for(;t+1<NT;t+=2){
    STEP(pB0,pB1,pA0,pA1,t,(t+3<NT),(t+1<NT),(t+1<NT));       ENDW(t);   RESC(); ROT();
    STEP(pA0,pA1,pB0,pB1,t+1,(t+4<NT),(t+2<NT),(t+2<NT));     ENDW(t+1); RESC(); ROT();
  }
  STEP(pB0,pB1,pA0,pA1,NT-1,false,false,false); RESC();
  { float sacc=pB0[0]+pB0[1]; _Pragma("unroll") for(int r=2;r<16;++r)sacc+=pB0[r]; _Pragma("unroll") for(int r=0;r<16;++r)sacc+=pB1[r]; l_reg+=sacc;
    pw0=(u32x4){PKW(pB0,0),PKW(pB0,2),PKW(pB0,4),PKW(pB0,6)};pw1=(u32x4){PKW(pB0,8),PKW(pB0,10),PKW(pB0,12),PKW(pB0,14)};pw2=(u32x4){PKW(pB1,0),PKW(pB1,2),PKW(pB1,4),PKW(pB1,6)};pw3=(u32x4){PKW(pB1,8),PKW(pB1,10),PKW(pB1,12),PKW(pB1,14)};
    SBAR(); pv(o,vb0+sl_cur,PAF(0),PAF(1),PAF(2),PAF(3)); }
  #undef PKW
  #undef PAF
  #undef VFR
  #undef PIN
  #undef MX3
  #undef GAPA
  #undef GAPB
  #undef EX
  #undef VRD
  #undef KRD
  #undef STEP
  #undef ENDW
  {auto rr=__builtin_amdgcn_permlane32_swap(__float_as_uint(l_reg),__float_as_uint(l_reg),false,false);l_reg=__uint_as_float(rr[0])+__uint_as_float(rr[1]);}
  if(hi==0)wsf[32+r32]=l_reg;asm volatile("s_waitcnt lgkmcnt(0)":::"memory");
  float rli[16];
  #pragma unroll
  for(int r=0;r<16;++r)rli[r]=__builtin_amdgcn_rcpf(wsf[32+crow(r,hi)]);
  bf16*Ow=Ou+(long)(wid*QBLK)*OP;
  { bf16*stg=(bf16*)(shm+LDS_OST)+wid*2048;
    #pragma unroll
    for(int r=0;r<16;++r){const int orow=crow(r,hi);
      #pragma unroll
      for(int d0=0;d0<2;++d0)stg[orow*64+d0*32+r32]=__float2bfloat16(o[d0][r]*rli[r]);}
    asm volatile("s_waitcnt lgkmcnt(0)":::"memory");
    #pragma unroll
    for(int i=0;i<4;++i){const int row=i*8+(lane>>3),ch=lane&7; const u32x4 v=*(const u32x4*)(stg+row*64+ch*8); ATTN_STORE16(Ow+(long)row*OP+ch*8,v);} }
  asm volatile("s_waitcnt lgkmcnt(0)\n\ts_barrier":::"memory");
  #undef DMA_K
  #undef DMA_V
  #undef CMASK
  #undef START
  #undef RESC
  #undef ROT
}
constexpr int ATTN_LDS_BYTES=LDS_BYTES;
#undef SBAR
#undef WAIT_BAR
}
#define LDS_WAIT() asm volatile("s_waitcnt lgkmcnt(0)" ::: "memory")

__device__ __forceinline__ void transpose_item(const float* W, int K, int N, bf16* WT, int k0, int n0, int dest_row0, LAS float* scr, int lane) {
    float t_[32];
#pragma unroll
    for (int i = 0; i < 32; ++i) t_[i] = W[(size_t)(k0 + 2 * i + (lane >> 5)) * N + n0 + (lane & 31)];
#pragma unroll
    for (int i = 0; i < 32; ++i) scr[(2 * i + (lane >> 5)) * 33 + (lane & 31)] = t_[i];
    LDS_WAIT(); asm volatile("" ::: "memory");
    const int c = lane & 7;
#pragma unroll
    for (int j = 0; j < 4; ++j) { const int n = (lane >> 3) + 8 * j; const LAS float* s = scr + (8 * c) * 33 + n;
        v4u o; o.x = pk2(s[0 * 33], s[1 * 33]); o.y = pk2(s[2 * 33], s[3 * 33]); o.z = pk2(s[4 * 33], s[5 * 33]); o.w = pk2(s[6 * 33], s[7 * 33]);
        *(GAS v4u*)(WT + (size_t)(dest_row0 + n) * K + k0 + 8 * c) = o; }
    LDS_WAIT(); asm volatile("" ::: "memory");
}

__device__ __forceinline__ void transpose_item8(const float* W, int K, int N, unsigned char* WT, int k0, int n0, int dest_row0, float sc, LAS float* scr, int lane) {
    float t_[32];
#pragma unroll
    for (int i = 0; i < 32; ++i) t_[i] = W[(size_t)(k0 + 2 * i + (lane >> 5)) * N + n0 + (lane & 31)];
#pragma unroll
    for (int i = 0; i < 32; ++i) scr[(2 * i + (lane >> 5)) * 33 + (lane & 31)] = t_[i] * sc;
    LDS_WAIT(); asm volatile("" ::: "memory");
    const int c = lane & 7;
#pragma unroll
    for (int j = 0; j < 4; ++j) { const int n = (lane >> 3) + 8 * j; const LAS float* s = scr + (8 * c) * 33 + n;
        unsigned w0 = 0, w1 = 0;
        w0 = __builtin_amdgcn_cvt_pk_fp8_f32(s[0 * 33], s[1 * 33], w0, false); w0 = __builtin_amdgcn_cvt_pk_fp8_f32(s[2 * 33], s[3 * 33], w0, true);
        w1 = __builtin_amdgcn_cvt_pk_fp8_f32(s[4 * 33], s[5 * 33], w1, false); w1 = __builtin_amdgcn_cvt_pk_fp8_f32(s[6 * 33], s[7 * 33], w1, true);
        *(GAS v2u*)(WT + (size_t)(dest_row0 + n) * K + k0 + 8 * c) = (v2u){w0, w1}; }
    LDS_WAIT(); asm volatile("" ::: "memory");
}

struct ProIn { const float *hy_w_in, *at_w_in, *w_out, *w_mem_kv, *w_gate, *w_up, *w_down; };
__device__ __forceinline__ void phase_weights(const ProIn& P, unsigned char* ws, LAS unsigned char* lds, int gw, int NGW, int wave, int lane) {
    LAS float* scr = (LAS float*)(lds + wave * 16384);
    constexpr int I_HY = 16 * 80, I_AT = 16 * 48, I_OUT = 16 * 32, I_MKV = 16 * 16, I_GU = 16 * 24, I_DN = 12 * 32;
    constexpr int E0 = 2 * I_HY, E1 = E0 + 2 * I_AT, E2 = E1 + 4 * I_OUT, E3 = E2 + 4 * I_MKV, E4 = E3 + 64 * I_GU, E5 = E4 + 64 * I_GU, E6 = E5 + 64 * I_DN;
    for (int it = gw; it < E6; it += NGW) {
        int r = it;
        if (r < E0) { const int j = r / I_HY, q = r % I_HY, kb = q / 80, nb = q % 80;
            transpose_item(P.hy_w_in + (size_t)j * DM * D_IN_HY, DM, D_IN_HY, (bf16*)(ws + WS_WHY) + (size_t)j * D_IN_HY * DM, 64 * kb, 32 * nb, 32 * nb, scr, lane); continue; }
        r -= E0;
        if (r < 2 * I_AT) { const int j = r / I_AT, q = r % I_AT, kb = q / 48, nb = q % 48;
            const int n0 = 32 * nb, o = n0 & 255;
            transpose_item(P.at_w_in + (size_t)j * DM * D_IN_AT, DM, D_IN_AT, (bf16*)(ws + WS_WAT) + (size_t)j * D_IN_AT * DM, 64 * kb, n0, (n0 & ~255) + 128 * ((o & 63) >> 5) + 32 * (o >> 6), scr, lane); continue; }
        r -= 2 * I_AT;
        if (r < 4 * I_OUT) { const int j = r / I_OUT, q = r % I_OUT, kb = q / 32, nb = q % 32;
            transpose_item(P.w_out + (size_t)j * DM * DM, DM, DM, (bf16*)(ws + WS_WOUT) + (size_t)j * DM * DM, 64 * kb, 32 * nb, 32 * nb, scr, lane); continue; }
        r -= 4 * I_OUT;
        if (r < 4 * I_MKV) { const int j = r / I_MKV, q = r % I_MKV, kb = q / 16, nb = q % 16;
            transpose_item(P.w_mem_kv + (size_t)j * DM * 512, DM, 512, (bf16*)(ws + WS_WMKV), 64 * kb, 32 * nb, j * 512 + 32 * nb, scr, lane); continue; }
        r -= 4 * I_MKV;
        if (r < 64 * I_GU) { const int j = r / I_GU, q = r % I_GU, kb = q / 24, nb = q % 24, n0 = 32 * nb;
            transpose_item8(P.w_gate + (size_t)j * DM * EFF, DM, EFF, (unsigned char*)(ws + WS_W1) + (size_t)j * 1536 * DM, 64 * kb, n0, (n0 >> 7) * 256 + (n0 & 127), W8_SCALE, scr, lane); continue; }
        r -= 64 * I_GU;
        if (r < 64 * I_GU) { const int j = r / I_GU, q = r % I_GU, kb = q / 24, nb = q % 24, n0 = 32 * nb;
            transpose_item8(P.w_up + (size_t)j * DM * EFF, DM, EFF, (unsigned char*)(ws + WS_W1) + (size_t)j * 1536 * DM, 64 * kb, n0, (n0 >> 7) * 256 + 128 + (n0 & 127), W8_SCALE, scr, lane); continue; }
        r -= 64 * I_GU;
        { const int j = r / I_DN, q = r % I_DN, kb = q / 32, nb = q % 32;
            transpose_item8(P.w_down + (size_t)j * EFF * DM, EFF, DM, (unsigned char*)(ws + WS_W2) + (size_t)j * DM * EFF, 64 * kb, 32 * nb, 32 * nb, W8_SCALE, scr, lane); }
    }
}

__device__ __forceinline__ void rms_row_bf16(const float* xrow, const float* g, bf16* orow, int lane) {
    const GAS f32x4* xr = (const GAS f32x4*)xrow + lane; const GAS f32x4* gr = (const GAS f32x4*)g + lane;
    f32x4 v[4]; float s = 0.f;
#pragma unroll
    for (int j = 0; j < 4; ++j) { v[j] = xr[64 * j]; s += (v[j].x * v[j].x + v[j].y * v[j].y) + (v[j].z * v[j].z + v[j].w * v[j].w); }
    const float rstd = 1.f / sqrtf(wave_sum(s) * (1.f / DM) + NORM_EPS);
    GAS v2u* o8 = (GAS v2u*)orow + lane;
#pragma unroll
    for (int j = 0; j < 4; ++j) { const f32x4 gg = gr[64 * j]; v2u w; w.x = pk2(v[j].x * rstd * gg.x, v[j].y * rstd * gg.y); w.y = pk2(v[j].z * rstd * gg.z, v[j].w * rstd * gg.w); o8[64 * j] = w; }
}

__device__ __forceinline__ void phase_mem_h2(const float* mem, const float* mem_g, const float* fw1, const float* fb1, const float* fw2, const float* fb2, const float* ffreq,
                                              unsigned char* ws, int gw, int NGW, int lane) {
    for (int m = gw; m < BATCH * MEM_LEN; m += NGW) rms_row_bf16(mem + (size_t)m * DM, mem_g, (bf16*)(ws + WS_MEMN) + (size_t)m * DM, lane);
    float* H2 = (float*)(ws + WS_H2);
    for (int it = gw; it < 2 * SEQ; it += NGW) {
        const int j = it / SEQ, n = it % SEQ;
        const float* w1 = fw1 + j * HY_EMB * HY_FILT; const float* w2 = fw2 + j * HY_FILT * HY_FILT;
        const float t = (float)n * (1.0f / (float)(SEQ - 1));
        const float w = (6.283185307179586f * (float)n) / (float)SEQ;
        float feat = 0.f;
        if (lane == 0) feat = t;
        else if (lane <= 16) { const float band = 1e-4f + (float)(lane - 1) * ((15.0f - 1e-4f) / 15.0f); feat = cosf(band * w); }
        else if (lane <= 32) { const float band = 1e-4f + (float)(lane - 17) * ((15.0f - 1e-4f) / 15.0f); feat = -sinf(band * w); }
        const float fr = ffreq[j * HY_FILT + lane];
        float a = fb1[j * HY_FILT + lane];
        for (int i = 0; i < HY_EMB; ++i) a += __shfl(feat, i) * w1[i * HY_FILT + lane];
        const float h1 = sinf(fr * a);
        float a2 = fb2[j * HY_FILT + lane];
        for (int i = 0; i < HY_FILT; ++i) a2 += __shfl(h1, i) * w2[i * HY_FILT + lane];
        H2[(size_t)it * HY_FILT + lane] = sinf(fr * a2);
    }
}

template <bool COMBINE, bool FINAL>
__device__ __forceinline__ void phase_norm(const float* hin, float* hout, const float* g, bf16* U, float* fout, const int* POS, const bf16* Y, int gw, int NGW, int lane) {
    int m = gw;
    if (m >= M_TOK) return;
    f32x4 cur[4]; int cpos = -1;
    { const GAS f32x4* xr = (const GAS f32x4*)(hin + (size_t)m * DM) + lane;
#pragma unroll
      for (int j = 0; j < 4; ++j) cur[j] = xr[64 * j];
      if (COMBINE) { const int b = m / SEQ, t = m % SEQ; if (lane < NEXP) cpos = POS[(size_t)(b * NEXP + lane) * SEQ + t]; } }
#pragma unroll 1
    for (; m < M_TOK; m += NGW) {
        const int mn = m + NGW; f32x4 nxt[4]; int npos = -1;
#pragma unroll
        for (int j = 0; j < 4; ++j) nxt[j] = cur[j];
        if (mn < M_TOK) { const GAS f32x4* xr = (const GAS f32x4*)(hin + (size_t)mn * DM) + lane;
#pragma unroll
            for (int j = 0; j < 4; ++j) nxt[j] = xr[64 * j];
            if (COMBINE) { const int b = mn / SEQ, t = mn % SEQ; if (lane < NEXP) npos = POS[(size_t)(b * NEXP + lane) * SEQ + t]; } }
        f32x4 v[4];
#pragma unroll
        for (int j = 0; j < 4; ++j) v[j] = cur[j];
        if (COMBINE) {
            const int b = m / SEQ;
            unsigned long long mask = __ballot(cpos >= 0);
            while (mask) {
                v2u y[4][4]; bool has[4];
#pragma unroll
                for (int k = 0; k < 4; ++k) { has[k] = mask != 0ull;
                    if (has[k]) { const int e = __builtin_amdgcn_readfirstlane(__builtin_ctzll(mask)); mask &= mask - 1ull; const int p = __builtin_amdgcn_readlane(cpos, e);
                        const GAS v2u* yr = (const GAS v2u*)(Y + ((size_t)(b * NEXP + e) * CAP + p) * DM) + lane;
#pragma unroll
                        for (int j = 0; j < 4; ++j) y[k][j] = yr[64 * j]; } }
#pragma unroll
                for (int k = 0; k < 4; ++k) if (has[k]) {
#pragma unroll
                    for (int j = 0; j < 4; ++j) { const v2u w = y[k][j]; v[j].x += bflo(w.x); v[j].y += bfhi(w.x); v[j].z += bflo(w.y); v[j].w += bfhi(w.y); } }
            }
            if (!FINAL) { GAS f32x4* ho = (GAS f32x4*)(hout + (size_t)m * DM) + lane;
#pragma unroll
                for (int j = 0; j < 4; ++j) ho[64 * j] = v[j]; }
        }
        float s = 0.f;
#pragma unroll
        for (int j = 0; j < 4; ++j) s += (v[j].x * v[j].x + v[j].y * v[j].y) + (v[j].z * v[j].z + v[j].w * v[j].w);
        const float rstd = 1.f / sqrtf(wave_sum(s) * (1.f / DM) + NORM_EPS);
        const GAS f32x4* gr = (const GAS f32x4*)g + lane;
        if (FINAL) { GAS f32x4* o = (GAS f32x4*)(fout + (size_t)m * DM) + lane;
#pragma unroll
            for (int j = 0; j < 4; ++j) o[64 * j] = v[j] * rstd * gr[64 * j]; }
        else { GAS v2u* o8 = (GAS v2u*)(U + (size_t)m * DM) + lane;
#pragma unroll
            for (int j = 0; j < 4; ++j) { const f32x4 gg = gr[64 * j]; v2u w; w.x = pk2(v[j].x * rstd * gg.x, v[j].y * rstd * gg.y); w.y = pk2(v[j].z * rstd * gg.z, v[j].w * rstd * gg.w); o8[64 * j] = w; } }
#pragma unroll
        for (int j = 0; j < 4; ++j) cur[j] = nxt[j];
        cpos = npos;
    }
}

__device__ __forceinline__ void phase_ffn_norm_router(const float* H, const float* g, const float* Wr, unsigned char* XN8, float* AFF, LAS unsigned char* lds, int gw, int NGW, int lane, int tid) {
    LAS f32x4* WL = (LAS f32x4*)lds;
    for (int q = tid; q < 64 * 64; q += NTHREADS) { const int ln = q & 63, s = q >> 6, e4 = s & 3, ji = s >> 2, i = ji & 3, j = ji >> 2; const int d = 4 * ln + i + 256 * j;
        WL[q] = *(const GAS f32x4*)(Wr + (size_t)d * NEXP + 4 * e4); }
    __syncthreads();
    constexpr int R = 4;
    const GAS f32x4* gr = (const GAS f32x4*)g + lane;
#pragma unroll 1
    for (int m0 = gw * R; m0 < M_TOK; m0 += NGW * R) {
        int lo_ = lane; asm volatile("" : "+v"(lo_));
        f32x4 v[R][4]; float rstd[R];
#pragma unroll
        for (int r = 0; r < R; ++r) { const GAS f32x4* xr = (const GAS f32x4*)(H + (size_t)(m0 + r) * DM) + lane;
#pragma unroll
            for (int j = 0; j < 4; ++j) v[r][j] = xr[64 * j]; }
#pragma unroll
        for (int r = 0; r < R; ++r) { float s = 0.f;
#pragma unroll
            for (int j = 0; j < 4; ++j) s += (v[r][j].x * v[r][j].x + v[r][j].y * v[r][j].y) + (v[r][j].z * v[r][j].z + v[r][j].w * v[r][j].w);
            rstd[r] = 1.f / sqrtf(wave_sum(s) * (1.f / DM) + NORM_EPS); }
        f32x4 lg[R][4];
#pragma unroll
        for (int r = 0; r < R; ++r)
#pragma unroll
            for (int e4 = 0; e4 < 4; ++e4) lg[r][e4] = (f32x4){0.f, 0.f, 0.f, 0.f};
#pragma unroll
        for (int j = 0; j < 4; ++j) { const f32x4 gg = gr[64 * j];
#pragma unroll
            for (int r = 0; r < R; ++r) { v[r][j] = v[r][j] * rstd[r] * gg;
                unsigned w = 0; w = __builtin_amdgcn_cvt_pk_fp8_f32(v[r][j].x, v[r][j].y, w, false); w = __builtin_amdgcn_cvt_pk_fp8_f32(v[r][j].z, v[r][j].w, w, true);
                ((GAS unsigned*)(XN8 + (size_t)(m0 + r) * DM) + lane)[64 * j] = w; }
#pragma unroll
            for (int i = 0; i < 4; ++i)
#pragma unroll
                for (int e4 = 0; e4 < 4; ++e4) { const f32x4 wv = WL[((j * 4 + i) * 4 + e4) * 64 + lo_];
#pragma unroll
                    for (int r = 0; r < R; ++r) { const float xs = v[r][j][i];
#pragma unroll
                        for (int c = 0; c < 4; ++c) asm("v_fmac_f32 %0, %1, %2" : "+v"(lg[r][e4][c]) : "v"(wv[c]), "v"(xs)); } }
            __builtin_amdgcn_sched_barrier(0); }
#pragma unroll
        for (int r = 0; r < R; ++r) {
            float l16[16];
#pragma unroll
            for (int e = 0; e < 16; ++e) l16[e] = wave_sum(lg[r][e >> 2][e & 3]);
            float mx = l16[0];
#pragma unroll
            for (int e = 1; e < 16; ++e) mx = fmaxf(mx, l16[e]);
            float den = 0.f;
#pragma unroll
            for (int e = 0; e < 16; ++e) { l16[e] = expf(l16[e] - mx); den += l16[e]; }
            float mine = 0.f;
#pragma unroll
            for (int e = 0; e < 16; ++e) mine = (lane == e) ? l16[e] : mine;
            const int m = m0 + r, b = m / SEQ, t = m % SEQ;
            if (lane < NEXP) AFF[(size_t)(b * NEXP + lane) * SEQ + t] = mine / den;
        }
    }
    __syncthreads();
}

__device__ __forceinline__ int block_excl_scan(int v, LAS int* scr, int tid, int lane, int wave, int* tot) {
    int inc = v;
#pragma unroll
    for (int o = 1; o < 64; o <<= 1) { const int n = __shfl_up(inc, o); if (lane >= o) inc += n; }
    __syncthreads();
    if (lane == 63) scr[wave] = inc;
    __syncthreads();
    int base = 0, total = 0;
#pragma unroll
    for (int w = 0; w < NWAVES; ++w) { const int c = scr[w]; if (w < wave) base += c; total += c; }
    *tot = total;
    return base + inc - v;
}

__device__ __forceinline__ void phase_topk(const float* AFF, int* IDX, float* GATE, int* POS, LAS unsigned char* ldsm, int blk, int nblk, int tid, int lane, int wave) {
    LAS int* hist = (LAS int*)ldsm;
    LAS int* sel = (LAS int*)(ldsm + 1024);
    LAS int* scr = (LAS int*)(ldsm + 1280);
    for (int g = blk; g < NGRP; g += nblk) {
        unsigned v[16];
        { const GAS v4u* src = (const GAS v4u*)(AFF + (size_t)g * SEQ) + tid * 4;
#pragma unroll
          for (int q = 0; q < 4; ++q) { const v4u w = src[q]; v[4 * q] = w.x; v[4 * q + 1] = w.y; v[4 * q + 2] = w.z; v[4 * q + 3] = w.w; } }
        unsigned prefix = 0u; int krem = CAP;
#pragma unroll 1
        for (int pass = 0; pass < 4; ++pass) {
            const int shift = 24 - 8 * pass;
            const unsigned himask = (pass == 0) ? 0u : (0xffffffffu << (shift + 8));
            __syncthreads();
            if (tid < 256) hist[tid] = 0;
            __syncthreads();
#pragma unroll
            for (int i = 0; i < 16; ++i) if ((v[i] & himask) == prefix) __hip_atomic_fetch_add(hist + ((v[i] >> shift) & 255u), 1, __ATOMIC_RELAXED, __HIP_MEMORY_SCOPE_WORKGROUP);
            __syncthreads();
            if (wave == 0) {
                int c[4]; int s = 0;
#pragma unroll
                for (int j = 0; j < 4; ++j) { c[j] = hist[255 - 4 * lane - j]; s += c[j]; }
                int inc = s;
#pragma unroll
                for (int o = 1; o < 64; o <<= 1) { const int n = __shfl_up(inc, o); if (lane >= o) inc += n; }
                int before = inc - s;
                if (before < krem && krem <= inc) {
                    int bin = 0, kk = krem - before; bool done = false;
#pragma unroll
                    for (int j = 0; j < 4; ++j) { if (!done) { if (kk <= c[j]) { bin = 255 - 4 * lane - j; done = true; } else kk -= c[j]; } }
                    sel[0] = bin; sel[1] = kk;
                }
            }
            __syncthreads();
            prefix |= ((unsigned)sel[0]) << shift; krem = sel[1];
        }
        int ceq = 0;
#pragma unroll
        for (int i = 0; i < 16; ++i) ceq += (v[i] == prefix) ? 1 : 0;
        int tot;
        int eqrank = block_excl_scan(ceq, scr, tid, lane, wave, &tot);
        int csel = 0; unsigned selmask = 0u;
#pragma unroll
        for (int i = 0; i < 16; ++i) { bool s = v[i] > prefix; if (v[i] == prefix) { s = eqrank < krem; ++eqrank; } if (s) { selmask |= 1u << i; ++csel; } }
        int slot = block_excl_scan(csel, scr, tid, lane, wave, &tot);
        const int b = g / NEXP;
        int pv[16];
#pragma unroll
        for (int i = 0; i < 16; ++i) {
            pv[i] = -1;
            if (selmask & (1u << i)) { pv[i] = slot; IDX[g * CAP + slot] = b * SEQ + tid * 16 + i; GATE[g * CAP + slot] = __builtin_bit_cast(float, v[i]); ++slot; }
        }
        { GAS v4u* dst = (GAS v4u*)(POS + (size_t)g * SEQ) + tid * 4;
#pragma unroll
          for (int q = 0; q < 4; ++q) { v4u w; w.x = (unsigned)pv[4 * q]; w.y = (unsigned)pv[4 * q + 1]; w.z = (unsigned)pv[4 * q + 2]; w.w = (unsigned)pv[4 * q + 3]; dst[q] = w; } }
        __syncthreads();
    }
}

__device__ __forceinline__ void phase_gather(const bf16* XN, const int* IDX, bf16* XG, int gw, int NGW, int lane) {
    for (int r = gw; r < XROWS; r += NGW) {
        const int src = __builtin_amdgcn_readfirstlane(IDX[r]);
        const GAS v4u* s = (const GAS v4u*)(XN + (size_t)src * DM) + lane; GAS v4u* d = (GAS v4u*)(XG + (size_t)r * DM) + lane;
        const v4u a = s[0], b = s[64]; d[0] = a; d[64] = b;
    }
}

__device__ __forceinline__ void phase_qk_rope(bf16* P, const float* gq, const float* gk, int gw, int NGW, int lane) {
    const int hh = lane >> 2, part = lane & 3, axis = part >> 1, half = part & 1;
    const float* g = (hh < NQH ? gq : gk) + 16 * part;
    float gv[16], inv[16];
#pragma unroll
    for (int i = 0; i < 16; ++i) { gv[i] = g[i]; inv[i] = exp2f(-(float)i * (13.287712379549449f / 16.0f)); }
    const float osc = hh < NQH ? ATT_C2 : 1.0f;
    int m = gw; v4u c0 = (v4u){0u, 0u, 0u, 0u}, c1 = c0;
    if (m < M_TOK) { const GAS v4u* p = (const GAS v4u*)(P + (size_t)m * D_IN_AT + hh * HD + 16 * part); c0 = p[0]; c1 = p[1]; }
#pragma unroll 1
    for (; m < M_TOK; m += NGW) {
        const int t = m % SEQ; const float pos = (float)(axis == 0 ? (t >> 6) : (t & 63));
        GAS v4u* p = (GAS v4u*)(P + (size_t)m * D_IN_AT + hh * HD + 16 * part);
        const v4u w0 = c0, w1 = c1;
        if (m + NGW < M_TOK) { const GAS v4u* pn = (const GAS v4u*)(P + (size_t)(m + NGW) * D_IN_AT + hh * HD + 16 * part); c0 = pn[0]; c1 = pn[1]; }
        float x[16];
        x[0] = bflo(w0.x); x[1] = bfhi(w0.x); x[2] = bflo(w0.y); x[3] = bfhi(w0.y); x[4] = bflo(w0.z); x[5] = bfhi(w0.z); x[6] = bflo(w0.w); x[7] = bfhi(w0.w);
        x[8] = bflo(w1.x); x[9] = bfhi(w1.x); x[10] = bflo(w1.y); x[11] = bfhi(w1.y); x[12] = bflo(w1.z); x[13] = bfhi(w1.z); x[14] = bflo(w1.w); x[15] = bfhi(w1.w);
        float ss = 0.f;
#pragma unroll
        for (int i = 0; i < 16; ++i) ss += x[i] * x[i];
        ss += __shfl_xor(ss, 1); ss += __shfl_xor(ss, 2);
        const float rstd = 1.f / sqrtf(ss * (1.f / HD) + NORM_EPS);
        float o[16];
#pragma unroll
        for (int i = 0; i < 16; ++i) {
            const float xn = x[i] * rstd * gv[i]; const float xp = __shfl_xor(xn, 1);
            float sn, cs; sincosf(pos * inv[i], &sn, &cs);
            o[i] = (half == 0 ? (xn * cs - xp * sn) : (xp * sn + xn * cs)) * osc;
        }
        v4u r0, r1;
        r0.x = pk2(o[0], o[1]); r0.y = pk2(o[2], o[3]); r0.z = pk2(o[4], o[5]); r0.w = pk2(o[6], o[7]);
        r1.x = pk2(o[8], o[9]); r1.y = pk2(o[10], o[11]); r1.z = pk2(o[12], o[13]); r1.w = pk2(o[14], o[15]);
        p[0] = r0; p[1] = r1;
    }
}

__device__ __forceinline__ void phase_transpose_mix(const bf16* MIXT, bf16* MIX, int blk, int nblk, int tid) {
    for (int it = blk; it < (D_MAIN / 64) * (M_TOK / NTHREADS); it += nblk) {
        const int cb = it % (D_MAIN / 64), mb = it / (D_MAIN / 64); const int m = mb * NTHREADS + tid, c0 = cb * 64;
        unsigned w[32];
#pragma unroll
        for (int c = 0; c < 32; ++c) { const unsigned lo = MIXT[(size_t)(c0 + 2 * c) * M_TOK + m], hi = MIXT[(size_t)(c0 + 2 * c + 1) * M_TOK + m]; w[c] = lo | (hi << 16); }
        GAS v4u* d = (GAS v4u*)(MIX + (size_t)m * DM + c0);
#pragma unroll
        for (int q = 0; q < 8; ++q) { v4u o; o.x = w[4 * q]; o.y = w[4 * q + 1]; o.z = w[4 * q + 2]; o.w = w[4 * q + 3]; d[q] = o; }
    }
}
__device__ __forceinline__ void phase_taps(const float* H2j, const float* w3, bf16* TAPS, int gw, int NGW, int lane) {
    typedef float f32x16 __attribute__((ext_vector_type(16))); typedef short bf16x8_t __attribute__((ext_vector_type(8)));
    const float min_decay = -4.605170185988091f / 1.5f, max_decay = -4.605170185988091f / 0.3f;
    const int li = lane & 31, hi = lane >> 5;
#pragma unroll 1
    for (int it = gw; it < (FCOLS / 32) * (SEQ / 128); it += NGW) {
        const int ct = it % (FCOLS / 32), ng = it / (FCOLS / 32), col0 = ct * 32;
        bf16x8_t a[4];
#pragma unroll
        for (int s = 0; s < 4; ++s) { float t[8];
#pragma unroll
            for (int j = 0; j < 8; ++j) t[j] = w3[(size_t)(16 * s + 8 * hi + j) * FCOLS + col0 + li];
            v4u p; p.x = pk2(t[0], t[1]); p.y = pk2(t[2], t[3]); p.z = pk2(t[4], t[5]); p.w = pk2(t[6], t[7]); a[s] = __builtin_bit_cast(bf16x8_t, p); }
        f32x4 hv[4][8];
#pragma unroll
        for (int nt = 0; nt < 4; ++nt) { const GAS f32x4* hp = (const GAS f32x4*)(H2j + (size_t)(ng * 128 + nt * 32 + li) * HY_FILT + 8 * hi);
#pragma unroll
            for (int s = 0; s < 4; ++s) { hv[nt][2 * s] = hp[4 * s]; hv[nt][2 * s + 1] = hp[4 * s + 1]; } }
#pragma unroll
        for (int nt = 0; nt < 4; ++nt) {
            const int n0 = ng * 128 + nt * 32;
            f32x16 acc;
#pragma unroll
            for (int r = 0; r < 16; ++r) acc[r] = 0.f;
#pragma unroll
            for (int s = 0; s < 4; ++s) { const f32x4 v0 = hv[nt][2 * s], v1 = hv[nt][2 * s + 1];
                v4u p; p.x = pk2(v0.x, v0.y); p.y = pk2(v0.z, v0.w); p.z = pk2(v1.x, v1.y); p.w = pk2(v1.z, v1.w);
                acc = __builtin_amdgcn_mfma_f32_32x32x16_bf16(a[s], __builtin_bit_cast(bf16x8_t, p), acc, 0, 0, 0); }
            const float t = (float)(n0 + li) * (1.0f / (float)(SEQ - 1));
#pragma unroll
            for (int r = 0; r < 16; ++r) { const int col = col0 + (r & 3) + 8 * (r >> 2) + 4 * hi, c = col % D_MAIN;
                const float ad = fabsf(min_decay + (float)c * ((max_decay - min_decay) / (float)(D_MAIN - 1)));
                TAPS[(size_t)col * SEQ + n0 + li] = (bf16)f2bf(acc[r] * expf(-t * ad)); }
        }
    }
}

__device__ __forceinline__ constexpr float twc(int k) { constexpr float T[16] = {1.0f, 0.98078528040323043f, 0.92387953251128674f, 0.83146961230254524f, 0.70710678118654757f, 0.55557023301960218f, 0.38268343236508978f, 0.19509032201612825f,
    0.0f, -0.19509032201612825f, -0.38268343236508978f, -0.55557023301960218f, -0.70710678118654757f, -0.83146961230254524f, -0.92387953251128674f, -0.98078528040323043f}; return T[k]; }
__device__ __forceinline__ constexpr float tws(int k) { constexpr float T[16] = {0.0f, 0.19509032201612825f, 0.38268343236508978f, 0.55557023301960218f, 0.70710678118654757f, 0.83146961230254524f, 0.92387953251128674f, 0.98078528040323043f,
    1.0f, 0.98078528040323043f, 0.92387953251128674f, 0.83146961230254524f, 0.70710678118654757f, 0.55557023301960218f, 0.38268343236508978f, 0.19509032201612825f}; return T[k]; }
__device__ __forceinline__ constexpr int bitrev(int i, int bits) { int r = 0; for (int b = 0; b < bits; ++b) if (i & (1 << b)) r |= 1 << (bits - 1 - b); return r; }

template <int N, int LEN> struct FftStage {
    static __device__ __forceinline__ void run(float (&re)[N], float (&im)[N]) {
        constexpr int half = LEN / 2, step = 32 / LEN;
#pragma unroll
        for (int base = 0; base < N; base += LEN)
#pragma unroll
            for (int j = 0; j < half; ++j) {
                const int i0 = base + j, i1 = i0 + half, idx = j * step;
                const float ar = re[i0], ai = im[i0], br = re[i1], bi = im[i1];
                re[i0] = ar + br; im[i0] = ai + bi;
                const float dr = ar - br, di = ai - bi;
                if (idx == 0) { re[i1] = dr; im[i1] = di; }
                else if (idx == 8) { re[i1] = di; im[i1] = -dr; }
                else { const float c = twc(idx), s = tws(idx); re[i1] = dr * c + di * s; im[i1] = di * c - dr * s; }
            }
        if constexpr (LEN > 2) FftStage<N, LEN / 2>::run(re, im);
    }
};
template <int N, int BITS> __device__ __forceinline__ void fft_reg(float (&re)[N], float (&im)[N]) {
    FftStage<N, N>::run(re, im);
    float tr[N], ti[N];
#pragma unroll
    for (int i = 0; i < N; ++i) { tr[bitrev(i, BITS)] = re[i]; ti[bitrev(i, BITS)] = im[i]; }
#pragma unroll
    for (int i = 0; i < N; ++i) { re[i] = tr[i]; im[i] = ti[i]; }
}

__device__ __forceinline__ void fft16k(float (&re)[32], float (&im)[32], LAS f32x2* L, int tid_in) {
    int tid = tid_in; asm volatile("" : "+v"(tid));
    fft_reg<32, 5>(re, im);
#pragma unroll
    for (int k1 = 1; k1 < 32; ++k1) { const float fr = (float)((tid * k1) & 16383) * (1.0f / 16384.0f); const float c = __builtin_amdgcn_cosf(fr), s = __builtin_amdgcn_sinf(fr);
        const float r = re[k1], i = im[k1]; re[k1] = r * c + i * s; im[k1] = i * c - r * s; if ((k1 & 3) == 3) __builtin_amdgcn_sched_barrier(0); }
#pragma unroll
    for (int k1 = 0; k1 < 32; ++k1) L[k1 * 513 + tid] = (f32x2){re[k1], im[k1]};
    __syncthreads();
    const int n3 = tid & 31, ka = tid >> 5;
    float ar[16], ai[16], br[16], bi[16];
#pragma unroll
    for (int n2 = 0; n2 < 16; ++n2) { const f32x2 a = L[ka * 513 + n2 * 32 + n3], b = L[(ka + 16) * 513 + n2 * 32 + n3]; ar[n2] = a.x; ai[n2] = a.y; br[n2] = b.x; bi[n2] = b.y; }
    fft_reg<16, 4>(ar, ai); fft_reg<16, 4>(br, bi);
#pragma unroll
    for (int k2 = 1; k2 < 16; ++k2) { const float fr = (float)((n3 * k2) & 511) * (1.0f / 512.0f); const float c = __builtin_amdgcn_cosf(fr), s = __builtin_amdgcn_sinf(fr);
        float r = ar[k2], i = ai[k2]; ar[k2] = r * c + i * s; ai[k2] = i * c - r * s;
        r = br[k2]; i = bi[k2]; br[k2] = r * c + i * s; bi[k2] = i * c - r * s; if ((k2 & 3) == 3) __builtin_amdgcn_sched_barrier(0); }
    __syncthreads();
#pragma unroll
    for (int k2 = 0; k2 < 16; ++k2) { L[n3 * 513 + k2 * 32 + ka] = (f32x2){ar[k2], ai[k2]}; L[n3 * 513 + k2 * 32 + ka + 16] = (f32x2){br[k2], bi[k2]}; }
    __syncthreads();
#pragma unroll
    for (int q = 0; q < 32; ++q) { const f32x2 v = L[q * 513 + tid]; re[q] = v.x; im[q] = v.y; }
    fft_reg<32, 5>(re, im);
}

constexpr int HS_SP = SEQ + 16;
__device__ __forceinline__ void hy_stage(LAS bf16* S, int slot, const bf16* src, int tid) {
    LAS bf16* d = S + slot * HS_SP + 8;
    if (tid == 0) { d[-1] = 0; d[SEQ] = 0; }
#pragma unroll
    for (int q = 0; q < 2; ++q) { const int ch = q * NTHREADS + tid; *(LAS v4u*)(d + ch * 8) = *(const GAS v4u*)(src + ch * 8); }
}
__device__ __forceinline__ float hy_sc(const LAS bf16* S, int slot, int t, float w0, float w1, float w2) {
    const LAS bf16* p = S + slot * HS_SP + 8 + t;
    return bf2f(p[-1]) * w0 + bf2f(p[0]) * w1 + bf2f(p[1]) * w2;
}

__device__ __forceinline__ void phase_hyena_conv(const bf16* PT, const bf16* TAPS, const float* shortw, const float* skip, f32x2* XSall, bf16* MIXT,
                                                 LAS unsigned char* lds, int blk, int nblk, int tid_in, int lane, int wave, int pmode = 0) {
    LAS f32x2* L = (LAS f32x2*)lds; LAS bf16* S = (LAS bf16*)lds; LAS float* red = (LAS float*)(lds + LDS_MISC);
    f32x2* XS = XSall + (size_t)blk * 16384;
    f32x2* ZS = XS + 16384 * 256;
    constexpr int N = 16384;
#pragma unroll 1
    for (int c = blk; c < D_MAIN; c += nblk) {
        const bf16* hf0 = TAPS + (size_t)c * SEQ; const bf16* hb0 = TAPS + (size_t)(D_MAIN + c) * SEQ;
        const bf16* hf1 = TAPS + (size_t)(2 * D_MAIN + c) * SEQ; const bf16* hb1 = TAPS + (size_t)(3 * D_MAIN + c) * SEQ;
        const bf16* px1 = PT + (size_t)c * M_TOK; const bf16* px2 = PT + (size_t)(D_MAIN + c) * M_TOK; const bf16* pv = PT + (size_t)(2 * D_MAIN + c) * M_TOK;
        const float wx1[3] = {shortw[c], shortw[2304 + c], shortw[4608 + c]};
        const float wx2[3] = {shortw[D_MAIN + c], shortw[2304 + D_MAIN + c], shortw[4608 + D_MAIN + c]};
        const float wv[3] = {shortw[2 * D_MAIN + c], shortw[2304 + 2 * D_MAIN + c], shortw[4608 + 2 * D_MAIN + c]};
        const float sk0 = skip[c], sk1 = skip[D_MAIN + c];
        float re[32], im[32];
#pragma unroll 1
        for (int pass = 0; pass < 5; ++pass) {
            int tid = tid_in; asm volatile("" : "+v"(tid));
            if (pass == 0) {
#pragma unroll
                for (int r = 0; r < 16; ++r) { const int n = r * 512 + tid; re[r] = bf2f(hf0[n]); im[r] = bf2f(hf1[n]); }
#pragma unroll
                for (int r = 16; r < 32; ++r) { const int idx = (32 - r) * 512 - tid; const bool z = (idx == SEQ); const int ii = z ? 0 : idx; re[r] = z ? 0.f : bf2f(hb0[ii]); im[r] = z ? 0.f : bf2f(hb1[ii]); }
                float e0 = 0.f, e1 = 0.f;
                if (tid == 0) { e0 = bf2f(hb0[0]); e1 = bf2f(hb1[0]); }
                float s0 = fabsf(e0), s1 = fabsf(e1);
#pragma unroll
                for (int r = 0; r < 32; ++r) { s0 += fabsf(re[r]); s1 += fabsf(im[r]); }
                s0 = wave_sum(s0); s1 = wave_sum(s1);
                __syncthreads();
                if (lane == 0) { red[wave] = s0; red[8 + wave] = s1; }
                __syncthreads();
                float t0 = 0.f, t1 = 0.f;
#pragma unroll
                for (int w = 0; w < NWAVES; ++w) { t0 += red[w]; t1 += red[8 + w]; }
                const float sc0 = 1.0f / (t0 + 1e-6f), sc1 = 1.0f / (t1 + 1e-6f);
                re[0] += e0; im[0] += e1;
#pragma unroll
                for (int r = 0; r < 32; ++r) { re[r] *= sc0; im[r] *= sc1; }
            } else if (pass == 1) {
                __syncthreads();
                hy_stage(S, 0, pv, tid); hy_stage(S, 1, pv + SEQ, tid);
                __syncthreads();
#pragma unroll
                for (int r = 0; r < 16; ++r) { const int t = r * 512 + tid; re[r] = hy_sc(S, 0, t, wv[0], wv[1], wv[2]); im[r] = hy_sc(S, 1, t, wv[0], wv[1], wv[2]); }
#pragma unroll
                for (int r = 16; r < 32; ++r) { re[r] = 0.f; im[r] = 0.f; }
            }
            __syncthreads();
            fft16k(re, im, L, tid);
            if (pass == 0) {
#pragma unroll
                for (int r = 0; r < 32; ++r) XS[r * 512 + tid] = (f32x2){re[r], im[r]};
                __syncthreads();
            } else if (pass == 1 || pass == 3) {
#pragma unroll
                for (int r = 0; r < 32; ++r) {
                    const int f = r * 512 + tid; const f32x2 xa = XS[f], xb = XS[(N - f) & (N - 1)];
                    float kr, ki;
                    if (pass == 1) { kr = xa.x + xb.x; ki = xa.y - xb.y; } else { kr = xa.y + xb.y; ki = xb.x - xa.x; }
                    kr *= (0.5f / (float)N); ki *= (0.5f / (float)N);
                    const float zr_ = re[r], zi_ = im[r];
                    re[r] = zr_ * kr - zi_ * ki; im[r] = -(zr_ * ki + zi_ * kr);
                }
            } else if (pass == 2) {
                __syncthreads();
                hy_stage(S, 0, pv, tid); hy_stage(S, 1, pv + SEQ, tid); hy_stage(S, 2, px1, tid); hy_stage(S, 3, px1 + SEQ, tid);
                __syncthreads();
#pragma unroll
                for (int r = 0; r < 16; ++r) { const int t = r * 512 + tid;
                    const float v0 = hy_sc(S, 0, t, wv[0], wv[1], wv[2]), v1 = hy_sc(S, 1, t, wv[0], wv[1], wv[2]);
                    const float g0 = hy_sc(S, 2, t, wx1[0], wx1[1], wx1[2]), g1 = hy_sc(S, 3, t, wx1[0], wx1[1], wx1[2]);
                    re[r] = g0 * (re[r] + sk0 * v0); im[r] = g1 * (-im[r] + sk0 * v1); ZS[t] = (f32x2){re[r], im[r]}; }
#pragma unroll
                for (int r = 16; r < 32; ++r) { re[r] = 0.f; im[r] = 0.f; }
            } else {
                __syncthreads();
                hy_stage(S, 0, px2, tid); hy_stage(S, 1, px2 + SEQ, tid);
                __syncthreads();
#pragma unroll
                for (int r = 0; r < 16; ++r) { const int t = r * 512 + tid;
                    const float g0 = hy_sc(S, 0, t, wx2[0], wx2[1], wx2[2]), g1 = hy_sc(S, 1, t, wx2[0], wx2[1], wx2[2]);
                    const f32x2 z = ZS[t];
                    const float o0 = g0 * (re[r] + sk1 * z.x), o1 = g1 * (-im[r] + sk1 * z.y);
                    MIXT[(size_t)c * M_TOK + t] = (bf16)f2bf(o0); MIXT[(size_t)c * M_TOK + SEQ + t] = (bf16)f2bf(o1); }
            }
        }
        __syncthreads();
    }
}
#ifndef MK_PER_PHASE
#define MK_PER_PHASE 0
#endif
#ifndef CONV_PMODE
#define CONV_PMODE 0
#endif
#ifndef REPMASK
#define REPMASK 0u
#endif
#define REP(kind) _Pragma("unroll 1") for (int r_ = 0; r_ < 1 + (int)((REPMASK >> (kind)) & 1u); ++r_)
struct Args {
    const float* in[24]; float* out; unsigned char* ws; int ph_lo, ph_hi;
};
constexpr int N_PHASES = 1 + (DEPTH - 1) + DEPTH * 8 - DEPTH / 2 + 1;

template <int QP, int KP>
__device__ __forceinline__ void run_attn(const bf16* Q, const bf16* K, const bf16* V, bf16* O, int NT, char* shm) {
    attn_body::attn_unit<8, QP, KP, DM>((const attn_body::bf16*)Q, (const attn_body::bf16*)K, (const attn_body::bf16*)V, (attn_body::bf16*)O, NT, shm);
}

__global__ void __launch_bounds__(NTHREADS, 2) hybrid_fwd(Args args) {
    extern __shared__ __attribute__((aligned(16))) unsigned char lds_raw[];
    LAS unsigned char* lds = (LAS unsigned char*)lds_raw;
    const int G = gridDim.x, bx = blockIdx.x;
    const int vcu = (G % 8 == 0) ? (bx % 8) * (G / 8) + bx / 8 : bx;
    const int NGW = G * NWAVES;
    unsigned char* ws = args.ws;
    const float* x = args.in[0]; const float* mem = args.in[1]; const float* mix_g = args.in[2]; const float* ffn_g = args.in[3]; const float* mem_g = args.in[4]; const float* fin_g = args.in[5];
    const float* hy_short = args.in[9]; const float* f_w1 = args.in[10]; const float* f_b1 = args.in[11]; const float* f_w2 = args.in[12]; const float* f_b2 = args.in[13];
    const float* f_w3 = args.in[14]; const float* f_freq = args.in[15]; const float* hy_skip = args.in[16]; const float* qg = args.in[18]; const float* kg = args.in[19]; const float* router = args.in[20];
    float* H = args.out;
    bf16* U = (bf16*)(ws + WS_U); bf16* PROJ = (bf16*)(ws + WS_PROJ); bf16* CQ = (bf16*)(ws + WS_CQ); bf16* MIX = (bf16*)(ws + WS_MIX); bf16* MIXT = (bf16*)(ws + WS_MIXT);
    float* AFF = (float*)(ws + WS_AFF); int* IDX = (int*)(ws + WS_IDX); float* GATE = (float*)(ws + WS_GATE); int* POS = (int*)(ws + WS_POS);
    bf16* XG = (bf16*)(ws + WS_XG); bf16* HID = (bf16*)(ws + WS_HID); bf16* Y = (bf16*)(ws + WS_Y); bf16* TAPS = (bf16*)(ws + WS_TAPS);
    const bf16* MKV = (const bf16*)(ws + WS_MKV);
    cg::grid_group grid = cg::this_grid();
    volatile LAS unsigned* bst = (volatile LAS unsigned*)(lds + LDS_MISC + 4096);
    if (threadIdx.x < 2) bst[threadIdx.x] = 0u;
    __syncthreads();
    XcdBarrier xbar = xcd_barrier_post((unsigned*)(ws + WS_CTL) + 1024, bst);
    const int lo = args.ph_lo, hi = args.ph_hi;
    int ph = 0;
#define PHASE_BEGIN if (lo <= ph && ph < hi) { const int tid = opaque_tid(), lane = tid & 63, wave = __builtin_amdgcn_readfirstlane(tid >> 6), gw = vcu * NWAVES + wave; (void)lane; (void)gw;
#ifdef EXTRA_XBAR
#define PHASE_END   if (ph + 1 < hi) { if (ph == lo) grid.sync(); else { xcd_barrier(xbar); if (ph < EXTRA_XBAR) xcd_barrier(xbar); } } } ++ph;
#else
#define PHASE_END   if (ph + 1 < hi) { if (ph == lo) grid.sync(); else xcd_barrier(xbar); } } ++ph;
#endif

    PHASE_BEGIN
        ProIn P{args.in[8], args.in[17], args.in[7], args.in[6], args.in[21], args.in[22], args.in[23]};
        REP(0) phase_weights(P, ws, lds, gw, NGW, wave, lane);
        REP(1) phase_mem_h2(mem, mem_g, f_w1, f_b1, f_w2, f_b2, f_freq, ws, gw, NGW, lane);
        REP(3) phase_norm<false, false>(x, nullptr, mix_g, U, nullptr, nullptr, nullptr, gw, NGW, lane);
    PHASE_END

#pragma unroll 1
    for (int i = 0; i < DEPTH; ++i) {
        const bool hy = (i & 1) == 0; const int j = i >> 1;
        if (i > 0) {
        PHASE_BEGIN
            phase_norm<true, false>(H, H, mix_g + i * DM, U, nullptr, POS, Y, gw, NGW, lane);
        PHASE_END
        }
        PHASE_BEGIN
            if (i == 0) {
                pg8::Gemm g{(const bf16*)(ws + WS_MEMN), (const bf16*)(ws + WS_WMKV), BATCH * MEM_LEN, 2048, DM, 1 << 30, 1, 0};
                pg8::StaticOrder S; S.init(BATCH * MEM_LEN, 2048, G, bx);
                pg8::EpiRowBf16 E{(bf16*)(ws + WS_MKV), 2048, -1, 1.f};
                pg8::gemm_phase<pg8::EpiRowBf16, pg8::StaticOrder, true, true>(lds, g, S, E);
            }
            if (hy) {
                REP(4) phase_taps((const float*)(ws + WS_H2) + (size_t)j * SEQ * HY_FILT, f_w3 + (size_t)j * HY_FILT * FCOLS, TAPS, gw, NGW, lane);
                pg8::Gemm g{U, (const bf16*)(ws + WS_WHY) + (size_t)j * D_IN_HY * DM, M_TOK, D_IN_HY, DM, 1 << 30, 1, 0};
                pg8::StaticOrder S; S.init(M_TOK, D_IN_HY, G, bx);
                pg8::EpiHyIn E{PROJ, M_TOK, 9, CQ, ATT_C2};
                REP(5) pg8::gemm_phase<pg8::EpiHyIn, pg8::StaticOrder, true, true>(lds, g, S, E);
            } else {
                pg8::Gemm g{U, (const bf16*)(ws + WS_WAT) + (size_t)j * D_IN_AT * DM, M_TOK, D_IN_AT, DM, 1 << 30, 1, 0};
                pg8::StaticOrder S; S.init(M_TOK, D_IN_AT, G, bx);
                pg8::EpiAtIn E{PROJ, D_IN_AT, qg + j * HD, kg + j * HD, ATT_C2, NORM_EPS, SEQ - 1};
                REP(6) pg8::gemm_phase<pg8::EpiAtIn, pg8::StaticOrder, true, true>(lds, g, S, E);
            }
        PHASE_END
        PHASE_BEGIN
            if (hy) {
                REP(8) phase_hyena_conv(PROJ, TAPS, hy_short + (size_t)j * 3 * 2304, hy_skip + (size_t)j * 2 * D_MAIN, (f32x2*)(ws + WS_FFTX), MIXT, lds, bx, G, tid, lane, wave);
                REP(9) for (int u = vcu; u < 256; u += G) { const int b = u >> 7, h4 = (u >> 5) & 3, qb = u & 31; const size_t row = (size_t)b * SEQ + qb * 256;
                    run_attn<256, 2048>(CQ + row * 256 + h4 * HD, MKV + (size_t)b * MEM_LEN * 2048 + i * 512 + h4 * HD, MKV + (size_t)b * MEM_LEN * 2048 + i * 512 + 256 + h4 * HD,
                                        MIX + row * DM + D_MAIN + h4 * HD, MEM_LEN / 64, (char*)lds_raw); }
            } else {
                REP(10) for (int u = vcu; u < 768; u += G) { const int bk = (u & 255) >> 5, qb = u & 31, hs = u >> 8, b = bk >> 2, kvh = bk & 3, h = kvh * 3 + hs; const size_t row = (size_t)b * SEQ + qb * 256;
                    run_attn<D_IN_AT, D_IN_AT>(PROJ + row * D_IN_AT + h * HD, PROJ + (size_t)b * SEQ * D_IN_AT + D_MAIN + kvh * HD, PROJ + (size_t)b * SEQ * D_IN_AT + D_MAIN + 256 + kvh * HD,
                                               MIX + row * DM + h * HD, SEQ / 64, (char*)lds_raw); }
                REP(9) for (int u = vcu; u < 256; u += G) { const int b = u >> 7, h4 = (u >> 5) & 3, qb = u & 31; const size_t row = (size_t)b * SEQ + qb * 256;
                    run_attn<D_IN_AT, 2048>(PROJ + row * D_IN_AT + 1280 + h4 * HD, MKV + (size_t)b * MEM_LEN * 2048 + i * 512 + h4 * HD, MKV + (size_t)b * MEM_LEN * 2048 + i * 512 + 256 + h4 * HD,
                                            MIX + row * DM + D_MAIN + h4 * HD, MEM_LEN / 64, (char*)lds_raw); }
            }
        PHASE_END
        if (hy) {
            PHASE_BEGIN
                REP(11) phase_transpose_mix(MIXT, MIX, bx, G, tid);
            PHASE_END
        }
        PHASE_BEGIN
            pg8::Gemm g{MIX, (const bf16*)(ws + WS_WOUT) + (size_t)i * DM * DM, M_TOK, DM, DM, 1 << 30, 1, 0};
            pg8::StaticOrder S; S.init(M_TOK, DM, G, bx);
            pg8::EpiResF32 E{i == 0 ? x : (const float*)H, H, DM};
            if (i == 0) { REP(12) pg8::gemm_phase<pg8::EpiResF32, pg8::StaticOrder, true, true>(lds, g, S, E); } else pg8::gemm_phase<pg8::EpiResF32, pg8::StaticOrder, true, true>(lds, g, S, E);
        PHASE_END
        PHASE_BEGIN
            REP(13) phase_ffn_norm_router(H, ffn_g + i * DM, router + (size_t)i * DM * NEXP, (unsigned char*)U, AFF, lds, gw, NGW, lane, tid);
        PHASE_END
        PHASE_BEGIN
            REP(14) phase_topk(AFF, IDX, GATE, POS, lds + LDS_MISC, bx, G, tid, lane, wave);
        PHASE_END
        PHASE_BEGIN
            pg8::Gemm g{U, (const bf16*)(ws + WS_W1 + (size_t)i * NEXP * 1536 * DM), XROWS, 1536, DM / 2, 4, NEXP, (size_t)1536 * DM};
            pg8::StaticOrder S; S.init(XROWS, 1536, G, bx);
            pg8::EpiSwiGLU8 E{(unsigned char*)HID, EFF, 1.0f / W8_SCALE};
            REP(16) pg8::gemm_phase<pg8::EpiSwiGLU8, pg8::StaticOrder, true, true, true, true>(lds, g, S, E, IDX);
        PHASE_END
        PHASE_BEGIN
            pg8::Gemm g{HID, (const bf16*)(ws + WS_W2 + (size_t)i * NEXP * DM * EFF), XROWS, DM, EFF / 2, 4, NEXP, (size_t)DM * EFF};
            pg8::StaticOrder S; S.init(XROWS, DM, G, bx);
            pg8::EpiDown E{Y, DM, GATE, 1.0f / W8_SCALE};
            REP(17) pg8::gemm_phase<pg8::EpiDown, pg8::StaticOrder, true, true, false, true>(lds, g, S, E);
        PHASE_END
    }
    PHASE_BEGIN
        phase_norm<true, true>(H, nullptr, fin_g, nullptr, args.out, POS, Y, gw, NGW, lane);
    PHASE_END
#undef PHASE_BEGIN
#undef PHASE_END
}

extern "C" void kernel_launch(void* const* d_in, const int* in_sizes, int n_in, void* d_out, int out_size, void* d_ws, size_t ws_size, hipStream_t stream) {
    static int grid = 0;
    if (grid == 0) {
        if (n_in != 24 || out_size != M_TOK * DM || ws_size < WS_END) { fprintf(stderr, "kernel_launch: unexpected shapes (n_in %d out %d ws %zu need %zu)\n", n_in, out_size, ws_size, (size_t)WS_END); grid = -1; return; }
        int dev = 0, cus = 0, per_cu = 0;
        if (hipGetDevice(&dev) != hipSuccess || hipDeviceGetAttribute(&cus, hipDeviceAttributeMultiprocessorCount, dev) != hipSuccess) { grid = -1; return; }
        if (hipFuncSetAttribute((const void*)hybrid_fwd, hipFuncAttributeMaxDynamicSharedMemorySize, LDS_BYTES) != hipSuccess) { fprintf(stderr, "kernel_launch: hipFuncSetAttribute failed\n"); grid = -1; return; }
        if (hipOccupancyMaxActiveBlocksPerMultiprocessor(&per_cu, (const void*)hybrid_fwd, NTHREADS, LDS_BYTES) != hipSuccess || per_cu < 1) { fprintf(stderr, "kernel_launch: occupancy query says %d blocks/CU\n", per_cu); per_cu = 1; }
        (void)hipGetLastError();
        grid = cus;
    }
    if (grid < 0) return;
    if (hipMemsetAsync((char*)d_ws + WS_CTL, 0, 64 * 1024, stream) != hipSuccess) { fprintf(stderr, "kernel_launch: memset failed\n"); return; }
    Args a{};
    for (int i = 0; i < 24; ++i) a.in[i] = (const float*)d_in[i];
    a.out = (float*)d_out; a.ws = (unsigned char*)d_ws;
#if MK_PER_PHASE
    for (int li = 0; li < N_PHASES; ++li) {
        a.ph_lo = li; a.ph_hi = li + 1;
        void* kargs[] = {&a};
        hipError_t e = hipLaunchCooperativeKernel((const void*)hybrid_fwd, dim3(grid), dim3(NTHREADS), kargs, LDS_BYTES, stream);
        if (e != hipSuccess) { fprintf(stderr, "kernel_launch: launch %d failed: %s\n", li, hipGetErrorString(e)); break; }
    }
#else
    a.ph_lo = 0; a.ph_hi = N_PHASES;
    void* kargs[] = {&a};
    hipError_t e = hipLaunchCooperativeKernel((const void*)hybrid_fwd, dim3(grid), dim3(NTHREADS), kargs, LDS_BYTES, stream);
    if (e != hipSuccess) fprintf(stderr, "kernel_launch: cooperative launch failed: %s (grid %d)\n", hipGetErrorString(e), grid);
#endif
}
```

```cpp
#include <hip/hip_runtime.h>
#include <hip/hip_cooperative_groups.h>
#include <hip/hip_bf16.h>
#include <cmath>
#include <cstdio>
#include <cstdint>
namespace cg = cooperative_groups;

constexpr int BATCH = 2, SEQ = 8192, DM = 1024, DEPTH = 4, M_TOK = BATCH * SEQ;
constexpr int HD = 64, MEM_LEN = 256, D_MEM = 256, D_MAIN = 768, NQH = 12, NKVH = 4;
constexpr int D_IN_HY = 2560, D_IN_AT = 1536;
constexpr int NEXP = 16, CAP = 1024, EFF = 768, NGRP = BATCH * NEXP, XROWS = NGRP * CAP;
constexpr int HY_EMB = 33, HY_FILT = 64, FCOLS = 4 * D_MAIN;
constexpr float NORM_EPS = 1e-6f;
constexpr float W8_SCALE = 32.0f;
constexpr float ATT_C2 = 0.125f * 1.4426950408889634f;

constexpr size_t MiB = 1u << 20;
constexpr size_t WS_CTL = 0;
constexpr size_t WS_WHY = 2 * MiB;
constexpr size_t WS_WAT = 12 * MiB;
constexpr size_t WS_WOUT = 18 * MiB;
constexpr size_t WS_WMKV = 26 * MiB;
constexpr size_t WS_W1 = 32 * MiB;
constexpr size_t WS_W2 = 224 * MiB;
constexpr size_t WS_U = 320 * MiB;
constexpr size_t WS_PROJ = 352 * MiB;
constexpr size_t WS_CQ = WS_PROJ + 72 * MiB;
constexpr size_t WS_MIX = 432 * MiB;
constexpr size_t WS_MIXT = 464 * MiB;
constexpr size_t WS_AFF = 488 * MiB;
constexpr size_t WS_IDX = 489 * MiB;
constexpr size_t WS_GATE = WS_IDX + 128 * 1024;
constexpr size_t WS_POS = 490 * MiB;
constexpr size_t WS_XG = 492 * MiB;
constexpr size_t WS_HID = 556 * MiB;
constexpr size_t WS_TAPS = WS_XG;
constexpr size_t WS_Y = 604 * MiB;
constexpr size_t WS_FFTX = WS_Y;
constexpr size_t WS_H2 = 668 * MiB;
constexpr size_t WS_MEMN = 672 * MiB;
constexpr size_t WS_MKV = 673 * MiB;
constexpr size_t WS_END = 676 * MiB;

constexpr int LDS_RING = 0;
constexpr int LDS_MISC = 132 * 1024;
constexpr int LDS_BYTES = 140 * 1024;
constexpr int NTHREADS = 512, NWAVES = 8;

#define GAS __attribute__((address_space(1)))
#define LAS __attribute__((address_space(3)))
typedef unsigned short bf16;
typedef unsigned v4u __attribute__((ext_vector_type(4)));
typedef unsigned v2u __attribute__((ext_vector_type(2)));
typedef float f32x4 __attribute__((ext_vector_type(4)));
typedef float f32x2 __attribute__((ext_vector_type(2)));
__device__ __forceinline__ unsigned f2bf(float f) { unsigned u = __builtin_bit_cast(unsigned, f); return (u + 0x7fffu + ((u >> 16) & 1u)) >> 16; }
__device__ __forceinline__ unsigned pk2(float lo, float hi) { return f2bf(lo) | (f2bf(hi) << 16); }
__device__ __forceinline__ float bf2f(unsigned short h) { return __builtin_bit_cast(float, (unsigned)h << 16); }
__device__ __forceinline__ float bflo(unsigned w) { return __builtin_bit_cast(float, w << 16); }
__device__ __forceinline__ float bfhi(unsigned w) { return __builtin_bit_cast(float, w & 0xffff0000u); }
__device__ __forceinline__ float wave_sum(float v) {
#pragma unroll
    for (int o = 1; o < 64; o <<= 1) v += __shfl_xor(v, o);
    return v;
}
__device__ __forceinline__ int opaque_tid() { int t = threadIdx.x; asm volatile("" : "+v"(t)); return t; }
#define MK_PER_PHASE 0
#define XB_TMO      128
#define XB_XCNT(j)  (256  + 64 * (j))
#define XB_XSUB(j)  (1280 + 64 * (j))
#define XB_XGEN(j)  (2304 + 64 * (j))
#define XB_TOP      3328
#define XB_TOPGEN   3392
#define XCD_BAR_WORDS 3456
#define XB_SPIN_CAP (1u << 18)

__device__ __forceinline__ unsigned xb_ld(unsigned* p)              { return __hip_atomic_load(p, __ATOMIC_RELAXED, __HIP_MEMORY_SCOPE_AGENT); }
__device__ __forceinline__ unsigned xb_add(unsigned* p, unsigned v) { return __hip_atomic_fetch_add(p, v, __ATOMIC_RELAXED, __HIP_MEMORY_SCOPE_AGENT); }
__device__ __forceinline__ unsigned xb_xcc_id() { return (unsigned)__builtin_amdgcn_s_getreg((3 << 11) | 20) & 0xFu; }
#define XB_SPIN(cond, bar) do { unsigned _sp = 0; while (cond) { __builtin_amdgcn_s_sleep(1); \
    if ((++_sp & 255u) == 0u) { if (xb_ld(&(bar)[XB_TMO])) break; if (_sp > XB_SPIN_CAP) { atomicAdd(&(bar)[XB_TMO], 1u); break; } } } } while (0)

struct XcdBarrier {
    unsigned* bar; unsigned x;
    volatile LAS unsigned* st;
};

__device__ __forceinline__ XcdBarrier xcd_barrier_post(unsigned* bar, volatile LAS unsigned* st) {
    XcdBarrier b; b.bar = bar; b.x = xb_xcc_id(); b.st = st;
    if (threadIdx.x == 0) (void)xb_add(&bar[XB_XCNT(b.x)], 1u);
    return b;
}
__device__ __forceinline__ void xcd_barrier_complete(unsigned* bar, unsigned x, unsigned& nloc, unsigned& nx) {
    const unsigned G = gridDim.x * gridDim.y * gridDim.z;
    unsigned sum, cnt, mine, sp = 0u;
    for (;;) {
        sum = 0u; cnt = 0u; mine = 0u;
#pragma unroll
        for (unsigned j = 0; j < 16; ++j) { const unsigned c = xb_ld(&bar[XB_XCNT(j)]); sum += c; cnt += (c > 0u) ? 1u : 0u; mine = (j == x) ? c : mine; }
        if (sum == G) break;
        __builtin_amdgcn_s_sleep(1);
        if ((++sp & 255u) == 0u) { if (xb_ld(&bar[XB_TMO])) break; if (sp > XB_SPIN_CAP) { atomicAdd(&bar[XB_TMO], 1u); break; } }
    }
    nloc = mine > 0u ? mine : 1u; nx = cnt > 0u ? cnt : 1u;
}

__device__ __forceinline__ void xcd_barrier(const XcdBarrier& b) {
    asm volatile("s_waitcnt vmcnt(0)" ::: "memory");
    __syncthreads();
    if (threadIdx.x == 0) {
        unsigned* bar = b.bar;
        __builtin_amdgcn_s_waitcnt(0);
        unsigned nloc = b.st[0], nx = b.st[1];
        if (nloc == 0u) { xcd_barrier_complete(bar, b.x, nloc, nx); b.st[0] = nloc; b.st[1] = nx; }
        const unsigned old = xb_add(&bar[XB_XSUB(b.x)], 1u);
        const unsigned gen = old / nloc;
        if (old + 1u == (gen + 1u) * nloc) {
            __builtin_amdgcn_fence(__ATOMIC_RELEASE, "agent");
            asm volatile("s_waitcnt vmcnt(0)" ::: "memory");
            const unsigned og = xb_add(&bar[XB_TOP], 1u);
            const unsigned tg = og / nx;
            if (og + 1u == (tg + 1u) * nx) xb_add(&bar[XB_TOPGEN], 1u);
            else XB_SPIN(xb_ld(&bar[XB_TOPGEN]) == tg, bar);
            __builtin_amdgcn_fence(__ATOMIC_ACQUIRE, "agent");
            xb_add(&bar[XB_XGEN(b.x)], 1u);
            asm volatile("s_waitcnt vmcnt(0)" ::: "memory");
        } else {
            XB_SPIN(xb_ld(&bar[XB_XGEN(b.x)]) == gen, bar);
            __builtin_amdgcn_fence(__ATOMIC_ACQUIRE, "agent");
            asm volatile("s_waitcnt vmcnt(0)" ::: "memory");
        }
    }
    __syncthreads();
}
namespace pg8 {
#define PG8_LAS __attribute__((address_space(3)))
typedef unsigned short bf16_t;
typedef short bf16x8 __attribute__((ext_vector_type(8)));
typedef float f32x4 __attribute__((ext_vector_type(4)));
typedef unsigned u32x4 __attribute__((ext_vector_type(4)));
constexpr int BM = 256, BK = 64, HALF = 128, HTB = HALF * BK * 2  , STAGE_BYTES = 8 * HTB, NXCD = 8, WGM = 8;

__host__ __device__ __forceinline__ int lds_byte(int r, int c) { const int st = (r >> 4) * 2 + (c >> 5), rr = r & 15, cc = c & 31, ob = rr * 64 + cc * 2; return st * 1024 + (ob ^ (((ob >> 9) & 1) << 5)); }
__host__ __device__ __forceinline__ void stage_rc(int b, int& R, int& C) { const int st = b / 1024, sb = b % 1024, swz = sb ^ (((sb >> 9) & 1) << 5); R = (st >> 1) * 16 + swz / 64; C = (st & 1) * 32 + (swz % 64) / 2; }
__host__ __device__ __forceinline__ int perm32(int rho) { const int n = rho >> 4, i = rho & 15; return 8 * (i >> 2) + 4 * n + (i & 3); }

struct Unit { int pm, pn; };
struct Gemm { const bf16_t* A; const bf16_t* Bt; int M, N, K; int gdiv, gmod; size_t gstride; };

struct StaticOrder {
    int nM, nN, nwg, G, c;
    __host__ __device__ void init(int M, int N, int G_, int c_) { nM = M / BM; nN = N / BM; nwg = nM * nN; G = G_; c = c_; }
    __host__ __device__ bool next(int i, Unit& u) const {
        const long L = (long)i * G + c; if (L >= nwg) return false;
        int wgid = (int)L; { const int q = nwg / NXCD, r = nwg % NXCD, xcd = wgid % NXCD, off = wgid / NXCD; wgid = (xcd < r ? xcd * (q + 1) : r * (q + 1) + (xcd - r) * q) + off; }
        const int nig = WGM * nN, gid = wgid / nig, fm = gid * WGM, gsz = (nM - fm) < WGM ? (nM - fm) : WGM;
        u.pm = fm + ((wgid % nig) % gsz); u.pn = (wgid % nig) / gsz; return true;
    }
    __device__ __forceinline__ void a_ready(const Unit&) const {}
    __device__ __forceinline__ void done(const Unit&) const {}
};


__device__ __forceinline__ unsigned cvt_pk_bf16(float lo, float hi) { unsigned r; asm volatile("v_cvt_pk_bf16_f32 %0, %1, %2" : "=v"(r) : "v"(lo), "v"(hi)); return r; }
typedef unsigned u32x2 __attribute__((ext_vector_type(2)));
struct EpiRowBf16 {
    static constexpr bool PERM = false, AFTER_DRAIN = false;
    bf16_t* O; int ldc; int sc_pn; float sc;
    __device__ __forceinline__ void operator()(const f32x4 (&acc)[2][2][4][2], const Unit& u, int wr, int wc, int fr, int fq) const {
        const float s = (u.pn == sc_pn) ? sc : 1.f;
        const int row0 = u.pm * BM + wr * 64 + fr, col0 = u.pn * BM + wc * 32 + 4 * fq;
#pragma unroll
        for (int ai = 0; ai < 2; ++ai)
#pragma unroll
            for (int m = 0; m < 4; ++m) { bf16_t* rowp = O + (size_t)(row0 + ai * HALF + m * 16) * ldc + col0;
#pragma unroll
                for (int bj = 0; bj < 2; ++bj)
#pragma unroll
                    for (int n = 0; n < 2; ++n) { const f32x4 v = acc[ai][bj][m][n] * s; u32x2 w; w.x = cvt_pk_bf16(v[0], v[1]); w.y = cvt_pk_bf16(v[2], v[3]);
                        *(u32x2*)(rowp + bj * HALF + n * 16) = w; } }
    }
};
struct EpiHyIn {
    static constexpr bool PERM = false, AFTER_DRAIN = false;
    bf16_t* OT; int ldt; int tp_tiles; bf16_t* CQ; float sc;
    __device__ __forceinline__ void operator()(const f32x4 (&acc)[2][2][4][2], const Unit& u, int wr, int wc, int fr, int fq) const {
        const int row0 = u.pm * BM + wr * 64 + fr;
        if (u.pn < tp_tiles) {
            const int col0 = u.pn * BM + wc * 32 + 4 * fq;
#pragma unroll
            for (int ai = 0; ai < 2; ++ai)
#pragma unroll
                for (int m = 0; m < 4; ++m) { const int row = row0 + ai * HALF + m * 16;
#pragma unroll
                    for (int bj = 0; bj < 2; ++bj)
#pragma unroll
                        for (int n = 0; n < 2; ++n) { const f32x4 v = acc[ai][bj][m][n]; const unsigned w0 = cvt_pk_bf16(v[0], v[1]), w1 = cvt_pk_bf16(v[2], v[3]);
                            bf16_t* p = OT + (size_t)(col0 + bj * HALF + n * 16) * ldt + row;
                            p[0] = (bf16_t)(w0 & 0xffffu); p[(size_t)ldt] = (bf16_t)(w0 >> 16); p[(size_t)2 * ldt] = (bf16_t)(w1 & 0xffffu); p[(size_t)3 * ldt] = (bf16_t)(w1 >> 16); } }
        } else {
            const int col0 = wc * 32 + 4 * fq;
#pragma unroll
            for (int ai = 0; ai < 2; ++ai)
#pragma unroll
                for (int m = 0; m < 4; ++m) { bf16_t* rowp = CQ + (size_t)(row0 + ai * HALF + m * 16) * 256 + col0;
#pragma unroll
                    for (int bj = 0; bj < 2; ++bj)
#pragma unroll
                        for (int n = 0; n < 2; ++n) { const f32x4 v = acc[ai][bj][m][n] * sc; u32x2 w; w.x = cvt_pk_bf16(v[0], v[1]); w.y = cvt_pk_bf16(v[2], v[3]);
                            *(u32x2*)(rowp + bj * HALF + n * 16) = w; } }
        }
    }
};
struct EpiAtIn {
    static constexpr bool PERM = false, AFTER_DRAIN = false;
    bf16_t* O; int ldc; const float* gq; const float* gk; float csc; float eps; int seq_mask;
    __device__ __forceinline__ void operator()(const f32x4 (&acc)[2][2][4][2], const Unit& u, int wr, int wc, int fr, int fq) const {
        const int row0 = u.pm * BM + wr * 64 + fr, colb = u.pn * BM + wc * 64 + 4 * fq;
        if (u.pn <= 3) {
            const float* gp = (u.pn == 3 ? gk : gq) + 4 * fq; const float osc = (u.pn == 3) ? 1.f : csc;
            float invr[4];
#pragma unroll
            for (int q = 0; q < 4; ++q) invr[q] = exp2f(-(float)(4 * fq + q) * (13.287712379549449f / 16.0f)) * 0.15915494309189535f;
#pragma unroll
            for (int ai = 0; ai < 2; ++ai)
#pragma unroll
                for (int m = 0; m < 4; ++m) {
                    const int row = row0 + ai * HALF + m * 16; int t = row & seq_mask; asm volatile("" : "+v"(t));
                    float ss = 0.f;
#pragma unroll
                    for (int bj = 0; bj < 2; ++bj)
#pragma unroll
                        for (int n = 0; n < 2; ++n) { const f32x4 x = acc[ai][bj][m][n]; ss += (x[0] * x[0] + x[1] * x[1]) + (x[2] * x[2] + x[3] * x[3]); }
                    ss += __shfl_xor(ss, 16); ss += __shfl_xor(ss, 32);
                    const float rs = osc * __builtin_amdgcn_rsqf(ss * (1.0f / 64.0f) + eps);
                    bf16_t* rowp = O + (size_t)row * ldc + colb;
#pragma unroll
                    for (int bj = 0; bj < 2; ++bj) {
                        const float pos = (float)(bj == 0 ? (t >> 6) : (t & 63));
                        const f32x4 xa = acc[ai][bj][m][0] * rs * *(const f32x4*)(gp + 32 * bj), xb = acc[ai][bj][m][1] * rs * *(const f32x4*)(gp + 32 * bj + 16);
                        f32x4 oa, ob;
#pragma unroll
                        for (int q = 0; q < 4; ++q) { const float rev = pos * invr[q]; const float c = __builtin_amdgcn_cosf(rev), s = __builtin_amdgcn_sinf(rev);
                            oa[q] = xa[q] * c - xb[q] * s; ob[q] = xa[q] * s + xb[q] * c; }
                        u32x2 w; w.x = cvt_pk_bf16(oa[0], oa[1]); w.y = cvt_pk_bf16(oa[2], oa[3]); *(u32x2*)(rowp + 32 * bj) = w;
                        w.x = cvt_pk_bf16(ob[0], ob[1]); w.y = cvt_pk_bf16(ob[2], ob[3]); *(u32x2*)(rowp + 32 * bj + 16) = w;
                    }
                    asm volatile("" ::: "memory");
                }
        } else {
            const float s = (u.pn == 5) ? csc : 1.f;
#pragma unroll
            for (int ai = 0; ai < 2; ++ai)
#pragma unroll
                for (int m = 0; m < 4; ++m) { bf16_t* rowp = O + (size_t)(row0 + ai * HALF + m * 16) * ldc + colb;
#pragma unroll
                    for (int bj = 0; bj < 2; ++bj)
#pragma unroll
                        for (int n = 0; n < 2; ++n) { const f32x4 v = acc[ai][bj][m][n] * s; u32x2 w; w.x = cvt_pk_bf16(v[0], v[1]); w.y = cvt_pk_bf16(v[2], v[3]);
                            *(u32x2*)(rowp + 32 * bj + 16 * n) = w; } }
        }
    }
};
struct EpiResF32 {
    static constexpr bool PERM = false, AFTER_DRAIN = false;
    const float* res; float* out; int ldc;
    __device__ __forceinline__ void operator()(const f32x4 (&acc)[2][2][4][2], const Unit& u, int wr, int wc, int fr, int fq) const {
        const int row0 = u.pm * BM + wr * 64 + fr, col0 = u.pn * BM + wc * 32 + 4 * fq;
#pragma unroll
        for (int ai = 0; ai < 2; ++ai)
#pragma unroll
            for (int m = 0; m < 4; ++m) { const size_t off = (size_t)(row0 + ai * HALF + m * 16) * ldc + col0;
#pragma unroll
                for (int bj = 0; bj < 2; ++bj)
#pragma unroll
                    for (int n = 0; n < 2; ++n) { const f32x4 r = *(const f32x4*)(res + off + bj * HALF + n * 16); *(f32x4*)(out + off + bj * HALF + n * 16) = r + acc[ai][bj][m][n]; } }
    }
};
struct EpiSwiGLU {
    static constexpr bool PERM = false, AFTER_DRAIN = false;
    bf16_t* O; int ldc;
    __device__ __forceinline__ void operator()(const f32x4 (&acc)[2][2][4][2], const Unit& u, int wr, int wc, int fr, int fq) const {
        const int row0 = u.pm * BM + wr * 64 + fr, col0 = u.pn * HALF + wc * 32 + 4 * fq;
#pragma unroll
        for (int ai = 0; ai < 2; ++ai)
#pragma unroll
            for (int m = 0; m < 4; ++m) { bf16_t* rowp = O + (size_t)(row0 + ai * HALF + m * 16) * ldc + col0;
#pragma unroll
                for (int n = 0; n < 2; ++n) { const f32x4 g = acc[ai][0][m][n], up = acc[ai][1][m][n]; f32x4 h;
#pragma unroll
                    for (int q = 0; q < 4; ++q) h[q] = g[q] * up[q] * __builtin_amdgcn_rcpf(1.f + __expf(-g[q]));
                    u32x2 w; w.x = cvt_pk_bf16(h[0], h[1]); w.y = cvt_pk_bf16(h[2], h[3]); *(u32x2*)(rowp + n * 16) = w; } }
    }
};
struct EpiSwiGLU8 {
    static constexpr bool PERM = false, AFTER_DRAIN = false;
    unsigned char* O; int ldc; float wsc;
    __device__ __forceinline__ void operator()(const f32x4 (&acc)[2][2][4][2], const Unit& u, int wr, int wc, int fr, int fq) const {
        const int row0 = u.pm * BM + wr * 64 + fr, col0 = u.pn * HALF + wc * 32 + 4 * fq;
#pragma unroll
        for (int ai = 0; ai < 2; ++ai)
#pragma unroll
            for (int m = 0; m < 4; ++m) { unsigned char* rowp = O + (size_t)(row0 + ai * HALF + m * 16) * ldc + col0;
#pragma unroll
                for (int n = 0; n < 2; ++n) { const f32x4 g = acc[ai][0][m][n] * wsc, up = acc[ai][1][m][n] * wsc; f32x4 h;
#pragma unroll
                    for (int q = 0; q < 4; ++q) h[q] = g[q] * up[q] * __builtin_amdgcn_rcpf(1.f + __expf(-g[q]));
                    unsigned w = 0; w = __builtin_amdgcn_cvt_pk_fp8_f32(h[0], h[1], w, false); w = __builtin_amdgcn_cvt_pk_fp8_f32(h[2], h[3], w, true); *(unsigned*)(rowp + n * 16) = w; } }
    }
};
struct EpiDown {
    static constexpr bool PERM = false, AFTER_DRAIN = false;
    bf16_t* O; int ldc; const float* gate; float wsc;
    __device__ __forceinline__ void operator()(const f32x4 (&acc)[2][2][4][2], const Unit& u, int wr, int wc, int fr, int fq) const {
        const int row0 = u.pm * BM + wr * 64 + fr, col0 = u.pn * BM + wc * 32 + 4 * fq;
#pragma unroll
        for (int ai = 0; ai < 2; ++ai)
#pragma unroll
            for (int m = 0; m < 4; ++m) { const int row = row0 + ai * HALF + m * 16; const float gs = gate[row] * wsc; bf16_t* rowp = O + (size_t)row * ldc + col0;
#pragma unroll
                for (int bj = 0; bj < 2; ++bj)
#pragma unroll
                    for (int n = 0; n < 2; ++n) { const f32x4 v = acc[ai][bj][m][n] * gs; u32x2 w; w.x = cvt_pk_bf16(v[0], v[1]); w.y = cvt_pk_bf16(v[2], v[3]);
                        *(u32x2*)(rowp + bj * HALF + n * 16) = w; } }
    }
};
template <class Epi, class Sched, bool ALIGN_EPI = false, bool SP2 = false, bool GATHER = false, bool FP8 = false>
__device__ __forceinline__ void gemm_phase(PG8_LAS unsigned char* lds, const Gemm g, const Sched& S, const Epi& E, const int* gidx = nullptr) {
    const int tid = opaque_tid(), wid = __builtin_amdgcn_readfirstlane(tid >> 6), lane = tid & 63, wr = wid >> 2, wc = wid & 3, fr = lane & 15, fq = lane >> 4;
    const int K = g.K, nt = K / BK;
    unsigned voffA[2], voffB[2];
#pragma unroll
    for (int i = 0; i < 2; ++i) { int R, C; stage_rc(tid * 16 + i * 8192, R, C); const int Rb = Epi::PERM ? ((R & ~31) + perm32(R & 31)) : R;
        voffA[i] = (unsigned)(R * K + C) * 2u; voffB[i] = (unsigned)(Rb * K + C) * 2u; }
    const size_t kstep = (size_t)(BK * 2);
    const size_t hstep = (size_t)HALF * K * 2;
    const size_t tstep = 2 * hstep;
    const unsigned ldsw = (unsigned)wid * 1024u;
    const int aoff = lds_byte(wr * 64 + fr, fq * 8), boff = lds_byte(wc * 32 + fr, fq * 8);
#define PG8_SA(b, h) (((b) * 2 + (h)) * HTB)
#define PG8_SB(b, h) ((4 + (b) * 2 + (h)) * HTB)
#define PG8_STAGE(bufoff, gbase, voff) do { _Pragma("unroll") for (int _i = 0; _i < 2; ++_i) \
        __builtin_amdgcn_global_load_lds((const unsigned*)((const char*)(gbase) + (voff)[_i]), (PG8_LAS unsigned*)(lds + (bufoff) + ldsw + _i * 8192), 16, 0, 0); } while (0)
#define PG8_LDA(dst, b, h) do { _Pragma("unroll") for (int m = 0; m < 4; ++m) { if constexpr (FP8) { const v4i_ lo_ = *(const PG8_LAS v4i_*)(lds + PG8_SA(b, h) + aoff + m * 2048), hi_ = *(const PG8_LAS v4i_*)(lds + PG8_SA(b, h) + aoff + m * 2048 + 1024); \
        dst##8[m] = __builtin_shufflevector(lo_, hi_, 0, 1, 2, 3, 4, 5, 6, 7); } else { _Pragma("unroll") for (int k = 0; k < 2; ++k) dst[m][k] = *(const PG8_LAS bf16x8*)(lds + PG8_SA(b, h) + aoff + m * 2048 + k * 1024); } } } while (0)
#define PG8_LDB(dst, b, h) do { _Pragma("unroll") for (int n = 0; n < 2; ++n) { if constexpr (FP8) { const v4i_ lo_ = *(const PG8_LAS v4i_*)(lds + PG8_SB(b, h) + boff + n * 2048), hi_ = *(const PG8_LAS v4i_*)(lds + PG8_SB(b, h) + boff + n * 2048 + 1024); \
        dst##8[n] = __builtin_shufflevector(lo_, hi_, 0, 1, 2, 3, 4, 5, 6, 7); } else { _Pragma("unroll") for (int k = 0; k < 2; ++k) dst[n][k] = *(const PG8_LAS bf16x8*)(lds + PG8_SB(b, h) + boff + n * 2048 + k * 1024); } } } while (0)
#define PG8_MMA(ai, bj, At, Bt) do { __builtin_amdgcn_s_setprio(1); _Pragma("unroll") for (int m = 0; m < 4; ++m) _Pragma("unroll") for (int n = 0; n < 2; ++n) { \
        if constexpr (FP8) asm volatile("v_mfma_scale_f32_16x16x128_f8f6f4 %0, %1, %2, %0, %3, %3 op_sel_hi:[0,0,0]" : "+v"(acc[ai][bj][m][n]) : "v"(Bt##8[n]), "v"(At##8[m]), "v"(sc127_));   \
        else { _Pragma("unroll") for (int k = 0; k < 2; ++k) acc[ai][bj][m][n] = __builtin_amdgcn_mfma_f32_16x16x32_bf16(Bt[n][k], At[m][k], acc[ai][bj][m][n], 0, 0, 0); } } \
        __builtin_amdgcn_s_setprio(0); } while (0)
#define PG8_WAIT_V(n) asm volatile("s_waitcnt vmcnt(" #n ")" ::: "memory")
#define PG8_WAIT_L(n) asm volatile("s_waitcnt lgkmcnt(" #n ")" ::: "memory")
#define PG8_BAR __builtin_amdgcn_s_barrier()
#define PG8_SCHED __builtin_amdgcn_sched_barrier(0)
    Unit cur, nxt; int ui = 0;
    if (!S.next(0, cur)) return;
    f32x4 acc[2][2][4][2];
#pragma unroll
    for (int a = 0; a < 2; ++a)
#pragma unroll
        for (int b = 0; b < 2; ++b)
#pragma unroll
            for (int m = 0; m < 4; ++m)
#pragma unroll
                for (int n = 0; n < 2; ++n) acc[a][b][m][n] = (f32x4){0.f, 0.f, 0.f, 0.f};
    typedef int v8i_ __attribute__((ext_vector_type(8))); typedef int v4i_ __attribute__((ext_vector_type(4)));
    const int sc127_ = 127;
    bf16x8 At[4][2], B0[2][2], B1[2][2]; v8i_ At8[4], B08[2], B18[2];
    static_assert(SP2, "this copy of the body keeps only the SP2 K-loop up to date");
    int rA[2]; { int R_, C_; stage_rc(tid * 16, R_, C_); rA[0] = R_; stage_rc(tid * 16 + 8192, R_, C_); rA[1] = R_; }
    unsigned cv0[2], cv1[2], nv0[2], nv1[2];
    unsigned vh1[2]; vh1[0] = voffA[0] + (unsigned)hstep; vh1[1] = voffA[1] + (unsigned)hstep;
#define PG8_CV0 (GATHER ? cv0 : voffA)
#define PG8_CV1 (GATHER ? cv1 : vh1)
#define PG8_SV0 (GATHER ? sv0 : voffA)
#define PG8_SV1 (GATHER ? sv1 : vh1)
#define PG8_ROWOFF(dst0, dst1, unit) do { _Pragma("unroll") for (int i_ = 0; i_ < 2; ++i_) { \
        if constexpr (GATHER) { const int c2_ = (int)(voffA[i_] - (unsigned)(rA[i_] * K) * 2u); \
            dst0[i_] = (unsigned)gidx[(unit).pm * BM + rA[i_]] * (unsigned)(K * 2) + (unsigned)c2_; dst1[i_] = (unsigned)gidx[(unit).pm * BM + HALF + rA[i_]] * (unsigned)(K * 2) + (unsigned)c2_; } \
        else { dst0[i_] = voffA[i_]; dst1[i_] = voffA[i_] + (unsigned)hstep; } } } while (0)
    if constexpr (GATHER) PG8_ROWOFF(cv0, cv1, cur);
    const char* cA = GATHER ? (const char*)g.A : (const char*)g.A + (size_t)cur.pm * tstep; const char* cB = (const char*)g.Bt + (size_t)((cur.pm / g.gdiv) % g.gmod) * g.gstride + (size_t)cur.pn * tstep;
    S.a_ready(cur);
    if constexpr (SP2) {
        PG8_STAGE(PG8_SB(0, 0), cB, voffB); PG8_STAGE(PG8_SB(0, 1), cB + hstep, voffB); PG8_STAGE(PG8_SA(0, 0), cA, PG8_CV0); PG8_STAGE(PG8_SA(0, 1), cA, PG8_CV1);
        if (wr == 1) PG8_BAR;
        PG8_WAIT_V(2); PG8_BAR;
        PG8_STAGE(PG8_SB(1, 0), cB + kstep, voffB); PG8_STAGE(PG8_SA(1, 0), cA + kstep, PG8_CV0); PG8_STAGE(PG8_SB(1, 1), cB + hstep + kstep, voffB);
        PG8_WAIT_V(6); PG8_BAR;
    } else {
        PG8_STAGE(PG8_SB(0, 0), cB, voffB); PG8_STAGE(PG8_SA(0, 0), cA, voffA); PG8_STAGE(PG8_SB(0, 1), cB + hstep, voffB); PG8_STAGE(PG8_SA(0, 1), cA + hstep, voffA);
        if (wr == 1) PG8_BAR;
        PG8_WAIT_V(4); PG8_BAR;
        PG8_STAGE(PG8_SB(1, 0), cB + kstep, voffB); PG8_STAGE(PG8_SA(1, 0), cA + kstep, voffA); PG8_STAGE(PG8_SB(1, 1), cB + hstep + kstep, voffB);
        PG8_WAIT_V(6); PG8_BAR;
    }
    for (;;) {
        const bool has_next = S.next(ui + 1, nxt);
        if constexpr (GATHER) { if (has_next) PG8_ROWOFF(nv0, nv1, nxt); else { nv0[0] = cv0[0]; nv0[1] = cv0[1]; nv1[0] = cv1[0]; nv1[1] = cv1[1]; } }
        const char* nA = GATHER ? (const char*)g.A : (has_next ? (const char*)g.A + (size_t)nxt.pm * tstep : cA); const char* nB = has_next ? (const char*)g.Bt + (size_t)((nxt.pm / g.gdiv) % g.gmod) * g.gstride + (size_t)nxt.pn * tstep : cB;
        for (int t = 0; t < nt; t += 2) {
            const bool last = (t == nt - 2);
            unsigned sv0[2], sv1[2]; if constexpr (GATHER) { sv0[0] = last ? nv0[0] : cv0[0]; sv0[1] = last ? nv0[1] : cv0[1]; sv1[0] = last ? nv1[0] : cv1[0]; sv1[1] = last ? nv1[1] : cv1[1]; }
            const char* a1 = cA + (size_t)(t + 1) * kstep;
            const char* a2 = last ? nA : cA + (size_t)(t + 2) * kstep; const char* b2 = last ? nB : cB + (size_t)(t + 2) * kstep;
            const char* a3 = a2 + kstep; const char* b3 = b2 + kstep;
            if (last && has_next) S.a_ready(nxt);
            if constexpr (SP2) {
            PG8_LDB(B0, 0, 0); PG8_LDB(B1, 0, 1); PG8_SCHED; PG8_LDA(At, 0, 0); PG8_STAGE(PG8_SA(1, 1), a1, PG8_CV1);
            PG8_WAIT_V(8); PG8_WAIT_L(0); PG8_BAR; PG8_MMA(0, 0, At, B0); PG8_MMA(0, 1, At, B1); PG8_BAR; PG8_SCHED;
            PG8_LDA(At, 0, 1); PG8_STAGE(PG8_SB(0, 0), b2, voffB); PG8_STAGE(PG8_SB(0, 1), b2 + hstep, voffB); PG8_STAGE(PG8_SA(0, 0), a2, PG8_SV0);
            PG8_WAIT_V(8); PG8_WAIT_L(0); PG8_BAR; PG8_MMA(1, 0, At, B0); PG8_MMA(1, 1, At, B1); PG8_BAR; PG8_SCHED;
            PG8_LDB(B0, 1, 0); PG8_LDB(B1, 1, 1); PG8_SCHED; PG8_LDA(At, 1, 0); PG8_STAGE(PG8_SA(0, 1), a2, PG8_SV1);
            PG8_WAIT_V(8); PG8_WAIT_L(0); PG8_BAR; PG8_MMA(0, 0, At, B0); PG8_MMA(0, 1, At, B1); PG8_BAR; PG8_SCHED;
            PG8_LDA(At, 1, 1); PG8_STAGE(PG8_SB(1, 0), b3, voffB); PG8_STAGE(PG8_SB(1, 1), b3 + hstep, voffB); PG8_STAGE(PG8_SA(1, 0), a3, PG8_SV0);
            PG8_WAIT_V(8); PG8_WAIT_L(0); PG8_BAR; PG8_MMA(1, 0, At, B0); PG8_MMA(1, 1, At, B1); PG8_BAR; PG8_SCHED;
            } else {
            PG8_LDB(B0, 0, 0); PG8_SCHED; PG8_LDA(At, 0, 0); PG8_STAGE(PG8_SA(1, 1), a1 + hstep, voffA);
            PG8_WAIT_L(8); PG8_BAR; PG8_WAIT_L(0); PG8_MMA(0, 0, At, B0); PG8_BAR; PG8_SCHED;
            PG8_LDB(B1, 0, 1); PG8_STAGE(PG8_SB(0, 0), b2, voffB);
            PG8_BAR; PG8_WAIT_L(0); PG8_MMA(0, 1, At, B1); PG8_BAR;
            PG8_LDA(At, 0, 1); PG8_STAGE(PG8_SA(0, 0), a2, voffA);
            PG8_BAR; PG8_WAIT_L(0); PG8_MMA(1, 0, At, B0); PG8_BAR; PG8_SCHED;
            PG8_STAGE(PG8_SB(0, 1), b2 + hstep, voffB);
            PG8_WAIT_V(6); PG8_BAR; PG8_MMA(1, 1, At, B1); PG8_BAR;
            PG8_LDB(B0, 1, 0); PG8_SCHED; PG8_LDA(At, 1, 0); PG8_STAGE(PG8_SA(0, 1), a2 + hstep, voffA);
            PG8_WAIT_L(8); PG8_BAR; PG8_WAIT_L(0); PG8_MMA(0, 0, At, B0); PG8_BAR; PG8_SCHED;
            PG8_LDB(B1, 1, 1); PG8_STAGE(PG8_SB(1, 0), b3, voffB);
            PG8_BAR; PG8_WAIT_L(0); PG8_MMA(0, 1, At, B1); PG8_BAR;
            PG8_LDA(At, 1, 1); PG8_STAGE(PG8_SA(1, 0), a3, voffA);
            PG8_BAR; PG8_WAIT_L(0); PG8_MMA(1, 0, At, B0); PG8_BAR; PG8_SCHED;
            PG8_STAGE(PG8_SB(1, 1), b3 + hstep, voffB);
            PG8_WAIT_V(6); PG8_BAR; PG8_MMA(1, 1, At, B1); PG8_BAR;
            }
        }
        if constexpr (ALIGN_EPI) { if (wr == 0) PG8_BAR; }
        if constexpr (!Epi::AFTER_DRAIN) { E(acc, cur, wr, wc, fr, fq); S.done(cur); }
        if (!has_next) break;
#pragma unroll
        for (int a = 0; a < 2; ++a)
#pragma unroll
            for (int b = 0; b < 2; ++b)
#pragma unroll
                for (int m = 0; m < 4; ++m)
#pragma unroll
                    for (int n = 0; n < 2; ++n) acc[a][b][m][n] = (f32x4){0.f, 0.f, 0.f, 0.f};
        cur = nxt; cA = nA; cB = nB; ++ui; if constexpr (GATHER) { cv0[0] = nv0[0]; cv0[1] = nv0[1]; cv1[0] = nv1[0]; cv1[1] = nv1[1]; }
        if constexpr (ALIGN_EPI) { if (wr == 1) PG8_BAR; }
    }
    PG8_WAIT_V(0);
    if constexpr (!ALIGN_EPI) { if (wr == 0) PG8_BAR; }
    PG8_BAR;
    if constexpr (Epi::AFTER_DRAIN) { E.fused(acc, cur, wr, wc, fr, fq, lds, wid, lane); S.done(cur); }
#undef PG8_ROWOFF
#undef PG8_CV0
#undef PG8_CV1
#undef PG8_SV0
#undef PG8_SV1
#undef PG8_SA
#undef PG8_SB
#undef PG8_STAGE
#undef PG8_LDA
#undef PG8_LDB
#undef PG8_MMA
#undef PG8_WAIT_V
#undef PG8_WAIT_L
#undef PG8_BAR
#undef PG8_SCHED
}
}
namespace attn_body {
using bf16=__hip_bfloat16;
using bf16x8=__attribute__((ext_vector_type(8)))short;
using s16x4=__attribute__((ext_vector_type(4)))short;
using f32x16=__attribute__((ext_vector_type(16)))float;
using u32x4=__attribute__((ext_vector_type(4)))unsigned;
constexpr int D=64;
constexpr int NW=8,QBLK=32,QB=QBLK*NW,KVBLK=64;
__device__ __forceinline__ int crow(int r,int hi){return (r&3)+8*(r>>2)+4*hi;}
#define SBAR() __builtin_amdgcn_sched_barrier(0)
__device__ __forceinline__ void cmask(f32x16&p0,f32x16&p1,int jb,int qrel,int hi){
  const float NEG=-INFINITY; int kb=64*jb+4*hi;
  #pragma unroll
  for(int r=0;r<16;++r){int kv=kb+(r&3)+8*(r>>2); if(kv>qrel)p0[r]=NEG; if(kv+32>qrel)p1[r]=NEG;}
}

constexpr int NSLOT=3, SLOTB=8192;
constexpr int LDS_K=0, LDS_V=NSLOT*SLOTB, LDS_WS=2*NSLOT*SLOTB, LDS_OST=LDS_WS+NW*64*4, LDS_BYTES=LDS_OST+NW*4096;
constexpr float C2=0.125f*1.4426950408889634f;
__device__ __forceinline__ void glds16(const void*gsrc,unsigned lds_dst){unsigned keep;
  asm volatile("s_mov_b32 %0, m0\n\ts_mov_b32 m0, %2\n\ts_nop 0\n\tglobal_load_lds_dwordx4 %1, off\n\ts_mov_b32 m0, %0":"=&s"(keep):"v"(gsrc),"s"(lds_dst):"memory");}
__device__ __forceinline__ float max3f(float a,float b,float c){float r;asm("v_max3_f32 %0, %1, %2, %3":"=v"(r):"v"(a),"v"(b),"v"(c));return r;}
__device__ __forceinline__ float max2f(float a,float b){float r;asm("v_max_f32_e32 %0, %1, %2":"=v"(r):"v"(a),"v"(b));return r;}
__device__ __forceinline__ float fadd_s(float a,float b){float r;asm("v_add_f32_e32 %0, %1, %2":"=v"(r):"v"(a),"v"(b));return r;}
__device__ __forceinline__ float fsub_s(float a,float b){float r;asm("v_sub_f32_e32 %0, %1, %2":"=v"(r):"v"(a),"v"(b));return r;}
typedef float f32x2_t __attribute__((ext_vector_type(2))); typedef __bf16 bf16x2_t __attribute__((ext_vector_type(2)));
__device__ __forceinline__ unsigned cvtpk_s(float lo,float hi){f32x2_t v={lo,hi};bf16x2_t b=__builtin_convertvector(v,bf16x2_t);return __builtin_bit_cast(unsigned,b);}
#define WAIT_BAR(N) asm volatile("s_waitcnt vmcnt(" #N ") lgkmcnt(0)\n\ts_barrier":::"memory")

__device__ __forceinline__ void qkt(f32x16&p0,f32x16&p1,const char*Kslot,const bf16x8*qr,const f32x16&negm,int r32,int hi){
  const char*kb=Kslot+hi*1024+r32*16;
  #pragma unroll
  for(int d0=0;d0<4;++d0){
    const bf16x8 b0=*reinterpret_cast<const bf16x8*>(kb+d0*2048);
    const bf16x8 b1=*reinterpret_cast<const bf16x8*>(kb+d0*2048+512);
    if(d0==0){p0=__builtin_amdgcn_mfma_f32_32x32x16_bf16(b0,qr[0],negm,0,0,0);p1=__builtin_amdgcn_mfma_f32_32x32x16_bf16(b1,qr[0],negm,0,0,0);}
    else{p0=__builtin_amdgcn_mfma_f32_32x32x16_bf16(b0,qr[d0],p0,0,0,0);p1=__builtin_amdgcn_mfma_f32_32x32x16_bf16(b1,qr[d0],p1,0,0,0);}}
}
typedef __attribute__((address_space(3))) const char* lds_cptr;
typedef short v4i16_t __attribute__((ext_vector_type(4)));
__device__ __forceinline__ void kload8(bf16x8*kf,lds_cptr kp){
  kf[0]=*(const __attribute__((address_space(3))) bf16x8*)(kp);      kf[1]=*(const __attribute__((address_space(3))) bf16x8*)(kp+512);
  kf[2]=*(const __attribute__((address_space(3))) bf16x8*)(kp+2048); kf[3]=*(const __attribute__((address_space(3))) bf16x8*)(kp+2560);
  kf[4]=*(const __attribute__((address_space(3))) bf16x8*)(kp+4096); kf[5]=*(const __attribute__((address_space(3))) bf16x8*)(kp+4608);
  kf[6]=*(const __attribute__((address_space(3))) bf16x8*)(kp+6144); kf[7]=*(const __attribute__((address_space(3))) bf16x8*)(kp+6656);
}
__device__ __forceinline__ void kload2(bf16x8*kf,lds_cptr kp,int j){ kf[2*j]=*(const __attribute__((address_space(3))) bf16x8*)(kp+j*2048); kf[2*j+1]=*(const __attribute__((address_space(3))) bf16x8*)(kp+j*2048+512); }
__device__ __forceinline__ s16x4 vtr(lds_cptr p){ return __builtin_bit_cast(s16x4,__builtin_amdgcn_ds_read_tr16_b64_v4i16((__attribute__((address_space(3))) v4i16_t*)p)); }
__device__ __forceinline__ float rowmax(const f32x16&p0,const f32x16&p1){
  float a=max3f(p0[0],p0[1],p1[0]),b=max3f(p0[2],p0[3],p1[1]);a=max3f(a,p1[2],p1[3]);
  #pragma unroll
  for(int r=4;r<16;r+=4){a=max3f(a,p0[r],p0[r+1]);b=max3f(b,p0[r+2],p0[r+3]);a=max3f(a,p1[r],p1[r+1]);b=max3f(b,p1[r+2],p1[r+3]);}
  const float m=max2f(a,b);
  auto rr=__builtin_amdgcn_permlane32_swap(__float_as_uint(m),__float_as_uint(m),false,false);
  return max2f(__uint_as_float(rr[0]),__uint_as_float(rr[1]));
}
__device__ __forceinline__ void pv(f32x16*o,int vb,bf16x8 pa0,bf16x8 pa1,bf16x8 pa2,bf16x8 pa3){
  #pragma unroll
  for(int d0=0;d0<2;++d0){s16x4 lo[4],hi[4];
    #pragma unroll
    for(int ks=0;ks<4;++ks){
      asm volatile("ds_read_b64_tr_b16 %0,%1 offset:%c2":"=&v"(lo[ks]):"v"(vb),"i"(d0*4096+ks*1024):"memory");
      asm volatile("ds_read_b64_tr_b16 %0,%1 offset:%c2":"=&v"(hi[ks]):"v"(vb),"i"(d0*4096+ks*1024+512):"memory");}
    asm volatile("s_waitcnt lgkmcnt(0)":::"memory");SBAR();
    #define PK(k) (bf16x8){lo[k][0],lo[k][1],lo[k][2],lo[k][3],hi[k][0],hi[k][1],hi[k][2],hi[k][3]}
    o[d0]=__builtin_amdgcn_mfma_f32_32x32x16_bf16(pa0,PK(0),o[d0],0,0,0);
    o[d0]=__builtin_amdgcn_mfma_f32_32x32x16_bf16(pa1,PK(1),o[d0],0,0,0);
    o[d0]=__builtin_amdgcn_mfma_f32_32x32x16_bf16(pa2,PK(2),o[d0],0,0,0);
    o[d0]=__builtin_amdgcn_mfma_f32_32x32x16_bf16(pa3,PK(3),o[d0],0,0,0);
    #undef PK
  }
}

#ifndef ATTN_STORE16
#define ATTN_STORE16(p,v) (*(u32x4*)(p)=(v))
#endif
template<int THRL,int QP,int KP,int OP> __device__ __forceinline__ void attn_unit(const bf16*Qu,const bf16*__restrict__ Kh,const bf16*__restrict__ Vh,bf16*Ou,const int NT,char*shm){
  const int tid=opaque_tid(),lane=tid&63,r32=lane&31,hi=lane>>5; const int wid=__builtin_amdgcn_readfirstlane(tid>>6);
  const bf16*Qw=Qu+(long)(wid*QBLK)*QP;
  const unsigned lds0=(unsigned)(uintptr_t)shm;
  float*wsf=(float*)(shm+LDS_WS)+wid*64;
  const bf16*ksrc=Kh+(long)lane*KP+wid*8;
  const bf16*vsrc=Vh+(long)(16*(wid&3)+(lane>>2))*KP+(wid>>2)*32+(lane&3)*8;
  const unsigned kdst=lds0+LDS_K+wid*1024, vdst=lds0+LDS_V+wid*1024;
  #define DMA_K(t,slot) glds16(ksrc+(long)(t)*KVBLK*KP,(unsigned)__builtin_amdgcn_readfirstlane(kdst+(slot)))
  #define DMA_V(t,slot) glds16(vsrc+(long)(t)*KVBLK*KP,(unsigned)__builtin_amdgcn_readfirstlane(vdst+(slot)))
  const int vb0=(int)(lds0+LDS_V)+((lane>>4)&1)*32+(lane&3)*8+(4*hi+((lane&15)>>2))*64;
  const char*Kbase=shm+LDS_K; bf16x8 kf[8];
  const lds_cptr shm3=(lds_cptr)shm; const lds_cptr kp0=shm3+LDS_K+hi*1024+r32*16; const lds_cptr vp0=shm3+LDS_V+((lane>>4)&1)*32+(lane&3)*8+(4*hi+((lane&15)>>2))*64;
  DMA_K(0,0);DMA_V(0,0);DMA_K(1,SLOTB);
  bf16x8 qr[4];
  #pragma unroll
  for(int d0=0;d0<4;++d0)qr[d0]=*reinterpret_cast<const bf16x8*>(&Qw[(long)r32*QP+d0*16+hi*8]);
  float mhat=0.f,l_reg=0.f;f32x16 o[2];o[0]=f32x16{};o[1]=f32x16{};f32x16 negm=f32x16{};asm volatile("":"+v"(negm));
  #define CMASK(P0,P1,t) do{}while(0)
  bool resc=false;
  #define START(P0,P1) do{ const float rm=rowmax(P0,P1); resc=false; \
    { const float dl=rm; mhat=fadd_s(mhat,dl); \
      _Pragma("unroll") for(int r=0;r<16;++r){P0[r]=fsub_s(P0[r],dl);P1[r]=fsub_s(P1[r],dl);} \
      _Pragma("unroll") for(int r=0;r<16;++r)negm[r]=-mhat; asm volatile("":"+v"(negm)); } \
    _Pragma("unroll") for(int r=0;r<16;++r)P0[r]=__builtin_amdgcn_exp2f(P0[r]); }while(0)
  #define RESC() do{ if(resc){ asm volatile("s_waitcnt lgkmcnt(0)":::"memory"); \
      _Pragma("unroll") for(int d_=0;d_<2;++d_) _Pragma("unroll") for(int r=0;r<16;++r)o[d_][r]*=wsf[crow(r,hi)]; } }while(0)
  f32x16 pA0,pA1,pB0,pB1;
  int sl_prev=0,sl_cur=0,sl_next=SLOTB;
  #define ROT() do{sl_prev=sl_cur;sl_cur=sl_next;sl_next=(sl_next==(NSLOT-1)*SLOTB)?0:sl_next+SLOTB;}while(0)
  DMA_K(2,2*SLOTB);
  WAIT_BAR(3);
  qkt(pA0,pA1,Kbase,qr,negm,r32,hi);asm volatile("s_nop 15\n\ts_nop 7":"+v"(pA0),"+v"(pA1));CMASK(pA0,pA1,0);
  START(pA0,pA1);
  _Pragma("unroll") for(int r=0;r<16;++r)pA1[r]=__builtin_amdgcn_exp2f(pA1[r]);
  WAIT_BAR(0);
  DMA_K(3,0);DMA_V(1,SLOTB);
  ROT();
  kload8(kf,kp0+sl_cur);
  WAIT_BAR(2);
  s16x4 vlo[8],vhi[8]; u32x4 pw0,pw1,pw2,pw3;
  #define PKW(P,B) cvtpk_s(P[B],P[B+1])
  #define PAF(k) __builtin_bit_cast(bf16x8,pw##k)
  #define VFR(i) (bf16x8){vlo[i][0],vlo[i][1],vlo[i][2],vlo[i][3],vhi[i][0],vhi[i][1],vhi[i][2],vhi[i][3]}
  #define PIN(x) asm volatile("":"+v"(x))
  #define MX3(a,b,c) __builtin_fmaxf(__builtin_fmaxf((a),(b)),(c))
  #define GAPA(MF,A0,A1,A2,A3,W0,W1,PW) do{ MF; sacc+=A0; sacc+=A1; sacc+=A2; sacc+=A3; PIN(sacc); W0; W1; PIN(PW); SBAR(); }while(0)
  #define EX(v) __builtin_amdgcn_exp2f(v)
  #define GAPB(MF,X,B) do{ MF; X[B]=EX(X[B]); X[B+1]=EX(X[B+1]); X[B+2]=EX(X[B+2]); X[B+3]=EX(X[B+3]); PIN(X); SBAR(); }while(0)
  #define VRD(i) do{ vlo[i]=vtr(vp_+(((i)>>2)*4096+((i)&3)*1024)); vhi[i]=vtr(vp_+(((i)>>2)*4096+((i)&3)*1024+512)); }while(0)
  #define KRD(G,j) do{ if(G){ kload2(kf,kp0+sl_next,j); SBAR(); } }while(0)
  #define STEP(C0,C1,P0,P1,t,GK,GV,GL) do{ SBAR(); \
    const lds_cptr vp_=vp0+sl_prev; \
    VRD(0); SBAR(); float sacc=(P0[0]+P0[1]); \
    GAPA(C0=__builtin_amdgcn_mfma_f32_32x32x16_bf16(kf[0],qr[0],negm,0,0,0), P0[2],P0[3],P0[4],P0[5],     pw0[0]=PKW(P0,0), pw0[1]=PKW(P0,2), pw0); \
    VRD(4); SBAR(); GAPA(C1=__builtin_amdgcn_mfma_f32_32x32x16_bf16(kf[1],qr[0],negm,0,0,0), P0[6],P0[7],P0[8],P0[9],     pw0[2]=PKW(P0,4), pw0[3]=PKW(P0,6), pw0); \
    VRD(1); SBAR(); GAPA(C0=__builtin_amdgcn_mfma_f32_32x32x16_bf16(kf[2],qr[1],C0,0,0,0),   P0[10],P0[11],P0[12],P0[13], pw1[0]=PKW(P0,8), pw1[1]=PKW(P0,10), pw1); \
    VRD(5); SBAR(); GAPA(C1=__builtin_amdgcn_mfma_f32_32x32x16_bf16(kf[3],qr[1],C1,0,0,0),   P0[14],P0[15],P1[0],P1[1],   pw1[2]=PKW(P0,12),pw1[3]=PKW(P0,14), pw1); \
    VRD(2); SBAR(); GAPA(C0=__builtin_amdgcn_mfma_f32_32x32x16_bf16(kf[4],qr[2],C0,0,0,0),   P1[2],P1[3],P1[4],P1[5],     pw2[0]=PKW(P1,0), pw2[1]=PKW(P1,2), pw2); \
    VRD(6); SBAR(); GAPA(C1=__builtin_amdgcn_mfma_f32_32x32x16_bf16(kf[5],qr[2],C1,0,0,0),   P1[6],P1[7],P1[8],P1[9],     pw2[2]=PKW(P1,4), pw2[3]=PKW(P1,6), pw2); \
    VRD(3); SBAR(); GAPA(C0=__builtin_amdgcn_mfma_f32_32x32x16_bf16(kf[6],qr[3],C0,0,0,0),   P1[10],P1[11],P1[12],P1[13], pw3[0]=PKW(P1,8), pw3[1]=PKW(P1,10), pw3); \
    VRD(7); SBAR(); GAPA(C1=__builtin_amdgcn_mfma_f32_32x32x16_bf16(kf[7],qr[3],C1,0,0,0),   P1[14],P1[15],0.f,0.f,       pw3[2]=PKW(P1,12),pw3[3]=PKW(P1,14), pw3); \
    l_reg+=sacc; \
    if(GK){DMA_K((t)+3,sl_cur);} if(GV){DMA_V((t)+1,sl_next);} \
    CMASK(C0,C1,t); \
    { float a=MX3(C0[0],C0[1],C1[0]),b=MX3(C0[2],C0[3],C1[1]); a=MX3(a,C1[2],C1[3]); \
      _Pragma("unroll") for(int r=4;r<16;r+=4){a=MX3(a,C0[r],C0[r+1]);b=MX3(b,C0[r+2],C0[r+3]);a=MX3(a,C1[r],C1[r+1]);b=MX3(b,C1[r+2],C1[r+3]);} \
      float rm=__builtin_fmaxf(a,b); { auto rr=__builtin_amdgcn_permlane32_swap(__float_as_uint(rm),__float_as_uint(rm),false,false); rm=__builtin_fmaxf(__uint_as_float(rr[0]),__uint_as_float(rr[1])); } \
      resc=false; \
      if(__builtin_expect(__any(rm>(float)THRL),0)){ const float dl=__builtin_fmaxf(rm,0.f); mhat+=dl; \
        _Pragma("unroll") for(int r=0;r<16;++r){C0[r]-=dl;C1[r]-=dl;} \
        _Pragma("unroll") for(int r=0;r<16;++r)negm[r]=-mhat; asm volatile("":"+v"(negm)); \
        const float f=__builtin_amdgcn_exp2f(-dl); l_reg*=f; if(hi==0)wsf[r32]=f; resc=true; } } \
    SBAR(); \
    GAPB(o[0]=__builtin_amdgcn_mfma_f32_32x32x16_bf16(PAF(0),VFR(0),o[0],0,0,0), C0,0); \
    GAPB(o[1]=__builtin_amdgcn_mfma_f32_32x32x16_bf16(PAF(0),VFR(4),o[1],0,0,0), C0,4); \
    KRD(GL,0); GAPB(o[0]=__builtin_amdgcn_mfma_f32_32x32x16_bf16(PAF(1),VFR(1),o[0],0,0,0), C0,8); \
    KRD(GL,1); GAPB(o[1]=__builtin_amdgcn_mfma_f32_32x32x16_bf16(PAF(1),VFR(5),o[1],0,0,0), C0,12); \
    KRD(GL,2); GAPB(o[0]=__builtin_amdgcn_mfma_f32_32x32x16_bf16(PAF(2),VFR(2),o[0],0,0,0), C1,0); \
    KRD(GL,3); GAPB(o[1]=__builtin_amdgcn_mfma_f32_32x32x16_bf16(PAF(2),VFR(6),o[1],0,0,0), C1,4); \
    GAPB(o[0]=__builtin_amdgcn_mfma_f32_32x32x16_bf16(PAF(3),VFR(3),o[0],0,0,0), C1,8); \
    GAPB(o[1]=__builtin_amdgcn_mfma_f32_32x32x16_bf16(PAF(3),VFR(7),o[1],0,0,0), C1,12); \
    }while(0)
  int t=1;
  #undef CMASK
  #define CMASK(P0,P1,t) do{}while(0)
  for(;t+5<NT;t+=2){
    STEP(pB0,pB1,pA0,pA1,t,true,true,true);     WAIT_BAR(2); RESC(); ROT();
    STEP(pA0,pA1,pB0,pB1,t+1,true,true,true);   WAIT_BAR(2); RESC(); ROT();
  }
  #undef CMASK
  #define CMASK(P0,P1,t) do{}while(0)
  #define ENDW(tt) do{ if((tt)+3<NT){WAIT_BAR(2);} else if((tt)+2<NT){WAIT_BAR(1);} else {WAIT_BAR(0);} }while(0)
  for(;t+1<NT;t+=2){
    STEP(pB0,pB1,pA0,pA1,t,(t+3<NT),(t+1<NT),(t+1<NT));       ENDW(t);   RESC(); ROT();
    STEP(pA0,pA1,pB0,pB1,t+1,(t+4<NT),(t+2<NT),(t+2<NT));     ENDW(t+1); RESC(); ROT();
  }
  STEP(pB0,pB1,pA0,pA1,NT-1,false,false,false); RESC();
  { float sacc=pB0[0]+pB0[1]; _Pragma("unroll") for(int r=2;r<16;++r)sacc+=pB0[r]; _Pragma("unroll") for(int r=0;r<16;++r)sacc+=pB1[r]; l_reg+=sacc;
    pw0=(u32x4){PKW(pB0,0),PKW(pB0,2),PKW(pB0,4),PKW(pB0,6)};pw1=(u32x4){PKW(pB0,8),PKW(pB0,10),PKW(pB0,12),PKW(pB0,14)};pw2=(u32x4){PKW(pB1,0),PKW(pB1,2),PKW(pB1,4),PKW(pB1,6)};pw3=(u32x4){PKW(pB1,8),PKW(pB1,10),PKW(pB1,12),PKW(pB1,14)};
    SBAR(); pv(o,vb0+sl_cur,PAF(0),PAF(1),PAF(2),PAF(3)); }
  #undef PKW
  #undef PAF
  #undef VFR
  #undef PIN
  #undef MX3
  #undef GAPA
  #undef GAPB
  #undef EX
  #undef VRD
  #undef KRD
  #undef STEP
  #undef ENDW
  {auto rr=__builtin_amdgcn_permlane32_swap(__float_as_uint(l_reg),__float_as_uint(l_reg),false,false);l_reg=__uint_as_float(rr[0])+__uint_as_float(rr[1]);}
  if(hi==0)wsf[32+r32]=l_reg;asm volatile("s_waitcnt lgkmcnt(0)":::"memory");
  float rli[16];
  #pragma unroll
  for(int r=0;r<16;++r)rli[r]=__builtin_amdgcn_rcpf(wsf[32+crow(r,hi)]);
  bf16*Ow=Ou+(long)(wid*QBLK)*OP;
  { bf16*stg=(bf16*)(shm+LDS_OST)+wid*2048;
    #pragma unroll
    for(int r=0;r<16;++r){const int orow=crow(r,hi);
      #pragma unroll
      for(int d0=0;d0<2;++d0)stg[orow*64+d0*32+r32]=__float2bfloat16(o[d0][r]*rli[r]);}
    asm volatile("s_waitcnt lgkmcnt(0)":::"memory");
    #pragma unroll
    for(int i=0;i<4;++i){const int row=i*8+(lane>>3),ch=lane&7; const u32x4 v=*(const u32x4*)(stg+row*64+ch*8); ATTN_STORE16(Ow+(long)row*OP+ch*8,v);} }
  asm volatile("s_waitcnt lgkmcnt(0)\n\ts_barrier":::"memory");
  #undef DMA_K
  #undef DMA_V
  #undef CMASK
  #undef START
  #undef RESC
  #undef ROT
}
constexpr int ATTN_LDS_BYTES=LDS_BYTES;
#undef SBAR
#undef WAIT_BAR
}
#define LDS_WAIT() asm volatile("s_waitcnt lgkmcnt(0)" ::: "memory")

__device__ __forceinline__ void transpose_item(const float* W, int K, int N, bf16* WT, int k0, int n0, int dest_row0, LAS float* scr, int lane) {
    float t_[32];
#pragma unroll
    for (int i = 0; i < 32; ++i) t_[i] = W[(size_t)(k0 + 2 * i + (lane >> 5)) * N + n0 + (lane & 31)];
#pragma unroll
    for (int i = 0; i < 32; ++i) scr[(2 * i + (lane >> 5)) * 33 + (lane & 31)] = t_[i];
    LDS_WAIT(); asm volatile("" ::: "memory");
    const int c = lane & 7;
#pragma unroll
    for (int j = 0; j < 4; ++j) { const int n = (lane >> 3) + 8 * j; const LAS float* s = scr + (8 * c) * 33 + n;
        v4u o; o.x = pk2(s[0 * 33], s[1 * 33]); o.y = pk2(s[2 * 33], s[3 * 33]); o.z = pk2(s[4 * 33], s[5 * 33]); o.w = pk2(s[6 * 33], s[7 * 33]);
        *(GAS v4u*)(WT + (size_t)(dest_row0 + n) * K + k0 + 8 * c) = o; }
    LDS_WAIT(); asm volatile("" ::: "memory");
}

__device__ __forceinline__ void transpose_item8(const float* W, int K, int N, unsigned char* WT, int k0, int n0, int dest_row0, float sc, LAS float* scr, int lane) {
    float t_[32];
#pragma unroll
    for (int i = 0; i < 32; ++i) t_[i] = W[(size_t)(k0 + 2 * i + (lane >> 5)) * N + n0 + (lane & 31)];
#pragma unroll
    for (int i = 0; i < 32; ++i) scr[(2 * i + (lane >> 5)) * 33 + (lane & 31)] = t_[i] * sc;
    LDS_WAIT(); asm volatile("" ::: "memory");
    const int c = lane & 7;
#pragma unroll
    for (int j = 0; j < 4; ++j) { const int n = (lane >> 3) + 8 * j; const LAS float* s = scr + (8 * c) * 33 + n;
        unsigned w0 = 0, w1 = 0;
        w0 = __builtin_amdgcn_cvt_pk_fp8_f32(s[0 * 33], s[1 * 33], w0, false); w0 = __builtin_amdgcn_cvt_pk_fp8_f32(s[2 * 33], s[3 * 33], w0, true);
        w1 = __builtin_amdgcn_cvt_pk_fp8_f32(s[4 * 33], s[5 * 33], w1, false); w1 = __builtin_amdgcn_cvt_pk_fp8_f32(s[6 * 33], s[7 * 33], w1, true);
        *(GAS v2u*)(WT + (size_t)(dest_row0 + n) * K + k0 + 8 * c) = (v2u){w0, w1}; }
    LDS_WAIT(); asm volatile("" ::: "memory");
}

struct ProIn { const float *hy_w_in, *at_w_in, *w_out, *w_mem_kv; };
__device__ __forceinline__ void phase_weights(const ProIn& P, unsigned char* ws, LAS unsigned char* lds, int gw, int NGW, int wave, int lane) {
    LAS float* scr = (LAS float*)(lds + wave * 16384);
    constexpr int I_HY = 16 * 80, I_AT = 16 * 48, I_OUT = 16 * 32, I_MKV = 16 * 16;
    constexpr int E0 = 2 * I_HY, E1 = E0 + 2 * I_AT, E2 = E1 + 4 * I_OUT, E3 = E2 + 4 * I_MKV;
    for (int it = gw; it < E3; it += NGW) {
        int r = it;
        if (r < E0) { const int j = r / I_HY, q = r % I_HY, kb = q / 80, nb = q % 80;
            transpose_item(P.hy_w_in + (size_t)j * DM * D_IN_HY, DM, D_IN_HY, (bf16*)(ws + WS_WHY) + (size_t)j * D_IN_HY * DM, 64 * kb, 32 * nb, 32 * nb, scr, lane); continue; }
        r -= E0;
        if (r < 2 * I_AT) { const int j = r / I_AT, q = r % I_AT, kb = q / 48, nb = q % 48;
            const int n0 = 32 * nb, o = n0 & 255;
            transpose_item(P.at_w_in + (size_t)j * DM * D_IN_AT, DM, D_IN_AT, (bf16*)(ws + WS_WAT) + (size_t)j * D_IN_AT * DM, 64 * kb, n0, (n0 & ~255) + 128 * ((o & 63) >> 5) + 32 * (o >> 6), scr, lane); continue; }
        r -= 2 * I_AT;
        if (r < 4 * I_OUT) { const int j = r / I_OUT, q = r % I_OUT, kb = q / 32, nb = q % 32;
            transpose_item(P.w_out + (size_t)j * DM * DM, DM, DM, (bf16*)(ws + WS_WOUT) + (size_t)j * DM * DM, 64 * kb, 32 * nb, 32 * nb, scr, lane); continue; }
        r -= 4 * I_OUT;
        { const int j = r / I_MKV, q = r % I_MKV, kb = q / 16, nb = q % 16;
            transpose_item(P.w_mem_kv + (size_t)j * DM * 512, DM, 512, (bf16*)(ws + WS_WMKV), 64 * kb, 32 * nb, j * 512 + 32 * nb, scr, lane); }
        (void)r;
    }
}

struct XwIn { const float *w_gate, *w_up, *w_down; unsigned char* ws; };
constexpr int XW_PER_EXPERT = 3 * 384, XW_PER_LAYER = NEXP * XW_PER_EXPERT;
constexpr int XW_QA_HY = 5, XW_QA_AT = 4, XW_QB = 3, XW_NA = 128 * NWAVES, XW_NB = 224 * NWAVES;
__host__ __device__ constexpr int xw_qa(int layer) { return (layer & 1) ? XW_QA_AT : XW_QA_HY; }
__host__ __device__ constexpr int xw_p0(int layer, bool sched) { return sched ? XW_PER_LAYER - xw_qa(layer) * XW_NA - XW_QB * XW_NB : XW_PER_LAYER; }
__device__ __forceinline__ void xw_item(const XwIn& B, int layer, int r, LAS float* scr, int lane) {
    const int j = layer * NEXP + r / XW_PER_EXPERT, q = r % XW_PER_EXPERT, kind = q / 384, qq = q % 384;
    if (kind < 2) { const int kb = qq / 24, nb = qq % 24, n0 = 32 * nb;
        transpose_item8((kind == 0 ? B.w_gate : B.w_up) + (size_t)j * DM * EFF, DM, EFF, B.ws + WS_W1 + (size_t)j * 1536 * DM, 64 * kb, n0, (n0 >> 7) * 256 + 128 * kind + (n0 & 127), W8_SCALE, scr, lane); }
    else { const int kb = qq / 32, nb = qq % 32;
        transpose_item8(B.w_down + (size_t)j * EFF * DM, EFF, DM, B.ws + WS_W2 + (size_t)j * DM * EFF, 64 * kb, 32 * nb, 32 * nb, W8_SCALE, scr, lane); }
}
__device__ __forceinline__ void phase_xw_p0(const XwIn& B, bool sched, LAS float* scr, int gw, int NGW, int lane) {
#pragma unroll 1
    for (int layer = 0; layer < DEPTH; ++layer) { const int n = xw_p0(layer, sched);
#pragma unroll 1
        for (int r = gw; r < n; r += NGW) xw_item(B, layer, r, scr, lane); }
}
__device__ __forceinline__ void xw_slice_a(const XwIn& B, int layer, LAS float* scr, int bx, int wave, int lane) {
    const int base = xw_p0(layer, true) + (bx - 128) * NWAVES + wave;
#pragma unroll 1
    for (int k = 0; k < xw_qa(layer); ++k) xw_item(B, layer, base + k * XW_NA, scr, lane);
}
__device__ __forceinline__ void xw_slice_b(const XwIn& B, int layer, LAS float* scr, int bx, int wave, int lane) {
    const int base = xw_p0(layer, true) + xw_qa(layer) * XW_NA + (bx - 32) * NWAVES + wave;
#pragma unroll 1
    for (int k = 0; k < XW_QB; ++k) xw_item(B, layer, base + k * XW_NB, scr, lane);
}

__device__ __forceinline__ void rms_row_bf16(const float* xrow, const float* g, bf16* orow, int lane) {
    const GAS f32x4* xr = (const GAS f32x4*)xrow + lane; const GAS f32x4* gr = (const GAS f32x4*)g + lane;
    f32x4 v[4]; float s = 0.f;
#pragma unroll
    for (int j = 0; j < 4; ++j) { v[j] = xr[64 * j]; s += (v[j].x * v[j].x + v[j].y * v[j].y) + (v[j].z * v[j].z + v[j].w * v[j].w); }
    const float rstd = 1.f / sqrtf(wave_sum(s) * (1.f / DM) + NORM_EPS);
    GAS v2u* o8 = (GAS v2u*)orow + lane;
#pragma unroll
    for (int j = 0; j < 4; ++j) { const f32x4 gg = gr[64 * j]; v2u w; w.x = pk2(v[j].x * rstd * gg.x, v[j].y * rstd * gg.y); w.y = pk2(v[j].z * rstd * gg.z, v[j].w * rstd * gg.w); o8[64 * j] = w; }
}

__device__ __forceinline__ void phase_mem_h2(const float* mem, const float* mem_g, const float* fw1, const float* fb1, const float* fw2, const float* fb2, const float* ffreq,
                                              unsigned char* ws, int gw, int NGW, int lane) {
    for (int m = gw; m < BATCH * MEM_LEN; m += NGW) rms_row_bf16(mem + (size_t)m * DM, mem_g, (bf16*)(ws + WS_MEMN) + (size_t)m * DM, lane);
    float* H2 = (float*)(ws + WS_H2);
    for (int it = gw; it < 2 * SEQ; it += NGW) {
        const int j = it / SEQ, n = it % SEQ;
        const float* w1 = fw1 + j * HY_EMB * HY_FILT; const float* w2 = fw2 + j * HY_FILT * HY_FILT;
        const float t = (float)n * (1.0f / (float)(SEQ - 1));
        const float w = (6.283185307179586f * (float)n) / (float)SEQ;
        float feat = 0.f;
        if (lane == 0) feat = t;
        else if (lane <= 16) { const float band = 1e-4f + (float)(lane - 1) * ((15.0f - 1e-4f) / 15.0f); feat = cosf(band * w); }
        else if (lane <= 32) { const float band = 1e-4f + (float)(lane - 17) * ((15.0f - 1e-4f) / 15.0f); feat = -sinf(band * w); }
        const float fr = ffreq[j * HY_FILT + lane];
        float a = fb1[j * HY_FILT + lane];
        for (int i = 0; i < HY_EMB; ++i) a += __shfl(feat, i) * w1[i * HY_FILT + lane];
        const float h1 = sinf(fr * a);
        float a2 = fb2[j * HY_FILT + lane];
        for (int i = 0; i < HY_FILT; ++i) a2 += __shfl(h1, i) * w2[i * HY_FILT + lane];
        H2[(size_t)it * HY_FILT + lane] = sinf(fr * a2);
    }
}

template <bool COMBINE, bool FINAL>
__device__ __forceinline__ void phase_norm(const float* hin, float* hout, const float* g, bf16* U, float* fout, const int* POS, const bf16* Y, int gw, int NGW, int lane) {
    int m = gw;
    if (m >= M_TOK) return;
    f32x4 cur[4]; int cpos = -1;
    { const GAS f32x4* xr = (const GAS f32x4*)(hin + (size_t)m * DM) + lane;
#pragma unroll
      for (int j = 0; j < 4; ++j) cur[j] = xr[64 * j];
      if (COMBINE) { const int b = m / SEQ, t = m % SEQ; if (lane < NEXP) cpos = POS[(size_t)(b * NEXP + lane) * SEQ + t]; } }
#pragma unroll 1
    for (; m < M_TOK; m += NGW) {
        const int mn = m + NGW; f32x4 nxt[4]; int npos = -1;
#pragma unroll
        for (int j = 0; j < 4; ++j) nxt[j] = cur[j];
        if (mn < M_TOK) { const GAS f32x4* xr = (const GAS f32x4*)(hin + (size_t)mn * DM) + lane;
#pragma unroll
            for (int j = 0; j < 4; ++j) nxt[j] = xr[64 * j];
            if (COMBINE) { const int b = mn / SEQ, t = mn % SEQ; if (lane < NEXP) npos = POS[(size_t)(b * NEXP + lane) * SEQ + t]; } }
        f32x4 v[4];
#pragma unroll
        for (int j = 0; j < 4; ++j) v[j] = cur[j];
        if (COMBINE) {
            const int b = m / SEQ;
            unsigned long long mask = __ballot(cpos >= 0);
            while (mask) {
                v2u y[4][4]; bool has[4];
#pragma unroll
                for (int k = 0; k < 4; ++k) { has[k] = mask != 0ull;
                    if (has[k]) { const int e = __builtin_amdgcn_readfirstlane(__builtin_ctzll(mask)); mask &= mask - 1ull; const int p = __builtin_amdgcn_readlane(cpos, e);
                        const GAS v2u* yr = (const GAS v2u*)(Y + ((size_t)(b * NEXP + e) * CAP + p) * DM) + lane;
#pragma unroll
                        for (int j = 0; j < 4; ++j) y[k][j] = yr[64 * j]; } }
#pragma unroll
                for (int k = 0; k < 4; ++k) if (has[k]) {
#pragma unroll
                    for (int j = 0; j < 4; ++j) { const v2u w = y[k][j]; v[j].x += bflo(w.x); v[j].y += bfhi(w.x); v[j].z += bflo(w.y); v[j].w += bfhi(w.y); } }
            }
            if (!FINAL) { GAS f32x4* ho = (GAS f32x4*)(hout + (size_t)m * DM) + lane;
#pragma unroll
                for (int j = 0; j < 4; ++j) ho[64 * j] = v[j]; }
        }
        float s = 0.f;
#pragma unroll
        for (int j = 0; j < 4; ++j) s += (v[j].x * v[j].x + v[j].y * v[j].y) + (v[j].z * v[j].z + v[j].w * v[j].w);
        const float rstd = 1.f / sqrtf(wave_sum(s) * (1.f / DM) + NORM_EPS);
        const GAS f32x4* gr = (const GAS f32x4*)g + lane;
        if (FINAL) { GAS f32x4* o = (GAS f32x4*)(fout + (size_t)m * DM) + lane;
#pragma unroll
            for (int j = 0; j < 4; ++j) o[64 * j] = v[j] * rstd * gr[64 * j]; }
        else { GAS v2u* o8 = (GAS v2u*)(U + (size_t)m * DM) + lane;
#pragma unroll
            for (int j = 0; j < 4; ++j) { const f32x4 gg = gr[64 * j]; v2u w; w.x = pk2(v[j].x * rstd * gg.x, v[j].y * rstd * gg.y); w.y = pk2(v[j].z * rstd * gg.z, v[j].w * rstd * gg.w); o8[64 * j] = w; } }
#pragma unroll
        for (int j = 0; j < 4; ++j) cur[j] = nxt[j];
        cpos = npos;
    }
}

__device__ __forceinline__ void phase_ffn_norm_router(const float* H, const float* g, const float* Wr, unsigned char* XN8, float* AFF, LAS unsigned char* lds, int gw, int NGW, int lane, int tid) {
    LAS f32x4* WL = (LAS f32x4*)lds;
    for (int q = tid; q < 64 * 64; q += NTHREADS) { const int ln = q & 63, s = q >> 6, e4 = s & 3, ji = s >> 2, i = ji & 3, j = ji >> 2; const int d = 4 * ln + i + 256 * j;
        WL[q] = *(const GAS f32x4*)(Wr + (size_t)d * NEXP + 4 * e4); }
    __syncthreads();
    constexpr int R = 4;
    const GAS f32x4* gr = (const GAS f32x4*)g + lane;
#pragma unroll 1
    for (int m0 = gw * R; m0 < M_TOK; m0 += NGW * R) {
        int lo_ = lane; asm volatile("" : "+v"(lo_));
        f32x4 v[R][4]; float rstd[R];
#pragma unroll
        for (int r = 0; r < R; ++r) { const GAS f32x4* xr = (const GAS f32x4*)(H + (size_t)(m0 + r) * DM) + lane;
#pragma unroll
            for (int j = 0; j < 4; ++j) v[r][j] = xr[64 * j]; }
#pragma unroll
        for (int r = 0; r < R; ++r) { float s = 0.f;
#pragma unroll
            for (int j = 0; j < 4; ++j) s += (v[r][j].x * v[r][j].x + v[r][j].y * v[r][j].y) + (v[r][j].z * v[r][j].z + v[r][j].w * v[r][j].w);
            rstd[r] = 1.f / sqrtf(wave_sum(s) * (1.f / DM) + NORM_EPS); }
        f32x4 lg[R][4];
#pragma unroll
        for (int r = 0; r < R; ++r)
#pragma unroll
            for (int e4 = 0; e4 < 4; ++e4) lg[r][e4] = (f32x4){0.f, 0.f, 0.f, 0.f};
#pragma unroll
        for (int j = 0; j < 4; ++j) { const f32x4 gg = gr[64 * j];
#pragma unroll
            for (int r = 0; r < R; ++r) { v[r][j] = v[r][j] * rstd[r] * gg;
                unsigned w = 0; w = __builtin_amdgcn_cvt_pk_fp8_f32(v[r][j].x, v[r][j].y, w, false); w = __builtin_amdgcn_cvt_pk_fp8_f32(v[r][j].z, v[r][j].w, w, true);
                ((GAS unsigned*)(XN8 + (size_t)(m0 + r) * DM) + lane)[64 * j] = w; }
#pragma unroll
            for (int i = 0; i < 4; ++i)
#pragma unroll
                for (int e4 = 0; e4 < 4; ++e4) { const f32x4 wv = WL[((j * 4 + i) * 4 + e4) * 64 + lo_];
#pragma unroll
                    for (int r = 0; r < R; ++r) { const float xs = v[r][j][i];
#pragma unroll
                        for (int c = 0; c < 4; ++c) asm("v_fmac_f32 %0, %1, %2" : "+v"(lg[r][e4][c]) : "v"(wv[c]), "v"(xs)); } }
            __builtin_amdgcn_sched_barrier(0); }
#pragma unroll
        for (int r = 0; r < R; ++r) {
            float l16[16];
#pragma unroll
            for (int e = 0; e < 16; ++e) l16[e] = wave_sum(lg[r][e >> 2][e & 3]);
            float mx = l16[0];
#pragma unroll
            for (int e = 1; e < 16; ++e) mx = fmaxf(mx, l16[e]);
            float den = 0.f;
#pragma unroll
            for (int e = 0; e < 16; ++e) { l16[e] = expf(l16[e] - mx); den += l16[e]; }
            float mine = 0.f;
#pragma unroll
            for (int e = 0; e < 16; ++e) mine = (lane == e) ? l16[e] : mine;
            const int m = m0 + r, b = m / SEQ, t = m % SEQ;
            if (lane < NEXP) AFF[(size_t)(b * NEXP + lane) * SEQ + t] = mine / den;
        }
    }
    __syncthreads();
}

__device__ __forceinline__ int block_excl_scan(int v, LAS int* scr, int tid, int lane, int wave, int* tot) {
    int inc = v;
#pragma unroll
    for (int o = 1; o < 64; o <<= 1) { const int n = __shfl_up(inc, o); if (lane >= o) inc += n; }
    __syncthreads();
    if (lane == 63) scr[wave] = inc;
    __syncthreads();
    int base = 0, total = 0;
#pragma unroll
    for (int w = 0; w < NWAVES; ++w) { const int c = scr[w]; if (w < wave) base += c; total += c; }
    *tot = total;
    return base + inc - v;
}

__device__ __forceinline__ void phase_topk(const float* AFF, int* IDX, float* GATE, int* POS, LAS unsigned char* ldsm, int blk, int nblk, int tid, int lane, int wave) {
    LAS int* hist = (LAS int*)ldsm;
    LAS int* sel = (LAS int*)(ldsm + 1024);
    LAS int* scr = (LAS int*)(ldsm + 1280);
    for (int g = blk; g < NGRP; g += nblk) {
        unsigned v[16];
        { const GAS v4u* src = (const GAS v4u*)(AFF + (size_t)g * SEQ) + tid * 4;
#pragma unroll
          for (int q = 0; q < 4; ++q) { const v4u w = src[q]; v[4 * q] = w.x; v[4 * q + 1] = w.y; v[4 * q + 2] = w.z; v[4 * q + 3] = w.w; } }
        unsigned prefix = 0u; int krem = CAP;
#pragma unroll 1
        for (int pass = 0; pass < 4; ++pass) {
            const int shift = 24 - 8 * pass;
            const unsigned himask = (pass == 0) ? 0u : (0xffffffffu << (shift + 8));
            __syncthreads();
            if (tid < 256) hist[tid] = 0;
            __syncthreads();
#pragma unroll
            for (int i = 0; i < 16; ++i) if ((v[i] & himask) == prefix) __hip_atomic_fetch_add(hist + ((v[i] >> shift) & 255u), 1, __ATOMIC_RELAXED, __HIP_MEMORY_SCOPE_WORKGROUP);
            __syncthreads();
            if (wave == 0) {
                int c[4]; int s = 0;
#pragma unroll
                for (int j = 0; j < 4; ++j) { c[j] = hist[255 - 4 * lane - j]; s += c[j]; }
                int inc = s;
#pragma unroll
                for (int o = 1; o < 64; o <<= 1) { const int n = __shfl_up(inc, o); if (lane >= o) inc += n; }
                int before = inc - s;
                if (before < krem && krem <= inc) {
                    int bin = 0, kk = krem - before; bool done = false;
#pragma unroll
                    for (int j = 0; j < 4; ++j) { if (!done) { if (kk <= c[j]) { bin = 255 - 4 * lane - j; done = true; } else kk -= c[j]; } }
                    sel[0] = bin; sel[1] = kk;
                }
            }
            __syncthreads();
            prefix |= ((unsigned)sel[0]) << shift; krem = sel[1];
        }
        int ceq = 0;
#pragma unroll
        for (int i = 0; i < 16; ++i) ceq += (v[i] == prefix) ? 1 : 0;
        int tot;
        int eqrank = block_excl_scan(ceq, scr, tid, lane, wave, &tot);
        int csel = 0; unsigned selmask = 0u;
#pragma unroll
        for (int i = 0; i < 16; ++i) { bool s = v[i] > prefix; if (v[i] == prefix) { s = eqrank < krem; ++eqrank; } if (s) { selmask |= 1u << i; ++csel; } }
        int slot = block_excl_scan(csel, scr, tid, lane, wave, &tot);
        const int b = g / NEXP;
        int pv[16];
#pragma unroll
        for (int i = 0; i < 16; ++i) {
            pv[i] = -1;
            if (selmask & (1u << i)) { pv[i] = slot; IDX[g * CAP + slot] = b * SEQ + tid * 16 + i; GATE[g * CAP + slot] = __builtin_bit_cast(float, v[i]); ++slot; }
        }
        { GAS v4u* dst = (GAS v4u*)(POS + (size_t)g * SEQ) + tid * 4;
#pragma unroll
          for (int q = 0; q < 4; ++q) { v4u w; w.x = (unsigned)pv[4 * q]; w.y = (unsigned)pv[4 * q + 1]; w.z = (unsigned)pv[4 * q + 2]; w.w = (unsigned)pv[4 * q + 3]; dst[q] = w; } }
        __syncthreads();
    }
}

__device__ __forceinline__ void phase_gather(const bf16* XN, const int* IDX, bf16* XG, int gw, int NGW, int lane) {
    for (int r = gw; r < XROWS; r += NGW) {
        const int src = __builtin_amdgcn_readfirstlane(IDX[r]);
        const GAS v4u* s = (const GAS v4u*)(XN + (size_t)src * DM) + lane; GAS v4u* d = (GAS v4u*)(XG + (size_t)r * DM) + lane;
        const v4u a = s[0], b = s[64]; d[0] = a; d[64] = b;
    }
}

__device__ __forceinline__ void phase_qk_rope(bf16* P, const float* gq, const float* gk, int gw, int NGW, int lane) {
    const int hh = lane >> 2, part = lane & 3, axis = part >> 1, half = part & 1;
    const float* g = (hh < NQH ? gq : gk) + 16 * part;
    float gv[16], inv[16];
#pragma unroll
    for (int i = 0; i < 16; ++i) { gv[i] = g[i]; inv[i] = exp2f(-(float)i * (13.287712379549449f / 16.0f)); }
    const float osc = hh < NQH ? ATT_C2 : 1.0f;
    int m = gw; v4u c0 = (v4u){0u, 0u, 0u, 0u}, c1 = c0;
    if (m < M_TOK) { const GAS v4u* p = (const GAS v4u*)(P + (size_t)m * D_IN_AT + hh * HD + 16 * part); c0 = p[0]; c1 = p[1]; }
#pragma unroll 1
    for (; m < M_TOK; m += NGW) {
        const int t = m % SEQ; const float pos = (float)(axis == 0 ? (t >> 6) : (t & 63));
        GAS v4u* p = (GAS v4u*)(P + (size_t)m * D_IN_AT + hh * HD + 16 * part);
        const v4u w0 = c0, w1 = c1;
        if (m + NGW < M_TOK) { const GAS v4u* pn = (const GAS v4u*)(P + (size_t)(m + NGW) * D_IN_AT + hh * HD + 16 * part); c0 = pn[0]; c1 = pn[1]; }
        float x[16];
        x[0] = bflo(w0.x); x[1] = bfhi(w0.x); x[2] = bflo(w0.y); x[3] = bfhi(w0.y); x[4] = bflo(w0.z); x[5] = bfhi(w0.z); x[6] = bflo(w0.w); x[7] = bfhi(w0.w);
        x[8] = bflo(w1.x); x[9] = bfhi(w1.x); x[10] = bflo(w1.y); x[11] = bfhi(w1.y); x[12] = bflo(w1.z); x[13] = bfhi(w1.z); x[14] = bflo(w1.w); x[15] = bfhi(w1.w);
        float ss = 0.f;
#pragma unroll
        for (int i = 0; i < 16; ++i) ss += x[i] * x[i];
        ss += __shfl_xor(ss, 1); ss += __shfl_xor(ss, 2);
        const float rstd = 1.f / sqrtf(ss * (1.f / HD) + NORM_EPS);
        float o[16];
#pragma unroll
        for (int i = 0; i < 16; ++i) {
            const float xn = x[i] * rstd * gv[i]; const float xp = __shfl_xor(xn, 1);
            float sn, cs; sincosf(pos * inv[i], &sn, &cs);
            o[i] = (half == 0 ? (xn * cs - xp * sn) : (xp * sn + xn * cs)) * osc;
        }
        v4u r0, r1;
        r0.x = pk2(o[0], o[1]); r0.y = pk2(o[2], o[3]); r0.z = pk2(o[4], o[5]); r0.w = pk2(o[6], o[7]);
        r1.x = pk2(o[8], o[9]); r1.y = pk2(o[10], o[11]); r1.z = pk2(o[12], o[13]); r1.w = pk2(o[14], o[15]);
        p[0] = r0; p[1] = r1;
    }
}

__device__ __forceinline__ void phase_transpose_mix(const bf16* MIXT, bf16* MIX, int blk, int nblk, int tid) {
    for (int it = blk; it < (D_MAIN / 64) * (M_TOK / NTHREADS); it += nblk) {
        const int cb = it % (D_MAIN / 64), mb = it / (D_MAIN / 64); const int m = mb * NTHREADS + tid, c0 = cb * 64;
        unsigned w[32];
#pragma unroll
        for (int c = 0; c < 32; ++c) { const unsigned lo = MIXT[(size_t)(c0 + 2 * c) * M_TOK + m], hi = MIXT[(size_t)(c0 + 2 * c + 1) * M_TOK + m]; w[c] = lo | (hi << 16); }
        GAS v4u* d = (GAS v4u*)(MIX + (size_t)m * DM + c0);
#pragma unroll
        for (int q = 0; q < 8; ++q) { v4u o; o.x = w[4 * q]; o.y = w[4 * q + 1]; o.z = w[4 * q + 2]; o.w = w[4 * q + 3]; d[q] = o; }
    }
}
__device__ __forceinline__ void phase_taps(const float* H2j, const float* w3, bf16* TAPS, int gw, int NGW, int lane) {
    typedef float f32x16 __attribute__((ext_vector_type(16))); typedef short bf16x8_t __attribute__((ext_vector_type(8)));
    const float min_decay = -4.605170185988091f / 1.5f, max_decay = -4.605170185988091f / 0.3f;
    const int li = lane & 31, hi = lane >> 5;
#pragma unroll 1
    for (int it = gw; it < (FCOLS / 32) * (SEQ / 128); it += NGW) {
        const int ct = it % (FCOLS / 32), ng = it / (FCOLS / 32), col0 = ct * 32;
        bf16x8_t a[4];
#pragma unroll
        for (int s = 0; s < 4; ++s) { float t[8];
#pragma unroll
            for (int j = 0; j < 8; ++j) t[j] = w3[(size_t)(16 * s + 8 * hi + j) * FCOLS + col0 + li];
            v4u p; p.x = pk2(t[0], t[1]); p.y = pk2(t[2], t[3]); p.z = pk2(t[4], t[5]); p.w = pk2(t[6], t[7]); a[s] = __builtin_bit_cast(bf16x8_t, p); }
        f32x4 hv[4][8];
#pragma unroll
        for (int nt = 0; nt < 4; ++nt) { const GAS f32x4* hp = (const GAS f32x4*)(H2j + (size_t)(ng * 128 + nt * 32 + li) * HY_FILT + 8 * hi);
#pragma unroll
            for (int s = 0; s < 4; ++s) { hv[nt][2 * s] = hp[4 * s]; hv[nt][2 * s + 1] = hp[4 * s + 1]; } }
#pragma unroll
        for (int nt = 0; nt < 4; ++nt) {
            const int n0 = ng * 128 + nt * 32;
            f32x16 acc;
#pragma unroll
            for (int r = 0; r < 16; ++r) acc[r] = 0.f;
#pragma unroll
            for (int s = 0; s < 4; ++s) { const f32x4 v0 = hv[nt][2 * s], v1 = hv[nt][2 * s + 1];
                v4u p; p.x = pk2(v0.x, v0.y); p.y = pk2(v0.z, v0.w); p.z = pk2(v1.x, v1.y); p.w = pk2(v1.z, v1.w);
                acc = __builtin_amdgcn_mfma_f32_32x32x16_bf16(a[s], __builtin_bit_cast(bf16x8_t, p), acc, 0, 0, 0); }
            const float t = (float)(n0 + li) * (1.0f / (float)(SEQ - 1));
#pragma unroll
            for (int r = 0; r < 16; ++r) { const int col = col0 + (r & 3) + 8 * (r >> 2) + 4 * hi, c = col % D_MAIN;
                const float ad = fabsf(min_decay + (float)c * ((max_decay - min_decay) / (float)(D_MAIN - 1)));
                TAPS[(size_t)col * SEQ + n0 + li] = (bf16)f2bf(acc[r] * expf(-t * ad)); }
        }
    }
}

__device__ __forceinline__ constexpr float twc(int k) { constexpr float T[16] = {1.0f, 0.98078528040323043f, 0.92387953251128674f, 0.83146961230254524f, 0.70710678118654757f, 0.55557023301960218f, 0.38268343236508978f, 0.19509032201612825f,
    0.0f, -0.19509032201612825f, -0.38268343236508978f, -0.55557023301960218f, -0.70710678118654757f, -0.83146961230254524f, -0.92387953251128674f, -0.98078528040323043f}; return T[k]; }
__device__ __forceinline__ constexpr float tws(int k) { constexpr float T[16] = {0.0f, 0.19509032201612825f, 0.38268343236508978f, 0.55557023301960218f, 0.70710678118654757f, 0.83146961230254524f, 0.92387953251128674f, 0.98078528040323043f,
    1.0f, 0.98078528040323043f, 0.92387953251128674f, 0.83146961230254524f, 0.70710678118654757f, 0.55557023301960218f, 0.38268343236508978f, 0.19509032201612825f}; return T[k]; }
__device__ __forceinline__ constexpr int bitrev(int i, int bits) { int r = 0; for (int b = 0; b < bits; ++b) if (i & (1 << b)) r |= 1 << (bits - 1 - b); return r; }

template <int N, int LEN> struct FftStage {
    static __device__ __forceinline__ void run(float (&re)[N], float (&im)[N]) {
        constexpr int half = LEN / 2, step = 32 / LEN;
#pragma unroll
        for (int base = 0; base < N; base += LEN)
#pragma unroll
            for (int j = 0; j < half; ++j) {
                const int i0 = base + j, i1 = i0 + half, idx = j * step;
                const float ar = re[i0], ai = im[i0], br = re[i1], bi = im[i1];
                re[i0] = ar + br; im[i0] = ai + bi;
                const float dr = ar - br, di = ai - bi;
                if (idx == 0) { re[i1] = dr; im[i1] = di; }
                else if (idx == 8) { re[i1] = di; im[i1] = -dr; }
                else { const float c = twc(idx), s = tws(idx); re[i1] = dr * c + di * s; im[i1] = di * c - dr * s; }
            }
        if constexpr (LEN > 2) FftStage<N, LEN / 2>::run(re, im);
    }
};
template <int N, int BITS> __device__ __forceinline__ void fft_reg(float (&re)[N], float (&im)[N]) {
    FftStage<N, N>::run(re, im);
    float tr[N], ti[N];
#pragma unroll
    for (int i = 0; i < N; ++i) { tr[bitrev(i, BITS)] = re[i]; ti[bitrev(i, BITS)] = im[i]; }
#pragma unroll
    for (int i = 0; i < N; ++i) { re[i] = tr[i]; im[i] = ti[i]; }
}

__device__ __forceinline__ void fft16k(float (&re)[32], float (&im)[32], LAS f32x2* L, int tid_in) {
    int tid = tid_in; asm volatile("" : "+v"(tid));
    fft_reg<32, 5>(re, im);
#pragma unroll
    for (int k1 = 1; k1 < 32; ++k1) { const float fr = (float)((tid * k1) & 16383) * (1.0f / 16384.0f); const float c = __builtin_amdgcn_cosf(fr), s = __builtin_amdgcn_sinf(fr);
        const float r = re[k1], i = im[k1]; re[k1] = r * c + i * s; im[k1] = i * c - r * s; if ((k1 & 3) == 3) __builtin_amdgcn_sched_barrier(0); }
#pragma unroll
    for (int k1 = 0; k1 < 32; ++k1) L[k1 * 513 + tid] = (f32x2){re[k1], im[k1]};
    __syncthreads();
    const int n3 = tid & 31, ka = tid >> 5;
    float ar[16], ai[16], br[16], bi[16];
#pragma unroll
    for (int n2 = 0; n2 < 16; ++n2) { const f32x2 a = L[ka * 513 + n2 * 32 + n3], b = L[(ka + 16) * 513 + n2 * 32 + n3]; ar[n2] = a.x; ai[n2] = a.y; br[n2] = b.x; bi[n2] = b.y; }
    fft_reg<16, 4>(ar, ai); fft_reg<16, 4>(br, bi);
#pragma unroll
    for (int k2 = 1; k2 < 16; ++k2) { const float fr = (float)((n3 * k2) & 511) * (1.0f / 512.0f); const float c = __builtin_amdgcn_cosf(fr), s = __builtin_amdgcn_sinf(fr);
        float r = ar[k2], i = ai[k2]; ar[k2] = r * c + i * s; ai[k2] = i * c - r * s;
        r = br[k2]; i = bi[k2]; br[k2] = r * c + i * s; bi[k2] = i * c - r * s; if ((k2 & 3) == 3) __builtin_amdgcn_sched_barrier(0); }
    __syncthreads();
#pragma unroll
    for (int k2 = 0; k2 < 16; ++k2) { L[n3 * 513 + k2 * 32 + ka] = (f32x2){ar[k2], ai[k2]}; L[n3 * 513 + k2 * 32 + ka + 16] = (f32x2){br[k2], bi[k2]}; }
    __syncthreads();
#pragma unroll
    for (int q = 0; q < 32; ++q) { const f32x2 v = L[q * 513 + tid]; re[q] = v.x; im[q] = v.y; }
    fft_reg<32, 5>(re, im);
}

constexpr int HS_SP = SEQ + 16;
__device__ __forceinline__ void hy_stage(LAS bf16* S, int slot, const bf16* src, int tid) {
    LAS bf16* d = S + slot * HS_SP + 8;
    if (tid == 0) { d[-1] = 0; d[SEQ] = 0; }
#pragma unroll
    for (int q = 0; q < 2; ++q) { const int ch = q * NTHREADS + tid; *(LAS v4u*)(d + ch * 8) = *(const GAS v4u*)(src + ch * 8); }
}
__device__ __forceinline__ float hy_sc(const LAS bf16* S, int slot, int t, float w0, float w1, float w2) {
    const LAS bf16* p = S + slot * HS_SP + 8 + t;
    return bf2f(p[-1]) * w0 + bf2f(p[0]) * w1 + bf2f(p[1]) * w2;
}

__device__ __forceinline__ void phase_hyena_conv(const bf16* PT, const bf16* TAPS, const float* shortw, const float* skip, f32x2* XSall, bf16* MIXT,
                                                 LAS unsigned char* lds, int blk, int nblk, int tid_in, int lane, int wave, int pmode = 0) {
    LAS f32x2* L = (LAS f32x2*)lds; LAS bf16* S = (LAS bf16*)lds; LAS float* red = (LAS float*)(lds + LDS_MISC);
    f32x2* XS = XSall + (size_t)blk * 16384;
    f32x2* ZS = XS + 16384 * 256;
    constexpr int N = 16384;
#pragma unroll 1
    for (int c = blk; c < D_MAIN; c += nblk) {
        const bf16* hf0 = TAPS + (size_t)c * SEQ; const bf16* hb0 = TAPS + (size_t)(D_MAIN + c) * SEQ;
        const bf16* hf1 = TAPS + (size_t)(2 * D_MAIN + c) * SEQ; const bf16* hb1 = TAPS + (size_t)(3 * D_MAIN + c) * SEQ;
        const bf16* px1 = PT + (size_t)c * M_TOK; const bf16* px2 = PT + (size_t)(D_MAIN + c) * M_TOK; const bf16* pv = PT + (size_t)(2 * D_MAIN + c) * M_TOK;
        const float wx1[3] = {shortw[c], shortw[2304 + c], shortw[4608 + c]};
        const float wx2[3] = {shortw[D_MAIN + c], shortw[2304 + D_MAIN + c], shortw[4608 + D_MAIN + c]};
        const float wv[3] = {shortw[2 * D_MAIN + c], shortw[2304 + 2 * D_MAIN + c], shortw[4608 + 2 * D_MAIN + c]};
        const float sk0 = skip[c], sk1 = skip[D_MAIN + c];
        float re[32], im[32];
#pragma unroll 1
        for (int pass = 0; pass < 5; ++pass) {
            int tid = tid_in; asm volatile("" : "+v"(tid));
            if (pass == 0) {
#pragma unroll
                for (int r = 0; r < 16; ++r) { const int n = r * 512 + tid; re[r] = bf2f(hf0[n]); im[r] = bf2f(hf1[n]); }
#pragma unroll
                for (int r = 16; r < 32; ++r) { const int idx = (32 - r) * 512 - tid; const bool z = (idx == SEQ); const int ii = z ? 0 : idx; re[r] = z ? 0.f : bf2f(hb0[ii]); im[r] = z ? 0.f : bf2f(hb1[ii]); }
                float e0 = 0.f, e1 = 0.f;
                if (tid == 0) { e0 = bf2f(hb0[0]); e1 = bf2f(hb1[0]); }
                float s0 = fabsf(e0), s1 = fabsf(e1);
#pragma unroll
                for (int r = 0; r < 32; ++r) { s0 += fabsf(re[r]); s1 += fabsf(im[r]); }
                s0 = wave_sum(s0); s1 = wave_sum(s1);
                __syncthreads();
                if (lane == 0) { red[wave] = s0; red[8 + wave] = s1; }
                __syncthreads();
                float t0 = 0.f, t1 = 0.f;
#pragma unroll
                for (int w = 0; w < NWAVES; ++w) { t0 += red[w]; t1 += red[8 + w]; }
                const float sc0 = 1.0f / (t0 + 1e-6f), sc1 = 1.0f / (t1 + 1e-6f);
                re[0] += e0; im[0] += e1;
#pragma unroll
                for (int r = 0; r < 32; ++r) { re[r] *= sc0; im[r] *= sc1; }
            } else if (pass == 1) {
                __syncthreads();
                hy_stage(S, 0, pv, tid); hy_stage(S, 1, pv + SEQ, tid);
                __syncthreads();
#pragma unroll
                for (int r = 0; r < 16; ++r) { const int t = r * 512 + tid; re[r] = hy_sc(S, 0, t, wv[0], wv[1], wv[2]); im[r] = hy_sc(S, 1, t, wv[0], wv[1], wv[2]); }
#pragma unroll
                for (int r = 16; r < 32; ++r) { re[r] = 0.f; im[r] = 0.f; }
            }
            __syncthreads();
            fft16k(re, im, L, tid);
            if (pass == 0) {
#pragma unroll
                for (int r = 0; r < 32; ++r) XS[r * 512 + tid] = (f32x2){re[r], im[r]};
                __syncthreads();
            } else if (pass == 1 || pass == 3) {
#pragma unroll
                for (int r = 0; r < 32; ++r) {
                    const int f = r * 512 + tid; const f32x2 xa = XS[f], xb = XS[(N - f) & (N - 1)];
                    float kr, ki;
                    if (pass == 1) { kr = xa.x + xb.x; ki = xa.y - xb.y; } else { kr = xa.y + xb.y; ki = xb.x - xa.x; }
                    kr *= (0.5f / (float)N); ki *= (0.5f / (float)N);
                    const float zr_ = re[r], zi_ = im[r];
                    re[r] = zr_ * kr - zi_ * ki; im[r] = -(zr_ * ki + zi_ * kr);
                }
            } else if (pass == 2) {
                __syncthreads();
                hy_stage(S, 0, pv, tid); hy_stage(S, 1, pv + SEQ, tid); hy_stage(S, 2, px1, tid); hy_stage(S, 3, px1 + SEQ, tid);
                __syncthreads();
#pragma unroll
                for (int r = 0; r < 16; ++r) { const int t = r * 512 + tid;
                    const float v0 = hy_sc(S, 0, t, wv[0], wv[1], wv[2]), v1 = hy_sc(S, 1, t, wv[0], wv[1], wv[2]);
                    const float g0 = hy_sc(S, 2, t, wx1[0], wx1[1], wx1[2]), g1 = hy_sc(S, 3, t, wx1[0], wx1[1], wx1[2]);
                    re[r] = g0 * (re[r] + sk0 * v0); im[r] = g1 * (-im[r] + sk0 * v1); ZS[t] = (f32x2){re[r], im[r]}; }
#pragma unroll
                for (int r = 16; r < 32; ++r) { re[r] = 0.f; im[r] = 0.f; }
            } else {
                __syncthreads();
                hy_stage(S, 0, px2, tid); hy_stage(S, 1, px2 + SEQ, tid);
                __syncthreads();
#pragma unroll
                for (int r = 0; r < 16; ++r) { const int t = r * 512 + tid;
                    const float g0 = hy_sc(S, 0, t, wx2[0], wx2[1], wx2[2]), g1 = hy_sc(S, 1, t, wx2[0], wx2[1], wx2[2]);
                    const f32x2 z = ZS[t];
                    const float o0 = g0 * (re[r] + sk1 * z.x), o1 = g1 * (-im[r] + sk1 * z.y);
                    MIXT[(size_t)c * M_TOK + t] = (bf16)f2bf(o0); MIXT[(size_t)c * M_TOK + SEQ + t] = (bf16)f2bf(o1); }
            }
        }
        __syncthreads();
    }
}
#ifndef MK_PER_PHASE
#define MK_PER_PHASE 0
#endif
#ifndef CONV_PMODE
#define CONV_PMODE 0
#endif
#ifndef REPMASK
#define REPMASK 0u
#endif
#define REP(kind) _Pragma("unroll 1") for (int r_ = 0; r_ < 1 + (int)((REPMASK >> (kind)) & 1u); ++r_)
struct Args {
    const float* in[24]; float* out; unsigned char* ws; int ph_lo, ph_hi;
};
constexpr int N_PHASES = 1 + (DEPTH - 1) + DEPTH * 8 - DEPTH / 2 + 1;

template <int QP, int KP>
__device__ __forceinline__ void run_attn(const bf16* Q, const bf16* K, const bf16* V, bf16* O, int NT, char* shm) {
    attn_body::attn_unit<8, QP, KP, DM>((const attn_body::bf16*)Q, (const attn_body::bf16*)K, (const attn_body::bf16*)V, (attn_body::bf16*)O, NT, shm);
}

__global__ void __launch_bounds__(NTHREADS, 2) hybrid_fwd(Args args) {
    extern __shared__ __attribute__((aligned(16))) unsigned char lds_raw[];
    LAS unsigned char* lds = (LAS unsigned char*)lds_raw;
    const int G = gridDim.x, bx = blockIdx.x;
    const int vcu = (G % 8 == 0) ? (bx % 8) * (G / 8) + bx / 8 : bx;
    const int NGW = G * NWAVES;
    unsigned char* ws = args.ws;
    const float* x = args.in[0]; const float* mem = args.in[1]; const float* mix_g = args.in[2]; const float* ffn_g = args.in[3]; const float* mem_g = args.in[4]; const float* fin_g = args.in[5];
    const float* hy_short = args.in[9]; const float* f_w1 = args.in[10]; const float* f_b1 = args.in[11]; const float* f_w2 = args.in[12]; const float* f_b2 = args.in[13];
    const float* f_w3 = args.in[14]; const float* f_freq = args.in[15]; const float* hy_skip = args.in[16]; const float* qg = args.in[18]; const float* kg = args.in[19]; const float* router = args.in[20];
    float* H = args.out;
    bf16* U = (bf16*)(ws + WS_U); bf16* PROJ = (bf16*)(ws + WS_PROJ); bf16* CQ = (bf16*)(ws + WS_CQ); bf16* MIX = (bf16*)(ws + WS_MIX); bf16* MIXT = (bf16*)(ws + WS_MIXT);
    float* AFF = (float*)(ws + WS_AFF); int* IDX = (int*)(ws + WS_IDX); float* GATE = (float*)(ws + WS_GATE); int* POS = (int*)(ws + WS_POS);
    bf16* XG = (bf16*)(ws + WS_XG); bf16* HID = (bf16*)(ws + WS_HID); bf16* Y = (bf16*)(ws + WS_Y); bf16* TAPS = (bf16*)(ws + WS_TAPS);
    const bf16* MKV = (const bf16*)(ws + WS_MKV);
    cg::grid_group grid = cg::this_grid();
    volatile LAS unsigned* bst = (volatile LAS unsigned*)(lds + LDS_MISC + 4096);
    if (threadIdx.x < 2) bst[threadIdx.x] = 0u;
    __syncthreads();
    XcdBarrier xbar = xcd_barrier_post((unsigned*)(ws + WS_CTL) + 1024, bst);
    const int lo = args.ph_lo, hi = args.ph_hi;
    const XwIn XW{args.in[21], args.in[22], args.in[23], ws}; const bool xw_sched = (G == 256);
    int ph = 0;
#define PHASE_BEGIN if (lo <= ph && ph < hi) { const int tid = opaque_tid(), lane = tid & 63, wave = __builtin_amdgcn_readfirstlane(tid >> 6), gw = vcu * NWAVES + wave; (void)lane; (void)gw;
#ifdef EXTRA_XBAR
#define PHASE_END   if (ph + 1 < hi) { if (ph == lo) grid.sync(); else { xcd_barrier(xbar); if (ph < EXTRA_XBAR) xcd_barrier(xbar); } } } ++ph;
#else
#define PHASE_END   if (ph + 1 < hi) { if (ph == lo) grid.sync(); else xcd_barrier(xbar); } } ++ph;
#endif

    PHASE_BEGIN
        ProIn P{args.in[8], args.in[17], args.in[7], args.in[6]};
        REP(0) { phase_weights(P, ws, lds, gw, NGW, wave, lane); phase_xw_p0(XW, xw_sched, (LAS float*)(lds + wave * 16384), gw, NGW, lane); }
        REP(1) phase_mem_h2(mem, mem_g, f_w1, f_b1, f_w2, f_b2, f_freq, ws, gw, NGW, lane);
        REP(3) phase_norm<false, false>(x, nullptr, mix_g, U, nullptr, nullptr, nullptr, gw, NGW, lane);
    PHASE_END

#pragma unroll 1
    for (int i = 0; i < DEPTH; ++i) {
        const bool hy = (i & 1) == 0; const int j = i >> 1;
        if (i > 0) {
        PHASE_BEGIN
            phase_norm<true, false>(H, H, mix_g + i * DM, U, nullptr, POS, Y, gw, NGW, lane);
        PHASE_END
        }
        PHASE_BEGIN
            if (i == 0) {
                pg8::Gemm g{(const bf16*)(ws + WS_MEMN), (const bf16*)(ws + WS_WMKV), BATCH * MEM_LEN, 2048, DM, 1 << 30, 1, 0};
                pg8::StaticOrder S; S.init(BATCH * MEM_LEN, 2048, G, bx);
                pg8::EpiRowBf16 E{(bf16*)(ws + WS_MKV), 2048, -1, 1.f};
                pg8::gemm_phase<pg8::EpiRowBf16, pg8::StaticOrder, true, true>(lds, g, S, E);
            }
            if (hy) {
                REP(4) phase_taps((const float*)(ws + WS_H2) + (size_t)j * SEQ * HY_FILT, f_w3 + (size_t)j * HY_FILT * FCOLS, TAPS, gw, NGW, lane);
                pg8::Gemm g{U, (const bf16*)(ws + WS_WHY) + (size_t)j * D_IN_HY * DM, M_TOK, D_IN_HY, DM, 1 << 30, 1, 0};
                pg8::StaticOrder S; S.init(M_TOK, D_IN_HY, G, bx);
                pg8::EpiHyIn E{PROJ, M_TOK, 9, CQ, ATT_C2};
                REP(5) pg8::gemm_phase<pg8::EpiHyIn, pg8::StaticOrder, true, true>(lds, g, S, E);
            } else {
                pg8::Gemm g{U, (const bf16*)(ws + WS_WAT) + (size_t)j * D_IN_AT * DM, M_TOK, D_IN_AT, DM, 1 << 30, 1, 0};
                pg8::StaticOrder S; S.init(M_TOK, D_IN_AT, G, bx);
                pg8::EpiAtIn E{PROJ, D_IN_AT, qg + j * HD, kg + j * HD, ATT_C2, NORM_EPS, SEQ - 1};
                REP(6) pg8::gemm_phase<pg8::EpiAtIn, pg8::StaticOrder, true, true>(lds, g, S, E);
            }
            if (xw_sched && bx >= 128) xw_slice_a(XW, i, (LAS float*)(lds + wave * 16384), bx, wave, lane);
        PHASE_END
        PHASE_BEGIN
            if (hy) {
                REP(8) phase_hyena_conv(PROJ, TAPS, hy_short + (size_t)j * 3 * 2304, hy_skip + (size_t)j * 2 * D_MAIN, (f32x2*)(ws + WS_FFTX), MIXT, lds, bx, G, tid, lane, wave);
                REP(9) for (int u = vcu; u < 256; u += G) { const int b = u >> 7, h4 = (u >> 5) & 3, qb = u & 31; const size_t row = (size_t)b * SEQ + qb * 256;
                    run_attn<256, 2048>(CQ + row * 256 + h4 * HD, MKV + (size_t)b * MEM_LEN * 2048 + i * 512 + h4 * HD, MKV + (size_t)b * MEM_LEN * 2048 + i * 512 + 256 + h4 * HD,
                                        MIX + row * DM + D_MAIN + h4 * HD, MEM_LEN / 64, (char*)lds_raw); }
            } else {
                REP(10) for (int u = vcu; u < 768; u += G) { const int bk = (u & 255) >> 5, qb = u & 31, hs = u >> 8, b = bk >> 2, kvh = bk & 3, h = kvh * 3 + hs; const size_t row = (size_t)b * SEQ + qb * 256;
                    run_attn<D_IN_AT, D_IN_AT>(PROJ + row * D_IN_AT + h * HD, PROJ + (size_t)b * SEQ * D_IN_AT + D_MAIN + kvh * HD, PROJ + (size_t)b * SEQ * D_IN_AT + D_MAIN + 256 + kvh * HD,
                                               MIX + row * DM + h * HD, SEQ / 64, (char*)lds_raw); }
                REP(9) for (int u = vcu; u < 256; u += G) { const int b = u >> 7, h4 = (u >> 5) & 3, qb = u & 31; const size_t row = (size_t)b * SEQ + qb * 256;
                    run_attn<D_IN_AT, 2048>(PROJ + row * D_IN_AT + 1280 + h4 * HD, MKV + (size_t)b * MEM_LEN * 2048 + i * 512 + h4 * HD, MKV + (size_t)b * MEM_LEN * 2048 + i * 512 + 256 + h4 * HD,
                                            MIX + row * DM + D_MAIN + h4 * HD, MEM_LEN / 64, (char*)lds_raw); }
            }
        PHASE_END
        if (hy) {
            PHASE_BEGIN
                REP(11) phase_transpose_mix(MIXT, MIX, bx, G, tid);
            PHASE_END
        }
        PHASE_BEGIN
            pg8::Gemm g{MIX, (const bf16*)(ws + WS_WOUT) + (size_t)i * DM * DM, M_TOK, DM, DM, 1 << 30, 1, 0};
            pg8::StaticOrder S; S.init(M_TOK, DM, G, bx);
            pg8::EpiResF32 E{i == 0 ? x : (const float*)H, H, DM};
            if (i == 0) { REP(12) pg8::gemm_phase<pg8::EpiResF32, pg8::StaticOrder, true, true>(lds, g, S, E); } else pg8::gemm_phase<pg8::EpiResF32, pg8::StaticOrder, true, true>(lds, g, S, E);
        PHASE_END
        PHASE_BEGIN
            REP(13) phase_ffn_norm_router(H, ffn_g + i * DM, router + (size_t)i * DM * NEXP, (unsigned char*)U, AFF, lds, gw, NGW, lane, tid);
        PHASE_END
        PHASE_BEGIN
            REP(14) phase_topk(AFF, IDX, GATE, POS, lds + LDS_MISC, bx, G, tid, lane, wave);
            if (xw_sched && bx >= 32) xw_slice_b(XW, i, (LAS float*)(lds + wave * 16384), bx, wave, lane);
        PHASE_END
        PHASE_BEGIN
            pg8::Gemm g{U, (const bf16*)(ws + WS_W1 + (size_t)i * NEXP * 1536 * DM), XROWS, 1536, DM / 2, 4, NEXP, (size_t)1536 * DM};
            pg8::StaticOrder S; S.init(XROWS, 1536, G, bx);
            pg8::EpiSwiGLU8 E{(unsigned char*)HID, EFF, 1.0f / W8_SCALE};
            REP(16) pg8::gemm_phase<pg8::EpiSwiGLU8, pg8::StaticOrder, true, true, true, true>(lds, g, S, E, IDX);
        PHASE_END
        PHASE_BEGIN
            pg8::Gemm g{HID, (const bf16*)(ws + WS_W2 + (size_t)i * NEXP * DM * EFF), XROWS, DM, EFF / 2, 4, NEXP, (size_t)DM * EFF};
            pg8::StaticOrder S; S.init(XROWS, DM, G, bx);
            pg8::EpiDown E{Y, DM, GATE, 1.0f / W8_SCALE};
            REP(17) pg8::gemm_phase<pg8::EpiDown, pg8::StaticOrder, true, true, false, true>(lds, g, S, E);
        PHASE_END
    }
    PHASE_BEGIN
        phase_norm<true, true>(H, nullptr, fin_g, nullptr, args.out, POS, Y, gw, NGW, lane);
    PHASE_END
#undef PHASE_BEGIN
#undef PHASE_END
}

extern "C" void kernel_launch(void* const* d_in, const int* in_sizes, int n_in, void* d_out, int out_size, void* d_ws, size_t ws_size, hipStream_t stream) {
    static int grid = 0;
    if (grid == 0) {
        if (n_in != 24 || out_size != M_TOK * DM || ws_size < WS_END) { fprintf(stderr, "kernel_launch: unexpected shapes (n_in %d out %d ws %zu need %zu)\n", n_in, out_size, ws_size, (size_t)WS_END); grid = -1; return; }
        int dev = 0, cus = 0, per_cu = 0;
        if (hipGetDevice(&dev) != hipSuccess || hipDeviceGetAttribute(&cus, hipDeviceAttributeMultiprocessorCount, dev) != hipSuccess) { grid = -1; return; }
        if (hipFuncSetAttribute((const void*)hybrid_fwd, hipFuncAttributeMaxDynamicSharedMemorySize, LDS_BYTES) != hipSuccess) { fprintf(stderr, "kernel_launch: hipFuncSetAttribute failed\n"); grid = -1; return; }
        if (hipOccupancyMaxActiveBlocksPerMultiprocessor(&per_cu, (const void*)hybrid_fwd, NTHREADS, LDS_BYTES) != hipSuccess || per_cu < 1) { fprintf(stderr, "kernel_launch: occupancy query says %d blocks/CU\n", per_cu); per_cu = 1; }
        (void)hipGetLastError();
        grid = cus;
    }
    if (grid < 0) return;
    if (hipMemsetAsync((char*)d_ws + WS_CTL, 0, 64 * 1024, stream) != hipSuccess) { fprintf(stderr, "kernel_launch: memset failed\n"); return; }
    Args a{};
    for (int i = 0; i < 24; ++i) a.in[i] = (const float*)d_in[i];
    a.out = (float*)d_out; a.ws = (unsigned char*)d_ws;
#if MK_PER_PHASE
    for (int li = 0; li < N_PHASES; ++li) {
        a.ph_lo = li; a.ph_hi = li + 1;
        void* kargs[] = {&a};
        hipError_t e = hipLaunchCooperativeKernel((const void*)hybrid_fwd, dim3(grid), dim3(NTHREADS), kargs, LDS_BYTES, stream);
        if (e != hipSuccess) { fprintf(stderr, "kernel_launch: launch %d failed: %s\n", li, hipGetErrorString(e)); break; }
    }
#else
    a.ph_lo = 0; a.ph_hi = N_PHASES;
    void* kargs[] = {&a};
    hipError_t e = hipLaunchCooperativeKernel((const void*)hybrid_fwd, dim3(grid), dim3(NTHREADS), kargs, LDS_BYTES, stream);
    if (e != hipSuccess) fprintf(stderr, "kernel_launch: cooperative launch failed: %s (grid %d)\n", hipGetErrorString(e), grid);
#endif
}
```

```cpp
#include <hip/hip_runtime.h>
#include <hip/hip_cooperative_groups.h>
#include <hip/hip_bf16.h>
#include <cmath>
#include <cstdio>
#include <cstdint>
namespace cg = cooperative_groups;

constexpr int BATCH = 2, SEQ = 8192, DM = 1024, DEPTH = 4, M_TOK = BATCH * SEQ;
constexpr int HD = 64, MEM_LEN = 256, D_MEM = 256, D_MAIN = 768, NQH = 12, NKVH = 4;
constexpr int D_IN_HY = 2560, D_IN_AT = 1536;
constexpr int NEXP = 16, CAP = 1024, EFF = 768, NGRP = BATCH * NEXP, XROWS = NGRP * CAP;
constexpr int HY_EMB = 33, HY_FILT = 64, FCOLS = 4 * D_MAIN;
constexpr float NORM_EPS = 1e-6f;
constexpr float W8_SCALE = 32.0f;
constexpr float ATT_C2 = 0.125f * 1.4426950408889634f;

constexpr size_t MiB = 1u << 20;
constexpr size_t WS_CTL = 0;
constexpr size_t WS_WHY = 2 * MiB;
constexpr size_t WS_WAT = 12 * MiB;
constexpr size_t WS_WOUT = 18 * MiB;
constexpr size_t WS_WMKV = 26 * MiB;
constexpr size_t WS_W1 = 32 * MiB;
constexpr size_t WS_W2 = 224 * MiB;
constexpr size_t WS_U = 320 * MiB;
constexpr size_t WS_PROJ = 352 * MiB;
constexpr size_t WS_CQ = WS_PROJ + 72 * MiB;
constexpr size_t WS_MIX = 432 * MiB;
constexpr size_t WS_MIXT = 464 * MiB;
constexpr size_t WS_AFF = 488 * MiB;
constexpr size_t WS_IDX = 489 * MiB;
constexpr size_t WS_GATE = WS_IDX + 128 * 1024;
constexpr size_t WS_POS = 490 * MiB;
constexpr size_t WS_XG = 492 * MiB;
constexpr size_t WS_HID = 556 * MiB;
constexpr size_t WS_TAPS = WS_XG;
constexpr size_t WS_Y = 604 * MiB;
constexpr size_t WS_FFTX = WS_Y;
constexpr size_t WS_H2 = 668 * MiB;
constexpr size_t WS_MEMN = 672 * MiB;
constexpr size_t WS_MKV = 673 * MiB;
constexpr size_t WS_PART = 676 * MiB;
constexpr size_t WS_PSS = 692 * MiB;
constexpr size_t WS_RSTD = 697 * MiB;
constexpr size_t WS_RS = WS_RSTD + 128 * 1024;
constexpr size_t WS_WRG = 698 * MiB;
constexpr size_t WS_END = 699 * MiB;

constexpr int LDS_RING = 0;
constexpr int LDS_MISC = 132 * 1024;
constexpr int LDS_BYTES = 140 * 1024;
constexpr int NTHREADS = 512, NWAVES = 8;

#define GAS __attribute__((address_space(1)))
#define LAS __attribute__((address_space(3)))
typedef unsigned short bf16;
typedef unsigned v4u __attribute__((ext_vector_type(4)));
typedef unsigned v2u __attribute__((ext_vector_type(2)));
typedef float f32x4 __attribute__((ext_vector_type(4)));
typedef float f32x2 __attribute__((ext_vector_type(2)));
__device__ __forceinline__ unsigned f2bf(float f) { unsigned u = __builtin_bit_cast(unsigned, f); return (u + 0x7fffu + ((u >> 16) & 1u)) >> 16; }
__device__ __forceinline__ unsigned pk2(float lo, float hi) { return f2bf(lo) | (f2bf(hi) << 16); }
__device__ __forceinline__ float bf2f(unsigned short h) { return __builtin_bit_cast(float, (unsigned)h << 16); }
__device__ __forceinline__ float bflo(unsigned w) { return __builtin_bit_cast(float, w << 16); }
__device__ __forceinline__ float bfhi(unsigned w) { return __builtin_bit_cast(float, w & 0xffff0000u); }
__device__ __forceinline__ float wave_sum(float v) {
#pragma unroll
    for (int o = 1; o < 64; o <<= 1) v += __shfl_xor(v, o);
    return v;
}
__device__ __forceinline__ int opaque_tid() { int t = threadIdx.x; asm volatile("" : "+v"(t)); return t; }
#define MK_PER_PHASE 0

#define XB_TMO      128
#define XB_XCNT(j)  (256  + 64 * (j))
#define XB_XSUB(j)  (1280 + 64 * (j))
#define XB_XGEN(j)  (2304 + 64 * (j))
#define XB_TOP      3328
#define XB_TOPGEN   3392
#define XCD_BAR_WORDS 3456
#define XB_SPIN_CAP (1u << 18)

__device__ __forceinline__ unsigned xb_ld(unsigned* p)              { return __hip_atomic_load(p, __ATOMIC_RELAXED, __HIP_MEMORY_SCOPE_AGENT); }
__device__ __forceinline__ unsigned xb_add(unsigned* p, unsigned v) { return __hip_atomic_fetch_add(p, v, __ATOMIC_RELAXED, __HIP_MEMORY_SCOPE_AGENT); }
__device__ __forceinline__ unsigned xb_xcc_id() { return (unsigned)__builtin_amdgcn_s_getreg((3 << 11) | 20) & 0xFu; }
#define XB_SPIN(cond, bar) do { unsigned _sp = 0; while (cond) { __builtin_amdgcn_s_sleep(1); \
    if ((++_sp & 255u) == 0u) { if (xb_ld(&(bar)[XB_TMO])) break; if (_sp > XB_SPIN_CAP) { atomicAdd(&(bar)[XB_TMO], 1u); break; } } } } while (0)

struct XcdBarrier {
    unsigned* bar; unsigned x;
    volatile LAS unsigned* st;
};

__device__ __forceinline__ XcdBarrier xcd_barrier_post(unsigned* bar, volatile LAS unsigned* st) {
    XcdBarrier b; b.bar = bar; b.x = xb_xcc_id(); b.st = st;
    if (threadIdx.x == 0) (void)xb_add(&bar[XB_XCNT(b.x)], 1u);
    return b;
}
__device__ __forceinline__ void xcd_barrier_complete(unsigned* bar, unsigned x, unsigned& nloc, unsigned& nx) {
    const unsigned G = gridDim.x * gridDim.y * gridDim.z;
    unsigned sum, cnt, mine, sp = 0u;
    for (;;) {
        sum = 0u; cnt = 0u; mine = 0u;
#pragma unroll
        for (unsigned j = 0; j < 16; ++j) { const unsigned c = xb_ld(&bar[XB_XCNT(j)]); sum += c; cnt += (c > 0u) ? 1u : 0u; mine = (j == x) ? c : mine; }
        if (sum == G) break;
        __builtin_amdgcn_s_sleep(1);
        if ((++sp & 255u) == 0u) { if (xb_ld(&bar[XB_TMO])) break; if (sp > XB_SPIN_CAP) { atomicAdd(&bar[XB_TMO], 1u); break; } }
    }
    nloc = mine > 0u ? mine : 1u; nx = cnt > 0u ? cnt : 1u;
}

__device__ __forceinline__ void xcd_barrier(const XcdBarrier& b) {
    asm volatile("s_waitcnt vmcnt(0)" ::: "memory");
    __syncthreads();
    if (threadIdx.x == 0) {
        unsigned* bar = b.bar;
        __builtin_amdgcn_s_waitcnt(0);
        unsigned nloc = b.st[0], nx = b.st[1];
        if (nloc == 0u) { xcd_barrier_complete(bar, b.x, nloc, nx); b.st[0] = nloc; b.st[1] = nx; }
        const unsigned old = xb_add(&bar[XB_XSUB(b.x)], 1u);
        const unsigned gen = old / nloc;
        if (old + 1u == (gen + 1u) * nloc) {
            __builtin_amdgcn_fence(__ATOMIC_RELEASE, "agent");
            asm volatile("s_waitcnt vmcnt(0)" ::: "memory");
            const unsigned og = xb_add(&bar[XB_TOP], 1u);
            const unsigned tg = og / nx;
            if (og + 1u == (tg + 1u) * nx) xb_add(&bar[XB_TOPGEN], 1u);
            else XB_SPIN(xb_ld(&bar[XB_TOPGEN]) == tg, bar);
            __builtin_amdgcn_fence(__ATOMIC_ACQUIRE, "agent");
            xb_add(&bar[XB_XGEN(b.x)], 1u);
            asm volatile("s_waitcnt vmcnt(0)" ::: "memory");
        } else {
            XB_SPIN(xb_ld(&bar[XB_XGEN(b.x)]) == gen, bar);
            __builtin_amdgcn_fence(__ATOMIC_ACQUIRE, "agent");
            asm volatile("s_waitcnt vmcnt(0)" ::: "memory");
        }
    }
    __syncthreads();
}
namespace pg8 {
#define PG8_LAS __attribute__((address_space(3)))
typedef unsigned short bf16_t;
typedef short bf16x8 __attribute__((ext_vector_type(8)));
typedef float f32x4 __attribute__((ext_vector_type(4)));
typedef unsigned u32x4 __attribute__((ext_vector_type(4)));
constexpr int BM = 256, BK = 64, HALF = 128, HTB = HALF * BK * 2  , STAGE_BYTES = 8 * HTB, NXCD = 8, WGM = 8;

__host__ __device__ __forceinline__ int lds_byte(int r, int c) { const int st = (r >> 4) * 2 + (c >> 5), rr = r & 15, cc = c & 31, ob = rr * 64 + cc * 2; return st * 1024 + (ob ^ (((ob >> 9) & 1) << 5)); }
__host__ __device__ __forceinline__ void stage_rc(int b, int& R, int& C) { const int st = b / 1024, sb = b % 1024, swz = sb ^ (((sb >> 9) & 1) << 5); R = (st >> 1) * 16 + swz / 64; C = (st & 1) * 32 + (swz % 64) / 2; }
__host__ __device__ __forceinline__ int perm32(int rho) { const int n = rho >> 4, i = rho & 15; return 8 * (i >> 2) + 4 * n + (i & 3); }

struct Unit { int pm, pn; };
struct Gemm { const bf16_t* A; const bf16_t* Bt; int M, N, K; int gdiv, gmod; size_t gstride; };

struct StaticOrder {
    int nM, nN, nwg, G, c;
    __host__ __device__ void init(int M, int N, int G_, int c_) { nM = M / BM; nN = N / BM; nwg = nM * nN; G = G_; c = c_; }
    __host__ __device__ bool next(int i, Unit& u) const {
        const long L = (long)i * G + c; if (L >= nwg) return false;
        int wgid = (int)L; { const int q = nwg / NXCD, r = nwg % NXCD, xcd = wgid % NXCD, off = wgid / NXCD; wgid = (xcd < r ? xcd * (q + 1) : r * (q + 1) + (xcd - r) * q) + off; }
        const int nig = WGM * nN, gid = wgid / nig, fm = gid * WGM, gsz = (nM - fm) < WGM ? (nM - fm) : WGM;
        u.pm = fm + ((wgid % nig) % gsz); u.pn = (wgid % nig) / gsz; return true;
    }
    __device__ __forceinline__ void a_ready(const Unit&) const {}
    __device__ __forceinline__ void done(const Unit&) const {}
};


__device__ __forceinline__ unsigned cvt_pk_bf16(float lo, float hi) { unsigned r; asm volatile("v_cvt_pk_bf16_f32 %0, %1, %2" : "=v"(r) : "v"(lo), "v"(hi)); return r; }
typedef unsigned u32x2 __attribute__((ext_vector_type(2)));
struct EpiRowBf16 {
    static constexpr bool PERM = false, AFTER_DRAIN = false;
    bf16_t* O; int ldc; int sc_pn; float sc;
    __device__ __forceinline__ void operator()(const f32x4 (&acc)[2][2][4][2], const Unit& u, int wr, int wc, int fr, int fq) const {
        const float s = (u.pn == sc_pn) ? sc : 1.f;
        const int row0 = u.pm * BM + wr * 64 + fr, col0 = u.pn * BM + wc * 32 + 4 * fq;
#pragma unroll
        for (int ai = 0; ai < 2; ++ai)
#pragma unroll
            for (int m = 0; m < 4; ++m) { bf16_t* rowp = O + (size_t)(row0 + ai * HALF + m * 16) * ldc + col0;
#pragma unroll
                for (int bj = 0; bj < 2; ++bj)
#pragma unroll
                    for (int n = 0; n < 2; ++n) { const f32x4 v = acc[ai][bj][m][n] * s; u32x2 w; w.x = cvt_pk_bf16(v[0], v[1]); w.y = cvt_pk_bf16(v[2], v[3]);
                        *(u32x2*)(rowp + bj * HALF + n * 16) = w; } }
    }
};
struct EpiHyIn {
    static constexpr bool PERM = false, AFTER_DRAIN = false;
    bf16_t* OT; int ldt; int tp_tiles; bf16_t* CQ; float sc;
    __device__ __forceinline__ void operator()(const f32x4 (&acc)[2][2][4][2], const Unit& u, int wr, int wc, int fr, int fq) const {
        const int row0 = u.pm * BM + wr * 64 + fr;
        if (u.pn < tp_tiles) {
            const int col0 = u.pn * BM + wc * 32 + 4 * fq;
#pragma unroll
            for (int ai = 0; ai < 2; ++ai)
#pragma unroll
                for (int m = 0; m < 4; ++m) { const int row = row0 + ai * HALF + m * 16;
#pragma unroll
                    for (int bj = 0; bj < 2; ++bj)
#pragma unroll
                        for (int n = 0; n < 2; ++n) { const f32x4 v = acc[ai][bj][m][n]; const unsigned w0 = cvt_pk_bf16(v[0], v[1]), w1 = cvt_pk_bf16(v[2], v[3]);
                            bf16_t* p = OT + (size_t)(col0 + bj * HALF + n * 16) * ldt + row;
                            p[0] = (bf16_t)(w0 & 0xffffu); p[(size_t)ldt] = (bf16_t)(w0 >> 16); p[(size_t)2 * ldt] = (bf16_t)(w1 & 0xffffu); p[(size_t)3 * ldt] = (bf16_t)(w1 >> 16); } }
        } else {
            const int col0 = wc * 32 + 4 * fq;
#pragma unroll
            for (int ai = 0; ai < 2; ++ai)
#pragma unroll
                for (int m = 0; m < 4; ++m) { bf16_t* rowp = CQ + (size_t)(row0 + ai * HALF + m * 16) * 256 + col0;
#pragma unroll
                    for (int bj = 0; bj < 2; ++bj)
#pragma unroll
                        for (int n = 0; n < 2; ++n) { const f32x4 v = acc[ai][bj][m][n] * sc; u32x2 w; w.x = cvt_pk_bf16(v[0], v[1]); w.y = cvt_pk_bf16(v[2], v[3]);
                            *(u32x2*)(rowp + bj * HALF + n * 16) = w; } }
        }
    }
};
struct EpiAtIn {
    static constexpr bool PERM = false, AFTER_DRAIN = false;
    bf16_t* O; int ldc; const float* gq; const float* gk; float csc; float eps; int seq_mask;
    __device__ __forceinline__ void operator()(const f32x4 (&acc)[2][2][4][2], const Unit& u, int wr, int wc, int fr, int fq) const {
        const int row0 = u.pm * BM + wr * 64 + fr, colb = u.pn * BM + wc * 64 + 4 * fq;
        if (u.pn <= 3) {
            const float* gp = (u.pn == 3 ? gk : gq) + 4 * fq; const float osc = (u.pn == 3) ? 1.f : csc;
            float invr[4];
#pragma unroll
            for (int q = 0; q < 4; ++q) invr[q] = exp2f(-(float)(4 * fq + q) * (13.287712379549449f / 16.0f)) * 0.15915494309189535f;
#pragma unroll
            for (int ai = 0; ai < 2; ++ai)
#pragma unroll
                for (int m = 0; m < 4; ++m) {
                    const int row = row0 + ai * HALF + m * 16; int t = row & seq_mask; asm volatile("" : "+v"(t));
                    float ss = 0.f;
#pragma unroll
                    for (int bj = 0; bj < 2; ++bj)
#pragma unroll
                        for (int n = 0; n < 2; ++n) { const f32x4 x = acc[ai][bj][m][n]; ss += (x[0] * x[0] + x[1] * x[1]) + (x[2] * x[2] + x[3] * x[3]); }
                    ss += __shfl_xor(ss, 16); ss += __shfl_xor(ss, 32);
                    const float rs = osc * __builtin_amdgcn_rsqf(ss * (1.0f / 64.0f) + eps);
                    bf16_t* rowp = O + (size_t)row * ldc + colb;
#pragma unroll
                    for (int bj = 0; bj < 2; ++bj) {
                        const float pos = (float)(bj == 0 ? (t >> 6) : (t & 63));
                        const f32x4 xa = acc[ai][bj][m][0] * rs * *(const f32x4*)(gp + 32 * bj), xb = acc[ai][bj][m][1] * rs * *(const f32x4*)(gp + 32 * bj + 16);
                        f32x4 oa, ob;
#pragma unroll
                        for (int q = 0; q < 4; ++q) { const float rev = pos * invr[q]; const float c = __builtin_amdgcn_cosf(rev), s = __builtin_amdgcn_sinf(rev);
                            oa[q] = xa[q] * c - xb[q] * s; ob[q] = xa[q] * s + xb[q] * c; }
                        u32x2 w; w.x = cvt_pk_bf16(oa[0], oa[1]); w.y = cvt_pk_bf16(oa[2], oa[3]); *(u32x2*)(rowp + 32 * bj) = w;
                        w.x = cvt_pk_bf16(ob[0], ob[1]); w.y = cvt_pk_bf16(ob[2], ob[3]); *(u32x2*)(rowp + 32 * bj + 16) = w;
                    }
                    asm volatile("" ::: "memory");
                }
        } else {
            const float s = (u.pn == 5) ? csc : 1.f;
#pragma unroll
            for (int ai = 0; ai < 2; ++ai)
#pragma unroll
                for (int m = 0; m < 4; ++m) { bf16_t* rowp = O + (size_t)(row0 + ai * HALF + m * 16) * ldc + colb;
#pragma unroll
                    for (int bj = 0; bj < 2; ++bj)
#pragma unroll
                        for (int n = 0; n < 2; ++n) { const f32x4 v = acc[ai][bj][m][n] * s; u32x2 w; w.x = cvt_pk_bf16(v[0], v[1]); w.y = cvt_pk_bf16(v[2], v[3]);
                            *(u32x2*)(rowp + 32 * bj + 16 * n) = w; } }
        }
    }
};
struct EpiResF32 {
    static constexpr bool PERM = false, AFTER_DRAIN = false;
    const float* res; float* out; int ldc;
    __device__ __forceinline__ void operator()(const f32x4 (&acc)[2][2][4][2], const Unit& u, int wr, int wc, int fr, int fq) const {
        const int row0 = u.pm * BM + wr * 64 + fr, col0 = u.pn * BM + wc * 32 + 4 * fq;
#pragma unroll
        for (int ai = 0; ai < 2; ++ai)
#pragma unroll
            for (int m = 0; m < 4; ++m) { const size_t off = (size_t)(row0 + ai * HALF + m * 16) * ldc + col0;
#pragma unroll
                for (int bj = 0; bj < 2; ++bj)
#pragma unroll
                    for (int n = 0; n < 2; ++n) { const f32x4 r = *(const f32x4*)(res + off + bj * HALF + n * 16); *(f32x4*)(out + off + bj * HALF + n * 16) = r + acc[ai][bj][m][n]; } }
    }
};
struct EpiOutX {
    static constexpr bool PERM = false, AFTER_DRAIN = false;
    const float* res; float* out; int ldc; const float* gain; const float* WrG; unsigned char* XN8; float* PLG; float* PSS; int M;
    static __device__ __forceinline__ void split8(const f32x4 a, const f32x4 b, bf16x8& hi, bf16x8& lo) {
        u32x4 h, l; float r[8] = {a[0], a[1], a[2], a[3], b[0], b[1], b[2], b[3]};
#pragma unroll
        for (int k = 0; k < 4; ++k) { const unsigned p = cvt_pk_bf16(r[2 * k], r[2 * k + 1]); h[k] = p;
            const float d0 = r[2 * k] - __builtin_bit_cast(float, p << 16), d1 = r[2 * k + 1] - __builtin_bit_cast(float, p & 0xffff0000u); l[k] = cvt_pk_bf16(d0, d1); }
        hi = __builtin_bit_cast(bf16x8, h); lo = __builtin_bit_cast(bf16x8, l);
    }
    __device__ __forceinline__ void operator()(f32x4 (&acc)[2][2][4][2], const Unit& u, int wr, int wc, int fr, int fq) const {
        const int row0 = u.pm * BM + wr * 64 + fr, col0 = u.pn * BM + wc * 32 + 4 * fq, slot = u.pn * 4 + wc;
        bf16x8 whi[2], wlo[2];
#pragma unroll
        for (int bj = 0; bj < 2; ++bj) { const float* wp = WrG + (size_t)fr * ldc + col0 + bj * HALF; split8(*(const f32x4*)wp, *(const f32x4*)(wp + 16), whi[bj], wlo[bj]); }
#pragma unroll
        for (int ai = 0; ai < 2; ++ai)
#pragma unroll
            for (int m = 0; m < 4; ++m) { const int row = row0 + ai * HALF + m * 16; const size_t off = (size_t)row * ldc + col0; float ss = 0.f; f32x4 lg = (f32x4){0.f, 0.f, 0.f, 0.f};
#pragma unroll
                for (int bj = 0; bj < 2; ++bj) {
#pragma unroll
                    for (int n = 0; n < 2; ++n) { const int co = bj * HALF + n * 16;
                        const f32x4 h = *(const f32x4*)(res + off + co) + acc[ai][bj][m][n]; acc[ai][bj][m][n] = h; *(f32x4*)(out + off + co) = h;
                        ss += (h[0] * h[0] + h[1] * h[1]) + (h[2] * h[2] + h[3] * h[3]);
                        const f32x4 x = h * *(const f32x4*)(gain + col0 + co);
                        unsigned w = 0; w = __builtin_amdgcn_cvt_pk_fp8_f32(x[0], x[1], w, false); w = __builtin_amdgcn_cvt_pk_fp8_f32(x[2], x[3], w, true); *(unsigned*)(XN8 + off + co) = w; }
                    bf16x8 hhi, hlo; split8(acc[ai][bj][m][0], acc[ai][bj][m][1], hhi, hlo);
                    lg = __builtin_amdgcn_mfma_f32_16x16x32_bf16(wlo[bj], hhi, lg, 0, 0, 0);
                    lg = __builtin_amdgcn_mfma_f32_16x16x32_bf16(whi[bj], hlo, lg, 0, 0, 0);
                    lg = __builtin_amdgcn_mfma_f32_16x16x32_bf16(whi[bj], hhi, lg, 0, 0, 0); }
                ss += __shfl_xor(ss, 16); ss += __shfl_xor(ss, 32);
                if (fq == 0) PSS[(size_t)slot * M + row] = ss;
                *(f32x4*)(PLG + ((size_t)slot * M + row) * 16 + 4 * fq) = lg;
                asm volatile("" ::: "memory"); }
    }
};
struct EpiSwiGLU {
    static constexpr bool PERM = false, AFTER_DRAIN = false;
    bf16_t* O; int ldc;
    __device__ __forceinline__ void operator()(const f32x4 (&acc)[2][2][4][2], const Unit& u, int wr, int wc, int fr, int fq) const {
        const int row0 = u.pm * BM + wr * 64 + fr, col0 = u.pn * HALF + wc * 32 + 4 * fq;
#pragma unroll
        for (int ai = 0; ai < 2; ++ai)
#pragma unroll
            for (int m = 0; m < 4; ++m) { bf16_t* rowp = O + (size_t)(row0 + ai * HALF + m * 16) * ldc + col0;
#pragma unroll
                for (int n = 0; n < 2; ++n) { const f32x4 g = acc[ai][0][m][n], up = acc[ai][1][m][n]; f32x4 h;
#pragma unroll
                    for (int q = 0; q < 4; ++q) h[q] = g[q] * up[q] * __builtin_amdgcn_rcpf(1.f + __expf(-g[q]));
                    u32x2 w; w.x = cvt_pk_bf16(h[0], h[1]); w.y = cvt_pk_bf16(h[2], h[3]); *(u32x2*)(rowp + n * 16) = w; } }
    }
};
struct EpiSwiGLU8 {
    static constexpr bool PERM = false, AFTER_DRAIN = false;
    unsigned char* O; int ldc; float wsc; const float* rs;
    __device__ __forceinline__ void operator()(const f32x4 (&acc)[2][2][4][2], const Unit& u, int wr, int wc, int fr, int fq) const {
        const int row0 = u.pm * BM + wr * 64 + fr, col0 = u.pn * HALF + wc * 32 + 4 * fq;
#pragma unroll
        for (int ai = 0; ai < 2; ++ai)
#pragma unroll
            for (int m = 0; m < 4; ++m) { const int row = row0 + ai * HALF + m * 16; unsigned char* rowp = O + (size_t)row * ldc + col0; const float sc = wsc * rs[row];
#pragma unroll
                for (int n = 0; n < 2; ++n) { const f32x4 g = acc[ai][0][m][n] * sc, up = acc[ai][1][m][n] * sc; f32x4 h;
#pragma unroll
                    for (int q = 0; q < 4; ++q) h[q] = g[q] * up[q] * __builtin_amdgcn_rcpf(1.f + __expf(-g[q]));
                    unsigned w = 0; w = __builtin_amdgcn_cvt_pk_fp8_f32(h[0], h[1], w, false); w = __builtin_amdgcn_cvt_pk_fp8_f32(h[2], h[3], w, true); *(unsigned*)(rowp + n * 16) = w; } }
    }
};
struct EpiDown {
    static constexpr bool PERM = false, AFTER_DRAIN = false;
    bf16_t* O; int ldc; const float* gate; float wsc;
    __device__ __forceinline__ void operator()(const f32x4 (&acc)[2][2][4][2], const Unit& u, int wr, int wc, int fr, int fq) const {
        const int row0 = u.pm * BM + wr * 64 + fr, col0 = u.pn * BM + wc * 32 + 4 * fq;
#pragma unroll
        for (int ai = 0; ai < 2; ++ai)
#pragma unroll
            for (int m = 0; m < 4; ++m) { const int row = row0 + ai * HALF + m * 16; const float gs = gate[row] * wsc; bf16_t* rowp = O + (size_t)row * ldc + col0;
#pragma unroll
                for (int bj = 0; bj < 2; ++bj)
#pragma unroll
                    for (int n = 0; n < 2; ++n) { const f32x4 v = acc[ai][bj][m][n] * gs; u32x2 w; w.x = cvt_pk_bf16(v[0], v[1]); w.y = cvt_pk_bf16(v[2], v[3]);
                        *(u32x2*)(rowp + bj * HALF + n * 16) = w; } }
    }
};
template <class Epi, class Sched, bool ALIGN_EPI = false, bool SP2 = false, bool GATHER = false, bool FP8 = false>
__device__ __forceinline__ void gemm_phase(PG8_LAS unsigned char* lds, const Gemm g, const Sched& S, const Epi& E, const int* gidx = nullptr) {
    const int tid = opaque_tid(), wid = __builtin_amdgcn_readfirstlane(tid >> 6), lane = tid & 63, wr = wid >> 2, wc = wid & 3, fr = lane & 15, fq = lane >> 4;
    const int K = g.K, nt = K / BK;
    unsigned voffA[2], voffB[2];
#pragma unroll
    for (int i = 0; i < 2; ++i) { int R, C; stage_rc(tid * 16 + i * 8192, R, C); const int Rb = Epi::PERM ? ((R & ~31) + perm32(R & 31)) : R;
        voffA[i] = (unsigned)(R * K + C) * 2u; voffB[i] = (unsigned)(Rb * K + C) * 2u; }
    const size_t kstep = (size_t)(BK * 2);
    const size_t hstep = (size_t)HALF * K * 2;
    const size_t tstep = 2 * hstep;
    const unsigned ldsw = (unsigned)wid * 1024u;
    const int aoff = lds_byte(wr * 64 + fr, fq * 8), boff = lds_byte(wc * 32 + fr, fq * 8);
#define PG8_SA(b, h) (((b) * 2 + (h)) * HTB)
#define PG8_SB(b, h) ((4 + (b) * 2 + (h)) * HTB)
#define PG8_STAGE(bufoff, gbase, voff) do { _Pragma("unroll") for (int _i = 0; _i < 2; ++_i) \
        __builtin_amdgcn_global_load_lds((const unsigned*)((const char*)(gbase) + (voff)[_i]), (PG8_LAS unsigned*)(lds + (bufoff) + ldsw + _i * 8192), 16, 0, 0); } while (0)
#define PG8_LDA(dst, b, h) do { _Pragma("unroll") for (int m = 0; m < 4; ++m) { if constexpr (FP8) { const v4i_ lo_ = *(const PG8_LAS v4i_*)(lds + PG8_SA(b, h) + aoff + m * 2048), hi_ = *(const PG8_LAS v4i_*)(lds + PG8_SA(b, h) + aoff + m * 2048 + 1024); \
        dst##8[m] = __builtin_shufflevector(lo_, hi_, 0, 1, 2, 3, 4, 5, 6, 7); } else { _Pragma("unroll") for (int k = 0; k < 2; ++k) dst[m][k] = *(const PG8_LAS bf16x8*)(lds + PG8_SA(b, h) + aoff + m * 2048 + k * 1024); } } } while (0)
#define PG8_LDB(dst, b, h) do { _Pragma("unroll") for (int n = 0; n < 2; ++n) { if constexpr (FP8) { const v4i_ lo_ = *(const PG8_LAS v4i_*)(lds + PG8_SB(b, h) + boff + n * 2048), hi_ = *(const PG8_LAS v4i_*)(lds + PG8_SB(b, h) + boff + n * 2048 + 1024); \
        dst##8[n] = __builtin_shufflevector(lo_, hi_, 0, 1, 2, 3, 4, 5, 6, 7); } else { _Pragma("unroll") for (int k = 0; k < 2; ++k) dst[n][k] = *(const PG8_LAS bf16x8*)(lds + PG8_SB(b, h) + boff + n * 2048 + k * 1024); } } } while (0)
#define PG8_MMA(ai, bj, At, Bt) do { __builtin_amdgcn_s_setprio(1); _Pragma("unroll") for (int m = 0; m < 4; ++m) _Pragma("unroll") for (int n = 0; n < 2; ++n) { \
        if constexpr (FP8) asm volatile("v_mfma_scale_f32_16x16x128_f8f6f4 %0, %1, %2, %0, %3, %3 op_sel_hi:[0,0,0]" : "+v"(acc[ai][bj][m][n]) : "v"(Bt##8[n]), "v"(At##8[m]), "v"(sc127_));   \
        else { _Pragma("unroll") for (int k = 0; k < 2; ++k) acc[ai][bj][m][n] = __builtin_amdgcn_mfma_f32_16x16x32_bf16(Bt[n][k], At[m][k], acc[ai][bj][m][n], 0, 0, 0); } } \
        __builtin_amdgcn_s_setprio(0); } while (0)
#define PG8_WAIT_V(n) asm volatile("s_waitcnt vmcnt(" #n ")" ::: "memory")
#define PG8_WAIT_L(n) asm volatile("s_waitcnt lgkmcnt(" #n ")" ::: "memory")
#define PG8_BAR __builtin_amdgcn_s_barrier()
#define PG8_SCHED __builtin_amdgcn_sched_barrier(0)
    Unit cur, nxt; int ui = 0;
    if (!S.next(0, cur)) return;
    f32x4 acc[2][2][4][2];
#pragma unroll
    for (int a = 0; a < 2; ++a)
#pragma unroll
        for (int b = 0; b < 2; ++b)
#pragma unroll
            for (int m = 0; m < 4; ++m)
#pragma unroll
                for (int n = 0; n < 2; ++n) acc[a][b][m][n] = (f32x4){0.f, 0.f, 0.f, 0.f};
    typedef int v8i_ __attribute__((ext_vector_type(8))); typedef int v4i_ __attribute__((ext_vector_type(4)));
    const int sc127_ = 127;
    bf16x8 At[4][2], B0[2][2], B1[2][2]; v8i_ At8[4], B08[2], B18[2];
    static_assert(SP2, "this copy of the body keeps only the SP2 K-loop up to date");
    int rA[2]; { int R_, C_; stage_rc(tid * 16, R_, C_); rA[0] = R_; stage_rc(tid * 16 + 8192, R_, C_); rA[1] = R_; }
    unsigned cv0[2], cv1[2], nv0[2], nv1[2];
    unsigned vh1[2]; vh1[0] = voffA[0] + (unsigned)hstep; vh1[1] = voffA[1] + (unsigned)hstep;
#define PG8_CV0 (GATHER ? cv0 : voffA)
#define PG8_CV1 (GATHER ? cv1 : vh1)
#define PG8_SV0 (GATHER ? sv0 : voffA)
#define PG8_SV1 (GATHER ? sv1 : vh1)
#define PG8_ROWOFF(dst0, dst1, unit) do { _Pragma("unroll") for (int i_ = 0; i_ < 2; ++i_) { \
        if constexpr (GATHER) { const int c2_ = (int)(voffA[i_] - (unsigned)(rA[i_] * K) * 2u); \
            dst0[i_] = (unsigned)gidx[(unit).pm * BM + rA[i_]] * (unsigned)(K * 2) + (unsigned)c2_; dst1[i_] = (unsigned)gidx[(unit).pm * BM + HALF + rA[i_]] * (unsigned)(K * 2) + (unsigned)c2_; } \
        else { dst0[i_] = voffA[i_]; dst1[i_] = voffA[i_] + (unsigned)hstep; } } } while (0)
    if constexpr (GATHER) PG8_ROWOFF(cv0, cv1, cur);
    const char* cA = GATHER ? (const char*)g.A : (const char*)g.A + (size_t)cur.pm * tstep; const char* cB = (const char*)g.Bt + (size_t)((cur.pm / g.gdiv) % g.gmod) * g.gstride + (size_t)cur.pn * tstep;
    S.a_ready(cur);
    if constexpr (SP2) {
        PG8_STAGE(PG8_SB(0, 0), cB, voffB); PG8_STAGE(PG8_SB(0, 1), cB + hstep, voffB); PG8_STAGE(PG8_SA(0, 0), cA, PG8_CV0); PG8_STAGE(PG8_SA(0, 1), cA, PG8_CV1);
        if (wr == 1) PG8_BAR;
        PG8_WAIT_V(2); PG8_BAR;
        PG8_STAGE(PG8_SB(1, 0), cB + kstep, voffB); PG8_STAGE(PG8_SA(1, 0), cA + kstep, PG8_CV0); PG8_STAGE(PG8_SB(1, 1), cB + hstep + kstep, voffB);
        PG8_WAIT_V(6); PG8_BAR;
    } else {
        PG8_STAGE(PG8_SB(0, 0), cB, voffB); PG8_STAGE(PG8_SA(0, 0), cA, voffA); PG8_STAGE(PG8_SB(0, 1), cB + hstep, voffB); PG8_STAGE(PG8_SA(0, 1), cA + hstep, voffA);
        if (wr == 1) PG8_BAR;
        PG8_WAIT_V(4); PG8_BAR;
        PG8_STAGE(PG8_SB(1, 0), cB + kstep, voffB); PG8_STAGE(PG8_SA(1, 0), cA + kstep, voffA); PG8_STAGE(PG8_SB(1, 1), cB + hstep + kstep, voffB);
        PG8_WAIT_V(6); PG8_BAR;
    }
    for (;;) {
        const bool has_next = S.next(ui + 1, nxt);
        if constexpr (GATHER) { if (has_next) PG8_ROWOFF(nv0, nv1, nxt); else { nv0[0] = cv0[0]; nv0[1] = cv0[1]; nv1[0] = cv1[0]; nv1[1] = cv1[1]; } }
        const char* nA = GATHER ? (const char*)g.A : (has_next ? (const char*)g.A + (size_t)nxt.pm * tstep : cA); const char* nB = has_next ? (const char*)g.Bt + (size_t)((nxt.pm / g.gdiv) % g.gmod) * g.gstride + (size_t)nxt.pn * tstep : cB;
        for (int t = 0; t < nt; t += 2) {
            const bool last = (t == nt - 2);
            unsigned sv0[2], sv1[2]; if constexpr (GATHER) { sv0[0] = last ? nv0[0] : cv0[0]; sv0[1] = last ? nv0[1] : cv0[1]; sv1[0] = last ? nv1[0] : cv1[0]; sv1[1] = last ? nv1[1] : cv1[1]; }
            const char* a1 = cA + (size_t)(t + 1) * kstep;
            const char* a2 = last ? nA : cA + (size_t)(t + 2) * kstep; const char* b2 = last ? nB : cB + (size_t)(t + 2) * kstep;
            const char* a3 = a2 + kstep; const char* b3 = b2 + kstep;
            if (last && has_next) S.a_ready(nxt);
            if constexpr (SP2) {
            PG8_LDB(B0, 0, 0); PG8_LDB(B1, 0, 1); PG8_SCHED; PG8_LDA(At, 0, 0); PG8_STAGE(PG8_SA(1, 1), a1, PG8_CV1);
            PG8_WAIT_V(8); PG8_WAIT_L(0); PG8_BAR; PG8_MMA(0, 0, At, B0); PG8_MMA(0, 1, At, B1); PG8_BAR; PG8_SCHED;
            PG8_LDA(At, 0, 1); PG8_STAGE(PG8_SB(0, 0), b2, voffB); PG8_STAGE(PG8_SB(0, 1), b2 + hstep, voffB); PG8_STAGE(PG8_SA(0, 0), a2, PG8_SV0);
            PG8_WAIT_V(8); PG8_WAIT_L(0); PG8_BAR; PG8_MMA(1, 0, At, B0); PG8_MMA(1, 1, At, B1); PG8_BAR; PG8_SCHED;
            PG8_LDB(B0, 1, 0); PG8_LDB(B1, 1, 1); PG8_SCHED; PG8_LDA(At, 1, 0); PG8_STAGE(PG8_SA(0, 1), a2, PG8_SV1);
            PG8_WAIT_V(8); PG8_WAIT_L(0); PG8_BAR; PG8_MMA(0, 0, At, B0); PG8_MMA(0, 1, At, B1); PG8_BAR; PG8_SCHED;
            PG8_LDA(At, 1, 1); PG8_STAGE(PG8_SB(1, 0), b3, voffB); PG8_STAGE(PG8_SB(1, 1), b3 + hstep, voffB); PG8_STAGE(PG8_SA(1, 0), a3, PG8_SV0);
            PG8_WAIT_V(8); PG8_WAIT_L(0); PG8_BAR; PG8_MMA(1, 0, At, B0); PG8_MMA(1, 1, At, B1); PG8_BAR; PG8_SCHED;
            } else {
            PG8_LDB(B0, 0, 0); PG8_SCHED; PG8_LDA(At, 0, 0); PG8_STAGE(PG8_SA(1, 1), a1 + hstep, voffA);
            PG8_WAIT_L(8); PG8_BAR; PG8_WAIT_L(0); PG8_MMA(0, 0, At, B0); PG8_BAR; PG8_SCHED;
            PG8_LDB(B1, 0, 1); PG8_STAGE(PG8_SB(0, 0), b2, voffB);
            PG8_BAR; PG8_WAIT_L(0); PG8_MMA(0, 1, At, B1); PG8_BAR;
            PG8_LDA(At, 0, 1); PG8_STAGE(PG8_SA(0, 0), a2, voffA);
            PG8_BAR; PG8_WAIT_L(0); PG8_MMA(1, 0, At, B0); PG8_BAR; PG8_SCHED;
            PG8_STAGE(PG8_SB(0, 1), b2 + hstep, voffB);
            PG8_WAIT_V(6); PG8_BAR; PG8_MMA(1, 1, At, B1); PG8_BAR;
            PG8_LDB(B0, 1, 0); PG8_SCHED; PG8_LDA(At, 1, 0); PG8_STAGE(PG8_SA(0, 1), a2 + hstep, voffA);
            PG8_WAIT_L(8); PG8_BAR; PG8_WAIT_L(0); PG8_MMA(0, 0, At, B0); PG8_BAR; PG8_SCHED;
            PG8_LDB(B1, 1, 1); PG8_STAGE(PG8_SB(1, 0), b3, voffB);
            PG8_BAR; PG8_WAIT_L(0); PG8_MMA(0, 1, At, B1); PG8_BAR;
            PG8_LDA(At, 1, 1); PG8_STAGE(PG8_SA(1, 0), a3, voffA);
            PG8_BAR; PG8_WAIT_L(0); PG8_MMA(1, 0, At, B0); PG8_BAR; PG8_SCHED;
            PG8_STAGE(PG8_SB(1, 1), b3 + hstep, voffB);
            PG8_WAIT_V(6); PG8_BAR; PG8_MMA(1, 1, At, B1); PG8_BAR;
            }
        }
        if constexpr (ALIGN_EPI) { if (wr == 0) PG8_BAR; }
        if constexpr (!Epi::AFTER_DRAIN) { E(acc, cur, wr, wc, fr, fq); S.done(cur); }
        if (!has_next) break;
#pragma unroll
        for (int a = 0; a < 2; ++a)
#pragma unroll
            for (int b = 0; b < 2; ++b)
#pragma unroll
                for (int m = 0; m < 4; ++m)
#pragma unroll
                    for (int n = 0; n < 2; ++n) acc[a][b][m][n] = (f32x4){0.f, 0.f, 0.f, 0.f};
        cur = nxt; cA = nA; cB = nB; ++ui; if constexpr (GATHER) { cv0[0] = nv0[0]; cv0[1] = nv0[1]; cv1[0] = nv1[0]; cv1[1] = nv1[1]; }
        if constexpr (ALIGN_EPI) { if (wr == 1) PG8_BAR; }
    }
    PG8_WAIT_V(0);
    if constexpr (!ALIGN_EPI) { if (wr == 0) PG8_BAR; }
    PG8_BAR;
    if constexpr (Epi::AFTER_DRAIN) { E.fused(acc, cur, wr, wc, fr, fq, lds, wid, lane); S.done(cur); }
#undef PG8_ROWOFF
#undef PG8_CV0
#undef PG8_CV1
#undef PG8_SV0
#undef PG8_SV1
#undef PG8_SA
#undef PG8_SB
#undef PG8_STAGE
#undef PG8_LDA
#undef PG8_LDB
#undef PG8_MMA
#undef PG8_WAIT_V
#undef PG8_WAIT_L
#undef PG8_BAR
#undef PG8_SCHED
}
}
namespace attn_body {
using bf16=__hip_bfloat16;
using bf16x8=__attribute__((ext_vector_type(8)))short;
using s16x4=__attribute__((ext_vector_type(4)))short;
using f32x16=__attribute__((ext_vector_type(16)))float;
using u32x4=__attribute__((ext_vector_type(4)))unsigned;
constexpr int D=64;
constexpr int NW=8,QBLK=32,QB=QBLK*NW,KVBLK=64;
__device__ __forceinline__ int crow(int r,int hi){return (r&3)+8*(r>>2)+4*hi;}
#define SBAR() __builtin_amdgcn_sched_barrier(0)
__device__ __forceinline__ void cmask(f32x16&p0,f32x16&p1,int jb,int qrel,int hi){
  const float NEG=-INFINITY; int kb=64*jb+4*hi;
  #pragma unroll
  for(int r=0;r<16;++r){int kv=kb+(r&3)+8*(r>>2); if(kv>qrel)p0[r]=NEG; if(kv+32>qrel)p1[r]=NEG;}
}

constexpr int NSLOT=3, SLOTB=8192;
constexpr int LDS_K=0, LDS_V=NSLOT*SLOTB, LDS_WS=2*NSLOT*SLOTB, LDS_OST=LDS_WS+NW*64*4, LDS_BYTES=LDS_OST+NW*4096;
constexpr float C2=0.125f*1.4426950408889634f;
__device__ __forceinline__ void glds16(const void*gsrc,unsigned lds_dst){unsigned keep;
  asm volatile("s_mov_b32 %0, m0\n\ts_mov_b32 m0, %2\n\ts_nop 0\n\tglobal_load_lds_dwordx4 %1, off\n\ts_mov_b32 m0, %0":"=&s"(keep):"v"(gsrc),"s"(lds_dst):"memory");}
__device__ __forceinline__ float max3f(float a,float b,float c){float r;asm("v_max3_f32 %0, %1, %2, %3":"=v"(r):"v"(a),"v"(b),"v"(c));return r;}
__device__ __forceinline__ float max2f(float a,float b){float r;asm("v_max_f32_e32 %0, %1, %2":"=v"(r):"v"(a),"v"(b));return r;}
__device__ __forceinline__ float fadd_s(float a,float b){float r;asm("v_add_f32_e32 %0, %1, %2":"=v"(r):"v"(a),"v"(b));return r;}
__device__ __forceinline__ float fsub_s(float a,float b){float r;asm("v_sub_f32_e32 %0, %1, %2":"=v"(r):"v"(a),"v"(b));return r;}
typedef float f32x2_t __attribute__((ext_vector_type(2))); typedef __bf16 bf16x2_t __attribute__((ext_vector_type(2)));
__device__ __forceinline__ unsigned cvtpk_s(float lo,float hi){f32x2_t v={lo,hi};bf16x2_t b=__builtin_convertvector(v,bf16x2_t);return __builtin_bit_cast(unsigned,b);}
#define WAIT_BAR(N) asm volatile("s_waitcnt vmcnt(" #N ") lgkmcnt(0)\n\ts_barrier":::"memory")

__device__ __forceinline__ void qkt(f32x16&p0,f32x16&p1,const char*Kslot,const bf16x8*qr,const f32x16&negm,int r32,int hi){
  const char*kb=Kslot+hi*1024+r32*16;
  #pragma unroll
  for(int d0=0;d0<4;++d0){
    const bf16x8 b0=*reinterpret_cast<const bf16x8*>(kb+d0*2048);
    const bf16x8 b1=*reinterpret_cast<const bf16x8*>(kb+d0*2048+512);
    if(d0==0){p0=__builtin_amdgcn_mfma_f32_32x32x16_bf16(b0,qr[0],negm,0,0,0);p1=__builtin_amdgcn_mfma_f32_32x32x16_bf16(b1,qr[0],negm,0,0,0);}
    else{p0=__builtin_amdgcn_mfma_f32_32x32x16_bf16(b0,qr[d0],p0,0,0,0);p1=__builtin_amdgcn_mfma_f32_32x32x16_bf16(b1,qr[d0],p1,0,0,0);}}
}
typedef __attribute__((address_space(3))) const char* lds_cptr;
typedef short v4i16_t __attribute__((ext_vector_type(4)));
__device__ __forceinline__ void kload8(bf16x8*kf,lds_cptr kp){
  kf[0]=*(const __attribute__((address_space(3))) bf16x8*)(kp);      kf[1]=*(const __attribute__((address_space(3))) bf16x8*)(kp+512);
  kf[2]=*(const __attribute__((address_space(3))) bf16x8*)(kp+2048); kf[3]=*(const __attribute__((address_space(3))) bf16x8*)(kp+2560);
  kf[4]=*(const __attribute__((address_space(3))) bf16x8*)(kp+4096); kf[5]=*(const __attribute__((address_space(3))) bf16x8*)(kp+4608);
  kf[6]=*(const __attribute__((address_space(3))) bf16x8*)(kp+6144); kf[7]=*(const __attribute__((address_space(3))) bf16x8*)(kp+6656);
}
__device__ __forceinline__ void kload2(bf16x8*kf,lds_cptr kp,int j){ kf[2*j]=*(const __attribute__((address_space(3))) bf16x8*)(kp+j*2048); kf[2*j+1]=*(const __attribute__((address_space(3))) bf16x8*)(kp+j*2048+512); }
__device__ __forceinline__ s16x4 vtr(lds_cptr p){ return __builtin_bit_cast(s16x4,__builtin_amdgcn_ds_read_tr16_b64_v4i16((__attribute__((address_space(3))) v4i16_t*)p)); }
__device__ __forceinline__ float rowmax(const f32x16&p0,const f32x16&p1){
  float a=max3f(p0[0],p0[1],p1[0]),b=max3f(p0[2],p0[3],p1[1]);a=max3f(a,p1[2],p1[3]);
  #pragma unroll
  for(int r=4;r<16;r+=4){a=max3f(a,p0[r],p0[r+1]);b=max3f(b,p0[r+2],p0[r+3]);a=max3f(a,p1[r],p1[r+1]);b=max3f(b,p1[r+2],p1[r+3]);}
  const float m=max2f(a,b);
  auto rr=__builtin_amdgcn_permlane32_swap(__float_as_uint(m),__float_as_uint(m),false,false);
  return max2f(__uint_as_float(rr[0]),__uint_as_float(rr[1]));
}
__device__ __forceinline__ void pv(f32x16*o,int vb,bf16x8 pa0,bf16x8 pa1,bf16x8 pa2,bf16x8 pa3){
  #pragma unroll
  for(int d0=0;d0<2;++d0){s16x4 lo[4],hi[4];
    #pragma unroll
    for(int ks=0;ks<4;++ks){
      asm volatile("ds_read_b64_tr_b16 %0,%1 offset:%c2":"=&v"(lo[ks]):"v"(vb),"i"(d0*4096+ks*1024):"memory");
      asm volatile("ds_read_b64_tr_b16 %0,%1 offset:%c2":"=&v"(hi[ks]):"v"(vb),"i"(d0*4096+ks*1024+512):"memory");}
    asm volatile("s_waitcnt lgkmcnt(0)":::"memory");SBAR();
    #define PK(k) (bf16x8){lo[k][0],lo[k][1],lo[k][2],lo[k][3],hi[k][0],hi[k][1],hi[k][2],hi[k][3]}
    o[d0]=__builtin_amdgcn_mfma_f32_32x32x16_bf16(pa0,PK(0),o[d0],0,0,0);
    o[d0]=__builtin_amdgcn_mfma_f32_32x32x16_bf16(pa1,PK(1),o[d0],0,0,0);
    o[d0]=__builtin_amdgcn_mfma_f32_32x32x16_bf16(pa2,PK(2),o[d0],0,0,0);
    o[d0]=__builtin_amdgcn_mfma_f32_32x32x16_bf16(pa3,PK(3),o[d0],0,0,0);
    #undef PK
  }
}

#ifndef ATTN_STORE16
#define ATTN_STORE16(p,v) (*(u32x4*)(p)=(v))
#endif
template<int THRL,int QP,int KP,int OP> __device__ __forceinline__ void attn_unit(const bf16*Qu,const bf16*__restrict__ Kh,const bf16*__restrict__ Vh,bf16*Ou,const int NT,char*shm){
  const int tid=opaque_tid(),lane=tid&63,r32=lane&31,hi=lane>>5; const int wid=__builtin_amdgcn_readfirstlane(tid>>6);
  const bf16*Qw=Qu+(long)(wid*QBLK)*QP;
  const unsigned lds0=(unsigned)(uintptr_t)shm;
  float*wsf=(float*)(shm+LDS_WS)+wid*64;
  const bf16*ksrc=Kh+(long)lane*KP+wid*8;
  const bf16*vsrc=Vh+(long)(16*(wid&3)+(lane>>2))*KP+(wid>>2)*32+(lane&3)*8;
  const unsigned kdst=lds0+LDS_K+wid*1024, vdst=lds0+LDS_V+wid*1024;
  #define DMA_K(t,slot) glds16(ksrc+(long)(t)*KVBLK*KP,(unsigned)__builtin_amdgcn_readfirstlane(kdst+(slot)))
  #define DMA_V(t,slot) glds16(vsrc+(long)(t)*KVBLK*KP,(unsigned)__builtin_amdgcn_readfirstlane(vdst+(slot)))
  const int vb0=(int)(lds0+LDS_V)+((lane>>4)&1)*32+(lane&3)*8+(4*hi+((lane&15)>>2))*64;
  const char*Kbase=shm+LDS_K; bf16x8 kf[8];
  const lds_cptr shm3=(lds_cptr)shm; const lds_cptr kp0=shm3+LDS_K+hi*1024+r32*16; const lds_cptr vp0=shm3+LDS_V+((lane>>4)&1)*32+(lane&3)*8+(4*hi+((lane&15)>>2))*64;
  DMA_K(0,0);DMA_V(0,0);DMA_K(1,SLOTB);
  bf16x8 qr[4];
  #pragma unroll
  for(int d0=0;d0<4;++d0)qr[d0]=*reinterpret_cast<const bf16x8*>(&Qw[(long)r32*QP+d0*16+hi*8]);
  float mhat=0.f,l_reg=0.f;f32x16 o[2];o[0]=f32x16{};o[1]=f32x16{};f32x16 negm=f32x16{};asm volatile("":"+v"(negm));
  #define CMASK(P0,P1,t) do{}while(0)
  bool resc=false;
  #define START(P0,P1) do{ const float rm=rowmax(P0,P1); resc=false; \
    { const float dl=rm; mhat=fadd_s(mhat,dl); \
      _Pragma("unroll") for(int r=0;r<16;++r){P0[r]=fsub_s(P0[r],dl);P1[r]=fsub_s(P1[r],dl);} \
      _Pragma("unroll") for(int r=0;r<16;++r)negm[r]=-mhat; asm volatile("":"+v"(negm)); } \
    _Pragma("unroll") for(int r=0;r<16;++r)P0[r]=__builtin_amdgcn_exp2f(P0[r]); }while(0)
  #define RESC() do{ if(resc){ asm volatile("s_waitcnt lgkmcnt(0)":::"memory"); \
      _Pragma("unroll") for(int d_=0;d_<2;++d_) _Pragma("unroll") for(int r=0;r<16;++r)o[d_][r]*=wsf[crow(r,hi)]; } }while(0)
  f32x16 pA0,pA1,pB0,pB1;
  int sl_prev=0,sl_cur=0,sl_next=SLOTB;
  #define ROT() do{sl_prev=sl_cur;sl_cur=sl_next;sl_next=(sl_next==(NSLOT-1)*SLOTB)?0:sl_next+SLOTB;}while(0)
  DMA_K(2,2*SLOTB);
  WAIT_BAR(3);
  qkt(pA0,pA1,Kbase,qr,negm,r32,hi);asm volatile("s_nop 15\n\ts_nop 7":"+v"(pA0),"+v"(pA1));CMASK(pA0,pA1,0);
  START(pA0,pA1);
  _Pragma("unroll") for(int r=0;r<16;++r)pA1[r]=__builtin_amdgcn_exp2f(pA1[r]);
  WAIT_BAR(0);
  DMA_K(3,0);DMA_V(1,SLOTB);
  ROT();
  kload8(kf,kp0+sl_cur);
  WAIT_BAR(2);
  s16x4 vlo[8],vhi[8]; u32x4 pw0,pw1,pw2,pw3;
  #define PKW(P,B) cvtpk_s(P[B],P[B+1])
  #define PAF(k) __builtin_bit_cast(bf16x8,pw##k)
  #define VFR(i) (bf16x8){vlo[i][0],vlo[i][1],vlo[i][2],vlo[i][3],vhi[i][0],vhi[i][1],vhi[i][2],vhi[i][3]}
  #define PIN(x) asm volatile("":"+v"(x))
  #define MX3(a,b,c) __builtin_fmaxf(__builtin_fmaxf((a),(b)),(c))
  #define GAPA(MF,A0,A1,A2,A3,W0,W1,PW) do{ MF; sacc+=A0; sacc+=A1; sacc+=A2; sacc+=A3; PIN(sacc); W0; W1; PIN(PW); SBAR(); }while(0)
  #define EX(v) __builtin_amdgcn_exp2f(v)
  #define GAPB(MF,X,B) do{ MF; X[B]=EX(X[B]); X[B+1]=EX(X[B+1]); X[B+2]=EX(X[B+2]); X[B+3]=EX(X[B+3]); PIN(X); SBAR(); }while(0)
  #define VRD(i) do{ vlo[i]=vtr(vp_+(((i)>>2)*4096+((i)&3)*1024)); vhi[i]=vtr(vp_+(((i)>>2)*4096+((i)&3)*1024+512)); }while(0)
  #define KRD(G,j) do{ if(G){ kload2(kf,kp0+sl_next,j); SBAR(); } }while(0)
  #define STEP(C0,C1,P0,P1,t,GK,GV,GL) do{ SBAR(); \
    const lds_cptr vp_=vp0+sl_prev; \
    VRD(0); SBAR(); float sacc=(P0[0]+P0[1]); \
    GAPA(C0=__builtin_amdgcn_mfma_f32_32x32x16_bf16(kf[0],qr[0],negm,0,0,0), P0[2],P0[3],P0[4],P0[5],     pw0[0]=PKW(P0,0), pw0[1]=PKW(P0,2), pw0); \
    VRD(4); SBAR(); GAPA(C1=__builtin_amdgcn_mfma_f32_32x32x16_bf16(kf[1],qr[0],negm,0,0,0), P0[6],P0[7],P0[8],P0[9],     pw0[2]=PKW(P0,4), pw0[3]=PKW(P0,6), pw0); \
    VRD(1); SBAR(); GAPA(C0=__builtin_amdgcn_mfma_f32_32x32x16_bf16(kf[2],qr[1],C0,0,0,0),   P0[10],P0[11],P0[12],P0[13], pw1[0]=PKW(P0,8), pw1[1]=PKW(P0,10), pw1); \
    VRD(5); SBAR(); GAPA(C1=__builtin_amdgcn_mfma_f32_32x32x16_bf16(kf[3],qr[1],C1,0,0,0),   P0[14],P0[15],P1[0],P1[1],   pw1[2]=PKW(P0,12),pw1[3]=PKW(P0,14), pw1); \
    VRD(2); SBAR(); GAPA(C0=__builtin_amdgcn_mfma_f32_32x32x16_bf16(kf[4],qr[2],C0,0,0,0),   P1[2],P1[3],P1[4],P1[5],     pw2[0]=PKW(P1,0), pw2[1]=PKW(P1,2), pw2); \
    VRD(6); SBAR(); GAPA(C1=__builtin_amdgcn_mfma_f32_32x32x16_bf16(kf[5],qr[2],C1,0,0,0),   P1[6],P1[7],P1[8],P1[9],     pw2[2]=PKW(P1,4), pw2[3]=PKW(P1,6), pw2); \
    VRD(3); SBAR(); GAPA(C0=__builtin_amdgcn_mfma_f32_32x32x16_bf16(kf[6],qr[3],C0,0,0,0),   P1[10],P1[11],P1[12],P1[13], pw3[0]=PKW(P1,8), pw3[1]=PKW(P1,10), pw3); \
    VRD(7); SBAR(); GAPA(C1=__builtin_amdgcn_mfma_f32_32x32x16_bf16(kf[7],qr[3],C1,0,0,0),   P1[14],P1[15],0.f,0.f,       pw3[2]=PKW(P1,12),pw3[3]=PKW(P1,14), pw3); \
    l_reg+=sacc; \
    if(GK){DMA_K((t)+3,sl_cur);} if(GV){DMA_V((t)+1,sl_next);} \
    CMASK(C0,C1,t); \
    { float a=MX3(C0[0],C0[1],C1[0]),b=MX3(C0[2],C0[3],C1[1]); a=MX3(a,C1[2],C1[3]); \
      _Pragma("unroll") for(int r=4;r<16;r+=4){a=MX3(a,C0[r],C0[r+1]);b=MX3(b,C0[r+2],C0[r+3]);a=MX3(a,C1[r],C1[r+1]);b=MX3(b,C1[r+2],C1[r+3]);} \
      float rm=__builtin_fmaxf(a,b); { auto rr=__builtin_amdgcn_permlane32_swap(__float_as_uint(rm),__float_as_uint(rm),false,false); rm=__builtin_fmaxf(__uint_as_float(rr[0]),__uint_as_float(rr[1])); } \
      resc=false; \
      if(__builtin_expect(__any(rm>(float)THRL),0)){ const float dl=__builtin_fmaxf(rm,0.f); mhat+=dl; \
        _Pragma("unroll") for(int r=0;r<16;++r){C0[r]-=dl;C1[r]-=dl;} \
        _Pragma("unroll") for(int r=0;r<16;++r)negm[r]=-mhat; asm volatile("":"+v"(negm)); \
        const float f=__builtin_amdgcn_exp2f(-dl); l_reg*=f; if(hi==0)wsf[r32]=f; resc=true; } } \
    SBAR(); \
    GAPB(o[0]=__builtin_amdgcn_mfma_f32_32x32x16_bf16(PAF(0),VFR(0),o[0],0,0,0), C0,0); \
    GAPB(o[1]=__builtin_amdgcn_mfma_f32_32x32x16_bf16(PAF(0),VFR(4),o[1],0,0,0), C0,4); \
    KRD(GL,0); GAPB(o[0]=__builtin_amdgcn_mfma_f32_32x32x16_bf16(PAF(1),VFR(1),o[0],0,0,0), C0,8); \
    KRD(GL,1); GAPB(o[1]=__builtin_amdgcn_mfma_f32_32x32x16_bf16(PAF(1),VFR(5),o[1],0,0,0), C0,12); \
    KRD(GL,2); GAPB(o[0]=__builtin_amdgcn_mfma_f32_32x32x16_bf16(PAF(2),VFR(2),o[0],0,0,0), C1,0); \
    KRD(GL,3); GAPB(o[1]=__builtin_amdgcn_mfma_f32_32x32x16_bf16(PAF(2),VFR(6),o[1],0,0,0), C1,4); \
    GAPB(o[0]=__builtin_amdgcn_mfma_f32_32x32x16_bf16(PAF(3),VFR(3),o[0],0,0,0), C1,8); \
    GAPB(o[1]=__builtin_amdgcn_mfma_f32_32x32x16_bf16(PAF(3),VFR(7),o[1],0,0,0), C1,12); \
    }while(0)
  int t=1;
  #undef CMASK
  #define CMASK(P0,P1,t) do{}while(0)
  for(;t+5<NT;t+=2){
    STEP(pB0,pB1,pA0,pA1,t,true,true,true);     WAIT_BAR(2); RESC(); ROT();
    STEP(pA0,pA1,pB0,pB1,t+1,true,true,true);   WAIT_BAR(2); RESC(); ROT();
  }
  #undef CMASK
  #define CMASK(P0,P1,t) do{}while(0)
  #define ENDW(tt) do{ if((tt)+3<NT){WAIT_BAR(2);} else if((tt)+2<NT){WAIT_BAR(1);} else {WAIT_BAR(0);} }while(0)
  for(;t+1<NT;t+=2){
    STEP(pB0,pB1,pA0,pA1,t,(t+3<NT),(t+1<NT),(t+1<NT));       ENDW(t);   RESC(); ROT();
    STEP(pA0,pA1,pB0,pB1,t+1,(t+4<NT),(t+2<NT),(t+2<NT));     ENDW(t+1); RESC(); ROT();
  }
  STEP(pB0,pB1,pA0,pA1,NT-1,false,false,false); RESC();
  { float sacc=pB0[0]+pB0[1]; _Pragma("unroll") for(int r=2;r<16;++r)sacc+=pB0[r]; _Pragma("unroll") for(int r=0;r<16;++r)sacc+=pB1[r]; l_reg+=sacc;
    pw0=(u32x4){PKW(pB0,0),PKW(pB0,2),PKW(pB0,4),PKW(pB0,6)};pw1=(u32x4){PKW(pB0,8),PKW(pB0,10),PKW(pB0,12),PKW(pB0,14)};pw2=(u32x4){PKW(pB1,0),PKW(pB1,2),PKW(pB1,4),PKW(pB1,6)};pw3=(u32x4){PKW(pB1,8),PKW(pB1,10),PKW(pB1,12),PKW(pB1,14)};
    SBAR(); pv(o,vb0+sl_cur,PAF(0),PAF(1),PAF(2),PAF(3)); }
  #undef PKW
  #undef PAF
  #undef VFR
  #undef PIN
  #undef MX3
  #undef GAPA
  #undef GAPB
  #undef EX
  #undef VRD
  #undef KRD
  #undef STEP
  #undef ENDW
  {auto rr=__builtin_amdgcn_permlane32_swap(__float_as_uint(l_reg),__float_as_uint(l_reg),false,false);l_reg=__uint_as_float(rr[0])+__uint_as_float(rr[1]);}
  if(hi==0)wsf[32+r32]=l_reg;asm volatile("s_waitcnt lgkmcnt(0)":::"memory");
  float rli[16];
  #pragma unroll
  for(int r=0;r<16;++r)rli[r]=__builtin_amdgcn_rcpf(wsf[32+crow(r,hi)]);
  bf16*Ow=Ou+(long)(wid*QBLK)*OP;
  { bf16*stg=(bf16*)(shm+LDS_OST)+wid*2048;
    #pragma unroll
    for(int r=0;r<16;++r){const int orow=crow(r,hi);
      #pragma unroll
      for(int d0=0;d0<2;++d0)stg[orow*64+d0*32+r32]=__float2bfloat16(o[d0][r]*rli[r]);}
    asm volatile("s_waitcnt lgkmcnt(0)":::"memory");
    #pragma unroll
    for(int i=0;i<4;++i){const int row=i*8+(lane>>3),ch=lane&7; const u32x4 v=*(const u32x4*)(stg+row*64+ch*8); ATTN_STORE16(Ow+(long)row*OP+ch*8,v);} }
  asm volatile("s_waitcnt lgkmcnt(0)\n\ts_barrier":::"memory");
  #undef DMA_K
  #undef DMA_V
  #undef CMASK
  #undef START
  #undef RESC
  #undef ROT
}
constexpr int ATTN_LDS_BYTES=LDS_BYTES;
#undef SBAR
#undef WAIT_BAR
}
#define LDS_WAIT() asm volatile("s_waitcnt lgkmcnt(0)" ::: "memory")

__device__ __forceinline__ void transpose_item(const float* W, int K, int N, bf16* WT, int k0, int n0, int dest_row0, LAS float* scr, int lane) {
    float t_[32];
#pragma unroll
    for (int i = 0; i < 32; ++i) t_[i] = W[(size_t)(k0 + 2 * i + (lane >> 5)) * N + n0 + (lane & 31)];
#pragma unroll
    for (int i = 0; i < 32; ++i) scr[(2 * i + (lane >> 5)) * 33 + (lane & 31)] = t_[i];
    LDS_WAIT(); asm volatile("" ::: "memory");
    const int c = lane & 7;
#pragma unroll
    for (int j = 0; j < 4; ++j) { const int n = (lane >> 3) + 8 * j; const LAS float* s = scr + (8 * c) * 33 + n;
        v4u o; o.x = pk2(s[0 * 33], s[1 * 33]); o.y = pk2(s[2 * 33], s[3 * 33]); o.z = pk2(s[4 * 33], s[5 * 33]); o.w = pk2(s[6 * 33], s[7 * 33]);
        *(GAS v4u*)(WT + (size_t)(dest_row0 + n) * K + k0 + 8 * c) = o; }
    LDS_WAIT(); asm volatile("" ::: "memory");
}

__device__ __forceinline__ void transpose_item8(const float* W, int K, int N, unsigned char* WT, int k0, int n0, int dest_row0, float sc, LAS float* scr, int lane) {
    float t_[32];
#pragma unroll
    for (int i = 0; i < 32; ++i) t_[i] = W[(size_t)(k0 + 2 * i + (lane >> 5)) * N + n0 + (lane & 31)];
#pragma unroll
    for (int i = 0; i < 32; ++i) scr[(2 * i + (lane >> 5)) * 33 + (lane & 31)] = t_[i] * sc;
    LDS_WAIT(); asm volatile("" ::: "memory");
    const int c = lane & 7;
#pragma unroll
    for (int j = 0; j < 4; ++j) { const int n = (lane >> 3) + 8 * j; const LAS float* s = scr + (8 * c) * 33 + n;
        unsigned w0 = 0, w1 = 0;
        w0 = __builtin_amdgcn_cvt_pk_fp8_f32(s[0 * 33], s[1 * 33], w0, false); w0 = __builtin_amdgcn_cvt_pk_fp8_f32(s[2 * 33], s[3 * 33], w0, true);
        w1 = __builtin_amdgcn_cvt_pk_fp8_f32(s[4 * 33], s[5 * 33], w1, false); w1 = __builtin_amdgcn_cvt_pk_fp8_f32(s[6 * 33], s[7 * 33], w1, true);
        *(GAS v2u*)(WT + (size_t)(dest_row0 + n) * K + k0 + 8 * c) = (v2u){w0, w1}; }
    LDS_WAIT(); asm volatile("" ::: "memory");
}

struct ProIn { const float *hy_w_in, *at_w_in, *w_out, *w_mem_kv; };
__device__ __forceinline__ void phase_weights(const ProIn& P, unsigned char* ws, LAS unsigned char* lds, int gw, int NGW, int wave, int lane) {
    LAS float* scr = (LAS float*)(lds + wave * 16384);
    constexpr int I_HY = 16 * 80, I_AT = 16 * 48, I_OUT = 16 * 32, I_MKV = 16 * 16;
    constexpr int E0 = 2 * I_HY, E1 = E0 + 2 * I_AT, E2 = E1 + 4 * I_OUT, E3 = E2 + 4 * I_MKV;
    for (int it = gw; it < E3; it += NGW) {
        int r = it;
        if (r < E0) { const int j = r / I_HY, q = r % I_HY, kb = q / 80, nb = q % 80;
            transpose_item(P.hy_w_in + (size_t)j * DM * D_IN_HY, DM, D_IN_HY, (bf16*)(ws + WS_WHY) + (size_t)j * D_IN_HY * DM, 64 * kb, 32 * nb, 32 * nb, scr, lane); continue; }
        r -= E0;
        if (r < 2 * I_AT) { const int j = r / I_AT, q = r % I_AT, kb = q / 48, nb = q % 48;
            const int n0 = 32 * nb, o = n0 & 255;
            transpose_item(P.at_w_in + (size_t)j * DM * D_IN_AT, DM, D_IN_AT, (bf16*)(ws + WS_WAT) + (size_t)j * D_IN_AT * DM, 64 * kb, n0, (n0 & ~255) + 128 * ((o & 63) >> 5) + 32 * (o >> 6), scr, lane); continue; }
        r -= 2 * I_AT;
        if (r < 4 * I_OUT) { const int j = r / I_OUT, q = r % I_OUT, kb = q / 32, nb = q % 32;
            transpose_item(P.w_out + (size_t)j * DM * DM, DM, DM, (bf16*)(ws + WS_WOUT) + (size_t)j * DM * DM, 64 * kb, 32 * nb, 32 * nb, scr, lane); continue; }
        r -= 4 * I_OUT;
        { const int j = r / I_MKV, q = r % I_MKV, kb = q / 16, nb = q % 16;
            transpose_item(P.w_mem_kv + (size_t)j * DM * 512, DM, 512, (bf16*)(ws + WS_WMKV), 64 * kb, 32 * nb, j * 512 + 32 * nb, scr, lane); }
        (void)r;
    }
}

struct XwIn { const float *w_gate, *w_up, *w_down; unsigned char* ws; };
constexpr int XW_PER_EXPERT = 3 * 384, XW_PER_LAYER = NEXP * XW_PER_EXPERT;
constexpr int XW_QA_HY = 5, XW_QA_AT = 4, XW_QB = 3, XW_NA = 128 * NWAVES, XW_NB = 224 * NWAVES;
__host__ __device__ constexpr int xw_qa(int layer) { return (layer & 1) ? XW_QA_AT : XW_QA_HY; }
__host__ __device__ constexpr int xw_p0(int layer, bool sched) { return sched ? XW_PER_LAYER - xw_qa(layer) * XW_NA - XW_QB * XW_NB : XW_PER_LAYER; }
__device__ __forceinline__ void xw_item(const XwIn& B, int layer, int r, LAS float* scr, int lane) {
    const int j = layer * NEXP + r / XW_PER_EXPERT, q = r % XW_PER_EXPERT, kind = q / 384, qq = q % 384;
    if (kind < 2) { const int kb = qq / 24, nb = qq % 24, n0 = 32 * nb;
        transpose_item8((kind == 0 ? B.w_gate : B.w_up) + (size_t)j * DM * EFF, DM, EFF, B.ws + WS_W1 + (size_t)j * 1536 * DM, 64 * kb, n0, (n0 >> 7) * 256 + 128 * kind + (n0 & 127), W8_SCALE, scr, lane); }
    else { const int kb = qq / 32, nb = qq % 32;
        transpose_item8(B.w_down + (size_t)j * EFF * DM, EFF, DM, B.ws + WS_W2 + (size_t)j * DM * EFF, 64 * kb, 32 * nb, 32 * nb, W8_SCALE, scr, lane); }
}
__device__ __forceinline__ void phase_xw_p0(const XwIn& B, bool sched, LAS float* scr, int gw, int NGW, int lane) {
#pragma unroll 1
    for (int layer = 0; layer < DEPTH; ++layer) { const int n = xw_p0(layer, sched);
#pragma unroll 1
        for (int r = gw; r < n; r += NGW) xw_item(B, layer, r, scr, lane); }
}
__device__ __forceinline__ void xw_slice_a(const XwIn& B, int layer, LAS float* scr, int bx, int wave, int lane) {
    const int base = xw_p0(layer, true) + (bx - 128) * NWAVES + wave;
#pragma unroll 1
    for (int k = 0; k < xw_qa(layer); ++k) xw_item(B, layer, base + k * XW_NA, scr, lane);
}
__device__ __forceinline__ void xw_slice_b(const XwIn& B, int layer, LAS float* scr, int bx, int wave, int lane) {
    const int base = xw_p0(layer, true) + xw_qa(layer) * XW_NA + (bx - 32) * NWAVES + wave;
#pragma unroll 1
    for (int k = 0; k < XW_QB; ++k) xw_item(B, layer, base + k * XW_NB, scr, lane);
}

__device__ __forceinline__ void phase_wrg(const float* ffn_g, const float* router, float* WRG, int gtid, int nthreads) {
    for (int q = gtid; q < DEPTH * NEXP * DM; q += nthreads) { const int l = q / (NEXP * DM), e = (q / DM) % NEXP, d = q % DM; WRG[q] = ffn_g[l * DM + d] * router[((size_t)l * DM + d) * NEXP + e]; }
}

__device__ __forceinline__ void rms_row_bf16(const float* xrow, const float* g, bf16* orow, int lane) {
    const GAS f32x4* xr = (const GAS f32x4*)xrow + lane; const GAS f32x4* gr = (const GAS f32x4*)g + lane;
    f32x4 v[4]; float s = 0.f;
#pragma unroll
    for (int j = 0; j < 4; ++j) { v[j] = xr[64 * j]; s += (v[j].x * v[j].x + v[j].y * v[j].y) + (v[j].z * v[j].z + v[j].w * v[j].w); }
    const float rstd = 1.f / sqrtf(wave_sum(s) * (1.f / DM) + NORM_EPS);
    GAS v2u* o8 = (GAS v2u*)orow + lane;
#pragma unroll
    for (int j = 0; j < 4; ++j) { const f32x4 gg = gr[64 * j]; v2u w; w.x = pk2(v[j].x * rstd * gg.x, v[j].y * rstd * gg.y); w.y = pk2(v[j].z * rstd * gg.z, v[j].w * rstd * gg.w); o8[64 * j] = w; }
}

__device__ __forceinline__ void phase_mem_h2(const float* mem, const float* mem_g, const float* fw1, const float* fb1, const float* fw2, const float* fb2, const float* ffreq,
                                              unsigned char* ws, int gw, int NGW, int lane) {
    for (int m = gw; m < BATCH * MEM_LEN; m += NGW) rms_row_bf16(mem + (size_t)m * DM, mem_g, (bf16*)(ws + WS_MEMN) + (size_t)m * DM, lane);
    float* H2 = (float*)(ws + WS_H2);
    for (int it = gw; it < 2 * SEQ; it += NGW) {
        const int j = it / SEQ, n = it % SEQ;
        const float* w1 = fw1 + j * HY_EMB * HY_FILT; const float* w2 = fw2 + j * HY_FILT * HY_FILT;
        const float t = (float)n * (1.0f / (float)(SEQ - 1));
        const float w = (6.283185307179586f * (float)n) / (float)SEQ;
        float feat = 0.f;
        if (lane == 0) feat = t;
        else if (lane <= 16) { const float band = 1e-4f + (float)(lane - 1) * ((15.0f - 1e-4f) / 15.0f); feat = cosf(band * w); }
        else if (lane <= 32) { const float band = 1e-4f + (float)(lane - 17) * ((15.0f - 1e-4f) / 15.0f); feat = -sinf(band * w); }
        const float fr = ffreq[j * HY_FILT + lane];
        float a = fb1[j * HY_FILT + lane];
        for (int i = 0; i < HY_EMB; ++i) a += __shfl(feat, i) * w1[i * HY_FILT + lane];
        const float h1 = sinf(fr * a);
        float a2 = fb2[j * HY_FILT + lane];
        for (int i = 0; i < HY_FILT; ++i) a2 += __shfl(h1, i) * w2[i * HY_FILT + lane];
        H2[(size_t)it * HY_FILT + lane] = sinf(fr * a2);
    }
}

template <bool COMBINE, bool FINAL>
__device__ __forceinline__ void phase_norm(const float* hin, float* hout, const float* g, bf16* U, float* fout, const int* POS, const bf16* Y, int gw, int NGW, int lane) {
    int m = gw;
    if (m >= M_TOK) return;
    f32x4 cur[4]; int cpos = -1;
    { const GAS f32x4* xr = (const GAS f32x4*)(hin + (size_t)m * DM) + lane;
#pragma unroll
      for (int j = 0; j < 4; ++j) cur[j] = xr[64 * j];
      if (COMBINE) { const int b = m / SEQ, t = m % SEQ; if (lane < NEXP) cpos = POS[(size_t)(b * NEXP + lane) * SEQ + t]; } }
#pragma unroll 1
    for (; m < M_TOK; m += NGW) {
        const int mn = m + NGW; f32x4 nxt[4]; int npos = -1;
#pragma unroll
        for (int j = 0; j < 4; ++j) nxt[j] = cur[j];
        if (mn < M_TOK) { const GAS f32x4* xr = (const GAS f32x4*)(hin + (size_t)mn * DM) + lane;
#pragma unroll
            for (int j = 0; j < 4; ++j) nxt[j] = xr[64 * j];
            if (COMBINE) { const int b = mn / SEQ, t = mn % SEQ; if (lane < NEXP) npos = POS[(size_t)(b * NEXP + lane) * SEQ + t]; } }
        f32x4 v[4];
#pragma unroll
        for (int j = 0; j < 4; ++j) v[j] = cur[j];
        if (COMBINE) {
            const int b = m / SEQ;
            unsigned long long mask = __ballot(cpos >= 0);
            while (mask) {
                v2u y[4][4]; bool has[4];
#pragma unroll
                for (int k = 0; k < 4; ++k) { has[k] = mask != 0ull;
                    if (has[k]) { const int e = __builtin_amdgcn_readfirstlane(__builtin_ctzll(mask)); mask &= mask - 1ull; const int p = __builtin_amdgcn_readlane(cpos, e);
                        const GAS v2u* yr = (const GAS v2u*)(Y + ((size_t)(b * NEXP + e) * CAP + p) * DM) + lane;
#pragma unroll
                        for (int j = 0; j < 4; ++j) y[k][j] = yr[64 * j]; } }
#pragma unroll
                for (int k = 0; k < 4; ++k) if (has[k]) {
#pragma unroll
                    for (int j = 0; j < 4; ++j) { const v2u w = y[k][j]; v[j].x += bflo(w.x); v[j].y += bfhi(w.x); v[j].z += bflo(w.y); v[j].w += bfhi(w.y); } }
            }
            if (!FINAL) { GAS f32x4* ho = (GAS f32x4*)(hout + (size_t)m * DM) + lane;
#pragma unroll
                for (int j = 0; j < 4; ++j) ho[64 * j] = v[j]; }
        }
        float s = 0.f;
#pragma unroll
        for (int j = 0; j < 4; ++j) s += (v[j].x * v[j].x + v[j].y * v[j].y) + (v[j].z * v[j].z + v[j].w * v[j].w);
        const float rstd = 1.f / sqrtf(wave_sum(s) * (1.f / DM) + NORM_EPS);
        const GAS f32x4* gr = (const GAS f32x4*)g + lane;
        if (FINAL) { GAS f32x4* o = (GAS f32x4*)(fout + (size_t)m * DM) + lane;
#pragma unroll
            for (int j = 0; j < 4; ++j) o[64 * j] = v[j] * rstd * gr[64 * j]; }
        else { GAS v2u* o8 = (GAS v2u*)(U + (size_t)m * DM) + lane;
#pragma unroll
            for (int j = 0; j < 4; ++j) { const f32x4 gg = gr[64 * j]; v2u w; w.x = pk2(v[j].x * rstd * gg.x, v[j].y * rstd * gg.y); w.y = pk2(v[j].z * rstd * gg.z, v[j].w * rstd * gg.w); o8[64 * j] = w; } }
#pragma unroll
        for (int j = 0; j < 4; ++j) cur[j] = nxt[j];
        cpos = npos;
    }
}

__device__ __forceinline__ void phase_ffn_norm_router(const float* H, const float* g, const float* Wr, unsigned char* XN8, float* AFF, LAS unsigned char* lds, int gw, int NGW, int lane, int tid) {
    LAS f32x4* WL = (LAS f32x4*)lds;
    for (int q = tid; q < 64 * 64; q += NTHREADS) { const int ln = q & 63, s = q >> 6, e4 = s & 3, ji = s >> 2, i = ji & 3, j = ji >> 2; const int d = 4 * ln + i + 256 * j;
        WL[q] = *(const GAS f32x4*)(Wr + (size_t)d * NEXP + 4 * e4); }
    __syncthreads();
    constexpr int R = 4;
    const GAS f32x4* gr = (const GAS f32x4*)g + lane;
#pragma unroll 1
    for (int m0 = gw * R; m0 < M_TOK; m0 += NGW * R) {
        int lo_ = lane; asm volatile("" : "+v"(lo_));
        f32x4 v[R][4]; float rstd[R];
#pragma unroll
        for (int r = 0; r < R; ++r) { const GAS f32x4* xr = (const GAS f32x4*)(H + (size_t)(m0 + r) * DM) + lane;
#pragma unroll
            for (int j = 0; j < 4; ++j) v[r][j] = xr[64 * j]; }
#pragma unroll
        for (int r = 0; r < R; ++r) { float s = 0.f;
#pragma unroll
            for (int j = 0; j < 4; ++j) s += (v[r][j].x * v[r][j].x + v[r][j].y * v[r][j].y) + (v[r][j].z * v[r][j].z + v[r][j].w * v[r][j].w);
            rstd[r] = 1.f / sqrtf(wave_sum(s) * (1.f / DM) + NORM_EPS); }
        f32x4 lg[R][4];
#pragma unroll
        for (int r = 0; r < R; ++r)
#pragma unroll
            for (int e4 = 0; e4 < 4; ++e4) lg[r][e4] = (f32x4){0.f, 0.f, 0.f, 0.f};
#pragma unroll
        for (int j = 0; j < 4; ++j) { const f32x4 gg = gr[64 * j];
#pragma unroll
            for (int r = 0; r < R; ++r) { v[r][j] = v[r][j] * rstd[r] * gg;
                unsigned w = 0; w = __builtin_amdgcn_cvt_pk_fp8_f32(v[r][j].x, v[r][j].y, w, false); w = __builtin_amdgcn_cvt_pk_fp8_f32(v[r][j].z, v[r][j].w, w, true);
                ((GAS unsigned*)(XN8 + (size_t)(m0 + r) * DM) + lane)[64 * j] = w; }
#pragma unroll
            for (int i = 0; i < 4; ++i)
#pragma unroll
                for (int e4 = 0; e4 < 4; ++e4) { const f32x4 wv = WL[((j * 4 + i) * 4 + e4) * 64 + lo_];
#pragma unroll
                    for (int r = 0; r < R; ++r) { const float xs = v[r][j][i];
#pragma unroll
                        for (int c = 0; c < 4; ++c) asm("v_fmac_f32 %0, %1, %2" : "+v"(lg[r][e4][c]) : "v"(wv[c]), "v"(xs)); } }
            __builtin_amdgcn_sched_barrier(0); }
#pragma unroll
        for (int r = 0; r < R; ++r) {
            float l16[16];
#pragma unroll
            for (int e = 0; e < 16; ++e) l16[e] = wave_sum(lg[r][e >> 2][e & 3]);
            float mx = l16[0];
#pragma unroll
            for (int e = 1; e < 16; ++e) mx = fmaxf(mx, l16[e]);
            float den = 0.f;
#pragma unroll
            for (int e = 0; e < 16; ++e) { l16[e] = expf(l16[e] - mx); den += l16[e]; }
            float mine = 0.f;
#pragma unroll
            for (int e = 0; e < 16; ++e) mine = (lane == e) ? l16[e] : mine;
            const int m = m0 + r, b = m / SEQ, t = m % SEQ;
            if (lane < NEXP) AFF[(size_t)(b * NEXP + lane) * SEQ + t] = mine / den;
        }
    }
    __syncthreads();
}

__device__ __forceinline__ void phase_router_sum(const float* PLG, const float* PSS, float* RSTD, float* AFF, int gw, int NGW, int lane) {
    const int e = lane & 15, rq = lane >> 4;
    for (int m0 = gw * 4; m0 < M_TOK; m0 += NGW * 4) {
        const int m = m0 + rq;
        float lgt = 0.f;
#pragma unroll
        for (int slot = 0; slot < 16; ++slot) lgt += PLG[((size_t)slot * M_TOK + m) * 16 + e];
        float ss = PSS[(size_t)e * M_TOK + m];
#pragma unroll
        for (int o = 1; o < 16; o <<= 1) ss += __shfl_xor(ss, o);
        const float rstd = 1.f / sqrtf(ss * (1.f / DM) + NORM_EPS);
        lgt *= rstd;
        float mx = lgt;
#pragma unroll
        for (int o = 1; o < 16; o <<= 1) mx = fmaxf(mx, __shfl_xor(mx, o));
        const float ex = expf(lgt - mx); float den = ex;
#pragma unroll
        for (int o = 1; o < 16; o <<= 1) den += __shfl_xor(den, o);
        const int b = m / SEQ, t = m % SEQ;
        AFF[(size_t)(b * NEXP + e) * SEQ + t] = ex / den;
        if (e == 0) RSTD[m] = rstd;
    }
}

__device__ __forceinline__ int block_excl_scan(int v, LAS int* scr, int tid, int lane, int wave, int* tot) {
    int inc = v;
#pragma unroll
    for (int o = 1; o < 64; o <<= 1) { const int n = __shfl_up(inc, o); if (lane >= o) inc += n; }
    __syncthreads();
    if (lane == 63) scr[wave] = inc;
    __syncthreads();
    int base = 0, total = 0;
#pragma unroll
    for (int w = 0; w < NWAVES; ++w) { const int c = scr[w]; if (w < wave) base += c; total += c; }
    *tot = total;
    return base + inc - v;
}

__device__ __forceinline__ void phase_topk(const float* AFF, const float* RSTD, float* RS, int* IDX, float* GATE, int* POS, LAS unsigned char* ldsm, int blk, int nblk, int tid, int lane, int wave) {
    LAS int* hist = (LAS int*)ldsm;
    LAS int* sel = (LAS int*)(ldsm + 1024);
    LAS int* scr = (LAS int*)(ldsm + 1280);
    for (int g = blk; g < NGRP; g += nblk) {
        unsigned v[16];
        { const GAS v4u* src = (const GAS v4u*)(AFF + (size_t)g * SEQ) + tid * 4;
#pragma unroll
          for (int q = 0; q < 4; ++q) { const v4u w = src[q]; v[4 * q] = w.x; v[4 * q + 1] = w.y; v[4 * q + 2] = w.z; v[4 * q + 3] = w.w; } }
        unsigned prefix = 0u; int krem = CAP;
#pragma unroll 1
        for (int pass = 0; pass < 4; ++pass) {
            const int shift = 24 - 8 * pass;
            const unsigned himask = (pass == 0) ? 0u : (0xffffffffu << (shift + 8));
            __syncthreads();
            if (tid < 256) hist[tid] = 0;
            __syncthreads();
#pragma unroll
            for (int i = 0; i < 16; ++i) if ((v[i] & himask) == prefix) __hip_atomic_fetch_add(hist + ((v[i] >> shift) & 255u), 1, __ATOMIC_RELAXED, __HIP_MEMORY_SCOPE_WORKGROUP);
            __syncthreads();
            if (wave == 0) {
                int c[4]; int s = 0;
#pragma unroll
                for (int j = 0; j < 4; ++j) { c[j] = hist[255 - 4 * lane - j]; s += c[j]; }
                int inc = s;
#pragma unroll
                for (int o = 1; o < 64; o <<= 1) { const int n = __shfl_up(inc, o); if (lane >= o) inc += n; }
                int before = inc - s;
                if (before < krem && krem <= inc) {
                    int bin = 0, kk = krem - before; bool done = false;
#pragma unroll
                    for (int j = 0; j < 4; ++j) { if (!done) { if (kk <= c[j]) { bin = 255 - 4 * lane - j; done = true; } else kk -= c[j]; } }
                    sel[0] = bin; sel[1] = kk;
                }
            }
            __syncthreads();
            prefix |= ((unsigned)sel[0]) << shift; krem = sel[1];
        }
        int ceq = 0;
#pragma unroll
        for (int i = 0; i < 16; ++i) ceq += (v[i] == prefix) ? 1 : 0;
        int tot;
        int eqrank = block_excl_scan(ceq, scr, tid, lane, wave, &tot);
        int csel = 0; unsigned selmask = 0u;
#pragma unroll
        for (int i = 0; i < 16; ++i) { bool s = v[i] > prefix; if (v[i] == prefix) { s = eqrank < krem; ++eqrank; } if (s) { selmask |= 1u << i; ++csel; } }
        int slot = block_excl_scan(csel, scr, tid, lane, wave, &tot);
        const int b = g / NEXP;
        int pv[16];
#pragma unroll
        for (int i = 0; i < 16; ++i) {
            pv[i] = -1;
            if (selmask & (1u << i)) { pv[i] = slot; IDX[g * CAP + slot] = b * SEQ + tid * 16 + i; GATE[g * CAP + slot] = __builtin_bit_cast(float, v[i]); RS[g * CAP + slot] = RSTD[b * SEQ + tid * 16 + i]; ++slot; }
        }
        { GAS v4u* dst = (GAS v4u*)(POS + (size_t)g * SEQ) + tid * 4;
#pragma unroll
          for (int q = 0; q < 4; ++q) { v4u w; w.x = (unsigned)pv[4 * q]; w.y = (unsigned)pv[4 * q + 1]; w.z = (unsigned)pv[4 * q + 2]; w.w = (unsigned)pv[4 * q + 3]; dst[q] = w; } }
        __syncthreads();
    }
}

__device__ __forceinline__ void phase_gather(const bf16* XN, const int* IDX, bf16* XG, int gw, int NGW, int lane) {
    for (int r = gw; r < XROWS; r += NGW) {
        const int src = __builtin_amdgcn_readfirstlane(IDX[r]);
        const GAS v4u* s = (const GAS v4u*)(XN + (size_t)src * DM) + lane; GAS v4u* d = (GAS v4u*)(XG + (size_t)r * DM) + lane;
        const v4u a = s[0], b = s[64]; d[0] = a; d[64] = b;
    }
}

__device__ __forceinline__ void phase_qk_rope(bf16* P, const float* gq, const float* gk, int gw, int NGW, int lane) {
    const int hh = lane >> 2, part = lane & 3, axis = part >> 1, half = part & 1;
    const float* g = (hh < NQH ? gq : gk) + 16 * part;
    float gv[16], inv[16];
#pragma unroll
    for (int i = 0; i < 16; ++i) { gv[i] = g[i]; inv[i] = exp2f(-(float)i * (13.287712379549449f / 16.0f)); }
    const float osc = hh < NQH ? ATT_C2 : 1.0f;
    int m = gw; v4u c0 = (v4u){0u, 0u, 0u, 0u}, c1 = c0;
    if (m < M_TOK) { const GAS v4u* p = (const GAS v4u*)(P + (size_t)m * D_IN_AT + hh * HD + 16 * part); c0 = p[0]; c1 = p[1]; }
#pragma unroll 1
    for (; m < M_TOK; m += NGW) {
        const int t = m % SEQ; const float pos = (float)(axis == 0 ? (t >> 6) : (t & 63));
        GAS v4u* p = (GAS v4u*)(P + (size_t)m * D_IN_AT + hh * HD + 16 * part);
        const v4u w0 = c0, w1 = c1;
        if (m + NGW < M_TOK) { const GAS v4u* pn = (const GAS v4u*)(P + (size_t)(m + NGW) * D_IN_AT + hh * HD + 16 * part); c0 = pn[0]; c1 = pn[1]; }
        float x[16];
        x[0] = bflo(w0.x); x[1] = bfhi(w0.x); x[2] = bflo(w0.y); x[3] = bfhi(w0.y); x[4] = bflo(w0.z); x[5] = bfhi(w0.z); x[6] = bflo(w0.w); x[7] = bfhi(w0.w);
        x[8] = bflo(w1.x); x[9] = bfhi(w1.x); x[10] = bflo(w1.y); x[11] = bfhi(w1.y); x[12] = bflo(w1.z); x[13] = bfhi(w1.z); x[14] = bflo(w1.w); x[15] = bfhi(w1.w);
        float ss = 0.f;
#pragma unroll
        for (int i = 0; i < 16; ++i) ss += x[i] * x[i];
        ss += __shfl_xor(ss, 1); ss += __shfl_xor(ss, 2);
        const float rstd = 1.f / sqrtf(ss * (1.f / HD) + NORM_EPS);
        float o[16];
#pragma unroll
        for (int i = 0; i < 16; ++i) {
            const float xn = x[i] * rstd * gv[i]; const float xp = __shfl_xor(xn, 1);
            float sn, cs; sincosf(pos * inv[i], &sn, &cs);
            o[i] = (half == 0 ? (xn * cs - xp * sn) : (xp * sn + xn * cs)) * osc;
        }
        v4u r0, r1;
        r0.x = pk2(o[0], o[1]); r0.y = pk2(o[2], o[3]); r0.z = pk2(o[4], o[5]); r0.w = pk2(o[6], o[7]);
        r1.x = pk2(o[8], o[9]); r1.y = pk2(o[10], o[11]); r1.z = pk2(o[12], o[13]); r1.w = pk2(o[14], o[15]);
        p[0] = r0; p[1] = r1;
    }
}

__device__ __forceinline__ void phase_transpose_mix(const bf16* MIXT, bf16* MIX, int blk, int nblk, int tid) {
    for (int it = blk; it < (D_MAIN / 64) * (M_TOK / NTHREADS); it += nblk) {
        const int cb = it % (D_MAIN / 64), mb = it / (D_MAIN / 64); const int m = mb * NTHREADS + tid, c0 = cb * 64;
        unsigned w[32];
#pragma unroll
        for (int c = 0; c < 32; ++c) { const unsigned lo = MIXT[(size_t)(c0 + 2 * c) * M_TOK + m], hi = MIXT[(size_t)(c0 + 2 * c + 1) * M_TOK + m]; w[c] = lo | (hi << 16); }
        GAS v4u* d = (GAS v4u*)(MIX + (size_t)m * DM + c0);
#pragma unroll
        for (int q = 0; q < 8; ++q) { v4u o; o.x = w[4 * q]; o.y = w[4 * q + 1]; o.z = w[4 * q + 2]; o.w = w[4 * q + 3]; d[q] = o; }
    }
}
__device__ __forceinline__ void phase_taps(const float* H2j, const float* w3, bf16* TAPS, int gw, int NGW, int lane) {
    typedef float f32x16 __attribute__((ext_vector_type(16))); typedef short bf16x8_t __attribute__((ext_vector_type(8)));
    const float min_decay = -4.605170185988091f / 1.5f, max_decay = -4.605170185988091f / 0.3f;
    const int li = lane & 31, hi = lane >> 5;
#pragma unroll 1
    for (int it = gw; it < (FCOLS / 32) * (SEQ / 128); it += NGW) {
        const int ct = it % (FCOLS / 32), ng = it / (FCOLS / 32), col0 = ct * 32;
        bf16x8_t a[4];
#pragma unroll
        for (int s = 0; s < 4; ++s) { float t[8];
#pragma unroll
            for (int j = 0; j < 8; ++j) t[j] = w3[(size_t)(16 * s + 8 * hi + j) * FCOLS + col0 + li];
            v4u p; p.x = pk2(t[0], t[1]); p.y = pk2(t[2], t[3]); p.z = pk2(t[4], t[5]); p.w = pk2(t[6], t[7]); a[s] = __builtin_bit_cast(bf16x8_t, p); }
        f32x4 hv[4][8];
#pragma unroll
        for (int nt = 0; nt < 4; ++nt) { const GAS f32x4* hp = (const GAS f32x4*)(H2j + (size_t)(ng * 128 + nt * 32 + li) * HY_FILT + 8 * hi);
#pragma unroll
            for (int s = 0; s < 4; ++s) { hv[nt][2 * s] = hp[4 * s]; hv[nt][2 * s + 1] = hp[4 * s + 1]; } }
#pragma unroll
        for (int nt = 0; nt < 4; ++nt) {
            const int n0 = ng * 128 + nt * 32;
            f32x16 acc;
#pragma unroll
            for (int r = 0; r < 16; ++r) acc[r] = 0.f;
#pragma unroll
            for (int s = 0; s < 4; ++s) { const f32x4 v0 = hv[nt][2 * s], v1 = hv[nt][2 * s + 1];
                v4u p; p.x = pk2(v0.x, v0.y); p.y = pk2(v0.z, v0.w); p.z = pk2(v1.x, v1.y); p.w = pk2(v1.z, v1.w);
                acc = __builtin_amdgcn_mfma_f32_32x32x16_bf16(a[s], __builtin_bit_cast(bf16x8_t, p), acc, 0, 0, 0); }
            const float t = (float)(n0 + li) * (1.0f / (float)(SEQ - 1));
#pragma unroll
            for (int r = 0; r < 16; ++r) { const int col = col0 + (r & 3) + 8 * (r >> 2) + 4 * hi, c = col % D_MAIN;
                const float ad = fabsf(min_decay + (float)c * ((max_decay - min_decay) / (float)(D_MAIN - 1)));
                TAPS[(size_t)col * SEQ + n0 + li] = (bf16)f2bf(acc[r] * expf(-t * ad)); }
        }
    }
}

__device__ __forceinline__ constexpr float twc(int k) { constexpr float T[16] = {1.0f, 0.98078528040323043f, 0.92387953251128674f, 0.83146961230254524f, 0.70710678118654757f, 0.55557023301960218f, 0.38268343236508978f, 0.19509032201612825f,
    0.0f, -0.19509032201612825f, -0.38268343236508978f, -0.55557023301960218f, -0.70710678118654757f, -0.83146961230254524f, -0.92387953251128674f, -0.98078528040323043f}; return T[k]; }
__device__ __forceinline__ constexpr float tws(int k) { constexpr float T[16] = {0.0f, 0.19509032201612825f, 0.38268343236508978f, 0.55557023301960218f, 0.70710678118654757f, 0.83146961230254524f, 0.92387953251128674f, 0.98078528040323043f,
    1.0f, 0.98078528040323043f, 0.92387953251128674f, 0.83146961230254524f, 0.70710678118654757f, 0.55557023301960218f, 0.38268343236508978f, 0.19509032201612825f}; return T[k]; }
__device__ __forceinline__ constexpr int bitrev(int i, int bits) { int r = 0; for (int b = 0; b < bits; ++b) if (i & (1 << b)) r |= 1 << (bits - 1 - b); return r; }

template <int N, int LEN> struct FftStage {
    static __device__ __forceinline__ void run(float (&re)[N], float (&im)[N]) {
        constexpr int half = LEN / 2, step = 32 / LEN;
#pragma unroll
        for (int base = 0; base < N; base += LEN)
#pragma unroll
            for (int j = 0; j < half; ++j) {
                const int i0 = base + j, i1 = i0 + half, idx = j * step;
                const float ar = re[i0], ai = im[i0], br = re[i1], bi = im[i1];
                re[i0] = ar + br; im[i0] = ai + bi;
                const float dr = ar - br, di = ai - bi;
                if (idx == 0) { re[i1] = dr; im[i1] = di; }
                else if (idx == 8) { re[i1] = di; im[i1] = -dr; }
                else { const float c = twc(idx), s = tws(idx); re[i1] = dr * c + di * s; im[i1] = di * c - dr * s; }
            }
        if constexpr (LEN > 2) FftStage<N, LEN / 2>::run(re, im);
    }
};
template <int N, int BITS> __device__ __forceinline__ void fft_reg(float (&re)[N], float (&im)[N]) {
    FftStage<N, N>::run(re, im);
    float tr[N], ti[N];
#pragma unroll
    for (int i = 0; i < N; ++i) { tr[bitrev(i, BITS)] = re[i]; ti[bitrev(i, BITS)] = im[i]; }
#pragma unroll
    for (int i = 0; i < N; ++i) { re[i] = tr[i]; im[i] = ti[i]; }
}

__device__ __forceinline__ void fft16k(float (&re)[32], float (&im)[32], LAS f32x2* L, int tid_in) {
    int tid = tid_in; asm volatile("" : "+v"(tid));
    fft_reg<32, 5>(re, im);
#pragma unroll
    for (int k1 = 1; k1 < 32; ++k1) { const float fr = (float)((tid * k1) & 16383) * (1.0f / 16384.0f); const float c = __builtin_amdgcn_cosf(fr), s = __builtin_amdgcn_sinf(fr);
        const float r = re[k1], i = im[k1]; re[k1] = r * c + i * s; im[k1] = i * c - r * s; if ((k1 & 3) == 3) __builtin_amdgcn_sched_barrier(0); }
#pragma unroll
    for (int k1 = 0; k1 < 32; ++k1) L[k1 * 513 + tid] = (f32x2){re[k1], im[k1]};
    __syncthreads();
    const int n3 = tid & 31, ka = tid >> 5;
    float ar[16], ai[16], br[16], bi[16];
#pragma unroll
    for (int n2 = 0; n2 < 16; ++n2) { const f32x2 a = L[ka * 513 + n2 * 32 + n3], b = L[(ka + 16) * 513 + n2 * 32 + n3]; ar[n2] = a.x; ai[n2] = a.y; br[n2] = b.x; bi[n2] = b.y; }
    fft_reg<16, 4>(ar, ai); fft_reg<16, 4>(br, bi);
#pragma unroll
    for (int k2 = 1; k2 < 16; ++k2) { const float fr = (float)((n3 * k2) & 511) * (1.0f / 512.0f); const float c = __builtin_amdgcn_cosf(fr), s = __builtin_amdgcn_sinf(fr);
        float r = ar[k2], i = ai[k2]; ar[k2] = r * c + i * s; ai[k2] = i * c - r * s;
        r = br[k2]; i = bi[k2]; br[k2] = r * c + i * s; bi[k2] = i * c - r * s; if ((k2 & 3) == 3) __builtin_amdgcn_sched_barrier(0); }
    __syncthreads();
#pragma unroll
    for (int k2 = 0; k2 < 16; ++k2) { L[n3 * 513 + k2 * 32 + ka] = (f32x2){ar[k2], ai[k2]}; L[n3 * 513 + k2 * 32 + ka + 16] = (f32x2){br[k2], bi[k2]}; }
    __syncthreads();
#pragma unroll
    for (int q = 0; q < 32; ++q) { const f32x2 v = L[q * 513 + tid]; re[q] = v.x; im[q] = v.y; }
    fft_reg<32, 5>(re, im);
}

constexpr int HS_SP = SEQ + 16;
__device__ __forceinline__ void hy_stage(LAS bf16* S, int slot, const bf16* src, int tid) {
    LAS bf16* d = S + slot * HS_SP + 8;
    if (tid == 0) { d[-1] = 0; d[SEQ] = 0; }
#pragma unroll
    for (int q = 0; q < 2; ++q) { const int ch = q * NTHREADS + tid; *(LAS v4u*)(d + ch * 8) = *(const GAS v4u*)(src + ch * 8); }
}
__device__ __forceinline__ float hy_sc(const LAS bf16* S, int slot, int t, float w0, float w1, float w2) {
    const LAS bf16* p = S + slot * HS_SP + 8 + t;
    return bf2f(p[-1]) * w0 + bf2f(p[0]) * w1 + bf2f(p[1]) * w2;
}

__device__ __forceinline__ void phase_hyena_conv(const bf16* PT, const bf16* TAPS, const float* shortw, const float* skip, f32x2* XSall, bf16* MIXT,
                                                 LAS unsigned char* lds, int blk, int nblk, int tid_in, int lane, int wave, int pmode = 0) {
    LAS f32x2* L = (LAS f32x2*)lds; LAS bf16* S = (LAS bf16*)lds; LAS float* red = (LAS float*)(lds + LDS_MISC);
    f32x2* XS = XSall + (size_t)blk * 16384;
    f32x2* ZS = XS + 16384 * 256;
    constexpr int N = 16384;
#pragma unroll 1
    for (int c = blk; c < D_MAIN; c += nblk) {
        const bf16* hf0 = TAPS + (size_t)c * SEQ; const bf16* hb0 = TAPS + (size_t)(D_MAIN + c) * SEQ;
        const bf16* hf1 = TAPS + (size_t)(2 * D_MAIN + c) * SEQ; const bf16* hb1 = TAPS + (size_t)(3 * D_MAIN + c) * SEQ;
        const bf16* px1 = PT + (size_t)c * M_TOK; const bf16* px2 = PT + (size_t)(D_MAIN + c) * M_TOK; const bf16* pv = PT + (size_t)(2 * D_MAIN + c) * M_TOK;
        const float wx1[3] = {shortw[c], shortw[2304 + c], shortw[4608 + c]};
        const float wx2[3] = {shortw[D_MAIN + c], shortw[2304 + D_MAIN + c], shortw[4608 + D_MAIN + c]};
        const float wv[3] = {shortw[2 * D_MAIN + c], shortw[2304 + 2 * D_MAIN + c], shortw[4608 + 2 * D_MAIN + c]};
        const float sk0 = skip[c], sk1 = skip[D_MAIN + c];
        float re[32], im[32];
#pragma unroll 1
        for (int pass = 0; pass < 5; ++pass) {
            int tid = tid_in; asm volatile("" : "+v"(tid));
            if (pass == 0) {
#pragma unroll
                for (int r = 0; r < 16; ++r) { const int n = r * 512 + tid; re[r] = bf2f(hf0[n]); im[r] = bf2f(hf1[n]); }
#pragma unroll
                for (int r = 16; r < 32; ++r) { const int idx = (32 - r) * 512 - tid; const bool z = (idx == SEQ); const int ii = z ? 0 : idx; re[r] = z ? 0.f : bf2f(hb0[ii]); im[r] = z ? 0.f : bf2f(hb1[ii]); }
                float e0 = 0.f, e1 = 0.f;
                if (tid == 0) { e0 = bf2f(hb0[0]); e1 = bf2f(hb1[0]); }
                float s0 = fabsf(e0), s1 = fabsf(e1);
#pragma unroll
                for (int r = 0; r < 32; ++r) { s0 += fabsf(re[r]); s1 += fabsf(im[r]); }
                s0 = wave_sum(s0); s1 = wave_sum(s1);
                __syncthreads();
                if (lane == 0) { red[wave] = s0; red[8 + wave] = s1; }
                __syncthreads();
                float t0 = 0.f, t1 = 0.f;
#pragma unroll
                for (int w = 0; w < NWAVES; ++w) { t0 += red[w]; t1 += red[8 + w]; }
                const float sc0 = 1.0f / (t0 + 1e-6f), sc1 = 1.0f / (t1 + 1e-6f);
                re[0] += e0; im[0] += e1;
#pragma unroll
                for (int r = 0; r < 32; ++r) { re[r] *= sc0; im[r] *= sc1; }
            } else if (pass == 1) {
                __syncthreads();
                hy_stage(S, 0, pv, tid); hy_stage(S, 1, pv + SEQ, tid);
                __syncthreads();
#pragma unroll
                for (int r = 0; r < 16; ++r) { const int t = r * 512 + tid; re[r] = hy_sc(S, 0, t, wv[0], wv[1], wv[2]); im[r] = hy_sc(S, 1, t, wv[0], wv[1], wv[2]); }
#pragma unroll
                for (int r = 16; r < 32; ++r) { re[r] = 0.f; im[r] = 0.f; }
            }
            __syncthreads();
            fft16k(re, im, L, tid);
            if (pass == 0) {
#pragma unroll
                for (int r = 0; r < 32; ++r) XS[r * 512 + tid] = (f32x2){re[r], im[r]};
                __syncthreads();
            } else if (pass == 1 || pass == 3) {
#pragma unroll
                for (int r = 0; r < 32; ++r) {
                    const int f = r * 512 + tid; const f32x2 xa = XS[f], xb = XS[(N - f) & (N - 1)];
                    float kr, ki;
                    if (pass == 1) { kr = xa.x + xb.x; ki = xa.y - xb.y; } else { kr = xa.y + xb.y; ki = xb.x - xa.x; }
                    kr *= (0.5f / (float)N); ki *= (0.5f / (float)N);
                    const float zr_ = re[r], zi_ = im[r];
                    re[r] = zr_ * kr - zi_ * ki; im[r] = -(zr_ * ki + zi_ * kr);
                }
            } else if (pass == 2) {
                __syncthreads();
                hy_stage(S, 0, pv, tid); hy_stage(S, 1, pv + SEQ, tid); hy_stage(S, 2, px1, tid); hy_stage(S, 3, px1 + SEQ, tid);
                __syncthreads();
#pragma unroll
                for (int r = 0; r < 16; ++r) { const int t = r * 512 + tid;
                    const float v0 = hy_sc(S, 0, t, wv[0], wv[1], wv[2]), v1 = hy_sc(S, 1, t, wv[0], wv[1], wv[2]);
                    const float g0 = hy_sc(S, 2, t, wx1[0], wx1[1], wx1[2]), g1 = hy_sc(S, 3, t, wx1[0], wx1[1], wx1[2]);
                    re[r] = g0 * (re[r] + sk0 * v0); im[r] = g1 * (-im[r] + sk0 * v1); ZS[t] = (f32x2){re[r], im[r]}; }
#pragma unroll
                for (int r = 16; r < 32; ++r) { re[r] = 0.f; im[r] = 0.f; }
            } else {
                __syncthreads();
                hy_stage(S, 0, px2, tid); hy_stage(S, 1, px2 + SEQ, tid);
                __syncthreads();
#pragma unroll
                for (int r = 0; r < 16; ++r) { const int t = r * 512 + tid;
                    const float g0 = hy_sc(S, 0, t, wx2[0], wx2[1], wx2[2]), g1 = hy_sc(S, 1, t, wx2[0], wx2[1], wx2[2]);
                    const f32x2 z = ZS[t];
                    const float o0 = g0 * (re[r] + sk1 * z.x), o1 = g1 * (-im[r] + sk1 * z.y);
                    MIXT[(size_t)c * M_TOK + t] = (bf16)f2bf(o0); MIXT[(size_t)c * M_TOK + SEQ + t] = (bf16)f2bf(o1); }
            }
        }
        __syncthreads();
    }
}
#ifndef MK_PER_PHASE
#define MK_PER_PHASE 0
#endif
#ifndef CONV_PMODE
#define CONV_PMODE 0
#endif
#ifndef REPMASK
#define REPMASK 0u
#endif
#define REP(kind) _Pragma("unroll 1") for (int r_ = 0; r_ < 1 + (int)((REPMASK >> (kind)) & 1u); ++r_)
struct Args {
    const float* in[24]; float* out; unsigned char* ws; int ph_lo, ph_hi;
};
constexpr int N_PHASES = 1 + (DEPTH - 1) + DEPTH * 8 - DEPTH / 2 + 1;

template <int QP, int KP>
__device__ __forceinline__ void run_attn(const bf16* Q, const bf16* K, const bf16* V, bf16* O, int NT, char* shm) {
    attn_body::attn_unit<8, QP, KP, DM>((const attn_body::bf16*)Q, (const attn_body::bf16*)K, (const attn_body::bf16*)V, (attn_body::bf16*)O, NT, shm);
}

__global__ void __launch_bounds__(NTHREADS, 2) hybrid_fwd(Args args) {
    extern __shared__ __attribute__((aligned(16))) unsigned char lds_raw[];
    LAS unsigned char* lds = (LAS unsigned char*)lds_raw;
    const int G = gridDim.x, bx = blockIdx.x;
    const int vcu = (G % 8 == 0) ? (bx % 8) * (G / 8) + bx / 8 : bx;
    const int NGW = G * NWAVES;
    unsigned char* ws = args.ws;
    const float* x = args.in[0]; const float* mem = args.in[1]; const float* mix_g = args.in[2]; const float* ffn_g = args.in[3]; const float* mem_g = args.in[4]; const float* fin_g = args.in[5];
    const float* hy_short = args.in[9]; const float* f_w1 = args.in[10]; const float* f_b1 = args.in[11]; const float* f_w2 = args.in[12]; const float* f_b2 = args.in[13];
    const float* f_w3 = args.in[14]; const float* f_freq = args.in[15]; const float* hy_skip = args.in[16]; const float* qg = args.in[18]; const float* kg = args.in[19]; const float* router = args.in[20];
    float* H = args.out;
    bf16* U = (bf16*)(ws + WS_U); bf16* PROJ = (bf16*)(ws + WS_PROJ); bf16* CQ = (bf16*)(ws + WS_CQ); bf16* MIX = (bf16*)(ws + WS_MIX); bf16* MIXT = (bf16*)(ws + WS_MIXT);
    float* AFF = (float*)(ws + WS_AFF); int* IDX = (int*)(ws + WS_IDX); float* GATE = (float*)(ws + WS_GATE); int* POS = (int*)(ws + WS_POS);
    bf16* XG = (bf16*)(ws + WS_XG); bf16* HID = (bf16*)(ws + WS_HID); bf16* Y = (bf16*)(ws + WS_Y); bf16* TAPS = (bf16*)(ws + WS_TAPS);
    const bf16* MKV = (const bf16*)(ws + WS_MKV);
    cg::grid_group grid = cg::this_grid();
    volatile LAS unsigned* bst = (volatile LAS unsigned*)(lds + LDS_MISC + 4096);
    if (threadIdx.x < 2) bst[threadIdx.x] = 0u;
    __syncthreads();
    XcdBarrier xbar = xcd_barrier_post((unsigned*)(ws + WS_CTL) + 1024, bst);
    const int lo = args.ph_lo, hi = args.ph_hi;
    const XwIn XW{args.in[21], args.in[22], args.in[23], ws}; const bool xw_sched = (G == 256);
    int ph = 0;
#define PHASE_BEGIN if (lo <= ph && ph < hi) { const int tid = opaque_tid(), lane = tid & 63, wave = __builtin_amdgcn_readfirstlane(tid >> 6), gw = vcu * NWAVES + wave; (void)lane; (void)gw;
#ifdef EXTRA_XBAR
#define PHASE_END   if (ph + 1 < hi) { if (ph == lo) grid.sync(); else { xcd_barrier(xbar); if (ph < EXTRA_XBAR) xcd_barrier(xbar); } } } ++ph;
#else
#define PHASE_END   if (ph + 1 < hi) { if (ph == lo) grid.sync(); else xcd_barrier(xbar); } } ++ph;
#endif

    PHASE_BEGIN
        ProIn P{args.in[8], args.in[17], args.in[7], args.in[6]};
        REP(0) { phase_weights(P, ws, lds, gw, NGW, wave, lane); phase_xw_p0(XW, xw_sched, (LAS float*)(lds + wave * 16384), gw, NGW, lane); }
        phase_wrg(ffn_g, router, (float*)(ws + WS_WRG), (int)(bx * NTHREADS + tid), (int)(G * NTHREADS));
        REP(1) phase_mem_h2(mem, mem_g, f_w1, f_b1, f_w2, f_b2, f_freq, ws, gw, NGW, lane);
        REP(3) phase_norm<false, false>(x, nullptr, mix_g, U, nullptr, nullptr, nullptr, gw, NGW, lane);
    PHASE_END

#pragma unroll 1
    for (int i = 0; i < DEPTH; ++i) {
        const bool hy = (i & 1) == 0; const int j = i >> 1;
        if (i > 0) {
        PHASE_BEGIN
            phase_norm<true, false>(H, H, mix_g + i * DM, U, nullptr, POS, Y, gw, NGW, lane);
        PHASE_END
        }
        PHASE_BEGIN
            if (i == 0) {
                pg8::Gemm g{(const bf16*)(ws + WS_MEMN), (const bf16*)(ws + WS_WMKV), BATCH * MEM_LEN, 2048, DM, 1 << 30, 1, 0};
                pg8::StaticOrder S; S.init(BATCH * MEM_LEN, 2048, G, bx);
                pg8::EpiRowBf16 E{(bf16*)(ws + WS_MKV), 2048, -1, 1.f};
                pg8::gemm_phase<pg8::EpiRowBf16, pg8::StaticOrder, true, true>(lds, g, S, E);
            }
            if (hy) {
                REP(4) phase_taps((const float*)(ws + WS_H2) + (size_t)j * SEQ * HY_FILT, f_w3 + (size_t)j * HY_FILT * FCOLS, TAPS, gw, NGW, lane);
                pg8::Gemm g{U, (const bf16*)(ws + WS_WHY) + (size_t)j * D_IN_HY * DM, M_TOK, D_IN_HY, DM, 1 << 30, 1, 0};
                pg8::StaticOrder S; S.init(M_TOK, D_IN_HY, G, bx);
                pg8::EpiHyIn E{PROJ, M_TOK, 9, CQ, ATT_C2};
                REP(5) pg8::gemm_phase<pg8::EpiHyIn, pg8::StaticOrder, true, true>(lds, g, S, E);
            } else {
                pg8::Gemm g{U, (const bf16*)(ws + WS_WAT) + (size_t)j * D_IN_AT * DM, M_TOK, D_IN_AT, DM, 1 << 30, 1, 0};
                pg8::StaticOrder S; S.init(M_TOK, D_IN_AT, G, bx);
                pg8::EpiAtIn E{PROJ, D_IN_AT, qg + j * HD, kg + j * HD, ATT_C2, NORM_EPS, SEQ - 1};
                REP(6) pg8::gemm_phase<pg8::EpiAtIn, pg8::StaticOrder, true, true>(lds, g, S, E);
            }
            if (xw_sched && bx >= 128) xw_slice_a(XW, i, (LAS float*)(lds + wave * 16384), bx, wave, lane);
        PHASE_END
        PHASE_BEGIN
            if (hy) {
                REP(8) phase_hyena_conv(PROJ, TAPS, hy_short + (size_t)j * 3 * 2304, hy_skip + (size_t)j * 2 * D_MAIN, (f32x2*)(ws + WS_FFTX), MIXT, lds, bx, G, tid, lane, wave);
                REP(9) for (int u = vcu; u < 256; u += G) { const int b = u >> 7, h4 = (u >> 5) & 3, qb = u & 31; const size_t row = (size_t)b * SEQ + qb * 256;
                    run_attn<256, 2048>(CQ + row * 256 + h4 * HD, MKV + (size_t)b * MEM_LEN * 2048 + i * 512 + h4 * HD, MKV + (size_t)b * MEM_LEN * 2048 + i * 512 + 256 + h4 * HD,
                                        MIX + row * DM + D_MAIN + h4 * HD, MEM_LEN / 64, (char*)lds_raw); }
            } else {
                REP(10) for (int u = vcu; u < 768; u += G) { const int bk = (u & 255) >> 5, qb = u & 31, hs = u >> 8, b = bk >> 2, kvh = bk & 3, h = kvh * 3 + hs; const size_t row = (size_t)b * SEQ + qb * 256;
                    run_attn<D_IN_AT, D_IN_AT>(PROJ + row * D_IN_AT + h * HD, PROJ + (size_t)b * SEQ * D_IN_AT + D_MAIN + kvh * HD, PROJ + (size_t)b * SEQ * D_IN_AT + D_MAIN + 256 + kvh * HD,
                                               MIX + row * DM + h * HD, SEQ / 64, (char*)lds_raw); }
                REP(9) for (int u = vcu; u < 256; u += G) { const int b = u >> 7, h4 = (u >> 5) & 3, qb = u & 31; const size_t row = (size_t)b * SEQ + qb * 256;
                    run_attn<D_IN_AT, 2048>(PROJ + row * D_IN_AT + 1280 + h4 * HD, MKV + (size_t)b * MEM_LEN * 2048 + i * 512 + h4 * HD, MKV + (size_t)b * MEM_LEN * 2048 + i * 512 + 256 + h4 * HD,
                                            MIX + row * DM + D_MAIN + h4 * HD, MEM_LEN / 64, (char*)lds_raw); }
            }
        PHASE_END
        if (hy) {
            PHASE_BEGIN
                REP(11) phase_transpose_mix(MIXT, MIX, bx, G, tid);
            PHASE_END
        }
        PHASE_BEGIN
            pg8::Gemm g{MIX, (const bf16*)(ws + WS_WOUT) + (size_t)i * DM * DM, M_TOK, DM, DM, 1 << 30, 1, 0};
            pg8::StaticOrder S; S.init(M_TOK, DM, G, bx);
            pg8::EpiOutX E{i == 0 ? x : (const float*)H, H, DM, ffn_g + i * DM, (const float*)(ws + WS_WRG) + (size_t)i * NEXP * DM, (unsigned char*)U, (float*)(ws + WS_PART), (float*)(ws + WS_PSS), M_TOK};
            pg8::gemm_phase<pg8::EpiOutX, pg8::StaticOrder, true, true>(lds, g, S, E);
        PHASE_END
        PHASE_BEGIN
            REP(13) phase_router_sum((const float*)(ws + WS_PART), (const float*)(ws + WS_PSS), (float*)(ws + WS_RSTD), AFF, gw, NGW, lane);
        PHASE_END
        PHASE_BEGIN
            REP(14) phase_topk(AFF, (const float*)(ws + WS_RSTD), (float*)(ws + WS_RS), IDX, GATE, POS, lds + LDS_MISC, bx, G, tid, lane, wave);
            if (xw_sched && bx >= 32) xw_slice_b(XW, i, (LAS float*)(lds + wave * 16384), bx, wave, lane);
        PHASE_END
        PHASE_BEGIN
            pg8::Gemm g{U, (const bf16*)(ws + WS_W1 + (size_t)i * NEXP * 1536 * DM), XROWS, 1536, DM / 2, 4, NEXP, (size_t)1536 * DM};
            pg8::StaticOrder S; S.init(XROWS, 1536, G, bx);
            pg8::EpiSwiGLU8 E{(unsigned char*)HID, EFF, 1.0f / W8_SCALE, (const float*)(ws + WS_RS)};
            REP(16) pg8::gemm_phase<pg8::EpiSwiGLU8, pg8::StaticOrder, true, true, true, true>(lds, g, S, E, IDX);
        PHASE_END
        PHASE_BEGIN
            pg8::Gemm g{HID, (const bf16*)(ws + WS_W2 + (size_t)i * NEXP * DM * EFF), XROWS, DM, EFF / 2, 4, NEXP, (size_t)DM * EFF};
            pg8::StaticOrder S; S.init(XROWS, DM, G, bx);
            pg8::EpiDown E{Y, DM, GATE, 1.0f / W8_SCALE};
            REP(17) pg8::gemm_phase<pg8::EpiDown, pg8::StaticOrder, true, true, false, true>(lds, g, S, E);
        PHASE_END
    }
    PHASE_BEGIN
        phase_norm<true, true>(H, nullptr, fin_g, nullptr, args.out, POS, Y, gw, NGW, lane);
    PHASE_END
#undef PHASE_BEGIN
#undef PHASE_END
}

extern "C" void kernel_launch(void* const* d_in, const int* in_sizes, int n_in, void* d_out, int out_size, void* d_ws, size_t ws_size, hipStream_t stream) {
    static int grid = 0;
    if (grid == 0) {
        if (n_in != 24 || out_size != M_TOK * DM || ws_size < WS_END) { fprintf(stderr, "kernel_launch: unexpected shapes (n_in %d out %d ws %zu need %zu)\n", n_in, out_size, ws_size, (size_t)WS_END); grid = -1; return; }
        int dev = 0, cus = 0, per_cu = 0;
        if (hipGetDevice(&dev) != hipSuccess || hipDeviceGetAttribute(&cus, hipDeviceAttributeMultiprocessorCount, dev) != hipSuccess) { grid = -1; return; }
        if (hipFuncSetAttribute((const void*)hybrid_fwd, hipFuncAttributeMaxDynamicSharedMemorySize, LDS_BYTES) != hipSuccess) { fprintf(stderr, "kernel_launch: hipFuncSetAttribute failed\n"); grid = -1; return; }
        if (hipOccupancyMaxActiveBlocksPerMultiprocessor(&per_cu, (const void*)hybrid_fwd, NTHREADS, LDS_BYTES) != hipSuccess || per_cu < 1) { fprintf(stderr, "kernel_launch: occupancy query says %d blocks/CU\n", per_cu); per_cu = 1; }
        (void)hipGetLastError();
        grid = cus;
    }
    if (grid < 0) return;
    if (hipMemsetAsync((char*)d_ws + WS_CTL, 0, 64 * 1024, stream) != hipSuccess) { fprintf(stderr, "kernel_launch: memset failed\n"); return; }
    Args a{};
    for (int i = 0; i < 24; ++i) a.in[i] = (const float*)d_in[i];
    a.out = (float*)d_out; a.ws = (unsigned char*)d_ws;
#if MK_PER_PHASE
    for (int li = 0; li < N_PHASES; ++li) {
        a.ph_lo = li; a.ph_hi = li + 1;
        void* kargs[] = {&a};
        hipError_t e = hipLaunchCooperativeKernel((const void*)hybrid_fwd, dim3(grid), dim3(NTHREADS), kargs, LDS_BYTES, stream);
        if (e != hipSuccess) { fprintf(stderr, "kernel_launch: launch %d failed: %s\n", li, hipGetErrorString(e)); break; }
    }
#else
    a.ph_lo = 0; a.ph_hi = N_PHASES;
    void* kargs[] = {&a};
    hipError_t e = hipLaunchCooperativeKernel((const void*)hybrid_fwd, dim3(grid), dim3(NTHREADS), kargs, LDS_BYTES, stream);
    if (e != hipSuccess) fprintf(stderr, "kernel_launch: cooperative launch failed: %s (grid %d)\n", hipGetErrorString(e), grid);
#endif
}
```

```cpp
#include <hip/hip_runtime.h>
#include <hip/hip_cooperative_groups.h>
#include <hip/hip_bf16.h>
#include <cmath>
#include <cstdio>
#include <cstdint>
namespace cg = cooperative_groups;

constexpr int BATCH = 2, SEQ = 8192, DM = 1024, DEPTH = 4, M_TOK = BATCH * SEQ;
constexpr int HD = 64, MEM_LEN = 256, D_MEM = 256, D_MAIN = 768, NQH = 12, NKVH = 4;
constexpr int D_IN_HY = 2560, D_IN_AT = 1536;
constexpr int NEXP = 16, CAP = 1024, EFF = 768, NGRP = BATCH * NEXP, XROWS = NGRP * CAP;
constexpr int HY_EMB = 33, HY_FILT = 64, FCOLS = 4 * D_MAIN;
constexpr float NORM_EPS = 1e-6f;
constexpr float W8_SCALE = 32.0f;
constexpr float ATT_C2 = 0.125f * 1.4426950408889634f;

constexpr size_t MiB = 1u << 20;
constexpr size_t WS_CTL = 0;
constexpr size_t WS_WHY = 2 * MiB;
constexpr size_t WS_WAT = 12 * MiB;
constexpr size_t WS_WOUT = 18 * MiB;
constexpr size_t WS_WMKV = 26 * MiB;
constexpr size_t WS_W1 = 32 * MiB;
constexpr size_t WS_W2 = 224 * MiB;
constexpr size_t WS_U = 320 * MiB;
constexpr size_t WS_PROJ = 352 * MiB;
constexpr size_t WS_CQ = WS_PROJ + 72 * MiB;
constexpr size_t WS_MIX = 432 * MiB;
constexpr size_t WS_MIXT = 464 * MiB;
constexpr size_t WS_AFF = 488 * MiB;
constexpr size_t WS_IDX = 489 * MiB;
constexpr size_t WS_GATE = WS_IDX + 128 * 1024;
constexpr size_t WS_POS = 490 * MiB;
constexpr size_t WS_XG = 492 * MiB;
constexpr size_t WS_HID = 556 * MiB;
constexpr size_t WS_TAPS = WS_XG;
constexpr size_t WS_Y = 604 * MiB;
constexpr size_t WS_FFTX = WS_Y;
constexpr size_t WS_H2 = 668 * MiB;
constexpr size_t WS_MEMN = 672 * MiB;
constexpr size_t WS_MKV = 673 * MiB;
constexpr size_t WS_PART = 676 * MiB;
constexpr size_t WS_PSS = 692 * MiB;
constexpr size_t WS_RSTD = 697 * MiB;
constexpr size_t WS_RS = WS_RSTD + 128 * 1024;
constexpr size_t WS_WRG = 698 * MiB;
constexpr size_t WS_END = 699 * MiB;

constexpr int LDS_RING = 0;
constexpr int LDS_MISC = 132 * 1024;
constexpr int LDS_BYTES = 140 * 1024;
constexpr int NTHREADS = 512, NWAVES = 8;

#define GAS __attribute__((address_space(1)))
#define LAS __attribute__((address_space(3)))
typedef unsigned short bf16;
typedef unsigned v4u __attribute__((ext_vector_type(4)));
typedef unsigned v2u __attribute__((ext_vector_type(2)));
typedef float f32x4 __attribute__((ext_vector_type(4)));
typedef float f32x2 __attribute__((ext_vector_type(2)));
__device__ __forceinline__ unsigned f2bf(float f) { unsigned u = __builtin_bit_cast(unsigned, f); return (u + 0x7fffu + ((u >> 16) & 1u)) >> 16; }
__device__ __forceinline__ unsigned pk2(float lo, float hi) { return f2bf(lo) | (f2bf(hi) << 16); }
__device__ __forceinline__ float bf2f(unsigned short h) { return __builtin_bit_cast(float, (unsigned)h << 16); }
__device__ __forceinline__ float bflo(unsigned w) { return __builtin_bit_cast(float, w << 16); }
__device__ __forceinline__ float bfhi(unsigned w) { return __builtin_bit_cast(float, w & 0xffff0000u); }
__device__ __forceinline__ float wave_sum(float v) {
#pragma unroll
    for (int o = 1; o < 64; o <<= 1) v += __shfl_xor(v, o);
    return v;
}
__device__ __forceinline__ int opaque_tid() { int t = threadIdx.x; asm volatile("" : "+v"(t)); return t; }
#define MK_PER_PHASE 0
#define XB_TMO      128
#define XB_XCNT(j)  (256  + 64 * (j))
#define XB_XSUB(j)  (1280 + 64 * (j))
#define XB_XGEN(j)  (2304 + 64 * (j))
#define XB_TOP      3328
#define XB_TOPGEN   3392
#define XCD_BAR_WORDS 3456
#define XB_SPIN_CAP (1u << 18)

__device__ __forceinline__ unsigned xb_ld(unsigned* p)              { return __hip_atomic_load(p, __ATOMIC_RELAXED, __HIP_MEMORY_SCOPE_AGENT); }
__device__ __forceinline__ unsigned xb_add(unsigned* p, unsigned v) { return __hip_atomic_fetch_add(p, v, __ATOMIC_RELAXED, __HIP_MEMORY_SCOPE_AGENT); }
__device__ __forceinline__ unsigned xb_xcc_id() { return (unsigned)__builtin_amdgcn_s_getreg((3 << 11) | 20) & 0xFu; }
#define XB_SPIN(cond, bar) do { unsigned _sp = 0; while (cond) { __builtin_amdgcn_s_sleep(1); \
    if ((++_sp & 255u) == 0u) { if (xb_ld(&(bar)[XB_TMO])) break; if (_sp > XB_SPIN_CAP) { atomicAdd(&(bar)[XB_TMO], 1u); break; } } } } while (0)

struct XcdBarrier {
    unsigned* bar; unsigned x;
    volatile LAS unsigned* st;
};

__device__ __forceinline__ XcdBarrier xcd_barrier_post(unsigned* bar, volatile LAS unsigned* st) {
    XcdBarrier b; b.bar = bar; b.x = xb_xcc_id(); b.st = st;
    if (threadIdx.x == 0) (void)xb_add(&bar[XB_XCNT(b.x)], 1u);
    return b;
}
__device__ __forceinline__ void xcd_barrier_complete(unsigned* bar, unsigned x, unsigned& nloc, unsigned& nx) {
    const unsigned G = gridDim.x * gridDim.y * gridDim.z;
    unsigned sum, cnt, mine, sp = 0u;
    for (;;) {
        sum = 0u; cnt = 0u; mine = 0u;
#pragma unroll
        for (unsigned j = 0; j < 16; ++j) { const unsigned c = xb_ld(&bar[XB_XCNT(j)]); sum += c; cnt += (c > 0u) ? 1u : 0u; mine = (j == x) ? c : mine; }
        if (sum == G) break;
        __builtin_amdgcn_s_sleep(1);
        if ((++sp & 255u) == 0u) { if (xb_ld(&bar[XB_TMO])) break; if (sp > XB_SPIN_CAP) { atomicAdd(&bar[XB_TMO], 1u); break; } }
    }
    nloc = mine > 0u ? mine : 1u; nx = cnt > 0u ? cnt : 1u;
}

__device__ __forceinline__ void xcd_barrier(const XcdBarrier& b) {
    asm volatile("s_waitcnt vmcnt(0)" ::: "memory");
    __syncthreads();
    if (threadIdx.x == 0) {
        unsigned* bar = b.bar;
        __builtin_amdgcn_s_waitcnt(0);
        unsigned nloc = b.st[0], nx = b.st[1];
        if (nloc == 0u) { xcd_barrier_complete(bar, b.x, nloc, nx); b.st[0] = nloc; b.st[1] = nx; }
        const unsigned old = xb_add(&bar[XB_XSUB(b.x)], 1u);
        const unsigned gen = old / nloc;
        if (old + 1u == (gen + 1u) * nloc) {
            __builtin_amdgcn_fence(__ATOMIC_RELEASE, "agent");
            asm volatile("s_waitcnt vmcnt(0)" ::: "memory");
            const unsigned og = xb_add(&bar[XB_TOP], 1u);
            const unsigned tg = og / nx;
            if (og + 1u == (tg + 1u) * nx) xb_add(&bar[XB_TOPGEN], 1u);
            else XB_SPIN(xb_ld(&bar[XB_TOPGEN]) == tg, bar);
            __builtin_amdgcn_fence(__ATOMIC_ACQUIRE, "agent");
            xb_add(&bar[XB_XGEN(b.x)], 1u);
            asm volatile("s_waitcnt vmcnt(0)" ::: "memory");
        } else {
            XB_SPIN(xb_ld(&bar[XB_XGEN(b.x)]) == gen, bar);
            __builtin_amdgcn_fence(__ATOMIC_ACQUIRE, "agent");
            asm volatile("s_waitcnt vmcnt(0)" ::: "memory");
        }
    }
    __syncthreads();
}
namespace pg8 {
#define PG8_LAS __attribute__((address_space(3)))
typedef unsigned short bf16_t;
typedef short bf16x8 __attribute__((ext_vector_type(8)));
typedef float f32x4 __attribute__((ext_vector_type(4)));
typedef unsigned u32x4 __attribute__((ext_vector_type(4)));
constexpr int BM = 256, BK = 64, HALF = 128, HTB = HALF * BK * 2  , STAGE_BYTES = 8 * HTB, NXCD = 8, WGM = 8;

__host__ __device__ __forceinline__ int lds_byte(int r, int c) { const int st = (r >> 4) * 2 + (c >> 5), rr = r & 15, cc = c & 31, ob = rr * 64 + cc * 2; return st * 1024 + (ob ^ (((ob >> 9) & 1) << 5)); }
__host__ __device__ __forceinline__ void stage_rc(int b, int& R, int& C) { const int st = b / 1024, sb = b % 1024, swz = sb ^ (((sb >> 9) & 1) << 5); R = (st >> 1) * 16 + swz / 64; C = (st & 1) * 32 + (swz % 64) / 2; }
__host__ __device__ __forceinline__ int perm32(int rho) { const int n = rho >> 4, i = rho & 15; return 8 * (i >> 2) + 4 * n + (i & 3); }

struct Unit { int pm, pn; };
struct Gemm { const bf16_t* A; const bf16_t* Bt; int M, N, K; int gdiv, gmod; size_t gstride; };

struct StaticOrder {
    int nM, nN, nwg, G, c;
    __host__ __device__ void init(int M, int N, int G_, int c_) { nM = M / BM; nN = N / BM; nwg = nM * nN; G = G_; c = c_; }
    __host__ __device__ bool next(int i, Unit& u) const {
        const long L = (long)i * G + c; if (L >= nwg) return false;
        int wgid = (int)L; { const int q = nwg / NXCD, r = nwg % NXCD, xcd = wgid % NXCD, off = wgid / NXCD; wgid = (xcd < r ? xcd * (q + 1) : r * (q + 1) + (xcd - r) * q) + off; }
        const int nig = WGM * nN, gid = wgid / nig, fm = gid * WGM, gsz = (nM - fm) < WGM ? (nM - fm) : WGM;
        u.pm = fm + ((wgid % nig) % gsz); u.pn = (wgid % nig) / gsz; return true;
    }
    __device__ __forceinline__ void a_ready(const Unit&) const {}
    __device__ __forceinline__ void done(const Unit&) const {}
};


__device__ __forceinline__ unsigned cvt_pk_bf16(float lo, float hi) { unsigned r; asm volatile("v_cvt_pk_bf16_f32 %0, %1, %2" : "=v"(r) : "v"(lo), "v"(hi)); return r; }
typedef unsigned u32x2 __attribute__((ext_vector_type(2)));
struct EpiRowBf16 {
    static constexpr bool PERM = false, AFTER_DRAIN = false;
    bf16_t* O; int ldc; int sc_pn; float sc;
    __device__ __forceinline__ void operator()(const f32x4 (&acc)[2][2][4][2], const Unit& u, int wr, int wc, int fr, int fq) const {
        const float s = (u.pn == sc_pn) ? sc : 1.f;
        const int row0 = u.pm * BM + wr * 64 + fr, col0 = u.pn * BM + wc * 32 + 4 * fq;
#pragma unroll
        for (int ai = 0; ai < 2; ++ai)
#pragma unroll
            for (int m = 0; m < 4; ++m) { bf16_t* rowp = O + (size_t)(row0 + ai * HALF + m * 16) * ldc + col0;
#pragma unroll
                for (int bj = 0; bj < 2; ++bj)
#pragma unroll
                    for (int n = 0; n < 2; ++n) { const f32x4 v = acc[ai][bj][m][n] * s; u32x2 w; w.x = cvt_pk_bf16(v[0], v[1]); w.y = cvt_pk_bf16(v[2], v[3]);
                        *(u32x2*)(rowp + bj * HALF + n * 16) = w; } }
    }
};
struct EpiHyIn {
    static constexpr bool PERM = false, AFTER_DRAIN = false;
    bf16_t* OT; int ldt; int tp_tiles; bf16_t* CQ; float sc;
    __device__ __forceinline__ void operator()(const f32x4 (&acc)[2][2][4][2], const Unit& u, int wr, int wc, int fr, int fq) const {
        const int row0 = u.pm * BM + wr * 64 + fr;
        if (u.pn < tp_tiles) {
            const int col0 = u.pn * BM + wc * 32 + 4 * fq;
#pragma unroll
            for (int ai = 0; ai < 2; ++ai)
#pragma unroll
                for (int m = 0; m < 4; ++m) { const int row = row0 + ai * HALF + m * 16;
#pragma unroll
                    for (int bj = 0; bj < 2; ++bj)
#pragma unroll
                        for (int n = 0; n < 2; ++n) { const f32x4 v = acc[ai][bj][m][n]; const unsigned w0 = cvt_pk_bf16(v[0], v[1]), w1 = cvt_pk_bf16(v[2], v[3]);
                            bf16_t* p = OT + (size_t)(col0 + bj * HALF + n * 16) * ldt + row;
                            p[0] = (bf16_t)(w0 & 0xffffu); p[(size_t)ldt] = (bf16_t)(w0 >> 16); p[(size_t)2 * ldt] = (bf16_t)(w1 & 0xffffu); p[(size_t)3 * ldt] = (bf16_t)(w1 >> 16); } }
        } else {
            const int col0 = wc * 32 + 4 * fq;
#pragma unroll
            for (int ai = 0; ai < 2; ++ai)
#pragma unroll
                for (int m = 0; m < 4; ++m) { bf16_t* rowp = CQ + (size_t)(row0 + ai * HALF + m * 16) * 256 + col0;
#pragma unroll
                    for (int bj = 0; bj < 2; ++bj)
#pragma unroll
                        for (int n = 0; n < 2; ++n) { const f32x4 v = acc[ai][bj][m][n] * sc; u32x2 w; w.x = cvt_pk_bf16(v[0], v[1]); w.y = cvt_pk_bf16(v[2], v[3]);
                            *(u32x2*)(rowp + bj * HALF + n * 16) = w; } }
        }
    }
};
struct EpiAtIn {
    static constexpr bool PERM = false, AFTER_DRAIN = false;
    bf16_t* O; int ldc; const float* gq; const float* gk; float csc; float eps; int seq_mask;
    __device__ __forceinline__ void operator()(const f32x4 (&acc)[2][2][4][2], const Unit& u, int wr, int wc, int fr, int fq) const {
        const int row0 = u.pm * BM + wr * 64 + fr, colb = u.pn * BM + wc * 64 + 4 * fq;
        if (u.pn <= 3) {
            const float* gp = (u.pn == 3 ? gk : gq) + 4 * fq; const float osc = (u.pn == 3) ? 1.f : csc;
            float invr[4];
#pragma unroll
            for (int q = 0; q < 4; ++q) invr[q] = exp2f(-(float)(4 * fq + q) * (13.287712379549449f / 16.0f)) * 0.15915494309189535f;
#pragma unroll
            for (int ai = 0; ai < 2; ++ai)
#pragma unroll
                for (int m = 0; m < 4; ++m) {
                    const int row = row0 + ai * HALF + m * 16; int t = row & seq_mask; asm volatile("" : "+v"(t));
                    float ss = 0.f;
#pragma unroll
                    for (int bj = 0; bj < 2; ++bj)
#pragma unroll
                        for (int n = 0; n < 2; ++n) { const f32x4 x = acc[ai][bj][m][n]; ss += (x[0] * x[0] + x[1] * x[1]) + (x[2] * x[2] + x[3] * x[3]); }
                    ss += __shfl_xor(ss, 16); ss += __shfl_xor(ss, 32);
                    const float rs = osc * __builtin_amdgcn_rsqf(ss * (1.0f / 64.0f) + eps);
                    bf16_t* rowp = O + (size_t)row * ldc + colb;
#pragma unroll
                    for (int bj = 0; bj < 2; ++bj) {
                        const float pos = (float)(bj == 0 ? (t >> 6) : (t & 63));
                        const f32x4 xa = acc[ai][bj][m][0] * rs * *(const f32x4*)(gp + 32 * bj), xb = acc[ai][bj][m][1] * rs * *(const f32x4*)(gp + 32 * bj + 16);
                        f32x4 oa, ob;
#pragma unroll
                        for (int q = 0; q < 4; ++q) { const float rev = pos * invr[q]; const float c = __builtin_amdgcn_cosf(rev), s = __builtin_amdgcn_sinf(rev);
                            oa[q] = xa[q] * c - xb[q] * s; ob[q] = xa[q] * s + xb[q] * c; }
                        u32x2 w; w.x = cvt_pk_bf16(oa[0], oa[1]); w.y = cvt_pk_bf16(oa[2], oa[3]); *(u32x2*)(rowp + 32 * bj) = w;
                        w.x = cvt_pk_bf16(ob[0], ob[1]); w.y = cvt_pk_bf16(ob[2], ob[3]); *(u32x2*)(rowp + 32 * bj + 16) = w;
                    }
                    asm volatile("" ::: "memory");
                }
        } else {
            const float s = (u.pn == 5) ? csc : 1.f;
#pragma unroll
            for (int ai = 0; ai < 2; ++ai)
#pragma unroll
                for (int m = 0; m < 4; ++m) { bf16_t* rowp = O + (size_t)(row0 + ai * HALF + m * 16) * ldc + colb;
#pragma unroll
                    for (int bj = 0; bj < 2; ++bj)
#pragma unroll
                        for (int n = 0; n < 2; ++n) { const f32x4 v = acc[ai][bj][m][n] * s; u32x2 w; w.x = cvt_pk_bf16(v[0], v[1]); w.y = cvt_pk_bf16(v[2], v[3]);
                            *(u32x2*)(rowp + 32 * bj + 16 * n) = w; } }
        }
    }
};
struct EpiResF32 {
    static constexpr bool PERM = false, AFTER_DRAIN = false;
    const float* res; float* out; int ldc;
    __device__ __forceinline__ void operator()(const f32x4 (&acc)[2][2][4][2], const Unit& u, int wr, int wc, int fr, int fq) const {
        const int row0 = u.pm * BM + wr * 64 + fr, col0 = u.pn * BM + wc * 32 + 4 * fq;
#pragma unroll
        for (int ai = 0; ai < 2; ++ai)
#pragma unroll
            for (int m = 0; m < 4; ++m) { const size_t off = (size_t)(row0 + ai * HALF + m * 16) * ldc + col0;
#pragma unroll
                for (int bj = 0; bj < 2; ++bj)
#pragma unroll
                    for (int n = 0; n < 2; ++n) { const f32x4 r = *(const f32x4*)(res + off + bj * HALF + n * 16); *(f32x4*)(out + off + bj * HALF + n * 16) = r + acc[ai][bj][m][n]; } }
    }
};
__device__ __forceinline__ unsigned pk4_fp8_sat(const f32x4 x) {
    unsigned w = 0;
    w = __builtin_amdgcn_cvt_pk_fp8_f32(__builtin_amdgcn_fmed3f(x[0], -448.f, 448.f), __builtin_amdgcn_fmed3f(x[1], -448.f, 448.f), w, false);
    w = __builtin_amdgcn_cvt_pk_fp8_f32(__builtin_amdgcn_fmed3f(x[2], -448.f, 448.f), __builtin_amdgcn_fmed3f(x[3], -448.f, 448.f), w, true);
    return w;
}
struct EpiOutX {
    static constexpr bool PERM = false, AFTER_DRAIN = false;
    const float* res; float* out; int ldc; const float* gain; const float* WrG; unsigned char* XN8; float* PLG; float* PSS; int M;
    static __device__ __forceinline__ void split8(const f32x4 a, const f32x4 b, bf16x8& hi, bf16x8& lo) {
        u32x4 h, l; float r[8] = {a[0], a[1], a[2], a[3], b[0], b[1], b[2], b[3]};
#pragma unroll
        for (int k = 0; k < 4; ++k) { const unsigned p = cvt_pk_bf16(r[2 * k], r[2 * k + 1]); h[k] = p;
            const float d0 = r[2 * k] - __builtin_bit_cast(float, p << 16), d1 = r[2 * k + 1] - __builtin_bit_cast(float, p & 0xffff0000u); l[k] = cvt_pk_bf16(d0, d1); }
        hi = __builtin_bit_cast(bf16x8, h); lo = __builtin_bit_cast(bf16x8, l);
    }
    __device__ __forceinline__ void operator()(f32x4 (&acc)[2][2][4][2], const Unit& u, int wr, int wc, int fr, int fq) const {
        const int row0 = u.pm * BM + wr * 64 + fr, col0 = u.pn * BM + wc * 32 + 4 * fq, slot = u.pn * 4 + wc;
        bf16x8 whi[2], wlo[2];
#pragma unroll
        for (int bj = 0; bj < 2; ++bj) { const float* wp = WrG + (size_t)fr * ldc + col0 + bj * HALF; split8(*(const f32x4*)wp, *(const f32x4*)(wp + 16), whi[bj], wlo[bj]); }
#pragma unroll
        for (int ai = 0; ai < 2; ++ai)
#pragma unroll
            for (int m = 0; m < 4; ++m) { const int row = row0 + ai * HALF + m * 16; const size_t off = (size_t)row * ldc + col0; float ss = 0.f; f32x4 lg = (f32x4){0.f, 0.f, 0.f, 0.f};
#pragma unroll
                for (int bj = 0; bj < 2; ++bj) {
#pragma unroll
                    for (int n = 0; n < 2; ++n) { const int co = bj * HALF + n * 16;
                        const f32x4 h = *(const f32x4*)(res + off + co) + acc[ai][bj][m][n]; acc[ai][bj][m][n] = h; *(f32x4*)(out + off + co) = h;
                        ss += (h[0] * h[0] + h[1] * h[1]) + (h[2] * h[2] + h[3] * h[3]);
                        const f32x4 x = h * *(const f32x4*)(gain + col0 + co);
                        *(unsigned*)(XN8 + off + co) = pk4_fp8_sat(x); }
                    bf16x8 hhi, hlo; split8(acc[ai][bj][m][0], acc[ai][bj][m][1], hhi, hlo);
                    lg = __builtin_amdgcn_mfma_f32_16x16x32_bf16(wlo[bj], hhi, lg, 0, 0, 0);
                    lg = __builtin_amdgcn_mfma_f32_16x16x32_bf16(whi[bj], hlo, lg, 0, 0, 0);
                    lg = __builtin_amdgcn_mfma_f32_16x16x32_bf16(whi[bj], hhi, lg, 0, 0, 0); }
                ss += __shfl_xor(ss, 16); ss += __shfl_xor(ss, 32);
                if (fq == 0) PSS[(size_t)slot * M + row] = ss;
                *(f32x4*)(PLG + ((size_t)slot * M + row) * 16 + 4 * fq) = lg;
                asm volatile("" ::: "memory"); }
    }
};
struct EpiSwiGLU {
    static constexpr bool PERM = false, AFTER_DRAIN = false;
    bf16_t* O; int ldc;
    __device__ __forceinline__ void operator()(const f32x4 (&acc)[2][2][4][2], const Unit& u, int wr, int wc, int fr, int fq) const {
        const int row0 = u.pm * BM + wr * 64 + fr, col0 = u.pn * HALF + wc * 32 + 4 * fq;
#pragma unroll
        for (int ai = 0; ai < 2; ++ai)
#pragma unroll
            for (int m = 0; m < 4; ++m) { bf16_t* rowp = O + (size_t)(row0 + ai * HALF + m * 16) * ldc + col0;
#pragma unroll
                for (int n = 0; n < 2; ++n) { const f32x4 g = acc[ai][0][m][n], up = acc[ai][1][m][n]; f32x4 h;
#pragma unroll
                    for (int q = 0; q < 4; ++q) h[q] = g[q] * up[q] * __builtin_amdgcn_rcpf(1.f + __expf(-g[q]));
                    u32x2 w; w.x = cvt_pk_bf16(h[0], h[1]); w.y = cvt_pk_bf16(h[2], h[3]); *(u32x2*)(rowp + n * 16) = w; } }
    }
};
struct EpiSwiGLU8 {
    static constexpr bool PERM = false, AFTER_DRAIN = false;
    unsigned char* O; int ldc; float wsc; const float* rs;
    __device__ __forceinline__ void operator()(const f32x4 (&acc)[2][2][4][2], const Unit& u, int wr, int wc, int fr, int fq) const {
        const int row0 = u.pm * BM + wr * 64 + fr, col0 = u.pn * HALF + wc * 32 + 4 * fq;
#pragma unroll
        for (int ai = 0; ai < 2; ++ai)
#pragma unroll
            for (int m = 0; m < 4; ++m) { const int row = row0 + ai * HALF + m * 16; unsigned char* rowp = O + (size_t)row * ldc + col0; const float sc = wsc * rs[row];
#pragma unroll
                for (int n = 0; n < 2; ++n) { const f32x4 g = acc[ai][0][m][n] * sc, up = acc[ai][1][m][n] * sc; f32x4 h;
#pragma unroll
                    for (int q = 0; q < 4; ++q) h[q] = g[q] * up[q] * __builtin_amdgcn_rcpf(1.f + __expf(-g[q]));
                    *(unsigned*)(rowp + n * 16) = pk4_fp8_sat(h); } }
    }
};
struct EpiDown {
    static constexpr bool PERM = false, AFTER_DRAIN = false;
    bf16_t* O; int ldc; const float* gate; float wsc;
    __device__ __forceinline__ void operator()(const f32x4 (&acc)[2][2][4][2], const Unit& u, int wr, int wc, int fr, int fq) const {
        const int row0 = u.pm * BM + wr * 64 + fr, col0 = u.pn * BM + wc * 32 + 4 * fq;
#pragma unroll
        for (int ai = 0; ai < 2; ++ai)
#pragma unroll
            for (int m = 0; m < 4; ++m) { const int row = row0 + ai * HALF + m * 16; const float gs = gate[row] * wsc; bf16_t* rowp = O + (size_t)row * ldc + col0;
#pragma unroll
                for (int bj = 0; bj < 2; ++bj)
#pragma unroll
                    for (int n = 0; n < 2; ++n) { const f32x4 v = acc[ai][bj][m][n] * gs; u32x2 w; w.x = cvt_pk_bf16(v[0], v[1]); w.y = cvt_pk_bf16(v[2], v[3]);
                        *(u32x2*)(rowp + bj * HALF + n * 16) = w; } }
    }
};
template <class Epi, class Sched, bool ALIGN_EPI = false, bool SP2 = false, bool GATHER = false, bool FP8 = false>
__device__ __forceinline__ void gemm_phase(PG8_LAS unsigned char* lds, const Gemm g, const Sched& S, const Epi& E, const int* gidx = nullptr) {
    const int tid = opaque_tid(), wid = __builtin_amdgcn_readfirstlane(tid >> 6), lane = tid & 63, wr = wid >> 2, wc = wid & 3, fr = lane & 15, fq = lane >> 4;
    const int K = g.K, nt = K / BK;
    unsigned voffA[2], voffB[2];
#pragma unroll
    for (int i = 0; i < 2; ++i) { int R, C; stage_rc(tid * 16 + i * 8192, R, C); const int Rb = Epi::PERM ? ((R & ~31) + perm32(R & 31)) : R;
        voffA[i] = (unsigned)(R * K + C) * 2u; voffB[i] = (unsigned)(Rb * K + C) * 2u; }
    const size_t kstep = (size_t)(BK * 2);
    const size_t hstep = (size_t)HALF * K * 2;
    const size_t tstep = 2 * hstep;
    const unsigned ldsw = (unsigned)wid * 1024u;
    const int aoff = lds_byte(wr * 64 + fr, fq * 8), boff = lds_byte(wc * 32 + fr, fq * 8);
#define PG8_SA(b, h) (((b) * 2 + (h)) * HTB)
#define PG8_SB(b, h) ((4 + (b) * 2 + (h)) * HTB)
#define PG8_STAGE(bufoff, gbase, voff) do { _Pragma("unroll") for (int _i = 0; _i < 2; ++_i) \
        __builtin_amdgcn_global_load_lds((const unsigned*)((const char*)(gbase) + (voff)[_i]), (PG8_LAS unsigned*)(lds + (bufoff) + ldsw + _i * 8192), 16, 0, 0); } while (0)
#define PG8_LDA(dst, b, h) do { _Pragma("unroll") for (int m = 0; m < 4; ++m) { if constexpr (FP8) { const v4i_ lo_ = *(const PG8_LAS v4i_*)(lds + PG8_SA(b, h) + aoff + m * 2048), hi_ = *(const PG8_LAS v4i_*)(lds + PG8_SA(b, h) + aoff + m * 2048 + 1024); \
        dst##8[m] = __builtin_shufflevector(lo_, hi_, 0, 1, 2, 3, 4, 5, 6, 7); } else { _Pragma("unroll") for (int k = 0; k < 2; ++k) dst[m][k] = *(const PG8_LAS bf16x8*)(lds + PG8_SA(b, h) + aoff + m * 2048 + k * 1024); } } } while (0)
#define PG8_LDB(dst, b, h) do { _Pragma("unroll") for (int n = 0; n < 2; ++n) { if constexpr (FP8) { const v4i_ lo_ = *(const PG8_LAS v4i_*)(lds + PG8_SB(b, h) + boff + n * 2048), hi_ = *(const PG8_LAS v4i_*)(lds + PG8_SB(b, h) + boff + n * 2048 + 1024); \
        dst##8[n] = __builtin_shufflevector(lo_, hi_, 0, 1, 2, 3, 4, 5, 6, 7); } else { _Pragma("unroll") for (int k = 0; k < 2; ++k) dst[n][k] = *(const PG8_LAS bf16x8*)(lds + PG8_SB(b, h) + boff + n * 2048 + k * 1024); } } } while (0)
#define PG8_MMA(ai, bj, At, Bt) do { __builtin_amdgcn_s_setprio(1); _Pragma("unroll") for (int m = 0; m < 4; ++m) _Pragma("unroll") for (int n = 0; n < 2; ++n) { \
        if constexpr (FP8) asm volatile("v_mfma_scale_f32_16x16x128_f8f6f4 %0, %1, %2, %0, %3, %3 op_sel_hi:[0,0,0]" : "+v"(acc[ai][bj][m][n]) : "v"(Bt##8[n]), "v"(At##8[m]), "v"(sc127_));   \
        else { _Pragma("unroll") for (int k = 0; k < 2; ++k) acc[ai][bj][m][n] = __builtin_amdgcn_mfma_f32_16x16x32_bf16(Bt[n][k], At[m][k], acc[ai][bj][m][n], 0, 0, 0); } } \
        __builtin_amdgcn_s_setprio(0); } while (0)
#define PG8_WAIT_V(n) asm volatile("s_waitcnt vmcnt(" #n ")" ::: "memory")
#define PG8_WAIT_L(n) asm volatile("s_waitcnt lgkmcnt(" #n ")" ::: "memory")
#define PG8_BAR __builtin_amdgcn_s_barrier()
#define PG8_SCHED __builtin_amdgcn_sched_barrier(0)
    Unit cur, nxt; int ui = 0;
    if (!S.next(0, cur)) return;
    f32x4 acc[2][2][4][2];
#pragma unroll
    for (int a = 0; a < 2; ++a)
#pragma unroll
        for (int b = 0; b < 2; ++b)
#pragma unroll
            for (int m = 0; m < 4; ++m)
#pragma unroll
                for (int n = 0; n < 2; ++n) acc[a][b][m][n] = (f32x4){0.f, 0.f, 0.f, 0.f};
    typedef int v8i_ __attribute__((ext_vector_type(8))); typedef int v4i_ __attribute__((ext_vector_type(4)));
    const int sc127_ = 127;
    bf16x8 At[4][2], B0[2][2], B1[2][2]; v8i_ At8[4], B08[2], B18[2];
    static_assert(SP2, "this copy of the body keeps only the SP2 K-loop up to date");
    int rA[2]; { int R_, C_; stage_rc(tid * 16, R_, C_); rA[0] = R_; stage_rc(tid * 16 + 8192, R_, C_); rA[1] = R_; }
    unsigned cv0[2], cv1[2], nv0[2], nv1[2];
    unsigned vh1[2]; vh1[0] = voffA[0] + (unsigned)hstep; vh1[1] = voffA[1] + (unsigned)hstep;
#define PG8_CV0 (GATHER ? cv0 : voffA)
#define PG8_CV1 (GATHER ? cv1 : vh1)
#define PG8_SV0 (GATHER ? sv0 : voffA)
#define PG8_SV1 (GATHER ? sv1 : vh1)
#define PG8_ROWOFF(dst0, dst1, unit) do { _Pragma("unroll") for (int i_ = 0; i_ < 2; ++i_) { \
        if constexpr (GATHER) { const int c2_ = (int)(voffA[i_] - (unsigned)(rA[i_] * K) * 2u); \
            dst0[i_] = (unsigned)gidx[(unit).pm * BM + rA[i_]] * (unsigned)(K * 2) + (unsigned)c2_; dst1[i_] = (unsigned)gidx[(unit).pm * BM + HALF + rA[i_]] * (unsigned)(K * 2) + (unsigned)c2_; } \
        else { dst0[i_] = voffA[i_]; dst1[i_] = voffA[i_] + (unsigned)hstep; } } } while (0)
    if constexpr (GATHER) PG8_ROWOFF(cv0, cv1, cur);
    const char* cA = GATHER ? (const char*)g.A : (const char*)g.A + (size_t)cur.pm * tstep; const char* cB = (const char*)g.Bt + (size_t)((cur.pm / g.gdiv) % g.gmod) * g.gstride + (size_t)cur.pn * tstep;
    S.a_ready(cur);
    if constexpr (SP2) {
        PG8_STAGE(PG8_SB(0, 0), cB, voffB); PG8_STAGE(PG8_SB(0, 1), cB + hstep, voffB); PG8_STAGE(PG8_SA(0, 0), cA, PG8_CV0); PG8_STAGE(PG8_SA(0, 1), cA, PG8_CV1);
        if (wr == 1) PG8_BAR;
        PG8_WAIT_V(2); PG8_BAR;
        PG8_STAGE(PG8_SB(1, 0), cB + kstep, voffB); PG8_STAGE(PG8_SA(1, 0), cA + kstep, PG8_CV0); PG8_STAGE(PG8_SB(1, 1), cB + hstep + kstep, voffB);
        PG8_WAIT_V(6); PG8_BAR;
    } else {
        PG8_STAGE(PG8_SB(0, 0), cB, voffB); PG8_STAGE(PG8_SA(0, 0), cA, voffA); PG8_STAGE(PG8_SB(0, 1), cB + hstep, voffB); PG8_STAGE(PG8_SA(0, 1), cA + hstep, voffA);
        if (wr == 1) PG8_BAR;
        PG8_WAIT_V(4); PG8_BAR;
        PG8_STAGE(PG8_SB(1, 0), cB + kstep, voffB); PG8_STAGE(PG8_SA(1, 0), cA + kstep, voffA); PG8_STAGE(PG8_SB(1, 1), cB + hstep + kstep, voffB);
        PG8_WAIT_V(6); PG8_BAR;
    }
    for (;;) {
        const bool has_next = S.next(ui + 1, nxt);
        if constexpr (GATHER) { if (has_next) PG8_ROWOFF(nv0, nv1, nxt); else { nv0[0] = cv0[0]; nv0[1] = cv0[1]; nv1[0] = cv1[0]; nv1[1] = cv1[1]; } }
        const char* nA = GATHER ? (const char*)g.A : (has_next ? (const char*)g.A + (size_t)nxt.pm * tstep : cA); const char* nB = has_next ? (const char*)g.Bt + (size_t)((nxt.pm / g.gdiv) % g.gmod) * g.gstride + (size_t)nxt.pn * tstep : cB;
        for (int t = 0; t < nt; t += 2) {
            const bool last = (t == nt - 2);
            unsigned sv0[2], sv1[2]; if constexpr (GATHER) { sv0[0] = last ? nv0[0] : cv0[0]; sv0[1] = last ? nv0[1] : cv0[1]; sv1[0] = last ? nv1[0] : cv1[0]; sv1[1] = last ? nv1[1] : cv1[1]; }
            const char* a1 = cA + (size_t)(t + 1) * kstep;
            const char* a2 = last ? nA : cA + (size_t)(t + 2) * kstep; const char* b2 = last ? nB : cB + (size_t)(t + 2) * kstep;
            const char* a3 = a2 + kstep; const char* b3 = b2 + kstep;
            if (last && has_next) S.a_ready(nxt);
            if constexpr (SP2) {
            PG8_LDB(B0, 0, 0); PG8_LDB(B1, 0, 1); PG8_SCHED; PG8_LDA(At, 0, 0); PG8_STAGE(PG8_SA(1, 1), a1, PG8_CV1);
            PG8_WAIT_V(8); PG8_WAIT_L(0); PG8_BAR; PG8_MMA(0, 0, At, B0); PG8_MMA(0, 1, At, B1); PG8_BAR; PG8_SCHED;
            PG8_LDA(At, 0, 1); PG8_STAGE(PG8_SB(0, 0), b2, voffB); PG8_STAGE(PG8_SB(0, 1), b2 + hstep, voffB); PG8_STAGE(PG8_SA(0, 0), a2, PG8_SV0);
            PG8_WAIT_V(8); PG8_WAIT_L(0); PG8_BAR; PG8_MMA(1, 0, At, B0); PG8_MMA(1, 1, At, B1); PG8_BAR; PG8_SCHED;
            PG8_LDB(B0, 1, 0); PG8_LDB(B1, 1, 1); PG8_SCHED; PG8_LDA(At, 1, 0); PG8_STAGE(PG8_SA(0, 1), a2, PG8_SV1);
            PG8_WAIT_V(8); PG8_WAIT_L(0); PG8_BAR; PG8_MMA(0, 0, At, B0); PG8_MMA(0, 1, At, B1); PG8_BAR; PG8_SCHED;
            PG8_LDA(At, 1, 1); PG8_STAGE(PG8_SB(1, 0), b3, voffB); PG8_STAGE(PG8_SB(1, 1), b3 + hstep, voffB); PG8_STAGE(PG8_SA(1, 0), a3, PG8_SV0);
            PG8_WAIT_V(8); PG8_WAIT_L(0); PG8_BAR; PG8_MMA(1, 0, At, B0); PG8_MMA(1, 1, At, B1); PG8_BAR; PG8_SCHED;
            } else {
            PG8_LDB(B0, 0, 0); PG8_SCHED; PG8_LDA(At, 0, 0); PG8_STAGE(PG8_SA(1, 1), a1 + hstep, voffA);
            PG8_WAIT_L(8); PG8_BAR; PG8_WAIT_L(0); PG8_MMA(0, 0, At, B0); PG8_BAR; PG8_SCHED;
            PG8_LDB(B1, 0, 1); PG8_STAGE(PG8_SB(0, 0), b2, voffB);
            PG8_BAR; PG8_WAIT_L(0); PG8_MMA(0, 1, At, B1); PG8_BAR;
            PG8_LDA(At, 0, 1); PG8_STAGE(PG8_SA(0, 0), a2, voffA);
            PG8_BAR; PG8_WAIT_L(0); PG8_MMA(1, 0, At, B0); PG8_BAR; PG8_SCHED;
            PG8_STAGE(PG8_SB(0, 1), b2 + hstep, voffB);
            PG8_WAIT_V(6); PG8_BAR; PG8_MMA(1, 1, At, B1); PG8_BAR;
            PG8_LDB(B0, 1, 0); PG8_SCHED; PG8_LDA(At, 1, 0); PG8_STAGE(PG8_SA(0, 1), a2 + hstep, voffA);
            PG8_WAIT_L(8); PG8_BAR; PG8_WAIT_L(0); PG8_MMA(0, 0, At, B0); PG8_BAR; PG8_SCHED;
            PG8_LDB(B1, 1, 1); PG8_STAGE(PG8_SB(1, 0), b3, voffB);
            PG8_BAR; PG8_WAIT_L(0); PG8_MMA(0, 1, At, B1); PG8_BAR;
            PG8_LDA(At, 1, 1); PG8_STAGE(PG8_SA(1, 0), a3, voffA);
            PG8_BAR; PG8_WAIT_L(0); PG8_MMA(1, 0, At, B0); PG8_BAR; PG8_SCHED;
            PG8_STAGE(PG8_SB(1, 1), b3 + hstep, voffB);
            PG8_WAIT_V(6); PG8_BAR; PG8_MMA(1, 1, At, B1); PG8_BAR;
            }
        }
        if constexpr (ALIGN_EPI) { if (wr == 0) PG8_BAR; }
        if constexpr (!Epi::AFTER_DRAIN) { E(acc, cur, wr, wc, fr, fq); S.done(cur); }
        if (!has_next) break;
#pragma unroll
        for (int a = 0; a < 2; ++a)
#pragma unroll
            for (int b = 0; b < 2; ++b)
#pragma unroll
                for (int m = 0; m < 4; ++m)
#pragma unroll
                    for (int n = 0; n < 2; ++n) acc[a][b][m][n] = (f32x4){0.f, 0.f, 0.f, 0.f};
        cur = nxt; cA = nA; cB = nB; ++ui; if constexpr (GATHER) { cv0[0] = nv0[0]; cv0[1] = nv0[1]; cv1[0] = nv1[0]; cv1[1] = nv1[1]; }
        if constexpr (ALIGN_EPI) { if (wr == 1) PG8_BAR; }
    }
    PG8_WAIT_V(0);
    if constexpr (!ALIGN_EPI) { if (wr == 0) PG8_BAR; }
    PG8_BAR;
    if constexpr (Epi::AFTER_DRAIN) { E.fused(acc, cur, wr, wc, fr, fq, lds, wid, lane); S.done(cur); }
#undef PG8_ROWOFF
#undef PG8_CV0
#undef PG8_CV1
#undef PG8_SV0
#undef PG8_SV1
#undef PG8_SA
#undef PG8_SB
#undef PG8_STAGE
#undef PG8_LDA
#undef PG8_LDB
#undef PG8_MMA
#undef PG8_WAIT_V
#undef PG8_WAIT_L
#undef PG8_BAR
#undef PG8_SCHED
}
}
namespace attn_body {
using bf16=__hip_bfloat16;
using bf16x8=__attribute__((ext_vector_type(8)))short;
using s16x4=__attribute__((ext_vector_type(4)))short;
using f32x16=__attribute__((ext_vector_type(16)))float;
using u32x4=__attribute__((ext_vector_type(4)))unsigned;
constexpr int D=64;
constexpr int NW=8,QBLK=32,QB=QBLK*NW,KVBLK=64;
__device__ __forceinline__ int crow(int r,int hi){return (r&3)+8*(r>>2)+4*hi;}
#define SBAR() __builtin_amdgcn_sched_barrier(0)
__device__ __forceinline__ void cmask(f32x16&p0,f32x16&p1,int jb,int qrel,int hi){
  const float NEG=-INFINITY; int kb=64*jb+4*hi;
  #pragma unroll
  for(int r=0;r<16;++r){int kv=kb+(r&3)+8*(r>>2); if(kv>qrel)p0[r]=NEG; if(kv+32>qrel)p1[r]=NEG;}
}

constexpr int NSLOT=3, SLOTB=8192;
constexpr int LDS_K=0, LDS_V=NSLOT*SLOTB, LDS_WS=2*NSLOT*SLOTB, LDS_OST=LDS_WS+NW*64*4, LDS_BYTES=LDS_OST+NW*4096;
constexpr float C2=0.125f*1.4426950408889634f;
__device__ __forceinline__ void glds16(const void*gsrc,unsigned lds_dst){unsigned keep;
  asm volatile("s_mov_b32 %0, m0\n\ts_mov_b32 m0, %2\n\ts_nop 0\n\tglobal_load_lds_dwordx4 %1, off\n\ts_mov_b32 m0, %0":"=&s"(keep):"v"(gsrc),"s"(lds_dst):"memory");}
__device__ __forceinline__ float max3f(float a,float b,float c){float r;asm("v_max3_f32 %0, %1, %2, %3":"=v"(r):"v"(a),"v"(b),"v"(c));return r;}
__device__ __forceinline__ float max2f(float a,float b){float r;asm("v_max_f32_e32 %0, %1, %2":"=v"(r):"v"(a),"v"(b));return r;}
__device__ __forceinline__ float fadd_s(float a,float b){float r;asm("v_add_f32_e32 %0, %1, %2":"=v"(r):"v"(a),"v"(b));return r;}
__device__ __forceinline__ float fsub_s(float a,float b){float r;asm("v_sub_f32_e32 %0, %1, %2":"=v"(r):"v"(a),"v"(b));return r;}
typedef float f32x2_t __attribute__((ext_vector_type(2))); typedef __bf16 bf16x2_t __attribute__((ext_vector_type(2)));
__device__ __forceinline__ unsigned cvtpk_s(float lo,float hi){f32x2_t v={lo,hi};bf16x2_t b=__builtin_convertvector(v,bf16x2_t);return __builtin_bit_cast(unsigned,b);}
#define WAIT_BAR(N) asm volatile("s_waitcnt vmcnt(" #N ") lgkmcnt(0)\n\ts_barrier":::"memory")

__device__ __forceinline__ void qkt(f32x16&p0,f32x16&p1,const char*Kslot,const bf16x8*qr,const f32x16&negm,int r32,int hi){
  const char*kb=Kslot+hi*1024+r32*16;
  #pragma unroll
  for(int d0=0;d0<4;++d0){
    const bf16x8 b0=*reinterpret_cast<const bf16x8*>(kb+d0*2048);
    const bf16x8 b1=*reinterpret_cast<const bf16x8*>(kb+d0*2048+512);
    if(d0==0){p0=__builtin_amdgcn_mfma_f32_32x32x16_bf16(b0,qr[0],negm,0,0,0);p1=__builtin_amdgcn_mfma_f32_32x32x16_bf16(b1,qr[0],negm,0,0,0);}
    else{p0=__builtin_amdgcn_mfma_f32_32x32x16_bf16(b0,qr[d0],p0,0,0,0);p1=__builtin_amdgcn_mfma_f32_32x32x16_bf16(b1,qr[d0],p1,0,0,0);}}
}
typedef __attribute__((address_space(3))) const char* lds_cptr;
typedef short v4i16_t __attribute__((ext_vector_type(4)));
__device__ __forceinline__ void kload8(bf16x8*kf,lds_cptr kp){
  kf[0]=*(const __attribute__((address_space(3))) bf16x8*)(kp);      kf[1]=*(const __attribute__((address_space(3))) bf16x8*)(kp+512);
  kf[2]=*(const __attribute__((address_space(3))) bf16x8*)(kp+2048); kf[3]=*(const __attribute__((address_space(3))) bf16x8*)(kp+2560);
  kf[4]=*(const __attribute__((address_space(3))) bf16x8*)(kp+4096); kf[5]=*(const __attribute__((address_space(3))) bf16x8*)(kp+4608);
  kf[6]=*(const __attribute__((address_space(3))) bf16x8*)(kp+6144); kf[7]=*(const __attribute__((address_space(3))) bf16x8*)(kp+6656);
}
__device__ __forceinline__ void kload2(bf16x8*kf,lds_cptr kp,int j){ kf[2*j]=*(const __attribute__((address_space(3))) bf16x8*)(kp+j*2048); kf[2*j+1]=*(const __attribute__((address_space(3))) bf16x8*)(kp+j*2048+512); }
__device__ __forceinline__ s16x4 vtr(lds_cptr p){ return __builtin_bit_cast(s16x4,__builtin_amdgcn_ds_read_tr16_b64_v4i16((__attribute__((address_space(3))) v4i16_t*)p)); }
__device__ __forceinline__ float rowmax(const f32x16&p0,const f32x16&p1){
  float a=max3f(p0[0],p0[1],p1[0]),b=max3f(p0[2],p0[3],p1[1]);a=max3f(a,p1[2],p1[3]);
  #pragma unroll
  for(int r=4;r<16;r+=4){a=max3f(a,p0[r],p0[r+1]);b=max3f(b,p0[r+2],p0[r+3]);a=max3f(a,p1[r],p1[r+1]);b=max3f(b,p1[r+2],p1[r+3]);}
  const float m=max2f(a,b);
  auto rr=__builtin_amdgcn_permlane32_swap(__float_as_uint(m),__float_as_uint(m),false,false);
  return max2f(__uint_as_float(rr[0]),__uint_as_float(rr[1]));
}
__device__ __forceinline__ void pv(f32x16*o,int vb,bf16x8 pa0,bf16x8 pa1,bf16x8 pa2,bf16x8 pa3){
  #pragma unroll
  for(int d0=0;d0<2;++d0){s16x4 lo[4],hi[4];
    #pragma unroll
    for(int ks=0;ks<4;++ks){
      asm volatile("ds_read_b64_tr_b16 %0,%1 offset:%c2":"=&v"(lo[ks]):"v"(vb),"i"(d0*4096+ks*1024):"memory");
      asm volatile("ds_read_b64_tr_b16 %0,%1 offset:%c2":"=&v"(hi[ks]):"v"(vb),"i"(d0*4096+ks*1024+512):"memory");}
    asm volatile("s_waitcnt lgkmcnt(0)":::"memory");SBAR();
    #define PK(k) (bf16x8){lo[k][0],lo[k][1],lo[k][2],lo[k][3],hi[k][0],hi[k][1],hi[k][2],hi[k][3]}
    o[d0]=__builtin_amdgcn_mfma_f32_32x32x16_bf16(pa0,PK(0),o[d0],0,0,0);
    o[d0]=__builtin_amdgcn_mfma_f32_32x32x16_bf16(pa1,PK(1),o[d0],0,0,0);
    o[d0]=__builtin_amdgcn_mfma_f32_32x32x16_bf16(pa2,PK(2),o[d0],0,0,0);
    o[d0]=__builtin_amdgcn_mfma_f32_32x32x16_bf16(pa3,PK(3),o[d0],0,0,0);
    #undef PK
  }
}

#ifndef ATTN_STORE16
#define ATTN_STORE16(p,v) (*(u32x4*)(p)=(v))
#endif
template<int THRL,int QP,int KP,int OP> __device__ __forceinline__ void attn_unit(const bf16*Qu,const bf16*__restrict__ Kh,const bf16*__restrict__ Vh,bf16*Ou,const int NT,char*shm){
  const int tid=opaque_tid(),lane=tid&63,r32=lane&31,hi=lane>>5; const int wid=__builtin_amdgcn_readfirstlane(tid>>6);
  const bf16*Qw=Qu+(long)(wid*QBLK)*QP;
  const unsigned lds0=(unsigned)(uintptr_t)shm;
  float*wsf=(float*)(shm+LDS_WS)+wid*64;
  const bf16*ksrc=Kh+(long)lane*KP+wid*8;
  const bf16*vsrc=Vh+(long)(16*(wid&3)+(lane>>2))*KP+(wid>>2)*32+(lane&3)*8;
  const unsigned kdst=lds0+LDS_K+wid*1024, vdst=lds0+LDS_V+wid*1024;
  #define DMA_K(t,slot) glds16(ksrc+(long)(t)*KVBLK*KP,(unsigned)__builtin_amdgcn_readfirstlane(kdst+(slot)))
  #define DMA_V(t,slot) glds16(vsrc+(long)(t)*KVBLK*KP,(unsigned)__builtin_amdgcn_readfirstlane(vdst+(slot)))
  const int vb0=(int)(lds0+LDS_V)+((lane>>4)&1)*32+(lane&3)*8+(4*hi+((lane&15)>>2))*64;
  const char*Kbase=shm+LDS_K; bf16x8 kf[8];
  const lds_cptr shm3=(lds_cptr)shm; const lds_cptr kp0=shm3+LDS_K+hi*1024+r32*16; const lds_cptr vp0=shm3+LDS_V+((lane>>4)&1)*32+(lane&3)*8+(4*hi+((lane&15)>>2))*64;
  DMA_K(0,0);DMA_V(0,0);DMA_K(1,SLOTB);
  bf16x8 qr[4];
  #pragma unroll
  for(int d0=0;d0<4;++d0)qr[d0]=*reinterpret_cast<const bf16x8*>(&Qw[(long)r32*QP+d0*16+hi*8]);
  float mhat=0.f,l_reg=0.f;f32x16 o[2];o[0]=f32x16{};o[1]=f32x16{};f32x16 negm=f32x16{};asm volatile("":"+v"(negm));
  #define CMASK(P0,P1,t) do{}while(0)
  bool resc=false;
  #define START(P0,P1) do{ const float rm=rowmax(P0,P1); resc=false; \
    { const float dl=rm; mhat=fadd_s(mhat,dl); \
      _Pragma("unroll") for(int r=0;r<16;++r){P0[r]=fsub_s(P0[r],dl);P1[r]=fsub_s(P1[r],dl);} \
      _Pragma("unroll") for(int r=0;r<16;++r)negm[r]=-mhat; asm volatile("":"+v"(negm)); } \
    _Pragma("unroll") for(int r=0;r<16;++r)P0[r]=__builtin_amdgcn_exp2f(P0[r]); }while(0)
  #define RESC() do{ if(resc){ asm volatile("s_waitcnt lgkmcnt(0)":::"memory"); \
      _Pragma("unroll") for(int d_=0;d_<2;++d_) _Pragma("unroll") for(int r=0;r<16;++r)o[d_][r]*=wsf[crow(r,hi)]; } }while(0)
  f32x16 pA0,pA1,pB0,pB1;
  int sl_prev=0,sl_cur=0,sl_next=SLOTB;
  #define ROT() do{sl_prev=sl_cur;sl_cur=sl_next;sl_next=(sl_next==(NSLOT-1)*SLOTB)?0:sl_next+SLOTB;}while(0)
  DMA_K(2,2*SLOTB);
  WAIT_BAR(3);
  qkt(pA0,pA1,Kbase,qr,negm,r32,hi);asm volatile("s_nop 15\n\ts_nop 7":"+v"(pA0),"+v"(pA1));CMASK(pA0,pA1,0);
  START(pA0,pA1);
  _Pragma("unroll") for(int r=0;r<16;++r)pA1[r]=__builtin_amdgcn_exp2f(pA1[r]);
  WAIT_BAR(0);
  DMA_K(3,0);DMA_V(1,SLOTB);
  ROT();
  kload8(kf,kp0+sl_cur);
  WAIT_BAR(2);
  s16x4 vlo[8],vhi[8]; u32x4 pw0,pw1,pw2,pw3;
  #define PKW(P,B) cvtpk_s(P[B],P[B+1])
  #define PAF(k) __builtin_bit_cast(bf16x8,pw##k)
  #define VFR(i) (bf16x8){vlo[i][0],vlo[i][1],vlo[i][2],vlo[i][3],vhi[i][0],vhi[i][1],vhi[i][2],vhi[i][3]}
  #define PIN(x) asm volatile("":"+v"(x))
  #define MX3(a,b,c) __builtin_fmaxf(__builtin_fmaxf((a),(b)),(c))
  #define GAPA(MF,A0,A1,A2,A3,W0,W1,PW) do{ MF; sacc+=A0; sacc+=A1; sacc+=A2; sacc+=A3; PIN(sacc); W0; W1; PIN(PW); SBAR(); }while(0)
  #define EX(v) __builtin_amdgcn_exp2f(v)
  #define GAPB(MF,X,B) do{ MF; X[B]=EX(X[B]); X[B+1]=EX(X[B+1]); X[B+2]=EX(X[B+2]); X[B+3]=EX(X[B+3]); PIN(X); SBAR(); }while(0)
  #define VRD(i) do{ vlo[i]=vtr(vp_+(((i)>>2)*4096+((i)&3)*1024)); vhi[i]=vtr(vp_+(((i)>>2)*4096+((i)&3)*1024+512)); }while(0)
  #define KRD(G,j) do{ if(G){ kload2(kf,kp0+sl_next,j); SBAR(); } }while(0)
  #define STEP(C0,C1,P0,P1,t,GK,GV,GL) do{ SBAR(); \
    const lds_cptr vp_=vp0+sl_prev; \
    VRD(0); SBAR(); float sacc=(P0[0]+P0[1]); \
    GAPA(C0=__builtin_amdgcn_mfma_f32_32x32x16_bf16(kf[0],qr[0],negm,0,0,0), P0[2],P0[3],P0[4],P0[5],     pw0[0]=PKW(P0,0), pw0[1]=PKW(P0,2), pw0); \
    VRD(4); SBAR(); GAPA(C1=__builtin_amdgcn_mfma_f32_32x32x16_bf16(kf[1],qr[0],negm,0,0,0), P0[6],P0[7],P0[8],P0[9],     pw0[2]=PKW(P0,4), pw0[3]=PKW(P0,6), pw0); \
    VRD(1); SBAR(); GAPA(C0=__builtin_amdgcn_mfma_f32_32x32x16_bf16(kf[2],qr[1],C0,0,0,0),   P0[10],P0[11],P0[12],P0[13], pw1[0]=PKW(P0,8), pw1[1]=PKW(P0,10), pw1); \
    VRD(5); SBAR(); GAPA(C1=__builtin_amdgcn_mfma_f32_32x32x16_bf16(kf[3],qr[1],C1,0,0,0),   P0[14],P0[15],P1[0],P1[1],   pw1[2]=PKW(P0,12),pw1[3]=PKW(P0,14), pw1); \
    VRD(2); SBAR(); GAPA(C0=__builtin_amdgcn_mfma_f32_32x32x16_bf16(kf[4],qr[2],C0,0,0,0),   P1[2],P1[3],P1[4],P1[5],     pw2[0]=PKW(P1,0), pw2[1]=PKW(P1,2), pw2); \
    VRD(6); SBAR(); GAPA(C1=__builtin_amdgcn_mfma_f32_32x32x16_bf16(kf[5],qr[2],C1,0,0,0),   P1[6],P1[7],P1[8],P1[9],     pw2[2]=PKW(P1,4), pw2[3]=PKW(P1,6), pw2); \
    VRD(3); SBAR(); GAPA(C0=__builtin_amdgcn_mfma_f32_32x32x16_bf16(kf[6],qr[3],C0,0,0,0),   P1[10],P1[11],P1[12],P1[13], pw3[0]=PKW(P1,8), pw3[1]=PKW(P1,10), pw3); \
    VRD(7); SBAR(); GAPA(C1=__builtin_amdgcn_mfma_f32_32x32x16_bf16(kf[7],qr[3],C1,0,0,0),   P1[14],P1[15],0.f,0.f,       pw3[2]=PKW(P1,12),pw3[3]=PKW(P1,14), pw3); \
    l_reg+=sacc; \
    if(GK){DMA_K((t)+3,sl_cur);} if(GV){DMA_V((t)+1,sl_next);} \
    CMASK(C0,C1,t); \
    { float a=MX3(C0[0],C0[1],C1[0]),b=MX3(C0[2],C0[3],C1[1]); a=MX3(a,C1[2],C1[3]); \
      _Pragma("unroll") for(int r=4;r<16;r+=4){a=MX3(a,C0[r],C0[r+1]);b=MX3(b,C0[r+2],C0[r+3]);a=MX3(a,C1[r],C1[r+1]);b=MX3(b,C1[r+2],C1[r+3]);} \
      float rm=__builtin_fmaxf(a,b); { auto rr=__builtin_amdgcn_permlane32_swap(__float_as_uint(rm),__float_as_uint(rm),false,false); rm=__builtin_fmaxf(__uint_as_float(rr[0]),__uint_as_float(rr[1])); } \
      resc=false; \
      if(__builtin_expect(__any(rm>(float)THRL),0)){ const float dl=__builtin_fmaxf(rm,0.f); mhat+=dl; \
        _Pragma("unroll") for(int r=0;r<16;++r){C0[r]-=dl;C1[r]-=dl;} \
        _Pragma("unroll") for(int r=0;r<16;++r)negm[r]=-mhat; asm volatile("":"+v"(negm)); \
        const float f=__builtin_amdgcn_exp2f(-dl); l_reg*=f; if(hi==0)wsf[r32]=f; resc=true; } } \
    SBAR(); \
    GAPB(o[0]=__builtin_amdgcn_mfma_f32_32x32x16_bf16(PAF(0),VFR(0),o[0],0,0,0), C0,0); \
    GAPB(o[1]=__builtin_amdgcn_mfma_f32_32x32x16_bf16(PAF(0),VFR(4),o[1],0,0,0), C0,4); \
    KRD(GL,0); GAPB(o[0]=__builtin_amdgcn_mfma_f32_32x32x16_bf16(PAF(1),VFR(1),o[0],0,0,0), C0,8); \
    KRD(GL,1); GAPB(o[1]=__builtin_amdgcn_mfma_f32_32x32x16_bf16(PAF(1),VFR(5),o[1],0,0,0), C0,12); \
    KRD(GL,2); GAPB(o[0]=__builtin_amdgcn_mfma_f32_32x32x16_bf16(PAF(2),VFR(2),o[0],0,0,0), C1,0); \
    KRD(GL,3); GAPB(o[1]=__builtin_amdgcn_mfma_f32_32x32x16_bf16(PAF(2),VFR(6),o[1],0,0,0), C1,4); \
    GAPB(o[0]=__builtin_amdgcn_mfma_f32_32x32x16_bf16(PAF(3),VFR(3),o[0],0,0,0), C1,8); \
    GAPB(o[1]=__builtin_amdgcn_mfma_f32_32x32x16_bf16(PAF(3),VFR(7),o[1],0,0,0), C1,12); \
    }while(0)
  int t=1;
  #undef CMASK
  #define CMASK(P0,P1,t) do{}while(0)
  for(;t+5<NT;t+=2){
    STEP(pB0,pB1,pA0,pA1,t,true,true,true);     WAIT_BAR(2); RESC(); ROT();
    STEP(pA0,pA1,pB0,pB1,t+1,true,true,true);   WAIT_BAR(2); RESC(); ROT();
  }
  #undef CMASK
  #define CMASK(P0,P1,t) do{}while(0)
  #define ENDW(tt) do{ if((tt)+3<NT){WAIT_BAR(2);} else if((tt)+2<NT){WAIT_BAR(1);} else {WAIT_BAR(0);} }while(0)
  for(;t+1<NT;t+=2){
    STEP(pB0,pB1,pA0,pA1,t,(t+3<NT),(t+1<NT),(t+1<NT));       ENDW(t);   RESC(); ROT();
    STEP(pA0,pA1,pB0,pB1,t+1,(t+4<NT),(t+2<NT),(t+2<NT));     ENDW(t+1); RESC(); ROT();
  }
  STEP(pB0,pB1,pA0,pA1,NT-1,false,false,false); RESC();
  { float sacc=pB0[0]+pB0[1]; _Pragma("unroll") for(int r=2;r<16;++r)sacc+=pB0[r]; _Pragma("unroll") for(int r=0;r<16;++r)sacc+=pB1[r]; l_reg+=sacc;
    pw0=(u32x4){PKW(pB0,0),PKW(pB0,2),PKW(pB0,4),PKW(pB0,6)};pw1=(u32x4){PKW(pB0,8),PKW(pB0,10),PKW(pB0,12),PKW(pB0,14)};pw2=(u32x4){PKW(pB1,0),PKW(pB1,2),PKW(pB1,4),PKW(pB1,6)};pw3=(u32x4){PKW(pB1,8),PKW(pB1,10),PKW(pB1,12),PKW(pB1,14)};
    SBAR(); pv(o,vb0+sl_cur,PAF(0),PAF(1),PAF(2),PAF(3)); }
  #undef PKW
  #undef PAF
  #undef VFR
  #undef PIN
  #undef MX3
  #undef GAPA
  #undef GAPB
  #undef EX
  #undef VRD
  #undef KRD
  #undef STEP
  #undef ENDW
  {auto rr=__builtin_amdgcn_permlane32_swap(__float_as_uint(l_reg),__float_as_uint(l_reg),false,false);l_reg=__uint_as_float(rr[0])+__uint_as_float(rr[1]);}
  if(hi==0)wsf[32+r32]=l_reg;asm volatile("s_waitcnt lgkmcnt(0)":::"memory");
  float rli[16];
  #pragma unroll
  for(int r=0;r<16;++r)rli[r]=__builtin_amdgcn_rcpf(wsf[32+crow(r,hi)]);
  bf16*Ow=Ou+(long)(wid*QBLK)*OP;
  { bf16*stg=(bf16*)(shm+LDS_OST)+wid*2048;
    #pragma unroll
    for(int r=0;r<16;++r){const int orow=crow(r,hi);
      #pragma unroll
      for(int d0=0;d0<2;++d0)stg[orow*64+d0*32+r32]=__float2bfloat16(o[d0][r]*rli[r]);}
    asm volatile("s_waitcnt lgkmcnt(0)":::"memory");
    #pragma unroll
    for(int i=0;i<4;++i){const int row=i*8+(lane>>3),ch=lane&7; const u32x4 v=*(const u32x4*)(stg+row*64+ch*8); ATTN_STORE16(Ow+(long)row*OP+ch*8,v);} }
  asm volatile("s_waitcnt lgkmcnt(0)\n\ts_barrier":::"memory");
  #undef DMA_K
  #undef DMA_V
  #undef CMASK
  #undef START
  #undef RESC
  #undef ROT
}
constexpr int ATTN_LDS_BYTES=LDS_BYTES;
#undef SBAR
#undef WAIT_BAR
}
#define LDS_WAIT() asm volatile("s_waitcnt lgkmcnt(0)" ::: "memory")

__device__ __forceinline__ void transpose_item(const float* W, int K, int N, bf16* WT, int k0, int n0, int dest_row0, LAS float* scr, int lane) {
    float t_[32];
#pragma unroll
    for (int i = 0; i < 32; ++i) t_[i] = W[(size_t)(k0 + 2 * i + (lane >> 5)) * N + n0 + (lane & 31)];
#pragma unroll
    for (int i = 0; i < 32; ++i) scr[(2 * i + (lane >> 5)) * 33 + (lane & 31)] = t_[i];
    LDS_WAIT(); asm volatile("" ::: "memory");
    const int c = lane & 7;
#pragma unroll
    for (int j = 0; j < 4; ++j) { const int n = (lane >> 3) + 8 * j; const LAS float* s = scr + (8 * c) * 33 + n;
        v4u o; o.x = pk2(s[0 * 33], s[1 * 33]); o.y = pk2(s[2 * 33], s[3 * 33]); o.z = pk2(s[4 * 33], s[5 * 33]); o.w = pk2(s[6 * 33], s[7 * 33]);
        *(GAS v4u*)(WT + (size_t)(dest_row0 + n) * K + k0 + 8 * c) = o; }
    LDS_WAIT(); asm volatile("" ::: "memory");
}

__device__ __forceinline__ void transpose_item8(const float* W, int K, int N, unsigned char* WT, int k0, int n0, int dest_row0, float sc, LAS float* scr, int lane) {
    float t_[32];
#pragma unroll
    for (int i = 0; i < 32; ++i) t_[i] = W[(size_t)(k0 + 2 * i + (lane >> 5)) * N + n0 + (lane & 31)];
#pragma unroll
    for (int i = 0; i < 32; ++i) scr[(2 * i + (lane >> 5)) * 33 + (lane & 31)] = __builtin_amdgcn_fmed3f(t_[i] * sc, -448.f, 448.f);
    LDS_WAIT(); asm volatile("" ::: "memory");
    const int c = lane & 7;
#pragma unroll
    for (int j = 0; j < 4; ++j) { const int n = (lane >> 3) + 8 * j; const LAS float* s = scr + (8 * c) * 33 + n;
        unsigned w0 = 0, w1 = 0;
        w0 = __builtin_amdgcn_cvt_pk_fp8_f32(s[0 * 33], s[1 * 33], w0, false); w0 = __builtin_amdgcn_cvt_pk_fp8_f32(s[2 * 33], s[3 * 33], w0, true);
        w1 = __builtin_amdgcn_cvt_pk_fp8_f32(s[4 * 33], s[5 * 33], w1, false); w1 = __builtin_amdgcn_cvt_pk_fp8_f32(s[6 * 33], s[7 * 33], w1, true);
        *(GAS v2u*)(WT + (size_t)(dest_row0 + n) * K + k0 + 8 * c) = (v2u){w0, w1}; }
    LDS_WAIT(); asm volatile("" ::: "memory");
}

struct ProIn { const float *hy_w_in, *at_w_in, *w_out, *w_mem_kv; };
__device__ __forceinline__ void phase_weights(const ProIn& P, unsigned char* ws, LAS unsigned char* lds, int gw, int NGW, int wave, int lane) {
    LAS float* scr = (LAS float*)(lds + wave * 16384);
    constexpr int I_HY = 16 * 80, I_AT = 16 * 48, I_OUT = 16 * 32, I_MKV = 16 * 16;
    constexpr int E0 = 2 * I_HY, E1 = E0 + 2 * I_AT, E2 = E1 + 4 * I_OUT, E3 = E2 + 4 * I_MKV;
    for (int it = gw; it < E3; it += NGW) {
        int r = it;
        if (r < E0) { const int j = r / I_HY, q = r % I_HY, kb = q / 80, nb = q % 80;
            transpose_item(P.hy_w_in + (size_t)j * DM * D_IN_HY, DM, D_IN_HY, (bf16*)(ws + WS_WHY) + (size_t)j * D_IN_HY * DM, 64 * kb, 32 * nb, 32 * nb, scr, lane); continue; }
        r -= E0;
        if (r < 2 * I_AT) { const int j = r / I_AT, q = r % I_AT, kb = q / 48, nb = q % 48;
            const int n0 = 32 * nb, o = n0 & 255;
            transpose_item(P.at_w_in + (size_t)j * DM * D_IN_AT, DM, D_IN_AT, (bf16*)(ws + WS_WAT) + (size_t)j * D_IN_AT * DM, 64 * kb, n0, (n0 & ~255) + 128 * ((o & 63) >> 5) + 32 * (o >> 6), scr, lane); continue; }
        r -= 2 * I_AT;
        if (r < 4 * I_OUT) { const int j = r / I_OUT, q = r % I_OUT, kb = q / 32, nb = q % 32;
            transpose_item(P.w_out + (size_t)j * DM * DM, DM, DM, (bf16*)(ws + WS_WOUT) + (size_t)j * DM * DM, 64 * kb, 32 * nb, 32 * nb, scr, lane); continue; }
        r -= 4 * I_OUT;
        { const int j = r / I_MKV, q = r % I_MKV, kb = q / 16, nb = q % 16;
            transpose_item(P.w_mem_kv + (size_t)j * DM * 512, DM, 512, (bf16*)(ws + WS_WMKV), 64 * kb, 32 * nb, j * 512 + 32 * nb, scr, lane); }
        (void)r;
    }
}

struct XwIn { const float *w_gate, *w_up, *w_down; unsigned char* ws; };
constexpr int XW_PER_EXPERT = 3 * 384, XW_PER_LAYER = NEXP * XW_PER_EXPERT;
constexpr int XW_QA_HY = 5, XW_QA_AT = 4, XW_QB = 3, XW_NA = 128 * NWAVES, XW_NB = 224 * NWAVES;
__host__ __device__ constexpr int xw_qa(int layer) { return (layer & 1) ? XW_QA_AT : XW_QA_HY; }
__host__ __device__ constexpr int xw_p0(int layer, bool sched) { return sched ? XW_PER_LAYER - xw_qa(layer) * XW_NA - XW_QB * XW_NB : XW_PER_LAYER; }
__device__ __forceinline__ void xw_item(const XwIn& B, int layer, int r, LAS float* scr, int lane) {
    const int j = layer * NEXP + r / XW_PER_EXPERT, q = r % XW_PER_EXPERT, kind = q / 384, qq = q % 384;
    if (kind < 2) { const int kb = qq / 24, nb = qq % 24, n0 = 32 * nb;
        transpose_item8((kind == 0 ? B.w_gate : B.w_up) + (size_t)j * DM * EFF, DM, EFF, B.ws + WS_W1 + (size_t)j * 1536 * DM, 64 * kb, n0, (n0 >> 7) * 256 + 128 * kind + (n0 & 127), W8_SCALE, scr, lane); }
    else { const int kb = qq / 32, nb = qq % 32;
        transpose_item8(B.w_down + (size_t)j * EFF * DM, EFF, DM, B.ws + WS_W2 + (size_t)j * DM * EFF, 64 * kb, 32 * nb, 32 * nb, W8_SCALE, scr, lane); }
}
__device__ __forceinline__ void phase_xw_p0(const XwIn& B, bool sched, LAS float* scr, int gw, int NGW, int lane) {
#pragma unroll 1
    for (int layer = 0; layer < DEPTH; ++layer) { const int n = xw_p0(layer, sched);
#pragma unroll 1
        for (int r = gw; r < n; r += NGW) xw_item(B, layer, r, scr, lane); }
}
__device__ __forceinline__ void xw_slice_a(const XwIn& B, int layer, LAS float* scr, int bx, int wave, int lane) {
    const int base = xw_p0(layer, true) + (bx - 128) * NWAVES + wave;
#pragma unroll 1
    for (int k = 0; k < xw_qa(layer); ++k) xw_item(B, layer, base + k * XW_NA, scr, lane);
}
__device__ __forceinline__ void xw_slice_b(const XwIn& B, int layer, LAS float* scr, int bx, int wave, int lane) {
    const int base = xw_p0(layer, true) + xw_qa(layer) * XW_NA + (bx - 32) * NWAVES + wave;
#pragma unroll 1
    for (int k = 0; k < XW_QB; ++k) xw_item(B, layer, base + k * XW_NB, scr, lane);
}

__device__ __forceinline__ void phase_wrg(const float* ffn_g, const float* router, float* WRG, int gtid, int nthreads) {
    for (int q = gtid; q < DEPTH * NEXP * DM; q += nthreads) { const int l = q / (NEXP * DM), e = (q / DM) % NEXP, d = q % DM; WRG[q] = ffn_g[l * DM + d] * router[((size_t)l * DM + d) * NEXP + e]; }
}

__device__ __forceinline__ void rms_row_bf16(const float* xrow, const float* g, bf16* orow, int lane) {
    const GAS f32x4* xr = (const GAS f32x4*)xrow + lane; const GAS f32x4* gr = (const GAS f32x4*)g + lane;
    f32x4 v[4]; float s = 0.f;
#pragma unroll
    for (int j = 0; j < 4; ++j) { v[j] = xr[64 * j]; s += (v[j].x * v[j].x + v[j].y * v[j].y) + (v[j].z * v[j].z + v[j].w * v[j].w); }
    const float rstd = 1.f / sqrtf(wave_sum(s) * (1.f / DM) + NORM_EPS);
    GAS v2u* o8 = (GAS v2u*)orow + lane;
#pragma unroll
    for (int j = 0; j < 4; ++j) { const f32x4 gg = gr[64 * j]; v2u w; w.x = pk2(v[j].x * rstd * gg.x, v[j].y * rstd * gg.y); w.y = pk2(v[j].z * rstd * gg.z, v[j].w * rstd * gg.w); o8[64 * j] = w; }
}

__device__ __forceinline__ void phase_mem_h2(const float* mem, const float* mem_g, const float* fw1, const float* fb1, const float* fw2, const float* fb2, const float* ffreq,
                                              unsigned char* ws, int gw, int NGW, int lane) {
    for (int m = gw; m < BATCH * MEM_LEN; m += NGW) rms_row_bf16(mem + (size_t)m * DM, mem_g, (bf16*)(ws + WS_MEMN) + (size_t)m * DM, lane);
    float* H2 = (float*)(ws + WS_H2);
    for (int it = gw; it < 2 * SEQ; it += NGW) {
        const int j = it / SEQ, n = it % SEQ;
        const float* w1 = fw1 + j * HY_EMB * HY_FILT; const float* w2 = fw2 + j * HY_FILT * HY_FILT;
        const float t = (float)n * (1.0f / (float)(SEQ - 1));
        const float w = (6.283185307179586f * (float)n) / (float)SEQ;
        float feat = 0.f;
        if (lane == 0) feat = t;
        else if (lane <= 16) { const float band = 1e-4f + (float)(lane - 1) * ((15.0f - 1e-4f) / 15.0f); feat = cosf(band * w); }
        else if (lane <= 32) { const float band = 1e-4f + (float)(lane - 17) * ((15.0f - 1e-4f) / 15.0f); feat = -sinf(band * w); }
        const float fr = ffreq[j * HY_FILT + lane];
        float a = fb1[j * HY_FILT + lane];
        for (int i = 0; i < HY_EMB; ++i) a += __shfl(feat, i) * w1[i * HY_FILT + lane];
        const float h1 = sinf(fr * a);
        float a2 = fb2[j * HY_FILT + lane];
        for (int i = 0; i < HY_FILT; ++i) a2 += __shfl(h1, i) * w2[i * HY_FILT + lane];
        H2[(size_t)it * HY_FILT + lane] = sinf(fr * a2);
    }
}

template <bool COMBINE, bool FINAL>
__device__ __forceinline__ void phase_norm(const float* hin, float* hout, const float* g, bf16* U, float* fout, const int* POS, const bf16* Y, int gw, int NGW, int lane) {
    int m = gw;
    if (m >= M_TOK) return;
    f32x4 cur[4]; int cpos = -1;
    { const GAS f32x4* xr = (const GAS f32x4*)(hin + (size_t)m * DM) + lane;
#pragma unroll
      for (int j = 0; j < 4; ++j) cur[j] = xr[64 * j];
      if (COMBINE) { const int b = m / SEQ, t = m % SEQ; if (lane < NEXP) cpos = POS[(size_t)(b * NEXP + lane) * SEQ + t]; } }
#pragma unroll 1
    for (; m < M_TOK; m += NGW) {
        const int mn = m + NGW; f32x4 nxt[4]; int npos = -1;
#pragma unroll
        for (int j = 0; j < 4; ++j) nxt[j] = cur[j];
        if (mn < M_TOK) { const GAS f32x4* xr = (const GAS f32x4*)(hin + (size_t)mn * DM) + lane;
#pragma unroll
            for (int j = 0; j < 4; ++j) nxt[j] = xr[64 * j];
            if (COMBINE) { const int b = mn / SEQ, t = mn % SEQ; if (lane < NEXP) npos = POS[(size_t)(b * NEXP + lane) * SEQ + t]; } }
        f32x4 v[4];
#pragma unroll
        for (int j = 0; j < 4; ++j) v[j] = cur[j];
        if (COMBINE) {
            const int b = m / SEQ;
            unsigned long long mask = __ballot(cpos >= 0);
            while (mask) {
                v2u y[4][4]; bool has[4];
#pragma unroll
                for (int k = 0; k < 4; ++k) { has[k] = mask != 0ull;
                    if (has[k]) { const int e = __builtin_amdgcn_readfirstlane(__builtin_ctzll(mask)); mask &= mask - 1ull; const int p = __builtin_amdgcn_readlane(cpos, e);
                        const GAS v2u* yr = (const GAS v2u*)(Y + ((size_t)(b * NEXP + e) * CAP + p) * DM) + lane;
#pragma unroll
                        for (int j = 0; j < 4; ++j) y[k][j] = yr[64 * j]; } }
#pragma unroll
                for (int k = 0; k < 4; ++k) if (has[k]) {
#pragma unroll
                    for (int j = 0; j < 4; ++j) { const v2u w = y[k][j]; v[j].x += bflo(w.x); v[j].y += bfhi(w.x); v[j].z += bflo(w.y); v[j].w += bfhi(w.y); } }
            }
            if (!FINAL) { GAS f32x4* ho = (GAS f32x4*)(hout + (size_t)m * DM) + lane;
#pragma unroll
                for (int j = 0; j < 4; ++j) ho[64 * j] = v[j]; }
        }
        float s = 0.f;
#pragma unroll
        for (int j = 0; j < 4; ++j) s += (v[j].x * v[j].x + v[j].y * v[j].y) + (v[j].z * v[j].z + v[j].w * v[j].w);
        const float rstd = 1.f / sqrtf(wave_sum(s) * (1.f / DM) + NORM_EPS);
        const GAS f32x4* gr = (const GAS f32x4*)g + lane;
        if (FINAL) { GAS f32x4* o = (GAS f32x4*)(fout + (size_t)m * DM) + lane;
#pragma unroll
            for (int j = 0; j < 4; ++j) o[64 * j] = v[j] * rstd * gr[64 * j]; }
        else { GAS v2u* o8 = (GAS v2u*)(U + (size_t)m * DM) + lane;
#pragma unroll
            for (int j = 0; j < 4; ++j) { const f32x4 gg = gr[64 * j]; v2u w; w.x = pk2(v[j].x * rstd * gg.x, v[j].y * rstd * gg.y); w.y = pk2(v[j].z * rstd * gg.z, v[j].w * rstd * gg.w); o8[64 * j] = w; } }
#pragma unroll
        for (int j = 0; j < 4; ++j) cur[j] = nxt[j];
        cpos = npos;
    }
}

__device__ __forceinline__ void phase_ffn_norm_router(const float* H, const float* g, const float* Wr, unsigned char* XN8, float* AFF, LAS unsigned char* lds, int gw, int NGW, int lane, int tid) {
    LAS f32x4* WL = (LAS f32x4*)lds;
    for (int q = tid; q < 64 * 64; q += NTHREADS) { const int ln = q & 63, s = q >> 6, e4 = s & 3, ji = s >> 2, i = ji & 3, j = ji >> 2; const int d = 4 * ln + i + 256 * j;
        WL[q] = *(const GAS f32x4*)(Wr + (size_t)d * NEXP + 4 * e4); }
    __syncthreads();
    constexpr int R = 4;
    const GAS f32x4* gr = (const GAS f32x4*)g + lane;
#pragma unroll 1
    for (int m0 = gw * R; m0 < M_TOK; m0 += NGW * R) {
        int lo_ = lane; asm volatile("" : "+v"(lo_));
        f32x4 v[R][4]; float rstd[R];
#pragma unroll
        for (int r = 0; r < R; ++r) { const GAS f32x4* xr = (const GAS f32x4*)(H + (size_t)(m0 + r) * DM) + lane;
#pragma unroll
            for (int j = 0; j < 4; ++j) v[r][j] = xr[64 * j]; }
#pragma unroll
        for (int r = 0; r < R; ++r) { float s = 0.f;
#pragma unroll
            for (int j = 0; j < 4; ++j) s += (v[r][j].x * v[r][j].x + v[r][j].y * v[r][j].y) + (v[r][j].z * v[r][j].z + v[r][j].w * v[r][j].w);
            rstd[r] = 1.f / sqrtf(wave_sum(s) * (1.f / DM) + NORM_EPS); }
        f32x4 lg[R][4];
#pragma unroll
        for (int r = 0; r < R; ++r)
#pragma unroll
            for (int e4 = 0; e4 < 4; ++e4) lg[r][e4] = (f32x4){0.f, 0.f, 0.f, 0.f};
#pragma unroll
        for (int j = 0; j < 4; ++j) { const f32x4 gg = gr[64 * j];
#pragma unroll
            for (int r = 0; r < R; ++r) { v[r][j] = v[r][j] * rstd[r] * gg;
                unsigned w = 0; w = __builtin_amdgcn_cvt_pk_fp8_f32(v[r][j].x, v[r][j].y, w, false); w = __builtin_amdgcn_cvt_pk_fp8_f32(v[r][j].z, v[r][j].w, w, true);
                ((GAS unsigned*)(XN8 + (size_t)(m0 + r) * DM) + lane)[64 * j] = w; }
#pragma unroll
            for (int i = 0; i < 4; ++i)
#pragma unroll
                for (int e4 = 0; e4 < 4; ++e4) { const f32x4 wv = WL[((j * 4 + i) * 4 + e4) * 64 + lo_];
#pragma unroll
                    for (int r = 0; r < R; ++r) { const float xs = v[r][j][i];
#pragma unroll
                        for (int c = 0; c < 4; ++c) asm("v_fmac_f32 %0, %1, %2" : "+v"(lg[r][e4][c]) : "v"(wv[c]), "v"(xs)); } }
            __builtin_amdgcn_sched_barrier(0); }
#pragma unroll
        for (int r = 0; r < R; ++r) {
            float l16[16];
#pragma unroll
            for (int e = 0; e < 16; ++e) l16[e] = wave_sum(lg[r][e >> 2][e & 3]);
            float mx = l16[0];
#pragma unroll
            for (int e = 1; e < 16; ++e) mx = fmaxf(mx, l16[e]);
            float den = 0.f;
#pragma unroll
            for (int e = 0; e < 16; ++e) { l16[e] = expf(l16[e] - mx); den += l16[e]; }
            float mine = 0.f;
#pragma unroll
            for (int e = 0; e < 16; ++e) mine = (lane == e) ? l16[e] : mine;
            const int m = m0 + r, b = m / SEQ, t = m % SEQ;
            if (lane < NEXP) AFF[(size_t)(b * NEXP + lane) * SEQ + t] = mine / den;
        }
    }
    __syncthreads();
}

__device__ __forceinline__ void phase_router_sum(const float* PLG, const float* PSS, float* RSTD, float* AFF, int gw, int NGW, int lane) {
    const int e = lane & 15, rq = lane >> 4;
    for (int m0 = gw * 4; m0 < M_TOK; m0 += NGW * 4) {
        const int m = m0 + rq;
        float lgt = 0.f;
#pragma unroll
        for (int slot = 0; slot < 16; ++slot) lgt += PLG[((size_t)slot * M_TOK + m) * 16 + e];
        float ss = PSS[(size_t)e * M_TOK + m];
#pragma unroll
        for (int o = 1; o < 16; o <<= 1) ss += __shfl_xor(ss, o);
        const float rstd = 1.f / sqrtf(ss * (1.f / DM) + NORM_EPS);
        lgt *= rstd;
        float mx = lgt;
#pragma unroll
        for (int o = 1; o < 16; o <<= 1) mx = fmaxf(mx, __shfl_xor(mx, o));
        const float ex = expf(lgt - mx); float den = ex;
#pragma unroll
        for (int o = 1; o < 16; o <<= 1) den += __shfl_xor(den, o);
        const int b = m / SEQ, t = m % SEQ;
        AFF[(size_t)(b * NEXP + e) * SEQ + t] = ex / den;
        if (e == 0) RSTD[m] = rstd;
    }
}

__device__ __forceinline__ int block_excl_scan(int v, LAS int* scr, int tid, int lane, int wave, int* tot) {
    int inc = v;
#pragma unroll
    for (int o = 1; o < 64; o <<= 1) { const int n = __shfl_up(inc, o); if (lane >= o) inc += n; }
    __syncthreads();
    if (lane == 63) scr[wave] = inc;
    __syncthreads();
    int base = 0, total = 0;
#pragma unroll
    for (int w = 0; w < NWAVES; ++w) { const int c = scr[w]; if (w < wave) base += c; total += c; }
    *tot = total;
    return base + inc - v;
}

__device__ __forceinline__ void phase_topk(const float* AFF, const float* RSTD, float* RS, int* IDX, float* GATE, int* POS, LAS unsigned char* ldsm, int blk, int nblk, int tid, int lane, int wave) {
    LAS int* hist = (LAS int*)ldsm;
    LAS int* sel = (LAS int*)(ldsm + 1024);
    LAS int* scr = (LAS int*)(ldsm + 1280);
    for (int g = blk; g < NGRP; g += nblk) {
        unsigned v[16];
        { const GAS v4u* src = (const GAS v4u*)(AFF + (size_t)g * SEQ) + tid * 4;
#pragma unroll
          for (int q = 0; q < 4; ++q) { const v4u w = src[q]; v[4 * q] = w.x; v[4 * q + 1] = w.y; v[4 * q + 2] = w.z; v[4 * q + 3] = w.w; } }
        unsigned prefix = 0u; int krem = CAP;
#pragma unroll 1
        for (int pass = 0; pass < 4; ++pass) {
            const int shift = 24 - 8 * pass;
            const unsigned himask = (pass == 0) ? 0u : (0xffffffffu << (shift + 8));
            __syncthreads();
            if (tid < 256) hist[tid] = 0;
            __syncthreads();
#pragma unroll
            for (int i = 0; i < 16; ++i) if ((v[i] & himask) == prefix) __hip_atomic_fetch_add(hist + ((v[i] >> shift) & 255u), 1, __ATOMIC_RELAXED, __HIP_MEMORY_SCOPE_WORKGROUP);
            __syncthreads();
            if (wave == 0) {
                int c[4]; int s = 0;
#pragma unroll
                for (int j = 0; j < 4; ++j) { c[j] = hist[255 - 4 * lane - j]; s += c[j]; }
                int inc = s;
#pragma unroll
                for (int o = 1; o < 64; o <<= 1) { const int n = __shfl_up(inc, o); if (lane >= o) inc += n; }
                int before = inc - s;
                if (before < krem && krem <= inc) {
                    int bin = 0, kk = krem - before; bool done = false;
#pragma unroll
                    for (int j = 0; j < 4; ++j) { if (!done) { if (kk <= c[j]) { bin = 255 - 4 * lane - j; done = true; } else kk -= c[j]; } }
                    sel[0] = bin; sel[1] = kk;
                }
            }
            __syncthreads();
            prefix |= ((unsigned)sel[0]) << shift; krem = sel[1];
        }
        int ceq = 0;
#pragma unroll
        for (int i = 0; i < 16; ++i) ceq += (v[i] == prefix) ? 1 : 0;
        int tot;
        int eqrank = block_excl_scan(ceq, scr, tid, lane, wave, &tot);
        int csel = 0; unsigned selmask = 0u;
#pragma unroll
        for (int i = 0; i < 16; ++i) { bool s = v[i] > prefix; if (v[i] == prefix) { s = eqrank < krem; ++eqrank; } if (s) { selmask |= 1u << i; ++csel; } }
        int slot = block_excl_scan(csel, scr, tid, lane, wave, &tot);
        const int b = g / NEXP;
        int pv[16];
#pragma unroll
        for (int i = 0; i < 16; ++i) {
            pv[i] = -1;
            if (selmask & (1u << i)) { pv[i] = slot; IDX[g * CAP + slot] = b * SEQ + tid * 16 + i; GATE[g * CAP + slot] = __builtin_bit_cast(float, v[i]); RS[g * CAP + slot] = RSTD[b * SEQ + tid * 16 + i]; ++slot; }
        }
        { GAS v4u* dst = (GAS v4u*)(POS + (size_t)g * SEQ) + tid * 4;
#pragma unroll
          for (int q = 0; q < 4; ++q) { v4u w; w.x = (unsigned)pv[4 * q]; w.y = (unsigned)pv[4 * q + 1]; w.z = (unsigned)pv[4 * q + 2]; w.w = (unsigned)pv[4 * q + 3]; dst[q] = w; } }
        __syncthreads();
    }
}

__device__ __forceinline__ void phase_gather(const bf16* XN, const int* IDX, bf16* XG, int gw, int NGW, int lane) {
    for (int r = gw; r < XROWS; r += NGW) {
        const int src = __builtin_amdgcn_readfirstlane(IDX[r]);
        const GAS v4u* s = (const GAS v4u*)(XN + (size_t)src * DM) + lane; GAS v4u* d = (GAS v4u*)(XG + (size_t)r * DM) + lane;
        const v4u a = s[0], b = s[64]; d[0] = a; d[64] = b;
    }
}

__device__ __forceinline__ void phase_qk_rope(bf16* P, const float* gq, const float* gk, int gw, int NGW, int lane) {
    const int hh = lane >> 2, part = lane & 3, axis = part >> 1, half = part & 1;
    const float* g = (hh < NQH ? gq : gk) + 16 * part;
    float gv[16], inv[16];
#pragma unroll
    for (int i = 0; i < 16; ++i) { gv[i] = g[i]; inv[i] = exp2f(-(float)i * (13.287712379549449f / 16.0f)); }
    const float osc = hh < NQH ? ATT_C2 : 1.0f;
    int m = gw; v4u c0 = (v4u){0u, 0u, 0u, 0u}, c1 = c0;
    if (m < M_TOK) { const GAS v4u* p = (const GAS v4u*)(P + (size_t)m * D_IN_AT + hh * HD + 16 * part); c0 = p[0]; c1 = p[1]; }
#pragma unroll 1
    for (; m < M_TOK; m += NGW) {
        const int t = m % SEQ; const float pos = (float)(axis == 0 ? (t >> 6) : (t & 63));
        GAS v4u* p = (GAS v4u*)(P + (size_t)m * D_IN_AT + hh * HD + 16 * part);
        const v4u w0 = c0, w1 = c1;
        if (m + NGW < M_TOK) { const GAS v4u* pn = (const GAS v4u*)(P + (size_t)(m + NGW) * D_IN_AT + hh * HD + 16 * part); c0 = pn[0]; c1 = pn[1]; }
        float x[16];
        x[0] = bflo(w0.x); x[1] = bfhi(w0.x); x[2] = bflo(w0.y); x[3] = bfhi(w0.y); x[4] = bflo(w0.z); x[5] = bfhi(w0.z); x[6] = bflo(w0.w); x[7] = bfhi(w0.w);
        x[8] = bflo(w1.x); x[9] = bfhi(w1.x); x[10] = bflo(w1.y); x[11] = bfhi(w1.y); x[12] = bflo(w1.z); x[13] = bfhi(w1.z); x[14] = bflo(w1.w); x[15] = bfhi(w1.w);
        float ss = 0.f;
#pragma unroll
        for (int i = 0; i < 16; ++i) ss += x[i] * x[i];
        ss += __shfl_xor(ss, 1); ss += __shfl_xor(ss, 2);
        const float rstd = 1.f / sqrtf(ss * (1.f / HD) + NORM_EPS);
        float o[16];
#pragma unroll
        for (int i = 0; i < 16; ++i) {
            const float xn = x[i] * rstd * gv[i]; const float xp = __shfl_xor(xn, 1);
            float sn, cs; sincosf(pos * inv[i], &sn, &cs);
            o[i] = (half == 0 ? (xn * cs - xp * sn) : (xp * sn + xn * cs)) * osc;
        }
        v4u r0, r1;
        r0.x = pk2(o[0], o[1]); r0.y = pk2(o[2], o[3]); r0.z = pk2(o[4], o[5]); r0.w = pk2(o[6], o[7]);
        r1.x = pk2(o[8], o[9]); r1.y = pk2(o[10], o[11]); r1.z = pk2(o[12], o[13]); r1.w = pk2(o[14], o[15]);
        p[0] = r0; p[1] = r1;
    }
}

__device__ __forceinline__ void phase_transpose_mix(const bf16* MIXT, bf16* MIX, int blk, int nblk, int tid) {
    for (int it = blk; it < (D_MAIN / 64) * (M_TOK / NTHREADS); it += nblk) {
        const int cb = it % (D_MAIN / 64), mb = it / (D_MAIN / 64); const int m = mb * NTHREADS + tid, c0 = cb * 64;
        unsigned w[32];
#pragma unroll
        for (int c = 0; c < 32; ++c) { const unsigned lo = MIXT[(size_t)(c0 + 2 * c) * M_TOK + m], hi = MIXT[(size_t)(c0 + 2 * c + 1) * M_TOK + m]; w[c] = lo | (hi << 16); }
        GAS v4u* d = (GAS v4u*)(MIX + (size_t)m * DM + c0);
#pragma unroll
        for (int q = 0; q < 8; ++q) { v4u o; o.x = w[4 * q]; o.y = w[4 * q + 1]; o.z = w[4 * q + 2]; o.w = w[4 * q + 3]; d[q] = o; }
    }
}
__device__ __forceinline__ void phase_taps(const float* H2j, const float* w3, bf16* TAPS, int gw, int NGW, int lane) {
    typedef float f32x16 __attribute__((ext_vector_type(16))); typedef short bf16x8_t __attribute__((ext_vector_type(8)));
    const float min_decay = -4.605170185988091f / 1.5f, max_decay = -4.605170185988091f / 0.3f;
    const int li = lane & 31, hi = lane >> 5;
#pragma unroll 1
    for (int it = gw; it < (FCOLS / 32) * (SEQ / 128); it += NGW) {
        const int ct = it % (FCOLS / 32), ng = it / (FCOLS / 32), col0 = ct * 32;
        bf16x8_t a[4];
#pragma unroll
        for (int s = 0; s < 4; ++s) { float t[8];
#pragma unroll
            for (int j = 0; j < 8; ++j) t[j] = w3[(size_t)(16 * s + 8 * hi + j) * FCOLS + col0 + li];
            v4u p; p.x = pk2(t[0], t[1]); p.y = pk2(t[2], t[3]); p.z = pk2(t[4], t[5]); p.w = pk2(t[6], t[7]); a[s] = __builtin_bit_cast(bf16x8_t, p); }
        f32x4 hv[4][8];
#pragma unroll
        for (int nt = 0; nt < 4; ++nt) { const GAS f32x4* hp = (const GAS f32x4*)(H2j + (size_t)(ng * 128 + nt * 32 + li) * HY_FILT + 8 * hi);
#pragma unroll
            for (int s = 0; s < 4; ++s) { hv[nt][2 * s] = hp[4 * s]; hv[nt][2 * s + 1] = hp[4 * s + 1]; } }
#pragma unroll
        for (int nt = 0; nt < 4; ++nt) {
            const int n0 = ng * 128 + nt * 32;
            f32x16 acc;
#pragma unroll
            for (int r = 0; r < 16; ++r) acc[r] = 0.f;
#pragma unroll
            for (int s = 0; s < 4; ++s) { const f32x4 v0 = hv[nt][2 * s], v1 = hv[nt][2 * s + 1];
                v4u p; p.x = pk2(v0.x, v0.y); p.y = pk2(v0.z, v0.w); p.z = pk2(v1.x, v1.y); p.w = pk2(v1.z, v1.w);
                acc = __builtin_amdgcn_mfma_f32_32x32x16_bf16(a[s], __builtin_bit_cast(bf16x8_t, p), acc, 0, 0, 0); }
            const float t = (float)(n0 + li) * (1.0f / (float)(SEQ - 1));
#pragma unroll
            for (int r = 0; r < 16; ++r) { const int col = col0 + (r & 3) + 8 * (r >> 2) + 4 * hi, c = col % D_MAIN;
                const float ad = fabsf(min_decay + (float)c * ((max_decay - min_decay) / (float)(D_MAIN - 1)));
                TAPS[(size_t)col * SEQ + n0 + li] = (bf16)f2bf(acc[r] * expf(-t * ad)); }
        }
    }
}

__device__ __forceinline__ constexpr float twc(int k) { constexpr float T[16] = {1.0f, 0.98078528040323043f, 0.92387953251128674f, 0.83146961230254524f, 0.70710678118654757f, 0.55557023301960218f, 0.38268343236508978f, 0.19509032201612825f,
    0.0f, -0.19509032201612825f, -0.38268343236508978f, -0.55557023301960218f, -0.70710678118654757f, -0.83146961230254524f, -0.92387953251128674f, -0.98078528040323043f}; return T[k]; }
__device__ __forceinline__ constexpr float tws(int k) { constexpr float T[16] = {0.0f, 0.19509032201612825f, 0.38268343236508978f, 0.55557023301960218f, 0.70710678118654757f, 0.83146961230254524f, 0.92387953251128674f, 0.98078528040323043f,
    1.0f, 0.98078528040323043f, 0.92387953251128674f, 0.83146961230254524f, 0.70710678118654757f, 0.55557023301960218f, 0.38268343236508978f, 0.19509032201612825f}; return T[k]; }
__device__ __forceinline__ constexpr int bitrev(int i, int bits) { int r = 0; for (int b = 0; b < bits; ++b) if (i & (1 << b)) r |= 1 << (bits - 1 - b); return r; }

template <int N, int LEN> struct FftStage {
    static __device__ __forceinline__ void run(float (&re)[N], float (&im)[N]) {
        constexpr int half = LEN / 2, step = 32 / LEN;
#pragma unroll
        for (int base = 0; base < N; base += LEN)
#pragma unroll
            for (int j = 0; j < half; ++j) {
                const int i0 = base + j, i1 = i0 + half, idx = j * step;
                const float ar = re[i0], ai = im[i0], br = re[i1], bi = im[i1];
                re[i0] = ar + br; im[i0] = ai + bi;
                const float dr = ar - br, di = ai - bi;
                if (idx == 0) { re[i1] = dr; im[i1] = di; }
                else if (idx == 8) { re[i1] = di; im[i1] = -dr; }
                else { const float c = twc(idx), s = tws(idx); re[i1] = dr * c + di * s; im[i1] = di * c - dr * s; }
            }
        if constexpr (LEN > 2) FftStage<N, LEN / 2>::run(re, im);
    }
};
template <int N, int BITS> __device__ __forceinline__ void fft_reg(float (&re)[N], float (&im)[N]) {
    FftStage<N, N>::run(re, im);
    float tr[N], ti[N];
#pragma unroll
    for (int i = 0; i < N; ++i) { tr[bitrev(i, BITS)] = re[i]; ti[bitrev(i, BITS)] = im[i]; }
#pragma unroll
    for (int i = 0; i < N; ++i) { re[i] = tr[i]; im[i] = ti[i]; }
}

__device__ __forceinline__ void fft16k(float (&re)[32], float (&im)[32], LAS f32x2* L, int tid_in) {
    int tid = tid_in; asm volatile("" : "+v"(tid));
    fft_reg<32, 5>(re, im);
#pragma unroll
    for (int k1 = 1; k1 < 32; ++k1) { const float fr = (float)((tid * k1) & 16383) * (1.0f / 16384.0f); const float c = __builtin_amdgcn_cosf(fr), s = __builtin_amdgcn_sinf(fr);
        const float r = re[k1], i = im[k1]; re[k1] = r * c + i * s; im[k1] = i * c - r * s; if ((k1 & 3) == 3) __builtin_amdgcn_sched_barrier(0); }
#pragma unroll
    for (int k1 = 0; k1 < 32; ++k1) L[k1 * 513 + tid] = (f32x2){re[k1], im[k1]};
    __syncthreads();
    const int n3 = tid & 31, ka = tid >> 5;
    float ar[16], ai[16], br[16], bi[16];
#pragma unroll
    for (int n2 = 0; n2 < 16; ++n2) { const f32x2 a = L[ka * 513 + n2 * 32 + n3], b = L[(ka + 16) * 513 + n2 * 32 + n3]; ar[n2] = a.x; ai[n2] = a.y; br[n2] = b.x; bi[n2] = b.y; }
    fft_reg<16, 4>(ar, ai); fft_reg<16, 4>(br, bi);
#pragma unroll
    for (int k2 = 1; k2 < 16; ++k2) { const float fr = (float)((n3 * k2) & 511) * (1.0f / 512.0f); const float c = __builtin_amdgcn_cosf(fr), s = __builtin_amdgcn_sinf(fr);
        float r = ar[k2], i = ai[k2]; ar[k2] = r * c + i * s; ai[k2] = i * c - r * s;
        r = br[k2]; i = bi[k2]; br[k2] = r * c + i * s; bi[k2] = i * c - r * s; if ((k2 & 3) == 3) __builtin_amdgcn_sched_barrier(0); }
    __syncthreads();
#pragma unroll
    for (int k2 = 0; k2 < 16; ++k2) { L[n3 * 513 + k2 * 32 + ka] = (f32x2){ar[k2], ai[k2]}; L[n3 * 513 + k2 * 32 + ka + 16] = (f32x2){br[k2], bi[k2]}; }
    __syncthreads();
#pragma unroll
    for (int q = 0; q < 32; ++q) { const f32x2 v = L[q * 513 + tid]; re[q] = v.x; im[q] = v.y; }
    fft_reg<32, 5>(re, im);
}

constexpr int HS_SP = SEQ + 16;
__device__ __forceinline__ void hy_stage(LAS bf16* S, int slot, const bf16* src, int tid) {
    LAS bf16* d = S + slot * HS_SP + 8;
    if (tid == 0) { d[-1] = 0; d[SEQ] = 0; }
#pragma unroll
    for (int q = 0; q < 2; ++q) { const int ch = q * NTHREADS + tid; *(LAS v4u*)(d + ch * 8) = *(const GAS v4u*)(src + ch * 8); }
}
__device__ __forceinline__ float hy_sc(const LAS bf16* S, int slot, int t, float w0, float w1, float w2) {
    const LAS bf16* p = S + slot * HS_SP + 8 + t;
    return bf2f(p[-1]) * w0 + bf2f(p[0]) * w1 + bf2f(p[1]) * w2;
}

__device__ __forceinline__ void phase_hyena_conv(const bf16* PT, const bf16* TAPS, const float* shortw, const float* skip, f32x2* XSall, bf16* MIXT,
                                                 LAS unsigned char* lds, int blk, int nblk, int tid_in, int lane, int wave, int pmode = 0) {
    LAS f32x2* L = (LAS f32x2*)lds; LAS bf16* S = (LAS bf16*)lds; LAS float* red = (LAS float*)(lds + LDS_MISC);
    f32x2* XS = XSall + (size_t)blk * 16384;
    f32x2* ZS = XS + 16384 * 256;
    constexpr int N = 16384;
#pragma unroll 1
    for (int c = blk; c < D_MAIN; c += nblk) {
        const bf16* hf0 = TAPS + (size_t)c * SEQ; const bf16* hb0 = TAPS + (size_t)(D_MAIN + c) * SEQ;
        const bf16* hf1 = TAPS + (size_t)(2 * D_MAIN + c) * SEQ; const bf16* hb1 = TAPS + (size_t)(3 * D_MAIN + c) * SEQ;
        const bf16* px1 = PT + (size_t)c * M_TOK; const bf16* px2 = PT + (size_t)(D_MAIN + c) * M_TOK; const bf16* pv = PT + (size_t)(2 * D_MAIN + c) * M_TOK;
        const float wx1[3] = {shortw[c], shortw[2304 + c], shortw[4608 + c]};
        const float wx2[3] = {shortw[D_MAIN + c], shortw[2304 + D_MAIN + c], shortw[4608 + D_MAIN + c]};
        const float wv[3] = {shortw[2 * D_MAIN + c], shortw[2304 + 2 * D_MAIN + c], shortw[4608 + 2 * D_MAIN + c]};
        const float sk0 = skip[c], sk1 = skip[D_MAIN + c];
        float re[32], im[32], vr[16], vi[16];
#pragma unroll 1
        for (int pass = 0; pass < 5; ++pass) {
            int tid = tid_in; asm volatile("" : "+v"(tid));
            if (pass == 0) {
#pragma unroll
                for (int r = 0; r < 16; ++r) { const int n = r * 512 + tid; re[r] = bf2f(hf0[n]); im[r] = bf2f(hf1[n]); }
#pragma unroll
                for (int r = 16; r < 32; ++r) { const int idx = (32 - r) * 512 - tid; const bool z = (idx == SEQ); const int ii = z ? 0 : idx; re[r] = z ? 0.f : bf2f(hb0[ii]); im[r] = z ? 0.f : bf2f(hb1[ii]); }
                float e0 = 0.f, e1 = 0.f;
                if (tid == 0) { e0 = bf2f(hb0[0]); e1 = bf2f(hb1[0]); }
                float s0 = fabsf(e0), s1 = fabsf(e1);
#pragma unroll
                for (int r = 0; r < 32; ++r) { s0 += fabsf(re[r]); s1 += fabsf(im[r]); }
                s0 = wave_sum(s0); s1 = wave_sum(s1);
                __syncthreads();
                if (lane == 0) { red[wave] = s0; red[8 + wave] = s1; }
                __syncthreads();
                float t0 = 0.f, t1 = 0.f;
#pragma unroll
                for (int w = 0; w < NWAVES; ++w) { t0 += red[w]; t1 += red[8 + w]; }
                const float sc0 = 1.0f / (t0 + 1e-6f), sc1 = 1.0f / (t1 + 1e-6f);
                re[0] += e0; im[0] += e1;
#pragma unroll
                for (int r = 0; r < 32; ++r) { re[r] *= sc0; im[r] *= sc1; }
            } else if (pass == 1) {
                __syncthreads();
                hy_stage(S, 0, pv, tid); hy_stage(S, 1, pv + SEQ, tid);
                __syncthreads();
#pragma unroll
                for (int r = 0; r < 16; ++r) { const int t = r * 512 + tid; re[r] = hy_sc(S, 0, t, wv[0], wv[1], wv[2]); im[r] = hy_sc(S, 1, t, wv[0], wv[1], wv[2]); vr[r] = re[r]; vi[r] = im[r]; }
#pragma unroll
                for (int r = 16; r < 32; ++r) { re[r] = 0.f; im[r] = 0.f; }
            }
            __syncthreads();
            fft16k(re, im, L, tid);
            if (pass == 0) {
#pragma unroll
                for (int r = 0; r < 32; ++r) XS[r * 512 + tid] = (f32x2){re[r], im[r]};
                __syncthreads();
            } else if (pass == 1 || pass == 3) {
#pragma unroll
                for (int r = 0; r < 32; ++r) {
                    const int f = r * 512 + tid; const f32x2 xa = XS[f], xb = XS[(N - f) & (N - 1)];
                    float kr, ki;
                    if (pass == 1) { kr = xa.x + xb.x; ki = xa.y - xb.y; } else { kr = xa.y + xb.y; ki = xb.x - xa.x; }
                    kr *= (0.5f / (float)N); ki *= (0.5f / (float)N);
                    const float zr_ = re[r], zi_ = im[r];
                    re[r] = zr_ * kr - zi_ * ki; im[r] = -(zr_ * ki + zi_ * kr);
                }
            } else if (pass == 2) {
                __syncthreads();
                hy_stage(S, 2, px1, tid); hy_stage(S, 3, px1 + SEQ, tid);
                __syncthreads();
#pragma unroll
                for (int r = 0; r < 16; ++r) { const int t = r * 512 + tid;
                    const float v0 = vr[r], v1 = vi[r];
                    const float g0 = hy_sc(S, 2, t, wx1[0], wx1[1], wx1[2]), g1 = hy_sc(S, 3, t, wx1[0], wx1[1], wx1[2]);
                    re[r] = g0 * (re[r] + sk0 * v0); im[r] = g1 * (-im[r] + sk0 * v1); ZS[t] = (f32x2){re[r], im[r]}; }
#pragma unroll
                for (int r = 16; r < 32; ++r) { re[r] = 0.f; im[r] = 0.f; }
            } else {
                __syncthreads();
                hy_stage(S, 0, px2, tid); hy_stage(S, 1, px2 + SEQ, tid);
                __syncthreads();
#pragma unroll
                for (int r = 0; r < 16; ++r) { const int t = r * 512 + tid;
                    const float g0 = hy_sc(S, 0, t, wx2[0], wx2[1], wx2[2]), g1 = hy_sc(S, 1, t, wx2[0], wx2[1], wx2[2]);
                    const f32x2 z = ZS[t];
                    const float o0 = g0 * (re[r] + sk1 * z.x), o1 = g1 * (-im[r] + sk1 * z.y);
                    MIXT[(size_t)c * M_TOK + t] = (bf16)f2bf(o0); MIXT[(size_t)c * M_TOK + SEQ + t] = (bf16)f2bf(o1); }
            }
        }
        __syncthreads();
    }
}
#ifndef MK_PER_PHASE
#define MK_PER_PHASE 0
#endif
#ifndef CONV_PMODE
#define CONV_PMODE 0
#endif
#ifndef REPMASK
#define REPMASK 0u
#endif
#define REP(kind) _Pragma("unroll 1") for (int r_ = 0; r_ < 1 + (int)((REPMASK >> (kind)) & 1u); ++r_)
struct Args {
    const float* in[24]; float* out; unsigned char* ws; int ph_lo, ph_hi;
};
constexpr int N_PHASES = 1 + (DEPTH - 1) + DEPTH * 8 - DEPTH / 2 + 1;

template <int QP, int KP>
__device__ __forceinline__ void run_attn(const bf16* Q, const bf16* K, const bf16* V, bf16* O, int NT, char* shm) {
    attn_body::attn_unit<8, QP, KP, DM>((const attn_body::bf16*)Q, (const attn_body::bf16*)K, (const attn_body::bf16*)V, (attn_body::bf16*)O, NT, shm);
}

__global__ void __launch_bounds__(NTHREADS, 2) hybrid_fwd(Args args) {
    extern __shared__ __attribute__((aligned(16))) unsigned char lds_raw[];
    LAS unsigned char* lds = (LAS unsigned char*)lds_raw;
    const int G = gridDim.x, bx = blockIdx.x;
    const int vcu = (G % 8 == 0) ? (bx % 8) * (G / 8) + bx / 8 : bx;
    const int NGW = G * NWAVES;
    unsigned char* ws = args.ws;
    const float* x = args.in[0]; const float* mem = args.in[1]; const float* mix_g = args.in[2]; const float* ffn_g = args.in[3]; const float* mem_g = args.in[4]; const float* fin_g = args.in[5];
    const float* hy_short = args.in[9]; const float* f_w1 = args.in[10]; const float* f_b1 = args.in[11]; const float* f_w2 = args.in[12]; const float* f_b2 = args.in[13];
    const float* f_w3 = args.in[14]; const float* f_freq = args.in[15]; const float* hy_skip = args.in[16]; const float* qg = args.in[18]; const float* kg = args.in[19]; const float* router = args.in[20];
    float* H = args.out;
    bf16* U = (bf16*)(ws + WS_U); bf16* PROJ = (bf16*)(ws + WS_PROJ); bf16* CQ = (bf16*)(ws + WS_CQ); bf16* MIX = (bf16*)(ws + WS_MIX); bf16* MIXT = (bf16*)(ws + WS_MIXT);
    float* AFF = (float*)(ws + WS_AFF); int* IDX = (int*)(ws + WS_IDX); float* GATE = (float*)(ws + WS_GATE); int* POS = (int*)(ws + WS_POS);
    bf16* XG = (bf16*)(ws + WS_XG); bf16* HID = (bf16*)(ws + WS_HID); bf16* Y = (bf16*)(ws + WS_Y); bf16* TAPS = (bf16*)(ws + WS_TAPS);
    const bf16* MKV = (const bf16*)(ws + WS_MKV);
    cg::grid_group grid = cg::this_grid();
    volatile LAS unsigned* bst = (volatile LAS unsigned*)(lds + LDS_MISC + 4096);
    if (threadIdx.x < 2) bst[threadIdx.x] = 0u;
    __syncthreads();
    XcdBarrier xbar = xcd_barrier_post((unsigned*)(ws + WS_CTL) + 1024, bst);
    const int lo = args.ph_lo, hi = args.ph_hi;
    const XwIn XW{args.in[21], args.in[22], args.in[23], ws}; const bool xw_sched = (G == 256);
    int ph = 0;
#define PHASE_BEGIN if (lo <= ph && ph < hi) { const int tid = opaque_tid(), lane = tid & 63, wave = __builtin_amdgcn_readfirstlane(tid >> 6), gw = vcu * NWAVES + wave; (void)lane; (void)gw;
#ifdef EXTRA_XBAR
#define PHASE_END   if (ph + 1 < hi) { if (ph == lo) grid.sync(); else { xcd_barrier(xbar); if (ph < EXTRA_XBAR) xcd_barrier(xbar); } } } ++ph;
#else
#define PHASE_END   if (ph + 1 < hi) { if (ph == lo) grid.sync(); else xcd_barrier(xbar); } } ++ph;
#endif

    PHASE_BEGIN
        ProIn P{args.in[8], args.in[17], args.in[7], args.in[6]};
        REP(0) { phase_weights(P, ws, lds, gw, NGW, wave, lane); phase_xw_p0(XW, xw_sched, (LAS float*)(lds + wave * 16384), gw, NGW, lane); }
        phase_wrg(ffn_g, router, (float*)(ws + WS_WRG), (int)(bx * NTHREADS + tid), (int)(G * NTHREADS));
        REP(1) phase_mem_h2(mem, mem_g, f_w1, f_b1, f_w2, f_b2, f_freq, ws, gw, NGW, lane);
        REP(3) phase_norm<false, false>(x, nullptr, mix_g, U, nullptr, nullptr, nullptr, gw, NGW, lane);
    PHASE_END

#pragma unroll 1
    for (int i = 0; i < DEPTH; ++i) {
        const bool hy = (i & 1) == 0; const int j = i >> 1;
        if (i > 0) {
        PHASE_BEGIN
            phase_norm<true, false>(H, H, mix_g + i * DM, U, nullptr, POS, Y, gw, NGW, lane);
        PHASE_END
        }
        PHASE_BEGIN
            if (i == 0) {
                pg8::Gemm g{(const bf16*)(ws + WS_MEMN), (const bf16*)(ws + WS_WMKV), BATCH * MEM_LEN, 2048, DM, 1 << 30, 1, 0};
                pg8::StaticOrder S; S.init(BATCH * MEM_LEN, 2048, G, bx);
                pg8::EpiRowBf16 E{(bf16*)(ws + WS_MKV), 2048, -1, 1.f};
                pg8::gemm_phase<pg8::EpiRowBf16, pg8::StaticOrder, true, true>(lds, g, S, E);
            }
            if (hy) {
                REP(4) phase_taps((const float*)(ws + WS_H2) + (size_t)j * SEQ * HY_FILT, f_w3 + (size_t)j * HY_FILT * FCOLS, TAPS, gw, NGW, lane);
                pg8::Gemm g{U, (const bf16*)(ws + WS_WHY) + (size_t)j * D_IN_HY * DM, M_TOK, D_IN_HY, DM, 1 << 30, 1, 0};
                pg8::StaticOrder S; S.init(M_TOK, D_IN_HY, G, bx);
                pg8::EpiHyIn E{PROJ, M_TOK, 9, CQ, ATT_C2};
                REP(5) pg8::gemm_phase<pg8::EpiHyIn, pg8::StaticOrder, true, true>(lds, g, S, E);
            } else {
                pg8::Gemm g{U, (const bf16*)(ws + WS_WAT) + (size_t)j * D_IN_AT * DM, M_TOK, D_IN_AT, DM, 1 << 30, 1, 0};
                pg8::StaticOrder S; S.init(M_TOK, D_IN_AT, G, bx);
                pg8::EpiAtIn E{PROJ, D_IN_AT, qg + j * HD, kg + j * HD, ATT_C2, NORM_EPS, SEQ - 1};
                REP(6) pg8::gemm_phase<pg8::EpiAtIn, pg8::StaticOrder, true, true>(lds, g, S, E);
            }
            if (xw_sched && bx >= 128) xw_slice_a(XW, i, (LAS float*)(lds + wave * 16384), bx, wave, lane);
        PHASE_END
        PHASE_BEGIN
            if (hy) {
                REP(8) phase_hyena_conv(PROJ, TAPS, hy_short + (size_t)j * 3 * 2304, hy_skip + (size_t)j * 2 * D_MAIN, (f32x2*)(ws + WS_FFTX), MIXT, lds, bx, G, tid, lane, wave);
                REP(9) for (int u = vcu; u < 256; u += G) { const int b = u >> 7, h4 = (u >> 5) & 3, qb = u & 31; const size_t row = (size_t)b * SEQ + qb * 256;
                    run_attn<256, 2048>(CQ + row * 256 + h4 * HD, MKV + (size_t)b * MEM_LEN * 2048 + i * 512 + h4 * HD, MKV + (size_t)b * MEM_LEN * 2048 + i * 512 + 256 + h4 * HD,
                                        MIX + row * DM + D_MAIN + h4 * HD, MEM_LEN / 64, (char*)lds_raw); }
            } else {
                REP(10) for (int u = vcu; u < 768; u += G) { const int bk = (u & 255) >> 5, qb = u & 31, hs = u >> 8, b = bk >> 2, kvh = bk & 3, h = kvh * 3 + hs; const size_t row = (size_t)b * SEQ + qb * 256;
                    run_attn<D_IN_AT, D_IN_AT>(PROJ + row * D_IN_AT + h * HD, PROJ + (size_t)b * SEQ * D_IN_AT + D_MAIN + kvh * HD, PROJ + (size_t)b * SEQ * D_IN_AT + D_MAIN + 256 + kvh * HD,
                                               MIX + row * DM + h * HD, SEQ / 64, (char*)lds_raw); }
                REP(9) for (int u = vcu; u < 256; u += G) { const int b = u >> 7, h4 = (u >> 5) & 3, qb = u & 31; const size_t row = (size_t)b * SEQ + qb * 256;
                    run_attn<D_IN_AT, 2048>(PROJ + row * D_IN_AT + 1280 + h4 * HD, MKV + (size_t)b * MEM_LEN * 2048 + i * 512 + h4 * HD, MKV + (size_t)b * MEM_LEN * 2048 + i * 512 + 256 + h4 * HD,
                                            MIX + row * DM + D_MAIN + h4 * HD, MEM_LEN / 64, (char*)lds_raw); }
            }
        PHASE_END
        if (hy) {
            PHASE_BEGIN
                REP(11) phase_transpose_mix(MIXT, MIX, bx, G, tid);
            PHASE_END
        }
        PHASE_BEGIN
            pg8::Gemm g{MIX, (const bf16*)(ws + WS_WOUT) + (size_t)i * DM * DM, M_TOK, DM, DM, 1 << 30, 1, 0};
            pg8::StaticOrder S; S.init(M_TOK, DM, G, bx);
            pg8::EpiOutX E{i == 0 ? x : (const float*)H, H, DM, ffn_g + i * DM, (const float*)(ws + WS_WRG) + (size_t)i * NEXP * DM, (unsigned char*)U, (float*)(ws + WS_PART), (float*)(ws + WS_PSS), M_TOK};
            pg8::gemm_phase<pg8::EpiOutX, pg8::StaticOrder, true, true>(lds, g, S, E);
        PHASE_END
        PHASE_BEGIN
            REP(13) phase_router_sum((const float*)(ws + WS_PART), (const float*)(ws + WS_PSS), (float*)(ws + WS_RSTD), AFF, gw, NGW, lane);
        PHASE_END
        PHASE_BEGIN
            REP(14) phase_topk(AFF, (const float*)(ws + WS_RSTD), (float*)(ws + WS_RS), IDX, GATE, POS, lds + LDS_MISC, bx, G, tid, lane, wave);
            if (xw_sched && bx >= 32) xw_slice_b(XW, i, (LAS float*)(lds + wave * 16384), bx, wave, lane);
        PHASE_END
        PHASE_BEGIN
            pg8::Gemm g{U, (const bf16*)(ws + WS_W1 + (size_t)i * NEXP * 1536 * DM), XROWS, 1536, DM / 2, 4, NEXP, (size_t)1536 * DM};
            pg8::StaticOrder S; S.init(XROWS, 1536, G, bx);
            pg8::EpiSwiGLU8 E{(unsigned char*)HID, EFF, 1.0f / W8_SCALE, (const float*)(ws + WS_RS)};
            REP(16) pg8::gemm_phase<pg8::EpiSwiGLU8, pg8::StaticOrder, true, true, true, true>(lds, g, S, E, IDX);
        PHASE_END
        PHASE_BEGIN
            pg8::Gemm g{HID, (const bf16*)(ws + WS_W2 + (size_t)i * NEXP * DM * EFF), XROWS, DM, EFF / 2, 4, NEXP, (size_t)DM * EFF};
            pg8::StaticOrder S; S.init(XROWS, DM, G, bx);
            pg8::EpiDown E{Y, DM, GATE, 1.0f / W8_SCALE};
            REP(17) pg8::gemm_phase<pg8::EpiDown, pg8::StaticOrder, true, true, false, true>(lds, g, S, E);
        PHASE_END
    }
    PHASE_BEGIN
        phase_norm<true, true>(H, nullptr, fin_g, nullptr, args.out, POS, Y, gw, NGW, lane);
    PHASE_END
#undef PHASE_BEGIN
#undef PHASE_END
}

extern "C" void kernel_launch(void* const* d_in, const int* in_sizes, int n_in, void* d_out, int out_size, void* d_ws, size_t ws_size, hipStream_t stream) {
    static int grid = 0;
    if (grid == 0) {
        if (n_in != 24 || out_size != M_TOK * DM || ws_size < WS_END) { fprintf(stderr, "kernel_launch: unexpected shapes (n_in %d out %d ws %zu need %zu)\n", n_in, out_size, ws_size, (size_t)WS_END); grid = -1; return; }
        int dev = 0, cus = 0, per_cu = 0;
        if (hipGetDevice(&dev) != hipSuccess || hipDeviceGetAttribute(&cus, hipDeviceAttributeMultiprocessorCount, dev) != hipSuccess) { grid = -1; return; }
        if (hipFuncSetAttribute((const void*)hybrid_fwd, hipFuncAttributeMaxDynamicSharedMemorySize, LDS_BYTES) != hipSuccess) { fprintf(stderr, "kernel_launch: hipFuncSetAttribute failed\n"); grid = -1; return; }
        if (hipOccupancyMaxActiveBlocksPerMultiprocessor(&per_cu, (const void*)hybrid_fwd, NTHREADS, LDS_BYTES) != hipSuccess || per_cu < 1) { fprintf(stderr, "kernel_launch: occupancy query says %d blocks/CU\n", per_cu); per_cu = 1; }
        (void)hipGetLastError();
        grid = cus;
    }
    if (grid < 0) return;
    if (hipMemsetAsync((char*)d_ws + WS_CTL, 0, 64 * 1024, stream) != hipSuccess) { fprintf(stderr, "kernel_launch: memset failed\n"); return; }
    Args a{};
    for (int i = 0; i < 24; ++i) a.in[i] = (const float*)d_in[i];
    a.out = (float*)d_out; a.ws = (unsigned char*)d_ws;
#if MK_PER_PHASE
    for (int li = 0; li < N_PHASES; ++li) {
        a.ph_lo = li; a.ph_hi = li + 1;
        void* kargs[] = {&a};
        hipError_t e = hipLaunchCooperativeKernel((const void*)hybrid_fwd, dim3(grid), dim3(NTHREADS), kargs, LDS_BYTES, stream);
        if (e != hipSuccess) { fprintf(stderr, "kernel_launch: launch %d failed: %s\n", li, hipGetErrorString(e)); break; }
    }
#else
    a.ph_lo = 0; a.ph_hi = N_PHASES;
    void* kargs[] = {&a};
    hipError_t e = hipLaunchCooperativeKernel((const void*)hybrid_fwd, dim3(grid), dim3(NTHREADS), kargs, LDS_BYTES, stream);
    if (e != hipSuccess) fprintf(stderr, "kernel_launch: cooperative launch failed: %s (grid %d)\n", hipGetErrorString(e), grid);
#endif
}
```

```cpp
#include <hip/hip_runtime.h>
#include <hip/hip_cooperative_groups.h>
#include <hip/hip_bf16.h>
#include <cmath>
#include <cstdio>
#include <cstdint>
namespace cg = cooperative_groups;

constexpr int BATCH = 2, SEQ = 8192, DM = 1024, DEPTH = 4, M_TOK = BATCH * SEQ;
constexpr int HD = 64, MEM_LEN = 256, D_MEM = 256, D_MAIN = 768, NQH = 12, NKVH = 4;
constexpr int D_IN_HY = 2560, D_IN_AT = 1536;
constexpr int NEXP = 16, CAP = 1024, EFF = 768, NGRP = BATCH * NEXP, XROWS = NGRP * CAP;
constexpr int HY_EMB = 33, HY_FILT = 64, FCOLS = 4 * D_MAIN;
constexpr float NORM_EPS = 1e-6f;
constexpr float W8_SCALE = 32.0f;
constexpr float ATT_C2 = 0.125f * 1.4426950408889634f;

constexpr size_t MiB = 1u << 20;
constexpr size_t WS_CTL = 0;
constexpr size_t WS_WHY = 2 * MiB;
constexpr size_t WS_WAT = 12 * MiB;
constexpr size_t WS_WOUT = 18 * MiB;
constexpr size_t WS_WMKV = 26 * MiB;
constexpr size_t WS_W1 = 32 * MiB;
constexpr size_t WS_W2 = 224 * MiB;
constexpr size_t WS_U = 320 * MiB;
constexpr size_t WS_PROJ = 352 * MiB;
constexpr size_t WS_CQ = WS_PROJ + 72 * MiB;
constexpr size_t WS_MIX = 432 * MiB;
constexpr size_t WS_MIXT = 464 * MiB;
constexpr size_t WS_AFF = 488 * MiB;
constexpr size_t WS_IDX = 489 * MiB;
constexpr size_t WS_GATE = WS_IDX + 128 * 1024;
constexpr size_t WS_POS = 490 * MiB;
constexpr size_t WS_XG = 492 * MiB;
constexpr size_t WS_HID = 556 * MiB;
constexpr size_t WS_TAPS = WS_XG;
constexpr size_t WS_Y = 604 * MiB;
constexpr size_t WS_FFTX = WS_Y;
constexpr size_t WS_H2 = 668 * MiB;
constexpr size_t WS_MEMN = 672 * MiB;
constexpr size_t WS_MKV = 673 * MiB;
constexpr size_t WS_PART = 676 * MiB;
constexpr size_t WS_PSS = 692 * MiB;
constexpr size_t WS_RSTD = 697 * MiB;
constexpr size_t WS_RS = WS_RSTD + 128 * 1024;
constexpr size_t WS_WRG = 698 * MiB;
constexpr size_t WS_END = 699 * MiB;

constexpr int LDS_RING = 0;
constexpr int LDS_MISC = 132 * 1024;
constexpr int LDS_BYTES = 140 * 1024;
constexpr int NTHREADS = 512, NWAVES = 8;

#define GAS __attribute__((address_space(1)))
#define LAS __attribute__((address_space(3)))
typedef unsigned short bf16;
typedef unsigned v4u __attribute__((ext_vector_type(4)));
typedef unsigned v2u __attribute__((ext_vector_type(2)));
typedef float f32x4 __attribute__((ext_vector_type(4)));
typedef float f32x2 __attribute__((ext_vector_type(2)));
__device__ __forceinline__ unsigned f2bf(float f) { unsigned u = __builtin_bit_cast(unsigned, f); return (u + 0x7fffu + ((u >> 16) & 1u)) >> 16; }
__device__ __forceinline__ unsigned pk2(float lo, float hi) { return f2bf(lo) | (f2bf(hi) << 16); }
__device__ __forceinline__ float bf2f(unsigned short h) { return __builtin_bit_cast(float, (unsigned)h << 16); }
__device__ __forceinline__ float bflo(unsigned w) { return __builtin_bit_cast(float, w << 16); }
__device__ __forceinline__ float bfhi(unsigned w) { return __builtin_bit_cast(float, w & 0xffff0000u); }
__device__ __forceinline__ float wave_sum(float v) {
#pragma unroll
    for (int o = 1; o < 64; o <<= 1) v += __shfl_xor(v, o);
    return v;
}
__device__ __forceinline__ int opaque_tid() { int t = threadIdx.x; asm volatile("" : "+v"(t)); return t; }
#define MK_PER_PHASE 0

#define XB_TMO      128
#define XB_XCNT(j)  (256  + 64 * (j))
#define XB_XSUB(j)  (1280 + 64 * (j))
#define XB_XGEN(j)  (2304 + 64 * (j))
#define XB_TOP      3328
#define XB_TOPGEN   3392
#define XCD_BAR_WORDS 3456
#define XB_SPIN_CAP (1u << 18)

__device__ __forceinline__ unsigned xb_ld(unsigned* p)              { return __hip_atomic_load(p, __ATOMIC_RELAXED, __HIP_MEMORY_SCOPE_AGENT); }
__device__ __forceinline__ unsigned xb_add(unsigned* p, unsigned v) { return __hip_atomic_fetch_add(p, v, __ATOMIC_RELAXED, __HIP_MEMORY_SCOPE_AGENT); }
__device__ __forceinline__ unsigned xb_xcc_id() { return (unsigned)__builtin_amdgcn_s_getreg((3 << 11) | 20) & 0xFu; }
#define XB_SPIN(cond, bar) do { unsigned _sp = 0; while (cond) { __builtin_amdgcn_s_sleep(1); \
    if ((++_sp & 255u) == 0u) { if (xb_ld(&(bar)[XB_TMO])) break; if (_sp > XB_SPIN_CAP) { atomicAdd(&(bar)[XB_TMO], 1u); break; } } } } while (0)

struct XcdBarrier {
    unsigned* bar; unsigned x;
    volatile LAS unsigned* st;
};

__device__ __forceinline__ XcdBarrier xcd_barrier_post(unsigned* bar, volatile LAS unsigned* st) {
    XcdBarrier b; b.bar = bar; b.x = xb_xcc_id(); b.st = st;
    if (threadIdx.x == 0) (void)xb_add(&bar[XB_XCNT(b.x)], 1u);
    return b;
}
__device__ __forceinline__ void xcd_barrier_complete(unsigned* bar, unsigned x, unsigned& nloc, unsigned& nx) {
    const unsigned G = gridDim.x * gridDim.y * gridDim.z;
    unsigned sum, cnt, mine, sp = 0u;
    for (;;) {
        sum = 0u; cnt = 0u; mine = 0u;
#pragma unroll
        for (unsigned j = 0; j < 16; ++j) { const unsigned c = xb_ld(&bar[XB_XCNT(j)]); sum += c; cnt += (c > 0u) ? 1u : 0u; mine = (j == x) ? c : mine; }
        if (sum == G) break;
        __builtin_amdgcn_s_sleep(1);
        if ((++sp & 255u) == 0u) { if (xb_ld(&bar[XB_TMO])) break; if (sp > XB_SPIN_CAP) { atomicAdd(&bar[XB_TMO], 1u); break; } }
    }
    nloc = mine > 0u ? mine : 1u; nx = cnt > 0u ? cnt : 1u;
}

__device__ __forceinline__ void xcd_barrier(const XcdBarrier& b) {
    asm volatile("s_waitcnt vmcnt(0)" ::: "memory");
    __syncthreads();
    if (threadIdx.x == 0) {
        unsigned* bar = b.bar;
        __builtin_amdgcn_s_waitcnt(0);
        unsigned nloc = b.st[0], nx = b.st[1];
        if (nloc == 0u) { xcd_barrier_complete(bar, b.x, nloc, nx); b.st[0] = nloc; b.st[1] = nx; }
        const unsigned old = xb_add(&bar[XB_XSUB(b.x)], 1u);
        const unsigned gen = old / nloc;
        if (old + 1u == (gen + 1u) * nloc) {
            __builtin_amdgcn_fence(__ATOMIC_RELEASE, "agent");
            asm volatile("s_waitcnt vmcnt(0)" ::: "memory");
            const unsigned og = xb_add(&bar[XB_TOP], 1u);
            const unsigned tg = og / nx;
            if (og + 1u == (tg + 1u) * nx) xb_add(&bar[XB_TOPGEN], 1u);
            else XB_SPIN(xb_ld(&bar[XB_TOPGEN]) == tg, bar);
            __builtin_amdgcn_fence(__ATOMIC_ACQUIRE, "agent");
            xb_add(&bar[XB_XGEN(b.x)], 1u);
            asm volatile("s_waitcnt vmcnt(0)" ::: "memory");
        } else {
            XB_SPIN(xb_ld(&bar[XB_XGEN(b.x)]) == gen, bar);
            __builtin_amdgcn_fence(__ATOMIC_ACQUIRE, "agent");
            asm volatile("s_waitcnt vmcnt(0)" ::: "memory");
        }
    }
    __syncthreads();
}
namespace pg8 {
#define PG8_LAS __attribute__((address_space(3)))
typedef unsigned short bf16_t;
typedef short bf16x8 __attribute__((ext_vector_type(8)));
typedef float f32x4 __attribute__((ext_vector_type(4)));
typedef unsigned u32x4 __attribute__((ext_vector_type(4)));
constexpr int BM = 256, BK = 64, HALF = 128, HTB = HALF * BK * 2  , STAGE_BYTES = 8 * HTB, NXCD = 8, WGM = 8;

__host__ __device__ __forceinline__ int lds_byte(int r, int c) { const int st = (r >> 4) * 2 + (c >> 5), rr = r & 15, cc = c & 31, ob = rr * 64 + cc * 2; return st * 1024 + (ob ^ (((ob >> 9) & 1) << 5)); }
__host__ __device__ __forceinline__ void stage_rc(int b, int& R, int& C) { const int st = b / 1024, sb = b % 1024, swz = sb ^ (((sb >> 9) & 1) << 5); R = (st >> 1) * 16 + swz / 64; C = (st & 1) * 32 + (swz % 64) / 2; }
__host__ __device__ __forceinline__ int perm32(int rho) { const int n = rho >> 4, i = rho & 15; return 8 * (i >> 2) + 4 * n + (i & 3); }

struct Unit { int pm, pn; };
struct Gemm { const bf16_t* A; const bf16_t* Bt; int M, N, K; int gdiv, gmod; size_t gstride; };

struct StaticOrder {
    int nM, nN, nwg, G, c;
    __host__ __device__ void init(int M, int N, int G_, int c_) { nM = M / BM; nN = N / BM; nwg = nM * nN; G = G_; c = c_; }
    __host__ __device__ bool next(int i, Unit& u) const {
        const long L = (long)i * G + c; if (L >= nwg) return false;
        int wgid = (int)L; { const int q = nwg / NXCD, r = nwg % NXCD, xcd = wgid % NXCD, off = wgid / NXCD; wgid = (xcd < r ? xcd * (q + 1) : r * (q + 1) + (xcd - r) * q) + off; }
        const int nig = WGM * nN, gid = wgid / nig, fm = gid * WGM, gsz = (nM - fm) < WGM ? (nM - fm) : WGM;
        u.pm = fm + ((wgid % nig) % gsz); u.pn = (wgid % nig) / gsz; return true;
    }
    __device__ __forceinline__ void a_ready(const Unit&) const {}
    __device__ __forceinline__ void done(const Unit&) const {}
};


__device__ __forceinline__ unsigned cvt_pk_bf16(float lo, float hi) { unsigned r; asm volatile("v_cvt_pk_bf16_f32 %0, %1, %2" : "=v"(r) : "v"(lo), "v"(hi)); return r; }
typedef unsigned u32x2 __attribute__((ext_vector_type(2)));
struct EpiRowBf16 {
    static constexpr bool PERM = false, AFTER_DRAIN = false;
    bf16_t* O; int ldc; int sc_pn; float sc;
    __device__ __forceinline__ void operator()(const f32x4 (&acc)[2][2][4][2], const Unit& u, int wr, int wc, int fr, int fq) const {
        const float s = (u.pn == sc_pn) ? sc : 1.f;
        const int row0 = u.pm * BM + wr * 64 + fr, col0 = u.pn * BM + wc * 32 + 4 * fq;
#pragma unroll
        for (int ai = 0; ai < 2; ++ai)
#pragma unroll
            for (int m = 0; m < 4; ++m) { bf16_t* rowp = O + (size_t)(row0 + ai * HALF + m * 16) * ldc + col0;
#pragma unroll
                for (int bj = 0; bj < 2; ++bj)
#pragma unroll
                    for (int n = 0; n < 2; ++n) { const f32x4 v = acc[ai][bj][m][n] * s; u32x2 w; w.x = cvt_pk_bf16(v[0], v[1]); w.y = cvt_pk_bf16(v[2], v[3]);
                        *(u32x2*)(rowp + bj * HALF + n * 16) = w; } }
    }
};
struct EpiHyIn {
    static constexpr bool PERM = false, AFTER_DRAIN = false;
    bf16_t* OT; int ldt; int tp_tiles; bf16_t* CQ; float sc;
    __device__ __forceinline__ void operator()(const f32x4 (&acc)[2][2][4][2], const Unit& u, int wr, int wc, int fr, int fq) const {
        const int row0 = u.pm * BM + wr * 64 + fr;
        if (u.pn < tp_tiles) {
            const int col0 = u.pn * BM + wc * 32 + 4 * fq;
#pragma unroll
            for (int ai = 0; ai < 2; ++ai)
#pragma unroll
                for (int m = 0; m < 4; ++m) { const int row = row0 + ai * HALF + m * 16;
#pragma unroll
                    for (int bj = 0; bj < 2; ++bj)
#pragma unroll
                        for (int n = 0; n < 2; ++n) { const f32x4 v = acc[ai][bj][m][n]; const unsigned w0 = cvt_pk_bf16(v[0], v[1]), w1 = cvt_pk_bf16(v[2], v[3]);
                            bf16_t* p = OT + (size_t)(col0 + bj * HALF + n * 16) * ldt + row;
                            p[0] = (bf16_t)(w0 & 0xffffu); p[(size_t)ldt] = (bf16_t)(w0 >> 16); p[(size_t)2 * ldt] = (bf16_t)(w1 & 0xffffu); p[(size_t)3 * ldt] = (bf16_t)(w1 >> 16); } }
        } else {
            const int col0 = wc * 32 + 4 * fq;
#pragma unroll
            for (int ai = 0; ai < 2; ++ai)
#pragma unroll
                for (int m = 0; m < 4; ++m) { bf16_t* rowp = CQ + (size_t)(row0 + ai * HALF + m * 16) * 256 + col0;
#pragma unroll
                    for (int bj = 0; bj < 2; ++bj)
#pragma unroll
                        for (int n = 0; n < 2; ++n) { const f32x4 v = acc[ai][bj][m][n] * sc; u32x2 w; w.x = cvt_pk_bf16(v[0], v[1]); w.y = cvt_pk_bf16(v[2], v[3]);
                            *(u32x2*)(rowp + bj * HALF + n * 16) = w; } }
        }
    }
};
struct EpiAtIn {
    static constexpr bool PERM = false, AFTER_DRAIN = false;
    bf16_t* O; int ldc; const float* gq; const float* gk; float csc; float eps; int seq_mask;
    __device__ __forceinline__ void operator()(const f32x4 (&acc)[2][2][4][2], const Unit& u, int wr, int wc, int fr, int fq) const {
        const int row0 = u.pm * BM + wr * 64 + fr, colb = u.pn * BM + wc * 64 + 4 * fq;
        if (u.pn <= 3) {
            const float* gp = (u.pn == 3 ? gk : gq) + 4 * fq; const float osc = (u.pn == 3) ? 1.f : csc;
            float invr[4];
#pragma unroll
            for (int q = 0; q < 4; ++q) invr[q] = exp2f(-(float)(4 * fq + q) * (13.287712379549449f / 16.0f)) * 0.15915494309189535f;
#pragma unroll
            for (int ai = 0; ai < 2; ++ai)
#pragma unroll
                for (int m = 0; m < 4; ++m) {
                    const int row = row0 + ai * HALF + m * 16; int t = row & seq_mask; asm volatile("" : "+v"(t));
                    float ss = 0.f;
#pragma unroll
                    for (int bj = 0; bj < 2; ++bj)
#pragma unroll
                        for (int n = 0; n < 2; ++n) { const f32x4 x = acc[ai][bj][m][n]; ss += (x[0] * x[0] + x[1] * x[1]) + (x[2] * x[2] + x[3] * x[3]); }
                    ss += __shfl_xor(ss, 16); ss += __shfl_xor(ss, 32);
                    const float rs = osc * __builtin_amdgcn_rsqf(ss * (1.0f / 64.0f) + eps);
                    bf16_t* rowp = O + (size_t)row * ldc + colb;
#pragma unroll
                    for (int bj = 0; bj < 2; ++bj) {
                        const float pos = (float)(bj == 0 ? (t >> 6) : (t & 63));
                        const f32x4 xa = acc[ai][bj][m][0] * rs * *(const f32x4*)(gp + 32 * bj), xb = acc[ai][bj][m][1] * rs * *(const f32x4*)(gp + 32 * bj + 16);
                        f32x4 oa, ob;
#pragma unroll
                        for (int q = 0; q < 4; ++q) { const float rev = pos * invr[q]; const float c = __builtin_amdgcn_cosf(rev), s = __builtin_amdgcn_sinf(rev);
                            oa[q] = xa[q] * c - xb[q] * s; ob[q] = xa[q] * s + xb[q] * c; }
                        u32x2 w; w.x = cvt_pk_bf16(oa[0], oa[1]); w.y = cvt_pk_bf16(oa[2], oa[3]); *(u32x2*)(rowp + 32 * bj) = w;
                        w.x = cvt_pk_bf16(ob[0], ob[1]); w.y = cvt_pk_bf16(ob[2], ob[3]); *(u32x2*)(rowp + 32 * bj + 16) = w;
                    }
                    asm volatile("" ::: "memory");
                }
        } else {
            const float s = (u.pn == 5) ? csc : 1.f;
#pragma unroll
            for (int ai = 0; ai < 2; ++ai)
#pragma unroll
                for (int m = 0; m < 4; ++m) { bf16_t* rowp = O + (size_t)(row0 + ai * HALF + m * 16) * ldc + colb;
#pragma unroll
                    for (int bj = 0; bj < 2; ++bj)
#pragma unroll
                        for (int n = 0; n < 2; ++n) { const f32x4 v = acc[ai][bj][m][n] * s; u32x2 w; w.x = cvt_pk_bf16(v[0], v[1]); w.y = cvt_pk_bf16(v[2], v[3]);
                            *(u32x2*)(rowp + 32 * bj + 16 * n) = w; } }
        }
    }
};
struct EpiResF32 {
    static constexpr bool PERM = false, AFTER_DRAIN = false;
    const float* res; float* out; int ldc;
    __device__ __forceinline__ void operator()(const f32x4 (&acc)[2][2][4][2], const Unit& u, int wr, int wc, int fr, int fq) const {
        const int row0 = u.pm * BM + wr * 64 + fr, col0 = u.pn * BM + wc * 32 + 4 * fq;
#pragma unroll
        for (int ai = 0; ai < 2; ++ai)
#pragma unroll
            for (int m = 0; m < 4; ++m) { const size_t off = (size_t)(row0 + ai * HALF + m * 16) * ldc + col0;
#pragma unroll
                for (int bj = 0; bj < 2; ++bj)
#pragma unroll
                    for (int n = 0; n < 2; ++n) { const f32x4 r = *(const f32x4*)(res + off + bj * HALF + n * 16); *(f32x4*)(out + off + bj * HALF + n * 16) = r + acc[ai][bj][m][n]; } }
    }
};
__device__ __forceinline__ unsigned pk4_fp8_sat(const f32x4 x) {
    unsigned w = 0;
    w = __builtin_amdgcn_cvt_pk_fp8_f32(__builtin_amdgcn_fmed3f(x[0], -448.f, 448.f), __builtin_amdgcn_fmed3f(x[1], -448.f, 448.f), w, false);
    w = __builtin_amdgcn_cvt_pk_fp8_f32(__builtin_amdgcn_fmed3f(x[2], -448.f, 448.f), __builtin_amdgcn_fmed3f(x[3], -448.f, 448.f), w, true);
    return w;
}
struct EpiOutX {
    static constexpr bool PERM = false, AFTER_DRAIN = false;
    const float* res; float* out; int ldc; const float* gain; const float* WrG; unsigned char* XN8; float* PLG; float* PSS; int M;
    static __device__ __forceinline__ void split8(const f32x4 a, const f32x4 b, bf16x8& hi, bf16x8& lo) {
        u32x4 h, l; float r[8] = {a[0], a[1], a[2], a[3], b[0], b[1], b[2], b[3]};
#pragma unroll
        for (int k = 0; k < 4; ++k) { const unsigned p = cvt_pk_bf16(r[2 * k], r[2 * k + 1]); h[k] = p;
            const float d0 = r[2 * k] - __builtin_bit_cast(float, p << 16), d1 = r[2 * k + 1] - __builtin_bit_cast(float, p & 0xffff0000u); l[k] = cvt_pk_bf16(d0, d1); }
        hi = __builtin_bit_cast(bf16x8, h); lo = __builtin_bit_cast(bf16x8, l);
    }
    __device__ __forceinline__ void operator()(f32x4 (&acc)[2][2][4][2], const Unit& u, int wr, int wc, int fr, int fq) const {
        const int row0 = u.pm * BM + wr * 64 + fr, col0 = u.pn * BM + wc * 32 + 4 * fq, slot = u.pn * 4 + wc;
        bf16x8 whi[2], wlo[2];
#pragma unroll
        for (int bj = 0; bj < 2; ++bj) { const float* wp = WrG + (size_t)fr * ldc + col0 + bj * HALF; split8(*(const f32x4*)wp, *(const f32x4*)(wp + 16), whi[bj], wlo[bj]); }
#pragma unroll
        for (int ai = 0; ai < 2; ++ai)
#pragma unroll
            for (int m = 0; m < 4; ++m) { const int row = row0 + ai * HALF + m * 16; const size_t off = (size_t)row * ldc + col0; float ss = 0.f; f32x4 lg = (f32x4){0.f, 0.f, 0.f, 0.f};
#pragma unroll
                for (int bj = 0; bj < 2; ++bj) {
#pragma unroll
                    for (int n = 0; n < 2; ++n) { const int co = bj * HALF + n * 16;
                        const f32x4 h = *(const f32x4*)(res + off + co) + acc[ai][bj][m][n]; acc[ai][bj][m][n] = h; *(f32x4*)(out + off + co) = h;
                        ss += (h[0] * h[0] + h[1] * h[1]) + (h[2] * h[2] + h[3] * h[3]);
                        const f32x4 x = h * *(const f32x4*)(gain + col0 + co);
                        *(unsigned*)(XN8 + off + co) = pk4_fp8_sat(x); }
                    bf16x8 hhi, hlo; split8(acc[ai][bj][m][0], acc[ai][bj][m][1], hhi, hlo);
                    lg = __builtin_amdgcn_mfma_f32_16x16x32_bf16(wlo[bj], hhi, lg, 0, 0, 0);
                    lg = __builtin_amdgcn_mfma_f32_16x16x32_bf16(whi[bj], hlo, lg, 0, 0, 0);
                    lg = __builtin_amdgcn_mfma_f32_16x16x32_bf16(whi[bj], hhi, lg, 0, 0, 0); }
                ss += __shfl_xor(ss, 16); ss += __shfl_xor(ss, 32);
                if (fq == 0) PSS[(size_t)slot * M + row] = ss;
                *(f32x4*)(PLG + ((size_t)slot * M + row) * 16 + 4 * fq) = lg;
                asm volatile("" ::: "memory"); }
    }
};
struct EpiSwiGLU {
    static constexpr bool PERM = false, AFTER_DRAIN = false;
    bf16_t* O; int ldc;
    __device__ __forceinline__ void operator()(const f32x4 (&acc)[2][2][4][2], const Unit& u, int wr, int wc, int fr, int fq) const {
        const int row0 = u.pm * BM + wr * 64 + fr, col0 = u.pn * HALF + wc * 32 + 4 * fq;
#pragma unroll
        for (int ai = 0; ai < 2; ++ai)
#pragma unroll
            for (int m = 0; m < 4; ++m) { bf16_t* rowp = O + (size_t)(row0 + ai * HALF + m * 16) * ldc + col0;
#pragma unroll
                for (int n = 0; n < 2; ++n) { const f32x4 g = acc[ai][0][m][n], up = acc[ai][1][m][n]; f32x4 h;
#pragma unroll
                    for (int q = 0; q < 4; ++q) h[q] = g[q] * up[q] * __builtin_amdgcn_rcpf(1.f + __expf(-g[q]));
                    u32x2 w; w.x = cvt_pk_bf16(h[0], h[1]); w.y = cvt_pk_bf16(h[2], h[3]); *(u32x2*)(rowp + n * 16) = w; } }
    }
};
struct EpiSwiGLU8 {
    static constexpr bool PERM = false, AFTER_DRAIN = false;
    unsigned char* O; int ldc; float wsc; const float* rs;
    __device__ __forceinline__ void operator()(const f32x4 (&acc)[2][2][4][2], const Unit& u, int wr, int wc, int fr, int fq) const {
        const int row0 = u.pm * BM + wr * 64 + fr, col0 = u.pn * HALF + wc * 32 + 4 * fq;
#pragma unroll
        for (int ai = 0; ai < 2; ++ai)
#pragma unroll
            for (int m = 0; m < 4; ++m) { const int row = row0 + ai * HALF + m * 16; unsigned char* rowp = O + (size_t)row * ldc + col0; const float sc = wsc * rs[row];
#pragma unroll
                for (int n = 0; n < 2; ++n) { const f32x4 g = acc[ai][0][m][n] * sc, up = acc[ai][1][m][n] * sc; f32x4 h;
#pragma unroll
                    for (int q = 0; q < 4; ++q) h[q] = g[q] * up[q] * __builtin_amdgcn_rcpf(1.f + __expf(-g[q]));
                    *(unsigned*)(rowp + n * 16) = pk4_fp8_sat(h); } }
    }
};
struct EpiDown {
    static constexpr bool PERM = false, AFTER_DRAIN = false;
    bf16_t* O; int ldc; const float* gate; float wsc;
    __device__ __forceinline__ void operator()(const f32x4 (&acc)[2][2][4][2], const Unit& u, int wr, int wc, int fr, int fq) const {
        const int row0 = u.pm * BM + wr * 64 + fr, col0 = u.pn * BM + wc * 32 + 4 * fq;
#pragma unroll
        for (int ai = 0; ai < 2; ++ai)
#pragma unroll
            for (int m = 0; m < 4; ++m) { const int row = row0 + ai * HALF + m * 16; const float gs = gate[row] * wsc; bf16_t* rowp = O + (size_t)row * ldc + col0;
#pragma unroll
                for (int bj = 0; bj < 2; ++bj)
#pragma unroll
                    for (int n = 0; n < 2; ++n) { const f32x4 v = acc[ai][bj][m][n] * gs; u32x2 w; w.x = cvt_pk_bf16(v[0], v[1]); w.y = cvt_pk_bf16(v[2], v[3]);
                        *(u32x2*)(rowp + bj * HALF + n * 16) = w; } }
    }
};
template <class Epi, class Sched, bool ALIGN_EPI = false, bool SP2 = false, bool GATHER = false, bool FP8 = false>
__device__ __forceinline__ void gemm_phase(PG8_LAS unsigned char* lds, const Gemm g, const Sched& S, const Epi& E, const int* gidx = nullptr) {
    const int tid = opaque_tid(), wid = __builtin_amdgcn_readfirstlane(tid >> 6), lane = tid & 63, wr = wid >> 2, wc = wid & 3, fr = lane & 15, fq = lane >> 4;
    const int K = g.K, nt = K / BK;
    unsigned voffA[2], voffB[2];
#pragma unroll
    for (int i = 0; i < 2; ++i) { int R, C; stage_rc(tid * 16 + i * 8192, R, C); const int Rb = Epi::PERM ? ((R & ~31) + perm32(R & 31)) : R;
        voffA[i] = (unsigned)(R * K + C) * 2u; voffB[i] = (unsigned)(Rb * K + C) * 2u; }
    const size_t kstep = (size_t)(BK * 2);
    const size_t hstep = (size_t)HALF * K * 2;
    const size_t tstep = 2 * hstep;
    const unsigned ldsw = (unsigned)wid * 1024u;
    const int aoff = lds_byte(wr * 64 + fr, fq * 8), boff = lds_byte(wc * 32 + fr, fq * 8);
#define PG8_SA(b, h) (((b) * 2 + (h)) * HTB)
#define PG8_SB(b, h) ((4 + (b) * 2 + (h)) * HTB)
#define PG8_STAGE(bufoff, gbase, voff) do { _Pragma("unroll") for (int _i = 0; _i < 2; ++_i) \
        __builtin_amdgcn_global_load_lds((const unsigned*)((const char*)(gbase) + (voff)[_i]), (PG8_LAS unsigned*)(lds + (bufoff) + ldsw + _i * 8192), 16, 0, 0); } while (0)
#define PG8_LDA(dst, b, h) do { _Pragma("unroll") for (int m = 0; m < 4; ++m) { if constexpr (FP8) { const v4i_ lo_ = *(const PG8_LAS v4i_*)(lds + PG8_SA(b, h) + aoff + m * 2048), hi_ = *(const PG8_LAS v4i_*)(lds + PG8_SA(b, h) + aoff + m * 2048 + 1024); \
        dst##8[m] = __builtin_shufflevector(lo_, hi_, 0, 1, 2, 3, 4, 5, 6, 7); } else { _Pragma("unroll") for (int k = 0; k < 2; ++k) dst[m][k] = *(const PG8_LAS bf16x8*)(lds + PG8_SA(b, h) + aoff + m * 2048 + k * 1024); } } } while (0)
#define PG8_LDB(dst, b, h) do { _Pragma("unroll") for (int n = 0; n < 2; ++n) { if constexpr (FP8) { const v4i_ lo_ = *(const PG8_LAS v4i_*)(lds + PG8_SB(b, h) + boff + n * 2048), hi_ = *(const PG8_LAS v4i_*)(lds + PG8_SB(b, h) + boff + n * 2048 + 1024); \
        dst##8[n] = __builtin_shufflevector(lo_, hi_, 0, 1, 2, 3, 4, 5, 6, 7); } else { _Pragma("unroll") for (int k = 0; k < 2; ++k) dst[n][k] = *(const PG8_LAS bf16x8*)(lds + PG8_SB(b, h) + boff + n * 2048 + k * 1024); } } } while (0)
#define PG8_MMA(ai, bj, At, Bt) do { __builtin_amdgcn_s_setprio(1); _Pragma("unroll") for (int m = 0; m < 4; ++m) _Pragma("unroll") for (int n = 0; n < 2; ++n) { \
        if constexpr (FP8) asm volatile("v_mfma_scale_f32_16x16x128_f8f6f4 %0, %1, %2, %0, %3, %3 op_sel_hi:[0,0,0]" : "+v"(acc[ai][bj][m][n]) : "v"(Bt##8[n]), "v"(At##8[m]), "v"(sc127_));   \
        else { _Pragma("unroll") for (int k = 0; k < 2; ++k) acc[ai][bj][m][n] = __builtin_amdgcn_mfma_f32_16x16x32_bf16(Bt[n][k], At[m][k], acc[ai][bj][m][n], 0, 0, 0); } } \
        __builtin_amdgcn_s_setprio(0); } while (0)
#define PG8_WAIT_V(n) asm volatile("s_waitcnt vmcnt(" #n ")" ::: "memory")
#define PG8_WAIT_L(n) asm volatile("s_waitcnt lgkmcnt(" #n ")" ::: "memory")
#define PG8_BAR __builtin_amdgcn_s_barrier()
#define PG8_SCHED __builtin_amdgcn_sched_barrier(0)
    Unit cur, nxt; int ui = 0;
    if (!S.next(0, cur)) return;
    f32x4 acc[2][2][4][2];
#pragma unroll
    for (int a = 0; a < 2; ++a)
#pragma unroll
        for (int b = 0; b < 2; ++b)
#pragma unroll
            for (int m = 0; m < 4; ++m)
#pragma unroll
                for (int n = 0; n < 2; ++n) acc[a][b][m][n] = (f32x4){0.f, 0.f, 0.f, 0.f};
    typedef int v8i_ __attribute__((ext_vector_type(8))); typedef int v4i_ __attribute__((ext_vector_type(4)));
    const int sc127_ = 127;
    bf16x8 At[4][2], B0[2][2], B1[2][2]; v8i_ At8[4], B08[2], B18[2];
    static_assert(SP2, "this copy of the body keeps only the SP2 K-loop up to date");
    int rA[2]; { int R_, C_; stage_rc(tid * 16, R_, C_); rA[0] = R_; stage_rc(tid * 16 + 8192, R_, C_); rA[1] = R_; }
    unsigned cv0[2], cv1[2], nv0[2], nv1[2];
    unsigned vh1[2]; vh1[0] = voffA[0] + (unsigned)hstep; vh1[1] = voffA[1] + (unsigned)hstep;
#define PG8_CV0 (GATHER ? cv0 : voffA)
#define PG8_CV1 (GATHER ? cv1 : vh1)
#define PG8_SV0 (GATHER ? sv0 : voffA)
#define PG8_SV1 (GATHER ? sv1 : vh1)
#define PG8_ROWOFF(dst0, dst1, unit) do { _Pragma("unroll") for (int i_ = 0; i_ < 2; ++i_) { \
        if constexpr (GATHER) { const int c2_ = (int)(voffA[i_] - (unsigned)(rA[i_] * K) * 2u); \
            dst0[i_] = (unsigned)gidx[(unit).pm * BM + rA[i_]] * (unsigned)(K * 2) + (unsigned)c2_; dst1[i_] = (unsigned)gidx[(unit).pm * BM + HALF + rA[i_]] * (unsigned)(K * 2) + (unsigned)c2_; } \
        else { dst0[i_] = voffA[i_]; dst1[i_] = voffA[i_] + (unsigned)hstep; } } } while (0)
    if constexpr (GATHER) PG8_ROWOFF(cv0, cv1, cur);
    const char* cA = GATHER ? (const char*)g.A : (const char*)g.A + (size_t)cur.pm * tstep; const char* cB = (const char*)g.Bt + (size_t)((cur.pm / g.gdiv) % g.gmod) * g.gstride + (size_t)cur.pn * tstep;
    S.a_ready(cur);
    if constexpr (SP2) {
        PG8_STAGE(PG8_SB(0, 0), cB, voffB); PG8_STAGE(PG8_SB(0, 1), cB + hstep, voffB); PG8_STAGE(PG8_SA(0, 0), cA, PG8_CV0); PG8_STAGE(PG8_SA(0, 1), cA, PG8_CV1);
        if (wr == 1) PG8_BAR;
        PG8_WAIT_V(2); PG8_BAR;
        PG8_STAGE(PG8_SB(1, 0), cB + kstep, voffB); PG8_STAGE(PG8_SA(1, 0), cA + kstep, PG8_CV0); PG8_STAGE(PG8_SB(1, 1), cB + hstep + kstep, voffB);
        PG8_WAIT_V(6); PG8_BAR;
    } else {
        PG8_STAGE(PG8_SB(0, 0), cB, voffB); PG8_STAGE(PG8_SA(0, 0), cA, voffA); PG8_STAGE(PG8_SB(0, 1), cB + hstep, voffB); PG8_STAGE(PG8_SA(0, 1), cA + hstep, voffA);
        if (wr == 1) PG8_BAR;
        PG8_WAIT_V(4); PG8_BAR;
        PG8_STAGE(PG8_SB(1, 0), cB + kstep, voffB); PG8_STAGE(PG8_SA(1, 0), cA + kstep, voffA); PG8_STAGE(PG8_SB(1, 1), cB + hstep + kstep, voffB);
        PG8_WAIT_V(6); PG8_BAR;
    }
    for (;;) {
        const bool has_next = S.next(ui + 1, nxt);
        if constexpr (GATHER) { if (has_next) PG8_ROWOFF(nv0, nv1, nxt); else { nv0[0] = cv0[0]; nv0[1] = cv0[1]; nv1[0] = cv1[0]; nv1[1] = cv1[1]; } }
        const char* nA = GATHER ? (const char*)g.A : (has_next ? (const char*)g.A + (size_t)nxt.pm * tstep : cA); const char* nB = has_next ? (const char*)g.Bt + (size_t)((nxt.pm / g.gdiv) % g.gmod) * g.gstride + (size_t)nxt.pn * tstep : cB;
        for (int t = 0; t < nt; t += 2) {
            const bool last = (t == nt - 2);
            unsigned sv0[2], sv1[2]; if constexpr (GATHER) { sv0[0] = last ? nv0[0] : cv0[0]; sv0[1] = last ? nv0[1] : cv0[1]; sv1[0] = last ? nv1[0] : cv1[0]; sv1[1] = last ? nv1[1] : cv1[1]; }
            const char* a1 = cA + (size_t)(t + 1) * kstep;
            const char* a2 = last ? nA : cA + (size_t)(t + 2) * kstep; const char* b2 = last ? nB : cB + (size_t)(t + 2) * kstep;
            const char* a3 = a2 + kstep; const char* b3 = b2 + kstep;
            if (last && has_next) S.a_ready(nxt);
            if constexpr (SP2) {
            PG8_LDB(B0, 0, 0); PG8_LDB(B1, 0, 1); PG8_SCHED; PG8_LDA(At, 0, 0); PG8_STAGE(PG8_SA(1, 1), a1, PG8_CV1);
            PG8_WAIT_V(8); PG8_WAIT_L(0); PG8_BAR; PG8_MMA(0, 0, At, B0); PG8_MMA(0, 1, At, B1); PG8_BAR; PG8_SCHED;
            PG8_LDA(At, 0, 1); PG8_STAGE(PG8_SB(0, 0), b2, voffB); PG8_STAGE(PG8_SB(0, 1), b2 + hstep, voffB); PG8_STAGE(PG8_SA(0, 0), a2, PG8_SV0);
            PG8_WAIT_V(8); PG8_WAIT_L(0); PG8_BAR; PG8_MMA(1, 0, At, B0); PG8_MMA(1, 1, At, B1); PG8_BAR; PG8_SCHED;
            PG8_LDB(B0, 1, 0); PG8_LDB(B1, 1, 1); PG8_SCHED; PG8_LDA(At, 1, 0); PG8_STAGE(PG8_SA(0, 1), a2, PG8_SV1);
            PG8_WAIT_V(8); PG8_WAIT_L(0); PG8_BAR; PG8_MMA(0, 0, At, B0); PG8_MMA(0, 1, At, B1); PG8_BAR; PG8_SCHED;
            PG8_LDA(At, 1, 1); PG8_STAGE(PG8_SB(1, 0), b3, voffB); PG8_STAGE(PG8_SB(1, 1), b3 + hstep, voffB); PG8_STAGE(PG8_SA(1, 0), a3, PG8_SV0);
            PG8_WAIT_V(8); PG8_WAIT_L(0); PG8_BAR; PG8_MMA(1, 0, At, B0); PG8_MMA(1, 1, At, B1); PG8_BAR; PG8_SCHED;
            } else {
            PG8_LDB(B0, 0, 0); PG8_SCHED; PG8_LDA(At, 0, 0); PG8_STAGE(PG8_SA(1, 1), a1 + hstep, voffA);
            PG8_WAIT_L(8); PG8_BAR; PG8_WAIT_L(0); PG8_MMA(0, 0, At, B0); PG8_BAR; PG8_SCHED;
            PG8_LDB(B1, 0, 1); PG8_STAGE(PG8_SB(0, 0), b2, voffB);
            PG8_BAR; PG8_WAIT_L(0); PG8_MMA(0, 1, At, B1); PG8_BAR;
            PG8_LDA(At, 0, 1); PG8_STAGE(PG8_SA(0, 0), a2, voffA);
            PG8_BAR; PG8_WAIT_L(0); PG8_MMA(1, 0, At, B0); PG8_BAR; PG8_SCHED;
            PG8_STAGE(PG8_SB(0, 1), b2 + hstep, voffB);
            PG8_WAIT_V(6); PG8_BAR; PG8_MMA(1, 1, At, B1); PG8_BAR;
            PG8_LDB(B0, 1, 0); PG8_SCHED; PG8_LDA(At, 1, 0); PG8_STAGE(PG8_SA(0, 1), a2 + hstep, voffA);
            PG8_WAIT_L(8); PG8_BAR; PG8_WAIT_L(0); PG8_MMA(0, 0, At, B0); PG8_BAR; PG8_SCHED;
            PG8_LDB(B1, 1, 1); PG8_STAGE(PG8_SB(1, 0), b3, voffB);
            PG8_BAR; PG8_WAIT_L(0); PG8_MMA(0, 1, At, B1); PG8_BAR;
            PG8_LDA(At, 1, 1); PG8_STAGE(PG8_SA(1, 0), a3, voffA);
            PG8_BAR; PG8_WAIT_L(0); PG8_MMA(1, 0, At, B0); PG8_BAR; PG8_SCHED;
            PG8_STAGE(PG8_SB(1, 1), b3 + hstep, voffB);
            PG8_WAIT_V(6); PG8_BAR; PG8_MMA(1, 1, At, B1); PG8_BAR;
            }
        }
        if constexpr (ALIGN_EPI) { if (wr == 0) PG8_BAR; }
        if constexpr (!Epi::AFTER_DRAIN) { E(acc, cur, wr, wc, fr, fq); S.done(cur); }
        if (!has_next) break;
#pragma unroll
        for (int a = 0; a < 2; ++a)
#pragma unroll
            for (int b = 0; b < 2; ++b)
#pragma unroll
                for (int m = 0; m < 4; ++m)
#pragma unroll
                    for (int n = 0; n < 2; ++n) acc[a][b][m][n] = (f32x4){0.f, 0.f, 0.f, 0.f};
        cur = nxt; cA = nA; cB = nB; ++ui; if constexpr (GATHER) { cv0[0] = nv0[0]; cv0[1] = nv0[1]; cv1[0] = nv1[0]; cv1[1] = nv1[1]; }
        if constexpr (ALIGN_EPI) { if (wr == 1) PG8_BAR; }
    }
    PG8_WAIT_V(0);
    if constexpr (!ALIGN_EPI) { if (wr == 0) PG8_BAR; }
    PG8_BAR;
    if constexpr (Epi::AFTER_DRAIN) { E.fused(acc, cur, wr, wc, fr, fq, lds, wid, lane); S.done(cur); }
#undef PG8_ROWOFF
#undef PG8_CV0
#undef PG8_CV1
#undef PG8_SV0
#undef PG8_SV1
#undef PG8_SA
#undef PG8_SB
#undef PG8_STAGE
#undef PG8_LDA
#undef PG8_LDB
#undef PG8_MMA
#undef PG8_WAIT_V
#undef PG8_WAIT_L
#undef PG8_BAR
#undef PG8_SCHED
}
}
namespace attn_body {
using bf16=__hip_bfloat16;
using bf16x8=__attribute__((ext_vector_type(8)))short;
using s16x4=__attribute__((ext_vector_type(4)))short;
using f32x16=__attribute__((ext_vector_type(16)))float;
using u32x4=__attribute__((ext_vector_type(4)))unsigned;
constexpr int D=64;
constexpr int NW=8,QBLK=32,QB=QBLK*NW,KVBLK=64;
__device__ __forceinline__ int crow(int r,int hi){return (r&3)+8*(r>>2)+4*hi;}
#define SBAR() __builtin_amdgcn_sched_barrier(0)
__device__ __forceinline__ void cmask(f32x16&p0,f32x16&p1,int jb,int qrel,int hi){
  const float NEG=-INFINITY; int kb=64*jb+4*hi;
  #pragma unroll
  for(int r=0;r<16;++r){int kv=kb+(r&3)+8*(r>>2); if(kv>qrel)p0[r]=NEG; if(kv+32>qrel)p1[r]=NEG;}
}

constexpr int NSLOT=3, SLOTB=8192;
constexpr int LDS_K=0, LDS_V=NSLOT*SLOTB, LDS_WS=2*NSLOT*SLOTB, LDS_OST=LDS_WS+NW*64*4, LDS_BYTES=LDS_OST+NW*4096;
constexpr float C2=0.125f*1.4426950408889634f;
__device__ __forceinline__ void glds16(const void*gsrc,unsigned lds_dst){unsigned keep;
  asm volatile("s_mov_b32 %0, m0\n\ts_mov_b32 m0, %2\n\ts_nop 0\n\tglobal_load_lds_dwordx4 %1, off\n\ts_mov_b32 m0, %0":"=&s"(keep):"v"(gsrc),"s"(lds_dst):"memory");}
__device__ __forceinline__ float max3f(float a,float b,float c){float r;asm("v_max3_f32 %0, %1, %2, %3":"=v"(r):"v"(a),"v"(b),"v"(c));return r;}
__device__ __forceinline__ float max2f(float a,float b){float r;asm("v_max_f32_e32 %0, %1, %2":"=v"(r):"v"(a),"v"(b));return r;}
__device__ __forceinline__ float fadd_s(float a,float b){float r;asm("v_add_f32_e32 %0, %1, %2":"=v"(r):"v"(a),"v"(b));return r;}
__device__ __forceinline__ float fsub_s(float a,float b){float r;asm("v_sub_f32_e32 %0, %1, %2":"=v"(r):"v"(a),"v"(b));return r;}
typedef float f32x2_t __attribute__((ext_vector_type(2))); typedef __bf16 bf16x2_t __attribute__((ext_vector_type(2)));
__device__ __forceinline__ unsigned cvtpk_s(float lo,float hi){f32x2_t v={lo,hi};bf16x2_t b=__builtin_convertvector(v,bf16x2_t);return __builtin_bit_cast(unsigned,b);}
#define WAIT_BAR(N) asm volatile("s_waitcnt vmcnt(" #N ") lgkmcnt(0)\n\ts_barrier":::"memory")

__device__ __forceinline__ void qkt(f32x16&p0,f32x16&p1,const char*Kslot,const bf16x8*qr,const f32x16&negm,int r32,int hi){
  const char*kb=Kslot+hi*1024+r32*16;
  #pragma unroll
  for(int d0=0;d0<4;++d0){
    const bf16x8 b0=*reinterpret_cast<const bf16x8*>(kb+d0*2048);
    const bf16x8 b1=*reinterpret_cast<const bf16x8*>(kb+d0*2048+512);
    if(d0==0){p0=__builtin_amdgcn_mfma_f32_32x32x16_bf16(b0,qr[0],negm,0,0,0);p1=__builtin_amdgcn_mfma_f32_32x32x16_bf16(b1,qr[0],negm,0,0,0);}
    else{p0=__builtin_amdgcn_mfma_f32_32x32x16_bf16(b0,qr[d0],p0,0,0,0);p1=__builtin_amdgcn_mfma_f32_32x32x16_bf16(b1,qr[d0],p1,0,0,0);}}
}
typedef __attribute__((address_space(3))) const char* lds_cptr;
typedef short v4i16_t __attribute__((ext_vector_type(4)));
__device__ __forceinline__ void kload8(bf16x8*kf,lds_cptr kp){
  kf[0]=*(const __attribute__((address_space(3))) bf16x8*)(kp);      kf[1]=*(const __attribute__((address_space(3))) bf16x8*)(kp+512);
  kf[2]=*(const __attribute__((address_space(3))) bf16x8*)(kp+2048); kf[3]=*(const __attribute__((address_space(3))) bf16x8*)(kp+2560);
  kf[4]=*(const __attribute__((address_space(3))) bf16x8*)(kp+4096); kf[5]=*(const __attribute__((address_space(3))) bf16x8*)(kp+4608);
  kf[6]=*(const __attribute__((address_space(3))) bf16x8*)(kp+6144); kf[7]=*(const __attribute__((address_space(3))) bf16x8*)(kp+6656);
}
__device__ __forceinline__ void kload2(bf16x8*kf,lds_cptr kp,int j){ kf[2*j]=*(const __attribute__((address_space(3))) bf16x8*)(kp+j*2048); kf[2*j+1]=*(const __attribute__((address_space(3))) bf16x8*)(kp+j*2048+512); }
__device__ __forceinline__ s16x4 vtr(lds_cptr p){ return __builtin_bit_cast(s16x4,__builtin_amdgcn_ds_read_tr16_b64_v4i16((__attribute__((address_space(3))) v4i16_t*)p)); }
__device__ __forceinline__ float rowmax(const f32x16&p0,const f32x16&p1){
  float a=max3f(p0[0],p0[1],p1[0]),b=max3f(p0[2],p0[3],p1[1]);a=max3f(a,p1[2],p1[3]);
  #pragma unroll
  for(int r=4;r<16;r+=4){a=max3f(a,p0[r],p0[r+1]);b=max3f(b,p0[r+2],p0[r+3]);a=max3f(a,p1[r],p1[r+1]);b=max3f(b,p1[r+2],p1[r+3]);}
  const float m=max2f(a,b);
  auto rr=__builtin_amdgcn_permlane32_swap(__float_as_uint(m),__float_as_uint(m),false,false);
  return max2f(__uint_as_float(rr[0]),__uint_as_float(rr[1]));
}
__device__ __forceinline__ void pv(f32x16*o,int vb,bf16x8 pa0,bf16x8 pa1,bf16x8 pa2,bf16x8 pa3){
  #pragma unroll
  for(int d0=0;d0<2;++d0){s16x4 lo[4],hi[4];
    #pragma unroll
    for(int ks=0;ks<4;++ks){
      asm volatile("ds_read_b64_tr_b16 %0,%1 offset:%c2":"=&v"(lo[ks]):"v"(vb),"i"(d0*4096+ks*1024):"memory");
      asm volatile("ds_read_b64_tr_b16 %0,%1 offset:%c2":"=&v"(hi[ks]):"v"(vb),"i"(d0*4096+ks*1024+512):"memory");}
    asm volatile("s_waitcnt lgkmcnt(0)":::"memory");SBAR();
    #define PK(k) (bf16x8){lo[k][0],lo[k][1],lo[k][2],lo[k][3],hi[k][0],hi[k][1],hi[k][2],hi[k][3]}
    o[d0]=__builtin_amdgcn_mfma_f32_32x32x16_bf16(pa0,PK(0),o[d0],0,0,0);
    o[d0]=__builtin_amdgcn_mfma_f32_32x32x16_bf16(pa1,PK(1),o[d0],0,0,0);
    o[d0]=__builtin_amdgcn_mfma_f32_32x32x16_bf16(pa2,PK(2),o[d0],0,0,0);
    o[d0]=__builtin_amdgcn_mfma_f32_32x32x16_bf16(pa3,PK(3),o[d0],0,0,0);
    #undef PK
  }
}

#ifndef ATTN_STORE16
#define ATTN_STORE16(p,v) (*(u32x4*)(p)=(v))
#endif
template<int THRL,int QP,int KP,int OP> __device__ __forceinline__ void attn_unit(const bf16*Qu,const bf16*__restrict__ Kh,const bf16*__restrict__ Vh,bf16*Ou,const int NT,char*shm){
  const int tid=opaque_tid(),lane=tid&63,r32=lane&31,hi=lane>>5; const int wid=__builtin_amdgcn_readfirstlane(tid>>6);
  const bf16*Qw=Qu+(long)(wid*QBLK)*QP;
  const unsigned lds0=(unsigned)(uintptr_t)shm;
  float*wsf=(float*)(shm+LDS_WS)+wid*64;
  const bf16*ksrc=Kh+(long)lane*KP+wid*8;
  const bf16*vsrc=Vh+(long)(16*(wid&3)+(lane>>2))*KP+(wid>>2)*32+(lane&3)*8;
  const unsigned kdst=lds0+LDS_K+wid*1024, vdst=lds0+LDS_V+wid*1024;
  #define DMA_K(t,slot) glds16(ksrc+(long)(t)*KVBLK*KP,(unsigned)__builtin_amdgcn_readfirstlane(kdst+(slot)))
  #define DMA_V(t,slot) glds16(vsrc+(long)(t)*KVBLK*KP,(unsigned)__builtin_amdgcn_readfirstlane(vdst+(slot)))
  const int vb0=(int)(lds0+LDS_V)+((lane>>4)&1)*32+(lane&3)*8+(4*hi+((lane&15)>>2))*64;
  const char*Kbase=shm+LDS_K; bf16x8 kf[8];
  const lds_cptr shm3=(lds_cptr)shm; const lds_cptr kp0=shm3+LDS_K+hi*1024+r32*16; const lds_cptr vp0=shm3+LDS_V+((lane>>4)&1)*32+(lane&3)*8+(4*hi+((lane&15)>>2))*64;
  DMA_K(0,0);DMA_V(0,0);DMA_K(1,SLOTB);
  bf16x8 qr[4];
  #pragma unroll
  for(int d0=0;d0<4;++d0)qr[d0]=*reinterpret_cast<const bf16x8*>(&Qw[(long)r32*QP+d0*16+hi*8]);
  float mhat=0.f,l_reg=0.f;f32x16 o[2];o[0]=f32x16{};o[1]=f32x16{};f32x16 negm=f32x16{};asm volatile("":"+v"(negm));
  #define CMASK(P0,P1,t) do{}while(0)
  bool resc=false;
  #define START(P0,P1) do{ const float rm=rowmax(P0,P1); resc=false; \
    { const float dl=rm; mhat=fadd_s(mhat,dl); \
      _Pragma("unroll") for(int r=0;r<16;++r){P0[r]=fsub_s(P0[r],dl);P1[r]=fsub_s(P1[r],dl);} \
      _Pragma("unroll") for(int r=0;r<16;++r)negm[r]=-mhat; asm volatile("":"+v"(negm)); } \
    _Pragma("unroll") for(int r=0;r<16;++r)P0[r]=__builtin_amdgcn_exp2f(P0[r]); }while(0)
  #define RESC() do{ if(resc){ asm volatile("s_waitcnt lgkmcnt(0)":::"memory"); \
      _Pragma("unroll") for(int d_=0;d_<2;++d_) _Pragma("unroll") for(int r=0;r<16;++r)o[d_][r]*=wsf[crow(r,hi)]; } }while(0)
  f32x16 pA0,pA1,pB0,pB1;
  int sl_prev=0,sl_cur=0,sl_next=SLOTB;
  #define ROT() do{sl_prev=sl_cur;sl_cur=sl_next;sl_next=(sl_next==(NSLOT-1)*SLOTB)?0:sl_next+SLOTB;}while(0)
  DMA_K(2,2*SLOTB);
  WAIT_BAR(3);
  qkt(pA0,pA1,Kbase,qr,negm,r32,hi);asm volatile("s_nop 15\n\ts_nop 7":"+v"(pA0),"+v"(pA1));CMASK(pA0,pA1,0);
  START(pA0,pA1);
  _Pragma("unroll") for(int r=0;r<16;++r)pA1[r]=__builtin_amdgcn_exp2f(pA1[r]);
  WAIT_BAR(0);
  DMA_K(3,0);DMA_V(1,SLOTB);
  ROT();
  kload8(kf,kp0+sl_cur);
  WAIT_BAR(2);
  s16x4 vlo[8],vhi[8]; u32x4 pw0,pw1,pw2,pw3;
  #define PKW(P,B) cvtpk_s(P[B],P[B+1])
  #define PAF(k) __builtin_bit_cast(bf16x8,pw##k)
  #define VFR(i) (bf16x8){vlo[i][0],vlo[i][1],vlo[i][2],vlo[i][3],vhi[i][0],vhi[i][1],vhi[i][2],vhi[i][3]}
  #define PIN(x) asm volatile("":"+v"(x))
  #define MX3(a,b,c) __builtin_fmaxf(__builtin_fmaxf((a),(b)),(c))
  #define GAPA(MF,A0,A1,A2,A3,W0,W1,PW) do{ MF; sacc+=A0; sacc+=A1; sacc+=A2; sacc+=A3; PIN(sacc); W0; W1; PIN(PW); SBAR(); }while(0)
  #define EX(v) __builtin_amdgcn_exp2f(v)
  #define GAPB(MF,X,B) do{ MF; X[B]=EX(X[B]); X[B+1]=EX(X[B+1]); X[B+2]=EX(X[B+2]); X[B+3]=EX(X[B+3]); PIN(X); SBAR(); }while(0)
  #define VRD(i) do{ vlo[i]=vtr(vp_+(((i)>>2)*4096+((i)&3)*1024)); vhi[i]=vtr(vp_+(((i)>>2)*4096+((i)&3)*1024+512)); }while(0)
  #define KRD(G,j) do{ if(G){ kload2(kf,kp0+sl_next,j); SBAR(); } }while(0)
  #define STEP(C0,C1,P0,P1,t,GK,GV,GL) do{ SBAR(); \
    const lds_cptr vp_=vp0+sl_prev; \
    VRD(0); SBAR(); float sacc=(P0[0]+P0[1]); \
    GAPA(C0=__builtin_amdgcn_mfma_f32_32x32x16_bf16(kf[0],qr[0],negm,0,0,0), P0[2],P0[3],P0[4],P0[5],     pw0[0]=PKW(P0,0), pw0[1]=PKW(P0,2), pw0); \
    VRD(4); SBAR(); GAPA(C1=__builtin_amdgcn_mfma_f32_32x32x16_bf16(kf[1],qr[0],negm,0,0,0), P0[6],P0[7],P0[8],P0[9],     pw0[2]=PKW(P0,4), pw0[3]=PKW(P0,6), pw0); \
    VRD(1); SBAR(); GAPA(C0=__builtin_amdgcn_mfma_f32_32x32x16_bf16(kf[2],qr[1],C0,0,0,0),   P0[10],P0[11],P0[12],P0[13], pw1[0]=PKW(P0,8), pw1[1]=PKW(P0,10), pw1); \
    VRD(5); SBAR(); GAPA(C1=__builtin_amdgcn_mfma_f32_32x32x16_bf16(kf[3],qr[1],C1,0,0,0),   P0[14],P0[15],P1[0],P1[1],   pw1[2]=PKW(P0,12),pw1[3]=PKW(P0,14), pw1); \
    VRD(2); SBAR(); GAPA(C0=__builtin_amdgcn_mfma_f32_32x32x16_bf16(kf[4],qr[2],C0,0,0,0),   P1[2],P1[3],P1[4],P1[5],     pw2[0]=PKW(P1,0), pw2[1]=PKW(P1,2), pw2); \
    VRD(6); SBAR(); GAPA(C1=__builtin_amdgcn_mfma_f32_32x32x16_bf16(kf[5],qr[2],C1,0,0,0),   P1[6],P1[7],P1[8],P1[9],     pw2[2]=PKW(P1,4), pw2[3]=PKW(P1,6), pw2); \
    VRD(3); SBAR(); GAPA(C0=__builtin_amdgcn_mfma_f32_32x32x16_bf16(kf[6],qr[3],C0,0,0,0),   P1[10],P1[11],P1[12],P1[13], pw3[0]=PKW(P1,8), pw3[1]=PKW(P1,10), pw3); \
    VRD(7); SBAR(); GAPA(C1=__builtin_amdgcn_mfma_f32_32x32x16_bf16(kf[7],qr[3],C1,0,0,0),   P1[14],P1[15],0.f,0.f,       pw3[2]=PKW(P1,12),pw3[3]=PKW(P1,14), pw3); \
    l_reg+=sacc; \
    if(GK){DMA_K((t)+3,sl_cur);} if(GV){DMA_V((t)+1,sl_next);} \
    CMASK(C0,C1,t); \
    { float a=MX3(C0[0],C0[1],C1[0]),b=MX3(C0[2],C0[3],C1[1]); a=MX3(a,C1[2],C1[3]); \
      _Pragma("unroll") for(int r=4;r<16;r+=4){a=MX3(a,C0[r],C0[r+1]);b=MX3(b,C0[r+2],C0[r+3]);a=MX3(a,C1[r],C1[r+1]);b=MX3(b,C1[r+2],C1[r+3]);} \
      float rm=__builtin_fmaxf(a,b); { auto rr=__builtin_amdgcn_permlane32_swap(__float_as_uint(rm),__float_as_uint(rm),false,false); rm=__builtin_fmaxf(__uint_as_float(rr[0]),__uint_as_float(rr[1])); } \
      resc=false; \
      if(__builtin_expect(__any(rm>(float)THRL),0)){ const float dl=__builtin_fmaxf(rm,0.f); mhat+=dl; \
        _Pragma("unroll") for(int r=0;r<16;++r){C0[r]-=dl;C1[r]-=dl;} \
        _Pragma("unroll") for(int r=0;r<16;++r)negm[r]=-mhat; asm volatile("":"+v"(negm)); \
        const float f=__builtin_amdgcn_exp2f(-dl); l_reg*=f; if(hi==0)wsf[r32]=f; resc=true; } } \
    SBAR(); \
    GAPB(o[0]=__builtin_amdgcn_mfma_f32_32x32x16_bf16(PAF(0),VFR(0),o[0],0,0,0), C0,0); \
    GAPB(o[1]=__builtin_amdgcn_mfma_f32_32x32x16_bf16(PAF(0),VFR(4),o[1],0,0,0), C0,4); \
    KRD(GL,0); GAPB(o[0]=__builtin_amdgcn_mfma_f32_32x32x16_bf16(PAF(1),VFR(1),o[0],0,0,0), C0,8); \
    KRD(GL,1); GAPB(o[1]=__builtin_amdgcn_mfma_f32_32x32x16_bf16(PAF(1),VFR(5),o[1],0,0,0), C0,12); \
    KRD(GL,2); GAPB(o[0]=__builtin_amdgcn_mfma_f32_32x32x16_bf16(PAF(2),VFR(2),o[0],0,0,0), C1,0); \
    KRD(GL,3); GAPB(o[1]=__builtin_amdgcn_mfma_f32_32x32x16_bf16(PAF(2),VFR(6),o[1],0,0,0), C1,4); \
    GAPB(o[0]=__builtin_amdgcn_mfma_f32_32x32x16_bf16(PAF(3),VFR(3),o[0],0,0,0), C1,8); \
    GAPB(o[1]=__builtin_amdgcn_mfma_f32_32x32x16_bf16(PAF(3),VFR(7),o[1],0,0,0), C1,12); \
    }while(0)
  int t=1;
  #undef CMASK
  #define CMASK(P0,P1,t) do{}while(0)
  for(;t+5<NT;t+=2){
    STEP(pB0,pB1,pA0,pA1,t,true,true,true);     WAIT_BAR(2); RESC(); ROT();
    STEP(pA0,pA1,pB0,pB1,t+1,true,true,true);   WAIT_BAR(2); RESC(); ROT();
  }
  #undef CMASK
  #define CMASK(P0,P1,t) do{}while(0)
  #define ENDW(tt) do{ if((tt)+3<NT){WAIT_BAR(2);} else if((tt)+2<NT){WAIT_BAR(1);} else {WAIT_BAR(0);} }while(0)
  for(;t+1<NT;t+=2){
    STEP(pB0,pB1,pA0,pA1,t,(t+3<NT),(t+1<NT),(t+1<NT));       ENDW(t);   RESC(); ROT();
    STEP(pA0,pA1,pB0,pB1,t+1,(t+4<NT),(t+2<NT),(t+2<NT));     ENDW(t+1); RESC(); ROT();
  }
  STEP(pB0,pB1,pA0,pA1,NT-1,false,false,false); RESC();
  { float sacc=pB0[0]+pB0[1]; _Pragma("unroll") for(int r=2;r<16;++r)sacc+=pB0[r]; _Pragma("unroll") for(int r=0;r<16;++r)sacc+=pB1[r]; l_reg+=sacc;
    pw0=(u32x4){PKW(pB0,0),PKW(pB0,2),PKW(pB0,4),PKW(pB0,6)};pw1=(u32x4){PKW(pB0,8),PKW(pB0,10),PKW(pB0,12),PKW(pB0,14)};pw2=(u32x4){PKW(pB1,0),PKW(pB1,2),PKW(pB1,4),PKW(pB1,6)};pw3=(u32x4){PKW(pB1,8),PKW(pB1,10),PKW(pB1,12),PKW(pB1,14)};
    SBAR(); pv(o,vb0+sl_cur,PAF(0),PAF(1),PAF(2),PAF(3)); }
  #undef PKW
  #undef PAF
  #undef VFR
  #undef PIN
  #undef MX3
  #undef GAPA
  #undef GAPB
  #undef EX
  #undef VRD
  #undef KRD
  #undef STEP
  #undef ENDW
  {auto rr=__builtin_amdgcn_permlane32_swap(__float_as_uint(l_reg),__float_as_uint(l_reg),false,false);l_reg=__uint_as_float(rr[0])+__uint_as_float(rr[1]);}
  if(hi==0)wsf[32+r32]=l_reg;asm volatile("s_waitcnt lgkmcnt(0)":::"memory");
  float rli[16];
  #pragma unroll
  for(int r=0;r<16;++r)rli[r]=__builtin_amdgcn_rcpf(wsf[32+crow(r,hi)]);
  bf16*Ow=Ou+(long)(wid*QBLK)*OP;
  { bf16*stg=(bf16*)(shm+LDS_OST)+wid*2048;
    #pragma unroll
    for(int r=0;r<16;++r){const int orow=crow(r,hi);
      #pragma unroll
      for(int d0=0;d0<2;++d0)stg[orow*64+d0*32+r32]=__float2bfloat16(o[d0][r]*rli[r]);}
    asm volatile("s_waitcnt lgkmcnt(0)":::"memory");
    #pragma unroll
    for(int i=0;i<4;++i){const int row=i*8+(lane>>3),ch=lane&7; const u32x4 v=*(const u32x4*)(stg+row*64+ch*8); ATTN_STORE16(Ow+(long)row*OP+ch*8,v);} }
  asm volatile("s_waitcnt lgkmcnt(0)\n\ts_barrier":::"memory");
  #undef DMA_K
  #undef DMA_V
  #undef CMASK
  #undef START
  #undef RESC
  #undef ROT
}
constexpr int ATTN_LDS_BYTES=LDS_BYTES;
#undef SBAR
#undef WAIT_BAR
}
#define LDS_WAIT() asm volatile("s_waitcnt lgkmcnt(0)" ::: "memory")

__device__ __forceinline__ void transpose_item(const float* W, int K, int N, bf16* WT, int k0, int n0, int dest_row0, LAS float* scr, int lane) {
    float t_[32];
#pragma unroll
    for (int i = 0; i < 32; ++i) t_[i] = W[(size_t)(k0 + 2 * i + (lane >> 5)) * N + n0 + (lane & 31)];
#pragma unroll
    for (int i = 0; i < 32; ++i) scr[(2 * i + (lane >> 5)) * 33 + (lane & 31)] = t_[i];
    LDS_WAIT(); asm volatile("" ::: "memory");
    const int c = lane & 7;
#pragma unroll
    for (int j = 0; j < 4; ++j) { const int n = (lane >> 3) + 8 * j; const LAS float* s = scr + (8 * c) * 33 + n;
        v4u o; o.x = pk2(s[0 * 33], s[1 * 33]); o.y = pk2(s[2 * 33], s[3 * 33]); o.z = pk2(s[4 * 33], s[5 * 33]); o.w = pk2(s[6 * 33], s[7 * 33]);
        *(GAS v4u*)(WT + (size_t)(dest_row0 + n) * K + k0 + 8 * c) = o; }
    LDS_WAIT(); asm volatile("" ::: "memory");
}

__device__ __forceinline__ void transpose_item8(const float* W, int K, int N, unsigned char* WT, int k0, int n0, int dest_row0, float sc, LAS float* scr, int lane) {
    float t_[32];
#pragma unroll
    for (int i = 0; i < 32; ++i) t_[i] = W[(size_t)(k0 + 2 * i + (lane >> 5)) * N + n0 + (lane & 31)];
#pragma unroll
    for (int i = 0; i < 32; ++i) scr[(2 * i + (lane >> 5)) * 33 + (lane & 31)] = __builtin_amdgcn_fmed3f(t_[i] * sc, -448.f, 448.f);
    LDS_WAIT(); asm volatile("" ::: "memory");
    const int c = lane & 7;
#pragma unroll
    for (int j = 0; j < 4; ++j) { const int n = (lane >> 3) + 8 * j; const LAS float* s = scr + (8 * c) * 33 + n;
        unsigned w0 = 0, w1 = 0;
        w0 = __builtin_amdgcn_cvt_pk_fp8_f32(s[0 * 33], s[1 * 33], w0, false); w0 = __builtin_amdgcn_cvt_pk_fp8_f32(s[2 * 33], s[3 * 33], w0, true);
        w1 = __builtin_amdgcn_cvt_pk_fp8_f32(s[4 * 33], s[5 * 33], w1, false); w1 = __builtin_amdgcn_cvt_pk_fp8_f32(s[6 * 33], s[7 * 33], w1, true);
        *(GAS v2u*)(WT + (size_t)(dest_row0 + n) * K + k0 + 8 * c) = (v2u){w0, w1}; }
    LDS_WAIT(); asm volatile("" ::: "memory");
}

struct ProIn { const float *hy_w_in, *at_w_in, *w_out, *w_mem_kv; };
__device__ __forceinline__ void phase_weights(const ProIn& P, unsigned char* ws, LAS unsigned char* lds, int gw, int NGW, int wave, int lane) {
    LAS float* scr = (LAS float*)(lds + wave * 16384);
    constexpr int I_HY = 16 * 80, I_AT = 16 * 48, I_OUT = 16 * 32, I_MKV = 16 * 16;
    constexpr int E0 = 2 * I_HY, E1 = E0 + 2 * I_AT, E2 = E1 + 4 * I_OUT, E3 = E2 + 4 * I_MKV;
    for (int it = gw; it < E3; it += NGW) {
        int r = it;
        if (r < E0) { const int j = r / I_HY, q = r % I_HY, kb = q / 80, nb = q % 80;
            transpose_item(P.hy_w_in + (size_t)j * DM * D_IN_HY, DM, D_IN_HY, (bf16*)(ws + WS_WHY) + (size_t)j * D_IN_HY * DM, 64 * kb, 32 * nb, 32 * nb, scr, lane); continue; }
        r -= E0;
        if (r < 2 * I_AT) { const int j = r / I_AT, q = r % I_AT, kb = q / 48, nb = q % 48;
            const int n0 = 32 * nb, o = n0 & 255;
            transpose_item(P.at_w_in + (size_t)j * DM * D_IN_AT, DM, D_IN_AT, (bf16*)(ws + WS_WAT) + (size_t)j * D_IN_AT * DM, 64 * kb, n0, (n0 & ~255) + 128 * ((o & 63) >> 5) + 32 * (o >> 6), scr, lane); continue; }
        r -= 2 * I_AT;
        if (r < 4 * I_OUT) { const int j = r / I_OUT, q = r % I_OUT, kb = q / 32, nb = q % 32;
            transpose_item(P.w_out + (size_t)j * DM * DM, DM, DM, (bf16*)(ws + WS_WOUT) + (size_t)j * DM * DM, 64 * kb, 32 * nb, 32 * nb, scr, lane); continue; }
        r -= 4 * I_OUT;
        { const int j = r / I_MKV, q = r % I_MKV, kb = q / 16, nb = q % 16;
            transpose_item(P.w_mem_kv + (size_t)j * DM * 512, DM, 512, (bf16*)(ws + WS_WMKV), 64 * kb, 32 * nb, j * 512 + 32 * nb, scr, lane); }
        (void)r;
    }
}

struct XwIn { const float *w_gate, *w_up, *w_down; unsigned char* ws; };
constexpr int XW_PER_EXPERT = 3 * 384, XW_PER_LAYER = NEXP * XW_PER_EXPERT;
constexpr int XW_QA_HY = 5, XW_QA_AT = 4, XW_QB = 3, XW_NA = 128 * NWAVES, XW_NB = 224 * NWAVES;
__host__ __device__ constexpr int xw_qa(int layer) { return (layer & 1) ? XW_QA_AT : XW_QA_HY; }
__host__ __device__ constexpr int xw_p0(int layer, bool sched) { return sched ? XW_PER_LAYER - xw_qa(layer) * XW_NA - XW_QB * XW_NB : XW_PER_LAYER; }
__device__ __forceinline__ void xw_item(const XwIn& B, int layer, int r, LAS float* scr, int lane) {
    const int j = layer * NEXP + r / XW_PER_EXPERT, q = r % XW_PER_EXPERT, kind = q / 384, qq = q % 384;
    if (kind < 2) { const int kb = qq / 24, nb = qq % 24, n0 = 32 * nb;
        transpose_item8((kind == 0 ? B.w_gate : B.w_up) + (size_t)j * DM * EFF, DM, EFF, B.ws + WS_W1 + (size_t)j * 1536 * DM, 64 * kb, n0, (n0 >> 7) * 256 + 128 * kind + (n0 & 127), W8_SCALE, scr, lane); }
    else { const int kb = qq / 32, nb = qq % 32;
        transpose_item8(B.w_down + (size_t)j * EFF * DM, EFF, DM, B.ws + WS_W2 + (size_t)j * DM * EFF, 64 * kb, 32 * nb, 32 * nb, W8_SCALE, scr, lane); }
}
__device__ __forceinline__ void phase_xw_p0(const XwIn& B, bool sched, LAS float* scr, int gw, int NGW, int lane) {
#pragma unroll 1
    for (int layer = 0; layer < DEPTH; ++layer) { const int n = xw_p0(layer, sched);
#pragma unroll 1
        for (int r = gw; r < n; r += NGW) xw_item(B, layer, r, scr, lane); }
}
__device__ __forceinline__ void xw_slice_a(const XwIn& B, int layer, LAS float* scr, int bx, int wave, int lane) {
    const int base = xw_p0(layer, true) + (bx - 128) * NWAVES + wave;
#pragma unroll 1
    for (int k = 0; k < xw_qa(layer); ++k) xw_item(B, layer, base + k * XW_NA, scr, lane);
}
__device__ __forceinline__ void xw_slice_b(const XwIn& B, int layer, LAS float* scr, int bx, int wave, int lane) {
    const int base = xw_p0(layer, true) + xw_qa(layer) * XW_NA + (bx - 32) * NWAVES + wave;
#pragma unroll 1
    for (int k = 0; k < XW_QB; ++k) xw_item(B, layer, base + k * XW_NB, scr, lane);
}

__device__ __forceinline__ void phase_wrg(const float* ffn_g, const float* router, float* WRG, int gtid, int nthreads) {
    for (int q = gtid; q < DEPTH * NEXP * DM; q += nthreads) { const int l = q / (NEXP * DM), e = (q / DM) % NEXP, d = q % DM; WRG[q] = ffn_g[l * DM + d] * router[((size_t)l * DM + d) * NEXP + e]; }
}

__device__ __forceinline__ void rms_row_bf16(const float* xrow, const float* g, bf16* orow, int lane) {
    const GAS f32x4* xr = (const GAS f32x4*)xrow + lane; const GAS f32x4* gr = (const GAS f32x4*)g + lane;
    f32x4 v[4]; float s = 0.f;
#pragma unroll
    for (int j = 0; j < 4; ++j) { v[j] = xr[64 * j]; s += (v[j].x * v[j].x + v[j].y * v[j].y) + (v[j].z * v[j].z + v[j].w * v[j].w); }
    const float rstd = 1.f / sqrtf(wave_sum(s) * (1.f / DM) + NORM_EPS);
    GAS v2u* o8 = (GAS v2u*)orow + lane;
#pragma unroll
    for (int j = 0; j < 4; ++j) { const f32x4 gg = gr[64 * j]; v2u w; w.x = pk2(v[j].x * rstd * gg.x, v[j].y * rstd * gg.y); w.y = pk2(v[j].z * rstd * gg.z, v[j].w * rstd * gg.w); o8[64 * j] = w; }
}

__device__ __forceinline__ void phase_mem_h2(const float* mem, const float* mem_g, const float* fw1, const float* fb1, const float* fw2, const float* fb2, const float* ffreq,
                                              unsigned char* ws, int gw, int NGW, int lane) {
    for (int m = gw; m < BATCH * MEM_LEN; m += NGW) rms_row_bf16(mem + (size_t)m * DM, mem_g, (bf16*)(ws + WS_MEMN) + (size_t)m * DM, lane);
    float* H2 = (float*)(ws + WS_H2);
    for (int it = gw; it < 2 * SEQ; it += NGW) {
        const int j = it / SEQ, n = it % SEQ;
        const float* w1 = fw1 + j * HY_EMB * HY_FILT; const float* w2 = fw2 + j * HY_FILT * HY_FILT;
        const float t = (float)n * (1.0f / (float)(SEQ - 1));
        const float w = (6.283185307179586f * (float)n) / (float)SEQ;
        float feat = 0.f;
        if (lane == 0) feat = t;
        else if (lane <= 16) { const float band = 1e-4f + (float)(lane - 1) * ((15.0f - 1e-4f) / 15.0f); feat = cosf(band * w); }
        else if (lane <= 32) { const float band = 1e-4f + (float)(lane - 17) * ((15.0f - 1e-4f) / 15.0f); feat = -sinf(band * w); }
        const float fr = ffreq[j * HY_FILT + lane];
        float a = fb1[j * HY_FILT + lane];
        for (int i = 0; i < HY_EMB; ++i) a += __shfl(feat, i) * w1[i * HY_FILT + lane];
        const float h1 = sinf(fr * a);
        float a2 = fb2[j * HY_FILT + lane];
        for (int i = 0; i < HY_FILT; ++i) a2 += __shfl(h1, i) * w2[i * HY_FILT + lane];
        H2[(size_t)it * HY_FILT + lane] = sinf(fr * a2);
    }
}

template <bool COMBINE, bool FINAL>
__device__ __forceinline__ void phase_norm(const float* hin, float* hout, const float* g, bf16* U, float* fout, const int* POS, const bf16* Y, int gw, int NGW, int lane) {
    int m = gw;
    if (m >= M_TOK) return;
    f32x4 cur[4]; int cpos = -1;
    { const GAS f32x4* xr = (const GAS f32x4*)(hin + (size_t)m * DM) + lane;
#pragma unroll
      for (int j = 0; j < 4; ++j) cur[j] = xr[64 * j];
      if (COMBINE) { const int b = m / SEQ, t = m % SEQ; if (lane < NEXP) cpos = POS[(size_t)(b * NEXP + lane) * SEQ + t]; } }
#pragma unroll 1
    for (; m < M_TOK; m += NGW) {
        const int mn = m + NGW; f32x4 nxt[4]; int npos = -1;
#pragma unroll
        for (int j = 0; j < 4; ++j) nxt[j] = cur[j];
        if (mn < M_TOK) { const GAS f32x4* xr = (const GAS f32x4*)(hin + (size_t)mn * DM) + lane;
#pragma unroll
            for (int j = 0; j < 4; ++j) nxt[j] = xr[64 * j];
            if (COMBINE) { const int b = mn / SEQ, t = mn % SEQ; if (lane < NEXP) npos = POS[(size_t)(b * NEXP + lane) * SEQ + t]; } }
        f32x4 v[4];
#pragma unroll
        for (int j = 0; j < 4; ++j) v[j] = cur[j];
        if (COMBINE) {
            const int b = m / SEQ;
            unsigned long long mask = __ballot(cpos >= 0);
            while (mask) {
                v2u y[4][4]; bool has[4];
#pragma unroll
                for (int k = 0; k < 4; ++k) { has[k] = mask != 0ull;
                    if (has[k]) { const int e = __builtin_amdgcn_readfirstlane(__builtin_ctzll(mask)); mask &= mask - 1ull; const int p = __builtin_amdgcn_readlane(cpos, e);
                        const GAS v2u* yr = (const GAS v2u*)(Y + ((size_t)(b * NEXP + e) * CAP + p) * DM) + lane;
#pragma unroll
                        for (int j = 0; j < 4; ++j) y[k][j] = yr[64 * j]; } }
#pragma unroll
                for (int k = 0; k < 4; ++k) if (has[k]) {
#pragma unroll
                    for (int j = 0; j < 4; ++j) { const v2u w = y[k][j]; v[j].x += bflo(w.x); v[j].y += bfhi(w.x); v[j].z += bflo(w.y); v[j].w += bfhi(w.y); } }
            }
            if (!FINAL) { GAS f32x4* ho = (GAS f32x4*)(hout + (size_t)m * DM) + lane;
#pragma unroll
                for (int j = 0; j < 4; ++j) ho[64 * j] = v[j]; }
        }
        float s = 0.f;
#pragma unroll
        for (int j = 0; j < 4; ++j) s += (v[j].x * v[j].x + v[j].y * v[j].y) + (v[j].z * v[j].z + v[j].w * v[j].w);
        const float rstd = 1.f / sqrtf(wave_sum(s) * (1.f / DM) + NORM_EPS);
        const GAS f32x4* gr = (const GAS f32x4*)g + lane;
        if (FINAL) { GAS f32x4* o = (GAS f32x4*)(fout + (size_t)m * DM) + lane;
#pragma unroll
            for (int j = 0; j < 4; ++j) o[64 * j] = v[j] * rstd * gr[64 * j]; }
        else { GAS v2u* o8 = (GAS v2u*)(U + (size_t)m * DM) + lane;
#pragma unroll
            for (int j = 0; j < 4; ++j) { const f32x4 gg = gr[64 * j]; v2u w; w.x = pk2(v[j].x * rstd * gg.x, v[j].y * rstd * gg.y); w.y = pk2(v[j].z * rstd * gg.z, v[j].w * rstd * gg.w); o8[64 * j] = w; } }
#pragma unroll
        for (int j = 0; j < 4; ++j) cur[j] = nxt[j];
        cpos = npos;
    }
}

__device__ __forceinline__ void phase_ffn_norm_router(const float* H, const float* g, const float* Wr, unsigned char* XN8, float* AFF, LAS unsigned char* lds, int gw, int NGW, int lane, int tid) {
    LAS f32x4* WL = (LAS f32x4*)lds;
    for (int q = tid; q < 64 * 64; q += NTHREADS) { const int ln = q & 63, s = q >> 6, e4 = s & 3, ji = s >> 2, i = ji & 3, j = ji >> 2; const int d = 4 * ln + i + 256 * j;
        WL[q] = *(const GAS f32x4*)(Wr + (size_t)d * NEXP + 4 * e4); }
    __syncthreads();
    constexpr int R = 4;
    const GAS f32x4* gr = (const GAS f32x4*)g + lane;
#pragma unroll 1
    for (int m0 = gw * R; m0 < M_TOK; m0 += NGW * R) {
        int lo_ = lane; asm volatile("" : "+v"(lo_));
        f32x4 v[R][4]; float rstd[R];
#pragma unroll
        for (int r = 0; r < R; ++r) { const GAS f32x4* xr = (const GAS f32x4*)(H + (size_t)(m0 + r) * DM) + lane;
#pragma unroll
            for (int j = 0; j < 4; ++j) v[r][j] = xr[64 * j]; }
#pragma unroll
        for (int r = 0; r < R; ++r) { float s = 0.f;
#pragma unroll
            for (int j = 0; j < 4; ++j) s += (v[r][j].x * v[r][j].x + v[r][j].y * v[r][j].y) + (v[r][j].z * v[r][j].z + v[r][j].w * v[r][j].w);
            rstd[r] = 1.f / sqrtf(wave_sum(s) * (1.f / DM) + NORM_EPS); }
        f32x4 lg[R][4];
#pragma unroll
        for (int r = 0; r < R; ++r)
#pragma unroll
            for (int e4 = 0; e4 < 4; ++e4) lg[r][e4] = (f32x4){0.f, 0.f, 0.f, 0.f};
#pragma unroll
        for (int j = 0; j < 4; ++j) { const f32x4 gg = gr[64 * j];
#pragma unroll
            for (int r = 0; r < R; ++r) { v[r][j] = v[r][j] * rstd[r] * gg;
                unsigned w = 0; w = __builtin_amdgcn_cvt_pk_fp8_f32(v[r][j].x, v[r][j].y, w, false); w = __builtin_amdgcn_cvt_pk_fp8_f32(v[r][j].z, v[r][j].w, w, true);
                ((GAS unsigned*)(XN8 + (size_t)(m0 + r) * DM) + lane)[64 * j] = w; }
#pragma unroll
            for (int i = 0; i < 4; ++i)
#pragma unroll
                for (int e4 = 0; e4 < 4; ++e4) { const f32x4 wv = WL[((j * 4 + i) * 4 + e4) * 64 + lo_];
#pragma unroll
                    for (int r = 0; r < R; ++r) { const float xs = v[r][j][i];
#pragma unroll
                        for (int c = 0; c < 4; ++c) asm("v_fmac_f32 %0, %1, %2" : "+v"(lg[r][e4][c]) : "v"(wv[c]), "v"(xs)); } }
            __builtin_amdgcn_sched_barrier(0); }
#pragma unroll
        for (int r = 0; r < R; ++r) {
            float l16[16];
#pragma unroll
            for (int e = 0; e < 16; ++e) l16[e] = wave_sum(lg[r][e >> 2][e & 3]);
            float mx = l16[0];
#pragma unroll
            for (int e = 1; e < 16; ++e) mx = fmaxf(mx, l16[e]);
            float den = 0.f;
#pragma unroll
            for (int e = 0; e < 16; ++e) { l16[e] = expf(l16[e] - mx); den += l16[e]; }
            float mine = 0.f;
#pragma unroll
            for (int e = 0; e < 16; ++e) mine = (lane == e) ? l16[e] : mine;
            const int m = m0 + r, b = m / SEQ, t = m % SEQ;
            if (lane < NEXP) AFF[(size_t)(b * NEXP + lane) * SEQ + t] = mine / den;
        }
    }
    __syncthreads();
}

__device__ __forceinline__ void phase_router_sum(const float* PLG, const float* PSS, float* RSTD, float* AFF, int gw, int NGW, int lane) {
    const int e = lane & 15, rq = lane >> 4;
    for (int m0 = gw * 4; m0 < M_TOK; m0 += NGW * 4) {
        const int m = m0 + rq;
        float lgt = 0.f;
#pragma unroll
        for (int slot = 0; slot < 16; ++slot) lgt += PLG[((size_t)slot * M_TOK + m) * 16 + e];
        float ss = PSS[(size_t)e * M_TOK + m];
#pragma unroll
        for (int o = 1; o < 16; o <<= 1) ss += __shfl_xor(ss, o);
        const float rstd = 1.f / sqrtf(ss * (1.f / DM) + NORM_EPS);
        lgt *= rstd;
        float mx = lgt;
#pragma unroll
        for (int o = 1; o < 16; o <<= 1) mx = fmaxf(mx, __shfl_xor(mx, o));
        const float ex = expf(lgt - mx); float den = ex;
#pragma unroll
        for (int o = 1; o < 16; o <<= 1) den += __shfl_xor(den, o);
        const int b = m / SEQ, t = m % SEQ;
        AFF[(size_t)(b * NEXP + e) * SEQ + t] = ex / den;
        if (e == 0) RSTD[m] = rstd;
    }
}

__device__ __forceinline__ int block_excl_scan(int v, LAS int* scr, int tid, int lane, int wave, int* tot) {
    int inc = v;
#pragma unroll
    for (int o = 1; o < 64; o <<= 1) { const int n = __shfl_up(inc, o); if (lane >= o) inc += n; }
    __syncthreads();
    if (lane == 63) scr[wave] = inc;
    __syncthreads();
    int base = 0, total = 0;
#pragma unroll
    for (int w = 0; w < NWAVES; ++w) { const int c = scr[w]; if (w < wave) base += c; total += c; }
    *tot = total;
    return base + inc - v;
}

__device__ __forceinline__ void phase_topk(const float* AFF, const float* RSTD, float* RS, int* IDX, float* GATE, int* POS, LAS unsigned char* ldsm, int blk, int nblk, int tid, int lane, int wave) {
    LAS int* hist = (LAS int*)ldsm;
    LAS int* sel = (LAS int*)(ldsm + 1024);
    LAS int* scr = (LAS int*)(ldsm + 1280);
    for (int g = blk; g < NGRP; g += nblk) {
        unsigned v[16];
        { const GAS v4u* src = (const GAS v4u*)(AFF + (size_t)g * SEQ) + tid * 4;
#pragma unroll
          for (int q = 0; q < 4; ++q) { const v4u w = src[q]; v[4 * q] = w.x; v[4 * q + 1] = w.y; v[4 * q + 2] = w.z; v[4 * q + 3] = w.w; } }
        unsigned prefix = 0u; int krem = CAP;
#pragma unroll 1
        for (int pass = 0; pass < 4; ++pass) {
            const int shift = 24 - 8 * pass;
            const unsigned himask = (pass == 0) ? 0u : (0xffffffffu << (shift + 8));
            __syncthreads();
            if (tid < 256) hist[tid] = 0;
            __syncthreads();
#pragma unroll
            for (int i = 0; i < 16; ++i) if ((v[i] & himask) == prefix) __hip_atomic_fetch_add(hist + ((v[i] >> shift) & 255u), 1, __ATOMIC_RELAXED, __HIP_MEMORY_SCOPE_WORKGROUP);
            __syncthreads();
            if (wave == 0) {
                int c[4]; int s = 0;
#pragma unroll
                for (int j = 0; j < 4; ++j) { c[j] = hist[255 - 4 * lane - j]; s += c[j]; }
                int inc = s;
#pragma unroll
                for (int o = 1; o < 64; o <<= 1) { const int n = __shfl_up(inc, o); if (lane >= o) inc += n; }
                int before = inc - s;
                if (before < krem && krem <= inc) {
                    int bin = 0, kk = krem - before; bool done = false;
#pragma unroll
                    for (int j = 0; j < 4; ++j) { if (!done) { if (kk <= c[j]) { bin = 255 - 4 * lane - j; done = true; } else kk -= c[j]; } }
                    sel[0] = bin; sel[1] = kk;
                }
            }
            __syncthreads();
            prefix |= ((unsigned)sel[0]) << shift; krem = sel[1];
        }
        int ceq = 0;
#pragma unroll
        for (int i = 0; i < 16; ++i) ceq += (v[i] == prefix) ? 1 : 0;
        int tot;
        int eqrank = block_excl_scan(ceq, scr, tid, lane, wave, &tot);
        int csel = 0; unsigned selmask = 0u;
#pragma unroll
        for (int i = 0; i < 16; ++i) { bool s = v[i] > prefix; if (v[i] == prefix) { s = eqrank < krem; ++eqrank; } if (s) { selmask |= 1u << i; ++csel; } }
        int slot = block_excl_scan(csel, scr, tid, lane, wave, &tot);
        const int b = g / NEXP;
        int pv[16];
#pragma unroll
        for (int i = 0; i < 16; ++i) {
            pv[i] = -1;
            if (selmask & (1u << i)) { pv[i] = slot; IDX[g * CAP + slot] = b * SEQ + tid * 16 + i; GATE[g * CAP + slot] = __builtin_bit_cast(float, v[i]); RS[g * CAP + slot] = RSTD[b * SEQ + tid * 16 + i]; ++slot; }
        }
        { GAS v4u* dst = (GAS v4u*)(POS + (size_t)g * SEQ) + tid * 4;
#pragma unroll
          for (int q = 0; q < 4; ++q) { v4u w; w.x = (unsigned)pv[4 * q]; w.y = (unsigned)pv[4 * q + 1]; w.z = (unsigned)pv[4 * q + 2]; w.w = (unsigned)pv[4 * q + 3]; dst[q] = w; } }
        __syncthreads();
    }
}

__device__ __forceinline__ void phase_gather(const bf16* XN, const int* IDX, bf16* XG, int gw, int NGW, int lane) {
    for (int r = gw; r < XROWS; r += NGW) {
        const int src = __builtin_amdgcn_readfirstlane(IDX[r]);
        const GAS v4u* s = (const GAS v4u*)(XN + (size_t)src * DM) + lane; GAS v4u* d = (GAS v4u*)(XG + (size_t)r * DM) + lane;
        const v4u a = s[0], b = s[64]; d[0] = a; d[64] = b;
    }
}

__device__ __forceinline__ void phase_qk_rope(bf16* P, const float* gq, const float* gk, int gw, int NGW, int lane) {
    const int hh = lane >> 2, part = lane & 3, axis = part >> 1, half = part & 1;
    const float* g = (hh < NQH ? gq : gk) + 16 * part;
    float gv[16], inv[16];
#pragma unroll
    for (int i = 0; i < 16; ++i) { gv[i] = g[i]; inv[i] = exp2f(-(float)i * (13.287712379549449f / 16.0f)); }
    const float osc = hh < NQH ? ATT_C2 : 1.0f;
    int m = gw; v4u c0 = (v4u){0u, 0u, 0u, 0u}, c1 = c0;
    if (m < M_TOK) { const GAS v4u* p = (const GAS v4u*)(P + (size_t)m * D_IN_AT + hh * HD + 16 * part); c0 = p[0]; c1 = p[1]; }
#pragma unroll 1
    for (; m < M_TOK; m += NGW) {
        const int t = m % SEQ; const float pos = (float)(axis == 0 ? (t >> 6) : (t & 63));
        GAS v4u* p = (GAS v4u*)(P + (size_t)m * D_IN_AT + hh * HD + 16 * part);
        const v4u w0 = c0, w1 = c1;
        if (m + NGW < M_TOK) { const GAS v4u* pn = (const GAS v4u*)(P + (size_t)(m + NGW) * D_IN_AT + hh * HD + 16 * part); c0 = pn[0]; c1 = pn[1]; }
        float x[16];
        x[0] = bflo(w0.x); x[1] = bfhi(w0.x); x[2] = bflo(w0.y); x[3] = bfhi(w0.y); x[4] = bflo(w0.z); x[5] = bfhi(w0.z); x[6] = bflo(w0.w); x[7] = bfhi(w0.w);
        x[8] = bflo(w1.x); x[9] = bfhi(w1.x); x[10] = bflo(w1.y); x[11] = bfhi(w1.y); x[12] = bflo(w1.z); x[13] = bfhi(w1.z); x[14] = bflo(w1.w); x[15] = bfhi(w1.w);
        float ss = 0.f;
#pragma unroll
        for (int i = 0; i < 16; ++i) ss += x[i] * x[i];
        ss += __shfl_xor(ss, 1); ss += __shfl_xor(ss, 2);
        const float rstd = 1.f / sqrtf(ss * (1.f / HD) + NORM_EPS);
        float o[16];
#pragma unroll
        for (int i = 0; i < 16; ++i) {
            const float xn = x[i] * rstd * gv[i]; const float xp = __shfl_xor(xn, 1);
            float sn, cs; sincosf(pos * inv[i], &sn, &cs);
            o[i] = (half == 0 ? (xn * cs - xp * sn) : (xp * sn + xn * cs)) * osc;
        }
        v4u r0, r1;
        r0.x = pk2(o[0], o[1]); r0.y = pk2(o[2], o[3]); r0.z = pk2(o[4], o[5]); r0.w = pk2(o[6], o[7]);
        r1.x = pk2(o[8], o[9]); r1.y = pk2(o[10], o[11]); r1.z = pk2(o[12], o[13]); r1.w = pk2(o[14], o[15]);
        p[0] = r0; p[1] = r1;
    }
}

__device__ __forceinline__ void phase_transpose_mix(const bf16* MIXT, bf16* MIX, int blk, int nblk, int tid) {
    for (int it = blk; it < (D_MAIN / 64) * (M_TOK / NTHREADS); it += nblk) {
        const int cb = it % (D_MAIN / 64), mb = it / (D_MAIN / 64); const int m = mb * NTHREADS + tid, c0 = cb * 64;
        unsigned w[32];
#pragma unroll
        for (int c = 0; c < 32; ++c) { const unsigned lo = MIXT[(size_t)(c0 + 2 * c) * M_TOK + m], hi = MIXT[(size_t)(c0 + 2 * c + 1) * M_TOK + m]; w[c] = lo | (hi << 16); }
        GAS v4u* d = (GAS v4u*)(MIX + (size_t)m * DM + c0);
#pragma unroll
        for (int q = 0; q < 8; ++q) { v4u o; o.x = w[4 * q]; o.y = w[4 * q + 1]; o.z = w[4 * q + 2]; o.w = w[4 * q + 3]; d[q] = o; }
    }
}
__device__ __forceinline__ void phase_taps(const float* H2j, const float* w3, bf16* TAPS, int gw, int NGW, int lane) {
    typedef float f32x16 __attribute__((ext_vector_type(16))); typedef short bf16x8_t __attribute__((ext_vector_type(8)));
    const float min_decay = -4.605170185988091f / 1.5f, max_decay = -4.605170185988091f / 0.3f;
    const int li = lane & 31, hi = lane >> 5;
#pragma unroll 1
    for (int it = gw; it < (FCOLS / 32) * (SEQ / 128); it += NGW) {
        const int ct = it % (FCOLS / 32), ng = it / (FCOLS / 32), col0 = ct * 32;
        bf16x8_t a[4];
#pragma unroll
        for (int s = 0; s < 4; ++s) { float t[8];
#pragma unroll
            for (int j = 0; j < 8; ++j) t[j] = w3[(size_t)(16 * s + 8 * hi + j) * FCOLS + col0 + li];
            v4u p; p.x = pk2(t[0], t[1]); p.y = pk2(t[2], t[3]); p.z = pk2(t[4], t[5]); p.w = pk2(t[6], t[7]); a[s] = __builtin_bit_cast(bf16x8_t, p); }
        f32x4 hv[4][8];
#pragma unroll
        for (int nt = 0; nt < 4; ++nt) { const GAS f32x4* hp = (const GAS f32x4*)(H2j + (size_t)(ng * 128 + nt * 32 + li) * HY_FILT + 8 * hi);
#pragma unroll
            for (int s = 0; s < 4; ++s) { hv[nt][2 * s] = hp[4 * s]; hv[nt][2 * s + 1] = hp[4 * s + 1]; } }
#pragma unroll
        for (int nt = 0; nt < 4; ++nt) {
            const int n0 = ng * 128 + nt * 32;
            f32x16 acc;
#pragma unroll
            for (int r = 0; r < 16; ++r) acc[r] = 0.f;
#pragma unroll
            for (int s = 0; s < 4; ++s) { const f32x4 v0 = hv[nt][2 * s], v1 = hv[nt][2 * s + 1];
                v4u p; p.x = pk2(v0.x, v0.y); p.y = pk2(v0.z, v0.w); p.z = pk2(v1.x, v1.y); p.w = pk2(v1.z, v1.w);
                acc = __builtin_amdgcn_mfma_f32_32x32x16_bf16(a[s], __builtin_bit_cast(bf16x8_t, p), acc, 0, 0, 0); }
            const float t = (float)(n0 + li) * (1.0f / (float)(SEQ - 1));
#pragma unroll
            for (int r = 0; r < 16; ++r) { const int col = col0 + (r & 3) + 8 * (r >> 2) + 4 * hi, c = col % D_MAIN;
                const float ad = fabsf(min_decay + (float)c * ((max_decay - min_decay) / (float)(D_MAIN - 1)));
                TAPS[(size_t)col * SEQ + n0 + li] = (bf16)f2bf(acc[r] * expf(-t * ad)); }
        }
    }
}

__device__ __forceinline__ constexpr float twc(int k) { constexpr float T[16] = {1.0f, 0.98078528040323043f, 0.92387953251128674f, 0.83146961230254524f, 0.70710678118654757f, 0.55557023301960218f, 0.38268343236508978f, 0.19509032201612825f,
    0.0f, -0.19509032201612825f, -0.38268343236508978f, -0.55557023301960218f, -0.70710678118654757f, -0.83146961230254524f, -0.92387953251128674f, -0.98078528040323043f}; return T[k]; }
__device__ __forceinline__ constexpr float tws(int k) { constexpr float T[16] = {0.0f, 0.19509032201612825f, 0.38268343236508978f, 0.55557023301960218f, 0.70710678118654757f, 0.83146961230254524f, 0.92387953251128674f, 0.98078528040323043f,
    1.0f, 0.98078528040323043f, 0.92387953251128674f, 0.83146961230254524f, 0.70710678118654757f, 0.55557023301960218f, 0.38268343236508978f, 0.19509032201612825f}; return T[k]; }
__device__ __forceinline__ constexpr int bitrev(int i, int bits) { int r = 0; for (int b = 0; b < bits; ++b) if (i & (1 << b)) r |= 1 << (bits - 1 - b); return r; }

template <int N, int LEN> struct FftStage {
    static __device__ __forceinline__ void run(float (&re)[N], float (&im)[N]) {
        constexpr int half = LEN / 2, step = 32 / LEN;
#pragma unroll
        for (int base = 0; base < N; base += LEN)
#pragma unroll
            for (int j = 0; j < half; ++j) {
                const int i0 = base + j, i1 = i0 + half, idx = j * step;
                const float ar = re[i0], ai = im[i0], br = re[i1], bi = im[i1];
                re[i0] = ar + br; im[i0] = ai + bi;
                const float dr = ar - br, di = ai - bi;
                if (idx == 0) { re[i1] = dr; im[i1] = di; }
                else if (idx == 8) { re[i1] = di; im[i1] = -dr; }
                else { const float c = twc(idx), s = tws(idx); re[i1] = dr * c + di * s; im[i1] = di * c - dr * s; }
            }
        if constexpr (LEN > 2) FftStage<N, LEN / 2>::run(re, im);
    }
};
template <int N, int BITS> __device__ __forceinline__ void fft_reg(float (&re)[N], float (&im)[N]) {
    FftStage<N, N>::run(re, im);
    float tr[N], ti[N];
#pragma unroll
    for (int i = 0; i < N; ++i) { tr[bitrev(i, BITS)] = re[i]; ti[bitrev(i, BITS)] = im[i]; }
#pragma unroll
    for (int i = 0; i < N; ++i) { re[i] = tr[i]; im[i] = ti[i]; }
}

template <int N, int LEN> struct FftStageC {
    static __device__ __forceinline__ void run(f32x2 (&x)[N]) {
        constexpr int half = LEN / 2, step = 32 / LEN;
#pragma unroll
        for (int base = 0; base < N; base += LEN)
#pragma unroll
            for (int j = 0; j < half; ++j) {
                const int i0 = base + j, i1 = i0 + half, idx = j * step;
                const f32x2 a = x[i0], b = x[i1];
                x[i0] = a + b;
                const f32x2 d = a - b;
                if (idx == 0) x[i1] = d;
                else if (idx == 8) x[i1] = (f32x2){d.y, -d.x};
                else { const float c = twc(idx), s = tws(idx); const f32x2 t = (f32x2){d.y, -d.x}; x[i1] = d * c + t * s; }
            }
        if constexpr (LEN > 2) FftStageC<N, LEN / 2>::run(x);
    }
};
template <int N, int BITS> __device__ __forceinline__ void fft_regc(f32x2 (&x)[N]) {
    FftStageC<N, N>::run(x);
    f32x2 t[N];
#pragma unroll
    for (int i = 0; i < N; ++i) t[bitrev(i, BITS)] = x[i];
#pragma unroll
    for (int i = 0; i < N; ++i) x[i] = t[i];
}
__device__ __forceinline__ void fft16k_c(f32x2 (&x)[32], LAS f32x2* L, int tid_in) {
    int tid = tid_in; asm volatile("" : "+v"(tid));
    fft_regc<32, 5>(x);
#pragma unroll
    for (int k1 = 1; k1 < 32; ++k1) { const float fr = (float)((tid * k1) & 16383) * (1.0f / 16384.0f); const float c = __builtin_amdgcn_cosf(fr), s = __builtin_amdgcn_sinf(fr);
        const f32x2 d = x[k1], t = (f32x2){d.y, -d.x}; x[k1] = d * c + t * s; if ((k1 & 3) == 3) __builtin_amdgcn_sched_barrier(0); }
#pragma unroll
    for (int k1 = 0; k1 < 32; ++k1) L[k1 * 513 + tid] = x[k1];
    __syncthreads();
    const int n3 = tid & 31, ka = tid >> 5;
    f32x2 a[16], b[16];
#pragma unroll
    for (int n2 = 0; n2 < 16; ++n2) { a[n2] = L[ka * 513 + n2 * 32 + n3]; b[n2] = L[(ka + 16) * 513 + n2 * 32 + n3]; }
    fft_regc<16, 4>(a); fft_regc<16, 4>(b);
#pragma unroll
    for (int k2 = 1; k2 < 16; ++k2) { const float fr = (float)((n3 * k2) & 511) * (1.0f / 512.0f); const float c = __builtin_amdgcn_cosf(fr), s = __builtin_amdgcn_sinf(fr);
        f32x2 d = a[k2], t = (f32x2){d.y, -d.x}; a[k2] = d * c + t * s; d = b[k2]; t = (f32x2){d.y, -d.x}; b[k2] = d * c + t * s; if ((k2 & 3) == 3) __builtin_amdgcn_sched_barrier(0); }
    __syncthreads();
#pragma unroll
    for (int k2 = 0; k2 < 16; ++k2) { L[n3 * 513 + k2 * 32 + ka] = a[k2]; L[n3 * 513 + k2 * 32 + ka + 16] = b[k2]; }
    __syncthreads();
#pragma unroll
    for (int q = 0; q < 32; ++q) x[q] = L[q * 513 + tid];
    fft_regc<32, 5>(x);
}
__device__ __forceinline__ void fft16k(float (&re)[32], float (&im)[32], LAS f32x2* L, int tid) {
    f32x2 x[32];
#pragma unroll
    for (int r = 0; r < 32; ++r) x[r] = (f32x2){re[r], im[r]};
    fft16k_c(x, L, tid);
#pragma unroll
    for (int r = 0; r < 32; ++r) { re[r] = x[r].x; im[r] = x[r].y; }
}

constexpr int HS_SP = SEQ + 16;
__device__ __forceinline__ void hy_stage(LAS bf16* S, int slot, const bf16* src, int tid) {
    LAS bf16* d = S + slot * HS_SP + 8;
    if (tid == 0) { d[-1] = 0; d[SEQ] = 0; }
#pragma unroll
    for (int q = 0; q < 2; ++q) { const int ch = q * NTHREADS + tid; *(LAS v4u*)(d + ch * 8) = *(const GAS v4u*)(src + ch * 8); }
}
__device__ __forceinline__ float hy_sc(const LAS bf16* S, int slot, int t, float w0, float w1, float w2) {
    const LAS bf16* p = S + slot * HS_SP + 8 + t;
    return bf2f(p[-1]) * w0 + bf2f(p[0]) * w1 + bf2f(p[1]) * w2;
}

__device__ __forceinline__ void phase_hyena_conv(const bf16* PT, const bf16* TAPS, const float* shortw, const float* skip, f32x2* XSall, bf16* MIXT,
                                                 LAS unsigned char* lds, int blk, int nblk, int tid_in, int lane, int wave, int pmode = 0) {
    LAS f32x2* L = (LAS f32x2*)lds; LAS bf16* S = (LAS bf16*)lds; LAS float* red = (LAS float*)(lds + LDS_MISC);
    f32x2* XS = XSall + (size_t)blk * 16384;
    f32x2* ZS = XS + 16384 * 256;
    constexpr int N = 16384;
#pragma unroll 1
    for (int c = blk; c < D_MAIN; c += nblk) {
        const bf16* hf0 = TAPS + (size_t)c * SEQ; const bf16* hb0 = TAPS + (size_t)(D_MAIN + c) * SEQ;
        const bf16* hf1 = TAPS + (size_t)(2 * D_MAIN + c) * SEQ; const bf16* hb1 = TAPS + (size_t)(3 * D_MAIN + c) * SEQ;
        const bf16* px1 = PT + (size_t)c * M_TOK; const bf16* px2 = PT + (size_t)(D_MAIN + c) * M_TOK; const bf16* pv = PT + (size_t)(2 * D_MAIN + c) * M_TOK;
        const float wx1[3] = {shortw[c], shortw[2304 + c], shortw[4608 + c]};
        const float wx2[3] = {shortw[D_MAIN + c], shortw[2304 + D_MAIN + c], shortw[4608 + D_MAIN + c]};
        const float wv[3] = {shortw[2 * D_MAIN + c], shortw[2304 + 2 * D_MAIN + c], shortw[4608 + 2 * D_MAIN + c]};
        const float sk0 = skip[c], sk1 = skip[D_MAIN + c];
        f32x2 x[32]; float vr[16], vi[16];
#pragma unroll 1
        for (int pass = 0; pass < 5; ++pass) {
            int tid = tid_in; asm volatile("" : "+v"(tid));
            if (pass == 0) {
#pragma unroll
                for (int r = 0; r < 16; ++r) { const int n = r * 512 + tid; x[r].x = bf2f(hf0[n]); x[r].y = bf2f(hf1[n]); }
#pragma unroll
                for (int r = 16; r < 32; ++r) { const int idx = (32 - r) * 512 - tid; const bool z = (idx == SEQ); const int ii = z ? 0 : idx; x[r].x = z ? 0.f : bf2f(hb0[ii]); x[r].y = z ? 0.f : bf2f(hb1[ii]); }
                float e0 = 0.f, e1 = 0.f;
                if (tid == 0) { e0 = bf2f(hb0[0]); e1 = bf2f(hb1[0]); }
                float s0 = fabsf(e0), s1 = fabsf(e1);
#pragma unroll
                for (int r = 0; r < 32; ++r) { s0 += fabsf(x[r].x); s1 += fabsf(x[r].y); }
                s0 = wave_sum(s0); s1 = wave_sum(s1);
                __syncthreads();
                if (lane == 0) { red[wave] = s0; red[8 + wave] = s1; }
                __syncthreads();
                float t0 = 0.f, t1 = 0.f;
#pragma unroll
                for (int w = 0; w < NWAVES; ++w) { t0 += red[w]; t1 += red[8 + w]; }
                const float sc0 = 1.0f / (t0 + 1e-6f), sc1 = 1.0f / (t1 + 1e-6f);
                x[0].x += e0; x[0].y += e1;
#pragma unroll
                for (int r = 0; r < 32; ++r) { x[r].x *= sc0; x[r].y *= sc1; }
            } else if (pass == 1) {
                __syncthreads();
                hy_stage(S, 0, pv, tid); hy_stage(S, 1, pv + SEQ, tid);
                __syncthreads();
#pragma unroll
                for (int r = 0; r < 16; ++r) { const int t = r * 512 + tid; x[r].x = hy_sc(S, 0, t, wv[0], wv[1], wv[2]); x[r].y = hy_sc(S, 1, t, wv[0], wv[1], wv[2]); vr[r] = x[r].x; vi[r] = x[r].y; }
#pragma unroll
                for (int r = 16; r < 32; ++r) { x[r].x = 0.f; x[r].y = 0.f; }
            }
            __syncthreads();
            fft16k_c(x, L, tid);
            if (pass == 0) {
#pragma unroll
                for (int r = 0; r < 32; ++r) XS[r * 512 + tid] = (f32x2){x[r].x, x[r].y};
                __syncthreads();
            } else if (pass == 1 || pass == 3) {
#pragma unroll
                for (int r = 0; r < 32; ++r) {
                    const int f = r * 512 + tid; const f32x2 xa = XS[f], xb = XS[(N - f) & (N - 1)];
                    float kr, ki;
                    if (pass == 1) { kr = xa.x + xb.x; ki = xa.y - xb.y; } else { kr = xa.y + xb.y; ki = xb.x - xa.x; }
                    kr *= (0.5f / (float)N); ki *= (0.5f / (float)N);
                    const float zr_ = x[r].x, zi_ = x[r].y;
                    x[r].x = zr_ * kr - zi_ * ki; x[r].y = -(zr_ * ki + zi_ * kr);
                }
            } else if (pass == 2) {
                __syncthreads();
                hy_stage(S, 2, px1, tid); hy_stage(S, 3, px1 + SEQ, tid);
                __syncthreads();
#pragma unroll
                for (int r = 0; r < 16; ++r) { const int t = r * 512 + tid;
                    const float v0 = vr[r], v1 = vi[r];
                    const float g0 = hy_sc(S, 2, t, wx1[0], wx1[1], wx1[2]), g1 = hy_sc(S, 3, t, wx1[0], wx1[1], wx1[2]);
                    x[r].x = g0 * (x[r].x + sk0 * v0); x[r].y = g1 * (-x[r].y + sk0 * v1); ZS[t] = (f32x2){x[r].x, x[r].y}; }
#pragma unroll
                for (int r = 16; r < 32; ++r) { x[r].x = 0.f; x[r].y = 0.f; }
            } else {
                __syncthreads();
                hy_stage(S, 0, px2, tid); hy_stage(S, 1, px2 + SEQ, tid);
                __syncthreads();
#pragma unroll
                for (int r = 0; r < 16; ++r) { const int t = r * 512 + tid;
                    const float g0 = hy_sc(S, 0, t, wx2[0], wx2[1], wx2[2]), g1 = hy_sc(S, 1, t, wx2[0], wx2[1], wx2[2]);
                    const f32x2 z = ZS[t];
                    const float o0 = g0 * (x[r].x + sk1 * z.x), o1 = g1 * (-x[r].y + sk1 * z.y);
                    MIXT[(size_t)c * M_TOK + t] = (bf16)f2bf(o0); MIXT[(size_t)c * M_TOK + SEQ + t] = (bf16)f2bf(o1); }
            }
        }
        __syncthreads();
    }
}
#ifndef MK_PER_PHASE
#define MK_PER_PHASE 0
#endif
#ifndef CONV_PMODE
#define CONV_PMODE 0
#endif
#ifndef REPMASK
#define REPMASK 0u
#endif
#define REP(kind) _Pragma("unroll 1") for (int r_ = 0; r_ < 1 + (int)((REPMASK >> (kind)) & 1u); ++r_)
struct Args {
    const float* in[24]; float* out; unsigned char* ws; int ph_lo, ph_hi;
};
constexpr int N_PHASES = 1 + (DEPTH - 1) + DEPTH * 8 - DEPTH / 2 + 1;

template <int QP, int KP>
__device__ __forceinline__ void run_attn(const bf16* Q, const bf16* K, const bf16* V, bf16* O, int NT, char* shm) {
    attn_body::attn_unit<8, QP, KP, DM>((const attn_body::bf16*)Q, (const attn_body::bf16*)K, (const attn_body::bf16*)V, (attn_body::bf16*)O, NT, shm);
}

__global__ void __launch_bounds__(NTHREADS, 2) hybrid_fwd(Args args) {
    extern __shared__ __attribute__((aligned(16))) unsigned char lds_raw[];
    LAS unsigned char* lds = (LAS unsigned char*)lds_raw;
    const int G = gridDim.x, bx = blockIdx.x;
    const int vcu = (G % 8 == 0) ? (bx % 8) * (G / 8) + bx / 8 : bx;
    const int NGW = G * NWAVES;
    unsigned char* ws = args.ws;
    const float* x = args.in[0]; const float* mem = args.in[1]; const float* mix_g = args.in[2]; const float* ffn_g = args.in[3]; const float* mem_g = args.in[4]; const float* fin_g = args.in[5];
    const float* hy_short = args.in[9]; const float* f_w1 = args.in[10]; const float* f_b1 = args.in[11]; const float* f_w2 = args.in[12]; const float* f_b2 = args.in[13];
    const float* f_w3 = args.in[14]; const float* f_freq = args.in[15]; const float* hy_skip = args.in[16]; const float* qg = args.in[18]; const float* kg = args.in[19]; const float* router = args.in[20];
    float* H = args.out;
    bf16* U = (bf16*)(ws + WS_U); bf16* PROJ = (bf16*)(ws + WS_PROJ); bf16* CQ = (bf16*)(ws + WS_CQ); bf16* MIX = (bf16*)(ws + WS_MIX); bf16* MIXT = (bf16*)(ws + WS_MIXT);
    float* AFF = (float*)(ws + WS_AFF); int* IDX = (int*)(ws + WS_IDX); float* GATE = (float*)(ws + WS_GATE); int* POS = (int*)(ws + WS_POS);
    bf16* XG = (bf16*)(ws + WS_XG); bf16* HID = (bf16*)(ws + WS_HID); bf16* Y = (bf16*)(ws + WS_Y); bf16* TAPS = (bf16*)(ws + WS_TAPS);
    const bf16* MKV = (const bf16*)(ws + WS_MKV);
    cg::grid_group grid = cg::this_grid();
    volatile LAS unsigned* bst = (volatile LAS unsigned*)(lds + LDS_MISC + 4096);
    if (threadIdx.x < 2) bst[threadIdx.x] = 0u;
    __syncthreads();
    XcdBarrier xbar = xcd_barrier_post((unsigned*)(ws + WS_CTL) + 1024, bst);
    const int lo = args.ph_lo, hi = args.ph_hi;
    const XwIn XW{args.in[21], args.in[22], args.in[23], ws}; const bool xw_sched = (G == 256);
    int ph = 0;
#define PHASE_BEGIN if (lo <= ph && ph < hi) { const int tid = opaque_tid(), lane = tid & 63, wave = __builtin_amdgcn_readfirstlane(tid >> 6), gw = vcu * NWAVES + wave; (void)lane; (void)gw;
#ifdef EXTRA_XBAR
#define PHASE_END   if (ph + 1 < hi) { if (ph == lo) grid.sync(); else { xcd_barrier(xbar); if (ph < EXTRA_XBAR) xcd_barrier(xbar); } } } ++ph;
#else
#define PHASE_END   if (ph + 1 < hi) { if (ph == lo) grid.sync(); else xcd_barrier(xbar); } } ++ph;
#endif

    PHASE_BEGIN
        ProIn P{args.in[8], args.in[17], args.in[7], args.in[6]};
        REP(0) { phase_weights(P, ws, lds, gw, NGW, wave, lane); phase_xw_p0(XW, xw_sched, (LAS float*)(lds + wave * 16384), gw, NGW, lane); }
        phase_wrg(ffn_g, router, (float*)(ws + WS_WRG), (int)(bx * NTHREADS + tid), (int)(G * NTHREADS));
        REP(1) phase_mem_h2(mem, mem_g, f_w1, f_b1, f_w2, f_b2, f_freq, ws, gw, NGW, lane);
        REP(3) phase_norm<false, false>(x, nullptr, mix_g, U, nullptr, nullptr, nullptr, gw, NGW, lane);
    PHASE_END

#pragma unroll 1
    for (int i = 0; i < DEPTH; ++i) {
        const bool hy = (i & 1) == 0; const int j = i >> 1;
        if (i > 0) {
        PHASE_BEGIN
            phase_norm<true, false>(H, H, mix_g + i * DM, U, nullptr, POS, Y, gw, NGW, lane);
        PHASE_END
        }
        PHASE_BEGIN
            if (i == 0) {
                pg8::Gemm g{(const bf16*)(ws + WS_MEMN), (const bf16*)(ws + WS_WMKV), BATCH * MEM_LEN, 2048, DM, 1 << 30, 1, 0};
                pg8::StaticOrder S; S.init(BATCH * MEM_LEN, 2048, G, bx);
                pg8::EpiRowBf16 E{(bf16*)(ws + WS_MKV), 2048, -1, 1.f};
                pg8::gemm_phase<pg8::EpiRowBf16, pg8::StaticOrder, true, true>(lds, g, S, E);
            }
            if (hy) {
                REP(4) phase_taps((const float*)(ws + WS_H2) + (size_t)j * SEQ * HY_FILT, f_w3 + (size_t)j * HY_FILT * FCOLS, TAPS, gw, NGW, lane);
                pg8::Gemm g{U, (const bf16*)(ws + WS_WHY) + (size_t)j * D_IN_HY * DM, M_TOK, D_IN_HY, DM, 1 << 30, 1, 0};
                pg8::StaticOrder S; S.init(M_TOK, D_IN_HY, G, bx);
                pg8::EpiHyIn E{PROJ, M_TOK, 9, CQ, ATT_C2};
                REP(5) pg8::gemm_phase<pg8::EpiHyIn, pg8::StaticOrder, true, true>(lds, g, S, E);
            } else {
                pg8::Gemm g{U, (const bf16*)(ws + WS_WAT) + (size_t)j * D_IN_AT * DM, M_TOK, D_IN_AT, DM, 1 << 30, 1, 0};
                pg8::StaticOrder S; S.init(M_TOK, D_IN_AT, G, bx);
                pg8::EpiAtIn E{PROJ, D_IN_AT, qg + j * HD, kg + j * HD, ATT_C2, NORM_EPS, SEQ - 1};
                REP(6) pg8::gemm_phase<pg8::EpiAtIn, pg8::StaticOrder, true, true>(lds, g, S, E);
            }
            if (xw_sched && bx >= 128) xw_slice_a(XW, i, (LAS float*)(lds + wave * 16384), bx, wave, lane);
        PHASE_END
        PHASE_BEGIN
            if (hy) {
                REP(8) phase_hyena_conv(PROJ, TAPS, hy_short + (size_t)j * 3 * 2304, hy_skip + (size_t)j * 2 * D_MAIN, (f32x2*)(ws + WS_FFTX), MIXT, lds, bx, G, tid, lane, wave);
                REP(9) for (int u = vcu; u < 256; u += G) { const int b = u >> 7, h4 = (u >> 5) & 3, qb = u & 31; const size_t row = (size_t)b * SEQ + qb * 256;
                    run_attn<256, 2048>(CQ + row * 256 + h4 * HD, MKV + (size_t)b * MEM_LEN * 2048 + i * 512 + h4 * HD, MKV + (size_t)b * MEM_LEN * 2048 + i * 512 + 256 + h4 * HD,
                                        MIX + row * DM + D_MAIN + h4 * HD, MEM_LEN / 64, (char*)lds_raw); }
            } else {
                REP(10) for (int u = vcu; u < 768; u += G) { const int bk = (u & 255) >> 5, qb = u & 31, hs = u >> 8, b = bk >> 2, kvh = bk & 3, h = kvh * 3 + hs; const size_t row = (size_t)b * SEQ + qb * 256;
                    run_attn<D_IN_AT, D_IN_AT>(PROJ + row * D_IN_AT + h * HD, PROJ + (size_t)b * SEQ * D_IN_AT + D_MAIN + kvh * HD, PROJ + (size_t)b * SEQ * D_IN_AT + D_MAIN + 256 + kvh * HD,
                                               MIX + row * DM + h * HD, SEQ / 64, (char*)lds_raw); }
                REP(9) for (int u = vcu; u < 256; u += G) { const int b = u >> 7, h4 = (u >> 5) & 3, qb = u & 31; const size_t row = (size_t)b * SEQ + qb * 256;
                    run_attn<D_IN_AT, 2048>(PROJ + row * D_IN_AT + 1280 + h4 * HD, MKV + (size_t)b * MEM_LEN * 2048 + i * 512 + h4 * HD, MKV + (size_t)b * MEM_LEN * 2048 + i * 512 + 256 + h4 * HD,
                                            MIX + row * DM + D_MAIN + h4 * HD, MEM_LEN / 64, (char*)lds_raw); }
            }
        PHASE_END
        if (hy) {
            PHASE_BEGIN
                REP(11) phase_transpose_mix(MIXT, MIX, bx, G, tid);
            PHASE_END
        }
        PHASE_BEGIN
            pg8::Gemm g{MIX, (const bf16*)(ws + WS_WOUT) + (size_t)i * DM * DM, M_TOK, DM, DM, 1 << 30, 1, 0};
            pg8::StaticOrder S; S.init(M_TOK, DM, G, bx);
            pg8::EpiOutX E{i == 0 ? x : (const float*)H, H, DM, ffn_g + i * DM, (const float*)(ws + WS_WRG) + (size_t)i * NEXP * DM, (unsigned char*)U, (float*)(ws + WS_PART), (float*)(ws + WS_PSS), M_TOK};
            pg8::gemm_phase<pg8::EpiOutX, pg8::StaticOrder, true, true>(lds, g, S, E);
        PHASE_END
        PHASE_BEGIN
            REP(13) phase_router_sum((const float*)(ws + WS_PART), (const float*)(ws + WS_PSS), (float*)(ws + WS_RSTD), AFF, gw, NGW, lane);
        PHASE_END
        PHASE_BEGIN
            REP(14) phase_topk(AFF, (const float*)(ws + WS_RSTD), (float*)(ws + WS_RS), IDX, GATE, POS, lds + LDS_MISC, bx, G, tid, lane, wave);
            if (xw_sched && bx >= 32) xw_slice_b(XW, i, (LAS float*)(lds + wave * 16384), bx, wave, lane);
        PHASE_END
        PHASE_BEGIN
            pg8::Gemm g{U, (const bf16*)(ws + WS_W1 + (size_t)i * NEXP * 1536 * DM), XROWS, 1536, DM / 2, 4, NEXP, (size_t)1536 * DM};
            pg8::StaticOrder S; S.init(XROWS, 1536, G, bx);
            pg8::EpiSwiGLU8 E{(unsigned char*)HID, EFF, 1.0f / W8_SCALE, (const float*)(ws + WS_RS)};
            REP(16) pg8::gemm_phase<pg8::EpiSwiGLU8, pg8::StaticOrder, true, true, true, true>(lds, g, S, E, IDX);
        PHASE_END
        PHASE_BEGIN
            pg8::Gemm g{HID, (const bf16*)(ws + WS_W2 + (size_t)i * NEXP * DM * EFF), XROWS, DM, EFF / 2, 4, NEXP, (size_t)DM * EFF};
            pg8::StaticOrder S; S.init(XROWS, DM, G, bx);
            pg8::EpiDown E{Y, DM, GATE, 1.0f / W8_SCALE};
            REP(17) pg8::gemm_phase<pg8::EpiDown, pg8::StaticOrder, true, true, false, true>(lds, g, S, E);
        PHASE_END
    }
    PHASE_BEGIN
        phase_norm<true, true>(H, nullptr, fin_g, nullptr, args.out, POS, Y, gw, NGW, lane);
    PHASE_END
#undef PHASE_BEGIN
#undef PHASE_END
}

extern "C" void kernel_launch(void* const* d_in, const int* in_sizes, int n_in, void* d_out, int out_size, void* d_ws, size_t ws_size, hipStream_t stream) {
    static int grid = 0;
    if (grid == 0) {
        if (n_in != 24 || out_size != M_TOK * DM || ws_size < WS_END) { fprintf(stderr, "kernel_launch: unexpected shapes (n_in %d out %d ws %zu need %zu)\n", n_in, out_size, ws_size, (size_t)WS_END); grid = -1; return; }
        int dev = 0, cus = 0, per_cu = 0;
        if (hipGetDevice(&dev) != hipSuccess || hipDeviceGetAttribute(&cus, hipDeviceAttributeMultiprocessorCount, dev) != hipSuccess) { grid = -1; return; }
        if (hipFuncSetAttribute((const void*)hybrid_fwd, hipFuncAttributeMaxDynamicSharedMemorySize, LDS_BYTES) != hipSuccess) { fprintf(stderr, "kernel_launch: hipFuncSetAttribute failed\n"); grid = -1; return; }
        if (hipOccupancyMaxActiveBlocksPerMultiprocessor(&per_cu, (const void*)hybrid_fwd, NTHREADS, LDS_BYTES) != hipSuccess || per_cu < 1) { fprintf(stderr, "kernel_launch: occupancy query says %d blocks/CU\n", per_cu); per_cu = 1; }
        (void)hipGetLastError();
        grid = cus;
    }
    if (grid < 0) return;
    if (hipMemsetAsync((char*)d_ws + WS_CTL, 0, 64 * 1024, stream) != hipSuccess) { fprintf(stderr, "kernel_launch: memset failed\n"); return; }
    Args a{};
    for (int i = 0; i < 24; ++i) a.in[i] = (const float*)d_in[i];
    a.out = (float*)d_out; a.ws = (unsigned char*)d_ws;
#if MK_PER_PHASE
    for (int li = 0; li < N_PHASES; ++li) {
        a.ph_lo = li; a.ph_hi = li + 1;
        void* kargs[] = {&a};
        hipError_t e = hipLaunchCooperativeKernel((const void*)hybrid_fwd, dim3(grid), dim3(NTHREADS), kargs, LDS_BYTES, stream);
        if (e != hipSuccess) { fprintf(stderr, "kernel_launch: launch %d failed: %s\n", li, hipGetErrorString(e)); break; }
    }
#else
    a.ph_lo = 0; a.ph_hi = N_PHASES;
    void* kargs[] = {&a};
    hipError_t e = hipLaunchCooperativeKernel((const void*)hybrid_fwd, dim3(grid), dim3(NTHREADS), kargs, LDS_BYTES, stream);
    if (e != hipSuccess) fprintf(stderr, "kernel_launch: cooperative launch failed: %s (grid %d)\n", hipGetErrorString(e), grid);
#endif
}
```

```cpp
#include <hip/hip_runtime.h>
#include <hip/hip_cooperative_groups.h>
#include <hip/hip_bf16.h>
#include <cmath>
#include <cstdio>
#include <cstdint>
namespace cg = cooperative_groups;

constexpr int BATCH = 2, SEQ = 8192, DM = 1024, DEPTH = 4, M_TOK = BATCH * SEQ;
constexpr int HD = 64, MEM_LEN = 256, D_MEM = 256, D_MAIN = 768, NQH = 12, NKVH = 4;
constexpr int D_IN_HY = 2560, D_IN_AT = 1536;
constexpr int NEXP = 16, CAP = 1024, EFF = 768, NGRP = BATCH * NEXP, XROWS = NGRP * CAP;
constexpr int HY_EMB = 33, HY_FILT = 64, FCOLS = 4 * D_MAIN;
constexpr float NORM_EPS = 1e-6f;
constexpr float W8_SCALE = 32.0f;
constexpr float ATT_C2 = 0.125f * 1.4426950408889634f;

constexpr size_t MiB = 1u << 20;
constexpr size_t WS_CTL = 0;
constexpr size_t WS_WHY = 2 * MiB;
constexpr size_t WS_WAT = 12 * MiB;
constexpr size_t WS_WOUT = 18 * MiB;
constexpr size_t WS_WMKV = 26 * MiB;
constexpr size_t WS_W1 = 32 * MiB;
constexpr size_t WS_W2 = 224 * MiB;
constexpr size_t WS_U = 320 * MiB;
constexpr size_t WS_PROJ = 352 * MiB;
constexpr size_t WS_CQ = WS_PROJ + 72 * MiB;
constexpr size_t WS_MIX = 432 * MiB;
constexpr size_t WS_MIXT = 464 * MiB;
constexpr size_t WS_AFF = 488 * MiB;
constexpr size_t WS_IDX = 489 * MiB;
constexpr size_t WS_GATE = WS_IDX + 128 * 1024;
constexpr size_t WS_POS = 490 * MiB;
constexpr size_t WS_XG = 492 * MiB;
constexpr size_t WS_HID = 556 * MiB;
constexpr size_t WS_TAPS = WS_XG;
constexpr size_t WS_Y = 604 * MiB;
constexpr size_t WS_FFTX = WS_Y;
constexpr size_t WS_H2 = 668 * MiB;
constexpr size_t WS_MEMN = 672 * MiB;
constexpr size_t WS_MKV = 673 * MiB;
constexpr size_t WS_PART = 676 * MiB;
constexpr size_t WS_PSS = 692 * MiB;
constexpr size_t WS_RSTD = 697 * MiB;
constexpr size_t WS_RS = WS_RSTD + 128 * 1024;
constexpr size_t WS_WRG = 698 * MiB;
constexpr size_t WS_END = 699 * MiB;

constexpr int LDS_RING = 0;
constexpr int LDS_MISC = 132 * 1024;
constexpr int LDS_BYTES = 140 * 1024;
constexpr int NTHREADS = 512, NWAVES = 8;

#define GAS __attribute__((address_space(1)))
#define LAS __attribute__((address_space(3)))
typedef unsigned short bf16;
typedef unsigned v4u __attribute__((ext_vector_type(4)));
typedef unsigned v2u __attribute__((ext_vector_type(2)));
typedef float f32x4 __attribute__((ext_vector_type(4)));
typedef float f32x2 __attribute__((ext_vector_type(2)));
__device__ __forceinline__ unsigned f2bf(float f) { unsigned u = __builtin_bit_cast(unsigned, f); return (u + 0x7fffu + ((u >> 16) & 1u)) >> 16; }
__device__ __forceinline__ unsigned pk2(float lo, float hi) { return f2bf(lo) | (f2bf(hi) << 16); }
__device__ __forceinline__ float bf2f(unsigned short h) { return __builtin_bit_cast(float, (unsigned)h << 16); }
__device__ __forceinline__ float bflo(unsigned w) { return __builtin_bit_cast(float, w << 16); }
__device__ __forceinline__ float bfhi(unsigned w) { return __builtin_bit_cast(float, w & 0xffff0000u); }
__device__ __forceinline__ float wave_sum(float v) {
#pragma unroll
    for (int o = 1; o < 64; o <<= 1) v += __shfl_xor(v, o);
    return v;
}
__device__ __forceinline__ int opaque_tid() { int t = threadIdx.x; asm volatile("" : "+v"(t)); return t; }
#define MK_PER_PHASE 0

#define XB_TMO      128
#define XB_XCNT(j)  (256  + 64 * (j))
#define XB_XSUB(j)  (1280 + 64 * (j))
#define XB_XGEN(j)  (2304 + 64 * (j))
#define XB_TOP      3328
#define XB_TOPGEN   3392
#define XCD_BAR_WORDS 3456
#define XB_SPIN_CAP (1u << 18)

__device__ __forceinline__ unsigned xb_ld(unsigned* p)              { return __hip_atomic_load(p, __ATOMIC_RELAXED, __HIP_MEMORY_SCOPE_AGENT); }
__device__ __forceinline__ unsigned xb_add(unsigned* p, unsigned v) { return __hip_atomic_fetch_add(p, v, __ATOMIC_RELAXED, __HIP_MEMORY_SCOPE_AGENT); }
__device__ __forceinline__ unsigned xb_xcc_id() { return (unsigned)__builtin_amdgcn_s_getreg((3 << 11) | 20) & 0xFu; }
#define XB_SPIN(cond, bar) do { unsigned _sp = 0; while (cond) { __builtin_amdgcn_s_sleep(1); \
    if ((++_sp & 255u) == 0u) { if (xb_ld(&(bar)[XB_TMO])) break; if (_sp > XB_SPIN_CAP) { atomicAdd(&(bar)[XB_TMO], 1u); break; } } } } while (0)

struct XcdBarrier {
    unsigned* bar; unsigned x;
    volatile LAS unsigned* st;
};

__device__ __forceinline__ XcdBarrier xcd_barrier_post(unsigned* bar, volatile LAS unsigned* st) {
    XcdBarrier b; b.bar = bar; b.x = xb_xcc_id(); b.st = st;
    if (threadIdx.x == 0) (void)xb_add(&bar[XB_XCNT(b.x)], 1u);
    return b;
}
__device__ __forceinline__ void xcd_barrier_complete(unsigned* bar, unsigned x, unsigned& nloc, unsigned& nx) {
    const unsigned G = gridDim.x * gridDim.y * gridDim.z;
    unsigned sum, cnt, mine, sp = 0u;
    for (;;) {
        sum = 0u; cnt = 0u; mine = 0u;
#pragma unroll
        for (unsigned j = 0; j < 16; ++j) { const unsigned c = xb_ld(&bar[XB_XCNT(j)]); sum += c; cnt += (c > 0u) ? 1u : 0u; mine = (j == x) ? c : mine; }
        if (sum == G) break;
        __builtin_amdgcn_s_sleep(1);
        if ((++sp & 255u) == 0u) { if (xb_ld(&bar[XB_TMO])) break; if (sp > XB_SPIN_CAP) { atomicAdd(&bar[XB_TMO], 1u); break; } }
    }
    nloc = mine > 0u ? mine : 1u; nx = cnt > 0u ? cnt : 1u;
}

__device__ __forceinline__ void xcd_barrier(const XcdBarrier& b) {
    asm volatile("s_waitcnt vmcnt(0)" ::: "memory");
    __syncthreads();
    if (threadIdx.x == 0) {
        unsigned* bar = b.bar;
        __builtin_amdgcn_s_waitcnt(0);
        unsigned nloc = b.st[0], nx = b.st[1];
        if (nloc == 0u) { xcd_barrier_complete(bar, b.x, nloc, nx); b.st[0] = nloc; b.st[1] = nx; }
        const unsigned old = xb_add(&bar[XB_XSUB(b.x)], 1u);
        const unsigned gen = old / nloc;
        if (old + 1u == (gen + 1u) * nloc) {
            __builtin_amdgcn_fence(__ATOMIC_RELEASE, "agent");
            asm volatile("s_waitcnt vmcnt(0)" ::: "memory");
            const unsigned og = xb_add(&bar[XB_TOP], 1u);
            const unsigned tg = og / nx;
            if (og + 1u == (tg + 1u) * nx) xb_add(&bar[XB_TOPGEN], 1u);
            else XB_SPIN(xb_ld(&bar[XB_TOPGEN]) == tg, bar);
            __builtin_amdgcn_fence(__ATOMIC_ACQUIRE, "agent");
            xb_add(&bar[XB_XGEN(b.x)], 1u);
            asm volatile("s_waitcnt vmcnt(0)" ::: "memory");
        } else {
            XB_SPIN(xb_ld(&bar[XB_XGEN(b.x)]) == gen, bar);
            __builtin_amdgcn_fence(__ATOMIC_ACQUIRE, "agent");
            asm volatile("s_waitcnt vmcnt(0)" ::: "memory");
        }
    }
    __syncthreads();
}
namespace pg8 {
#define PG8_LAS __attribute__((address_space(3)))
typedef unsigned short bf16_t;
typedef short bf16x8 __attribute__((ext_vector_type(8)));
typedef float f32x4 __attribute__((ext_vector_type(4)));
typedef unsigned u32x4 __attribute__((ext_vector_type(4)));
constexpr int BM = 256, BK = 64, HALF = 128, HTB = HALF * BK * 2  , STAGE_BYTES = 8 * HTB, NXCD = 8, WGM = 8;

__host__ __device__ __forceinline__ int lds_byte(int r, int c) { const int st = (r >> 4) * 2 + (c >> 5), rr = r & 15, cc = c & 31, ob = rr * 64 + cc * 2; return st * 1024 + (ob ^ (((ob >> 9) & 1) << 5)); }
__host__ __device__ __forceinline__ void stage_rc(int b, int& R, int& C) { const int st = b / 1024, sb = b % 1024, swz = sb ^ (((sb >> 9) & 1) << 5); R = (st >> 1) * 16 + swz / 64; C = (st & 1) * 32 + (swz % 64) / 2; }
__host__ __device__ __forceinline__ int perm32(int rho) { const int n = rho >> 4, i = rho & 15; return 8 * (i >> 2) + 4 * n + (i & 3); }

struct Unit { int pm, pn; };
struct Gemm { const bf16_t* A; const bf16_t* Bt; int M, N, K; int gdiv, gmod; size_t gstride; };

struct StaticOrder {
    int nM, nN, nwg, G, c;
    __host__ __device__ void init(int M, int N, int G_, int c_) { nM = M / BM; nN = N / BM; nwg = nM * nN; G = G_; c = c_; }
    __host__ __device__ bool next(int i, Unit& u) const {
        const long L = (long)i * G + c; if (L >= nwg) return false;
        int wgid = (int)L; { const int q = nwg / NXCD, r = nwg % NXCD, xcd = wgid % NXCD, off = wgid / NXCD; wgid = (xcd < r ? xcd * (q + 1) : r * (q + 1) + (xcd - r) * q) + off; }
        const int nig = WGM * nN, gid = wgid / nig, fm = gid * WGM, gsz = (nM - fm) < WGM ? (nM - fm) : WGM;
        u.pm = fm + ((wgid % nig) % gsz); u.pn = (wgid % nig) / gsz; return true;
    }
    __device__ __forceinline__ void a_ready(const Unit&) const {}
    __device__ __forceinline__ void done(const Unit&) const {}
};


__device__ __forceinline__ unsigned cvt_pk_bf16(float lo, float hi) { unsigned r; asm volatile("v_cvt_pk_bf16_f32 %0, %1, %2" : "=v"(r) : "v"(lo), "v"(hi)); return r; }
typedef unsigned u32x2 __attribute__((ext_vector_type(2)));
struct EpiRowBf16 {
    static constexpr bool PERM = false, AFTER_DRAIN = false;
    bf16_t* O; int ldc; int sc_pn; float sc;
    __device__ __forceinline__ void operator()(const f32x4 (&acc)[2][2][4][2], const Unit& u, int wr, int wc, int fr, int fq) const {
        const float s = (u.pn == sc_pn) ? sc : 1.f;
        const int row0 = u.pm * BM + wr * 64 + fr, col0 = u.pn * BM + wc * 32 + 4 * fq;
#pragma unroll
        for (int ai = 0; ai < 2; ++ai)
#pragma unroll
            for (int m = 0; m < 4; ++m) { bf16_t* rowp = O + (size_t)(row0 + ai * HALF + m * 16) * ldc + col0;
#pragma unroll
                for (int bj = 0; bj < 2; ++bj)
#pragma unroll
                    for (int n = 0; n < 2; ++n) { const f32x4 v = acc[ai][bj][m][n] * s; u32x2 w; w.x = cvt_pk_bf16(v[0], v[1]); w.y = cvt_pk_bf16(v[2], v[3]);
                        *(u32x2*)(rowp + bj * HALF + n * 16) = w; } }
    }
};
struct EpiHyIn {
    static constexpr bool PERM = false, AFTER_DRAIN = false;
    bf16_t* OT; int ldt; int tp_tiles; bf16_t* CQ; float sc;
    __device__ __forceinline__ void operator()(const f32x4 (&acc)[2][2][4][2], const Unit& u, int wr, int wc, int fr, int fq) const {
        const int row0 = u.pm * BM + wr * 64 + fr;
        if (u.pn < tp_tiles) {
            const int col0 = u.pn * BM + wc * 32 + 4 * fq;
#pragma unroll
            for (int ai = 0; ai < 2; ++ai)
#pragma unroll
                for (int m = 0; m < 4; ++m) { const int row = row0 + ai * HALF + m * 16;
#pragma unroll
                    for (int bj = 0; bj < 2; ++bj)
#pragma unroll
                        for (int n = 0; n < 2; ++n) { const f32x4 v = acc[ai][bj][m][n]; const unsigned w0 = cvt_pk_bf16(v[0], v[1]), w1 = cvt_pk_bf16(v[2], v[3]);
                            bf16_t* p = OT + (size_t)(col0 + bj * HALF + n * 16) * ldt + row;
                            p[0] = (bf16_t)(w0 & 0xffffu); p[(size_t)ldt] = (bf16_t)(w0 >> 16); p[(size_t)2 * ldt] = (bf16_t)(w1 & 0xffffu); p[(size_t)3 * ldt] = (bf16_t)(w1 >> 16); } }
        } else {
            const int col0 = wc * 32 + 4 * fq;
#pragma unroll
            for (int ai = 0; ai < 2; ++ai)
#pragma unroll
                for (int m = 0; m < 4; ++m) { bf16_t* rowp = CQ + (size_t)(row0 + ai * HALF + m * 16) * 256 + col0;
#pragma unroll
                    for (int bj = 0; bj < 2; ++bj)
#pragma unroll
                        for (int n = 0; n < 2; ++n) { const f32x4 v = acc[ai][bj][m][n] * sc; u32x2 w; w.x = cvt_pk_bf16(v[0], v[1]); w.y = cvt_pk_bf16(v[2], v[3]);
                            *(u32x2*)(rowp + bj * HALF + n * 16) = w; } }
        }
    }
};
struct EpiAtIn {
    static constexpr bool PERM = false, AFTER_DRAIN = false;
    bf16_t* O; int ldc; const float* gq; const float* gk; float csc; float eps; int seq_mask;
    __device__ __forceinline__ void operator()(const f32x4 (&acc)[2][2][4][2], const Unit& u, int wr, int wc, int fr, int fq) const {
        const int row0 = u.pm * BM + wr * 64 + fr, colb = u.pn * BM + wc * 64 + 4 * fq;
        if (u.pn <= 3) {
            const float* gp = (u.pn == 3 ? gk : gq) + 4 * fq; const float osc = (u.pn == 3) ? 1.f : csc;
            float invr[4];
#pragma unroll
            for (int q = 0; q < 4; ++q) invr[q] = exp2f(-(float)(4 * fq + q) * (13.287712379549449f / 16.0f)) * 0.15915494309189535f;
#pragma unroll
            for (int ai = 0; ai < 2; ++ai)
#pragma unroll
                for (int m = 0; m < 4; ++m) {
                    const int row = row0 + ai * HALF + m * 16; int t = row & seq_mask; asm volatile("" : "+v"(t));
                    float ss = 0.f;
#pragma unroll
                    for (int bj = 0; bj < 2; ++bj)
#pragma unroll
                        for (int n = 0; n < 2; ++n) { const f32x4 x = acc[ai][bj][m][n]; ss += (x[0] * x[0] + x[1] * x[1]) + (x[2] * x[2] + x[3] * x[3]); }
                    ss += __shfl_xor(ss, 16); ss += __shfl_xor(ss, 32);
                    const float rs = osc * __builtin_amdgcn_rsqf(ss * (1.0f / 64.0f) + eps);
                    bf16_t* rowp = O + (size_t)row * ldc + colb;
#pragma unroll
                    for (int bj = 0; bj < 2; ++bj) {
                        const float pos = (float)(bj == 0 ? (t >> 6) : (t & 63));
                        const f32x4 xa = acc[ai][bj][m][0] * rs * *(const f32x4*)(gp + 32 * bj), xb = acc[ai][bj][m][1] * rs * *(const f32x4*)(gp + 32 * bj + 16);
                        f32x4 oa, ob;
#pragma unroll
                        for (int q = 0; q < 4; ++q) { const float rev = pos * invr[q]; const float c = __builtin_amdgcn_cosf(rev), s = __builtin_amdgcn_sinf(rev);
                            oa[q] = xa[q] * c - xb[q] * s; ob[q] = xa[q] * s + xb[q] * c; }
                        u32x2 w; w.x = cvt_pk_bf16(oa[0], oa[1]); w.y = cvt_pk_bf16(oa[2], oa[3]); *(u32x2*)(rowp + 32 * bj) = w;
                        w.x = cvt_pk_bf16(ob[0], ob[1]); w.y = cvt_pk_bf16(ob[2], ob[3]); *(u32x2*)(rowp + 32 * bj + 16) = w;
                    }
                    asm volatile("" ::: "memory");
                }
        } else {
            const float s = (u.pn == 5) ? csc : 1.f;
#pragma unroll
            for (int ai = 0; ai < 2; ++ai)
#pragma unroll
                for (int m = 0; m < 4; ++m) { bf16_t* rowp = O + (size_t)(row0 + ai * HALF + m * 16) * ldc + colb;
#pragma unroll
                    for (int bj = 0; bj < 2; ++bj)
#pragma unroll
                        for (int n = 0; n < 2; ++n) { const f32x4 v = acc[ai][bj][m][n] * s; u32x2 w; w.x = cvt_pk_bf16(v[0], v[1]); w.y = cvt_pk_bf16(v[2], v[3]);
                            *(u32x2*)(rowp + 32 * bj + 16 * n) = w; } }
        }
    }
};
struct EpiResF32 {
    static constexpr bool PERM = false, AFTER_DRAIN = false;
    const float* res; float* out; int ldc;
    __device__ __forceinline__ void operator()(const f32x4 (&acc)[2][2][4][2], const Unit& u, int wr, int wc, int fr, int fq) const {
        const int row0 = u.pm * BM + wr * 64 + fr, col0 = u.pn * BM + wc * 32 + 4 * fq;
#pragma unroll
        for (int ai = 0; ai < 2; ++ai)
#pragma unroll
            for (int m = 0; m < 4; ++m) { const size_t off = (size_t)(row0 + ai * HALF + m * 16) * ldc + col0;
#pragma unroll
                for (int bj = 0; bj < 2; ++bj)
#pragma unroll
                    for (int n = 0; n < 2; ++n) { const f32x4 r = *(const f32x4*)(res + off + bj * HALF + n * 16); *(f32x4*)(out + off + bj * HALF + n * 16) = r + acc[ai][bj][m][n]; } }
    }
};
__device__ __forceinline__ unsigned pk4_fp8_sat(const f32x4 x) {
    unsigned w = 0;
    w = __builtin_amdgcn_cvt_pk_fp8_f32(__builtin_amdgcn_fmed3f(x[0], -448.f, 448.f), __builtin_amdgcn_fmed3f(x[1], -448.f, 448.f), w, false);
    w = __builtin_amdgcn_cvt_pk_fp8_f32(__builtin_amdgcn_fmed3f(x[2], -448.f, 448.f), __builtin_amdgcn_fmed3f(x[3], -448.f, 448.f), w, true);
    return w;
}
struct EpiOutX {
    static constexpr bool PERM = true, AFTER_DRAIN = false;
    const float* res; float* out; int ldc; const float* gain; const float* WrG; unsigned char* XN8; float* PLG; float* PSS; int M;
    static __device__ __forceinline__ void split8(const f32x4 a, const f32x4 b, bf16x8& hi, bf16x8& lo) {
        u32x4 h, l; float r[8] = {a[0], a[1], a[2], a[3], b[0], b[1], b[2], b[3]};
#pragma unroll
        for (int k = 0; k < 4; ++k) { const unsigned p = cvt_pk_bf16(r[2 * k], r[2 * k + 1]); h[k] = p;
            const float d0 = r[2 * k] - __builtin_bit_cast(float, p << 16), d1 = r[2 * k + 1] - __builtin_bit_cast(float, p & 0xffff0000u); l[k] = cvt_pk_bf16(d0, d1); }
        hi = __builtin_bit_cast(bf16x8, h); lo = __builtin_bit_cast(bf16x8, l);
    }
    __device__ __forceinline__ void operator()(f32x4 (&acc)[2][2][4][2], const Unit& u, int wr, int wc, int fr, int fq) const {
        const int row0 = u.pm * BM + wr * 64 + fr, col0 = u.pn * BM + wc * 32 + 8 * fq, slot = u.pn * 4 + wc;
        bf16x8 whi[2], wlo[2];
#pragma unroll
        for (int bj = 0; bj < 2; ++bj) { const float* wp = WrG + (size_t)fr * ldc + col0 + bj * HALF; split8(*(const f32x4*)wp, *(const f32x4*)(wp + 4), whi[bj], wlo[bj]); }
        f32x4 rcur[4], rnxt[4];
#pragma unroll
        for (int q = 0; q < 4; ++q) rcur[q] = *(const f32x4*)(res + (size_t)row0 * ldc + col0 + (q >> 1) * HALF + (q & 1) * 4);
#pragma unroll
        for (int idx = 0; idx < 8; ++idx) { const int ai = idx >> 2, m = idx & 3;
            const int row = row0 + ai * HALF + m * 16; const size_t off = (size_t)row * ldc + col0; float ss = 0.f; f32x4 lg = (f32x4){0.f, 0.f, 0.f, 0.f}; u32x4 xw;
            if (idx < 7) { const int rown = row0 + ((idx + 1) >> 2) * HALF + ((idx + 1) & 3) * 16;
#pragma unroll
                for (int q = 0; q < 4; ++q) rnxt[q] = *(const f32x4*)(res + (size_t)rown * ldc + col0 + (q >> 1) * HALF + (q & 1) * 4); }
#pragma unroll
            for (int bj = 0; bj < 2; ++bj) {
#pragma unroll
                for (int n = 0; n < 2; ++n) { const int co = bj * HALF + n * 4;
                    const f32x4 h = rcur[bj * 2 + n] + acc[ai][bj][m][n]; acc[ai][bj][m][n] = h; *(f32x4*)(out + off + co) = h;
                    ss += (h[0] * h[0] + h[1] * h[1]) + (h[2] * h[2] + h[3] * h[3]);
                    const f32x4 x = h * *(const f32x4*)(gain + col0 + co);
                    xw[bj * 2 + n] = pk4_fp8_sat(x); }
                bf16x8 hhi, hlo; split8(acc[ai][bj][m][0], acc[ai][bj][m][1], hhi, hlo);
                lg = __builtin_amdgcn_mfma_f32_16x16x32_bf16(wlo[bj], hhi, lg, 0, 0, 0);
                lg = __builtin_amdgcn_mfma_f32_16x16x32_bf16(whi[bj], hlo, lg, 0, 0, 0);
                lg = __builtin_amdgcn_mfma_f32_16x16x32_bf16(whi[bj], hhi, lg, 0, 0, 0); }
            *(u32x4*)(XN8 + (size_t)row * ldc + u.pn * BM + wc * 64 + fq * 16) = xw;
            ss += __shfl_xor(ss, 16); ss += __shfl_xor(ss, 32);
            if (fq == 0) PSS[(size_t)slot * M + row] = ss;
            *(f32x4*)(PLG + ((size_t)slot * M + row) * 16 + 4 * fq) = lg;
#pragma unroll
            for (int q = 0; q < 4; ++q) rcur[q] = rnxt[q];
            asm volatile("" ::: "memory"); }
    }
};
struct EpiSwiGLU {
    static constexpr bool PERM = false, AFTER_DRAIN = false;
    bf16_t* O; int ldc;
    __device__ __forceinline__ void operator()(const f32x4 (&acc)[2][2][4][2], const Unit& u, int wr, int wc, int fr, int fq) const {
        const int row0 = u.pm * BM + wr * 64 + fr, col0 = u.pn * HALF + wc * 32 + 4 * fq;
#pragma unroll
        for (int ai = 0; ai < 2; ++ai)
#pragma unroll
            for (int m = 0; m < 4; ++m) { bf16_t* rowp = O + (size_t)(row0 + ai * HALF + m * 16) * ldc + col0;
#pragma unroll
                for (int n = 0; n < 2; ++n) { const f32x4 g = acc[ai][0][m][n], up = acc[ai][1][m][n]; f32x4 h;
#pragma unroll
                    for (int q = 0; q < 4; ++q) h[q] = g[q] * up[q] * __builtin_amdgcn_rcpf(1.f + __expf(-g[q]));
                    u32x2 w; w.x = cvt_pk_bf16(h[0], h[1]); w.y = cvt_pk_bf16(h[2], h[3]); *(u32x2*)(rowp + n * 16) = w; } }
    }
};
struct EpiSwiGLU8 {
    static constexpr bool PERM = false, AFTER_DRAIN = false;
    unsigned char* O; int ldc; float wsc; const float* rs;
    __device__ __forceinline__ void operator()(const f32x4 (&acc)[2][2][4][2], const Unit& u, int wr, int wc, int fr, int fq) const {
        const int row0 = u.pm * BM + wr * 64 + fr, col0 = u.pn * HALF + wc * 32 + 4 * fq;
#pragma unroll
        for (int ai = 0; ai < 2; ++ai)
#pragma unroll
            for (int m = 0; m < 4; ++m) { const int row = row0 + ai * HALF + m * 16; const float sc = wsc * rs[row]; u32x2 hw;
#pragma unroll
                for (int n = 0; n < 2; ++n) { const f32x4 g = acc[ai][0][m][n] * sc, up = acc[ai][1][m][n] * sc; f32x4 h;
#pragma unroll
                    for (int q = 0; q < 4; ++q) h[q] = g[q] * up[q] * __builtin_amdgcn_rcpf(1.f + __expf(-g[q]));
                    hw[n] = pk4_fp8_sat(h); }
                *(u32x2*)(O + (size_t)row * ldc + u.pn * HALF + wc * 32 + fq * 8) = hw; }
    }
};
struct EpiDown {
    static constexpr bool PERM = true, AFTER_DRAIN = false;
    bf16_t* O; int ldc; const float* gate; float wsc;
    __device__ __forceinline__ void operator()(const f32x4 (&acc)[2][2][4][2], const Unit& u, int wr, int wc, int fr, int fq) const {
        const int row0 = u.pm * BM + wr * 64 + fr, col0 = u.pn * BM + wc * 32 + 8 * fq;
#pragma unroll
        for (int ai = 0; ai < 2; ++ai)
#pragma unroll
            for (int m = 0; m < 4; ++m) { const int row = row0 + ai * HALF + m * 16; const float gs = gate[row] * wsc; bf16_t* rowp = O + (size_t)row * ldc + col0;
#pragma unroll
                for (int bj = 0; bj < 2; ++bj) { const f32x4 v0 = acc[ai][bj][m][0] * gs, v1 = acc[ai][bj][m][1] * gs; u32x4 w;
                    w.x = cvt_pk_bf16(v0[0], v0[1]); w.y = cvt_pk_bf16(v0[2], v0[3]); w.z = cvt_pk_bf16(v1[0], v1[1]); w.w = cvt_pk_bf16(v1[2], v1[3]);
                    *(u32x4*)(rowp + bj * HALF) = w; } }
    }
};
template <class Epi, class Sched, bool ALIGN_EPI = false, bool SP2 = false, bool GATHER = false, bool FP8 = false>
__device__ __forceinline__ void gemm_phase(PG8_LAS unsigned char* lds, const Gemm g, const Sched& S, const Epi& E, const int* gidx = nullptr) {
    const int tid = opaque_tid(), wid = __builtin_amdgcn_readfirstlane(tid >> 6), lane = tid & 63, wr = wid >> 2, wc = wid & 3, fr = lane & 15, fq = lane >> 4;
    const int K = g.K, nt = K / BK;
    unsigned voffA[2], voffB[2];
#pragma unroll
    for (int i = 0; i < 2; ++i) { int R, C; stage_rc(tid * 16 + i * 8192, R, C); const int Rb = Epi::PERM ? ((R & ~31) + perm32(R & 31)) : R;
        voffA[i] = (unsigned)(R * K + C) * 2u; voffB[i] = (unsigned)(Rb * K + C) * 2u; }
    const size_t kstep = (size_t)(BK * 2);
    const size_t hstep = (size_t)HALF * K * 2;
    const size_t tstep = 2 * hstep;
    const unsigned ldsw = (unsigned)wid * 1024u;
    const int aoff = lds_byte(wr * 64 + fr, fq * 8), boff = lds_byte(wc * 32 + fr, fq * 8);
#define PG8_SA(b, h) (((b) * 2 + (h)) * HTB)
#define PG8_SB(b, h) ((4 + (b) * 2 + (h)) * HTB)
#define PG8_STAGE(bufoff, gbase, voff) do { _Pragma("unroll") for (int _i = 0; _i < 2; ++_i) \
        __builtin_amdgcn_global_load_lds((const unsigned*)((const char*)(gbase) + (voff)[_i]), (PG8_LAS unsigned*)(lds + (bufoff) + ldsw + _i * 8192), 16, 0, 0); } while (0)
#define PG8_LDA(dst, b, h) do { _Pragma("unroll") for (int m = 0; m < 4; ++m) { if constexpr (FP8) { const v4i_ lo_ = *(const PG8_LAS v4i_*)(lds + PG8_SA(b, h) + aoff + m * 2048), hi_ = *(const PG8_LAS v4i_*)(lds + PG8_SA(b, h) + aoff + m * 2048 + 1024); \
        dst##8[m] = __builtin_shufflevector(lo_, hi_, 0, 1, 2, 3, 4, 5, 6, 7); } else { _Pragma("unroll") for (int k = 0; k < 2; ++k) dst[m][k] = *(const PG8_LAS bf16x8*)(lds + PG8_SA(b, h) + aoff + m * 2048 + k * 1024); } } } while (0)
#define PG8_LDB(dst, b, h) do { _Pragma("unroll") for (int n = 0; n < 2; ++n) { if constexpr (FP8) { const v4i_ lo_ = *(const PG8_LAS v4i_*)(lds + PG8_SB(b, h) + boff + n * 2048), hi_ = *(const PG8_LAS v4i_*)(lds + PG8_SB(b, h) + boff + n * 2048 + 1024); \
        dst##8[n] = __builtin_shufflevector(lo_, hi_, 0, 1, 2, 3, 4, 5, 6, 7); } else { _Pragma("unroll") for (int k = 0; k < 2; ++k) dst[n][k] = *(const PG8_LAS bf16x8*)(lds + PG8_SB(b, h) + boff + n * 2048 + k * 1024); } } } while (0)
#define PG8_MMA(ai, bj, At, Bt) do { __builtin_amdgcn_s_setprio(1); _Pragma("unroll") for (int m = 0; m < 4; ++m) _Pragma("unroll") for (int n = 0; n < 2; ++n) { \
        if constexpr (FP8) asm volatile("v_mfma_scale_f32_16x16x128_f8f6f4 %0, %1, %2, %0, %3, %3 op_sel_hi:[0,0,0]" : "+v"(acc[ai][bj][m][n]) : "v"(Bt##8[n]), "v"(At##8[m]), "v"(sc127_));   \
        else { _Pragma("unroll") for (int k = 0; k < 2; ++k) acc[ai][bj][m][n] = __builtin_amdgcn_mfma_f32_16x16x32_bf16(Bt[n][k], At[m][k], acc[ai][bj][m][n], 0, 0, 0); } } \
        __builtin_amdgcn_s_setprio(0); } while (0)
#define PG8_WAIT_V(n) asm volatile("s_waitcnt vmcnt(" #n ")" ::: "memory")
#define PG8_WAIT_L(n) asm volatile("s_waitcnt lgkmcnt(" #n ")" ::: "memory")
#define PG8_BAR __builtin_amdgcn_s_barrier()
#define PG8_SCHED __builtin_amdgcn_sched_barrier(0)
    Unit cur, nxt; int ui = 0;
    if (!S.next(0, cur)) return;
    f32x4 acc[2][2][4][2];
#pragma unroll
    for (int a = 0; a < 2; ++a)
#pragma unroll
        for (int b = 0; b < 2; ++b)
#pragma unroll
            for (int m = 0; m < 4; ++m)
#pragma unroll
                for (int n = 0; n < 2; ++n) acc[a][b][m][n] = (f32x4){0.f, 0.f, 0.f, 0.f};
    typedef int v8i_ __attribute__((ext_vector_type(8))); typedef int v4i_ __attribute__((ext_vector_type(4)));
    const int sc127_ = 127;
    bf16x8 At[4][2], B0[2][2], B1[2][2]; v8i_ At8[4], B08[2], B18[2];
    static_assert(SP2, "this copy of the body keeps only the SP2 K-loop up to date");
    int rA[2]; { int R_, C_; stage_rc(tid * 16, R_, C_); rA[0] = R_; stage_rc(tid * 16 + 8192, R_, C_); rA[1] = R_; }
    unsigned cv0[2], cv1[2], nv0[2], nv1[2];
    unsigned vh1[2]; vh1[0] = voffA[0] + (unsigned)hstep; vh1[1] = voffA[1] + (unsigned)hstep;
#define PG8_CV0 (GATHER ? cv0 : voffA)
#define PG8_CV1 (GATHER ? cv1 : vh1)
#define PG8_SV0 (GATHER ? sv0 : voffA)
#define PG8_SV1 (GATHER ? sv1 : vh1)
#define PG8_ROWOFF(dst0, dst1, unit) do { _Pragma("unroll") for (int i_ = 0; i_ < 2; ++i_) { \
        if constexpr (GATHER) { const int c2_ = (int)(voffA[i_] - (unsigned)(rA[i_] * K) * 2u); \
            dst0[i_] = (unsigned)gidx[(unit).pm * BM + rA[i_]] * (unsigned)(K * 2) + (unsigned)c2_; dst1[i_] = (unsigned)gidx[(unit).pm * BM + HALF + rA[i_]] * (unsigned)(K * 2) + (unsigned)c2_; } \
        else { dst0[i_] = voffA[i_]; dst1[i_] = voffA[i_] + (unsigned)hstep; } } } while (0)
    if constexpr (GATHER) PG8_ROWOFF(cv0, cv1, cur);
    const char* cA = GATHER ? (const char*)g.A : (const char*)g.A + (size_t)cur.pm * tstep; const char* cB = (const char*)g.Bt + (size_t)((cur.pm / g.gdiv) % g.gmod) * g.gstride + (size_t)cur.pn * tstep;
    S.a_ready(cur);
    if constexpr (SP2) {
        PG8_STAGE(PG8_SB(0, 0), cB, voffB); PG8_STAGE(PG8_SB(0, 1), cB + hstep, voffB); PG8_STAGE(PG8_SA(0, 0), cA, PG8_CV0); PG8_STAGE(PG8_SA(0, 1), cA, PG8_CV1);
        if (wr == 1) PG8_BAR;
        PG8_WAIT_V(2); PG8_BAR;
        PG8_STAGE(PG8_SB(1, 0), cB + kstep, voffB); PG8_STAGE(PG8_SA(1, 0), cA + kstep, PG8_CV0); PG8_STAGE(PG8_SB(1, 1), cB + hstep + kstep, voffB);
        PG8_WAIT_V(6); PG8_BAR;
    } else {
        PG8_STAGE(PG8_SB(0, 0), cB, voffB); PG8_STAGE(PG8_SA(0, 0), cA, voffA); PG8_STAGE(PG8_SB(0, 1), cB + hstep, voffB); PG8_STAGE(PG8_SA(0, 1), cA + hstep, voffA);
        if (wr == 1) PG8_BAR;
        PG8_WAIT_V(4); PG8_BAR;
        PG8_STAGE(PG8_SB(1, 0), cB + kstep, voffB); PG8_STAGE(PG8_SA(1, 0), cA + kstep, voffA); PG8_STAGE(PG8_SB(1, 1), cB + hstep + kstep, voffB);
        PG8_WAIT_V(6); PG8_BAR;
    }
    for (;;) {
        const bool has_next = S.next(ui + 1, nxt);
        if constexpr (GATHER) { if (has_next) PG8_ROWOFF(nv0, nv1, nxt); else { nv0[0] = cv0[0]; nv0[1] = cv0[1]; nv1[0] = cv1[0]; nv1[1] = cv1[1]; } }
        const char* nA = GATHER ? (const char*)g.A : (has_next ? (const char*)g.A + (size_t)nxt.pm * tstep : cA); const char* nB = has_next ? (const char*)g.Bt + (size_t)((nxt.pm / g.gdiv) % g.gmod) * g.gstride + (size_t)nxt.pn * tstep : cB;
        for (int t = 0; t < nt; t += 2) {
            const bool last = (t == nt - 2);
            unsigned sv0[2], sv1[2]; if constexpr (GATHER) { sv0[0] = last ? nv0[0] : cv0[0]; sv0[1] = last ? nv0[1] : cv0[1]; sv1[0] = last ? nv1[0] : cv1[0]; sv1[1] = last ? nv1[1] : cv1[1]; }
            const char* a1 = cA + (size_t)(t + 1) * kstep;
            const char* a2 = last ? nA : cA + (size_t)(t + 2) * kstep; const char* b2 = last ? nB : cB + (size_t)(t + 2) * kstep;
            const char* a3 = a2 + kstep; const char* b3 = b2 + kstep;
            if (last && has_next) S.a_ready(nxt);
            if constexpr (SP2) {
            PG8_LDB(B0, 0, 0); PG8_LDB(B1, 0, 1); PG8_SCHED; PG8_LDA(At, 0, 0); PG8_STAGE(PG8_SA(1, 1), a1, PG8_CV1);
            PG8_WAIT_V(8); PG8_WAIT_L(0); PG8_BAR; PG8_MMA(0, 0, At, B0); PG8_MMA(0, 1, At, B1); PG8_BAR; PG8_SCHED;
            PG8_LDA(At, 0, 1); PG8_STAGE(PG8_SB(0, 0), b2, voffB); PG8_STAGE(PG8_SB(0, 1), b2 + hstep, voffB); PG8_STAGE(PG8_SA(0, 0), a2, PG8_SV0);
            PG8_WAIT_V(8); PG8_WAIT_L(0); PG8_BAR; PG8_MMA(1, 0, At, B0); PG8_MMA(1, 1, At, B1); PG8_BAR; PG8_SCHED;
            PG8_LDB(B0, 1, 0); PG8_LDB(B1, 1, 1); PG8_SCHED; PG8_LDA(At, 1, 0); PG8_STAGE(PG8_SA(0, 1), a2, PG8_SV1);
            PG8_WAIT_V(8); PG8_WAIT_L(0); PG8_BAR; PG8_MMA(0, 0, At, B0); PG8_MMA(0, 1, At, B1); PG8_BAR; PG8_SCHED;
            PG8_LDA(At, 1, 1); PG8_STAGE(PG8_SB(1, 0), b3, voffB); PG8_STAGE(PG8_SB(1, 1), b3 + hstep, voffB); PG8_STAGE(PG8_SA(1, 0), a3, PG8_SV0);
            PG8_WAIT_V(8); PG8_WAIT_L(0); PG8_BAR; PG8_MMA(1, 0, At, B0); PG8_MMA(1, 1, At, B1); PG8_BAR; PG8_SCHED;
            } else {
            PG8_LDB(B0, 0, 0); PG8_SCHED; PG8_LDA(At, 0, 0); PG8_STAGE(PG8_SA(1, 1), a1 + hstep, voffA);
            PG8_WAIT_L(8); PG8_BAR; PG8_WAIT_L(0); PG8_MMA(0, 0, At, B0); PG8_BAR; PG8_SCHED;
            PG8_LDB(B1, 0, 1); PG8_STAGE(PG8_SB(0, 0), b2, voffB);
            PG8_BAR; PG8_WAIT_L(0); PG8_MMA(0, 1, At, B1); PG8_BAR;
            PG8_LDA(At, 0, 1); PG8_STAGE(PG8_SA(0, 0), a2, voffA);
            PG8_BAR; PG8_WAIT_L(0); PG8_MMA(1, 0, At, B0); PG8_BAR; PG8_SCHED;
            PG8_STAGE(PG8_SB(0, 1), b2 + hstep, voffB);
            PG8_WAIT_V(6); PG8_BAR; PG8_MMA(1, 1, At, B1); PG8_BAR;
            PG8_LDB(B0, 1, 0); PG8_SCHED; PG8_LDA(At, 1, 0); PG8_STAGE(PG8_SA(0, 1), a2 + hstep, voffA);
            PG8_WAIT_L(8); PG8_BAR; PG8_WAIT_L(0); PG8_MMA(0, 0, At, B0); PG8_BAR; PG8_SCHED;
            PG8_LDB(B1, 1, 1); PG8_STAGE(PG8_SB(1, 0), b3, voffB);
            PG8_BAR; PG8_WAIT_L(0); PG8_MMA(0, 1, At, B1); PG8_BAR;
            PG8_LDA(At, 1, 1); PG8_STAGE(PG8_SA(1, 0), a3, voffA);
            PG8_BAR; PG8_WAIT_L(0); PG8_MMA(1, 0, At, B0); PG8_BAR; PG8_SCHED;
            PG8_STAGE(PG8_SB(1, 1), b3 + hstep, voffB);
            PG8_WAIT_V(6); PG8_BAR; PG8_MMA(1, 1, At, B1); PG8_BAR;
            }
        }
        if constexpr (ALIGN_EPI) { if (wr == 0) PG8_BAR; }
        if constexpr (!Epi::AFTER_DRAIN) { E(acc, cur, wr, wc, fr, fq); S.done(cur); }
        if (!has_next) break;
#pragma unroll
        for (int a = 0; a < 2; ++a)
#pragma unroll
            for (int b = 0; b < 2; ++b)
#pragma unroll
                for (int m = 0; m < 4; ++m)
#pragma unroll
                    for (int n = 0; n < 2; ++n) acc[a][b][m][n] = (f32x4){0.f, 0.f, 0.f, 0.f};
        cur = nxt; cA = nA; cB = nB; ++ui; if constexpr (GATHER) { cv0[0] = nv0[0]; cv0[1] = nv0[1]; cv1[0] = nv1[0]; cv1[1] = nv1[1]; }
        if constexpr (ALIGN_EPI) { if (wr == 1) PG8_BAR; }
    }
    PG8_WAIT_V(0);
    if constexpr (!ALIGN_EPI) { if (wr == 0) PG8_BAR; }
    PG8_BAR;
    if constexpr (Epi::AFTER_DRAIN) { E.fused(acc, cur, wr, wc, fr, fq, lds, wid, lane); S.done(cur); }
#undef PG8_ROWOFF
#undef PG8_CV0
#undef PG8_CV1
#undef PG8_SV0
#undef PG8_SV1
#undef PG8_SA
#undef PG8_SB
#undef PG8_STAGE
#undef PG8_LDA
#undef PG8_LDB
#undef PG8_MMA
#undef PG8_WAIT_V
#undef PG8_WAIT_L
#undef PG8_BAR
#undef PG8_SCHED
}
}
namespace attn_body {
using bf16=__hip_bfloat16;
using bf16x8=__attribute__((ext_vector_type(8)))short;
using s16x4=__attribute__((ext_vector_type(4)))short;
using f32x16=__attribute__((ext_vector_type(16)))float;
using u32x4=__attribute__((ext_vector_type(4)))unsigned;
constexpr int D=64;
constexpr int NW=8,QBLK=32,QB=QBLK*NW,KVBLK=64;
__device__ __forceinline__ int crow(int r,int hi){return (r&3)+8*(r>>2)+4*hi;}
#define SBAR() __builtin_amdgcn_sched_barrier(0)
__device__ __forceinline__ void cmask(f32x16&p0,f32x16&p1,int jb,int qrel,int hi){
  const float NEG=-INFINITY; int kb=64*jb+4*hi;
  #pragma unroll
  for(int r=0;r<16;++r){int kv=kb+(r&3)+8*(r>>2); if(kv>qrel)p0[r]=NEG; if(kv+32>qrel)p1[r]=NEG;}
}

constexpr int NSLOT=3, SLOTB=8192;
constexpr int LDS_K=0, LDS_V=NSLOT*SLOTB, LDS_WS=2*NSLOT*SLOTB, LDS_OST=LDS_WS+NW*64*4, LDS_BYTES=LDS_OST+NW*4096;
constexpr float C2=0.125f*1.4426950408889634f;
__device__ __forceinline__ void glds16(const void*gsrc,unsigned lds_dst){unsigned keep;
  asm volatile("s_mov_b32 %0, m0\n\ts_mov_b32 m0, %2\n\ts_nop 0\n\tglobal_load_lds_dwordx4 %1, off\n\ts_mov_b32 m0, %0":"=&s"(keep):"v"(gsrc),"s"(lds_dst):"memory");}
__device__ __forceinline__ float max3f(float a,float b,float c){float r;asm("v_max3_f32 %0, %1, %2, %3":"=v"(r):"v"(a),"v"(b),"v"(c));return r;}
__device__ __forceinline__ float max2f(float a,float b){float r;asm("v_max_f32_e32 %0, %1, %2":"=v"(r):"v"(a),"v"(b));return r;}
__device__ __forceinline__ float fadd_s(float a,float b){float r;asm("v_add_f32_e32 %0, %1, %2":"=v"(r):"v"(a),"v"(b));return r;}
__device__ __forceinline__ float fsub_s(float a,float b){float r;asm("v_sub_f32_e32 %0, %1, %2":"=v"(r):"v"(a),"v"(b));return r;}
typedef float f32x2_t __attribute__((ext_vector_type(2))); typedef __bf16 bf16x2_t __attribute__((ext_vector_type(2)));
__device__ __forceinline__ unsigned cvtpk_s(float lo,float hi){f32x2_t v={lo,hi};bf16x2_t b=__builtin_convertvector(v,bf16x2_t);return __builtin_bit_cast(unsigned,b);}
#define WAIT_BAR(N) asm volatile("s_waitcnt vmcnt(" #N ") lgkmcnt(0)\n\ts_barrier":::"memory")

__device__ __forceinline__ void qkt(f32x16&p0,f32x16&p1,const char*Kslot,const bf16x8*qr,const f32x16&negm,int r32,int hi){
  const char*kb=Kslot+hi*1024+r32*16;
  #pragma unroll
  for(int d0=0;d0<4;++d0){
    const bf16x8 b0=*reinterpret_cast<const bf16x8*>(kb+d0*2048);
    const bf16x8 b1=*reinterpret_cast<const bf16x8*>(kb+d0*2048+512);
    if(d0==0){p0=__builtin_amdgcn_mfma_f32_32x32x16_bf16(b0,qr[0],negm,0,0,0);p1=__builtin_amdgcn_mfma_f32_32x32x16_bf16(b1,qr[0],negm,0,0,0);}
    else{p0=__builtin_amdgcn_mfma_f32_32x32x16_bf16(b0,qr[d0],p0,0,0,0);p1=__builtin_amdgcn_mfma_f32_32x32x16_bf16(b1,qr[d0],p1,0,0,0);}}
}
typedef __attribute__((address_space(3))) const char* lds_cptr;
typedef short v4i16_t __attribute__((ext_vector_type(4)));
__device__ __forceinline__ void kload8(bf16x8*kf,lds_cptr kp){
  kf[0]=*(const __attribute__((address_space(3))) bf16x8*)(kp);      kf[1]=*(const __attribute__((address_space(3))) bf16x8*)(kp+512);
  kf[2]=*(const __attribute__((address_space(3))) bf16x8*)(kp+2048); kf[3]=*(const __attribute__((address_space(3))) bf16x8*)(kp+2560);
  kf[4]=*(const __attribute__((address_space(3))) bf16x8*)(kp+4096); kf[5]=*(const __attribute__((address_space(3))) bf16x8*)(kp+4608);
  kf[6]=*(const __attribute__((address_space(3))) bf16x8*)(kp+6144); kf[7]=*(const __attribute__((address_space(3))) bf16x8*)(kp+6656);
}
__device__ __forceinline__ void kload2(bf16x8*kf,lds_cptr kp,int j){ kf[2*j]=*(const __attribute__((address_space(3))) bf16x8*)(kp+j*2048); kf[2*j+1]=*(const __attribute__((address_space(3))) bf16x8*)(kp+j*2048+512); }
__device__ __forceinline__ s16x4 vtr(lds_cptr p){ return __builtin_bit_cast(s16x4,__builtin_amdgcn_ds_read_tr16_b64_v4i16((__attribute__((address_space(3))) v4i16_t*)p)); }
__device__ __forceinline__ float rowmax(const f32x16&p0,const f32x16&p1){
  float a=max3f(p0[0],p0[1],p1[0]),b=max3f(p0[2],p0[3],p1[1]);a=max3f(a,p1[2],p1[3]);
  #pragma unroll
  for(int r=4;r<16;r+=4){a=max3f(a,p0[r],p0[r+1]);b=max3f(b,p0[r+2],p0[r+3]);a=max3f(a,p1[r],p1[r+1]);b=max3f(b,p1[r+2],p1[r+3]);}
  const float m=max2f(a,b);
  auto rr=__builtin_amdgcn_permlane32_swap(__float_as_uint(m),__float_as_uint(m),false,false);
  return max2f(__uint_as_float(rr[0]),__uint_as_float(rr[1]));
}
__device__ __forceinline__ void pv(f32x16*o,int vb,bf16x8 pa0,bf16x8 pa1,bf16x8 pa2,bf16x8 pa3){
  #pragma unroll
  for(int d0=0;d0<2;++d0){s16x4 lo[4],hi[4];
    #pragma unroll
    for(int ks=0;ks<4;++ks){
      asm volatile("ds_read_b64_tr_b16 %0,%1 offset:%c2":"=&v"(lo[ks]):"v"(vb),"i"(d0*4096+ks*1024):"memory");
      asm volatile("ds_read_b64_tr_b16 %0,%1 offset:%c2":"=&v"(hi[ks]):"v"(vb),"i"(d0*4096+ks*1024+512):"memory");}
    asm volatile("s_waitcnt lgkmcnt(0)":::"memory");SBAR();
    #define PK(k) (bf16x8){lo[k][0],lo[k][1],lo[k][2],lo[k][3],hi[k][0],hi[k][1],hi[k][2],hi[k][3]}
    o[d0]=__builtin_amdgcn_mfma_f32_32x32x16_bf16(pa0,PK(0),o[d0],0,0,0);
    o[d0]=__builtin_amdgcn_mfma_f32_32x32x16_bf16(pa1,PK(1),o[d0],0,0,0);
    o[d0]=__builtin_amdgcn_mfma_f32_32x32x16_bf16(pa2,PK(2),o[d0],0,0,0);
    o[d0]=__builtin_amdgcn_mfma_f32_32x32x16_bf16(pa3,PK(3),o[d0],0,0,0);
    #undef PK
  }
}

#ifndef ATTN_STORE16
#define ATTN_STORE16(p,v) (*(u32x4*)(p)=(v))
#endif
template<int THRL,int QP,int KP,int OP> __device__ __forceinline__ void attn_unit(const bf16*Qu,const bf16*__restrict__ Kh,const bf16*__restrict__ Vh,bf16*Ou,const int NT,char*shm){
  const int tid=opaque_tid(),lane=tid&63,r32=lane&31,hi=lane>>5; const int wid=__builtin_amdgcn_readfirstlane(tid>>6);
  const bf16*Qw=Qu+(long)(wid*QBLK)*QP;
  const unsigned lds0=(unsigned)(uintptr_t)shm;
  float*wsf=(float*)(shm+LDS_WS)+wid*64;
  const bf16*ksrc=Kh+(long)lane*KP+wid*8;
  const bf16*vsrc=Vh+(long)(16*(wid&3)+(lane>>2))*KP+(wid>>2)*32+(lane&3)*8;
  const unsigned kdst=lds0+LDS_K+wid*1024, vdst=lds0+LDS_V+wid*1024;
  #define DMA_K(t,slot) glds16(ksrc+(long)(t)*KVBLK*KP,(unsigned)__builtin_amdgcn_readfirstlane(kdst+(slot)))
  #define DMA_V(t,slot) glds16(vsrc+(long)(t)*KVBLK*KP,(unsigned)__builtin_amdgcn_readfirstlane(vdst+(slot)))
  const int vb0=(int)(lds0+LDS_V)+((lane>>4)&1)*32+(lane&3)*8+(4*hi+((lane&15)>>2))*64;
  const char*Kbase=shm+LDS_K; bf16x8 kf[8];
  const lds_cptr shm3=(lds_cptr)shm; const lds_cptr kp0=shm3+LDS_K+hi*1024+r32*16; const lds_cptr vp0=shm3+LDS_V+((lane>>4)&1)*32+(lane&3)*8+(4*hi+((lane&15)>>2))*64;
  DMA_K(0,0);DMA_V(0,0);DMA_K(1,SLOTB);
  bf16x8 qr[4];
  #pragma unroll
  for(int d0=0;d0<4;++d0)qr[d0]=*reinterpret_cast<const bf16x8*>(&Qw[(long)r32*QP+d0*16+hi*8]);
  float mhat=0.f,l_reg=0.f;f32x16 o[2];o[0]=f32x16{};o[1]=f32x16{};f32x16 negm=f32x16{};asm volatile("":"+v"(negm));
  #define CMASK(P0,P1,t) do{}while(0)
  bool resc=false;
  #define START(P0,P1) do{ const float rm=rowmax(P0,P1); resc=false; \
    { const float dl=rm; mhat=fadd_s(mhat,dl); \
      _Pragma("unroll") for(int r=0;r<16;++r){P0[r]=fsub_s(P0[r],dl);P1[r]=fsub_s(P1[r],dl);} \
      _Pragma("unroll") for(int r=0;r<16;++r)negm[r]=-mhat; asm volatile("":"+v"(negm)); } \
    _Pragma("unroll") for(int r=0;r<16;++r)P0[r]=__builtin_amdgcn_exp2f(P0[r]); }while(0)
  #define RESC() do{ if(resc){ asm volatile("s_waitcnt lgkmcnt(0)":::"memory"); \
      _Pragma("unroll") for(int d_=0;d_<2;++d_) _Pragma("unroll") for(int r=0;r<16;++r)o[d_][r]*=wsf[crow(r,hi)]; } }while(0)
  f32x16 pA0,pA1,pB0,pB1;
  int sl_prev=0,sl_cur=0,sl_next=SLOTB;
  #define ROT() do{sl_prev=sl_cur;sl_cur=sl_next;sl_next=(sl_next==(NSLOT-1)*SLOTB)?0:sl_next+SLOTB;}while(0)
  DMA_K(2,2*SLOTB);
  WAIT_BAR(3);
  qkt(pA0,pA1,Kbase,qr,negm,r32,hi);asm volatile("s_nop 15\n\ts_nop 7":"+v"(pA0),"+v"(pA1));CMASK(pA0,pA1,0);
  START(pA0,pA1);
  _Pragma("unroll") for(int r=0;r<16;++r)pA1[r]=__builtin_amdgcn_exp2f(pA1[r]);
  WAIT_BAR(0);
  DMA_K(3,0);DMA_V(1,SLOTB);
  ROT();
  kload8(kf,kp0+sl_cur);
  WAIT_BAR(2);
  s16x4 vlo[8],vhi[8]; u32x4 pw0,pw1,pw2,pw3;
  #define PKW(P,B) cvtpk_s(P[B],P[B+1])
  #define PAF(k) __builtin_bit_cast(bf16x8,pw##k)
  #define VFR(i) (bf16x8){vlo[i][0],vlo[i][1],vlo[i][2],vlo[i][3],vhi[i][0],vhi[i][1],vhi[i][2],vhi[i][3]}
  #define PIN(x) asm volatile("":"+v"(x))
  #define MX3(a,b,c) __builtin_fmaxf(__builtin_fmaxf((a),(b)),(c))
  #define GAPA(MF,A0,A1,A2,A3,W0,W1,PW) do{ MF; sacc+=A0; sacc+=A1; sacc+=A2; sacc+=A3; PIN(sacc); W0; W1; PIN(PW); SBAR(); }while(0)
  #define EX(v) __builtin_amdgcn_exp2f(v)
  #define GAPB(MF,X,B) do{ MF; X[B]=EX(X[B]); X[B+1]=EX(X[B+1]); X[B+2]=EX(X[B+2]); X[B+3]=EX(X[B+3]); PIN(X); SBAR(); }while(0)
  #define VRD(i) do{ vlo[i]=vtr(vp_+(((i)>>2)*4096+((i)&3)*1024)); vhi[i]=vtr(vp_+(((i)>>2)*4096+((i)&3)*1024+512)); }while(0)
  #define KRD(G,j) do{ if(G){ kload2(kf,kp0+sl_next,j); SBAR(); } }while(0)
  #define STEP(C0,C1,P0,P1,t,GK,GV,GL) do{ SBAR(); \
    const lds_cptr vp_=vp0+sl_prev; \
    VRD(0); SBAR(); float sacc=(P0[0]+P0[1]); \
    GAPA(C0=__builtin_amdgcn_mfma_f32_32x32x16_bf16(kf[0],qr[0],negm,0,0,0), P0[2],P0[3],P0[4],P0[5],     pw0[0]=PKW(P0,0), pw0[1]=PKW(P0,2), pw0); \
    VRD(4); SBAR(); GAPA(C1=__builtin_amdgcn_mfma_f32_32x32x16_bf16(kf[1],qr[0],negm,0,0,0), P0[6],P0[7],P0[8],P0[9],     pw0[2]=PKW(P0,4), pw0[3]=PKW(P0,6), pw0); \
    VRD(1); SBAR(); GAPA(C0=__builtin_amdgcn_mfma_f32_32x32x16_bf16(kf[2],qr[1],C0,0,0,0),   P0[10],P0[11],P0[12],P0[13], pw1[0]=PKW(P0,8), pw1[1]=PKW(P0,10), pw1); \
    VRD(5); SBAR(); GAPA(C1=__builtin_amdgcn_mfma_f32_32x32x16_bf16(kf[3],qr[1],C1,0,0,0),   P0[14],P0[15],P1[0],P1[1],   pw1[2]=PKW(P0,12),pw1[3]=PKW(P0,14), pw1); \
    VRD(2); SBAR(); GAPA(C0=__builtin_amdgcn_mfma_f32_32x32x16_bf16(kf[4],qr[2],C0,0,0,0),   P1[2],P1[3],P1[4],P1[5],     pw2[0]=PKW(P1,0), pw2[1]=PKW(P1,2), pw2); \
    VRD(6); SBAR(); GAPA(C1=__builtin_amdgcn_mfma_f32_32x32x16_bf16(kf[5],qr[2],C1,0,0,0),   P1[6],P1[7],P1[8],P1[9],     pw2[2]=PKW(P1,4), pw2[3]=PKW(P1,6), pw2); \
    VRD(3); SBAR(); GAPA(C0=__builtin_amdgcn_mfma_f32_32x32x16_bf16(kf[6],qr[3],C0,0,0,0),   P1[10],P1[11],P1[12],P1[13], pw3[0]=PKW(P1,8), pw3[1]=PKW(P1,10), pw3); \
    VRD(7); SBAR(); GAPA(C1=__builtin_amdgcn_mfma_f32_32x32x16_bf16(kf[7],qr[3],C1,0,0,0),   P1[14],P1[15],0.f,0.f,       pw3[2]=PKW(P1,12),pw3[3]=PKW(P1,14), pw3); \
    l_reg+=sacc; \
    if(GK){DMA_K((t)+3,sl_cur);} if(GV){DMA_V((t)+1,sl_next);} \
    CMASK(C0,C1,t); \
    { float a=MX3(C0[0],C0[1],C1[0]),b=MX3(C0[2],C0[3],C1[1]); a=MX3(a,C1[2],C1[3]); \
      _Pragma("unroll") for(int r=4;r<16;r+=4){a=MX3(a,C0[r],C0[r+1]);b=MX3(b,C0[r+2],C0[r+3]);a=MX3(a,C1[r],C1[r+1]);b=MX3(b,C1[r+2],C1[r+3]);} \
      float rm=__builtin_fmaxf(a,b); { auto rr=__builtin_amdgcn_permlane32_swap(__float_as_uint(rm),__float_as_uint(rm),false,false); rm=__builtin_fmaxf(__uint_as_float(rr[0]),__uint_as_float(rr[1])); } \
      resc=false; \
      if(__builtin_expect(__any(rm>(float)THRL),0)){ const float dl=__builtin_fmaxf(rm,0.f); mhat+=dl; \
        _Pragma("unroll") for(int r=0;r<16;++r){C0[r]-=dl;C1[r]-=dl;} \
        _Pragma("unroll") for(int r=0;r<16;++r)negm[r]=-mhat; asm volatile("":"+v"(negm)); \
        const float f=__builtin_amdgcn_exp2f(-dl); l_reg*=f; if(hi==0)wsf[r32]=f; resc=true; } } \
    SBAR(); \
    GAPB(o[0]=__builtin_amdgcn_mfma_f32_32x32x16_bf16(PAF(0),VFR(0),o[0],0,0,0), C0,0); \
    GAPB(o[1]=__builtin_amdgcn_mfma_f32_32x32x16_bf16(PAF(0),VFR(4),o[1],0,0,0), C0,4); \
    KRD(GL,0); GAPB(o[0]=__builtin_amdgcn_mfma_f32_32x32x16_bf16(PAF(1),VFR(1),o[0],0,0,0), C0,8); \
    KRD(GL,1); GAPB(o[1]=__builtin_amdgcn_mfma_f32_32x32x16_bf16(PAF(1),VFR(5),o[1],0,0,0), C0,12); \
    KRD(GL,2); GAPB(o[0]=__builtin_amdgcn_mfma_f32_32x32x16_bf16(PAF(2),VFR(2),o[0],0,0,0), C1,0); \
    KRD(GL,3); GAPB(o[1]=__builtin_amdgcn_mfma_f32_32x32x16_bf16(PAF(2),VFR(6),o[1],0,0,0), C1,4); \
    GAPB(o[0]=__builtin_amdgcn_mfma_f32_32x32x16_bf16(PAF(3),VFR(3),o[0],0,0,0), C1,8); \
    GAPB(o[1]=__builtin_amdgcn_mfma_f32_32x32x16_bf16(PAF(3),VFR(7),o[1],0,0,0), C1,12); \
    }while(0)
  int t=1;
  #undef CMASK
  #define CMASK(P0,P1,t) do{}while(0)
  for(;t+5<NT;t+=2){
    STEP(pB0,pB1,pA0,pA1,t,true,true,true);     WAIT_BAR(2); RESC(); ROT();
    STEP(pA0,pA1,pB0,pB1,t+1,true,true,true);   WAIT_BAR(2); RESC(); ROT();
  }
  #undef CMASK
  #define CMASK(P0,P1,t) do{}while(0)
  #define ENDW(tt) do{ if((tt)+3<NT){WAIT_BAR(2);} else if((tt)+2<NT){WAIT_BAR(1);} else {WAIT_BAR(0);} }while(0)
  for(;t+1<NT;t+=2){
    STEP(pB0,pB1,pA0,pA1,t,(t+3<NT),(t+1<NT),(t+1<NT));       ENDW(t);   RESC(); ROT();
    STEP(pA0,pA1,pB0,pB1,t+1,(t+4<NT),(t+2<NT),(t+2<NT));     ENDW(t+1); RESC(); ROT();
  }
  STEP(pB0,pB1,pA0,pA1,NT-1,false,false,false); RESC();
  { float sacc=pB0[0]+pB0[1]; _Pragma("unroll") for(int r=2;r<16;++r)sacc+=pB0[r]; _Pragma("unroll") for(int r=0;r<16;++r)sacc+=pB1[r]; l_reg+=sacc;
    pw0=(u32x4){PKW(pB0,0),PKW(pB0,2),PKW(pB0,4),PKW(pB0,6)};pw1=(u32x4){PKW(pB0,8),PKW(pB0,10),PKW(pB0,12),PKW(pB0,14)};pw2=(u32x4){PKW(pB1,0),PKW(pB1,2),PKW(pB1,4),PKW(pB1,6)};pw3=(u32x4){PKW(pB1,8),PKW(pB1,10),PKW(pB1,12),PKW(pB1,14)};
    SBAR(); pv(o,vb0+sl_cur,PAF(0),PAF(1),PAF(2),PAF(3)); }
  #undef PKW
  #undef PAF
  #undef VFR
  #undef PIN
  #undef MX3
  #undef GAPA
  #undef GAPB
  #undef EX
  #undef VRD
  #undef KRD
  #undef STEP
  #undef ENDW
  {auto rr=__builtin_amdgcn_permlane32_swap(__float_as_uint(l_reg),__float_as_uint(l_reg),false,false);l_reg=__uint_as_float(rr[0])+__uint_as_float(rr[1]);}
  if(hi==0)wsf[32+r32]=l_reg;asm volatile("s_waitcnt lgkmcnt(0)":::"memory");
  float rli[16];
  #pragma unroll
  for(int r=0;r<16;++r)rli[r]=__builtin_amdgcn_rcpf(wsf[32+crow(r,hi)]);
  bf16*Ow=Ou+(long)(wid*QBLK)*OP;
  { bf16*stg=(bf16*)(shm+LDS_OST)+wid*2048;
    #pragma unroll
    for(int r=0;r<16;++r){const int orow=crow(r,hi);
      #pragma unroll
      for(int d0=0;d0<2;++d0)stg[orow*64+d0*32+r32]=__float2bfloat16(o[d0][r]*rli[r]);}
    asm volatile("s_waitcnt lgkmcnt(0)":::"memory");
    #pragma unroll
    for(int i=0;i<4;++i){const int row=i*8+(lane>>3),ch=lane&7; const u32x4 v=*(const u32x4*)(stg+row*64+ch*8); ATTN_STORE16(Ow+(long)row*OP+ch*8,v);} }
  asm volatile("s_waitcnt lgkmcnt(0)\n\ts_barrier":::"memory");
  #undef DMA_K
  #undef DMA_V
  #undef CMASK
  #undef START
  #undef RESC
  #undef ROT
}
constexpr int ATTN_LDS_BYTES=LDS_BYTES;
#undef SBAR
#undef WAIT_BAR
}
#define LDS_WAIT() asm volatile("s_waitcnt lgkmcnt(0)" ::: "memory")

__device__ __forceinline__ void transpose_item(const float* W, int K, int N, bf16* WT, int k0, int n0, int dest_row0, LAS float* scr, int lane) {
    float t_[32];
#pragma unroll
    for (int i = 0; i < 32; ++i) t_[i] = W[(size_t)(k0 + 2 * i + (lane >> 5)) * N + n0 + (lane & 31)];
#pragma unroll
    for (int i = 0; i < 32; ++i) scr[(2 * i + (lane >> 5)) * 33 + (lane & 31)] = t_[i];
    LDS_WAIT(); asm volatile("" ::: "memory");
    const int c = lane & 7;
#pragma unroll
    for (int j = 0; j < 4; ++j) { const int n = (lane >> 3) + 8 * j; const LAS float* s = scr + (8 * c) * 33 + n;
        v4u o; o.x = pk2(s[0 * 33], s[1 * 33]); o.y = pk2(s[2 * 33], s[3 * 33]); o.z = pk2(s[4 * 33], s[5 * 33]); o.w = pk2(s[6 * 33], s[7 * 33]);
        *(GAS v4u*)(WT + (size_t)(dest_row0 + n) * K + k0 + 8 * c) = o; }
    LDS_WAIT(); asm volatile("" ::: "memory");
}

template <int KMODE>
__device__ __forceinline__ void transpose_item8(const float* W, int K, int N, unsigned char* WT, int k0, int n0, int dest_row0, float sc, LAS float* scr, int lane) {
    float t_[32];
#pragma unroll
    for (int i = 0; i < 32; ++i) t_[i] = W[(size_t)(k0 + 2 * i + (lane >> 5)) * N + n0 + (lane & 31)];
#pragma unroll
    for (int i = 0; i < 32; ++i) scr[(2 * i + (lane >> 5)) * 33 + (lane & 31)] = __builtin_amdgcn_fmed3f(t_[i] * sc, -448.f, 448.f);
    LDS_WAIT(); asm volatile("" ::: "memory");
    const int c = lane & 7, w = c >> 2, fq = c & 3, wh = (k0 >> 6) & 1;
    const int doff = KMODE == 1 ? (k0 & ~255) + 64 * (2 * wh + w) + 16 * fq + 8 * ((k0 >> 7) & 1) : KMODE == 2 ? (k0 & ~127) + 32 * (2 * wh + w) + 8 * fq : k0 + 8 * c;
#pragma unroll
    for (int j = 0; j < 4; ++j) { const int n = (lane >> 3) + 8 * j; const LAS float* s = scr + n;
        float v[8];
#pragma unroll
        for (int e = 0; e < 8; ++e) { const int kk = KMODE == 2 ? 32 * w + 16 * (e >> 2) + 4 * fq + (e & 3) : 8 * c + e; v[e] = s[kk * 33]; }
        unsigned w0 = 0, w1 = 0;
        w0 = __builtin_amdgcn_cvt_pk_fp8_f32(v[0], v[1], w0, false); w0 = __builtin_amdgcn_cvt_pk_fp8_f32(v[2], v[3], w0, true);
        w1 = __builtin_amdgcn_cvt_pk_fp8_f32(v[4], v[5], w1, false); w1 = __builtin_amdgcn_cvt_pk_fp8_f32(v[6], v[7], w1, true);
        *(GAS v2u*)(WT + (size_t)(dest_row0 + n) * K + doff) = (v2u){w0, w1}; }
    LDS_WAIT(); asm volatile("" ::: "memory");
}

struct ProIn { const float *hy_w_in, *at_w_in, *w_out, *w_mem_kv; };
__device__ __forceinline__ void phase_weights(const ProIn& P, unsigned char* ws, LAS unsigned char* lds, int gw, int NGW, int wave, int lane) {
    LAS float* scr = (LAS float*)(lds + wave * 16384);
    constexpr int I_HY = 16 * 80, I_AT = 16 * 48, I_OUT = 16 * 32, I_MKV = 16 * 16;
    constexpr int E0 = 2 * I_HY, E1 = E0 + 2 * I_AT, E2 = E1 + 4 * I_OUT, E3 = E2 + 4 * I_MKV;
    for (int it = gw; it < E3; it += NGW) {
        int r = it;
        if (r < E0) { const int j = r / I_HY, q = r % I_HY, kb = q / 80, nb = q % 80;
            transpose_item(P.hy_w_in + (size_t)j * DM * D_IN_HY, DM, D_IN_HY, (bf16*)(ws + WS_WHY) + (size_t)j * D_IN_HY * DM, 64 * kb, 32 * nb, 32 * nb, scr, lane); continue; }
        r -= E0;
        if (r < 2 * I_AT) { const int j = r / I_AT, q = r % I_AT, kb = q / 48, nb = q % 48;
            const int n0 = 32 * nb, o = n0 & 255;
            transpose_item(P.at_w_in + (size_t)j * DM * D_IN_AT, DM, D_IN_AT, (bf16*)(ws + WS_WAT) + (size_t)j * D_IN_AT * DM, 64 * kb, n0, (n0 & ~255) + 128 * ((o & 63) >> 5) + 32 * (o >> 6), scr, lane); continue; }
        r -= 2 * I_AT;
        if (r < 4 * I_OUT) { const int j = r / I_OUT, q = r % I_OUT, kb = q / 32, nb = q % 32;
            transpose_item(P.w_out + (size_t)j * DM * DM, DM, DM, (bf16*)(ws + WS_WOUT) + (size_t)j * DM * DM, 64 * kb, 32 * nb, 32 * nb, scr, lane); continue; }
        r -= 4 * I_OUT;
        { const int j = r / I_MKV, q = r % I_MKV, kb = q / 16, nb = q % 16;
            transpose_item(P.w_mem_kv + (size_t)j * DM * 512, DM, 512, (bf16*)(ws + WS_WMKV), 64 * kb, 32 * nb, j * 512 + 32 * nb, scr, lane); }
        (void)r;
    }
}

struct XwIn { const float *w_gate, *w_up, *w_down; unsigned char* ws; };
constexpr int XW_PER_EXPERT = 3 * 384, XW_PER_LAYER = NEXP * XW_PER_EXPERT;
constexpr int XW_QA_HY = 5, XW_QA_AT = 4, XW_QB = 3, XW_NA = 128 * NWAVES, XW_NB = 224 * NWAVES;
__host__ __device__ constexpr int xw_qa(int layer) { return (layer & 1) ? XW_QA_AT : XW_QA_HY; }
__host__ __device__ constexpr int xw_p0(int layer, bool sched) { return sched ? XW_PER_LAYER - xw_qa(layer) * XW_NA - XW_QB * XW_NB : XW_PER_LAYER; }
__device__ __forceinline__ void xw_item(const XwIn& B, int layer, int r, LAS float* scr, int lane) {
    const int j = layer * NEXP + r / XW_PER_EXPERT, q = r % XW_PER_EXPERT, kind = q / 384, qq = q % 384;
    if (kind < 2) { const int kb = qq / 24, nb = qq % 24, n0 = 32 * nb;
        transpose_item8<1>((kind == 0 ? B.w_gate : B.w_up) + (size_t)j * DM * EFF, DM, EFF, B.ws + WS_W1 + (size_t)j * 1536 * DM, 64 * kb, n0, (n0 >> 7) * 256 + 128 * kind + (n0 & 127), W8_SCALE, scr, lane); }
    else { const int kb = qq / 32, nb = qq % 32;
        transpose_item8<2>(B.w_down + (size_t)j * EFF * DM, EFF, DM, B.ws + WS_W2 + (size_t)j * DM * EFF, 64 * kb, 32 * nb, 32 * nb, W8_SCALE, scr, lane); }
}
__device__ __forceinline__ void phase_xw_p0(const XwIn& B, bool sched, LAS float* scr, int gw, int NGW, int lane) {
#pragma unroll 1
    for (int layer = 0; layer < DEPTH; ++layer) { const int n = xw_p0(layer, sched);
#pragma unroll 1
        for (int r = gw; r < n; r += NGW) xw_item(B, layer, r, scr, lane); }
}
__device__ __forceinline__ void xw_slice_a(const XwIn& B, int layer, LAS float* scr, int bx, int wave, int lane) {
    const int base = xw_p0(layer, true) + (bx - 128) * NWAVES + wave;
#pragma unroll 1
    for (int k = 0; k < xw_qa(layer); ++k) xw_item(B, layer, base + k * XW_NA, scr, lane);
}
__device__ __forceinline__ void xw_slice_b(const XwIn& B, int layer, LAS float* scr, int bx, int wave, int lane) {
    const int base = xw_p0(layer, true) + xw_qa(layer) * XW_NA + (bx - 32) * NWAVES + wave;
#pragma unroll 1
    for (int k = 0; k < XW_QB; ++k) xw_item(B, layer, base + k * XW_NB, scr, lane);
}

__device__ __forceinline__ void phase_wrg(const float* ffn_g, const float* router, float* WRG, int gtid, int nthreads) {
    for (int q = gtid; q < DEPTH * NEXP * DM; q += nthreads) { const int l = q / (NEXP * DM), e = (q / DM) % NEXP, d = q % DM; WRG[q] = ffn_g[l * DM + d] * router[((size_t)l * DM + d) * NEXP + e]; }
}

__device__ __forceinline__ void rms_row_bf16(const float* xrow, const float* g, bf16* orow, int lane) {
    const GAS f32x4* xr = (const GAS f32x4*)xrow + lane; const GAS f32x4* gr = (const GAS f32x4*)g + lane;
    f32x4 v[4]; float s = 0.f;
#pragma unroll
    for (int j = 0; j < 4; ++j) { v[j] = xr[64 * j]; s += (v[j].x * v[j].x + v[j].y * v[j].y) + (v[j].z * v[j].z + v[j].w * v[j].w); }
    const float rstd = 1.f / sqrtf(wave_sum(s) * (1.f / DM) + NORM_EPS);
    GAS v2u* o8 = (GAS v2u*)orow + lane;
#pragma unroll
    for (int j = 0; j < 4; ++j) { const f32x4 gg = gr[64 * j]; v2u w; w.x = pk2(v[j].x * rstd * gg.x, v[j].y * rstd * gg.y); w.y = pk2(v[j].z * rstd * gg.z, v[j].w * rstd * gg.w); o8[64 * j] = w; }
}

__device__ __forceinline__ void phase_mem_h2(const float* mem, const float* mem_g, const float* fw1, const float* fb1, const float* fw2, const float* fb2, const float* ffreq,
                                              unsigned char* ws, int gw, int NGW, int lane) {
    for (int m = gw; m < BATCH * MEM_LEN; m += NGW) rms_row_bf16(mem + (size_t)m * DM, mem_g, (bf16*)(ws + WS_MEMN) + (size_t)m * DM, lane);
    float* H2 = (float*)(ws + WS_H2);
    for (int it = gw; it < 2 * SEQ; it += NGW) {
        const int j = it / SEQ, n = it % SEQ;
        const float* w1 = fw1 + j * HY_EMB * HY_FILT; const float* w2 = fw2 + j * HY_FILT * HY_FILT;
        const float t = (float)n * (1.0f / (float)(SEQ - 1));
        const float w = (6.283185307179586f * (float)n) / (float)SEQ;
        float feat = 0.f;
        if (lane == 0) feat = t;
        else if (lane <= 16) { const float band = 1e-4f + (float)(lane - 1) * ((15.0f - 1e-4f) / 15.0f); feat = cosf(band * w); }
        else if (lane <= 32) { const float band = 1e-4f + (float)(lane - 17) * ((15.0f - 1e-4f) / 15.0f); feat = -sinf(band * w); }
        const float fr = ffreq[j * HY_FILT + lane];
        float a = fb1[j * HY_FILT + lane];
        for (int i = 0; i < HY_EMB; ++i) a += __shfl(feat, i) * w1[i * HY_FILT + lane];
        const float h1 = sinf(fr * a);
        float a2 = fb2[j * HY_FILT + lane];
        for (int i = 0; i < HY_FILT; ++i) a2 += __shfl(h1, i) * w2[i * HY_FILT + lane];
        H2[(size_t)it * HY_FILT + lane] = sinf(fr * a2);
    }
}

template <bool COMBINE, bool FINAL>
__device__ __forceinline__ void phase_norm(const float* hin, float* hout, const float* g, bf16* U, float* fout, const int* POS, const bf16* Y, int gw, int NGW, int lane) {
    int m = gw;
    if (m >= M_TOK) return;
    f32x4 cur[4]; int cpos = -1;
    { const GAS f32x4* xr = (const GAS f32x4*)(hin + (size_t)m * DM) + lane;
#pragma unroll
      for (int j = 0; j < 4; ++j) cur[j] = xr[64 * j];
      if (COMBINE) { const int b = m / SEQ, t = m % SEQ; if (lane < NEXP) cpos = POS[(size_t)(b * NEXP + lane) * SEQ + t]; } }
#pragma unroll 1
    for (; m < M_TOK; m += NGW) {
        const int mn = m + NGW; f32x4 nxt[4]; int npos = -1;
#pragma unroll
        for (int j = 0; j < 4; ++j) nxt[j] = cur[j];
        if (mn < M_TOK) { const GAS f32x4* xr = (const GAS f32x4*)(hin + (size_t)mn * DM) + lane;
#pragma unroll
            for (int j = 0; j < 4; ++j) nxt[j] = xr[64 * j];
            if (COMBINE) { const int b = mn / SEQ, t = mn % SEQ; if (lane < NEXP) npos = POS[(size_t)(b * NEXP + lane) * SEQ + t]; } }
        f32x4 v[4];
#pragma unroll
        for (int j = 0; j < 4; ++j) v[j] = cur[j];
        if (COMBINE) {
            const int b = m / SEQ;
            unsigned long long mask = __ballot(cpos >= 0);
            while (mask) {
                v2u y[4][4]; bool has[4];
#pragma unroll
                for (int k = 0; k < 4; ++k) { has[k] = mask != 0ull;
                    if (has[k]) { const int e = __builtin_amdgcn_readfirstlane(__builtin_ctzll(mask)); mask &= mask - 1ull; const int p = __builtin_amdgcn_readlane(cpos, e);
                        const GAS v2u* yr = (const GAS v2u*)(Y + ((size_t)(b * NEXP + e) * CAP + p) * DM) + lane;
#pragma unroll
                        for (int j = 0; j < 4; ++j) y[k][j] = yr[64 * j]; } }
#pragma unroll
                for (int k = 0; k < 4; ++k) if (has[k]) {
#pragma unroll
                    for (int j = 0; j < 4; ++j) { const v2u w = y[k][j]; v[j].x += bflo(w.x); v[j].y += bfhi(w.x); v[j].z += bflo(w.y); v[j].w += bfhi(w.y); } }
            }
            if (!FINAL) { GAS f32x4* ho = (GAS f32x4*)(hout + (size_t)m * DM) + lane;
#pragma unroll
                for (int j = 0; j < 4; ++j) ho[64 * j] = v[j]; }
        }
        float s = 0.f;
#pragma unroll
        for (int j = 0; j < 4; ++j) s += (v[j].x * v[j].x + v[j].y * v[j].y) + (v[j].z * v[j].z + v[j].w * v[j].w);
        const float rstd = 1.f / sqrtf(wave_sum(s) * (1.f / DM) + NORM_EPS);
        const GAS f32x4* gr = (const GAS f32x4*)g + lane;
        if (FINAL) { GAS f32x4* o = (GAS f32x4*)(fout + (size_t)m * DM) + lane;
#pragma unroll
            for (int j = 0; j < 4; ++j) o[64 * j] = v[j] * rstd * gr[64 * j]; }
        else { GAS v2u* o8 = (GAS v2u*)(U + (size_t)m * DM) + lane;
#pragma unroll
            for (int j = 0; j < 4; ++j) { const f32x4 gg = gr[64 * j]; v2u w; w.x = pk2(v[j].x * rstd * gg.x, v[j].y * rstd * gg.y); w.y = pk2(v[j].z * rstd * gg.z, v[j].w * rstd * gg.w); o8[64 * j] = w; } }
#pragma unroll
        for (int j = 0; j < 4; ++j) cur[j] = nxt[j];
        cpos = npos;
    }
}

__device__ __forceinline__ void phase_ffn_norm_router(const float* H, const float* g, const float* Wr, unsigned char* XN8, float* AFF, LAS unsigned char* lds, int gw, int NGW, int lane, int tid) {
    LAS f32x4* WL = (LAS f32x4*)lds;
    for (int q = tid; q < 64 * 64; q += NTHREADS) { const int ln = q & 63, s = q >> 6, e4 = s & 3, ji = s >> 2, i = ji & 3, j = ji >> 2; const int d = 4 * ln + i + 256 * j;
        WL[q] = *(const GAS f32x4*)(Wr + (size_t)d * NEXP + 4 * e4); }
    __syncthreads();
    constexpr int R = 4;
    const GAS f32x4* gr = (const GAS f32x4*)g + lane;
#pragma unroll 1
    for (int m0 = gw * R; m0 < M_TOK; m0 += NGW * R) {
        int lo_ = lane; asm volatile("" : "+v"(lo_));
        f32x4 v[R][4]; float rstd[R];
#pragma unroll
        for (int r = 0; r < R; ++r) { const GAS f32x4* xr = (const GAS f32x4*)(H + (size_t)(m0 + r) * DM) + lane;
#pragma unroll
            for (int j = 0; j < 4; ++j) v[r][j] = xr[64 * j]; }
#pragma unroll
        for (int r = 0; r < R; ++r) { float s = 0.f;
#pragma unroll
            for (int j = 0; j < 4; ++j) s += (v[r][j].x * v[r][j].x + v[r][j].y * v[r][j].y) + (v[r][j].z * v[r][j].z + v[r][j].w * v[r][j].w);
            rstd[r] = 1.f / sqrtf(wave_sum(s) * (1.f / DM) + NORM_EPS); }
        f32x4 lg[R][4];
#pragma unroll
        for (int r = 0; r < R; ++r)
#pragma unroll
            for (int e4 = 0; e4 < 4; ++e4) lg[r][e4] = (f32x4){0.f, 0.f, 0.f, 0.f};
#pragma unroll
        for (int j = 0; j < 4; ++j) { const f32x4 gg = gr[64 * j];
#pragma unroll
            for (int r = 0; r < R; ++r) { v[r][j] = v[r][j] * rstd[r] * gg;
                unsigned w = 0; w = __builtin_amdgcn_cvt_pk_fp8_f32(v[r][j].x, v[r][j].y, w, false); w = __builtin_amdgcn_cvt_pk_fp8_f32(v[r][j].z, v[r][j].w, w, true);
                ((GAS unsigned*)(XN8 + (size_t)(m0 + r) * DM) + lane)[64 * j] = w; }
#pragma unroll
            for (int i = 0; i < 4; ++i)
#pragma unroll
                for (int e4 = 0; e4 < 4; ++e4) { const f32x4 wv = WL[((j * 4 + i) * 4 + e4) * 64 + lo_];
#pragma unroll
                    for (int r = 0; r < R; ++r) { const float xs = v[r][j][i];
#pragma unroll
                        for (int c = 0; c < 4; ++c) asm("v_fmac_f32 %0, %1, %2" : "+v"(lg[r][e4][c]) : "v"(wv[c]), "v"(xs)); } }
            __builtin_amdgcn_sched_barrier(0); }
#pragma unroll
        for (int r = 0; r < R; ++r) {
            float l16[16];
#pragma unroll
            for (int e = 0; e < 16; ++e) l16[e] = wave_sum(lg[r][e >> 2][e & 3]);
            float mx = l16[0];
#pragma unroll
            for (int e = 1; e < 16; ++e) mx = fmaxf(mx, l16[e]);
            float den = 0.f;
#pragma unroll
            for (int e = 0; e < 16; ++e) { l16[e] = expf(l16[e] - mx); den += l16[e]; }
            float mine = 0.f;
#pragma unroll
            for (int e = 0; e < 16; ++e) mine = (lane == e) ? l16[e] : mine;
            const int m = m0 + r, b = m / SEQ, t = m % SEQ;
            if (lane < NEXP) AFF[(size_t)(b * NEXP + lane) * SEQ + t] = mine / den;
        }
    }
    __syncthreads();
}

__device__ __forceinline__ void phase_router_sum(const float* PLG, const float* PSS, float* RSTD, float* AFF, int gw, int NGW, int lane) {
    const int e = lane & 15, rq = lane >> 4;
    for (int m0 = gw * 4; m0 < M_TOK; m0 += NGW * 4) {
        const int m = m0 + rq;
        float lgt = 0.f;
#pragma unroll
        for (int slot = 0; slot < 16; ++slot) lgt += PLG[((size_t)slot * M_TOK + m) * 16 + e];
        float ss = PSS[(size_t)e * M_TOK + m];
#pragma unroll
        for (int o = 1; o < 16; o <<= 1) ss += __shfl_xor(ss, o);
        const float rstd = 1.f / sqrtf(ss * (1.f / DM) + NORM_EPS);
        lgt *= rstd;
        float mx = lgt;
#pragma unroll
        for (int o = 1; o < 16; o <<= 1) mx = fmaxf(mx, __shfl_xor(mx, o));
        const float ex = expf(lgt - mx); float den = ex;
#pragma unroll
        for (int o = 1; o < 16; o <<= 1) den += __shfl_xor(den, o);
        const int b = m / SEQ, t = m % SEQ;
        AFF[(size_t)(b * NEXP + e) * SEQ + t] = ex / den;
        if (e == 0) RSTD[m] = rstd;
    }
}

__device__ __forceinline__ int block_excl_scan(int v, LAS int* scr, int tid, int lane, int wave, int* tot) {
    int inc = v;
#pragma unroll
    for (int o = 1; o < 64; o <<= 1) { const int n = __shfl_up(inc, o); if (lane >= o) inc += n; }
    __syncthreads();
    if (lane == 63) scr[wave] = inc;
    __syncthreads();
    int base = 0, total = 0;
#pragma unroll
    for (int w = 0; w < NWAVES; ++w) { const int c = scr[w]; if (w < wave) base += c; total += c; }
    *tot = total;
    return base + inc - v;
}

__device__ __forceinline__ void phase_topk(const float* AFF, const float* RSTD, float* RS, int* IDX, float* GATE, int* POS, LAS unsigned char* ldsm, int blk, int nblk, int tid, int lane, int wave) {
    LAS int* hist = (LAS int*)ldsm;
    LAS int* sel = (LAS int*)(ldsm + 1024);
    LAS int* scr = (LAS int*)(ldsm + 1280);
    for (int g = blk; g < NGRP; g += nblk) {
        unsigned v[16];
        { const GAS v4u* src = (const GAS v4u*)(AFF + (size_t)g * SEQ) + tid * 4;
#pragma unroll
          for (int q = 0; q < 4; ++q) { const v4u w = src[q]; v[4 * q] = w.x; v[4 * q + 1] = w.y; v[4 * q + 2] = w.z; v[4 * q + 3] = w.w; } }
        unsigned prefix = 0u; int krem = CAP;
#pragma unroll 1
        for (int pass = 0; pass < 4; ++pass) {
            const int shift = 24 - 8 * pass;
            const unsigned himask = (pass == 0) ? 0u : (0xffffffffu << (shift + 8));
            __syncthreads();
            if (tid < 256) hist[tid] = 0;
            __syncthreads();
#pragma unroll
            for (int i = 0; i < 16; ++i) if ((v[i] & himask) == prefix) __hip_atomic_fetch_add(hist + ((v[i] >> shift) & 255u), 1, __ATOMIC_RELAXED, __HIP_MEMORY_SCOPE_WORKGROUP);
            __syncthreads();
            if (wave == 0) {
                int c[4]; int s = 0;
#pragma unroll
                for (int j = 0; j < 4; ++j) { c[j] = hist[255 - 4 * lane - j]; s += c[j]; }
                int inc = s;
#pragma unroll
                for (int o = 1; o < 64; o <<= 1) { const int n = __shfl_up(inc, o); if (lane >= o) inc += n; }
                int before = inc - s;
                if (before < krem && krem <= inc) {
                    int bin = 0, kk = krem - before; bool done = false;
#pragma unroll
                    for (int j = 0; j < 4; ++j) { if (!done) { if (kk <= c[j]) { bin = 255 - 4 * lane - j; done = true; } else kk -= c[j]; } }
                    sel[0] = bin; sel[1] = kk;
                }
            }
            __syncthreads();
            prefix |= ((unsigned)sel[0]) << shift; krem = sel[1];
        }
        int ceq = 0;
#pragma unroll
        for (int i = 0; i < 16; ++i) ceq += (v[i] == prefix) ? 1 : 0;
        int tot;
        int eqrank = block_excl_scan(ceq, scr, tid, lane, wave, &tot);
        int csel = 0; unsigned selmask = 0u;
#pragma unroll
        for (int i = 0; i < 16; ++i) { bool s = v[i] > prefix; if (v[i] == prefix) { s = eqrank < krem; ++eqrank; } if (s) { selmask |= 1u << i; ++csel; } }
        int slot = block_excl_scan(csel, scr, tid, lane, wave, &tot);
        const int b = g / NEXP;
        int pv[16];
#pragma unroll
        for (int i = 0; i < 16; ++i) {
            pv[i] = -1;
            if (selmask & (1u << i)) { pv[i] = slot; IDX[g * CAP + slot] = b * SEQ + tid * 16 + i; GATE[g * CAP + slot] = __builtin_bit_cast(float, v[i]); RS[g * CAP + slot] = RSTD[b * SEQ + tid * 16 + i]; ++slot; }
        }
        { GAS v4u* dst = (GAS v4u*)(POS + (size_t)g * SEQ) + tid * 4;
#pragma unroll
          for (int q = 0; q < 4; ++q) { v4u w; w.x = (unsigned)pv[4 * q]; w.y = (unsigned)pv[4 * q + 1]; w.z = (unsigned)pv[4 * q + 2]; w.w = (unsigned)pv[4 * q + 3]; dst[q] = w; } }
        __syncthreads();
    }
}

__device__ __forceinline__ void phase_gather(const bf16* XN, const int* IDX, bf16* XG, int gw, int NGW, int lane) {
    for (int r = gw; r < XROWS; r += NGW) {
        const int src = __builtin_amdgcn_readfirstlane(IDX[r]);
        const GAS v4u* s = (const GAS v4u*)(XN + (size_t)src * DM) + lane; GAS v4u* d = (GAS v4u*)(XG + (size_t)r * DM) + lane;
        const v4u a = s[0], b = s[64]; d[0] = a; d[64] = b;
    }
}

__device__ __forceinline__ void phase_qk_rope(bf16* P, const float* gq, const float* gk, int gw, int NGW, int lane) {
    const int hh = lane >> 2, part = lane & 3, axis = part >> 1, half = part & 1;
    const float* g = (hh < NQH ? gq : gk) + 16 * part;
    float gv[16], inv[16];
#pragma unroll
    for (int i = 0; i < 16; ++i) { gv[i] = g[i]; inv[i] = exp2f(-(float)i * (13.287712379549449f / 16.0f)); }
    const float osc = hh < NQH ? ATT_C2 : 1.0f;
    int m = gw; v4u c0 = (v4u){0u, 0u, 0u, 0u}, c1 = c0;
    if (m < M_TOK) { const GAS v4u* p = (const GAS v4u*)(P + (size_t)m * D_IN_AT + hh * HD + 16 * part); c0 = p[0]; c1 = p[1]; }
#pragma unroll 1
    for (; m < M_TOK; m += NGW) {
        const int t = m % SEQ; const float pos = (float)(axis == 0 ? (t >> 6) : (t & 63));
        GAS v4u* p = (GAS v4u*)(P + (size_t)m * D_IN_AT + hh * HD + 16 * part);
        const v4u w0 = c0, w1 = c1;
        if (m + NGW < M_TOK) { const GAS v4u* pn = (const GAS v4u*)(P + (size_t)(m + NGW) * D_IN_AT + hh * HD + 16 * part); c0 = pn[0]; c1 = pn[1]; }
        float x[16];
        x[0] = bflo(w0.x); x[1] = bfhi(w0.x); x[2] = bflo(w0.y); x[3] = bfhi(w0.y); x[4] = bflo(w0.z); x[5] = bfhi(w0.z); x[6] = bflo(w0.w); x[7] = bfhi(w0.w);
        x[8] = bflo(w1.x); x[9] = bfhi(w1.x); x[10] = bflo(w1.y); x[11] = bfhi(w1.y); x[12] = bflo(w1.z); x[13] = bfhi(w1.z); x[14] = bflo(w1.w); x[15] = bfhi(w1.w);
        float ss = 0.f;
#pragma unroll
        for (int i = 0; i < 16; ++i) ss += x[i] * x[i];
        ss += __shfl_xor(ss, 1); ss += __shfl_xor(ss, 2);
        const float rstd = 1.f / sqrtf(ss * (1.f / HD) + NORM_EPS);
        float o[16];
#pragma unroll
        for (int i = 0; i < 16; ++i) {
            const float xn = x[i] * rstd * gv[i]; const float xp = __shfl_xor(xn, 1);
            float sn, cs; sincosf(pos * inv[i], &sn, &cs);
            o[i] = (half == 0 ? (xn * cs - xp * sn) : (xp * sn + xn * cs)) * osc;
        }
        v4u r0, r1;
        r0.x = pk2(o[0], o[1]); r0.y = pk2(o[2], o[3]); r0.z = pk2(o[4], o[5]); r0.w = pk2(o[6], o[7]);
        r1.x = pk2(o[8], o[9]); r1.y = pk2(o[10], o[11]); r1.z = pk2(o[12], o[13]); r1.w = pk2(o[14], o[15]);
        p[0] = r0; p[1] = r1;
    }
}

__device__ __forceinline__ void phase_transpose_mix(const bf16* MIXT, bf16* MIX, int blk, int nblk, int tid) {
    for (int it = blk; it < (D_MAIN / 64) * (M_TOK / NTHREADS); it += nblk) {
        const int cb = it % (D_MAIN / 64), mb = it / (D_MAIN / 64); const int m = mb * NTHREADS + tid, c0 = cb * 64;
        unsigned w[32];
#pragma unroll
        for (int c = 0; c < 32; ++c) { const unsigned lo = MIXT[(size_t)(c0 + 2 * c) * M_TOK + m], hi = MIXT[(size_t)(c0 + 2 * c + 1) * M_TOK + m]; w[c] = lo | (hi << 16); }
        GAS v4u* d = (GAS v4u*)(MIX + (size_t)m * DM + c0);
#pragma unroll
        for (int q = 0; q < 8; ++q) { v4u o; o.x = w[4 * q]; o.y = w[4 * q + 1]; o.z = w[4 * q + 2]; o.w = w[4 * q + 3]; d[q] = o; }
    }
}
__device__ __forceinline__ void phase_taps(const float* H2j, const float* w3, bf16* TAPS, int gw, int NGW, int lane) {
    typedef float f32x16 __attribute__((ext_vector_type(16))); typedef short bf16x8_t __attribute__((ext_vector_type(8)));
    const float min_decay = -4.605170185988091f / 1.5f, max_decay = -4.605170185988091f / 0.3f;
    const int li = lane & 31, hi = lane >> 5;
#pragma unroll 1
    for (int it = gw; it < (FCOLS / 32) * (SEQ / 128); it += NGW) {
        const int ct = it % (FCOLS / 32), ng = it / (FCOLS / 32), col0 = ct * 32;
        bf16x8_t a[4];
#pragma unroll
        for (int s = 0; s < 4; ++s) { float t[8];
#pragma unroll
            for (int j = 0; j < 8; ++j) t[j] = w3[(size_t)(16 * s + 8 * hi + j) * FCOLS + col0 + li];
            v4u p; p.x = pk2(t[0], t[1]); p.y = pk2(t[2], t[3]); p.z = pk2(t[4], t[5]); p.w = pk2(t[6], t[7]); a[s] = __builtin_bit_cast(bf16x8_t, p); }
        f32x4 hv[4][8];
#pragma unroll
        for (int nt = 0; nt < 4; ++nt) { const GAS f32x4* hp = (const GAS f32x4*)(H2j + (size_t)(ng * 128 + nt * 32 + li) * HY_FILT + 8 * hi);
#pragma unroll
            for (int s = 0; s < 4; ++s) { hv[nt][2 * s] = hp[4 * s]; hv[nt][2 * s + 1] = hp[4 * s + 1]; } }
#pragma unroll
        for (int nt = 0; nt < 4; ++nt) {
            const int n0 = ng * 128 + nt * 32;
            f32x16 acc;
#pragma unroll
            for (int r = 0; r < 16; ++r) acc[r] = 0.f;
#pragma unroll
            for (int s = 0; s < 4; ++s) { const f32x4 v0 = hv[nt][2 * s], v1 = hv[nt][2 * s + 1];
                v4u p; p.x = pk2(v0.x, v0.y); p.y = pk2(v0.z, v0.w); p.z = pk2(v1.x, v1.y); p.w = pk2(v1.z, v1.w);
                acc = __builtin_amdgcn_mfma_f32_32x32x16_bf16(a[s], __builtin_bit_cast(bf16x8_t, p), acc, 0, 0, 0); }
            const float t = (float)(n0 + li) * (1.0f / (float)(SEQ - 1));
#pragma unroll
            for (int r = 0; r < 16; ++r) { const int col = col0 + (r & 3) + 8 * (r >> 2) + 4 * hi, c = col % D_MAIN;
                const float ad = fabsf(min_decay + (float)c * ((max_decay - min_decay) / (float)(D_MAIN - 1)));
                TAPS[(size_t)col * SEQ + n0 + li] = (bf16)f2bf(acc[r] * expf(-t * ad)); }
        }
    }
}

__device__ __forceinline__ constexpr float twc(int k) { constexpr float T[16] = {1.0f, 0.98078528040323043f, 0.92387953251128674f, 0.83146961230254524f, 0.70710678118654757f, 0.55557023301960218f, 0.38268343236508978f, 0.19509032201612825f,
    0.0f, -0.19509032201612825f, -0.38268343236508978f, -0.55557023301960218f, -0.70710678118654757f, -0.83146961230254524f, -0.92387953251128674f, -0.98078528040323043f}; return T[k]; }
__device__ __forceinline__ constexpr float tws(int k) { constexpr float T[16] = {0.0f, 0.19509032201612825f, 0.38268343236508978f, 0.55557023301960218f, 0.70710678118654757f, 0.83146961230254524f, 0.92387953251128674f, 0.98078528040323043f,
    1.0f, 0.98078528040323043f, 0.92387953251128674f, 0.83146961230254524f, 0.70710678118654757f, 0.55557023301960218f, 0.38268343236508978f, 0.19509032201612825f}; return T[k]; }
__device__ __forceinline__ constexpr int bitrev(int i, int bits) { int r = 0; for (int b = 0; b < bits; ++b) if (i & (1 << b)) r |= 1 << (bits - 1 - b); return r; }

template <int N, int LEN> struct FftStage {
    static __device__ __forceinline__ void run(float (&re)[N], float (&im)[N]) {
        constexpr int half = LEN / 2, step = 32 / LEN;
#pragma unroll
        for (int base = 0; base < N; base += LEN)
#pragma unroll
            for (int j = 0; j < half; ++j) {
                const int i0 = base + j, i1 = i0 + half, idx = j * step;
                const float ar = re[i0], ai = im[i0], br = re[i1], bi = im[i1];
                re[i0] = ar + br; im[i0] = ai + bi;
                const float dr = ar - br, di = ai - bi;
                if (idx == 0) { re[i1] = dr; im[i1] = di; }
                else if (idx == 8) { re[i1] = di; im[i1] = -dr; }
                else { const float c = twc(idx), s = tws(idx); re[i1] = dr * c + di * s; im[i1] = di * c - dr * s; }
            }
        if constexpr (LEN > 2) FftStage<N, LEN / 2>::run(re, im);
    }
};
template <int N, int BITS> __device__ __forceinline__ void fft_reg(float (&re)[N], float (&im)[N]) {
    FftStage<N, N>::run(re, im);
    float tr[N], ti[N];
#pragma unroll
    for (int i = 0; i < N; ++i) { tr[bitrev(i, BITS)] = re[i]; ti[bitrev(i, BITS)] = im[i]; }
#pragma unroll
    for (int i = 0; i < N; ++i) { re[i] = tr[i]; im[i] = ti[i]; }
}

template <int N, int LEN> struct FftStageC {
    static __device__ __forceinline__ void run(f32x2 (&x)[N]) {
        constexpr int half = LEN / 2, step = 32 / LEN;
#pragma unroll
        for (int base = 0; base < N; base += LEN)
#pragma unroll
            for (int j = 0; j < half; ++j) {
                const int i0 = base + j, i1 = i0 + half, idx = j * step;
                const f32x2 a = x[i0], b = x[i1];
                x[i0] = a + b;
                const f32x2 d = a - b;
                if (idx == 0) x[i1] = d;
                else if (idx == 8) x[i1] = (f32x2){d.y, -d.x};
                else { const float c = twc(idx), s = tws(idx); const f32x2 t = (f32x2){d.y, -d.x}; x[i1] = d * c + t * s; }
            }
        if constexpr (LEN > 2) FftStageC<N, LEN / 2>::run(x);
    }
};
template <int N, int BITS> __device__ __forceinline__ void fft_regc(f32x2 (&x)[N]) {
    FftStageC<N, N>::run(x);
    f32x2 t[N];
#pragma unroll
    for (int i = 0; i < N; ++i) t[bitrev(i, BITS)] = x[i];
#pragma unroll
    for (int i = 0; i < N; ++i) x[i] = t[i];
}
__device__ __forceinline__ void fft16k_c(f32x2 (&x)[32], LAS f32x2* L, int tid_in) {
    int tid = tid_in; asm volatile("" : "+v"(tid));
    fft_regc<32, 5>(x);
#pragma unroll
    for (int k1 = 1; k1 < 32; ++k1) { const float fr = (float)((tid * k1) & 16383) * (1.0f / 16384.0f); const float c = __builtin_amdgcn_cosf(fr), s = __builtin_amdgcn_sinf(fr);
        const f32x2 d = x[k1], t = (f32x2){d.y, -d.x}; x[k1] = d * c + t * s; if ((k1 & 3) == 3) __builtin_amdgcn_sched_barrier(0); }
#pragma unroll
    for (int k1 = 0; k1 < 32; ++k1) L[k1 * 513 + tid] = x[k1];
    __syncthreads();
    const int n3 = tid & 31, ka = tid >> 5;
    f32x2 a[16], b[16];
#pragma unroll
    for (int n2 = 0; n2 < 16; ++n2) { a[n2] = L[ka * 513 + n2 * 32 + n3]; b[n2] = L[(ka + 16) * 513 + n2 * 32 + n3]; }
    fft_regc<16, 4>(a); fft_regc<16, 4>(b);
#pragma unroll
    for (int k2 = 1; k2 < 16; ++k2) { const float fr = (float)((n3 * k2) & 511) * (1.0f / 512.0f); const float c = __builtin_amdgcn_cosf(fr), s = __builtin_amdgcn_sinf(fr);
        f32x2 d = a[k2], t = (f32x2){d.y, -d.x}; a[k2] = d * c + t * s; d = b[k2]; t = (f32x2){d.y, -d.x}; b[k2] = d * c + t * s; if ((k2 & 3) == 3) __builtin_amdgcn_sched_barrier(0); }
    __syncthreads();
#pragma unroll
    for (int k2 = 0; k2 < 16; ++k2) { L[n3 * 513 + k2 * 32 + ka] = a[k2]; L[n3 * 513 + k2 * 32 + ka + 16] = b[k2]; }
    __syncthreads();
#pragma unroll
    for (int q = 0; q < 32; ++q) x[q] = L[q * 513 + tid];
    fft_regc<32, 5>(x);
}
__device__ __forceinline__ void fft16k(float (&re)[32], float (&im)[32], LAS f32x2* L, int tid) {
    f32x2 x[32];
#pragma unroll
    for (int r = 0; r < 32; ++r) x[r] = (f32x2){re[r], im[r]};
    fft16k_c(x, L, tid);
#pragma unroll
    for (int r = 0; r < 32; ++r) { re[r] = x[r].x; im[r] = x[r].y; }
}

constexpr int HS_SP = SEQ + 16;
__device__ __forceinline__ void hy_stage(LAS bf16* S, int slot, const bf16* src, int tid) {
    LAS bf16* d = S + slot * HS_SP + 8;
    if (tid == 0) { d[-1] = 0; d[SEQ] = 0; }
#pragma unroll
    for (int q = 0; q < 2; ++q) { const int ch = q * NTHREADS + tid; *(LAS v4u*)(d + ch * 8) = *(const GAS v4u*)(src + ch * 8); }
}
__device__ __forceinline__ float hy_sc(const LAS bf16* S, int slot, int t, float w0, float w1, float w2) {
    const LAS bf16* p = S + slot * HS_SP + 8 + t;
    return bf2f(p[-1]) * w0 + bf2f(p[0]) * w1 + bf2f(p[1]) * w2;
}

__device__ __forceinline__ void phase_hyena_conv(const bf16* PT, const bf16* TAPS, const float* shortw, const float* skip, f32x2* XSall, bf16* MIXT,
                                                 LAS unsigned char* lds, int blk, int nblk, int tid_in, int lane, int wave, int pmode = 0) {
    LAS f32x2* L = (LAS f32x2*)lds; LAS bf16* S = (LAS bf16*)lds; LAS float* red = (LAS float*)(lds + LDS_MISC);
    f32x2* XS = XSall + (size_t)blk * 16384;
    f32x2* ZS = XS + 16384 * 256;
    constexpr int N = 16384;
#pragma unroll 1
    for (int c = blk; c < D_MAIN; c += nblk) {
        const bf16* hf0 = TAPS + (size_t)c * SEQ; const bf16* hb0 = TAPS + (size_t)(D_MAIN + c) * SEQ;
        const bf16* hf1 = TAPS + (size_t)(2 * D_MAIN + c) * SEQ; const bf16* hb1 = TAPS + (size_t)(3 * D_MAIN + c) * SEQ;
        const bf16* px1 = PT + (size_t)c * M_TOK; const bf16* px2 = PT + (size_t)(D_MAIN + c) * M_TOK; const bf16* pv = PT + (size_t)(2 * D_MAIN + c) * M_TOK;
        const float wx1[3] = {shortw[c], shortw[2304 + c], shortw[4608 + c]};
        const float wx2[3] = {shortw[D_MAIN + c], shortw[2304 + D_MAIN + c], shortw[4608 + D_MAIN + c]};
        const float wv[3] = {shortw[2 * D_MAIN + c], shortw[2304 + 2 * D_MAIN + c], shortw[4608 + 2 * D_MAIN + c]};
        const float sk0 = skip[c], sk1 = skip[D_MAIN + c];
        f32x2 x[32]; float vr[16], vi[16];
#pragma unroll 1
        for (int pass = 0; pass < 5; ++pass) {
            int tid = tid_in; asm volatile("" : "+v"(tid));
            if (pass == 0) {
#pragma unroll
                for (int r = 0; r < 16; ++r) { const int n = r * 512 + tid; x[r].x = bf2f(hf0[n]); x[r].y = bf2f(hf1[n]); }
#pragma unroll
                for (int r = 16; r < 32; ++r) { const int idx = (32 - r) * 512 - tid; const bool z = (idx == SEQ); const int ii = z ? 0 : idx; x[r].x = z ? 0.f : bf2f(hb0[ii]); x[r].y = z ? 0.f : bf2f(hb1[ii]); }
                float e0 = 0.f, e1 = 0.f;
                if (tid == 0) { e0 = bf2f(hb0[0]); e1 = bf2f(hb1[0]); }
                float s0 = fabsf(e0), s1 = fabsf(e1);
#pragma unroll
                for (int r = 0; r < 32; ++r) { s0 += fabsf(x[r].x); s1 += fabsf(x[r].y); }
                s0 = wave_sum(s0); s1 = wave_sum(s1);
                __syncthreads();
                if (lane == 0) { red[wave] = s0; red[8 + wave] = s1; }
                __syncthreads();
                float t0 = 0.f, t1 = 0.f;
#pragma unroll
                for (int w = 0; w < NWAVES; ++w) { t0 += red[w]; t1 += red[8 + w]; }
                const float sc0 = 1.0f / (t0 + 1e-6f), sc1 = 1.0f / (t1 + 1e-6f);
                x[0].x += e0; x[0].y += e1;
#pragma unroll
                for (int r = 0; r < 32; ++r) { x[r].x *= sc0; x[r].y *= sc1; }
            } else if (pass == 1) {
                __syncthreads();
                hy_stage(S, 0, pv, tid); hy_stage(S, 1, pv + SEQ, tid);
                __syncthreads();
#pragma unroll
                for (int r = 0; r < 16; ++r) { const int t = r * 512 + tid; x[r].x = hy_sc(S, 0, t, wv[0], wv[1], wv[2]); x[r].y = hy_sc(S, 1, t, wv[0], wv[1], wv[2]); vr[r] = x[r].x; vi[r] = x[r].y; }
#pragma unroll
                for (int r = 16; r < 32; ++r) { x[r].x = 0.f; x[r].y = 0.f; }
            }
            __syncthreads();
            fft16k_c(x, L, tid);
            if (pass == 0) {
#pragma unroll
                for (int r = 0; r < 32; ++r) XS[r * 512 + tid] = (f32x2){x[r].x, x[r].y};
                __syncthreads();
            } else if (pass == 1 || pass == 3) {
#pragma unroll
                for (int r = 0; r < 32; ++r) {
                    const int f = r * 512 + tid; const f32x2 xa = XS[f], xb = XS[(N - f) & (N - 1)];
                    float kr, ki;
                    if (pass == 1) { kr = xa.x + xb.x; ki = xa.y - xb.y; } else { kr = xa.y + xb.y; ki = xb.x - xa.x; }
                    kr *= (0.5f / (float)N); ki *= (0.5f / (float)N);
                    const float zr_ = x[r].x, zi_ = x[r].y;
                    x[r].x = zr_ * kr - zi_ * ki; x[r].y = -(zr_ * ki + zi_ * kr);
                }
            } else if (pass == 2) {
                __syncthreads();
                hy_stage(S, 2, px1, tid); hy_stage(S, 3, px1 + SEQ, tid);
                __syncthreads();
#pragma unroll
                for (int r = 0; r < 16; ++r) { const int t = r * 512 + tid;
                    const float v0 = vr[r], v1 = vi[r];
                    const float g0 = hy_sc(S, 2, t, wx1[0], wx1[1], wx1[2]), g1 = hy_sc(S, 3, t, wx1[0], wx1[1], wx1[2]);
                    x[r].x = g0 * (x[r].x + sk0 * v0); x[r].y = g1 * (-x[r].y + sk0 * v1); ZS[t] = (f32x2){x[r].x, x[r].y}; }
#pragma unroll
                for (int r = 16; r < 32; ++r) { x[r].x = 0.f; x[r].y = 0.f; }
            } else {
                __syncthreads();
                hy_stage(S, 0, px2, tid); hy_stage(S, 1, px2 + SEQ, tid);
                __syncthreads();
#pragma unroll
                for (int r = 0; r < 16; ++r) { const int t = r * 512 + tid;
                    const float g0 = hy_sc(S, 0, t, wx2[0], wx2[1], wx2[2]), g1 = hy_sc(S, 1, t, wx2[0], wx2[1], wx2[2]);
                    const f32x2 z = ZS[t];
                    const float o0 = g0 * (x[r].x + sk1 * z.x), o1 = g1 * (-x[r].y + sk1 * z.y);
                    MIXT[(size_t)c * M_TOK + t] = (bf16)f2bf(o0); MIXT[(size_t)c * M_TOK + SEQ + t] = (bf16)f2bf(o1); }
            }
        }
        __syncthreads();
    }
}
#ifndef MK_PER_PHASE
#define MK_PER_PHASE 0
#endif
#ifndef CONV_PMODE
#define CONV_PMODE 0
#endif
#ifndef REPMASK
#define REPMASK 0u
#endif
#define REP(kind) _Pragma("unroll 1") for (int r_ = 0; r_ < 1 + (int)((REPMASK >> (kind)) & 1u); ++r_)
struct Args {
    const float* in[24]; float* out; unsigned char* ws; int ph_lo, ph_hi;
};
constexpr int N_PHASES = 1 + (DEPTH - 1) + DEPTH * 8 - DEPTH / 2 + 1;

template <int QP, int KP>
__device__ __forceinline__ void run_attn(const bf16* Q, const bf16* K, const bf16* V, bf16* O, int NT, char* shm) {
    attn_body::attn_unit<8, QP, KP, DM>((const attn_body::bf16*)Q, (const attn_body::bf16*)K, (const attn_body::bf16*)V, (attn_body::bf16*)O, NT, shm);
}

__global__ void __launch_bounds__(NTHREADS, 2) hybrid_fwd(Args args) {
    extern __shared__ __attribute__((aligned(16))) unsigned char lds_raw[];
    LAS unsigned char* lds = (LAS unsigned char*)lds_raw;
    const int G = gridDim.x, bx = blockIdx.x;
    const int vcu = (G % 8 == 0) ? (bx % 8) * (G / 8) + bx / 8 : bx;
    const int NGW = G * NWAVES;
    unsigned char* ws = args.ws;
    const float* x = args.in[0]; const float* mem = args.in[1]; const float* mix_g = args.in[2]; const float* ffn_g = args.in[3]; const float* mem_g = args.in[4]; const float* fin_g = args.in[5];
    const float* hy_short = args.in[9]; const float* f_w1 = args.in[10]; const float* f_b1 = args.in[11]; const float* f_w2 = args.in[12]; const float* f_b2 = args.in[13];
    const float* f_w3 = args.in[14]; const float* f_freq = args.in[15]; const float* hy_skip = args.in[16]; const float* qg = args.in[18]; const float* kg = args.in[19]; const float* router = args.in[20];
    float* H = args.out;
    bf16* U = (bf16*)(ws + WS_U); bf16* PROJ = (bf16*)(ws + WS_PROJ); bf16* CQ = (bf16*)(ws + WS_CQ); bf16* MIX = (bf16*)(ws + WS_MIX); bf16* MIXT = (bf16*)(ws + WS_MIXT);
    float* AFF = (float*)(ws + WS_AFF); int* IDX = (int*)(ws + WS_IDX); float* GATE = (float*)(ws + WS_GATE); int* POS = (int*)(ws + WS_POS);
    bf16* XG = (bf16*)(ws + WS_XG); bf16* HID = (bf16*)(ws + WS_HID); bf16* Y = (bf16*)(ws + WS_Y); bf16* TAPS = (bf16*)(ws + WS_TAPS);
    const bf16* MKV = (const bf16*)(ws + WS_MKV);
    cg::grid_group grid = cg::this_grid();
    volatile LAS unsigned* bst = (volatile LAS unsigned*)(lds + LDS_MISC + 4096);
    if (threadIdx.x < 2) bst[threadIdx.x] = 0u;
    __syncthreads();
    XcdBarrier xbar = xcd_barrier_post((unsigned*)(ws + WS_CTL) + 1024, bst);
    const int lo = args.ph_lo, hi = args.ph_hi;
    const XwIn XW{args.in[21], args.in[22], args.in[23], ws}; const bool xw_sched = (G == 256);
    int ph = 0;
#ifdef TSEL
    unsigned long long tacc_ = 0ull, t0_ = 0ull, t1_ = 0ull; int pk_ = 0;
#endif
#ifdef TSEL
#ifndef TAMP
#define TAMP 10
#endif
#ifndef TBAR
#define TBAR 0
#endif
#define PH_T0(k) pk_ = (k); t0_ = __builtin_amdgcn_s_memrealtime();
#define PH_T1 t1_ = __builtin_amdgcn_s_memrealtime(); if (!TBAR && (pk_ == TSEL || TSEL == 99)) tacc_ += t1_ - t0_;
#define PH_T2 if (TBAR && (pk_ == TSEL || TSEL == 99)) tacc_ += __builtin_amdgcn_s_memrealtime() - t1_;
#else
#define PH_T0(k)
#define PH_T1
#define PH_T2
#endif
#define PHASE_BEGINK(k) PH_T0(k) if (lo <= ph && ph < hi) { const int tid = opaque_tid(), lane = tid & 63, wave = __builtin_amdgcn_readfirstlane(tid >> 6), gw = vcu * NWAVES + wave; (void)lane; (void)gw;
#ifdef EXTRA_XBAR
#define PHASE_END   if (ph + 1 < hi) { if (ph == lo) grid.sync(); else { xcd_barrier(xbar); if (ph < EXTRA_XBAR) xcd_barrier(xbar); } } } ++ph;
#else
#define PHASE_END   PH_T1 if (ph + 1 < hi) { if (ph == lo) grid.sync(); else xcd_barrier(xbar); } PH_T2 } ++ph;
#endif

    PHASE_BEGINK(0)
        ProIn P{args.in[8], args.in[17], args.in[7], args.in[6]};
        REP(0) { phase_weights(P, ws, lds, gw, NGW, wave, lane); phase_xw_p0(XW, xw_sched, (LAS float*)(lds + wave * 16384), gw, NGW, lane); }
        phase_wrg(ffn_g, router, (float*)(ws + WS_WRG), (int)(bx * NTHREADS + tid), (int)(G * NTHREADS));
        REP(1) phase_mem_h2(mem, mem_g, f_w1, f_b1, f_w2, f_b2, f_freq, ws, gw, NGW, lane);
        REP(3) phase_norm<false, false>(x, nullptr, mix_g, U, nullptr, nullptr, nullptr, gw, NGW, lane);
    PHASE_END

#pragma unroll 1
    for (int i = 0; i < DEPTH; ++i) {
        const bool hy = (i & 1) == 0; const int j = i >> 1;
        if (i > 0) {
        PHASE_BEGINK(1)
            phase_norm<true, false>(H, H, mix_g + i * DM, U, nullptr, POS, Y, gw, NGW, lane);
        PHASE_END
        }
        PHASE_BEGINK(2)
            if (i == 0) {
                pg8::Gemm g{(const bf16*)(ws + WS_MEMN), (const bf16*)(ws + WS_WMKV), BATCH * MEM_LEN, 2048, DM, 1 << 30, 1, 0};
                pg8::StaticOrder S; S.init(BATCH * MEM_LEN, 2048, G, bx);
                pg8::EpiRowBf16 E{(bf16*)(ws + WS_MKV), 2048, -1, 1.f};
                pg8::gemm_phase<pg8::EpiRowBf16, pg8::StaticOrder, true, true>(lds, g, S, E);
            }
            if (hy) {
                REP(4) phase_taps((const float*)(ws + WS_H2) + (size_t)j * SEQ * HY_FILT, f_w3 + (size_t)j * HY_FILT * FCOLS, TAPS, gw, NGW, lane);
                pg8::Gemm g{U, (const bf16*)(ws + WS_WHY) + (size_t)j * D_IN_HY * DM, M_TOK, D_IN_HY, DM, 1 << 30, 1, 0};
                pg8::StaticOrder S; S.init(M_TOK, D_IN_HY, G, bx);
                pg8::EpiHyIn E{PROJ, M_TOK, 9, CQ, ATT_C2};
                REP(5) pg8::gemm_phase<pg8::EpiHyIn, pg8::StaticOrder, true, true>(lds, g, S, E);
            } else {
                pg8::Gemm g{U, (const bf16*)(ws + WS_WAT) + (size_t)j * D_IN_AT * DM, M_TOK, D_IN_AT, DM, 1 << 30, 1, 0};
                pg8::StaticOrder S; S.init(M_TOK, D_IN_AT, G, bx);
                pg8::EpiAtIn E{PROJ, D_IN_AT, qg + j * HD, kg + j * HD, ATT_C2, NORM_EPS, SEQ - 1};
                REP(6) pg8::gemm_phase<pg8::EpiAtIn, pg8::StaticOrder, true, true>(lds, g, S, E);
            }
            if (xw_sched && bx >= 128) xw_slice_a(XW, i, (LAS float*)(lds + wave * 16384), bx, wave, lane);
        PHASE_END
        PHASE_BEGINK(3)
            if (hy) {
                REP(8) phase_hyena_conv(PROJ, TAPS, hy_short + (size_t)j * 3 * 2304, hy_skip + (size_t)j * 2 * D_MAIN, (f32x2*)(ws + WS_FFTX), MIXT, lds, bx, G, tid, lane, wave);
                REP(9) for (int u = vcu; u < 256; u += G) { const int b = u >> 7, h4 = (u >> 5) & 3, qb = u & 31; const size_t row = (size_t)b * SEQ + qb * 256;
                    run_attn<256, 2048>(CQ + row * 256 + h4 * HD, MKV + (size_t)b * MEM_LEN * 2048 + i * 512 + h4 * HD, MKV + (size_t)b * MEM_LEN * 2048 + i * 512 + 256 + h4 * HD,
                                        MIX + row * DM + D_MAIN + h4 * HD, MEM_LEN / 64, (char*)lds_raw); }
            } else {
                REP(10) for (int u = vcu; u < 768; u += G) { const int bk = (u & 255) >> 5, qb = u & 31, hs = u >> 8, b = bk >> 2, kvh = bk & 3, h = kvh * 3 + hs; const size_t row = (size_t)b * SEQ + qb * 256;
                    run_attn<D_IN_AT, D_IN_AT>(PROJ + row * D_IN_AT + h * HD, PROJ + (size_t)b * SEQ * D_IN_AT + D_MAIN + kvh * HD, PROJ + (size_t)b * SEQ * D_IN_AT + D_MAIN + 256 + kvh * HD,
                                               MIX + row * DM + h * HD, SEQ / 64, (char*)lds_raw); }
                REP(9) for (int u = vcu; u < 256; u += G) { const int b = u >> 7, h4 = (u >> 5) & 3, qb = u & 31; const size_t row = (size_t)b * SEQ + qb * 256;
                    run_attn<D_IN_AT, 2048>(PROJ + row * D_IN_AT + 1280 + h4 * HD, MKV + (size_t)b * MEM_LEN * 2048 + i * 512 + h4 * HD, MKV + (size_t)b * MEM_LEN * 2048 + i * 512 + 256 + h4 * HD,
                                            MIX + row * DM + D_MAIN + h4 * HD, MEM_LEN / 64, (char*)lds_raw); }
            }
        PHASE_END
        if (hy) {
            PHASE_BEGINK(4)
                REP(11) phase_transpose_mix(MIXT, MIX, bx, G, tid);
            PHASE_END
        }
        PHASE_BEGINK(5)
            pg8::Gemm g{MIX, (const bf16*)(ws + WS_WOUT) + (size_t)i * DM * DM, M_TOK, DM, DM, 1 << 30, 1, 0};
            pg8::StaticOrder S; S.init(M_TOK, DM, G, bx);
            pg8::EpiOutX E{i == 0 ? x : (const float*)H, H, DM, ffn_g + i * DM, (const float*)(ws + WS_WRG) + (size_t)i * NEXP * DM, (unsigned char*)U, (float*)(ws + WS_PART), (float*)(ws + WS_PSS), M_TOK};
            pg8::gemm_phase<pg8::EpiOutX, pg8::StaticOrder, true, true>(lds, g, S, E);
        PHASE_END
        PHASE_BEGINK(6)
            REP(13) phase_router_sum((const float*)(ws + WS_PART), (const float*)(ws + WS_PSS), (float*)(ws + WS_RSTD), AFF, gw, NGW, lane);
        PHASE_END
        PHASE_BEGINK(7)
            REP(14) phase_topk(AFF, (const float*)(ws + WS_RSTD), (float*)(ws + WS_RS), IDX, GATE, POS, lds + LDS_MISC, bx, G, tid, lane, wave);
            if (xw_sched && bx >= 32) xw_slice_b(XW, i, (LAS float*)(lds + wave * 16384), bx, wave, lane);
        PHASE_END
        PHASE_BEGINK(8)
            pg8::Gemm g{U, (const bf16*)(ws + WS_W1 + (size_t)i * NEXP * 1536 * DM), XROWS, 1536, DM / 2, 4, NEXP, (size_t)1536 * DM};
            pg8::StaticOrder S; S.init(XROWS, 1536, G, bx);
            pg8::EpiSwiGLU8 E{(unsigned char*)HID, EFF, 1.0f / W8_SCALE, (const float*)(ws + WS_RS)};
            REP(16) pg8::gemm_phase<pg8::EpiSwiGLU8, pg8::StaticOrder, true, true, true, true>(lds, g, S, E, IDX);
        PHASE_END
        PHASE_BEGINK(9)
            pg8::Gemm g{HID, (const bf16*)(ws + WS_W2 + (size_t)i * NEXP * DM * EFF), XROWS, DM, EFF / 2, 4, NEXP, (size_t)DM * EFF};
            pg8::StaticOrder S; S.init(XROWS, DM, G, bx);
            pg8::EpiDown E{Y, DM, GATE, 1.0f / W8_SCALE};
            REP(17) pg8::gemm_phase<pg8::EpiDown, pg8::StaticOrder, true, true, false, true>(lds, g, S, E);
        PHASE_END
    }
    PHASE_BEGINK(10)
        phase_norm<true, true>(H, nullptr, fin_g, nullptr, args.out, POS, Y, gw, NGW, lane);
    PHASE_END
#ifdef TSEL
    if (bx == 0 && threadIdx.x == 0 && hi - lo > 1) { const unsigned long long te_ = __builtin_amdgcn_s_memrealtime(); while (__builtin_amdgcn_s_memrealtime() - te_ < (unsigned long long)TAMP * tacc_) __builtin_amdgcn_s_sleep(8); }
#endif
#undef PHASE_BEGINK
#undef PHASE_END
}

extern "C" void kernel_launch(void* const* d_in, const int* in_sizes, int n_in, void* d_out, int out_size, void* d_ws, size_t ws_size, hipStream_t stream) {
    static int grid = 0;
    if (grid == 0) {
        if (n_in != 24 || out_size != M_TOK * DM || ws_size < WS_END) { fprintf(stderr, "kernel_launch: unexpected shapes (n_in %d out %d ws %zu need %zu)\n", n_in, out_size, ws_size, (size_t)WS_END); grid = -1; return; }
        int dev = 0, cus = 0, per_cu = 0;
        if (hipGetDevice(&dev) != hipSuccess || hipDeviceGetAttribute(&cus, hipDeviceAttributeMultiprocessorCount, dev) != hipSuccess) { grid = -1; return; }
        if (hipFuncSetAttribute((const void*)hybrid_fwd, hipFuncAttributeMaxDynamicSharedMemorySize, LDS_BYTES) != hipSuccess) { fprintf(stderr, "kernel_launch: hipFuncSetAttribute failed\n"); grid = -1; return; }
        if (hipOccupancyMaxActiveBlocksPerMultiprocessor(&per_cu, (const void*)hybrid_fwd, NTHREADS, LDS_BYTES) != hipSuccess || per_cu < 1) { fprintf(stderr, "kernel_launch: occupancy query says %d blocks/CU\n", per_cu); per_cu = 1; }
        (void)hipGetLastError();
        grid = cus;
    }
    if (grid < 0) return;
    if (hipMemsetAsync((char*)d_ws + WS_CTL, 0, 64 * 1024, stream) != hipSuccess) { fprintf(stderr, "kernel_launch: memset failed\n"); return; }
    Args a{};
    for (int i = 0; i < 24; ++i) a.in[i] = (const float*)d_in[i];
    a.out = (float*)d_out; a.ws = (unsigned char*)d_ws;
#if MK_PER_PHASE
    for (int li = 0; li < N_PHASES; ++li) {
        a.ph_lo = li; a.ph_hi = li + 1;
        void* kargs[] = {&a};
        hipError_t e = hipLaunchCooperativeKernel((const void*)hybrid_fwd, dim3(grid), dim3(NTHREADS), kargs, LDS_BYTES, stream);
        if (e != hipSuccess) { fprintf(stderr, "kernel_launch: launch %d failed: %s\n", li, hipGetErrorString(e)); break; }
    }
#else
    a.ph_lo = 0; a.ph_hi = N_PHASES;
    void* kargs[] = {&a};
    hipError_t e = hipLaunchCooperativeKernel((const void*)hybrid_fwd, dim3(grid), dim3(NTHREADS), kargs, LDS_BYTES, stream);
    if (e != hipSuccess) fprintf(stderr, "kernel_launch: cooperative launch failed: %s (grid %d)\n", hipGetErrorString(e), grid);
#endif
}
```

```cpp
#include <hip/hip_runtime.h>
#include <hip/hip_cooperative_groups.h>
#include <hip/hip_bf16.h>
#include <cmath>
#include <cstdio>
#include <cstdint>
namespace cg = cooperative_groups;

constexpr int BATCH = 2, SEQ = 8192, DM = 1024, DEPTH = 4, M_TOK = BATCH * SEQ;
constexpr int HD = 64, MEM_LEN = 256, D_MEM = 256, D_MAIN = 768, NQH = 12, NKVH = 4;
constexpr int D_IN_HY = 2560, D_IN_AT = 1536;
constexpr int NEXP = 16, CAP = 1024, EFF = 768, NGRP = BATCH * NEXP, XROWS = NGRP * CAP;
constexpr int HY_EMB = 33, HY_FILT = 64, FCOLS = 4 * D_MAIN;
constexpr float NORM_EPS = 1e-6f;
constexpr float W8_SCALE = 32.0f;
constexpr float ATT_C2 = 0.125f * 1.4426950408889634f;

constexpr size_t MiB = 1u << 20;
constexpr size_t WS_CTL = 0;
constexpr size_t WS_WHY = 2 * MiB;
constexpr size_t WS_WAT = 12 * MiB;
constexpr size_t WS_WOUT = 18 * MiB;
constexpr size_t WS_WMKV = 26 * MiB;
constexpr size_t WS_W1 = 32 * MiB;
constexpr size_t WS_W2 = 224 * MiB;
constexpr size_t WS_U = 320 * MiB;
constexpr size_t WS_PROJ = 352 * MiB;
constexpr size_t WS_CQ = WS_PROJ + 72 * MiB;
constexpr size_t WS_MIX = 432 * MiB;
constexpr size_t WS_MIXT = 464 * MiB;
constexpr size_t WS_AFF = 488 * MiB;
constexpr size_t WS_IDX = 489 * MiB;
constexpr size_t WS_GATE = WS_IDX + 128 * 1024;
constexpr size_t WS_POS = 490 * MiB;
constexpr size_t WS_XG = 492 * MiB;
constexpr size_t WS_HID = 556 * MiB;
constexpr size_t WS_TAPS = WS_XG;
constexpr size_t WS_Y = 604 * MiB;
constexpr size_t WS_FFTX = WS_Y;
constexpr size_t WS_H2 = 668 * MiB;
constexpr size_t WS_MEMN = 672 * MiB;
constexpr size_t WS_MKV = 673 * MiB;
constexpr size_t WS_PART = 676 * MiB;
constexpr size_t WS_PSS = 692 * MiB;
constexpr size_t WS_RSTD = 697 * MiB;
constexpr size_t WS_RS = WS_RSTD + 128 * 1024;
constexpr size_t WS_WRG = 698 * MiB;
constexpr size_t WS_END = 699 * MiB;

constexpr int LDS_RING = 0;
constexpr int LDS_MISC = 132 * 1024;
constexpr int LDS_BYTES = 140 * 1024;
constexpr int NTHREADS = 512, NWAVES = 8;

#define GAS __attribute__((address_space(1)))
#define LAS __attribute__((address_space(3)))
typedef unsigned short bf16;
typedef unsigned v4u __attribute__((ext_vector_type(4)));
typedef unsigned v2u __attribute__((ext_vector_type(2)));
typedef float f32x4 __attribute__((ext_vector_type(4)));
typedef float f32x2 __attribute__((ext_vector_type(2)));
__device__ __forceinline__ unsigned f2bf(float f) { unsigned u = __builtin_bit_cast(unsigned, f); return (u + 0x7fffu + ((u >> 16) & 1u)) >> 16; }
__device__ __forceinline__ unsigned pk2(float lo, float hi) { return f2bf(lo) | (f2bf(hi) << 16); }
__device__ __forceinline__ float bf2f(unsigned short h) { return __builtin_bit_cast(float, (unsigned)h << 16); }
__device__ __forceinline__ float bflo(unsigned w) { return __builtin_bit_cast(float, w << 16); }
__device__ __forceinline__ float bfhi(unsigned w) { return __builtin_bit_cast(float, w & 0xffff0000u); }
__device__ __forceinline__ float wave_sum(float v) {
#pragma unroll
    for (int o = 1; o < 64; o <<= 1) v += __shfl_xor(v, o);
    return v;
}
__device__ __forceinline__ int opaque_tid() { int t = threadIdx.x; asm volatile("" : "+v"(t)); return t; }
#define MK_PER_PHASE 0

#define XB_TMO      128
#define XB_XCNT(j)  (256  + 64 * (j))
#define XB_XSUB(j)  (1280 + 64 * (j))
#define XB_XGEN(j)  (2304 + 64 * (j))
#define XB_TOP      3328
#define XB_TOPGEN   3392
#define XCD_BAR_WORDS 3456
#define XB_SPIN_CAP (1u << 18)

__device__ __forceinline__ unsigned xb_ld(unsigned* p)              { return __hip_atomic_load(p, __ATOMIC_RELAXED, __HIP_MEMORY_SCOPE_AGENT); }
__device__ __forceinline__ unsigned xb_add(unsigned* p, unsigned v) { return __hip_atomic_fetch_add(p, v, __ATOMIC_RELAXED, __HIP_MEMORY_SCOPE_AGENT); }
__device__ __forceinline__ unsigned xb_xcc_id() { return (unsigned)__builtin_amdgcn_s_getreg((3 << 11) | 20) & 0xFu; }
#define XB_SPIN(cond, bar) do { unsigned _sp = 0; while (cond) { __builtin_amdgcn_s_sleep(1); \
    if ((++_sp & 255u) == 0u) { if (xb_ld(&(bar)[XB_TMO])) break; if (_sp > XB_SPIN_CAP) { atomicAdd(&(bar)[XB_TMO], 1u); break; } } } } while (0)

struct XcdBarrier {
    unsigned* bar; unsigned x;
    volatile LAS unsigned* st;
};

__device__ __forceinline__ XcdBarrier xcd_barrier_post(unsigned* bar, volatile LAS unsigned* st) {
    XcdBarrier b; b.bar = bar; b.x = xb_xcc_id(); b.st = st;
    if (threadIdx.x == 0) (void)xb_add(&bar[XB_XCNT(b.x)], 1u);
    return b;
}
__device__ __forceinline__ void xcd_barrier_complete(unsigned* bar, unsigned x, unsigned& nloc, unsigned& nx) {
    const unsigned G = gridDim.x * gridDim.y * gridDim.z;
    unsigned sum, cnt, mine, sp = 0u;
    for (;;) {
        sum = 0u; cnt = 0u; mine = 0u;
#pragma unroll
        for (unsigned j = 0; j < 16; ++j) { const unsigned c = xb_ld(&bar[XB_XCNT(j)]); sum += c; cnt += (c > 0u) ? 1u : 0u; mine = (j == x) ? c : mine; }
        if (sum == G) break;
        __builtin_amdgcn_s_sleep(1);
        if ((++sp & 255u) == 0u) { if (xb_ld(&bar[XB_TMO])) break; if (sp > XB_SPIN_CAP) { atomicAdd(&bar[XB_TMO], 1u); break; } }
    }
    nloc = mine > 0u ? mine : 1u; nx = cnt > 0u ? cnt : 1u;
}

__device__ __forceinline__ void xcd_barrier(const XcdBarrier& b) {
    asm volatile("s_waitcnt vmcnt(0)" ::: "memory");
    __syncthreads();
    if (threadIdx.x == 0) {
        unsigned* bar = b.bar;
        __builtin_amdgcn_s_waitcnt(0);
        unsigned nloc = b.st[0], nx = b.st[1];
        if (nloc == 0u) { xcd_barrier_complete(bar, b.x, nloc, nx); b.st[0] = nloc; b.st[1] = nx; }
        const unsigned old = xb_add(&bar[XB_XSUB(b.x)], 1u);
        const unsigned gen = old / nloc;
        if (old + 1u == (gen + 1u) * nloc) {
            __builtin_amdgcn_fence(__ATOMIC_RELEASE, "agent");
            asm volatile("s_waitcnt vmcnt(0)" ::: "memory");
            const unsigned og = xb_add(&bar[XB_TOP], 1u);
            const unsigned tg = og / nx;
            if (og + 1u == (tg + 1u) * nx) xb_add(&bar[XB_TOPGEN], 1u);
            else XB_SPIN(xb_ld(&bar[XB_TOPGEN]) == tg, bar);
            __builtin_amdgcn_fence(__ATOMIC_ACQUIRE, "agent");
            xb_add(&bar[XB_XGEN(b.x)], 1u);
            asm volatile("s_waitcnt vmcnt(0)" ::: "memory");
        } else {
            XB_SPIN(xb_ld(&bar[XB_XGEN(b.x)]) == gen, bar);
            __builtin_amdgcn_fence(__ATOMIC_ACQUIRE, "agent");
            asm volatile("s_waitcnt vmcnt(0)" ::: "memory");
        }
    }
    __syncthreads();
}
namespace pg8 {
#define PG8_LAS __attribute__((address_space(3)))
typedef unsigned short bf16_t;
typedef short bf16x8 __attribute__((ext_vector_type(8)));
typedef float f32x4 __attribute__((ext_vector_type(4)));
typedef unsigned u32x4 __attribute__((ext_vector_type(4)));
constexpr int BM = 256, BK = 64, HALF = 128, HTB = HALF * BK * 2  , STAGE_BYTES = 8 * HTB, NXCD = 8, WGM = 8;

__host__ __device__ __forceinline__ int lds_byte(int r, int c) { const int st = (r >> 4) * 2 + (c >> 5), rr = r & 15, cc = c & 31, ob = rr * 64 + cc * 2; return st * 1024 + (ob ^ (((ob >> 9) & 1) << 5)); }
__host__ __device__ __forceinline__ void stage_rc(int b, int& R, int& C) { const int st = b / 1024, sb = b % 1024, swz = sb ^ (((sb >> 9) & 1) << 5); R = (st >> 1) * 16 + swz / 64; C = (st & 1) * 32 + (swz % 64) / 2; }
__host__ __device__ __forceinline__ int perm32(int rho) { const int n = rho >> 4, i = rho & 15; return 8 * (i >> 2) + 4 * n + (i & 3); }

struct Unit { int pm, pn; };
struct Gemm { const bf16_t* A; const bf16_t* Bt; int M, N, K; int gdiv, gmod; size_t gstride; };

struct StaticOrder {
    int nM, nN, nwg, G, c;
    __host__ __device__ void init(int M, int N, int G_, int c_) { nM = M / BM; nN = N / BM; nwg = nM * nN; G = G_; c = c_; }
    __host__ __device__ bool next(int i, Unit& u) const {
        const long L = (long)i * G + c; if (L >= nwg) return false;
        int wgid = (int)L; { const int q = nwg / NXCD, r = nwg % NXCD, xcd = wgid % NXCD, off = wgid / NXCD; wgid = (xcd < r ? xcd * (q + 1) : r * (q + 1) + (xcd - r) * q) + off; }
        const int nig = WGM * nN, gid = wgid / nig, fm = gid * WGM, gsz = (nM - fm) < WGM ? (nM - fm) : WGM;
        u.pm = fm + ((wgid % nig) % gsz); u.pn = (wgid % nig) / gsz; return true;
    }
    __device__ __forceinline__ void a_ready(const Unit&) const {}
    __device__ __forceinline__ void done(const Unit&) const {}
};


__device__ __forceinline__ unsigned cvt_pk_bf16(float lo, float hi) { unsigned r; asm volatile("v_cvt_pk_bf16_f32 %0, %1, %2" : "=v"(r) : "v"(lo), "v"(hi)); return r; }
typedef unsigned u32x2 __attribute__((ext_vector_type(2)));
struct EpiRowBf16 {
    static constexpr bool PERM = false, AFTER_DRAIN = false;
    bf16_t* O; int ldc; int sc_pn; float sc;
    __device__ __forceinline__ void operator()(const f32x4 (&acc)[2][2][4][2], const Unit& u, int wr, int wc, int fr, int fq) const {
        const float s = (u.pn == sc_pn) ? sc : 1.f;
        const int row0 = u.pm * BM + wr * 64 + fr, col0 = u.pn * BM + wc * 32 + 4 * fq;
#pragma unroll
        for (int ai = 0; ai < 2; ++ai)
#pragma unroll
            for (int m = 0; m < 4; ++m) { bf16_t* rowp = O + (size_t)(row0 + ai * HALF + m * 16) * ldc + col0;
#pragma unroll
                for (int bj = 0; bj < 2; ++bj)
#pragma unroll
                    for (int n = 0; n < 2; ++n) { const f32x4 v = acc[ai][bj][m][n] * s; u32x2 w; w.x = cvt_pk_bf16(v[0], v[1]); w.y = cvt_pk_bf16(v[2], v[3]);
                        *(u32x2*)(rowp + bj * HALF + n * 16) = w; } }
    }
};
struct EpiHyIn {
    static constexpr bool PERM = false, AFTER_DRAIN = false;
    bf16_t* OT; int ldt; int tp_tiles; bf16_t* CQ; float sc;
    __device__ __forceinline__ void operator()(const f32x4 (&acc)[2][2][4][2], const Unit& u, int wr, int wc, int fr, int fq) const {
        const int row0 = u.pm * BM + wr * 64 + fr;
        if (u.pn < tp_tiles) {
            const int col0 = u.pn * BM + wc * 32 + 4 * fq;
#pragma unroll
            for (int ai = 0; ai < 2; ++ai)
#pragma unroll
                for (int m = 0; m < 4; ++m) { const int row = row0 + ai * HALF + m * 16;
#pragma unroll
                    for (int bj = 0; bj < 2; ++bj)
#pragma unroll
                        for (int n = 0; n < 2; ++n) { const f32x4 v = acc[ai][bj][m][n]; const unsigned w0 = cvt_pk_bf16(v[0], v[1]), w1 = cvt_pk_bf16(v[2], v[3]);
                            bf16_t* p = OT + (size_t)(col0 + bj * HALF + n * 16) * ldt + row;
                            p[0] = (bf16_t)(w0 & 0xffffu); p[(size_t)ldt] = (bf16_t)(w0 >> 16); p[(size_t)2 * ldt] = (bf16_t)(w1 & 0xffffu); p[(size_t)3 * ldt] = (bf16_t)(w1 >> 16); } }
        } else {
            const int col0 = wc * 32 + 4 * fq;
#pragma unroll
            for (int ai = 0; ai < 2; ++ai)
#pragma unroll
                for (int m = 0; m < 4; ++m) { bf16_t* rowp = CQ + (size_t)(row0 + ai * HALF + m * 16) * 256 + col0;
#pragma unroll
                    for (int bj = 0; bj < 2; ++bj)
#pragma unroll
                        for (int n = 0; n < 2; ++n) { const f32x4 v = acc[ai][bj][m][n] * sc; u32x2 w; w.x = cvt_pk_bf16(v[0], v[1]); w.y = cvt_pk_bf16(v[2], v[3]);
                            *(u32x2*)(rowp + bj * HALF + n * 16) = w; } }
        }
    }
};
struct EpiAtIn {
    static constexpr bool PERM = false, AFTER_DRAIN = false;
    bf16_t* O; int ldc; const float* gq; const float* gk; float csc; float eps; int seq_mask;
    __device__ __forceinline__ void operator()(const f32x4 (&acc)[2][2][4][2], const Unit& u, int wr, int wc, int fr, int fq) const {
        const int row0 = u.pm * BM + wr * 64 + fr, colb = u.pn * BM + wc * 64 + 4 * fq;
        if (u.pn <= 3) {
            const float* gp = (u.pn == 3 ? gk : gq) + 4 * fq; const float osc = (u.pn == 3) ? 1.f : csc;
            float invr[4];
#pragma unroll
            for (int q = 0; q < 4; ++q) invr[q] = exp2f(-(float)(4 * fq + q) * (13.287712379549449f / 16.0f)) * 0.15915494309189535f;
#pragma unroll
            for (int ai = 0; ai < 2; ++ai)
#pragma unroll
                for (int m = 0; m < 4; ++m) {
                    const int row = row0 + ai * HALF + m * 16; int t = row & seq_mask; asm volatile("" : "+v"(t));
                    float ss = 0.f;
#pragma unroll
                    for (int bj = 0; bj < 2; ++bj)
#pragma unroll
                        for (int n = 0; n < 2; ++n) { const f32x4 x = acc[ai][bj][m][n]; ss += (x[0] * x[0] + x[1] * x[1]) + (x[2] * x[2] + x[3] * x[3]); }
                    ss += __shfl_xor(ss, 16); ss += __shfl_xor(ss, 32);
                    const float rs = osc * __builtin_amdgcn_rsqf(ss * (1.0f / 64.0f) + eps);
                    bf16_t* rowp = O + (size_t)row * ldc + colb;
#pragma unroll
                    for (int bj = 0; bj < 2; ++bj) {
                        const float pos = (float)(bj == 0 ? (t >> 6) : (t & 63));
                        const f32x4 xa = acc[ai][bj][m][0] * rs * *(const f32x4*)(gp + 32 * bj), xb = acc[ai][bj][m][1] * rs * *(const f32x4*)(gp + 32 * bj + 16);
                        f32x4 oa, ob;
#pragma unroll
                        for (int q = 0; q < 4; ++q) { const float rev = pos * invr[q]; const float c = __builtin_amdgcn_cosf(rev), s = __builtin_amdgcn_sinf(rev);
                            oa[q] = xa[q] * c - xb[q] * s; ob[q] = xa[q] * s + xb[q] * c; }
                        u32x2 w; w.x = cvt_pk_bf16(oa[0], oa[1]); w.y = cvt_pk_bf16(oa[2], oa[3]); *(u32x2*)(rowp + 32 * bj) = w;
                        w.x = cvt_pk_bf16(ob[0], ob[1]); w.y = cvt_pk_bf16(ob[2], ob[3]); *(u32x2*)(rowp + 32 * bj + 16) = w;
                    }
                    asm volatile("" ::: "memory");
                }
        } else {
            const float s = (u.pn == 5) ? csc : 1.f;
#pragma unroll
            for (int ai = 0; ai < 2; ++ai)
#pragma unroll
                for (int m = 0; m < 4; ++m) { bf16_t* rowp = O + (size_t)(row0 + ai * HALF + m * 16) * ldc + colb;
#pragma unroll
                    for (int bj = 0; bj < 2; ++bj)
#pragma unroll
                        for (int n = 0; n < 2; ++n) { const f32x4 v = acc[ai][bj][m][n] * s; u32x2 w; w.x = cvt_pk_bf16(v[0], v[1]); w.y = cvt_pk_bf16(v[2], v[3]);
                            *(u32x2*)(rowp + 32 * bj + 16 * n) = w; } }
        }
    }
};
struct EpiResF32 {
    static constexpr bool PERM = false, AFTER_DRAIN = false;
    const float* res; float* out; int ldc;
    __device__ __forceinline__ void operator()(const f32x4 (&acc)[2][2][4][2], const Unit& u, int wr, int wc, int fr, int fq) const {
        const int row0 = u.pm * BM + wr * 64 + fr, col0 = u.pn * BM + wc * 32 + 4 * fq;
#pragma unroll
        for (int ai = 0; ai < 2; ++ai)
#pragma unroll
            for (int m = 0; m < 4; ++m) { const size_t off = (size_t)(row0 + ai * HALF + m * 16) * ldc + col0;
#pragma unroll
                for (int bj = 0; bj < 2; ++bj)
#pragma unroll
                    for (int n = 0; n < 2; ++n) { const f32x4 r = *(const f32x4*)(res + off + bj * HALF + n * 16); *(f32x4*)(out + off + bj * HALF + n * 16) = r + acc[ai][bj][m][n]; } }
    }
};
__device__ __forceinline__ unsigned pk4_fp8_sat(const f32x4 x) {
    unsigned w = 0;
    w = __builtin_amdgcn_cvt_pk_fp8_f32(__builtin_amdgcn_fmed3f(x[0], -448.f, 448.f), __builtin_amdgcn_fmed3f(x[1], -448.f, 448.f), w, false);
    w = __builtin_amdgcn_cvt_pk_fp8_f32(__builtin_amdgcn_fmed3f(x[2], -448.f, 448.f), __builtin_amdgcn_fmed3f(x[3], -448.f, 448.f), w, true);
    return w;
}
struct EpiOutX {
    static constexpr bool PERM = true, AFTER_DRAIN = false;
    const float* res; float* out; int ldc; const float* gain; const float* WrG; unsigned char* XN8; float* PLG; float* PSS; int M;
    static __device__ __forceinline__ void split8(const f32x4 a, const f32x4 b, bf16x8& hi, bf16x8& lo) {
        u32x4 h, l; float r[8] = {a[0], a[1], a[2], a[3], b[0], b[1], b[2], b[3]};
#pragma unroll
        for (int k = 0; k < 4; ++k) { const unsigned p = cvt_pk_bf16(r[2 * k], r[2 * k + 1]); h[k] = p;
            const float d0 = r[2 * k] - __builtin_bit_cast(float, p << 16), d1 = r[2 * k + 1] - __builtin_bit_cast(float, p & 0xffff0000u); l[k] = cvt_pk_bf16(d0, d1); }
        hi = __builtin_bit_cast(bf16x8, h); lo = __builtin_bit_cast(bf16x8, l);
    }
    __device__ __forceinline__ void operator()(f32x4 (&acc)[2][2][4][2], const Unit& u, int wr, int wc, int fr, int fq) const {
        const int row0 = u.pm * BM + wr * 64 + fr, col0 = u.pn * BM + wc * 32 + 8 * fq, slot = u.pn * 4 + wc;
        bf16x8 whi[2], wlo[2];
#pragma unroll
        for (int bj = 0; bj < 2; ++bj) { const float* wp = WrG + (size_t)fr * ldc + col0 + bj * HALF; split8(*(const f32x4*)wp, *(const f32x4*)(wp + 4), whi[bj], wlo[bj]); }
        f32x4 rcur[4], rnxt[4];
#pragma unroll
        for (int q = 0; q < 4; ++q) rcur[q] = *(const f32x4*)(res + (size_t)row0 * ldc + col0 + (q >> 1) * HALF + (q & 1) * 4);
#pragma unroll
        for (int idx = 0; idx < 8; ++idx) { const int ai = idx >> 2, m = idx & 3;
            const int row = row0 + ai * HALF + m * 16; const size_t off = (size_t)row * ldc + col0; float ss = 0.f; f32x4 lg = (f32x4){0.f, 0.f, 0.f, 0.f}; u32x4 xw;
            if (idx < 7) { const int rown = row0 + ((idx + 1) >> 2) * HALF + ((idx + 1) & 3) * 16;
#pragma unroll
                for (int q = 0; q < 4; ++q) rnxt[q] = *(const f32x4*)(res + (size_t)rown * ldc + col0 + (q >> 1) * HALF + (q & 1) * 4); }
#pragma unroll
            for (int bj = 0; bj < 2; ++bj) {
#pragma unroll
                for (int n = 0; n < 2; ++n) { const int co = bj * HALF + n * 4;
                    const f32x4 h = rcur[bj * 2 + n] + acc[ai][bj][m][n]; acc[ai][bj][m][n] = h; *(f32x4*)(out + off + co) = h;
                    ss += (h[0] * h[0] + h[1] * h[1]) + (h[2] * h[2] + h[3] * h[3]);
                    const f32x4 x = h * *(const f32x4*)(gain + col0 + co);
                    xw[bj * 2 + n] = pk4_fp8_sat(x); }
                bf16x8 hhi, hlo; split8(acc[ai][bj][m][0], acc[ai][bj][m][1], hhi, hlo);
                lg = __builtin_amdgcn_mfma_f32_16x16x32_bf16(wlo[bj], hhi, lg, 0, 0, 0);
                lg = __builtin_amdgcn_mfma_f32_16x16x32_bf16(whi[bj], hlo, lg, 0, 0, 0);
                lg = __builtin_amdgcn_mfma_f32_16x16x32_bf16(whi[bj], hhi, lg, 0, 0, 0); }
            *(u32x4*)(XN8 + (size_t)row * ldc + u.pn * BM + wc * 64 + fq * 16) = xw;
            ss += __shfl_xor(ss, 16); ss += __shfl_xor(ss, 32);
            if (fq == 0) PSS[(size_t)slot * M + row] = ss;
            *(f32x4*)(PLG + ((size_t)slot * M + row) * 16 + 4 * fq) = lg;
#pragma unroll
            for (int q = 0; q < 4; ++q) rcur[q] = rnxt[q];
            asm volatile("" ::: "memory"); }
    }
};
struct EpiSwiGLU {
    static constexpr bool PERM = false, AFTER_DRAIN = false;
    bf16_t* O; int ldc;
    __device__ __forceinline__ void operator()(const f32x4 (&acc)[2][2][4][2], const Unit& u, int wr, int wc, int fr, int fq) const {
        const int row0 = u.pm * BM + wr * 64 + fr, col0 = u.pn * HALF + wc * 32 + 4 * fq;
#pragma unroll
        for (int ai = 0; ai < 2; ++ai)
#pragma unroll
            for (int m = 0; m < 4; ++m) { bf16_t* rowp = O + (size_t)(row0 + ai * HALF + m * 16) * ldc + col0;
#pragma unroll
                for (int n = 0; n < 2; ++n) { const f32x4 g = acc[ai][0][m][n], up = acc[ai][1][m][n]; f32x4 h;
#pragma unroll
                    for (int q = 0; q < 4; ++q) h[q] = g[q] * up[q] * __builtin_amdgcn_rcpf(1.f + __expf(-g[q]));
                    u32x2 w; w.x = cvt_pk_bf16(h[0], h[1]); w.y = cvt_pk_bf16(h[2], h[3]); *(u32x2*)(rowp + n * 16) = w; } }
    }
};
struct EpiSwiGLU8 {
    static constexpr bool PERM = false, AFTER_DRAIN = false;
    unsigned char* O; int ldc; float wsc; const float* rs;
    __device__ __forceinline__ void operator()(const f32x4 (&acc)[2][2][4][2], const Unit& u, int wr, int wc, int fr, int fq) const {
        const int row0 = u.pm * BM + wr * 64 + fr, col0 = u.pn * HALF + wc * 32 + 4 * fq;
#pragma unroll
        for (int ai = 0; ai < 2; ++ai)
#pragma unroll
            for (int m = 0; m < 4; ++m) { const int row = row0 + ai * HALF + m * 16; const float sc = wsc * rs[row]; u32x2 hw;
#pragma unroll
                for (int n = 0; n < 2; ++n) { const f32x4 g = acc[ai][0][m][n] * sc, up = acc[ai][1][m][n] * sc; f32x4 h;
#pragma unroll
                    for (int q = 0; q < 4; ++q) h[q] = g[q] * up[q] * __builtin_amdgcn_rcpf(1.f + __expf(-g[q]));
                    hw[n] = pk4_fp8_sat(h); }
                *(u32x2*)(O + (size_t)row * ldc + u.pn * HALF + wc * 32 + fq * 8) = hw; }
    }
};
struct EpiDown {
    static constexpr bool PERM = true, AFTER_DRAIN = false;
    bf16_t* O; int ldc; const float* gate; float wsc;
    __device__ __forceinline__ void operator()(const f32x4 (&acc)[2][2][4][2], const Unit& u, int wr, int wc, int fr, int fq) const {
        const int row0 = u.pm * BM + wr * 64 + fr, col0 = u.pn * BM + wc * 32 + 8 * fq;
#pragma unroll
        for (int ai = 0; ai < 2; ++ai)
#pragma unroll
            for (int m = 0; m < 4; ++m) { const int row = row0 + ai * HALF + m * 16; const float gs = gate[row] * wsc; bf16_t* rowp = O + (size_t)row * ldc + col0;
#pragma unroll
                for (int bj = 0; bj < 2; ++bj) { const f32x4 v0 = acc[ai][bj][m][0] * gs, v1 = acc[ai][bj][m][1] * gs; u32x4 w;
                    w.x = cvt_pk_bf16(v0[0], v0[1]); w.y = cvt_pk_bf16(v0[2], v0[3]); w.z = cvt_pk_bf16(v1[0], v1[1]); w.w = cvt_pk_bf16(v1[2], v1[3]);
                    *(u32x4*)(rowp + bj * HALF) = w; } }
    }
};
template <class Epi, class Sched, bool ALIGN_EPI = false, bool SP2 = false, bool GATHER = false, bool FP8 = false>
__device__ __forceinline__ void gemm_phase(PG8_LAS unsigned char* lds, const Gemm g, const Sched& S, const Epi& E, const int* gidx = nullptr) {
    const int tid = opaque_tid(), wid = __builtin_amdgcn_readfirstlane(tid >> 6), lane = tid & 63, wr = wid >> 2, wc = wid & 3, fr = lane & 15, fq = lane >> 4;
    const int K = g.K, nt = K / BK;
    unsigned voffA[2], voffB[2];
#pragma unroll
    for (int i = 0; i < 2; ++i) { int R, C; stage_rc(tid * 16 + i * 8192, R, C); const int Rb = Epi::PERM ? ((R & ~31) + perm32(R & 31)) : R;
        voffA[i] = (unsigned)(R * K + C) * 2u; voffB[i] = (unsigned)(Rb * K + C) * 2u; }
    const size_t kstep = (size_t)(BK * 2);
    const size_t hstep = (size_t)HALF * K * 2;
    const size_t tstep = 2 * hstep;
    const unsigned ldsw = (unsigned)wid * 1024u;
    const int aoff = lds_byte(wr * 64 + fr, fq * 8), boff = lds_byte(wc * 32 + fr, fq * 8);
#define PG8_SA(b, h) (((b) * 2 + (h)) * HTB)
#define PG8_SB(b, h) ((4 + (b) * 2 + (h)) * HTB)
#define PG8_STAGE(bufoff, gbase, voff) do { _Pragma("unroll") for (int _i = 0; _i < 2; ++_i) \
        __builtin_amdgcn_global_load_lds((const unsigned*)((const char*)(gbase) + (voff)[_i]), (PG8_LAS unsigned*)(lds + (bufoff) + ldsw + _i * 8192), 16, 0, 0); } while (0)
#define PG8_LDA(dst, b, h) do { _Pragma("unroll") for (int m = 0; m < 4; ++m) { if constexpr (FP8) { const v4i_ lo_ = *(const PG8_LAS v4i_*)(lds + PG8_SA(b, h) + aoff + m * 2048), hi_ = *(const PG8_LAS v4i_*)(lds + PG8_SA(b, h) + aoff + m * 2048 + 1024); \
        dst##8[m] = __builtin_shufflevector(lo_, hi_, 0, 1, 2, 3, 4, 5, 6, 7); } else { _Pragma("unroll") for (int k = 0; k < 2; ++k) dst[m][k] = *(const PG8_LAS bf16x8*)(lds + PG8_SA(b, h) + aoff + m * 2048 + k * 1024); } } } while (0)
#define PG8_LDB(dst, b, h) do { _Pragma("unroll") for (int n = 0; n < 2; ++n) { if constexpr (FP8) { const v4i_ lo_ = *(const PG8_LAS v4i_*)(lds + PG8_SB(b, h) + boff + n * 2048), hi_ = *(const PG8_LAS v4i_*)(lds + PG8_SB(b, h) + boff + n * 2048 + 1024); \
        dst##8[n] = __builtin_shufflevector(lo_, hi_, 0, 1, 2, 3, 4, 5, 6, 7); } else { _Pragma("unroll") for (int k = 0; k < 2; ++k) dst[n][k] = *(const PG8_LAS bf16x8*)(lds + PG8_SB(b, h) + boff + n * 2048 + k * 1024); } } } while (0)
#define PG8_MMA(ai, bj, At, Bt) do { __builtin_amdgcn_s_setprio(1); _Pragma("unroll") for (int m = 0; m < 4; ++m) _Pragma("unroll") for (int n = 0; n < 2; ++n) { \
        if constexpr (FP8) asm volatile("v_mfma_scale_f32_16x16x128_f8f6f4 %0, %1, %2, %0, %3, %3 op_sel_hi:[0,0,0]" : "+v"(acc[ai][bj][m][n]) : "v"(Bt##8[n]), "v"(At##8[m]), "v"(sc127_));   \
        else { _Pragma("unroll") for (int k = 0; k < 2; ++k) acc[ai][bj][m][n] = __builtin_amdgcn_mfma_f32_16x16x32_bf16(Bt[n][k], At[m][k], acc[ai][bj][m][n], 0, 0, 0); } } \
        __builtin_amdgcn_s_setprio(0); } while (0)
#define PG8_WAIT_V(n) asm volatile("s_waitcnt vmcnt(" #n ")" ::: "memory")
#define PG8_WAIT_L(n) asm volatile("s_waitcnt lgkmcnt(" #n ")" ::: "memory")
#define PG8_BAR __builtin_amdgcn_s_barrier()
#define PG8_SCHED __builtin_amdgcn_sched_barrier(0)
    Unit cur, nxt; int ui = 0;
    if (!S.next(0, cur)) return;
    f32x4 acc[2][2][4][2];
#pragma unroll
    for (int a = 0; a < 2; ++a)
#pragma unroll
        for (int b = 0; b < 2; ++b)
#pragma unroll
            for (int m = 0; m < 4; ++m)
#pragma unroll
                for (int n = 0; n < 2; ++n) acc[a][b][m][n] = (f32x4){0.f, 0.f, 0.f, 0.f};
    typedef int v8i_ __attribute__((ext_vector_type(8))); typedef int v4i_ __attribute__((ext_vector_type(4)));
    const int sc127_ = 127;
    bf16x8 At[4][2], B0[2][2], B1[2][2]; v8i_ At8[4], B08[2], B18[2];
    static_assert(SP2, "this copy of the body keeps only the SP2 K-loop up to date");
    int rA[2]; { int R_, C_; stage_rc(tid * 16, R_, C_); rA[0] = R_; stage_rc(tid * 16 + 8192, R_, C_); rA[1] = R_; }
    unsigned cv0[2], cv1[2], nv0[2], nv1[2];
    unsigned vh1[2]; vh1[0] = voffA[0] + (unsigned)hstep; vh1[1] = voffA[1] + (unsigned)hstep;
#define PG8_CV0 (GATHER ? cv0 : voffA)
#define PG8_CV1 (GATHER ? cv1 : vh1)
#define PG8_SV0 (GATHER ? sv0 : voffA)
#define PG8_SV1 (GATHER ? sv1 : vh1)
#define PG8_ROWOFF(dst0, dst1, unit) do { _Pragma("unroll") for (int i_ = 0; i_ < 2; ++i_) { \
        if constexpr (GATHER) { const int c2_ = (int)(voffA[i_] - (unsigned)(rA[i_] * K) * 2u); \
            dst0[i_] = (unsigned)gidx[(unit).pm * BM + rA[i_]] * (unsigned)(K * 2) + (unsigned)c2_; dst1[i_] = (unsigned)gidx[(unit).pm * BM + HALF + rA[i_]] * (unsigned)(K * 2) + (unsigned)c2_; } \
        else { dst0[i_] = voffA[i_]; dst1[i_] = voffA[i_] + (unsigned)hstep; } } } while (0)
    if constexpr (GATHER) PG8_ROWOFF(cv0, cv1, cur);
    const char* cA = GATHER ? (const char*)g.A : (const char*)g.A + (size_t)cur.pm * tstep; const char* cB = (const char*)g.Bt + (size_t)((cur.pm / g.gdiv) % g.gmod) * g.gstride + (size_t)cur.pn * tstep;
    S.a_ready(cur);
    if constexpr (SP2) {
        PG8_STAGE(PG8_SB(0, 0), cB, voffB); PG8_STAGE(PG8_SB(0, 1), cB + hstep, voffB); PG8_STAGE(PG8_SA(0, 0), cA, PG8_CV0); PG8_STAGE(PG8_SA(0, 1), cA, PG8_CV1);
        if (wr == 1) PG8_BAR;
        PG8_WAIT_V(2); PG8_BAR;
        PG8_STAGE(PG8_SB(1, 0), cB + kstep, voffB); PG8_STAGE(PG8_SA(1, 0), cA + kstep, PG8_CV0); PG8_STAGE(PG8_SB(1, 1), cB + hstep + kstep, voffB);
        PG8_WAIT_V(6); PG8_BAR;
    } else {
        PG8_STAGE(PG8_SB(0, 0), cB, voffB); PG8_STAGE(PG8_SA(0, 0), cA, voffA); PG8_STAGE(PG8_SB(0, 1), cB + hstep, voffB); PG8_STAGE(PG8_SA(0, 1), cA + hstep, voffA);
        if (wr == 1) PG8_BAR;
        PG8_WAIT_V(4); PG8_BAR;
        PG8_STAGE(PG8_SB(1, 0), cB + kstep, voffB); PG8_STAGE(PG8_SA(1, 0), cA + kstep, voffA); PG8_STAGE(PG8_SB(1, 1), cB + hstep + kstep, voffB);
        PG8_WAIT_V(6); PG8_BAR;
    }
    for (;;) {
        const bool has_next = S.next(ui + 1, nxt);
        if constexpr (GATHER) { if (has_next) PG8_ROWOFF(nv0, nv1, nxt); else { nv0[0] = cv0[0]; nv0[1] = cv0[1]; nv1[0] = cv1[0]; nv1[1] = cv1[1]; } }
        const char* nA = GATHER ? (const char*)g.A : (has_next ? (const char*)g.A + (size_t)nxt.pm * tstep : cA); const char* nB = has_next ? (const char*)g.Bt + (size_t)((nxt.pm / g.gdiv) % g.gmod) * g.gstride + (size_t)nxt.pn * tstep : cB;
        for (int t = 0; t < nt; t += 2) {
            const bool last = (t == nt - 2);
            unsigned sv0[2], sv1[2]; if constexpr (GATHER) { sv0[0] = last ? nv0[0] : cv0[0]; sv0[1] = last ? nv0[1] : cv0[1]; sv1[0] = last ? nv1[0] : cv1[0]; sv1[1] = last ? nv1[1] : cv1[1]; }
            const char* a1 = cA + (size_t)(t + 1) * kstep;
            const char* a2 = last ? nA : cA + (size_t)(t + 2) * kstep; const char* b2 = last ? nB : cB + (size_t)(t + 2) * kstep;
            const char* a3 = a2 + kstep; const char* b3 = b2 + kstep;
            if (last && has_next) S.a_ready(nxt);
            if constexpr (SP2) {
            PG8_LDB(B0, 0, 0); PG8_LDB(B1, 0, 1); PG8_SCHED; PG8_LDA(At, 0, 0); PG8_STAGE(PG8_SA(1, 1), a1, PG8_CV1);
            PG8_WAIT_V(8); PG8_WAIT_L(0); PG8_BAR; PG8_MMA(0, 0, At, B0); PG8_MMA(0, 1, At, B1); PG8_BAR; PG8_SCHED;
            PG8_LDA(At, 0, 1); PG8_STAGE(PG8_SB(0, 0), b2, voffB); PG8_STAGE(PG8_SB(0, 1), b2 + hstep, voffB); PG8_STAGE(PG8_SA(0, 0), a2, PG8_SV0);
            PG8_WAIT_V(8); PG8_WAIT_L(0); PG8_BAR; PG8_MMA(1, 0, At, B0); PG8_MMA(1, 1, At, B1); PG8_BAR; PG8_SCHED;
            PG8_LDB(B0, 1, 0); PG8_LDB(B1, 1, 1); PG8_SCHED; PG8_LDA(At, 1, 0); PG8_STAGE(PG8_SA(0, 1), a2, PG8_SV1);
            PG8_WAIT_V(8); PG8_WAIT_L(0); PG8_BAR; PG8_MMA(0, 0, At, B0); PG8_MMA(0, 1, At, B1); PG8_BAR; PG8_SCHED;
            PG8_LDA(At, 1, 1); PG8_STAGE(PG8_SB(1, 0), b3, voffB); PG8_STAGE(PG8_SB(1, 1), b3 + hstep, voffB); PG8_STAGE(PG8_SA(1, 0), a3, PG8_SV0);
            PG8_WAIT_V(8); PG8_WAIT_L(0); PG8_BAR; PG8_MMA(1, 0, At, B0); PG8_MMA(1, 1, At, B1); PG8_BAR; PG8_SCHED;
            } else {
            PG8_LDB(B0, 0, 0); PG8_SCHED; PG8_LDA(At, 0, 0); PG8_STAGE(PG8_SA(1, 1), a1 + hstep, voffA);
            PG8_WAIT_L(8); PG8_BAR; PG8_WAIT_L(0); PG8_MMA(0, 0, At, B0); PG8_BAR; PG8_SCHED;
            PG8_LDB(B1, 0, 1); PG8_STAGE(PG8_SB(0, 0), b2, voffB);
            PG8_BAR; PG8_WAIT_L(0); PG8_MMA(0, 1, At, B1); PG8_BAR;
            PG8_LDA(At, 0, 1); PG8_STAGE(PG8_SA(0, 0), a2, voffA);
            PG8_BAR; PG8_WAIT_L(0); PG8_MMA(1, 0, At, B0); PG8_BAR; PG8_SCHED;
            PG8_STAGE(PG8_SB(0, 1), b2 + hstep, voffB);
            PG8_WAIT_V(6); PG8_BAR; PG8_MMA(1, 1, At, B1); PG8_BAR;
            PG8_LDB(B0, 1, 0); PG8_SCHED; PG8_LDA(At, 1, 0); PG8_STAGE(PG8_SA(0, 1), a2 + hstep, voffA);
            PG8_WAIT_L(8); PG8_BAR; PG8_WAIT_L(0); PG8_MMA(0, 0, At, B0); PG8_BAR; PG8_SCHED;
            PG8_LDB(B1, 1, 1); PG8_STAGE(PG8_SB(1, 0), b3, voffB);
            PG8_BAR; PG8_WAIT_L(0); PG8_MMA(0, 1, At, B1); PG8_BAR;
            PG8_LDA(At, 1, 1); PG8_STAGE(PG8_SA(1, 0), a3, voffA);
            PG8_BAR; PG8_WAIT_L(0); PG8_MMA(1, 0, At, B0); PG8_BAR; PG8_SCHED;
            PG8_STAGE(PG8_SB(1, 1), b3 + hstep, voffB);
            PG8_WAIT_V(6); PG8_BAR; PG8_MMA(1, 1, At, B1); PG8_BAR;
            }
        }
        if constexpr (ALIGN_EPI) { if (wr == 0) PG8_BAR; }
        if constexpr (!Epi::AFTER_DRAIN) { E(acc, cur, wr, wc, fr, fq); S.done(cur); }
        if (!has_next) break;
#pragma unroll
        for (int a = 0; a < 2; ++a)
#pragma unroll
            for (int b = 0; b < 2; ++b)
#pragma unroll
                for (int m = 0; m < 4; ++m)
#pragma unroll
                    for (int n = 0; n < 2; ++n) acc[a][b][m][n] = (f32x4){0.f, 0.f, 0.f, 0.f};
        cur = nxt; cA = nA; cB = nB; ++ui; if constexpr (GATHER) { cv0[0] = nv0[0]; cv0[1] = nv0[1]; cv1[0] = nv1[0]; cv1[1] = nv1[1]; }
        if constexpr (ALIGN_EPI) { if (wr == 1) PG8_BAR; }
    }
    PG8_WAIT_V(0);
    if constexpr (!ALIGN_EPI) { if (wr == 0) PG8_BAR; }
    PG8_BAR;
    if constexpr (Epi::AFTER_DRAIN) { E.fused(acc, cur, wr, wc, fr, fq, lds, wid, lane); S.done(cur); }
#undef PG8_ROWOFF
#undef PG8_CV0
#undef PG8_CV1
#undef PG8_SV0
#undef PG8_SV1
#undef PG8_SA
#undef PG8_SB
#undef PG8_STAGE
#undef PG8_LDA
#undef PG8_LDB
#undef PG8_MMA
#undef PG8_WAIT_V
#undef PG8_WAIT_L
#undef PG8_BAR
#undef PG8_SCHED
}
}
namespace attn_body {
using bf16=__hip_bfloat16;
using bf16x8=__attribute__((ext_vector_type(8)))short;
using s16x4=__attribute__((ext_vector_type(4)))short;
using f32x16=__attribute__((ext_vector_type(16)))float;
using u32x4=__attribute__((ext_vector_type(4)))unsigned;
constexpr int D=64;
constexpr int NW=8,QBLK=32,QB=QBLK*NW,KVBLK=64;
__device__ __forceinline__ int crow(int r,int hi){return (r&3)+8*(r>>2)+4*hi;}
#define SBAR() __builtin_amdgcn_sched_barrier(0)
__device__ __forceinline__ void cmask(f32x16&p0,f32x16&p1,int jb,int qrel,int hi){
  const float NEG=-INFINITY; int kb=64*jb+4*hi;
  #pragma unroll
  for(int r=0;r<16;++r){int kv=kb+(r&3)+8*(r>>2); if(kv>qrel)p0[r]=NEG; if(kv+32>qrel)p1[r]=NEG;}
}

constexpr int NSLOT=3, SLOTB=8192;
constexpr int LDS_K=0, LDS_V=NSLOT*SLOTB, LDS_WS=2*NSLOT*SLOTB, LDS_OST=LDS_WS+NW*64*4, LDS_BYTES=LDS_OST+NW*4096;
constexpr float C2=0.125f*1.4426950408889634f;
__device__ __forceinline__ void glds16(const void*gsrc,unsigned lds_dst){unsigned keep;
  asm volatile("s_mov_b32 %0, m0\n\ts_mov_b32 m0, %2\n\ts_nop 0\n\tglobal_load_lds_dwordx4 %1, off\n\ts_mov_b32 m0, %0":"=&s"(keep):"v"(gsrc),"s"(lds_dst):"memory");}
__device__ __forceinline__ float max3f(float a,float b,float c){float r;asm("v_max3_f32 %0, %1, %2, %3":"=v"(r):"v"(a),"v"(b),"v"(c));return r;}
__device__ __forceinline__ float max2f(float a,float b){float r;asm("v_max_f32_e32 %0, %1, %2":"=v"(r):"v"(a),"v"(b));return r;}
__device__ __forceinline__ float fadd_s(float a,float b){float r;asm("v_add_f32_e32 %0, %1, %2":"=v"(r):"v"(a),"v"(b));return r;}
__device__ __forceinline__ float fsub_s(float a,float b){float r;asm("v_sub_f32_e32 %0, %1, %2":"=v"(r):"v"(a),"v"(b));return r;}
typedef float f32x2_t __attribute__((ext_vector_type(2))); typedef __bf16 bf16x2_t __attribute__((ext_vector_type(2)));
__device__ __forceinline__ unsigned cvtpk_s(float lo,float hi){f32x2_t v={lo,hi};bf16x2_t b=__builtin_convertvector(v,bf16x2_t);return __builtin_bit_cast(unsigned,b);}
#define WAIT_BAR(N) asm volatile("s_waitcnt vmcnt(" #N ") lgkmcnt(0)\n\ts_barrier":::"memory")

__device__ __forceinline__ void qkt(f32x16&p0,f32x16&p1,const char*Kslot,const bf16x8*qr,const f32x16&negm,int r32,int hi){
  const char*kb=Kslot+hi*1024+r32*16;
  #pragma unroll
  for(int d0=0;d0<4;++d0){
    const bf16x8 b0=*reinterpret_cast<const bf16x8*>(kb+d0*2048);
    const bf16x8 b1=*reinterpret_cast<const bf16x8*>(kb+d0*2048+512);
    if(d0==0){p0=__builtin_amdgcn_mfma_f32_32x32x16_bf16(b0,qr[0],negm,0,0,0);p1=__builtin_amdgcn_mfma_f32_32x32x16_bf16(b1,qr[0],negm,0,0,0);}
    else{p0=__builtin_amdgcn_mfma_f32_32x32x16_bf16(b0,qr[d0],p0,0,0,0);p1=__builtin_amdgcn_mfma_f32_32x32x16_bf16(b1,qr[d0],p1,0,0,0);}}
}
typedef __attribute__((address_space(3))) const char* lds_cptr;
typedef short v4i16_t __attribute__((ext_vector_type(4)));
__device__ __forceinline__ void kload8(bf16x8*kf,lds_cptr kp){
  kf[0]=*(const __attribute__((address_space(3))) bf16x8*)(kp);      kf[1]=*(const __attribute__((address_space(3))) bf16x8*)(kp+512);
  kf[2]=*(const __attribute__((address_space(3))) bf16x8*)(kp+2048); kf[3]=*(const __attribute__((address_space(3))) bf16x8*)(kp+2560);
  kf[4]=*(const __attribute__((address_space(3))) bf16x8*)(kp+4096); kf[5]=*(const __attribute__((address_space(3))) bf16x8*)(kp+4608);
  kf[6]=*(const __attribute__((address_space(3))) bf16x8*)(kp+6144); kf[7]=*(const __attribute__((address_space(3))) bf16x8*)(kp+6656);
}
__device__ __forceinline__ void kload2(bf16x8*kf,lds_cptr kp,int j){ kf[2*j]=*(const __attribute__((address_space(3))) bf16x8*)(kp+j*2048); kf[2*j+1]=*(const __attribute__((address_space(3))) bf16x8*)(kp+j*2048+512); }
__device__ __forceinline__ s16x4 vtr(lds_cptr p){ return __builtin_bit_cast(s16x4,__builtin_amdgcn_ds_read_tr16_b64_v4i16((__attribute__((address_space(3))) v4i16_t*)p)); }
__device__ __forceinline__ float rowmax(const f32x16&p0,const f32x16&p1){
  float a=max3f(p0[0],p0[1],p1[0]),b=max3f(p0[2],p0[3],p1[1]);a=max3f(a,p1[2],p1[3]);
  #pragma unroll
  for(int r=4;r<16;r+=4){a=max3f(a,p0[r],p0[r+1]);b=max3f(b,p0[r+2],p0[r+3]);a=max3f(a,p1[r],p1[r+1]);b=max3f(b,p1[r+2],p1[r+3]);}
  const float m=max2f(a,b);
  auto rr=__builtin_amdgcn_permlane32_swap(__float_as_uint(m),__float_as_uint(m),false,false);
  return max2f(__uint_as_float(rr[0]),__uint_as_float(rr[1]));
}
__device__ __forceinline__ void pv(f32x16*o,int vb,bf16x8 pa0,bf16x8 pa1,bf16x8 pa2,bf16x8 pa3){
  #pragma unroll
  for(int d0=0;d0<2;++d0){s16x4 lo[4],hi[4];
    #pragma unroll
    for(int ks=0;ks<4;++ks){
      asm volatile("ds_read_b64_tr_b16 %0,%1 offset:%c2":"=&v"(lo[ks]):"v"(vb),"i"(d0*4096+ks*1024):"memory");
      asm volatile("ds_read_b64_tr_b16 %0,%1 offset:%c2":"=&v"(hi[ks]):"v"(vb),"i"(d0*4096+ks*1024+512):"memory");}
    asm volatile("s_waitcnt lgkmcnt(0)":::"memory");SBAR();
    #define PK(k) (bf16x8){lo[k][0],lo[k][1],lo[k][2],lo[k][3],hi[k][0],hi[k][1],hi[k][2],hi[k][3]}
    o[d0]=__builtin_amdgcn_mfma_f32_32x32x16_bf16(pa0,PK(0),o[d0],0,0,0);
    o[d0]=__builtin_amdgcn_mfma_f32_32x32x16_bf16(pa1,PK(1),o[d0],0,0,0);
    o[d0]=__builtin_amdgcn_mfma_f32_32x32x16_bf16(pa2,PK(2),o[d0],0,0,0);
    o[d0]=__builtin_amdgcn_mfma_f32_32x32x16_bf16(pa3,PK(3),o[d0],0,0,0);
    #undef PK
  }
}

#ifndef ATTN_STORE16
#define ATTN_STORE16(p,v) (*(u32x4*)(p)=(v))
#endif
template<int THRL,int QP,int KP,int OP> __device__ __forceinline__ void attn_unit(const bf16*Qu,const bf16*__restrict__ Kh,const bf16*__restrict__ Vh,bf16*Ou,const int NT,char*shm){
  const int tid=opaque_tid(),lane=tid&63,r32=lane&31,hi=lane>>5; const int wid=__builtin_amdgcn_readfirstlane(tid>>6);
  const bf16*Qw=Qu+(long)(wid*QBLK)*QP;
  const unsigned lds0=(unsigned)(uintptr_t)shm;
  float*wsf=(float*)(shm+LDS_WS)+wid*64;
  const bf16*ksrc=Kh+(long)lane*KP+wid*8;
  const bf16*vsrc=Vh+(long)(16*(wid&3)+(lane>>2))*KP+(wid>>2)*32+(lane&3)*8;
  const unsigned kdst=lds0+LDS_K+wid*1024, vdst=lds0+LDS_V+wid*1024;
  #define DMA_K(t,slot) glds16(ksrc+(long)(t)*KVBLK*KP,(unsigned)__builtin_amdgcn_readfirstlane(kdst+(slot)))
  #define DMA_V(t,slot) glds16(vsrc+(long)(t)*KVBLK*KP,(unsigned)__builtin_amdgcn_readfirstlane(vdst+(slot)))
  const int vb0=(int)(lds0+LDS_V)+((lane>>4)&1)*32+(lane&3)*8+(4*hi+((lane&15)>>2))*64;
  const char*Kbase=shm+LDS_K; bf16x8 kf[8];
  const lds_cptr shm3=(lds_cptr)shm; const lds_cptr kp0=shm3+LDS_K+hi*1024+r32*16; const lds_cptr vp0=shm3+LDS_V+((lane>>4)&1)*32+(lane&3)*8+(4*hi+((lane&15)>>2))*64;
  DMA_K(0,0);DMA_V(0,0);DMA_K(1,SLOTB);
  bf16x8 qr[4];
  #pragma unroll
  for(int d0=0;d0<4;++d0)qr[d0]=*reinterpret_cast<const bf16x8*>(&Qw[(long)r32*QP+d0*16+hi*8]);
  float mhat=0.f,l_reg=0.f;f32x16 o[2];o[0]=f32x16{};o[1]=f32x16{};f32x16 negm=f32x16{};asm volatile("":"+v"(negm));
  #define CMASK(P0,P1,t) do{}while(0)
  bool resc=false;
  #define START(P0,P1) do{ const float rm=rowmax(P0,P1); resc=false; \
    { const float dl=rm; mhat=fadd_s(mhat,dl); \
      _Pragma("unroll") for(int r=0;r<16;++r){P0[r]=fsub_s(P0[r],dl);P1[r]=fsub_s(P1[r],dl);} \
      _Pragma("unroll") for(int r=0;r<16;++r)negm[r]=-mhat; asm volatile("":"+v"(negm)); } \
    _Pragma("unroll") for(int r=0;r<16;++r)P0[r]=__builtin_amdgcn_exp2f(P0[r]); }while(0)
  #define RESC() do{ if(resc){ asm volatile("s_waitcnt lgkmcnt(0)":::"memory"); \
      _Pragma("unroll") for(int d_=0;d_<2;++d_) _Pragma("unroll") for(int r=0;r<16;++r)o[d_][r]*=wsf[crow(r,hi)]; } }while(0)
  f32x16 pA0,pA1,pB0,pB1;
  int sl_prev=0,sl_cur=0,sl_next=SLOTB;
  #define ROT() do{sl_prev=sl_cur;sl_cur=sl_next;sl_next=(sl_next==(NSLOT-1)*SLOTB)?0:sl_next+SLOTB;}while(0)
  DMA_K(2,2*SLOTB);
  WAIT_BAR(3);
  qkt(pA0,pA1,Kbase,qr,negm,r32,hi);asm volatile("s_nop 15\n\ts_nop 7":"+v"(pA0),"+v"(pA1));CMASK(pA0,pA1,0);
  START(pA0,pA1);
  _Pragma("unroll") for(int r=0;r<16;++r)pA1[r]=__builtin_amdgcn_exp2f(pA1[r]);
  WAIT_BAR(0);
  DMA_K(3,0);DMA_V(1,SLOTB);
  ROT();
  kload8(kf,kp0+sl_cur);
  WAIT_BAR(2);
  s16x4 vlo[8],vhi[8]; u32x4 pw0,pw1,pw2,pw3;
  #define PKW(P,B) cvtpk_s(P[B],P[B+1])
  #define PAF(k) __builtin_bit_cast(bf16x8,pw##k)
  #define VFR(i) (bf16x8){vlo[i][0],vlo[i][1],vlo[i][2],vlo[i][3],vhi[i][0],vhi[i][1],vhi[i][2],vhi[i][3]}
  #define PIN(x) asm volatile("":"+v"(x))
  #define MX3(a,b,c) __builtin_fmaxf(__builtin_fmaxf((a),(b)),(c))
  #define GAPA(MF,A0,A1,A2,A3,W0,W1,PW) do{ MF; sacc+=A0; sacc+=A1; sacc+=A2; sacc+=A3; PIN(sacc); W0; W1; PIN(PW); SBAR(); }while(0)
  #define EX(v) __builtin_amdgcn_exp2f(v)
  #define GAPB(MF,X,B) do{ MF; X[B]=EX(X[B]); X[B+1]=EX(X[B+1]); X[B+2]=EX(X[B+2]); X[B+3]=EX(X[B+3]); PIN(X); SBAR(); }while(0)
  #define VRD(i) do{ vlo[i]=vtr(vp_+(((i)>>2)*4096+((i)&3)*1024)); vhi[i]=vtr(vp_+(((i)>>2)*4096+((i)&3)*1024+512)); }while(0)
  #define KRD(G,j) do{ if(G){ kload2(kf,kp0+sl_next,j); SBAR(); } }while(0)
  #define STEP(C0,C1,P0,P1,t,GK,GV,GL) do{ SBAR(); \
    const lds_cptr vp_=vp0+sl_prev; \
    VRD(0); SBAR(); float sacc=(P0[0]+P0[1]); \
    GAPA(C0=__builtin_amdgcn_mfma_f32_32x32x16_bf16(kf[0],qr[0],negm,0,0,0), P0[2],P0[3],P0[4],P0[5],     pw0[0]=PKW(P0,0), pw0[1]=PKW(P0,2), pw0); \
    VRD(4); SBAR(); GAPA(C1=__builtin_amdgcn_mfma_f32_32x32x16_bf16(kf[1],qr[0],negm,0,0,0), P0[6],P0[7],P0[8],P0[9],     pw0[2]=PKW(P0,4), pw0[3]=PKW(P0,6), pw0); \
    VRD(1); SBAR(); GAPA(C0=__builtin_amdgcn_mfma_f32_32x32x16_bf16(kf[2],qr[1],C0,0,0,0),   P0[10],P0[11],P0[12],P0[13], pw1[0]=PKW(P0,8), pw1[1]=PKW(P0,10), pw1); \
    VRD(5); SBAR(); GAPA(C1=__builtin_amdgcn_mfma_f32_32x32x16_bf16(kf[3],qr[1],C1,0,0,0),   P0[14],P0[15],P1[0],P1[1],   pw1[2]=PKW(P0,12),pw1[3]=PKW(P0,14), pw1); \
    VRD(2); SBAR(); GAPA(C0=__builtin_amdgcn_mfma_f32_32x32x16_bf16(kf[4],qr[2],C0,0,0,0),   P1[2],P1[3],P1[4],P1[5],     pw2[0]=PKW(P1,0), pw2[1]=PKW(P1,2), pw2); \
    VRD(6); SBAR(); GAPA(C1=__builtin_amdgcn_mfma_f32_32x32x16_bf16(kf[5],qr[2],C1,0,0,0),   P1[6],P1[7],P1[8],P1[9],     pw2[2]=PKW(P1,4), pw2[3]=PKW(P1,6), pw2); \
    VRD(3); SBAR(); GAPA(C0=__builtin_amdgcn_mfma_f32_32x32x16_bf16(kf[6],qr[3],C0,0,0,0),   P1[10],P1[11],P1[12],P1[13], pw3[0]=PKW(P1,8), pw3[1]=PKW(P1,10), pw3); \
    VRD(7); SBAR(); GAPA(C1=__builtin_amdgcn_mfma_f32_32x32x16_bf16(kf[7],qr[3],C1,0,0,0),   P1[14],P1[15],0.f,0.f,       pw3[2]=PKW(P1,12),pw3[3]=PKW(P1,14), pw3); \
    l_reg+=sacc; \
    if(GK){DMA_K((t)+3,sl_cur);} if(GV){DMA_V((t)+1,sl_next);} \
    CMASK(C0,C1,t); \
    { float a=MX3(C0[0],C0[1],C1[0]),b=MX3(C0[2],C0[3],C1[1]); a=MX3(a,C1[2],C1[3]); \
      _Pragma("unroll") for(int r=4;r<16;r+=4){a=MX3(a,C0[r],C0[r+1]);b=MX3(b,C0[r+2],C0[r+3]);a=MX3(a,C1[r],C1[r+1]);b=MX3(b,C1[r+2],C1[r+3]);} \
      float rm=__builtin_fmaxf(a,b); { auto rr=__builtin_amdgcn_permlane32_swap(__float_as_uint(rm),__float_as_uint(rm),false,false); rm=__builtin_fmaxf(__uint_as_float(rr[0]),__uint_as_float(rr[1])); } \
      resc=false; \
      if(__builtin_expect(__any(rm>(float)THRL),0)){ const float dl=__builtin_fmaxf(rm,0.f); mhat+=dl; \
        _Pragma("unroll") for(int r=0;r<16;++r){C0[r]-=dl;C1[r]-=dl;} \
        _Pragma("unroll") for(int r=0;r<16;++r)negm[r]=-mhat; asm volatile("":"+v"(negm)); \
        const float f=__builtin_amdgcn_exp2f(-dl); l_reg*=f; if(hi==0)wsf[r32]=f; resc=true; } } \
    SBAR(); \
    GAPB(o[0]=__builtin_amdgcn_mfma_f32_32x32x16_bf16(PAF(0),VFR(0),o[0],0,0,0), C0,0); \
    GAPB(o[1]=__builtin_amdgcn_mfma_f32_32x32x16_bf16(PAF(0),VFR(4),o[1],0,0,0), C0,4); \
    KRD(GL,0); GAPB(o[0]=__builtin_amdgcn_mfma_f32_32x32x16_bf16(PAF(1),VFR(1),o[0],0,0,0), C0,8); \
    KRD(GL,1); GAPB(o[1]=__builtin_amdgcn_mfma_f32_32x32x16_bf16(PAF(1),VFR(5),o[1],0,0,0), C0,12); \
    KRD(GL,2); GAPB(o[0]=__builtin_amdgcn_mfma_f32_32x32x16_bf16(PAF(2),VFR(2),o[0],0,0,0), C1,0); \
    KRD(GL,3); GAPB(o[1]=__builtin_amdgcn_mfma_f32_32x32x16_bf16(PAF(2),VFR(6),o[1],0,0,0), C1,4); \
    GAPB(o[0]=__builtin_amdgcn_mfma_f32_32x32x16_bf16(PAF(3),VFR(3),o[0],0,0,0), C1,8); \
    GAPB(o[1]=__builtin_amdgcn_mfma_f32_32x32x16_bf16(PAF(3),VFR(7),o[1],0,0,0), C1,12); \
    }while(0)
  int t=1;
  #undef CMASK
  #define CMASK(P0,P1,t) do{}while(0)
  for(;t+5<NT;t+=2){
    STEP(pB0,pB1,pA0,pA1,t,true,true,true);     WAIT_BAR(2); RESC(); ROT();
    STEP(pA0,pA1,pB0,pB1,t+1,true,true,true);   WAIT_BAR(2); RESC(); ROT();
  }
  #undef CMASK
  #define CMASK(P0,P1,t) do{}while(0)
  #define ENDW(tt) do{ if((tt)+3<NT){WAIT_BAR(2);} else if((tt)+2<NT){WAIT_BAR(1);} else {WAIT_BAR(0);} }while(0)
  for(;t+1<NT;t+=2){
    STEP(pB0,pB1,pA0,pA1,t,(t+3<NT),(t+1<NT),(t+1<NT));       ENDW(t);   RESC(); ROT();
    STEP(pA0,pA1,pB0,pB1,t+1,(t+4<NT),(t+2<NT),(t+2<NT));     ENDW(t+1); RESC(); ROT();
  }
  STEP(pB0,pB1,pA0,pA1,NT-1,false,false,false); RESC();
  { float sacc=pB0[0]+pB0[1]; _Pragma("unroll") for(int r=2;r<16;++r)sacc+=pB0[r]; _Pragma("unroll") for(int r=0;r<16;++r)sacc+=pB1[r]; l_reg+=sacc;
    pw0=(u32x4){PKW(pB0,0),PKW(pB0,2),PKW(pB0,4),PKW(pB0,6)};pw1=(u32x4){PKW(pB0,8),PKW(pB0,10),PKW(pB0,12),PKW(pB0,14)};pw2=(u32x4){PKW(pB1,0),PKW(pB1,2),PKW(pB1,4),PKW(pB1,6)};pw3=(u32x4){PKW(pB1,8),PKW(pB1,10),PKW(pB1,12),PKW(pB1,14)};
    SBAR(); pv(o,vb0+sl_cur,PAF(0),PAF(1),PAF(2),PAF(3)); }
  #undef PKW
  #undef PAF
  #undef VFR
  #undef PIN
  #undef MX3
  #undef GAPA
  #undef GAPB
  #undef EX
  #undef VRD
  #undef KRD
  #undef STEP
  #undef ENDW
  {auto rr=__builtin_amdgcn_permlane32_swap(__float_as_uint(l_reg),__float_as_uint(l_reg),false,false);l_reg=__uint_as_float(rr[0])+__uint_as_float(rr[1]);}
  if(hi==0)wsf[32+r32]=l_reg;asm volatile("s_waitcnt lgkmcnt(0)":::"memory");
  float rli[16];
  #pragma unroll
  for(int r=0;r<16;++r)rli[r]=__builtin_amdgcn_rcpf(wsf[32+crow(r,hi)]);
  bf16*Ow=Ou+(long)(wid*QBLK)*OP;
  { bf16*stg=(bf16*)(shm+LDS_OST)+wid*2048;
    #pragma unroll
    for(int r=0;r<16;++r){const int orow=crow(r,hi);
      #pragma unroll
      for(int d0=0;d0<2;++d0)stg[orow*64+d0*32+r32]=__float2bfloat16(o[d0][r]*rli[r]);}
    asm volatile("s_waitcnt lgkmcnt(0)":::"memory");
    #pragma unroll
    for(int i=0;i<4;++i){const int row=i*8+(lane>>3),ch=lane&7; const u32x4 v=*(const u32x4*)(stg+row*64+ch*8); ATTN_STORE16(Ow+(long)row*OP+ch*8,v);} }
  asm volatile("s_waitcnt lgkmcnt(0)\n\ts_barrier":::"memory");
  #undef DMA_K
  #undef DMA_V
  #undef CMASK
  #undef START
  #undef RESC
  #undef ROT
}
constexpr int ATTN_LDS_BYTES=LDS_BYTES;
#undef SBAR
#undef WAIT_BAR
}
#define LDS_WAIT() asm volatile("s_waitcnt lgkmcnt(0)" ::: "memory")

__device__ __forceinline__ void transpose_item(const float* W, int K, int N, bf16* WT, int k0, int n0, int dest_row0, LAS float* scr, int lane) {
    float t_[32];
#pragma unroll
    for (int i = 0; i < 32; ++i) t_[i] = W[(size_t)(k0 + 2 * i + (lane >> 5)) * N + n0 + (lane & 31)];
#pragma unroll
    for (int i = 0; i < 32; ++i) scr[(2 * i + (lane >> 5)) * 33 + (lane & 31)] = t_[i];
    LDS_WAIT(); asm volatile("" ::: "memory");
    const int c = lane & 7;
#pragma unroll
    for (int j = 0; j < 4; ++j) { const int n = (lane >> 3) + 8 * j; const LAS float* s = scr + (8 * c) * 33 + n;
        v4u o; o.x = pk2(s[0 * 33], s[1 * 33]); o.y = pk2(s[2 * 33], s[3 * 33]); o.z = pk2(s[4 * 33], s[5 * 33]); o.w = pk2(s[6 * 33], s[7 * 33]);
        *(GAS v4u*)(WT + (size_t)(dest_row0 + n) * K + k0 + 8 * c) = o; }
    LDS_WAIT(); asm volatile("" ::: "memory");
}

template <int KMODE>
__device__ __forceinline__ void transpose_item8(const float* W, int K, int N, unsigned char* WT, int k0, int n0, int dest_row0, float sc, LAS float* scr, int lane) {
    float t_[32];
#pragma unroll
    for (int i = 0; i < 32; ++i) t_[i] = W[(size_t)(k0 + 2 * i + (lane >> 5)) * N + n0 + (lane & 31)];
#pragma unroll
    for (int i = 0; i < 32; ++i) scr[(2 * i + (lane >> 5)) * 33 + (lane & 31)] = __builtin_amdgcn_fmed3f(t_[i] * sc, -448.f, 448.f);
    LDS_WAIT(); asm volatile("" ::: "memory");
    const int c = lane & 7, w = c >> 2, fq = c & 3, wh = (k0 >> 6) & 1;
    const int doff = KMODE == 1 ? (k0 & ~255) + 64 * (2 * wh + w) + 16 * fq + 8 * ((k0 >> 7) & 1) : KMODE == 2 ? (k0 & ~127) + 32 * (2 * wh + w) + 8 * fq : k0 + 8 * c;
#pragma unroll
    for (int j = 0; j < 4; ++j) { const int n = (lane >> 3) + 8 * j; const LAS float* s = scr + n;
        float v[8];
#pragma unroll
        for (int e = 0; e < 8; ++e) { const int kk = KMODE == 2 ? 32 * w + 16 * (e >> 2) + 4 * fq + (e & 3) : 8 * c + e; v[e] = s[kk * 33]; }
        unsigned w0 = 0, w1 = 0;
        w0 = __builtin_amdgcn_cvt_pk_fp8_f32(v[0], v[1], w0, false); w0 = __builtin_amdgcn_cvt_pk_fp8_f32(v[2], v[3], w0, true);
        w1 = __builtin_amdgcn_cvt_pk_fp8_f32(v[4], v[5], w1, false); w1 = __builtin_amdgcn_cvt_pk_fp8_f32(v[6], v[7], w1, true);
        *(GAS v2u*)(WT + (size_t)(dest_row0 + n) * K + doff) = (v2u){w0, w1}; }
    LDS_WAIT(); asm volatile("" ::: "memory");
}

struct ProIn { const float *hy_w_in, *at_w_in, *w_out, *w_mem_kv; };
__device__ __forceinline__ void phase_weights(const ProIn& P, unsigned char* ws, LAS unsigned char* lds, int gw, int NGW, int wave, int lane) {
    LAS float* scr = (LAS float*)(lds + wave * 16384);
    constexpr int I_HY = 16 * 80, I_AT = 16 * 48, I_OUT = 16 * 32, I_MKV = 16 * 16;
    constexpr int E0 = 2 * I_HY, E1 = E0 + 2 * I_AT, E2 = E1 + 4 * I_OUT, E3 = E2 + 4 * I_MKV;
    for (int it = gw; it < E3; it += NGW) {
        int r = it;
        if (r < E0) { const int j = r / I_HY, q = r % I_HY, kb = q / 80, nb = q % 80;
            transpose_item(P.hy_w_in + (size_t)j * DM * D_IN_HY, DM, D_IN_HY, (bf16*)(ws + WS_WHY) + (size_t)j * D_IN_HY * DM, 64 * kb, 32 * nb, 32 * nb, scr, lane); continue; }
        r -= E0;
        if (r < 2 * I_AT) { const int j = r / I_AT, q = r % I_AT, kb = q / 48, nb = q % 48;
            const int n0 = 32 * nb, o = n0 & 255;
            transpose_item(P.at_w_in + (size_t)j * DM * D_IN_AT, DM, D_IN_AT, (bf16*)(ws + WS_WAT) + (size_t)j * D_IN_AT * DM, 64 * kb, n0, (n0 & ~255) + 128 * ((o & 63) >> 5) + 32 * (o >> 6), scr, lane); continue; }
        r -= 2 * I_AT;
        if (r < 4 * I_OUT) { const int j = r / I_OUT, q = r % I_OUT, kb = q / 32, nb = q % 32;
            transpose_item(P.w_out + (size_t)j * DM * DM, DM, DM, (bf16*)(ws + WS_WOUT) + (size_t)j * DM * DM, 64 * kb, 32 * nb, 32 * nb, scr, lane); continue; }
        r -= 4 * I_OUT;
        { const int j = r / I_MKV, q = r % I_MKV, kb = q / 16, nb = q % 16;
            transpose_item(P.w_mem_kv + (size_t)j * DM * 512, DM, 512, (bf16*)(ws + WS_WMKV), 64 * kb, 32 * nb, j * 512 + 32 * nb, scr, lane); }
        (void)r;
    }
}

struct XwIn { const float *w_gate, *w_up, *w_down; unsigned char* ws; };
constexpr int XW_PER_EXPERT = 3 * 384, XW_PER_LAYER = NEXP * XW_PER_EXPERT;
constexpr int XW_QA_HY = 5, XW_QA_AT = 4, XW_QB = 3, XW_NA = 128 * NWAVES, XW_NB = 224 * NWAVES;
__host__ __device__ constexpr int xw_qa(int layer) { return (layer & 1) ? XW_QA_AT : XW_QA_HY; }
__host__ __device__ constexpr int xw_p0(int layer, bool sched) { return sched ? XW_PER_LAYER - xw_qa(layer) * XW_NA - XW_QB * XW_NB : XW_PER_LAYER; }
__device__ __forceinline__ void xw_item(const XwIn& B, int layer, int r, LAS float* scr, int lane) {
    const int j = layer * NEXP + r / XW_PER_EXPERT, q = r % XW_PER_EXPERT, kind = q / 384, qq = q % 384;
    if (kind < 2) { const int kb = qq / 24, nb = qq % 24, n0 = 32 * nb;
        transpose_item8<1>((kind == 0 ? B.w_gate : B.w_up) + (size_t)j * DM * EFF, DM, EFF, B.ws + WS_W1 + (size_t)j * 1536 * DM, 64 * kb, n0, (n0 >> 7) * 256 + 128 * kind + (n0 & 127), W8_SCALE, scr, lane); }
    else { const int kb = qq / 32, nb = qq % 32;
        transpose_item8<2>(B.w_down + (size_t)j * EFF * DM, EFF, DM, B.ws + WS_W2 + (size_t)j * DM * EFF, 64 * kb, 32 * nb, 32 * nb, W8_SCALE, scr, lane); }
}
__device__ __forceinline__ void phase_xw_p0(const XwIn& B, bool sched, LAS float* scr, int gw, int NGW, int lane) {
#pragma unroll 1
    for (int layer = 0; layer < DEPTH; ++layer) { const int n = xw_p0(layer, sched);
#pragma unroll 1
        for (int r = gw; r < n; r += NGW) xw_item(B, layer, r, scr, lane); }
}
__device__ __forceinline__ void xw_slice_a(const XwIn& B, int layer, LAS float* scr, int bx, int wave, int lane) {
    const int base = xw_p0(layer, true) + (bx - 128) * NWAVES + wave;
#pragma unroll 1
    for (int k = 0; k < xw_qa(layer); ++k) xw_item(B, layer, base + k * XW_NA, scr, lane);
}
__device__ __forceinline__ void xw_slice_b(const XwIn& B, int layer, LAS float* scr, int bx, int wave, int lane) {
    const int base = xw_p0(layer, true) + xw_qa(layer) * XW_NA + (bx - 32) * NWAVES + wave;
#pragma unroll 1
    for (int k = 0; k < XW_QB; ++k) xw_item(B, layer, base + k * XW_NB, scr, lane);
}

__device__ __forceinline__ void phase_wrg(const float* ffn_g, const float* router, float* WRG, int gtid, int nthreads) {
    for (int q = gtid; q < DEPTH * NEXP * DM; q += nthreads) { const int l = q / (NEXP * DM), e = (q / DM) % NEXP, d = q % DM; WRG[q] = ffn_g[l * DM + d] * router[((size_t)l * DM + d) * NEXP + e]; }
}

__device__ __forceinline__ void rms_row_bf16(const float* xrow, const float* g, bf16* orow, int lane) {
    const GAS f32x4* xr = (const GAS f32x4*)xrow + lane; const GAS f32x4* gr = (const GAS f32x4*)g + lane;
    f32x4 v[4]; float s = 0.f;
#pragma unroll
    for (int j = 0; j < 4; ++j) { v[j] = xr[64 * j]; s += (v[j].x * v[j].x + v[j].y * v[j].y) + (v[j].z * v[j].z + v[j].w * v[j].w); }
    const float rstd = 1.f / sqrtf(wave_sum(s) * (1.f / DM) + NORM_EPS);
    GAS v2u* o8 = (GAS v2u*)orow + lane;
#pragma unroll
    for (int j = 0; j < 4; ++j) { const f32x4 gg = gr[64 * j]; v2u w; w.x = pk2(v[j].x * rstd * gg.x, v[j].y * rstd * gg.y); w.y = pk2(v[j].z * rstd * gg.z, v[j].w * rstd * gg.w); o8[64 * j] = w; }
}

__device__ __forceinline__ void phase_mem_h2(const float* mem, const float* mem_g, const float* fw1, const float* fb1, const float* fw2, const float* fb2, const float* ffreq,
                                              unsigned char* ws, int gw, int NGW, int lane) {
    for (int m = gw; m < BATCH * MEM_LEN; m += NGW) rms_row_bf16(mem + (size_t)m * DM, mem_g, (bf16*)(ws + WS_MEMN) + (size_t)m * DM, lane);
    float* H2 = (float*)(ws + WS_H2);
    for (int it = gw; it < 2 * SEQ; it += NGW) {
        const int j = it / SEQ, n = it % SEQ;
        const float* w1 = fw1 + j * HY_EMB * HY_FILT; const float* w2 = fw2 + j * HY_FILT * HY_FILT;
        const float t = (float)n * (1.0f / (float)(SEQ - 1));
        const float w = (6.283185307179586f * (float)n) / (float)SEQ;
        float feat = 0.f;
        if (lane == 0) feat = t;
        else if (lane <= 16) { const float band = 1e-4f + (float)(lane - 1) * ((15.0f - 1e-4f) / 15.0f); feat = cosf(band * w); }
        else if (lane <= 32) { const float band = 1e-4f + (float)(lane - 17) * ((15.0f - 1e-4f) / 15.0f); feat = -sinf(band * w); }
        const float fr = ffreq[j * HY_FILT + lane];
        float a = fb1[j * HY_FILT + lane];
        for (int i = 0; i < HY_EMB; ++i) a += __shfl(feat, i) * w1[i * HY_FILT + lane];
        const float h1 = sinf(fr * a);
        float a2 = fb2[j * HY_FILT + lane];
        for (int i = 0; i < HY_FILT; ++i) a2 += __shfl(h1, i) * w2[i * HY_FILT + lane];
        H2[(size_t)it * HY_FILT + lane] = sinf(fr * a2);
    }
}

template <bool COMBINE, bool FINAL>
__device__ __forceinline__ void phase_norm(const float* hin, float* hout, const float* g, bf16* U, float* fout, const int* POS, const bf16* Y, int gw, int NGW, int lane) {
    int m = gw;
    if (m >= M_TOK) return;
    f32x4 cur[4]; int cpos = -1;
    { const GAS f32x4* xr = (const GAS f32x4*)(hin + (size_t)m * DM) + lane;
#pragma unroll
      for (int j = 0; j < 4; ++j) cur[j] = xr[64 * j];
      if (COMBINE) { const int b = m / SEQ, t = m % SEQ; if (lane < NEXP) cpos = POS[(size_t)(b * NEXP + lane) * SEQ + t]; } }
#pragma unroll 1
    for (; m < M_TOK; m += NGW) {
        const int mn = m + NGW; f32x4 nxt[4]; int npos = -1;
#pragma unroll
        for (int j = 0; j < 4; ++j) nxt[j] = cur[j];
        if (mn < M_TOK) { const GAS f32x4* xr = (const GAS f32x4*)(hin + (size_t)mn * DM) + lane;
#pragma unroll
            for (int j = 0; j < 4; ++j) nxt[j] = xr[64 * j];
            if (COMBINE) { const int b = mn / SEQ, t = mn % SEQ; if (lane < NEXP) npos = POS[(size_t)(b * NEXP + lane) * SEQ + t]; } }
        f32x4 v[4];
#pragma unroll
        for (int j = 0; j < 4; ++j) v[j] = cur[j];
        if (COMBINE) {
            const int b = m / SEQ;
            unsigned long long mask = __ballot(cpos >= 0);
            while (mask) {
                v2u y[4][4]; bool has[4];
#pragma unroll
                for (int k = 0; k < 4; ++k) { has[k] = mask != 0ull;
                    if (has[k]) { const int e = __builtin_amdgcn_readfirstlane(__builtin_ctzll(mask)); mask &= mask - 1ull; const int p = __builtin_amdgcn_readlane(cpos, e);
                        const GAS v2u* yr = (const GAS v2u*)(Y + ((size_t)(b * NEXP + e) * CAP + p) * DM) + lane;
#pragma unroll
                        for (int j = 0; j < 4; ++j) y[k][j] = yr[64 * j]; } }
#pragma unroll
                for (int k = 0; k < 4; ++k) if (has[k]) {
#pragma unroll
                    for (int j = 0; j < 4; ++j) { const v2u w = y[k][j]; v[j].x += bflo(w.x); v[j].y += bfhi(w.x); v[j].z += bflo(w.y); v[j].w += bfhi(w.y); } }
            }
            if (!FINAL) { GAS f32x4* ho = (GAS f32x4*)(hout + (size_t)m * DM) + lane;
#pragma unroll
                for (int j = 0; j < 4; ++j) ho[64 * j] = v[j]; }
        }
        float s = 0.f;
#pragma unroll
        for (int j = 0; j < 4; ++j) s += (v[j].x * v[j].x + v[j].y * v[j].y) + (v[j].z * v[j].z + v[j].w * v[j].w);
        const float rstd = 1.f / sqrtf(wave_sum(s) * (1.f / DM) + NORM_EPS);
        const GAS f32x4* gr = (const GAS f32x4*)g + lane;
        if (FINAL) { GAS f32x4* o = (GAS f32x4*)(fout + (size_t)m * DM) + lane;
#pragma unroll
            for (int j = 0; j < 4; ++j) o[64 * j] = v[j] * rstd * gr[64 * j]; }
        else { GAS v2u* o8 = (GAS v2u*)(U + (size_t)m * DM) + lane;
#pragma unroll
            for (int j = 0; j < 4; ++j) { const f32x4 gg = gr[64 * j]; v2u w; w.x = pk2(v[j].x * rstd * gg.x, v[j].y * rstd * gg.y); w.y = pk2(v[j].z * rstd * gg.z, v[j].w * rstd * gg.w); o8[64 * j] = w; } }
#pragma unroll
        for (int j = 0; j < 4; ++j) cur[j] = nxt[j];
        cpos = npos;
    }
}

__device__ __forceinline__ void phase_ffn_norm_router(const float* H, const float* g, const float* Wr, unsigned char* XN8, float* AFF, LAS unsigned char* lds, int gw, int NGW, int lane, int tid) {
    LAS f32x4* WL = (LAS f32x4*)lds;
    for (int q = tid; q < 64 * 64; q += NTHREADS) { const int ln = q & 63, s = q >> 6, e4 = s & 3, ji = s >> 2, i = ji & 3, j = ji >> 2; const int d = 4 * ln + i + 256 * j;
        WL[q] = *(const GAS f32x4*)(Wr + (size_t)d * NEXP + 4 * e4); }
    __syncthreads();
    constexpr int R = 4;
    const GAS f32x4* gr = (const GAS f32x4*)g + lane;
#pragma unroll 1
    for (int m0 = gw * R; m0 < M_TOK; m0 += NGW * R) {
        int lo_ = lane; asm volatile("" : "+v"(lo_));
        f32x4 v[R][4]; float rstd[R];
#pragma unroll
        for (int r = 0; r < R; ++r) { const GAS f32x4* xr = (const GAS f32x4*)(H + (size_t)(m0 + r) * DM) + lane;
#pragma unroll
            for (int j = 0; j < 4; ++j) v[r][j] = xr[64 * j]; }
#pragma unroll
        for (int r = 0; r < R; ++r) { float s = 0.f;
#pragma unroll
            for (int j = 0; j < 4; ++j) s += (v[r][j].x * v[r][j].x + v[r][j].y * v[r][j].y) + (v[r][j].z * v[r][j].z + v[r][j].w * v[r][j].w);
            rstd[r] = 1.f / sqrtf(wave_sum(s) * (1.f / DM) + NORM_EPS); }
        f32x4 lg[R][4];
#pragma unroll
        for (int r = 0; r < R; ++r)
#pragma unroll
            for (int e4 = 0; e4 < 4; ++e4) lg[r][e4] = (f32x4){0.f, 0.f, 0.f, 0.f};
#pragma unroll
        for (int j = 0; j < 4; ++j) { const f32x4 gg = gr[64 * j];
#pragma unroll
            for (int r = 0; r < R; ++r) { v[r][j] = v[r][j] * rstd[r] * gg;
                unsigned w = 0; w = __builtin_amdgcn_cvt_pk_fp8_f32(v[r][j].x, v[r][j].y, w, false); w = __builtin_amdgcn_cvt_pk_fp8_f32(v[r][j].z, v[r][j].w, w, true);
                ((GAS unsigned*)(XN8 + (size_t)(m0 + r) * DM) + lane)[64 * j] = w; }
#pragma unroll
            for (int i = 0; i < 4; ++i)
#pragma unroll
                for (int e4 = 0; e4 < 4; ++e4) { const f32x4 wv = WL[((j * 4 + i) * 4 + e4) * 64 + lo_];
#pragma unroll
                    for (int r = 0; r < R; ++r) { const float xs = v[r][j][i];
#pragma unroll
                        for (int c = 0; c < 4; ++c) asm("v_fmac_f32 %0, %1, %2" : "+v"(lg[r][e4][c]) : "v"(wv[c]), "v"(xs)); } }
            __builtin_amdgcn_sched_barrier(0); }
#pragma unroll
        for (int r = 0; r < R; ++r) {
            float l16[16];
#pragma unroll
            for (int e = 0; e < 16; ++e) l16[e] = wave_sum(lg[r][e >> 2][e & 3]);
            float mx = l16[0];
#pragma unroll
            for (int e = 1; e < 16; ++e) mx = fmaxf(mx, l16[e]);
            float den = 0.f;
#pragma unroll
            for (int e = 0; e < 16; ++e) { l16[e] = expf(l16[e] - mx); den += l16[e]; }
            float mine = 0.f;
#pragma unroll
            for (int e = 0; e < 16; ++e) mine = (lane == e) ? l16[e] : mine;
            const int m = m0 + r, b = m / SEQ, t = m % SEQ;
            if (lane < NEXP) AFF[(size_t)(b * NEXP + lane) * SEQ + t] = mine / den;
        }
    }
    __syncthreads();
}

__device__ __forceinline__ void phase_router_sum(const float* PLG, const float* PSS, float* RSTD, float* AFF, int gw, int NGW, int lane) {
    const int e = lane & 15, rq = lane >> 4;
    for (int m0 = gw * 4; m0 < M_TOK; m0 += NGW * 4) {
        const int m = m0 + rq;
        float lgt = 0.f;
#pragma unroll
        for (int slot = 0; slot < 16; ++slot) lgt += PLG[((size_t)slot * M_TOK + m) * 16 + e];
        float ss = PSS[(size_t)e * M_TOK + m];
#pragma unroll
        for (int o = 1; o < 16; o <<= 1) ss += __shfl_xor(ss, o);
        const float rstd = 1.f / sqrtf(ss * (1.f / DM) + NORM_EPS);
        lgt *= rstd;
        float mx = lgt;
#pragma unroll
        for (int o = 1; o < 16; o <<= 1) mx = fmaxf(mx, __shfl_xor(mx, o));
        const float ex = expf(lgt - mx); float den = ex;
#pragma unroll
        for (int o = 1; o < 16; o <<= 1) den += __shfl_xor(den, o);
        const int b = m / SEQ, t = m % SEQ;
        AFF[(size_t)(b * NEXP + e) * SEQ + t] = ex / den;
        if (e == 0) RSTD[m] = rstd;
    }
}

__device__ __forceinline__ int block_excl_scan(int v, LAS int* scr, int tid, int lane, int wave, int* tot) {
    int inc = v;
#pragma unroll
    for (int o = 1; o < 64; o <<= 1) { const int n = __shfl_up(inc, o); if (lane >= o) inc += n; }
    __syncthreads();
    if (lane == 63) scr[wave] = inc;
    __syncthreads();
    int base = 0, total = 0;
#pragma unroll
    for (int w = 0; w < NWAVES; ++w) { const int c = scr[w]; if (w < wave) base += c; total += c; }
    *tot = total;
    return base + inc - v;
}

__device__ __forceinline__ void phase_topk(const float* AFF, const float* RSTD, float* RS, int* IDX, float* GATE, int* POS, LAS unsigned char* ldsm, int blk, int nblk, int tid, int lane, int wave) {
    LAS int* hist = (LAS int*)ldsm;
    LAS int* sel = (LAS int*)(ldsm + 1024);
    LAS int* scr = (LAS int*)(ldsm + 1280);
    for (int g = blk; g < NGRP; g += nblk) {
        unsigned v[16];
        { const GAS v4u* src = (const GAS v4u*)(AFF + (size_t)g * SEQ) + tid * 4;
#pragma unroll
          for (int q = 0; q < 4; ++q) { const v4u w = src[q]; v[4 * q] = w.x; v[4 * q + 1] = w.y; v[4 * q + 2] = w.z; v[4 * q + 3] = w.w; } }
        unsigned prefix = 0u; int krem = CAP;
#pragma unroll 1
        for (int pass = 0; pass < 4; ++pass) {
            const int shift = 24 - 8 * pass;
            const unsigned himask = (pass == 0) ? 0u : (0xffffffffu << (shift + 8));
            __syncthreads();
            if (tid < 256) hist[tid] = 0;
            __syncthreads();
#pragma unroll
            for (int i = 0; i < 16; ++i) if ((v[i] & himask) == prefix) __hip_atomic_fetch_add(hist + ((v[i] >> shift) & 255u), 1, __ATOMIC_RELAXED, __HIP_MEMORY_SCOPE_WORKGROUP);
            __syncthreads();
            if (wave == 0) {
                int c[4]; int s = 0;
#pragma unroll
                for (int j = 0; j < 4; ++j) { c[j] = hist[255 - 4 * lane - j]; s += c[j]; }
                int inc = s;
#pragma unroll
                for (int o = 1; o < 64; o <<= 1) { const int n = __shfl_up(inc, o); if (lane >= o) inc += n; }
                int before = inc - s;
                if (before < krem && krem <= inc) {
                    int bin = 0, kk = krem - before; bool done = false;
#pragma unroll
                    for (int j = 0; j < 4; ++j) { if (!done) { if (kk <= c[j]) { bin = 255 - 4 * lane - j; done = true; } else kk -= c[j]; } }
                    sel[0] = bin; sel[1] = kk;
                }
            }
            __syncthreads();
            prefix |= ((unsigned)sel[0]) << shift; krem = sel[1];
        }
        int ceq = 0;
#pragma unroll
        for (int i = 0; i < 16; ++i) ceq += (v[i] == prefix) ? 1 : 0;
        int tot;
        int eqrank = block_excl_scan(ceq, scr, tid, lane, wave, &tot);
        int csel = 0; unsigned selmask = 0u;
#pragma unroll
        for (int i = 0; i < 16; ++i) { bool s = v[i] > prefix; if (v[i] == prefix) { s = eqrank < krem; ++eqrank; } if (s) { selmask |= 1u << i; ++csel; } }
        int slot = block_excl_scan(csel, scr, tid, lane, wave, &tot);
        const int b = g / NEXP;
        int pv[16];
#pragma unroll
        for (int i = 0; i < 16; ++i) {
            pv[i] = -1;
            if (selmask & (1u << i)) { pv[i] = slot; IDX[g * CAP + slot] = b * SEQ + tid * 16 + i; GATE[g * CAP + slot] = __builtin_bit_cast(float, v[i]); RS[g * CAP + slot] = RSTD[b * SEQ + tid * 16 + i]; ++slot; }
        }
        { GAS v4u* dst = (GAS v4u*)(POS + (size_t)g * SEQ) + tid * 4;
#pragma unroll
          for (int q = 0; q < 4; ++q) { v4u w; w.x = (unsigned)pv[4 * q]; w.y = (unsigned)pv[4 * q + 1]; w.z = (unsigned)pv[4 * q + 2]; w.w = (unsigned)pv[4 * q + 3]; dst[q] = w; } }
        __syncthreads();
    }
}

__device__ __forceinline__ void phase_gather(const bf16* XN, const int* IDX, bf16* XG, int gw, int NGW, int lane) {
    for (int r = gw; r < XROWS; r += NGW) {
        const int src = __builtin_amdgcn_readfirstlane(IDX[r]);
        const GAS v4u* s = (const GAS v4u*)(XN + (size_t)src * DM) + lane; GAS v4u* d = (GAS v4u*)(XG + (size_t)r * DM) + lane;
        const v4u a = s[0], b = s[64]; d[0] = a; d[64] = b;
    }
}

__device__ __forceinline__ void phase_qk_rope(bf16* P, const float* gq, const float* gk, int gw, int NGW, int lane) {
    const int hh = lane >> 2, part = lane & 3, axis = part >> 1, half = part & 1;
    const float* g = (hh < NQH ? gq : gk) + 16 * part;
    float gv[16], inv[16];
#pragma unroll
    for (int i = 0; i < 16; ++i) { gv[i] = g[i]; inv[i] = exp2f(-(float)i * (13.287712379549449f / 16.0f)); }
    const float osc = hh < NQH ? ATT_C2 : 1.0f;
    int m = gw; v4u c0 = (v4u){0u, 0u, 0u, 0u}, c1 = c0;
    if (m < M_TOK) { const GAS v4u* p = (const GAS v4u*)(P + (size_t)m * D_IN_AT + hh * HD + 16 * part); c0 = p[0]; c1 = p[1]; }
#pragma unroll 1
    for (; m < M_TOK; m += NGW) {
        const int t = m % SEQ; const float pos = (float)(axis == 0 ? (t >> 6) : (t & 63));
        GAS v4u* p = (GAS v4u*)(P + (size_t)m * D_IN_AT + hh * HD + 16 * part);
        const v4u w0 = c0, w1 = c1;
        if (m + NGW < M_TOK) { const GAS v4u* pn = (const GAS v4u*)(P + (size_t)(m + NGW) * D_IN_AT + hh * HD + 16 * part); c0 = pn[0]; c1 = pn[1]; }
        float x[16];
        x[0] = bflo(w0.x); x[1] = bfhi(w0.x); x[2] = bflo(w0.y); x[3] = bfhi(w0.y); x[4] = bflo(w0.z); x[5] = bfhi(w0.z); x[6] = bflo(w0.w); x[7] = bfhi(w0.w);
        x[8] = bflo(w1.x); x[9] = bfhi(w1.x); x[10] = bflo(w1.y); x[11] = bfhi(w1.y); x[12] = bflo(w1.z); x[13] = bfhi(w1.z); x[14] = bflo(w1.w); x[15] = bfhi(w1.w);
        float ss = 0.f;
#pragma unroll
        for (int i = 0; i < 16; ++i) ss += x[i] * x[i];
        ss += __shfl_xor(ss, 1); ss += __shfl_xor(ss, 2);
        const float rstd = 1.f / sqrtf(ss * (1.f / HD) + NORM_EPS);
        float o[16];
#pragma unroll
        for (int i = 0; i < 16; ++i) {
            const float xn = x[i] * rstd * gv[i]; const float xp = __shfl_xor(xn, 1);
            float sn, cs; sincosf(pos * inv[i], &sn, &cs);
            o[i] = (half == 0 ? (xn * cs - xp * sn) : (xp * sn + xn * cs)) * osc;
        }
        v4u r0, r1;
        r0.x = pk2(o[0], o[1]); r0.y = pk2(o[2], o[3]); r0.z = pk2(o[4], o[5]); r0.w = pk2(o[6], o[7]);
        r1.x = pk2(o[8], o[9]); r1.y = pk2(o[10], o[11]); r1.z = pk2(o[12], o[13]); r1.w = pk2(o[14], o[15]);
        p[0] = r0; p[1] = r1;
    }
}

__device__ __forceinline__ void phase_transpose_mix(const bf16* MIXT, bf16* MIX, int blk, int nblk, int tid) {
    for (int it = blk; it < (D_MAIN / 64) * (M_TOK / NTHREADS); it += nblk) {
        const int cb = it % (D_MAIN / 64), mb = it / (D_MAIN / 64); const int m = mb * NTHREADS + tid, c0 = cb * 64;
        unsigned w[32];
#pragma unroll
        for (int c = 0; c < 32; ++c) { const unsigned lo = MIXT[(size_t)(c0 + 2 * c) * M_TOK + m], hi = MIXT[(size_t)(c0 + 2 * c + 1) * M_TOK + m]; w[c] = lo | (hi << 16); }
        GAS v4u* d = (GAS v4u*)(MIX + (size_t)m * DM + c0);
#pragma unroll
        for (int q = 0; q < 8; ++q) { v4u o; o.x = w[4 * q]; o.y = w[4 * q + 1]; o.z = w[4 * q + 2]; o.w = w[4 * q + 3]; d[q] = o; }
    }
}
__device__ __forceinline__ void phase_taps(const float* H2j, const float* w3, float* TAPS, int gw, int NGW, int lane) {
    typedef float f32x16 __attribute__((ext_vector_type(16))); typedef short bf16x8_t __attribute__((ext_vector_type(8)));
    const float min_decay = -4.605170185988091f / 1.5f, max_decay = -4.605170185988091f / 0.3f;
    const int li = lane & 31, hi = lane >> 5;
#pragma unroll 1
    for (int it = gw; it < (FCOLS / 32) * (SEQ / 128); it += NGW) {
        const int ct = it % (FCOLS / 32), ng = it / (FCOLS / 32), col0 = ct * 32;
        bf16x8_t a[4];
#pragma unroll
        for (int s = 0; s < 4; ++s) { float t[8];
#pragma unroll
            for (int j = 0; j < 8; ++j) t[j] = w3[(size_t)(16 * s + 8 * hi + j) * FCOLS + col0 + li];
            v4u p; p.x = pk2(t[0], t[1]); p.y = pk2(t[2], t[3]); p.z = pk2(t[4], t[5]); p.w = pk2(t[6], t[7]); a[s] = __builtin_bit_cast(bf16x8_t, p); }
        f32x4 hv[4][8];
#pragma unroll
        for (int nt = 0; nt < 4; ++nt) { const GAS f32x4* hp = (const GAS f32x4*)(H2j + (size_t)(ng * 128 + nt * 32 + li) * HY_FILT + 8 * hi);
#pragma unroll
            for (int s = 0; s < 4; ++s) { hv[nt][2 * s] = hp[4 * s]; hv[nt][2 * s + 1] = hp[4 * s + 1]; } }
#pragma unroll
        for (int nt = 0; nt < 4; ++nt) {
            const int n0 = ng * 128 + nt * 32;
            f32x16 acc;
#pragma unroll
            for (int r = 0; r < 16; ++r) acc[r] = 0.f;
#pragma unroll
            for (int s = 0; s < 4; ++s) { const f32x4 v0 = hv[nt][2 * s], v1 = hv[nt][2 * s + 1];
                v4u p; p.x = pk2(v0.x, v0.y); p.y = pk2(v0.z, v0.w); p.z = pk2(v1.x, v1.y); p.w = pk2(v1.z, v1.w);
                acc = __builtin_amdgcn_mfma_f32_32x32x16_bf16(a[s], __builtin_bit_cast(bf16x8_t, p), acc, 0, 0, 0); }
            const float t = (float)(n0 + li) * (1.0f / (float)(SEQ - 1));
#pragma unroll
            for (int r = 0; r < 16; ++r) { const int col = col0 + (r & 3) + 8 * (r >> 2) + 4 * hi, c = col % D_MAIN;
                const float ad = fabsf(min_decay + (float)c * ((max_decay - min_decay) / (float)(D_MAIN - 1)));
                TAPS[(size_t)col * SEQ + n0 + li] = acc[r] * expf(-t * ad); }
        }
    }
}

__device__ __forceinline__ constexpr float twc(int k) { constexpr float T[16] = {1.0f, 0.98078528040323043f, 0.92387953251128674f, 0.83146961230254524f, 0.70710678118654757f, 0.55557023301960218f, 0.38268343236508978f, 0.19509032201612825f,
    0.0f, -0.19509032201612825f, -0.38268343236508978f, -0.55557023301960218f, -0.70710678118654757f, -0.83146961230254524f, -0.92387953251128674f, -0.98078528040323043f}; return T[k]; }
__device__ __forceinline__ constexpr float tws(int k) { constexpr float T[16] = {0.0f, 0.19509032201612825f, 0.38268343236508978f, 0.55557023301960218f, 0.70710678118654757f, 0.83146961230254524f, 0.92387953251128674f, 0.98078528040323043f,
    1.0f, 0.98078528040323043f, 0.92387953251128674f, 0.83146961230254524f, 0.70710678118654757f, 0.55557023301960218f, 0.38268343236508978f, 0.19509032201612825f}; return T[k]; }
__device__ __forceinline__ constexpr int bitrev(int i, int bits) { int r = 0; for (int b = 0; b < bits; ++b) if (i & (1 << b)) r |= 1 << (bits - 1 - b); return r; }

template <int N, int LEN> struct FftStage {
    static __device__ __forceinline__ void run(float (&re)[N], float (&im)[N]) {
        constexpr int half = LEN / 2, step = 32 / LEN;
#pragma unroll
        for (int base = 0; base < N; base += LEN)
#pragma unroll
            for (int j = 0; j < half; ++j) {
                const int i0 = base + j, i1 = i0 + half, idx = j * step;
                const float ar = re[i0], ai = im[i0], br = re[i1], bi = im[i1];
                re[i0] = ar + br; im[i0] = ai + bi;
                const float dr = ar - br, di = ai - bi;
                if (idx == 0) { re[i1] = dr; im[i1] = di; }
                else if (idx == 8) { re[i1] = di; im[i1] = -dr; }
                else { const float c = twc(idx), s = tws(idx); re[i1] = dr * c + di * s; im[i1] = di * c - dr * s; }
            }
        if constexpr (LEN > 2) FftStage<N, LEN / 2>::run(re, im);
    }
};
template <int N, int BITS> __device__ __forceinline__ void fft_reg(float (&re)[N], float (&im)[N]) {
    FftStage<N, N>::run(re, im);
    float tr[N], ti[N];
#pragma unroll
    for (int i = 0; i < N; ++i) { tr[bitrev(i, BITS)] = re[i]; ti[bitrev(i, BITS)] = im[i]; }
#pragma unroll
    for (int i = 0; i < N; ++i) { re[i] = tr[i]; im[i] = ti[i]; }
}

template <int N, int LEN> struct FftStageC {
    static __device__ __forceinline__ void run(f32x2 (&x)[N]) {
        constexpr int half = LEN / 2, step = 32 / LEN;
#pragma unroll
        for (int base = 0; base < N; base += LEN)
#pragma unroll
            for (int j = 0; j < half; ++j) {
                const int i0 = base + j, i1 = i0 + half, idx = j * step;
                const f32x2 a = x[i0], b = x[i1];
                x[i0] = a + b;
                const f32x2 d = a - b;
                if (idx == 0) x[i1] = d;
                else if (idx == 8) x[i1] = (f32x2){d.y, -d.x};
                else { const float c = twc(idx), s = tws(idx); const f32x2 t = (f32x2){d.y, -d.x}; x[i1] = d * c + t * s; }
            }
        if constexpr (LEN > 2) FftStageC<N, LEN / 2>::run(x);
    }
};
template <int N, int BITS> __device__ __forceinline__ void fft_regc(f32x2 (&x)[N]) {
    FftStageC<N, N>::run(x);
    f32x2 t[N];
#pragma unroll
    for (int i = 0; i < N; ++i) t[bitrev(i, BITS)] = x[i];
#pragma unroll
    for (int i = 0; i < N; ++i) x[i] = t[i];
}
__device__ __forceinline__ void fft16k_c(f32x2 (&x)[32], LAS f32x2* L, int tid_in) {
    int tid = tid_in; asm volatile("" : "+v"(tid));
    fft_regc<32, 5>(x);
#pragma unroll
    for (int k1 = 1; k1 < 32; ++k1) { const float fr = (float)((tid * k1) & 16383) * (1.0f / 16384.0f); const float c = __builtin_amdgcn_cosf(fr), s = __builtin_amdgcn_sinf(fr);
        const f32x2 d = x[k1], t = (f32x2){d.y, -d.x}; x[k1] = d * c + t * s; if ((k1 & 3) == 3) __builtin_amdgcn_sched_barrier(0); }
#pragma unroll
    for (int k1 = 0; k1 < 32; ++k1) L[k1 * 513 + tid] = x[k1];
    __syncthreads();
    const int n3 = tid & 31, ka = tid >> 5;
    f32x2 a[16], b[16];
#pragma unroll
    for (int n2 = 0; n2 < 16; ++n2) { a[n2] = L[ka * 513 + n2 * 32 + n3]; b[n2] = L[(ka + 16) * 513 + n2 * 32 + n3]; }
    fft_regc<16, 4>(a); fft_regc<16, 4>(b);
#pragma unroll
    for (int k2 = 1; k2 < 16; ++k2) { const float fr = (float)((n3 * k2) & 511) * (1.0f / 512.0f); const float c = __builtin_amdgcn_cosf(fr), s = __builtin_amdgcn_sinf(fr);
        f32x2 d = a[k2], t = (f32x2){d.y, -d.x}; a[k2] = d * c + t * s; d = b[k2]; t = (f32x2){d.y, -d.x}; b[k2] = d * c + t * s; if ((k2 & 3) == 3) __builtin_amdgcn_sched_barrier(0); }
    __syncthreads();
#pragma unroll
    for (int k2 = 0; k2 < 16; ++k2) { L[n3 * 513 + k2 * 32 + ka] = a[k2]; L[n3 * 513 + k2 * 32 + ka + 16] = b[k2]; }
    __syncthreads();
#pragma unroll
    for (int q = 0; q < 32; ++q) x[q] = L[q * 513 + tid];
    fft_regc<32, 5>(x);
}
__device__ __forceinline__ void fft16k(float (&re)[32], float (&im)[32], LAS f32x2* L, int tid) {
    f32x2 x[32];
#pragma unroll
    for (int r = 0; r < 32; ++r) x[r] = (f32x2){re[r], im[r]};
    fft16k_c(x, L, tid);
#pragma unroll
    for (int r = 0; r < 32; ++r) { re[r] = x[r].x; im[r] = x[r].y; }
}

constexpr int HS_SP = SEQ + 16;
__device__ __forceinline__ void hy_stage(LAS bf16* S, int slot, const bf16* src, int tid) {
    LAS bf16* d = S + slot * HS_SP + 8;
    if (tid == 0) { d[-1] = 0; d[SEQ] = 0; }
#pragma unroll
    for (int q = 0; q < 2; ++q) { const int ch = q * NTHREADS + tid; *(LAS v4u*)(d + ch * 8) = *(const GAS v4u*)(src + ch * 8); }
}
__device__ __forceinline__ float hy_sc(const LAS bf16* S, int slot, int t, float w0, float w1, float w2) {
    const LAS bf16* p = S + slot * HS_SP + 8 + t;
    return bf2f(p[-1]) * w0 + bf2f(p[0]) * w1 + bf2f(p[1]) * w2;
}

#ifdef CSEL
#define CT(sec) do { const unsigned long long tn_ = __builtin_amdgcn_s_memrealtime(); if (csec_ == CSEL && blk == 0 && tid_in == 0) ctime_ += tn_ - ct0_; ct0_ = tn_; csec_ = (sec); } while (0)
#else
#define CT(sec)
#endif
__device__ __forceinline__ void phase_hyena_conv(const bf16* PT, const float* TAPS, const float* shortw, const float* skip, f32x2* XSall, bf16* MIXT,
                                                 LAS unsigned char* lds, int blk, int nblk, int tid_in, int lane, int wave, int pmode = 0) {
    LAS f32x2* L = (LAS f32x2*)lds; LAS bf16* S = (LAS bf16*)lds; LAS float* red = (LAS float*)(lds + LDS_MISC);
    f32x2* XS = XSall + (size_t)blk * 16384;
    f32x2* ZS = XS + 16384 * 256;
    constexpr int N = 16384;
#ifdef CSEL
    unsigned long long ctime_ = 0ull, ct0_ = __builtin_amdgcn_s_memrealtime(); int csec_ = -1;
#endif
#pragma unroll 1
    for (int c = blk; c < D_MAIN; c += nblk) {
        const float* hf0 = TAPS + (size_t)c * SEQ; const float* hb0 = TAPS + (size_t)(D_MAIN + c) * SEQ;
        const float* hf1 = TAPS + (size_t)(2 * D_MAIN + c) * SEQ; const float* hb1 = TAPS + (size_t)(3 * D_MAIN + c) * SEQ;
        const bf16* px1 = PT + (size_t)c * M_TOK; const bf16* px2 = PT + (size_t)(D_MAIN + c) * M_TOK; const bf16* pv = PT + (size_t)(2 * D_MAIN + c) * M_TOK;
        const float wx1[3] = {shortw[c], shortw[2304 + c], shortw[4608 + c]};
        const float wx2[3] = {shortw[D_MAIN + c], shortw[2304 + D_MAIN + c], shortw[4608 + D_MAIN + c]};
        const float wv[3] = {shortw[2 * D_MAIN + c], shortw[2304 + 2 * D_MAIN + c], shortw[4608 + 2 * D_MAIN + c]};
        const float sk0 = skip[c], sk1 = skip[D_MAIN + c];
        f32x2 x[32]; float vr[16], vi[16];
#pragma unroll 1
        for (int pass = 0; pass < 5; ++pass) {
            int tid = tid_in; asm volatile("" : "+v"(tid));
            CT(pass == 0 ? 0 : (pass == 1 ? 7 : 8));
            if (pass == 0) {
#pragma unroll
                for (int r = 0; r < 16; ++r) { const int n = r * 512 + tid; x[r].x = hf0[n]; x[r].y = hf1[n]; }
#pragma unroll
                for (int r = 16; r < 32; ++r) { const int idx = (32 - r) * 512 - tid; const bool z = (idx == SEQ); const int ii = z ? 0 : idx; x[r].x = z ? 0.f : hb0[ii]; x[r].y = z ? 0.f : hb1[ii]; }
                float e0 = 0.f, e1 = 0.f;
                if (tid == 0) { e0 = hb0[0]; e1 = hb1[0]; }
                float s0 = fabsf(e0), s1 = fabsf(e1);
#pragma unroll
                for (int r = 0; r < 32; ++r) { s0 += fabsf(x[r].x); s1 += fabsf(x[r].y); }
                s0 = wave_sum(s0); s1 = wave_sum(s1);
                __syncthreads();
                if (lane == 0) { red[wave] = s0; red[8 + wave] = s1; }
                __syncthreads();
                float t0 = 0.f, t1 = 0.f;
#pragma unroll
                for (int w = 0; w < NWAVES; ++w) { t0 += red[w]; t1 += red[8 + w]; }
                const float sc0 = 1.0f / (t0 + 1e-6f), sc1 = 1.0f / (t1 + 1e-6f);
                x[0].x += e0; x[0].y += e1;
#pragma unroll
                for (int r = 0; r < 32; ++r) { x[r].x *= sc0; x[r].y *= sc1; }
            } else if (pass == 1) {
                __syncthreads();
                hy_stage(S, 0, pv, tid); hy_stage(S, 1, pv + SEQ, tid);
                __syncthreads();
#pragma unroll
                for (int r = 0; r < 16; ++r) { const int t = r * 512 + tid; x[r].x = hy_sc(S, 0, t, wv[0], wv[1], wv[2]); x[r].y = hy_sc(S, 1, t, wv[0], wv[1], wv[2]); vr[r] = x[r].x; vi[r] = x[r].y; }
#pragma unroll
                for (int r = 16; r < 32; ++r) { x[r].x = 0.f; x[r].y = 0.f; }
            }
            __syncthreads();
            CT(1);
            fft16k_c(x, L, tid);
            CT(2 + pass);
            if (pass == 0) {
#pragma unroll
                for (int r = 0; r < 32; ++r) XS[r * 512 + tid] = (f32x2){x[r].x, x[r].y};
                __syncthreads();
            } else if (pass == 1 || pass == 3) {
#pragma unroll
                for (int r = 0; r < 32; ++r) {
                    const int f = r * 512 + tid; const f32x2 xa = XS[f], xb = XS[(N - f) & (N - 1)];
                    float kr, ki;
                    if (pass == 1) { kr = xa.x + xb.x; ki = xa.y - xb.y; } else { kr = xa.y + xb.y; ki = xb.x - xa.x; }
                    kr *= (0.5f / (float)N); ki *= (0.5f / (float)N);
                    const float zr_ = x[r].x, zi_ = x[r].y;
                    x[r].x = zr_ * kr - zi_ * ki; x[r].y = -(zr_ * ki + zi_ * kr);
                }
            } else if (pass == 2) {
                __syncthreads();
                hy_stage(S, 2, px1, tid); hy_stage(S, 3, px1 + SEQ, tid);
                __syncthreads();
#pragma unroll
                for (int r = 0; r < 16; ++r) { const int t = r * 512 + tid;
                    const float v0 = vr[r], v1 = vi[r];
                    const float g0 = hy_sc(S, 2, t, wx1[0], wx1[1], wx1[2]), g1 = hy_sc(S, 3, t, wx1[0], wx1[1], wx1[2]);
                    x[r].x = g0 * (x[r].x + sk0 * v0); x[r].y = g1 * (-x[r].y + sk0 * v1); ZS[t] = (f32x2){x[r].x, x[r].y}; }
#pragma unroll
                for (int r = 16; r < 32; ++r) { x[r].x = 0.f; x[r].y = 0.f; }
            } else {
                __syncthreads();
                hy_stage(S, 0, px2, tid); hy_stage(S, 1, px2 + SEQ, tid);
                __syncthreads();
#pragma unroll
                for (int r = 0; r < 16; ++r) { const int t = r * 512 + tid;
                    const float g0 = hy_sc(S, 0, t, wx2[0], wx2[1], wx2[2]), g1 = hy_sc(S, 1, t, wx2[0], wx2[1], wx2[2]);
                    const f32x2 z = ZS[t];
                    const float o0 = g0 * (x[r].x + sk1 * z.x), o1 = g1 * (-x[r].y + sk1 * z.y);
                    MIXT[(size_t)c * M_TOK + t] = (bf16)f2bf(o0); MIXT[(size_t)c * M_TOK + SEQ + t] = (bf16)f2bf(o1); }
            }
        }
        CT(-1);
        __syncthreads();
    }
#ifdef CSEL
    if (blk == 0 && tid_in == 0) *(unsigned long long*)((unsigned char*)XSall - WS_FFTX + 32768) += ctime_;
#endif
}
#ifndef MK_PER_PHASE
#define MK_PER_PHASE 0
#endif
#ifndef CONV_PMODE
#define CONV_PMODE 0
#endif
#ifndef REPMASK
#define REPMASK 0u
#endif
#define REP(kind) _Pragma("unroll 1") for (int r_ = 0; r_ < 1 + (int)((REPMASK >> (kind)) & 1u); ++r_)
struct Args {
    const float* in[24]; float* out; unsigned char* ws; int ph_lo, ph_hi;
};
constexpr int N_PHASES = 1 + (DEPTH - 1) + DEPTH * 8 - DEPTH / 2 + 1;

template <int QP, int KP>
__device__ __forceinline__ void run_attn(const bf16* Q, const bf16* K, const bf16* V, bf16* O, int NT, char* shm) {
    attn_body::attn_unit<8, QP, KP, DM>((const attn_body::bf16*)Q, (const attn_body::bf16*)K, (const attn_body::bf16*)V, (attn_body::bf16*)O, NT, shm);
}

__global__ void __launch_bounds__(NTHREADS, 2) hybrid_fwd(Args args) {
    extern __shared__ __attribute__((aligned(16))) unsigned char lds_raw[];
    LAS unsigned char* lds = (LAS unsigned char*)lds_raw;
    const int G = gridDim.x, bx = blockIdx.x;
    const int vcu = (G % 8 == 0) ? (bx % 8) * (G / 8) + bx / 8 : bx;
    const int NGW = G * NWAVES;
    unsigned char* ws = args.ws;
    const float* x = args.in[0]; const float* mem = args.in[1]; const float* mix_g = args.in[2]; const float* ffn_g = args.in[3]; const float* mem_g = args.in[4]; const float* fin_g = args.in[5];
    const float* hy_short = args.in[9]; const float* f_w1 = args.in[10]; const float* f_b1 = args.in[11]; const float* f_w2 = args.in[12]; const float* f_b2 = args.in[13];
    const float* f_w3 = args.in[14]; const float* f_freq = args.in[15]; const float* hy_skip = args.in[16]; const float* qg = args.in[18]; const float* kg = args.in[19]; const float* router = args.in[20];
    float* H = args.out;
    bf16* U = (bf16*)(ws + WS_U); bf16* PROJ = (bf16*)(ws + WS_PROJ); bf16* CQ = (bf16*)(ws + WS_CQ); bf16* MIX = (bf16*)(ws + WS_MIX); bf16* MIXT = (bf16*)(ws + WS_MIXT);
    float* AFF = (float*)(ws + WS_AFF); int* IDX = (int*)(ws + WS_IDX); float* GATE = (float*)(ws + WS_GATE); int* POS = (int*)(ws + WS_POS);
    bf16* XG = (bf16*)(ws + WS_XG); bf16* HID = (bf16*)(ws + WS_HID); bf16* Y = (bf16*)(ws + WS_Y); float* TAPS = (float*)(ws + WS_TAPS);
    const bf16* MKV = (const bf16*)(ws + WS_MKV);
    cg::grid_group grid = cg::this_grid();
    volatile LAS unsigned* bst = (volatile LAS unsigned*)(lds + LDS_MISC + 4096);
    if (threadIdx.x < 2) bst[threadIdx.x] = 0u;
    __syncthreads();
    XcdBarrier xbar = xcd_barrier_post((unsigned*)(ws + WS_CTL) + 1024, bst);
    const int lo = args.ph_lo, hi = args.ph_hi;
    const XwIn XW{args.in[21], args.in[22], args.in[23], ws}; const bool xw_sched = (G == 256);
    int ph = 0;
#ifdef TSEL
    unsigned long long tacc_ = 0ull, t0_ = 0ull, t1_ = 0ull; int pk_ = 0;
#endif
#ifdef TSEL
#ifndef TAMP
#define TAMP 10
#endif
#ifndef TBAR
#define TBAR 0
#endif
#define PH_T0(k) pk_ = (k); t0_ = __builtin_amdgcn_s_memrealtime();
#define PH_T1 t1_ = __builtin_amdgcn_s_memrealtime(); if (!TBAR && (pk_ == TSEL || TSEL == 99)) tacc_ += t1_ - t0_;
#define PH_T2 if (TBAR && (pk_ == TSEL || TSEL == 99)) tacc_ += __builtin_amdgcn_s_memrealtime() - t1_;
#else
#define PH_T0(k)
#define PH_T1
#define PH_T2
#endif
#define PHASE_BEGINK(k) PH_T0(k) if (lo <= ph && ph < hi) { const int tid = opaque_tid(), lane = tid & 63, wave = __builtin_amdgcn_readfirstlane(tid >> 6), gw = vcu * NWAVES + wave; (void)lane; (void)gw;
#ifdef EXTRA_XBAR
#define PHASE_END   if (ph + 1 < hi) { if (ph == lo) grid.sync(); else { xcd_barrier(xbar); if (ph < EXTRA_XBAR) xcd_barrier(xbar); } } } ++ph;
#else
#define PHASE_END   PH_T1 if (ph + 1 < hi) { if (ph == lo) grid.sync(); else xcd_barrier(xbar); } PH_T2 } ++ph;
#endif

    PHASE_BEGINK(0)
        ProIn P{args.in[8], args.in[17], args.in[7], args.in[6]};
        REP(0) { phase_weights(P, ws, lds, gw, NGW, wave, lane); phase_xw_p0(XW, xw_sched, (LAS float*)(lds + wave * 16384), gw, NGW, lane); }
        phase_wrg(ffn_g, router, (float*)(ws + WS_WRG), (int)(bx * NTHREADS + tid), (int)(G * NTHREADS));
        REP(1) phase_mem_h2(mem, mem_g, f_w1, f_b1, f_w2, f_b2, f_freq, ws, gw, NGW, lane);
        REP(3) phase_norm<false, false>(x, nullptr, mix_g, U, nullptr, nullptr, nullptr, gw, NGW, lane);
    PHASE_END

#pragma unroll 1
    for (int i = 0; i < DEPTH; ++i) {
        const bool hy = (i & 1) == 0; const int j = i >> 1;
        if (i > 0) {
        PHASE_BEGINK(1)
            phase_norm<true, false>(H, H, mix_g + i * DM, U, nullptr, POS, Y, gw, NGW, lane);
        PHASE_END
        }
        PHASE_BEGINK(2)
            if (i == 0) {
                pg8::Gemm g{(const bf16*)(ws + WS_MEMN), (const bf16*)(ws + WS_WMKV), BATCH * MEM_LEN, 2048, DM, 1 << 30, 1, 0};
                pg8::StaticOrder S; S.init(BATCH * MEM_LEN, 2048, G, bx);
                pg8::EpiRowBf16 E{(bf16*)(ws + WS_MKV), 2048, -1, 1.f};
                pg8::gemm_phase<pg8::EpiRowBf16, pg8::StaticOrder, true, true>(lds, g, S, E);
            }
            if (hy) {
                REP(4) phase_taps((const float*)(ws + WS_H2) + (size_t)j * SEQ * HY_FILT, f_w3 + (size_t)j * HY_FILT * FCOLS, TAPS, gw, NGW, lane);
                pg8::Gemm g{U, (const bf16*)(ws + WS_WHY) + (size_t)j * D_IN_HY * DM, M_TOK, D_IN_HY, DM, 1 << 30, 1, 0};
                pg8::StaticOrder S; S.init(M_TOK, D_IN_HY, G, bx);
                pg8::EpiHyIn E{PROJ, M_TOK, 9, CQ, ATT_C2};
                REP(5) pg8::gemm_phase<pg8::EpiHyIn, pg8::StaticOrder, true, true>(lds, g, S, E);
            } else {
                pg8::Gemm g{U, (const bf16*)(ws + WS_WAT) + (size_t)j * D_IN_AT * DM, M_TOK, D_IN_AT, DM, 1 << 30, 1, 0};
                pg8::StaticOrder S; S.init(M_TOK, D_IN_AT, G, bx);
                pg8::EpiAtIn E{PROJ, D_IN_AT, qg + j * HD, kg + j * HD, ATT_C2, NORM_EPS, SEQ - 1};
                REP(6) pg8::gemm_phase<pg8::EpiAtIn, pg8::StaticOrder, true, true>(lds, g, S, E);
            }
            if (xw_sched && bx >= 128) xw_slice_a(XW, i, (LAS float*)(lds + wave * 16384), bx, wave, lane);
        PHASE_END
        PHASE_BEGINK(3)
            if (hy) {
                REP(8) phase_hyena_conv(PROJ, TAPS, hy_short + (size_t)j * 3 * 2304, hy_skip + (size_t)j * 2 * D_MAIN, (f32x2*)(ws + WS_FFTX), MIXT, lds, bx, G, tid, lane, wave);
                REP(9) for (int u = vcu; u < 256; u += G) { const int b = u >> 7, h4 = (u >> 5) & 3, qb = u & 31; const size_t row = (size_t)b * SEQ + qb * 256;
                    run_attn<256, 2048>(CQ + row * 256 + h4 * HD, MKV + (size_t)b * MEM_LEN * 2048 + i * 512 + h4 * HD, MKV + (size_t)b * MEM_LEN * 2048 + i * 512 + 256 + h4 * HD,
                                        MIX + row * DM + D_MAIN + h4 * HD, MEM_LEN / 64, (char*)lds_raw); }
            } else {
                REP(10) for (int u = vcu; u < 768; u += G) { const int bk = (u & 255) >> 5, qb = u & 31, hs = u >> 8, b = bk >> 2, kvh = bk & 3, h = kvh * 3 + hs; const size_t row = (size_t)b * SEQ + qb * 256;
                    run_attn<D_IN_AT, D_IN_AT>(PROJ + row * D_IN_AT + h * HD, PROJ + (size_t)b * SEQ * D_IN_AT + D_MAIN + kvh * HD, PROJ + (size_t)b * SEQ * D_IN_AT + D_MAIN + 256 + kvh * HD,
                                               MIX + row * DM + h * HD, SEQ / 64, (char*)lds_raw); }
                REP(9) for (int u = vcu; u < 256; u += G) { const int b = u >> 7, h4 = (u >> 5) & 3, qb = u & 31; const size_t row = (size_t)b * SEQ + qb * 256;
                    run_attn<D_IN_AT, 2048>(PROJ + row * D_IN_AT + 1280 + h4 * HD, MKV + (size_t)b * MEM_LEN * 2048 + i * 512 + h4 * HD, MKV + (size_t)b * MEM_LEN * 2048 + i * 512 + 256 + h4 * HD,
                                            MIX + row * DM + D_MAIN + h4 * HD, MEM_LEN / 64, (char*)lds_raw); }
            }
        PHASE_END
        if (hy) {
            PHASE_BEGINK(4)
                REP(11) phase_transpose_mix(MIXT, MIX, bx, G, tid);
            PHASE_END
        }
        PHASE_BEGINK(5)
            pg8::Gemm g{MIX, (const bf16*)(ws + WS_WOUT) + (size_t)i * DM * DM, M_TOK, DM, DM, 1 << 30, 1, 0};
            pg8::StaticOrder S; S.init(M_TOK, DM, G, bx);
            pg8::EpiOutX E{i == 0 ? x : (const float*)H, H, DM, ffn_g + i * DM, (const float*)(ws + WS_WRG) + (size_t)i * NEXP * DM, (unsigned char*)U, (float*)(ws + WS_PART), (float*)(ws + WS_PSS), M_TOK};
            pg8::gemm_phase<pg8::EpiOutX, pg8::StaticOrder, true, true>(lds, g, S, E);
        PHASE_END
        PHASE_BEGINK(6)
            REP(13) phase_router_sum((const float*)(ws + WS_PART), (const float*)(ws + WS_PSS), (float*)(ws + WS_RSTD), AFF, gw, NGW, lane);
        PHASE_END
        PHASE_BEGINK(7)
            REP(14) phase_topk(AFF, (const float*)(ws + WS_RSTD), (float*)(ws + WS_RS), IDX, GATE, POS, lds + LDS_MISC, bx, G, tid, lane, wave);
            if (xw_sched && bx >= 32) xw_slice_b(XW, i, (LAS float*)(lds + wave * 16384), bx, wave, lane);
        PHASE_END
        PHASE_BEGINK(8)
            pg8::Gemm g{U, (const bf16*)(ws + WS_W1 + (size_t)i * NEXP * 1536 * DM), XROWS, 1536, DM / 2, 4, NEXP, (size_t)1536 * DM};
            pg8::StaticOrder S; S.init(XROWS, 1536, G, bx);
            pg8::EpiSwiGLU8 E{(unsigned char*)HID, EFF, 1.0f / W8_SCALE, (const float*)(ws + WS_RS)};
            REP(16) pg8::gemm_phase<pg8::EpiSwiGLU8, pg8::StaticOrder, true, true, true, true>(lds, g, S, E, IDX);
        PHASE_END
        PHASE_BEGINK(9)
            pg8::Gemm g{HID, (const bf16*)(ws + WS_W2 + (size_t)i * NEXP * DM * EFF), XROWS, DM, EFF / 2, 4, NEXP, (size_t)DM * EFF};
            pg8::StaticOrder S; S.init(XROWS, DM, G, bx);
            pg8::EpiDown E{Y, DM, GATE, 1.0f / W8_SCALE};
            REP(17) pg8::gemm_phase<pg8::EpiDown, pg8::StaticOrder, true, true, false, true>(lds, g, S, E);
        PHASE_END
    }
    PHASE_BEGINK(10)
        phase_norm<true, true>(H, nullptr, fin_g, nullptr, args.out, POS, Y, gw, NGW, lane);
    PHASE_END
#ifdef TSEL
#ifdef CSEL
    if (bx == 0 && threadIdx.x == 0) tacc_ += *(unsigned long long*)(ws + 32768);
#endif
    if (bx == 0 && threadIdx.x == 0 && hi - lo > 1) { const unsigned long long te_ = __builtin_amdgcn_s_memrealtime(); while (__builtin_amdgcn_s_memrealtime() - te_ < (unsigned long long)TAMP * tacc_) __builtin_amdgcn_s_sleep(8); }
#endif
#undef PHASE_BEGINK
#undef PHASE_END
}

extern "C" void kernel_launch(void* const* d_in, const int* in_sizes, int n_in, void* d_out, int out_size, void* d_ws, size_t ws_size, hipStream_t stream) {
    static int grid = 0;
    if (grid == 0) {
        if (n_in != 24 || out_size != M_TOK * DM || ws_size < WS_END) { fprintf(stderr, "kernel_launch: unexpected shapes (n_in %d out %d ws %zu need %zu)\n", n_in, out_size, ws_size, (size_t)WS_END); grid = -1; return; }
        int dev = 0, cus = 0, per_cu = 0;
        if (hipGetDevice(&dev) != hipSuccess || hipDeviceGetAttribute(&cus, hipDeviceAttributeMultiprocessorCount, dev) != hipSuccess) { grid = -1; return; }
        if (hipFuncSetAttribute((const void*)hybrid_fwd, hipFuncAttributeMaxDynamicSharedMemorySize, LDS_BYTES) != hipSuccess) { fprintf(stderr, "kernel_launch: hipFuncSetAttribute failed\n"); grid = -1; return; }
        if (hipOccupancyMaxActiveBlocksPerMultiprocessor(&per_cu, (const void*)hybrid_fwd, NTHREADS, LDS_BYTES) != hipSuccess || per_cu < 1) { fprintf(stderr, "kernel_launch: occupancy query says %d blocks/CU\n", per_cu); per_cu = 1; }
        (void)hipGetLastError();
        grid = cus;
    }
    if (grid < 0) return;
    if (hipMemsetAsync((char*)d_ws + WS_CTL, 0, 64 * 1024, stream) != hipSuccess) { fprintf(stderr, "kernel_launch: memset failed\n"); return; }
    Args a{};
    for (int i = 0; i < 24; ++i) a.in[i] = (const float*)d_in[i];
    a.out = (float*)d_out; a.ws = (unsigned char*)d_ws;
#if MK_PER_PHASE
    for (int li = 0; li < N_PHASES; ++li) {
        a.ph_lo = li; a.ph_hi = li + 1;
        void* kargs[] = {&a};
        hipError_t e = hipLaunchCooperativeKernel((const void*)hybrid_fwd, dim3(grid), dim3(NTHREADS), kargs, LDS_BYTES, stream);
        if (e != hipSuccess) { fprintf(stderr, "kernel_launch: launch %d failed: %s\n", li, hipGetErrorString(e)); break; }
    }
#else
    a.ph_lo = 0; a.ph_hi = N_PHASES;
    void* kargs[] = {&a};
    hipError_t e = hipLaunchCooperativeKernel((const void*)hybrid_fwd, dim3(grid), dim3(NTHREADS), kargs, LDS_BYTES, stream);
    if (e != hipSuccess) fprintf(stderr, "kernel_launch: cooperative launch failed: %s (grid %d)\n", hipGetErrorString(e), grid);
#endif
}
```

```cpp
#include <hip/hip_runtime.h>
#include <hip/hip_cooperative_groups.h>
#include <hip/hip_bf16.h>
#include <cmath>
#include <cstdio>
#include <cstdint>
namespace cg = cooperative_groups;

constexpr int BATCH = 2, SEQ = 8192, DM = 1024, DEPTH = 4, M_TOK = BATCH * SEQ;
constexpr int HD = 64, MEM_LEN = 256, D_MEM = 256, D_MAIN = 768, NQH = 12, NKVH = 4;
constexpr int D_IN_HY = 2560, D_IN_AT = 1536;
constexpr int NEXP = 16, CAP = 1024, EFF = 768, NGRP = BATCH * NEXP, XROWS = NGRP * CAP;
constexpr int HY_EMB = 33, HY_FILT = 64, FCOLS = 4 * D_MAIN;
constexpr float NORM_EPS = 1e-6f;
constexpr float W8_SCALE = 32.0f;
constexpr float ATT_C2 = 0.125f * 1.4426950408889634f;

constexpr size_t MiB = 1u << 20;
constexpr size_t WS_CTL = 0;
constexpr size_t WS_WHY = 2 * MiB;
constexpr size_t WS_WAT = 12 * MiB;
constexpr size_t WS_WOUT = 18 * MiB;
constexpr size_t WS_WMKV = 26 * MiB;
constexpr size_t WS_W1 = 32 * MiB;
constexpr size_t WS_W2 = 224 * MiB;
constexpr size_t WS_U = 320 * MiB;
constexpr size_t WS_PROJ = 352 * MiB;
constexpr size_t WS_CQ = WS_PROJ + 72 * MiB;
constexpr size_t WS_MIX = 432 * MiB;
constexpr size_t WS_MIXT = 464 * MiB;
constexpr size_t WS_AFF = 488 * MiB;
constexpr size_t WS_IDX = 489 * MiB;
constexpr size_t WS_GATE = WS_IDX + 128 * 1024;
constexpr size_t WS_POS = 490 * MiB;
constexpr size_t WS_XG = 492 * MiB;
constexpr size_t WS_HID = 556 * MiB;
constexpr size_t WS_TAPS = WS_XG;
constexpr size_t WS_Y = 604 * MiB;
constexpr size_t WS_FFTX = WS_Y;
constexpr size_t WS_H2 = 668 * MiB;
constexpr size_t WS_MEMN = 672 * MiB;
constexpr size_t WS_MKV = 673 * MiB;
constexpr size_t WS_PART = 676 * MiB;
constexpr size_t WS_PSS = 692 * MiB;
constexpr size_t WS_RSTD = 697 * MiB;
constexpr size_t WS_RS = WS_RSTD + 128 * 1024;
constexpr size_t WS_WRG = 698 * MiB;
constexpr size_t WS_ZS = 700 * MiB;
constexpr size_t WS_END = 732 * MiB;

constexpr int LDS_RING = 0;
constexpr int LDS_MISC = 132 * 1024;
constexpr int LDS_BYTES = 140 * 1024;
constexpr int NTHREADS = 512, NWAVES = 8;

#define GAS __attribute__((address_space(1)))
#define LAS __attribute__((address_space(3)))
typedef unsigned short bf16;
typedef unsigned v4u __attribute__((ext_vector_type(4)));
typedef unsigned v2u __attribute__((ext_vector_type(2)));
typedef float f32x4 __attribute__((ext_vector_type(4)));
typedef float f32x2 __attribute__((ext_vector_type(2)));
__device__ __forceinline__ unsigned f2bf(float f) { unsigned u = __builtin_bit_cast(unsigned, f); return (u + 0x7fffu + ((u >> 16) & 1u)) >> 16; }
__device__ __forceinline__ unsigned pk2(float lo, float hi) { return f2bf(lo) | (f2bf(hi) << 16); }
__device__ __forceinline__ float bf2f(unsigned short h) { return __builtin_bit_cast(float, (unsigned)h << 16); }
__device__ __forceinline__ float bflo(unsigned w) { return __builtin_bit_cast(float, w << 16); }
__device__ __forceinline__ float bfhi(unsigned w) { return __builtin_bit_cast(float, w & 0xffff0000u); }
__device__ __forceinline__ float wave_sum(float v) {
#pragma unroll
    for (int o = 1; o < 64; o <<= 1) v += __shfl_xor(v, o);
    return v;
}
__device__ __forceinline__ int opaque_tid() { int t = threadIdx.x; asm volatile("" : "+v"(t)); return t; }
#define MK_PER_PHASE 0

#define XB_TMO      128
#define XB_XCNT(j)  (256  + 64 * (j))
#define XB_XSUB(j)  (1280 + 64 * (j))
#define XB_XGEN(j)  (2304 + 64 * (j))
#define XB_TOP      3328
#define XB_TOPGEN   3392
#define XCD_BAR_WORDS 3456
#define XB_SPIN_CAP (1u << 18)

__device__ __forceinline__ unsigned xb_ld(unsigned* p)              { return __hip_atomic_load(p, __ATOMIC_RELAXED, __HIP_MEMORY_SCOPE_AGENT); }
__device__ __forceinline__ unsigned xb_add(unsigned* p, unsigned v) { return __hip_atomic_fetch_add(p, v, __ATOMIC_RELAXED, __HIP_MEMORY_SCOPE_AGENT); }
__device__ __forceinline__ unsigned xb_xcc_id() { return (unsigned)__builtin_amdgcn_s_getreg((3 << 11) | 20) & 0xFu; }
#define XB_SPIN(cond, bar) do { unsigned _sp = 0; while (cond) { __builtin_amdgcn_s_sleep(1); \
    if ((++_sp & 255u) == 0u) { if (xb_ld(&(bar)[XB_TMO])) break; if (_sp > XB_SPIN_CAP) { atomicAdd(&(bar)[XB_TMO], 1u); break; } } } } while (0)

struct XcdBarrier {
    unsigned* bar; unsigned x;
    volatile LAS unsigned* st;
};

__device__ __forceinline__ XcdBarrier xcd_barrier_post(unsigned* bar, volatile LAS unsigned* st) {
    XcdBarrier b; b.bar = bar; b.x = xb_xcc_id(); b.st = st;
    if (threadIdx.x == 0) (void)xb_add(&bar[XB_XCNT(b.x)], 1u);
    return b;
}
__device__ __forceinline__ void xcd_barrier_complete(unsigned* bar, unsigned x, unsigned& nloc, unsigned& nx) {
    const unsigned G = gridDim.x * gridDim.y * gridDim.z;
    unsigned sum, cnt, mine, sp = 0u;
    for (;;) {
        sum = 0u; cnt = 0u; mine = 0u;
#pragma unroll
        for (unsigned j = 0; j < 16; ++j) { const unsigned c = xb_ld(&bar[XB_XCNT(j)]); sum += c; cnt += (c > 0u) ? 1u : 0u; mine = (j == x) ? c : mine; }
        if (sum == G) break;
        __builtin_amdgcn_s_sleep(1);
        if ((++sp & 255u) == 0u) { if (xb_ld(&bar[XB_TMO])) break; if (sp > XB_SPIN_CAP) { atomicAdd(&bar[XB_TMO], 1u); break; } }
    }
    nloc = mine > 0u ? mine : 1u; nx = cnt > 0u ? cnt : 1u;
}

__device__ __forceinline__ void xcd_barrier(const XcdBarrier& b) {
    asm volatile("s_waitcnt vmcnt(0)" ::: "memory");
    __syncthreads();
    if (threadIdx.x == 0) {
        unsigned* bar = b.bar;
        __builtin_amdgcn_s_waitcnt(0);
        unsigned nloc = b.st[0], nx = b.st[1];
        if (nloc == 0u) { xcd_barrier_complete(bar, b.x, nloc, nx); b.st[0] = nloc; b.st[1] = nx; }
        const unsigned old = xb_add(&bar[XB_XSUB(b.x)], 1u);
        const unsigned gen = old / nloc;
        if (old + 1u == (gen + 1u) * nloc) {
            __builtin_amdgcn_fence(__ATOMIC_RELEASE, "agent");
            asm volatile("s_waitcnt vmcnt(0)" ::: "memory");
            const unsigned og = xb_add(&bar[XB_TOP], 1u);
            const unsigned tg = og / nx;
            if (og + 1u == (tg + 1u) * nx) xb_add(&bar[XB_TOPGEN], 1u);
            else XB_SPIN(xb_ld(&bar[XB_TOPGEN]) == tg, bar);
            __builtin_amdgcn_fence(__ATOMIC_ACQUIRE, "agent");
            xb_add(&bar[XB_XGEN(b.x)], 1u);
            asm volatile("s_waitcnt vmcnt(0)" ::: "memory");
        } else {
            XB_SPIN(xb_ld(&bar[XB_XGEN(b.x)]) == gen, bar);
            __builtin_amdgcn_fence(__ATOMIC_ACQUIRE, "agent");
            asm volatile("s_waitcnt vmcnt(0)" ::: "memory");
        }
    }
    __syncthreads();
}
namespace pg8 {
#define PG8_LAS __attribute__((address_space(3)))
typedef unsigned short bf16_t;
typedef short bf16x8 __attribute__((ext_vector_type(8)));
typedef float f32x4 __attribute__((ext_vector_type(4)));
typedef unsigned u32x4 __attribute__((ext_vector_type(4)));
constexpr int BM = 256, BK = 64, HALF = 128, HTB = HALF * BK * 2  , STAGE_BYTES = 8 * HTB, NXCD = 8, WGM = 8;

__host__ __device__ __forceinline__ int lds_byte(int r, int c) { const int st = (r >> 4) * 2 + (c >> 5), rr = r & 15, cc = c & 31, ob = rr * 64 + cc * 2; return st * 1024 + (ob ^ (((ob >> 9) & 1) << 5)); }
__host__ __device__ __forceinline__ void stage_rc(int b, int& R, int& C) { const int st = b / 1024, sb = b % 1024, swz = sb ^ (((sb >> 9) & 1) << 5); R = (st >> 1) * 16 + swz / 64; C = (st & 1) * 32 + (swz % 64) / 2; }
__host__ __device__ __forceinline__ int perm32(int rho) { const int n = rho >> 4, i = rho & 15; return 8 * (i >> 2) + 4 * n + (i & 3); }

struct Unit { int pm, pn; };
struct Gemm { const bf16_t* A; const bf16_t* Bt; int M, N, K; int gdiv, gmod; size_t gstride; };

struct StaticOrder {
    int nM, nN, nwg, G, c;
    __host__ __device__ void init(int M, int N, int G_, int c_) { nM = M / BM; nN = N / BM; nwg = nM * nN; G = G_; c = c_; }
    __host__ __device__ bool next(int i, Unit& u) const {
        const long L = (long)i * G + c; if (L >= nwg) return false;
        int wgid = (int)L; { const int q = nwg / NXCD, r = nwg % NXCD, xcd = wgid % NXCD, off = wgid / NXCD; wgid = (xcd < r ? xcd * (q + 1) : r * (q + 1) + (xcd - r) * q) + off; }
        const int nig = WGM * nN, gid = wgid / nig, fm = gid * WGM, gsz = (nM - fm) < WGM ? (nM - fm) : WGM;
        u.pm = fm + ((wgid % nig) % gsz); u.pn = (wgid % nig) / gsz; return true;
    }
    __device__ __forceinline__ void a_ready(const Unit&) const {}
    __device__ __forceinline__ void done(const Unit&) const {}
};


__device__ __forceinline__ unsigned cvt_pk_bf16(float lo, float hi) { unsigned r; asm volatile("v_cvt_pk_bf16_f32 %0, %1, %2" : "=v"(r) : "v"(lo), "v"(hi)); return r; }
typedef unsigned u32x2 __attribute__((ext_vector_type(2)));
struct EpiRowBf16 {
    static constexpr bool PERM = false, AFTER_DRAIN = false;
    bf16_t* O; int ldc; int sc_pn; float sc;
    __device__ __forceinline__ void operator()(const f32x4 (&acc)[2][2][4][2], const Unit& u, int wr, int wc, int fr, int fq) const {
        const float s = (u.pn == sc_pn) ? sc : 1.f;
        const int row0 = u.pm * BM + wr * 64 + fr, col0 = u.pn * BM + wc * 32 + 4 * fq;
#pragma unroll
        for (int ai = 0; ai < 2; ++ai)
#pragma unroll
            for (int m = 0; m < 4; ++m) { bf16_t* rowp = O + (size_t)(row0 + ai * HALF + m * 16) * ldc + col0;
#pragma unroll
                for (int bj = 0; bj < 2; ++bj)
#pragma unroll
                    for (int n = 0; n < 2; ++n) { const f32x4 v = acc[ai][bj][m][n] * s; u32x2 w; w.x = cvt_pk_bf16(v[0], v[1]); w.y = cvt_pk_bf16(v[2], v[3]);
                        *(u32x2*)(rowp + bj * HALF + n * 16) = w; } }
    }
};
struct EpiHyIn {
    static constexpr bool PERM = false, AFTER_DRAIN = false;
    bf16_t* OT; int ldt; int tp_tiles; bf16_t* CQ; float sc;
    __device__ __forceinline__ void operator()(const f32x4 (&acc)[2][2][4][2], const Unit& u, int wr, int wc, int fr, int fq) const {
        const int row0 = u.pm * BM + wr * 64 + fr;
        if (u.pn < tp_tiles) {
            const int col0 = u.pn * BM + wc * 32 + 4 * fq;
#pragma unroll
            for (int ai = 0; ai < 2; ++ai)
#pragma unroll
                for (int m = 0; m < 4; ++m) { const int row = row0 + ai * HALF + m * 16;
#pragma unroll
                    for (int bj = 0; bj < 2; ++bj)
#pragma unroll
                        for (int n = 0; n < 2; ++n) { const f32x4 v = acc[ai][bj][m][n]; const unsigned w0 = cvt_pk_bf16(v[0], v[1]), w1 = cvt_pk_bf16(v[2], v[3]);
                            bf16_t* p = OT + (size_t)(col0 + bj * HALF + n * 16) * ldt + row;
                            p[0] = (bf16_t)(w0 & 0xffffu); p[(size_t)ldt] = (bf16_t)(w0 >> 16); p[(size_t)2 * ldt] = (bf16_t)(w1 & 0xffffu); p[(size_t)3 * ldt] = (bf16_t)(w1 >> 16); } }
        } else {
            const int col0 = wc * 32 + 4 * fq;
#pragma unroll
            for (int ai = 0; ai < 2; ++ai)
#pragma unroll
                for (int m = 0; m < 4; ++m) { bf16_t* rowp = CQ + (size_t)(row0 + ai * HALF + m * 16) * 256 + col0;
#pragma unroll
                    for (int bj = 0; bj < 2; ++bj)
#pragma unroll
                        for (int n = 0; n < 2; ++n) { const f32x4 v = acc[ai][bj][m][n] * sc; u32x2 w; w.x = cvt_pk_bf16(v[0], v[1]); w.y = cvt_pk_bf16(v[2], v[3]);
                            *(u32x2*)(rowp + bj * HALF + n * 16) = w; } }
        }
    }
};
struct EpiAtIn {
    static constexpr bool PERM = false, AFTER_DRAIN = false;
    bf16_t* O; int ldc; const float* gq; const float* gk; float csc; float eps; int seq_mask;
    __device__ __forceinline__ void operator()(const f32x4 (&acc)[2][2][4][2], const Unit& u, int wr, int wc, int fr, int fq) const {
        const int row0 = u.pm * BM + wr * 64 + fr, colb = u.pn * BM + wc * 64 + 4 * fq;
        if (u.pn <= 3) {
            const float* gp = (u.pn == 3 ? gk : gq) + 4 * fq; const float osc = (u.pn == 3) ? 1.f : csc;
            float invr[4];
#pragma unroll
            for (int q = 0; q < 4; ++q) invr[q] = exp2f(-(float)(4 * fq + q) * (13.287712379549449f / 16.0f)) * 0.15915494309189535f;
#pragma unroll
            for (int ai = 0; ai < 2; ++ai)
#pragma unroll
                for (int m = 0; m < 4; ++m) {
                    const int row = row0 + ai * HALF + m * 16; int t = row & seq_mask; asm volatile("" : "+v"(t));
                    float ss = 0.f;
#pragma unroll
                    for (int bj = 0; bj < 2; ++bj)
#pragma unroll
                        for (int n = 0; n < 2; ++n) { const f32x4 x = acc[ai][bj][m][n]; ss += (x[0] * x[0] + x[1] * x[1]) + (x[2] * x[2] + x[3] * x[3]); }
                    ss += __shfl_xor(ss, 16); ss += __shfl_xor(ss, 32);
                    const float rs = osc * __builtin_amdgcn_rsqf(ss * (1.0f / 64.0f) + eps);
                    bf16_t* rowp = O + (size_t)row * ldc + colb;
#pragma unroll
                    for (int bj = 0; bj < 2; ++bj) {
                        const float pos = (float)(bj == 0 ? (t >> 6) : (t & 63));
                        const f32x4 xa = acc[ai][bj][m][0] * rs * *(const f32x4*)(gp + 32 * bj), xb = acc[ai][bj][m][1] * rs * *(const f32x4*)(gp + 32 * bj + 16);
                        f32x4 oa, ob;
#pragma unroll
                        for (int q = 0; q < 4; ++q) { const float rev = pos * invr[q]; const float c = __builtin_amdgcn_cosf(rev), s = __builtin_amdgcn_sinf(rev);
                            oa[q] = xa[q] * c - xb[q] * s; ob[q] = xa[q] * s + xb[q] * c; }
                        u32x2 w; w.x = cvt_pk_bf16(oa[0], oa[1]); w.y = cvt_pk_bf16(oa[2], oa[3]); *(u32x2*)(rowp + 32 * bj) = w;
                        w.x = cvt_pk_bf16(ob[0], ob[1]); w.y = cvt_pk_bf16(ob[2], ob[3]); *(u32x2*)(rowp + 32 * bj + 16) = w;
                    }
                    asm volatile("" ::: "memory");
                }
        } else {
            const float s = (u.pn == 5) ? csc : 1.f;
#pragma unroll
            for (int ai = 0; ai < 2; ++ai)
#pragma unroll
                for (int m = 0; m < 4; ++m) { bf16_t* rowp = O + (size_t)(row0 + ai * HALF + m * 16) * ldc + colb;
#pragma unroll
                    for (int bj = 0; bj < 2; ++bj)
#pragma unroll
                        for (int n = 0; n < 2; ++n) { const f32x4 v = acc[ai][bj][m][n] * s; u32x2 w; w.x = cvt_pk_bf16(v[0], v[1]); w.y = cvt_pk_bf16(v[2], v[3]);
                            *(u32x2*)(rowp + 32 * bj + 16 * n) = w; } }
        }
    }
};
struct EpiResF32 {
    static constexpr bool PERM = false, AFTER_DRAIN = false;
    const float* res; float* out; int ldc;
    __device__ __forceinline__ void operator()(const f32x4 (&acc)[2][2][4][2], const Unit& u, int wr, int wc, int fr, int fq) const {
        const int row0 = u.pm * BM + wr * 64 + fr, col0 = u.pn * BM + wc * 32 + 4 * fq;
#pragma unroll
        for (int ai = 0; ai < 2; ++ai)
#pragma unroll
            for (int m = 0; m < 4; ++m) { const size_t off = (size_t)(row0 + ai * HALF + m * 16) * ldc + col0;
#pragma unroll
                for (int bj = 0; bj < 2; ++bj)
#pragma unroll
                    for (int n = 0; n < 2; ++n) { const f32x4 r = *(const f32x4*)(res + off + bj * HALF + n * 16); *(f32x4*)(out + off + bj * HALF + n * 16) = r + acc[ai][bj][m][n]; } }
    }
};
__device__ __forceinline__ unsigned pk4_fp8_sat(const f32x4 x) {
    unsigned w = 0;
    w = __builtin_amdgcn_cvt_pk_fp8_f32(__builtin_amdgcn_fmed3f(x[0], -448.f, 448.f), __builtin_amdgcn_fmed3f(x[1], -448.f, 448.f), w, false);
    w = __builtin_amdgcn_cvt_pk_fp8_f32(__builtin_amdgcn_fmed3f(x[2], -448.f, 448.f), __builtin_amdgcn_fmed3f(x[3], -448.f, 448.f), w, true);
    return w;
}
struct EpiOutX {
    static constexpr bool PERM = true, AFTER_DRAIN = false;
    const float* res; float* out; int ldc; const float* gain; const float* WrG; unsigned char* XN8; float* PLG; float* PSS; int M;
    static __device__ __forceinline__ void split8(const f32x4 a, const f32x4 b, bf16x8& hi, bf16x8& lo) {
        u32x4 h, l; float r[8] = {a[0], a[1], a[2], a[3], b[0], b[1], b[2], b[3]};
#pragma unroll
        for (int k = 0; k < 4; ++k) { const unsigned p = cvt_pk_bf16(r[2 * k], r[2 * k + 1]); h[k] = p;
            const float d0 = r[2 * k] - __builtin_bit_cast(float, p << 16), d1 = r[2 * k + 1] - __builtin_bit_cast(float, p & 0xffff0000u); l[k] = cvt_pk_bf16(d0, d1); }
        hi = __builtin_bit_cast(bf16x8, h); lo = __builtin_bit_cast(bf16x8, l);
    }
    __device__ __forceinline__ void operator()(f32x4 (&acc)[2][2][4][2], const Unit& u, int wr, int wc, int fr, int fq) const {
        const int row0 = u.pm * BM + wr * 64 + fr, col0 = u.pn * BM + wc * 32 + 8 * fq, slot = u.pn * 4 + wc;
        bf16x8 whi[2], wlo[2];
#pragma unroll
        for (int bj = 0; bj < 2; ++bj) { const float* wp = WrG + (size_t)fr * ldc + col0 + bj * HALF; split8(*(const f32x4*)wp, *(const f32x4*)(wp + 4), whi[bj], wlo[bj]); }
#pragma unroll
        for (int idx = 0; idx < 8; ++idx) { const int ai = idx >> 2, m = idx & 3;
            const int row = row0 + ai * HALF + m * 16; const size_t off = (size_t)row * ldc + col0; float ss = 0.f; f32x4 lg = (f32x4){0.f, 0.f, 0.f, 0.f}; u32x4 xw;
#pragma unroll
            for (int bj = 0; bj < 2; ++bj) {
#pragma unroll
                for (int n = 0; n < 2; ++n) { const int co = bj * HALF + n * 4;
                    const f32x4 h = *(const f32x4*)(res + off + co) + acc[ai][bj][m][n]; acc[ai][bj][m][n] = h; *(f32x4*)(out + off + co) = h;
                    ss += (h[0] * h[0] + h[1] * h[1]) + (h[2] * h[2] + h[3] * h[3]);
                    const f32x4 x = h * *(const f32x4*)(gain + col0 + co);
                    xw[bj * 2 + n] = pk4_fp8_sat(x); }
                bf16x8 hhi, hlo; split8(acc[ai][bj][m][0], acc[ai][bj][m][1], hhi, hlo);
                lg = __builtin_amdgcn_mfma_f32_16x16x32_bf16(wlo[bj], hhi, lg, 0, 0, 0);
                lg = __builtin_amdgcn_mfma_f32_16x16x32_bf16(whi[bj], hlo, lg, 0, 0, 0);
                lg = __builtin_amdgcn_mfma_f32_16x16x32_bf16(whi[bj], hhi, lg, 0, 0, 0); }
            *(u32x4*)(XN8 + (size_t)row * ldc + u.pn * BM + wc * 64 + fq * 16) = xw;
            ss += __shfl_xor(ss, 16); ss += __shfl_xor(ss, 32);
            if (fq == 0) PSS[(size_t)slot * M + row] = ss;
            *(f32x4*)(PLG + ((size_t)slot * M + row) * 16 + 4 * fq) = lg;
            asm volatile("" ::: "memory"); }
    }
};
struct EpiSwiGLU {
    static constexpr bool PERM = false, AFTER_DRAIN = false;
    bf16_t* O; int ldc;
    __device__ __forceinline__ void operator()(const f32x4 (&acc)[2][2][4][2], const Unit& u, int wr, int wc, int fr, int fq) const {
        const int row0 = u.pm * BM + wr * 64 + fr, col0 = u.pn * HALF + wc * 32 + 4 * fq;
#pragma unroll
        for (int ai = 0; ai < 2; ++ai)
#pragma unroll
            for (int m = 0; m < 4; ++m) { bf16_t* rowp = O + (size_t)(row0 + ai * HALF + m * 16) * ldc + col0;
#pragma unroll
                for (int n = 0; n < 2; ++n) { const f32x4 g = acc[ai][0][m][n], up = acc[ai][1][m][n]; f32x4 h;
#pragma unroll
                    for (int q = 0; q < 4; ++q) h[q] = g[q] * up[q] * __builtin_amdgcn_rcpf(1.f + __expf(-g[q]));
                    u32x2 w; w.x = cvt_pk_bf16(h[0], h[1]); w.y = cvt_pk_bf16(h[2], h[3]); *(u32x2*)(rowp + n * 16) = w; } }
    }
};
struct EpiSwiGLU8 {
    static constexpr bool PERM = false, AFTER_DRAIN = false;
    unsigned char* O; int ldc; float wsc; const float* rs;
    __device__ __forceinline__ void operator()(const f32x4 (&acc)[2][2][4][2], const Unit& u, int wr, int wc, int fr, int fq) const {
        const int row0 = u.pm * BM + wr * 64 + fr, col0 = u.pn * HALF + wc * 32 + 4 * fq;
#pragma unroll
        for (int ai = 0; ai < 2; ++ai)
#pragma unroll
            for (int m = 0; m < 4; ++m) { const int row = row0 + ai * HALF + m * 16; const float sc = wsc * rs[row]; u32x2 hw;
#pragma unroll
                for (int n = 0; n < 2; ++n) { const f32x4 g = acc[ai][0][m][n] * sc, up = acc[ai][1][m][n] * sc; f32x4 h;
#pragma unroll
                    for (int q = 0; q < 4; ++q) h[q] = g[q] * up[q] * __builtin_amdgcn_rcpf(1.f + __expf(-g[q]));
                    hw[n] = pk4_fp8_sat(h); }
                *(u32x2*)(O + (size_t)row * ldc + u.pn * HALF + wc * 32 + fq * 8) = hw; }
    }
};
struct EpiDown {
    static constexpr bool PERM = true, AFTER_DRAIN = false;
    bf16_t* O; int ldc; const float* gate; float wsc;
    __device__ __forceinline__ void operator()(const f32x4 (&acc)[2][2][4][2], const Unit& u, int wr, int wc, int fr, int fq) const {
        const int row0 = u.pm * BM + wr * 64 + fr, col0 = u.pn * BM + wc * 32 + 8 * fq;
#pragma unroll
        for (int ai = 0; ai < 2; ++ai)
#pragma unroll
            for (int m = 0; m < 4; ++m) { const int row = row0 + ai * HALF + m * 16; const float gs = gate[row] * wsc; bf16_t* rowp = O + (size_t)row * ldc + col0;
#pragma unroll
                for (int bj = 0; bj < 2; ++bj) { const f32x4 v0 = acc[ai][bj][m][0] * gs, v1 = acc[ai][bj][m][1] * gs; u32x4 w;
                    w.x = cvt_pk_bf16(v0[0], v0[1]); w.y = cvt_pk_bf16(v0[2], v0[3]); w.z = cvt_pk_bf16(v1[0], v1[1]); w.w = cvt_pk_bf16(v1[2], v1[3]);
                    *(u32x4*)(rowp + bj * HALF) = w; } }
    }
};
template <class Epi, class Sched, bool ALIGN_EPI = false, bool SP2 = false, bool GATHER = false, bool FP8 = false>
__device__ __forceinline__ void gemm_phase(PG8_LAS unsigned char* lds, const Gemm g, const Sched& S, const Epi& E, const int* gidx = nullptr) {
    const int tid = opaque_tid(), wid = __builtin_amdgcn_readfirstlane(tid >> 6), lane = tid & 63, wr = wid >> 2, wc = wid & 3, fr = lane & 15, fq = lane >> 4;
    const int K = g.K, nt = K / BK;
    unsigned voffA[2], voffB[2];
#pragma unroll
    for (int i = 0; i < 2; ++i) { int R, C; stage_rc(tid * 16 + i * 8192, R, C); const int Rb = Epi::PERM ? ((R & ~31) + perm32(R & 31)) : R;
        voffA[i] = (unsigned)(R * K + C) * 2u; voffB[i] = (unsigned)(Rb * K + C) * 2u; }
    const size_t kstep = (size_t)(BK * 2);
    const size_t hstep = (size_t)HALF * K * 2;
    const size_t tstep = 2 * hstep;
    const unsigned ldsw = (unsigned)wid * 1024u;
    const int aoff = lds_byte(wr * 64 + fr, fq * 8), boff = lds_byte(wc * 32 + fr, fq * 8);
#define PG8_SA(b, h) (((b) * 2 + (h)) * HTB)
#define PG8_SB(b, h) ((4 + (b) * 2 + (h)) * HTB)
#define PG8_STAGE(bufoff, gbase, voff) do { _Pragma("unroll") for (int _i = 0; _i < 2; ++_i) \
        __builtin_amdgcn_global_load_lds((const unsigned*)((const char*)(gbase) + (voff)[_i]), (PG8_LAS unsigned*)(lds + (bufoff) + ldsw + _i * 8192), 16, 0, 0); } while (0)
#define PG8_LDA(dst, b, h) do { _Pragma("unroll") for (int m = 0; m < 4; ++m) { if constexpr (FP8) { const v4i_ lo_ = *(const PG8_LAS v4i_*)(lds + PG8_SA(b, h) + aoff + m * 2048), hi_ = *(const PG8_LAS v4i_*)(lds + PG8_SA(b, h) + aoff + m * 2048 + 1024); \
        dst##8[m] = __builtin_shufflevector(lo_, hi_, 0, 1, 2, 3, 4, 5, 6, 7); } else { _Pragma("unroll") for (int k = 0; k < 2; ++k) dst[m][k] = *(const PG8_LAS bf16x8*)(lds + PG8_SA(b, h) + aoff + m * 2048 + k * 1024); } } } while (0)
#define PG8_LDB(dst, b, h) do { _Pragma("unroll") for (int n = 0; n < 2; ++n) { if constexpr (FP8) { const v4i_ lo_ = *(const PG8_LAS v4i_*)(lds + PG8_SB(b, h) + boff + n * 2048), hi_ = *(const PG8_LAS v4i_*)(lds + PG8_SB(b, h) + boff + n * 2048 + 1024); \
        dst##8[n] = __builtin_shufflevector(lo_, hi_, 0, 1, 2, 3, 4, 5, 6, 7); } else { _Pragma("unroll") for (int k = 0; k < 2; ++k) dst[n][k] = *(const PG8_LAS bf16x8*)(lds + PG8_SB(b, h) + boff + n * 2048 + k * 1024); } } } while (0)
#define PG8_MMA(ai, bj, At, Bt) do { __builtin_amdgcn_s_setprio(1); _Pragma("unroll") for (int m = 0; m < 4; ++m) _Pragma("unroll") for (int n = 0; n < 2; ++n) { \
        if constexpr (FP8) asm volatile("v_mfma_scale_f32_16x16x128_f8f6f4 %0, %1, %2, %0, %3, %3 op_sel_hi:[0,0,0]" : "+v"(acc[ai][bj][m][n]) : "v"(Bt##8[n]), "v"(At##8[m]), "v"(sc127_));   \
        else { _Pragma("unroll") for (int k = 0; k < 2; ++k) acc[ai][bj][m][n] = __builtin_amdgcn_mfma_f32_16x16x32_bf16(Bt[n][k], At[m][k], acc[ai][bj][m][n], 0, 0, 0); } } \
        __builtin_amdgcn_s_setprio(0); } while (0)
#define PG8_WAIT_V(n) asm volatile("s_waitcnt vmcnt(" #n ")" ::: "memory")
#define PG8_WAIT_L(n) asm volatile("s_waitcnt lgkmcnt(" #n ")" ::: "memory")
#define PG8_BAR __builtin_amdgcn_s_barrier()
#define PG8_SCHED __builtin_amdgcn_sched_barrier(0)
    Unit cur, nxt; int ui = 0;
    if (!S.next(0, cur)) return;
    f32x4 acc[2][2][4][2];
#pragma unroll
    for (int a = 0; a < 2; ++a)
#pragma unroll
        for (int b = 0; b < 2; ++b)
#pragma unroll
            for (int m = 0; m < 4; ++m)
#pragma unroll
                for (int n = 0; n < 2; ++n) acc[a][b][m][n] = (f32x4){0.f, 0.f, 0.f, 0.f};
    typedef int v8i_ __attribute__((ext_vector_type(8))); typedef int v4i_ __attribute__((ext_vector_type(4)));
    const int sc127_ = 127;
    bf16x8 At[4][2], B0[2][2], B1[2][2]; v8i_ At8[4], B08[2], B18[2];
    static_assert(SP2, "this copy of the body keeps only the SP2 K-loop up to date");
    int rA[2]; { int R_, C_; stage_rc(tid * 16, R_, C_); rA[0] = R_; stage_rc(tid * 16 + 8192, R_, C_); rA[1] = R_; }
    unsigned cvp[2], nvp[2], c2_[2]; c2_[0] = voffA[0] - (unsigned)(rA[0] * K) * 2u; c2_[1] = voffA[1] - (unsigned)(rA[1] * K) * 2u;
    unsigned vh1[2]; vh1[0] = voffA[0] + (unsigned)hstep; vh1[1] = voffA[1] + (unsigned)hstep;
#define PG8_ROWOFF(dst, unit) do { _Pragma("unroll") for (int i_ = 0; i_ < 2; ++i_) dst[i_] = (unsigned)gidx[(unit).pm * BM + rA[i_]] | ((unsigned)gidx[(unit).pm * BM + HALF + rA[i_]] << 16); } while (0)
#define PG8_STAGE_A(bufoff, gbase, P, H) do { unsigned to_[2]; _Pragma("unroll") for (int i_ = 0; i_ < 2; ++i_) \
        to_[i_] = GATHER ? ((P[i_] >> (16 * (H))) & 0xffffu) * (unsigned)(K * 2) + c2_[i_] : ((H) ? vh1[i_] : voffA[i_]); PG8_STAGE(bufoff, gbase, to_); } while (0)
    if constexpr (GATHER) PG8_ROWOFF(cvp, cur); else { cvp[0] = 0u; cvp[1] = 0u; }
    const char* cA = GATHER ? (const char*)g.A : (const char*)g.A + (size_t)cur.pm * tstep; const char* cB = (const char*)g.Bt + (size_t)((cur.pm / g.gdiv) % g.gmod) * g.gstride + (size_t)cur.pn * tstep;
    S.a_ready(cur);
    if constexpr (SP2) {
        PG8_STAGE(PG8_SB(0, 0), cB, voffB); PG8_STAGE(PG8_SB(0, 1), cB + hstep, voffB); PG8_STAGE_A(PG8_SA(0, 0), cA, cvp, 0); PG8_STAGE_A(PG8_SA(0, 1), cA, cvp, 1);
        if (wr == 1) PG8_BAR;
        PG8_WAIT_V(2); PG8_BAR;
        PG8_STAGE(PG8_SB(1, 0), cB + kstep, voffB); PG8_STAGE_A(PG8_SA(1, 0), cA + kstep, cvp, 0); PG8_STAGE(PG8_SB(1, 1), cB + hstep + kstep, voffB);
        PG8_WAIT_V(6); PG8_BAR;
    } else {
        PG8_STAGE(PG8_SB(0, 0), cB, voffB); PG8_STAGE(PG8_SA(0, 0), cA, voffA); PG8_STAGE(PG8_SB(0, 1), cB + hstep, voffB); PG8_STAGE(PG8_SA(0, 1), cA + hstep, voffA);
        if (wr == 1) PG8_BAR;
        PG8_WAIT_V(4); PG8_BAR;
        PG8_STAGE(PG8_SB(1, 0), cB + kstep, voffB); PG8_STAGE(PG8_SA(1, 0), cA + kstep, voffA); PG8_STAGE(PG8_SB(1, 1), cB + hstep + kstep, voffB);
        PG8_WAIT_V(6); PG8_BAR;
    }
    for (;;) {
        const bool has_next = S.next(ui + 1, nxt);
        if constexpr (GATHER) { if (has_next) PG8_ROWOFF(nvp, nxt); else { nvp[0] = cvp[0]; nvp[1] = cvp[1]; } } else { nvp[0] = 0u; nvp[1] = 0u; }
        const char* nA = GATHER ? (const char*)g.A : (has_next ? (const char*)g.A + (size_t)nxt.pm * tstep : cA); const char* nB = has_next ? (const char*)g.Bt + (size_t)((nxt.pm / g.gdiv) % g.gmod) * g.gstride + (size_t)nxt.pn * tstep : cB;
        for (int t = 0; t < nt; t += 2) {
            const bool last = (t == nt - 2);
            unsigned svp[2]; svp[0] = last ? nvp[0] : cvp[0]; svp[1] = last ? nvp[1] : cvp[1];
            const char* a1 = cA + (size_t)(t + 1) * kstep;
            const char* a2 = last ? nA : cA + (size_t)(t + 2) * kstep; const char* b2 = last ? nB : cB + (size_t)(t + 2) * kstep;
            const char* a3 = a2 + kstep; const char* b3 = b2 + kstep;
            if (last && has_next) S.a_ready(nxt);
            if constexpr (SP2) {
            PG8_LDB(B0, 0, 0); PG8_LDB(B1, 0, 1); PG8_SCHED; PG8_LDA(At, 0, 0); PG8_STAGE_A(PG8_SA(1, 1), a1, cvp, 1);
            PG8_WAIT_V(8); PG8_WAIT_L(0); PG8_BAR; PG8_MMA(0, 0, At, B0); PG8_MMA(0, 1, At, B1); PG8_BAR; PG8_SCHED;
            PG8_LDA(At, 0, 1); PG8_STAGE(PG8_SB(0, 0), b2, voffB); PG8_STAGE(PG8_SB(0, 1), b2 + hstep, voffB); PG8_STAGE_A(PG8_SA(0, 0), a2, svp, 0);
            PG8_WAIT_V(8); PG8_WAIT_L(0); PG8_BAR; PG8_MMA(1, 0, At, B0); PG8_MMA(1, 1, At, B1); PG8_BAR; PG8_SCHED;
            PG8_LDB(B0, 1, 0); PG8_LDB(B1, 1, 1); PG8_SCHED; PG8_LDA(At, 1, 0); PG8_STAGE_A(PG8_SA(0, 1), a2, svp, 1);
            PG8_WAIT_V(8); PG8_WAIT_L(0); PG8_BAR; PG8_MMA(0, 0, At, B0); PG8_MMA(0, 1, At, B1); PG8_BAR; PG8_SCHED;
            PG8_LDA(At, 1, 1); PG8_STAGE(PG8_SB(1, 0), b3, voffB); PG8_STAGE(PG8_SB(1, 1), b3 + hstep, voffB); PG8_STAGE_A(PG8_SA(1, 0), a3, svp, 0);
            PG8_WAIT_V(8); PG8_WAIT_L(0); PG8_BAR; PG8_MMA(1, 0, At, B0); PG8_MMA(1, 1, At, B1); PG8_BAR; PG8_SCHED;
            } else {
            PG8_LDB(B0, 0, 0); PG8_SCHED; PG8_LDA(At, 0, 0); PG8_STAGE(PG8_SA(1, 1), a1 + hstep, voffA);
            PG8_WAIT_L(8); PG8_BAR; PG8_WAIT_L(0); PG8_MMA(0, 0, At, B0); PG8_BAR; PG8_SCHED;
            PG8_LDB(B1, 0, 1); PG8_STAGE(PG8_SB(0, 0), b2, voffB);
            PG8_BAR; PG8_WAIT_L(0); PG8_MMA(0, 1, At, B1); PG8_BAR;
            PG8_LDA(At, 0, 1); PG8_STAGE(PG8_SA(0, 0), a2, voffA);
            PG8_BAR; PG8_WAIT_L(0); PG8_MMA(1, 0, At, B0); PG8_BAR; PG8_SCHED;
            PG8_STAGE(PG8_SB(0, 1), b2 + hstep, voffB);
            PG8_WAIT_V(6); PG8_BAR; PG8_MMA(1, 1, At, B1); PG8_BAR;
            PG8_LDB(B0, 1, 0); PG8_SCHED; PG8_LDA(At, 1, 0); PG8_STAGE(PG8_SA(0, 1), a2 + hstep, voffA);
            PG8_WAIT_L(8); PG8_BAR; PG8_WAIT_L(0); PG8_MMA(0, 0, At, B0); PG8_BAR; PG8_SCHED;
            PG8_LDB(B1, 1, 1); PG8_STAGE(PG8_SB(1, 0), b3, voffB);
            PG8_BAR; PG8_WAIT_L(0); PG8_MMA(0, 1, At, B1); PG8_BAR;
            PG8_LDA(At, 1, 1); PG8_STAGE(PG8_SA(1, 0), a3, voffA);
            PG8_BAR; PG8_WAIT_L(0); PG8_MMA(1, 0, At, B0); PG8_BAR; PG8_SCHED;
            PG8_STAGE(PG8_SB(1, 1), b3 + hstep, voffB);
            PG8_WAIT_V(6); PG8_BAR; PG8_MMA(1, 1, At, B1); PG8_BAR;
            }
        }
        if constexpr (ALIGN_EPI) { if (wr == 0) PG8_BAR; }
        if constexpr (!Epi::AFTER_DRAIN) { E(acc, cur, wr, wc, fr, fq); S.done(cur); }
        if (!has_next) break;
#pragma unroll
        for (int a = 0; a < 2; ++a)
#pragma unroll
            for (int b = 0; b < 2; ++b)
#pragma unroll
                for (int m = 0; m < 4; ++m)
#pragma unroll
                    for (int n = 0; n < 2; ++n) acc[a][b][m][n] = (f32x4){0.f, 0.f, 0.f, 0.f};
        cur = nxt; cA = nA; cB = nB; ++ui; if constexpr (GATHER) { cvp[0] = nvp[0]; cvp[1] = nvp[1]; }
        if constexpr (ALIGN_EPI) { if (wr == 1) PG8_BAR; }
    }
    PG8_WAIT_V(0);
    if constexpr (!ALIGN_EPI) { if (wr == 0) PG8_BAR; }
    PG8_BAR;
    if constexpr (Epi::AFTER_DRAIN) { E.fused(acc, cur, wr, wc, fr, fq, lds, wid, lane); S.done(cur); }
#undef PG8_ROWOFF
#undef PG8_STAGE_A
#undef PG8_SA
#undef PG8_SB
#undef PG8_STAGE
#undef PG8_LDA
#undef PG8_LDB
#undef PG8_MMA
#undef PG8_WAIT_V
#undef PG8_WAIT_L
#undef PG8_BAR
#undef PG8_SCHED
}
}
namespace attn_body {
using bf16=__hip_bfloat16;
using bf16x8=__attribute__((ext_vector_type(8)))short;
using s16x4=__attribute__((ext_vector_type(4)))short;
using f32x16=__attribute__((ext_vector_type(16)))float;
using u32x4=__attribute__((ext_vector_type(4)))unsigned;
constexpr int D=64;
constexpr int NW=8,QBLK=32,QB=QBLK*NW,KVBLK=64;
__device__ __forceinline__ int crow(int r,int hi){return (r&3)+8*(r>>2)+4*hi;}
#define SBAR() __builtin_amdgcn_sched_barrier(0)
__device__ __forceinline__ void cmask(f32x16&p0,f32x16&p1,int jb,int qrel,int hi){
  const float NEG=-INFINITY; int kb=64*jb+4*hi;
  #pragma unroll
  for(int r=0;r<16;++r){int kv=kb+(r&3)+8*(r>>2); if(kv>qrel)p0[r]=NEG; if(kv+32>qrel)p1[r]=NEG;}
}

constexpr int NSLOT=3, SLOTB=8192;
constexpr int LDS_K=0, LDS_V=NSLOT*SLOTB, LDS_WS=2*NSLOT*SLOTB, LDS_OST=LDS_WS+NW*64*4, LDS_BYTES=LDS_OST+NW*4096;
constexpr float C2=0.125f*1.4426950408889634f;
__device__ __forceinline__ void glds16(const void*gsrc,unsigned lds_dst){unsigned keep;
  asm volatile("s_mov_b32 %0, m0\n\ts_mov_b32 m0, %2\n\ts_nop 0\n\tglobal_load_lds_dwordx4 %1, off\n\ts_mov_b32 m0, %0":"=&s"(keep):"v"(gsrc),"s"(lds_dst):"memory");}
__device__ __forceinline__ float max3f(float a,float b,float c){float r;asm("v_max3_f32 %0, %1, %2, %3":"=v"(r):"v"(a),"v"(b),"v"(c));return r;}
__device__ __forceinline__ float max2f(float a,float b){float r;asm("v_max_f32_e32 %0, %1, %2":"=v"(r):"v"(a),"v"(b));return r;}
__device__ __forceinline__ float fadd_s(float a,float b){float r;asm("v_add_f32_e32 %0, %1, %2":"=v"(r):"v"(a),"v"(b));return r;}
__device__ __forceinline__ float fsub_s(float a,float b){float r;asm("v_sub_f32_e32 %0, %1, %2":"=v"(r):"v"(a),"v"(b));return r;}
typedef float f32x2_t __attribute__((ext_vector_type(2))); typedef __bf16 bf16x2_t __attribute__((ext_vector_type(2)));
__device__ __forceinline__ unsigned cvtpk_s(float lo,float hi){f32x2_t v={lo,hi};bf16x2_t b=__builtin_convertvector(v,bf16x2_t);return __builtin_bit_cast(unsigned,b);}
#define WAIT_BAR(N) asm volatile("s_waitcnt vmcnt(" #N ") lgkmcnt(0)\n\ts_barrier":::"memory")

__device__ __forceinline__ void qkt(f32x16&p0,f32x16&p1,const char*Kslot,const bf16x8*qr,const f32x16&negm,int r32,int hi){
  const char*kb=Kslot+hi*1024+r32*16;
  #pragma unroll
  for(int d0=0;d0<4;++d0){
    const bf16x8 b0=*reinterpret_cast<const bf16x8*>(kb+d0*2048);
    const bf16x8 b1=*reinterpret_cast<const bf16x8*>(kb+d0*2048+512);
    if(d0==0){p0=__builtin_amdgcn_mfma_f32_32x32x16_bf16(b0,qr[0],negm,0,0,0);p1=__builtin_amdgcn_mfma_f32_32x32x16_bf16(b1,qr[0],negm,0,0,0);}
    else{p0=__builtin_amdgcn_mfma_f32_32x32x16_bf16(b0,qr[d0],p0,0,0,0);p1=__builtin_amdgcn_mfma_f32_32x32x16_bf16(b1,qr[d0],p1,0,0,0);}}
}
typedef __attribute__((address_space(3))) const char* lds_cptr;
typedef short v4i16_t __attribute__((ext_vector_type(4)));
__device__ __forceinline__ void kload8(bf16x8*kf,lds_cptr kp){
  kf[0]=*(const __attribute__((address_space(3))) bf16x8*)(kp);      kf[1]=*(const __attribute__((address_space(3))) bf16x8*)(kp+512);
  kf[2]=*(const __attribute__((address_space(3))) bf16x8*)(kp+2048); kf[3]=*(const __attribute__((address_space(3))) bf16x8*)(kp+2560);
  kf[4]=*(const __attribute__((address_space(3))) bf16x8*)(kp+4096); kf[5]=*(const __attribute__((address_space(3))) bf16x8*)(kp+4608);
  kf[6]=*(const __attribute__((address_space(3))) bf16x8*)(kp+6144); kf[7]=*(const __attribute__((address_space(3))) bf16x8*)(kp+6656);
}
__device__ __forceinline__ void kload2(bf16x8*kf,lds_cptr kp,int j){ kf[2*j]=*(const __attribute__((address_space(3))) bf16x8*)(kp+j*2048); kf[2*j+1]=*(const __attribute__((address_space(3))) bf16x8*)(kp+j*2048+512); }
__device__ __forceinline__ s16x4 vtr(lds_cptr p){ return __builtin_bit_cast(s16x4,__builtin_amdgcn_ds_read_tr16_b64_v4i16((__attribute__((address_space(3))) v4i16_t*)p)); }
__device__ __forceinline__ float rowmax(const f32x16&p0,const f32x16&p1){
  float a=max3f(p0[0],p0[1],p1[0]),b=max3f(p0[2],p0[3],p1[1]);a=max3f(a,p1[2],p1[3]);
  #pragma unroll
  for(int r=4;r<16;r+=4){a=max3f(a,p0[r],p0[r+1]);b=max3f(b,p0[r+2],p0[r+3]);a=max3f(a,p1[r],p1[r+1]);b=max3f(b,p1[r+2],p1[r+3]);}
  const float m=max2f(a,b);
  auto rr=__builtin_amdgcn_permlane32_swap(__float_as_uint(m),__float_as_uint(m),false,false);
  return max2f(__uint_as_float(rr[0]),__uint_as_float(rr[1]));
}
__device__ __forceinline__ void pv(f32x16*o,int vb,bf16x8 pa0,bf16x8 pa1,bf16x8 pa2,bf16x8 pa3){
  #pragma unroll
  for(int d0=0;d0<2;++d0){s16x4 lo[4],hi[4];
    #pragma unroll
    for(int ks=0;ks<4;++ks){
      asm volatile("ds_read_b64_tr_b16 %0,%1 offset:%c2":"=&v"(lo[ks]):"v"(vb),"i"(d0*4096+ks*1024):"memory");
      asm volatile("ds_read_b64_tr_b16 %0,%1 offset:%c2":"=&v"(hi[ks]):"v"(vb),"i"(d0*4096+ks*1024+512):"memory");}
    asm volatile("s_waitcnt lgkmcnt(0)":::"memory");SBAR();
    #define PK(k) (bf16x8){lo[k][0],lo[k][1],lo[k][2],lo[k][3],hi[k][0],hi[k][1],hi[k][2],hi[k][3]}
    o[d0]=__builtin_amdgcn_mfma_f32_32x32x16_bf16(pa0,PK(0),o[d0],0,0,0);
    o[d0]=__builtin_amdgcn_mfma_f32_32x32x16_bf16(pa1,PK(1),o[d0],0,0,0);
    o[d0]=__builtin_amdgcn_mfma_f32_32x32x16_bf16(pa2,PK(2),o[d0],0,0,0);
    o[d0]=__builtin_amdgcn_mfma_f32_32x32x16_bf16(pa3,PK(3),o[d0],0,0,0);
    #undef PK
  }
}

#ifndef ATTN_STORE16
#define ATTN_STORE16(p,v) (*(u32x4*)(p)=(v))
#endif
template<int THRL,int QP,int KP,int OP> __device__ __forceinline__ void attn_unit(const bf16*Qu,const bf16*__restrict__ Kh,const bf16*__restrict__ Vh,bf16*Ou,const int NT,char*shm){
  const int tid=opaque_tid(),lane=tid&63,r32=lane&31,hi=lane>>5; const int wid=__builtin_amdgcn_readfirstlane(tid>>6);
  const bf16*Qw=Qu+(long)(wid*QBLK)*QP;
  const unsigned lds0=(unsigned)(uintptr_t)shm;
  float*wsf=(float*)(shm+LDS_WS)+wid*64;
  const bf16*ksrc=Kh+(long)lane*KP+wid*8;
  const bf16*vsrc=Vh+(long)(16*(wid&3)+(lane>>2))*KP+(wid>>2)*32+(lane&3)*8;
  const unsigned kdst=lds0+LDS_K+wid*1024, vdst=lds0+LDS_V+wid*1024;
  #define DMA_K(t,slot) glds16(ksrc+(long)(t)*KVBLK*KP,(unsigned)__builtin_amdgcn_readfirstlane(kdst+(slot)))
  #define DMA_V(t,slot) glds16(vsrc+(long)(t)*KVBLK*KP,(unsigned)__builtin_amdgcn_readfirstlane(vdst+(slot)))
  const int vb0=(int)(lds0+LDS_V)+((lane>>4)&1)*32+(lane&3)*8+(4*hi+((lane&15)>>2))*64;
  const char*Kbase=shm+LDS_K; bf16x8 kf[8];
  const lds_cptr shm3=(lds_cptr)shm; const lds_cptr kp0=shm3+LDS_K+hi*1024+r32*16; const lds_cptr vp0=shm3+LDS_V+((lane>>4)&1)*32+(lane&3)*8+(4*hi+((lane&15)>>2))*64;
  DMA_K(0,0);DMA_V(0,0);DMA_K(1,SLOTB);
  bf16x8 qr[4];
  #pragma unroll
  for(int d0=0;d0<4;++d0)qr[d0]=*reinterpret_cast<const bf16x8*>(&Qw[(long)r32*QP+d0*16+hi*8]);
  float mhat=0.f,l_reg=0.f;f32x16 o[2];o[0]=f32x16{};o[1]=f32x16{};f32x16 negm=f32x16{};asm volatile("":"+v"(negm));
  #define CMASK(P0,P1,t) do{}while(0)
  bool resc=false;
  #define START(P0,P1) do{ const float rm=rowmax(P0,P1); resc=false; \
    { const float dl=rm; mhat=fadd_s(mhat,dl); \
      _Pragma("unroll") for(int r=0;r<16;++r){P0[r]=fsub_s(P0[r],dl);P1[r]=fsub_s(P1[r],dl);} \
      _Pragma("unroll") for(int r=0;r<16;++r)negm[r]=-mhat; asm volatile("":"+v"(negm)); } \
    _Pragma("unroll") for(int r=0;r<16;++r)P0[r]=__builtin_amdgcn_exp2f(P0[r]); }while(0)
  #define RESC() do{ if(resc){ asm volatile("s_waitcnt lgkmcnt(0)":::"memory"); \
      _Pragma("unroll") for(int d_=0;d_<2;++d_) _Pragma("unroll") for(int r=0;r<16;++r)o[d_][r]*=wsf[crow(r,hi)]; } }while(0)
  f32x16 pA0,pA1,pB0,pB1;
  int sl_prev=0,sl_cur=0,sl_next=SLOTB;
  #define ROT() do{sl_prev=sl_cur;sl_cur=sl_next;sl_next=(sl_next==(NSLOT-1)*SLOTB)?0:sl_next+SLOTB;}while(0)
  DMA_K(2,2*SLOTB);
  WAIT_BAR(3);
  qkt(pA0,pA1,Kbase,qr,negm,r32,hi);asm volatile("s_nop 15\n\ts_nop 7":"+v"(pA0),"+v"(pA1));CMASK(pA0,pA1,0);
  START(pA0,pA1);
  _Pragma("unroll") for(int r=0;r<16;++r)pA1[r]=__builtin_amdgcn_exp2f(pA1[r]);
  WAIT_BAR(0);
  DMA_K(3,0);DMA_V(1,SLOTB);
  ROT();
  kload8(kf,kp0+sl_cur);
  WAIT_BAR(2);
  s16x4 vlo[8],vhi[8]; u32x4 pw0,pw1,pw2,pw3;
  #define PKW(P,B) cvtpk_s(P[B],P[B+1])
  #define PAF(k) __builtin_bit_cast(bf16x8,pw##k)
  #define VFR(i) (bf16x8){vlo[i][0],vlo[i][1],vlo[i][2],vlo[i][3],vhi[i][0],vhi[i][1],vhi[i][2],vhi[i][3]}
  #define PIN(x) asm volatile("":"+v"(x))
  #define MX3(a,b,c) __builtin_fmaxf(__builtin_fmaxf((a),(b)),(c))
  #define GAPA(MF,A0,A1,A2,A3,W0,W1,PW) do{ MF; sacc+=A0; sacc+=A1; sacc+=A2; sacc+=A3; PIN(sacc); W0; W1; PIN(PW); SBAR(); }while(0)
  #define EX(v) __builtin_amdgcn_exp2f(v)
  #define GAPB(MF,X,B) do{ MF; X[B]=EX(X[B]); X[B+1]=EX(X[B+1]); X[B+2]=EX(X[B+2]); X[B+3]=EX(X[B+3]); PIN(X); SBAR(); }while(0)
  #define VRD(i) do{ vlo[i]=vtr(vp_+(((i)>>2)*4096+((i)&3)*1024)); vhi[i]=vtr(vp_+(((i)>>2)*4096+((i)&3)*1024+512)); }while(0)
  #define KRD(G,j) do{ if(G){ kload2(kf,kp0+sl_next,j); SBAR(); } }while(0)
  #define STEP(C0,C1,P0,P1,t,GK,GV,GL) do{ SBAR(); \
    const lds_cptr vp_=vp0+sl_prev; \
    VRD(0); SBAR(); float sacc=(P0[0]+P0[1]); \
    GAPA(C0=__builtin_amdgcn_mfma_f32_32x32x16_bf16(kf[0],qr[0],negm,0,0,0), P0[2],P0[3],P0[4],P0[5],     pw0[0]=PKW(P0,0), pw0[1]=PKW(P0,2), pw0); \
    VRD(4); SBAR(); GAPA(C1=__builtin_amdgcn_mfma_f32_32x32x16_bf16(kf[1],qr[0],negm,0,0,0), P0[6],P0[7],P0[8],P0[9],     pw0[2]=PKW(P0,4), pw0[3]=PKW(P0,6), pw0); \
    VRD(1); SBAR(); GAPA(C0=__builtin_amdgcn_mfma_f32_32x32x16_bf16(kf[2],qr[1],C0,0,0,0),   P0[10],P0[11],P0[12],P0[13], pw1[0]=PKW(P0,8), pw1[1]=PKW(P0,10), pw1); \
    VRD(5); SBAR(); GAPA(C1=__builtin_amdgcn_mfma_f32_32x32x16_bf16(kf[3],qr[1],C1,0,0,0),   P0[14],P0[15],P1[0],P1[1],   pw1[2]=PKW(P0,12),pw1[3]=PKW(P0,14), pw1); \
    VRD(2); SBAR(); GAPA(C0=__builtin_amdgcn_mfma_f32_32x32x16_bf16(kf[4],qr[2],C0,0,0,0),   P1[2],P1[3],P1[4],P1[5],     pw2[0]=PKW(P1,0), pw2[1]=PKW(P1,2), pw2); \
    VRD(6); SBAR(); GAPA(C1=__builtin_amdgcn_mfma_f32_32x32x16_bf16(kf[5],qr[2],C1,0,0,0),   P1[6],P1[7],P1[8],P1[9],     pw2[2]=PKW(P1,4), pw2[3]=PKW(P1,6), pw2); \
    VRD(3); SBAR(); GAPA(C0=__builtin_amdgcn_mfma_f32_32x32x16_bf16(kf[6],qr[3],C0,0,0,0),   P1[10],P1[11],P1[12],P1[13], pw3[0]=PKW(P1,8), pw3[1]=PKW(P1,10), pw3); \
    VRD(7); SBAR(); GAPA(C1=__builtin_amdgcn_mfma_f32_32x32x16_bf16(kf[7],qr[3],C1,0,0,0),   P1[14],P1[15],0.f,0.f,       pw3[2]=PKW(P1,12),pw3[3]=PKW(P1,14), pw3); \
    l_reg+=sacc; \
    if(GK){DMA_K((t)+3,sl_cur);} if(GV){DMA_V((t)+1,sl_next);} \
    CMASK(C0,C1,t); \
    { float a=MX3(C0[0],C0[1],C1[0]),b=MX3(C0[2],C0[3],C1[1]); a=MX3(a,C1[2],C1[3]); \
      _Pragma("unroll") for(int r=4;r<16;r+=4){a=MX3(a,C0[r],C0[r+1]);b=MX3(b,C0[r+2],C0[r+3]);a=MX3(a,C1[r],C1[r+1]);b=MX3(b,C1[r+2],C1[r+3]);} \
      float rm=__builtin_fmaxf(a,b); { auto rr=__builtin_amdgcn_permlane32_swap(__float_as_uint(rm),__float_as_uint(rm),false,false); rm=__builtin_fmaxf(__uint_as_float(rr[0]),__uint_as_float(rr[1])); } \
      resc=false; \
      if(__builtin_expect(__any(rm>(float)THRL),0)){ const float dl=__builtin_fmaxf(rm,0.f); mhat+=dl; \
        _Pragma("unroll") for(int r=0;r<16;++r){C0[r]-=dl;C1[r]-=dl;} \
        _Pragma("unroll") for(int r=0;r<16;++r)negm[r]=-mhat; asm volatile("":"+v"(negm)); \
        const float f=__builtin_amdgcn_exp2f(-dl); l_reg*=f; if(hi==0)wsf[r32]=f; resc=true; } } \
    SBAR(); \
    GAPB(o[0]=__builtin_amdgcn_mfma_f32_32x32x16_bf16(PAF(0),VFR(0),o[0],0,0,0), C0,0); \
    GAPB(o[1]=__builtin_amdgcn_mfma_f32_32x32x16_bf16(PAF(0),VFR(4),o[1],0,0,0), C0,4); \
    KRD(GL,0); GAPB(o[0]=__builtin_amdgcn_mfma_f32_32x32x16_bf16(PAF(1),VFR(1),o[0],0,0,0), C0,8); \
    KRD(GL,1); GAPB(o[1]=__builtin_amdgcn_mfma_f32_32x32x16_bf16(PAF(1),VFR(5),o[1],0,0,0), C0,12); \
    KRD(GL,2); GAPB(o[0]=__builtin_amdgcn_mfma_f32_32x32x16_bf16(PAF(2),VFR(2),o[0],0,0,0), C1,0); \
    KRD(GL,3); GAPB(o[1]=__builtin_amdgcn_mfma_f32_32x32x16_bf16(PAF(2),VFR(6),o[1],0,0,0), C1,4); \
    GAPB(o[0]=__builtin_amdgcn_mfma_f32_32x32x16_bf16(PAF(3),VFR(3),o[0],0,0,0), C1,8); \
    GAPB(o[1]=__builtin_amdgcn_mfma_f32_32x32x16_bf16(PAF(3),VFR(7),o[1],0,0,0), C1,12); \
    }while(0)
  int t=1;
  #undef CMASK
  #define CMASK(P0,P1,t) do{}while(0)
  for(;t+5<NT;t+=2){
    STEP(pB0,pB1,pA0,pA1,t,true,true,true);     WAIT_BAR(2); RESC(); ROT();
    STEP(pA0,pA1,pB0,pB1,t+1,true,true,true);   WAIT_BAR(2); RESC(); ROT();
  }
  #undef CMASK
  #define CMASK(P0,P1,t) do{}while(0)
  #define ENDW(tt) do{ if((tt)+3<NT){WAIT_BAR(2);} else if((tt)+2<NT){WAIT_BAR(1);} else {WAIT_BAR(0);} }while(0)
  for(;t+1<NT;t+=2){
    STEP(pB0,pB1,pA0,pA1,t,(t+3<NT),(t+1<NT),(t+1<NT));       ENDW(t);   RESC(); ROT();
    STEP(pA0,pA1,pB0,pB1,t+1,(t+4<NT),(t+2<NT),(t+2<NT));     ENDW(t+1); RESC(); ROT();
  }
  STEP(pB0,pB1,pA0,pA1,NT-1,false,false,false); RESC();
  { float sacc=pB0[0]+pB0[1]; _Pragma("unroll") for(int r=2;r<16;++r)sacc+=pB0[r]; _Pragma("unroll") for(int r=0;r<16;++r)sacc+=pB1[r]; l_reg+=sacc;
    pw0=(u32x4){PKW(pB0,0),PKW(pB0,2),PKW(pB0,4),PKW(pB0,6)};pw1=(u32x4){PKW(pB0,8),PKW(pB0,10),PKW(pB0,12),PKW(pB0,14)};pw2=(u32x4){PKW(pB1,0),PKW(pB1,2),PKW(pB1,4),PKW(pB1,6)};pw3=(u32x4){PKW(pB1,8),PKW(pB1,10),PKW(pB1,12),PKW(pB1,14)};
    SBAR(); pv(o,vb0+sl_cur,PAF(0),PAF(1),PAF(2),PAF(3)); }
  #undef PKW
  #undef PAF
  #undef VFR
  #undef PIN
  #undef MX3
  #undef GAPA
  #undef GAPB
  #undef EX
  #undef VRD
  #undef KRD
  #undef STEP
  #undef ENDW
  {auto rr=__builtin_amdgcn_permlane32_swap(__float_as_uint(l_reg),__float_as_uint(l_reg),false,false);l_reg=__uint_as_float(rr[0])+__uint_as_float(rr[1]);}
  if(hi==0)wsf[32+r32]=l_reg;asm volatile("s_waitcnt lgkmcnt(0)":::"memory");
  float rli[16];
  #pragma unroll
  for(int r=0;r<16;++r)rli[r]=__builtin_amdgcn_rcpf(wsf[32+crow(r,hi)]);
  bf16*Ow=Ou+(long)(wid*QBLK)*OP;
  { bf16*stg=(bf16*)(shm+LDS_OST)+wid*2048;
    #pragma unroll
    for(int r=0;r<16;++r){const int orow=crow(r,hi);
      #pragma unroll
      for(int d0=0;d0<2;++d0)stg[orow*64+d0*32+r32]=__float2bfloat16(o[d0][r]*rli[r]);}
    asm volatile("s_waitcnt lgkmcnt(0)":::"memory");
    #pragma unroll
    for(int i=0;i<4;++i){const int row=i*8+(lane>>3),ch=lane&7; const u32x4 v=*(const u32x4*)(stg+row*64+ch*8); ATTN_STORE16(Ow+(long)row*OP+ch*8,v);} }
  asm volatile("s_waitcnt lgkmcnt(0)\n\ts_barrier":::"memory");
  #undef DMA_K
  #undef DMA_V
  #undef CMASK
  #undef START
  #undef RESC
  #undef ROT
}
constexpr int ATTN_LDS_BYTES=LDS_BYTES;
#undef SBAR
#undef WAIT_BAR
}
#define LDS_WAIT() asm volatile("s_waitcnt lgkmcnt(0)" ::: "memory")

__device__ __forceinline__ void transpose_item(const float* W, int K, int N, bf16* WT, int k0, int n0, int dest_row0, LAS float* scr, int lane) {
    float t_[32];
#pragma unroll
    for (int i = 0; i < 32; ++i) t_[i] = W[(size_t)(k0 + 2 * i + (lane >> 5)) * N + n0 + (lane & 31)];
#pragma unroll
    for (int i = 0; i < 32; ++i) scr[(2 * i + (lane >> 5)) * 33 + (lane & 31)] = t_[i];
    LDS_WAIT(); asm volatile("" ::: "memory");
    const int c = lane & 7;
#pragma unroll
    for (int j = 0; j < 4; ++j) { const int n = (lane >> 3) + 8 * j; const LAS float* s = scr + (8 * c) * 33 + n;
        v4u o; o.x = pk2(s[0 * 33], s[1 * 33]); o.y = pk2(s[2 * 33], s[3 * 33]); o.z = pk2(s[4 * 33], s[5 * 33]); o.w = pk2(s[6 * 33], s[7 * 33]);
        *(GAS v4u*)(WT + (size_t)(dest_row0 + n) * K + k0 + 8 * c) = o; }
    LDS_WAIT(); asm volatile("" ::: "memory");
}

template <int KMODE>
__device__ __forceinline__ void transpose_item8(const float* W, int K, int N, unsigned char* WT, int k0, int n0, int dest_row0, float sc, LAS float* scr, int lane) {
    float t_[32];
#pragma unroll
    for (int i = 0; i < 32; ++i) t_[i] = W[(size_t)(k0 + 2 * i + (lane >> 5)) * N + n0 + (lane & 31)];
#pragma unroll
    for (int i = 0; i < 32; ++i) scr[(2 * i + (lane >> 5)) * 33 + (lane & 31)] = __builtin_amdgcn_fmed3f(t_[i] * sc, -448.f, 448.f);
    LDS_WAIT(); asm volatile("" ::: "memory");
    const int c = lane & 7, w = c >> 2, fq = c & 3, wh = (k0 >> 6) & 1;
    const int doff = KMODE == 1 ? (k0 & ~255) + 64 * (2 * wh + w) + 16 * fq + 8 * ((k0 >> 7) & 1) : KMODE == 2 ? (k0 & ~127) + 32 * (2 * wh + w) + 8 * fq : k0 + 8 * c;
#pragma unroll
    for (int j = 0; j < 4; ++j) { const int n = (lane >> 3) + 8 * j; const LAS float* s = scr + n;
        float v[8];
#pragma unroll
        for (int e = 0; e < 8; ++e) { const int kk = KMODE == 2 ? 32 * w + 16 * (e >> 2) + 4 * fq + (e & 3) : 8 * c + e; v[e] = s[kk * 33]; }
        unsigned w0 = 0, w1 = 0;
        w0 = __builtin_amdgcn_cvt_pk_fp8_f32(v[0], v[1], w0, false); w0 = __builtin_amdgcn_cvt_pk_fp8_f32(v[2], v[3], w0, true);
        w1 = __builtin_amdgcn_cvt_pk_fp8_f32(v[4], v[5], w1, false); w1 = __builtin_amdgcn_cvt_pk_fp8_f32(v[6], v[7], w1, true);
        *(GAS v2u*)(WT + (size_t)(dest_row0 + n) * K + doff) = (v2u){w0, w1}; }
    LDS_WAIT(); asm volatile("" ::: "memory");
}

struct ProIn { const float *hy_w_in, *at_w_in, *w_out, *w_mem_kv; };
__device__ __forceinline__ void phase_weights(const ProIn& P, unsigned char* ws, LAS unsigned char* lds, int gw, int NGW, int wave, int lane) {
    LAS float* scr = (LAS float*)(lds + wave * 16384);
    constexpr int I_HY = 16 * 80, I_AT = 16 * 48, I_OUT = 16 * 32, I_MKV = 16 * 16;
    constexpr int E0 = 2 * I_HY, E1 = E0 + 2 * I_AT, E2 = E1 + 4 * I_OUT, E3 = E2 + 4 * I_MKV;
    for (int it = gw; it < E3; it += NGW) {
        int r = it;
        if (r < E0) { const int j = r / I_HY, q = r % I_HY, kb = q / 80, nb = q % 80;
            transpose_item(P.hy_w_in + (size_t)j * DM * D_IN_HY, DM, D_IN_HY, (bf16*)(ws + WS_WHY) + (size_t)j * D_IN_HY * DM, 64 * kb, 32 * nb, 32 * nb, scr, lane); continue; }
        r -= E0;
        if (r < 2 * I_AT) { const int j = r / I_AT, q = r % I_AT, kb = q / 48, nb = q % 48;
            const int n0 = 32 * nb, o = n0 & 255;
            transpose_item(P.at_w_in + (size_t)j * DM * D_IN_AT, DM, D_IN_AT, (bf16*)(ws + WS_WAT) + (size_t)j * D_IN_AT * DM, 64 * kb, n0, (n0 & ~255) + 128 * ((o & 63) >> 5) + 32 * (o >> 6), scr, lane); continue; }
        r -= 2 * I_AT;
        if (r < 4 * I_OUT) { const int j = r / I_OUT, q = r % I_OUT, kb = q / 32, nb = q % 32;
            transpose_item(P.w_out + (size_t)j * DM * DM, DM, DM, (bf16*)(ws + WS_WOUT) + (size_t)j * DM * DM, 64 * kb, 32 * nb, 32 * nb, scr, lane); continue; }
        r -= 4 * I_OUT;
        { const int j = r / I_MKV, q = r % I_MKV, kb = q / 16, nb = q % 16;
            transpose_item(P.w_mem_kv + (size_t)j * DM * 512, DM, 512, (bf16*)(ws + WS_WMKV), 64 * kb, 32 * nb, j * 512 + 32 * nb, scr, lane); }
        (void)r;
    }
}

struct XwIn { const float *w_gate, *w_up, *w_down; unsigned char* ws; };
constexpr int XW_PER_EXPERT = 3 * 384, XW_PER_LAYER = NEXP * XW_PER_EXPERT;
constexpr int XW_QA_HY = 5, XW_QA_AT = 4, XW_QB = 3, XW_NA = 128 * NWAVES, XW_NB = 224 * NWAVES;
__host__ __device__ constexpr int xw_qa(int layer) { return (layer & 1) ? XW_QA_AT : XW_QA_HY; }
__host__ __device__ constexpr int xw_p0(int layer, bool sched) { return sched ? XW_PER_LAYER - xw_qa(layer) * XW_NA - XW_QB * XW_NB : XW_PER_LAYER; }
__device__ __forceinline__ void xw_item(const XwIn& B, int layer, int r, LAS float* scr, int lane) {
    const int j = layer * NEXP + r / XW_PER_EXPERT, q = r % XW_PER_EXPERT, kind = q / 384, qq = q % 384;
    if (kind < 2) { const int kb = qq / 24, nb = qq % 24, n0 = 32 * nb;
        transpose_item8<1>((kind == 0 ? B.w_gate : B.w_up) + (size_t)j * DM * EFF, DM, EFF, B.ws + WS_W1 + (size_t)j * 1536 * DM, 64 * kb, n0, (n0 >> 7) * 256 + 128 * kind + (n0 & 127), W8_SCALE, scr, lane); }
    else { const int kb = qq / 32, nb = qq % 32;
        transpose_item8<2>(B.w_down + (size_t)j * EFF * DM, EFF, DM, B.ws + WS_W2 + (size_t)j * DM * EFF, 64 * kb, 32 * nb, 32 * nb, W8_SCALE, scr, lane); }
}
__device__ __forceinline__ void phase_xw_p0(const XwIn& B, bool sched, LAS float* scr, int gw, int NGW, int lane) {
#pragma unroll 1
    for (int layer = 0; layer < DEPTH; ++layer) { const int n = xw_p0(layer, sched);
#pragma unroll 1
        for (int r = gw; r < n; r += NGW) xw_item(B, layer, r, scr, lane); }
}
__device__ __forceinline__ void xw_slice_a(const XwIn& B, int layer, LAS float* scr, int bx, int wave, int lane) {
    const int base = xw_p0(layer, true) + (bx - 128) * NWAVES + wave;
#pragma unroll 1
    for (int k = 0; k < xw_qa(layer); ++k) xw_item(B, layer, base + k * XW_NA, scr, lane);
}
__device__ __forceinline__ void xw_slice_b(const XwIn& B, int layer, LAS float* scr, int bx, int wave, int lane) {
    const int base = xw_p0(layer, true) + xw_qa(layer) * XW_NA + (bx - 32) * NWAVES + wave;
#pragma unroll 1
    for (int k = 0; k < XW_QB; ++k) xw_item(B, layer, base + k * XW_NB, scr, lane);
}

__device__ __forceinline__ void phase_wrg(const float* ffn_g, const float* router, float* WRG, int gtid, int nthreads) {
    for (int q = gtid; q < DEPTH * NEXP * DM; q += nthreads) { const int l = q / (NEXP * DM), e = (q / DM) % NEXP, d = q % DM; WRG[q] = ffn_g[l * DM + d] * router[((size_t)l * DM + d) * NEXP + e]; }
}

__device__ __forceinline__ void rms_row_bf16(const float* xrow, const float* g, bf16* orow, int lane) {
    const GAS f32x4* xr = (const GAS f32x4*)xrow + lane; const GAS f32x4* gr = (const GAS f32x4*)g + lane;
    f32x4 v[4]; float s = 0.f;
#pragma unroll
    for (int j = 0; j < 4; ++j) { v[j] = xr[64 * j]; s += (v[j].x * v[j].x + v[j].y * v[j].y) + (v[j].z * v[j].z + v[j].w * v[j].w); }
    const float rstd = 1.f / sqrtf(wave_sum(s) * (1.f / DM) + NORM_EPS);
    GAS v2u* o8 = (GAS v2u*)orow + lane;
#pragma unroll
    for (int j = 0; j < 4; ++j) { const f32x4 gg = gr[64 * j]; v2u w; w.x = pk2(v[j].x * rstd * gg.x, v[j].y * rstd * gg.y); w.y = pk2(v[j].z * rstd * gg.z, v[j].w * rstd * gg.w); o8[64 * j] = w; }
}

__device__ __forceinline__ void phase_mem_h2(const float* mem, const float* mem_g, const float* fw1, const float* fb1, const float* fw2, const float* fb2, const float* ffreq,
                                              unsigned char* ws, int gw, int NGW, int lane) {
    for (int m = gw; m < BATCH * MEM_LEN; m += NGW) rms_row_bf16(mem + (size_t)m * DM, mem_g, (bf16*)(ws + WS_MEMN) + (size_t)m * DM, lane);
    float* H2 = (float*)(ws + WS_H2);
    for (int it = gw; it < 2 * SEQ; it += NGW) {
        const int j = it / SEQ, n = it % SEQ;
        const float* w1 = fw1 + j * HY_EMB * HY_FILT; const float* w2 = fw2 + j * HY_FILT * HY_FILT;
        const float t = (float)n * (1.0f / (float)(SEQ - 1));
        const float w = (6.283185307179586f * (float)n) / (float)SEQ;
        float feat = 0.f;
        if (lane == 0) feat = t;
        else if (lane <= 16) { const float band = 1e-4f + (float)(lane - 1) * ((15.0f - 1e-4f) / 15.0f); feat = cosf(band * w); }
        else if (lane <= 32) { const float band = 1e-4f + (float)(lane - 17) * ((15.0f - 1e-4f) / 15.0f); feat = -sinf(band * w); }
        const float fr = ffreq[j * HY_FILT + lane];
        float a = fb1[j * HY_FILT + lane];
        for (int i = 0; i < HY_EMB; ++i) a += __shfl(feat, i) * w1[i * HY_FILT + lane];
        const float h1 = sinf(fr * a);
        float a2 = fb2[j * HY_FILT + lane];
        for (int i = 0; i < HY_FILT; ++i) a2 += __shfl(h1, i) * w2[i * HY_FILT + lane];
        H2[(size_t)it * HY_FILT + lane] = sinf(fr * a2);
    }
}

template <bool COMBINE, bool FINAL>
__device__ __forceinline__ void phase_norm(const float* hin, float* hout, const float* g, bf16* U, float* fout, const int* POS, const bf16* Y, int gw, int NGW, int lane) {
    int m = gw;
    if (m >= M_TOK) return;
    f32x4 cur[4]; int cpos = -1;
    { const GAS f32x4* xr = (const GAS f32x4*)(hin + (size_t)m * DM) + lane;
#pragma unroll
      for (int j = 0; j < 4; ++j) cur[j] = xr[64 * j];
      if (COMBINE) { const int b = m / SEQ, t = m % SEQ; if (lane < NEXP) cpos = POS[(size_t)(b * NEXP + lane) * SEQ + t]; } }
#pragma unroll 1
    for (; m < M_TOK; m += NGW) {
        const int mn = m + NGW; f32x4 nxt[4]; int npos = -1;
#pragma unroll
        for (int j = 0; j < 4; ++j) nxt[j] = cur[j];
        if (mn < M_TOK) { const GAS f32x4* xr = (const GAS f32x4*)(hin + (size_t)mn * DM) + lane;
#pragma unroll
            for (int j = 0; j < 4; ++j) nxt[j] = xr[64 * j];
            if (COMBINE) { const int b = mn / SEQ, t = mn % SEQ; if (lane < NEXP) npos = POS[(size_t)(b * NEXP + lane) * SEQ + t]; } }
        f32x4 v[4];
#pragma unroll
        for (int j = 0; j < 4; ++j) v[j] = cur[j];
        if (COMBINE) {
            const int b = m / SEQ;
            unsigned long long mask = __ballot(cpos >= 0);
            while (mask) {
                v2u y[4][4]; bool has[4];
#pragma unroll
                for (int k = 0; k < 4; ++k) { has[k] = mask != 0ull;
                    if (has[k]) { const int e = __builtin_amdgcn_readfirstlane(__builtin_ctzll(mask)); mask &= mask - 1ull; const int p = __builtin_amdgcn_readlane(cpos, e);
                        const GAS v2u* yr = (const GAS v2u*)(Y + ((size_t)(b * NEXP + e) * CAP + p) * DM) + lane;
#pragma unroll
                        for (int j = 0; j < 4; ++j) y[k][j] = yr[64 * j]; } }
#pragma unroll
                for (int k = 0; k < 4; ++k) if (has[k]) {
#pragma unroll
                    for (int j = 0; j < 4; ++j) { const v2u w = y[k][j]; v[j].x += bflo(w.x); v[j].y += bfhi(w.x); v[j].z += bflo(w.y); v[j].w += bfhi(w.y); } }
            }
            if (!FINAL) { GAS f32x4* ho = (GAS f32x4*)(hout + (size_t)m * DM) + lane;
#pragma unroll
                for (int j = 0; j < 4; ++j) ho[64 * j] = v[j]; }
        }
        float s = 0.f;
#pragma unroll
        for (int j = 0; j < 4; ++j) s += (v[j].x * v[j].x + v[j].y * v[j].y) + (v[j].z * v[j].z + v[j].w * v[j].w);
        const float rstd = 1.f / sqrtf(wave_sum(s) * (1.f / DM) + NORM_EPS);
        const GAS f32x4* gr = (const GAS f32x4*)g + lane;
        if (FINAL) { GAS f32x4* o = (GAS f32x4*)(fout + (size_t)m * DM) + lane;
#pragma unroll
            for (int j = 0; j < 4; ++j) o[64 * j] = v[j] * rstd * gr[64 * j]; }
        else { GAS v2u* o8 = (GAS v2u*)(U + (size_t)m * DM) + lane;
#pragma unroll
            for (int j = 0; j < 4; ++j) { const f32x4 gg = gr[64 * j]; v2u w; w.x = pk2(v[j].x * rstd * gg.x, v[j].y * rstd * gg.y); w.y = pk2(v[j].z * rstd * gg.z, v[j].w * rstd * gg.w); o8[64 * j] = w; } }
#pragma unroll
        for (int j = 0; j < 4; ++j) cur[j] = nxt[j];
        cpos = npos;
    }
}

__device__ __forceinline__ void phase_ffn_norm_router(const float* H, const float* g, const float* Wr, unsigned char* XN8, float* AFF, LAS unsigned char* lds, int gw, int NGW, int lane, int tid) {
    LAS f32x4* WL = (LAS f32x4*)lds;
    for (int q = tid; q < 64 * 64; q += NTHREADS) { const int ln = q & 63, s = q >> 6, e4 = s & 3, ji = s >> 2, i = ji & 3, j = ji >> 2; const int d = 4 * ln + i + 256 * j;
        WL[q] = *(const GAS f32x4*)(Wr + (size_t)d * NEXP + 4 * e4); }
    __syncthreads();
    constexpr int R = 4;
    const GAS f32x4* gr = (const GAS f32x4*)g + lane;
#pragma unroll 1
    for (int m0 = gw * R; m0 < M_TOK; m0 += NGW * R) {
        int lo_ = lane; asm volatile("" : "+v"(lo_));
        f32x4 v[R][4]; float rstd[R];
#pragma unroll
        for (int r = 0; r < R; ++r) { const GAS f32x4* xr = (const GAS f32x4*)(H + (size_t)(m0 + r) * DM) + lane;
#pragma unroll
            for (int j = 0; j < 4; ++j) v[r][j] = xr[64 * j]; }
#pragma unroll
        for (int r = 0; r < R; ++r) { float s = 0.f;
#pragma unroll
            for (int j = 0; j < 4; ++j) s += (v[r][j].x * v[r][j].x + v[r][j].y * v[r][j].y) + (v[r][j].z * v[r][j].z + v[r][j].w * v[r][j].w);
            rstd[r] = 1.f / sqrtf(wave_sum(s) * (1.f / DM) + NORM_EPS); }
        f32x4 lg[R][4];
#pragma unroll
        for (int r = 0; r < R; ++r)
#pragma unroll
            for (int e4 = 0; e4 < 4; ++e4) lg[r][e4] = (f32x4){0.f, 0.f, 0.f, 0.f};
#pragma unroll
        for (int j = 0; j < 4; ++j) { const f32x4 gg = gr[64 * j];
#pragma unroll
            for (int r = 0; r < R; ++r) { v[r][j] = v[r][j] * rstd[r] * gg;
                unsigned w = 0; w = __builtin_amdgcn_cvt_pk_fp8_f32(v[r][j].x, v[r][j].y, w, false); w = __builtin_amdgcn_cvt_pk_fp8_f32(v[r][j].z, v[r][j].w, w, true);
                ((GAS unsigned*)(XN8 + (size_t)(m0 + r) * DM) + lane)[64 * j] = w; }
#pragma unroll
            for (int i = 0; i < 4; ++i)
#pragma unroll
                for (int e4 = 0; e4 < 4; ++e4) { const f32x4 wv = WL[((j * 4 + i) * 4 + e4) * 64 + lo_];
#pragma unroll
                    for (int r = 0; r < R; ++r) { const float xs = v[r][j][i];
#pragma unroll
                        for (int c = 0; c < 4; ++c) asm("v_fmac_f32 %0, %1, %2" : "+v"(lg[r][e4][c]) : "v"(wv[c]), "v"(xs)); } }
            __builtin_amdgcn_sched_barrier(0); }
#pragma unroll
        for (int r = 0; r < R; ++r) {
            float l16[16];
#pragma unroll
            for (int e = 0; e < 16; ++e) l16[e] = wave_sum(lg[r][e >> 2][e & 3]);
            float mx = l16[0];
#pragma unroll
            for (int e = 1; e < 16; ++e) mx = fmaxf(mx, l16[e]);
            float den = 0.f;
#pragma unroll
            for (int e = 0; e < 16; ++e) { l16[e] = expf(l16[e] - mx); den += l16[e]; }
            float mine = 0.f;
#pragma unroll
            for (int e = 0; e < 16; ++e) mine = (lane == e) ? l16[e] : mine;
            const int m = m0 + r, b = m / SEQ, t = m % SEQ;
            if (lane < NEXP) AFF[(size_t)(b * NEXP + lane) * SEQ + t] = mine / den;
        }
    }
    __syncthreads();
}

__device__ __forceinline__ void phase_router_sum(const float* PLG, const float* PSS, float* RSTD, float* AFF, int gw, int NGW, int lane) {
    const int e = lane & 15, rq = lane >> 4;
    for (int m0 = gw * 4; m0 < M_TOK; m0 += NGW * 4) {
        const int m = m0 + rq;
        float lgt = 0.f;
#pragma unroll
        for (int slot = 0; slot < 16; ++slot) lgt += PLG[((size_t)slot * M_TOK + m) * 16 + e];
        float ss = PSS[(size_t)e * M_TOK + m];
#pragma unroll
        for (int o = 1; o < 16; o <<= 1) ss += __shfl_xor(ss, o);
        const float rstd = 1.f / sqrtf(ss * (1.f / DM) + NORM_EPS);
        lgt *= rstd;
        float mx = lgt;
#pragma unroll
        for (int o = 1; o < 16; o <<= 1) mx = fmaxf(mx, __shfl_xor(mx, o));
        const float ex = expf(lgt - mx); float den = ex;
#pragma unroll
        for (int o = 1; o < 16; o <<= 1) den += __shfl_xor(den, o);
        const int b = m / SEQ, t = m % SEQ;
        AFF[(size_t)(b * NEXP + e) * SEQ + t] = ex / den;
        if (e == 0) RSTD[m] = rstd;
    }
}

__device__ __forceinline__ int block_excl_scan(int v, LAS int* scr, int tid, int lane, int wave, int* tot) {
    int inc = v;
#pragma unroll
    for (int o = 1; o < 64; o <<= 1) { const int n = __shfl_up(inc, o); if (lane >= o) inc += n; }
    __syncthreads();
    if (lane == 63) scr[wave] = inc;
    __syncthreads();
    int base = 0, total = 0;
#pragma unroll
    for (int w = 0; w < NWAVES; ++w) { const int c = scr[w]; if (w < wave) base += c; total += c; }
    *tot = total;
    return base + inc - v;
}

__device__ __forceinline__ void phase_topk(const float* AFF, const float* RSTD, float* RS, int* IDX, float* GATE, int* POS, LAS unsigned char* ldsm, int blk, int nblk, int tid, int lane, int wave) {
    LAS int* hist = (LAS int*)ldsm;
    LAS int* sel = (LAS int*)(ldsm + 1024);
    LAS int* scr = (LAS int*)(ldsm + 1280);
    for (int g = blk; g < NGRP; g += nblk) {
        unsigned v[16];
        { const GAS v4u* src = (const GAS v4u*)(AFF + (size_t)g * SEQ) + tid * 4;
#pragma unroll
          for (int q = 0; q < 4; ++q) { const v4u w = src[q]; v[4 * q] = w.x; v[4 * q + 1] = w.y; v[4 * q + 2] = w.z; v[4 * q + 3] = w.w; } }
        unsigned prefix = 0u; int krem = CAP;
#pragma unroll 1
        for (int pass = 0; pass < 4; ++pass) {
            const int shift = 24 - 8 * pass;
            const unsigned himask = (pass == 0) ? 0u : (0xffffffffu << (shift + 8));
            __syncthreads();
            if (tid < 256) hist[tid] = 0;
            __syncthreads();
#pragma unroll
            for (int i = 0; i < 16; ++i) if ((v[i] & himask) == prefix) __hip_atomic_fetch_add(hist + ((v[i] >> shift) & 255u), 1, __ATOMIC_RELAXED, __HIP_MEMORY_SCOPE_WORKGROUP);
            __syncthreads();
            if (wave == 0) {
                int c[4]; int s = 0;
#pragma unroll
                for (int j = 0; j < 4; ++j) { c[j] = hist[255 - 4 * lane - j]; s += c[j]; }
                int inc = s;
#pragma unroll
                for (int o = 1; o < 64; o <<= 1) { const int n = __shfl_up(inc, o); if (lane >= o) inc += n; }
                int before = inc - s;
                if (before < krem && krem <= inc) {
                    int bin = 0, kk = krem - before; bool done = false;
#pragma unroll
                    for (int j = 0; j < 4; ++j) { if (!done) { if (kk <= c[j]) { bin = 255 - 4 * lane - j; done = true; } else kk -= c[j]; } }
                    sel[0] = bin; sel[1] = kk;
                }
            }
            __syncthreads();
            prefix |= ((unsigned)sel[0]) << shift; krem = sel[1];
        }
        int ceq = 0;
#pragma unroll
        for (int i = 0; i < 16; ++i) ceq += (v[i] == prefix) ? 1 : 0;
        int tot;
        int eqrank = block_excl_scan(ceq, scr, tid, lane, wave, &tot);
        int csel = 0; unsigned selmask = 0u;
#pragma unroll
        for (int i = 0; i < 16; ++i) { bool s = v[i] > prefix; if (v[i] == prefix) { s = eqrank < krem; ++eqrank; } if (s) { selmask |= 1u << i; ++csel; } }
        int slot = block_excl_scan(csel, scr, tid, lane, wave, &tot);
        const int b = g / NEXP;
        int pv[16];
#pragma unroll
        for (int i = 0; i < 16; ++i) {
            pv[i] = -1;
            if (selmask & (1u << i)) { pv[i] = slot; IDX[g * CAP + slot] = b * SEQ + tid * 16 + i; GATE[g * CAP + slot] = __builtin_bit_cast(float, v[i]); RS[g * CAP + slot] = RSTD[b * SEQ + tid * 16 + i]; ++slot; }
        }
        { GAS v4u* dst = (GAS v4u*)(POS + (size_t)g * SEQ) + tid * 4;
#pragma unroll
          for (int q = 0; q < 4; ++q) { v4u w; w.x = (unsigned)pv[4 * q]; w.y = (unsigned)pv[4 * q + 1]; w.z = (unsigned)pv[4 * q + 2]; w.w = (unsigned)pv[4 * q + 3]; dst[q] = w; } }
        __syncthreads();
    }
}

__device__ __forceinline__ void phase_gather(const bf16* XN, const int* IDX, bf16* XG, int gw, int NGW, int lane) {
    for (int r = gw; r < XROWS; r += NGW) {
        const int src = __builtin_amdgcn_readfirstlane(IDX[r]);
        const GAS v4u* s = (const GAS v4u*)(XN + (size_t)src * DM) + lane; GAS v4u* d = (GAS v4u*)(XG + (size_t)r * DM) + lane;
        const v4u a = s[0], b = s[64]; d[0] = a; d[64] = b;
    }
}

__device__ __forceinline__ void phase_qk_rope(bf16* P, const float* gq, const float* gk, int gw, int NGW, int lane) {
    const int hh = lane >> 2, part = lane & 3, axis = part >> 1, half = part & 1;
    const float* g = (hh < NQH ? gq : gk) + 16 * part;
    float gv[16], inv[16];
#pragma unroll
    for (int i = 0; i < 16; ++i) { gv[i] = g[i]; inv[i] = exp2f(-(float)i * (13.287712379549449f / 16.0f)); }
    const float osc = hh < NQH ? ATT_C2 : 1.0f;
    int m = gw; v4u c0 = (v4u){0u, 0u, 0u, 0u}, c1 = c0;
    if (m < M_TOK) { const GAS v4u* p = (const GAS v4u*)(P + (size_t)m * D_IN_AT + hh * HD + 16 * part); c0 = p[0]; c1 = p[1]; }
#pragma unroll 1
    for (; m < M_TOK; m += NGW) {
        const int t = m % SEQ; const float pos = (float)(axis == 0 ? (t >> 6) : (t & 63));
        GAS v4u* p = (GAS v4u*)(P + (size_t)m * D_IN_AT + hh * HD + 16 * part);
        const v4u w0 = c0, w1 = c1;
        if (m + NGW < M_TOK) { const GAS v4u* pn = (const GAS v4u*)(P + (size_t)(m + NGW) * D_IN_AT + hh * HD + 16 * part); c0 = pn[0]; c1 = pn[1]; }
        float x[16];
        x[0] = bflo(w0.x); x[1] = bfhi(w0.x); x[2] = bflo(w0.y); x[3] = bfhi(w0.y); x[4] = bflo(w0.z); x[5] = bfhi(w0.z); x[6] = bflo(w0.w); x[7] = bfhi(w0.w);
        x[8] = bflo(w1.x); x[9] = bfhi(w1.x); x[10] = bflo(w1.y); x[11] = bfhi(w1.y); x[12] = bflo(w1.z); x[13] = bfhi(w1.z); x[14] = bflo(w1.w); x[15] = bfhi(w1.w);
        float ss = 0.f;
#pragma unroll
        for (int i = 0; i < 16; ++i) ss += x[i] * x[i];
        ss += __shfl_xor(ss, 1); ss += __shfl_xor(ss, 2);
        const float rstd = 1.f / sqrtf(ss * (1.f / HD) + NORM_EPS);
        float o[16];
#pragma unroll
        for (int i = 0; i < 16; ++i) {
            const float xn = x[i] * rstd * gv[i]; const float xp = __shfl_xor(xn, 1);
            float sn, cs; sincosf(pos * inv[i], &sn, &cs);
            o[i] = (half == 0 ? (xn * cs - xp * sn) : (xp * sn + xn * cs)) * osc;
        }
        v4u r0, r1;
        r0.x = pk2(o[0], o[1]); r0.y = pk2(o[2], o[3]); r0.z = pk2(o[4], o[5]); r0.w = pk2(o[6], o[7]);
        r1.x = pk2(o[8], o[9]); r1.y = pk2(o[10], o[11]); r1.z = pk2(o[12], o[13]); r1.w = pk2(o[14], o[15]);
        p[0] = r0; p[1] = r1;
    }
}

__device__ __forceinline__ void phase_transpose_mix(const bf16* MIXT, bf16* MIX, int blk, int nblk, int tid) {
    for (int it = blk; it < (D_MAIN / 64) * (M_TOK / NTHREADS); it += nblk) {
        const int cb = it % (D_MAIN / 64), mb = it / (D_MAIN / 64); const int m = mb * NTHREADS + tid, c0 = cb * 64;
        unsigned w[32];
#pragma unroll
        for (int c = 0; c < 32; ++c) { const unsigned lo = MIXT[(size_t)(c0 + 2 * c) * M_TOK + m], hi = MIXT[(size_t)(c0 + 2 * c + 1) * M_TOK + m]; w[c] = lo | (hi << 16); }
        GAS v4u* d = (GAS v4u*)(MIX + (size_t)m * DM + c0);
#pragma unroll
        for (int q = 0; q < 8; ++q) { v4u o; o.x = w[4 * q]; o.y = w[4 * q + 1]; o.z = w[4 * q + 2]; o.w = w[4 * q + 3]; d[q] = o; }
    }
}
__device__ __forceinline__ void phase_taps(const float* H2j, const float* w3, float* TAPS, int gw, int NGW, int lane) {
    typedef float f32x16 __attribute__((ext_vector_type(16))); typedef short bf16x8_t __attribute__((ext_vector_type(8)));
    const float min_decay = -4.605170185988091f / 1.5f, max_decay = -4.605170185988091f / 0.3f;
    const int li = lane & 31, hi = lane >> 5;
#pragma unroll 1
    for (int it = gw; it < (FCOLS / 32) * (SEQ / 128); it += NGW) {
        const int ct = it % (FCOLS / 32), ng = it / (FCOLS / 32), col0 = ct * 32;
        bf16x8_t a[4];
#pragma unroll
        for (int s = 0; s < 4; ++s) { float t[8];
#pragma unroll
            for (int j = 0; j < 8; ++j) t[j] = w3[(size_t)(16 * s + 8 * hi + j) * FCOLS + col0 + li];
            v4u p; p.x = pk2(t[0], t[1]); p.y = pk2(t[2], t[3]); p.z = pk2(t[4], t[5]); p.w = pk2(t[6], t[7]); a[s] = __builtin_bit_cast(bf16x8_t, p); }
        f32x4 hv[4][8];
#pragma unroll
        for (int nt = 0; nt < 4; ++nt) { const GAS f32x4* hp = (const GAS f32x4*)(H2j + (size_t)(ng * 128 + nt * 32 + li) * HY_FILT + 8 * hi);
#pragma unroll
            for (int s = 0; s < 4; ++s) { hv[nt][2 * s] = hp[4 * s]; hv[nt][2 * s + 1] = hp[4 * s + 1]; } }
#pragma unroll
        for (int nt = 0; nt < 4; ++nt) {
            const int n0 = ng * 128 + nt * 32;
            f32x16 acc;
#pragma unroll
            for (int r = 0; r < 16; ++r) acc[r] = 0.f;
#pragma unroll
            for (int s = 0; s < 4; ++s) { const f32x4 v0 = hv[nt][2 * s], v1 = hv[nt][2 * s + 1];
                v4u p; p.x = pk2(v0.x, v0.y); p.y = pk2(v0.z, v0.w); p.z = pk2(v1.x, v1.y); p.w = pk2(v1.z, v1.w);
                acc = __builtin_amdgcn_mfma_f32_32x32x16_bf16(a[s], __builtin_bit_cast(bf16x8_t, p), acc, 0, 0, 0); }
            const float t = (float)(n0 + li) * (1.0f / (float)(SEQ - 1));
#pragma unroll
            for (int r = 0; r < 16; ++r) { const int col = col0 + (r & 3) + 8 * (r >> 2) + 4 * hi, c = col % D_MAIN;
                const float ad = fabsf(min_decay + (float)c * ((max_decay - min_decay) / (float)(D_MAIN - 1)));
                TAPS[(size_t)col * SEQ + n0 + li] = acc[r] * expf(-t * ad); }
        }
    }
}

__device__ __forceinline__ constexpr float twc(int k) { constexpr float T[16] = {1.0f, 0.98078528040323043f, 0.92387953251128674f, 0.83146961230254524f, 0.70710678118654757f, 0.55557023301960218f, 0.38268343236508978f, 0.19509032201612825f,
    0.0f, -0.19509032201612825f, -0.38268343236508978f, -0.55557023301960218f, -0.70710678118654757f, -0.83146961230254524f, -0.92387953251128674f, -0.98078528040323043f}; return T[k]; }
__device__ __forceinline__ constexpr float tws(int k) { constexpr float T[16] = {0.0f, 0.19509032201612825f, 0.38268343236508978f, 0.55557023301960218f, 0.70710678118654757f, 0.83146961230254524f, 0.92387953251128674f, 0.98078528040323043f,
    1.0f, 0.98078528040323043f, 0.92387953251128674f, 0.83146961230254524f, 0.70710678118654757f, 0.55557023301960218f, 0.38268343236508978f, 0.19509032201612825f}; return T[k]; }
__device__ __forceinline__ constexpr int bitrev(int i, int bits) { int r = 0; for (int b = 0; b < bits; ++b) if (i & (1 << b)) r |= 1 << (bits - 1 - b); return r; }

template <int N, int LEN> struct FftStage {
    static __device__ __forceinline__ void run(float (&re)[N], float (&im)[N]) {
        constexpr int half = LEN / 2, step = 32 / LEN;
#pragma unroll
        for (int base = 0; base < N; base += LEN)
#pragma unroll
            for (int j = 0; j < half; ++j) {
                const int i0 = base + j, i1 = i0 + half, idx = j * step;
                const float ar = re[i0], ai = im[i0], br = re[i1], bi = im[i1];
                re[i0] = ar + br; im[i0] = ai + bi;
                const float dr = ar - br, di = ai - bi;
                if (idx == 0) { re[i1] = dr; im[i1] = di; }
                else if (idx == 8) { re[i1] = di; im[i1] = -dr; }
                else { const float c = twc(idx), s = tws(idx); re[i1] = dr * c + di * s; im[i1] = di * c - dr * s; }
            }
        if constexpr (LEN > 2) FftStage<N, LEN / 2>::run(re, im);
    }
};
template <int N, int BITS> __device__ __forceinline__ void fft_reg(float (&re)[N], float (&im)[N]) {
    FftStage<N, N>::run(re, im);
    float tr[N], ti[N];
#pragma unroll
    for (int i = 0; i < N; ++i) { tr[bitrev(i, BITS)] = re[i]; ti[bitrev(i, BITS)] = im[i]; }
#pragma unroll
    for (int i = 0; i < N; ++i) { re[i] = tr[i]; im[i] = ti[i]; }
}

template <int N, int LEN> struct FftStageC {
    static __device__ __forceinline__ void run(f32x2 (&x)[N]) {
        constexpr int half = LEN / 2, step = 32 / LEN;
#pragma unroll
        for (int base = 0; base < N; base += LEN)
#pragma unroll
            for (int j = 0; j < half; ++j) {
                const int i0 = base + j, i1 = i0 + half, idx = j * step;
                const f32x2 a = x[i0], b = x[i1];
                x[i0] = a + b;
                const f32x2 d = a - b;
                if (idx == 0) x[i1] = d;
                else if (idx == 8) x[i1] = (f32x2){d.y, -d.x};
                else { const float c = twc(idx), s = tws(idx); const f32x2 t = (f32x2){d.y, -d.x}; x[i1] = d * c + t * s; }
            }
        if constexpr (LEN > 2) FftStageC<N, LEN / 2>::run(x);
    }
};
template <int N, int BITS> __device__ __forceinline__ void fft_regc(f32x2 (&x)[N]) {
    FftStageC<N, N>::run(x);
    f32x2 t[N];
#pragma unroll
    for (int i = 0; i < N; ++i) t[bitrev(i, BITS)] = x[i];
#pragma unroll
    for (int i = 0; i < N; ++i) x[i] = t[i];
}
__device__ __forceinline__ void fft16k_c(f32x2 (&x)[32], LAS f32x2* L, int tid_in) {
    int tid = tid_in; asm volatile("" : "+v"(tid));
    fft_regc<32, 5>(x);
#pragma unroll
    for (int k1 = 1; k1 < 32; ++k1) { const float fr = (float)((tid * k1) & 16383) * (1.0f / 16384.0f); const float c = __builtin_amdgcn_cosf(fr), s = __builtin_amdgcn_sinf(fr);
        const f32x2 d = x[k1], t = (f32x2){d.y, -d.x}; x[k1] = d * c + t * s; if ((k1 & 3) == 3) __builtin_amdgcn_sched_barrier(0); }
#pragma unroll
    for (int k1 = 0; k1 < 32; ++k1) L[k1 * 513 + tid] = x[k1];
    __syncthreads();
    const int n3 = tid & 31, ka = tid >> 5;
    f32x2 a[16], b[16];
#pragma unroll
    for (int n2 = 0; n2 < 16; ++n2) { a[n2] = L[ka * 513 + n2 * 32 + n3]; b[n2] = L[(ka + 16) * 513 + n2 * 32 + n3]; }
    fft_regc<16, 4>(a); fft_regc<16, 4>(b);
#pragma unroll
    for (int k2 = 1; k2 < 16; ++k2) { const float fr = (float)((n3 * k2) & 511) * (1.0f / 512.0f); const float c = __builtin_amdgcn_cosf(fr), s = __builtin_amdgcn_sinf(fr);
        f32x2 d = a[k2], t = (f32x2){d.y, -d.x}; a[k2] = d * c + t * s; d = b[k2]; t = (f32x2){d.y, -d.x}; b[k2] = d * c + t * s; if ((k2 & 3) == 3) __builtin_amdgcn_sched_barrier(0); }
    __syncthreads();
#pragma unroll
    for (int k2 = 0; k2 < 16; ++k2) { L[n3 * 513 + k2 * 32 + ka] = a[k2]; L[n3 * 513 + k2 * 32 + ka + 16] = b[k2]; }
    __syncthreads();
#pragma unroll
    for (int q = 0; q < 32; ++q) x[q] = L[q * 513 + tid];
    fft_regc<32, 5>(x);
}
__device__ __forceinline__ void fft16k(float (&re)[32], float (&im)[32], LAS f32x2* L, int tid) {
    f32x2 x[32];
#pragma unroll
    for (int r = 0; r < 32; ++r) x[r] = (f32x2){re[r], im[r]};
    fft16k_c(x, L, tid);
#pragma unroll
    for (int r = 0; r < 32; ++r) { re[r] = x[r].x; im[r] = x[r].y; }
}

constexpr int HS_SP = SEQ + 16;
__device__ __forceinline__ void hy_stage(LAS bf16* S, int slot, const bf16* src, int tid) {
    LAS bf16* d = S + slot * HS_SP + 8;
    if (tid == 0) { d[-1] = 0; d[SEQ] = 0; }
#pragma unroll
    for (int q = 0; q < 2; ++q) { const int ch = q * NTHREADS + tid; *(LAS v4u*)(d + ch * 8) = *(const GAS v4u*)(src + ch * 8); }
}
__device__ __forceinline__ float hy_sc(const LAS bf16* S, int slot, int t, float w0, float w1, float w2) {
    const LAS bf16* p = S + slot * HS_SP + 8 + t;
    return bf2f(p[-1]) * w0 + bf2f(p[0]) * w1 + bf2f(p[1]) * w2;
}

#ifdef CSEL
#define CT(sec) do { const unsigned long long tn_ = __builtin_amdgcn_s_memrealtime(); if (csec_ == CSEL) ctime_ += tn_ - ct0_; ct0_ = tn_; csec_ = (sec); } while (0)
#else
#define CT(sec)
#endif
__device__ __forceinline__ void phase_hyena_conv(const bf16* PT, const float* TAPS, const float* shortw, const float* skip, f32x2* XSall, f32x2* ZSall, bf16* MIXT,
                                                 LAS unsigned char* lds, int blk, int nblk, int tid_in, int lane, int wave, int pmode = 0) {
    LAS f32x2* L = (LAS f32x2*)lds; LAS bf16* S = (LAS bf16*)lds; LAS float* red = (LAS float*)(lds + LDS_MISC);
    f32x2* XK0 = XSall + (size_t)blk * 16384;
    f32x2* XK1 = XK0 + 16384 * 256; f32x2* ZS = ZSall + (size_t)blk * 16384;
    constexpr int N = 16384;
#ifdef CSEL
    unsigned long long ctime_ = 0ull, ct0_ = __builtin_amdgcn_s_memrealtime(); int csec_ = -1;
#endif
#pragma unroll 1
    for (int c = blk; c < D_MAIN; c += nblk) {
        f32x2 x[32]; float vr[16], vi[16];
#pragma unroll 1
        for (int pass = 0; pass < 5; ++pass) {
            int tid = tid_in; asm volatile("" : "+v"(tid));
            CT(pass == 0 ? 0 : (pass == 1 ? 7 : 8));
            if (pass == 0) {
                const float* hf0 = TAPS + (size_t)c * SEQ; const float* hb0 = TAPS + (size_t)(D_MAIN + c) * SEQ;
                const float* hf1 = TAPS + (size_t)(2 * D_MAIN + c) * SEQ; const float* hb1 = TAPS + (size_t)(3 * D_MAIN + c) * SEQ;
#pragma unroll
                for (int r = 0; r < 16; ++r) { const int n = r * 512 + tid; x[r].x = hf0[n]; x[r].y = hf1[n]; }
#pragma unroll
                for (int r = 16; r < 32; ++r) { const int idx = (32 - r) * 512 - tid; const bool z = (idx == SEQ); const int ii = z ? 0 : idx; x[r].x = z ? 0.f : hb0[ii]; x[r].y = z ? 0.f : hb1[ii]; }
                float e0 = 0.f, e1 = 0.f;
                if (tid == 0) { e0 = hb0[0]; e1 = hb1[0]; }
                float s0 = fabsf(e0), s1 = fabsf(e1);
#pragma unroll
                for (int r = 0; r < 32; ++r) { s0 += fabsf(x[r].x); s1 += fabsf(x[r].y); }
                s0 = wave_sum(s0); s1 = wave_sum(s1);
                __syncthreads();
                if (lane == 0) { red[wave] = s0; red[8 + wave] = s1; }
                __syncthreads();
                float t0 = 0.f, t1 = 0.f;
#pragma unroll
                for (int w = 0; w < NWAVES; ++w) { t0 += red[w]; t1 += red[8 + w]; }
                const float sc0 = 1.0f / (t0 + 1e-6f), sc1 = 1.0f / (t1 + 1e-6f);
                x[0].x += e0; x[0].y += e1;
#pragma unroll
                for (int r = 0; r < 32; ++r) { x[r].x *= sc0; x[r].y *= sc1; }
            } else if (pass == 1) {
                __syncthreads();
                const bf16* pv = PT + (size_t)(2 * D_MAIN + c) * M_TOK; const float wv[3] = {shortw[2 * D_MAIN + c], shortw[2304 + 2 * D_MAIN + c], shortw[4608 + 2 * D_MAIN + c]};
                hy_stage(S, 0, pv, tid); hy_stage(S, 1, pv + SEQ, tid);
                __syncthreads();
#pragma unroll
                for (int r = 0; r < 16; ++r) { const int t = r * 512 + tid; x[r].x = hy_sc(S, 0, t, wv[0], wv[1], wv[2]); x[r].y = hy_sc(S, 1, t, wv[0], wv[1], wv[2]); vr[r] = x[r].x; vi[r] = x[r].y; }
#pragma unroll
                for (int r = 16; r < 32; ++r) { x[r].x = 0.f; x[r].y = 0.f; }
            }
            __syncthreads();
            CT(1);
            fft16k_c(x, L, tid);
            CT(2 + pass);
            if (pass == 0) {
                __syncthreads();
#pragma unroll
                for (int r = 0; r < 32; ++r) L[r * 513 + tid] = x[r];
                __syncthreads();
                const int tp = (512 - tid) & 511;
#pragma unroll
                for (int r = 0; r < 32; ++r) { const int rp = (tid == 0) ? ((32 - r) & 31) : (31 - r);
                    const f32x2 xa = x[r], xb = L[rp * 513 + tp]; const float sc_ = 0.5f / (float)N;
                    XK0[r * 512 + tid] = (f32x2){(xa.x + xb.x) * sc_, (xa.y - xb.y) * sc_};
                    XK1[r * 512 + tid] = (f32x2){(xa.y + xb.y) * sc_, (xb.x - xa.x) * sc_}; if ((r & 7) == 7) __builtin_amdgcn_sched_barrier(0); }
            } else if (pass == 1 || pass == 3) {
                const f32x2* XK = (pass == 1) ? XK0 : XK1;
#pragma unroll
                for (int r = 0; r < 32; ++r) { const f32x2 k = XK[r * 512 + tid]; const float zr_ = x[r].x, zi_ = x[r].y;
                    x[r].x = zr_ * k.x - zi_ * k.y; x[r].y = -(zr_ * k.y + zi_ * k.x); }
            } else if (pass == 2) {
                __syncthreads();
                const bf16* px1 = PT + (size_t)c * M_TOK; const float sk0 = skip[c]; const float wx1[3] = {shortw[c], shortw[2304 + c], shortw[4608 + c]};
                hy_stage(S, 2, px1, tid); hy_stage(S, 3, px1 + SEQ, tid);
                __syncthreads();
#pragma unroll
                for (int r = 0; r < 16; ++r) { const int t = r * 512 + tid;
                    const float v0 = vr[r], v1 = vi[r];
                    const float g0 = hy_sc(S, 2, t, wx1[0], wx1[1], wx1[2]), g1 = hy_sc(S, 3, t, wx1[0], wx1[1], wx1[2]);
                    x[r].x = g0 * (x[r].x + sk0 * v0); x[r].y = g1 * (-x[r].y + sk0 * v1); ZS[t] = (f32x2){x[r].x, x[r].y}; }
#pragma unroll
                for (int r = 16; r < 32; ++r) { x[r].x = 0.f; x[r].y = 0.f; }
            } else {
                __syncthreads();
                const bf16* px2 = PT + (size_t)(D_MAIN + c) * M_TOK; const float sk1 = skip[D_MAIN + c];
                const float wx2[3] = {shortw[D_MAIN + c], shortw[2304 + D_MAIN + c], shortw[4608 + D_MAIN + c]};
                hy_stage(S, 0, px2, tid); hy_stage(S, 1, px2 + SEQ, tid);
                __syncthreads();
#pragma unroll
                for (int r = 0; r < 16; ++r) { const int t = r * 512 + tid;
                    const float g0 = hy_sc(S, 0, t, wx2[0], wx2[1], wx2[2]), g1 = hy_sc(S, 1, t, wx2[0], wx2[1], wx2[2]);
                    const f32x2 z = ZS[t];
                    const float o0 = g0 * (x[r].x + sk1 * z.x), o1 = g1 * (-x[r].y + sk1 * z.y);
                    MIXT[(size_t)c * M_TOK + t] = (bf16)f2bf(o0); MIXT[(size_t)c * M_TOK + SEQ + t] = (bf16)f2bf(o1); }
            }
        }
        CT(-1);
        __syncthreads();
    }
#ifdef CSEL
    if (blk == 0 && tid_in == 0) *(unsigned long long*)((unsigned char*)XSall - WS_FFTX + 32768) += ctime_;
#endif
}
#ifndef MK_PER_PHASE
#define MK_PER_PHASE 0
#endif
#ifndef CONV_PMODE
#define CONV_PMODE 0
#endif
#ifndef REPMASK
#define REPMASK 0u
#endif
#define REP(kind) _Pragma("unroll 1") for (int r_ = 0; r_ < 1 + (int)((REPMASK >> (kind)) & 1u); ++r_)
struct Args {
    const float* in[24]; float* out; unsigned char* ws; int ph_lo, ph_hi;
};
constexpr int N_PHASES = 1 + (DEPTH - 1) + DEPTH * 8 - DEPTH / 2 + 1;

template <int QP, int KP>
__device__ __forceinline__ void run_attn(const bf16* Q, const bf16* K, const bf16* V, bf16* O, int NT, char* shm) {
    attn_body::attn_unit<8, QP, KP, DM>((const attn_body::bf16*)Q, (const attn_body::bf16*)K, (const attn_body::bf16*)V, (attn_body::bf16*)O, NT, shm);
}

__global__ void __launch_bounds__(NTHREADS, 2) hybrid_fwd(Args args) {
    extern __shared__ __attribute__((aligned(16))) unsigned char lds_raw[];
    LAS unsigned char* lds = (LAS unsigned char*)lds_raw;
    const int G = gridDim.x, bx = blockIdx.x;
    const int vcu = (G % 8 == 0) ? (bx % 8) * (G / 8) + bx / 8 : bx;
    const int NGW = G * NWAVES;
    unsigned char* ws = args.ws;
    const float* x = args.in[0]; const float* mem = args.in[1]; const float* mix_g = args.in[2]; const float* ffn_g = args.in[3]; const float* mem_g = args.in[4]; const float* fin_g = args.in[5];
    const float* hy_short = args.in[9]; const float* f_w1 = args.in[10]; const float* f_b1 = args.in[11]; const float* f_w2 = args.in[12]; const float* f_b2 = args.in[13];
    const float* f_w3 = args.in[14]; const float* f_freq = args.in[15]; const float* hy_skip = args.in[16]; const float* qg = args.in[18]; const float* kg = args.in[19]; const float* router = args.in[20];
    float* H = args.out;
    bf16* U = (bf16*)(ws + WS_U); bf16* PROJ = (bf16*)(ws + WS_PROJ); bf16* CQ = (bf16*)(ws + WS_CQ); bf16* MIX = (bf16*)(ws + WS_MIX); bf16* MIXT = (bf16*)(ws + WS_MIXT);
    float* AFF = (float*)(ws + WS_AFF); int* IDX = (int*)(ws + WS_IDX); float* GATE = (float*)(ws + WS_GATE); int* POS = (int*)(ws + WS_POS);
    bf16* XG = (bf16*)(ws + WS_XG); bf16* HID = (bf16*)(ws + WS_HID); bf16* Y = (bf16*)(ws + WS_Y); float* TAPS = (float*)(ws + WS_TAPS);
    const bf16* MKV = (const bf16*)(ws + WS_MKV);
    cg::grid_group grid = cg::this_grid();
    volatile LAS unsigned* bst = (volatile LAS unsigned*)(lds + LDS_MISC + 4096);
    if (threadIdx.x < 2) bst[threadIdx.x] = 0u;
    __syncthreads();
    XcdBarrier xbar = xcd_barrier_post((unsigned*)(ws + WS_CTL) + 1024, bst);
    const int lo = args.ph_lo, hi = args.ph_hi;
    const XwIn XW{args.in[21], args.in[22], args.in[23], ws}; const bool xw_sched = (G == 256);
    int ph = 0;
#ifdef TSEL
    unsigned long long tacc_ = 0ull, t0_ = 0ull, t1_ = 0ull; int pk_ = 0, tpar_ = 0;
#endif
#ifdef TSEL
#ifndef TAMP
#define TAMP 10
#endif
#ifndef TBAR
#define TBAR 0
#endif
#define PH_T0(k) pk_ = (k); t0_ = __builtin_amdgcn_s_memrealtime();
#ifndef TPAR
#define TPAR -1
#endif
#define PH_T1 t1_ = __builtin_amdgcn_s_memrealtime(); if (!TBAR && (pk_ == TSEL || TSEL == 99) && (TPAR < 0 || tpar_ == TPAR)) tacc_ += t1_ - t0_;
#define PH_T2 if (TBAR && (pk_ == TSEL || TSEL == 99)) tacc_ += __builtin_amdgcn_s_memrealtime() - t1_;
#else
#define PH_T0(k)
#define PH_T1
#define PH_T2
#endif
#define PHASE_BEGINK(k) PH_T0(k) if (lo <= ph && ph < hi) { const int tid = opaque_tid(), lane = tid & 63, wave = __builtin_amdgcn_readfirstlane(tid >> 6), gw = vcu * NWAVES + wave; (void)lane; (void)gw;
#ifdef EXTRA_XBAR
#define PHASE_END   if (ph + 1 < hi) { if (ph == lo) grid.sync(); else { xcd_barrier(xbar); if (ph < EXTRA_XBAR) xcd_barrier(xbar); } } } ++ph;
#else
#define PHASE_END   PH_T1 if (ph + 1 < hi) { if (ph == lo) grid.sync(); else xcd_barrier(xbar); } PH_T2 } ++ph;
#endif

    PHASE_BEGINK(0)
        ProIn P{args.in[8], args.in[17], args.in[7], args.in[6]};
        REP(0) { phase_weights(P, ws, lds, gw, NGW, wave, lane); phase_xw_p0(XW, xw_sched, (LAS float*)(lds + wave * 16384), gw, NGW, lane); }
        phase_wrg(ffn_g, router, (float*)(ws + WS_WRG), (int)(bx * NTHREADS + tid), (int)(G * NTHREADS));
        REP(1) phase_mem_h2(mem, mem_g, f_w1, f_b1, f_w2, f_b2, f_freq, ws, gw, NGW, lane);
        REP(3) phase_norm<false, false>(x, nullptr, mix_g, U, nullptr, nullptr, nullptr, gw, NGW, lane);
    PHASE_END

#pragma unroll 1
    for (int i = 0; i < DEPTH; ++i) {
        const bool hy = (i & 1) == 0; const int j = i >> 1;
#ifdef TSEL
        tpar_ = i & 1;
#endif
        if (i > 0) {
        PHASE_BEGINK(1)
            phase_norm<true, false>(H, H, mix_g + i * DM, U, nullptr, POS, Y, gw, NGW, lane);
        PHASE_END
        }
        PHASE_BEGINK(2)
            if (i == 0) {
                pg8::Gemm g{(const bf16*)(ws + WS_MEMN), (const bf16*)(ws + WS_WMKV), BATCH * MEM_LEN, 2048, DM, 1 << 30, 1, 0};
                pg8::StaticOrder S; S.init(BATCH * MEM_LEN, 2048, G, bx);
                pg8::EpiRowBf16 E{(bf16*)(ws + WS_MKV), 2048, -1, 1.f};
                pg8::gemm_phase<pg8::EpiRowBf16, pg8::StaticOrder, true, true>(lds, g, S, E);
            }
            if (hy) {
                REP(4) phase_taps((const float*)(ws + WS_H2) + (size_t)j * SEQ * HY_FILT, f_w3 + (size_t)j * HY_FILT * FCOLS, TAPS, gw, NGW, lane);
                pg8::Gemm g{U, (const bf16*)(ws + WS_WHY) + (size_t)j * D_IN_HY * DM, M_TOK, D_IN_HY, DM, 1 << 30, 1, 0};
                pg8::StaticOrder S; S.init(M_TOK, D_IN_HY, G, bx);
                pg8::EpiHyIn E{PROJ, M_TOK, 9, CQ, ATT_C2};
                REP(5) pg8::gemm_phase<pg8::EpiHyIn, pg8::StaticOrder, true, true>(lds, g, S, E);
            } else {
                pg8::Gemm g{U, (const bf16*)(ws + WS_WAT) + (size_t)j * D_IN_AT * DM, M_TOK, D_IN_AT, DM, 1 << 30, 1, 0};
                pg8::StaticOrder S; S.init(M_TOK, D_IN_AT, G, bx);
                pg8::EpiAtIn E{PROJ, D_IN_AT, qg + j * HD, kg + j * HD, ATT_C2, NORM_EPS, SEQ - 1};
                REP(6) pg8::gemm_phase<pg8::EpiAtIn, pg8::StaticOrder, true, true>(lds, g, S, E);
            }
            if (xw_sched && bx >= 128) xw_slice_a(XW, i, (LAS float*)(lds + wave * 16384), bx, wave, lane);
        PHASE_END
        PHASE_BEGINK(3)
            if (hy) {
                REP(8) phase_hyena_conv(PROJ, TAPS, hy_short + (size_t)j * 3 * 2304, hy_skip + (size_t)j * 2 * D_MAIN, (f32x2*)(ws + WS_FFTX), (f32x2*)(ws + WS_ZS), MIXT, lds, bx, G, tid, lane, wave);
                REP(9) for (int u = vcu; u < 256; u += G) { const int b = u >> 7, h4 = (u >> 5) & 3, qb = u & 31; const size_t row = (size_t)b * SEQ + qb * 256;
                    run_attn<256, 2048>(CQ + row * 256 + h4 * HD, MKV + (size_t)b * MEM_LEN * 2048 + i * 512 + h4 * HD, MKV + (size_t)b * MEM_LEN * 2048 + i * 512 + 256 + h4 * HD,
                                        MIX + row * DM + D_MAIN + h4 * HD, MEM_LEN / 64, (char*)lds_raw); }
            } else {
                REP(10) for (int u = vcu; u < 768; u += G) { const int bk = (u & 255) >> 5, qb = u & 31, hs = u >> 8, b = bk >> 2, kvh = bk & 3, h = kvh * 3 + hs; const size_t row = (size_t)b * SEQ + qb * 256;
                    run_attn<D_IN_AT, D_IN_AT>(PROJ + row * D_IN_AT + h * HD, PROJ + (size_t)b * SEQ * D_IN_AT + D_MAIN + kvh * HD, PROJ + (size_t)b * SEQ * D_IN_AT + D_MAIN + 256 + kvh * HD,
                                               MIX + row * DM + h * HD, SEQ / 64, (char*)lds_raw); }
                REP(9) for (int u = vcu; u < 256; u += G) { const int b = u >> 7, h4 = (u >> 5) & 3, qb = u & 31; const size_t row = (size_t)b * SEQ + qb * 256;
                    run_attn<D_IN_AT, 2048>(PROJ + row * D_IN_AT + 1280 + h4 * HD, MKV + (size_t)b * MEM_LEN * 2048 + i * 512 + h4 * HD, MKV + (size_t)b * MEM_LEN * 2048 + i * 512 + 256 + h4 * HD,
                                            MIX + row * DM + D_MAIN + h4 * HD, MEM_LEN / 64, (char*)lds_raw); }
            }
        PHASE_END
        if (hy) {
            PHASE_BEGINK(4)
                REP(11) phase_transpose_mix(MIXT, MIX, bx, G, tid);
            PHASE_END
        }
        PHASE_BEGINK(5)
            pg8::Gemm g{MIX, (const bf16*)(ws + WS_WOUT) + (size_t)i * DM * DM, M_TOK, DM, DM, 1 << 30, 1, 0};
            pg8::StaticOrder S; S.init(M_TOK, DM, G, bx);
            pg8::EpiOutX E{i == 0 ? x : (const float*)H, H, DM, ffn_g + i * DM, (const float*)(ws + WS_WRG) + (size_t)i * NEXP * DM, (unsigned char*)U, (float*)(ws + WS_PART), (float*)(ws + WS_PSS), M_TOK};
            pg8::gemm_phase<pg8::EpiOutX, pg8::StaticOrder, true, true>(lds, g, S, E);
        PHASE_END
        PHASE_BEGINK(6)
            REP(13) phase_router_sum((const float*)(ws + WS_PART), (const float*)(ws + WS_PSS), (float*)(ws + WS_RSTD), AFF, gw, NGW, lane);
        PHASE_END
        PHASE_BEGINK(7)
            REP(14) phase_topk(AFF, (const float*)(ws + WS_RSTD), (float*)(ws + WS_RS), IDX, GATE, POS, lds + LDS_MISC, bx, G, tid, lane, wave);
            if (xw_sched && bx >= 32) xw_slice_b(XW, i, (LAS float*)(lds + wave * 16384), bx, wave, lane);
        PHASE_END
        PHASE_BEGINK(8)
            pg8::Gemm g{U, (const bf16*)(ws + WS_W1 + (size_t)i * NEXP * 1536 * DM), XROWS, 1536, DM / 2, 4, NEXP, (size_t)1536 * DM};
            pg8::StaticOrder S; S.init(XROWS, 1536, G, bx);
            pg8::EpiSwiGLU8 E{(unsigned char*)HID, EFF, 1.0f / W8_SCALE, (const float*)(ws + WS_RS)};
            REP(16) pg8::gemm_phase<pg8::EpiSwiGLU8, pg8::StaticOrder, true, true, true, true>(lds, g, S, E, IDX);
        PHASE_END
        PHASE_BEGINK(9)
            pg8::Gemm g{HID, (const bf16*)(ws + WS_W2 + (size_t)i * NEXP * DM * EFF), XROWS, DM, EFF / 2, 4, NEXP, (size_t)DM * EFF};
            pg8::StaticOrder S; S.init(XROWS, DM, G, bx);
            pg8::EpiDown E{Y, DM, GATE, 1.0f / W8_SCALE};
            REP(17) pg8::gemm_phase<pg8::EpiDown, pg8::StaticOrder, true, true, false, true>(lds, g, S, E);
        PHASE_END
    }
    PHASE_BEGINK(10)
        phase_norm<true, true>(H, nullptr, fin_g, nullptr, args.out, POS, Y, gw, NGW, lane);
    PHASE_END
#ifdef TSEL
#ifdef CSEL
    if (bx == 0 && threadIdx.x == 0) tacc_ += *(unsigned long long*)(ws + 32768);
#endif
    if (bx == 0 && threadIdx.x == 0 && hi - lo > 1) { const unsigned long long te_ = __builtin_amdgcn_s_memrealtime(); while (__builtin_amdgcn_s_memrealtime() - te_ < (unsigned long long)TAMP * tacc_) __builtin_amdgcn_s_sleep(8); }
#endif
#undef PHASE_BEGINK
#undef PHASE_END
}

extern "C" void kernel_launch(void* const* d_in, const int* in_sizes, int n_in, void* d_out, int out_size, void* d_ws, size_t ws_size, hipStream_t stream) {
    static int grid = 0;
    if (grid == 0) {
        if (n_in != 24 || out_size != M_TOK * DM || ws_size < WS_END) { fprintf(stderr, "kernel_launch: unexpected shapes (n_in %d out %d ws %zu need %zu)\n", n_in, out_size, ws_size, (size_t)WS_END); grid = -1; return; }
        int dev = 0, cus = 0, per_cu = 0;
        if (hipGetDevice(&dev) != hipSuccess || hipDeviceGetAttribute(&cus, hipDeviceAttributeMultiprocessorCount, dev) != hipSuccess) { grid = -1; return; }
        if (hipFuncSetAttribute((const void*)hybrid_fwd, hipFuncAttributeMaxDynamicSharedMemorySize, LDS_BYTES) != hipSuccess) { fprintf(stderr, "kernel_launch: hipFuncSetAttribute failed\n"); grid = -1; return; }
        if (hipOccupancyMaxActiveBlocksPerMultiprocessor(&per_cu, (const void*)hybrid_fwd, NTHREADS, LDS_BYTES) != hipSuccess || per_cu < 1) { fprintf(stderr, "kernel_launch: occupancy query says %d blocks/CU\n", per_cu); per_cu = 1; }
        (void)hipGetLastError();
        grid = cus;
    }
    if (grid < 0) return;
    if (hipMemsetAsync((char*)d_ws + WS_CTL, 0, 64 * 1024, stream) != hipSuccess) { fprintf(stderr, "kernel_launch: memset failed\n"); return; }
    Args a{};
    for (int i = 0; i < 24; ++i) a.in[i] = (const float*)d_in[i];
    a.out = (float*)d_out; a.ws = (unsigned char*)d_ws;
#if MK_PER_PHASE
    for (int li = 0; li < N_PHASES; ++li) {
        a.ph_lo = li; a.ph_hi = li + 1;
        void* kargs[] = {&a};
        hipError_t e = hipLaunchCooperativeKernel((const void*)hybrid_fwd, dim3(grid), dim3(NTHREADS), kargs, LDS_BYTES, stream);
        if (e != hipSuccess) { fprintf(stderr, "kernel_launch: launch %d failed: %s\n", li, hipGetErrorString(e)); break; }
    }
#else
    a.ph_lo = 0; a.ph_hi = N_PHASES;
    void* kargs[] = {&a};
    hipError_t e = hipLaunchCooperativeKernel((const void*)hybrid_fwd, dim3(grid), dim3(NTHREADS), kargs, LDS_BYTES, stream);
    if (e != hipSuccess) fprintf(stderr, "kernel_launch: cooperative launch failed: %s (grid %d)\n", hipGetErrorString(e), grid);
#endif
}
```

```cpp
#include <hip/hip_runtime.h>
#include <hip/hip_cooperative_groups.h>
#include <hip/hip_bf16.h>
#include <cmath>
#include <cstdio>
#include <cstdint>
namespace cg = cooperative_groups;

constexpr int BATCH = 2, SEQ = 8192, DM = 1024, DEPTH = 4, M_TOK = BATCH * SEQ;
constexpr int HD = 64, MEM_LEN = 256, D_MEM = 256, D_MAIN = 768, NQH = 12, NKVH = 4;
constexpr int D_IN_HY = 2560, D_IN_AT = 1536;
constexpr int NEXP = 16, CAP = 1024, EFF = 768, NGRP = BATCH * NEXP, XROWS = NGRP * CAP;
constexpr int HY_EMB = 33, HY_FILT = 64, FCOLS = 4 * D_MAIN;
constexpr float NORM_EPS = 1e-6f;
constexpr float W8_SCALE = 32.0f;
constexpr float ATT_C2 = 0.125f * 1.4426950408889634f;

constexpr size_t MiB = 1u << 20;
constexpr size_t WS_CTL = 0;
constexpr size_t WS_WHY = 2 * MiB;
constexpr size_t WS_WAT = 12 * MiB;
constexpr size_t WS_WOUT = 18 * MiB;
constexpr size_t WS_WMKV = 26 * MiB;
constexpr size_t WS_W1 = 32 * MiB;
constexpr size_t WS_W2 = 224 * MiB;
constexpr size_t WS_U = 320 * MiB;
constexpr size_t WS_PROJ = 352 * MiB;
constexpr size_t WS_CQ = WS_PROJ + 72 * MiB;
constexpr size_t WS_MIX = 432 * MiB;
constexpr size_t WS_MIXT = 464 * MiB;
constexpr size_t WS_AFF = 488 * MiB;
constexpr size_t WS_IDX = 489 * MiB;
constexpr size_t WS_GATE = WS_IDX + 128 * 1024;
constexpr size_t WS_POS = 490 * MiB;
constexpr size_t WS_XG = 492 * MiB;
constexpr size_t WS_HID = 556 * MiB;
constexpr size_t WS_TAPS = WS_XG;
constexpr size_t WS_Y = 604 * MiB;
constexpr size_t WS_FFTX = WS_Y;
constexpr size_t WS_H2 = 668 * MiB;
constexpr size_t WS_MEMN = 672 * MiB;
constexpr size_t WS_MKV = 673 * MiB;
constexpr size_t WS_PART = 676 * MiB;
constexpr size_t WS_PSS = 692 * MiB;
constexpr size_t WS_RSTD = 697 * MiB;
constexpr size_t WS_RS = WS_RSTD + 128 * 1024;
constexpr size_t WS_WRG = 698 * MiB;
constexpr size_t WS_ZS = 700 * MiB;
constexpr size_t WS_END = 732 * MiB;

constexpr int LDS_RING = 0;
constexpr int LDS_MISC = 132 * 1024;
constexpr int LDS_BYTES = 140 * 1024;
constexpr int NTHREADS = 512, NWAVES = 8;

#define GAS __attribute__((address_space(1)))
#define LAS __attribute__((address_space(3)))
typedef unsigned short bf16;
typedef unsigned v4u __attribute__((ext_vector_type(4)));
typedef unsigned v2u __attribute__((ext_vector_type(2)));
typedef float f32x4 __attribute__((ext_vector_type(4)));
typedef float f32x2 __attribute__((ext_vector_type(2)));
__device__ __forceinline__ unsigned f2bf(float f) { unsigned u = __builtin_bit_cast(unsigned, f); return (u + 0x7fffu + ((u >> 16) & 1u)) >> 16; }
__device__ __forceinline__ unsigned pk2(float lo, float hi) { return f2bf(lo) | (f2bf(hi) << 16); }
__device__ __forceinline__ float bf2f(unsigned short h) { return __builtin_bit_cast(float, (unsigned)h << 16); }
__device__ __forceinline__ float bflo(unsigned w) { return __builtin_bit_cast(float, w << 16); }
__device__ __forceinline__ float bfhi(unsigned w) { return __builtin_bit_cast(float, w & 0xffff0000u); }
__device__ __forceinline__ float wave_sum(float v) {
#pragma unroll
    for (int o = 1; o < 64; o <<= 1) v += __shfl_xor(v, o);
    return v;
}
__device__ __forceinline__ int opaque_tid() { int t = threadIdx.x; asm volatile("" : "+v"(t)); return t; }
#define MK_PER_PHASE 0

#define XB_TMO      128
#define XB_XCNT(j)  (256  + 64 * (j))
#define XB_XSUB(j)  (1280 + 64 * (j))
#define XB_XGEN(j)  (2304 + 64 * (j))
#define XB_TOP      3328
#define XB_TOPGEN   3392
#define XCD_BAR_WORDS 3456
#define XB_SPIN_CAP (1u << 18)

__device__ __forceinline__ unsigned xb_ld(unsigned* p)              { return __hip_atomic_load(p, __ATOMIC_RELAXED, __HIP_MEMORY_SCOPE_AGENT); }
__device__ __forceinline__ unsigned xb_add(unsigned* p, unsigned v) { return __hip_atomic_fetch_add(p, v, __ATOMIC_RELAXED, __HIP_MEMORY_SCOPE_AGENT); }
__device__ __forceinline__ unsigned xb_xcc_id() { return (unsigned)__builtin_amdgcn_s_getreg((3 << 11) | 20) & 0xFu; }
#define XB_SPIN(cond, bar) do { unsigned _sp = 0; while (cond) { __builtin_amdgcn_s_sleep(1); \
    if ((++_sp & 255u) == 0u) { if (xb_ld(&(bar)[XB_TMO])) break; if (_sp > XB_SPIN_CAP) { atomicAdd(&(bar)[XB_TMO], 1u); break; } } } } while (0)

struct XcdBarrier {
    unsigned* bar; unsigned x;
    volatile LAS unsigned* st;
};

__device__ __forceinline__ XcdBarrier xcd_barrier_post(unsigned* bar, volatile LAS unsigned* st) {
    XcdBarrier b; b.bar = bar; b.x = xb_xcc_id(); b.st = st;
    if (threadIdx.x == 0) (void)xb_add(&bar[XB_XCNT(b.x)], 1u);
    return b;
}
__device__ __forceinline__ void xcd_barrier_complete(unsigned* bar, unsigned x, unsigned& nloc, unsigned& nx) {
    const unsigned G = gridDim.x * gridDim.y * gridDim.z;
    unsigned sum, cnt, mine, sp = 0u;
    for (;;) {
        sum = 0u; cnt = 0u; mine = 0u;
#pragma unroll
        for (unsigned j = 0; j < 16; ++j) { const unsigned c = xb_ld(&bar[XB_XCNT(j)]); sum += c; cnt += (c > 0u) ? 1u : 0u; mine = (j == x) ? c : mine; }
        if (sum == G) break;
        __builtin_amdgcn_s_sleep(1);
        if ((++sp & 255u) == 0u) { if (xb_ld(&bar[XB_TMO])) break; if (sp > XB_SPIN_CAP) { atomicAdd(&bar[XB_TMO], 1u); break; } }
    }
    nloc = mine > 0u ? mine : 1u; nx = cnt > 0u ? cnt : 1u;
}

__device__ __forceinline__ void xcd_barrier(const XcdBarrier& b) {
    asm volatile("s_waitcnt vmcnt(0)" ::: "memory");
    __syncthreads();
    if (threadIdx.x == 0) {
        unsigned* bar = b.bar;
        __builtin_amdgcn_s_waitcnt(0);
        unsigned nloc = b.st[0], nx = b.st[1];
        if (nloc == 0u) { xcd_barrier_complete(bar, b.x, nloc, nx); b.st[0] = nloc; b.st[1] = nx; }
        const unsigned old = xb_add(&bar[XB_XSUB(b.x)], 1u);
        const unsigned gen = old / nloc;
        if (old + 1u == (gen + 1u) * nloc) {
            __builtin_amdgcn_fence(__ATOMIC_RELEASE, "agent");
            asm volatile("s_waitcnt vmcnt(0)" ::: "memory");
            const unsigned og = xb_add(&bar[XB_TOP], 1u);
            const unsigned tg = og / nx;
            if (og + 1u == (tg + 1u) * nx) xb_add(&bar[XB_TOPGEN], 1u);
            else XB_SPIN(xb_ld(&bar[XB_TOPGEN]) == tg, bar);
            __builtin_amdgcn_fence(__ATOMIC_ACQUIRE, "agent");
            xb_add(&bar[XB_XGEN(b.x)], 1u);
            asm volatile("s_waitcnt vmcnt(0)" ::: "memory");
        } else {
            XB_SPIN(xb_ld(&bar[XB_XGEN(b.x)]) == gen, bar);
            __builtin_amdgcn_fence(__ATOMIC_ACQUIRE, "agent");
            asm volatile("s_waitcnt vmcnt(0)" ::: "memory");
        }
    }
    __syncthreads();
}
namespace pg8 {
#define PG8_LAS __attribute__((address_space(3)))
typedef unsigned short bf16_t;
typedef short bf16x8 __attribute__((ext_vector_type(8)));
typedef float f32x4 __attribute__((ext_vector_type(4)));
typedef unsigned u32x4 __attribute__((ext_vector_type(4)));
constexpr int BM = 256, BK = 64, HALF = 128, HTB = HALF * BK * 2  , STAGE_BYTES = 8 * HTB, NXCD = 8, WGM = 8;

__host__ __device__ __forceinline__ int lds_byte(int r, int c) { const int st = (r >> 4) * 2 + (c >> 5), rr = r & 15, cc = c & 31, ob = rr * 64 + cc * 2; return st * 1024 + (ob ^ (((ob >> 9) & 1) << 5)); }
__host__ __device__ __forceinline__ void stage_rc(int b, int& R, int& C) { const int st = b / 1024, sb = b % 1024, swz = sb ^ (((sb >> 9) & 1) << 5); R = (st >> 1) * 16 + swz / 64; C = (st & 1) * 32 + (swz % 64) / 2; }
__host__ __device__ __forceinline__ int perm32(int rho) { const int n = rho >> 4, i = rho & 15; return 8 * (i >> 2) + 4 * n + (i & 3); }

struct Unit { int pm, pn; };
struct Gemm { const bf16_t* A; const bf16_t* Bt; int M, N, K; int gdiv, gmod; size_t gstride; };

struct StaticOrder {
    int nM, nN, nwg, G, c;
    __host__ __device__ void init(int M, int N, int G_, int c_) { nM = M / BM; nN = N / BM; nwg = nM * nN; G = G_; c = c_; }
    __host__ __device__ bool next(int i, Unit& u) const {
        const long L = (long)i * G + c; if (L >= nwg) return false;
        int wgid = (int)L; { const int q = nwg / NXCD, r = nwg % NXCD, xcd = wgid % NXCD, off = wgid / NXCD; wgid = (xcd < r ? xcd * (q + 1) : r * (q + 1) + (xcd - r) * q) + off; }
        const int nig = WGM * nN, gid = wgid / nig, fm = gid * WGM, gsz = (nM - fm) < WGM ? (nM - fm) : WGM;
        u.pm = fm + ((wgid % nig) % gsz); u.pn = (wgid % nig) / gsz; return true;
    }
    __device__ __forceinline__ void a_ready(const Unit&) const {}
    __device__ __forceinline__ void done(const Unit&) const {}
};


__device__ __forceinline__ unsigned cvt_pk_bf16(float lo, float hi) { unsigned r; asm volatile("v_cvt_pk_bf16_f32 %0, %1, %2" : "=v"(r) : "v"(lo), "v"(hi)); return r; }
typedef unsigned u32x2 __attribute__((ext_vector_type(2)));
struct EpiRowBf16 {
    static constexpr bool PERM = false, AFTER_DRAIN = false;
    bf16_t* O; int ldc; int sc_pn; float sc;
    __device__ __forceinline__ void operator()(const f32x4 (&acc)[2][2][4][2], const Unit& u, int wr, int wc, int fr, int fq) const {
        const float s = (u.pn == sc_pn) ? sc : 1.f;
        const int row0 = u.pm * BM + wr * 64 + fr, col0 = u.pn * BM + wc * 32 + 4 * fq;
#pragma unroll
        for (int ai = 0; ai < 2; ++ai)
#pragma unroll
            for (int m = 0; m < 4; ++m) { bf16_t* rowp = O + (size_t)(row0 + ai * HALF + m * 16) * ldc + col0;
#pragma unroll
                for (int bj = 0; bj < 2; ++bj)
#pragma unroll
                    for (int n = 0; n < 2; ++n) { const f32x4 v = acc[ai][bj][m][n] * s; u32x2 w; w.x = cvt_pk_bf16(v[0], v[1]); w.y = cvt_pk_bf16(v[2], v[3]);
                        *(u32x2*)(rowp + bj * HALF + n * 16) = w; } }
    }
};
struct EpiHyIn {
    static constexpr bool PERM = false, AFTER_DRAIN = false;
    bf16_t* OT; int ldt; int tp_tiles; bf16_t* CQ; float sc;
    __device__ __forceinline__ void operator()(const f32x4 (&acc)[2][2][4][2], const Unit& u, int wr, int wc, int fr, int fq) const {
        const int row0 = u.pm * BM + wr * 64 + fr;
        if (u.pn < tp_tiles) {
            const int col0 = u.pn * BM + wc * 32 + 4 * fq;
#pragma unroll
            for (int ai = 0; ai < 2; ++ai)
#pragma unroll
                for (int m = 0; m < 4; ++m) { const int row = row0 + ai * HALF + m * 16;
#pragma unroll
                    for (int bj = 0; bj < 2; ++bj)
#pragma unroll
                        for (int n = 0; n < 2; ++n) { const f32x4 v = acc[ai][bj][m][n]; const unsigned w0 = cvt_pk_bf16(v[0], v[1]), w1 = cvt_pk_bf16(v[2], v[3]);
                            bf16_t* p = OT + (size_t)(col0 + bj * HALF + n * 16) * ldt + row;
                            p[0] = (bf16_t)(w0 & 0xffffu); p[(size_t)ldt] = (bf16_t)(w0 >> 16); p[(size_t)2 * ldt] = (bf16_t)(w1 & 0xffffu); p[(size_t)3 * ldt] = (bf16_t)(w1 >> 16); } }
        } else {
            const int col0 = wc * 32 + 4 * fq;
#pragma unroll
            for (int ai = 0; ai < 2; ++ai)
#pragma unroll
                for (int m = 0; m < 4; ++m) { bf16_t* rowp = CQ + (size_t)(row0 + ai * HALF + m * 16) * 256 + col0;
#pragma unroll
                    for (int bj = 0; bj < 2; ++bj)
#pragma unroll
                        for (int n = 0; n < 2; ++n) { const f32x4 v = acc[ai][bj][m][n] * sc; u32x2 w; w.x = cvt_pk_bf16(v[0], v[1]); w.y = cvt_pk_bf16(v[2], v[3]);
                            *(u32x2*)(rowp + bj * HALF + n * 16) = w; } }
        }
    }
};
struct EpiAtIn {
    static constexpr bool PERM = false, AFTER_DRAIN = false;
    bf16_t* O; int ldc; const float* gq; const float* gk; float csc; float eps; int seq_mask;
    __device__ __forceinline__ void operator()(const f32x4 (&acc)[2][2][4][2], const Unit& u, int wr, int wc, int fr, int fq) const {
        const int row0 = u.pm * BM + wr * 64 + fr, colb = u.pn * BM + wc * 64 + 4 * fq;
        if (u.pn <= 3) {
            const float* gp = (u.pn == 3 ? gk : gq) + 4 * fq; const float osc = (u.pn == 3) ? 1.f : csc;
            float invr[4];
#pragma unroll
            for (int q = 0; q < 4; ++q) invr[q] = exp2f(-(float)(4 * fq + q) * (13.287712379549449f / 16.0f)) * 0.15915494309189535f;
#pragma unroll
            for (int ai = 0; ai < 2; ++ai)
#pragma unroll
                for (int m = 0; m < 4; ++m) {
                    const int row = row0 + ai * HALF + m * 16; int t = row & seq_mask; asm volatile("" : "+v"(t));
                    float ss = 0.f;
#pragma unroll
                    for (int bj = 0; bj < 2; ++bj)
#pragma unroll
                        for (int n = 0; n < 2; ++n) { const f32x4 x = acc[ai][bj][m][n]; ss += (x[0] * x[0] + x[1] * x[1]) + (x[2] * x[2] + x[3] * x[3]); }
                    ss += __shfl_xor(ss, 16); ss += __shfl_xor(ss, 32);
                    const float rs = osc * __builtin_amdgcn_rsqf(ss * (1.0f / 64.0f) + eps);
                    bf16_t* rowp = O + (size_t)row * ldc + colb;
#pragma unroll
                    for (int bj = 0; bj < 2; ++bj) {
                        const float pos = (float)(bj == 0 ? (t >> 6) : (t & 63));
                        const f32x4 xa = acc[ai][bj][m][0] * rs * *(const f32x4*)(gp + 32 * bj), xb = acc[ai][bj][m][1] * rs * *(const f32x4*)(gp + 32 * bj + 16);
                        f32x4 oa, ob;
#pragma unroll
                        for (int q = 0; q < 4; ++q) { const float rev = pos * invr[q]; const float c = __builtin_amdgcn_cosf(rev), s = __builtin_amdgcn_sinf(rev);
                            oa[q] = xa[q] * c - xb[q] * s; ob[q] = xa[q] * s + xb[q] * c; }
                        u32x2 w; w.x = cvt_pk_bf16(oa[0], oa[1]); w.y = cvt_pk_bf16(oa[2], oa[3]); *(u32x2*)(rowp + 32 * bj) = w;
                        w.x = cvt_pk_bf16(ob[0], ob[1]); w.y = cvt_pk_bf16(ob[2], ob[3]); *(u32x2*)(rowp + 32 * bj + 16) = w;
                    }
                    asm volatile("" ::: "memory");
                }
        } else {
            const float s = (u.pn == 5) ? csc : 1.f;
#pragma unroll
            for (int ai = 0; ai < 2; ++ai)
#pragma unroll
                for (int m = 0; m < 4; ++m) { bf16_t* rowp = O + (size_t)(row0 + ai * HALF + m * 16) * ldc + colb;
#pragma unroll
                    for (int bj = 0; bj < 2; ++bj)
#pragma unroll
                        for (int n = 0; n < 2; ++n) { const f32x4 v = acc[ai][bj][m][n] * s; u32x2 w; w.x = cvt_pk_bf16(v[0], v[1]); w.y = cvt_pk_bf16(v[2], v[3]);
                            *(u32x2*)(rowp + 32 * bj + 16 * n) = w; } }
        }
    }
};
struct EpiResF32 {
    static constexpr bool PERM = false, AFTER_DRAIN = false;
    const float* res; float* out; int ldc;
    __device__ __forceinline__ void operator()(const f32x4 (&acc)[2][2][4][2], const Unit& u, int wr, int wc, int fr, int fq) const {
        const int row0 = u.pm * BM + wr * 64 + fr, col0 = u.pn * BM + wc * 32 + 4 * fq;
#pragma unroll
        for (int ai = 0; ai < 2; ++ai)
#pragma unroll
            for (int m = 0; m < 4; ++m) { const size_t off = (size_t)(row0 + ai * HALF + m * 16) * ldc + col0;
#pragma unroll
                for (int bj = 0; bj < 2; ++bj)
#pragma unroll
                    for (int n = 0; n < 2; ++n) { const f32x4 r = *(const f32x4*)(res + off + bj * HALF + n * 16); *(f32x4*)(out + off + bj * HALF + n * 16) = r + acc[ai][bj][m][n]; } }
    }
};
__device__ __forceinline__ unsigned pk4_fp8_sat(const f32x4 x) {
    unsigned w = 0;
    w = __builtin_amdgcn_cvt_pk_fp8_f32(__builtin_amdgcn_fmed3f(x[0], -448.f, 448.f), __builtin_amdgcn_fmed3f(x[1], -448.f, 448.f), w, false);
    w = __builtin_amdgcn_cvt_pk_fp8_f32(__builtin_amdgcn_fmed3f(x[2], -448.f, 448.f), __builtin_amdgcn_fmed3f(x[3], -448.f, 448.f), w, true);
    return w;
}
struct EpiOutX {
    static constexpr bool PERM = true, AFTER_DRAIN = false;
    const float* res; float* out; int ldc; const float* gain; const float* WrG; unsigned char* XN8; float* PLG; float* PSS; int M;
    static __device__ __forceinline__ void split8(const f32x4 a, const f32x4 b, bf16x8& hi, bf16x8& lo) {
        u32x4 h, l; float r[8] = {a[0], a[1], a[2], a[3], b[0], b[1], b[2], b[3]};
#pragma unroll
        for (int k = 0; k < 4; ++k) { const unsigned p = cvt_pk_bf16(r[2 * k], r[2 * k + 1]); h[k] = p;
            const float d0 = r[2 * k] - __builtin_bit_cast(float, p << 16), d1 = r[2 * k + 1] - __builtin_bit_cast(float, p & 0xffff0000u); l[k] = cvt_pk_bf16(d0, d1); }
        hi = __builtin_bit_cast(bf16x8, h); lo = __builtin_bit_cast(bf16x8, l);
    }
    __device__ __forceinline__ void operator()(f32x4 (&acc)[2][2][4][2], const Unit& u, int wr, int wc, int fr, int fq) const {
        const int row0 = u.pm * BM + wr * 64 + fr, col0 = u.pn * BM + wc * 32 + 8 * fq, slot = u.pn * 4 + wc;
        bf16x8 whi[2], wlo[2];
#pragma unroll
        for (int bj = 0; bj < 2; ++bj) { const float* wp = WrG + (size_t)fr * ldc + col0 + bj * HALF; split8(*(const f32x4*)wp, *(const f32x4*)(wp + 4), whi[bj], wlo[bj]); }
#pragma unroll
        for (int idx = 0; idx < 8; ++idx) { const int ai = idx >> 2, m = idx & 3;
            const int row = row0 + ai * HALF + m * 16; const size_t off = (size_t)row * ldc + col0; float ss = 0.f; f32x4 lg = (f32x4){0.f, 0.f, 0.f, 0.f}; u32x4 xw;
#pragma unroll
            for (int bj = 0; bj < 2; ++bj) {
#pragma unroll
                for (int n = 0; n < 2; ++n) { const int co = bj * HALF + n * 4;
                    const f32x4 h = *(const f32x4*)(res + off + co) + acc[ai][bj][m][n]; acc[ai][bj][m][n] = h; *(f32x4*)(out + off + co) = h;
                    ss += (h[0] * h[0] + h[1] * h[1]) + (h[2] * h[2] + h[3] * h[3]);
                    const f32x4 x = h * *(const f32x4*)(gain + col0 + co);
                    xw[bj * 2 + n] = pk4_fp8_sat(x); }
                bf16x8 hhi, hlo; split8(acc[ai][bj][m][0], acc[ai][bj][m][1], hhi, hlo);
                lg = __builtin_amdgcn_mfma_f32_16x16x32_bf16(wlo[bj], hhi, lg, 0, 0, 0);
                lg = __builtin_amdgcn_mfma_f32_16x16x32_bf16(whi[bj], hlo, lg, 0, 0, 0);
                lg = __builtin_amdgcn_mfma_f32_16x16x32_bf16(whi[bj], hhi, lg, 0, 0, 0); }
            *(u32x4*)(XN8 + (size_t)row * ldc + u.pn * BM + wc * 64 + fq * 16) = xw;
            ss += __shfl_xor(ss, 16); ss += __shfl_xor(ss, 32);
            if (fq == 0) PSS[(size_t)slot * M + row] = ss;
            *(f32x4*)(PLG + ((size_t)slot * M + row) * 16 + 4 * fq) = lg;
            asm volatile("" ::: "memory"); }
    }
};
struct EpiSwiGLU {
    static constexpr bool PERM = false, AFTER_DRAIN = false;
    bf16_t* O; int ldc;
    __device__ __forceinline__ void operator()(const f32x4 (&acc)[2][2][4][2], const Unit& u, int wr, int wc, int fr, int fq) const {
        const int row0 = u.pm * BM + wr * 64 + fr, col0 = u.pn * HALF + wc * 32 + 4 * fq;
#pragma unroll
        for (int ai = 0; ai < 2; ++ai)
#pragma unroll
            for (int m = 0; m < 4; ++m) { bf16_t* rowp = O + (size_t)(row0 + ai * HALF + m * 16) * ldc + col0;
#pragma unroll
                for (int n = 0; n < 2; ++n) { const f32x4 g = acc[ai][0][m][n], up = acc[ai][1][m][n]; f32x4 h;
#pragma unroll
                    for (int q = 0; q < 4; ++q) h[q] = g[q] * up[q] * __builtin_amdgcn_rcpf(1.f + __expf(-g[q]));
                    u32x2 w; w.x = cvt_pk_bf16(h[0], h[1]); w.y = cvt_pk_bf16(h[2], h[3]); *(u32x2*)(rowp + n * 16) = w; } }
    }
};
struct EpiSwiGLU8 {
    static constexpr bool PERM = false, AFTER_DRAIN = false;
    unsigned char* O; int ldc; float wsc; const float* rs;
    __device__ __forceinline__ void operator()(const f32x4 (&acc)[2][2][4][2], const Unit& u, int wr, int wc, int fr, int fq) const {
        const int row0 = u.pm * BM + wr * 64 + fr, col0 = u.pn * HALF + wc * 32 + 4 * fq;
#pragma unroll
        for (int ai = 0; ai < 2; ++ai)
#pragma unroll
            for (int m = 0; m < 4; ++m) { const int row = row0 + ai * HALF + m * 16; const float sc = wsc * rs[row]; u32x2 hw;
#pragma unroll
                for (int n = 0; n < 2; ++n) { const f32x4 g = acc[ai][0][m][n] * sc, up = acc[ai][1][m][n] * sc; f32x4 h;
#pragma unroll
                    for (int q = 0; q < 4; ++q) h[q] = g[q] * up[q] * __builtin_amdgcn_rcpf(1.f + __expf(-g[q]));
                    hw[n] = pk4_fp8_sat(h); }
                *(u32x2*)(O + (size_t)row * ldc + u.pn * HALF + wc * 32 + fq * 8) = hw; }
    }
};
struct EpiDown {
    static constexpr bool PERM = true, AFTER_DRAIN = false;
    bf16_t* O; int ldc; const float* gate; float wsc;
    __device__ __forceinline__ void operator()(const f32x4 (&acc)[2][2][4][2], const Unit& u, int wr, int wc, int fr, int fq) const {
        const int row0 = u.pm * BM + wr * 64 + fr, col0 = u.pn * BM + wc * 32 + 8 * fq;
#pragma unroll
        for (int ai = 0; ai < 2; ++ai)
#pragma unroll
            for (int m = 0; m < 4; ++m) { const int row = row0 + ai * HALF + m * 16; const float gs = gate[row] * wsc; bf16_t* rowp = O + (size_t)row * ldc + col0;
#pragma unroll
                for (int bj = 0; bj < 2; ++bj) { const f32x4 v0 = acc[ai][bj][m][0] * gs, v1 = acc[ai][bj][m][1] * gs; u32x4 w;
                    w.x = cvt_pk_bf16(v0[0], v0[1]); w.y = cvt_pk_bf16(v0[2], v0[3]); w.z = cvt_pk_bf16(v1[0], v1[1]); w.w = cvt_pk_bf16(v1[2], v1[3]);
                    *(u32x4*)(rowp + bj * HALF) = w; } }
    }
};
template <class Epi, class Sched, bool ALIGN_EPI = false, bool SP2 = false, bool GATHER = false, bool FP8 = false>
__device__ __forceinline__ void gemm_phase(PG8_LAS unsigned char* lds, const Gemm g, const Sched& S, const Epi& E, const int* gidx = nullptr) {
    const int tid = opaque_tid(), wid = __builtin_amdgcn_readfirstlane(tid >> 6), lane = tid & 63, wr = wid >> 2, wc = wid & 3, fr = lane & 15, fq = lane >> 4;
    const int K = g.K, nt = K / BK;
    unsigned voffA[2], voffB[2];
#pragma unroll
    for (int i = 0; i < 2; ++i) { int R, C; stage_rc(tid * 16 + i * 8192, R, C); const int Rb = Epi::PERM ? ((R & ~31) + perm32(R & 31)) : R;
        voffA[i] = (unsigned)(R * K + C) * 2u; voffB[i] = (unsigned)(Rb * K + C) * 2u; }
    const size_t kstep = (size_t)(BK * 2);
    const size_t hstep = (size_t)HALF * K * 2;
    const size_t tstep = 2 * hstep;
    const unsigned ldsw = (unsigned)wid * 1024u;
    const int aoff = lds_byte(wr * 64 + fr, fq * 8), boff = lds_byte(wc * 32 + fr, fq * 8);
#define PG8_SA(b, h) (((b) * 2 + (h)) * HTB)
#define PG8_SB(b, h) ((4 + (b) * 2 + (h)) * HTB)
#define PG8_STAGE(bufoff, gbase, voff) do { _Pragma("unroll") for (int _i = 0; _i < 2; ++_i) \
        __builtin_amdgcn_global_load_lds((const unsigned*)((const char*)(gbase) + (voff)[_i]), (PG8_LAS unsigned*)(lds + (bufoff) + ldsw + _i * 8192), 16, 0, 0); } while (0)
#define PG8_LDA(dst, b, h) do { _Pragma("unroll") for (int m = 0; m < 4; ++m) { if constexpr (FP8) { const v4i_ lo_ = *(const PG8_LAS v4i_*)(lds + PG8_SA(b, h) + aoff + m * 2048), hi_ = *(const PG8_LAS v4i_*)(lds + PG8_SA(b, h) + aoff + m * 2048 + 1024); \
        dst##8[m] = __builtin_shufflevector(lo_, hi_, 0, 1, 2, 3, 4, 5, 6, 7); } else { _Pragma("unroll") for (int k = 0; k < 2; ++k) dst[m][k] = *(const PG8_LAS bf16x8*)(lds + PG8_SA(b, h) + aoff + m * 2048 + k * 1024); } } } while (0)
#define PG8_LDB(dst, b, h) do { _Pragma("unroll") for (int n = 0; n < 2; ++n) { if constexpr (FP8) { const v4i_ lo_ = *(const PG8_LAS v4i_*)(lds + PG8_SB(b, h) + boff + n * 2048), hi_ = *(const PG8_LAS v4i_*)(lds + PG8_SB(b, h) + boff + n * 2048 + 1024); \
        dst##8[n] = __builtin_shufflevector(lo_, hi_, 0, 1, 2, 3, 4, 5, 6, 7); } else { _Pragma("unroll") for (int k = 0; k < 2; ++k) dst[n][k] = *(const PG8_LAS bf16x8*)(lds + PG8_SB(b, h) + boff + n * 2048 + k * 1024); } } } while (0)
#define PG8_MMA(ai, bj, At, Bt) do { __builtin_amdgcn_s_setprio(1); _Pragma("unroll") for (int m = 0; m < 4; ++m) _Pragma("unroll") for (int n = 0; n < 2; ++n) { \
        if constexpr (FP8) asm volatile("v_mfma_scale_f32_16x16x128_f8f6f4 %0, %1, %2, %0, %3, %3 op_sel_hi:[0,0,0]" : "+v"(acc[ai][bj][m][n]) : "v"(Bt##8[n]), "v"(At##8[m]), "v"(sc127_));   \
        else { _Pragma("unroll") for (int k = 0; k < 2; ++k) acc[ai][bj][m][n] = __builtin_amdgcn_mfma_f32_16x16x32_bf16(Bt[n][k], At[m][k], acc[ai][bj][m][n], 0, 0, 0); } } \
        __builtin_amdgcn_s_setprio(0); } while (0)
#define PG8_WAIT_V(n) asm volatile("s_waitcnt vmcnt(" #n ")" ::: "memory")
#define PG8_WAIT_L(n) asm volatile("s_waitcnt lgkmcnt(" #n ")" ::: "memory")
#define PG8_BAR __builtin_amdgcn_s_barrier()
#define PG8_SCHED __builtin_amdgcn_sched_barrier(0)
    Unit cur, nxt; int ui = 0;
    if (!S.next(0, cur)) return;
    f32x4 acc[2][2][4][2];
#pragma unroll
    for (int a = 0; a < 2; ++a)
#pragma unroll
        for (int b = 0; b < 2; ++b)
#pragma unroll
            for (int m = 0; m < 4; ++m)
#pragma unroll
                for (int n = 0; n < 2; ++n) acc[a][b][m][n] = (f32x4){0.f, 0.f, 0.f, 0.f};
    typedef int v8i_ __attribute__((ext_vector_type(8))); typedef int v4i_ __attribute__((ext_vector_type(4)));
    const int sc127_ = 127;
    bf16x8 At[4][2], B0[2][2], B1[2][2]; v8i_ At8[4], B08[2], B18[2];
    static_assert(SP2, "this copy of the body keeps only the SP2 K-loop up to date");
    int rA[2]; { int R_, C_; stage_rc(tid * 16, R_, C_); rA[0] = R_; stage_rc(tid * 16 + 8192, R_, C_); rA[1] = R_; }
    unsigned cvp[2], nvp[2], c2_[2]; c2_[0] = voffA[0] - (unsigned)(rA[0] * K) * 2u; c2_[1] = voffA[1] - (unsigned)(rA[1] * K) * 2u;
    unsigned vh1[2]; vh1[0] = voffA[0] + (unsigned)hstep; vh1[1] = voffA[1] + (unsigned)hstep;
#define PG8_ROWOFF(dst, unit) do { _Pragma("unroll") for (int i_ = 0; i_ < 2; ++i_) dst[i_] = (unsigned)gidx[(unit).pm * BM + rA[i_]] | ((unsigned)gidx[(unit).pm * BM + HALF + rA[i_]] << 16); } while (0)
#define PG8_STAGE_A(bufoff, gbase, P, H) do { unsigned to_[2]; _Pragma("unroll") for (int i_ = 0; i_ < 2; ++i_) \
        to_[i_] = GATHER ? ((P[i_] >> (16 * (H))) & 0xffffu) * (unsigned)(K * 2) + c2_[i_] : ((H) ? vh1[i_] : voffA[i_]); PG8_STAGE(bufoff, gbase, to_); } while (0)
    if constexpr (GATHER) PG8_ROWOFF(cvp, cur); else { cvp[0] = 0u; cvp[1] = 0u; }
    const char* cA = GATHER ? (const char*)g.A : (const char*)g.A + (size_t)cur.pm * tstep; const char* cB = (const char*)g.Bt + (size_t)((cur.pm / g.gdiv) % g.gmod) * g.gstride + (size_t)cur.pn * tstep;
    S.a_ready(cur);
    if constexpr (SP2) {
        PG8_STAGE(PG8_SB(0, 0), cB, voffB); PG8_STAGE(PG8_SB(0, 1), cB + hstep, voffB); PG8_STAGE_A(PG8_SA(0, 0), cA, cvp, 0); PG8_STAGE_A(PG8_SA(0, 1), cA, cvp, 1);
        if (wr == 1) PG8_BAR;
        PG8_WAIT_V(2); PG8_BAR;
        PG8_STAGE(PG8_SB(1, 0), cB + kstep, voffB); PG8_STAGE_A(PG8_SA(1, 0), cA + kstep, cvp, 0); PG8_STAGE(PG8_SB(1, 1), cB + hstep + kstep, voffB);
        PG8_WAIT_V(6); PG8_BAR;
    } else {
        PG8_STAGE(PG8_SB(0, 0), cB, voffB); PG8_STAGE(PG8_SA(0, 0), cA, voffA); PG8_STAGE(PG8_SB(0, 1), cB + hstep, voffB); PG8_STAGE(PG8_SA(0, 1), cA + hstep, voffA);
        if (wr == 1) PG8_BAR;
        PG8_WAIT_V(4); PG8_BAR;
        PG8_STAGE(PG8_SB(1, 0), cB + kstep, voffB); PG8_STAGE(PG8_SA(1, 0), cA + kstep, voffA); PG8_STAGE(PG8_SB(1, 1), cB + hstep + kstep, voffB);
        PG8_WAIT_V(6); PG8_BAR;
    }
    for (;;) {
        const bool has_next = S.next(ui + 1, nxt);
        if constexpr (GATHER) { if (has_next) PG8_ROWOFF(nvp, nxt); else { nvp[0] = cvp[0]; nvp[1] = cvp[1]; } } else { nvp[0] = 0u; nvp[1] = 0u; }
        const char* nA = GATHER ? (const char*)g.A : (has_next ? (const char*)g.A + (size_t)nxt.pm * tstep : cA); const char* nB = has_next ? (const char*)g.Bt + (size_t)((nxt.pm / g.gdiv) % g.gmod) * g.gstride + (size_t)nxt.pn * tstep : cB;
        for (int t = 0; t < nt; t += 2) {
            const bool last = (t == nt - 2);
            unsigned svp[2]; svp[0] = last ? nvp[0] : cvp[0]; svp[1] = last ? nvp[1] : cvp[1];
            const char* a1 = cA + (size_t)(t + 1) * kstep;
            const char* a2 = last ? nA : cA + (size_t)(t + 2) * kstep; const char* b2 = last ? nB : cB + (size_t)(t + 2) * kstep;
            const char* a3 = a2 + kstep; const char* b3 = b2 + kstep;
            if (last && has_next) S.a_ready(nxt);
            if constexpr (SP2) {
            PG8_LDB(B0, 0, 0); PG8_LDB(B1, 0, 1); PG8_SCHED; PG8_LDA(At, 0, 0); PG8_STAGE_A(PG8_SA(1, 1), a1, cvp, 1);
            PG8_WAIT_V(8); PG8_WAIT_L(0); PG8_BAR; PG8_MMA(0, 0, At, B0); PG8_MMA(0, 1, At, B1); PG8_BAR; PG8_SCHED;
            PG8_LDA(At, 0, 1); PG8_STAGE(PG8_SB(0, 0), b2, voffB); PG8_STAGE(PG8_SB(0, 1), b2 + hstep, voffB); PG8_STAGE_A(PG8_SA(0, 0), a2, svp, 0);
            PG8_WAIT_V(8); PG8_WAIT_L(0); PG8_BAR; PG8_MMA(1, 0, At, B0); PG8_MMA(1, 1, At, B1); PG8_BAR; PG8_SCHED;
            PG8_LDB(B0, 1, 0); PG8_LDB(B1, 1, 1); PG8_SCHED; PG8_LDA(At, 1, 0); PG8_STAGE_A(PG8_SA(0, 1), a2, svp, 1);
            PG8_WAIT_V(8); PG8_WAIT_L(0); PG8_BAR; PG8_MMA(0, 0, At, B0); PG8_MMA(0, 1, At, B1); PG8_BAR; PG8_SCHED;
            PG8_LDA(At, 1, 1); PG8_STAGE(PG8_SB(1, 0), b3, voffB); PG8_STAGE(PG8_SB(1, 1), b3 + hstep, voffB); PG8_STAGE_A(PG8_SA(1, 0), a3, svp, 0);
            PG8_WAIT_V(8); PG8_WAIT_L(0); PG8_BAR; PG8_MMA(1, 0, At, B0); PG8_MMA(1, 1, At, B1); PG8_BAR; PG8_SCHED;
            } else {
            PG8_LDB(B0, 0, 0); PG8_SCHED; PG8_LDA(At, 0, 0); PG8_STAGE(PG8_SA(1, 1), a1 + hstep, voffA);
            PG8_WAIT_L(8); PG8_BAR; PG8_WAIT_L(0); PG8_MMA(0, 0, At, B0); PG8_BAR; PG8_SCHED;
            PG8_LDB(B1, 0, 1); PG8_STAGE(PG8_SB(0, 0), b2, voffB);
            PG8_BAR; PG8_WAIT_L(0); PG8_MMA(0, 1, At, B1); PG8_BAR;
            PG8_LDA(At, 0, 1); PG8_STAGE(PG8_SA(0, 0), a2, voffA);
            PG8_BAR; PG8_WAIT_L(0); PG8_MMA(1, 0, At, B0); PG8_BAR; PG8_SCHED;
            PG8_STAGE(PG8_SB(0, 1), b2 + hstep, voffB);
            PG8_WAIT_V(6); PG8_BAR; PG8_MMA(1, 1, At, B1); PG8_BAR;
            PG8_LDB(B0, 1, 0); PG8_SCHED; PG8_LDA(At, 1, 0); PG8_STAGE(PG8_SA(0, 1), a2 + hstep, voffA);
            PG8_WAIT_L(8); PG8_BAR; PG8_WAIT_L(0); PG8_MMA(0, 0, At, B0); PG8_BAR; PG8_SCHED;
            PG8_LDB(B1, 1, 1); PG8_STAGE(PG8_SB(1, 0), b3, voffB);
            PG8_BAR; PG8_WAIT_L(0); PG8_MMA(0, 1, At, B1); PG8_BAR;
            PG8_LDA(At, 1, 1); PG8_STAGE(PG8_SA(1, 0), a3, voffA);
            PG8_BAR; PG8_WAIT_L(0); PG8_MMA(1, 0, At, B0); PG8_BAR; PG8_SCHED;
            PG8_STAGE(PG8_SB(1, 1), b3 + hstep, voffB);
            PG8_WAIT_V(6); PG8_BAR; PG8_MMA(1, 1, At, B1); PG8_BAR;
            }
        }
        if constexpr (ALIGN_EPI) { if (wr == 0) PG8_BAR; }
        if constexpr (!Epi::AFTER_DRAIN) { E(acc, cur, wr, wc, fr, fq); S.done(cur); }
        if (!has_next) break;
#pragma unroll
        for (int a = 0; a < 2; ++a)
#pragma unroll
            for (int b = 0; b < 2; ++b)
#pragma unroll
                for (int m = 0; m < 4; ++m)
#pragma unroll
                    for (int n = 0; n < 2; ++n) acc[a][b][m][n] = (f32x4){0.f, 0.f, 0.f, 0.f};
        cur = nxt; cA = nA; cB = nB; ++ui; if constexpr (GATHER) { cvp[0] = nvp[0]; cvp[1] = nvp[1]; }
        if constexpr (ALIGN_EPI) { if (wr == 1) PG8_BAR; }
    }
    PG8_WAIT_V(0);
    if constexpr (!ALIGN_EPI) { if (wr == 0) PG8_BAR; }
    PG8_BAR;
    if constexpr (Epi::AFTER_DRAIN) { E.fused(acc, cur, wr, wc, fr, fq, lds, wid, lane); S.done(cur); }
#undef PG8_ROWOFF
#undef PG8_STAGE_A
#undef PG8_SA
#undef PG8_SB
#undef PG8_STAGE
#undef PG8_LDA
#undef PG8_LDB
#undef PG8_MMA
#undef PG8_WAIT_V
#undef PG8_WAIT_L
#undef PG8_BAR
#undef PG8_SCHED
}
}
namespace attn_body {
using bf16=__hip_bfloat16;
using bf16x8=__attribute__((ext_vector_type(8)))short;
using s16x4=__attribute__((ext_vector_type(4)))short;
using f32x16=__attribute__((ext_vector_type(16)))float;
using u32x4=__attribute__((ext_vector_type(4)))unsigned;
constexpr int D=64;
constexpr int NW=8,QBLK=32,QB=QBLK*NW,KVBLK=64;
__device__ __forceinline__ int crow(int r,int hi){return (r&3)+8*(r>>2)+4*hi;}
#define SBAR() __builtin_amdgcn_sched_barrier(0)
__device__ __forceinline__ void cmask(f32x16&p0,f32x16&p1,int jb,int qrel,int hi){
  const float NEG=-INFINITY; int kb=64*jb+4*hi;
  #pragma unroll
  for(int r=0;r<16;++r){int kv=kb+(r&3)+8*(r>>2); if(kv>qrel)p0[r]=NEG; if(kv+32>qrel)p1[r]=NEG;}
}

constexpr int NSLOT=3, SLOTB=8192;
constexpr int LDS_K=0, LDS_V=NSLOT*SLOTB, LDS_WS=2*NSLOT*SLOTB, LDS_OST=LDS_WS+NW*64*4, LDS_BYTES=LDS_OST+NW*4096;
constexpr float C2=0.125f*1.4426950408889634f;
__device__ __forceinline__ void glds16(const void*gsrc,unsigned lds_dst){unsigned keep;
  asm volatile("s_mov_b32 %0, m0\n\ts_mov_b32 m0, %2\n\ts_nop 0\n\tglobal_load_lds_dwordx4 %1, off\n\ts_mov_b32 m0, %0":"=&s"(keep):"v"(gsrc),"s"(lds_dst):"memory");}
__device__ __forceinline__ float max3f(float a,float b,float c){float r;asm("v_max3_f32 %0, %1, %2, %3":"=v"(r):"v"(a),"v"(b),"v"(c));return r;}
__device__ __forceinline__ float max2f(float a,float b){float r;asm("v_max_f32_e32 %0, %1, %2":"=v"(r):"v"(a),"v"(b));return r;}
__device__ __forceinline__ float fadd_s(float a,float b){float r;asm("v_add_f32_e32 %0, %1, %2":"=v"(r):"v"(a),"v"(b));return r;}
__device__ __forceinline__ float fsub_s(float a,float b){float r;asm("v_sub_f32_e32 %0, %1, %2":"=v"(r):"v"(a),"v"(b));return r;}
typedef float f32x2_t __attribute__((ext_vector_type(2))); typedef __bf16 bf16x2_t __attribute__((ext_vector_type(2)));
__device__ __forceinline__ unsigned cvtpk_s(float lo,float hi){f32x2_t v={lo,hi};bf16x2_t b=__builtin_convertvector(v,bf16x2_t);return __builtin_bit_cast(unsigned,b);}
#define WAIT_BAR(N) asm volatile("s_waitcnt vmcnt(" #N ") lgkmcnt(0)\n\ts_barrier":::"memory")

__device__ __forceinline__ void qkt(f32x16&p0,f32x16&p1,const char*Kslot,const bf16x8*qr,const f32x16&negm,int r32,int hi){
  const char*kb=Kslot+hi*1024+r32*16;
  #pragma unroll
  for(int d0=0;d0<4;++d0){
    const bf16x8 b0=*reinterpret_cast<const bf16x8*>(kb+d0*2048);
    const bf16x8 b1=*reinterpret_cast<const bf16x8*>(kb+d0*2048+512);
    if(d0==0){p0=__builtin_amdgcn_mfma_f32_32x32x16_bf16(b0,qr[0],negm,0,0,0);p1=__builtin_amdgcn_mfma_f32_32x32x16_bf16(b1,qr[0],negm,0,0,0);}
    else{p0=__builtin_amdgcn_mfma_f32_32x32x16_bf16(b0,qr[d0],p0,0,0,0);p1=__builtin_amdgcn_mfma_f32_32x32x16_bf16(b1,qr[d0],p1,0,0,0);}}
}
typedef __attribute__((address_space(3))) const char* lds_cptr;
typedef short v4i16_t __attribute__((ext_vector_type(4)));
__device__ __forceinline__ void kload8(bf16x8*kf,lds_cptr kp){
  kf[0]=*(const __attribute__((address_space(3))) bf16x8*)(kp);      kf[1]=*(const __attribute__((address_space(3))) bf16x8*)(kp+512);
  kf[2]=*(const __attribute__((address_space(3))) bf16x8*)(kp+2048); kf[3]=*(const __attribute__((address_space(3))) bf16x8*)(kp+2560);
  kf[4]=*(const __attribute__((address_space(3))) bf16x8*)(kp+4096); kf[5]=*(const __attribute__((address_space(3))) bf16x8*)(kp+4608);
  kf[6]=*(const __attribute__((address_space(3))) bf16x8*)(kp+6144); kf[7]=*(const __attribute__((address_space(3))) bf16x8*)(kp+6656);
}
__device__ __forceinline__ void kload2(bf16x8*kf,lds_cptr kp,int j){ kf[2*j]=*(const __attribute__((address_space(3))) bf16x8*)(kp+j*2048); kf[2*j+1]=*(const __attribute__((address_space(3))) bf16x8*)(kp+j*2048+512); }
__device__ __forceinline__ s16x4 vtr(lds_cptr p){ return __builtin_bit_cast(s16x4,__builtin_amdgcn_ds_read_tr16_b64_v4i16((__attribute__((address_space(3))) v4i16_t*)p)); }
__device__ __forceinline__ float rowmax(const f32x16&p0,const f32x16&p1){
  float a=max3f(p0[0],p0[1],p1[0]),b=max3f(p0[2],p0[3],p1[1]);a=max3f(a,p1[2],p1[3]);
  #pragma unroll
  for(int r=4;r<16;r+=4){a=max3f(a,p0[r],p0[r+1]);b=max3f(b,p0[r+2],p0[r+3]);a=max3f(a,p1[r],p1[r+1]);b=max3f(b,p1[r+2],p1[r+3]);}
  const float m=max2f(a,b);
  auto rr=__builtin_amdgcn_permlane32_swap(__float_as_uint(m),__float_as_uint(m),false,false);
  return max2f(__uint_as_float(rr[0]),__uint_as_float(rr[1]));
}
__device__ __forceinline__ void pv(f32x16*o,int vb,bf16x8 pa0,bf16x8 pa1,bf16x8 pa2,bf16x8 pa3){
  #pragma unroll
  for(int d0=0;d0<2;++d0){s16x4 lo[4],hi[4];
    #pragma unroll
    for(int ks=0;ks<4;++ks){
      asm volatile("ds_read_b64_tr_b16 %0,%1 offset:%c2":"=&v"(lo[ks]):"v"(vb),"i"(d0*4096+ks*1024):"memory");
      asm volatile("ds_read_b64_tr_b16 %0,%1 offset:%c2":"=&v"(hi[ks]):"v"(vb),"i"(d0*4096+ks*1024+512):"memory");}
    asm volatile("s_waitcnt lgkmcnt(0)":::"memory");SBAR();
    #define PK(k) (bf16x8){lo[k][0],lo[k][1],lo[k][2],lo[k][3],hi[k][0],hi[k][1],hi[k][2],hi[k][3]}
    o[d0]=__builtin_amdgcn_mfma_f32_32x32x16_bf16(pa0,PK(0),o[d0],0,0,0);
    o[d0]=__builtin_amdgcn_mfma_f32_32x32x16_bf16(pa1,PK(1),o[d0],0,0,0);
    o[d0]=__builtin_amdgcn_mfma_f32_32x32x16_bf16(pa2,PK(2),o[d0],0,0,0);
    o[d0]=__builtin_amdgcn_mfma_f32_32x32x16_bf16(pa3,PK(3),o[d0],0,0,0);
    #undef PK
  }
}

#ifndef ATTN_STORE16
#define ATTN_STORE16(p,v) (*(u32x4*)(p)=(v))
#endif
template<int THRL,int QP,int KP,int OP> __device__ __forceinline__ void attn_unit(const bf16*Qu,const bf16*__restrict__ Kh,const bf16*__restrict__ Vh,bf16*Ou,const int NT,char*shm){
  const int tid=opaque_tid(),lane=tid&63,r32=lane&31,hi=lane>>5; const int wid=__builtin_amdgcn_readfirstlane(tid>>6);
  const bf16*Qw=Qu+(long)(wid*QBLK)*QP;
  const unsigned lds0=(unsigned)(uintptr_t)shm;
  float*wsf=(float*)(shm+LDS_WS)+wid*64;
  const bf16*ksrc=Kh+(long)lane*KP+wid*8;
  const bf16*vsrc=Vh+(long)(16*(wid&3)+(lane>>2))*KP+(wid>>2)*32+(lane&3)*8;
  const unsigned kdst=lds0+LDS_K+wid*1024, vdst=lds0+LDS_V+wid*1024;
  #define DMA_K(t,slot) glds16(ksrc+(long)(t)*KVBLK*KP,(unsigned)__builtin_amdgcn_readfirstlane(kdst+(slot)))
  #define DMA_V(t,slot) glds16(vsrc+(long)(t)*KVBLK*KP,(unsigned)__builtin_amdgcn_readfirstlane(vdst+(slot)))
  const int vb0=(int)(lds0+LDS_V)+((lane>>4)&1)*32+(lane&3)*8+(4*hi+((lane&15)>>2))*64;
  const char*Kbase=shm+LDS_K; bf16x8 kf[8];
  const lds_cptr shm3=(lds_cptr)shm; const lds_cptr kp0=shm3+LDS_K+hi*1024+r32*16; const lds_cptr vp0=shm3+LDS_V+((lane>>4)&1)*32+(lane&3)*8+(4*hi+((lane&15)>>2))*64;
  DMA_K(0,0);DMA_V(0,0);DMA_K(1,SLOTB);
  bf16x8 qr[4];
  #pragma unroll
  for(int d0=0;d0<4;++d0)qr[d0]=*reinterpret_cast<const bf16x8*>(&Qw[(long)r32*QP+d0*16+hi*8]);
  float mhat=0.f,l_reg=0.f;f32x16 o[2];o[0]=f32x16{};o[1]=f32x16{};f32x16 negm=f32x16{};asm volatile("":"+v"(negm));
  #define CMASK(P0,P1,t) do{}while(0)
  bool resc=false;
  #define START(P0,P1) do{ const float rm=rowmax(P0,P1); resc=false; \
    { const float dl=rm; mhat=fadd_s(mhat,dl); \
      _Pragma("unroll") for(int r=0;r<16;++r){P0[r]=fsub_s(P0[r],dl);P1[r]=fsub_s(P1[r],dl);} \
      _Pragma("unroll") for(int r=0;r<16;++r)negm[r]=-mhat; asm volatile("":"+v"(negm)); } \
    _Pragma("unroll") for(int r=0;r<16;++r)P0[r]=__builtin_amdgcn_exp2f(P0[r]); }while(0)
  #define RESC() do{ if(resc){ asm volatile("s_waitcnt lgkmcnt(0)":::"memory"); \
      _Pragma("unroll") for(int d_=0;d_<2;++d_) _Pragma("unroll") for(int r=0;r<16;++r)o[d_][r]*=wsf[crow(r,hi)]; } }while(0)
  f32x16 pA0,pA1,pB0,pB1;
  int sl_prev=0,sl_cur=0,sl_next=SLOTB;
  #define ROT() do{sl_prev=sl_cur;sl_cur=sl_next;sl_next=(sl_next==(NSLOT-1)*SLOTB)?0:sl_next+SLOTB;}while(0)
  DMA_K(2,2*SLOTB);
  WAIT_BAR(3);
  qkt(pA0,pA1,Kbase,qr,negm,r32,hi);asm volatile("s_nop 15\n\ts_nop 7":"+v"(pA0),"+v"(pA1));CMASK(pA0,pA1,0);
  START(pA0,pA1);
  _Pragma("unroll") for(int r=0;r<16;++r)pA1[r]=__builtin_amdgcn_exp2f(pA1[r]);
  WAIT_BAR(0);
  DMA_K(3,0);DMA_V(1,SLOTB);
  ROT();
  kload8(kf,kp0+sl_cur);
  WAIT_BAR(2);
  s16x4 vlo[8],vhi[8]; u32x4 pw0,pw1,pw2,pw3;
  #define PKW(P,B) cvtpk_s(P[B],P[B+1])
  #define PAF(k) __builtin_bit_cast(bf16x8,pw##k)
  #define VFR(i) (bf16x8){vlo[i][0],vlo[i][1],vlo[i][2],vlo[i][3],vhi[i][0],vhi[i][1],vhi[i][2],vhi[i][3]}
  #define PIN(x) asm volatile("":"+v"(x))
  #define MX3(a,b,c) __builtin_fmaxf(__builtin_fmaxf((a),(b)),(c))
  #define GAPA(MF,A0,A1,A2,A3,W0,W1,PW) do{ MF; sacc+=A0; sacc+=A1; sacc+=A2; sacc+=A3; PIN(sacc); W0; W1; PIN(PW); SBAR(); }while(0)
  #define EX(v) __builtin_amdgcn_exp2f(v)
  #define GAPB(MF,X,B) do{ MF; X[B]=EX(X[B]); X[B+1]=EX(X[B+1]); X[B+2]=EX(X[B+2]); X[B+3]=EX(X[B+3]); PIN(X); SBAR(); }while(0)
  #define VRD(i) do{ vlo[i]=vtr(vp_+(((i)>>2)*4096+((i)&3)*1024)); vhi[i]=vtr(vp_+(((i)>>2)*4096+((i)&3)*1024+512)); }while(0)
  #define KRD(G,j) do{ if(G){ kload2(kf,kp0+sl_next,j); SBAR(); } }while(0)
  #define STEP(C0,C1,P0,P1,t,GK,GV,GL) do{ SBAR(); \
    const lds_cptr vp_=vp0+sl_prev; \
    VRD(0); SBAR(); float sacc=(P0[0]+P0[1]); \
    GAPA(C0=__builtin_amdgcn_mfma_f32_32x32x16_bf16(kf[0],qr[0],negm,0,0,0), P0[2],P0[3],P0[4],P0[5],     pw0[0]=PKW(P0,0), pw0[1]=PKW(P0,2), pw0); \
    VRD(4); SBAR(); GAPA(C1=__builtin_amdgcn_mfma_f32_32x32x16_bf16(kf[1],qr[0],negm,0,0,0), P0[6],P0[7],P0[8],P0[9],     pw0[2]=PKW(P0,4), pw0[3]=PKW(P0,6), pw0); \
    VRD(1); SBAR(); GAPA(C0=__builtin_amdgcn_mfma_f32_32x32x16_bf16(kf[2],qr[1],C0,0,0,0),   P0[10],P0[11],P0[12],P0[13], pw1[0]=PKW(P0,8), pw1[1]=PKW(P0,10), pw1); \
    VRD(5); SBAR(); GAPA(C1=__builtin_amdgcn_mfma_f32_32x32x16_bf16(kf[3],qr[1],C1,0,0,0),   P0[14],P0[15],P1[0],P1[1],   pw1[2]=PKW(P0,12),pw1[3]=PKW(P0,14), pw1); \
    VRD(2); SBAR(); GAPA(C0=__builtin_amdgcn_mfma_f32_32x32x16_bf16(kf[4],qr[2],C0,0,0,0),   P1[2],P1[3],P1[4],P1[5],     pw2[0]=PKW(P1,0), pw2[1]=PKW(P1,2), pw2); \
    VRD(6); SBAR(); GAPA(C1=__builtin_amdgcn_mfma_f32_32x32x16_bf16(kf[5],qr[2],C1,0,0,0),   P1[6],P1[7],P1[8],P1[9],     pw2[2]=PKW(P1,4), pw2[3]=PKW(P1,6), pw2); \
    VRD(3); SBAR(); GAPA(C0=__builtin_amdgcn_mfma_f32_32x32x16_bf16(kf[6],qr[3],C0,0,0,0),   P1[10],P1[11],P1[12],P1[13], pw3[0]=PKW(P1,8), pw3[1]=PKW(P1,10), pw3); \
    VRD(7); SBAR(); GAPA(C1=__builtin_amdgcn_mfma_f32_32x32x16_bf16(kf[7],qr[3],C1,0,0,0),   P1[14],P1[15],0.f,0.f,       pw3[2]=PKW(P1,12),pw3[3]=PKW(P1,14), pw3); \
    l_reg+=sacc; \
    if(GK){DMA_K((t)+3,sl_cur);} if(GV){DMA_V((t)+1,sl_next);} \
    CMASK(C0,C1,t); \
    { float a=MX3(C0[0],C0[1],C1[0]),b=MX3(C0[2],C0[3],C1[1]); a=MX3(a,C1[2],C1[3]); \
      _Pragma("unroll") for(int r=4;r<16;r+=4){a=MX3(a,C0[r],C0[r+1]);b=MX3(b,C0[r+2],C0[r+3]);a=MX3(a,C1[r],C1[r+1]);b=MX3(b,C1[r+2],C1[r+3]);} \
      float rm=__builtin_fmaxf(a,b); { auto rr=__builtin_amdgcn_permlane32_swap(__float_as_uint(rm),__float_as_uint(rm),false,false); rm=__builtin_fmaxf(__uint_as_float(rr[0]),__uint_as_float(rr[1])); } \
      resc=false; \
      if(__builtin_expect(__any(rm>(float)THRL),0)){ const float dl=__builtin_fmaxf(rm,0.f); mhat+=dl; \
        _Pragma("unroll") for(int r=0;r<16;++r){C0[r]-=dl;C1[r]-=dl;} \
        _Pragma("unroll") for(int r=0;r<16;++r)negm[r]=-mhat; asm volatile("":"+v"(negm)); \
        const float f=__builtin_amdgcn_exp2f(-dl); l_reg*=f; if(hi==0)wsf[r32]=f; resc=true; } } \
    SBAR(); \
    GAPB(o[0]=__builtin_amdgcn_mfma_f32_32x32x16_bf16(PAF(0),VFR(0),o[0],0,0,0), C0,0); \
    GAPB(o[1]=__builtin_amdgcn_mfma_f32_32x32x16_bf16(PAF(0),VFR(4),o[1],0,0,0), C0,4); \
    KRD(GL,0); GAPB(o[0]=__builtin_amdgcn_mfma_f32_32x32x16_bf16(PAF(1),VFR(1),o[0],0,0,0), C0,8); \
    KRD(GL,1); GAPB(o[1]=__builtin_amdgcn_mfma_f32_32x32x16_bf16(PAF(1),VFR(5),o[1],0,0,0), C0,12); \
    KRD(GL,2); GAPB(o[0]=__builtin_amdgcn_mfma_f32_32x32x16_bf16(PAF(2),VFR(2),o[0],0,0,0), C1,0); \
    KRD(GL,3); GAPB(o[1]=__builtin_amdgcn_mfma_f32_32x32x16_bf16(PAF(2),VFR(6),o[1],0,0,0), C1,4); \
    GAPB(o[0]=__builtin_amdgcn_mfma_f32_32x32x16_bf16(PAF(3),VFR(3),o[0],0,0,0), C1,8); \
    GAPB(o[1]=__builtin_amdgcn_mfma_f32_32x32x16_bf16(PAF(3),VFR(7),o[1],0,0,0), C1,12); \
    }while(0)
  int t=1;
  #undef CMASK
  #define CMASK(P0,P1,t) do{}while(0)
  for(;t+5<NT;t+=2){
    STEP(pB0,pB1,pA0,pA1,t,true,true,true);     WAIT_BAR(2); RESC(); ROT();
    STEP(pA0,pA1,pB0,pB1,t+1,true,true,true);   WAIT_BAR(2); RESC(); ROT();
  }
  #undef CMASK
  #define CMASK(P0,P1,t) do{}while(0)
  #define ENDW(tt) do{ if((tt)+3<NT){WAIT_BAR(2);} else if((tt)+2<NT){WAIT_BAR(1);} else {WAIT_BAR(0);} }while(0)
  for(;t+1<NT;t+=2){
    STEP(pB0,pB1,pA0,pA1,t,(t+3<NT),(t+1<NT),(t+1<NT));       ENDW(t);   RESC(); ROT();
    STEP(pA0,pA1,pB0,pB1,t+1,(t+4<NT),(t+2<NT),(t+2<NT));     ENDW(t+1); RESC(); ROT();
  }
  STEP(pB0,pB1,pA0,pA1,NT-1,false,false,false); RESC();
  { float sacc=pB0[0]+pB0[1]; _Pragma("unroll") for(int r=2;r<16;++r)sacc+=pB0[r]; _Pragma("unroll") for(int r=0;r<16;++r)sacc+=pB1[r]; l_reg+=sacc;
    pw0=(u32x4){PKW(pB0,0),PKW(pB0,2),PKW(pB0,4),PKW(pB0,6)};pw1=(u32x4){PKW(pB0,8),PKW(pB0,10),PKW(pB0,12),PKW(pB0,14)};pw2=(u32x4){PKW(pB1,0),PKW(pB1,2),PKW(pB1,4),PKW(pB1,6)};pw3=(u32x4){PKW(pB1,8),PKW(pB1,10),PKW(pB1,12),PKW(pB1,14)};
    SBAR(); pv(o,vb0+sl_cur,PAF(0),PAF(1),PAF(2),PAF(3)); }
  #undef PKW
  #undef PAF
  #undef VFR
  #undef PIN
  #undef MX3
  #undef GAPA
  #undef GAPB
  #undef EX
  #undef VRD
  #undef KRD
  #undef STEP
  #undef ENDW
  {auto rr=__builtin_amdgcn_permlane32_swap(__float_as_uint(l_reg),__float_as_uint(l_reg),false,false);l_reg=__uint_as_float(rr[0])+__uint_as_float(rr[1]);}
  if(hi==0)wsf[32+r32]=l_reg;asm volatile("s_waitcnt lgkmcnt(0)":::"memory");
  float rli[16];
  #pragma unroll
  for(int r=0;r<16;++r)rli[r]=__builtin_amdgcn_rcpf(wsf[32+crow(r,hi)]);
  bf16*Ow=Ou+(long)(wid*QBLK)*OP;
  { bf16*stg=(bf16*)(shm+LDS_OST)+wid*2048;
    #pragma unroll
    for(int r=0;r<16;++r){const int orow=crow(r,hi);
      #pragma unroll
      for(int d0=0;d0<2;++d0)stg[orow*64+d0*32+r32]=__float2bfloat16(o[d0][r]*rli[r]);}
    asm volatile("s_waitcnt lgkmcnt(0)":::"memory");
    #pragma unroll
    for(int i=0;i<4;++i){const int row=i*8+(lane>>3),ch=lane&7; const u32x4 v=*(const u32x4*)(stg+row*64+ch*8); ATTN_STORE16(Ow+(long)row*OP+ch*8,v);} }
  asm volatile("s_waitcnt lgkmcnt(0)\n\ts_barrier":::"memory");
  #undef DMA_K
  #undef DMA_V
  #undef CMASK
  #undef START
  #undef RESC
  #undef ROT
}
constexpr int ATTN_LDS_BYTES=LDS_BYTES;
#undef SBAR
#undef WAIT_BAR
}
#define LDS_WAIT() asm volatile("s_waitcnt lgkmcnt(0)" ::: "memory")

__device__ __forceinline__ void transpose_item(const float* W, int K, int N, bf16* WT, int k0, int n0, int dest_row0, LAS float* scr, int lane) {
    float t_[32];
#pragma unroll
    for (int i = 0; i < 32; ++i) t_[i] = W[(size_t)(k0 + 2 * i + (lane >> 5)) * N + n0 + (lane & 31)];
#pragma unroll
    for (int i = 0; i < 32; ++i) scr[(2 * i + (lane >> 5)) * 33 + (lane & 31)] = t_[i];
    LDS_WAIT(); asm volatile("" ::: "memory");
    const int c = lane & 7;
#pragma unroll
    for (int j = 0; j < 4; ++j) { const int n = (lane >> 3) + 8 * j; const LAS float* s = scr + (8 * c) * 33 + n;
        v4u o; o.x = pk2(s[0 * 33], s[1 * 33]); o.y = pk2(s[2 * 33], s[3 * 33]); o.z = pk2(s[4 * 33], s[5 * 33]); o.w = pk2(s[6 * 33], s[7 * 33]);
        *(GAS v4u*)(WT + (size_t)(dest_row0 + n) * K + k0 + 8 * c) = o; }
    LDS_WAIT(); asm volatile("" ::: "memory");
}

template <int KMODE>
__device__ __forceinline__ void transpose_item8(const float* W, int K, int N, unsigned char* WT, int k0, int n0, int dest_row0, float sc, LAS float* scr, int lane) {
    float t_[32];
#pragma unroll
    for (int i = 0; i < 32; ++i) t_[i] = W[(size_t)(k0 + 2 * i + (lane >> 5)) * N + n0 + (lane & 31)];
#pragma unroll
    for (int i = 0; i < 32; ++i) scr[(2 * i + (lane >> 5)) * 33 + (lane & 31)] = __builtin_amdgcn_fmed3f(t_[i] * sc, -448.f, 448.f);
    LDS_WAIT(); asm volatile("" ::: "memory");
    const int c = lane & 7, w = c >> 2, fq = c & 3, wh = (k0 >> 6) & 1;
    const int doff = KMODE == 1 ? (k0 & ~255) + 64 * (2 * wh + w) + 16 * fq + 8 * ((k0 >> 7) & 1) : KMODE == 2 ? (k0 & ~127) + 32 * (2 * wh + w) + 8 * fq : k0 + 8 * c;
#pragma unroll
    for (int j = 0; j < 4; ++j) { const int n = (lane >> 3) + 8 * j; const LAS float* s = scr + n;
        float v[8];
#pragma unroll
        for (int e = 0; e < 8; ++e) { const int kk = KMODE == 2 ? 32 * w + 16 * (e >> 2) + 4 * fq + (e & 3) : 8 * c + e; v[e] = s[kk * 33]; }
        unsigned w0 = 0, w1 = 0;
        w0 = __builtin_amdgcn_cvt_pk_fp8_f32(v[0], v[1], w0, false); w0 = __builtin_amdgcn_cvt_pk_fp8_f32(v[2], v[3], w0, true);
        w1 = __builtin_amdgcn_cvt_pk_fp8_f32(v[4], v[5], w1, false); w1 = __builtin_amdgcn_cvt_pk_fp8_f32(v[6], v[7], w1, true);
        *(GAS v2u*)(WT + (size_t)(dest_row0 + n) * K + doff) = (v2u){w0, w1}; }
    LDS_WAIT(); asm volatile("" ::: "memory");
}

struct ProIn { const float *hy_w_in, *at_w_in, *w_out, *w_mem_kv; };
__device__ __forceinline__ void phase_weights(const ProIn& P, unsigned char* ws, LAS unsigned char* lds, int gw, int NGW, int wave, int lane) {
    LAS float* scr = (LAS float*)(lds + wave * 16384);
    constexpr int I_HY = 16 * 80, I_AT = 16 * 48, I_OUT = 16 * 32, I_MKV = 16 * 16;
    constexpr int E0 = 2 * I_HY, E1 = E0 + 2 * I_AT, E2 = E1 + 4 * I_OUT, E3 = E2 + 4 * I_MKV;
    for (int it = gw; it < E3; it += NGW) {
        int r = it;
        if (r < E0) { const int j = r / I_HY, q = r % I_HY, kb = q / 80, nb = q % 80;
            transpose_item(P.hy_w_in + (size_t)j * DM * D_IN_HY, DM, D_IN_HY, (bf16*)(ws + WS_WHY) + (size_t)j * D_IN_HY * DM, 64 * kb, 32 * nb, 32 * nb, scr, lane); continue; }
        r -= E0;
        if (r < 2 * I_AT) { const int j = r / I_AT, q = r % I_AT, kb = q / 48, nb = q % 48;
            const int n0 = 32 * nb, o = n0 & 255;
            transpose_item(P.at_w_in + (size_t)j * DM * D_IN_AT, DM, D_IN_AT, (bf16*)(ws + WS_WAT) + (size_t)j * D_IN_AT * DM, 64 * kb, n0, (n0 & ~255) + 128 * ((o & 63) >> 5) + 32 * (o >> 6), scr, lane); continue; }
        r -= 2 * I_AT;
        if (r < 4 * I_OUT) { const int j = r / I_OUT, q = r % I_OUT, kb = q / 32, nb = q % 32;
            transpose_item(P.w_out + (size_t)j * DM * DM, DM, DM, (bf16*)(ws + WS_WOUT) + (size_t)j * DM * DM, 64 * kb, 32 * nb, 32 * nb, scr, lane); continue; }
        r -= 4 * I_OUT;
        { const int j = r / I_MKV, q = r % I_MKV, kb = q / 16, nb = q % 16;
            transpose_item(P.w_mem_kv + (size_t)j * DM * 512, DM, 512, (bf16*)(ws + WS_WMKV), 64 * kb, 32 * nb, j * 512 + 32 * nb, scr, lane); }
        (void)r;
    }
}

struct XwIn { const float *w_gate, *w_up, *w_down; unsigned char* ws; };
constexpr int XW_PER_EXPERT = 3 * 384, XW_PER_LAYER = NEXP * XW_PER_EXPERT;
constexpr int XW_QA_HY = 5, XW_QA_AT = 4, XW_QB = 3, XW_NA = 128 * NWAVES, XW_NB = 224 * NWAVES;
__host__ __device__ constexpr int xw_qa(int layer) { return (layer & 1) ? XW_QA_AT : XW_QA_HY; }
__host__ __device__ constexpr int xw_p0(int layer, bool sched) { return sched ? XW_PER_LAYER - xw_qa(layer) * XW_NA - XW_QB * XW_NB : XW_PER_LAYER; }
__device__ __forceinline__ void xw_item(const XwIn& B, int layer, int r, LAS float* scr, int lane) {
    const int j = layer * NEXP + r / XW_PER_EXPERT, q = r % XW_PER_EXPERT, kind = q / 384, qq = q % 384;
    if (kind < 2) { const int kb = qq / 24, nb = qq % 24, n0 = 32 * nb;
        transpose_item8<1>((kind == 0 ? B.w_gate : B.w_up) + (size_t)j * DM * EFF, DM, EFF, B.ws + WS_W1 + (size_t)j * 1536 * DM, 64 * kb, n0, (n0 >> 7) * 256 + 128 * kind + (n0 & 127), W8_SCALE, scr, lane); }
    else { const int kb = qq / 32, nb = qq % 32;
        transpose_item8<2>(B.w_down + (size_t)j * EFF * DM, EFF, DM, B.ws + WS_W2 + (size_t)j * DM * EFF, 64 * kb, 32 * nb, 32 * nb, W8_SCALE, scr, lane); }
}
__device__ __forceinline__ void phase_xw_p0(const XwIn& B, bool sched, LAS float* scr, int gw, int NGW, int lane) {
#pragma unroll 1
    for (int layer = 0; layer < DEPTH; ++layer) { const int n = xw_p0(layer, sched);
#pragma unroll 1
        for (int r = gw; r < n; r += NGW) xw_item(B, layer, r, scr, lane); }
}
__device__ __forceinline__ void xw_slice_a(const XwIn& B, int layer, LAS float* scr, int bx, int wave, int lane) {
    const int base = xw_p0(layer, true) + (bx - 128) * NWAVES + wave;
#pragma unroll 1
    for (int k = 0; k < xw_qa(layer); ++k) xw_item(B, layer, base + k * XW_NA, scr, lane);
}
__device__ __forceinline__ void xw_slice_b(const XwIn& B, int layer, LAS float* scr, int bx, int wave, int lane) {
    const int base = xw_p0(layer, true) + xw_qa(layer) * XW_NA + (bx - 32) * NWAVES + wave;
#pragma unroll 1
    for (int k = 0; k < XW_QB; ++k) xw_item(B, layer, base + k * XW_NB, scr, lane);
}

__device__ __forceinline__ void phase_wrg(const float* ffn_g, const float* router, float* WRG, int gtid, int nthreads) {
    for (int q = gtid; q < DEPTH * NEXP * DM; q += nthreads) { const int l = q / (NEXP * DM), e = (q / DM) % NEXP, d = q % DM; WRG[q] = ffn_g[l * DM + d] * router[((size_t)l * DM + d) * NEXP + e]; }
}

__device__ __forceinline__ void rms_row_bf16(const float* xrow, const float* g, bf16* orow, int lane) {
    const GAS f32x4* xr = (const GAS f32x4*)xrow + lane; const GAS f32x4* gr = (const GAS f32x4*)g + lane;
    f32x4 v[4]; float s = 0.f;
#pragma unroll
    for (int j = 0; j < 4; ++j) { v[j] = xr[64 * j]; s += (v[j].x * v[j].x + v[j].y * v[j].y) + (v[j].z * v[j].z + v[j].w * v[j].w); }
    const float rstd = 1.f / sqrtf(wave_sum(s) * (1.f / DM) + NORM_EPS);
    GAS v2u* o8 = (GAS v2u*)orow + lane;
#pragma unroll
    for (int j = 0; j < 4; ++j) { const f32x4 gg = gr[64 * j]; v2u w; w.x = pk2(v[j].x * rstd * gg.x, v[j].y * rstd * gg.y); w.y = pk2(v[j].z * rstd * gg.z, v[j].w * rstd * gg.w); o8[64 * j] = w; }
}

__device__ __forceinline__ void phase_mem_h2(const float* mem, const float* mem_g, const float* fw1, const float* fb1, const float* fw2, const float* fb2, const float* ffreq,
                                              unsigned char* ws, int gw, int NGW, int lane) {
    for (int m = gw; m < BATCH * MEM_LEN; m += NGW) rms_row_bf16(mem + (size_t)m * DM, mem_g, (bf16*)(ws + WS_MEMN) + (size_t)m * DM, lane);
    float* H2 = (float*)(ws + WS_H2);
    for (int it = gw; it < 2 * SEQ; it += NGW) {
        const int j = it / SEQ, n = it % SEQ;
        const float* w1 = fw1 + j * HY_EMB * HY_FILT; const float* w2 = fw2 + j * HY_FILT * HY_FILT;
        const float t = (float)n * (1.0f / (float)(SEQ - 1));
        const float w = (6.283185307179586f * (float)n) / (float)SEQ;
        float feat = 0.f;
        if (lane == 0) feat = t;
        else if (lane <= 16) { const float band = 1e-4f + (float)(lane - 1) * ((15.0f - 1e-4f) / 15.0f); feat = cosf(band * w); }
        else if (lane <= 32) { const float band = 1e-4f + (float)(lane - 17) * ((15.0f - 1e-4f) / 15.0f); feat = -sinf(band * w); }
        const float fr = ffreq[j * HY_FILT + lane];
        float a = fb1[j * HY_FILT + lane];
        for (int i = 0; i < HY_EMB; ++i) a += __shfl(feat, i) * w1[i * HY_FILT + lane];
        const float h1 = sinf(fr * a);
        float a2 = fb2[j * HY_FILT + lane];
        for (int i = 0; i < HY_FILT; ++i) a2 += __shfl(h1, i) * w2[i * HY_FILT + lane];
        H2[(size_t)it * HY_FILT + lane] = sinf(fr * a2);
    }
}

template <bool COMBINE, bool FINAL>
__device__ __forceinline__ void phase_norm(const float* hin, float* hout, const float* g, bf16* U, float* fout, const int* POS, const bf16* Y, int gw, int NGW, int lane) {
    int m = gw;
    if (m >= M_TOK) return;
    f32x4 cur[4]; int cpos = -1;
    { const GAS f32x4* xr = (const GAS f32x4*)(hin + (size_t)m * DM) + lane;
#pragma unroll
      for (int j = 0; j < 4; ++j) cur[j] = xr[64 * j];
      if (COMBINE) { const int b = m / SEQ, t = m % SEQ; if (lane < NEXP) cpos = POS[(size_t)(b * NEXP + lane) * SEQ + t]; } }
#pragma unroll 1
    for (; m < M_TOK; m += NGW) {
        const int mn = m + NGW; f32x4 nxt[4]; int npos = -1;
#pragma unroll
        for (int j = 0; j < 4; ++j) nxt[j] = cur[j];
        if (mn < M_TOK) { const GAS f32x4* xr = (const GAS f32x4*)(hin + (size_t)mn * DM) + lane;
#pragma unroll
            for (int j = 0; j < 4; ++j) nxt[j] = xr[64 * j];
            if (COMBINE) { const int b = mn / SEQ, t = mn % SEQ; if (lane < NEXP) npos = POS[(size_t)(b * NEXP + lane) * SEQ + t]; } }
        f32x4 v[4];
#pragma unroll
        for (int j = 0; j < 4; ++j) v[j] = cur[j];
        if (COMBINE) {
            const int b = m / SEQ;
            unsigned long long mask = __ballot(cpos >= 0);
            while (mask) {
                v2u y[4][4]; bool has[4];
#pragma unroll
                for (int k = 0; k < 4; ++k) { has[k] = mask != 0ull;
                    if (has[k]) { const int e = __builtin_amdgcn_readfirstlane(__builtin_ctzll(mask)); mask &= mask - 1ull; const int p = __builtin_amdgcn_readlane(cpos, e);
                        const GAS v2u* yr = (const GAS v2u*)(Y + ((size_t)(b * NEXP + e) * CAP + p) * DM) + lane;
#pragma unroll
                        for (int j = 0; j < 4; ++j) y[k][j] = yr[64 * j]; } }
#pragma unroll
                for (int k = 0; k < 4; ++k) if (has[k]) {
#pragma unroll
                    for (int j = 0; j < 4; ++j) { const v2u w = y[k][j]; v[j].x += bflo(w.x); v[j].y += bfhi(w.x); v[j].z += bflo(w.y); v[j].w += bfhi(w.y); } }
            }
            if (!FINAL) { GAS f32x4* ho = (GAS f32x4*)(hout + (size_t)m * DM) + lane;
#pragma unroll
                for (int j = 0; j < 4; ++j) ho[64 * j] = v[j]; }
        }
        float s = 0.f;
#pragma unroll
        for (int j = 0; j < 4; ++j) s += (v[j].x * v[j].x + v[j].y * v[j].y) + (v[j].z * v[j].z + v[j].w * v[j].w);
        const float rstd = 1.f / sqrtf(wave_sum(s) * (1.f / DM) + NORM_EPS);
        const GAS f32x4* gr = (const GAS f32x4*)g + lane;
        if (FINAL) { GAS f32x4* o = (GAS f32x4*)(fout + (size_t)m * DM) + lane;
#pragma unroll
            for (int j = 0; j < 4; ++j) o[64 * j] = v[j] * rstd * gr[64 * j]; }
        else { GAS v2u* o8 = (GAS v2u*)(U + (size_t)m * DM) + lane;
#pragma unroll
            for (int j = 0; j < 4; ++j) { const f32x4 gg = gr[64 * j]; v2u w; w.x = pk2(v[j].x * rstd * gg.x, v[j].y * rstd * gg.y); w.y = pk2(v[j].z * rstd * gg.z, v[j].w * rstd * gg.w); o8[64 * j] = w; } }
#pragma unroll
        for (int j = 0; j < 4; ++j) cur[j] = nxt[j];
        cpos = npos;
    }
}

__device__ __forceinline__ void phase_ffn_norm_router(const float* H, const float* g, const float* Wr, unsigned char* XN8, float* AFF, LAS unsigned char* lds, int gw, int NGW, int lane, int tid) {
    LAS f32x4* WL = (LAS f32x4*)lds;
    for (int q = tid; q < 64 * 64; q += NTHREADS) { const int ln = q & 63, s = q >> 6, e4 = s & 3, ji = s >> 2, i = ji & 3, j = ji >> 2; const int d = 4 * ln + i + 256 * j;
        WL[q] = *(const GAS f32x4*)(Wr + (size_t)d * NEXP + 4 * e4); }
    __syncthreads();
    constexpr int R = 4;
    const GAS f32x4* gr = (const GAS f32x4*)g + lane;
#pragma unroll 1
    for (int m0 = gw * R; m0 < M_TOK; m0 += NGW * R) {
        int lo_ = lane; asm volatile("" : "+v"(lo_));
        f32x4 v[R][4]; float rstd[R];
#pragma unroll
        for (int r = 0; r < R; ++r) { const GAS f32x4* xr = (const GAS f32x4*)(H + (size_t)(m0 + r) * DM) + lane;
#pragma unroll
            for (int j = 0; j < 4; ++j) v[r][j] = xr[64 * j]; }
#pragma unroll
        for (int r = 0; r < R; ++r) { float s = 0.f;
#pragma unroll
            for (int j = 0; j < 4; ++j) s += (v[r][j].x * v[r][j].x + v[r][j].y * v[r][j].y) + (v[r][j].z * v[r][j].z + v[r][j].w * v[r][j].w);
            rstd[r] = 1.f / sqrtf(wave_sum(s) * (1.f / DM) + NORM_EPS); }
        f32x4 lg[R][4];
#pragma unroll
        for (int r = 0; r < R; ++r)
#pragma unroll
            for (int e4 = 0; e4 < 4; ++e4) lg[r][e4] = (f32x4){0.f, 0.f, 0.f, 0.f};
#pragma unroll
        for (int j = 0; j < 4; ++j) { const f32x4 gg = gr[64 * j];
#pragma unroll
            for (int r = 0; r < R; ++r) { v[r][j] = v[r][j] * rstd[r] * gg;
                unsigned w = 0; w = __builtin_amdgcn_cvt_pk_fp8_f32(v[r][j].x, v[r][j].y, w, false); w = __builtin_amdgcn_cvt_pk_fp8_f32(v[r][j].z, v[r][j].w, w, true);
                ((GAS unsigned*)(XN8 + (size_t)(m0 + r) * DM) + lane)[64 * j] = w; }
#pragma unroll
            for (int i = 0; i < 4; ++i)
#pragma unroll
                for (int e4 = 0; e4 < 4; ++e4) { const f32x4 wv = WL[((j * 4 + i) * 4 + e4) * 64 + lo_];
#pragma unroll
                    for (int r = 0; r < R; ++r) { const float xs = v[r][j][i];
#pragma unroll
                        for (int c = 0; c < 4; ++c) asm("v_fmac_f32 %0, %1, %2" : "+v"(lg[r][e4][c]) : "v"(wv[c]), "v"(xs)); } }
            __builtin_amdgcn_sched_barrier(0); }
#pragma unroll
        for (int r = 0; r < R; ++r) {
            float l16[16];
#pragma unroll
            for (int e = 0; e < 16; ++e) l16[e] = wave_sum(lg[r][e >> 2][e & 3]);
            float mx = l16[0];
#pragma unroll
            for (int e = 1; e < 16; ++e) mx = fmaxf(mx, l16[e]);
            float den = 0.f;
#pragma unroll
            for (int e = 0; e < 16; ++e) { l16[e] = expf(l16[e] - mx); den += l16[e]; }
            float mine = 0.f;
#pragma unroll
            for (int e = 0; e < 16; ++e) mine = (lane == e) ? l16[e] : mine;
            const int m = m0 + r, b = m / SEQ, t = m % SEQ;
            if (lane < NEXP) AFF[(size_t)(b * NEXP + lane) * SEQ + t] = mine / den;
        }
    }
    __syncthreads();
}

__device__ __forceinline__ void phase_router_sum(const float* PLG, const float* PSS, float* RSTD, float* AFF, int gw, int NGW, int lane) {
    const int e = lane & 15, rq = lane >> 4;
    for (int m0 = gw * 4; m0 < M_TOK; m0 += NGW * 4) {
        const int m = m0 + rq;
        float lgt = 0.f;
#pragma unroll
        for (int slot = 0; slot < 16; ++slot) lgt += PLG[((size_t)slot * M_TOK + m) * 16 + e];
        float ss = PSS[(size_t)e * M_TOK + m];
#pragma unroll
        for (int o = 1; o < 16; o <<= 1) ss += __shfl_xor(ss, o);
        const float rstd = 1.f / sqrtf(ss * (1.f / DM) + NORM_EPS);
        lgt *= rstd;
        float mx = lgt;
#pragma unroll
        for (int o = 1; o < 16; o <<= 1) mx = fmaxf(mx, __shfl_xor(mx, o));
        const float ex = expf(lgt - mx); float den = ex;
#pragma unroll
        for (int o = 1; o < 16; o <<= 1) den += __shfl_xor(den, o);
        const int b = m / SEQ, t = m % SEQ;
        AFF[(size_t)(b * NEXP + e) * SEQ + t] = ex / den;
        if (e == 0) RSTD[m] = rstd;
    }
}

__device__ __forceinline__ int block_excl_scan(int v, LAS int* scr, int tid, int lane, int wave, int* tot) {
    int inc = v;
#pragma unroll
    for (int o = 1; o < 64; o <<= 1) { const int n = __shfl_up(inc, o); if (lane >= o) inc += n; }
    __syncthreads();
    if (lane == 63) scr[wave] = inc;
    __syncthreads();
    int base = 0, total = 0;
#pragma unroll
    for (int w = 0; w < NWAVES; ++w) { const int c = scr[w]; if (w < wave) base += c; total += c; }
    *tot = total;
    return base + inc - v;
}

__device__ __forceinline__ void phase_topk(const float* AFF, const float* RSTD, float* RS, int* IDX, float* GATE, int* POS, LAS unsigned char* ldsm, int blk, int nblk, int tid, int lane, int wave) {
    LAS int* hist = (LAS int*)ldsm;
    LAS int* sel = (LAS int*)(ldsm + 1024);
    LAS int* scr = (LAS int*)(ldsm + 1280);
    for (int g = blk; g < NGRP; g += nblk) {
        unsigned v[16];
        { const GAS v4u* src = (const GAS v4u*)(AFF + (size_t)g * SEQ) + tid * 4;
#pragma unroll
          for (int q = 0; q < 4; ++q) { const v4u w = src[q]; v[4 * q] = w.x; v[4 * q + 1] = w.y; v[4 * q + 2] = w.z; v[4 * q + 3] = w.w; } }
        unsigned prefix = 0u; int krem = CAP;
#pragma unroll 1
        for (int pass = 0; pass < 4; ++pass) {
            const int shift = 24 - 8 * pass;
            const unsigned himask = (pass == 0) ? 0u : (0xffffffffu << (shift + 8));
            __syncthreads();
            if (tid < 256) hist[tid] = 0;
            __syncthreads();
#pragma unroll
            for (int i = 0; i < 16; ++i) if ((v[i] & himask) == prefix) __hip_atomic_fetch_add(hist + ((v[i] >> shift) & 255u), 1, __ATOMIC_RELAXED, __HIP_MEMORY_SCOPE_WORKGROUP);
            __syncthreads();
            if (wave == 0) {
                int c[4]; int s = 0;
#pragma unroll
                for (int j = 0; j < 4; ++j) { c[j] = hist[255 - 4 * lane - j]; s += c[j]; }
                int inc = s;
#pragma unroll
                for (int o = 1; o < 64; o <<= 1) { const int n = __shfl_up(inc, o); if (lane >= o) inc += n; }
                int before = inc - s;
                if (before < krem && krem <= inc) {
                    int bin = 0, kk = krem - before; bool done = false;
#pragma unroll
                    for (int j = 0; j < 4; ++j) { if (!done) { if (kk <= c[j]) { bin = 255 - 4 * lane - j; done = true; } else kk -= c[j]; } }
                    sel[0] = bin; sel[1] = kk;
                }
            }
            __syncthreads();
            prefix |= ((unsigned)sel[0]) << shift; krem = sel[1];
        }
        int ceq = 0;
#pragma unroll
        for (int i = 0; i < 16; ++i) ceq += (v[i] == prefix) ? 1 : 0;
        int tot;
        int eqrank = block_excl_scan(ceq, scr, tid, lane, wave, &tot);
        int csel = 0; unsigned selmask = 0u;
#pragma unroll
        for (int i = 0; i < 16; ++i) { bool s = v[i] > prefix; if (v[i] == prefix) { s = eqrank < krem; ++eqrank; } if (s) { selmask |= 1u << i; ++csel; } }
        int slot = block_excl_scan(csel, scr, tid, lane, wave, &tot);
        const int b = g / NEXP;
        int pv[16];
#pragma unroll
        for (int i = 0; i < 16; ++i) {
            pv[i] = -1;
            if (selmask & (1u << i)) { pv[i] = slot; IDX[g * CAP + slot] = b * SEQ + tid * 16 + i; GATE[g * CAP + slot] = __builtin_bit_cast(float, v[i]); RS[g * CAP + slot] = RSTD[b * SEQ + tid * 16 + i]; ++slot; }
        }
        { GAS v4u* dst = (GAS v4u*)(POS + (size_t)g * SEQ) + tid * 4;
#pragma unroll
          for (int q = 0; q < 4; ++q) { v4u w; w.x = (unsigned)pv[4 * q]; w.y = (unsigned)pv[4 * q + 1]; w.z = (unsigned)pv[4 * q + 2]; w.w = (unsigned)pv[4 * q + 3]; dst[q] = w; } }
        __syncthreads();
    }
}

__device__ __forceinline__ void phase_gather(const bf16* XN, const int* IDX, bf16* XG, int gw, int NGW, int lane) {
    for (int r = gw; r < XROWS; r += NGW) {
        const int src = __builtin_amdgcn_readfirstlane(IDX[r]);
        const GAS v4u* s = (const GAS v4u*)(XN + (size_t)src * DM) + lane; GAS v4u* d = (GAS v4u*)(XG + (size_t)r * DM) + lane;
        const v4u a = s[0], b = s[64]; d[0] = a; d[64] = b;
    }
}

__device__ __forceinline__ void phase_qk_rope(bf16* P, const float* gq, const float* gk, int gw, int NGW, int lane) {
    const int hh = lane >> 2, part = lane & 3, axis = part >> 1, half = part & 1;
    const float* g = (hh < NQH ? gq : gk) + 16 * part;
    float gv[16], inv[16];
#pragma unroll
    for (int i = 0; i < 16; ++i) { gv[i] = g[i]; inv[i] = exp2f(-(float)i * (13.287712379549449f / 16.0f)); }
    const float osc = hh < NQH ? ATT_C2 : 1.0f;
    int m = gw; v4u c0 = (v4u){0u, 0u, 0u, 0u}, c1 = c0;
    if (m < M_TOK) { const GAS v4u* p = (const GAS v4u*)(P + (size_t)m * D_IN_AT + hh * HD + 16 * part); c0 = p[0]; c1 = p[1]; }
#pragma unroll 1
    for (; m < M_TOK; m += NGW) {
        const int t = m % SEQ; const float pos = (float)(axis == 0 ? (t >> 6) : (t & 63));
        GAS v4u* p = (GAS v4u*)(P + (size_t)m * D_IN_AT + hh * HD + 16 * part);
        const v4u w0 = c0, w1 = c1;
        if (m + NGW < M_TOK) { const GAS v4u* pn = (const GAS v4u*)(P + (size_t)(m + NGW) * D_IN_AT + hh * HD + 16 * part); c0 = pn[0]; c1 = pn[1]; }
        float x[16];
        x[0] = bflo(w0.x); x[1] = bfhi(w0.x); x[2] = bflo(w0.y); x[3] = bfhi(w0.y); x[4] = bflo(w0.z); x[5] = bfhi(w0.z); x[6] = bflo(w0.w); x[7] = bfhi(w0.w);
        x[8] = bflo(w1.x); x[9] = bfhi(w1.x); x[10] = bflo(w1.y); x[11] = bfhi(w1.y); x[12] = bflo(w1.z); x[13] = bfhi(w1.z); x[14] = bflo(w1.w); x[15] = bfhi(w1.w);
        float ss = 0.f;
#pragma unroll
        for (int i = 0; i < 16; ++i) ss += x[i] * x[i];
        ss += __shfl_xor(ss, 1); ss += __shfl_xor(ss, 2);
        const float rstd = 1.f / sqrtf(ss * (1.f / HD) + NORM_EPS);
        float o[16];
#pragma unroll
        for (int i = 0; i < 16; ++i) {
            const float xn = x[i] * rstd * gv[i]; const float xp = __shfl_xor(xn, 1);
            float sn, cs; sincosf(pos * inv[i], &sn, &cs);
            o[i] = (half == 0 ? (xn * cs - xp * sn) : (xp * sn + xn * cs)) * osc;
        }
        v4u r0, r1;
        r0.x = pk2(o[0], o[1]); r0.y = pk2(o[2], o[3]); r0.z = pk2(o[4], o[5]); r0.w = pk2(o[6], o[7]);
        r1.x = pk2(o[8], o[9]); r1.y = pk2(o[10], o[11]); r1.z = pk2(o[12], o[13]); r1.w = pk2(o[14], o[15]);
        p[0] = r0; p[1] = r1;
    }
}

__device__ __forceinline__ void phase_transpose_mix(const bf16* MIXT, bf16* MIX, LAS unsigned char* lds, int blk, int nblk, int tid) {
    constexpr int TP = 516;
    for (int it = blk; it < (D_MAIN / 64) * (M_TOK / 256); it += nblk) {
        const int cb = it % (D_MAIN / 64), mb = it / (D_MAIN / 64), c0 = cb * 64, m0 = mb * 256;
        __syncthreads();
#pragma unroll
        for (int k = 0; k < 4; ++k) { const int p = tid + NTHREADS * k, ch = p >> 5, seg = p & 31;
            const v4u w = *(const GAS v4u*)(MIXT + (size_t)(c0 + ch) * M_TOK + m0 + seg * 8);
            LAS unsigned* d = (LAS unsigned*)(lds + ch * TP + seg * 16); d[0] = w.x; d[1] = w.y; d[2] = w.z; d[3] = w.w; }
        __syncthreads();
#pragma unroll
        for (int k = 0; k < 4; ++k) { const int q = tid + NTHREADS * k, r = q >> 3, j = q & 7;
            const LAS bf16* s = (const LAS bf16*)(lds + (8 * j) * TP) + r;
            v4u o; o.x = (unsigned)s[0] | ((unsigned)s[TP / 2] << 16); o.y = (unsigned)s[2 * (TP / 2)] | ((unsigned)s[3 * (TP / 2)] << 16);
            o.z = (unsigned)s[4 * (TP / 2)] | ((unsigned)s[5 * (TP / 2)] << 16); o.w = (unsigned)s[6 * (TP / 2)] | ((unsigned)s[7 * (TP / 2)] << 16);
            *(GAS v4u*)(MIX + (size_t)(m0 + r) * DM + c0 + 8 * j) = o; }
    }
    __syncthreads();
}
__device__ __forceinline__ void phase_taps(const float* H2j, const float* w3, float* TAPS, int gw, int NGW, int lane) {
    typedef float f32x16 __attribute__((ext_vector_type(16))); typedef short bf16x8_t __attribute__((ext_vector_type(8)));
    const float min_decay = -4.605170185988091f / 1.5f, max_decay = -4.605170185988091f / 0.3f;
    const int li = lane & 31, hi = lane >> 5;
#pragma unroll 1
    for (int it = gw; it < (FCOLS / 32) * (SEQ / 128); it += NGW) {
        const int ct = it % (FCOLS / 32), ng = it / (FCOLS / 32), col0 = ct * 32;
        bf16x8_t a[4];
#pragma unroll
        for (int s = 0; s < 4; ++s) { float t[8];
#pragma unroll
            for (int j = 0; j < 8; ++j) t[j] = w3[(size_t)(16 * s + 8 * hi + j) * FCOLS + col0 + li];
            v4u p; p.x = pk2(t[0], t[1]); p.y = pk2(t[2], t[3]); p.z = pk2(t[4], t[5]); p.w = pk2(t[6], t[7]); a[s] = __builtin_bit_cast(bf16x8_t, p); }
        f32x4 hv[4][8];
#pragma unroll
        for (int nt = 0; nt < 4; ++nt) { const GAS f32x4* hp = (const GAS f32x4*)(H2j + (size_t)(ng * 128 + nt * 32 + li) * HY_FILT + 8 * hi);
#pragma unroll
            for (int s = 0; s < 4; ++s) { hv[nt][2 * s] = hp[4 * s]; hv[nt][2 * s + 1] = hp[4 * s + 1]; } }
#pragma unroll
        for (int nt = 0; nt < 4; ++nt) {
            const int n0 = ng * 128 + nt * 32;
            f32x16 acc;
#pragma unroll
            for (int r = 0; r < 16; ++r) acc[r] = 0.f;
#pragma unroll
            for (int s = 0; s < 4; ++s) { const f32x4 v0 = hv[nt][2 * s], v1 = hv[nt][2 * s + 1];
                v4u p; p.x = pk2(v0.x, v0.y); p.y = pk2(v0.z, v0.w); p.z = pk2(v1.x, v1.y); p.w = pk2(v1.z, v1.w);
                acc = __builtin_amdgcn_mfma_f32_32x32x16_bf16(a[s], __builtin_bit_cast(bf16x8_t, p), acc, 0, 0, 0); }
            const float t = (float)(n0 + li) * (1.0f / (float)(SEQ - 1));
#pragma unroll
            for (int r = 0; r < 16; ++r) { const int col = col0 + (r & 3) + 8 * (r >> 2) + 4 * hi, c = col % D_MAIN;
                const float ad = fabsf(min_decay + (float)c * ((max_decay - min_decay) / (float)(D_MAIN - 1)));
                TAPS[(size_t)col * SEQ + n0 + li] = acc[r] * expf(-t * ad); }
        }
    }
}

__device__ __forceinline__ constexpr float twc(int k) { constexpr float T[16] = {1.0f, 0.98078528040323043f, 0.92387953251128674f, 0.83146961230254524f, 0.70710678118654757f, 0.55557023301960218f, 0.38268343236508978f, 0.19509032201612825f,
    0.0f, -0.19509032201612825f, -0.38268343236508978f, -0.55557023301960218f, -0.70710678118654757f, -0.83146961230254524f, -0.92387953251128674f, -0.98078528040323043f}; return T[k]; }
__device__ __forceinline__ constexpr float tws(int k) { constexpr float T[16] = {0.0f, 0.19509032201612825f, 0.38268343236508978f, 0.55557023301960218f, 0.70710678118654757f, 0.83146961230254524f, 0.92387953251128674f, 0.98078528040323043f,
    1.0f, 0.98078528040323043f, 0.92387953251128674f, 0.83146961230254524f, 0.70710678118654757f, 0.55557023301960218f, 0.38268343236508978f, 0.19509032201612825f}; return T[k]; }
__device__ __forceinline__ constexpr int bitrev(int i, int bits) { int r = 0; for (int b = 0; b < bits; ++b) if (i & (1 << b)) r |= 1 << (bits - 1 - b); return r; }

template <int N, int LEN> struct FftStage {
    static __device__ __forceinline__ void run(float (&re)[N], float (&im)[N]) {
        constexpr int half = LEN / 2, step = 32 / LEN;
#pragma unroll
        for (int base = 0; base < N; base += LEN)
#pragma unroll
            for (int j = 0; j < half; ++j) {
                const int i0 = base + j, i1 = i0 + half, idx = j * step;
                const float ar = re[i0], ai = im[i0], br = re[i1], bi = im[i1];
                re[i0] = ar + br; im[i0] = ai + bi;
                const float dr = ar - br, di = ai - bi;
                if (idx == 0) { re[i1] = dr; im[i1] = di; }
                else if (idx == 8) { re[i1] = di; im[i1] = -dr; }
                else { const float c = twc(idx), s = tws(idx); re[i1] = dr * c + di * s; im[i1] = di * c - dr * s; }
            }
        if constexpr (LEN > 2) FftStage<N, LEN / 2>::run(re, im);
    }
};
template <int N, int BITS> __device__ __forceinline__ void fft_reg(float (&re)[N], float (&im)[N]) {
    FftStage<N, N>::run(re, im);
    float tr[N], ti[N];
#pragma unroll
    for (int i = 0; i < N; ++i) { tr[bitrev(i, BITS)] = re[i]; ti[bitrev(i, BITS)] = im[i]; }
#pragma unroll
    for (int i = 0; i < N; ++i) { re[i] = tr[i]; im[i] = ti[i]; }
}

template <int N, int LEN> struct FftStageC {
    static __device__ __forceinline__ void run(f32x2 (&x)[N]) {
        constexpr int half = LEN / 2, step = 32 / LEN;
#pragma unroll
        for (int base = 0; base < N; base += LEN)
#pragma unroll
            for (int j = 0; j < half; ++j) {
                const int i0 = base + j, i1 = i0 + half, idx = j * step;
                const f32x2 a = x[i0], b = x[i1];
                x[i0] = a + b;
                const f32x2 d = a - b;
                if (idx == 0) x[i1] = d;
                else if (idx == 8) x[i1] = (f32x2){d.y, -d.x};
                else { const float c = twc(idx), s = tws(idx); const f32x2 t = (f32x2){d.y, -d.x}; x[i1] = d * c + t * s; }
            }
        if constexpr (LEN > 2) FftStageC<N, LEN / 2>::run(x);
    }
};
template <int N, int BITS> __device__ __forceinline__ void fft_regc(f32x2 (&x)[N]) {
    FftStageC<N, N>::run(x);
    f32x2 t[N];
#pragma unroll
    for (int i = 0; i < N; ++i) t[bitrev(i, BITS)] = x[i];
#pragma unroll
    for (int i = 0; i < N; ++i) x[i] = t[i];
}
__device__ __forceinline__ void fft16k_c(f32x2 (&x)[32], LAS f32x2* L, int tid_in) {
    int tid = tid_in; asm volatile("" : "+v"(tid));
    fft_regc<32, 5>(x);
#pragma unroll
    for (int k1 = 1; k1 < 32; ++k1) { const float fr = (float)((tid * k1) & 16383) * (1.0f / 16384.0f); const float c = __builtin_amdgcn_cosf(fr), s = __builtin_amdgcn_sinf(fr);
        const f32x2 d = x[k1], t = (f32x2){d.y, -d.x}; x[k1] = d * c + t * s; if ((k1 & 3) == 3) __builtin_amdgcn_sched_barrier(0); }
#pragma unroll
    for (int k1 = 0; k1 < 32; ++k1) L[k1 * 513 + tid] = x[k1];
    __syncthreads();
    const int n3 = tid & 31, ka = tid >> 5;
    f32x2 a[16], b[16];
#pragma unroll
    for (int n2 = 0; n2 < 16; ++n2) { a[n2] = L[ka * 513 + n2 * 32 + n3]; b[n2] = L[(ka + 16) * 513 + n2 * 32 + n3]; }
    fft_regc<16, 4>(a); fft_regc<16, 4>(b);
#pragma unroll
    for (int k2 = 1; k2 < 16; ++k2) { const float fr = (float)((n3 * k2) & 511) * (1.0f / 512.0f); const float c = __builtin_amdgcn_cosf(fr), s = __builtin_amdgcn_sinf(fr);
        f32x2 d = a[k2], t = (f32x2){d.y, -d.x}; a[k2] = d * c + t * s; d = b[k2]; t = (f32x2){d.y, -d.x}; b[k2] = d * c + t * s; if ((k2 & 3) == 3) __builtin_amdgcn_sched_barrier(0); }
    __syncthreads();
#pragma unroll
    for (int k2 = 0; k2 < 16; ++k2) { L[n3 * 513 + k2 * 32 + ka] = a[k2]; L[n3 * 513 + k2 * 32 + ka + 16] = b[k2]; }
    __syncthreads();
#pragma unroll
    for (int q = 0; q < 32; ++q) x[q] = L[q * 513 + tid];
    fft_regc<32, 5>(x);
}
__device__ __forceinline__ void fft16k(float (&re)[32], float (&im)[32], LAS f32x2* L, int tid) {
    f32x2 x[32];
#pragma unroll
    for (int r = 0; r < 32; ++r) x[r] = (f32x2){re[r], im[r]};
    fft16k_c(x, L, tid);
#pragma unroll
    for (int r = 0; r < 32; ++r) { re[r] = x[r].x; im[r] = x[r].y; }
}

constexpr int HS_SP = SEQ + 16;
__device__ __forceinline__ void hy_stage(LAS bf16* S, int slot, const bf16* src, int tid) {
    LAS bf16* d = S + slot * HS_SP + 8;
    if (tid == 0) { d[-1] = 0; d[SEQ] = 0; }
#pragma unroll
    for (int q = 0; q < 2; ++q) { const int ch = q * NTHREADS + tid; *(LAS v4u*)(d + ch * 8) = *(const GAS v4u*)(src + ch * 8); }
}
__device__ __forceinline__ float hy_sc(const LAS bf16* S, int slot, int t, float w0, float w1, float w2) {
    const LAS bf16* p = S + slot * HS_SP + 8 + t;
    return bf2f(p[-1]) * w0 + bf2f(p[0]) * w1 + bf2f(p[1]) * w2;
}

#ifdef CSEL
#define CT(sec) do { const unsigned long long tn_ = __builtin_amdgcn_s_memrealtime(); if (csec_ == CSEL) ctime_ += tn_ - ct0_; ct0_ = tn_; csec_ = (sec); } while (0)
#else
#define CT(sec)
#endif
__device__ __forceinline__ void phase_hyena_conv(const bf16* PT, const float* TAPS, const float* shortw, const float* skip, f32x2* XSall, f32x2* ZSall, bf16* MIXT,
                                                 LAS unsigned char* lds, int blk, int nblk, int tid_in, int lane, int wave, int pmode = 0) {
    LAS f32x2* L = (LAS f32x2*)lds; LAS bf16* S = (LAS bf16*)lds; LAS float* red = (LAS float*)(lds + LDS_MISC);
    f32x2* XK0 = XSall + (size_t)blk * 16384;
    f32x2* XK1 = XK0 + 16384 * 256; f32x2* ZS = ZSall + (size_t)blk * 16384;
    constexpr int N = 16384;
#ifdef CSEL
    unsigned long long ctime_ = 0ull, ct0_ = __builtin_amdgcn_s_memrealtime(); int csec_ = -1;
#endif
#pragma unroll 1
    for (int c = blk; c < D_MAIN; c += nblk) {
        f32x2 x[32]; float vr[16], vi[16];
#pragma unroll 1
        for (int pass = 0; pass < 5; ++pass) {
            int tid = tid_in; asm volatile("" : "+v"(tid));
            CT(pass == 0 ? 0 : (pass == 1 ? 7 : 8));
            if (pass == 0) {
                const float* hf0 = TAPS + (size_t)c * SEQ; const float* hb0 = TAPS + (size_t)(D_MAIN + c) * SEQ;
                const float* hf1 = TAPS + (size_t)(2 * D_MAIN + c) * SEQ; const float* hb1 = TAPS + (size_t)(3 * D_MAIN + c) * SEQ;
#pragma unroll
                for (int r = 0; r < 16; ++r) { const int n = r * 512 + tid; x[r].x = hf0[n]; x[r].y = hf1[n]; }
#pragma unroll
                for (int r = 16; r < 32; ++r) { const int idx = (32 - r) * 512 - tid; const bool z = (idx == SEQ); const int ii = z ? 0 : idx; x[r].x = z ? 0.f : hb0[ii]; x[r].y = z ? 0.f : hb1[ii]; }
                float e0 = 0.f, e1 = 0.f;
                if (tid == 0) { e0 = hb0[0]; e1 = hb1[0]; }
                float s0 = fabsf(e0), s1 = fabsf(e1);
#pragma unroll
                for (int r = 0; r < 32; ++r) { s0 += fabsf(x[r].x); s1 += fabsf(x[r].y); }
                s0 = wave_sum(s0); s1 = wave_sum(s1);
                __syncthreads();
                if (lane == 0) { red[wave] = s0; red[8 + wave] = s1; }
                __syncthreads();
                float t0 = 0.f, t1 = 0.f;
#pragma unroll
                for (int w = 0; w < NWAVES; ++w) { t0 += red[w]; t1 += red[8 + w]; }
                const float sc0 = 1.0f / (t0 + 1e-6f), sc1 = 1.0f / (t1 + 1e-6f);
                x[0].x += e0; x[0].y += e1;
#pragma unroll
                for (int r = 0; r < 32; ++r) { x[r].x *= sc0; x[r].y *= sc1; }
            } else if (pass == 1) {
                __syncthreads();
                const bf16* pv = PT + (size_t)(2 * D_MAIN + c) * M_TOK; const float wv[3] = {shortw[2 * D_MAIN + c], shortw[2304 + 2 * D_MAIN + c], shortw[4608 + 2 * D_MAIN + c]};
                hy_stage(S, 0, pv, tid); hy_stage(S, 1, pv + SEQ, tid);
                __syncthreads();
#pragma unroll
                for (int r = 0; r < 16; ++r) { const int t = r * 512 + tid; x[r].x = hy_sc(S, 0, t, wv[0], wv[1], wv[2]); x[r].y = hy_sc(S, 1, t, wv[0], wv[1], wv[2]); vr[r] = x[r].x; vi[r] = x[r].y; }
#pragma unroll
                for (int r = 16; r < 32; ++r) { x[r].x = 0.f; x[r].y = 0.f; }
            }
            __syncthreads();
            CT(1);
            fft16k_c(x, L, tid);
            CT(2 + pass);
            if (pass == 0) {
                __syncthreads();
#pragma unroll
                for (int r = 0; r < 32; ++r) L[r * 513 + tid] = x[r];
                __syncthreads();
                const int tp = (512 - tid) & 511;
#pragma unroll
                for (int r = 0; r < 32; ++r) { const int rp = (tid == 0) ? ((32 - r) & 31) : (31 - r);
                    const f32x2 xa = x[r], xb = L[rp * 513 + tp]; const float sc_ = 0.5f / (float)N;
                    XK0[r * 512 + tid] = (f32x2){(xa.x + xb.x) * sc_, (xa.y - xb.y) * sc_};
                    XK1[r * 512 + tid] = (f32x2){(xa.y + xb.y) * sc_, (xb.x - xa.x) * sc_}; if ((r & 7) == 7) __builtin_amdgcn_sched_barrier(0); }
            } else if (pass == 1 || pass == 3) {
                const f32x2* XK = (pass == 1) ? XK0 : XK1;
#pragma unroll
                for (int r = 0; r < 32; ++r) { const f32x2 k = XK[r * 512 + tid]; const float zr_ = x[r].x, zi_ = x[r].y;
                    x[r].x = zr_ * k.x - zi_ * k.y; x[r].y = -(zr_ * k.y + zi_ * k.x); }
            } else if (pass == 2) {
                __syncthreads();
                const bf16* px1 = PT + (size_t)c * M_TOK; const float sk0 = skip[c]; const float wx1[3] = {shortw[c], shortw[2304 + c], shortw[4608 + c]};
                hy_stage(S, 2, px1, tid); hy_stage(S, 3, px1 + SEQ, tid);
                __syncthreads();
#pragma unroll
                for (int r = 0; r < 16; ++r) { const int t = r * 512 + tid;
                    const float v0 = vr[r], v1 = vi[r];
                    const float g0 = hy_sc(S, 2, t, wx1[0], wx1[1], wx1[2]), g1 = hy_sc(S, 3, t, wx1[0], wx1[1], wx1[2]);
                    x[r].x = g0 * (x[r].x + sk0 * v0); x[r].y = g1 * (-x[r].y + sk0 * v1); ZS[t] = (f32x2){x[r].x, x[r].y}; }
#pragma unroll
                for (int r = 16; r < 32; ++r) { x[r].x = 0.f; x[r].y = 0.f; }
            } else {
                __syncthreads();
                const bf16* px2 = PT + (size_t)(D_MAIN + c) * M_TOK; const float sk1 = skip[D_MAIN + c];
                const float wx2[3] = {shortw[D_MAIN + c], shortw[2304 + D_MAIN + c], shortw[4608 + D_MAIN + c]};
                hy_stage(S, 0, px2, tid); hy_stage(S, 1, px2 + SEQ, tid);
                __syncthreads();
#pragma unroll
                for (int r = 0; r < 16; ++r) { const int t = r * 512 + tid;
                    const float g0 = hy_sc(S, 0, t, wx2[0], wx2[1], wx2[2]), g1 = hy_sc(S, 1, t, wx2[0], wx2[1], wx2[2]);
                    const f32x2 z = ZS[t];
                    const float o0 = g0 * (x[r].x + sk1 * z.x), o1 = g1 * (-x[r].y + sk1 * z.y);
                    MIXT[(size_t)c * M_TOK + t] = (bf16)f2bf(o0); MIXT[(size_t)c * M_TOK + SEQ + t] = (bf16)f2bf(o1); }
            }
        }
        CT(-1);
        __syncthreads();
    }
#ifdef CSEL
    if (blk == 0 && tid_in == 0) *(unsigned long long*)((unsigned char*)XSall - WS_FFTX + 32768) += ctime_;
#endif
}
#ifndef MK_PER_PHASE
#define MK_PER_PHASE 0
#endif
#ifndef CONV_PMODE
#define CONV_PMODE 0
#endif
#ifndef REPMASK
#define REPMASK 0u
#endif
#define REP(kind) _Pragma("unroll 1") for (int r_ = 0; r_ < 1 + (int)((REPMASK >> (kind)) & 1u); ++r_)
struct Args {
    const float* in[24]; float* out; unsigned char* ws; int ph_lo, ph_hi;
};
constexpr int N_PHASES = 1 + (DEPTH - 1) + DEPTH * 8 - DEPTH / 2 + 1;

template <int QP, int KP>
__device__ __forceinline__ void run_attn(const bf16* Q, const bf16* K, const bf16* V, bf16* O, int NT, char* shm) {
    attn_body::attn_unit<8, QP, KP, DM>((const attn_body::bf16*)Q, (const attn_body::bf16*)K, (const attn_body::bf16*)V, (attn_body::bf16*)O, NT, shm);
}

__global__ void __launch_bounds__(NTHREADS, 2) hybrid_fwd(Args args) {
    extern __shared__ __attribute__((aligned(16))) unsigned char lds_raw[];
    LAS unsigned char* lds = (LAS unsigned char*)lds_raw;
    const int G = gridDim.x, bx = blockIdx.x;
    const int vcu = (G % 8 == 0) ? (bx % 8) * (G / 8) + bx / 8 : bx;
    const int NGW = G * NWAVES;
    unsigned char* ws = args.ws;
    const float* x = args.in[0]; const float* mem = args.in[1]; const float* mix_g = args.in[2]; const float* ffn_g = args.in[3]; const float* mem_g = args.in[4]; const float* fin_g = args.in[5];
    const float* hy_short = args.in[9]; const float* f_w1 = args.in[10]; const float* f_b1 = args.in[11]; const float* f_w2 = args.in[12]; const float* f_b2 = args.in[13];
    const float* f_w3 = args.in[14]; const float* f_freq = args.in[15]; const float* hy_skip = args.in[16]; const float* qg = args.in[18]; const float* kg = args.in[19]; const float* router = args.in[20];
    float* H = args.out;
    bf16* U = (bf16*)(ws + WS_U); bf16* PROJ = (bf16*)(ws + WS_PROJ); bf16* CQ = (bf16*)(ws + WS_CQ); bf16* MIX = (bf16*)(ws + WS_MIX); bf16* MIXT = (bf16*)(ws + WS_MIXT);
    float* AFF = (float*)(ws + WS_AFF); int* IDX = (int*)(ws + WS_IDX); float* GATE = (float*)(ws + WS_GATE); int* POS = (int*)(ws + WS_POS);
    bf16* XG = (bf16*)(ws + WS_XG); bf16* HID = (bf16*)(ws + WS_HID); bf16* Y = (bf16*)(ws + WS_Y); float* TAPS = (float*)(ws + WS_TAPS);
    const bf16* MKV = (const bf16*)(ws + WS_MKV);
    cg::grid_group grid = cg::this_grid();
    volatile LAS unsigned* bst = (volatile LAS unsigned*)(lds + LDS_MISC + 4096);
    if (threadIdx.x < 2) bst[threadIdx.x] = 0u;
    __syncthreads();
    XcdBarrier xbar = xcd_barrier_post((unsigned*)(ws + WS_CTL) + 1024, bst);
    const int lo = args.ph_lo, hi = args.ph_hi;
    const XwIn XW{args.in[21], args.in[22], args.in[23], ws}; const bool xw_sched = (G == 256);
    int ph = 0;
#ifdef TSEL
    unsigned long long tacc_ = 0ull, t0_ = 0ull, t1_ = 0ull; int pk_ = 0, tpar_ = 0;
#endif
#ifdef TSEL
#ifndef TAMP
#define TAMP 10
#endif
#ifndef TBAR
#define TBAR 0
#endif
#define PH_T0(k) pk_ = (k); t0_ = __builtin_amdgcn_s_memrealtime();
#ifndef TPAR
#define TPAR -1
#endif
#define PH_T1 t1_ = __builtin_amdgcn_s_memrealtime(); if (!TBAR && (pk_ == TSEL || TSEL == 99) && (TPAR < 0 || tpar_ == TPAR)) tacc_ += t1_ - t0_;
#define PH_T2 if (TBAR && (pk_ == TSEL || TSEL == 99)) tacc_ += __builtin_amdgcn_s_memrealtime() - t1_;
#else
#define PH_T0(k)
#define PH_T1
#define PH_T2
#endif
#define PHASE_BEGINK(k) PH_T0(k) if (lo <= ph && ph < hi) { const int tid = opaque_tid(), lane = tid & 63, wave = __builtin_amdgcn_readfirstlane(tid >> 6), gw = vcu * NWAVES + wave; (void)lane; (void)gw;
#ifdef EXTRA_XBAR
#define PHASE_END   if (ph + 1 < hi) { if (ph == lo) grid.sync(); else { xcd_barrier(xbar); if (ph < EXTRA_XBAR) xcd_barrier(xbar); } } } ++ph;
#else
#define PHASE_END   PH_T1 if (ph + 1 < hi) { if (ph == lo) grid.sync(); else xcd_barrier(xbar); } PH_T2 } ++ph;
#endif

    PHASE_BEGINK(0)
        ProIn P{args.in[8], args.in[17], args.in[7], args.in[6]};
        REP(0) { phase_weights(P, ws, lds, gw, NGW, wave, lane); phase_xw_p0(XW, xw_sched, (LAS float*)(lds + wave * 16384), gw, NGW, lane); }
        phase_wrg(ffn_g, router, (float*)(ws + WS_WRG), (int)(bx * NTHREADS + tid), (int)(G * NTHREADS));
        REP(1) phase_mem_h2(mem, mem_g, f_w1, f_b1, f_w2, f_b2, f_freq, ws, gw, NGW, lane);
        REP(3) phase_norm<false, false>(x, nullptr, mix_g, U, nullptr, nullptr, nullptr, gw, NGW, lane);
    PHASE_END

#pragma unroll 1
    for (int i = 0; i < DEPTH; ++i) {
        const bool hy = (i & 1) == 0; const int j = i >> 1;
#ifdef TSEL
        tpar_ = i & 1;
#endif
        if (i > 0) {
        PHASE_BEGINK(1)
            phase_norm<true, false>(H, H, mix_g + i * DM, U, nullptr, POS, Y, gw, NGW, lane);
        PHASE_END
        }
        PHASE_BEGINK(2)
            if (i == 0) {
                pg8::Gemm g{(const bf16*)(ws + WS_MEMN), (const bf16*)(ws + WS_WMKV), BATCH * MEM_LEN, 2048, DM, 1 << 30, 1, 0};
                pg8::StaticOrder S; S.init(BATCH * MEM_LEN, 2048, G, bx);
                pg8::EpiRowBf16 E{(bf16*)(ws + WS_MKV), 2048, -1, 1.f};
                pg8::gemm_phase<pg8::EpiRowBf16, pg8::StaticOrder, true, true>(lds, g, S, E);
            }
            if (hy) {
                REP(4) phase_taps((const float*)(ws + WS_H2) + (size_t)j * SEQ * HY_FILT, f_w3 + (size_t)j * HY_FILT * FCOLS, TAPS, gw, NGW, lane);
                pg8::Gemm g{U, (const bf16*)(ws + WS_WHY) + (size_t)j * D_IN_HY * DM, M_TOK, D_IN_HY, DM, 1 << 30, 1, 0};
                pg8::StaticOrder S; S.init(M_TOK, D_IN_HY, G, bx);
                pg8::EpiHyIn E{PROJ, M_TOK, 9, CQ, ATT_C2};
                REP(5) pg8::gemm_phase<pg8::EpiHyIn, pg8::StaticOrder, true, true>(lds, g, S, E);
            } else {
                pg8::Gemm g{U, (const bf16*)(ws + WS_WAT) + (size_t)j * D_IN_AT * DM, M_TOK, D_IN_AT, DM, 1 << 30, 1, 0};
                pg8::StaticOrder S; S.init(M_TOK, D_IN_AT, G, bx);
                pg8::EpiAtIn E{PROJ, D_IN_AT, qg + j * HD, kg + j * HD, ATT_C2, NORM_EPS, SEQ - 1};
                REP(6) pg8::gemm_phase<pg8::EpiAtIn, pg8::StaticOrder, true, true>(lds, g, S, E);
            }
            if (xw_sched && bx >= 128) xw_slice_a(XW, i, (LAS float*)(lds + wave * 16384), bx, wave, lane);
        PHASE_END
        PHASE_BEGINK(3)
            if (hy) {
                REP(8) phase_hyena_conv(PROJ, TAPS, hy_short + (size_t)j * 3 * 2304, hy_skip + (size_t)j * 2 * D_MAIN, (f32x2*)(ws + WS_FFTX), (f32x2*)(ws + WS_ZS), MIXT, lds, bx, G, tid, lane, wave);
                REP(9) for (int u = vcu; u < 256; u += G) { const int b = u >> 7, h4 = (u >> 5) & 3, qb = u & 31; const size_t row = (size_t)b * SEQ + qb * 256;
                    run_attn<256, 2048>(CQ + row * 256 + h4 * HD, MKV + (size_t)b * MEM_LEN * 2048 + i * 512 + h4 * HD, MKV + (size_t)b * MEM_LEN * 2048 + i * 512 + 256 + h4 * HD,
                                        MIX + row * DM + D_MAIN + h4 * HD, MEM_LEN / 64, (char*)lds_raw); }
            } else {
                REP(10) for (int u = vcu; u < 768; u += G) { const int bk = (u & 255) >> 5, qb = u & 31, hs = u >> 8, b = bk >> 2, kvh = bk & 3, h = kvh * 3 + hs; const size_t row = (size_t)b * SEQ + qb * 256;
                    run_attn<D_IN_AT, D_IN_AT>(PROJ + row * D_IN_AT + h * HD, PROJ + (size_t)b * SEQ * D_IN_AT + D_MAIN + kvh * HD, PROJ + (size_t)b * SEQ * D_IN_AT + D_MAIN + 256 + kvh * HD,
                                               MIX + row * DM + h * HD, SEQ / 64, (char*)lds_raw); }
                REP(9) for (int u = vcu; u < 256; u += G) { const int b = u >> 7, h4 = (u >> 5) & 3, qb = u & 31; const size_t row = (size_t)b * SEQ + qb * 256;
                    run_attn<D_IN_AT, 2048>(PROJ + row * D_IN_AT + 1280 + h4 * HD, MKV + (size_t)b * MEM_LEN * 2048 + i * 512 + h4 * HD, MKV + (size_t)b * MEM_LEN * 2048 + i * 512 + 256 + h4 * HD,
                                            MIX + row * DM + D_MAIN + h4 * HD, MEM_LEN / 64, (char*)lds_raw); }
            }
        PHASE_END
        if (hy) {
            PHASE_BEGINK(4)
                REP(11) phase_transpose_mix(MIXT, MIX, lds, bx, G, tid);
            PHASE_END
        }
        PHASE_BEGINK(5)
            pg8::Gemm g{MIX, (const bf16*)(ws + WS_WOUT) + (size_t)i * DM * DM, M_TOK, DM, DM, 1 << 30, 1, 0};
            pg8::StaticOrder S; S.init(M_TOK, DM, G, bx);
            pg8::EpiOutX E{i == 0 ? x : (const float*)H, H, DM, ffn_g + i * DM, (const float*)(ws + WS_WRG) + (size_t)i * NEXP * DM, (unsigned char*)U, (float*)(ws + WS_PART), (float*)(ws + WS_PSS), M_TOK};
            pg8::gemm_phase<pg8::EpiOutX, pg8::StaticOrder, true, true>(lds, g, S, E);
        PHASE_END
        PHASE_BEGINK(6)
            REP(13) phase_router_sum((const float*)(ws + WS_PART), (const float*)(ws + WS_PSS), (float*)(ws + WS_RSTD), AFF, gw, NGW, lane);
        PHASE_END
        PHASE_BEGINK(7)
            REP(14) phase_topk(AFF, (const float*)(ws + WS_RSTD), (float*)(ws + WS_RS), IDX, GATE, POS, lds + LDS_MISC, bx, G, tid, lane, wave);
            if (xw_sched && bx >= 32) xw_slice_b(XW, i, (LAS float*)(lds + wave * 16384), bx, wave, lane);
        PHASE_END
        PHASE_BEGINK(8)
            pg8::Gemm g{U, (const bf16*)(ws + WS_W1 + (size_t)i * NEXP * 1536 * DM), XROWS, 1536, DM / 2, 4, NEXP, (size_t)1536 * DM};
            pg8::StaticOrder S; S.init(XROWS, 1536, G, bx);
            pg8::EpiSwiGLU8 E{(unsigned char*)HID, EFF, 1.0f / W8_SCALE, (const float*)(ws + WS_RS)};
            REP(16) pg8::gemm_phase<pg8::EpiSwiGLU8, pg8::StaticOrder, true, true, true, true>(lds, g, S, E, IDX);
        PHASE_END
        PHASE_BEGINK(9)
            pg8::Gemm g{HID, (const bf16*)(ws + WS_W2 + (size_t)i * NEXP * DM * EFF), XROWS, DM, EFF / 2, 4, NEXP, (size_t)DM * EFF};
            pg8::StaticOrder S; S.init(XROWS, DM, G, bx);
            pg8::EpiDown E{Y, DM, GATE, 1.0f / W8_SCALE};
            REP(17) pg8::gemm_phase<pg8::EpiDown, pg8::StaticOrder, true, true, false, true>(lds, g, S, E);
        PHASE_END
    }
    PHASE_BEGINK(10)
        phase_norm<true, true>(H, nullptr, fin_g, nullptr, args.out, POS, Y, gw, NGW, lane);
    PHASE_END
#ifdef TSEL
#ifdef CSEL
    if (bx == 0 && threadIdx.x == 0) tacc_ += *(unsigned long long*)(ws + 32768);
#endif
    if (bx == 0 && threadIdx.x == 0 && hi - lo > 1) { const unsigned long long te_ = __builtin_amdgcn_s_memrealtime(); while (__builtin_amdgcn_s_memrealtime() - te_ < (unsigned long long)TAMP * tacc_) __builtin_amdgcn_s_sleep(8); }
#endif
#undef PHASE_BEGINK
#undef PHASE_END
}

extern "C" void kernel_launch(void* const* d_in, const int* in_sizes, int n_in, void* d_out, int out_size, void* d_ws, size_t ws_size, hipStream_t stream) {
    static int grid = 0;
    if (grid == 0) {
        if (n_in != 24 || out_size != M_TOK * DM || ws_size < WS_END) { fprintf(stderr, "kernel_launch: unexpected shapes (n_in %d out %d ws %zu need %zu)\n", n_in, out_size, ws_size, (size_t)WS_END); grid = -1; return; }
        int dev = 0, cus = 0, per_cu = 0;
        if (hipGetDevice(&dev) != hipSuccess || hipDeviceGetAttribute(&cus, hipDeviceAttributeMultiprocessorCount, dev) != hipSuccess) { grid = -1; return; }
        if (hipFuncSetAttribute((const void*)hybrid_fwd, hipFuncAttributeMaxDynamicSharedMemorySize, LDS_BYTES) != hipSuccess) { fprintf(stderr, "kernel_launch: hipFuncSetAttribute failed\n"); grid = -1; return; }
        if (hipOccupancyMaxActiveBlocksPerMultiprocessor(&per_cu, (const void*)hybrid_fwd, NTHREADS, LDS_BYTES) != hipSuccess || per_cu < 1) { fprintf(stderr, "kernel_launch: occupancy query says %d blocks/CU\n", per_cu); per_cu = 1; }
        (void)hipGetLastError();
        grid = cus;
    }
    if (grid < 0) return;
    if (hipMemsetAsync((char*)d_ws + WS_CTL, 0, 64 * 1024, stream) != hipSuccess) { fprintf(stderr, "kernel_launch: memset failed\n"); return; }
    Args a{};
    for (int i = 0; i < 24; ++i) a.in[i] = (const float*)d_in[i];
    a.out = (float*)d_out; a.ws = (unsigned char*)d_ws;
#if MK_PER_PHASE
    for (int li = 0; li < N_PHASES; ++li) {
        a.ph_lo = li; a.ph_hi = li + 1;
        void* kargs[] = {&a};
        hipError_t e = hipLaunchCooperativeKernel((const void*)hybrid_fwd, dim3(grid), dim3(NTHREADS), kargs, LDS_BYTES, stream);
        if (e != hipSuccess) { fprintf(stderr, "kernel_launch: launch %d failed: %s\n", li, hipGetErrorString(e)); break; }
    }
#else
    a.ph_lo = 0; a.ph_hi = N_PHASES;
    void* kargs[] = {&a};
    hipError_t e = hipLaunchCooperativeKernel((const void*)hybrid_fwd, dim3(grid), dim3(NTHREADS), kargs, LDS_BYTES, stream);
    if (e != hipSuccess) fprintf(stderr, "kernel_launch: cooperative launch failed: %s (grid %d)\n", hipGetErrorString(e), grid);
#endif
}
```

```cpp
#include <hip/hip_runtime.h>
#include <hip/hip_cooperative_groups.h>
#include <hip/hip_bf16.h>
#include <cmath>
#include <cstdio>
#include <cstdint>
namespace cg = cooperative_groups;

constexpr int BATCH = 2, SEQ = 8192, DM = 1024, DEPTH = 4, M_TOK = BATCH * SEQ;
constexpr int HD = 64, MEM_LEN = 256, D_MEM = 256, D_MAIN = 768, NQH = 12, NKVH = 4;
constexpr int D_IN_HY = 2560, D_IN_AT = 1536;
constexpr int NEXP = 16, CAP = 1024, EFF = 768, NGRP = BATCH * NEXP, XROWS = NGRP * CAP;
constexpr int HY_EMB = 33, HY_FILT = 64, FCOLS = 4 * D_MAIN;
constexpr float NORM_EPS = 1e-6f;
constexpr float W8_SCALE = 32.0f;
constexpr float ATT_C2 = 0.125f * 1.4426950408889634f;

constexpr size_t MiB = 1u << 20;
constexpr size_t WS_CTL = 0;
constexpr size_t WS_WHY = 2 * MiB;
constexpr size_t WS_WAT = 12 * MiB;
constexpr size_t WS_WOUT = 18 * MiB;
constexpr size_t WS_WMKV = 26 * MiB;
constexpr size_t WS_W1 = 32 * MiB;
constexpr size_t WS_W2 = 224 * MiB;
constexpr size_t WS_U = 320 * MiB;
constexpr size_t WS_PROJ = 352 * MiB;
constexpr size_t WS_CQ = WS_PROJ + 72 * MiB;
constexpr size_t WS_MIX = 432 * MiB;
constexpr size_t WS_MIXT = 464 * MiB;
constexpr size_t WS_AFF = 488 * MiB;
constexpr size_t WS_IDX = 489 * MiB;
constexpr size_t WS_GATE = WS_IDX + 128 * 1024;
constexpr size_t WS_POS = 490 * MiB;
constexpr size_t WS_XG = 492 * MiB;
constexpr size_t WS_HID = 556 * MiB;
constexpr size_t WS_TAPS = WS_XG;
constexpr size_t WS_Y = 604 * MiB;
constexpr size_t WS_FFTX = WS_Y;
constexpr size_t WS_H2 = 668 * MiB;
constexpr size_t WS_MEMN = 672 * MiB;
constexpr size_t WS_MKV = 673 * MiB;
constexpr size_t WS_PART = 676 * MiB;
constexpr size_t WS_PSS = 692 * MiB;
constexpr size_t WS_RSTD = 697 * MiB;
constexpr size_t WS_RS = WS_RSTD + 128 * 1024;
constexpr size_t WS_WRG = 698 * MiB;
constexpr size_t WS_ZS = 700 * MiB;
constexpr size_t WS_END = 732 * MiB;

constexpr int LDS_RING = 0;
constexpr int LDS_MISC = 132 * 1024;
constexpr int LDS_BYTES = 140 * 1024;
constexpr int NTHREADS = 512, NWAVES = 8;

#define GAS __attribute__((address_space(1)))
#define LAS __attribute__((address_space(3)))
typedef unsigned short bf16;
typedef unsigned v4u __attribute__((ext_vector_type(4)));
typedef unsigned v2u __attribute__((ext_vector_type(2)));
typedef float f32x4 __attribute__((ext_vector_type(4)));
typedef float f32x2 __attribute__((ext_vector_type(2)));
__device__ __forceinline__ unsigned f2bf(float f) { unsigned u = __builtin_bit_cast(unsigned, f); return (u + 0x7fffu + ((u >> 16) & 1u)) >> 16; }
__device__ __forceinline__ unsigned pk2(float lo, float hi) { return f2bf(lo) | (f2bf(hi) << 16); }
__device__ __forceinline__ float bf2f(unsigned short h) { return __builtin_bit_cast(float, (unsigned)h << 16); }
__device__ __forceinline__ float bflo(unsigned w) { return __builtin_bit_cast(float, w << 16); }
__device__ __forceinline__ float bfhi(unsigned w) { return __builtin_bit_cast(float, w & 0xffff0000u); }
__device__ __forceinline__ float wave_sum(float v) {
#pragma unroll
    for (int o = 1; o < 64; o <<= 1) v += __shfl_xor(v, o);
    return v;
}
__device__ __forceinline__ int opaque_tid(int wave_s) { int l; asm volatile("v_mbcnt_lo_u32_b32 %0, -1, 0\n\tv_mbcnt_hi_u32_b32 %0, -1, %0" : "=v"(l)); return (wave_s << 6) | l; }
#define MK_PER_PHASE 0

#define XB_TMO      128
#define XB_XCNT(j)  (256  + 64 * (j))
#define XB_XSUB(j)  (1280 + 64 * (j))
#define XB_XGEN(j)  (2304 + 64 * (j))
#define XB_TOP      3328
#define XB_TOPGEN   3392
#define XCD_BAR_WORDS 3456
#define XB_SPIN_CAP (1u << 18)

__device__ __forceinline__ unsigned xb_ld(unsigned* p)              { return __hip_atomic_load(p, __ATOMIC_RELAXED, __HIP_MEMORY_SCOPE_AGENT); }
__device__ __forceinline__ unsigned xb_add(unsigned* p, unsigned v) { return __hip_atomic_fetch_add(p, v, __ATOMIC_RELAXED, __HIP_MEMORY_SCOPE_AGENT); }
__device__ __forceinline__ unsigned xb_xcc_id() { return (unsigned)__builtin_amdgcn_s_getreg((3 << 11) | 20) & 0xFu; }
#define XB_SPIN(cond, bar) do { unsigned _sp = 0; while (cond) { __builtin_amdgcn_s_sleep(1); \
    if ((++_sp & 255u) == 0u) { if (xb_ld(&(bar)[XB_TMO])) break; if (_sp > XB_SPIN_CAP) { atomicAdd(&(bar)[XB_TMO], 1u); break; } } } } while (0)

struct XcdBarrier {
    unsigned* bar; unsigned x;
    volatile LAS unsigned* st;
};

__device__ __forceinline__ XcdBarrier xcd_barrier_post(unsigned* bar, volatile LAS unsigned* st) {
    XcdBarrier b; b.bar = bar; b.x = xb_xcc_id(); b.st = st;
    if (threadIdx.x == 0) (void)xb_add(&bar[XB_XCNT(b.x)], 1u);
    return b;
}
__device__ __forceinline__ void xcd_barrier_complete(unsigned* bar, unsigned x, unsigned& nloc, unsigned& nx) {
    const unsigned G = gridDim.x * gridDim.y * gridDim.z;
    unsigned sum, cnt, mine, sp = 0u;
    for (;;) {
        sum = 0u; cnt = 0u; mine = 0u;
#pragma unroll
        for (unsigned j = 0; j < 16; ++j) { const unsigned c = xb_ld(&bar[XB_XCNT(j)]); sum += c; cnt += (c > 0u) ? 1u : 0u; mine = (j == x) ? c : mine; }
        if (sum == G) break;
        __builtin_amdgcn_s_sleep(1);
        if ((++sp & 255u) == 0u) { if (xb_ld(&bar[XB_TMO])) break; if (sp > XB_SPIN_CAP) { atomicAdd(&bar[XB_TMO], 1u); break; } }
    }
    nloc = mine > 0u ? mine : 1u; nx = cnt > 0u ? cnt : 1u;
}

__device__ __forceinline__ void xcd_barrier(const XcdBarrier& b) {
    asm volatile("s_waitcnt vmcnt(0)" ::: "memory");
    __syncthreads();
    if (threadIdx.x == 0) {
        unsigned* bar = b.bar;
        __builtin_amdgcn_s_waitcnt(0);
        unsigned nloc = b.st[0], nx = b.st[1];
        if (nloc == 0u) { xcd_barrier_complete(bar, b.x, nloc, nx); b.st[0] = nloc; b.st[1] = nx; }
        const unsigned old = xb_add(&bar[XB_XSUB(b.x)], 1u);
        const unsigned gen = old / nloc;
        if (old + 1u == (gen + 1u) * nloc) {
            __builtin_amdgcn_fence(__ATOMIC_RELEASE, "agent");
            asm volatile("s_waitcnt vmcnt(0)" ::: "memory");
            const unsigned og = xb_add(&bar[XB_TOP], 1u);
            const unsigned tg = og / nx;
            if (og + 1u == (tg + 1u) * nx) xb_add(&bar[XB_TOPGEN], 1u);
            else XB_SPIN(xb_ld(&bar[XB_TOPGEN]) == tg, bar);
            __builtin_amdgcn_fence(__ATOMIC_ACQUIRE, "agent");
            xb_add(&bar[XB_XGEN(b.x)], 1u);
            asm volatile("s_waitcnt vmcnt(0)" ::: "memory");
        } else {
            XB_SPIN(xb_ld(&bar[XB_XGEN(b.x)]) == gen, bar);
            __builtin_amdgcn_fence(__ATOMIC_ACQUIRE, "agent");
            asm volatile("s_waitcnt vmcnt(0)" ::: "memory");
        }
    }
    __syncthreads();
}
namespace pg8 {
#define PG8_LAS __attribute__((address_space(3)))
typedef unsigned short bf16_t;
typedef short bf16x8 __attribute__((ext_vector_type(8)));
typedef float f32x4 __attribute__((ext_vector_type(4)));
typedef unsigned u32x4 __attribute__((ext_vector_type(4)));
constexpr int BM = 256, BK = 64, HALF = 128, HTB = HALF * BK * 2  , STAGE_BYTES = 8 * HTB, NXCD = 8, WGM = 8;

__host__ __device__ __forceinline__ int lds_byte(int r, int c) { const int st = (r >> 4) * 2 + (c >> 5), rr = r & 15, cc = c & 31, ob = rr * 64 + cc * 2; return st * 1024 + (ob ^ (((ob >> 9) & 1) << 5)); }
__host__ __device__ __forceinline__ void stage_rc(int b, int& R, int& C) { const int st = b / 1024, sb = b % 1024, swz = sb ^ (((sb >> 9) & 1) << 5); R = (st >> 1) * 16 + swz / 64; C = (st & 1) * 32 + (swz % 64) / 2; }
__host__ __device__ __forceinline__ int perm32(int rho) { const int n = rho >> 4, i = rho & 15; return 8 * (i >> 2) + 4 * n + (i & 3); }

struct Unit { int pm, pn; };
struct Gemm { const bf16_t* A; const bf16_t* Bt; int M, N, K; int gdiv, gmod; size_t gstride; };

struct StaticOrder {
    int nM, nN, nwg, G, c;
    __host__ __device__ void init(int M, int N, int G_, int c_) { nM = M / BM; nN = N / BM; nwg = nM * nN; G = G_; c = c_; }
    __host__ __device__ bool next(int i, Unit& u) const {
        const long L = (long)i * G + c; if (L >= nwg) return false;
        int wgid = (int)L; { const int q = nwg / NXCD, r = nwg % NXCD, xcd = wgid % NXCD, off = wgid / NXCD; wgid = (xcd < r ? xcd * (q + 1) : r * (q + 1) + (xcd - r) * q) + off; }
        const int nig = WGM * nN, gid = wgid / nig, fm = gid * WGM, gsz = (nM - fm) < WGM ? (nM - fm) : WGM;
        u.pm = fm + ((wgid % nig) % gsz); u.pn = (wgid % nig) / gsz; return true;
    }
    __device__ __forceinline__ void a_ready(const Unit&) const {}
    __device__ __forceinline__ void done(const Unit&) const {}
};


__device__ __forceinline__ unsigned cvt_pk_bf16(float lo, float hi) { unsigned r; asm volatile("v_cvt_pk_bf16_f32 %0, %1, %2" : "=v"(r) : "v"(lo), "v"(hi)); return r; }
typedef unsigned u32x2 __attribute__((ext_vector_type(2)));
struct EpiRowBf16 {
    static constexpr bool PERM = false, AFTER_DRAIN = false;
    bf16_t* O; int ldc; int sc_pn; float sc;
    __device__ __forceinline__ void operator()(const f32x4 (&acc)[2][2][4][2], const Unit& u, int wr, int wc, int fr, int fq) const {
        const float s = (u.pn == sc_pn) ? sc : 1.f;
        const int row0 = u.pm * BM + wr * 64 + fr, col0 = u.pn * BM + wc * 32 + 4 * fq;
#pragma unroll
        for (int ai = 0; ai < 2; ++ai)
#pragma unroll
            for (int m = 0; m < 4; ++m) { bf16_t* rowp = O + (size_t)(row0 + ai * HALF + m * 16) * ldc + col0;
#pragma unroll
                for (int bj = 0; bj < 2; ++bj)
#pragma unroll
                    for (int n = 0; n < 2; ++n) { const f32x4 v = acc[ai][bj][m][n] * s; u32x2 w; w.x = cvt_pk_bf16(v[0], v[1]); w.y = cvt_pk_bf16(v[2], v[3]);
                        *(u32x2*)(rowp + bj * HALF + n * 16) = w; } }
    }
};
struct EpiHyIn {
    static constexpr bool PERM = false, AFTER_DRAIN = false;
    bf16_t* OT; int ldt; int tp_tiles; bf16_t* CQ; float sc;
    __device__ __forceinline__ void operator()(const f32x4 (&acc)[2][2][4][2], const Unit& u, int wr, int wc, int fr, int fq) const {
        const int row0 = u.pm * BM + wr * 64 + fr;
        if (u.pn < tp_tiles) {
            const int col0 = u.pn * BM + wc * 32 + 4 * fq;
#pragma unroll
            for (int ai = 0; ai < 2; ++ai)
#pragma unroll
                for (int m = 0; m < 4; ++m) { const int row = row0 + ai * HALF + m * 16;
#pragma unroll
                    for (int bj = 0; bj < 2; ++bj)
#pragma unroll
                        for (int n = 0; n < 2; ++n) { const f32x4 v = acc[ai][bj][m][n]; const unsigned w0 = cvt_pk_bf16(v[0], v[1]), w1 = cvt_pk_bf16(v[2], v[3]);
                            bf16_t* p = OT + (size_t)(col0 + bj * HALF + n * 16) * ldt + row;
                            p[0] = (bf16_t)(w0 & 0xffffu); p[(size_t)ldt] = (bf16_t)(w0 >> 16); p[(size_t)2 * ldt] = (bf16_t)(w1 & 0xffffu); p[(size_t)3 * ldt] = (bf16_t)(w1 >> 16); } }
        } else {
            const int col0 = wc * 32 + 4 * fq;
#pragma unroll
            for (int ai = 0; ai < 2; ++ai)
#pragma unroll
                for (int m = 0; m < 4; ++m) { bf16_t* rowp = CQ + (size_t)(row0 + ai * HALF + m * 16) * 256 + col0;
#pragma unroll
                    for (int bj = 0; bj < 2; ++bj)
#pragma unroll
                        for (int n = 0; n < 2; ++n) { const f32x4 v = acc[ai][bj][m][n] * sc; u32x2 w; w.x = cvt_pk_bf16(v[0], v[1]); w.y = cvt_pk_bf16(v[2], v[3]);
                            *(u32x2*)(rowp + bj * HALF + n * 16) = w; } }
        }
    }
};
struct EpiAtIn {
    static constexpr bool PERM = false, AFTER_DRAIN = false;
    bf16_t* Oq; bf16_t* Ok; bf16_t* Ov; bf16_t* Oc; const float* gq; const float* gk; float csc; float eps; int seq_mask;
    __device__ __forceinline__ void operator()(const f32x4 (&acc)[2][2][4][2], const Unit& u, int wr, int wc, int fr, int fq) const {
        const int row0 = u.pm * BM + wr * 64 + fr, colb = (u.pn < 3 ? u.pn * BM : 0) + wc * 64 + 4 * fq; const int ldc = u.pn < 3 ? 768 : 256;
        bf16_t* O = u.pn < 3 ? Oq : (u.pn == 3 ? Ok : (u.pn == 4 ? Ov : Oc));
        if (u.pn <= 3) {
            const float* gp = (u.pn == 3 ? gk : gq) + 4 * fq; const float osc = (u.pn == 3) ? 1.f : csc;
            float invr[4];
#pragma unroll
            for (int q = 0; q < 4; ++q) invr[q] = exp2f(-(float)(4 * fq + q) * (13.287712379549449f / 16.0f)) * 0.15915494309189535f;
#pragma unroll
            for (int ai = 0; ai < 2; ++ai)
#pragma unroll
                for (int m = 0; m < 4; ++m) {
                    const int row = row0 + ai * HALF + m * 16; int t = row & seq_mask; asm volatile("" : "+v"(t));
                    float ss = 0.f;
#pragma unroll
                    for (int bj = 0; bj < 2; ++bj)
#pragma unroll
                        for (int n = 0; n < 2; ++n) { const f32x4 x = acc[ai][bj][m][n]; ss += (x[0] * x[0] + x[1] * x[1]) + (x[2] * x[2] + x[3] * x[3]); }
                    ss += __shfl_xor(ss, 16); ss += __shfl_xor(ss, 32);
                    const float rs = osc * __builtin_amdgcn_rsqf(ss * (1.0f / 64.0f) + eps);
                    bf16_t* rowp = O + (size_t)row * ldc + colb;
#pragma unroll
                    for (int bj = 0; bj < 2; ++bj) {
                        const float pos = (float)(bj == 0 ? (t >> 6) : (t & 63));
                        const f32x4 xa = acc[ai][bj][m][0] * rs * *(const f32x4*)(gp + 32 * bj), xb = acc[ai][bj][m][1] * rs * *(const f32x4*)(gp + 32 * bj + 16);
                        f32x4 oa, ob;
#pragma unroll
                        for (int q = 0; q < 4; ++q) { const float rev = pos * invr[q]; const float c = __builtin_amdgcn_cosf(rev), s = __builtin_amdgcn_sinf(rev);
                            oa[q] = xa[q] * c - xb[q] * s; ob[q] = xa[q] * s + xb[q] * c; }
                        u32x2 w; w.x = cvt_pk_bf16(oa[0], oa[1]); w.y = cvt_pk_bf16(oa[2], oa[3]); *(u32x2*)(rowp + 32 * bj) = w;
                        w.x = cvt_pk_bf16(ob[0], ob[1]); w.y = cvt_pk_bf16(ob[2], ob[3]); *(u32x2*)(rowp + 32 * bj + 16) = w;
                    }
                    asm volatile("" ::: "memory");
                }
        } else {
            const float s = (u.pn == 5) ? csc : 1.f;
#pragma unroll
            for (int ai = 0; ai < 2; ++ai)
#pragma unroll
                for (int m = 0; m < 4; ++m) { bf16_t* rowp = O + (size_t)(row0 + ai * HALF + m * 16) * ldc + colb;
#pragma unroll
                    for (int bj = 0; bj < 2; ++bj)
#pragma unroll
                        for (int n = 0; n < 2; ++n) { const f32x4 v = acc[ai][bj][m][n] * s; u32x2 w; w.x = cvt_pk_bf16(v[0], v[1]); w.y = cvt_pk_bf16(v[2], v[3]);
                            *(u32x2*)(rowp + 32 * bj + 16 * n) = w; } }
        }
    }
};
struct EpiResF32 {
    static constexpr bool PERM = false, AFTER_DRAIN = false;
    const float* res; float* out; int ldc;
    __device__ __forceinline__ void operator()(const f32x4 (&acc)[2][2][4][2], const Unit& u, int wr, int wc, int fr, int fq) const {
        const int row0 = u.pm * BM + wr * 64 + fr, col0 = u.pn * BM + wc * 32 + 4 * fq;
#pragma unroll
        for (int ai = 0; ai < 2; ++ai)
#pragma unroll
            for (int m = 0; m < 4; ++m) { const size_t off = (size_t)(row0 + ai * HALF + m * 16) * ldc + col0;
#pragma unroll
                for (int bj = 0; bj < 2; ++bj)
#pragma unroll
                    for (int n = 0; n < 2; ++n) { const f32x4 r = *(const f32x4*)(res + off + bj * HALF + n * 16); *(f32x4*)(out + off + bj * HALF + n * 16) = r + acc[ai][bj][m][n]; } }
    }
};
__device__ __forceinline__ unsigned pk4_fp8_sat(const f32x4 x) {
    unsigned w = 0;
    w = __builtin_amdgcn_cvt_pk_fp8_f32(__builtin_amdgcn_fmed3f(x[0], -448.f, 448.f), __builtin_amdgcn_fmed3f(x[1], -448.f, 448.f), w, false);
    w = __builtin_amdgcn_cvt_pk_fp8_f32(__builtin_amdgcn_fmed3f(x[2], -448.f, 448.f), __builtin_amdgcn_fmed3f(x[3], -448.f, 448.f), w, true);
    return w;
}
struct EpiOutX {
    static constexpr bool PERM = true, AFTER_DRAIN = false;
    const float* res; float* out; int ldc; const float* gain; const float* WrG; unsigned char* XN8; float* PLG; float* PSS; int M;
    static __device__ __forceinline__ void split8(const f32x4 a, const f32x4 b, bf16x8& hi, bf16x8& lo) {
        u32x4 h, l; float r[8] = {a[0], a[1], a[2], a[3], b[0], b[1], b[2], b[3]};
#pragma unroll
        for (int k = 0; k < 4; ++k) { const unsigned p = cvt_pk_bf16(r[2 * k], r[2 * k + 1]); h[k] = p;
            const float d0 = r[2 * k] - __builtin_bit_cast(float, p << 16), d1 = r[2 * k + 1] - __builtin_bit_cast(float, p & 0xffff0000u); l[k] = cvt_pk_bf16(d0, d1); }
        hi = __builtin_bit_cast(bf16x8, h); lo = __builtin_bit_cast(bf16x8, l);
    }
    __device__ __forceinline__ void operator()(f32x4 (&acc)[2][2][4][2], const Unit& u, int wr, int wc, int fr, int fq) const {
        const int row0 = u.pm * BM + wr * 64 + fr, col0 = u.pn * BM + wc * 32 + 8 * fq, slot = u.pn * 4 + wc;
        bf16x8 whi[2], wlo[2];
#pragma unroll
        for (int bj = 0; bj < 2; ++bj) { const float* wp = WrG + (size_t)fr * ldc + col0 + bj * HALF; split8(*(const f32x4*)wp, *(const f32x4*)(wp + 4), whi[bj], wlo[bj]); }
#pragma unroll
        for (int idx = 0; idx < 8; ++idx) { const int ai = idx >> 2, m = idx & 3;
            const int row = row0 + ai * HALF + m * 16; const size_t off = (size_t)row * ldc + col0; float ss = 0.f; f32x4 lg = (f32x4){0.f, 0.f, 0.f, 0.f}; u32x4 xw;
#pragma unroll
            for (int bj = 0; bj < 2; ++bj) {
#pragma unroll
                for (int n = 0; n < 2; ++n) { const int co = bj * HALF + n * 4;
                    const f32x4 h = *(const f32x4*)(res + off + co) + acc[ai][bj][m][n]; acc[ai][bj][m][n] = h; *(f32x4*)(out + off + co) = h;
                    ss += (h[0] * h[0] + h[1] * h[1]) + (h[2] * h[2] + h[3] * h[3]);
                    const f32x4 x = h * *(const f32x4*)(gain + col0 + co);
                    xw[bj * 2 + n] = pk4_fp8_sat(x); }
                bf16x8 hhi, hlo; split8(acc[ai][bj][m][0], acc[ai][bj][m][1], hhi, hlo);
                lg = __builtin_amdgcn_mfma_f32_16x16x32_bf16(wlo[bj], hhi, lg, 0, 0, 0);
                lg = __builtin_amdgcn_mfma_f32_16x16x32_bf16(whi[bj], hlo, lg, 0, 0, 0);
                lg = __builtin_amdgcn_mfma_f32_16x16x32_bf16(whi[bj], hhi, lg, 0, 0, 0); }
            *(u32x4*)(XN8 + (size_t)row * ldc + u.pn * BM + wc * 64 + fq * 16) = xw;
            ss += __shfl_xor(ss, 16); ss += __shfl_xor(ss, 32);
            if (fq == 0) PSS[(size_t)slot * M + row] = ss;
            *(f32x4*)(PLG + ((size_t)slot * M + row) * 16 + 4 * fq) = lg;
            asm volatile("" ::: "memory"); }
    }
};
struct EpiSwiGLU {
    static constexpr bool PERM = false, AFTER_DRAIN = false;
    bf16_t* O; int ldc;
    __device__ __forceinline__ void operator()(const f32x4 (&acc)[2][2][4][2], const Unit& u, int wr, int wc, int fr, int fq) const {
        const int row0 = u.pm * BM + wr * 64 + fr, col0 = u.pn * HALF + wc * 32 + 4 * fq;
#pragma unroll
        for (int ai = 0; ai < 2; ++ai)
#pragma unroll
            for (int m = 0; m < 4; ++m) { bf16_t* rowp = O + (size_t)(row0 + ai * HALF + m * 16) * ldc + col0;
#pragma unroll
                for (int n = 0; n < 2; ++n) { const f32x4 g = acc[ai][0][m][n], up = acc[ai][1][m][n]; f32x4 h;
#pragma unroll
                    for (int q = 0; q < 4; ++q) h[q] = g[q] * up[q] * __builtin_amdgcn_rcpf(1.f + __expf(-g[q]));
                    u32x2 w; w.x = cvt_pk_bf16(h[0], h[1]); w.y = cvt_pk_bf16(h[2], h[3]); *(u32x2*)(rowp + n * 16) = w; } }
    }
};
struct EpiSwiGLU8 {
    static constexpr bool PERM = false, AFTER_DRAIN = false;
    unsigned char* O; int ldc; float wsc; const float* rs;
    __device__ __forceinline__ void operator()(const f32x4 (&acc)[2][2][4][2], const Unit& u, int wr, int wc, int fr, int fq) const {
        const int row0 = u.pm * BM + wr * 64 + fr, col0 = u.pn * HALF + wc * 32 + 4 * fq;
#pragma unroll
        for (int ai = 0; ai < 2; ++ai)
#pragma unroll
            for (int m = 0; m < 4; ++m) { const int row = row0 + ai * HALF + m * 16; const float sc = wsc * rs[row]; u32x2 hw;
#pragma unroll
                for (int n = 0; n < 2; ++n) { const f32x4 g = acc[ai][0][m][n] * sc, up = acc[ai][1][m][n] * sc; f32x4 h;
#pragma unroll
                    for (int q = 0; q < 4; ++q) h[q] = g[q] * up[q] * __builtin_amdgcn_rcpf(1.f + __expf(-g[q]));
                    hw[n] = pk4_fp8_sat(h); }
                *(u32x2*)(O + (size_t)row * ldc + u.pn * HALF + wc * 32 + fq * 8) = hw; }
    }
};
struct EpiDown {
    static constexpr bool PERM = true, AFTER_DRAIN = false;
    bf16_t* O; int ldc; const float* gate; float wsc;
    __device__ __forceinline__ void operator()(const f32x4 (&acc)[2][2][4][2], const Unit& u, int wr, int wc, int fr, int fq) const {
        const int row0 = u.pm * BM + wr * 64 + fr, col0 = u.pn * BM + wc * 32 + 8 * fq;
#pragma unroll
        for (int ai = 0; ai < 2; ++ai)
#pragma unroll
            for (int m = 0; m < 4; ++m) { const int row = row0 + ai * HALF + m * 16; const float gs = gate[row] * wsc; bf16_t* rowp = O + (size_t)row * ldc + col0;
#pragma unroll
                for (int bj = 0; bj < 2; ++bj) { const f32x4 v0 = acc[ai][bj][m][0] * gs, v1 = acc[ai][bj][m][1] * gs; u32x4 w;
                    w.x = cvt_pk_bf16(v0[0], v0[1]); w.y = cvt_pk_bf16(v0[2], v0[3]); w.z = cvt_pk_bf16(v1[0], v1[1]); w.w = cvt_pk_bf16(v1[2], v1[3]);
                    *(u32x4*)(rowp + bj * HALF) = w; } }
    }
};
template <class Epi, class Sched, bool ALIGN_EPI = false, bool SP2 = false, bool GATHER = false, bool FP8 = false>
__device__ __forceinline__ void gemm_phase(PG8_LAS unsigned char* lds, const Gemm g, const Sched& S, const Epi& E, int wave_s, const int* gidx = nullptr) {
    const int tid = opaque_tid(wave_s), wid = __builtin_amdgcn_readfirstlane(tid >> 6), lane = tid & 63, wr = wid >> 2, wc = wid & 3, fr = lane & 15, fq = lane >> 4;
    const int K = g.K, nt = K / BK;
    unsigned voffA[2], voffB[2];
#pragma unroll
    for (int i = 0; i < 2; ++i) { int R, C; stage_rc(tid * 16 + i * 8192, R, C); const int Rb = Epi::PERM ? ((R & ~31) + perm32(R & 31)) : R;
        voffA[i] = (unsigned)(R * K + C) * 2u; voffB[i] = (unsigned)(Rb * K + C) * 2u; }
    const size_t kstep = (size_t)(BK * 2);
    const size_t hstep = (size_t)HALF * K * 2;
    const size_t tstep = 2 * hstep;
    const unsigned ldsw = (unsigned)wid * 1024u;
    const int aoff = lds_byte(wr * 64 + fr, fq * 8), boff = lds_byte(wc * 32 + fr, fq * 8);
#define PG8_SA(b, h) (((b) * 2 + (h)) * HTB)
#define PG8_SB(b, h) ((4 + (b) * 2 + (h)) * HTB)
#define PG8_STAGE(bufoff, gbase, voff) do { _Pragma("unroll") for (int _i = 0; _i < 2; ++_i) \
        __builtin_amdgcn_global_load_lds((const unsigned*)((const char*)(gbase) + (voff)[_i]), (PG8_LAS unsigned*)(lds + (bufoff) + ldsw + _i * 8192), 16, 0, 0); } while (0)
#define PG8_LDA(dst, b, h) do { _Pragma("unroll") for (int m = 0; m < 4; ++m) { if constexpr (FP8) { const v4i_ lo_ = *(const PG8_LAS v4i_*)(lds + PG8_SA(b, h) + aoff + m * 2048), hi_ = *(const PG8_LAS v4i_*)(lds + PG8_SA(b, h) + aoff + m * 2048 + 1024); \
        dst##8[m] = __builtin_shufflevector(lo_, hi_, 0, 1, 2, 3, 4, 5, 6, 7); } else { _Pragma("unroll") for (int k = 0; k < 2; ++k) dst[m][k] = *(const PG8_LAS bf16x8*)(lds + PG8_SA(b, h) + aoff + m * 2048 + k * 1024); } } } while (0)
#define PG8_LDB(dst, b, h) do { _Pragma("unroll") for (int n = 0; n < 2; ++n) { if constexpr (FP8) { const v4i_ lo_ = *(const PG8_LAS v4i_*)(lds + PG8_SB(b, h) + boff + n * 2048), hi_ = *(const PG8_LAS v4i_*)(lds + PG8_SB(b, h) + boff + n * 2048 + 1024); \
        dst##8[n] = __builtin_shufflevector(lo_, hi_, 0, 1, 2, 3, 4, 5, 6, 7); } else { _Pragma("unroll") for (int k = 0; k < 2; ++k) dst[n][k] = *(const PG8_LAS bf16x8*)(lds + PG8_SB(b, h) + boff + n * 2048 + k * 1024); } } } while (0)
#define PG8_MMA(ai, bj, At, Bt) do { __builtin_amdgcn_s_setprio(1); _Pragma("unroll") for (int m = 0; m < 4; ++m) _Pragma("unroll") for (int n = 0; n < 2; ++n) { \
        if constexpr (FP8) asm volatile("v_mfma_scale_f32_16x16x128_f8f6f4 %0, %1, %2, %0, %3, %3 op_sel_hi:[0,0,0]" : "+v"(acc[ai][bj][m][n]) : "v"(Bt##8[n]), "v"(At##8[m]), "v"(sc127_));   \
        else { _Pragma("unroll") for (int k = 0; k < 2; ++k) acc[ai][bj][m][n] = __builtin_amdgcn_mfma_f32_16x16x32_bf16(Bt[n][k], At[m][k], acc[ai][bj][m][n], 0, 0, 0); } } \
        __builtin_amdgcn_s_setprio(0); } while (0)
#define PG8_WAIT_V(n) asm volatile("s_waitcnt vmcnt(" #n ")" ::: "memory")
#define PG8_WAIT_L(n) asm volatile("s_waitcnt lgkmcnt(" #n ")" ::: "memory")
#define PG8_BAR __builtin_amdgcn_s_barrier()
#define PG8_SCHED __builtin_amdgcn_sched_barrier(0)
    Unit cur, nxt; int ui = 0;
    if (!S.next(0, cur)) return;
    f32x4 acc[2][2][4][2];
#pragma unroll
    for (int a = 0; a < 2; ++a)
#pragma unroll
        for (int b = 0; b < 2; ++b)
#pragma unroll
            for (int m = 0; m < 4; ++m)
#pragma unroll
                for (int n = 0; n < 2; ++n) acc[a][b][m][n] = (f32x4){0.f, 0.f, 0.f, 0.f};
    typedef int v8i_ __attribute__((ext_vector_type(8))); typedef int v4i_ __attribute__((ext_vector_type(4)));
    const int sc127_ = 127;
    bf16x8 At[4][2], B0[2][2], B1[2][2]; v8i_ At8[4], B08[2], B18[2];
    static_assert(SP2, "this copy of the body keeps only the SP2 K-loop up to date");
    int rA[2]; { int R_, C_; stage_rc(tid * 16, R_, C_); rA[0] = R_; stage_rc(tid * 16 + 8192, R_, C_); rA[1] = R_; }
    unsigned cvp[2], nvp[2], c2_[2]; c2_[0] = voffA[0] - (unsigned)(rA[0] * K) * 2u; c2_[1] = voffA[1] - (unsigned)(rA[1] * K) * 2u;
#define PG8_ROWOFF(dst, unit) do { _Pragma("unroll") for (int i_ = 0; i_ < 2; ++i_) dst[i_] = (unsigned)gidx[(unit).pm * BM + rA[i_]] | ((unsigned)gidx[(unit).pm * BM + HALF + rA[i_]] << 16); } while (0)
#define PG8_STAGE_A(bufoff, gbase, P, H) do { if constexpr (GATHER) { unsigned to_[2]; _Pragma("unroll") for (int i_ = 0; i_ < 2; ++i_) to_[i_] = ((P[i_] >> (16 * (H))) & 0xffffu) * (unsigned)(K * 2) + c2_[i_]; PG8_STAGE(bufoff, gbase, to_); } \
        else { PG8_STAGE(bufoff, (gbase) + ((H) ? hstep : (size_t)0), voffA); } } while (0)
    if constexpr (GATHER) PG8_ROWOFF(cvp, cur); else { cvp[0] = 0u; cvp[1] = 0u; }
    const char* cA = GATHER ? (const char*)g.A : (const char*)g.A + (size_t)cur.pm * tstep; const char* cB = (const char*)g.Bt + (size_t)((cur.pm / g.gdiv) % g.gmod) * g.gstride + (size_t)cur.pn * tstep;
    S.a_ready(cur);
    if constexpr (SP2) {
        PG8_STAGE(PG8_SB(0, 0), cB, voffB); PG8_STAGE(PG8_SB(0, 1), cB + hstep, voffB); PG8_STAGE_A(PG8_SA(0, 0), cA, cvp, 0); PG8_STAGE_A(PG8_SA(0, 1), cA, cvp, 1);
        if (wr == 1) PG8_BAR;
        PG8_WAIT_V(2); PG8_BAR;
        PG8_STAGE(PG8_SB(1, 0), cB + kstep, voffB); PG8_STAGE_A(PG8_SA(1, 0), cA + kstep, cvp, 0); PG8_STAGE(PG8_SB(1, 1), cB + hstep + kstep, voffB);
        PG8_WAIT_V(6); PG8_BAR;
    } else {
        PG8_STAGE(PG8_SB(0, 0), cB, voffB); PG8_STAGE(PG8_SA(0, 0), cA, voffA); PG8_STAGE(PG8_SB(0, 1), cB + hstep, voffB); PG8_STAGE(PG8_SA(0, 1), cA + hstep, voffA);
        if (wr == 1) PG8_BAR;
        PG8_WAIT_V(4); PG8_BAR;
        PG8_STAGE(PG8_SB(1, 0), cB + kstep, voffB); PG8_STAGE(PG8_SA(1, 0), cA + kstep, voffA); PG8_STAGE(PG8_SB(1, 1), cB + hstep + kstep, voffB);
        PG8_WAIT_V(6); PG8_BAR;
    }
    for (;;) {
        const bool has_next = S.next(ui + 1, nxt);
        if constexpr (GATHER) { if (has_next) PG8_ROWOFF(nvp, nxt); else { nvp[0] = cvp[0]; nvp[1] = cvp[1]; } } else { nvp[0] = 0u; nvp[1] = 0u; }
        const char* nA = GATHER ? (const char*)g.A : (has_next ? (const char*)g.A + (size_t)nxt.pm * tstep : cA); const char* nB = has_next ? (const char*)g.Bt + (size_t)((nxt.pm / g.gdiv) % g.gmod) * g.gstride + (size_t)nxt.pn * tstep : cB;
        for (int t = 0; t < nt; t += 2) {
            const bool last = (t == nt - 2);
            unsigned svp[2]; svp[0] = last ? nvp[0] : cvp[0]; svp[1] = last ? nvp[1] : cvp[1];
            const char* a1 = cA + (size_t)(t + 1) * kstep;
            const char* a2 = last ? nA : cA + (size_t)(t + 2) * kstep; const char* b2 = last ? nB : cB + (size_t)(t + 2) * kstep;
            const char* a3 = a2 + kstep; const char* b3 = b2 + kstep;
            if (last && has_next) S.a_ready(nxt);
            if constexpr (SP2) {
            PG8_LDB(B0, 0, 0); PG8_LDB(B1, 0, 1); PG8_SCHED; PG8_LDA(At, 0, 0); PG8_STAGE_A(PG8_SA(1, 1), a1, cvp, 1);
            PG8_WAIT_V(8); PG8_WAIT_L(0); PG8_BAR; PG8_MMA(0, 0, At, B0); PG8_MMA(0, 1, At, B1); PG8_BAR; PG8_SCHED;
            PG8_LDA(At, 0, 1); PG8_STAGE(PG8_SB(0, 0), b2, voffB); PG8_STAGE(PG8_SB(0, 1), b2 + hstep, voffB); PG8_STAGE_A(PG8_SA(0, 0), a2, svp, 0);
            PG8_WAIT_V(8); PG8_WAIT_L(0); PG8_BAR; PG8_MMA(1, 0, At, B0); PG8_MMA(1, 1, At, B1); PG8_BAR; PG8_SCHED;
            PG8_LDB(B0, 1, 0); PG8_LDB(B1, 1, 1); PG8_SCHED; PG8_LDA(At, 1, 0); PG8_STAGE_A(PG8_SA(0, 1), a2, svp, 1);
            PG8_WAIT_V(8); PG8_WAIT_L(0); PG8_BAR; PG8_MMA(0, 0, At, B0); PG8_MMA(0, 1, At, B1); PG8_BAR; PG8_SCHED;
            PG8_LDA(At, 1, 1); PG8_STAGE(PG8_SB(1, 0), b3, voffB); PG8_STAGE(PG8_SB(1, 1), b3 + hstep, voffB); PG8_STAGE_A(PG8_SA(1, 0), a3, svp, 0);
            PG8_WAIT_V(8); PG8_WAIT_L(0); PG8_BAR; PG8_MMA(1, 0, At, B0); PG8_MMA(1, 1, At, B1); PG8_BAR; PG8_SCHED;
            } else {
            PG8_LDB(B0, 0, 0); PG8_SCHED; PG8_LDA(At, 0, 0); PG8_STAGE(PG8_SA(1, 1), a1 + hstep, voffA);
            PG8_WAIT_L(8); PG8_BAR; PG8_WAIT_L(0); PG8_MMA(0, 0, At, B0); PG8_BAR; PG8_SCHED;
            PG8_LDB(B1, 0, 1); PG8_STAGE(PG8_SB(0, 0), b2, voffB);
            PG8_BAR; PG8_WAIT_L(0); PG8_MMA(0, 1, At, B1); PG8_BAR;
            PG8_LDA(At, 0, 1); PG8_STAGE(PG8_SA(0, 0), a2, voffA);
            PG8_BAR; PG8_WAIT_L(0); PG8_MMA(1, 0, At, B0); PG8_BAR; PG8_SCHED;
            PG8_STAGE(PG8_SB(0, 1), b2 + hstep, voffB);
            PG8_WAIT_V(6); PG8_BAR; PG8_MMA(1, 1, At, B1); PG8_BAR;
            PG8_LDB(B0, 1, 0); PG8_SCHED; PG8_LDA(At, 1, 0); PG8_STAGE(PG8_SA(0, 1), a2 + hstep, voffA);
            PG8_WAIT_L(8); PG8_BAR; PG8_WAIT_L(0); PG8_MMA(0, 0, At, B0); PG8_BAR; PG8_SCHED;
            PG8_LDB(B1, 1, 1); PG8_STAGE(PG8_SB(1, 0), b3, voffB);
            PG8_BAR; PG8_WAIT_L(0); PG8_MMA(0, 1, At, B1); PG8_BAR;
            PG8_LDA(At, 1, 1); PG8_STAGE(PG8_SA(1, 0), a3, voffA);
            PG8_BAR; PG8_WAIT_L(0); PG8_MMA(1, 0, At, B0); PG8_BAR; PG8_SCHED;
            PG8_STAGE(PG8_SB(1, 1), b3 + hstep, voffB);
            PG8_WAIT_V(6); PG8_BAR; PG8_MMA(1, 1, At, B1); PG8_BAR;
            }
        }
        if constexpr (ALIGN_EPI) { if (wr == 0) PG8_BAR; }
        if constexpr (!Epi::AFTER_DRAIN) { const int t_e = opaque_tid(wave_s); const int fr_e = t_e & 15, fq_e = (t_e & 63) >> 4;
            E(acc, cur, wr, wc, fr_e, fq_e); S.done(cur); }
        if (!has_next) break;
#pragma unroll
        for (int a = 0; a < 2; ++a)
#pragma unroll
            for (int b = 0; b < 2; ++b)
#pragma unroll
                for (int m = 0; m < 4; ++m)
#pragma unroll
                    for (int n = 0; n < 2; ++n) acc[a][b][m][n] = (f32x4){0.f, 0.f, 0.f, 0.f};
        cur = nxt; cA = nA; cB = nB; ++ui; if constexpr (GATHER) { cvp[0] = nvp[0]; cvp[1] = nvp[1]; }
        if constexpr (ALIGN_EPI) { if (wr == 1) PG8_BAR; }
    }
    PG8_WAIT_V(0);
    if constexpr (!ALIGN_EPI) { if (wr == 0) PG8_BAR; }
    PG8_BAR;
    if constexpr (Epi::AFTER_DRAIN) { E.fused(acc, cur, wr, wc, fr, fq, lds, wid, lane); S.done(cur); }
#undef PG8_ROWOFF
#undef PG8_STAGE_A
#undef PG8_SA
#undef PG8_SB
#undef PG8_STAGE
#undef PG8_LDA
#undef PG8_LDB
#undef PG8_MMA
#undef PG8_WAIT_V
#undef PG8_WAIT_L
#undef PG8_BAR
#undef PG8_SCHED
}
}
namespace attn_body {
using bf16=__hip_bfloat16;
using bf16x8=__attribute__((ext_vector_type(8)))short;
using s16x4=__attribute__((ext_vector_type(4)))short;
using f32x16=__attribute__((ext_vector_type(16)))float;
using u32x4=__attribute__((ext_vector_type(4)))unsigned;
constexpr int D=64;
constexpr int NW=8,QBLK=32,QB=QBLK*NW,KVBLK=64;
__device__ __forceinline__ int crow(int r,int hi){return (r&3)+8*(r>>2)+4*hi;}
#define SBAR() __builtin_amdgcn_sched_barrier(0)
__device__ __forceinline__ void cmask(f32x16&p0,f32x16&p1,int jb,int qrel,int hi){
  const float NEG=-INFINITY; int kb=64*jb+4*hi;
  #pragma unroll
  for(int r=0;r<16;++r){int kv=kb+(r&3)+8*(r>>2); if(kv>qrel)p0[r]=NEG; if(kv+32>qrel)p1[r]=NEG;}
}

constexpr int NSLOT=3, SLOTB=8192;
constexpr int LDS_K=0, LDS_V=NSLOT*SLOTB, LDS_WS=2*NSLOT*SLOTB, LDS_OST=LDS_WS+NW*64*4, LDS_BYTES=LDS_OST+NW*4096;
constexpr float C2=0.125f*1.4426950408889634f;
__device__ __forceinline__ void glds16(const void*gsrc,unsigned lds_dst){unsigned keep;
  asm volatile("s_mov_b32 %0, m0\n\ts_mov_b32 m0, %2\n\ts_nop 0\n\tglobal_load_lds_dwordx4 %1, off\n\ts_mov_b32 m0, %0":"=&s"(keep):"v"(gsrc),"s"(lds_dst):"memory");}
__device__ __forceinline__ float max3f(float a,float b,float c){float r;asm("v_max3_f32 %0, %1, %2, %3":"=v"(r):"v"(a),"v"(b),"v"(c));return r;}
__device__ __forceinline__ float max2f(float a,float b){float r;asm("v_max_f32_e32 %0, %1, %2":"=v"(r):"v"(a),"v"(b));return r;}
__device__ __forceinline__ float fadd_s(float a,float b){float r;asm("v_add_f32_e32 %0, %1, %2":"=v"(r):"v"(a),"v"(b));return r;}
__device__ __forceinline__ float fsub_s(float a,float b){float r;asm("v_sub_f32_e32 %0, %1, %2":"=v"(r):"v"(a),"v"(b));return r;}
typedef float f32x2_t __attribute__((ext_vector_type(2))); typedef __bf16 bf16x2_t __attribute__((ext_vector_type(2)));
__device__ __forceinline__ unsigned cvtpk_s(float lo,float hi){f32x2_t v={lo,hi};bf16x2_t b=__builtin_convertvector(v,bf16x2_t);return __builtin_bit_cast(unsigned,b);}
#define WAIT_BAR(N) asm volatile("s_waitcnt vmcnt(" #N ") lgkmcnt(0)\n\ts_barrier":::"memory")

__device__ __forceinline__ void qkt(f32x16&p0,f32x16&p1,const char*Kslot,const bf16x8*qr,const f32x16&negm,int r32,int hi){
  const char*kb=Kslot+hi*1024+r32*16;
  #pragma unroll
  for(int d0=0;d0<4;++d0){
    const bf16x8 b0=*reinterpret_cast<const bf16x8*>(kb+d0*2048);
    const bf16x8 b1=*reinterpret_cast<const bf16x8*>(kb+d0*2048+512);
    if(d0==0){p0=__builtin_amdgcn_mfma_f32_32x32x16_bf16(b0,qr[0],negm,0,0,0);p1=__builtin_amdgcn_mfma_f32_32x32x16_bf16(b1,qr[0],negm,0,0,0);}
    else{p0=__builtin_amdgcn_mfma_f32_32x32x16_bf16(b0,qr[d0],p0,0,0,0);p1=__builtin_amdgcn_mfma_f32_32x32x16_bf16(b1,qr[d0],p1,0,0,0);}}
}
typedef __attribute__((address_space(3))) const char* lds_cptr;
typedef short v4i16_t __attribute__((ext_vector_type(4)));
__device__ __forceinline__ void kload8(bf16x8*kf,lds_cptr kp){
  kf[0]=*(const __attribute__((address_space(3))) bf16x8*)(kp);      kf[1]=*(const __attribute__((address_space(3))) bf16x8*)(kp+512);
  kf[2]=*(const __attribute__((address_space(3))) bf16x8*)(kp+2048); kf[3]=*(const __attribute__((address_space(3))) bf16x8*)(kp+2560);
  kf[4]=*(const __attribute__((address_space(3))) bf16x8*)(kp+4096); kf[5]=*(const __attribute__((address_space(3))) bf16x8*)(kp+4608);
  kf[6]=*(const __attribute__((address_space(3))) bf16x8*)(kp+6144); kf[7]=*(const __attribute__((address_space(3))) bf16x8*)(kp+6656);
}
__device__ __forceinline__ void kload2(bf16x8*kf,lds_cptr kp,int j){ kf[2*j]=*(const __attribute__((address_space(3))) bf16x8*)(kp+j*2048); kf[2*j+1]=*(const __attribute__((address_space(3))) bf16x8*)(kp+j*2048+512); }
__device__ __forceinline__ s16x4 vtr(lds_cptr p){ return __builtin_bit_cast(s16x4,__builtin_amdgcn_ds_read_tr16_b64_v4i16((__attribute__((address_space(3))) v4i16_t*)p)); }
__device__ __forceinline__ float rowmax(const f32x16&p0,const f32x16&p1){
  float a=max3f(p0[0],p0[1],p1[0]),b=max3f(p0[2],p0[3],p1[1]);a=max3f(a,p1[2],p1[3]);
  #pragma unroll
  for(int r=4;r<16;r+=4){a=max3f(a,p0[r],p0[r+1]);b=max3f(b,p0[r+2],p0[r+3]);a=max3f(a,p1[r],p1[r+1]);b=max3f(b,p1[r+2],p1[r+3]);}
  const float m=max2f(a,b);
  auto rr=__builtin_amdgcn_permlane32_swap(__float_as_uint(m),__float_as_uint(m),false,false);
  return max2f(__uint_as_float(rr[0]),__uint_as_float(rr[1]));
}
__device__ __forceinline__ void pv(f32x16*o,int vb,bf16x8 pa0,bf16x8 pa1,bf16x8 pa2,bf16x8 pa3){
  #pragma unroll
  for(int d0=0;d0<2;++d0){s16x4 lo[4],hi[4];
    #pragma unroll
    for(int ks=0;ks<4;++ks){
      asm volatile("ds_read_b64_tr_b16 %0,%1 offset:%c2":"=&v"(lo[ks]):"v"(vb),"i"(d0*4096+ks*1024):"memory");
      asm volatile("ds_read_b64_tr_b16 %0,%1 offset:%c2":"=&v"(hi[ks]):"v"(vb),"i"(d0*4096+ks*1024+512):"memory");}
    asm volatile("s_waitcnt lgkmcnt(0)":::"memory");SBAR();
    #define PK(k) (bf16x8){lo[k][0],lo[k][1],lo[k][2],lo[k][3],hi[k][0],hi[k][1],hi[k][2],hi[k][3]}
    o[d0]=__builtin_amdgcn_mfma_f32_32x32x16_bf16(pa0,PK(0),o[d0],0,0,0);
    o[d0]=__builtin_amdgcn_mfma_f32_32x32x16_bf16(pa1,PK(1),o[d0],0,0,0);
    o[d0]=__builtin_amdgcn_mfma_f32_32x32x16_bf16(pa2,PK(2),o[d0],0,0,0);
    o[d0]=__builtin_amdgcn_mfma_f32_32x32x16_bf16(pa3,PK(3),o[d0],0,0,0);
    #undef PK
  }
}

#ifndef ATTN_STORE16
#define ATTN_STORE16(p,v) (*(u32x4*)(p)=(v))
#endif
template<int THRL,int QP,int KP,int OP> __device__ __forceinline__ void attn_unit(const bf16*Qu,const bf16*__restrict__ Kh,const bf16*__restrict__ Vh,bf16*Ou,const int NT,char*shm,int wave_s){
  const int tid=opaque_tid(wave_s),lane=tid&63,r32=lane&31,hi=lane>>5; const int wid=__builtin_amdgcn_readfirstlane(tid>>6);
  const bf16*Qw=Qu+(long)(wid*QBLK)*QP;
  const unsigned lds0=(unsigned)(uintptr_t)shm;
  float*wsf=(float*)(shm+LDS_WS)+wid*64;
  const bf16*ksrc=Kh+(long)lane*KP+wid*8;
  const bf16*vsrc=Vh+(long)(16*(wid&3)+(lane>>2))*KP+(wid>>2)*32+(lane&3)*8;
  const unsigned kdst=lds0+LDS_K+wid*1024, vdst=lds0+LDS_V+wid*1024;
  #define DMA_K(t,slot) glds16(ksrc+(long)(t)*KVBLK*KP,(unsigned)__builtin_amdgcn_readfirstlane(kdst+(slot)))
  #define DMA_V(t,slot) glds16(vsrc+(long)(t)*KVBLK*KP,(unsigned)__builtin_amdgcn_readfirstlane(vdst+(slot)))
  const int vb0=(int)(lds0+LDS_V)+((lane>>4)&1)*32+(lane&3)*8+(4*hi+((lane&15)>>2))*64;
  const char*Kbase=shm+LDS_K; bf16x8 kf[8];
  const lds_cptr shm3=(lds_cptr)shm; const lds_cptr kp0=shm3+LDS_K+hi*1024+r32*16; const lds_cptr vp0=shm3+LDS_V+((lane>>4)&1)*32+(lane&3)*8+(4*hi+((lane&15)>>2))*64;
  DMA_K(0,0);DMA_V(0,0);DMA_K(1,SLOTB);
  bf16x8 qr[4];
  #pragma unroll
  for(int d0=0;d0<4;++d0)qr[d0]=*reinterpret_cast<const bf16x8*>(&Qw[(long)r32*QP+d0*16+hi*8]);
  float mhat=0.f,l_reg=0.f;f32x16 o[2];o[0]=f32x16{};o[1]=f32x16{};f32x16 negm=f32x16{};asm volatile("":"+v"(negm));
  #define CMASK(P0,P1,t) do{}while(0)
  bool resc=false;
  #define START(P0,P1) do{ const float rm=rowmax(P0,P1); resc=false; \
    { const float dl=rm; mhat=fadd_s(mhat,dl); \
      _Pragma("unroll") for(int r=0;r<16;++r){P0[r]=fsub_s(P0[r],dl);P1[r]=fsub_s(P1[r],dl);} \
      _Pragma("unroll") for(int r=0;r<16;++r)negm[r]=-mhat; asm volatile("":"+v"(negm)); } \
    _Pragma("unroll") for(int r=0;r<16;++r)P0[r]=__builtin_amdgcn_exp2f(P0[r]); }while(0)
  #define RESC() do{ if(resc){ asm volatile("s_waitcnt lgkmcnt(0)":::"memory"); \
      _Pragma("unroll") for(int d_=0;d_<2;++d_) _Pragma("unroll") for(int r=0;r<16;++r)o[d_][r]*=wsf[crow(r,hi)]; } }while(0)
  f32x16 pA0,pA1,pB0,pB1;
  int sl_prev=0,sl_cur=0,sl_next=SLOTB;
  #define ROT() do{sl_prev=sl_cur;sl_cur=sl_next;sl_next=(sl_next==(NSLOT-1)*SLOTB)?0:sl_next+SLOTB;}while(0)
  DMA_K(2,2*SLOTB);
  WAIT_BAR(3);
  qkt(pA0,pA1,Kbase,qr,negm,r32,hi);asm volatile("s_nop 15\n\ts_nop 7":"+v"(pA0),"+v"(pA1));CMASK(pA0,pA1,0);
  START(pA0,pA1);
  _Pragma("unroll") for(int r=0;r<16;++r)pA1[r]=__builtin_amdgcn_exp2f(pA1[r]);
  WAIT_BAR(0);
  DMA_K(3,0);DMA_V(1,SLOTB);
  ROT();
  kload8(kf,kp0+sl_cur);
  WAIT_BAR(2);
  s16x4 vlo[8],vhi[8]; u32x4 pw0,pw1,pw2,pw3;
  #define PKW(P,B) cvtpk_s(P[B],P[B+1])
  #define PAF(k) __builtin_bit_cast(bf16x8,pw##k)
  #define VFR(i) (bf16x8){vlo[i][0],vlo[i][1],vlo[i][2],vlo[i][3],vhi[i][0],vhi[i][1],vhi[i][2],vhi[i][3]}
  #define PIN(x) asm volatile("":"+v"(x))
  #define MX3(a,b,c) __builtin_fmaxf(__builtin_fmaxf((a),(b)),(c))
  #define GAPA(MF,A0,A1,A2,A3,W0,W1,PW) do{ MF; sacc+=A0; sacc+=A1; sacc+=A2; sacc+=A3; PIN(sacc); W0; W1; PIN(PW); SBAR(); }while(0)
  #define EX(v) __builtin_amdgcn_exp2f(v)
  #define GAPB(MF,X,B) do{ MF; X[B]=EX(X[B]); X[B+1]=EX(X[B+1]); X[B+2]=EX(X[B+2]); X[B+3]=EX(X[B+3]); PIN(X); SBAR(); }while(0)
  #define VRD(i) do{ vlo[i]=vtr(vp_+(((i)>>2)*4096+((i)&3)*1024)); vhi[i]=vtr(vp_+(((i)>>2)*4096+((i)&3)*1024+512)); }while(0)
  #define KRD(G,j) do{ if(G){ kload2(kf,kp0+sl_next,j); SBAR(); } }while(0)
  #define STEP(C0,C1,P0,P1,t,GK,GV,GL) do{ SBAR(); \
    const lds_cptr vp_=vp0+sl_prev; \
    VRD(0); SBAR(); float sacc=(P0[0]+P0[1]); \
    GAPA(C0=__builtin_amdgcn_mfma_f32_32x32x16_bf16(kf[0],qr[0],negm,0,0,0), P0[2],P0[3],P0[4],P0[5],     pw0[0]=PKW(P0,0), pw0[1]=PKW(P0,2), pw0); \
    VRD(4); SBAR(); GAPA(C1=__builtin_amdgcn_mfma_f32_32x32x16_bf16(kf[1],qr[0],negm,0,0,0), P0[6],P0[7],P0[8],P0[9],     pw0[2]=PKW(P0,4), pw0[3]=PKW(P0,6), pw0); \
    VRD(1); SBAR(); GAPA(C0=__builtin_amdgcn_mfma_f32_32x32x16_bf16(kf[2],qr[1],C0,0,0,0),   P0[10],P0[11],P0[12],P0[13], pw1[0]=PKW(P0,8), pw1[1]=PKW(P0,10), pw1); \
    VRD(5); SBAR(); GAPA(C1=__builtin_amdgcn_mfma_f32_32x32x16_bf16(kf[3],qr[1],C1,0,0,0),   P0[14],P0[15],P1[0],P1[1],   pw1[2]=PKW(P0,12),pw1[3]=PKW(P0,14), pw1); \
    VRD(2); SBAR(); GAPA(C0=__builtin_amdgcn_mfma_f32_32x32x16_bf16(kf[4],qr[2],C0,0,0,0),   P1[2],P1[3],P1[4],P1[5],     pw2[0]=PKW(P1,0), pw2[1]=PKW(P1,2), pw2); \
    VRD(6); SBAR(); GAPA(C1=__builtin_amdgcn_mfma_f32_32x32x16_bf16(kf[5],qr[2],C1,0,0,0),   P1[6],P1[7],P1[8],P1[9],     pw2[2]=PKW(P1,4), pw2[3]=PKW(P1,6), pw2); \
    VRD(3); SBAR(); GAPA(C0=__builtin_amdgcn_mfma_f32_32x32x16_bf16(kf[6],qr[3],C0,0,0,0),   P1[10],P1[11],P1[12],P1[13], pw3[0]=PKW(P1,8), pw3[1]=PKW(P1,10), pw3); \
    VRD(7); SBAR(); GAPA(C1=__builtin_amdgcn_mfma_f32_32x32x16_bf16(kf[7],qr[3],C1,0,0,0),   P1[14],P1[15],0.f,0.f,       pw3[2]=PKW(P1,12),pw3[3]=PKW(P1,14), pw3); \
    l_reg+=sacc; \
    if(GK){DMA_K((t)+3,sl_cur);} if(GV){DMA_V((t)+1,sl_next);} \
    CMASK(C0,C1,t); \
    { float a=MX3(C0[0],C0[1],C1[0]),b=MX3(C0[2],C0[3],C1[1]); a=MX3(a,C1[2],C1[3]); \
      _Pragma("unroll") for(int r=4;r<16;r+=4){a=MX3(a,C0[r],C0[r+1]);b=MX3(b,C0[r+2],C0[r+3]);a=MX3(a,C1[r],C1[r+1]);b=MX3(b,C1[r+2],C1[r+3]);} \
      float rm=__builtin_fmaxf(a,b); { auto rr=__builtin_amdgcn_permlane32_swap(__float_as_uint(rm),__float_as_uint(rm),false,false); rm=__builtin_fmaxf(__uint_as_float(rr[0]),__uint_as_float(rr[1])); } \
      resc=false; \
      if(__builtin_expect(__any(rm>(float)THRL),0)){ const float dl=__builtin_fmaxf(rm,0.f); mhat+=dl; \
        _Pragma("unroll") for(int r=0;r<16;++r){C0[r]-=dl;C1[r]-=dl;} \
        _Pragma("unroll") for(int r=0;r<16;++r)negm[r]=-mhat; asm volatile("":"+v"(negm)); \
        const float f=__builtin_amdgcn_exp2f(-dl); l_reg*=f; if(hi==0)wsf[r32]=f; resc=true; } } \
    SBAR(); \
    GAPB(o[0]=__builtin_amdgcn_mfma_f32_32x32x16_bf16(PAF(0),VFR(0),o[0],0,0,0), C0,0); \
    GAPB(o[1]=__builtin_amdgcn_mfma_f32_32x32x16_bf16(PAF(0),VFR(4),o[1],0,0,0), C0,4); \
    KRD(GL,0); GAPB(o[0]=__builtin_amdgcn_mfma_f32_32x32x16_bf16(PAF(1),VFR(1),o[0],0,0,0), C0,8); \
    KRD(GL,1); GAPB(o[1]=__builtin_amdgcn_mfma_f32_32x32x16_bf16(PAF(1),VFR(5),o[1],0,0,0), C0,12); \
    KRD(GL,2); GAPB(o[0]=__builtin_amdgcn_mfma_f32_32x32x16_bf16(PAF(2),VFR(2),o[0],0,0,0), C1,0); \
    KRD(GL,3); GAPB(o[1]=__builtin_amdgcn_mfma_f32_32x32x16_bf16(PAF(2),VFR(6),o[1],0,0,0), C1,4); \
    GAPB(o[0]=__builtin_amdgcn_mfma_f32_32x32x16_bf16(PAF(3),VFR(3),o[0],0,0,0), C1,8); \
    GAPB(o[1]=__builtin_amdgcn_mfma_f32_32x32x16_bf16(PAF(3),VFR(7),o[1],0,0,0), C1,12); \
    }while(0)
  int t=1;
  #undef CMASK
  #define CMASK(P0,P1,t) do{}while(0)
  for(;t+5<NT;t+=2){
    STEP(pB0,pB1,pA0,pA1,t,true,true,true);     WAIT_BAR(2); RESC(); ROT();
    STEP(pA0,pA1,pB0,pB1,t+1,true,true,true);   WAIT_BAR(2); RESC(); ROT();
  }
  #undef CMASK
  #define CMASK(P0,P1,t) do{}while(0)
  #define ENDW(tt) do{ if((tt)+3<NT){WAIT_BAR(2);} else if((tt)+2<NT){WAIT_BAR(1);} else {WAIT_BAR(0);} }while(0)
  for(;t+1<NT;t+=2){
    STEP(pB0,pB1,pA0,pA1,t,(t+3<NT),(t+1<NT),(t+1<NT));       ENDW(t);   RESC(); ROT();
    STEP(pA0,pA1,pB0,pB1,t+1,(t+4<NT),(t+2<NT),(t+2<NT));     ENDW(t+1); RESC(); ROT();
  }
  STEP(pB0,pB1,pA0,pA1,NT-1,false,false,false); RESC();
  { float sacc=pB0[0]+pB0[1]; _Pragma("unroll") for(int r=2;r<16;++r)sacc+=pB0[r]; _Pragma("unroll") for(int r=0;r<16;++r)sacc+=pB1[r]; l_reg+=sacc;
    pw0=(u32x4){PKW(pB0,0),PKW(pB0,2),PKW(pB0,4),PKW(pB0,6)};pw1=(u32x4){PKW(pB0,8),PKW(pB0,10),PKW(pB0,12),PKW(pB0,14)};pw2=(u32x4){PKW(pB1,0),PKW(pB1,2),PKW(pB1,4),PKW(pB1,6)};pw3=(u32x4){PKW(pB1,8),PKW(pB1,10),PKW(pB1,12),PKW(pB1,14)};
    SBAR(); pv(o,vb0+sl_cur,PAF(0),PAF(1),PAF(2),PAF(3)); }
  #undef PKW
  #undef PAF
  #undef VFR
  #undef PIN
  #undef MX3
  #undef GAPA
  #undef GAPB
  #undef EX
  #undef VRD
  #undef KRD
  #undef STEP
  #undef ENDW
  {auto rr=__builtin_amdgcn_permlane32_swap(__float_as_uint(l_reg),__float_as_uint(l_reg),false,false);l_reg=__uint_as_float(rr[0])+__uint_as_float(rr[1]);}
  if(hi==0)wsf[32+r32]=l_reg;asm volatile("s_waitcnt lgkmcnt(0)":::"memory");
  float rli[16];
  #pragma unroll
  for(int r=0;r<16;++r)rli[r]=__builtin_amdgcn_rcpf(wsf[32+crow(r,hi)]);
  bf16*Ow=Ou+(long)(wid*QBLK)*OP;
  { bf16*stg=(bf16*)(shm+LDS_OST)+wid*2048;
    #pragma unroll
    for(int r=0;r<16;++r){const int orow=crow(r,hi);
      #pragma unroll
      for(int d0=0;d0<2;++d0)stg[orow*64+d0*32+r32]=__float2bfloat16(o[d0][r]*rli[r]);}
    asm volatile("s_waitcnt lgkmcnt(0)":::"memory");
    #pragma unroll
    for(int i=0;i<4;++i){const int row=i*8+(lane>>3),ch=lane&7; const u32x4 v=*(const u32x4*)(stg+row*64+ch*8); ATTN_STORE16(Ow+(long)row*OP+ch*8,v);} }
  asm volatile("s_waitcnt lgkmcnt(0)\n\ts_barrier":::"memory");
  #undef DMA_K
  #undef DMA_V
  #undef CMASK
  #undef START
  #undef RESC
  #undef ROT
}
constexpr int ATTN_LDS_BYTES=LDS_BYTES;
#undef SBAR
#undef WAIT_BAR
}
#define LDS_WAIT() asm volatile("s_waitcnt lgkmcnt(0)" ::: "memory")

__device__ __forceinline__ void transpose_item(const float* W, int K, int N, bf16* WT, int k0, int n0, int dest_row0, LAS float* scr, int lane) {
    float t_[32];
#pragma unroll
    for (int i = 0; i < 32; ++i) t_[i] = W[(size_t)(k0 + 2 * i + (lane >> 5)) * N + n0 + (lane & 31)];
#pragma unroll
    for (int i = 0; i < 32; ++i) scr[(2 * i + (lane >> 5)) * 33 + (lane & 31)] = t_[i];
    LDS_WAIT(); asm volatile("" ::: "memory");
    const int c = lane & 7;
#pragma unroll
    for (int j = 0; j < 4; ++j) { const int n = (lane >> 3) + 8 * j; const LAS float* s = scr + (8 * c) * 33 + n;
        v4u o; o.x = pk2(s[0 * 33], s[1 * 33]); o.y = pk2(s[2 * 33], s[3 * 33]); o.z = pk2(s[4 * 33], s[5 * 33]); o.w = pk2(s[6 * 33], s[7 * 33]);
        *(GAS v4u*)(WT + (size_t)(dest_row0 + n) * K + k0 + 8 * c) = o; }
    LDS_WAIT(); asm volatile("" ::: "memory");
}

template <int KMODE>
__device__ __forceinline__ void transpose_item8(const float* W, int K, int N, unsigned char* WT, int k0, int n0, int dest_row0, float sc, LAS float* scr, int lane) {
    float t_[32];
#pragma unroll
    for (int i = 0; i < 32; ++i) t_[i] = W[(size_t)(k0 + 2 * i + (lane >> 5)) * N + n0 + (lane & 31)];
#pragma unroll
    for (int i = 0; i < 32; ++i) scr[(2 * i + (lane >> 5)) * 33 + (lane & 31)] = __builtin_amdgcn_fmed3f(t_[i] * sc, -448.f, 448.f);
    LDS_WAIT(); asm volatile("" ::: "memory");
    const int c = lane & 7, w = c >> 2, fq = c & 3, wh = (k0 >> 6) & 1;
    const int doff = KMODE == 1 ? (k0 & ~255) + 64 * (2 * wh + w) + 16 * fq + 8 * ((k0 >> 7) & 1) : KMODE == 2 ? (k0 & ~127) + 32 * (2 * wh + w) + 8 * fq : k0 + 8 * c;
#pragma unroll
    for (int j = 0; j < 4; ++j) { const int n = (lane >> 3) + 8 * j; const LAS float* s = scr + n;
        float v[8];
#pragma unroll
        for (int e = 0; e < 8; ++e) { const int kk = KMODE == 2 ? 32 * w + 16 * (e >> 2) + 4 * fq + (e & 3) : 8 * c + e; v[e] = s[kk * 33]; }
        unsigned w0 = 0, w1 = 0;
        w0 = __builtin_amdgcn_cvt_pk_fp8_f32(v[0], v[1], w0, false); w0 = __builtin_amdgcn_cvt_pk_fp8_f32(v[2], v[3], w0, true);
        w1 = __builtin_amdgcn_cvt_pk_fp8_f32(v[4], v[5], w1, false); w1 = __builtin_amdgcn_cvt_pk_fp8_f32(v[6], v[7], w1, true);
        *(GAS v2u*)(WT + (size_t)(dest_row0 + n) * K + doff) = (v2u){w0, w1}; }
    LDS_WAIT(); asm volatile("" ::: "memory");
}

struct ProIn { const float *hy_w_in, *at_w_in, *w_out, *w_mem_kv; };
__device__ __forceinline__ void phase_weights(const ProIn& P, unsigned char* ws, LAS unsigned char* lds, int gw, int NGW, int wave, int lane) {
    LAS float* scr = (LAS float*)(lds + wave * 16384);
    constexpr int I_HY = 16 * 80, I_AT = 16 * 48, I_OUT = 16 * 32, I_MKV = 16 * 16;
    constexpr int E0 = 2 * I_HY, E1 = E0 + 2 * I_AT, E2 = E1 + 4 * I_OUT, E3 = E2 + 4 * I_MKV;
    for (int it = gw; it < E3; it += NGW) {
        int r = it;
        if (r < E0) { const int j = r / I_HY, q = r % I_HY, kb = q / 80, nb = q % 80;
            transpose_item(P.hy_w_in + (size_t)j * DM * D_IN_HY, DM, D_IN_HY, (bf16*)(ws + WS_WHY) + (size_t)j * D_IN_HY * DM, 64 * kb, 32 * nb, 32 * nb, scr, lane); continue; }
        r -= E0;
        if (r < 2 * I_AT) { const int j = r / I_AT, q = r % I_AT, kb = q / 48, nb = q % 48;
            const int n0 = 32 * nb, o = n0 & 255;
            transpose_item(P.at_w_in + (size_t)j * DM * D_IN_AT, DM, D_IN_AT, (bf16*)(ws + WS_WAT) + (size_t)j * D_IN_AT * DM, 64 * kb, n0, (n0 & ~255) + 128 * ((o & 63) >> 5) + 32 * (o >> 6), scr, lane); continue; }
        r -= 2 * I_AT;
        if (r < 4 * I_OUT) { const int j = r / I_OUT, q = r % I_OUT, kb = q / 32, nb = q % 32;
            transpose_item(P.w_out + (size_t)j * DM * DM, DM, DM, (bf16*)(ws + WS_WOUT) + (size_t)j * DM * DM, 64 * kb, 32 * nb, 32 * nb, scr, lane); continue; }
        r -= 4 * I_OUT;
        { const int j = r / I_MKV, q = r % I_MKV, kb = q / 16, nb = q % 16;
            transpose_item(P.w_mem_kv + (size_t)j * DM * 512, DM, 512, (bf16*)(ws + WS_WMKV), 64 * kb, 32 * nb, j * 512 + 32 * nb, scr, lane); }
        (void)r;
    }
}

struct XwIn { const float *w_gate, *w_up, *w_down; unsigned char* ws; };
constexpr int XW_PER_EXPERT = 3 * 384, XW_PER_LAYER = NEXP * XW_PER_EXPERT;
constexpr int XW_QA_HY = 5, XW_QA_AT = 4, XW_QB = 3, XW_NA = 128 * NWAVES, XW_NB = 224 * NWAVES;
__host__ __device__ constexpr int xw_qa(int layer) { return (layer & 1) ? XW_QA_AT : XW_QA_HY; }
__host__ __device__ constexpr int xw_p0(int layer, bool sched) { return sched ? XW_PER_LAYER - xw_qa(layer) * XW_NA - XW_QB * XW_NB : XW_PER_LAYER; }
__device__ __forceinline__ void xw_item(const XwIn& B, int layer, int r, LAS float* scr, int lane) {
    const int j = layer * NEXP + r / XW_PER_EXPERT, q = r % XW_PER_EXPERT, kind = q / 384, qq = q % 384;
    if (kind < 2) { const int kb = qq / 24, nb = qq % 24, n0 = 32 * nb;
        transpose_item8<1>((kind == 0 ? B.w_gate : B.w_up) + (size_t)j * DM * EFF, DM, EFF, B.ws + WS_W1 + (size_t)j * 1536 * DM, 64 * kb, n0, (n0 >> 7) * 256 + 128 * kind + (n0 & 127), W8_SCALE, scr, lane); }
    else { const int kb = qq / 32, nb = qq % 32;
        transpose_item8<2>(B.w_down + (size_t)j * EFF * DM, EFF, DM, B.ws + WS_W2 + (size_t)j * DM * EFF, 64 * kb, 32 * nb, 32 * nb, W8_SCALE, scr, lane); }
}
__device__ __forceinline__ void phase_xw_p0(const XwIn& B, bool sched, LAS float* scr, int gw, int NGW, int lane) {
#pragma unroll 1
    for (int layer = 0; layer < DEPTH; ++layer) { const int n = xw_p0(layer, sched);
#pragma unroll 1
        for (int r = gw; r < n; r += NGW) xw_item(B, layer, r, scr, lane); }
}
__device__ __forceinline__ void xw_slice_a(const XwIn& B, int layer, LAS float* scr, int bx, int wave, int lane) {
    const int base = xw_p0(layer, true) + (bx - 128) * NWAVES + wave;
#pragma unroll 1
    for (int k = 0; k < xw_qa(layer); ++k) xw_item(B, layer, base + k * XW_NA, scr, lane);
}
__device__ __forceinline__ void xw_slice_b(const XwIn& B, int layer, LAS float* scr, int bx, int wave, int lane) {
    const int base = xw_p0(layer, true) + xw_qa(layer) * XW_NA + (bx - 32) * NWAVES + wave;
#pragma unroll 1
    for (int k = 0; k < XW_QB; ++k) xw_item(B, layer, base + k * XW_NB, scr, lane);
}

__device__ __forceinline__ void phase_wrg(const float* ffn_g, const float* router, float* WRG, int gtid, int nthreads) {
    for (int q = gtid; q < DEPTH * NEXP * DM; q += nthreads) { const int l = q / (NEXP * DM), e = (q / DM) % NEXP, d = q % DM; WRG[q] = ffn_g[l * DM + d] * router[((size_t)l * DM + d) * NEXP + e]; }
}

__device__ __forceinline__ void rms_row_bf16(const float* xrow, const float* g, bf16* orow, int lane) {
    const GAS f32x4* xr = (const GAS f32x4*)xrow + lane; const GAS f32x4* gr = (const GAS f32x4*)g + lane;
    f32x4 v[4]; float s = 0.f;
#pragma unroll
    for (int j = 0; j < 4; ++j) { v[j] = xr[64 * j]; s += (v[j].x * v[j].x + v[j].y * v[j].y) + (v[j].z * v[j].z + v[j].w * v[j].w); }
    const float rstd = 1.f / sqrtf(wave_sum(s) * (1.f / DM) + NORM_EPS);
    GAS v2u* o8 = (GAS v2u*)orow + lane;
#pragma unroll
    for (int j = 0; j < 4; ++j) { const f32x4 gg = gr[64 * j]; v2u w; w.x = pk2(v[j].x * rstd * gg.x, v[j].y * rstd * gg.y); w.y = pk2(v[j].z * rstd * gg.z, v[j].w * rstd * gg.w); o8[64 * j] = w; }
}

__device__ __forceinline__ void phase_mem_h2(const float* mem, const float* mem_g, const float* fw1, const float* fb1, const float* fw2, const float* fb2, const float* ffreq,
                                              unsigned char* ws, int gw, int NGW, int lane) {
    for (int m = gw; m < BATCH * MEM_LEN; m += NGW) rms_row_bf16(mem + (size_t)m * DM, mem_g, (bf16*)(ws + WS_MEMN) + (size_t)m * DM, lane);
    float* H2 = (float*)(ws + WS_H2);
    for (int it = gw; it < 2 * SEQ; it += NGW) {
        const int j = it / SEQ, n = it % SEQ;
        const float* w1 = fw1 + j * HY_EMB * HY_FILT; const float* w2 = fw2 + j * HY_FILT * HY_FILT;
        const float t = (float)n * (1.0f / (float)(SEQ - 1));
        const float w = (6.283185307179586f * (float)n) / (float)SEQ;
        float feat = 0.f;
        if (lane == 0) feat = t;
        else if (lane <= 16) { const float band = 1e-4f + (float)(lane - 1) * ((15.0f - 1e-4f) / 15.0f); feat = cosf(band * w); }
        else if (lane <= 32) { const float band = 1e-4f + (float)(lane - 17) * ((15.0f - 1e-4f) / 15.0f); feat = -sinf(band * w); }
        const float fr = ffreq[j * HY_FILT + lane];
        float a = fb1[j * HY_FILT + lane];
        for (int i = 0; i < HY_EMB; ++i) a += __shfl(feat, i) * w1[i * HY_FILT + lane];
        const float h1 = sinf(fr * a);
        float a2 = fb2[j * HY_FILT + lane];
        for (int i = 0; i < HY_FILT; ++i) a2 += __shfl(h1, i) * w2[i * HY_FILT + lane];
        H2[(size_t)it * HY_FILT + lane] = sinf(fr * a2);
    }
}

template <bool COMBINE, bool FINAL>
__device__ __forceinline__ void phase_norm(const float* hin, float* hout, const float* g, bf16* U, float* fout, const int* POS, const bf16* Y, int gw, int NGW, int lane) {
    int m = gw;
    if (m >= M_TOK) return;
    f32x4 cur[4]; int cpos = -1;
    { const GAS f32x4* xr = (const GAS f32x4*)(hin + (size_t)m * DM) + lane;
#pragma unroll
      for (int j = 0; j < 4; ++j) cur[j] = xr[64 * j];
      if (COMBINE) { const int b = m / SEQ, t = m % SEQ; if (lane < NEXP) cpos = POS[(size_t)(b * NEXP + lane) * SEQ + t]; } }
#pragma unroll 1
    for (; m < M_TOK; m += NGW) {
        const int mn = m + NGW; f32x4 nxt[4]; int npos = -1;
#pragma unroll
        for (int j = 0; j < 4; ++j) nxt[j] = cur[j];
        if (mn < M_TOK) { const GAS f32x4* xr = (const GAS f32x4*)(hin + (size_t)mn * DM) + lane;
#pragma unroll
            for (int j = 0; j < 4; ++j) nxt[j] = xr[64 * j];
            if (COMBINE) { const int b = mn / SEQ, t = mn % SEQ; if (lane < NEXP) npos = POS[(size_t)(b * NEXP + lane) * SEQ + t]; } }
        f32x4 v[4];
#pragma unroll
        for (int j = 0; j < 4; ++j) v[j] = cur[j];
        if (COMBINE) {
            const int b = m / SEQ;
            unsigned long long mask = __ballot(cpos >= 0);
            while (mask) {
                v2u y[4][4]; bool has[4];
#pragma unroll
                for (int k = 0; k < 4; ++k) { has[k] = mask != 0ull;
                    if (has[k]) { const int e = __builtin_amdgcn_readfirstlane(__builtin_ctzll(mask)); mask &= mask - 1ull; const int p = __builtin_amdgcn_readlane(cpos, e);
                        const GAS v2u* yr = (const GAS v2u*)(Y + ((size_t)(b * NEXP + e) * CAP + p) * DM) + lane;
#pragma unroll
                        for (int j = 0; j < 4; ++j) y[k][j] = yr[64 * j]; } }
#pragma unroll
                for (int k = 0; k < 4; ++k) if (has[k]) {
#pragma unroll
                    for (int j = 0; j < 4; ++j) { const v2u w = y[k][j]; v[j].x += bflo(w.x); v[j].y += bfhi(w.x); v[j].z += bflo(w.y); v[j].w += bfhi(w.y); } }
            }
            if (!FINAL) { GAS f32x4* ho = (GAS f32x4*)(hout + (size_t)m * DM) + lane;
#pragma unroll
                for (int j = 0; j < 4; ++j) ho[64 * j] = v[j]; }
        }
        float s = 0.f;
#pragma unroll
        for (int j = 0; j < 4; ++j) s += (v[j].x * v[j].x + v[j].y * v[j].y) + (v[j].z * v[j].z + v[j].w * v[j].w);
        const float rstd = 1.f / sqrtf(wave_sum(s) * (1.f / DM) + NORM_EPS);
        const GAS f32x4* gr = (const GAS f32x4*)g + lane;
        if (FINAL) { GAS f32x4* o = (GAS f32x4*)(fout + (size_t)m * DM) + lane;
#pragma unroll
            for (int j = 0; j < 4; ++j) o[64 * j] = v[j] * rstd * gr[64 * j]; }
        else { GAS v2u* o8 = (GAS v2u*)(U + (size_t)m * DM) + lane;
#pragma unroll
            for (int j = 0; j < 4; ++j) { const f32x4 gg = gr[64 * j]; v2u w; w.x = pk2(v[j].x * rstd * gg.x, v[j].y * rstd * gg.y); w.y = pk2(v[j].z * rstd * gg.z, v[j].w * rstd * gg.w); o8[64 * j] = w; } }
#pragma unroll
        for (int j = 0; j < 4; ++j) cur[j] = nxt[j];
        cpos = npos;
    }
}

__device__ __forceinline__ void phase_ffn_norm_router(const float* H, const float* g, const float* Wr, unsigned char* XN8, float* AFF, LAS unsigned char* lds, int gw, int NGW, int lane, int tid) {
    LAS f32x4* WL = (LAS f32x4*)lds;
    for (int q = tid; q < 64 * 64; q += NTHREADS) { const int ln = q & 63, s = q >> 6, e4 = s & 3, ji = s >> 2, i = ji & 3, j = ji >> 2; const int d = 4 * ln + i + 256 * j;
        WL[q] = *(const GAS f32x4*)(Wr + (size_t)d * NEXP + 4 * e4); }
    __syncthreads();
    constexpr int R = 4;
    const GAS f32x4* gr = (const GAS f32x4*)g + lane;
#pragma unroll 1
    for (int m0 = gw * R; m0 < M_TOK; m0 += NGW * R) {
        int lo_ = lane; asm volatile("" : "+v"(lo_));
        f32x4 v[R][4]; float rstd[R];
#pragma unroll
        for (int r = 0; r < R; ++r) { const GAS f32x4* xr = (const GAS f32x4*)(H + (size_t)(m0 + r) * DM) + lane;
#pragma unroll
            for (int j = 0; j < 4; ++j) v[r][j] = xr[64 * j]; }
#pragma unroll
        for (int r = 0; r < R; ++r) { float s = 0.f;
#pragma unroll
            for (int j = 0; j < 4; ++j) s += (v[r][j].x * v[r][j].x + v[r][j].y * v[r][j].y) + (v[r][j].z * v[r][j].z + v[r][j].w * v[r][j].w);
            rstd[r] = 1.f / sqrtf(wave_sum(s) * (1.f / DM) + NORM_EPS); }
        f32x4 lg[R][4];
#pragma unroll
        for (int r = 0; r < R; ++r)
#pragma unroll
            for (int e4 = 0; e4 < 4; ++e4) lg[r][e4] = (f32x4){0.f, 0.f, 0.f, 0.f};
#pragma unroll
        for (int j = 0; j < 4; ++j) { const f32x4 gg = gr[64 * j];
#pragma unroll
            for (int r = 0; r < R; ++r) { v[r][j] = v[r][j] * rstd[r] * gg;
                unsigned w = 0; w = __builtin_amdgcn_cvt_pk_fp8_f32(v[r][j].x, v[r][j].y, w, false); w = __builtin_amdgcn_cvt_pk_fp8_f32(v[r][j].z, v[r][j].w, w, true);
                ((GAS unsigned*)(XN8 + (size_t)(m0 + r) * DM) + lane)[64 * j] = w; }
#pragma unroll
            for (int i = 0; i < 4; ++i)
#pragma unroll
                for (int e4 = 0; e4 < 4; ++e4) { const f32x4 wv = WL[((j * 4 + i) * 4 + e4) * 64 + lo_];
#pragma unroll
                    for (int r = 0; r < R; ++r) { const float xs = v[r][j][i];
#pragma unroll
                        for (int c = 0; c < 4; ++c) asm("v_fmac_f32 %0, %1, %2" : "+v"(lg[r][e4][c]) : "v"(wv[c]), "v"(xs)); } }
            __builtin_amdgcn_sched_barrier(0); }
#pragma unroll
        for (int r = 0; r < R; ++r) {
            float l16[16];
#pragma unroll
            for (int e = 0; e < 16; ++e) l16[e] = wave_sum(lg[r][e >> 2][e & 3]);
            float mx = l16[0];
#pragma unroll
            for (int e = 1; e < 16; ++e) mx = fmaxf(mx, l16[e]);
            float den = 0.f;
#pragma unroll
            for (int e = 0; e < 16; ++e) { l16[e] = expf(l16[e] - mx); den += l16[e]; }
            float mine = 0.f;
#pragma unroll
            for (int e = 0; e < 16; ++e) mine = (lane == e) ? l16[e] : mine;
            const int m = m0 + r, b = m / SEQ, t = m % SEQ;
            if (lane < NEXP) AFF[(size_t)(b * NEXP + lane) * SEQ + t] = mine / den;
        }
    }
    __syncthreads();
}

__device__ __forceinline__ void phase_router_sum(const float* PLG, const float* PSS, float* RSTD, float* AFF, int gw, int NGW, int lane) {
    const int e = lane & 15, rq = lane >> 4;
    for (int m0 = gw * 4; m0 < M_TOK; m0 += NGW * 4) {
        const int m = m0 + rq;
        float lgt = 0.f;
#pragma unroll
        for (int slot = 0; slot < 16; ++slot) lgt += PLG[((size_t)slot * M_TOK + m) * 16 + e];
        float ss = PSS[(size_t)e * M_TOK + m];
#pragma unroll
        for (int o = 1; o < 16; o <<= 1) ss += __shfl_xor(ss, o);
        const float rstd = 1.f / sqrtf(ss * (1.f / DM) + NORM_EPS);
        lgt *= rstd;
        float mx = lgt;
#pragma unroll
        for (int o = 1; o < 16; o <<= 1) mx = fmaxf(mx, __shfl_xor(mx, o));
        const float ex = expf(lgt - mx); float den = ex;
#pragma unroll
        for (int o = 1; o < 16; o <<= 1) den += __shfl_xor(den, o);
        const int b = m / SEQ, t = m % SEQ;
        AFF[(size_t)(b * NEXP + e) * SEQ + t] = ex / den;
        if (e == 0) RSTD[m] = rstd;
    }
}

__device__ __forceinline__ int block_excl_scan(int v, LAS int* scr, int tid, int lane, int wave, int* tot) {
    int inc = v;
#pragma unroll
    for (int o = 1; o < 64; o <<= 1) { const int n = __shfl_up(inc, o); if (lane >= o) inc += n; }
    __syncthreads();
    if (lane == 63) scr[wave] = inc;
    __syncthreads();
    int base = 0, total = 0;
#pragma unroll
    for (int w = 0; w < NWAVES; ++w) { const int c = scr[w]; if (w < wave) base += c; total += c; }
    *tot = total;
    return base + inc - v;
}

__device__ __forceinline__ void phase_topk(const float* AFF, const float* RSTD, float* RS, int* IDX, float* GATE, int* POS, LAS unsigned char* ldsm, int blk, int nblk, int tid, int lane, int wave) {
    LAS int* hist = (LAS int*)ldsm;
    LAS int* sel = (LAS int*)(ldsm + 1024);
    LAS int* scr = (LAS int*)(ldsm + 1280);
    for (int g = blk; g < NGRP; g += nblk) {
        unsigned v[16];
        { const GAS v4u* src = (const GAS v4u*)(AFF + (size_t)g * SEQ) + tid * 4;
#pragma unroll
          for (int q = 0; q < 4; ++q) { const v4u w = src[q]; v[4 * q] = w.x; v[4 * q + 1] = w.y; v[4 * q + 2] = w.z; v[4 * q + 3] = w.w; } }
        unsigned prefix = 0u; int krem = CAP;
#pragma unroll 1
        for (int pass = 0; pass < 4; ++pass) {
            const int shift = 24 - 8 * pass;
            const unsigned himask = (pass == 0) ? 0u : (0xffffffffu << (shift + 8));
            __syncthreads();
            if (tid < 256) hist[tid] = 0;
            __syncthreads();
#pragma unroll
            for (int i = 0; i < 16; ++i) if ((v[i] & himask) == prefix) __hip_atomic_fetch_add(hist + ((v[i] >> shift) & 255u), 1, __ATOMIC_RELAXED, __HIP_MEMORY_SCOPE_WORKGROUP);
            __syncthreads();
            if (wave == 0) {
                int c[4]; int s = 0;
#pragma unroll
                for (int j = 0; j < 4; ++j) { c[j] = hist[255 - 4 * lane - j]; s += c[j]; }
                int inc = s;
#pragma unroll
                for (int o = 1; o < 64; o <<= 1) { const int n = __shfl_up(inc, o); if (lane >= o) inc += n; }
                int before = inc - s;
                if (before < krem && krem <= inc) {
                    int bin = 0, kk = krem - before; bool done = false;
#pragma unroll
                    for (int j = 0; j < 4; ++j) { if (!done) { if (kk <= c[j]) { bin = 255 - 4 * lane - j; done = true; } else kk -= c[j]; } }
                    sel[0] = bin; sel[1] = kk;
                }
            }
            __syncthreads();
            prefix |= ((unsigned)sel[0]) << shift; krem = sel[1];
        }
        int ceq = 0;
#pragma unroll
        for (int i = 0; i < 16; ++i) ceq += (v[i] == prefix) ? 1 : 0;
        int tot;
        int eqrank = block_excl_scan(ceq, scr, tid, lane, wave, &tot);
        int csel = 0; unsigned selmask = 0u;
#pragma unroll
        for (int i = 0; i < 16; ++i) { bool s = v[i] > prefix; if (v[i] == prefix) { s = eqrank < krem; ++eqrank; } if (s) { selmask |= 1u << i; ++csel; } }
        int slot = block_excl_scan(csel, scr, tid, lane, wave, &tot);
        const int b = g / NEXP;
        int pv[16];
#pragma unroll
        for (int i = 0; i < 16; ++i) {
            pv[i] = -1;
            if (selmask & (1u << i)) { pv[i] = slot; IDX[g * CAP + slot] = b * SEQ + tid * 16 + i; GATE[g * CAP + slot] = __builtin_bit_cast(float, v[i]); RS[g * CAP + slot] = RSTD[b * SEQ + tid * 16 + i]; ++slot; }
        }
        { GAS v4u* dst = (GAS v4u*)(POS + (size_t)g * SEQ) + tid * 4;
#pragma unroll
          for (int q = 0; q < 4; ++q) { v4u w; w.x = (unsigned)pv[4 * q]; w.y = (unsigned)pv[4 * q + 1]; w.z = (unsigned)pv[4 * q + 2]; w.w = (unsigned)pv[4 * q + 3]; dst[q] = w; } }
        __syncthreads();
    }
}

__device__ __forceinline__ void phase_gather(const bf16* XN, const int* IDX, bf16* XG, int gw, int NGW, int lane) {
    for (int r = gw; r < XROWS; r += NGW) {
        const int src = __builtin_amdgcn_readfirstlane(IDX[r]);
        const GAS v4u* s = (const GAS v4u*)(XN + (size_t)src * DM) + lane; GAS v4u* d = (GAS v4u*)(XG + (size_t)r * DM) + lane;
        const v4u a = s[0], b = s[64]; d[0] = a; d[64] = b;
    }
}

__device__ __forceinline__ void phase_qk_rope(bf16* P, const float* gq, const float* gk, int gw, int NGW, int lane) {
    const int hh = lane >> 2, part = lane & 3, axis = part >> 1, half = part & 1;
    const float* g = (hh < NQH ? gq : gk) + 16 * part;
    float gv[16], inv[16];
#pragma unroll
    for (int i = 0; i < 16; ++i) { gv[i] = g[i]; inv[i] = exp2f(-(float)i * (13.287712379549449f / 16.0f)); }
    const float osc = hh < NQH ? ATT_C2 : 1.0f;
    int m = gw; v4u c0 = (v4u){0u, 0u, 0u, 0u}, c1 = c0;
    if (m < M_TOK) { const GAS v4u* p = (const GAS v4u*)(P + (size_t)m * D_IN_AT + hh * HD + 16 * part); c0 = p[0]; c1 = p[1]; }
#pragma unroll 1
    for (; m < M_TOK; m += NGW) {
        const int t = m % SEQ; const float pos = (float)(axis == 0 ? (t >> 6) : (t & 63));
        GAS v4u* p = (GAS v4u*)(P + (size_t)m * D_IN_AT + hh * HD + 16 * part);
        const v4u w0 = c0, w1 = c1;
        if (m + NGW < M_TOK) { const GAS v4u* pn = (const GAS v4u*)(P + (size_t)(m + NGW) * D_IN_AT + hh * HD + 16 * part); c0 = pn[0]; c1 = pn[1]; }
        float x[16];
        x[0] = bflo(w0.x); x[1] = bfhi(w0.x); x[2] = bflo(w0.y); x[3] = bfhi(w0.y); x[4] = bflo(w0.z); x[5] = bfhi(w0.z); x[6] = bflo(w0.w); x[7] = bfhi(w0.w);
        x[8] = bflo(w1.x); x[9] = bfhi(w1.x); x[10] = bflo(w1.y); x[11] = bfhi(w1.y); x[12] = bflo(w1.z); x[13] = bfhi(w1.z); x[14] = bflo(w1.w); x[15] = bfhi(w1.w);
        float ss = 0.f;
#pragma unroll
        for (int i = 0; i < 16; ++i) ss += x[i] * x[i];
        ss += __shfl_xor(ss, 1); ss += __shfl_xor(ss, 2);
        const float rstd = 1.f / sqrtf(ss * (1.f / HD) + NORM_EPS);
        float o[16];
#pragma unroll
        for (int i = 0; i < 16; ++i) {
            const float xn = x[i] * rstd * gv[i]; const float xp = __shfl_xor(xn, 1);
            float sn, cs; sincosf(pos * inv[i], &sn, &cs);
            o[i] = (half == 0 ? (xn * cs - xp * sn) : (xp * sn + xn * cs)) * osc;
        }
        v4u r0, r1;
        r0.x = pk2(o[0], o[1]); r0.y = pk2(o[2], o[3]); r0.z = pk2(o[4], o[5]); r0.w = pk2(o[6], o[7]);
        r1.x = pk2(o[8], o[9]); r1.y = pk2(o[10], o[11]); r1.z = pk2(o[12], o[13]); r1.w = pk2(o[14], o[15]);
        p[0] = r0; p[1] = r1;
    }
}

__device__ __forceinline__ void phase_transpose_mix(const bf16* MIXT, bf16* MIX, LAS unsigned char* lds, int blk, int nblk, int tid) {
    constexpr int TP = 516;
    for (int it = blk; it < (D_MAIN / 64) * (M_TOK / 256); it += nblk) {
        const int cb = it % (D_MAIN / 64), mb = it / (D_MAIN / 64), c0 = cb * 64, m0 = mb * 256;
        __syncthreads();
#pragma unroll
        for (int k = 0; k < 4; ++k) { const int p = tid + NTHREADS * k, ch = p >> 5, seg = p & 31;
            const v4u w = *(const GAS v4u*)(MIXT + (size_t)(c0 + ch) * M_TOK + m0 + seg * 8);
            LAS unsigned* d = (LAS unsigned*)(lds + ch * TP + seg * 16); d[0] = w.x; d[1] = w.y; d[2] = w.z; d[3] = w.w; }
        __syncthreads();
#pragma unroll
        for (int k = 0; k < 4; ++k) { const int q = tid + NTHREADS * k, r = q >> 3, j = q & 7;
            const LAS bf16* s = (const LAS bf16*)(lds + (8 * j) * TP) + r;
            v4u o; o.x = (unsigned)s[0] | ((unsigned)s[TP / 2] << 16); o.y = (unsigned)s[2 * (TP / 2)] | ((unsigned)s[3 * (TP / 2)] << 16);
            o.z = (unsigned)s[4 * (TP / 2)] | ((unsigned)s[5 * (TP / 2)] << 16); o.w = (unsigned)s[6 * (TP / 2)] | ((unsigned)s[7 * (TP / 2)] << 16);
            *(GAS v4u*)(MIX + (size_t)(m0 + r) * DM + c0 + 8 * j) = o; }
    }
    __syncthreads();
}
__device__ __forceinline__ void phase_taps(const float* H2j, const float* w3, float* TAPS, int gw, int NGW, int lane) {
    typedef float f32x16 __attribute__((ext_vector_type(16))); typedef short bf16x8_t __attribute__((ext_vector_type(8)));
    const float min_decay = -4.605170185988091f / 1.5f, max_decay = -4.605170185988091f / 0.3f;
    const int li = lane & 31, hi = lane >> 5;
#pragma unroll 1
    for (int it = gw; it < (FCOLS / 32) * (SEQ / 128); it += NGW) {
        const int ct = it % (FCOLS / 32), ng = it / (FCOLS / 32), col0 = ct * 32;
        bf16x8_t a[4];
#pragma unroll
        for (int s = 0; s < 4; ++s) { float t[8];
#pragma unroll
            for (int j = 0; j < 8; ++j) t[j] = w3[(size_t)(16 * s + 8 * hi + j) * FCOLS + col0 + li];
            v4u p; p.x = pk2(t[0], t[1]); p.y = pk2(t[2], t[3]); p.z = pk2(t[4], t[5]); p.w = pk2(t[6], t[7]); a[s] = __builtin_bit_cast(bf16x8_t, p); }
        f32x4 hv[4][8];
#pragma unroll
        for (int nt = 0; nt < 4; ++nt) { const GAS f32x4* hp = (const GAS f32x4*)(H2j + (size_t)(ng * 128 + nt * 32 + li) * HY_FILT + 8 * hi);
#pragma unroll
            for (int s = 0; s < 4; ++s) { hv[nt][2 * s] = hp[4 * s]; hv[nt][2 * s + 1] = hp[4 * s + 1]; } }
#pragma unroll
        for (int nt = 0; nt < 4; ++nt) {
            const int n0 = ng * 128 + nt * 32;
            f32x16 acc;
#pragma unroll
            for (int r = 0; r < 16; ++r) acc[r] = 0.f;
#pragma unroll
            for (int s = 0; s < 4; ++s) { const f32x4 v0 = hv[nt][2 * s], v1 = hv[nt][2 * s + 1];
                v4u p; p.x = pk2(v0.x, v0.y); p.y = pk2(v0.z, v0.w); p.z = pk2(v1.x, v1.y); p.w = pk2(v1.z, v1.w);
                acc = __builtin_amdgcn_mfma_f32_32x32x16_bf16(a[s], __builtin_bit_cast(bf16x8_t, p), acc, 0, 0, 0); }
            const float t = (float)(n0 + li) * (1.0f / (float)(SEQ - 1));
#pragma unroll
            for (int r = 0; r < 16; ++r) { const int col = col0 + (r & 3) + 8 * (r >> 2) + 4 * hi, c = col % D_MAIN;
                const float ad = fabsf(min_decay + (float)c * ((max_decay - min_decay) / (float)(D_MAIN - 1)));
                TAPS[(size_t)col * SEQ + n0 + li] = acc[r] * expf(-t * ad); }
        }
    }
}

__device__ __forceinline__ constexpr float twc(int k) { constexpr float T[16] = {1.0f, 0.98078528040323043f, 0.92387953251128674f, 0.83146961230254524f, 0.70710678118654757f, 0.55557023301960218f, 0.38268343236508978f, 0.19509032201612825f,
    0.0f, -0.19509032201612825f, -0.38268343236508978f, -0.55557023301960218f, -0.70710678118654757f, -0.83146961230254524f, -0.92387953251128674f, -0.98078528040323043f}; return T[k]; }
__device__ __forceinline__ constexpr float tws(int k) { constexpr float T[16] = {0.0f, 0.19509032201612825f, 0.38268343236508978f, 0.55557023301960218f, 0.70710678118654757f, 0.83146961230254524f, 0.92387953251128674f, 0.98078528040323043f,
    1.0f, 0.98078528040323043f, 0.92387953251128674f, 0.83146961230254524f, 0.70710678118654757f, 0.55557023301960218f, 0.38268343236508978f, 0.19509032201612825f}; return T[k]; }
__device__ __forceinline__ constexpr int bitrev(int i, int bits) { int r = 0; for (int b = 0; b < bits; ++b) if (i & (1 << b)) r |= 1 << (bits - 1 - b); return r; }

template <int N, int LEN> struct FftStage {
    static __device__ __forceinline__ void run(float (&re)[N], float (&im)[N]) {
        constexpr int half = LEN / 2, step = 32 / LEN;
#pragma unroll
        for (int base = 0; base < N; base += LEN)
#pragma unroll
            for (int j = 0; j < half; ++j) {
                const int i0 = base + j, i1 = i0 + half, idx = j * step;
                const float ar = re[i0], ai = im[i0], br = re[i1], bi = im[i1];
                re[i0] = ar + br; im[i0] = ai + bi;
                const float dr = ar - br, di = ai - bi;
                if (idx == 0) { re[i1] = dr; im[i1] = di; }
                else if (idx == 8) { re[i1] = di; im[i1] = -dr; }
                else { const float c = twc(idx), s = tws(idx); re[i1] = dr * c + di * s; im[i1] = di * c - dr * s; }
            }
        if constexpr (LEN > 2) FftStage<N, LEN / 2>::run(re, im);
    }
};
template <int N, int BITS> __device__ __forceinline__ void fft_reg(float (&re)[N], float (&im)[N]) {
    FftStage<N, N>::run(re, im);
    float tr[N], ti[N];
#pragma unroll
    for (int i = 0; i < N; ++i) { tr[bitrev(i, BITS)] = re[i]; ti[bitrev(i, BITS)] = im[i]; }
#pragma unroll
    for (int i = 0; i < N; ++i) { re[i] = tr[i]; im[i] = ti[i]; }
}

template <int N, int LEN> struct FftStageC {
    static __device__ __forceinline__ void run(f32x2 (&x)[N]) {
        constexpr int half = LEN / 2, step = 32 / LEN;
#pragma unroll
        for (int base = 0; base < N; base += LEN)
#pragma unroll
            for (int j = 0; j < half; ++j) {
                const int i0 = base + j, i1 = i0 + half, idx = j * step;
                const f32x2 a = x[i0], b = x[i1];
                x[i0] = a + b;
                const f32x2 d = a - b;
                if (idx == 0) x[i1] = d;
                else if (idx == 8) x[i1] = (f32x2){d.y, -d.x};
                else { const float c = twc(idx), s = tws(idx); const f32x2 t = (f32x2){d.y, -d.x}; x[i1] = d * c + t * s; }
            }
        if constexpr (LEN > 2) FftStageC<N, LEN / 2>::run(x);
    }
};
template <int N, int BITS> __device__ __forceinline__ void fft_regc(f32x2 (&x)[N]) {
    FftStageC<N, N>::run(x);
    f32x2 t[N];
#pragma unroll
    for (int i = 0; i < N; ++i) t[bitrev(i, BITS)] = x[i];
#pragma unroll
    for (int i = 0; i < N; ++i) x[i] = t[i];
}
__device__ __forceinline__ void fft16k_c(f32x2 (&x)[32], LAS f32x2* L, int tid_in) {
    int tid = tid_in; asm volatile("" : "+v"(tid));
    fft_regc<32, 5>(x);
#pragma unroll
    for (int k1 = 1; k1 < 32; ++k1) { const float fr = (float)((tid * k1) & 16383) * (1.0f / 16384.0f); const float c = __builtin_amdgcn_cosf(fr), s = __builtin_amdgcn_sinf(fr);
        const f32x2 d = x[k1], t = (f32x2){d.y, -d.x}; x[k1] = d * c + t * s; if ((k1 & 3) == 3) __builtin_amdgcn_sched_barrier(0); }
#pragma unroll
    for (int k1 = 0; k1 < 32; ++k1) L[k1 * 513 + tid] = x[k1];
    __syncthreads();
    const int n3 = tid & 31, ka = tid >> 5;
    f32x2 a[16], b[16];
#pragma unroll
    for (int n2 = 0; n2 < 16; ++n2) { a[n2] = L[ka * 513 + n2 * 32 + n3]; b[n2] = L[(ka + 16) * 513 + n2 * 32 + n3]; }
    fft_regc<16, 4>(a); fft_regc<16, 4>(b);
#pragma unroll
    for (int k2 = 1; k2 < 16; ++k2) { const float fr = (float)((n3 * k2) & 511) * (1.0f / 512.0f); const float c = __builtin_amdgcn_cosf(fr), s = __builtin_amdgcn_sinf(fr);
        f32x2 d = a[k2], t = (f32x2){d.y, -d.x}; a[k2] = d * c + t * s; d = b[k2]; t = (f32x2){d.y, -d.x}; b[k2] = d * c + t * s; if ((k2 & 3) == 3) __builtin_amdgcn_sched_barrier(0); }
    __syncthreads();
#pragma unroll
    for (int k2 = 0; k2 < 16; ++k2) { L[n3 * 513 + k2 * 32 + ka] = a[k2]; L[n3 * 513 + k2 * 32 + ka + 16] = b[k2]; }
    __syncthreads();
#pragma unroll
    for (int q = 0; q < 32; ++q) x[q] = L[q * 513 + tid];
    fft_regc<32, 5>(x);
}
__device__ __forceinline__ void fft16k(float (&re)[32], float (&im)[32], LAS f32x2* L, int tid) {
    f32x2 x[32];
#pragma unroll
    for (int r = 0; r < 32; ++r) x[r] = (f32x2){re[r], im[r]};
    fft16k_c(x, L, tid);
#pragma unroll
    for (int r = 0; r < 32; ++r) { re[r] = x[r].x; im[r] = x[r].y; }
}

constexpr int HS_SP = SEQ + 16;
__device__ __forceinline__ void hy_stage(LAS bf16* S, int slot, const bf16* src, int tid) {
    LAS bf16* d = S + slot * HS_SP + 8;
    if (tid == 0) { d[-1] = 0; d[SEQ] = 0; }
#pragma unroll
    for (int q = 0; q < 2; ++q) { const int ch = q * NTHREADS + tid; *(LAS v4u*)(d + ch * 8) = *(const GAS v4u*)(src + ch * 8); }
}
__device__ __forceinline__ float hy_sc(const LAS bf16* S, int slot, int t, float w0, float w1, float w2) {
    const LAS bf16* p = S + slot * HS_SP + 8 + t;
    return bf2f(p[-1]) * w0 + bf2f(p[0]) * w1 + bf2f(p[1]) * w2;
}

#ifdef CSEL
#define CT(sec) do { const unsigned long long tn_ = __builtin_amdgcn_s_memrealtime(); if (csec_ == CSEL) ctime_ += tn_ - ct0_; ct0_ = tn_; csec_ = (sec); } while (0)
#else
#define CT(sec)
#endif
__device__ __forceinline__ void phase_hyena_conv(const bf16* PT, const float* TAPS, const float* shortw, const float* skip, f32x2* XSall, f32x2* ZSall, bf16* MIXT,
                                                 LAS unsigned char* lds, int blk, int nblk, int tid_in, int lane, int wave, int pmode = 0) {
    LAS f32x2* L = (LAS f32x2*)lds; LAS bf16* S = (LAS bf16*)lds; LAS float* red = (LAS float*)(lds + LDS_MISC);
    f32x2* XK0 = XSall + (size_t)blk * 16384;
    f32x2* XK1 = XK0 + 16384 * 256; f32x2* ZS = ZSall + (size_t)blk * 16384;
    constexpr int N = 16384;
#ifdef CSEL
    unsigned long long ctime_ = 0ull, ct0_ = __builtin_amdgcn_s_memrealtime(); int csec_ = -1;
#endif
#pragma unroll 1
    for (int c = blk; c < D_MAIN; c += nblk) {
        f32x2 x[32]; float vr[16], vi[16];
#pragma unroll 1
        for (int pass = 0; pass < 5; ++pass) {
            int tid = tid_in; asm volatile("" : "+v"(tid));
            CT(pass == 0 ? 0 : (pass == 1 ? 7 : 8));
            if (pass == 0) {
                const float* hf0 = TAPS + (size_t)c * SEQ; const float* hb0 = TAPS + (size_t)(D_MAIN + c) * SEQ;
                const float* hf1 = TAPS + (size_t)(2 * D_MAIN + c) * SEQ; const float* hb1 = TAPS + (size_t)(3 * D_MAIN + c) * SEQ;
#pragma unroll
                for (int r = 0; r < 16; ++r) { const int n = r * 512 + tid; x[r].x = hf0[n]; x[r].y = hf1[n]; }
#pragma unroll
                for (int r = 16; r < 32; ++r) { const int idx = (32 - r) * 512 - tid; const bool z = (idx == SEQ); const int ii = z ? 0 : idx; x[r].x = z ? 0.f : hb0[ii]; x[r].y = z ? 0.f : hb1[ii]; }
                float e0 = 0.f, e1 = 0.f;
                if (tid == 0) { e0 = hb0[0]; e1 = hb1[0]; }
                float s0 = fabsf(e0), s1 = fabsf(e1);
#pragma unroll
                for (int r = 0; r < 32; ++r) { s0 += fabsf(x[r].x); s1 += fabsf(x[r].y); }
                s0 = wave_sum(s0); s1 = wave_sum(s1);
                __syncthreads();
                if (lane == 0) { red[wave] = s0; red[8 + wave] = s1; }
                __syncthreads();
                float t0 = 0.f, t1 = 0.f;
#pragma unroll
                for (int w = 0; w < NWAVES; ++w) { t0 += red[w]; t1 += red[8 + w]; }
                const float sc0 = 1.0f / (t0 + 1e-6f), sc1 = 1.0f / (t1 + 1e-6f);
                x[0].x += e0; x[0].y += e1;
#pragma unroll
                for (int r = 0; r < 32; ++r) { x[r].x *= sc0; x[r].y *= sc1; }
            } else if (pass == 1) {
                __syncthreads();
                const bf16* pv = PT + (size_t)(2 * D_MAIN + c) * M_TOK; const float wv[3] = {shortw[2 * D_MAIN + c], shortw[2304 + 2 * D_MAIN + c], shortw[4608 + 2 * D_MAIN + c]};
                hy_stage(S, 0, pv, tid); hy_stage(S, 1, pv + SEQ, tid);
                __syncthreads();
#pragma unroll
                for (int r = 0; r < 16; ++r) { const int t = r * 512 + tid; x[r].x = hy_sc(S, 0, t, wv[0], wv[1], wv[2]); x[r].y = hy_sc(S, 1, t, wv[0], wv[1], wv[2]); vr[r] = x[r].x; vi[r] = x[r].y; }
#pragma unroll
                for (int r = 16; r < 32; ++r) { x[r].x = 0.f; x[r].y = 0.f; }
            }
            __syncthreads();
            CT(1);
            fft16k_c(x, L, tid);
            CT(2 + pass);
            if (pass == 0) {
                __syncthreads();
#pragma unroll
                for (int r = 0; r < 32; ++r) L[r * 513 + tid] = x[r];
                __syncthreads();
                const int tp = (512 - tid) & 511;
#pragma unroll
                for (int r = 0; r < 32; ++r) { const int rp = (tid == 0) ? ((32 - r) & 31) : (31 - r);
                    const f32x2 xa = x[r], xb = L[rp * 513 + tp]; const float sc_ = 0.5f / (float)N;
                    XK0[r * 512 + tid] = (f32x2){(xa.x + xb.x) * sc_, (xa.y - xb.y) * sc_};
                    XK1[r * 512 + tid] = (f32x2){(xa.y + xb.y) * sc_, (xb.x - xa.x) * sc_}; if ((r & 7) == 7) __builtin_amdgcn_sched_barrier(0); }
            } else if (pass == 1 || pass == 3) {
                const f32x2* XK = (pass == 1) ? XK0 : XK1;
#pragma unroll
                for (int r = 0; r < 32; ++r) { const f32x2 k = XK[r * 512 + tid]; const float zr_ = x[r].x, zi_ = x[r].y;
                    x[r].x = zr_ * k.x - zi_ * k.y; x[r].y = -(zr_ * k.y + zi_ * k.x); }
            } else if (pass == 2) {
                __syncthreads();
                const bf16* px1 = PT + (size_t)c * M_TOK; const float sk0 = skip[c]; const float wx1[3] = {shortw[c], shortw[2304 + c], shortw[4608 + c]};
                hy_stage(S, 2, px1, tid); hy_stage(S, 3, px1 + SEQ, tid);
                __syncthreads();
#pragma unroll
                for (int r = 0; r < 16; ++r) { const int t = r * 512 + tid;
                    const float v0 = vr[r], v1 = vi[r];
                    const float g0 = hy_sc(S, 2, t, wx1[0], wx1[1], wx1[2]), g1 = hy_sc(S, 3, t, wx1[0], wx1[1], wx1[2]);
                    x[r].x = g0 * (x[r].x + sk0 * v0); x[r].y = g1 * (-x[r].y + sk0 * v1); ZS[t] = (f32x2){x[r].x, x[r].y}; }
#pragma unroll
                for (int r = 16; r < 32; ++r) { x[r].x = 0.f; x[r].y = 0.f; }
            } else {
                __syncthreads();
                const bf16* px2 = PT + (size_t)(D_MAIN + c) * M_TOK; const float sk1 = skip[D_MAIN + c];
                const float wx2[3] = {shortw[D_MAIN + c], shortw[2304 + D_MAIN + c], shortw[4608 + D_MAIN + c]};
                hy_stage(S, 0, px2, tid); hy_stage(S, 1, px2 + SEQ, tid);
                __syncthreads();
#pragma unroll
                for (int r = 0; r < 16; ++r) { const int t = r * 512 + tid;
                    const float g0 = hy_sc(S, 0, t, wx2[0], wx2[1], wx2[2]), g1 = hy_sc(S, 1, t, wx2[0], wx2[1], wx2[2]);
                    const f32x2 z = ZS[t];
                    const float o0 = g0 * (x[r].x + sk1 * z.x), o1 = g1 * (-x[r].y + sk1 * z.y);
                    MIXT[(size_t)c * M_TOK + t] = (bf16)f2bf(o0); MIXT[(size_t)c * M_TOK + SEQ + t] = (bf16)f2bf(o1); }
            }
        }
        CT(-1);
        __syncthreads();
    }
#ifdef CSEL
    if (blk == 0 && tid_in == 0) *(unsigned long long*)((unsigned char*)XSall - WS_FFTX + 32768) += ctime_;
#endif
}
#ifndef MK_PER_PHASE
#define MK_PER_PHASE 0
#endif
#ifndef CONV_PMODE
#define CONV_PMODE 0
#endif
#ifndef REPMASK
#define REPMASK 0u
#endif
#define REP(kind) _Pragma("unroll 1") for (int r_ = 0; r_ < 1 + (int)((REPMASK >> (kind)) & 1u); ++r_)
struct Args {
    const float* in[24]; float* out; unsigned char* ws; int ph_lo, ph_hi;
};
constexpr int N_PHASES = 1 + (DEPTH - 1) + DEPTH * 8 - DEPTH / 2 + 1;

template <int QP, int KP>
__device__ __forceinline__ void run_attn(const bf16* Q, const bf16* K, const bf16* V, bf16* O, int NT, char* shm, int wave_s) {
    attn_body::attn_unit<8, QP, KP, DM>((const attn_body::bf16*)Q, (const attn_body::bf16*)K, (const attn_body::bf16*)V, (attn_body::bf16*)O, NT, shm, wave_s);
}

__global__ void __launch_bounds__(NTHREADS, 2) hybrid_fwd(Args args) {
    extern __shared__ __attribute__((aligned(16))) unsigned char lds_raw[];
    LAS unsigned char* lds = (LAS unsigned char*)lds_raw;
    const int G = gridDim.x, bx = blockIdx.x;
    const int wave0 = __builtin_amdgcn_readfirstlane((int)(threadIdx.x >> 6));
    const int vcu = (G % 8 == 0) ? (bx % 8) * (G / 8) + bx / 8 : bx;
    const int NGW = G * NWAVES;
    unsigned char* ws = args.ws;
    const float* x = args.in[0]; const float* mem = args.in[1]; const float* mix_g = args.in[2]; const float* ffn_g = args.in[3]; const float* mem_g = args.in[4]; const float* fin_g = args.in[5];
    const float* hy_short = args.in[9]; const float* f_w1 = args.in[10]; const float* f_b1 = args.in[11]; const float* f_w2 = args.in[12]; const float* f_b2 = args.in[13];
    const float* f_w3 = args.in[14]; const float* f_freq = args.in[15]; const float* hy_skip = args.in[16]; const float* qg = args.in[18]; const float* kg = args.in[19]; const float* router = args.in[20];
    float* H = args.out;
    bf16* U = (bf16*)(ws + WS_U); bf16* PROJ = (bf16*)(ws + WS_PROJ); bf16* CQ = (bf16*)(ws + WS_CQ); bf16* MIX = (bf16*)(ws + WS_MIX); bf16* MIXT = (bf16*)(ws + WS_MIXT);
    float* AFF = (float*)(ws + WS_AFF); int* IDX = (int*)(ws + WS_IDX); float* GATE = (float*)(ws + WS_GATE); int* POS = (int*)(ws + WS_POS);
    bf16* XG = (bf16*)(ws + WS_XG); bf16* HID = (bf16*)(ws + WS_HID); bf16* Y = (bf16*)(ws + WS_Y); float* TAPS = (float*)(ws + WS_TAPS);
    const bf16* MKV = (const bf16*)(ws + WS_MKV);
    cg::grid_group grid = cg::this_grid();
    volatile LAS unsigned* bst = (volatile LAS unsigned*)(lds + LDS_MISC + 4096);
    if (threadIdx.x < 2) bst[threadIdx.x] = 0u;
    __syncthreads();
    XcdBarrier xbar = xcd_barrier_post((unsigned*)(ws + WS_CTL) + 1024, bst);
    const int lo = args.ph_lo, hi = args.ph_hi;
    const XwIn XW{args.in[21], args.in[22], args.in[23], ws}; const bool xw_sched = (G == 256);
    int ph = 0;
#ifdef TSEL
    unsigned long long tacc_ = 0ull, t0_ = 0ull, t1_ = 0ull; int pk_ = 0, tpar_ = 0;
#endif
#ifdef TSEL
#ifndef TAMP
#define TAMP 10
#endif
#ifndef TBAR
#define TBAR 0
#endif
#define PH_T0(k) pk_ = (k); t0_ = __builtin_amdgcn_s_memrealtime();
#ifndef TPAR
#define TPAR -1
#endif
#define PH_T1 t1_ = __builtin_amdgcn_s_memrealtime(); if (!TBAR && (pk_ == TSEL || TSEL == 99) && (TPAR < 0 || tpar_ == TPAR)) tacc_ += t1_ - t0_;
#define PH_T2 if (TBAR && (pk_ == TSEL || TSEL == 99)) tacc_ += __builtin_amdgcn_s_memrealtime() - t1_;
#else
#define PH_T0(k)
#define PH_T1
#define PH_T2
#endif
#define PHASE_BEGINK(k) PH_T0(k) if (lo <= ph && ph < hi) { const int tid = opaque_tid(wave0), lane = tid & 63, wave = __builtin_amdgcn_readfirstlane(tid >> 6), gw = vcu * NWAVES + wave; (void)lane; (void)gw;
#ifdef EXTRA_XBAR
#define PHASE_END   if (ph + 1 < hi) { if (ph == lo) grid.sync(); else { xcd_barrier(xbar); if (ph < EXTRA_XBAR) xcd_barrier(xbar); } } } ++ph;
#else
#define PHASE_END   PH_T1 if (ph + 1 < hi) { if (ph == lo) grid.sync(); else xcd_barrier(xbar); } PH_T2 } ++ph;
#endif

    PHASE_BEGINK(0)
        ProIn P{args.in[8], args.in[17], args.in[7], args.in[6]};
        REP(0) { phase_weights(P, ws, lds, gw, NGW, wave, lane); phase_xw_p0(XW, xw_sched, (LAS float*)(lds + wave * 16384), gw, NGW, lane); }
        phase_wrg(ffn_g, router, (float*)(ws + WS_WRG), (int)(bx * NTHREADS + tid), (int)(G * NTHREADS));
        REP(1) phase_mem_h2(mem, mem_g, f_w1, f_b1, f_w2, f_b2, f_freq, ws, gw, NGW, lane);
        REP(3) phase_norm<false, false>(x, nullptr, mix_g, U, nullptr, nullptr, nullptr, gw, NGW, lane);
    PHASE_END

#pragma unroll 1
    for (int i = 0; i < DEPTH; ++i) {
        const bool hy = (i & 1) == 0; const int j = i >> 1;
#ifdef TSEL
        tpar_ = i & 1;
#endif
        if (i > 0) {
        PHASE_BEGINK(1)
            phase_norm<true, false>(H, H, mix_g + i * DM, U, nullptr, POS, Y, gw, NGW, lane);
        PHASE_END
        }
        PHASE_BEGINK(2)
            if (i == 0) {
                pg8::Gemm g{(const bf16*)(ws + WS_MEMN), (const bf16*)(ws + WS_WMKV), BATCH * MEM_LEN, 2048, DM, 1 << 30, 1, 0};
                pg8::StaticOrder S; S.init(BATCH * MEM_LEN, 2048, G, bx);
                pg8::EpiRowBf16 E{(bf16*)(ws + WS_MKV), 2048, -1, 1.f};
                pg8::gemm_phase<pg8::EpiRowBf16, pg8::StaticOrder, true, true>(lds, g, S, E, wave);
            }
            if (hy) {
                REP(4) phase_taps((const float*)(ws + WS_H2) + (size_t)j * SEQ * HY_FILT, f_w3 + (size_t)j * HY_FILT * FCOLS, TAPS, gw, NGW, lane);
                pg8::Gemm g{U, (const bf16*)(ws + WS_WHY) + (size_t)j * D_IN_HY * DM, M_TOK, D_IN_HY, DM, 1 << 30, 1, 0};
                pg8::StaticOrder S; S.init(M_TOK, D_IN_HY, G, bx);
                pg8::EpiHyIn E{PROJ, M_TOK, 9, CQ, ATT_C2};
                REP(5) pg8::gemm_phase<pg8::EpiHyIn, pg8::StaticOrder, true, true>(lds, g, S, E, wave);
            } else {
                pg8::Gemm g{U, (const bf16*)(ws + WS_WAT) + (size_t)j * D_IN_AT * DM, M_TOK, D_IN_AT, DM, 1 << 30, 1, 0};
                pg8::StaticOrder S; S.init(M_TOK, D_IN_AT, G, bx);
                pg8::EpiAtIn E{PROJ, PROJ + (size_t)M_TOK * 768, PROJ + (size_t)M_TOK * 1024, PROJ + (size_t)M_TOK * 1280, qg + j * HD, kg + j * HD, ATT_C2, NORM_EPS, SEQ - 1};
                REP(6) pg8::gemm_phase<pg8::EpiAtIn, pg8::StaticOrder, true, true>(lds, g, S, E, wave);
            }
            if (xw_sched && bx >= 128) xw_slice_a(XW, i, (LAS float*)(lds + wave * 16384), bx, wave, lane);
        PHASE_END
        PHASE_BEGINK(3)
            if (hy) {
                REP(8) phase_hyena_conv(PROJ, TAPS, hy_short + (size_t)j * 3 * 2304, hy_skip + (size_t)j * 2 * D_MAIN, (f32x2*)(ws + WS_FFTX), (f32x2*)(ws + WS_ZS), MIXT, lds, bx, G, tid, lane, wave);
                REP(9) for (int u = vcu; u < 256; u += G) { const int b = u >> 7, h4 = (u >> 5) & 3, qb = u & 31; const size_t row = (size_t)b * SEQ + qb * 256;
                    run_attn<256, 2048>(CQ + row * 256 + h4 * HD, MKV + (size_t)b * MEM_LEN * 2048 + i * 512 + h4 * HD, MKV + (size_t)b * MEM_LEN * 2048 + i * 512 + 256 + h4 * HD,
                                        MIX + row * DM + D_MAIN + h4 * HD, MEM_LEN / 64, (char*)lds_raw, wave); }
            } else {
                REP(10) for (int u = vcu; u < 768; u += G) { const int bk = (u & 255) >> 5, qb = u & 31, hs = u >> 8, b = bk >> 2, kvh = bk & 3, h = kvh * 3 + hs; const size_t row = (size_t)b * SEQ + qb * 256;
                    run_attn<768, 256>(PROJ + row * 768 + h * HD, PROJ + (size_t)M_TOK * 768 + (size_t)b * SEQ * 256 + kvh * HD, PROJ + (size_t)M_TOK * 1024 + (size_t)b * SEQ * 256 + kvh * HD,
                                       MIX + row * DM + h * HD, SEQ / 64, (char*)lds_raw, wave); }
                REP(9) for (int u = vcu; u < 256; u += G) { const int b = u >> 7, h4 = (u >> 5) & 3, qb = u & 31; const size_t row = (size_t)b * SEQ + qb * 256;
                    run_attn<256, 2048>(PROJ + (size_t)M_TOK * 1280 + row * 256 + h4 * HD, MKV + (size_t)b * MEM_LEN * 2048 + i * 512 + h4 * HD, MKV + (size_t)b * MEM_LEN * 2048 + i * 512 + 256 + h4 * HD,
                                        MIX + row * DM + D_MAIN + h4 * HD, MEM_LEN / 64, (char*)lds_raw, wave); }
            }
        PHASE_END
        if (hy) {
            PHASE_BEGINK(4)
                REP(11) phase_transpose_mix(MIXT, MIX, lds, bx, G, tid);
            PHASE_END
        }
        PHASE_BEGINK(5)
            pg8::Gemm g{MIX, (const bf16*)(ws + WS_WOUT) + (size_t)i * DM * DM, M_TOK, DM, DM, 1 << 30, 1, 0};
            pg8::StaticOrder S; S.init(M_TOK, DM, G, bx);
            pg8::EpiOutX E{i == 0 ? x : (const float*)H, H, DM, ffn_g + i * DM, (const float*)(ws + WS_WRG) + (size_t)i * NEXP * DM, (unsigned char*)U, (float*)(ws + WS_PART), (float*)(ws + WS_PSS), M_TOK};
            pg8::gemm_phase<pg8::EpiOutX, pg8::StaticOrder, true, true>(lds, g, S, E, wave);
        PHASE_END
        PHASE_BEGINK(6)
            REP(13) phase_router_sum((const float*)(ws + WS_PART), (const float*)(ws + WS_PSS), (float*)(ws + WS_RSTD), AFF, gw, NGW, lane);
        PHASE_END
        PHASE_BEGINK(7)
            REP(14) phase_topk(AFF, (const float*)(ws + WS_RSTD), (float*)(ws + WS_RS), IDX, GATE, POS, lds + LDS_MISC, bx, G, tid, lane, wave);
            if (xw_sched && bx >= 32) xw_slice_b(XW, i, (LAS float*)(lds + wave * 16384), bx, wave, lane);
        PHASE_END
        PHASE_BEGINK(8)
            pg8::Gemm g{U, (const bf16*)(ws + WS_W1 + (size_t)i * NEXP * 1536 * DM), XROWS, 1536, DM / 2, 4, NEXP, (size_t)1536 * DM};
            pg8::StaticOrder S; S.init(XROWS, 1536, G, bx);
            pg8::EpiSwiGLU8 E{(unsigned char*)HID, EFF, 1.0f / W8_SCALE, (const float*)(ws + WS_RS)};
            REP(16) pg8::gemm_phase<pg8::EpiSwiGLU8, pg8::StaticOrder, true, true, true, true>(lds, g, S, E, wave, IDX);
        PHASE_END
        PHASE_BEGINK(9)
            pg8::Gemm g{HID, (const bf16*)(ws + WS_W2 + (size_t)i * NEXP * DM * EFF), XROWS, DM, EFF / 2, 4, NEXP, (size_t)DM * EFF};
            pg8::StaticOrder S; S.init(XROWS, DM, G, bx);
            pg8::EpiDown E{Y, DM, GATE, 1.0f / W8_SCALE};
            REP(17) pg8::gemm_phase<pg8::EpiDown, pg8::StaticOrder, true, true, false, true>(lds, g, S, E, wave);
        PHASE_END
    }
    PHASE_BEGINK(10)
        phase_norm<true, true>(H, nullptr, fin_g, nullptr, args.out, POS, Y, gw, NGW, lane);
    PHASE_END
#ifdef TSEL
#ifdef CSEL
    if (bx == 0 && threadIdx.x == 0) tacc_ += *(unsigned long long*)(ws + 32768);
#endif
    if (bx == 0 && threadIdx.x == 0 && hi - lo > 1) { const unsigned long long te_ = __builtin_amdgcn_s_memrealtime(); while (__builtin_amdgcn_s_memrealtime() - te_ < (unsigned long long)TAMP * tacc_) __builtin_amdgcn_s_sleep(8); }
#endif
#undef PHASE_BEGINK
#undef PHASE_END
}

extern "C" void kernel_launch(void* const* d_in, const int* in_sizes, int n_in, void* d_out, int out_size, void* d_ws, size_t ws_size, hipStream_t stream) {
    static int grid = 0;
    if (grid == 0) {
        if (n_in != 24 || out_size != M_TOK * DM || ws_size < WS_END) { fprintf(stderr, "kernel_launch: unexpected shapes (n_in %d out %d ws %zu need %zu)\n", n_in, out_size, ws_size, (size_t)WS_END); grid = -1; return; }
        int dev = 0, cus = 0, per_cu = 0;
        if (hipGetDevice(&dev) != hipSuccess || hipDeviceGetAttribute(&cus, hipDeviceAttributeMultiprocessorCount, dev) != hipSuccess) { grid = -1; return; }
        if (hipFuncSetAttribute((const void*)hybrid_fwd, hipFuncAttributeMaxDynamicSharedMemorySize, LDS_BYTES) != hipSuccess) { fprintf(stderr, "kernel_launch: hipFuncSetAttribute failed\n"); grid = -1; return; }
        if (hipOccupancyMaxActiveBlocksPerMultiprocessor(&per_cu, (const void*)hybrid_fwd, NTHREADS, LDS_BYTES) != hipSuccess || per_cu < 1) { fprintf(stderr, "kernel_launch: occupancy query says %d blocks/CU\n", per_cu); per_cu = 1; }
        (void)hipGetLastError();
        grid = cus;
    }
    if (grid < 0) return;
    if (hipMemsetAsync((char*)d_ws + WS_CTL, 0, 64 * 1024, stream) != hipSuccess) { fprintf(stderr, "kernel_launch: memset failed\n"); return; }
    Args a{};
    for (int i = 0; i < 24; ++i) a.in[i] = (const float*)d_in[i];
    a.out = (float*)d_out; a.ws = (unsigned char*)d_ws;
#if MK_PER_PHASE
    for (int li = 0; li < N_PHASES; ++li) {
        a.ph_lo = li; a.ph_hi = li + 1;
        void* kargs[] = {&a};
        hipError_t e = hipLaunchCooperativeKernel((const void*)hybrid_fwd, dim3(grid), dim3(NTHREADS), kargs, LDS_BYTES, stream);
        if (e != hipSuccess) { fprintf(stderr, "kernel_launch: launch %d failed: %s\n", li, hipGetErrorString(e)); break; }
    }
#else
    a.ph_lo = 0; a.ph_hi = N_PHASES;
    void* kargs[] = {&a};
    hipError_t e = hipLaunchCooperativeKernel((const void*)hybrid_fwd, dim3(grid), dim3(NTHREADS), kargs, LDS_BYTES, stream);
    if (e != hipSuccess) fprintf(stderr, "kernel_launch: cooperative launch failed: %s (grid %d)\n", hipGetErrorString(e), grid);
#endif
}
```

```cpp
#include <hip/hip_runtime.h>
#include <hip/hip_cooperative_groups.h>
#include <hip/hip_bf16.h>
#include <cmath>
#include <cstdio>
#include <cstdint>
namespace cg = cooperative_groups;

constexpr int BATCH = 2, SEQ = 8192, DM = 1024, DEPTH = 4, M_TOK = BATCH * SEQ;
constexpr int HD = 64, MEM_LEN = 256, D_MEM = 256, D_MAIN = 768, NQH = 12, NKVH = 4;
constexpr int D_IN_HY = 2560, D_IN_AT = 1536;
constexpr int NEXP = 16, CAP = 1024, EFF = 768, NGRP = BATCH * NEXP, XROWS = NGRP * CAP;
constexpr int HY_EMB = 33, HY_FILT = 64, FCOLS = 4 * D_MAIN;
constexpr float NORM_EPS = 1e-6f;
constexpr float W8_SCALE = 32.0f;
constexpr float ATT_C2 = 0.125f * 1.4426950408889634f;

constexpr size_t MiB = 1u << 20;
constexpr size_t WS_CTL = 0;
constexpr size_t WS_WHY = 2 * MiB;
constexpr size_t WS_WAT = 12 * MiB;
constexpr size_t WS_WOUT = 18 * MiB;
constexpr size_t WS_WMKV = 26 * MiB;
constexpr size_t WS_W1 = 32 * MiB;
constexpr size_t WS_W2 = 224 * MiB;
constexpr size_t WS_U = 320 * MiB;
constexpr size_t WS_PROJ = 352 * MiB;
constexpr size_t WS_CQ = WS_PROJ + 72 * MiB;
constexpr size_t WS_MIX = 432 * MiB;
constexpr size_t WS_MIXT = 464 * MiB;
constexpr size_t WS_AFF = 488 * MiB;
constexpr size_t WS_IDX = 489 * MiB;
constexpr size_t WS_GATE = WS_IDX + 128 * 1024;
constexpr size_t WS_POS = 490 * MiB;
constexpr size_t WS_XG = 492 * MiB;
constexpr size_t WS_HID = 556 * MiB;
constexpr size_t WS_TAPS = WS_XG;
constexpr size_t WS_Y = 604 * MiB;
constexpr size_t WS_FFTX = WS_Y;
constexpr size_t WS_H2 = 668 * MiB;
constexpr size_t WS_MEMN = 672 * MiB;
constexpr size_t WS_MKV = 673 * MiB;
constexpr size_t WS_PART = 676 * MiB;
constexpr size_t WS_PSS = 692 * MiB;
constexpr size_t WS_RSTD = 697 * MiB;
constexpr size_t WS_RS = WS_RSTD + 128 * 1024;
constexpr size_t WS_WRG = 698 * MiB;
constexpr size_t WS_ZS = 700 * MiB;
constexpr size_t WS_END = 732 * MiB;

constexpr int LDS_RING = 0;
constexpr int LDS_MISC = 132 * 1024;
constexpr int LDS_BYTES = 140 * 1024;
constexpr int NTHREADS = 512, NWAVES = 8;

#define GAS __attribute__((address_space(1)))
#define LAS __attribute__((address_space(3)))
typedef unsigned short bf16;
typedef unsigned v4u __attribute__((ext_vector_type(4)));
typedef unsigned v2u __attribute__((ext_vector_type(2)));
typedef float f32x4 __attribute__((ext_vector_type(4)));
typedef float f32x2 __attribute__((ext_vector_type(2)));
__device__ __forceinline__ unsigned f2bf(float f) { unsigned u = __builtin_bit_cast(unsigned, f); return (u + 0x7fffu + ((u >> 16) & 1u)) >> 16; }
__device__ __forceinline__ unsigned pk2(float lo, float hi) { return f2bf(lo) | (f2bf(hi) << 16); }
__device__ __forceinline__ float bf2f(unsigned short h) { return __builtin_bit_cast(float, (unsigned)h << 16); }
__device__ __forceinline__ float bflo(unsigned w) { return __builtin_bit_cast(float, w << 16); }
__device__ __forceinline__ float bfhi(unsigned w) { return __builtin_bit_cast(float, w & 0xffff0000u); }
__device__ __forceinline__ float wave_sum(float v) {
#pragma unroll
    for (int o = 1; o < 64; o <<= 1) v += __shfl_xor(v, o);
    return v;
}
__device__ __forceinline__ int opaque_tid(int wave_s) { int l; asm volatile("v_mbcnt_lo_u32_b32 %0, -1, 0\n\tv_mbcnt_hi_u32_b32 %0, -1, %0" : "=v"(l)); return (wave_s << 6) | l; }
#define MK_PER_PHASE 0

#define XB_TMO      128
#define XB_XCNT(j)  (256  + 64 * (j))
#define XB_XSUB(j)  (1280 + 64 * (j))
#define XB_XGEN(j)  (2304 + 64 * (j))
#define XB_TOP      3328
#define XB_TOPGEN   3392
#define XCD_BAR_WORDS 3456
#define XB_SPIN_CAP (1u << 18)

__device__ __forceinline__ unsigned xb_ld(unsigned* p)              { return __hip_atomic_load(p, __ATOMIC_RELAXED, __HIP_MEMORY_SCOPE_AGENT); }
__device__ __forceinline__ unsigned xb_add(unsigned* p, unsigned v) { return __hip_atomic_fetch_add(p, v, __ATOMIC_RELAXED, __HIP_MEMORY_SCOPE_AGENT); }
__device__ __forceinline__ unsigned xb_xcc_id() { return (unsigned)__builtin_amdgcn_s_getreg((3 << 11) | 20) & 0xFu; }
#define XB_SPIN(cond, bar) do { unsigned _sp = 0; while (cond) { __builtin_amdgcn_s_sleep(1); \
    if ((++_sp & 255u) == 0u) { if (xb_ld(&(bar)[XB_TMO])) break; if (_sp > XB_SPIN_CAP) { atomicAdd(&(bar)[XB_TMO], 1u); break; } } } } while (0)

struct XcdBarrier {
    unsigned* bar; unsigned x;
    volatile LAS unsigned* st;
};

__device__ __forceinline__ XcdBarrier xcd_barrier_post(unsigned* bar, volatile LAS unsigned* st) {
    XcdBarrier b; b.bar = bar; b.x = xb_xcc_id(); b.st = st;
    if (threadIdx.x == 0) (void)xb_add(&bar[XB_XCNT(b.x)], 1u);
    return b;
}
__device__ __forceinline__ void xcd_barrier_complete(unsigned* bar, unsigned x, unsigned& nloc, unsigned& nx) {
    const unsigned G = gridDim.x * gridDim.y * gridDim.z;
    unsigned sum, cnt, mine, sp = 0u;
    for (;;) {
        sum = 0u; cnt = 0u; mine = 0u;
#pragma unroll
        for (unsigned j = 0; j < 16; ++j) { const unsigned c = xb_ld(&bar[XB_XCNT(j)]); sum += c; cnt += (c > 0u) ? 1u : 0u; mine = (j == x) ? c : mine; }
        if (sum == G) break;
        __builtin_amdgcn_s_sleep(1);
        if ((++sp & 255u) == 0u) { if (xb_ld(&bar[XB_TMO])) break; if (sp > XB_SPIN_CAP) { atomicAdd(&bar[XB_TMO], 1u); break; } }
    }
    nloc = mine > 0u ? mine : 1u; nx = cnt > 0u ? cnt : 1u;
}

__device__ __forceinline__ void xcd_barrier(const XcdBarrier& b) {
    asm volatile("s_waitcnt vmcnt(0)" ::: "memory");
    __syncthreads();
    if (threadIdx.x == 0) {
        unsigned* bar = b.bar;
        __builtin_amdgcn_s_waitcnt(0);
        unsigned nloc = b.st[0], nx = b.st[1];
        if (nloc == 0u) { xcd_barrier_complete(bar, b.x, nloc, nx); b.st[0] = nloc; b.st[1] = nx; }
        const unsigned old = xb_add(&bar[XB_XSUB(b.x)], 1u);
        const unsigned gen = old / nloc;
        if (old + 1u == (gen + 1u) * nloc) {
            __builtin_amdgcn_fence(__ATOMIC_RELEASE, "agent");
            asm volatile("s_waitcnt vmcnt(0)" ::: "memory");
            const unsigned og = xb_add(&bar[XB_TOP], 1u);
            const unsigned tg = og / nx;
            if (og + 1u == (tg + 1u) * nx) xb_add(&bar[XB_TOPGEN], 1u);
            else XB_SPIN(xb_ld(&bar[XB_TOPGEN]) == tg, bar);
            __builtin_amdgcn_fence(__ATOMIC_ACQUIRE, "agent");
            xb_add(&bar[XB_XGEN(b.x)], 1u);
            asm volatile("s_waitcnt vmcnt(0)" ::: "memory");
        } else {
            XB_SPIN(xb_ld(&bar[XB_XGEN(b.x)]) == gen, bar);
            __builtin_amdgcn_fence(__ATOMIC_ACQUIRE, "agent");
            asm volatile("s_waitcnt vmcnt(0)" ::: "memory");
        }
    }
    __syncthreads();
}
namespace pg8 {
#define PG8_LAS __attribute__((address_space(3)))
typedef unsigned short bf16_t;
typedef short bf16x8 __attribute__((ext_vector_type(8)));
typedef float f32x4 __attribute__((ext_vector_type(4)));
typedef unsigned u32x4 __attribute__((ext_vector_type(4)));
constexpr int BM = 256, BK = 64, HALF = 128, HTB = HALF * BK * 2  , STAGE_BYTES = 8 * HTB, NXCD = 8, WGM = 8;

__host__ __device__ __forceinline__ int lds_byte(int r, int c) { const int st = (r >> 4) * 2 + (c >> 5), rr = r & 15, cc = c & 31, ob = rr * 64 + cc * 2; return st * 1024 + (ob ^ (((ob >> 9) & 1) << 5)); }
__host__ __device__ __forceinline__ void stage_rc(int b, int& R, int& C) { const int st = b / 1024, sb = b % 1024, swz = sb ^ (((sb >> 9) & 1) << 5); R = (st >> 1) * 16 + swz / 64; C = (st & 1) * 32 + (swz % 64) / 2; }
__host__ __device__ __forceinline__ int perm32(int rho) { const int n = rho >> 4, i = rho & 15; return 8 * (i >> 2) + 4 * n + (i & 3); }

struct Unit { int pm, pn; };
struct Gemm { const bf16_t* A; const bf16_t* Bt; int M, N, K; int gdiv, gmod; size_t gstride; };

struct StaticOrder {
    int nM, nN, nwg, G, c;
    __host__ __device__ void init(int M, int N, int G_, int c_) { nM = M / BM; nN = N / BM; nwg = nM * nN; G = G_; c = c_; }
    __host__ __device__ bool next(int i, Unit& u) const {
        const long L = (long)i * G + c; if (L >= nwg) return false;
        int wgid = (int)L; { const int q = nwg / NXCD, r = nwg % NXCD, xcd = wgid % NXCD, off = wgid / NXCD; wgid = (xcd < r ? xcd * (q + 1) : r * (q + 1) + (xcd - r) * q) + off; }
        const int nig = WGM * nN, gid = wgid / nig, fm = gid * WGM, gsz = (nM - fm) < WGM ? (nM - fm) : WGM;
        u.pm = fm + ((wgid % nig) % gsz); u.pn = (wgid % nig) / gsz; return true;
    }
    __device__ __forceinline__ void a_ready(const Unit&) const {}
    __device__ __forceinline__ void done(const Unit&) const {}
};


__device__ __forceinline__ unsigned cvt_pk_bf16(float lo, float hi) { unsigned r; asm volatile("v_cvt_pk_bf16_f32 %0, %1, %2" : "=v"(r) : "v"(lo), "v"(hi)); return r; }
typedef unsigned u32x2 __attribute__((ext_vector_type(2)));
struct EpiRowBf16 {
    static constexpr bool PERM = false, AFTER_DRAIN = false;
    bf16_t* O; int ldc; int sc_pn; float sc;
    __device__ __forceinline__ void operator()(const f32x4 (&acc)[2][2][4][2], const Unit& u, int wr, int wc, int fr, int fq) const {
        const float s = (u.pn == sc_pn) ? sc : 1.f;
        const int row0 = u.pm * BM + wr * 64 + fr, col0 = u.pn * BM + wc * 32 + 4 * fq;
#pragma unroll
        for (int ai = 0; ai < 2; ++ai)
#pragma unroll
            for (int m = 0; m < 4; ++m) { bf16_t* rowp = O + (size_t)(row0 + ai * HALF + m * 16) * ldc + col0;
#pragma unroll
                for (int bj = 0; bj < 2; ++bj)
#pragma unroll
                    for (int n = 0; n < 2; ++n) { const f32x4 v = acc[ai][bj][m][n] * s; u32x2 w; w.x = cvt_pk_bf16(v[0], v[1]); w.y = cvt_pk_bf16(v[2], v[3]);
                        *(u32x2*)(rowp + bj * HALF + n * 16) = w; } }
    }
};
struct EpiHyIn {
    static constexpr bool PERM = false, AFTER_DRAIN = false;
    bf16_t* OT; int ldt; int tp_tiles; bf16_t* CQ; float sc;
    __device__ __forceinline__ void operator()(const f32x4 (&acc)[2][2][4][2], const Unit& u, int wr, int wc, int fr, int fq) const {
        const int row0 = u.pm * BM + wr * 64 + fr;
        if (u.pn < tp_tiles) {
            const int col0 = u.pn * BM + wc * 32 + 4 * fq;
#pragma unroll
            for (int ai = 0; ai < 2; ++ai)
#pragma unroll
                for (int m = 0; m < 4; ++m) { const int row = row0 + ai * HALF + m * 16;
#pragma unroll
                    for (int bj = 0; bj < 2; ++bj)
#pragma unroll
                        for (int n = 0; n < 2; ++n) { const f32x4 v = acc[ai][bj][m][n]; const unsigned w0 = cvt_pk_bf16(v[0], v[1]), w1 = cvt_pk_bf16(v[2], v[3]);
                            bf16_t* p = OT + (size_t)(col0 + bj * HALF + n * 16) * ldt + row;
                            p[0] = (bf16_t)(w0 & 0xffffu); p[(size_t)ldt] = (bf16_t)(w0 >> 16); p[(size_t)2 * ldt] = (bf16_t)(w1 & 0xffffu); p[(size_t)3 * ldt] = (bf16_t)(w1 >> 16); } }
        } else {
            const int col0 = wc * 32 + 4 * fq;
#pragma unroll
            for (int ai = 0; ai < 2; ++ai)
#pragma unroll
                for (int m = 0; m < 4; ++m) { bf16_t* rowp = CQ + (size_t)(row0 + ai * HALF + m * 16) * 256 + col0;
#pragma unroll
                    for (int bj = 0; bj < 2; ++bj)
#pragma unroll
                        for (int n = 0; n < 2; ++n) { const f32x4 v = acc[ai][bj][m][n] * sc; u32x2 w; w.x = cvt_pk_bf16(v[0], v[1]); w.y = cvt_pk_bf16(v[2], v[3]);
                            *(u32x2*)(rowp + bj * HALF + n * 16) = w; } }
        }
    }
};
struct EpiAtIn {
    static constexpr bool PERM = false, AFTER_DRAIN = false;
    bf16_t* Oq; bf16_t* Ok; bf16_t* Ov; bf16_t* Oc; const float* gq; const float* gk; float csc; float eps; int seq_mask;
    __device__ __forceinline__ void operator()(const f32x4 (&acc)[2][2][4][2], const Unit& u, int wr, int wc, int fr, int fq) const {
        const int row0 = u.pm * BM + wr * 64 + fr, colb = (u.pn < 3 ? u.pn * BM : 0) + wc * 64 + 4 * fq; const int ldc = u.pn < 3 ? 768 : 256;
        bf16_t* O = u.pn < 3 ? Oq : (u.pn == 3 ? Ok : (u.pn == 4 ? Ov : Oc));
        if (u.pn <= 3) {
            const float* gp = (u.pn == 3 ? gk : gq) + 4 * fq; const float osc = (u.pn == 3) ? 1.f : csc;
            float invr[4];
#pragma unroll
            for (int q = 0; q < 4; ++q) invr[q] = exp2f(-(float)(4 * fq + q) * (13.287712379549449f / 16.0f)) * 0.15915494309189535f;
#pragma unroll
            for (int ai = 0; ai < 2; ++ai)
#pragma unroll
                for (int m = 0; m < 4; ++m) {
                    const int row = row0 + ai * HALF + m * 16; int t = row & seq_mask; asm volatile("" : "+v"(t));
                    float ss = 0.f;
#pragma unroll
                    for (int bj = 0; bj < 2; ++bj)
#pragma unroll
                        for (int n = 0; n < 2; ++n) { const f32x4 x = acc[ai][bj][m][n]; ss += (x[0] * x[0] + x[1] * x[1]) + (x[2] * x[2] + x[3] * x[3]); }
                    ss += __shfl_xor(ss, 16); ss += __shfl_xor(ss, 32);
                    const float rs = osc * __builtin_amdgcn_rsqf(ss * (1.0f / 64.0f) + eps);
                    bf16_t* rowp = O + (size_t)row * ldc + colb;
#pragma unroll
                    for (int bj = 0; bj < 2; ++bj) {
                        const float pos = (float)(bj == 0 ? (t >> 6) : (t & 63));
                        const f32x4 xa = acc[ai][bj][m][0] * rs * *(const f32x4*)(gp + 32 * bj), xb = acc[ai][bj][m][1] * rs * *(const f32x4*)(gp + 32 * bj + 16);
                        f32x4 oa, ob;
#pragma unroll
                        for (int q = 0; q < 4; ++q) { const float rev = pos * invr[q]; const float c = __builtin_amdgcn_cosf(rev), s = __builtin_amdgcn_sinf(rev);
                            oa[q] = xa[q] * c - xb[q] * s; ob[q] = xa[q] * s + xb[q] * c; }
                        u32x2 w; w.x = cvt_pk_bf16(oa[0], oa[1]); w.y = cvt_pk_bf16(oa[2], oa[3]); *(u32x2*)(rowp + 32 * bj) = w;
                        w.x = cvt_pk_bf16(ob[0], ob[1]); w.y = cvt_pk_bf16(ob[2], ob[3]); *(u32x2*)(rowp + 32 * bj + 16) = w;
                    }
                    asm volatile("" ::: "memory");
                }
        } else {
            const float s = (u.pn == 5) ? csc : 1.f;
#pragma unroll
            for (int ai = 0; ai < 2; ++ai)
#pragma unroll
                for (int m = 0; m < 4; ++m) { bf16_t* rowp = O + (size_t)(row0 + ai * HALF + m * 16) * ldc + colb;
#pragma unroll
                    for (int bj = 0; bj < 2; ++bj)
#pragma unroll
                        for (int n = 0; n < 2; ++n) { const f32x4 v = acc[ai][bj][m][n] * s; u32x2 w; w.x = cvt_pk_bf16(v[0], v[1]); w.y = cvt_pk_bf16(v[2], v[3]);
                            *(u32x2*)(rowp + 32 * bj + 16 * n) = w; } }
        }
    }
};
struct EpiResF32 {
    static constexpr bool PERM = false, AFTER_DRAIN = false;
    const float* res; float* out; int ldc;
    __device__ __forceinline__ void operator()(const f32x4 (&acc)[2][2][4][2], const Unit& u, int wr, int wc, int fr, int fq) const {
        const int row0 = u.pm * BM + wr * 64 + fr, col0 = u.pn * BM + wc * 32 + 4 * fq;
#pragma unroll
        for (int ai = 0; ai < 2; ++ai)
#pragma unroll
            for (int m = 0; m < 4; ++m) { const size_t off = (size_t)(row0 + ai * HALF + m * 16) * ldc + col0;
#pragma unroll
                for (int bj = 0; bj < 2; ++bj)
#pragma unroll
                    for (int n = 0; n < 2; ++n) { const f32x4 r = *(const f32x4*)(res + off + bj * HALF + n * 16); *(f32x4*)(out + off + bj * HALF + n * 16) = r + acc[ai][bj][m][n]; } }
    }
};
__device__ __forceinline__ unsigned pk4_fp8_sat(const f32x4 x) {
    unsigned w = 0;
    w = __builtin_amdgcn_cvt_pk_fp8_f32(__builtin_amdgcn_fmed3f(x[0], -448.f, 448.f), __builtin_amdgcn_fmed3f(x[1], -448.f, 448.f), w, false);
    w = __builtin_amdgcn_cvt_pk_fp8_f32(__builtin_amdgcn_fmed3f(x[2], -448.f, 448.f), __builtin_amdgcn_fmed3f(x[3], -448.f, 448.f), w, true);
    return w;
}
struct EpiOutX {
    static constexpr bool PERM = true, AFTER_DRAIN = false;
    const float* res; float* out; int ldc; const float* gain; const float* WrG; unsigned char* XN8; float* PLG; float* PSS; int M;
    static __device__ __forceinline__ void split8(const f32x4 a, const f32x4 b, bf16x8& hi, bf16x8& lo) {
        u32x4 h, l; float r[8] = {a[0], a[1], a[2], a[3], b[0], b[1], b[2], b[3]};
#pragma unroll
        for (int k = 0; k < 4; ++k) { const unsigned p = cvt_pk_bf16(r[2 * k], r[2 * k + 1]); h[k] = p;
            const float d0 = r[2 * k] - __builtin_bit_cast(float, p << 16), d1 = r[2 * k + 1] - __builtin_bit_cast(float, p & 0xffff0000u); l[k] = cvt_pk_bf16(d0, d1); }
        hi = __builtin_bit_cast(bf16x8, h); lo = __builtin_bit_cast(bf16x8, l);
    }
    __device__ __forceinline__ void operator()(f32x4 (&acc)[2][2][4][2], const Unit& u, int wr, int wc, int fr, int fq) const {
        const int row0 = u.pm * BM + wr * 64 + fr, col0 = u.pn * BM + wc * 32 + 8 * fq, slot = u.pn * 4 + wc;
        bf16x8 whi[2], wlo[2];
#pragma unroll
        for (int bj = 0; bj < 2; ++bj) { const float* wp = WrG + (size_t)fr * ldc + col0 + bj * HALF; split8(*(const f32x4*)wp, *(const f32x4*)(wp + 4), whi[bj], wlo[bj]); }
#pragma unroll
        for (int idx = 0; idx < 8; ++idx) { const int ai = idx >> 2, m = idx & 3;
            const int row = row0 + ai * HALF + m * 16; const size_t off = (size_t)row * ldc + col0; float ss = 0.f; f32x4 lg = (f32x4){0.f, 0.f, 0.f, 0.f}; u32x4 xw;
#pragma unroll
            for (int bj = 0; bj < 2; ++bj) {
#pragma unroll
                for (int n = 0; n < 2; ++n) { const int co = bj * HALF + n * 4;
                    const f32x4 h = *(const f32x4*)(res + off + co) + acc[ai][bj][m][n]; acc[ai][bj][m][n] = h; *(f32x4*)(out + off + co) = h;
                    ss += (h[0] * h[0] + h[1] * h[1]) + (h[2] * h[2] + h[3] * h[3]);
                    const f32x4 x = h * *(const f32x4*)(gain + col0 + co);
                    xw[bj * 2 + n] = pk4_fp8_sat(x); }
                bf16x8 hhi, hlo; split8(acc[ai][bj][m][0], acc[ai][bj][m][1], hhi, hlo);
                lg = __builtin_amdgcn_mfma_f32_16x16x32_bf16(wlo[bj], hhi, lg, 0, 0, 0);
                lg = __builtin_amdgcn_mfma_f32_16x16x32_bf16(whi[bj], hlo, lg, 0, 0, 0);
                lg = __builtin_amdgcn_mfma_f32_16x16x32_bf16(whi[bj], hhi, lg, 0, 0, 0); }
            *(u32x4*)(XN8 + (size_t)row * ldc + u.pn * BM + wc * 64 + fq * 16) = xw;
            ss += __shfl_xor(ss, 16); ss += __shfl_xor(ss, 32);
            if (fq == 0) PSS[(size_t)slot * M + row] = ss;
            *(f32x4*)(PLG + ((size_t)slot * M + row) * 16 + 4 * fq) = lg;
            asm volatile("" ::: "memory"); }
    }
};
struct EpiSwiGLU {
    static constexpr bool PERM = false, AFTER_DRAIN = false;
    bf16_t* O; int ldc;
    __device__ __forceinline__ void operator()(const f32x4 (&acc)[2][2][4][2], const Unit& u, int wr, int wc, int fr, int fq) const {
        const int row0 = u.pm * BM + wr * 64 + fr, col0 = u.pn * HALF + wc * 32 + 4 * fq;
#pragma unroll
        for (int ai = 0; ai < 2; ++ai)
#pragma unroll
            for (int m = 0; m < 4; ++m) { bf16_t* rowp = O + (size_t)(row0 + ai * HALF + m * 16) * ldc + col0;
#pragma unroll
                for (int n = 0; n < 2; ++n) { const f32x4 g = acc[ai][0][m][n], up = acc[ai][1][m][n]; f32x4 h;
#pragma unroll
                    for (int q = 0; q < 4; ++q) h[q] = g[q] * up[q] * __builtin_amdgcn_rcpf(1.f + __expf(-g[q]));
                    u32x2 w; w.x = cvt_pk_bf16(h[0], h[1]); w.y = cvt_pk_bf16(h[2], h[3]); *(u32x2*)(rowp + n * 16) = w; } }
    }
};
struct EpiSwiGLU8 {
    static constexpr bool PERM = false, AFTER_DRAIN = false;
    unsigned char* O; int ldc; float wsc; const float* rs;
    __device__ __forceinline__ void operator()(const f32x4 (&acc)[2][2][4][2], const Unit& u, int wr, int wc, int fr, int fq) const {
        const int row0 = u.pm * BM + wr * 64 + fr, col0 = u.pn * HALF + wc * 32 + 4 * fq;
#pragma unroll
        for (int ai = 0; ai < 2; ++ai)
#pragma unroll
            for (int m = 0; m < 4; ++m) { const int row = row0 + ai * HALF + m * 16; const float sc = wsc * rs[row]; u32x2 hw;
#pragma unroll
                for (int n = 0; n < 2; ++n) { const f32x4 g = acc[ai][0][m][n] * sc, up = acc[ai][1][m][n] * sc; f32x4 h;
#pragma unroll
                    for (int q = 0; q < 4; ++q) h[q] = g[q] * up[q] * __builtin_amdgcn_rcpf(1.f + __expf(-g[q]));
                    hw[n] = pk4_fp8_sat(h); }
                *(u32x2*)(O + (size_t)row * ldc + u.pn * HALF + wc * 32 + fq * 8) = hw; }
    }
};
struct EpiDown {
    static constexpr bool PERM = true, AFTER_DRAIN = false;
    bf16_t* O; int ldc; const float* gate; float wsc;
    __device__ __forceinline__ void operator()(const f32x4 (&acc)[2][2][4][2], const Unit& u, int wr, int wc, int fr, int fq) const {
        const int row0 = u.pm * BM + wr * 64 + fr, col0 = u.pn * BM + wc * 32 + 8 * fq;
#pragma unroll
        for (int ai = 0; ai < 2; ++ai)
#pragma unroll
            for (int m = 0; m < 4; ++m) { const int row = row0 + ai * HALF + m * 16; const float gs = gate[row] * wsc; bf16_t* rowp = O + (size_t)row * ldc + col0;
#pragma unroll
                for (int bj = 0; bj < 2; ++bj) { const f32x4 v0 = acc[ai][bj][m][0] * gs, v1 = acc[ai][bj][m][1] * gs; u32x4 w;
                    w.x = cvt_pk_bf16(v0[0], v0[1]); w.y = cvt_pk_bf16(v0[2], v0[3]); w.z = cvt_pk_bf16(v1[0], v1[1]); w.w = cvt_pk_bf16(v1[2], v1[3]);
                    *(u32x4*)(rowp + bj * HALF) = w; } }
    }
};
template <class Epi, class Sched, bool ALIGN_EPI = false, bool SP2 = false, bool GATHER = false, bool FP8 = false>
__device__ __forceinline__ void gemm_phase(PG8_LAS unsigned char* lds, const Gemm g, const Sched& S, const Epi& E, int wave_s, const int* gidx = nullptr) {
    const int tid = opaque_tid(wave_s), wid = __builtin_amdgcn_readfirstlane(tid >> 6), lane = tid & 63, wr = wid >> 2, wc = wid & 3, fr = lane & 15, fq = lane >> 4;
    const int K = g.K, nt = K / BK;
    unsigned voffA[2], voffB[2];
#pragma unroll
    for (int i = 0; i < 2; ++i) { int R, C; stage_rc(tid * 16 + i * 8192, R, C); const int Rb = Epi::PERM ? ((R & ~31) + perm32(R & 31)) : R;
        voffA[i] = (unsigned)(R * K + C) * 2u; voffB[i] = (unsigned)(Rb * K + C) * 2u; }
    const size_t kstep = (size_t)(BK * 2);
    const size_t hstep = (size_t)HALF * K * 2;
    const size_t tstep = 2 * hstep;
    const unsigned ldsw = (unsigned)wid * 1024u;
    const int aoff = lds_byte(wr * 64 + fr, fq * 8), boff = lds_byte(wc * 32 + fr, fq * 8);
#define PG8_SA(b, h) (((b) * 2 + (h)) * HTB)
#define PG8_SB(b, h) ((4 + (b) * 2 + (h)) * HTB)
#define PG8_STAGE(bufoff, gbase, voff) do { _Pragma("unroll") for (int _i = 0; _i < 2; ++_i) \
        __builtin_amdgcn_global_load_lds((const unsigned*)((const char*)(gbase) + (voff)[_i]), (PG8_LAS unsigned*)(lds + (bufoff) + ldsw + _i * 8192), 16, 0, 0); } while (0)
#define PG8_LDA(dst, b, h) do { _Pragma("unroll") for (int m = 0; m < 4; ++m) { if constexpr (FP8) { const v4i_ lo_ = *(const PG8_LAS v4i_*)(lds + PG8_SA(b, h) + aoff + m * 2048), hi_ = *(const PG8_LAS v4i_*)(lds + PG8_SA(b, h) + aoff + m * 2048 + 1024); \
        dst##8[m] = __builtin_shufflevector(lo_, hi_, 0, 1, 2, 3, 4, 5, 6, 7); } else { _Pragma("unroll") for (int k = 0; k < 2; ++k) dst[m][k] = *(const PG8_LAS bf16x8*)(lds + PG8_SA(b, h) + aoff + m * 2048 + k * 1024); } } } while (0)
#define PG8_LDB(dst, b, h) do { _Pragma("unroll") for (int n = 0; n < 2; ++n) { if constexpr (FP8) { const v4i_ lo_ = *(const PG8_LAS v4i_*)(lds + PG8_SB(b, h) + boff + n * 2048), hi_ = *(const PG8_LAS v4i_*)(lds + PG8_SB(b, h) + boff + n * 2048 + 1024); \
        dst##8[n] = __builtin_shufflevector(lo_, hi_, 0, 1, 2, 3, 4, 5, 6, 7); } else { _Pragma("unroll") for (int k = 0; k < 2; ++k) dst[n][k] = *(const PG8_LAS bf16x8*)(lds + PG8_SB(b, h) + boff + n * 2048 + k * 1024); } } } while (0)
#define PG8_MMA(ai, bj, At, Bt) do { __builtin_amdgcn_s_setprio(1); _Pragma("unroll") for (int m = 0; m < 4; ++m) _Pragma("unroll") for (int n = 0; n < 2; ++n) { \
        if constexpr (FP8) asm volatile("v_mfma_scale_f32_16x16x128_f8f6f4 %0, %1, %2, %0, %3, %3 op_sel_hi:[0,0,0]" : "+v"(acc[ai][bj][m][n]) : "v"(Bt##8[n]), "v"(At##8[m]), "v"(sc127_));   \
        else { _Pragma("unroll") for (int k = 0; k < 2; ++k) acc[ai][bj][m][n] = __builtin_amdgcn_mfma_f32_16x16x32_bf16(Bt[n][k], At[m][k], acc[ai][bj][m][n], 0, 0, 0); } } \
        __builtin_amdgcn_s_setprio(0); } while (0)
#define PG8_WAIT_V(n) asm volatile("s_waitcnt vmcnt(" #n ")" ::: "memory")
#define PG8_WAIT_L(n) asm volatile("s_waitcnt lgkmcnt(" #n ")" ::: "memory")
#define PG8_BAR __builtin_amdgcn_s_barrier()
#define PG8_SCHED __builtin_amdgcn_sched_barrier(0)
    Unit cur, nxt; int ui = 0;
    if (!S.next(0, cur)) return;
    f32x4 acc[2][2][4][2];
#pragma unroll
    for (int a = 0; a < 2; ++a)
#pragma unroll
        for (int b = 0; b < 2; ++b)
#pragma unroll
            for (int m = 0; m < 4; ++m)
#pragma unroll
                for (int n = 0; n < 2; ++n) acc[a][b][m][n] = (f32x4){0.f, 0.f, 0.f, 0.f};
    typedef int v8i_ __attribute__((ext_vector_type(8))); typedef int v4i_ __attribute__((ext_vector_type(4)));
    const int sc127_ = 127;
    bf16x8 At[4][2], B0[2][2], B1[2][2]; v8i_ At8[4], B08[2], B18[2];
    static_assert(SP2, "this copy of the body keeps only the SP2 K-loop up to date");
    int rA[2]; { int R_, C_; stage_rc(tid * 16, R_, C_); rA[0] = R_; stage_rc(tid * 16 + 8192, R_, C_); rA[1] = R_; }
    unsigned cvp[2], nvp[2], c2_[2]; c2_[0] = voffA[0] - (unsigned)(rA[0] * K) * 2u; c2_[1] = voffA[1] - (unsigned)(rA[1] * K) * 2u;
#define PG8_ROWOFF(dst, unit) do { _Pragma("unroll") for (int i_ = 0; i_ < 2; ++i_) dst[i_] = (unsigned)gidx[(unit).pm * BM + rA[i_]] | ((unsigned)gidx[(unit).pm * BM + HALF + rA[i_]] << 16); } while (0)
#define PG8_STAGE_A(bufoff, gbase, P, H) do { if constexpr (GATHER) { unsigned to_[2]; _Pragma("unroll") for (int i_ = 0; i_ < 2; ++i_) to_[i_] = ((P[i_] >> (16 * (H))) & 0xffffu) * (unsigned)(K * 2) + c2_[i_]; PG8_STAGE(bufoff, gbase, to_); } \
        else { PG8_STAGE(bufoff, (gbase) + ((H) ? hstep : (size_t)0), voffA); } } while (0)
    if constexpr (GATHER) PG8_ROWOFF(cvp, cur); else { cvp[0] = 0u; cvp[1] = 0u; }
    const char* cA = GATHER ? (const char*)g.A : (const char*)g.A + (size_t)cur.pm * tstep; const char* cB = (const char*)g.Bt + (size_t)((cur.pm / g.gdiv) % g.gmod) * g.gstride + (size_t)cur.pn * tstep;
    S.a_ready(cur);
    if constexpr (SP2) {
        PG8_STAGE(PG8_SB(0, 0), cB, voffB); PG8_STAGE(PG8_SB(0, 1), cB + hstep, voffB); PG8_STAGE_A(PG8_SA(0, 0), cA, cvp, 0); PG8_STAGE_A(PG8_SA(0, 1), cA, cvp, 1);
        if (wr == 1) PG8_BAR;
        PG8_WAIT_V(2); PG8_BAR;
        PG8_STAGE(PG8_SB(1, 0), cB + kstep, voffB); PG8_STAGE_A(PG8_SA(1, 0), cA + kstep, cvp, 0); PG8_STAGE(PG8_SB(1, 1), cB + hstep + kstep, voffB);
        PG8_WAIT_V(6); PG8_BAR;
    } else {
        PG8_STAGE(PG8_SB(0, 0), cB, voffB); PG8_STAGE(PG8_SA(0, 0), cA, voffA); PG8_STAGE(PG8_SB(0, 1), cB + hstep, voffB); PG8_STAGE(PG8_SA(0, 1), cA + hstep, voffA);
        if (wr == 1) PG8_BAR;
        PG8_WAIT_V(4); PG8_BAR;
        PG8_STAGE(PG8_SB(1, 0), cB + kstep, voffB); PG8_STAGE(PG8_SA(1, 0), cA + kstep, voffA); PG8_STAGE(PG8_SB(1, 1), cB + hstep + kstep, voffB);
        PG8_WAIT_V(6); PG8_BAR;
    }
    for (;;) {
        const bool has_next = S.next(ui + 1, nxt);
        if constexpr (GATHER) { if (has_next) PG8_ROWOFF(nvp, nxt); else { nvp[0] = cvp[0]; nvp[1] = cvp[1]; } } else { nvp[0] = 0u; nvp[1] = 0u; }
        const char* nA = GATHER ? (const char*)g.A : (has_next ? (const char*)g.A + (size_t)nxt.pm * tstep : cA); const char* nB = has_next ? (const char*)g.Bt + (size_t)((nxt.pm / g.gdiv) % g.gmod) * g.gstride + (size_t)nxt.pn * tstep : cB;
        for (int t = 0; t < nt; t += 2) {
            const bool last = (t == nt - 2);
            unsigned svp[2]; svp[0] = last ? nvp[0] : cvp[0]; svp[1] = last ? nvp[1] : cvp[1];
            const char* a1 = cA + (size_t)(t + 1) * kstep;
            const char* a2 = last ? nA : cA + (size_t)(t + 2) * kstep; const char* b2 = last ? nB : cB + (size_t)(t + 2) * kstep;
            const char* a3 = a2 + kstep; const char* b3 = b2 + kstep;
            if (last && has_next) S.a_ready(nxt);
            if constexpr (SP2) {
            PG8_LDB(B0, 0, 0); PG8_LDB(B1, 0, 1); PG8_SCHED; PG8_LDA(At, 0, 0); PG8_STAGE_A(PG8_SA(1, 1), a1, cvp, 1);
            PG8_WAIT_V(8); PG8_WAIT_L(0); PG8_BAR; PG8_MMA(0, 0, At, B0); PG8_MMA(0, 1, At, B1); PG8_BAR; PG8_SCHED;
            PG8_LDA(At, 0, 1); PG8_STAGE(PG8_SB(0, 0), b2, voffB); PG8_STAGE(PG8_SB(0, 1), b2 + hstep, voffB); PG8_STAGE_A(PG8_SA(0, 0), a2, svp, 0);
            PG8_WAIT_V(8); PG8_WAIT_L(0); PG8_BAR; PG8_MMA(1, 0, At, B0); PG8_MMA(1, 1, At, B1); PG8_BAR; PG8_SCHED;
            PG8_LDB(B0, 1, 0); PG8_LDB(B1, 1, 1); PG8_SCHED; PG8_LDA(At, 1, 0); PG8_STAGE_A(PG8_SA(0, 1), a2, svp, 1);
            PG8_WAIT_V(8); PG8_WAIT_L(0); PG8_BAR; PG8_MMA(0, 0, At, B0); PG8_MMA(0, 1, At, B1); PG8_BAR; PG8_SCHED;
            PG8_LDA(At, 1, 1); PG8_STAGE(PG8_SB(1, 0), b3, voffB); PG8_STAGE(PG8_SB(1, 1), b3 + hstep, voffB); PG8_STAGE_A(PG8_SA(1, 0), a3, svp, 0);
            PG8_WAIT_V(8); PG8_WAIT_L(0); PG8_BAR; PG8_MMA(1, 0, At, B0); PG8_MMA(1, 1, At, B1); PG8_BAR; PG8_SCHED;
            } else {
            PG8_LDB(B0, 0, 0); PG8_SCHED; PG8_LDA(At, 0, 0); PG8_STAGE(PG8_SA(1, 1), a1 + hstep, voffA);
            PG8_WAIT_L(8); PG8_BAR; PG8_WAIT_L(0); PG8_MMA(0, 0, At, B0); PG8_BAR; PG8_SCHED;
            PG8_LDB(B1, 0, 1); PG8_STAGE(PG8_SB(0, 0), b2, voffB);
            PG8_BAR; PG8_WAIT_L(0); PG8_MMA(0, 1, At, B1); PG8_BAR;
            PG8_LDA(At, 0, 1); PG8_STAGE(PG8_SA(0, 0), a2, voffA);
            PG8_BAR; PG8_WAIT_L(0); PG8_MMA(1, 0, At, B0); PG8_BAR; PG8_SCHED;
            PG8_STAGE(PG8_SB(0, 1), b2 + hstep, voffB);
            PG8_WAIT_V(6); PG8_BAR; PG8_MMA(1, 1, At, B1); PG8_BAR;
            PG8_LDB(B0, 1, 0); PG8_SCHED; PG8_LDA(At, 1, 0); PG8_STAGE(PG8_SA(0, 1), a2 + hstep, voffA);
            PG8_WAIT_L(8); PG8_BAR; PG8_WAIT_L(0); PG8_MMA(0, 0, At, B0); PG8_BAR; PG8_SCHED;
            PG8_LDB(B1, 1, 1); PG8_STAGE(PG8_SB(1, 0), b3, voffB);
            PG8_BAR; PG8_WAIT_L(0); PG8_MMA(0, 1, At, B1); PG8_BAR;
            PG8_LDA(At, 1, 1); PG8_STAGE(PG8_SA(1, 0), a3, voffA);
            PG8_BAR; PG8_WAIT_L(0); PG8_MMA(1, 0, At, B0); PG8_BAR; PG8_SCHED;
            PG8_STAGE(PG8_SB(1, 1), b3 + hstep, voffB);
            PG8_WAIT_V(6); PG8_BAR; PG8_MMA(1, 1, At, B1); PG8_BAR;
            }
        }
        if constexpr (ALIGN_EPI) { if (wr == 0) PG8_BAR; }
        if constexpr (!Epi::AFTER_DRAIN) { const int t_e = opaque_tid(wave_s); const int fr_e = t_e & 15, fq_e = (t_e & 63) >> 4;
            E(acc, cur, wr, wc, fr_e, fq_e); S.done(cur); }
        if (!has_next) break;
#pragma unroll
        for (int a = 0; a < 2; ++a)
#pragma unroll
            for (int b = 0; b < 2; ++b)
#pragma unroll
                for (int m = 0; m < 4; ++m)
#pragma unroll
                    for (int n = 0; n < 2; ++n) acc[a][b][m][n] = (f32x4){0.f, 0.f, 0.f, 0.f};
        cur = nxt; cA = nA; cB = nB; ++ui; if constexpr (GATHER) { cvp[0] = nvp[0]; cvp[1] = nvp[1]; }
        if constexpr (ALIGN_EPI) { if (wr == 1) PG8_BAR; }
    }
    PG8_WAIT_V(0);
    if constexpr (!ALIGN_EPI) { if (wr == 0) PG8_BAR; }
    PG8_BAR;
    if constexpr (Epi::AFTER_DRAIN) { E.fused(acc, cur, wr, wc, fr, fq, lds, wid, lane); S.done(cur); }
#undef PG8_ROWOFF
#undef PG8_STAGE_A
#undef PG8_SA
#undef PG8_SB
#undef PG8_STAGE
#undef PG8_LDA
#undef PG8_LDB
#undef PG8_MMA
#undef PG8_WAIT_V
#undef PG8_WAIT_L
#undef PG8_BAR
#undef PG8_SCHED
}
}
namespace attn_body {
using bf16=__hip_bfloat16;
using bf16x8=__attribute__((ext_vector_type(8)))short;
using s16x4=__attribute__((ext_vector_type(4)))short;
using f32x16=__attribute__((ext_vector_type(16)))float;
using u32x4=__attribute__((ext_vector_type(4)))unsigned;
constexpr int D=64;
constexpr int NW=8,QBLK=32,QB=QBLK*NW,KVBLK=64;
__device__ __forceinline__ int crow(int r,int hi){return (r&3)+8*(r>>2)+4*hi;}
#define SBAR() __builtin_amdgcn_sched_barrier(0)
__device__ __forceinline__ void cmask(f32x16&p0,f32x16&p1,int jb,int qrel,int hi){
  const float NEG=-INFINITY; int kb=64*jb+4*hi;
  #pragma unroll
  for(int r=0;r<16;++r){int kv=kb+(r&3)+8*(r>>2); if(kv>qrel)p0[r]=NEG; if(kv+32>qrel)p1[r]=NEG;}
}

constexpr int NSLOT=3, SLOTB=8192;
constexpr int LDS_K=0, LDS_V=NSLOT*SLOTB, LDS_WS=2*NSLOT*SLOTB, LDS_OST=LDS_WS+NW*64*4, LDS_BYTES=LDS_OST+NW*4096;
constexpr float C2=0.125f*1.4426950408889634f;
__device__ __forceinline__ void glds16(const void*gsrc,unsigned lds_dst){unsigned keep;
  asm volatile("s_mov_b32 %0, m0\n\ts_mov_b32 m0, %2\n\ts_nop 0\n\tglobal_load_lds_dwordx4 %1, off\n\ts_mov_b32 m0, %0":"=&s"(keep):"v"(gsrc),"s"(lds_dst):"memory");}
__device__ __forceinline__ float max3f(float a,float b,float c){float r;asm("v_max3_f32 %0, %1, %2, %3":"=v"(r):"v"(a),"v"(b),"v"(c));return r;}
__device__ __forceinline__ float max2f(float a,float b){float r;asm("v_max_f32_e32 %0, %1, %2":"=v"(r):"v"(a),"v"(b));return r;}
__device__ __forceinline__ float fadd_s(float a,float b){float r;asm("v_add_f32_e32 %0, %1, %2":"=v"(r):"v"(a),"v"(b));return r;}
__device__ __forceinline__ float fsub_s(float a,float b){float r;asm("v_sub_f32_e32 %0, %1, %2":"=v"(r):"v"(a),"v"(b));return r;}
typedef float f32x2_t __attribute__((ext_vector_type(2))); typedef __bf16 bf16x2_t __attribute__((ext_vector_type(2)));
__device__ __forceinline__ unsigned cvtpk_s(float lo,float hi){f32x2_t v={lo,hi};bf16x2_t b=__builtin_convertvector(v,bf16x2_t);return __builtin_bit_cast(unsigned,b);}
#define WAIT_BAR(N) asm volatile("s_waitcnt vmcnt(" #N ") lgkmcnt(0)\n\ts_barrier":::"memory")

__device__ __forceinline__ void qkt(f32x16&p0,f32x16&p1,const char*Kslot,const bf16x8*qr,const f32x16&negm,int r32,int hi){
  const char*kb=Kslot+hi*1024+r32*16;
  #pragma unroll
  for(int d0=0;d0<4;++d0){
    const bf16x8 b0=*reinterpret_cast<const bf16x8*>(kb+d0*2048);
    const bf16x8 b1=*reinterpret_cast<const bf16x8*>(kb+d0*2048+512);
    if(d0==0){p0=__builtin_amdgcn_mfma_f32_32x32x16_bf16(b0,qr[0],negm,0,0,0);p1=__builtin_amdgcn_mfma_f32_32x32x16_bf16(b1,qr[0],negm,0,0,0);}
    else{p0=__builtin_amdgcn_mfma_f32_32x32x16_bf16(b0,qr[d0],p0,0,0,0);p1=__builtin_amdgcn_mfma_f32_32x32x16_bf16(b1,qr[d0],p1,0,0,0);}}
}
typedef __attribute__((address_space(3))) const char* lds_cptr;
typedef short v4i16_t __attribute__((ext_vector_type(4)));
__device__ __forceinline__ void kload8(bf16x8*kf,lds_cptr kp){
  kf[0]=*(const __attribute__((address_space(3))) bf16x8*)(kp);      kf[1]=*(const __attribute__((address_space(3))) bf16x8*)(kp+512);
  kf[2]=*(const __attribute__((address_space(3))) bf16x8*)(kp+2048); kf[3]=*(const __attribute__((address_space(3))) bf16x8*)(kp+2560);
  kf[4]=*(const __attribute__((address_space(3))) bf16x8*)(kp+4096); kf[5]=*(const __attribute__((address_space(3))) bf16x8*)(kp+4608);
  kf[6]=*(const __attribute__((address_space(3))) bf16x8*)(kp+6144); kf[7]=*(const __attribute__((address_space(3))) bf16x8*)(kp+6656);
}
__device__ __forceinline__ void kload2(bf16x8*kf,lds_cptr kp,int j){ kf[2*j]=*(const __attribute__((address_space(3))) bf16x8*)(kp+j*2048); kf[2*j+1]=*(const __attribute__((address_space(3))) bf16x8*)(kp+j*2048+512); }
__device__ __forceinline__ s16x4 vtr(lds_cptr p){ return __builtin_bit_cast(s16x4,__builtin_amdgcn_ds_read_tr16_b64_v4i16((__attribute__((address_space(3))) v4i16_t*)p)); }
__device__ __forceinline__ float rowmax(const f32x16&p0,const f32x16&p1){
  float a=max3f(p0[0],p0[1],p1[0]),b=max3f(p0[2],p0[3],p1[1]);a=max3f(a,p1[2],p1[3]);
  #pragma unroll
  for(int r=4;r<16;r+=4){a=max3f(a,p0[r],p0[r+1]);b=max3f(b,p0[r+2],p0[r+3]);a=max3f(a,p1[r],p1[r+1]);b=max3f(b,p1[r+2],p1[r+3]);}
  const float m=max2f(a,b);
  auto rr=__builtin_amdgcn_permlane32_swap(__float_as_uint(m),__float_as_uint(m),false,false);
  return max2f(__uint_as_float(rr[0]),__uint_as_float(rr[1]));
}
__device__ __forceinline__ void pv(f32x16*o,int vb,bf16x8 pa0,bf16x8 pa1,bf16x8 pa2,bf16x8 pa3){
  #pragma unroll
  for(int d0=0;d0<2;++d0){s16x4 lo[4],hi[4];
    #pragma unroll
    for(int ks=0;ks<4;++ks){
      asm volatile("ds_read_b64_tr_b16 %0,%1 offset:%c2":"=&v"(lo[ks]):"v"(vb),"i"(d0*4096+ks*1024):"memory");
      asm volatile("ds_read_b64_tr_b16 %0,%1 offset:%c2":"=&v"(hi[ks]):"v"(vb),"i"(d0*4096+ks*1024+512):"memory");}
    asm volatile("s_waitcnt lgkmcnt(0)":::"memory");SBAR();
    #define PK(k) (bf16x8){lo[k][0],lo[k][1],lo[k][2],lo[k][3],hi[k][0],hi[k][1],hi[k][2],hi[k][3]}
    o[d0]=__builtin_amdgcn_mfma_f32_32x32x16_bf16(pa0,PK(0),o[d0],0,0,0);
    o[d0]=__builtin_amdgcn_mfma_f32_32x32x16_bf16(pa1,PK(1),o[d0],0,0,0);
    o[d0]=__builtin_amdgcn_mfma_f32_32x32x16_bf16(pa2,PK(2),o[d0],0,0,0);
    o[d0]=__builtin_amdgcn_mfma_f32_32x32x16_bf16(pa3,PK(3),o[d0],0,0,0);
    #undef PK
  }
}

#ifndef ATTN_STORE16
#define ATTN_STORE16(p,v) (*(u32x4*)(p)=(v))
#endif
template<int THRL,int QP,int KP,int OP> __device__ __forceinline__ void attn_unit(const bf16*Qu,const bf16*__restrict__ Kh,const bf16*__restrict__ Vh,bf16*Ou,const int NT,char*shm,int wave_s){
  const int tid=opaque_tid(wave_s),lane=tid&63,r32=lane&31,hi=lane>>5; const int wid=__builtin_amdgcn_readfirstlane(tid>>6);
  const bf16*Qw=Qu+(long)(wid*QBLK)*QP;
  const unsigned lds0=(unsigned)(uintptr_t)shm;
  float*wsf=(float*)(shm+LDS_WS)+wid*64;
  const bf16*ksrc=Kh+(long)lane*KP+wid*8;
  const bf16*vsrc=Vh+(long)(16*(wid&3)+(lane>>2))*KP+(wid>>2)*32+(lane&3)*8;
  const unsigned kdst=lds0+LDS_K+wid*1024, vdst=lds0+LDS_V+wid*1024;
  #define DMA_K(t,slot) glds16(ksrc+(long)(t)*KVBLK*KP,(unsigned)__builtin_amdgcn_readfirstlane(kdst+(slot)))
  #define DMA_V(t,slot) glds16(vsrc+(long)(t)*KVBLK*KP,(unsigned)__builtin_amdgcn_readfirstlane(vdst+(slot)))
  const int vb0=(int)(lds0+LDS_V)+((lane>>4)&1)*32+(lane&3)*8+(4*hi+((lane&15)>>2))*64;
  const char*Kbase=shm+LDS_K; bf16x8 kf[8];
  const lds_cptr shm3=(lds_cptr)shm; const lds_cptr kp0=shm3+LDS_K+hi*1024+r32*16; const lds_cptr vp0=shm3+LDS_V+((lane>>4)&1)*32+(lane&3)*8+(4*hi+((lane&15)>>2))*64;
  DMA_K(0,0);DMA_V(0,0);DMA_K(1,SLOTB);
  bf16x8 qr[4];
  #pragma unroll
  for(int d0=0;d0<4;++d0)qr[d0]=*reinterpret_cast<const bf16x8*>(&Qw[(long)r32*QP+d0*16+hi*8]);
  float mhat=0.f,l_reg=0.f;f32x16 o[2];o[0]=f32x16{};o[1]=f32x16{};f32x16 negm=f32x16{};asm volatile("":"+v"(negm));
  #define CMASK(P0,P1,t) do{}while(0)
  bool resc=false;
  #define START(P0,P1) do{ const float rm=(THRL<0)?14.0f:rowmax(P0,P1); resc=false; \
    { const float dl=rm; mhat=fadd_s(mhat,dl); \
      _Pragma("unroll") for(int r=0;r<16;++r){P0[r]=fsub_s(P0[r],dl);P1[r]=fsub_s(P1[r],dl);} \
      _Pragma("unroll") for(int r=0;r<16;++r)negm[r]=-mhat; asm volatile("":"+v"(negm)); } \
    _Pragma("unroll") for(int r=0;r<16;++r)P0[r]=__builtin_amdgcn_exp2f(P0[r]); }while(0)
  #define RESC() do{ if(resc){ asm volatile("s_waitcnt lgkmcnt(0)":::"memory"); \
      _Pragma("unroll") for(int d_=0;d_<2;++d_) _Pragma("unroll") for(int r=0;r<16;++r)o[d_][r]*=wsf[crow(r,hi)]; } }while(0)
  f32x16 pA0,pA1,pB0,pB1;
  int sl_prev=0,sl_cur=0,sl_next=SLOTB;
  #define ROT() do{sl_prev=sl_cur;sl_cur=sl_next;sl_next=(sl_next==(NSLOT-1)*SLOTB)?0:sl_next+SLOTB;}while(0)
  DMA_K(2,2*SLOTB);
  WAIT_BAR(3);
  qkt(pA0,pA1,Kbase,qr,negm,r32,hi);asm volatile("s_nop 15\n\ts_nop 7":"+v"(pA0),"+v"(pA1));CMASK(pA0,pA1,0);
  START(pA0,pA1);
  _Pragma("unroll") for(int r=0;r<16;++r)pA1[r]=__builtin_amdgcn_exp2f(pA1[r]);
  WAIT_BAR(0);
  DMA_K(3,0);DMA_V(1,SLOTB);
  ROT();
  kload8(kf,kp0+sl_cur);
  WAIT_BAR(2);
  s16x4 vlo[8],vhi[8]; u32x4 pw0,pw1,pw2,pw3;
  #define PKW(P,B) cvtpk_s(P[B],P[B+1])
  #define PAF(k) __builtin_bit_cast(bf16x8,pw##k)
  #define VFR(i) (bf16x8){vlo[i][0],vlo[i][1],vlo[i][2],vlo[i][3],vhi[i][0],vhi[i][1],vhi[i][2],vhi[i][3]}
  #define PIN(x) asm volatile("":"+v"(x))
  #define MX3(a,b,c) __builtin_fmaxf(__builtin_fmaxf((a),(b)),(c))
  #define GAPA(MF,A0,A1,A2,A3,W0,W1,PW) do{ MF; sacc+=A0; sacc+=A1; sacc+=A2; sacc+=A3; PIN(sacc); W0; W1; PIN(PW); SBAR(); }while(0)
  #define EX(v) __builtin_amdgcn_exp2f(v)
  #define GAPB(MF,X,B) do{ MF; X[B]=EX(X[B]); X[B+1]=EX(X[B+1]); X[B+2]=EX(X[B+2]); X[B+3]=EX(X[B+3]); PIN(X); SBAR(); }while(0)
  #define VRD(i) do{ vlo[i]=vtr(vp_+(((i)>>2)*4096+((i)&3)*1024)); vhi[i]=vtr(vp_+(((i)>>2)*4096+((i)&3)*1024+512)); }while(0)
  #define KRD(G,j) do{ if(G){ kload2(kf,kp0+sl_next,j); SBAR(); } }while(0)
  #define STEP(C0,C1,P0,P1,t,GK,GV,GL) do{ SBAR(); \
    const lds_cptr vp_=vp0+sl_prev; \
    VRD(0); SBAR(); float sacc=(P0[0]+P0[1]); \
    GAPA(C0=__builtin_amdgcn_mfma_f32_32x32x16_bf16(kf[0],qr[0],negm,0,0,0), P0[2],P0[3],P0[4],P0[5],     pw0[0]=PKW(P0,0), pw0[1]=PKW(P0,2), pw0); \
    VRD(4); SBAR(); GAPA(C1=__builtin_amdgcn_mfma_f32_32x32x16_bf16(kf[1],qr[0],negm,0,0,0), P0[6],P0[7],P0[8],P0[9],     pw0[2]=PKW(P0,4), pw0[3]=PKW(P0,6), pw0); \
    VRD(1); SBAR(); GAPA(C0=__builtin_amdgcn_mfma_f32_32x32x16_bf16(kf[2],qr[1],C0,0,0,0),   P0[10],P0[11],P0[12],P0[13], pw1[0]=PKW(P0,8), pw1[1]=PKW(P0,10), pw1); \
    VRD(5); SBAR(); GAPA(C1=__builtin_amdgcn_mfma_f32_32x32x16_bf16(kf[3],qr[1],C1,0,0,0),   P0[14],P0[15],P1[0],P1[1],   pw1[2]=PKW(P0,12),pw1[3]=PKW(P0,14), pw1); \
    VRD(2); SBAR(); GAPA(C0=__builtin_amdgcn_mfma_f32_32x32x16_bf16(kf[4],qr[2],C0,0,0,0),   P1[2],P1[3],P1[4],P1[5],     pw2[0]=PKW(P1,0), pw2[1]=PKW(P1,2), pw2); \
    VRD(6); SBAR(); GAPA(C1=__builtin_amdgcn_mfma_f32_32x32x16_bf16(kf[5],qr[2],C1,0,0,0),   P1[6],P1[7],P1[8],P1[9],     pw2[2]=PKW(P1,4), pw2[3]=PKW(P1,6), pw2); \
    VRD(3); SBAR(); GAPA(C0=__builtin_amdgcn_mfma_f32_32x32x16_bf16(kf[6],qr[3],C0,0,0,0),   P1[10],P1[11],P1[12],P1[13], pw3[0]=PKW(P1,8), pw3[1]=PKW(P1,10), pw3); \
    VRD(7); SBAR(); GAPA(C1=__builtin_amdgcn_mfma_f32_32x32x16_bf16(kf[7],qr[3],C1,0,0,0),   P1[14],P1[15],0.f,0.f,       pw3[2]=PKW(P1,12),pw3[3]=PKW(P1,14), pw3); \
    l_reg+=sacc; \
    if(GK){DMA_K((t)+3,sl_cur);} if(GV){DMA_V((t)+1,sl_next);} \
    CMASK(C0,C1,t); \
    if constexpr (THRL>=0) { float a=MX3(C0[0],C0[1],C1[0]),b=MX3(C0[2],C0[3],C1[1]); a=MX3(a,C1[2],C1[3]); \
      _Pragma("unroll") for(int r=4;r<16;r+=4){a=MX3(a,C0[r],C0[r+1]);b=MX3(b,C0[r+2],C0[r+3]);a=MX3(a,C1[r],C1[r+1]);b=MX3(b,C1[r+2],C1[r+3]);} \
      float rm=__builtin_fmaxf(a,b); { auto rr=__builtin_amdgcn_permlane32_swap(__float_as_uint(rm),__float_as_uint(rm),false,false); rm=__builtin_fmaxf(__uint_as_float(rr[0]),__uint_as_float(rr[1])); } \
      resc=false; \
      if(__builtin_expect(__any(rm>(float)THRL),0)){ const float dl=__builtin_fmaxf(rm,0.f); mhat+=dl; \
        _Pragma("unroll") for(int r=0;r<16;++r){C0[r]-=dl;C1[r]-=dl;} \
        _Pragma("unroll") for(int r=0;r<16;++r)negm[r]=-mhat; asm volatile("":"+v"(negm)); \
        const float f=__builtin_amdgcn_exp2f(-dl); l_reg*=f; if(hi==0)wsf[r32]=f; resc=true; } } \
    SBAR(); \
    GAPB(o[0]=__builtin_amdgcn_mfma_f32_32x32x16_bf16(PAF(0),VFR(0),o[0],0,0,0), C0,0); \
    GAPB(o[1]=__builtin_amdgcn_mfma_f32_32x32x16_bf16(PAF(0),VFR(4),o[1],0,0,0), C0,4); \
    KRD(GL,0); GAPB(o[0]=__builtin_amdgcn_mfma_f32_32x32x16_bf16(PAF(1),VFR(1),o[0],0,0,0), C0,8); \
    KRD(GL,1); GAPB(o[1]=__builtin_amdgcn_mfma_f32_32x32x16_bf16(PAF(1),VFR(5),o[1],0,0,0), C0,12); \
    KRD(GL,2); GAPB(o[0]=__builtin_amdgcn_mfma_f32_32x32x16_bf16(PAF(2),VFR(2),o[0],0,0,0), C1,0); \
    KRD(GL,3); GAPB(o[1]=__builtin_amdgcn_mfma_f32_32x32x16_bf16(PAF(2),VFR(6),o[1],0,0,0), C1,4); \
    GAPB(o[0]=__builtin_amdgcn_mfma_f32_32x32x16_bf16(PAF(3),VFR(3),o[0],0,0,0), C1,8); \
    GAPB(o[1]=__builtin_amdgcn_mfma_f32_32x32x16_bf16(PAF(3),VFR(7),o[1],0,0,0), C1,12); \
    }while(0)
  int t=1;
  #undef CMASK
  #define CMASK(P0,P1,t) do{}while(0)
  for(;t+5<NT;t+=2){
    STEP(pB0,pB1,pA0,pA1,t,true,true,true);     WAIT_BAR(2); RESC(); ROT();
    STEP(pA0,pA1,pB0,pB1,t+1,true,true,true);   WAIT_BAR(2); RESC(); ROT();
  }
  #undef CMASK
  #define CMASK(P0,P1,t) do{}while(0)
  #define ENDW(tt) do{ if((tt)+3<NT){WAIT_BAR(2);} else if((tt)+2<NT){WAIT_BAR(1);} else {WAIT_BAR(0);} }while(0)
  for(;t+1<NT;t+=2){
    STEP(pB0,pB1,pA0,pA1,t,(t+3<NT),(t+1<NT),(t+1<NT));       ENDW(t);   RESC(); ROT();
    STEP(pA0,pA1,pB0,pB1,t+1,(t+4<NT),(t+2<NT),(t+2<NT));     ENDW(t+1); RESC(); ROT();
  }
  STEP(pB0,pB1,pA0,pA1,NT-1,false,false,false); RESC();
  { float sacc=pB0[0]+pB0[1]; _Pragma("unroll") for(int r=2;r<16;++r)sacc+=pB0[r]; _Pragma("unroll") for(int r=0;r<16;++r)sacc+=pB1[r]; l_reg+=sacc;
    pw0=(u32x4){PKW(pB0,0),PKW(pB0,2),PKW(pB0,4),PKW(pB0,6)};pw1=(u32x4){PKW(pB0,8),PKW(pB0,10),PKW(pB0,12),PKW(pB0,14)};pw2=(u32x4){PKW(pB1,0),PKW(pB1,2),PKW(pB1,4),PKW(pB1,6)};pw3=(u32x4){PKW(pB1,8),PKW(pB1,10),PKW(pB1,12),PKW(pB1,14)};
    SBAR(); pv(o,vb0+sl_cur,PAF(0),PAF(1),PAF(2),PAF(3)); }
  #undef PKW
  #undef PAF
  #undef VFR
  #undef PIN
  #undef MX3
  #undef GAPA
  #undef GAPB
  #undef EX
  #undef VRD
  #undef KRD
  #undef STEP
  #undef ENDW
  {auto rr=__builtin_amdgcn_permlane32_swap(__float_as_uint(l_reg),__float_as_uint(l_reg),false,false);l_reg=__uint_as_float(rr[0])+__uint_as_float(rr[1]);}
  if(hi==0)wsf[32+r32]=l_reg;asm volatile("s_waitcnt lgkmcnt(0)":::"memory");
  float rli[16];
  #pragma unroll
  for(int r=0;r<16;++r)rli[r]=__builtin_amdgcn_rcpf(wsf[32+crow(r,hi)]);
  bf16*Ow=Ou+(long)(wid*QBLK)*OP;
  { bf16*stg=(bf16*)(shm+LDS_OST)+wid*2048;
    #pragma unroll
    for(int r=0;r<16;++r){const int orow=crow(r,hi);
      #pragma unroll
      for(int d0=0;d0<2;++d0)stg[orow*64+d0*32+r32]=__float2bfloat16(o[d0][r]*rli[r]);}
    asm volatile("s_waitcnt lgkmcnt(0)":::"memory");
    #pragma unroll
    for(int i=0;i<4;++i){const int row=i*8+(lane>>3),ch=lane&7; const u32x4 v=*(const u32x4*)(stg+row*64+ch*8); ATTN_STORE16(Ow+(long)row*OP+ch*8,v);} }
  asm volatile("s_waitcnt lgkmcnt(0)\n\ts_barrier":::"memory");
  #undef DMA_K
  #undef DMA_V
  #undef CMASK
  #undef START
  #undef RESC
  #undef ROT
}
constexpr int ATTN_LDS_BYTES=LDS_BYTES;
#undef SBAR
#undef WAIT_BAR
}
#define LDS_WAIT() asm volatile("s_waitcnt lgkmcnt(0)" ::: "memory")

__device__ __forceinline__ void transpose_item(const float* W, int K, int N, bf16* WT, int k0, int n0, int dest_row0, LAS float* scr, int lane) {
    float t_[32];
#pragma unroll
    for (int i = 0; i < 32; ++i) t_[i] = W[(size_t)(k0 + 2 * i + (lane >> 5)) * N + n0 + (lane & 31)];
#pragma unroll
    for (int i = 0; i < 32; ++i) scr[(2 * i + (lane >> 5)) * 33 + (lane & 31)] = t_[i];
    LDS_WAIT(); asm volatile("" ::: "memory");
    const int c = lane & 7;
#pragma unroll
    for (int j = 0; j < 4; ++j) { const int n = (lane >> 3) + 8 * j; const LAS float* s = scr + (8 * c) * 33 + n;
        v4u o; o.x = pk2(s[0 * 33], s[1 * 33]); o.y = pk2(s[2 * 33], s[3 * 33]); o.z = pk2(s[4 * 33], s[5 * 33]); o.w = pk2(s[6 * 33], s[7 * 33]);
        *(GAS v4u*)(WT + (size_t)(dest_row0 + n) * K + k0 + 8 * c) = o; }
    LDS_WAIT(); asm volatile("" ::: "memory");
}

template <int KMODE>
__device__ __forceinline__ void transpose_item8(const float* W, int K, int N, unsigned char* WT, int k0, int n0, int dest_row0, float sc, LAS float* scr, int lane) {
    float t_[32];
#pragma unroll
    for (int i = 0; i < 32; ++i) t_[i] = W[(size_t)(k0 + 2 * i + (lane >> 5)) * N + n0 + (lane & 31)];
#pragma unroll
    for (int i = 0; i < 32; ++i) scr[(2 * i + (lane >> 5)) * 33 + (lane & 31)] = __builtin_amdgcn_fmed3f(t_[i] * sc, -448.f, 448.f);
    LDS_WAIT(); asm volatile("" ::: "memory");
    const int c = lane & 7, w = c >> 2, fq = c & 3, wh = (k0 >> 6) & 1;
    const int doff = KMODE == 1 ? (k0 & ~255) + 64 * (2 * wh + w) + 16 * fq + 8 * ((k0 >> 7) & 1) : KMODE == 2 ? (k0 & ~127) + 32 * (2 * wh + w) + 8 * fq : k0 + 8 * c;
#pragma unroll
    for (int j = 0; j < 4; ++j) { const int n = (lane >> 3) + 8 * j; const LAS float* s = scr + n;
        float v[8];
#pragma unroll
        for (int e = 0; e < 8; ++e) { const int kk = KMODE == 2 ? 32 * w + 16 * (e >> 2) + 4 * fq + (e & 3) : 8 * c + e; v[e] = s[kk * 33]; }
        unsigned w0 = 0, w1 = 0;
        w0 = __builtin_amdgcn_cvt_pk_fp8_f32(v[0], v[1], w0, false); w0 = __builtin_amdgcn_cvt_pk_fp8_f32(v[2], v[3], w0, true);
        w1 = __builtin_amdgcn_cvt_pk_fp8_f32(v[4], v[5], w1, false); w1 = __builtin_amdgcn_cvt_pk_fp8_f32(v[6], v[7], w1, true);
        *(GAS v2u*)(WT + (size_t)(dest_row0 + n) * K + doff) = (v2u){w0, w1}; }
    LDS_WAIT(); asm volatile("" ::: "memory");
}

struct ProIn { const float *hy_w_in, *at_w_in, *w_out, *w_mem_kv; };
__device__ __forceinline__ void phase_weights(const ProIn& P, unsigned char* ws, LAS unsigned char* lds, int gw, int NGW, int wave, int lane) {
    LAS float* scr = (LAS float*)(lds + wave * 16384);
    constexpr int I_HY = 16 * 80, I_AT = 16 * 48, I_OUT = 16 * 32, I_MKV = 16 * 16;
    constexpr int E0 = 2 * I_HY, E1 = E0 + 2 * I_AT, E2 = E1 + 4 * I_OUT, E3 = E2 + 4 * I_MKV;
    for (int it = gw; it < E3; it += NGW) {
        int r = it;
        if (r < E0) { const int j = r / I_HY, q = r % I_HY, kb = q / 80, nb = q % 80;
            transpose_item(P.hy_w_in + (size_t)j * DM * D_IN_HY, DM, D_IN_HY, (bf16*)(ws + WS_WHY) + (size_t)j * D_IN_HY * DM, 64 * kb, 32 * nb, 32 * nb, scr, lane); continue; }
        r -= E0;
        if (r < 2 * I_AT) { const int j = r / I_AT, q = r % I_AT, kb = q / 48, nb = q % 48;
            const int n0 = 32 * nb, o = n0 & 255;
            transpose_item(P.at_w_in + (size_t)j * DM * D_IN_AT, DM, D_IN_AT, (bf16*)(ws + WS_WAT) + (size_t)j * D_IN_AT * DM, 64 * kb, n0, (n0 & ~255) + 128 * ((o & 63) >> 5) + 32 * (o >> 6), scr, lane); continue; }
        r -= 2 * I_AT;
        if (r < 4 * I_OUT) { const int j = r / I_OUT, q = r % I_OUT, kb = q / 32, nb = q % 32;
            transpose_item(P.w_out + (size_t)j * DM * DM, DM, DM, (bf16*)(ws + WS_WOUT) + (size_t)j * DM * DM, 64 * kb, 32 * nb, 32 * nb, scr, lane); continue; }
        r -= 4 * I_OUT;
        { const int j = r / I_MKV, q = r % I_MKV, kb = q / 16, nb = q % 16;
            transpose_item(P.w_mem_kv + (size_t)j * DM * 512, DM, 512, (bf16*)(ws + WS_WMKV), 64 * kb, 32 * nb, j * 512 + 32 * nb, scr, lane); }
        (void)r;
    }
}

struct XwIn { const float *w_gate, *w_up, *w_down; unsigned char* ws; };
constexpr int XW_PER_EXPERT = 3 * 384, XW_PER_LAYER = NEXP * XW_PER_EXPERT;
constexpr int XW_QA_HY = 5, XW_QA_AT = 4, XW_QB = 3, XW_NA = 128 * NWAVES, XW_NB = 224 * NWAVES;
__host__ __device__ constexpr int xw_qa(int layer) { return (layer & 1) ? XW_QA_AT : XW_QA_HY; }
__host__ __device__ constexpr int xw_p0(int layer, bool sched) { return sched ? XW_PER_LAYER - xw_qa(layer) * XW_NA - XW_QB * XW_NB : XW_PER_LAYER; }
__device__ __forceinline__ void xw_item(const XwIn& B, int layer, int r, LAS float* scr, int lane) {
    const int j = layer * NEXP + r / XW_PER_EXPERT, q = r % XW_PER_EXPERT, kind = q / 384, qq = q % 384;
    if (kind < 2) { const int kb = qq / 24, nb = qq % 24, n0 = 32 * nb;
        transpose_item8<1>((kind == 0 ? B.w_gate : B.w_up) + (size_t)j * DM * EFF, DM, EFF, B.ws + WS_W1 + (size_t)j * 1536 * DM, 64 * kb, n0, (n0 >> 7) * 256 + 128 * kind + (n0 & 127), W8_SCALE, scr, lane); }
    else { const int kb = qq / 32, nb = qq % 32;
        transpose_item8<2>(B.w_down + (size_t)j * EFF * DM, EFF, DM, B.ws + WS_W2 + (size_t)j * DM * EFF, 64 * kb, 32 * nb, 32 * nb, W8_SCALE, scr, lane); }
}
__device__ __forceinline__ void phase_xw_p0(const XwIn& B, bool sched, LAS float* scr, int gw, int NGW, int lane) {
#pragma unroll 1
    for (int layer = 0; layer < DEPTH; ++layer) { const int n = xw_p0(layer, sched);
#pragma unroll 1
        for (int r = gw; r < n; r += NGW) xw_item(B, layer, r, scr, lane); }
}
__device__ __forceinline__ void xw_slice_a(const XwIn& B, int layer, LAS float* scr, int bx, int wave, int lane) {
    const int base = xw_p0(layer, true) + (bx - 128) * NWAVES + wave;
#pragma unroll 1
    for (int k = 0; k < xw_qa(layer); ++k) xw_item(B, layer, base + k * XW_NA, scr, lane);
}
__device__ __forceinline__ void xw_slice_b(const XwIn& B, int layer, LAS float* scr, int bx, int wave, int lane) {
    const int base = xw_p0(layer, true) + xw_qa(layer) * XW_NA + (bx - 32) * NWAVES + wave;
#pragma unroll 1
    for (int k = 0; k < XW_QB; ++k) xw_item(B, layer, base + k * XW_NB, scr, lane);
}

__device__ __forceinline__ void phase_wrg(const float* ffn_g, const float* router, float* WRG, int gtid, int nthreads) {
    for (int q = gtid; q < DEPTH * NEXP * DM; q += nthreads) { const int l = q / (NEXP * DM), e = (q / DM) % NEXP, d = q % DM; WRG[q] = ffn_g[l * DM + d] * router[((size_t)l * DM + d) * NEXP + e]; }
}

__device__ __forceinline__ void rms_row_bf16(const float* xrow, const float* g, bf16* orow, int lane) {
    const GAS f32x4* xr = (const GAS f32x4*)xrow + lane; const GAS f32x4* gr = (const GAS f32x4*)g + lane;
    f32x4 v[4]; float s = 0.f;
#pragma unroll
    for (int j = 0; j < 4; ++j) { v[j] = xr[64 * j]; s += (v[j].x * v[j].x + v[j].y * v[j].y) + (v[j].z * v[j].z + v[j].w * v[j].w); }
    const float rstd = 1.f / sqrtf(wave_sum(s) * (1.f / DM) + NORM_EPS);
    GAS v2u* o8 = (GAS v2u*)orow + lane;
#pragma unroll
    for (int j = 0; j < 4; ++j) { const f32x4 gg = gr[64 * j]; v2u w; w.x = pk2(v[j].x * rstd * gg.x, v[j].y * rstd * gg.y); w.y = pk2(v[j].z * rstd * gg.z, v[j].w * rstd * gg.w); o8[64 * j] = w; }
}

__device__ __forceinline__ void phase_mem_h2(const float* mem, const float* mem_g, const float* fw1, const float* fb1, const float* fw2, const float* fb2, const float* ffreq,
                                              unsigned char* ws, int gw, int NGW, int lane) {
    for (int m = gw; m < BATCH * MEM_LEN; m += NGW) rms_row_bf16(mem + (size_t)m * DM, mem_g, (bf16*)(ws + WS_MEMN) + (size_t)m * DM, lane);
    float* H2 = (float*)(ws + WS_H2);
    for (int it = gw; it < 2 * SEQ; it += NGW) {
        const int j = it / SEQ, n = it % SEQ;
        const float* w1 = fw1 + j * HY_EMB * HY_FILT; const float* w2 = fw2 + j * HY_FILT * HY_FILT;
        const float t = (float)n * (1.0f / (float)(SEQ - 1));
        const float w = (6.283185307179586f * (float)n) / (float)SEQ;
        float feat = 0.f;
        if (lane == 0) feat = t;
        else if (lane <= 16) { const float band = 1e-4f + (float)(lane - 1) * ((15.0f - 1e-4f) / 15.0f); feat = cosf(band * w); }
        else if (lane <= 32) { const float band = 1e-4f + (float)(lane - 17) * ((15.0f - 1e-4f) / 15.0f); feat = -sinf(band * w); }
        const float fr = ffreq[j * HY_FILT + lane];
        float a = fb1[j * HY_FILT + lane];
        for (int i = 0; i < HY_EMB; ++i) a += __shfl(feat, i) * w1[i * HY_FILT + lane];
        const float h1 = sinf(fr * a);
        float a2 = fb2[j * HY_FILT + lane];
        for (int i = 0; i < HY_FILT; ++i) a2 += __shfl(h1, i) * w2[i * HY_FILT + lane];
        H2[(size_t)it * HY_FILT + lane] = sinf(fr * a2);
    }
}

template <bool COMBINE, bool FINAL>
__device__ __forceinline__ void phase_norm(const float* hin, float* hout, const float* g, bf16* U, float* fout, const int* POS, const bf16* Y, int gw, int NGW, int lane) {
    int m = gw;
    if (m >= M_TOK) return;
    f32x4 cur[4]; int cpos = -1;
    { const GAS f32x4* xr = (const GAS f32x4*)(hin + (size_t)m * DM) + lane;
#pragma unroll
      for (int j = 0; j < 4; ++j) cur[j] = xr[64 * j];
      if (COMBINE) { const int b = m / SEQ, t = m % SEQ; if (lane < NEXP) cpos = POS[(size_t)(b * NEXP + lane) * SEQ + t]; } }
#pragma unroll 1
    for (; m < M_TOK; m += NGW) {
        const int mn = m + NGW; f32x4 nxt[4]; int npos = -1;
#pragma unroll
        for (int j = 0; j < 4; ++j) nxt[j] = cur[j];
        if (mn < M_TOK) { const GAS f32x4* xr = (const GAS f32x4*)(hin + (size_t)mn * DM) + lane;
#pragma unroll
            for (int j = 0; j < 4; ++j) nxt[j] = xr[64 * j];
            if (COMBINE) { const int b = mn / SEQ, t = mn % SEQ; if (lane < NEXP) npos = POS[(size_t)(b * NEXP + lane) * SEQ + t]; } }
        f32x4 v[4];
#pragma unroll
        for (int j = 0; j < 4; ++j) v[j] = cur[j];
        if (COMBINE) {
            const int b = m / SEQ;
            unsigned long long mask = __ballot(cpos >= 0);
            while (mask) {
                v2u y[4][4]; bool has[4];
#pragma unroll
                for (int k = 0; k < 4; ++k) { has[k] = mask != 0ull;
                    if (has[k]) { const int e = __builtin_amdgcn_readfirstlane(__builtin_ctzll(mask)); mask &= mask - 1ull; const int p = __builtin_amdgcn_readlane(cpos, e);
                        const GAS v2u* yr = (const GAS v2u*)(Y + ((size_t)(b * NEXP + e) * CAP + p) * DM) + lane;
#pragma unroll
                        for (int j = 0; j < 4; ++j) y[k][j] = yr[64 * j]; } }
#pragma unroll
                for (int k = 0; k < 4; ++k) if (has[k]) {
#pragma unroll
                    for (int j = 0; j < 4; ++j) { const v2u w = y[k][j]; v[j].x += bflo(w.x); v[j].y += bfhi(w.x); v[j].z += bflo(w.y); v[j].w += bfhi(w.y); } }
            }
            if (!FINAL) { GAS f32x4* ho = (GAS f32x4*)(hout + (size_t)m * DM) + lane;
#pragma unroll
                for (int j = 0; j < 4; ++j) ho[64 * j] = v[j]; }
        }
        float s = 0.f;
#pragma unroll
        for (int j = 0; j < 4; ++j) s += (v[j].x * v[j].x + v[j].y * v[j].y) + (v[j].z * v[j].z + v[j].w * v[j].w);
        const float rstd = 1.f / sqrtf(wave_sum(s) * (1.f / DM) + NORM_EPS);
        const GAS f32x4* gr = (const GAS f32x4*)g + lane;
        if (FINAL) { GAS f32x4* o = (GAS f32x4*)(fout + (size_t)m * DM) + lane;
#pragma unroll
            for (int j = 0; j < 4; ++j) o[64 * j] = v[j] * rstd * gr[64 * j]; }
        else { GAS v2u* o8 = (GAS v2u*)(U + (size_t)m * DM) + lane;
#pragma unroll
            for (int j = 0; j < 4; ++j) { const f32x4 gg = gr[64 * j]; v2u w; w.x = pk2(v[j].x * rstd * gg.x, v[j].y * rstd * gg.y); w.y = pk2(v[j].z * rstd * gg.z, v[j].w * rstd * gg.w); o8[64 * j] = w; } }
#pragma unroll
        for (int j = 0; j < 4; ++j) cur[j] = nxt[j];
        cpos = npos;
    }
}

__device__ __forceinline__ void phase_ffn_norm_router(const float* H, const float* g, const float* Wr, unsigned char* XN8, float* AFF, LAS unsigned char* lds, int gw, int NGW, int lane, int tid) {
    LAS f32x4* WL = (LAS f32x4*)lds;
    for (int q = tid; q < 64 * 64; q += NTHREADS) { const int ln = q & 63, s = q >> 6, e4 = s & 3, ji = s >> 2, i = ji & 3, j = ji >> 2; const int d = 4 * ln + i + 256 * j;
        WL[q] = *(const GAS f32x4*)(Wr + (size_t)d * NEXP + 4 * e4); }
    __syncthreads();
    constexpr int R = 4;
    const GAS f32x4* gr = (const GAS f32x4*)g + lane;
#pragma unroll 1
    for (int m0 = gw * R; m0 < M_TOK; m0 += NGW * R) {
        int lo_ = lane; asm volatile("" : "+v"(lo_));
        f32x4 v[R][4]; float rstd[R];
#pragma unroll
        for (int r = 0; r < R; ++r) { const GAS f32x4* xr = (const GAS f32x4*)(H + (size_t)(m0 + r) * DM) + lane;
#pragma unroll
            for (int j = 0; j < 4; ++j) v[r][j] = xr[64 * j]; }
#pragma unroll
        for (int r = 0; r < R; ++r) { float s = 0.f;
#pragma unroll
            for (int j = 0; j < 4; ++j) s += (v[r][j].x * v[r][j].x + v[r][j].y * v[r][j].y) + (v[r][j].z * v[r][j].z + v[r][j].w * v[r][j].w);
            rstd[r] = 1.f / sqrtf(wave_sum(s) * (1.f / DM) + NORM_EPS); }
        f32x4 lg[R][4];
#pragma unroll
        for (int r = 0; r < R; ++r)
#pragma unroll
            for (int e4 = 0; e4 < 4; ++e4) lg[r][e4] = (f32x4){0.f, 0.f, 0.f, 0.f};
#pragma unroll
        for (int j = 0; j < 4; ++j) { const f32x4 gg = gr[64 * j];
#pragma unroll
            for (int r = 0; r < R; ++r) { v[r][j] = v[r][j] * rstd[r] * gg;
                unsigned w = 0; w = __builtin_amdgcn_cvt_pk_fp8_f32(v[r][j].x, v[r][j].y, w, false); w = __builtin_amdgcn_cvt_pk_fp8_f32(v[r][j].z, v[r][j].w, w, true);
                ((GAS unsigned*)(XN8 + (size_t)(m0 + r) * DM) + lane)[64 * j] = w; }
#pragma unroll
            for (int i = 0; i < 4; ++i)
#pragma unroll
                for (int e4 = 0; e4 < 4; ++e4) { const f32x4 wv = WL[((j * 4 + i) * 4 + e4) * 64 + lo_];
#pragma unroll
                    for (int r = 0; r < R; ++r) { const float xs = v[r][j][i];
#pragma unroll
                        for (int c = 0; c < 4; ++c) asm("v_fmac_f32 %0, %1, %2" : "+v"(lg[r][e4][c]) : "v"(wv[c]), "v"(xs)); } }
            __builtin_amdgcn_sched_barrier(0); }
#pragma unroll
        for (int r = 0; r < R; ++r) {
            float l16[16];
#pragma unroll
            for (int e = 0; e < 16; ++e) l16[e] = wave_sum(lg[r][e >> 2][e & 3]);
            float mx = l16[0];
#pragma unroll
            for (int e = 1; e < 16; ++e) mx = fmaxf(mx, l16[e]);
            float den = 0.f;
#pragma unroll
            for (int e = 0; e < 16; ++e) { l16[e] = expf(l16[e] - mx); den += l16[e]; }
            float mine = 0.f;
#pragma unroll
            for (int e = 0; e < 16; ++e) mine = (lane == e) ? l16[e] : mine;
            const int m = m0 + r, b = m / SEQ, t = m % SEQ;
            if (lane < NEXP) AFF[(size_t)(b * NEXP + lane) * SEQ + t] = mine / den;
        }
    }
    __syncthreads();
}

__device__ __forceinline__ void phase_router_sum(const float* PLG, const float* PSS, float* RSTD, float* AFF, int gw, int NGW, int lane) {
    const int e = lane & 15, rq = lane >> 4;
    for (int m0 = gw * 4; m0 < M_TOK; m0 += NGW * 4) {
        const int m = m0 + rq;
        float lgt = 0.f;
#pragma unroll
        for (int slot = 0; slot < 16; ++slot) lgt += PLG[((size_t)slot * M_TOK + m) * 16 + e];
        float ss = PSS[(size_t)e * M_TOK + m];
#pragma unroll
        for (int o = 1; o < 16; o <<= 1) ss += __shfl_xor(ss, o);
        const float rstd = 1.f / sqrtf(ss * (1.f / DM) + NORM_EPS);
        lgt *= rstd;
        float mx = lgt;
#pragma unroll
        for (int o = 1; o < 16; o <<= 1) mx = fmaxf(mx, __shfl_xor(mx, o));
        const float ex = expf(lgt - mx); float den = ex;
#pragma unroll
        for (int o = 1; o < 16; o <<= 1) den += __shfl_xor(den, o);
        const int b = m / SEQ, t = m % SEQ;
        AFF[(size_t)(b * NEXP + e) * SEQ + t] = ex / den;
        if (e == 0) RSTD[m] = rstd;
    }
}

__device__ __forceinline__ int block_excl_scan(int v, LAS int* scr, int tid, int lane, int wave, int* tot) {
    int inc = v;
#pragma unroll
    for (int o = 1; o < 64; o <<= 1) { const int n = __shfl_up(inc, o); if (lane >= o) inc += n; }
    __syncthreads();
    if (lane == 63) scr[wave] = inc;
    __syncthreads();
    int base = 0, total = 0;
#pragma unroll
    for (int w = 0; w < NWAVES; ++w) { const int c = scr[w]; if (w < wave) base += c; total += c; }
    *tot = total;
    return base + inc - v;
}

__device__ __forceinline__ void phase_topk(const float* AFF, const float* RSTD, float* RS, int* IDX, float* GATE, int* POS, LAS unsigned char* ldsm, int blk, int nblk, int tid, int lane, int wave) {
    LAS int* hist = (LAS int*)ldsm;
    LAS int* sel = (LAS int*)(ldsm + 1024);
    LAS int* scr = (LAS int*)(ldsm + 1280);
    for (int g = blk; g < NGRP; g += nblk) {
        unsigned v[16];
        { const GAS v4u* src = (const GAS v4u*)(AFF + (size_t)g * SEQ) + tid * 4;
#pragma unroll
          for (int q = 0; q < 4; ++q) { const v4u w = src[q]; v[4 * q] = w.x; v[4 * q + 1] = w.y; v[4 * q + 2] = w.z; v[4 * q + 3] = w.w; } }
        unsigned prefix = 0u; int krem = CAP;
#pragma unroll 1
        for (int pass = 0; pass < 4; ++pass) {
            const int shift = 24 - 8 * pass;
            const unsigned himask = (pass == 0) ? 0u : (0xffffffffu << (shift + 8));
            __syncthreads();
            if (tid < 256) hist[tid] = 0;
            __syncthreads();
#pragma unroll
            for (int i = 0; i < 16; ++i) if ((v[i] & himask) == prefix) __hip_atomic_fetch_add(hist + ((v[i] >> shift) & 255u), 1, __ATOMIC_RELAXED, __HIP_MEMORY_SCOPE_WORKGROUP);
            __syncthreads();
            if (wave == 0) {
                int c[4]; int s = 0;
#pragma unroll
                for (int j = 0; j < 4; ++j) { c[j] = hist[255 - 4 * lane - j]; s += c[j]; }
                int inc = s;
#pragma unroll
                for (int o = 1; o < 64; o <<= 1) { const int n = __shfl_up(inc, o); if (lane >= o) inc += n; }
                int before = inc - s;
                if (before < krem && krem <= inc) {
                    int bin = 0, kk = krem - before; bool done = false;
#pragma unroll
                    for (int j = 0; j < 4; ++j) { if (!done) { if (kk <= c[j]) { bin = 255 - 4 * lane - j; done = true; } else kk -= c[j]; } }
                    sel[0] = bin; sel[1] = kk;
                }
            }
            __syncthreads();
            prefix |= ((unsigned)sel[0]) << shift; krem = sel[1];
        }
        int ceq = 0;
#pragma unroll
        for (int i = 0; i < 16; ++i) ceq += (v[i] == prefix) ? 1 : 0;
        int tot;
        int eqrank = block_excl_scan(ceq, scr, tid, lane, wave, &tot);
        int csel = 0; unsigned selmask = 0u;
#pragma unroll
        for (int i = 0; i < 16; ++i) { bool s = v[i] > prefix; if (v[i] == prefix) { s = eqrank < krem; ++eqrank; } if (s) { selmask |= 1u << i; ++csel; } }
        int slot = block_excl_scan(csel, scr, tid, lane, wave, &tot);
        const int b = g / NEXP;
        int pv[16];
#pragma unroll
        for (int i = 0; i < 16; ++i) {
            pv[i] = -1;
            if (selmask & (1u << i)) { pv[i] = slot; IDX[g * CAP + slot] = b * SEQ + tid * 16 + i; GATE[g * CAP + slot] = __builtin_bit_cast(float, v[i]); RS[g * CAP + slot] = RSTD[b * SEQ + tid * 16 + i]; ++slot; }
        }
        { GAS v4u* dst = (GAS v4u*)(POS + (size_t)g * SEQ) + tid * 4;
#pragma unroll
          for (int q = 0; q < 4; ++q) { v4u w; w.x = (unsigned)pv[4 * q]; w.y = (unsigned)pv[4 * q + 1]; w.z = (unsigned)pv[4 * q + 2]; w.w = (unsigned)pv[4 * q + 3]; dst[q] = w; } }
        __syncthreads();
    }
}

__device__ __forceinline__ void phase_gather(const bf16* XN, const int* IDX, bf16* XG, int gw, int NGW, int lane) {
    for (int r = gw; r < XROWS; r += NGW) {
        const int src = __builtin_amdgcn_readfirstlane(IDX[r]);
        const GAS v4u* s = (const GAS v4u*)(XN + (size_t)src * DM) + lane; GAS v4u* d = (GAS v4u*)(XG + (size_t)r * DM) + lane;
        const v4u a = s[0], b = s[64]; d[0] = a; d[64] = b;
    }
}

__device__ __forceinline__ void phase_qk_rope(bf16* P, const float* gq, const float* gk, int gw, int NGW, int lane) {
    const int hh = lane >> 2, part = lane & 3, axis = part >> 1, half = part & 1;
    const float* g = (hh < NQH ? gq : gk) + 16 * part;
    float gv[16], inv[16];
#pragma unroll
    for (int i = 0; i < 16; ++i) { gv[i] = g[i]; inv[i] = exp2f(-(float)i * (13.287712379549449f / 16.0f)); }
    const float osc = hh < NQH ? ATT_C2 : 1.0f;
    int m = gw; v4u c0 = (v4u){0u, 0u, 0u, 0u}, c1 = c0;
    if (m < M_TOK) { const GAS v4u* p = (const GAS v4u*)(P + (size_t)m * D_IN_AT + hh * HD + 16 * part); c0 = p[0]; c1 = p[1]; }
#pragma unroll 1
    for (; m < M_TOK; m += NGW) {
        const int t = m % SEQ; const float pos = (float)(axis == 0 ? (t >> 6) : (t & 63));
        GAS v4u* p = (GAS v4u*)(P + (size_t)m * D_IN_AT + hh * HD + 16 * part);
        const v4u w0 = c0, w1 = c1;
        if (m + NGW < M_TOK) { const GAS v4u* pn = (const GAS v4u*)(P + (size_t)(m + NGW) * D_IN_AT + hh * HD + 16 * part); c0 = pn[0]; c1 = pn[1]; }
        float x[16];
        x[0] = bflo(w0.x); x[1] = bfhi(w0.x); x[2] = bflo(w0.y); x[3] = bfhi(w0.y); x[4] = bflo(w0.z); x[5] = bfhi(w0.z); x[6] = bflo(w0.w); x[7] = bfhi(w0.w);
        x[8] = bflo(w1.x); x[9] = bfhi(w1.x); x[10] = bflo(w1.y); x[11] = bfhi(w1.y); x[12] = bflo(w1.z); x[13] = bfhi(w1.z); x[14] = bflo(w1.w); x[15] = bfhi(w1.w);
        float ss = 0.f;
#pragma unroll
        for (int i = 0; i < 16; ++i) ss += x[i] * x[i];
        ss += __shfl_xor(ss, 1); ss += __shfl_xor(ss, 2);
        const float rstd = 1.f / sqrtf(ss * (1.f / HD) + NORM_EPS);
        float o[16];
#pragma unroll
        for (int i = 0; i < 16; ++i) {
            const float xn = x[i] * rstd * gv[i]; const float xp = __shfl_xor(xn, 1);
            float sn, cs; sincosf(pos * inv[i], &sn, &cs);
            o[i] = (half == 0 ? (xn * cs - xp * sn) : (xp * sn + xn * cs)) * osc;
        }
        v4u r0, r1;
        r0.x = pk2(o[0], o[1]); r0.y = pk2(o[2], o[3]); r0.z = pk2(o[4], o[5]); r0.w = pk2(o[6], o[7]);
        r1.x = pk2(o[8], o[9]); r1.y = pk2(o[10], o[11]); r1.z = pk2(o[12], o[13]); r1.w = pk2(o[14], o[15]);
        p[0] = r0; p[1] = r1;
    }
}

__device__ __forceinline__ void phase_transpose_mix(const bf16* MIXT, bf16* MIX, LAS unsigned char* lds, int blk, int nblk, int tid) {
    constexpr int TP = 516;
    for (int it = blk; it < (D_MAIN / 64) * (M_TOK / 256); it += nblk) {
        const int cb = it % (D_MAIN / 64), mb = it / (D_MAIN / 64), c0 = cb * 64, m0 = mb * 256;
        __syncthreads();
#pragma unroll
        for (int k = 0; k < 4; ++k) { const int p = tid + NTHREADS * k, ch = p >> 5, seg = p & 31;
            const v4u w = *(const GAS v4u*)(MIXT + (size_t)(c0 + ch) * M_TOK + m0 + seg * 8);
            LAS unsigned* d = (LAS unsigned*)(lds + ch * TP + seg * 16); d[0] = w.x; d[1] = w.y; d[2] = w.z; d[3] = w.w; }
        __syncthreads();
#pragma unroll
        for (int k = 0; k < 4; ++k) { const int q = tid + NTHREADS * k, r = q >> 3, j = q & 7;
            const LAS bf16* s = (const LAS bf16*)(lds + (8 * j) * TP) + r;
            v4u o; o.x = (unsigned)s[0] | ((unsigned)s[TP / 2] << 16); o.y = (unsigned)s[2 * (TP / 2)] | ((unsigned)s[3 * (TP / 2)] << 16);
            o.z = (unsigned)s[4 * (TP / 2)] | ((unsigned)s[5 * (TP / 2)] << 16); o.w = (unsigned)s[6 * (TP / 2)] | ((unsigned)s[7 * (TP / 2)] << 16);
            *(GAS v4u*)(MIX + (size_t)(m0 + r) * DM + c0 + 8 * j) = o; }
    }
    __syncthreads();
}
__device__ __forceinline__ void phase_taps(const float* H2j, const float* w3, float* TAPS, int gw, int NGW, int lane) {
    typedef float f32x16 __attribute__((ext_vector_type(16))); typedef short bf16x8_t __attribute__((ext_vector_type(8)));
    const float min_decay = -4.605170185988091f / 1.5f, max_decay = -4.605170185988091f / 0.3f;
    const int li = lane & 31, hi = lane >> 5;
#pragma unroll 1
    for (int it = gw; it < (FCOLS / 32) * (SEQ / 128); it += NGW) {
        const int ct = it % (FCOLS / 32), ng = it / (FCOLS / 32), col0 = ct * 32;
        bf16x8_t a[4];
#pragma unroll
        for (int s = 0; s < 4; ++s) { float t[8];
#pragma unroll
            for (int j = 0; j < 8; ++j) t[j] = w3[(size_t)(16 * s + 8 * hi + j) * FCOLS + col0 + li];
            v4u p; p.x = pk2(t[0], t[1]); p.y = pk2(t[2], t[3]); p.z = pk2(t[4], t[5]); p.w = pk2(t[6], t[7]); a[s] = __builtin_bit_cast(bf16x8_t, p); }
        f32x4 hv[4][8];
#pragma unroll
        for (int nt = 0; nt < 4; ++nt) { const GAS f32x4* hp = (const GAS f32x4*)(H2j + (size_t)(ng * 128 + nt * 32 + li) * HY_FILT + 8 * hi);
#pragma unroll
            for (int s = 0; s < 4; ++s) { hv[nt][2 * s] = hp[4 * s]; hv[nt][2 * s + 1] = hp[4 * s + 1]; } }
#pragma unroll
        for (int nt = 0; nt < 4; ++nt) {
            const int n0 = ng * 128 + nt * 32;
            f32x16 acc;
#pragma unroll
            for (int r = 0; r < 16; ++r) acc[r] = 0.f;
#pragma unroll
            for (int s = 0; s < 4; ++s) { const f32x4 v0 = hv[nt][2 * s], v1 = hv[nt][2 * s + 1];
                v4u p; p.x = pk2(v0.x, v0.y); p.y = pk2(v0.z, v0.w); p.z = pk2(v1.x, v1.y); p.w = pk2(v1.z, v1.w);
                acc = __builtin_amdgcn_mfma_f32_32x32x16_bf16(a[s], __builtin_bit_cast(bf16x8_t, p), acc, 0, 0, 0); }
            const float t = (float)(n0 + li) * (1.0f / (float)(SEQ - 1));
#pragma unroll
            for (int r = 0; r < 16; ++r) { const int col = col0 + (r & 3) + 8 * (r >> 2) + 4 * hi, c = col % D_MAIN;
                const float ad = fabsf(min_decay + (float)c * ((max_decay - min_decay) / (float)(D_MAIN - 1)));
                TAPS[(size_t)col * SEQ + n0 + li] = acc[r] * expf(-t * ad); }
        }
    }
}

__device__ __forceinline__ constexpr float twc(int k) { constexpr float T[16] = {1.0f, 0.98078528040323043f, 0.92387953251128674f, 0.83146961230254524f, 0.70710678118654757f, 0.55557023301960218f, 0.38268343236508978f, 0.19509032201612825f,
    0.0f, -0.19509032201612825f, -0.38268343236508978f, -0.55557023301960218f, -0.70710678118654757f, -0.83146961230254524f, -0.92387953251128674f, -0.98078528040323043f}; return T[k]; }
__device__ __forceinline__ constexpr float tws(int k) { constexpr float T[16] = {0.0f, 0.19509032201612825f, 0.38268343236508978f, 0.55557023301960218f, 0.70710678118654757f, 0.83146961230254524f, 0.92387953251128674f, 0.98078528040323043f,
    1.0f, 0.98078528040323043f, 0.92387953251128674f, 0.83146961230254524f, 0.70710678118654757f, 0.55557023301960218f, 0.38268343236508978f, 0.19509032201612825f}; return T[k]; }
__device__ __forceinline__ constexpr int bitrev(int i, int bits) { int r = 0; for (int b = 0; b < bits; ++b) if (i & (1 << b)) r |= 1 << (bits - 1 - b); return r; }

template <int N, int LEN> struct FftStage {
    static __device__ __forceinline__ void run(float (&re)[N], float (&im)[N]) {
        constexpr int half = LEN / 2, step = 32 / LEN;
#pragma unroll
        for (int base = 0; base < N; base += LEN)
#pragma unroll
            for (int j = 0; j < half; ++j) {
                const int i0 = base + j, i1 = i0 + half, idx = j * step;
                const float ar = re[i0], ai = im[i0], br = re[i1], bi = im[i1];
                re[i0] = ar + br; im[i0] = ai + bi;
                const float dr = ar - br, di = ai - bi;
                if (idx == 0) { re[i1] = dr; im[i1] = di; }
                else if (idx == 8) { re[i1] = di; im[i1] = -dr; }
                else { const float c = twc(idx), s = tws(idx); re[i1] = dr * c + di * s; im[i1] = di * c - dr * s; }
            }
        if constexpr (LEN > 2) FftStage<N, LEN / 2>::run(re, im);
    }
};
template <int N, int BITS> __device__ __forceinline__ void fft_reg(float (&re)[N], float (&im)[N]) {
    FftStage<N, N>::run(re, im);
    float tr[N], ti[N];
#pragma unroll
    for (int i = 0; i < N; ++i) { tr[bitrev(i, BITS)] = re[i]; ti[bitrev(i, BITS)] = im[i]; }
#pragma unroll
    for (int i = 0; i < N; ++i) { re[i] = tr[i]; im[i] = ti[i]; }
}

template <int N, int LEN> struct FftStageC {
    static __device__ __forceinline__ void run(f32x2 (&x)[N]) {
        constexpr int half = LEN / 2, step = 32 / LEN;
#pragma unroll
        for (int base = 0; base < N; base += LEN)
#pragma unroll
            for (int j = 0; j < half; ++j) {
                const int i0 = base + j, i1 = i0 + half, idx = j * step;
                const f32x2 a = x[i0], b = x[i1];
                x[i0] = a + b;
                const f32x2 d = a - b;
                if (idx == 0) x[i1] = d;
                else if (idx == 8) x[i1] = (f32x2){d.y, -d.x};
                else { const float c = twc(idx), s = tws(idx); const f32x2 t = (f32x2){d.y, -d.x}; x[i1] = d * c + t * s; }
            }
        if constexpr (LEN > 2) FftStageC<N, LEN / 2>::run(x);
    }
};
template <int N, int BITS> __device__ __forceinline__ void fft_regc(f32x2 (&x)[N]) {
    FftStageC<N, N>::run(x);
    f32x2 t[N];
#pragma unroll
    for (int i = 0; i < N; ++i) t[bitrev(i, BITS)] = x[i];
#pragma unroll
    for (int i = 0; i < N; ++i) x[i] = t[i];
}
__device__ __forceinline__ void fft16k_c(f32x2 (&x)[32], LAS f32x2* L, int tid_in) {
    int tid = tid_in; asm volatile("" : "+v"(tid));
    fft_regc<32, 5>(x);
#pragma unroll
    for (int k1 = 1; k1 < 32; ++k1) { const float fr = (float)((tid * k1) & 16383) * (1.0f / 16384.0f); const float c = __builtin_amdgcn_cosf(fr), s = __builtin_amdgcn_sinf(fr);
        const f32x2 d = x[k1], t = (f32x2){d.y, -d.x}; x[k1] = d * c + t * s; if ((k1 & 3) == 3) __builtin_amdgcn_sched_barrier(0); }
#pragma unroll
    for (int k1 = 0; k1 < 32; ++k1) L[k1 * 513 + tid] = x[k1];
    __syncthreads();
    const int n3 = tid & 31, ka = tid >> 5;
    f32x2 a[16], b[16];
#pragma unroll
    for (int n2 = 0; n2 < 16; ++n2) { a[n2] = L[ka * 513 + n2 * 32 + n3]; b[n2] = L[(ka + 16) * 513 + n2 * 32 + n3]; }
    fft_regc<16, 4>(a); fft_regc<16, 4>(b);
#pragma unroll
    for (int k2 = 1; k2 < 16; ++k2) { const float fr = (float)((n3 * k2) & 511) * (1.0f / 512.0f); const float c = __builtin_amdgcn_cosf(fr), s = __builtin_amdgcn_sinf(fr);
        f32x2 d = a[k2], t = (f32x2){d.y, -d.x}; a[k2] = d * c + t * s; d = b[k2]; t = (f32x2){d.y, -d.x}; b[k2] = d * c + t * s; if ((k2 & 3) == 3) __builtin_amdgcn_sched_barrier(0); }
    __syncthreads();
#pragma unroll
    for (int k2 = 0; k2 < 16; ++k2) { L[n3 * 513 + k2 * 32 + ka] = a[k2]; L[n3 * 513 + k2 * 32 + ka + 16] = b[k2]; }
    __syncthreads();
#pragma unroll
    for (int q = 0; q < 32; ++q) x[q] = L[q * 513 + tid];
    fft_regc<32, 5>(x);
}
__device__ __forceinline__ void fft16k(float (&re)[32], float (&im)[32], LAS f32x2* L, int tid) {
    f32x2 x[32];
#pragma unroll
    for (int r = 0; r < 32; ++r) x[r] = (f32x2){re[r], im[r]};
    fft16k_c(x, L, tid);
#pragma unroll
    for (int r = 0; r < 32; ++r) { re[r] = x[r].x; im[r] = x[r].y; }
}

constexpr int HS_SP = SEQ + 16;
__device__ __forceinline__ void hy_stage(LAS bf16* S, int slot, const bf16* src, int tid) {
    LAS bf16* d = S + slot * HS_SP + 8;
    if (tid == 0) { d[-1] = 0; d[SEQ] = 0; }
#pragma unroll
    for (int q = 0; q < 2; ++q) { const int ch = q * NTHREADS + tid; *(LAS v4u*)(d + ch * 8) = *(const GAS v4u*)(src + ch * 8); }
}
__device__ __forceinline__ float hy_sc(const LAS bf16* S, int slot, int t, float w0, float w1, float w2) {
    const LAS bf16* p = S + slot * HS_SP + 8 + t;
    return bf2f(p[-1]) * w0 + bf2f(p[0]) * w1 + bf2f(p[1]) * w2;
}

#ifdef CSEL
#define CT(sec) do { const unsigned long long tn_ = __builtin_amdgcn_s_memrealtime(); if (csec_ == CSEL) ctime_ += tn_ - ct0_; ct0_ = tn_; csec_ = (sec); } while (0)
#else
#define CT(sec)
#endif
__device__ __forceinline__ void phase_hyena_conv(const bf16* PT, const float* TAPS, const float* shortw, const float* skip, f32x2* XSall, f32x2* ZSall, bf16* MIXT,
                                                 LAS unsigned char* lds, int blk, int nblk, int tid_in, int lane, int wave, int pmode = 0) {
    LAS f32x2* L = (LAS f32x2*)lds; LAS bf16* S = (LAS bf16*)lds; LAS float* red = (LAS float*)(lds + LDS_MISC);
    f32x2* XK0 = XSall + (size_t)blk * 16384;
    f32x2* XK1 = XK0 + 16384 * 256; f32x2* ZS = ZSall + (size_t)blk * 16384;
    constexpr int N = 16384;
#ifdef CSEL
    unsigned long long ctime_ = 0ull, ct0_ = __builtin_amdgcn_s_memrealtime(); int csec_ = -1;
#endif
#pragma unroll 1
    for (int c = blk; c < D_MAIN; c += nblk) {
        f32x2 x[32]; float vr[16], vi[16];
#pragma unroll 1
        for (int pass = 0; pass < 5; ++pass) {
            int tid = tid_in; asm volatile("" : "+v"(tid));
            CT(pass == 0 ? 0 : (pass == 1 ? 7 : 8));
            if (pass == 0) {
                const float* hf0 = TAPS + (size_t)c * SEQ; const float* hb0 = TAPS + (size_t)(D_MAIN + c) * SEQ;
                const float* hf1 = TAPS + (size_t)(2 * D_MAIN + c) * SEQ; const float* hb1 = TAPS + (size_t)(3 * D_MAIN + c) * SEQ;
#pragma unroll
                for (int r = 0; r < 16; ++r) { const int n = r * 512 + tid; x[r].x = hf0[n]; x[r].y = hf1[n]; }
#pragma unroll
                for (int r = 16; r < 32; ++r) { const int idx = (32 - r) * 512 - tid; const bool z = (idx == SEQ); const int ii = z ? 0 : idx; x[r].x = z ? 0.f : hb0[ii]; x[r].y = z ? 0.f : hb1[ii]; }
                float e0 = 0.f, e1 = 0.f;
                if (tid == 0) { e0 = hb0[0]; e1 = hb1[0]; }
                float s0 = fabsf(e0), s1 = fabsf(e1);
#pragma unroll
                for (int r = 0; r < 32; ++r) { s0 += fabsf(x[r].x); s1 += fabsf(x[r].y); }
                s0 = wave_sum(s0); s1 = wave_sum(s1);
                __syncthreads();
                if (lane == 0) { red[wave] = s0; red[8 + wave] = s1; }
                __syncthreads();
                float t0 = 0.f, t1 = 0.f;
#pragma unroll
                for (int w = 0; w < NWAVES; ++w) { t0 += red[w]; t1 += red[8 + w]; }
                const float sc0 = 1.0f / (t0 + 1e-6f), sc1 = 1.0f / (t1 + 1e-6f);
                x[0].x += e0; x[0].y += e1;
#pragma unroll
                for (int r = 0; r < 32; ++r) { x[r].x *= sc0; x[r].y *= sc1; }
            } else if (pass == 1) {
                __syncthreads();
                const bf16* pv = PT + (size_t)(2 * D_MAIN + c) * M_TOK; const float wv[3] = {shortw[2 * D_MAIN + c], shortw[2304 + 2 * D_MAIN + c], shortw[4608 + 2 * D_MAIN + c]};
                hy_stage(S, 0, pv, tid); hy_stage(S, 1, pv + SEQ, tid);
                __syncthreads();
#pragma unroll
                for (int r = 0; r < 16; ++r) { const int t = r * 512 + tid; x[r].x = hy_sc(S, 0, t, wv[0], wv[1], wv[2]); x[r].y = hy_sc(S, 1, t, wv[0], wv[1], wv[2]); vr[r] = x[r].x; vi[r] = x[r].y; }
#pragma unroll
                for (int r = 16; r < 32; ++r) { x[r].x = 0.f; x[r].y = 0.f; }
            }
            __syncthreads();
            CT(1);
            fft16k_c(x, L, tid);
            CT(2 + pass);
            if (pass == 0) {
                __syncthreads();
#pragma unroll
                for (int r = 0; r < 32; ++r) L[r * 513 + tid] = x[r];
                __syncthreads();
                const int tp = (512 - tid) & 511;
#pragma unroll
                for (int r = 0; r < 32; ++r) { const int rp = (tid == 0) ? ((32 - r) & 31) : (31 - r);
                    const f32x2 xa = x[r], xb = L[rp * 513 + tp]; const float sc_ = 0.5f / (float)N;
                    XK0[r * 512 + tid] = (f32x2){(xa.x + xb.x) * sc_, (xa.y - xb.y) * sc_};
                    XK1[r * 512 + tid] = (f32x2){(xa.y + xb.y) * sc_, (xb.x - xa.x) * sc_}; if ((r & 7) == 7) __builtin_amdgcn_sched_barrier(0); }
            } else if (pass == 1 || pass == 3) {
                const f32x2* XK = (pass == 1) ? XK0 : XK1;
#pragma unroll
                for (int r = 0; r < 32; ++r) { const f32x2 k = XK[r * 512 + tid]; const float zr_ = x[r].x, zi_ = x[r].y;
                    x[r].x = zr_ * k.x - zi_ * k.y; x[r].y = -(zr_ * k.y + zi_ * k.x); }
            } else if (pass == 2) {
                __syncthreads();
                const bf16* px1 = PT + (size_t)c * M_TOK; const float sk0 = skip[c]; const float wx1[3] = {shortw[c], shortw[2304 + c], shortw[4608 + c]};
                hy_stage(S, 2, px1, tid); hy_stage(S, 3, px1 + SEQ, tid);
                __syncthreads();
#pragma unroll
                for (int r = 0; r < 16; ++r) { const int t = r * 512 + tid;
                    const float v0 = vr[r], v1 = vi[r];
                    const float g0 = hy_sc(S, 2, t, wx1[0], wx1[1], wx1[2]), g1 = hy_sc(S, 3, t, wx1[0], wx1[1], wx1[2]);
                    x[r].x = g0 * (x[r].x + sk0 * v0); x[r].y = g1 * (-x[r].y + sk0 * v1); ZS[t] = (f32x2){x[r].x, x[r].y}; }
#pragma unroll
                for (int r = 16; r < 32; ++r) { x[r].x = 0.f; x[r].y = 0.f; }
            } else {
                __syncthreads();
                const bf16* px2 = PT + (size_t)(D_MAIN + c) * M_TOK; const float sk1 = skip[D_MAIN + c];
                const float wx2[3] = {shortw[D_MAIN + c], shortw[2304 + D_MAIN + c], shortw[4608 + D_MAIN + c]};
                hy_stage(S, 0, px2, tid); hy_stage(S, 1, px2 + SEQ, tid);
                __syncthreads();
#pragma unroll
                for (int r = 0; r < 16; ++r) { const int t = r * 512 + tid;
                    const float g0 = hy_sc(S, 0, t, wx2[0], wx2[1], wx2[2]), g1 = hy_sc(S, 1, t, wx2[0], wx2[1], wx2[2]);
                    const f32x2 z = ZS[t];
                    const float o0 = g0 * (x[r].x + sk1 * z.x), o1 = g1 * (-x[r].y + sk1 * z.y);
                    MIXT[(size_t)c * M_TOK + t] = (bf16)f2bf(o0); MIXT[(size_t)c * M_TOK + SEQ + t] = (bf16)f2bf(o1); }
            }
        }
        CT(-1);
        __syncthreads();
    }
#ifdef CSEL
    if (blk == 0 && tid_in == 0) *(unsigned long long*)((unsigned char*)XSall - WS_FFTX + 32768) += ctime_;
#endif
}
#ifndef MK_PER_PHASE
#define MK_PER_PHASE 0
#endif
#ifndef CONV_PMODE
#define CONV_PMODE 0
#endif
#ifndef REPMASK
#define REPMASK 0u
#endif
#define REP(kind) _Pragma("unroll 1") for (int r_ = 0; r_ < 1 + (int)((REPMASK >> (kind)) & 1u); ++r_)
struct Args {
    const float* in[24]; float* out; unsigned char* ws; int ph_lo, ph_hi;
};
constexpr int N_PHASES = 1 + (DEPTH - 1) + DEPTH * 8 - DEPTH / 2 + 1;

template <int QP, int KP, int THRL = 8>
__device__ __forceinline__ void run_attn(const bf16* Q, const bf16* K, const bf16* V, bf16* O, int NT, char* shm, int wave_s) {
    attn_body::attn_unit<THRL, QP, KP, DM>((const attn_body::bf16*)Q, (const attn_body::bf16*)K, (const attn_body::bf16*)V, (attn_body::bf16*)O, NT, shm, wave_s);
}

__global__ void __launch_bounds__(NTHREADS, 2) hybrid_fwd(Args args) {
    extern __shared__ __attribute__((aligned(16))) unsigned char lds_raw[];
    LAS unsigned char* lds = (LAS unsigned char*)lds_raw;
    const int G = gridDim.x, bx = blockIdx.x;
    const int wave0 = __builtin_amdgcn_readfirstlane((int)(threadIdx.x >> 6));
    const int vcu = (G % 8 == 0) ? (bx % 8) * (G / 8) + bx / 8 : bx;
    const int NGW = G * NWAVES;
    unsigned char* const ws0_ = args.ws;
    const float* x = args.in[0]; const float* mem = args.in[1]; const float* mix_g = args.in[2]; const float* ffn_g = args.in[3]; const float* mem_g = args.in[4]; const float* fin_g = args.in[5];
    const float* hy_short = args.in[9]; const float* f_w1 = args.in[10]; const float* f_b1 = args.in[11]; const float* f_w2 = args.in[12]; const float* f_b2 = args.in[13];
    const float* f_w3 = args.in[14]; const float* f_freq = args.in[15]; const float* hy_skip = args.in[16]; const float* qg = args.in[18]; const float* kg = args.in[19]; const float* router = args.in[20];
    float* H = args.out;
#define U ((bf16*)(ws + WS_U))
#define PROJ ((bf16*)(ws + WS_PROJ))
#define CQ ((bf16*)(ws + WS_CQ))
#define MIX ((bf16*)(ws + WS_MIX))
#define MIXT ((bf16*)(ws + WS_MIXT))
#define AFF ((float*)(ws + WS_AFF))
#define IDX ((int*)(ws + WS_IDX))
#define GATE ((float*)(ws + WS_GATE))
#define POS ((int*)(ws + WS_POS))
#define HID ((bf16*)(ws + WS_HID))
#define Y ((bf16*)(ws + WS_Y))
#define TAPS ((float*)(ws + WS_TAPS))
#define MKV ((const bf16*)(ws + WS_MKV))
    cg::grid_group grid = cg::this_grid();
    volatile LAS unsigned* bst = (volatile LAS unsigned*)(lds + LDS_MISC + 4096);
    if (threadIdx.x < 2) bst[threadIdx.x] = 0u;
    __syncthreads();
    XcdBarrier xbar = xcd_barrier_post((unsigned*)(ws0_ + WS_CTL) + 1024, bst);
    const int lo = args.ph_lo, hi = args.ph_hi;
#define XW (XwIn{args.in[21], args.in[22], args.in[23], ws})
    const bool xw_sched = (G == 256);
    int ph = 0;
#ifdef TSEL
    unsigned long long tacc_ = 0ull, t0_ = 0ull, t1_ = 0ull; int pk_ = 0, tpar_ = 0;
#endif
#ifdef TSEL
#ifndef TAMP
#define TAMP 10
#endif
#ifndef TBAR
#define TBAR 0
#endif
#define PH_T0(k) pk_ = (k); t0_ = __builtin_amdgcn_s_memrealtime();
#ifndef TPAR
#define TPAR -1
#endif
#define PH_T1 t1_ = __builtin_amdgcn_s_memrealtime(); if (!TBAR && (pk_ == TSEL || TSEL == 99) && (TPAR < 0 || tpar_ == TPAR)) tacc_ += t1_ - t0_;
#define PH_T2 if (TBAR && (pk_ == TSEL || TSEL == 99)) tacc_ += __builtin_amdgcn_s_memrealtime() - t1_;
#else
#define PH_T0(k)
#define PH_T1
#define PH_T2
#endif
#define PHASE_BEGINK(k) PH_T0(k) if (lo <= ph && ph < hi) { unsigned char* ws = ws0_; asm volatile("" : "+s"(ws)); const int tid = opaque_tid(wave0), lane = tid & 63, wave = __builtin_amdgcn_readfirstlane(tid >> 6), gw = vcu * NWAVES + wave; (void)lane; (void)gw;
#ifdef EXTRA_XBAR
#define PHASE_END   if (ph + 1 < hi) { if (ph == lo) grid.sync(); else { xcd_barrier(xbar); if (ph < EXTRA_XBAR) xcd_barrier(xbar); } } } ++ph;
#else
#define PHASE_END   PH_T1 if (ph + 1 < hi) { if (ph == lo) grid.sync(); else xcd_barrier(xbar); } PH_T2 } ++ph;
#endif

    PHASE_BEGINK(0)
        ProIn P{args.in[8], args.in[17], args.in[7], args.in[6]};
        REP(0) { phase_weights(P, ws, lds, gw, NGW, wave, lane); phase_xw_p0(XW, xw_sched, (LAS float*)(lds + wave * 16384), gw, NGW, lane); }
        phase_wrg(ffn_g, router, (float*)(ws + WS_WRG), (int)(bx * NTHREADS + tid), (int)(G * NTHREADS));
        REP(1) phase_mem_h2(mem, mem_g, f_w1, f_b1, f_w2, f_b2, f_freq, ws, gw, NGW, lane);
        REP(3) phase_norm<false, false>(x, nullptr, mix_g, U, nullptr, nullptr, nullptr, gw, NGW, lane);
    PHASE_END

#pragma unroll 1
    for (int i = 0; i < DEPTH; ++i) {
        const bool hy = (i & 1) == 0; const int j = i >> 1;
#ifdef TSEL
        tpar_ = i & 1;
#endif
        if (i > 0) {
        PHASE_BEGINK(1)
            phase_norm<true, false>(H, H, mix_g + i * DM, U, nullptr, POS, Y, gw, NGW, lane);
        PHASE_END
        }
        PHASE_BEGINK(2)
            if (i == 0) {
                pg8::Gemm g{(const bf16*)(ws + WS_MEMN), (const bf16*)(ws + WS_WMKV), BATCH * MEM_LEN, 2048, DM, 1 << 30, 1, 0};
                pg8::StaticOrder S; S.init(BATCH * MEM_LEN, 2048, G, bx);
                pg8::EpiRowBf16 E{(bf16*)(ws + WS_MKV), 2048, -1, 1.f};
                pg8::gemm_phase<pg8::EpiRowBf16, pg8::StaticOrder, true, true>(lds, g, S, E, wave);
            }
            if (hy) {
                REP(4) phase_taps((const float*)(ws + WS_H2) + (size_t)j * SEQ * HY_FILT, f_w3 + (size_t)j * HY_FILT * FCOLS, TAPS, gw, NGW, lane);
                pg8::Gemm g{U, (const bf16*)(ws + WS_WHY) + (size_t)j * D_IN_HY * DM, M_TOK, D_IN_HY, DM, 1 << 30, 1, 0};
                pg8::StaticOrder S; S.init(M_TOK, D_IN_HY, G, bx);
                pg8::EpiHyIn E{PROJ, M_TOK, 9, CQ, ATT_C2};
                REP(5) pg8::gemm_phase<pg8::EpiHyIn, pg8::StaticOrder, true, true>(lds, g, S, E, wave);
            } else {
                pg8::Gemm g{U, (const bf16*)(ws + WS_WAT) + (size_t)j * D_IN_AT * DM, M_TOK, D_IN_AT, DM, 1 << 30, 1, 0};
                pg8::StaticOrder S; S.init(M_TOK, D_IN_AT, G, bx);
                pg8::EpiAtIn E{PROJ, PROJ + (size_t)M_TOK * 768, PROJ + (size_t)M_TOK * 1024, PROJ + (size_t)M_TOK * 1280, qg + j * HD, kg + j * HD, ATT_C2, NORM_EPS, SEQ - 1};
                REP(6) pg8::gemm_phase<pg8::EpiAtIn, pg8::StaticOrder, true, true>(lds, g, S, E, wave);
            }
            if (xw_sched && bx >= 128) xw_slice_a(XW, i, (LAS float*)(lds + wave * 16384), bx, wave, lane);
        PHASE_END
        PHASE_BEGINK(3)
            if (hy) {
                REP(8) phase_hyena_conv(PROJ, TAPS, hy_short + (size_t)j * 3 * 2304, hy_skip + (size_t)j * 2 * D_MAIN, (f32x2*)(ws + WS_FFTX), (f32x2*)(ws + WS_ZS), MIXT, lds, bx, G, tid, lane, wave);
                REP(9) for (int u = vcu; u < 256; u += G) { const int b = u >> 7, h4 = (u >> 5) & 3, qb = u & 31; const size_t row = (size_t)b * SEQ + qb * 256;
                    run_attn<256, 2048>(CQ + row * 256 + h4 * HD, MKV + (size_t)b * MEM_LEN * 2048 + i * 512 + h4 * HD, MKV + (size_t)b * MEM_LEN * 2048 + i * 512 + 256 + h4 * HD,
                                        MIX + row * DM + D_MAIN + h4 * HD, MEM_LEN / 64, (char*)lds_raw, wave); }
            } else {
                REP(10) for (int u = vcu; u < 768; u += G) { const int bk = (u & 255) >> 5, qb = u & 31, hs = u >> 8, b = bk >> 2, kvh = bk & 3, h = kvh * 3 + hs; const size_t row = (size_t)b * SEQ + qb * 256;
                    run_attn<768, 256, -1>(PROJ + row * 768 + h * HD, PROJ + (size_t)M_TOK * 768 + (size_t)b * SEQ * 256 + kvh * HD, PROJ + (size_t)M_TOK * 1024 + (size_t)b * SEQ * 256 + kvh * HD,
                                       MIX + row * DM + h * HD, SEQ / 64, (char*)lds_raw, wave); }
                REP(9) for (int u = vcu; u < 256; u += G) { const int b = u >> 7, h4 = (u >> 5) & 3, qb = u & 31; const size_t row = (size_t)b * SEQ + qb * 256;
                    run_attn<256, 2048>(PROJ + (size_t)M_TOK * 1280 + row * 256 + h4 * HD, MKV + (size_t)b * MEM_LEN * 2048 + i * 512 + h4 * HD, MKV + (size_t)b * MEM_LEN * 2048 + i * 512 + 256 + h4 * HD,
                                        MIX + row * DM + D_MAIN + h4 * HD, MEM_LEN / 64, (char*)lds_raw, wave); }
            }
        PHASE_END
        if (hy) {
            PHASE_BEGINK(4)
                REP(11) phase_transpose_mix(MIXT, MIX, lds, bx, G, tid);
            PHASE_END
        }
        PHASE_BEGINK(5)
            pg8::Gemm g{MIX, (const bf16*)(ws + WS_WOUT) + (size_t)i * DM * DM, M_TOK, DM, DM, 1 << 30, 1, 0};
            pg8::StaticOrder S; S.init(M_TOK, DM, G, bx);
            pg8::EpiOutX E{i == 0 ? x : (const float*)H, H, DM, ffn_g + i * DM, (const float*)(ws + WS_WRG) + (size_t)i * NEXP * DM, (unsigned char*)U, (float*)(ws + WS_PART), (float*)(ws + WS_PSS), M_TOK};
            pg8::gemm_phase<pg8::EpiOutX, pg8::StaticOrder, true, true>(lds, g, S, E, wave);
        PHASE_END
        PHASE_BEGINK(6)
            REP(13) phase_router_sum((const float*)(ws + WS_PART), (const float*)(ws + WS_PSS), (float*)(ws + WS_RSTD), AFF, gw, NGW, lane);
        PHASE_END
        PHASE_BEGINK(7)
            REP(14) phase_topk(AFF, (const float*)(ws + WS_RSTD), (float*)(ws + WS_RS), IDX, GATE, POS, lds + LDS_MISC, bx, G, tid, lane, wave);
            if (xw_sched && bx >= 32) xw_slice_b(XW, i, (LAS float*)(lds + wave * 16384), bx, wave, lane);
        PHASE_END
        PHASE_BEGINK(8)
            pg8::Gemm g{U, (const bf16*)(ws + WS_W1 + (size_t)i * NEXP * 1536 * DM), XROWS, 1536, DM / 2, 4, NEXP, (size_t)1536 * DM};
            pg8::StaticOrder S; S.init(XROWS, 1536, G, bx);
            pg8::EpiSwiGLU8 E{(unsigned char*)HID, EFF, 1.0f / W8_SCALE, (const float*)(ws + WS_RS)};
            REP(16) pg8::gemm_phase<pg8::EpiSwiGLU8, pg8::StaticOrder, true, true, true, true>(lds, g, S, E, wave, IDX);
        PHASE_END
        PHASE_BEGINK(9)
            pg8::Gemm g{HID, (const bf16*)(ws + WS_W2 + (size_t)i * NEXP * DM * EFF), XROWS, DM, EFF / 2, 4, NEXP, (size_t)DM * EFF};
            pg8::StaticOrder S; S.init(XROWS, DM, G, bx);
            pg8::EpiDown E{Y, DM, GATE, 1.0f / W8_SCALE};
            REP(17) pg8::gemm_phase<pg8::EpiDown, pg8::StaticOrder, true, true, false, true>(lds, g, S, E, wave);
        PHASE_END
    }
    PHASE_BEGINK(10)
        phase_norm<true, true>(H, nullptr, fin_g, nullptr, args.out, POS, Y, gw, NGW, lane);
    PHASE_END
#ifdef TSEL
#ifdef CSEL
    if (bx == 0 && threadIdx.x == 0) tacc_ += *(unsigned long long*)(ws0_ + 32768);
#endif
    if (bx == 0 && threadIdx.x == 0 && hi - lo > 1) { const unsigned long long te_ = __builtin_amdgcn_s_memrealtime(); while (__builtin_amdgcn_s_memrealtime() - te_ < (unsigned long long)TAMP * tacc_) __builtin_amdgcn_s_sleep(8); }
#endif
#undef PHASE_BEGINK
#undef U
#undef PROJ
#undef CQ
#undef MIX
#undef MIXT
#undef AFF
#undef IDX
#undef GATE
#undef POS
#undef HID
#undef Y
#undef TAPS
#undef MKV
#undef XW
#undef PHASE_END
}

extern "C" void kernel_launch(void* const* d_in, const int* in_sizes, int n_in, void* d_out, int out_size, void* d_ws, size_t ws_size, hipStream_t stream) {
    static int grid = 0;
    if (grid == 0) {
        if (n_in != 24 || out_size != M_TOK * DM || ws_size < WS_END) { fprintf(stderr, "kernel_launch: unexpected shapes (n_in %d out %d ws %zu need %zu)\n", n_in, out_size, ws_size, (size_t)WS_END); grid = -1; return; }
        int dev = 0, cus = 0, per_cu = 0;
        if (hipGetDevice(&dev) != hipSuccess || hipDeviceGetAttribute(&cus, hipDeviceAttributeMultiprocessorCount, dev) != hipSuccess) { grid = -1; return; }
        if (hipFuncSetAttribute((const void*)hybrid_fwd, hipFuncAttributeMaxDynamicSharedMemorySize, LDS_BYTES) != hipSuccess) { fprintf(stderr, "kernel_launch: hipFuncSetAttribute failed\n"); grid = -1; return; }
        if (hipOccupancyMaxActiveBlocksPerMultiprocessor(&per_cu, (const void*)hybrid_fwd, NTHREADS, LDS_BYTES) != hipSuccess || per_cu < 1) { fprintf(stderr, "kernel_launch: occupancy query says %d blocks/CU\n", per_cu); per_cu = 1; }
        (void)hipGetLastError();
        grid = cus;
    }
    if (grid < 0) return;
    if (hipMemsetAsync((char*)d_ws + WS_CTL, 0, 64 * 1024, stream) != hipSuccess) { fprintf(stderr, "kernel_launch: memset failed\n"); return; }
    Args a{};
    for (int i = 0; i < 24; ++i) a.in[i] = (const float*)d_in[i];
    a.out = (float*)d_out; a.ws = (unsigned char*)d_ws;
#if MK_PER_PHASE
    for (int li = 0; li < N_PHASES; ++li) {
        a.ph_lo = li; a.ph_hi = li + 1;
        void* kargs[] = {&a};
        hipError_t e = hipLaunchCooperativeKernel((const void*)hybrid_fwd, dim3(grid), dim3(NTHREADS), kargs, LDS_BYTES, stream);
        if (e != hipSuccess) { fprintf(stderr, "kernel_launch: launch %d failed: %s\n", li, hipGetErrorString(e)); break; }
    }
#else
    a.ph_lo = 0; a.ph_hi = N_PHASES;
    void* kargs[] = {&a};
    hipError_t e = hipLaunchCooperativeKernel((const void*)hybrid_fwd, dim3(grid), dim3(NTHREADS), kargs, LDS_BYTES, stream);
    if (e != hipSuccess) fprintf(stderr, "kernel_launch: cooperative launch failed: %s (grid %d)\n", hipGetErrorString(e), grid);
#endif
}
```

```cpp
#include <hip/hip_runtime.h>
#include <hip/hip_cooperative_groups.h>
#include <hip/hip_bf16.h>
#include <cmath>
#include <cstdio>
#include <cstdint>
namespace cg = cooperative_groups;

constexpr int BATCH = 2, SEQ = 8192, DM = 1024, DEPTH = 4, M_TOK = BATCH * SEQ;
constexpr int HD = 64, MEM_LEN = 256, D_MEM = 256, D_MAIN = 768, NQH = 12, NKVH = 4;
constexpr int D_IN_HY = 2560, D_IN_AT = 1536;
constexpr int NEXP = 16, CAP = 1024, EFF = 768, NGRP = BATCH * NEXP, XROWS = NGRP * CAP;
constexpr int HY_EMB = 33, HY_FILT = 64, FCOLS = 4 * D_MAIN;
constexpr float NORM_EPS = 1e-6f;
constexpr float W8_SCALE = 32.0f;
constexpr float ATT_C2 = 0.125f * 1.4426950408889634f;

constexpr size_t MiB = 1u << 20;
constexpr size_t WS_CTL = 0;
constexpr size_t WS_WHY = 2 * MiB;
constexpr size_t WS_WAT = 12 * MiB;
constexpr size_t WS_WOUT = 18 * MiB;
constexpr size_t WS_WMKV = 26 * MiB;
constexpr size_t WS_W1 = 32 * MiB;
constexpr size_t WS_W2 = 224 * MiB;
constexpr size_t WS_U = 320 * MiB;
constexpr size_t WS_PROJ = 352 * MiB;
constexpr size_t WS_CQ = WS_PROJ + 72 * MiB;
constexpr size_t WS_MIX = 432 * MiB;
constexpr size_t WS_MIXT = 464 * MiB;
constexpr size_t WS_AFF = 488 * MiB;
constexpr size_t WS_IDX = 489 * MiB;
constexpr size_t WS_GATE = WS_IDX + 128 * 1024;
constexpr size_t WS_POS = 490 * MiB;
constexpr size_t WS_XG = 492 * MiB;
constexpr size_t WS_HID = 556 * MiB;
constexpr size_t WS_TAPS = WS_XG;
constexpr size_t WS_Y = 604 * MiB;
constexpr size_t WS_FFTX = WS_Y;
constexpr size_t WS_H2 = 668 * MiB;
constexpr size_t WS_MEMN = 672 * MiB;
constexpr size_t WS_MKV = 673 * MiB;
constexpr size_t WS_PART = 676 * MiB;
constexpr size_t WS_PSS = 692 * MiB;
constexpr size_t WS_RSTD = 697 * MiB;
constexpr size_t WS_RS = WS_RSTD + 128 * 1024;
constexpr size_t WS_WRG = 698 * MiB;
constexpr size_t WS_ZS = 700 * MiB;
constexpr size_t WS_END = 732 * MiB;

constexpr int LDS_RING = 0;
constexpr int LDS_MISC = 132 * 1024;
constexpr int LDS_BYTES = 140 * 1024;
constexpr int NTHREADS = 512, NWAVES = 8;

#define GAS __attribute__((address_space(1)))
#define LAS __attribute__((address_space(3)))
typedef unsigned short bf16;
typedef unsigned v4u __attribute__((ext_vector_type(4)));
typedef unsigned v2u __attribute__((ext_vector_type(2)));
typedef float f32x4 __attribute__((ext_vector_type(4)));
typedef float f32x2 __attribute__((ext_vector_type(2)));
__device__ __forceinline__ unsigned f2bf(float f) { unsigned u = __builtin_bit_cast(unsigned, f); return (u + 0x7fffu + ((u >> 16) & 1u)) >> 16; }
__device__ __forceinline__ unsigned pk2(float lo, float hi) { return f2bf(lo) | (f2bf(hi) << 16); }
__device__ __forceinline__ float bf2f(unsigned short h) { return __builtin_bit_cast(float, (unsigned)h << 16); }
__device__ __forceinline__ float bflo(unsigned w) { return __builtin_bit_cast(float, w << 16); }
__device__ __forceinline__ float bfhi(unsigned w) { return __builtin_bit_cast(float, w & 0xffff0000u); }
__device__ __forceinline__ float wave_sum(float v) {
#pragma unroll
    for (int o = 1; o < 64; o <<= 1) v += __shfl_xor(v, o);
    return v;
}
__device__ __forceinline__ int opaque_tid(int wave_s) { int l; asm volatile("v_mbcnt_lo_u32_b32 %0, -1, 0\n\tv_mbcnt_hi_u32_b32 %0, -1, %0" : "=v"(l)); return (wave_s << 6) | l; }
#define MK_PER_PHASE 0

#define XB_TMO      128
#define XB_XCNT(j)  (256  + 64 * (j))
#define XB_XSUB(j)  (1280 + 64 * (j))
#define XB_XGEN(j)  (2304 + 64 * (j))
#define XB_TOP      3328
#define XB_TOPGEN   3392
#define XCD_BAR_WORDS 3456
#define XB_SPIN_CAP (1u << 18)

__device__ __forceinline__ unsigned xb_ld(unsigned* p)              { return __hip_atomic_load(p, __ATOMIC_RELAXED, __HIP_MEMORY_SCOPE_AGENT); }
__device__ __forceinline__ unsigned xb_add(unsigned* p, unsigned v) { return __hip_atomic_fetch_add(p, v, __ATOMIC_RELAXED, __HIP_MEMORY_SCOPE_AGENT); }
__device__ __forceinline__ unsigned xb_xcc_id() { return (unsigned)__builtin_amdgcn_s_getreg((3 << 11) | 20) & 0xFu; }
#define XB_SPIN(cond, bar) do { unsigned _sp = 0; while (cond) { __builtin_amdgcn_s_sleep(1); \
    if ((++_sp & 255u) == 0u) { if (xb_ld(&(bar)[XB_TMO])) break; if (_sp > XB_SPIN_CAP) { atomicAdd(&(bar)[XB_TMO], 1u); break; } } } } while (0)

struct XcdBarrier {
    unsigned* bar; unsigned x;
    volatile LAS unsigned* st;
};

__device__ __forceinline__ XcdBarrier xcd_barrier_post(unsigned* bar, volatile LAS unsigned* st) {
    XcdBarrier b; b.bar = bar; b.x = xb_xcc_id(); b.st = st;
    if (threadIdx.x == 0) (void)xb_add(&bar[XB_XCNT(b.x)], 1u);
    return b;
}
__device__ __forceinline__ void xcd_barrier_complete(unsigned* bar, unsigned x, unsigned& nloc, unsigned& nx) {
    const unsigned G = gridDim.x * gridDim.y * gridDim.z;
    unsigned sum, cnt, mine, sp = 0u;
    for (;;) {
        sum = 0u; cnt = 0u; mine = 0u;
#pragma unroll
        for (unsigned j = 0; j < 16; ++j) { const unsigned c = xb_ld(&bar[XB_XCNT(j)]); sum += c; cnt += (c > 0u) ? 1u : 0u; mine = (j == x) ? c : mine; }
        if (sum == G) break;
        __builtin_amdgcn_s_sleep(1);
        if ((++sp & 255u) == 0u) { if (xb_ld(&bar[XB_TMO])) break; if (sp > XB_SPIN_CAP) { atomicAdd(&bar[XB_TMO], 1u); break; } }
    }
    nloc = mine > 0u ? mine : 1u; nx = cnt > 0u ? cnt : 1u;
}

__device__ __forceinline__ void xcd_barrier(const XcdBarrier& b) {
    asm volatile("s_waitcnt vmcnt(0)" ::: "memory");
    __syncthreads();
    if (threadIdx.x == 0) {
        unsigned* bar = b.bar;
        __builtin_amdgcn_s_waitcnt(0);
        unsigned nloc = b.st[0], nx = b.st[1];
        if (nloc == 0u) { xcd_barrier_complete(bar, b.x, nloc, nx); b.st[0] = nloc; b.st[1] = nx; }
        const unsigned old = xb_add(&bar[XB_XSUB(b.x)], 1u);
        const unsigned gen = old / nloc;
        if (old + 1u == (gen + 1u) * nloc) {
            __builtin_amdgcn_fence(__ATOMIC_RELEASE, "agent");
            asm volatile("s_waitcnt vmcnt(0)" ::: "memory");
            const unsigned og = xb_add(&bar[XB_TOP], 1u);
            const unsigned tg = og / nx;
            if (og + 1u == (tg + 1u) * nx) xb_add(&bar[XB_TOPGEN], 1u);
            else XB_SPIN(xb_ld(&bar[XB_TOPGEN]) == tg, bar);
            __builtin_amdgcn_fence(__ATOMIC_ACQUIRE, "agent");
            xb_add(&bar[XB_XGEN(b.x)], 1u);
            asm volatile("s_waitcnt vmcnt(0)" ::: "memory");
        } else {
            XB_SPIN(xb_ld(&bar[XB_XGEN(b.x)]) == gen, bar);
            __builtin_amdgcn_fence(__ATOMIC_ACQUIRE, "agent");
            asm volatile("s_waitcnt vmcnt(0)" ::: "memory");
        }
    }
    __syncthreads();
}
namespace pg8 {
#define PG8_LAS __attribute__((address_space(3)))
typedef unsigned short bf16_t;
typedef short bf16x8 __attribute__((ext_vector_type(8)));
typedef float f32x4 __attribute__((ext_vector_type(4)));
typedef unsigned u32x4 __attribute__((ext_vector_type(4)));
constexpr int BM = 256, BK = 64, HALF = 128, HTB = HALF * BK * 2  , STAGE_BYTES = 8 * HTB, NXCD = 8, WGM = 8;

__host__ __device__ __forceinline__ int lds_byte(int r, int c) { const int st = (r >> 4) * 2 + (c >> 5), rr = r & 15, cc = c & 31, ob = rr * 64 + cc * 2; return st * 1024 + (ob ^ (((ob >> 9) & 1) << 5)); }
__host__ __device__ __forceinline__ void stage_rc(int b, int& R, int& C) { const int st = b / 1024, sb = b % 1024, swz = sb ^ (((sb >> 9) & 1) << 5); R = (st >> 1) * 16 + swz / 64; C = (st & 1) * 32 + (swz % 64) / 2; }
__host__ __device__ __forceinline__ int perm32(int rho) { const int n = rho >> 4, i = rho & 15; return 8 * (i >> 2) + 4 * n + (i & 3); }

struct Unit { int pm, pn; };
struct Gemm { const bf16_t* A; const bf16_t* Bt; int M, N, K; int gdiv, gmod; size_t gstride; };

struct StaticOrder {
    int nM, nN, nwg, G, c;
    __host__ __device__ void init(int M, int N, int G_, int c_) { nM = M / BM; nN = N / BM; nwg = nM * nN; G = G_; c = c_; }
    __host__ __device__ bool next(int i, Unit& u) const {
        const long L = (long)i * G + c; if (L >= nwg) return false;
        int wgid = (int)L; { const int q = nwg / NXCD, r = nwg % NXCD, xcd = wgid % NXCD, off = wgid / NXCD; wgid = (xcd < r ? xcd * (q + 1) : r * (q + 1) + (xcd - r) * q) + off; }
        const int nig = WGM * nN, gid = wgid / nig, fm = gid * WGM, gsz = (nM - fm) < WGM ? (nM - fm) : WGM;
        u.pm = fm + ((wgid % nig) % gsz); u.pn = (wgid % nig) / gsz; return true;
    }
    __device__ __forceinline__ void a_ready(const Unit&) const {}
    __device__ __forceinline__ void done(const Unit&) const {}
};


__device__ __forceinline__ unsigned cvt_pk_bf16(float lo, float hi) { unsigned r; asm volatile("v_cvt_pk_bf16_f32 %0, %1, %2" : "=v"(r) : "v"(lo), "v"(hi)); return r; }
typedef unsigned u32x2 __attribute__((ext_vector_type(2)));
struct EpiRowBf16 {
    static constexpr bool PERM = false, AFTER_DRAIN = false;
    bf16_t* O; int ldc; int sc_pn; float sc;
    __device__ __forceinline__ void operator()(const f32x4 (&acc)[2][2][4][2], const Unit& u, int wr, int wc, int fr, int fq) const {
        const float s = (u.pn == sc_pn) ? sc : 1.f;
        const int row0 = u.pm * BM + wr * 64 + fr, col0 = u.pn * BM + wc * 32 + 4 * fq;
#pragma unroll
        for (int ai = 0; ai < 2; ++ai)
#pragma unroll
            for (int m = 0; m < 4; ++m) { bf16_t* rowp = O + (size_t)(row0 + ai * HALF + m * 16) * ldc + col0;
#pragma unroll
                for (int bj = 0; bj < 2; ++bj)
#pragma unroll
                    for (int n = 0; n < 2; ++n) { const f32x4 v = acc[ai][bj][m][n] * s; u32x2 w; w.x = cvt_pk_bf16(v[0], v[1]); w.y = cvt_pk_bf16(v[2], v[3]);
                        *(u32x2*)(rowp + bj * HALF + n * 16) = w; } }
    }
};
struct EpiHyIn {
    static constexpr bool PERM = false, AFTER_DRAIN = false;
    bf16_t* OT; int ldt; int tp_tiles; bf16_t* CQ; float sc;
    __device__ __forceinline__ void operator()(const f32x4 (&acc)[2][2][4][2], const Unit& u, int wr, int wc, int fr, int fq) const {
        const int row0 = u.pm * BM + wr * 64 + fr;
        if (u.pn < tp_tiles) {
            const int col0 = u.pn * BM + wc * 32 + 4 * fq;
#pragma unroll
            for (int ai = 0; ai < 2; ++ai)
#pragma unroll
                for (int m = 0; m < 4; ++m) { const int row = row0 + ai * HALF + m * 16;
#pragma unroll
                    for (int bj = 0; bj < 2; ++bj)
#pragma unroll
                        for (int n = 0; n < 2; ++n) { const f32x4 v = acc[ai][bj][m][n]; const unsigned w0 = cvt_pk_bf16(v[0], v[1]), w1 = cvt_pk_bf16(v[2], v[3]);
                            bf16_t* p = OT + (size_t)(col0 + bj * HALF + n * 16) * ldt + row;
                            p[0] = (bf16_t)(w0 & 0xffffu); p[(size_t)ldt] = (bf16_t)(w0 >> 16); p[(size_t)2 * ldt] = (bf16_t)(w1 & 0xffffu); p[(size_t)3 * ldt] = (bf16_t)(w1 >> 16); } }
        } else {
            const int col0 = wc * 32 + 4 * fq;
#pragma unroll
            for (int ai = 0; ai < 2; ++ai)
#pragma unroll
                for (int m = 0; m < 4; ++m) { bf16_t* rowp = CQ + (size_t)(row0 + ai * HALF + m * 16) * 256 + col0;
#pragma unroll
                    for (int bj = 0; bj < 2; ++bj)
#pragma unroll
                        for (int n = 0; n < 2; ++n) { const f32x4 v = acc[ai][bj][m][n] * sc; u32x2 w; w.x = cvt_pk_bf16(v[0], v[1]); w.y = cvt_pk_bf16(v[2], v[3]);
                            *(u32x2*)(rowp + bj * HALF + n * 16) = w; } }
        }
    }
};
struct EpiAtIn {
    static constexpr bool PERM = false, AFTER_DRAIN = false;
    bf16_t* Oq; bf16_t* Ok; bf16_t* Ov; bf16_t* Oc; const float* gq; const float* gk; float csc; float eps; int seq_mask;
    __device__ __forceinline__ void operator()(const f32x4 (&acc)[2][2][4][2], const Unit& u, int wr, int wc, int fr, int fq) const {
        const int row0 = u.pm * BM + wr * 64 + fr, colb = (u.pn < 3 ? u.pn * BM : 0) + wc * 64 + 4 * fq; const int ldc = u.pn < 3 ? 768 : 256;
        bf16_t* O = u.pn < 3 ? Oq : (u.pn == 3 ? Ok : (u.pn == 4 ? Ov : Oc));
        if (u.pn <= 3) {
            const float* gp = (u.pn == 3 ? gk : gq) + 4 * fq; const float osc = (u.pn == 3) ? 1.f : csc;
            float invr[4];
#pragma unroll
            for (int q = 0; q < 4; ++q) invr[q] = exp2f(-(float)(4 * fq + q) * (13.287712379549449f / 16.0f)) * 0.15915494309189535f;
#pragma unroll
            for (int ai = 0; ai < 2; ++ai)
#pragma unroll
                for (int m = 0; m < 4; ++m) {
                    const int row = row0 + ai * HALF + m * 16; int t = row & seq_mask; asm volatile("" : "+v"(t));
                    float ss = 0.f;
#pragma unroll
                    for (int bj = 0; bj < 2; ++bj)
#pragma unroll
                        for (int n = 0; n < 2; ++n) { const f32x4 x = acc[ai][bj][m][n]; ss += (x[0] * x[0] + x[1] * x[1]) + (x[2] * x[2] + x[3] * x[3]); }
                    ss += __shfl_xor(ss, 16); ss += __shfl_xor(ss, 32);
                    const float rs = osc * __builtin_amdgcn_rsqf(ss * (1.0f / 64.0f) + eps);
                    bf16_t* rowp = O + (size_t)row * ldc + colb;
#pragma unroll
                    for (int bj = 0; bj < 2; ++bj) {
                        const float pos = (float)(bj == 0 ? (t >> 6) : (t & 63));
                        const f32x4 xa = acc[ai][bj][m][0] * rs * *(const f32x4*)(gp + 32 * bj), xb = acc[ai][bj][m][1] * rs * *(const f32x4*)(gp + 32 * bj + 16);
                        f32x4 oa, ob;
#pragma unroll
                        for (int q = 0; q < 4; ++q) { const float rev = pos * invr[q]; const float c = __builtin_amdgcn_cosf(rev), s = __builtin_amdgcn_sinf(rev);
                            oa[q] = xa[q] * c - xb[q] * s; ob[q] = xa[q] * s + xb[q] * c; }
                        u32x2 w; w.x = cvt_pk_bf16(oa[0], oa[1]); w.y = cvt_pk_bf16(oa[2], oa[3]); *(u32x2*)(rowp + 32 * bj) = w;
                        w.x = cvt_pk_bf16(ob[0], ob[1]); w.y = cvt_pk_bf16(ob[2], ob[3]); *(u32x2*)(rowp + 32 * bj + 16) = w;
                    }
                    asm volatile("" ::: "memory");
                }
        } else {
            const float s = (u.pn == 5) ? csc : 1.f;
#pragma unroll
            for (int ai = 0; ai < 2; ++ai)
#pragma unroll
                for (int m = 0; m < 4; ++m) { bf16_t* rowp = O + (size_t)(row0 + ai * HALF + m * 16) * ldc + colb;
#pragma unroll
                    for (int bj = 0; bj < 2; ++bj)
#pragma unroll
                        for (int n = 0; n < 2; ++n) { const f32x4 v = acc[ai][bj][m][n] * s; u32x2 w; w.x = cvt_pk_bf16(v[0], v[1]); w.y = cvt_pk_bf16(v[2], v[3]);
                            *(u32x2*)(rowp + 32 * bj + 16 * n) = w; } }
        }
    }
};
struct EpiResF32 {
    static constexpr bool PERM = false, AFTER_DRAIN = false;
    const float* res; float* out; int ldc;
    __device__ __forceinline__ void operator()(const f32x4 (&acc)[2][2][4][2], const Unit& u, int wr, int wc, int fr, int fq) const {
        const int row0 = u.pm * BM + wr * 64 + fr, col0 = u.pn * BM + wc * 32 + 4 * fq;
#pragma unroll
        for (int ai = 0; ai < 2; ++ai)
#pragma unroll
            for (int m = 0; m < 4; ++m) { const size_t off = (size_t)(row0 + ai * HALF + m * 16) * ldc + col0;
#pragma unroll
                for (int bj = 0; bj < 2; ++bj)
#pragma unroll
                    for (int n = 0; n < 2; ++n) { const f32x4 r = *(const f32x4*)(res + off + bj * HALF + n * 16); *(f32x4*)(out + off + bj * HALF + n * 16) = r + acc[ai][bj][m][n]; } }
    }
};
__device__ __forceinline__ unsigned pk4_fp8_sat(const f32x4 x) {
    unsigned w = 0;
    w = __builtin_amdgcn_cvt_pk_fp8_f32(__builtin_amdgcn_fmed3f(x[0], -448.f, 448.f), __builtin_amdgcn_fmed3f(x[1], -448.f, 448.f), w, false);
    w = __builtin_amdgcn_cvt_pk_fp8_f32(__builtin_amdgcn_fmed3f(x[2], -448.f, 448.f), __builtin_amdgcn_fmed3f(x[3], -448.f, 448.f), w, true);
    return w;
}
struct EpiOutX {
    static constexpr bool PERM = true, AFTER_DRAIN = false;
    const float* res; float* out; int ldc; const float* gain; const float* WrG; unsigned char* XN8; float* PLG; float* PSS; int M;
    static __device__ __forceinline__ void split8(const f32x4 a, const f32x4 b, bf16x8& hi, bf16x8& lo) {
        u32x4 h, l; float r[8] = {a[0], a[1], a[2], a[3], b[0], b[1], b[2], b[3]};
#pragma unroll
        for (int k = 0; k < 4; ++k) { const unsigned p = cvt_pk_bf16(r[2 * k], r[2 * k + 1]); h[k] = p;
            const float d0 = r[2 * k] - __builtin_bit_cast(float, p << 16), d1 = r[2 * k + 1] - __builtin_bit_cast(float, p & 0xffff0000u); l[k] = cvt_pk_bf16(d0, d1); }
        hi = __builtin_bit_cast(bf16x8, h); lo = __builtin_bit_cast(bf16x8, l);
    }
    __device__ __forceinline__ void operator()(f32x4 (&acc)[2][2][4][2], const Unit& u, int wr, int wc, int fr, int fq) const {
        const int row0 = u.pm * BM + wr * 64 + fr, col0 = u.pn * BM + wc * 32 + 8 * fq, slot = u.pn * 4 + wc;
        bf16x8 whi[2], wlo[2];
#pragma unroll
        for (int bj = 0; bj < 2; ++bj) { const float* wp = WrG + (size_t)fr * ldc + col0 + bj * HALF; split8(*(const f32x4*)wp, *(const f32x4*)(wp + 4), whi[bj], wlo[bj]); }
#pragma unroll
        for (int idx = 0; idx < 8; ++idx) { const int ai = idx >> 2, m = idx & 3;
            const int row = row0 + ai * HALF + m * 16; const size_t off = (size_t)row * ldc + col0; float ss = 0.f; f32x4 lg = (f32x4){0.f, 0.f, 0.f, 0.f}; u32x4 xw;
#pragma unroll
            for (int bj = 0; bj < 2; ++bj) {
#pragma unroll
                for (int n = 0; n < 2; ++n) { const int co = bj * HALF + n * 4;
                    const f32x4 h = *(const f32x4*)(res + off + co) + acc[ai][bj][m][n]; acc[ai][bj][m][n] = h; *(f32x4*)(out + off + co) = h;
                    ss += (h[0] * h[0] + h[1] * h[1]) + (h[2] * h[2] + h[3] * h[3]);
                    const f32x4 x = h * *(const f32x4*)(gain + col0 + co);
                    xw[bj * 2 + n] = pk4_fp8_sat(x); }
                bf16x8 hhi, hlo; split8(acc[ai][bj][m][0], acc[ai][bj][m][1], hhi, hlo);
                lg = __builtin_amdgcn_mfma_f32_16x16x32_bf16(wlo[bj], hhi, lg, 0, 0, 0);
                lg = __builtin_amdgcn_mfma_f32_16x16x32_bf16(whi[bj], hlo, lg, 0, 0, 0);
                lg = __builtin_amdgcn_mfma_f32_16x16x32_bf16(whi[bj], hhi, lg, 0, 0, 0); }
            *(u32x4*)(XN8 + (size_t)row * ldc + u.pn * BM + wc * 64 + fq * 16) = xw;
            ss += __shfl_xor(ss, 16); ss += __shfl_xor(ss, 32);
            if (fq == 0) PSS[(size_t)slot * M + row] = ss;
            *(f32x4*)(PLG + ((size_t)slot * M + row) * 16 + 4 * fq) = lg;
            asm volatile("" ::: "memory"); }
    }
};
struct EpiSwiGLU {
    static constexpr bool PERM = false, AFTER_DRAIN = false;
    bf16_t* O; int ldc;
    __device__ __forceinline__ void operator()(const f32x4 (&acc)[2][2][4][2], const Unit& u, int wr, int wc, int fr, int fq) const {
        const int row0 = u.pm * BM + wr * 64 + fr, col0 = u.pn * HALF + wc * 32 + 4 * fq;
#pragma unroll
        for (int ai = 0; ai < 2; ++ai)
#pragma unroll
            for (int m = 0; m < 4; ++m) { bf16_t* rowp = O + (size_t)(row0 + ai * HALF + m * 16) * ldc + col0;
#pragma unroll
                for (int n = 0; n < 2; ++n) { const f32x4 g = acc[ai][0][m][n], up = acc[ai][1][m][n]; f32x4 h;
#pragma unroll
                    for (int q = 0; q < 4; ++q) h[q] = g[q] * up[q] * __builtin_amdgcn_rcpf(1.f + __expf(-g[q]));
                    u32x2 w; w.x = cvt_pk_bf16(h[0], h[1]); w.y = cvt_pk_bf16(h[2], h[3]); *(u32x2*)(rowp + n * 16) = w; } }
    }
};
struct EpiSwiGLU8 {
    static constexpr bool PERM = false, AFTER_DRAIN = false;
    unsigned char* O; int ldc; float wsc; const float* rs;
    __device__ __forceinline__ void operator()(const f32x4 (&acc)[2][2][4][2], const Unit& u, int wr, int wc, int fr, int fq) const {
        const int row0 = u.pm * BM + wr * 64 + fr, col0 = u.pn * HALF + wc * 32 + 4 * fq;
#pragma unroll
        for (int ai = 0; ai < 2; ++ai)
#pragma unroll
            for (int m = 0; m < 4; ++m) { const int row = row0 + ai * HALF + m * 16; const float sc = wsc * rs[row]; u32x2 hw;
#pragma unroll
                for (int n = 0; n < 2; ++n) { const f32x4 g = acc[ai][0][m][n] * sc, up = acc[ai][1][m][n] * sc; f32x4 h;
#pragma unroll
                    for (int q = 0; q < 4; ++q) h[q] = g[q] * up[q] * __builtin_amdgcn_rcpf(1.f + __expf(-g[q]));
                    hw[n] = pk4_fp8_sat(h); }
                *(u32x2*)(O + (size_t)row * ldc + u.pn * HALF + wc * 32 + fq * 8) = hw; }
    }
};
struct EpiDown {
    static constexpr bool PERM = true, AFTER_DRAIN = false;
    bf16_t* O; int ldc; const float* gate; float wsc;
    __device__ __forceinline__ void operator()(const f32x4 (&acc)[2][2][4][2], const Unit& u, int wr, int wc, int fr, int fq) const {
        const int row0 = u.pm * BM + wr * 64 + fr, col0 = u.pn * BM + wc * 32 + 8 * fq;
#pragma unroll
        for (int ai = 0; ai < 2; ++ai)
#pragma unroll
            for (int m = 0; m < 4; ++m) { const int row = row0 + ai * HALF + m * 16; const float gs = gate[row] * wsc; bf16_t* rowp = O + (size_t)row * ldc + col0;
#pragma unroll
                for (int bj = 0; bj < 2; ++bj) { const f32x4 v0 = acc[ai][bj][m][0] * gs, v1 = acc[ai][bj][m][1] * gs; u32x4 w;
                    w.x = cvt_pk_bf16(v0[0], v0[1]); w.y = cvt_pk_bf16(v0[2], v0[3]); w.z = cvt_pk_bf16(v1[0], v1[1]); w.w = cvt_pk_bf16(v1[2], v1[3]);
                    *(u32x4*)(rowp + bj * HALF) = w; } }
    }
};
template <class Epi, class Sched, bool ALIGN_EPI = false, bool SP2 = false, bool GATHER = false, bool FP8 = false>
__device__ __forceinline__ void gemm_phase(PG8_LAS unsigned char* lds, const Gemm g, const Sched& S, const Epi& E, int wave_s, const int* gidx = nullptr) {
    const int tid = opaque_tid(wave_s), wid = __builtin_amdgcn_readfirstlane(tid >> 6), lane = tid & 63, wr = wid >> 2, wc = wid & 3, fr = lane & 15, fq = lane >> 4;
    const int K = g.K, nt = K / BK;
    unsigned voffA[2], voffB[2];
#pragma unroll
    for (int i = 0; i < 2; ++i) { int R, C; stage_rc(tid * 16 + i * 8192, R, C); const int Rb = Epi::PERM ? ((R & ~31) + perm32(R & 31)) : R;
        voffA[i] = (unsigned)(R * K + C) * 2u; voffB[i] = (unsigned)(Rb * K + C) * 2u; }
    const size_t kstep = (size_t)(BK * 2);
    const size_t hstep = (size_t)HALF * K * 2;
    const size_t tstep = 2 * hstep;
    const unsigned ldsw = (unsigned)wid * 1024u;
    const int aoff = lds_byte(wr * 64 + fr, fq * 8), boff = lds_byte(wc * 32 + fr, fq * 8);
#define PG8_SA(b, h) (((b) * 2 + (h)) * HTB)
#define PG8_SB(b, h) ((4 + (b) * 2 + (h)) * HTB)
#define PG8_STAGE(bufoff, gbase, voff) do { _Pragma("unroll") for (int _i = 0; _i < 2; ++_i) \
        __builtin_amdgcn_global_load_lds((const unsigned*)((const char*)(gbase) + (voff)[_i]), (PG8_LAS unsigned*)(lds + (bufoff) + ldsw + _i * 8192), 16, 0, 0); } while (0)
#define PG8_LDA(dst, b, h) do { _Pragma("unroll") for (int m = 0; m < 4; ++m) { if constexpr (FP8) { const v4i_ lo_ = *(const PG8_LAS v4i_*)(lds + PG8_SA(b, h) + aoff + m * 2048), hi_ = *(const PG8_LAS v4i_*)(lds + PG8_SA(b, h) + aoff + m * 2048 + 1024); \
        dst##8[m] = __builtin_shufflevector(lo_, hi_, 0, 1, 2, 3, 4, 5, 6, 7); } else { _Pragma("unroll") for (int k = 0; k < 2; ++k) dst[m][k] = *(const PG8_LAS bf16x8*)(lds + PG8_SA(b, h) + aoff + m * 2048 + k * 1024); } } } while (0)
#define PG8_LDB(dst, b, h) do { _Pragma("unroll") for (int n = 0; n < 2; ++n) { if constexpr (FP8) { const v4i_ lo_ = *(const PG8_LAS v4i_*)(lds + PG8_SB(b, h) + boff + n * 2048), hi_ = *(const PG8_LAS v4i_*)(lds + PG8_SB(b, h) + boff + n * 2048 + 1024); \
        dst##8[n] = __builtin_shufflevector(lo_, hi_, 0, 1, 2, 3, 4, 5, 6, 7); } else { _Pragma("unroll") for (int k = 0; k < 2; ++k) dst[n][k] = *(const PG8_LAS bf16x8*)(lds + PG8_SB(b, h) + boff + n * 2048 + k * 1024); } } } while (0)
#define PG8_MMA(ai, bj, At, Bt) do { __builtin_amdgcn_s_setprio(1); _Pragma("unroll") for (int m = 0; m < 4; ++m) _Pragma("unroll") for (int n = 0; n < 2; ++n) { \
        if constexpr (FP8) asm volatile("v_mfma_scale_f32_16x16x128_f8f6f4 %0, %1, %2, %0, %3, %3 op_sel_hi:[0,0,0]" : "+v"(acc[ai][bj][m][n]) : "v"(Bt##8[n]), "v"(At##8[m]), "v"(sc127_));   \
        else { _Pragma("unroll") for (int k = 0; k < 2; ++k) acc[ai][bj][m][n] = __builtin_amdgcn_mfma_f32_16x16x32_bf16(Bt[n][k], At[m][k], acc[ai][bj][m][n], 0, 0, 0); } } \
        __builtin_amdgcn_s_setprio(0); } while (0)
#define PG8_WAIT_V(n) asm volatile("s_waitcnt vmcnt(" #n ")" ::: "memory")
#define PG8_WAIT_L(n) asm volatile("s_waitcnt lgkmcnt(" #n ")" ::: "memory")
#define PG8_BAR __builtin_amdgcn_s_barrier()
#define PG8_SCHED __builtin_amdgcn_sched_barrier(0)
    Unit cur, nxt; int ui = 0;
    if (!S.next(0, cur)) return;
    f32x4 acc[2][2][4][2];
#pragma unroll
    for (int a = 0; a < 2; ++a)
#pragma unroll
        for (int b = 0; b < 2; ++b)
#pragma unroll
            for (int m = 0; m < 4; ++m)
#pragma unroll
                for (int n = 0; n < 2; ++n) acc[a][b][m][n] = (f32x4){0.f, 0.f, 0.f, 0.f};
    typedef int v8i_ __attribute__((ext_vector_type(8))); typedef int v4i_ __attribute__((ext_vector_type(4)));
    const int sc127_ = 127;
    bf16x8 At[4][2], B0[2][2], B1[2][2]; v8i_ At8[4], B08[2], B18[2];
    static_assert(SP2, "this copy of the body keeps only the SP2 K-loop up to date");
    int rA[2]; { int R_, C_; stage_rc(tid * 16, R_, C_); rA[0] = R_; stage_rc(tid * 16 + 8192, R_, C_); rA[1] = R_; }
    unsigned cvp[2], nvp[2], c2_[2]; c2_[0] = voffA[0] - (unsigned)(rA[0] * K) * 2u; c2_[1] = voffA[1] - (unsigned)(rA[1] * K) * 2u;
#define PG8_ROWOFF(dst, unit) do { _Pragma("unroll") for (int i_ = 0; i_ < 2; ++i_) dst[i_] = (unsigned)gidx[(unit).pm * BM + rA[i_]] | ((unsigned)gidx[(unit).pm * BM + HALF + rA[i_]] << 16); } while (0)
#define PG8_STAGE_A(bufoff, gbase, P, H) do { if constexpr (GATHER) { unsigned to_[2]; _Pragma("unroll") for (int i_ = 0; i_ < 2; ++i_) to_[i_] = ((P[i_] >> (16 * (H))) & 0xffffu) * (unsigned)(K * 2) + c2_[i_]; PG8_STAGE(bufoff, gbase, to_); } \
        else { PG8_STAGE(bufoff, (gbase) + ((H) ? hstep : (size_t)0), voffA); } } while (0)
    if constexpr (GATHER) PG8_ROWOFF(cvp, cur); else { cvp[0] = 0u; cvp[1] = 0u; }
    const char* cA = GATHER ? (const char*)g.A : (const char*)g.A + (size_t)cur.pm * tstep; const char* cB = (const char*)g.Bt + (size_t)((cur.pm / g.gdiv) % g.gmod) * g.gstride + (size_t)cur.pn * tstep;
    S.a_ready(cur);
    if constexpr (SP2) {
        PG8_STAGE(PG8_SB(0, 0), cB, voffB); PG8_STAGE(PG8_SB(0, 1), cB + hstep, voffB); PG8_STAGE_A(PG8_SA(0, 0), cA, cvp, 0); PG8_STAGE_A(PG8_SA(0, 1), cA, cvp, 1);
        if (wr == 1) PG8_BAR;
        PG8_WAIT_V(2); PG8_BAR;
        PG8_STAGE(PG8_SB(1, 0), cB + kstep, voffB); PG8_STAGE_A(PG8_SA(1, 0), cA + kstep, cvp, 0); PG8_STAGE(PG8_SB(1, 1), cB + hstep + kstep, voffB);
        PG8_WAIT_V(6); PG8_BAR;
    } else {
        PG8_STAGE(PG8_SB(0, 0), cB, voffB); PG8_STAGE(PG8_SA(0, 0), cA, voffA); PG8_STAGE(PG8_SB(0, 1), cB + hstep, voffB); PG8_STAGE(PG8_SA(0, 1), cA + hstep, voffA);
        if (wr == 1) PG8_BAR;
        PG8_WAIT_V(4); PG8_BAR;
        PG8_STAGE(PG8_SB(1, 0), cB + kstep, voffB); PG8_STAGE(PG8_SA(1, 0), cA + kstep, voffA); PG8_STAGE(PG8_SB(1, 1), cB + hstep + kstep, voffB);
        PG8_WAIT_V(6); PG8_BAR;
    }
    for (;;) {
        const bool has_next = S.next(ui + 1, nxt);
        if constexpr (GATHER) { if (has_next) PG8_ROWOFF(nvp, nxt); else { nvp[0] = cvp[0]; nvp[1] = cvp[1]; } } else { nvp[0] = 0u; nvp[1] = 0u; }
        const char* nA = GATHER ? (const char*)g.A : (has_next ? (const char*)g.A + (size_t)nxt.pm * tstep : cA); const char* nB = has_next ? (const char*)g.Bt + (size_t)((nxt.pm / g.gdiv) % g.gmod) * g.gstride + (size_t)nxt.pn * tstep : cB;
        for (int t = 0; t < nt; t += 2) {
            const bool last = (t == nt - 2);
            unsigned svp[2]; svp[0] = last ? nvp[0] : cvp[0]; svp[1] = last ? nvp[1] : cvp[1];
            const char* a1 = cA + (size_t)(t + 1) * kstep;
            const char* a2 = last ? nA : cA + (size_t)(t + 2) * kstep; const char* b2 = last ? nB : cB + (size_t)(t + 2) * kstep;
            const char* a3 = a2 + kstep; const char* b3 = b2 + kstep;
            if (last && has_next) S.a_ready(nxt);
            if constexpr (SP2) {
            PG8_LDB(B0, 0, 0); PG8_LDB(B1, 0, 1); PG8_SCHED; PG8_LDA(At, 0, 0); PG8_STAGE_A(PG8_SA(1, 1), a1, cvp, 1);
            PG8_WAIT_V(8); PG8_WAIT_L(0); PG8_BAR; PG8_MMA(0, 0, At, B0); PG8_MMA(0, 1, At, B1); PG8_BAR; PG8_SCHED;
            PG8_LDA(At, 0, 1); PG8_STAGE(PG8_SB(0, 0), b2, voffB); PG8_STAGE(PG8_SB(0, 1), b2 + hstep, voffB); PG8_STAGE_A(PG8_SA(0, 0), a2, svp, 0);
            PG8_WAIT_V(8); PG8_WAIT_L(0); PG8_BAR; PG8_MMA(1, 0, At, B0); PG8_MMA(1, 1, At, B1); PG8_BAR; PG8_SCHED;
            PG8_LDB(B0, 1, 0); PG8_LDB(B1, 1, 1); PG8_SCHED; PG8_LDA(At, 1, 0); PG8_STAGE_A(PG8_SA(0, 1), a2, svp, 1);
            PG8_WAIT_V(8); PG8_WAIT_L(0); PG8_BAR; PG8_MMA(0, 0, At, B0); PG8_MMA(0, 1, At, B1); PG8_BAR; PG8_SCHED;
            PG8_LDA(At, 1, 1); PG8_STAGE(PG8_SB(1, 0), b3, voffB); PG8_STAGE(PG8_SB(1, 1), b3 + hstep, voffB); PG8_STAGE_A(PG8_SA(1, 0), a3, svp, 0);
            PG8_WAIT_V(8); PG8_WAIT_L(0); PG8_BAR; PG8_MMA(1, 0, At, B0); PG8_MMA(1, 1, At, B1); PG8_BAR; PG8_SCHED;
            } else {
            PG8_LDB(B0, 0, 0); PG8_SCHED; PG8_LDA(At, 0, 0); PG8_STAGE(PG8_SA(1, 1), a1 + hstep, voffA);
            PG8_WAIT_L(8); PG8_BAR; PG8_WAIT_L(0); PG8_MMA(0, 0, At, B0); PG8_BAR; PG8_SCHED;
            PG8_LDB(B1, 0, 1); PG8_STAGE(PG8_SB(0, 0), b2, voffB);
            PG8_BAR; PG8_WAIT_L(0); PG8_MMA(0, 1, At, B1); PG8_BAR;
            PG8_LDA(At, 0, 1); PG8_STAGE(PG8_SA(0, 0), a2, voffA);
            PG8_BAR; PG8_WAIT_L(0); PG8_MMA(1, 0, At, B0); PG8_BAR; PG8_SCHED;
            PG8_STAGE(PG8_SB(0, 1), b2 + hstep, voffB);
            PG8_WAIT_V(6); PG8_BAR; PG8_MMA(1, 1, At, B1); PG8_BAR;
            PG8_LDB(B0, 1, 0); PG8_SCHED; PG8_LDA(At, 1, 0); PG8_STAGE(PG8_SA(0, 1), a2 + hstep, voffA);
            PG8_WAIT_L(8); PG8_BAR; PG8_WAIT_L(0); PG8_MMA(0, 0, At, B0); PG8_BAR; PG8_SCHED;
            PG8_LDB(B1, 1, 1); PG8_STAGE(PG8_SB(1, 0), b3, voffB);
            PG8_BAR; PG8_WAIT_L(0); PG8_MMA(0, 1, At, B1); PG8_BAR;
            PG8_LDA(At, 1, 1); PG8_STAGE(PG8_SA(1, 0), a3, voffA);
            PG8_BAR; PG8_WAIT_L(0); PG8_MMA(1, 0, At, B0); PG8_BAR; PG8_SCHED;
            PG8_STAGE(PG8_SB(1, 1), b3 + hstep, voffB);
            PG8_WAIT_V(6); PG8_BAR; PG8_MMA(1, 1, At, B1); PG8_BAR;
            }
        }
        if constexpr (ALIGN_EPI) { if (wr == 0) PG8_BAR; }
        if constexpr (!Epi::AFTER_DRAIN) { const int t_e = opaque_tid(wave_s); const int fr_e = t_e & 15, fq_e = (t_e & 63) >> 4;
            E(acc, cur, wr, wc, fr_e, fq_e); S.done(cur); }
        if (!has_next) break;
#pragma unroll
        for (int a = 0; a < 2; ++a)
#pragma unroll
            for (int b = 0; b < 2; ++b)
#pragma unroll
                for (int m = 0; m < 4; ++m)
#pragma unroll
                    for (int n = 0; n < 2; ++n) acc[a][b][m][n] = (f32x4){0.f, 0.f, 0.f, 0.f};
        cur = nxt; cA = nA; cB = nB; ++ui; if constexpr (GATHER) { cvp[0] = nvp[0]; cvp[1] = nvp[1]; }
        if constexpr (ALIGN_EPI) { if (wr == 1) PG8_BAR; }
    }
    PG8_WAIT_V(0);
    if constexpr (!ALIGN_EPI) { if (wr == 0) PG8_BAR; }
    PG8_BAR;
    if constexpr (Epi::AFTER_DRAIN) { E.fused(acc, cur, wr, wc, fr, fq, lds, wid, lane); S.done(cur); }
#undef PG8_ROWOFF
#undef PG8_STAGE_A
#undef PG8_SA
#undef PG8_SB
#undef PG8_STAGE
#undef PG8_LDA
#undef PG8_LDB
#undef PG8_MMA
#undef PG8_WAIT_V
#undef PG8_WAIT_L
#undef PG8_BAR
#undef PG8_SCHED
}
}
namespace attn_body {
using bf16=__hip_bfloat16;
using bf16x8=__attribute__((ext_vector_type(8)))short;
using s16x4=__attribute__((ext_vector_type(4)))short;
using f32x16=__attribute__((ext_vector_type(16)))float;
using u32x4=__attribute__((ext_vector_type(4)))unsigned;
constexpr int D=64;
constexpr int NW=8,QBLK=32,QB=QBLK*NW,KVBLK=64;
__device__ __forceinline__ int crow(int r,int hi){return (r&3)+8*(r>>2)+4*hi;}
#define SBAR() __builtin_amdgcn_sched_barrier(0)
__device__ __forceinline__ void cmask(f32x16&p0,f32x16&p1,int jb,int qrel,int hi){
  const float NEG=-INFINITY; int kb=64*jb+4*hi;
  #pragma unroll
  for(int r=0;r<16;++r){int kv=kb+(r&3)+8*(r>>2); if(kv>qrel)p0[r]=NEG; if(kv+32>qrel)p1[r]=NEG;}
}

constexpr int NSLOT=3, SLOTB=8192;
constexpr int LDS_K=0, LDS_V=NSLOT*SLOTB, LDS_WS=2*NSLOT*SLOTB, LDS_OST=LDS_WS+NW*64*4, LDS_BYTES=LDS_OST+NW*4096;
constexpr float C2=0.125f*1.4426950408889634f;
__device__ __forceinline__ void glds16(const void*gsrc,unsigned lds_dst){unsigned keep;
  asm volatile("s_mov_b32 %0, m0\n\ts_mov_b32 m0, %2\n\ts_nop 0\n\tglobal_load_lds_dwordx4 %1, off\n\ts_mov_b32 m0, %0":"=&s"(keep):"v"(gsrc),"s"(lds_dst):"memory");}
__device__ __forceinline__ float max3f(float a,float b,float c){float r;asm("v_max3_f32 %0, %1, %2, %3":"=v"(r):"v"(a),"v"(b),"v"(c));return r;}
__device__ __forceinline__ float max2f(float a,float b){float r;asm("v_max_f32_e32 %0, %1, %2":"=v"(r):"v"(a),"v"(b));return r;}
__device__ __forceinline__ float fadd_s(float a,float b){float r;asm("v_add_f32_e32 %0, %1, %2":"=v"(r):"v"(a),"v"(b));return r;}
__device__ __forceinline__ float fsub_s(float a,float b){float r;asm("v_sub_f32_e32 %0, %1, %2":"=v"(r):"v"(a),"v"(b));return r;}
typedef float f32x2_t __attribute__((ext_vector_type(2))); typedef __bf16 bf16x2_t __attribute__((ext_vector_type(2)));
__device__ __forceinline__ unsigned cvtpk_s(float lo,float hi){f32x2_t v={lo,hi};bf16x2_t b=__builtin_convertvector(v,bf16x2_t);return __builtin_bit_cast(unsigned,b);}
#define WAIT_BAR(N) asm volatile("s_waitcnt vmcnt(" #N ") lgkmcnt(0)\n\ts_barrier":::"memory")

__device__ __forceinline__ void qkt(f32x16&p0,f32x16&p1,const char*Kslot,const bf16x8*qr,const f32x16&negm,int r32,int hi){
  const char*kb=Kslot+hi*1024+r32*16;
  #pragma unroll
  for(int d0=0;d0<4;++d0){
    const bf16x8 b0=*reinterpret_cast<const bf16x8*>(kb+d0*2048);
    const bf16x8 b1=*reinterpret_cast<const bf16x8*>(kb+d0*2048+512);
    if(d0==0){p0=__builtin_amdgcn_mfma_f32_32x32x16_bf16(b0,qr[0],negm,0,0,0);p1=__builtin_amdgcn_mfma_f32_32x32x16_bf16(b1,qr[0],negm,0,0,0);}
    else{p0=__builtin_amdgcn_mfma_f32_32x32x16_bf16(b0,qr[d0],p0,0,0,0);p1=__builtin_amdgcn_mfma_f32_32x32x16_bf16(b1,qr[d0],p1,0,0,0);}}
}
typedef __attribute__((address_space(3))) const char* lds_cptr;
typedef short v4i16_t __attribute__((ext_vector_type(4)));
__device__ __forceinline__ void kload8(bf16x8*kf,lds_cptr kp){
  kf[0]=*(const __attribute__((address_space(3))) bf16x8*)(kp);      kf[1]=*(const __attribute__((address_space(3))) bf16x8*)(kp+512);
  kf[2]=*(const __attribute__((address_space(3))) bf16x8*)(kp+2048); kf[3]=*(const __attribute__((address_space(3))) bf16x8*)(kp+2560);
  kf[4]=*(const __attribute__((address_space(3))) bf16x8*)(kp+4096); kf[5]=*(const __attribute__((address_space(3))) bf16x8*)(kp+4608);
  kf[6]=*(const __attribute__((address_space(3))) bf16x8*)(kp+6144); kf[7]=*(const __attribute__((address_space(3))) bf16x8*)(kp+6656);
}
__device__ __forceinline__ void kload2(bf16x8*kf,lds_cptr kp,int j){ kf[2*j]=*(const __attribute__((address_space(3))) bf16x8*)(kp+j*2048); kf[2*j+1]=*(const __attribute__((address_space(3))) bf16x8*)(kp+j*2048+512); }
__device__ __forceinline__ s16x4 vtr(lds_cptr p){ return __builtin_bit_cast(s16x4,__builtin_amdgcn_ds_read_tr16_b64_v4i16((__attribute__((address_space(3))) v4i16_t*)p)); }
__device__ __forceinline__ float rowmax(const f32x16&p0,const f32x16&p1){
  float a=max3f(p0[0],p0[1],p1[0]),b=max3f(p0[2],p0[3],p1[1]);a=max3f(a,p1[2],p1[3]);
  #pragma unroll
  for(int r=4;r<16;r+=4){a=max3f(a,p0[r],p0[r+1]);b=max3f(b,p0[r+2],p0[r+3]);a=max3f(a,p1[r],p1[r+1]);b=max3f(b,p1[r+2],p1[r+3]);}
  const float m=max2f(a,b);
  auto rr=__builtin_amdgcn_permlane32_swap(__float_as_uint(m),__float_as_uint(m),false,false);
  return max2f(__uint_as_float(rr[0]),__uint_as_float(rr[1]));
}
__device__ __forceinline__ void pv(f32x16*o,int vb,bf16x8 pa0,bf16x8 pa1,bf16x8 pa2,bf16x8 pa3){
  #pragma unroll
  for(int d0=0;d0<2;++d0){s16x4 lo[4],hi[4];
    #pragma unroll
    for(int ks=0;ks<4;++ks){
      asm volatile("ds_read_b64_tr_b16 %0,%1 offset:%c2":"=&v"(lo[ks]):"v"(vb),"i"(d0*4096+ks*1024):"memory");
      asm volatile("ds_read_b64_tr_b16 %0,%1 offset:%c2":"=&v"(hi[ks]):"v"(vb),"i"(d0*4096+ks*1024+512):"memory");}
    asm volatile("s_waitcnt lgkmcnt(0)":::"memory");SBAR();
    #define PK(k) (bf16x8){lo[k][0],lo[k][1],lo[k][2],lo[k][3],hi[k][0],hi[k][1],hi[k][2],hi[k][3]}
    o[d0]=__builtin_amdgcn_mfma_f32_32x32x16_bf16(pa0,PK(0),o[d0],0,0,0);
    o[d0]=__builtin_amdgcn_mfma_f32_32x32x16_bf16(pa1,PK(1),o[d0],0,0,0);
    o[d0]=__builtin_amdgcn_mfma_f32_32x32x16_bf16(pa2,PK(2),o[d0],0,0,0);
    o[d0]=__builtin_amdgcn_mfma_f32_32x32x16_bf16(pa3,PK(3),o[d0],0,0,0);
    #undef PK
  }
}

#ifndef ATTN_STORE16
#define ATTN_STORE16(p,v) (*(u32x4*)(p)=(v))
#endif
template<int THRL,int QP,int KP,int OP> __device__ __forceinline__ void attn_unit(const bf16*Qu,const bf16*__restrict__ Kh,const bf16*__restrict__ Vh,bf16*Ou,const int NT,char*shm,int wave_s){
  const int tid=opaque_tid(wave_s),lane=tid&63,r32=lane&31,hi=lane>>5; const int wid=__builtin_amdgcn_readfirstlane(tid>>6);
  const bf16*Qw=Qu+(long)(wid*QBLK)*QP;
  const unsigned lds0=(unsigned)(uintptr_t)shm;
  float*wsf=(float*)(shm+LDS_WS)+wid*64;
  const bf16*ksrc=Kh+(long)lane*KP+wid*8;
  const bf16*vsrc=Vh+(long)(16*(wid&3)+(lane>>2))*KP+(wid>>2)*32+(lane&3)*8;
  const unsigned kdst=lds0+LDS_K+wid*1024, vdst=lds0+LDS_V+wid*1024;
  #define DMA_K(t,slot) glds16(ksrc+(long)(t)*KVBLK*KP,(unsigned)__builtin_amdgcn_readfirstlane(kdst+(slot)))
  #define DMA_V(t,slot) glds16(vsrc+(long)(t)*KVBLK*KP,(unsigned)__builtin_amdgcn_readfirstlane(vdst+(slot)))
  const int vb0=(int)(lds0+LDS_V)+((lane>>4)&1)*32+(lane&3)*8+(4*hi+((lane&15)>>2))*64;
  const char*Kbase=shm+LDS_K; bf16x8 kf[8];
  const lds_cptr shm3=(lds_cptr)shm; const lds_cptr kp0=shm3+LDS_K+hi*1024+r32*16; const lds_cptr vp0=shm3+LDS_V+((lane>>4)&1)*32+(lane&3)*8+(4*hi+((lane&15)>>2))*64;
  DMA_K(0,0);DMA_V(0,0);DMA_K(1,SLOTB);
  bf16x8 qr[4];
  #pragma unroll
  for(int d0=0;d0<4;++d0)qr[d0]=*reinterpret_cast<const bf16x8*>(&Qw[(long)r32*QP+d0*16+hi*8]);
  float mhat=0.f,l_reg=0.f;f32x16 o[2];o[0]=f32x16{};o[1]=f32x16{};f32x16 negm=f32x16{};asm volatile("":"+v"(negm));
  #define CMASK(P0,P1,t) do{}while(0)
  bool resc=false;
  #define START(P0,P1) do{ const float rm=(THRL<0)?14.0f:rowmax(P0,P1); resc=false; \
    { const float dl=rm; mhat=fadd_s(mhat,dl); \
      _Pragma("unroll") for(int r=0;r<16;++r){P0[r]=fsub_s(P0[r],dl);P1[r]=fsub_s(P1[r],dl);} \
      _Pragma("unroll") for(int r=0;r<16;++r)negm[r]=-mhat; asm volatile("":"+v"(negm)); } \
    _Pragma("unroll") for(int r=0;r<16;++r)P0[r]=__builtin_amdgcn_exp2f(P0[r]); }while(0)
  #define RESC() do{ if(resc){ asm volatile("s_waitcnt lgkmcnt(0)":::"memory"); \
      _Pragma("unroll") for(int d_=0;d_<2;++d_) _Pragma("unroll") for(int r=0;r<16;++r)o[d_][r]*=wsf[crow(r,hi)]; } }while(0)
  f32x16 pA0,pA1,pB0,pB1;
  int sl_prev=0,sl_cur=0,sl_next=SLOTB;
  #define ROT() do{sl_prev=sl_cur;sl_cur=sl_next;sl_next=(sl_next==(NSLOT-1)*SLOTB)?0:sl_next+SLOTB;}while(0)
  DMA_K(2,2*SLOTB);
  WAIT_BAR(3);
  qkt(pA0,pA1,Kbase,qr,negm,r32,hi);asm volatile("s_nop 15\n\ts_nop 7":"+v"(pA0),"+v"(pA1));CMASK(pA0,pA1,0);
  START(pA0,pA1);
  _Pragma("unroll") for(int r=0;r<16;++r)pA1[r]=__builtin_amdgcn_exp2f(pA1[r]);
  WAIT_BAR(0);
  DMA_K(3,0);DMA_V(1,SLOTB);
  ROT();
  kload8(kf,kp0+sl_cur);
  WAIT_BAR(2);
  s16x4 vlo[8],vhi[8]; u32x4 pw0,pw1,pw2,pw3;
  #define PKW(P,B) cvtpk_s(P[B],P[B+1])
  #define PAF(k) __builtin_bit_cast(bf16x8,pw##k)
  #define VFR(i) (bf16x8){vlo[i][0],vlo[i][1],vlo[i][2],vlo[i][3],vhi[i][0],vhi[i][1],vhi[i][2],vhi[i][3]}
  #define PIN(x) asm volatile("":"+v"(x))
  #define MX3(a,b,c) __builtin_fmaxf(__builtin_fmaxf((a),(b)),(c))
  #define GAPA(MF,A0,A1,A2,A3,W0,W1,PW) do{ MF; sacc2+=(f32x2_t){A0,A1}; sacc2+=(f32x2_t){A2,A3}; PIN(sacc2); W0; W1; PIN(PW); SBAR(); }while(0)
  #define EX(v) __builtin_amdgcn_exp2f(v)
  #define GAPB(MF,X,B) do{ MF; X[B]=EX(X[B]); X[B+1]=EX(X[B+1]); X[B+2]=EX(X[B+2]); X[B+3]=EX(X[B+3]); PIN(X); SBAR(); }while(0)
  #define VRD(i) do{ vlo[i]=vtr(vp_+(((i)>>2)*4096+((i)&3)*1024)); vhi[i]=vtr(vp_+(((i)>>2)*4096+((i)&3)*1024+512)); }while(0)
  #define KRD(G,j) do{ if(G){ kload2(kf,kp0+sl_next,j); SBAR(); } }while(0)
  #define STEP(C0,C1,P0,P1,t,GK,GV,GL) do{ SBAR(); \
    const lds_cptr vp_=vp0+sl_prev; \
    VRD(0); SBAR(); f32x2_t sacc2=(f32x2_t){P0[0],P0[1]}; \
    GAPA(C0=__builtin_amdgcn_mfma_f32_32x32x16_bf16(kf[0],qr[0],negm,0,0,0), P0[2],P0[3],P0[4],P0[5],     pw0[0]=PKW(P0,0), pw0[1]=PKW(P0,2), pw0); \
    VRD(4); SBAR(); GAPA(C1=__builtin_amdgcn_mfma_f32_32x32x16_bf16(kf[1],qr[0],negm,0,0,0), P0[6],P0[7],P0[8],P0[9],     pw0[2]=PKW(P0,4), pw0[3]=PKW(P0,6), pw0); \
    VRD(1); SBAR(); GAPA(C0=__builtin_amdgcn_mfma_f32_32x32x16_bf16(kf[2],qr[1],C0,0,0,0),   P0[10],P0[11],P0[12],P0[13], pw1[0]=PKW(P0,8), pw1[1]=PKW(P0,10), pw1); \
    VRD(5); SBAR(); GAPA(C1=__builtin_amdgcn_mfma_f32_32x32x16_bf16(kf[3],qr[1],C1,0,0,0),   P0[14],P0[15],P1[0],P1[1],   pw1[2]=PKW(P0,12),pw1[3]=PKW(P0,14), pw1); \
    VRD(2); SBAR(); GAPA(C0=__builtin_amdgcn_mfma_f32_32x32x16_bf16(kf[4],qr[2],C0,0,0,0),   P1[2],P1[3],P1[4],P1[5],     pw2[0]=PKW(P1,0), pw2[1]=PKW(P1,2), pw2); \
    VRD(6); SBAR(); GAPA(C1=__builtin_amdgcn_mfma_f32_32x32x16_bf16(kf[5],qr[2],C1,0,0,0),   P1[6],P1[7],P1[8],P1[9],     pw2[2]=PKW(P1,4), pw2[3]=PKW(P1,6), pw2); \
    VRD(3); SBAR(); GAPA(C0=__builtin_amdgcn_mfma_f32_32x32x16_bf16(kf[6],qr[3],C0,0,0,0),   P1[10],P1[11],P1[12],P1[13], pw3[0]=PKW(P1,8), pw3[1]=PKW(P1,10), pw3); \
    VRD(7); SBAR(); GAPA(C1=__builtin_amdgcn_mfma_f32_32x32x16_bf16(kf[7],qr[3],C1,0,0,0),   P1[14],P1[15],0.f,0.f,       pw3[2]=PKW(P1,12),pw3[3]=PKW(P1,14), pw3); \
    l_reg+=sacc2.x+sacc2.y; \
    if(GK){DMA_K((t)+3,sl_cur);} if(GV){DMA_V((t)+1,sl_next);} \
    CMASK(C0,C1,t); \
    if constexpr (THRL>=0) { float a=MX3(C0[0],C0[1],C1[0]),b=MX3(C0[2],C0[3],C1[1]); a=MX3(a,C1[2],C1[3]); \
      _Pragma("unroll") for(int r=4;r<16;r+=4){a=MX3(a,C0[r],C0[r+1]);b=MX3(b,C0[r+2],C0[r+3]);a=MX3(a,C1[r],C1[r+1]);b=MX3(b,C1[r+2],C1[r+3]);} \
      float rm=__builtin_fmaxf(a,b); { auto rr=__builtin_amdgcn_permlane32_swap(__float_as_uint(rm),__float_as_uint(rm),false,false); rm=__builtin_fmaxf(__uint_as_float(rr[0]),__uint_as_float(rr[1])); } \
      resc=false; \
      if(__builtin_expect(__any(rm>(float)THRL),0)){ const float dl=__builtin_fmaxf(rm,0.f); mhat+=dl; \
        _Pragma("unroll") for(int r=0;r<16;++r){C0[r]-=dl;C1[r]-=dl;} \
        _Pragma("unroll") for(int r=0;r<16;++r)negm[r]=-mhat; asm volatile("":"+v"(negm)); \
        const float f=__builtin_amdgcn_exp2f(-dl); l_reg*=f; if(hi==0)wsf[r32]=f; resc=true; } } \
    SBAR(); \
    GAPB(o[0]=__builtin_amdgcn_mfma_f32_32x32x16_bf16(PAF(0),VFR(0),o[0],0,0,0), C0,0); \
    GAPB(o[1]=__builtin_amdgcn_mfma_f32_32x32x16_bf16(PAF(0),VFR(4),o[1],0,0,0), C0,4); \
    KRD(GL,0); GAPB(o[0]=__builtin_amdgcn_mfma_f32_32x32x16_bf16(PAF(1),VFR(1),o[0],0,0,0), C0,8); \
    KRD(GL,1); GAPB(o[1]=__builtin_amdgcn_mfma_f32_32x32x16_bf16(PAF(1),VFR(5),o[1],0,0,0), C0,12); \
    KRD(GL,2); GAPB(o[0]=__builtin_amdgcn_mfma_f32_32x32x16_bf16(PAF(2),VFR(2),o[0],0,0,0), C1,0); \
    KRD(GL,3); GAPB(o[1]=__builtin_amdgcn_mfma_f32_32x32x16_bf16(PAF(2),VFR(6),o[1],0,0,0), C1,4); \
    GAPB(o[0]=__builtin_amdgcn_mfma_f32_32x32x16_bf16(PAF(3),VFR(3),o[0],0,0,0), C1,8); \
    GAPB(o[1]=__builtin_amdgcn_mfma_f32_32x32x16_bf16(PAF(3),VFR(7),o[1],0,0,0), C1,12); \
    }while(0)
  int t=1;
  #undef CMASK
  #define CMASK(P0,P1,t) do{}while(0)
  for(;t+5<NT;t+=2){
    STEP(pB0,pB1,pA0,pA1,t,true,true,true);     WAIT_BAR(2); RESC(); ROT();
    STEP(pA0,pA1,pB0,pB1,t+1,true,true,true);   WAIT_BAR(2); RESC(); ROT();
  }
  #undef CMASK
  #define CMASK(P0,P1,t) do{}while(0)
  #define ENDW(tt) do{ if((tt)+3<NT){WAIT_BAR(2);} else if((tt)+2<NT){WAIT_BAR(1);} else {WAIT_BAR(0);} }while(0)
  for(;t+1<NT;t+=2){
    STEP(pB0,pB1,pA0,pA1,t,(t+3<NT),(t+1<NT),(t+1<NT));       ENDW(t);   RESC(); ROT();
    STEP(pA0,pA1,pB0,pB1,t+1,(t+4<NT),(t+2<NT),(t+2<NT));     ENDW(t+1); RESC(); ROT();
  }
  STEP(pB0,pB1,pA0,pA1,NT-1,false,false,false); RESC();
  { float sacc=pB0[0]+pB0[1]; _Pragma("unroll") for(int r=2;r<16;++r)sacc+=pB0[r]; _Pragma("unroll") for(int r=0;r<16;++r)sacc+=pB1[r]; l_reg+=sacc;
    pw0=(u32x4){PKW(pB0,0),PKW(pB0,2),PKW(pB0,4),PKW(pB0,6)};pw1=(u32x4){PKW(pB0,8),PKW(pB0,10),PKW(pB0,12),PKW(pB0,14)};pw2=(u32x4){PKW(pB1,0),PKW(pB1,2),PKW(pB1,4),PKW(pB1,6)};pw3=(u32x4){PKW(pB1,8),PKW(pB1,10),PKW(pB1,12),PKW(pB1,14)};
    SBAR(); pv(o,vb0+sl_cur,PAF(0),PAF(1),PAF(2),PAF(3)); }
  #undef PKW
  #undef PAF
  #undef VFR
  #undef PIN
  #undef MX3
  #undef GAPA
  #undef GAPB
  #undef EX
  #undef VRD
  #undef KRD
  #undef STEP
  #undef ENDW
  {auto rr=__builtin_amdgcn_permlane32_swap(__float_as_uint(l_reg),__float_as_uint(l_reg),false,false);l_reg=__uint_as_float(rr[0])+__uint_as_float(rr[1]);}
  if(hi==0)wsf[32+r32]=l_reg;asm volatile("s_waitcnt lgkmcnt(0)":::"memory");
  float rli[16];
  #pragma unroll
  for(int r=0;r<16;++r)rli[r]=__builtin_amdgcn_rcpf(wsf[32+crow(r,hi)]);
  bf16*Ow=Ou+(long)(wid*QBLK)*OP;
  { bf16*stg=(bf16*)(shm+LDS_OST)+wid*2048;
    #pragma unroll
    for(int r=0;r<16;++r){const int orow=crow(r,hi);
      #pragma unroll
      for(int d0=0;d0<2;++d0)stg[orow*64+d0*32+r32]=__float2bfloat16(o[d0][r]*rli[r]);}
    asm volatile("s_waitcnt lgkmcnt(0)":::"memory");
    #pragma unroll
    for(int i=0;i<4;++i){const int row=i*8+(lane>>3),ch=lane&7; const u32x4 v=*(const u32x4*)(stg+row*64+ch*8); ATTN_STORE16(Ow+(long)row*OP+ch*8,v);} }
  asm volatile("s_waitcnt lgkmcnt(0)\n\ts_barrier":::"memory");
  #undef DMA_K
  #undef DMA_V
  #undef CMASK
  #undef START
  #undef RESC
  #undef ROT
}
constexpr int ATTN_LDS_BYTES=LDS_BYTES;
#undef SBAR
#undef WAIT_BAR
}
#define LDS_WAIT() asm volatile("s_waitcnt lgkmcnt(0)" ::: "memory")

__device__ __forceinline__ void transpose_item(const float* W, int K, int N, bf16* WT, int k0, int n0, int dest_row0, LAS float* scr, int lane) {
    float t_[32];
#pragma unroll
    for (int i = 0; i < 32; ++i) t_[i] = W[(size_t)(k0 + 2 * i + (lane >> 5)) * N + n0 + (lane & 31)];
#pragma unroll
    for (int i = 0; i < 32; ++i) scr[(2 * i + (lane >> 5)) * 33 + (lane & 31)] = t_[i];
    LDS_WAIT(); asm volatile("" ::: "memory");
    const int c = lane & 7;
#pragma unroll
    for (int j = 0; j < 4; ++j) { const int n = (lane >> 3) + 8 * j; const LAS float* s = scr + (8 * c) * 33 + n;
        v4u o; o.x = pk2(s[0 * 33], s[1 * 33]); o.y = pk2(s[2 * 33], s[3 * 33]); o.z = pk2(s[4 * 33], s[5 * 33]); o.w = pk2(s[6 * 33], s[7 * 33]);
        *(GAS v4u*)(WT + (size_t)(dest_row0 + n) * K + k0 + 8 * c) = o; }
    LDS_WAIT(); asm volatile("" ::: "memory");
}

template <int KMODE>
__device__ __forceinline__ void transpose_item8(const float* W, int K, int N, unsigned char* WT, int k0, int n0, int dest_row0, float sc, LAS float* scr, int lane) {
    float t_[32];
#pragma unroll
    for (int i = 0; i < 32; ++i) t_[i] = W[(size_t)(k0 + 2 * i + (lane >> 5)) * N + n0 + (lane & 31)];
#pragma unroll
    for (int i = 0; i < 32; ++i) scr[(2 * i + (lane >> 5)) * 33 + (lane & 31)] = __builtin_amdgcn_fmed3f(t_[i] * sc, -448.f, 448.f);
    LDS_WAIT(); asm volatile("" ::: "memory");
    const int c = lane & 7, w = c >> 2, fq = c & 3, wh = (k0 >> 6) & 1;
    const int doff = KMODE == 1 ? (k0 & ~255) + 64 * (2 * wh + w) + 16 * fq + 8 * ((k0 >> 7) & 1) : KMODE == 2 ? (k0 & ~127) + 32 * (2 * wh + w) + 8 * fq : k0 + 8 * c;
#pragma unroll
    for (int j = 0; j < 4; ++j) { const int n = (lane >> 3) + 8 * j; const LAS float* s = scr + n;
        float v[8];
#pragma unroll
        for (int e = 0; e < 8; ++e) { const int kk = KMODE == 2 ? 32 * w + 16 * (e >> 2) + 4 * fq + (e & 3) : 8 * c + e; v[e] = s[kk * 33]; }
        unsigned w0 = 0, w1 = 0;
        w0 = __builtin_amdgcn_cvt_pk_fp8_f32(v[0], v[1], w0, false); w0 = __builtin_amdgcn_cvt_pk_fp8_f32(v[2], v[3], w0, true);
        w1 = __builtin_amdgcn_cvt_pk_fp8_f32(v[4], v[5], w1, false); w1 = __builtin_amdgcn_cvt_pk_fp8_f32(v[6], v[7], w1, true);
        *(GAS v2u*)(WT + (size_t)(dest_row0 + n) * K + doff) = (v2u){w0, w1}; }
    LDS_WAIT(); asm volatile("" ::: "memory");
}

struct ProIn { const float *hy_w_in, *at_w_in, *w_out, *w_mem_kv; };
__device__ __forceinline__ void phase_weights(const ProIn& P, unsigned char* ws, LAS unsigned char* lds, int gw, int NGW, int wave, int lane) {
    LAS float* scr = (LAS float*)(lds + wave * 16384);
    constexpr int I_HY = 16 * 80, I_AT = 16 * 48, I_OUT = 16 * 32, I_MKV = 16 * 16;
    constexpr int E0 = 2 * I_HY, E1 = E0 + 2 * I_AT, E2 = E1 + 4 * I_OUT, E3 = E2 + 4 * I_MKV;
    for (int it = gw; it < E3; it += NGW) {
        int r = it;
        if (r < E0) { const int j = r / I_HY, q = r % I_HY, kb = q / 80, nb = q % 80;
            transpose_item(P.hy_w_in + (size_t)j * DM * D_IN_HY, DM, D_IN_HY, (bf16*)(ws + WS_WHY) + (size_t)j * D_IN_HY * DM, 64 * kb, 32 * nb, 32 * nb, scr, lane); continue; }
        r -= E0;
        if (r < 2 * I_AT) { const int j = r / I_AT, q = r % I_AT, kb = q / 48, nb = q % 48;
            const int n0 = 32 * nb, o = n0 & 255;
            transpose_item(P.at_w_in + (size_t)j * DM * D_IN_AT, DM, D_IN_AT, (bf16*)(ws + WS_WAT) + (size_t)j * D_IN_AT * DM, 64 * kb, n0, (n0 & ~255) + 128 * ((o & 63) >> 5) + 32 * (o >> 6), scr, lane); continue; }
        r -= 2 * I_AT;
        if (r < 4 * I_OUT) { const int j = r / I_OUT, q = r % I_OUT, kb = q / 32, nb = q % 32;
            transpose_item(P.w_out + (size_t)j * DM * DM, DM, DM, (bf16*)(ws + WS_WOUT) + (size_t)j * DM * DM, 64 * kb, 32 * nb, 32 * nb, scr, lane); continue; }
        r -= 4 * I_OUT;
        { const int j = r / I_MKV, q = r % I_MKV, kb = q / 16, nb = q % 16;
            transpose_item(P.w_mem_kv + (size_t)j * DM * 512, DM, 512, (bf16*)(ws + WS_WMKV), 64 * kb, 32 * nb, j * 512 + 32 * nb, scr, lane); }
        (void)r;
    }
}

struct XwIn { const float *w_gate, *w_up, *w_down; unsigned char* ws; };
constexpr int XW_PER_EXPERT = 3 * 384, XW_PER_LAYER = NEXP * XW_PER_EXPERT;
constexpr int XW_QA_HY = 5, XW_QA_AT = 4, XW_QB = 3, XW_NA = 128 * NWAVES, XW_NB = 224 * NWAVES;
__host__ __device__ constexpr int xw_qa(int layer) { return (layer & 1) ? XW_QA_AT : XW_QA_HY; }
__host__ __device__ constexpr int xw_p0(int layer, bool sched) { return sched ? XW_PER_LAYER - xw_qa(layer) * XW_NA - XW_QB * XW_NB : XW_PER_LAYER; }
__device__ __forceinline__ void xw_item(const XwIn& B, int layer, int r, LAS float* scr, int lane) {
    const int j = layer * NEXP + r / XW_PER_EXPERT, q = r % XW_PER_EXPERT, kind = q / 384, qq = q % 384;
    if (kind < 2) { const int kb = qq / 24, nb = qq % 24, n0 = 32 * nb;
        transpose_item8<1>((kind == 0 ? B.w_gate : B.w_up) + (size_t)j * DM * EFF, DM, EFF, B.ws + WS_W1 + (size_t)j * 1536 * DM, 64 * kb, n0, (n0 >> 7) * 256 + 128 * kind + (n0 & 127), W8_SCALE, scr, lane); }
    else { const int kb = qq / 32, nb = qq % 32;
        transpose_item8<2>(B.w_down + (size_t)j * EFF * DM, EFF, DM, B.ws + WS_W2 + (size_t)j * DM * EFF, 64 * kb, 32 * nb, 32 * nb, W8_SCALE, scr, lane); }
}
__device__ __forceinline__ void phase_xw_p0(const XwIn& B, bool sched, LAS float* scr, int gw, int NGW, int lane) {
#pragma unroll 1
    for (int layer = 0; layer < DEPTH; ++layer) { const int n = xw_p0(layer, sched);
#pragma unroll 1
        for (int r = gw; r < n; r += NGW) xw_item(B, layer, r, scr, lane); }
}
__device__ __forceinline__ void xw_slice_a(const XwIn& B, int layer, LAS float* scr, int bx, int wave, int lane) {
    const int base = xw_p0(layer, true) + (bx - 128) * NWAVES + wave;
#pragma unroll 1
    for (int k = 0; k < xw_qa(layer); ++k) xw_item(B, layer, base + k * XW_NA, scr, lane);
}
__device__ __forceinline__ void xw_slice_b(const XwIn& B, int layer, LAS float* scr, int bx, int wave, int lane) {
    const int base = xw_p0(layer, true) + xw_qa(layer) * XW_NA + (bx - 32) * NWAVES + wave;
#pragma unroll 1
    for (int k = 0; k < XW_QB; ++k) xw_item(B, layer, base + k * XW_NB, scr, lane);
}

__device__ __forceinline__ void phase_wrg(const float* ffn_g, const float* router, float* WRG, int gtid, int nthreads) {
    for (int q = gtid; q < DEPTH * NEXP * DM; q += nthreads) { const int l = q / (NEXP * DM), e = (q / DM) % NEXP, d = q % DM; WRG[q] = ffn_g[l * DM + d] * router[((size_t)l * DM + d) * NEXP + e]; }
}

__device__ __forceinline__ void rms_row_bf16(const float* xrow, const float* g, bf16* orow, int lane) {
    const GAS f32x4* xr = (const GAS f32x4*)xrow + lane; const GAS f32x4* gr = (const GAS f32x4*)g + lane;
    f32x4 v[4]; float s = 0.f;
#pragma unroll
    for (int j = 0; j < 4; ++j) { v[j] = xr[64 * j]; s += (v[j].x * v[j].x + v[j].y * v[j].y) + (v[j].z * v[j].z + v[j].w * v[j].w); }
    const float rstd = 1.f / sqrtf(wave_sum(s) * (1.f / DM) + NORM_EPS);
    GAS v2u* o8 = (GAS v2u*)orow + lane;
#pragma unroll
    for (int j = 0; j < 4; ++j) { const f32x4 gg = gr[64 * j]; v2u w; w.x = pk2(v[j].x * rstd * gg.x, v[j].y * rstd * gg.y); w.y = pk2(v[j].z * rstd * gg.z, v[j].w * rstd * gg.w); o8[64 * j] = w; }
}

__device__ __forceinline__ void phase_mem_h2(const float* mem, const float* mem_g, const float* fw1, const float* fb1, const float* fw2, const float* fb2, const float* ffreq,
                                              unsigned char* ws, int gw, int NGW, int lane) {
    for (int m = gw; m < BATCH * MEM_LEN; m += NGW) rms_row_bf16(mem + (size_t)m * DM, mem_g, (bf16*)(ws + WS_MEMN) + (size_t)m * DM, lane);
    float* H2 = (float*)(ws + WS_H2);
    for (int it = gw; it < 2 * SEQ; it += NGW) {
        const int j = it / SEQ, n = it % SEQ;
        const float* w1 = fw1 + j * HY_EMB * HY_FILT; const float* w2 = fw2 + j * HY_FILT * HY_FILT;
        const float t = (float)n * (1.0f / (float)(SEQ - 1));
        const float w = (6.283185307179586f * (float)n) / (float)SEQ;
        float feat = 0.f;
        if (lane == 0) feat = t;
        else if (lane <= 16) { const float band = 1e-4f + (float)(lane - 1) * ((15.0f - 1e-4f) / 15.0f); feat = cosf(band * w); }
        else if (lane <= 32) { const float band = 1e-4f + (float)(lane - 17) * ((15.0f - 1e-4f) / 15.0f); feat = -sinf(band * w); }
        const float fr = ffreq[j * HY_FILT + lane];
        float a = fb1[j * HY_FILT + lane];
        for (int i = 0; i < HY_EMB; ++i) a += __shfl(feat, i) * w1[i * HY_FILT + lane];
        const float h1 = sinf(fr * a);
        float a2 = fb2[j * HY_FILT + lane];
        for (int i = 0; i < HY_FILT; ++i) a2 += __shfl(h1, i) * w2[i * HY_FILT + lane];
        H2[(size_t)it * HY_FILT + lane] = sinf(fr * a2);
    }
}

template <bool COMBINE, bool FINAL>
__device__ __forceinline__ void phase_norm(const float* hin, float* hout, const float* g, bf16* U, float* fout, const int* POS, const bf16* Y, int gw, int NGW, int lane) {
    int m = gw;
    if (m >= M_TOK) return;
    f32x4 cur[4]; int cpos = -1;
    { const GAS f32x4* xr = (const GAS f32x4*)(hin + (size_t)m * DM) + lane;
#pragma unroll
      for (int j = 0; j < 4; ++j) cur[j] = xr[64 * j];
      if (COMBINE) { const int b = m / SEQ, t = m % SEQ; if (lane < NEXP) cpos = POS[(size_t)(b * NEXP + lane) * SEQ + t]; } }
#pragma unroll 1
    for (; m < M_TOK; m += NGW) {
        const int mn = m + NGW; f32x4 nxt[4]; int npos = -1;
#pragma unroll
        for (int j = 0; j < 4; ++j) nxt[j] = cur[j];
        if (mn < M_TOK) { const GAS f32x4* xr = (const GAS f32x4*)(hin + (size_t)mn * DM) + lane;
#pragma unroll
            for (int j = 0; j < 4; ++j) nxt[j] = xr[64 * j];
            if (COMBINE) { const int b = mn / SEQ, t = mn % SEQ; if (lane < NEXP) npos = POS[(size_t)(b * NEXP + lane) * SEQ + t]; } }
        f32x4 v[4];
#pragma unroll
        for (int j = 0; j < 4; ++j) v[j] = cur[j];
        if (COMBINE) {
            const int b = m / SEQ;
            unsigned long long mask = __ballot(cpos >= 0);
            while (mask) {
                v2u y[4][4]; bool has[4];
#pragma unroll
                for (int k = 0; k < 4; ++k) { has[k] = mask != 0ull;
                    if (has[k]) { const int e = __builtin_amdgcn_readfirstlane(__builtin_ctzll(mask)); mask &= mask - 1ull; const int p = __builtin_amdgcn_readlane(cpos, e);
                        const GAS v2u* yr = (const GAS v2u*)(Y + ((size_t)(b * NEXP + e) * CAP + p) * DM) + lane;
#pragma unroll
                        for (int j = 0; j < 4; ++j) y[k][j] = yr[64 * j]; } }
#pragma unroll
                for (int k = 0; k < 4; ++k) if (has[k]) {
#pragma unroll
                    for (int j = 0; j < 4; ++j) { const v2u w = y[k][j]; v[j].x += bflo(w.x); v[j].y += bfhi(w.x); v[j].z += bflo(w.y); v[j].w += bfhi(w.y); } }
            }
            if (!FINAL) { GAS f32x4* ho = (GAS f32x4*)(hout + (size_t)m * DM) + lane;
#pragma unroll
                for (int j = 0; j < 4; ++j) ho[64 * j] = v[j]; }
        }
        float s = 0.f;
#pragma unroll
        for (int j = 0; j < 4; ++j) s += (v[j].x * v[j].x + v[j].y * v[j].y) + (v[j].z * v[j].z + v[j].w * v[j].w);
        const float rstd = 1.f / sqrtf(wave_sum(s) * (1.f / DM) + NORM_EPS);
        const GAS f32x4* gr = (const GAS f32x4*)g + lane;
        if (FINAL) { GAS f32x4* o = (GAS f32x4*)(fout + (size_t)m * DM) + lane;
#pragma unroll
            for (int j = 0; j < 4; ++j) o[64 * j] = v[j] * rstd * gr[64 * j]; }
        else { GAS v2u* o8 = (GAS v2u*)(U + (size_t)m * DM) + lane;
#pragma unroll
            for (int j = 0; j < 4; ++j) { const f32x4 gg = gr[64 * j]; v2u w; w.x = pk2(v[j].x * rstd * gg.x, v[j].y * rstd * gg.y); w.y = pk2(v[j].z * rstd * gg.z, v[j].w * rstd * gg.w); o8[64 * j] = w; } }
#pragma unroll
        for (int j = 0; j < 4; ++j) cur[j] = nxt[j];
        cpos = npos;
    }
}

__device__ __forceinline__ void phase_ffn_norm_router(const float* H, const float* g, const float* Wr, unsigned char* XN8, float* AFF, LAS unsigned char* lds, int gw, int NGW, int lane, int tid) {
    LAS f32x4* WL = (LAS f32x4*)lds;
    for (int q = tid; q < 64 * 64; q += NTHREADS) { const int ln = q & 63, s = q >> 6, e4 = s & 3, ji = s >> 2, i = ji & 3, j = ji >> 2; const int d = 4 * ln + i + 256 * j;
        WL[q] = *(const GAS f32x4*)(Wr + (size_t)d * NEXP + 4 * e4); }
    __syncthreads();
    constexpr int R = 4;
    const GAS f32x4* gr = (const GAS f32x4*)g + lane;
#pragma unroll 1
    for (int m0 = gw * R; m0 < M_TOK; m0 += NGW * R) {
        int lo_ = lane; asm volatile("" : "+v"(lo_));
        f32x4 v[R][4]; float rstd[R];
#pragma unroll
        for (int r = 0; r < R; ++r) { const GAS f32x4* xr = (const GAS f32x4*)(H + (size_t)(m0 + r) * DM) + lane;
#pragma unroll
            for (int j = 0; j < 4; ++j) v[r][j] = xr[64 * j]; }
#pragma unroll
        for (int r = 0; r < R; ++r) { float s = 0.f;
#pragma unroll
            for (int j = 0; j < 4; ++j) s += (v[r][j].x * v[r][j].x + v[r][j].y * v[r][j].y) + (v[r][j].z * v[r][j].z + v[r][j].w * v[r][j].w);
            rstd[r] = 1.f / sqrtf(wave_sum(s) * (1.f / DM) + NORM_EPS); }
        f32x4 lg[R][4];
#pragma unroll
        for (int r = 0; r < R; ++r)
#pragma unroll
            for (int e4 = 0; e4 < 4; ++e4) lg[r][e4] = (f32x4){0.f, 0.f, 0.f, 0.f};
#pragma unroll
        for (int j = 0; j < 4; ++j) { const f32x4 gg = gr[64 * j];
#pragma unroll
            for (int r = 0; r < R; ++r) { v[r][j] = v[r][j] * rstd[r] * gg;
                unsigned w = 0; w = __builtin_amdgcn_cvt_pk_fp8_f32(v[r][j].x, v[r][j].y, w, false); w = __builtin_amdgcn_cvt_pk_fp8_f32(v[r][j].z, v[r][j].w, w, true);
                ((GAS unsigned*)(XN8 + (size_t)(m0 + r) * DM) + lane)[64 * j] = w; }
#pragma unroll
            for (int i = 0; i < 4; ++i)
#pragma unroll
                for (int e4 = 0; e4 < 4; ++e4) { const f32x4 wv = WL[((j * 4 + i) * 4 + e4) * 64 + lo_];
#pragma unroll
                    for (int r = 0; r < R; ++r) { const float xs = v[r][j][i];
#pragma unroll
                        for (int c = 0; c < 4; ++c) asm("v_fmac_f32 %0, %1, %2" : "+v"(lg[r][e4][c]) : "v"(wv[c]), "v"(xs)); } }
            __builtin_amdgcn_sched_barrier(0); }
#pragma unroll
        for (int r = 0; r < R; ++r) {
            float l16[16];
#pragma unroll
            for (int e = 0; e < 16; ++e) l16[e] = wave_sum(lg[r][e >> 2][e & 3]);
            float mx = l16[0];
#pragma unroll
            for (int e = 1; e < 16; ++e) mx = fmaxf(mx, l16[e]);
            float den = 0.f;
#pragma unroll
            for (int e = 0; e < 16; ++e) { l16[e] = expf(l16[e] - mx); den += l16[e]; }
            float mine = 0.f;
#pragma unroll
            for (int e = 0; e < 16; ++e) mine = (lane == e) ? l16[e] : mine;
            const int m = m0 + r, b = m / SEQ, t = m % SEQ;
            if (lane < NEXP) AFF[(size_t)(b * NEXP + lane) * SEQ + t] = mine / den;
        }
    }
    __syncthreads();
}

__device__ __forceinline__ void phase_router_sum(const float* PLG, const float* PSS, float* RSTD, float* AFF, int gw, int NGW, int lane) {
    const int e = lane & 15, rq = lane >> 4;
    for (int m0 = gw * 4; m0 < M_TOK; m0 += NGW * 4) {
        const int m = m0 + rq;
        float lgt = 0.f;
#pragma unroll
        for (int slot = 0; slot < 16; ++slot) lgt += PLG[((size_t)slot * M_TOK + m) * 16 + e];
        float ss = PSS[(size_t)e * M_TOK + m];
#pragma unroll
        for (int o = 1; o < 16; o <<= 1) ss += __shfl_xor(ss, o);
        const float rstd = 1.f / sqrtf(ss * (1.f / DM) + NORM_EPS);
        lgt *= rstd;
        float mx = lgt;
#pragma unroll
        for (int o = 1; o < 16; o <<= 1) mx = fmaxf(mx, __shfl_xor(mx, o));
        const float ex = expf(lgt - mx); float den = ex;
#pragma unroll
        for (int o = 1; o < 16; o <<= 1) den += __shfl_xor(den, o);
        const int b = m / SEQ, t = m % SEQ;
        AFF[(size_t)(b * NEXP + e) * SEQ + t] = ex / den;
        if (e == 0) RSTD[m] = rstd;
    }
}

__device__ __forceinline__ int block_excl_scan(int v, LAS int* scr, int tid, int lane, int wave, int* tot) {
    int inc = v;
#pragma unroll
    for (int o = 1; o < 64; o <<= 1) { const int n = __shfl_up(inc, o); if (lane >= o) inc += n; }
    __syncthreads();
    if (lane == 63) scr[wave] = inc;
    __syncthreads();
    int base = 0, total = 0;
#pragma unroll
    for (int w = 0; w < NWAVES; ++w) { const int c = scr[w]; if (w < wave) base += c; total += c; }
    *tot = total;
    return base + inc - v;
}

__device__ __forceinline__ void phase_topk(const float* AFF, const float* RSTD, float* RS, int* IDX, float* GATE, int* POS, LAS unsigned char* ldsm, int blk, int nblk, int tid, int lane, int wave) {
    LAS int* hist = (LAS int*)ldsm;
    LAS int* sel = (LAS int*)(ldsm + 1024);
    LAS int* scr = (LAS int*)(ldsm + 1280);
    for (int g = blk; g < NGRP; g += nblk) {
        unsigned v[16];
        { const GAS v4u* src = (const GAS v4u*)(AFF + (size_t)g * SEQ) + tid * 4;
#pragma unroll
          for (int q = 0; q < 4; ++q) { const v4u w = src[q]; v[4 * q] = w.x; v[4 * q + 1] = w.y; v[4 * q + 2] = w.z; v[4 * q + 3] = w.w; } }
        unsigned prefix = 0u; int krem = CAP;
#pragma unroll 1
        for (int pass = 0; pass < 4; ++pass) {
            const int shift = 24 - 8 * pass;
            const unsigned himask = (pass == 0) ? 0u : (0xffffffffu << (shift + 8));
            __syncthreads();
            if (tid < 256) hist[tid] = 0;
            __syncthreads();
#pragma unroll
            for (int i = 0; i < 16; ++i) if ((v[i] & himask) == prefix) __hip_atomic_fetch_add(hist + ((v[i] >> shift) & 255u), 1, __ATOMIC_RELAXED, __HIP_MEMORY_SCOPE_WORKGROUP);
            __syncthreads();
            if (wave == 0) {
                int c[4]; int s = 0;
#pragma unroll
                for (int j = 0; j < 4; ++j) { c[j] = hist[255 - 4 * lane - j]; s += c[j]; }
                int inc = s;
#pragma unroll
                for (int o = 1; o < 64; o <<= 1) { const int n = __shfl_up(inc, o); if (lane >= o) inc += n; }
                int before = inc - s;
                if (before < krem && krem <= inc) {
                    int bin = 0, kk = krem - before; bool done = false;
#pragma unroll
                    for (int j = 0; j < 4; ++j) { if (!done) { if (kk <= c[j]) { bin = 255 - 4 * lane - j; done = true; } else kk -= c[j]; } }
                    sel[0] = bin; sel[1] = kk;
                }
            }
            __syncthreads();
            prefix |= ((unsigned)sel[0]) << shift; krem = sel[1];
        }
        int ceq = 0;
#pragma unroll
        for (int i = 0; i < 16; ++i) ceq += (v[i] == prefix) ? 1 : 0;
        int tot;
        int eqrank = block_excl_scan(ceq, scr, tid, lane, wave, &tot);
        int csel = 0; unsigned selmask = 0u;
#pragma unroll
        for (int i = 0; i < 16; ++i) { bool s = v[i] > prefix; if (v[i] == prefix) { s = eqrank < krem; ++eqrank; } if (s) { selmask |= 1u << i; ++csel; } }
        int slot = block_excl_scan(csel, scr, tid, lane, wave, &tot);
        const int b = g / NEXP;
        int pv[16];
#pragma unroll
        for (int i = 0; i < 16; ++i) {
            pv[i] = -1;
            if (selmask & (1u << i)) { pv[i] = slot; IDX[g * CAP + slot] = b * SEQ + tid * 16 + i; GATE[g * CAP + slot] = __builtin_bit_cast(float, v[i]); RS[g * CAP + slot] = RSTD[b * SEQ + tid * 16 + i]; ++slot; }
        }
        { GAS v4u* dst = (GAS v4u*)(POS + (size_t)g * SEQ) + tid * 4;
#pragma unroll
          for (int q = 0; q < 4; ++q) { v4u w; w.x = (unsigned)pv[4 * q]; w.y = (unsigned)pv[4 * q + 1]; w.z = (unsigned)pv[4 * q + 2]; w.w = (unsigned)pv[4 * q + 3]; dst[q] = w; } }
        __syncthreads();
    }
}

__device__ __forceinline__ void phase_gather(const bf16* XN, const int* IDX, bf16* XG, int gw, int NGW, int lane) {
    for (int r = gw; r < XROWS; r += NGW) {
        const int src = __builtin_amdgcn_readfirstlane(IDX[r]);
        const GAS v4u* s = (const GAS v4u*)(XN + (size_t)src * DM) + lane; GAS v4u* d = (GAS v4u*)(XG + (size_t)r * DM) + lane;
        const v4u a = s[0], b = s[64]; d[0] = a; d[64] = b;
    }
}

__device__ __forceinline__ void phase_qk_rope(bf16* P, const float* gq, const float* gk, int gw, int NGW, int lane) {
    const int hh = lane >> 2, part = lane & 3, axis = part >> 1, half = part & 1;
    const float* g = (hh < NQH ? gq : gk) + 16 * part;
    float gv[16], inv[16];
#pragma unroll
    for (int i = 0; i < 16; ++i) { gv[i] = g[i]; inv[i] = exp2f(-(float)i * (13.287712379549449f / 16.0f)); }
    const float osc = hh < NQH ? ATT_C2 : 1.0f;
    int m = gw; v4u c0 = (v4u){0u, 0u, 0u, 0u}, c1 = c0;
    if (m < M_TOK) { const GAS v4u* p = (const GAS v4u*)(P + (size_t)m * D_IN_AT + hh * HD + 16 * part); c0 = p[0]; c1 = p[1]; }
#pragma unroll 1
    for (; m < M_TOK; m += NGW) {
        const int t = m % SEQ; const float pos = (float)(axis == 0 ? (t >> 6) : (t & 63));
        GAS v4u* p = (GAS v4u*)(P + (size_t)m * D_IN_AT + hh * HD + 16 * part);
        const v4u w0 = c0, w1 = c1;
        if (m + NGW < M_TOK) { const GAS v4u* pn = (const GAS v4u*)(P + (size_t)(m + NGW) * D_IN_AT + hh * HD + 16 * part); c0 = pn[0]; c1 = pn[1]; }
        float x[16];
        x[0] = bflo(w0.x); x[1] = bfhi(w0.x); x[2] = bflo(w0.y); x[3] = bfhi(w0.y); x[4] = bflo(w0.z); x[5] = bfhi(w0.z); x[6] = bflo(w0.w); x[7] = bfhi(w0.w);
        x[8] = bflo(w1.x); x[9] = bfhi(w1.x); x[10] = bflo(w1.y); x[11] = bfhi(w1.y); x[12] = bflo(w1.z); x[13] = bfhi(w1.z); x[14] = bflo(w1.w); x[15] = bfhi(w1.w);
        float ss = 0.f;
#pragma unroll
        for (int i = 0; i < 16; ++i) ss += x[i] * x[i];
        ss += __shfl_xor(ss, 1); ss += __shfl_xor(ss, 2);
        const float rstd = 1.f / sqrtf(ss * (1.f / HD) + NORM_EPS);
        float o[16];
#pragma unroll
        for (int i = 0; i < 16; ++i) {
            const float xn = x[i] * rstd * gv[i]; const float xp = __shfl_xor(xn, 1);
            float sn, cs; sincosf(pos * inv[i], &sn, &cs);
            o[i] = (half == 0 ? (xn * cs - xp * sn) : (xp * sn + xn * cs)) * osc;
        }
        v4u r0, r1;
        r0.x = pk2(o[0], o[1]); r0.y = pk2(o[2], o[3]); r0.z = pk2(o[4], o[5]); r0.w = pk2(o[6], o[7]);
        r1.x = pk2(o[8], o[9]); r1.y = pk2(o[10], o[11]); r1.z = pk2(o[12], o[13]); r1.w = pk2(o[14], o[15]);
        p[0] = r0; p[1] = r1;
    }
}

__device__ __forceinline__ void phase_transpose_mix(const bf16* MIXT, bf16* MIX, LAS unsigned char* lds, int blk, int nblk, int tid) {
    constexpr int TP = 516;
    for (int it = blk; it < (D_MAIN / 64) * (M_TOK / 256); it += nblk) {
        const int cb = it % (D_MAIN / 64), mb = it / (D_MAIN / 64), c0 = cb * 64, m0 = mb * 256;
        __syncthreads();
#pragma unroll
        for (int k = 0; k < 4; ++k) { const int p = tid + NTHREADS * k, ch = p >> 5, seg = p & 31;
            const v4u w = *(const GAS v4u*)(MIXT + (size_t)(c0 + ch) * M_TOK + m0 + seg * 8);
            LAS unsigned* d = (LAS unsigned*)(lds + ch * TP + seg * 16); d[0] = w.x; d[1] = w.y; d[2] = w.z; d[3] = w.w; }
        __syncthreads();
#pragma unroll
        for (int k = 0; k < 4; ++k) { const int q = tid + NTHREADS * k, r = q >> 3, j = q & 7;
            const LAS bf16* s = (const LAS bf16*)(lds + (8 * j) * TP) + r;
            v4u o; o.x = (unsigned)s[0] | ((unsigned)s[TP / 2] << 16); o.y = (unsigned)s[2 * (TP / 2)] | ((unsigned)s[3 * (TP / 2)] << 16);
            o.z = (unsigned)s[4 * (TP / 2)] | ((unsigned)s[5 * (TP / 2)] << 16); o.w = (unsigned)s[6 * (TP / 2)] | ((unsigned)s[7 * (TP / 2)] << 16);
            *(GAS v4u*)(MIX + (size_t)(m0 + r) * DM + c0 + 8 * j) = o; }
    }
    __syncthreads();
}
__device__ __forceinline__ void phase_taps(const float* H2j, const float* w3, float* TAPS, int gw, int NGW, int lane) {
    typedef float f32x16 __attribute__((ext_vector_type(16))); typedef short bf16x8_t __attribute__((ext_vector_type(8)));
    const float min_decay = -4.605170185988091f / 1.5f, max_decay = -4.605170185988091f / 0.3f;
    const int li = lane & 31, hi = lane >> 5;
#pragma unroll 1
    for (int it = gw; it < (FCOLS / 32) * (SEQ / 128); it += NGW) {
        const int ct = it % (FCOLS / 32), ng = it / (FCOLS / 32), col0 = ct * 32;
        bf16x8_t a[4];
#pragma unroll
        for (int s = 0; s < 4; ++s) { float t[8];
#pragma unroll
            for (int j = 0; j < 8; ++j) t[j] = w3[(size_t)(16 * s + 8 * hi + j) * FCOLS + col0 + li];
            v4u p; p.x = pk2(t[0], t[1]); p.y = pk2(t[2], t[3]); p.z = pk2(t[4], t[5]); p.w = pk2(t[6], t[7]); a[s] = __builtin_bit_cast(bf16x8_t, p); }
        f32x4 hv[4][8];
#pragma unroll
        for (int nt = 0; nt < 4; ++nt) { const GAS f32x4* hp = (const GAS f32x4*)(H2j + (size_t)(ng * 128 + nt * 32 + li) * HY_FILT + 8 * hi);
#pragma unroll
            for (int s = 0; s < 4; ++s) { hv[nt][2 * s] = hp[4 * s]; hv[nt][2 * s + 1] = hp[4 * s + 1]; } }
#pragma unroll
        for (int nt = 0; nt < 4; ++nt) {
            const int n0 = ng * 128 + nt * 32;
            f32x16 acc;
#pragma unroll
            for (int r = 0; r < 16; ++r) acc[r] = 0.f;
#pragma unroll
            for (int s = 0; s < 4; ++s) { const f32x4 v0 = hv[nt][2 * s], v1 = hv[nt][2 * s + 1];
                v4u p; p.x = pk2(v0.x, v0.y); p.y = pk2(v0.z, v0.w); p.z = pk2(v1.x, v1.y); p.w = pk2(v1.z, v1.w);
                acc = __builtin_amdgcn_mfma_f32_32x32x16_bf16(a[s], __builtin_bit_cast(bf16x8_t, p), acc, 0, 0, 0); }
            const float t = (float)(n0 + li) * (1.0f / (float)(SEQ - 1));
#pragma unroll
            for (int r = 0; r < 16; ++r) { const int col = col0 + (r & 3) + 8 * (r >> 2) + 4 * hi, c = col % D_MAIN;
                const float ad = fabsf(min_decay + (float)c * ((max_decay - min_decay) / (float)(D_MAIN - 1)));
                TAPS[(size_t)col * SEQ + n0 + li] = acc[r] * expf(-t * ad); }
        }
    }
}

__device__ __forceinline__ constexpr float twc(int k) { constexpr float T[16] = {1.0f, 0.98078528040323043f, 0.92387953251128674f, 0.83146961230254524f, 0.70710678118654757f, 0.55557023301960218f, 0.38268343236508978f, 0.19509032201612825f,
    0.0f, -0.19509032201612825f, -0.38268343236508978f, -0.55557023301960218f, -0.70710678118654757f, -0.83146961230254524f, -0.92387953251128674f, -0.98078528040323043f}; return T[k]; }
__device__ __forceinline__ constexpr float tws(int k) { constexpr float T[16] = {0.0f, 0.19509032201612825f, 0.38268343236508978f, 0.55557023301960218f, 0.70710678118654757f, 0.83146961230254524f, 0.92387953251128674f, 0.98078528040323043f,
    1.0f, 0.98078528040323043f, 0.92387953251128674f, 0.83146961230254524f, 0.70710678118654757f, 0.55557023301960218f, 0.38268343236508978f, 0.19509032201612825f}; return T[k]; }
__device__ __forceinline__ constexpr int bitrev(int i, int bits) { int r = 0; for (int b = 0; b < bits; ++b) if (i & (1 << b)) r |= 1 << (bits - 1 - b); return r; }

template <int N, int LEN> struct FftStage {
    static __device__ __forceinline__ void run(float (&re)[N], float (&im)[N]) {
        constexpr int half = LEN / 2, step = 32 / LEN;
#pragma unroll
        for (int base = 0; base < N; base += LEN)
#pragma unroll
            for (int j = 0; j < half; ++j) {
                const int i0 = base + j, i1 = i0 + half, idx = j * step;
                const float ar = re[i0], ai = im[i0], br = re[i1], bi = im[i1];
                re[i0] = ar + br; im[i0] = ai + bi;
                const float dr = ar - br, di = ai - bi;
                if (idx == 0) { re[i1] = dr; im[i1] = di; }
                else if (idx == 8) { re[i1] = di; im[i1] = -dr; }
                else { const float c = twc(idx), s = tws(idx); re[i1] = dr * c + di * s; im[i1] = di * c - dr * s; }
            }
        if constexpr (LEN > 2) FftStage<N, LEN / 2>::run(re, im);
    }
};
template <int N, int BITS> __device__ __forceinline__ void fft_reg(float (&re)[N], float (&im)[N]) {
    FftStage<N, N>::run(re, im);
    float tr[N], ti[N];
#pragma unroll
    for (int i = 0; i < N; ++i) { tr[bitrev(i, BITS)] = re[i]; ti[bitrev(i, BITS)] = im[i]; }
#pragma unroll
    for (int i = 0; i < N; ++i) { re[i] = tr[i]; im[i] = ti[i]; }
}

template <int N, int LEN> struct FftStageC {
    static __device__ __forceinline__ void run(f32x2 (&x)[N]) {
        constexpr int half = LEN / 2, step = 32 / LEN;
#pragma unroll
        for (int base = 0; base < N; base += LEN)
#pragma unroll
            for (int j = 0; j < half; ++j) {
                const int i0 = base + j, i1 = i0 + half, idx = j * step;
                const f32x2 a = x[i0], b = x[i1];
                x[i0] = a + b;
                const f32x2 d = a - b;
                if (idx == 0) x[i1] = d;
                else if (idx == 8) x[i1] = (f32x2){d.y, -d.x};
                else { const float c = twc(idx), s = tws(idx); const f32x2 t = (f32x2){d.y, -d.x}; x[i1] = d * c + t * s; }
            }
        if constexpr (LEN > 2) FftStageC<N, LEN / 2>::run(x);
    }
};
template <int N, int BITS> __device__ __forceinline__ void fft_regc(f32x2 (&x)[N]) {
    FftStageC<N, N>::run(x);
    f32x2 t[N];
#pragma unroll
    for (int i = 0; i < N; ++i) t[bitrev(i, BITS)] = x[i];
#pragma unroll
    for (int i = 0; i < N; ++i) x[i] = t[i];
}
__device__ __forceinline__ void fft16k_c(f32x2 (&x)[32], LAS f32x2* L, int tid_in) {
    int tid = tid_in; asm volatile("" : "+v"(tid));
    fft_regc<32, 5>(x);
#pragma unroll
    for (int k1 = 1; k1 < 32; ++k1) { const float fr = (float)((tid * k1) & 16383) * (1.0f / 16384.0f); const float c = __builtin_amdgcn_cosf(fr), s = __builtin_amdgcn_sinf(fr);
        const f32x2 d = x[k1], t = (f32x2){d.y, -d.x}; x[k1] = d * c + t * s; if ((k1 & 3) == 3) __builtin_amdgcn_sched_barrier(0); }
#pragma unroll
    for (int k1 = 0; k1 < 32; ++k1) L[k1 * 513 + tid] = x[k1];
    __syncthreads();
    const int n3 = tid & 31, ka = tid >> 5;
    f32x2 a[16], b[16];
#pragma unroll
    for (int n2 = 0; n2 < 16; ++n2) { a[n2] = L[ka * 513 + n2 * 32 + n3]; b[n2] = L[(ka + 16) * 513 + n2 * 32 + n3]; }
    fft_regc<16, 4>(a); fft_regc<16, 4>(b);
#pragma unroll
    for (int k2 = 1; k2 < 16; ++k2) { const float fr = (float)((n3 * k2) & 511) * (1.0f / 512.0f); const float c = __builtin_amdgcn_cosf(fr), s = __builtin_amdgcn_sinf(fr);
        f32x2 d = a[k2], t = (f32x2){d.y, -d.x}; a[k2] = d * c + t * s; d = b[k2]; t = (f32x2){d.y, -d.x}; b[k2] = d * c + t * s; if ((k2 & 3) == 3) __builtin_amdgcn_sched_barrier(0); }
    __syncthreads();
#pragma unroll
    for (int k2 = 0; k2 < 16; ++k2) { L[n3 * 513 + k2 * 32 + ka] = a[k2]; L[n3 * 513 + k2 * 32 + ka + 16] = b[k2]; }
    __syncthreads();
#pragma unroll
    for (int q = 0; q < 32; ++q) x[q] = L[q * 513 + tid];
    fft_regc<32, 5>(x);
}
__device__ __forceinline__ void fft16k(float (&re)[32], float (&im)[32], LAS f32x2* L, int tid) {
    f32x2 x[32];
#pragma unroll
    for (int r = 0; r < 32; ++r) x[r] = (f32x2){re[r], im[r]};
    fft16k_c(x, L, tid);
#pragma unroll
    for (int r = 0; r < 32; ++r) { re[r] = x[r].x; im[r] = x[r].y; }
}

constexpr int HS_SP = SEQ + 16;
__device__ __forceinline__ void hy_stage(LAS bf16* S, int slot, const bf16* src, int tid) {
    LAS bf16* d = S + slot * HS_SP + 8;
    if (tid == 0) { d[-1] = 0; d[SEQ] = 0; }
#pragma unroll
    for (int q = 0; q < 2; ++q) { const int ch = q * NTHREADS + tid; *(LAS v4u*)(d + ch * 8) = *(const GAS v4u*)(src + ch * 8); }
}
__device__ __forceinline__ float hy_sc(const LAS bf16* S, int slot, int t, float w0, float w1, float w2) {
    const LAS bf16* p = S + slot * HS_SP + 8 + t;
    return bf2f(p[-1]) * w0 + bf2f(p[0]) * w1 + bf2f(p[1]) * w2;
}

#ifdef CSEL
#define CT(sec) do { const unsigned long long tn_ = __builtin_amdgcn_s_memrealtime(); if (csec_ == CSEL) ctime_ += tn_ - ct0_; ct0_ = tn_; csec_ = (sec); } while (0)
#else
#define CT(sec)
#endif
__device__ __forceinline__ void phase_hyena_conv(const bf16* PT, const float* TAPS, const float* shortw, const float* skip, f32x2* XSall, f32x2* ZSall, bf16* MIXT,
                                                 LAS unsigned char* lds, int blk, int nblk, int tid_in, int lane, int wave, int pmode = 0) {
    LAS f32x2* L = (LAS f32x2*)lds; LAS bf16* S = (LAS bf16*)lds; LAS float* red = (LAS float*)(lds + LDS_MISC);
    f32x2* XK0 = XSall + (size_t)blk * 16384;
    f32x2* XK1 = XK0 + 16384 * 256; f32x2* ZS = ZSall + (size_t)blk * 16384;
    constexpr int N = 16384;
#ifdef CSEL
    unsigned long long ctime_ = 0ull, ct0_ = __builtin_amdgcn_s_memrealtime(); int csec_ = -1;
#endif
#pragma unroll 1
    for (int c = blk; c < D_MAIN; c += nblk) {
        f32x2 x[32]; float vr[16], vi[16];
#pragma unroll 1
        for (int pass = 0; pass < 5; ++pass) {
            int tid = tid_in; asm volatile("" : "+v"(tid));
            CT(pass == 0 ? 0 : (pass == 1 ? 7 : 8));
            if (pass == 0) {
                const float* hf0 = TAPS + (size_t)c * SEQ; const float* hb0 = TAPS + (size_t)(D_MAIN + c) * SEQ;
                const float* hf1 = TAPS + (size_t)(2 * D_MAIN + c) * SEQ; const float* hb1 = TAPS + (size_t)(3 * D_MAIN + c) * SEQ;
#pragma unroll
                for (int r = 0; r < 16; ++r) { const int n = r * 512 + tid; x[r].x = hf0[n]; x[r].y = hf1[n]; }
#pragma unroll
                for (int r = 16; r < 32; ++r) { const int idx = (32 - r) * 512 - tid; const bool z = (idx == SEQ); const int ii = z ? 0 : idx; x[r].x = z ? 0.f : hb0[ii]; x[r].y = z ? 0.f : hb1[ii]; }
                float e0 = 0.f, e1 = 0.f;
                if (tid == 0) { e0 = hb0[0]; e1 = hb1[0]; }
                float s0 = fabsf(e0), s1 = fabsf(e1);
#pragma unroll
                for (int r = 0; r < 32; ++r) { s0 += fabsf(x[r].x); s1 += fabsf(x[r].y); }
                s0 = wave_sum(s0); s1 = wave_sum(s1);
                __syncthreads();
                if (lane == 0) { red[wave] = s0; red[8 + wave] = s1; }
                __syncthreads();
                float t0 = 0.f, t1 = 0.f;
#pragma unroll
                for (int w = 0; w < NWAVES; ++w) { t0 += red[w]; t1 += red[8 + w]; }
                const float sc0 = 1.0f / (t0 + 1e-6f), sc1 = 1.0f / (t1 + 1e-6f);
                x[0].x += e0; x[0].y += e1;
#pragma unroll
                for (int r = 0; r < 32; ++r) { x[r].x *= sc0; x[r].y *= sc1; }
            } else if (pass == 1) {
                __syncthreads();
                const bf16* pv = PT + (size_t)(2 * D_MAIN + c) * M_TOK; const float wv[3] = {shortw[2 * D_MAIN + c], shortw[2304 + 2 * D_MAIN + c], shortw[4608 + 2 * D_MAIN + c]};
                hy_stage(S, 0, pv, tid); hy_stage(S, 1, pv + SEQ, tid);
                __syncthreads();
#pragma unroll
                for (int r = 0; r < 16; ++r) { const int t = r * 512 + tid; x[r].x = hy_sc(S, 0, t, wv[0], wv[1], wv[2]); x[r].y = hy_sc(S, 1, t, wv[0], wv[1], wv[2]); vr[r] = x[r].x; vi[r] = x[r].y; }
#pragma unroll
                for (int r = 16; r < 32; ++r) { x[r].x = 0.f; x[r].y = 0.f; }
            }
            __syncthreads();
            CT(1);
            fft16k_c(x, L, tid);
            CT(2 + pass);
            if (pass == 0) {
                __syncthreads();
#pragma unroll
                for (int r = 0; r < 32; ++r) L[r * 513 + tid] = x[r];
                __syncthreads();
                const int tp = (512 - tid) & 511;
#pragma unroll
                for (int r = 0; r < 32; ++r) { const int rp = (tid == 0) ? ((32 - r) & 31) : (31 - r);
                    const f32x2 xa = x[r], xb = L[rp * 513 + tp]; const float sc_ = 0.5f / (float)N;
                    XK0[r * 512 + tid] = (f32x2){(xa.x + xb.x) * sc_, (xa.y - xb.y) * sc_};
                    XK1[r * 512 + tid] = (f32x2){(xa.y + xb.y) * sc_, (xb.x - xa.x) * sc_}; if ((r & 7) == 7) __builtin_amdgcn_sched_barrier(0); }
            } else if (pass == 1 || pass == 3) {
                const f32x2* XK = (pass == 1) ? XK0 : XK1;
#pragma unroll
                for (int r = 0; r < 32; ++r) { const f32x2 k = XK[r * 512 + tid]; const float zr_ = x[r].x, zi_ = x[r].y;
                    x[r].x = zr_ * k.x - zi_ * k.y; x[r].y = -(zr_ * k.y + zi_ * k.x); }
            } else if (pass == 2) {
                __syncthreads();
                const bf16* px1 = PT + (size_t)c * M_TOK; const float sk0 = skip[c]; const float wx1[3] = {shortw[c], shortw[2304 + c], shortw[4608 + c]};
                hy_stage(S, 2, px1, tid); hy_stage(S, 3, px1 + SEQ, tid);
                __syncthreads();
#pragma unroll
                for (int r = 0; r < 16; ++r) { const int t = r * 512 + tid;
                    const float v0 = vr[r], v1 = vi[r];
                    const float g0 = hy_sc(S, 2, t, wx1[0], wx1[1], wx1[2]), g1 = hy_sc(S, 3, t, wx1[0], wx1[1], wx1[2]);
                    x[r].x = g0 * (x[r].x + sk0 * v0); x[r].y = g1 * (-x[r].y + sk0 * v1); ZS[t] = (f32x2){x[r].x, x[r].y}; }
#pragma unroll
                for (int r = 16; r < 32; ++r) { x[r].x = 0.f; x[r].y = 0.f; }
            } else {
                __syncthreads();
                const bf16* px2 = PT + (size_t)(D_MAIN + c) * M_TOK; const float sk1 = skip[D_MAIN + c];
                const float wx2[3] = {shortw[D_MAIN + c], shortw[2304 + D_MAIN + c], shortw[4608 + D_MAIN + c]};
                hy_stage(S, 0, px2, tid); hy_stage(S, 1, px2 + SEQ, tid);
                __syncthreads();
#pragma unroll
                for (int r = 0; r < 16; ++r) { const int t = r * 512 + tid;
                    const float g0 = hy_sc(S, 0, t, wx2[0], wx2[1], wx2[2]), g1 = hy_sc(S, 1, t, wx2[0], wx2[1], wx2[2]);
                    const f32x2 z = ZS[t];
                    const float o0 = g0 * (x[r].x + sk1 * z.x), o1 = g1 * (-x[r].y + sk1 * z.y);
                    MIXT[(size_t)c * M_TOK + t] = (bf16)f2bf(o0); MIXT[(size_t)c * M_TOK + SEQ + t] = (bf16)f2bf(o1); }
            }
        }
        CT(-1);
        __syncthreads();
    }
#ifdef CSEL
    if (blk == 0 && tid_in == 0) *(unsigned long long*)((unsigned char*)XSall - WS_FFTX + 32768) += ctime_;
#endif
}
#ifndef MK_PER_PHASE
#define MK_PER_PHASE 0
#endif
#ifndef CONV_PMODE
#define CONV_PMODE 0
#endif
#ifndef REPMASK
#define REPMASK 0u
#endif
#define REP(kind) _Pragma("unroll 1") for (int r_ = 0; r_ < 1 + (int)((REPMASK >> (kind)) & 1u); ++r_)
struct Args {
    const float* in[24]; float* out; unsigned char* ws; int ph_lo, ph_hi;
};
constexpr int N_PHASES = 1 + (DEPTH - 1) + DEPTH * 8 - DEPTH / 2 + 1;

template <int QP, int KP, int THRL = 8>
__device__ __forceinline__ void run_attn(const bf16* Q, const bf16* K, const bf16* V, bf16* O, int NT, char* shm, int wave_s) {
    attn_body::attn_unit<THRL, QP, KP, DM>((const attn_body::bf16*)Q, (const attn_body::bf16*)K, (const attn_body::bf16*)V, (attn_body::bf16*)O, NT, shm, wave_s);
}

__global__ void __launch_bounds__(NTHREADS, 2) hybrid_fwd(Args args) {
    extern __shared__ __attribute__((aligned(16))) unsigned char lds_raw[];
    LAS unsigned char* lds = (LAS unsigned char*)lds_raw;
    const int G = gridDim.x, bx = blockIdx.x;
    const int wave0 = __builtin_amdgcn_readfirstlane((int)(threadIdx.x >> 6));
    const int vcu = (G % 8 == 0) ? (bx % 8) * (G / 8) + bx / 8 : bx;
    const int NGW = G * NWAVES;
    unsigned char* const ws0_ = args.ws;
    const float* x = args.in[0]; const float* mem = args.in[1]; const float* mix_g = args.in[2]; const float* ffn_g = args.in[3]; const float* mem_g = args.in[4]; const float* fin_g = args.in[5];
    const float* hy_short = args.in[9]; const float* f_w1 = args.in[10]; const float* f_b1 = args.in[11]; const float* f_w2 = args.in[12]; const float* f_b2 = args.in[13];
    const float* f_w3 = args.in[14]; const float* f_freq = args.in[15]; const float* hy_skip = args.in[16]; const float* qg = args.in[18]; const float* kg = args.in[19]; const float* router = args.in[20];
    float* H = args.out;
#define U ((bf16*)(ws + WS_U))
#define PROJ ((bf16*)(ws + WS_PROJ))
#define CQ ((bf16*)(ws + WS_CQ))
#define MIX ((bf16*)(ws + WS_MIX))
#define MIXT ((bf16*)(ws + WS_MIXT))
#define AFF ((float*)(ws + WS_AFF))
#define IDX ((int*)(ws + WS_IDX))
#define GATE ((float*)(ws + WS_GATE))
#define POS ((int*)(ws + WS_POS))
#define HID ((bf16*)(ws + WS_HID))
#define Y ((bf16*)(ws + WS_Y))
#define TAPS ((float*)(ws + WS_TAPS))
#define MKV ((const bf16*)(ws + WS_MKV))
    cg::grid_group grid = cg::this_grid();
    volatile LAS unsigned* bst = (volatile LAS unsigned*)(lds + LDS_MISC + 4096);
    if (threadIdx.x < 2) bst[threadIdx.x] = 0u;
    __syncthreads();
    XcdBarrier xbar = xcd_barrier_post((unsigned*)(ws0_ + WS_CTL) + 1024, bst);
    const int lo = args.ph_lo, hi = args.ph_hi;
#define XW (XwIn{args.in[21], args.in[22], args.in[23], ws})
    const bool xw_sched = (G == 256);
    int ph = 0;
#ifdef TSEL
    unsigned long long tacc_ = 0ull, t0_ = 0ull, t1_ = 0ull; int pk_ = 0, tpar_ = 0;
#endif
#ifdef TSEL
#ifndef TAMP
#define TAMP 10
#endif
#ifndef TBAR
#define TBAR 0
#endif
#define PH_T0(k) pk_ = (k); t0_ = __builtin_amdgcn_s_memrealtime();
#ifndef TPAR
#define TPAR -1
#endif
#define PH_T1 t1_ = __builtin_amdgcn_s_memrealtime(); if (!TBAR && (pk_ == TSEL || TSEL == 99) && (TPAR < 0 || tpar_ == TPAR)) tacc_ += t1_ - t0_;
#define PH_T2 if (TBAR && (pk_ == TSEL || TSEL == 99)) tacc_ += __builtin_amdgcn_s_memrealtime() - t1_;
#else
#define PH_T0(k)
#define PH_T1
#define PH_T2
#endif
#define PHASE_BEGINK(k) PH_T0(k) if (lo <= ph && ph < hi) { unsigned char* ws = ws0_; asm volatile("" : "+s"(ws)); const int tid = opaque_tid(wave0), lane = tid & 63, wave = __builtin_amdgcn_readfirstlane(tid >> 6), gw = vcu * NWAVES + wave; (void)lane; (void)gw;
#ifdef EXTRA_XBAR
#define PHASE_END   if (ph + 1 < hi) { if (ph == lo) grid.sync(); else { xcd_barrier(xbar); if (ph < EXTRA_XBAR) xcd_barrier(xbar); } } } ++ph;
#else
#define PHASE_END   PH_T1 if (ph + 1 < hi) { if (ph == lo) grid.sync(); else xcd_barrier(xbar); } PH_T2 } ++ph;
#endif

    PHASE_BEGINK(0)
        ProIn P{args.in[8], args.in[17], args.in[7], args.in[6]};
        REP(0) { phase_weights(P, ws, lds, gw, NGW, wave, lane); phase_xw_p0(XW, xw_sched, (LAS float*)(lds + wave * 16384), gw, NGW, lane); }
        phase_wrg(ffn_g, router, (float*)(ws + WS_WRG), (int)(bx * NTHREADS + tid), (int)(G * NTHREADS));
        REP(1) phase_mem_h2(mem, mem_g, f_w1, f_b1, f_w2, f_b2, f_freq, ws, gw, NGW, lane);
        REP(3) phase_norm<false, false>(x, nullptr, mix_g, U, nullptr, nullptr, nullptr, gw, NGW, lane);
    PHASE_END

#pragma unroll 1
    for (int i = 0; i < DEPTH; ++i) {
        const bool hy = (i & 1) == 0; const int j = i >> 1;
#ifdef TSEL
        tpar_ = i & 1;
#endif
        if (i > 0) {
        PHASE_BEGINK(1)
            phase_norm<true, false>(H, H, mix_g + i * DM, U, nullptr, POS, Y, gw, NGW, lane);
        PHASE_END
        }
        PHASE_BEGINK(2)
            if (i == 0) {
                pg8::Gemm g{(const bf16*)(ws + WS_MEMN), (const bf16*)(ws + WS_WMKV), BATCH * MEM_LEN, 2048, DM, 1 << 30, 1, 0};
                pg8::StaticOrder S; S.init(BATCH * MEM_LEN, 2048, G, bx);
                pg8::EpiRowBf16 E{(bf16*)(ws + WS_MKV), 2048, -1, 1.f};
                pg8::gemm_phase<pg8::EpiRowBf16, pg8::StaticOrder, true, true>(lds, g, S, E, wave);
            }
            if (hy) {
                REP(4) phase_taps((const float*)(ws + WS_H2) + (size_t)j * SEQ * HY_FILT, f_w3 + (size_t)j * HY_FILT * FCOLS, TAPS, gw, NGW, lane);
                pg8::Gemm g{U, (const bf16*)(ws + WS_WHY) + (size_t)j * D_IN_HY * DM, M_TOK, D_IN_HY, DM, 1 << 30, 1, 0};
                pg8::StaticOrder S; S.init(M_TOK, D_IN_HY, G, bx);
                pg8::EpiHyIn E{PROJ, M_TOK, 9, CQ, ATT_C2};
                REP(5) pg8::gemm_phase<pg8::EpiHyIn, pg8::StaticOrder, true, true>(lds, g, S, E, wave);
            } else {
                pg8::Gemm g{U, (const bf16*)(ws + WS_WAT) + (size_t)j * D_IN_AT * DM, M_TOK, D_IN_AT, DM, 1 << 30, 1, 0};
                pg8::StaticOrder S; S.init(M_TOK, D_IN_AT, G, bx);
                pg8::EpiAtIn E{PROJ, PROJ + (size_t)M_TOK * 768, PROJ + (size_t)M_TOK * 1024, PROJ + (size_t)M_TOK * 1280, qg + j * HD, kg + j * HD, ATT_C2, NORM_EPS, SEQ - 1};
                REP(6) pg8::gemm_phase<pg8::EpiAtIn, pg8::StaticOrder, true, true>(lds, g, S, E, wave);
            }
            if (xw_sched && bx >= 128) xw_slice_a(XW, i, (LAS float*)(lds + wave * 16384), bx, wave, lane);
        PHASE_END
        PHASE_BEGINK(3)
            if (hy) {
                REP(8) phase_hyena_conv(PROJ, TAPS, hy_short + (size_t)j * 3 * 2304, hy_skip + (size_t)j * 2 * D_MAIN, (f32x2*)(ws + WS_FFTX), (f32x2*)(ws + WS_ZS), MIXT, lds, bx, G, tid, lane, wave);
                REP(9) for (int u = vcu; u < 256; u += G) { const int b = u >> 7, h4 = (u >> 5) & 3, qb = u & 31; const size_t row = (size_t)b * SEQ + qb * 256;
                    run_attn<256, 2048>(CQ + row * 256 + h4 * HD, MKV + (size_t)b * MEM_LEN * 2048 + i * 512 + h4 * HD, MKV + (size_t)b * MEM_LEN * 2048 + i * 512 + 256 + h4 * HD,
                                        MIX + row * DM + D_MAIN + h4 * HD, MEM_LEN / 64, (char*)lds_raw, wave); }
            } else {
                REP(10) for (int u = vcu; u < 768; u += G) { const int bk = (u & 255) >> 5, qb = u & 31, hs = u >> 8, b = bk >> 2, kvh = bk & 3, h = kvh * 3 + hs; const size_t row = (size_t)b * SEQ + qb * 256;
                    run_attn<768, 256, -1>(PROJ + row * 768 + h * HD, PROJ + (size_t)M_TOK * 768 + (size_t)b * SEQ * 256 + kvh * HD, PROJ + (size_t)M_TOK * 1024 + (size_t)b * SEQ * 256 + kvh * HD,
                                       MIX + row * DM + h * HD, SEQ / 64, (char*)lds_raw, wave); }
                REP(9) for (int u = vcu; u < 256; u += G) { const int b = u >> 7, h4 = (u >> 5) & 3, qb = u & 31; const size_t row = (size_t)b * SEQ + qb * 256;
                    run_attn<256, 2048>(PROJ + (size_t)M_TOK * 1280 + row * 256 + h4 * HD, MKV + (size_t)b * MEM_LEN * 2048 + i * 512 + h4 * HD, MKV + (size_t)b * MEM_LEN * 2048 + i * 512 + 256 + h4 * HD,
                                        MIX + row * DM + D_MAIN + h4 * HD, MEM_LEN / 64, (char*)lds_raw, wave); }
            }
        PHASE_END
        if (hy) {
            PHASE_BEGINK(4)
                REP(11) phase_transpose_mix(MIXT, MIX, lds, bx, G, tid);
            PHASE_END
        }
        PHASE_BEGINK(5)
            pg8::Gemm g{MIX, (const bf16*)(ws + WS_WOUT) + (size_t)i * DM * DM, M_TOK, DM, DM, 1 << 30, 1, 0};
            pg8::StaticOrder S; S.init(M_TOK, DM, G, bx);
            pg8::EpiOutX E{i == 0 ? x : (const float*)H, H, DM, ffn_g + i * DM, (const float*)(ws + WS_WRG) + (size_t)i * NEXP * DM, (unsigned char*)U, (float*)(ws + WS_PART), (float*)(ws + WS_PSS), M_TOK};
            pg8::gemm_phase<pg8::EpiOutX, pg8::StaticOrder, true, true>(lds, g, S, E, wave);
        PHASE_END
        PHASE_BEGINK(6)
            REP(13) phase_router_sum((const float*)(ws + WS_PART), (const float*)(ws + WS_PSS), (float*)(ws + WS_RSTD), AFF, gw, NGW, lane);
        PHASE_END
        PHASE_BEGINK(7)
            REP(14) phase_topk(AFF, (const float*)(ws + WS_RSTD), (float*)(ws + WS_RS), IDX, GATE, POS, lds + LDS_MISC, bx, G, tid, lane, wave);
            if (xw_sched && bx >= 32) xw_slice_b(XW, i, (LAS float*)(lds + wave * 16384), bx, wave, lane);
        PHASE_END
        PHASE_BEGINK(8)
            pg8::Gemm g{U, (const bf16*)(ws + WS_W1 + (size_t)i * NEXP * 1536 * DM), XROWS, 1536, DM / 2, 4, NEXP, (size_t)1536 * DM};
            pg8::StaticOrder S; S.init(XROWS, 1536, G, bx);
            pg8::EpiSwiGLU8 E{(unsigned char*)HID, EFF, 1.0f / W8_SCALE, (const float*)(ws + WS_RS)};
            REP(16) pg8::gemm_phase<pg8::EpiSwiGLU8, pg8::StaticOrder, true, true, true, true>(lds, g, S, E, wave, IDX);
        PHASE_END
        PHASE_BEGINK(9)
            pg8::Gemm g{HID, (const bf16*)(ws + WS_W2 + (size_t)i * NEXP * DM * EFF), XROWS, DM, EFF / 2, 4, NEXP, (size_t)DM * EFF};
            pg8::StaticOrder S; S.init(XROWS, DM, G, bx);
            pg8::EpiDown E{Y, DM, GATE, 1.0f / W8_SCALE};
            REP(17) pg8::gemm_phase<pg8::EpiDown, pg8::StaticOrder, true, true, false, true>(lds, g, S, E, wave);
        PHASE_END
    }
    PHASE_BEGINK(10)
        phase_norm<true, true>(H, nullptr, fin_g, nullptr, args.out, POS, Y, gw, NGW, lane);
    PHASE_END
#ifdef TSEL
#ifdef CSEL
    if (bx == 0 && threadIdx.x == 0) tacc_ += *(unsigned long long*)(ws0_ + 32768);
#endif
    if (bx == 0 && threadIdx.x == 0 && hi - lo > 1) { const unsigned long long te_ = __builtin_amdgcn_s_memrealtime(); while (__builtin_amdgcn_s_memrealtime() - te_ < (unsigned long long)TAMP * tacc_) __builtin_amdgcn_s_sleep(8); }
#endif
#undef PHASE_BEGINK
#undef U
#undef PROJ
#undef CQ
#undef MIX
#undef MIXT
#undef AFF
#undef IDX
#undef GATE
#undef POS
#undef HID
#undef Y
#undef TAPS
#undef MKV
#undef XW
#undef PHASE_END
}

extern "C" void kernel_launch(void* const* d_in, const int* in_sizes, int n_in, void* d_out, int out_size, void* d_ws, size_t ws_size, hipStream_t stream) {
    static int grid = 0;
    if (grid == 0) {
        if (n_in != 24 || out_size != M_TOK * DM || ws_size < WS_END) { fprintf(stderr, "kernel_launch: unexpected shapes (n_in %d out %d ws %zu need %zu)\n", n_in, out_size, ws_size, (size_t)WS_END); grid = -1; return; }
        int dev = 0, cus = 0, per_cu = 0;
        if (hipGetDevice(&dev) != hipSuccess || hipDeviceGetAttribute(&cus, hipDeviceAttributeMultiprocessorCount, dev) != hipSuccess) { grid = -1; return; }
        if (hipFuncSetAttribute((const void*)hybrid_fwd, hipFuncAttributeMaxDynamicSharedMemorySize, LDS_BYTES) != hipSuccess) { fprintf(stderr, "kernel_launch: hipFuncSetAttribute failed\n"); grid = -1; return; }
        if (hipOccupancyMaxActiveBlocksPerMultiprocessor(&per_cu, (const void*)hybrid_fwd, NTHREADS, LDS_BYTES) != hipSuccess || per_cu < 1) { fprintf(stderr, "kernel_launch: occupancy query says %d blocks/CU\n", per_cu); per_cu = 1; }
        (void)hipGetLastError();
        grid = cus;
    }
    if (grid < 0) return;
    if (hipMemsetAsync((char*)d_ws + WS_CTL, 0, 64 * 1024, stream) != hipSuccess) { fprintf(stderr, "kernel_launch: memset failed\n"); return; }
    Args a{};
    for (int i = 0; i < 24; ++i) a.in[i] = (const float*)d_in[i];
    a.out = (float*)d_out; a.ws = (unsigned char*)d_ws;
#if MK_PER_PHASE
    for (int li = 0; li < N_PHASES; ++li) {
        a.ph_lo = li; a.ph_hi = li + 1;
        void* kargs[] = {&a};
        hipError_t e = hipLaunchCooperativeKernel((const void*)hybrid_fwd, dim3(grid), dim3(NTHREADS), kargs, LDS_BYTES, stream);
        if (e != hipSuccess) { fprintf(stderr, "kernel_launch: launch %d failed: %s\n", li, hipGetErrorString(e)); break; }
    }
#else
    a.ph_lo = 0; a.ph_hi = N_PHASES;
    void* kargs[] = {&a};
    hipError_t e = hipLaunchCooperativeKernel((const void*)hybrid_fwd, dim3(grid), dim3(NTHREADS), kargs, LDS_BYTES, stream);
    if (e != hipSuccess) fprintf(stderr, "kernel_launch: cooperative launch failed: %s (grid %d)\n", hipGetErrorString(e), grid);
#endif
}
```

```cpp
#include <hip/hip_runtime.h>
#include <hip/hip_cooperative_groups.h>
#include <hip/hip_bf16.h>
#include <cmath>
#include <cstdio>
#include <cstdint>
namespace cg = cooperative_groups;

constexpr int BATCH = 2, SEQ = 8192, DM = 1024, DEPTH = 4, M_TOK = BATCH * SEQ;
constexpr int HD = 64, MEM_LEN = 256, D_MEM = 256, D_MAIN = 768, NQH = 12, NKVH = 4;
constexpr int D_IN_HY = 2560, D_IN_AT = 1536;
constexpr int NEXP = 16, CAP = 1024, EFF = 768, NGRP = BATCH * NEXP, XROWS = NGRP * CAP;
constexpr int HY_EMB = 33, HY_FILT = 64, FCOLS = 4 * D_MAIN;
constexpr float NORM_EPS = 1e-6f;
constexpr float W8_SCALE = 32.0f;
constexpr float ATT_C2 = 0.125f * 1.4426950408889634f;

constexpr size_t MiB = 1u << 20;
constexpr size_t WS_CTL = 0;
constexpr size_t WS_WHY = 2 * MiB;
constexpr size_t WS_WAT = 12 * MiB;
constexpr size_t WS_WOUT = 18 * MiB;
constexpr size_t WS_WMKV = 26 * MiB;
constexpr size_t WS_W1 = 32 * MiB;
constexpr size_t WS_W2 = 224 * MiB;
constexpr size_t WS_U = 320 * MiB;
constexpr size_t WS_PROJ = 352 * MiB;
constexpr size_t WS_CQ = WS_PROJ + 72 * MiB;
constexpr size_t WS_MIX = 432 * MiB;
constexpr size_t WS_MIXT = 464 * MiB;
constexpr size_t WS_AFF = 488 * MiB;
constexpr size_t WS_IDX = 489 * MiB;
constexpr size_t WS_GATE = WS_IDX + 128 * 1024;
constexpr size_t WS_POS = 490 * MiB;
constexpr size_t WS_XG = 492 * MiB;
constexpr size_t WS_HID = 556 * MiB;
constexpr size_t WS_TAPS = WS_XG;
constexpr size_t WS_Y = 604 * MiB;
constexpr size_t WS_FFTX = WS_Y;
constexpr size_t WS_H2 = 668 * MiB;
constexpr size_t WS_MEMN = 672 * MiB;
constexpr size_t WS_MKV = 673 * MiB;
constexpr size_t WS_PART = 676 * MiB;
constexpr size_t WS_PSS = 692 * MiB;
constexpr size_t WS_RSTD = 697 * MiB;
constexpr size_t WS_RS = WS_RSTD + 128 * 1024;
constexpr size_t WS_WRG = 698 * MiB;
constexpr size_t WS_ZS = 700 * MiB;
constexpr size_t WS_END = 732 * MiB;

constexpr int LDS_RING = 0;
constexpr int LDS_MISC = 132 * 1024;
constexpr int LDS_BYTES = 140 * 1024;
constexpr int NTHREADS = 512, NWAVES = 8;

#define GAS __attribute__((address_space(1)))
#define LAS __attribute__((address_space(3)))
typedef unsigned short bf16;
typedef unsigned v4u __attribute__((ext_vector_type(4)));
typedef unsigned v2u __attribute__((ext_vector_type(2)));
typedef float f32x4 __attribute__((ext_vector_type(4)));
typedef float f32x2 __attribute__((ext_vector_type(2)));
__device__ __forceinline__ unsigned f2bf(float f) { unsigned u = __builtin_bit_cast(unsigned, f); return (u + 0x7fffu + ((u >> 16) & 1u)) >> 16; }
__device__ __forceinline__ unsigned pk2(float lo, float hi) { return f2bf(lo) | (f2bf(hi) << 16); }
__device__ __forceinline__ float bf2f(unsigned short h) { return __builtin_bit_cast(float, (unsigned)h << 16); }
__device__ __forceinline__ float bflo(unsigned w) { return __builtin_bit_cast(float, w << 16); }
__device__ __forceinline__ float bfhi(unsigned w) { return __builtin_bit_cast(float, w & 0xffff0000u); }
__device__ __forceinline__ float wave_sum(float v) {
#pragma unroll
    for (int o = 1; o < 64; o <<= 1) v += __shfl_xor(v, o);
    return v;
}
__device__ __forceinline__ int opaque_tid(int wave_s) { int l; asm volatile("v_mbcnt_lo_u32_b32 %0, -1, 0\n\tv_mbcnt_hi_u32_b32 %0, -1, %0" : "=v"(l)); return (wave_s << 6) | l; }
#define MK_PER_PHASE 0

#define XB_TMO      128
#define XB_XCNT(j)  (256  + 64 * (j))
#define XB_XSUB(j)  (1280 + 64 * (j))
#define XB_XGEN(j)  (2304 + 64 * (j))
#define XB_TOP      3328
#define XB_TOPGEN   3392
#define XCD_BAR_WORDS 3456
#define XB_SPIN_CAP (1u << 18)

__device__ __forceinline__ unsigned xb_ld(unsigned* p)              { return __hip_atomic_load(p, __ATOMIC_RELAXED, __HIP_MEMORY_SCOPE_AGENT); }
__device__ __forceinline__ unsigned xb_add(unsigned* p, unsigned v) { return __hip_atomic_fetch_add(p, v, __ATOMIC_RELAXED, __HIP_MEMORY_SCOPE_AGENT); }
__device__ __forceinline__ unsigned xb_xcc_id() { return (unsigned)__builtin_amdgcn_s_getreg((3 << 11) | 20) & 0xFu; }
#define XB_SPIN(cond, bar) do { unsigned _sp = 0; while (cond) { __builtin_amdgcn_s_sleep(1); \
    if ((++_sp & 255u) == 0u) { if (xb_ld(&(bar)[XB_TMO])) break; if (_sp > XB_SPIN_CAP) { atomicAdd(&(bar)[XB_TMO], 1u); break; } } } } while (0)

struct XcdBarrier {
    unsigned* bar; unsigned x;
    volatile LAS unsigned* st;
};

__device__ __forceinline__ XcdBarrier xcd_barrier_post(unsigned* bar, volatile LAS unsigned* st) {
    XcdBarrier b; b.bar = bar; b.x = xb_xcc_id(); b.st = st;
    if (threadIdx.x == 0) (void)xb_add(&bar[XB_XCNT(b.x)], 1u);
    return b;
}
__device__ __forceinline__ void xcd_barrier_complete(unsigned* bar, unsigned x, unsigned& nloc, unsigned& nx) {
    const unsigned G = gridDim.x * gridDim.y * gridDim.z;
    unsigned sum, cnt, mine, sp = 0u;
    for (;;) {
        sum = 0u; cnt = 0u; mine = 0u;
#pragma unroll
        for (unsigned j = 0; j < 16; ++j) { const unsigned c = xb_ld(&bar[XB_XCNT(j)]); sum += c; cnt += (c > 0u) ? 1u : 0u; mine = (j == x) ? c : mine; }
        if (sum == G) break;
        __builtin_amdgcn_s_sleep(1);
        if ((++sp & 255u) == 0u) { if (xb_ld(&bar[XB_TMO])) break; if (sp > XB_SPIN_CAP) { atomicAdd(&bar[XB_TMO], 1u); break; } }
    }
    nloc = mine > 0u ? mine : 1u; nx = cnt > 0u ? cnt : 1u;
}

__device__ __forceinline__ void xcd_barrier(const XcdBarrier& b) {
    asm volatile("s_waitcnt vmcnt(0)" ::: "memory");
    __syncthreads();
    if (threadIdx.x == 0) {
        unsigned* bar = b.bar;
        __builtin_amdgcn_s_waitcnt(0);
        unsigned nloc = b.st[0], nx = b.st[1];
        if (nloc == 0u) { xcd_barrier_complete(bar, b.x, nloc, nx); b.st[0] = nloc; b.st[1] = nx; }
        const unsigned old = xb_add(&bar[XB_XSUB(b.x)], 1u);
        const unsigned gen = old / nloc;
        if (old + 1u == (gen + 1u) * nloc) {
            __builtin_amdgcn_fence(__ATOMIC_RELEASE, "agent");
            asm volatile("s_waitcnt vmcnt(0)" ::: "memory");
            const unsigned og = xb_add(&bar[XB_TOP], 1u);
            const unsigned tg = og / nx;
            if (og + 1u == (tg + 1u) * nx) xb_add(&bar[XB_TOPGEN], 1u);
            else XB_SPIN(xb_ld(&bar[XB_TOPGEN]) == tg, bar);
            __builtin_amdgcn_fence(__ATOMIC_ACQUIRE, "agent");
            xb_add(&bar[XB_XGEN(b.x)], 1u);
            asm volatile("s_waitcnt vmcnt(0)" ::: "memory");
        } else {
            XB_SPIN(xb_ld(&bar[XB_XGEN(b.x)]) == gen, bar);
            __builtin_amdgcn_fence(__ATOMIC_ACQUIRE, "agent");
            asm volatile("s_waitcnt vmcnt(0)" ::: "memory");
        }
    }
    __syncthreads();
}
namespace pg8 {
#define PG8_LAS __attribute__((address_space(3)))
typedef unsigned short bf16_t;
typedef short bf16x8 __attribute__((ext_vector_type(8)));
typedef float f32x4 __attribute__((ext_vector_type(4)));
typedef unsigned u32x4 __attribute__((ext_vector_type(4)));
constexpr int BM = 256, BK = 64, HALF = 128, HTB = HALF * BK * 2  , STAGE_BYTES = 8 * HTB, NXCD = 8, WGM = 8;

__host__ __device__ __forceinline__ int lds_byte(int r, int c) { const int st = (r >> 4) * 2 + (c >> 5), rr = r & 15, cc = c & 31, ob = rr * 64 + cc * 2; return st * 1024 + (ob ^ (((ob >> 9) & 1) << 5)); }
__host__ __device__ __forceinline__ void stage_rc(int b, int& R, int& C) { const int st = b / 1024, sb = b % 1024, swz = sb ^ (((sb >> 9) & 1) << 5); R = (st >> 1) * 16 + swz / 64; C = (st & 1) * 32 + (swz % 64) / 2; }
__host__ __device__ __forceinline__ int perm32(int rho) { const int n = rho >> 4, i = rho & 15; return 8 * (i >> 2) + 4 * n + (i & 3); }

struct Unit { int pm, pn; };
struct Gemm { const bf16_t* A; const bf16_t* Bt; int M, N, K; int gdiv, gmod; size_t gstride; };

struct StaticOrder {
    int nM, nN, nwg, G, c;
    __host__ __device__ void init(int M, int N, int G_, int c_) { nM = M / BM; nN = N / BM; nwg = nM * nN; G = G_; c = c_; }
    __host__ __device__ bool next(int i, Unit& u) const {
        const long L = (long)i * G + c; if (L >= nwg) return false;
        int wgid = (int)L; { const int q = nwg / NXCD, r = nwg % NXCD, xcd = wgid % NXCD, off = wgid / NXCD; wgid = (xcd < r ? xcd * (q + 1) : r * (q + 1) + (xcd - r) * q) + off; }
        const int nig = WGM * nN, gid = wgid / nig, fm = gid * WGM, gsz = (nM - fm) < WGM ? (nM - fm) : WGM;
        u.pm = fm + ((wgid % nig) % gsz); u.pn = (wgid % nig) / gsz; return true;
    }
    __device__ __forceinline__ void a_ready(const Unit&) const {}
    __device__ __forceinline__ void done(const Unit&) const {}
};


__device__ __forceinline__ unsigned cvt_pk_bf16(float lo, float hi) { unsigned r; asm volatile("v_cvt_pk_bf16_f32 %0, %1, %2" : "=v"(r) : "v"(lo), "v"(hi)); return r; }
typedef unsigned u32x2 __attribute__((ext_vector_type(2)));
struct EpiRowBf16 {
    static constexpr bool PERM = false, AFTER_DRAIN = false;
    bf16_t* O; int ldc; int sc_pn; float sc;
    __device__ __forceinline__ void operator()(const f32x4 (&acc)[2][2][4][2], const Unit& u, int wr, int wc, int fr, int fq) const {
        const float s = (u.pn == sc_pn) ? sc : 1.f;
        const int row0 = u.pm * BM + wr * 64 + fr, col0 = u.pn * BM + wc * 32 + 4 * fq;
#pragma unroll
        for (int ai = 0; ai < 2; ++ai)
#pragma unroll
            for (int m = 0; m < 4; ++m) { bf16_t* rowp = O + (size_t)(row0 + ai * HALF + m * 16) * ldc + col0;
#pragma unroll
                for (int bj = 0; bj < 2; ++bj)
#pragma unroll
                    for (int n = 0; n < 2; ++n) { const f32x4 v = acc[ai][bj][m][n] * s; u32x2 w; w.x = cvt_pk_bf16(v[0], v[1]); w.y = cvt_pk_bf16(v[2], v[3]);
                        *(u32x2*)(rowp + bj * HALF + n * 16) = w; } }
    }
};
struct EpiHyIn {
    static constexpr bool PERM = false, AFTER_DRAIN = false;
    bf16_t* OT; int ldt; int tp_tiles; bf16_t* CQ; float sc;
    __device__ __forceinline__ void operator()(const f32x4 (&acc)[2][2][4][2], const Unit& u, int wr, int wc, int fr, int fq) const {
        const int row0 = u.pm * BM + wr * 64 + fr;
        if (u.pn < tp_tiles) {
            const int col0 = u.pn * BM + wc * 32 + 4 * fq;
#pragma unroll
            for (int ai = 0; ai < 2; ++ai)
#pragma unroll
                for (int m = 0; m < 4; ++m) { const int row = row0 + ai * HALF + m * 16;
#pragma unroll
                    for (int bj = 0; bj < 2; ++bj)
#pragma unroll
                        for (int n = 0; n < 2; ++n) { const f32x4 v = acc[ai][bj][m][n]; const unsigned w0 = cvt_pk_bf16(v[0], v[1]), w1 = cvt_pk_bf16(v[2], v[3]);
                            bf16_t* p = OT + (size_t)(col0 + bj * HALF + n * 16) * ldt + row;
                            p[0] = (bf16_t)(w0 & 0xffffu); p[(size_t)ldt] = (bf16_t)(w0 >> 16); p[(size_t)2 * ldt] = (bf16_t)(w1 & 0xffffu); p[(size_t)3 * ldt] = (bf16_t)(w1 >> 16); } }
        } else {
            const int col0 = wc * 32 + 4 * fq;
#pragma unroll
            for (int ai = 0; ai < 2; ++ai)
#pragma unroll
                for (int m = 0; m < 4; ++m) { bf16_t* rowp = CQ + (size_t)(row0 + ai * HALF + m * 16) * 256 + col0;
#pragma unroll
                    for (int bj = 0; bj < 2; ++bj)
#pragma unroll
                        for (int n = 0; n < 2; ++n) { const f32x4 v = acc[ai][bj][m][n] * sc; u32x2 w; w.x = cvt_pk_bf16(v[0], v[1]); w.y = cvt_pk_bf16(v[2], v[3]);
                            *(u32x2*)(rowp + bj * HALF + n * 16) = w; } }
        }
    }
};
struct EpiAtIn {
    static constexpr bool PERM = false, AFTER_DRAIN = false;
    bf16_t* Oq; bf16_t* Ok; bf16_t* Ov; bf16_t* Oc; const float* gq; const float* gk; float csc; float eps; int seq_mask;
    __device__ __forceinline__ void operator()(const f32x4 (&acc)[2][2][4][2], const Unit& u, int wr, int wc, int fr, int fq) const {
        const int row0 = u.pm * BM + wr * 64 + fr, colb = (u.pn < 3 ? u.pn * BM : 0) + wc * 64 + 4 * fq; const int ldc = u.pn < 3 ? 768 : 256;
        bf16_t* O = u.pn < 3 ? Oq : (u.pn == 3 ? Ok : (u.pn == 4 ? Ov : Oc));
        if (u.pn <= 3) {
            const float* gp = (u.pn == 3 ? gk : gq) + 4 * fq; const float osc = (u.pn == 3) ? 1.f : csc;
            float invr[4];
#pragma unroll
            for (int q = 0; q < 4; ++q) invr[q] = exp2f(-(float)(4 * fq + q) * (13.287712379549449f / 16.0f)) * 0.15915494309189535f;
#pragma unroll
            for (int ai = 0; ai < 2; ++ai)
#pragma unroll
                for (int m = 0; m < 4; ++m) {
                    const int row = row0 + ai * HALF + m * 16; int t = row & seq_mask; asm volatile("" : "+v"(t));
                    float ss = 0.f;
#pragma unroll
                    for (int bj = 0; bj < 2; ++bj)
#pragma unroll
                        for (int n = 0; n < 2; ++n) { const f32x4 x = acc[ai][bj][m][n]; ss += (x[0] * x[0] + x[1] * x[1]) + (x[2] * x[2] + x[3] * x[3]); }
                    ss += __shfl_xor(ss, 16); ss += __shfl_xor(ss, 32);
                    const float rs = osc * __builtin_amdgcn_rsqf(ss * (1.0f / 64.0f) + eps);
                    bf16_t* rowp = O + (size_t)row * ldc + colb;
#pragma unroll
                    for (int bj = 0; bj < 2; ++bj) {
                        const float pos = (float)(bj == 0 ? (t >> 6) : (t & 63));
                        const f32x4 xa = acc[ai][bj][m][0] * rs * *(const f32x4*)(gp + 32 * bj), xb = acc[ai][bj][m][1] * rs * *(const f32x4*)(gp + 32 * bj + 16);
                        f32x4 oa, ob;
#pragma unroll
                        for (int q = 0; q < 4; ++q) { const float rev = pos * invr[q]; const float c = __builtin_amdgcn_cosf(rev), s = __builtin_amdgcn_sinf(rev);
                            oa[q] = xa[q] * c - xb[q] * s; ob[q] = xa[q] * s + xb[q] * c; }
                        u32x2 w; w.x = cvt_pk_bf16(oa[0], oa[1]); w.y = cvt_pk_bf16(oa[2], oa[3]); *(u32x2*)(rowp + 32 * bj) = w;
                        w.x = cvt_pk_bf16(ob[0], ob[1]); w.y = cvt_pk_bf16(ob[2], ob[3]); *(u32x2*)(rowp + 32 * bj + 16) = w;
                    }
                    asm volatile("" ::: "memory");
                }
        } else {
            const float s = (u.pn == 5) ? csc : 1.f;
#pragma unroll
            for (int ai = 0; ai < 2; ++ai)
#pragma unroll
                for (int m = 0; m < 4; ++m) { bf16_t* rowp = O + (size_t)(row0 + ai * HALF + m * 16) * ldc + colb;
#pragma unroll
                    for (int bj = 0; bj < 2; ++bj)
#pragma unroll
                        for (int n = 0; n < 2; ++n) { const f32x4 v = acc[ai][bj][m][n] * s; u32x2 w; w.x = cvt_pk_bf16(v[0], v[1]); w.y = cvt_pk_bf16(v[2], v[3]);
                            *(u32x2*)(rowp + 32 * bj + 16 * n) = w; } }
        }
    }
};
struct EpiResF32 {
    static constexpr bool PERM = false, AFTER_DRAIN = false;
    const float* res; float* out; int ldc;
    __device__ __forceinline__ void operator()(const f32x4 (&acc)[2][2][4][2], const Unit& u, int wr, int wc, int fr, int fq) const {
        const int row0 = u.pm * BM + wr * 64 + fr, col0 = u.pn * BM + wc * 32 + 4 * fq;
#pragma unroll
        for (int ai = 0; ai < 2; ++ai)
#pragma unroll
            for (int m = 0; m < 4; ++m) { const size_t off = (size_t)(row0 + ai * HALF + m * 16) * ldc + col0;
#pragma unroll
                for (int bj = 0; bj < 2; ++bj)
#pragma unroll
                    for (int n = 0; n < 2; ++n) { const f32x4 r = *(const f32x4*)(res + off + bj * HALF + n * 16); *(f32x4*)(out + off + bj * HALF + n * 16) = r + acc[ai][bj][m][n]; } }
    }
};
__device__ __forceinline__ unsigned pk4_fp8_sat(const f32x4 x) {
    unsigned w = 0;
    w = __builtin_amdgcn_cvt_pk_fp8_f32(__builtin_amdgcn_fmed3f(x[0], -448.f, 448.f), __builtin_amdgcn_fmed3f(x[1], -448.f, 448.f), w, false);
    w = __builtin_amdgcn_cvt_pk_fp8_f32(__builtin_amdgcn_fmed3f(x[2], -448.f, 448.f), __builtin_amdgcn_fmed3f(x[3], -448.f, 448.f), w, true);
    return w;
}
struct EpiOutX {
    static constexpr bool PERM = true, AFTER_DRAIN = false;
    const float* res; float* out; int ldc; const float* gain; const float* WrG; unsigned char* XN8; float* PLG; float* PSS; int M;
    static __device__ __forceinline__ void split8(const f32x4 a, const f32x4 b, bf16x8& hi, bf16x8& lo) {
        u32x4 h, l; float r[8] = {a[0], a[1], a[2], a[3], b[0], b[1], b[2], b[3]};
#pragma unroll
        for (int k = 0; k < 4; ++k) { const unsigned p = cvt_pk_bf16(r[2 * k], r[2 * k + 1]); h[k] = p;
            const float d0 = r[2 * k] - __builtin_bit_cast(float, p << 16), d1 = r[2 * k + 1] - __builtin_bit_cast(float, p & 0xffff0000u); l[k] = cvt_pk_bf16(d0, d1); }
        hi = __builtin_bit_cast(bf16x8, h); lo = __builtin_bit_cast(bf16x8, l);
    }
    __device__ __forceinline__ void operator()(f32x4 (&acc)[2][2][4][2], const Unit& u, int wr, int wc, int fr, int fq) const {
        const int row0 = u.pm * BM + wr * 64 + fr, col0 = u.pn * BM + wc * 32 + 8 * fq, slot = u.pn * 4 + wc;
        bf16x8 whi[2], wlo[2];
#pragma unroll
        for (int bj = 0; bj < 2; ++bj) { const float* wp = WrG + (size_t)fr * ldc + col0 + bj * HALF; split8(*(const f32x4*)wp, *(const f32x4*)(wp + 4), whi[bj], wlo[bj]); }
#pragma unroll
        for (int idx = 0; idx < 8; ++idx) { const int ai = idx >> 2, m = idx & 3;
            const int row = row0 + ai * HALF + m * 16; const size_t off = (size_t)row * ldc + col0; float ss = 0.f; f32x4 lg = (f32x4){0.f, 0.f, 0.f, 0.f}; u32x4 xw;
#pragma unroll
            for (int bj = 0; bj < 2; ++bj) {
#pragma unroll
                for (int n = 0; n < 2; ++n) { const int co = bj * HALF + n * 4;
                    const f32x4 h = *(const f32x4*)(res + off + co) + acc[ai][bj][m][n]; acc[ai][bj][m][n] = h; *(f32x4*)(out + off + co) = h;
                    ss += (h[0] * h[0] + h[1] * h[1]) + (h[2] * h[2] + h[3] * h[3]);
                    const f32x4 x = h * *(const f32x4*)(gain + col0 + co);
                    xw[bj * 2 + n] = pk4_fp8_sat(x); }
                bf16x8 hhi, hlo; split8(acc[ai][bj][m][0], acc[ai][bj][m][1], hhi, hlo);
                lg = __builtin_amdgcn_mfma_f32_16x16x32_bf16(wlo[bj], hhi, lg, 0, 0, 0);
                lg = __builtin_amdgcn_mfma_f32_16x16x32_bf16(whi[bj], hlo, lg, 0, 0, 0);
                lg = __builtin_amdgcn_mfma_f32_16x16x32_bf16(whi[bj], hhi, lg, 0, 0, 0); }
            *(u32x4*)(XN8 + (size_t)row * ldc + u.pn * BM + wc * 64 + fq * 16) = xw;
            ss += __shfl_xor(ss, 16); ss += __shfl_xor(ss, 32);
            if (fq == 0) PSS[(size_t)slot * M + row] = ss;
            *(f32x4*)(PLG + ((size_t)slot * M + row) * 16 + 4 * fq) = lg;
            asm volatile("" ::: "memory"); }
    }
};
struct EpiSwiGLU {
    static constexpr bool PERM = false, AFTER_DRAIN = false;
    bf16_t* O; int ldc;
    __device__ __forceinline__ void operator()(const f32x4 (&acc)[2][2][4][2], const Unit& u, int wr, int wc, int fr, int fq) const {
        const int row0 = u.pm * BM + wr * 64 + fr, col0 = u.pn * HALF + wc * 32 + 4 * fq;
#pragma unroll
        for (int ai = 0; ai < 2; ++ai)
#pragma unroll
            for (int m = 0; m < 4; ++m) { bf16_t* rowp = O + (size_t)(row0 + ai * HALF + m * 16) * ldc + col0;
#pragma unroll
                for (int n = 0; n < 2; ++n) { const f32x4 g = acc[ai][0][m][n], up = acc[ai][1][m][n]; f32x4 h;
#pragma unroll
                    for (int q = 0; q < 4; ++q) h[q] = g[q] * up[q] * __builtin_amdgcn_rcpf(1.f + __expf(-g[q]));
                    u32x2 w; w.x = cvt_pk_bf16(h[0], h[1]); w.y = cvt_pk_bf16(h[2], h[3]); *(u32x2*)(rowp + n * 16) = w; } }
    }
};
struct EpiSwiGLU8 {
    static constexpr bool PERM = false, AFTER_DRAIN = false;
    unsigned char* O; int ldc; float wsc; const float* rs;
    __device__ __forceinline__ void operator()(const f32x4 (&acc)[2][2][4][2], const Unit& u, int wr, int wc, int fr, int fq) const {
        const int row0 = u.pm * BM + wr * 64 + fr, col0 = u.pn * HALF + wc * 32 + 4 * fq;
#pragma unroll
        for (int ai = 0; ai < 2; ++ai)
#pragma unroll
            for (int m = 0; m < 4; ++m) { const int row = row0 + ai * HALF + m * 16; const float sc = wsc * rs[row]; u32x2 hw;
#pragma unroll
                for (int n = 0; n < 2; ++n) { const f32x4 g = acc[ai][0][m][n] * sc, up = acc[ai][1][m][n] * sc; f32x4 h;
#pragma unroll
                    for (int q = 0; q < 4; ++q) h[q] = g[q] * up[q] * __builtin_amdgcn_rcpf(1.f + __expf(-g[q]));
                    hw[n] = pk4_fp8_sat(h); }
                *(u32x2*)(O + (size_t)row * ldc + u.pn * HALF + wc * 32 + fq * 8) = hw; }
    }
};
struct EpiDown {
    static constexpr bool PERM = true, AFTER_DRAIN = false;
    bf16_t* O; int ldc; const float* gate; float wsc;
    __device__ __forceinline__ void operator()(const f32x4 (&acc)[2][2][4][2], const Unit& u, int wr, int wc, int fr, int fq) const {
        const int row0 = u.pm * BM + wr * 64 + fr, col0 = u.pn * BM + wc * 32 + 8 * fq;
#pragma unroll
        for (int ai = 0; ai < 2; ++ai)
#pragma unroll
            for (int m = 0; m < 4; ++m) { const int row = row0 + ai * HALF + m * 16; const float gs = gate[row] * wsc; bf16_t* rowp = O + (size_t)row * ldc + col0;
#pragma unroll
                for (int bj = 0; bj < 2; ++bj) { const f32x4 v0 = acc[ai][bj][m][0] * gs, v1 = acc[ai][bj][m][1] * gs; u32x4 w;
                    w.x = cvt_pk_bf16(v0[0], v0[1]); w.y = cvt_pk_bf16(v0[2], v0[3]); w.z = cvt_pk_bf16(v1[0], v1[1]); w.w = cvt_pk_bf16(v1[2], v1[3]);
                    *(u32x4*)(rowp + bj * HALF) = w; } }
    }
};
template <class Epi, class Sched, bool ALIGN_EPI = false, bool SP2 = false, bool GATHER = false, bool FP8 = false>
__device__ __forceinline__ void gemm_phase(PG8_LAS unsigned char* lds, const Gemm g, const Sched& S, const Epi& E, int wave_s, const int* gidx = nullptr) {
    const int tid = opaque_tid(wave_s), wid = __builtin_amdgcn_readfirstlane(tid >> 6), lane = tid & 63, wr = wid >> 2, wc = wid & 3, fr = lane & 15, fq = lane >> 4;
    const int K = g.K, nt = K / BK;
    unsigned voffA[2], voffB[2];
#pragma unroll
    for (int i = 0; i < 2; ++i) { int R, C; stage_rc(tid * 16 + i * 8192, R, C); const int Rb = Epi::PERM ? ((R & ~31) + perm32(R & 31)) : R;
        voffA[i] = (unsigned)(R * K + C) * 2u; voffB[i] = (unsigned)(Rb * K + C) * 2u; }
    const size_t kstep = (size_t)(BK * 2);
    const size_t hstep = (size_t)HALF * K * 2;
    const size_t tstep = 2 * hstep;
    const unsigned ldsw = (unsigned)wid * 1024u;
    const int aoff = lds_byte(wr * 64 + fr, fq * 8), boff = lds_byte(wc * 32 + fr, fq * 8);
#define PG8_SA(b, h) (((b) * 2 + (h)) * HTB)
#define PG8_SB(b, h) ((4 + (b) * 2 + (h)) * HTB)
#define PG8_STAGE(bufoff, gbase, voff) do { _Pragma("unroll") for (int _i = 0; _i < 2; ++_i) \
        __builtin_amdgcn_global_load_lds((const unsigned*)((const char*)(gbase) + (voff)[_i]), (PG8_LAS unsigned*)(lds + (bufoff) + ldsw + _i * 8192), 16, 0, 0); } while (0)
#define PG8_LDA(dst, b, h) do { _Pragma("unroll") for (int m = 0; m < 4; ++m) { if constexpr (FP8) { const v4i_ lo_ = *(const PG8_LAS v4i_*)(lds + PG8_SA(b, h) + aoff + m * 2048), hi_ = *(const PG8_LAS v4i_*)(lds + PG8_SA(b, h) + aoff + m * 2048 + 1024); \
        dst##8[m] = __builtin_shufflevector(lo_, hi_, 0, 1, 2, 3, 4, 5, 6, 7); } else { _Pragma("unroll") for (int k = 0; k < 2; ++k) dst[m][k] = *(const PG8_LAS bf16x8*)(lds + PG8_SA(b, h) + aoff + m * 2048 + k * 1024); } } } while (0)
#define PG8_LDB(dst, b, h) do { _Pragma("unroll") for (int n = 0; n < 2; ++n) { if constexpr (FP8) { const v4i_ lo_ = *(const PG8_LAS v4i_*)(lds + PG8_SB(b, h) + boff + n * 2048), hi_ = *(const PG8_LAS v4i_*)(lds + PG8_SB(b, h) + boff + n * 2048 + 1024); \
        dst##8[n] = __builtin_shufflevector(lo_, hi_, 0, 1, 2, 3, 4, 5, 6, 7); } else { _Pragma("unroll") for (int k = 0; k < 2; ++k) dst[n][k] = *(const PG8_LAS bf16x8*)(lds + PG8_SB(b, h) + boff + n * 2048 + k * 1024); } } } while (0)
#define PG8_MMA(ai, bj, At, Bt) do { __builtin_amdgcn_s_setprio(1); _Pragma("unroll") for (int m = 0; m < 4; ++m) _Pragma("unroll") for (int n = 0; n < 2; ++n) { \
        if constexpr (FP8) asm volatile("v_mfma_scale_f32_16x16x128_f8f6f4 %0, %1, %2, %0, %3, %3 op_sel_hi:[0,0,0]" : "+v"(acc[ai][bj][m][n]) : "v"(Bt##8[n]), "v"(At##8[m]), "v"(sc127_));   \
        else { _Pragma("unroll") for (int k = 0; k < 2; ++k) acc[ai][bj][m][n] = __builtin_amdgcn_mfma_f32_16x16x32_bf16(Bt[n][k], At[m][k], acc[ai][bj][m][n], 0, 0, 0); } } \
        __builtin_amdgcn_s_setprio(0); } while (0)
#define PG8_WAIT_V(n) asm volatile("s_waitcnt vmcnt(" #n ")" ::: "memory")
#define PG8_WAIT_L(n) asm volatile("s_waitcnt lgkmcnt(" #n ")" ::: "memory")
#define PG8_BAR __builtin_amdgcn_s_barrier()
#define PG8_SCHED __builtin_amdgcn_sched_barrier(0)
    Unit cur, nxt; int ui = 0;
    if (!S.next(0, cur)) return;
    f32x4 acc[2][2][4][2];
#pragma unroll
    for (int a = 0; a < 2; ++a)
#pragma unroll
        for (int b = 0; b < 2; ++b)
#pragma unroll
            for (int m = 0; m < 4; ++m)
#pragma unroll
                for (int n = 0; n < 2; ++n) acc[a][b][m][n] = (f32x4){0.f, 0.f, 0.f, 0.f};
    typedef int v8i_ __attribute__((ext_vector_type(8))); typedef int v4i_ __attribute__((ext_vector_type(4)));
    const int sc127_ = 127;
    bf16x8 At[4][2], B0[2][2], B1[2][2]; v8i_ At8[4], B08[2], B18[2];
    static_assert(SP2, "this copy of the body keeps only the SP2 K-loop up to date");
    int rA[2]; { int R_, C_; stage_rc(tid * 16, R_, C_); rA[0] = R_; stage_rc(tid * 16 + 8192, R_, C_); rA[1] = R_; }
    unsigned cvp[2], nvp[2], c2_[2]; c2_[0] = voffA[0] - (unsigned)(rA[0] * K) * 2u; c2_[1] = voffA[1] - (unsigned)(rA[1] * K) * 2u;
#define PG8_ROWOFF(dst, unit) do { _Pragma("unroll") for (int i_ = 0; i_ < 2; ++i_) dst[i_] = (unsigned)gidx[(unit).pm * BM + rA[i_]] | ((unsigned)gidx[(unit).pm * BM + HALF + rA[i_]] << 16); } while (0)
#define PG8_STAGE_A(bufoff, gbase, P, H) do { if constexpr (GATHER) { unsigned to_[2]; _Pragma("unroll") for (int i_ = 0; i_ < 2; ++i_) to_[i_] = ((P[i_] >> (16 * (H))) & 0xffffu) * (unsigned)(K * 2) + c2_[i_]; PG8_STAGE(bufoff, gbase, to_); } \
        else { PG8_STAGE(bufoff, (gbase) + ((H) ? hstep : (size_t)0), voffA); } } while (0)
    if constexpr (GATHER) PG8_ROWOFF(cvp, cur); else { cvp[0] = 0u; cvp[1] = 0u; }
    const char* cA = GATHER ? (const char*)g.A : (const char*)g.A + (size_t)cur.pm * tstep; const char* cB = (const char*)g.Bt + (size_t)((cur.pm / g.gdiv) % g.gmod) * g.gstride + (size_t)cur.pn * tstep;
    S.a_ready(cur);
    if constexpr (SP2) {
        PG8_STAGE(PG8_SB(0, 0), cB, voffB); PG8_STAGE(PG8_SB(0, 1), cB + hstep, voffB); PG8_STAGE_A(PG8_SA(0, 0), cA, cvp, 0); PG8_STAGE_A(PG8_SA(0, 1), cA, cvp, 1);
        if (wr == 1) PG8_BAR;
        PG8_WAIT_V(2); PG8_BAR;
        PG8_STAGE(PG8_SB(1, 0), cB + kstep, voffB); PG8_STAGE_A(PG8_SA(1, 0), cA + kstep, cvp, 0); PG8_STAGE(PG8_SB(1, 1), cB + hstep + kstep, voffB);
        PG8_WAIT_V(6); PG8_BAR;
    } else {
        PG8_STAGE(PG8_SB(0, 0), cB, voffB); PG8_STAGE(PG8_SA(0, 0), cA, voffA); PG8_STAGE(PG8_SB(0, 1), cB + hstep, voffB); PG8_STAGE(PG8_SA(0, 1), cA + hstep, voffA);
        if (wr == 1) PG8_BAR;
        PG8_WAIT_V(4); PG8_BAR;
        PG8_STAGE(PG8_SB(1, 0), cB + kstep, voffB); PG8_STAGE(PG8_SA(1, 0), cA + kstep, voffA); PG8_STAGE(PG8_SB(1, 1), cB + hstep + kstep, voffB);
        PG8_WAIT_V(6); PG8_BAR;
    }
    for (;;) {
        const bool has_next = S.next(ui + 1, nxt);
        if constexpr (GATHER) { if (has_next) PG8_ROWOFF(nvp, nxt); else { nvp[0] = cvp[0]; nvp[1] = cvp[1]; } } else { nvp[0] = 0u; nvp[1] = 0u; }
        const char* nA = GATHER ? (const char*)g.A : (has_next ? (const char*)g.A + (size_t)nxt.pm * tstep : cA); const char* nB = has_next ? (const char*)g.Bt + (size_t)((nxt.pm / g.gdiv) % g.gmod) * g.gstride + (size_t)nxt.pn * tstep : cB;
        for (int t = 0; t < nt; t += 2) {
            const bool last = (t == nt - 2);
            unsigned svp[2]; svp[0] = last ? nvp[0] : cvp[0]; svp[1] = last ? nvp[1] : cvp[1];
            const char* a1 = cA + (size_t)(t + 1) * kstep;
            const char* a2 = last ? nA : cA + (size_t)(t + 2) * kstep; const char* b2 = last ? nB : cB + (size_t)(t + 2) * kstep;
            const char* a3 = a2 + kstep; const char* b3 = b2 + kstep;
            if (last && has_next) S.a_ready(nxt);
            if constexpr (SP2) {
            PG8_LDB(B0, 0, 0); PG8_LDB(B1, 0, 1); PG8_SCHED; PG8_LDA(At, 0, 0); PG8_STAGE_A(PG8_SA(1, 1), a1, cvp, 1);
            PG8_WAIT_V(8); PG8_WAIT_L(0); PG8_BAR; PG8_MMA(0, 0, At, B0); PG8_MMA(0, 1, At, B1); PG8_BAR; PG8_SCHED;
            PG8_LDA(At, 0, 1); PG8_STAGE(PG8_SB(0, 0), b2, voffB); PG8_STAGE(PG8_SB(0, 1), b2 + hstep, voffB); PG8_STAGE_A(PG8_SA(0, 0), a2, svp, 0);
            PG8_WAIT_V(8); PG8_WAIT_L(0); PG8_BAR; PG8_MMA(1, 0, At, B0); PG8_MMA(1, 1, At, B1); PG8_BAR; PG8_SCHED;
            PG8_LDB(B0, 1, 0); PG8_LDB(B1, 1, 1); PG8_SCHED; PG8_LDA(At, 1, 0); PG8_STAGE_A(PG8_SA(0, 1), a2, svp, 1);
            PG8_WAIT_V(8); PG8_WAIT_L(0); PG8_BAR; PG8_MMA(0, 0, At, B0); PG8_MMA(0, 1, At, B1); PG8_BAR; PG8_SCHED;
            PG8_LDA(At, 1, 1); PG8_STAGE(PG8_SB(1, 0), b3, voffB); PG8_STAGE(PG8_SB(1, 1), b3 + hstep, voffB); PG8_STAGE_A(PG8_SA(1, 0), a3, svp, 0);
            PG8_WAIT_V(8); PG8_WAIT_L(0); PG8_BAR; PG8_MMA(1, 0, At, B0); PG8_MMA(1, 1, At, B1); PG8_BAR; PG8_SCHED;
            } else {
            PG8_LDB(B0, 0, 0); PG8_SCHED; PG8_LDA(At, 0, 0); PG8_STAGE(PG8_SA(1, 1), a1 + hstep, voffA);
            PG8_WAIT_L(8); PG8_BAR; PG8_WAIT_L(0); PG8_MMA(0, 0, At, B0); PG8_BAR; PG8_SCHED;
            PG8_LDB(B1, 0, 1); PG8_STAGE(PG8_SB(0, 0), b2, voffB);
            PG8_BAR; PG8_WAIT_L(0); PG8_MMA(0, 1, At, B1); PG8_BAR;
            PG8_LDA(At, 0, 1); PG8_STAGE(PG8_SA(0, 0), a2, voffA);
            PG8_BAR; PG8_WAIT_L(0); PG8_MMA(1, 0, At, B0); PG8_BAR; PG8_SCHED;
            PG8_STAGE(PG8_SB(0, 1), b2 + hstep, voffB);
            PG8_WAIT_V(6); PG8_BAR; PG8_MMA(1, 1, At, B1); PG8_BAR;
            PG8_LDB(B0, 1, 0); PG8_SCHED; PG8_LDA(At, 1, 0); PG8_STAGE(PG8_SA(0, 1), a2 + hstep, voffA);
            PG8_WAIT_L(8); PG8_BAR; PG8_WAIT_L(0); PG8_MMA(0, 0, At, B0); PG8_BAR; PG8_SCHED;
            PG8_LDB(B1, 1, 1); PG8_STAGE(PG8_SB(1, 0), b3, voffB);
            PG8_BAR; PG8_WAIT_L(0); PG8_MMA(0, 1, At, B1); PG8_BAR;
            PG8_LDA(At, 1, 1); PG8_STAGE(PG8_SA(1, 0), a3, voffA);
            PG8_BAR; PG8_WAIT_L(0); PG8_MMA(1, 0, At, B0); PG8_BAR; PG8_SCHED;
            PG8_STAGE(PG8_SB(1, 1), b3 + hstep, voffB);
            PG8_WAIT_V(6); PG8_BAR; PG8_MMA(1, 1, At, B1); PG8_BAR;
            }
        }
        if constexpr (ALIGN_EPI) { if (wr == 0) PG8_BAR; }
        if constexpr (!Epi::AFTER_DRAIN) { const int t_e = opaque_tid(wave_s); const int fr_e = t_e & 15, fq_e = (t_e & 63) >> 4;
            E(acc, cur, wr, wc, fr_e, fq_e); S.done(cur); }
        if (!has_next) break;
#pragma unroll
        for (int a = 0; a < 2; ++a)
#pragma unroll
            for (int b = 0; b < 2; ++b)
#pragma unroll
                for (int m = 0; m < 4; ++m)
#pragma unroll
                    for (int n = 0; n < 2; ++n) acc[a][b][m][n] = (f32x4){0.f, 0.f, 0.f, 0.f};
        cur = nxt; cA = nA; cB = nB; ++ui; if constexpr (GATHER) { cvp[0] = nvp[0]; cvp[1] = nvp[1]; }
        if constexpr (ALIGN_EPI) { if (wr == 1) PG8_BAR; }
    }
    PG8_WAIT_V(0);
    if constexpr (!ALIGN_EPI) { if (wr == 0) PG8_BAR; }
    PG8_BAR;
    if constexpr (Epi::AFTER_DRAIN) { E.fused(acc, cur, wr, wc, fr, fq, lds, wid, lane); S.done(cur); }
#undef PG8_ROWOFF
#undef PG8_STAGE_A
#undef PG8_SA
#undef PG8_SB
#undef PG8_STAGE
#undef PG8_LDA
#undef PG8_LDB
#undef PG8_MMA
#undef PG8_WAIT_V
#undef PG8_WAIT_L
#undef PG8_BAR
#undef PG8_SCHED
}
}
namespace attn_body {
using bf16=__hip_bfloat16;
using bf16x8=__attribute__((ext_vector_type(8)))short;
using s16x4=__attribute__((ext_vector_type(4)))short;
using f32x16=__attribute__((ext_vector_type(16)))float;
using u32x4=__attribute__((ext_vector_type(4)))unsigned;
constexpr int D=64;
constexpr int NW=8,QBLK=32,QB=QBLK*NW,KVBLK=64;
__device__ __forceinline__ int crow(int r,int hi){return (r&3)+8*(r>>2)+4*hi;}
#define SBAR() __builtin_amdgcn_sched_barrier(0)
__device__ __forceinline__ void cmask(f32x16&p0,f32x16&p1,int jb,int qrel,int hi){
  const float NEG=-INFINITY; int kb=64*jb+4*hi;
  #pragma unroll
  for(int r=0;r<16;++r){int kv=kb+(r&3)+8*(r>>2); if(kv>qrel)p0[r]=NEG; if(kv+32>qrel)p1[r]=NEG;}
}

constexpr int NSLOT=3, SLOTB=8192;
constexpr int LDS_K=0, LDS_V=NSLOT*SLOTB, LDS_WS=2*NSLOT*SLOTB, LDS_OST=LDS_WS+NW*64*4, LDS_BYTES=LDS_OST+NW*4096;
constexpr float C2=0.125f*1.4426950408889634f;
__device__ __forceinline__ void glds16(const void*gsrc,unsigned lds_dst){unsigned keep;
  asm volatile("s_mov_b32 %0, m0\n\ts_mov_b32 m0, %2\n\ts_nop 0\n\tglobal_load_lds_dwordx4 %1, off\n\ts_mov_b32 m0, %0":"=&s"(keep):"v"(gsrc),"s"(lds_dst):"memory");}
__device__ __forceinline__ float max3f(float a,float b,float c){float r;asm("v_max3_f32 %0, %1, %2, %3":"=v"(r):"v"(a),"v"(b),"v"(c));return r;}
__device__ __forceinline__ float max2f(float a,float b){float r;asm("v_max_f32_e32 %0, %1, %2":"=v"(r):"v"(a),"v"(b));return r;}
__device__ __forceinline__ float fadd_s(float a,float b){float r;asm("v_add_f32_e32 %0, %1, %2":"=v"(r):"v"(a),"v"(b));return r;}
__device__ __forceinline__ float fsub_s(float a,float b){float r;asm("v_sub_f32_e32 %0, %1, %2":"=v"(r):"v"(a),"v"(b));return r;}
typedef float f32x2_t __attribute__((ext_vector_type(2))); typedef __bf16 bf16x2_t __attribute__((ext_vector_type(2)));
__device__ __forceinline__ unsigned cvtpk_s(float lo,float hi){f32x2_t v={lo,hi};bf16x2_t b=__builtin_convertvector(v,bf16x2_t);return __builtin_bit_cast(unsigned,b);}
#define WAIT_BAR(N) asm volatile("s_waitcnt vmcnt(" #N ") lgkmcnt(0)\n\ts_barrier":::"memory")

__device__ __forceinline__ void qkt(f32x16&p0,f32x16&p1,const char*Kslot,const bf16x8*qr,const f32x16&negm,int r32,int hi){
  const char*kb=Kslot+hi*1024+r32*16;
  #pragma unroll
  for(int d0=0;d0<4;++d0){
    const bf16x8 b0=*reinterpret_cast<const bf16x8*>(kb+d0*2048);
    const bf16x8 b1=*reinterpret_cast<const bf16x8*>(kb+d0*2048+512);
    if(d0==0){p0=__builtin_amdgcn_mfma_f32_32x32x16_bf16(b0,qr[0],negm,0,0,0);p1=__builtin_amdgcn_mfma_f32_32x32x16_bf16(b1,qr[0],negm,0,0,0);}
    else{p0=__builtin_amdgcn_mfma_f32_32x32x16_bf16(b0,qr[d0],p0,0,0,0);p1=__builtin_amdgcn_mfma_f32_32x32x16_bf16(b1,qr[d0],p1,0,0,0);}}
}
typedef __attribute__((address_space(3))) const char* lds_cptr;
typedef short v4i16_t __attribute__((ext_vector_type(4)));
__device__ __forceinline__ void kload8(bf16x8*kf,lds_cptr kp){
  kf[0]=*(const __attribute__((address_space(3))) bf16x8*)(kp);      kf[1]=*(const __attribute__((address_space(3))) bf16x8*)(kp+512);
  kf[2]=*(const __attribute__((address_space(3))) bf16x8*)(kp+2048); kf[3]=*(const __attribute__((address_space(3))) bf16x8*)(kp+2560);
  kf[4]=*(const __attribute__((address_space(3))) bf16x8*)(kp+4096); kf[5]=*(const __attribute__((address_space(3))) bf16x8*)(kp+4608);
  kf[6]=*(const __attribute__((address_space(3))) bf16x8*)(kp+6144); kf[7]=*(const __attribute__((address_space(3))) bf16x8*)(kp+6656);
}
__device__ __forceinline__ void kload2(bf16x8*kf,lds_cptr kp,int j){ kf[2*j]=*(const __attribute__((address_space(3))) bf16x8*)(kp+j*2048); kf[2*j+1]=*(const __attribute__((address_space(3))) bf16x8*)(kp+j*2048+512); }
__device__ __forceinline__ s16x4 vtr(lds_cptr p){ return __builtin_bit_cast(s16x4,__builtin_amdgcn_ds_read_tr16_b64_v4i16((__attribute__((address_space(3))) v4i16_t*)p)); }
__device__ __forceinline__ float rowmax(const f32x16&p0,const f32x16&p1){
  float a=max3f(p0[0],p0[1],p1[0]),b=max3f(p0[2],p0[3],p1[1]);a=max3f(a,p1[2],p1[3]);
  #pragma unroll
  for(int r=4;r<16;r+=4){a=max3f(a,p0[r],p0[r+1]);b=max3f(b,p0[r+2],p0[r+3]);a=max3f(a,p1[r],p1[r+1]);b=max3f(b,p1[r+2],p1[r+3]);}
  const float m=max2f(a,b);
  auto rr=__builtin_amdgcn_permlane32_swap(__float_as_uint(m),__float_as_uint(m),false,false);
  return max2f(__uint_as_float(rr[0]),__uint_as_float(rr[1]));
}
__device__ __forceinline__ void pv(f32x16*o,int vb,bf16x8 pa0,bf16x8 pa1,bf16x8 pa2,bf16x8 pa3){
  #pragma unroll
  for(int d0=0;d0<2;++d0){s16x4 lo[4],hi[4];
    #pragma unroll
    for(int ks=0;ks<4;++ks){
      asm volatile("ds_read_b64_tr_b16 %0,%1 offset:%c2":"=&v"(lo[ks]):"v"(vb),"i"(d0*4096+ks*1024):"memory");
      asm volatile("ds_read_b64_tr_b16 %0,%1 offset:%c2":"=&v"(hi[ks]):"v"(vb),"i"(d0*4096+ks*1024+512):"memory");}
    asm volatile("s_waitcnt lgkmcnt(0)":::"memory");SBAR();
    #define PK(k) (bf16x8){lo[k][0],lo[k][1],lo[k][2],lo[k][3],hi[k][0],hi[k][1],hi[k][2],hi[k][3]}
    o[d0]=__builtin_amdgcn_mfma_f32_32x32x16_bf16(pa0,PK(0),o[d0],0,0,0);
    o[d0]=__builtin_amdgcn_mfma_f32_32x32x16_bf16(pa1,PK(1),o[d0],0,0,0);
    o[d0]=__builtin_amdgcn_mfma_f32_32x32x16_bf16(pa2,PK(2),o[d0],0,0,0);
    o[d0]=__builtin_amdgcn_mfma_f32_32x32x16_bf16(pa3,PK(3),o[d0],0,0,0);
    #undef PK
  }
}

#ifndef ATTN_STORE16
#define ATTN_STORE16(p,v) (*(u32x4*)(p)=(v))
#endif
template<int THRL,int QP,int KP,int OP> __device__ __forceinline__ void attn_unit(const bf16*Qu,const bf16*__restrict__ Kh,const bf16*__restrict__ Vh,bf16*Ou,const int NT,char*shm,int wave_s){
  const int tid=opaque_tid(wave_s),lane=tid&63,r32=lane&31,hi=lane>>5; const int wid=__builtin_amdgcn_readfirstlane(tid>>6);
  const bf16*Qw=Qu+(long)(wid*QBLK)*QP;
  const unsigned lds0=(unsigned)(uintptr_t)shm;
  float*wsf=(float*)(shm+LDS_WS)+wid*64;
  const bf16*ksrc=Kh+(long)lane*KP+wid*8;
  const bf16*vsrc=Vh+(long)(16*(wid&3)+(lane>>2))*KP+(wid>>2)*32+(lane&3)*8;
  const unsigned kdst=lds0+LDS_K+wid*1024, vdst=lds0+LDS_V+wid*1024;
  #define DMA_K(t,slot) glds16(ksrc+(long)(t)*KVBLK*KP,(unsigned)__builtin_amdgcn_readfirstlane(kdst+(slot)))
  #define DMA_V(t,slot) glds16(vsrc+(long)(t)*KVBLK*KP,(unsigned)__builtin_amdgcn_readfirstlane(vdst+(slot)))
  const int vb0=(int)(lds0+LDS_V)+((lane>>4)&1)*32+(lane&3)*8+(4*hi+((lane&15)>>2))*64;
  const char*Kbase=shm+LDS_K; bf16x8 kf[8];
  const lds_cptr shm3=(lds_cptr)shm; const lds_cptr kp0=shm3+LDS_K+hi*1024+r32*16; const lds_cptr vp0=shm3+LDS_V+((lane>>4)&1)*32+(lane&3)*8+(4*hi+((lane&15)>>2))*64;
  DMA_K(0,0);DMA_V(0,0);DMA_K(1,SLOTB);
  bf16x8 qr[4];
  #pragma unroll
  for(int d0=0;d0<4;++d0)qr[d0]=*reinterpret_cast<const bf16x8*>(&Qw[(long)r32*QP+d0*16+hi*8]);
  float mhat=0.f,l_reg=0.f;f32x16 o[2];o[0]=f32x16{};o[1]=f32x16{};f32x16 negm=f32x16{};asm volatile("":"+v"(negm));
  #define CMASK(P0,P1,t) do{}while(0)
  bool resc=false;
  #define START(P0,P1) do{ const float rm=(THRL<0)?14.0f:rowmax(P0,P1); resc=false; \
    { const float dl=rm; mhat=fadd_s(mhat,dl); \
      _Pragma("unroll") for(int r=0;r<16;++r){P0[r]=fsub_s(P0[r],dl);P1[r]=fsub_s(P1[r],dl);} \
      _Pragma("unroll") for(int r=0;r<16;++r)negm[r]=-mhat; asm volatile("":"+v"(negm)); } \
    _Pragma("unroll") for(int r=0;r<16;++r)P0[r]=__builtin_amdgcn_exp2f(P0[r]); }while(0)
  #define RESC() do{ if(resc){ asm volatile("s_waitcnt lgkmcnt(0)":::"memory"); \
      _Pragma("unroll") for(int d_=0;d_<2;++d_) _Pragma("unroll") for(int r=0;r<16;++r)o[d_][r]*=wsf[crow(r,hi)]; } }while(0)
  f32x16 pA0,pA1,pB0,pB1;
  int sl_prev=0,sl_cur=0,sl_next=SLOTB;
  #define ROT() do{sl_prev=sl_cur;sl_cur=sl_next;sl_next=(sl_next==(NSLOT-1)*SLOTB)?0:sl_next+SLOTB;}while(0)
  DMA_K(2,2*SLOTB);
  WAIT_BAR(3);
  qkt(pA0,pA1,Kbase,qr,negm,r32,hi);asm volatile("s_nop 15\n\ts_nop 7":"+v"(pA0),"+v"(pA1));CMASK(pA0,pA1,0);
  START(pA0,pA1);
  _Pragma("unroll") for(int r=0;r<16;++r)pA1[r]=__builtin_amdgcn_exp2f(pA1[r]);
  WAIT_BAR(0);
  DMA_K(3,0);DMA_V(1,SLOTB);
  ROT();
  kload8(kf,kp0+sl_cur);
  WAIT_BAR(2);
  s16x4 vlo[8],vhi[8]; u32x4 pw0,pw1,pw2,pw3;
  #define PKW(P,B) cvtpk_s(P[B],P[B+1])
  #define PAF(k) __builtin_bit_cast(bf16x8,pw##k)
  #define VFR(i) (bf16x8){vlo[i][0],vlo[i][1],vlo[i][2],vlo[i][3],vhi[i][0],vhi[i][1],vhi[i][2],vhi[i][3]}
  #define PIN(x) asm volatile("":"+v"(x))
  #define MX3(a,b,c) __builtin_fmaxf(__builtin_fmaxf((a),(b)),(c))
  #define GAPA(MF,A0,A1,A2,A3,W0,W1,PW) do{ MF; sacc2+=(f32x2_t){A0,A1}; sacc2+=(f32x2_t){A2,A3}; PIN(sacc2); W0; W1; PIN(PW); SBAR(); }while(0)
  #define EX(v) __builtin_amdgcn_exp2f(v)
  #define GAPB(MF,X,B) do{ MF; X[B]=EX(X[B]); X[B+1]=EX(X[B+1]); X[B+2]=EX(X[B+2]); X[B+3]=EX(X[B+3]); PIN(X); SBAR(); }while(0)
  #define VRD(i) do{ vlo[i]=vtr(vp_+(((i)>>2)*4096+((i)&3)*1024)); vhi[i]=vtr(vp_+(((i)>>2)*4096+((i)&3)*1024+512)); }while(0)
  #define KRD(G,j) do{ if(G){ kload2(kf,kp0+sl_next,j); SBAR(); } }while(0)
  #define STEP(C0,C1,P0,P1,t,GK,GV,GL) do{ SBAR(); \
    const lds_cptr vp_=vp0+sl_prev; \
    VRD(0); SBAR(); f32x2_t sacc2=(f32x2_t){P0[0],P0[1]}; \
    GAPA(C0=__builtin_amdgcn_mfma_f32_32x32x16_bf16(kf[0],qr[0],negm,0,0,0), P0[2],P0[3],P0[4],P0[5],     pw0[0]=PKW(P0,0), pw0[1]=PKW(P0,2), pw0); \
    VRD(4); SBAR(); GAPA(C1=__builtin_amdgcn_mfma_f32_32x32x16_bf16(kf[1],qr[0],negm,0,0,0), P0[6],P0[7],P0[8],P0[9],     pw0[2]=PKW(P0,4), pw0[3]=PKW(P0,6), pw0); \
    VRD(1); SBAR(); GAPA(C0=__builtin_amdgcn_mfma_f32_32x32x16_bf16(kf[2],qr[1],C0,0,0,0),   P0[10],P0[11],P0[12],P0[13], pw1[0]=PKW(P0,8), pw1[1]=PKW(P0,10), pw1); \
    VRD(5); SBAR(); GAPA(C1=__builtin_amdgcn_mfma_f32_32x32x16_bf16(kf[3],qr[1],C1,0,0,0),   P0[14],P0[15],P1[0],P1[1],   pw1[2]=PKW(P0,12),pw1[3]=PKW(P0,14), pw1); \
    VRD(2); SBAR(); GAPA(C0=__builtin_amdgcn_mfma_f32_32x32x16_bf16(kf[4],qr[2],C0,0,0,0),   P1[2],P1[3],P1[4],P1[5],     pw2[0]=PKW(P1,0), pw2[1]=PKW(P1,2), pw2); \
    VRD(6); SBAR(); GAPA(C1=__builtin_amdgcn_mfma_f32_32x32x16_bf16(kf[5],qr[2],C1,0,0,0),   P1[6],P1[7],P1[8],P1[9],     pw2[2]=PKW(P1,4), pw2[3]=PKW(P1,6), pw2); \
    VRD(3); SBAR(); GAPA(C0=__builtin_amdgcn_mfma_f32_32x32x16_bf16(kf[6],qr[3],C0,0,0,0),   P1[10],P1[11],P1[12],P1[13], pw3[0]=PKW(P1,8), pw3[1]=PKW(P1,10), pw3); \
    VRD(7); SBAR(); GAPA(C1=__builtin_amdgcn_mfma_f32_32x32x16_bf16(kf[7],qr[3],C1,0,0,0),   P1[14],P1[15],0.f,0.f,       pw3[2]=PKW(P1,12),pw3[3]=PKW(P1,14), pw3); \
    l_reg+=sacc2.x+sacc2.y; \
    if(GK){DMA_K((t)+3,sl_cur);} if(GV){DMA_V((t)+1,sl_next);} \
    CMASK(C0,C1,t); \
    if constexpr (THRL>=0) { float a=MX3(C0[0],C0[1],C1[0]),b=MX3(C0[2],C0[3],C1[1]); a=MX3(a,C1[2],C1[3]); \
      _Pragma("unroll") for(int r=4;r<16;r+=4){a=MX3(a,C0[r],C0[r+1]);b=MX3(b,C0[r+2],C0[r+3]);a=MX3(a,C1[r],C1[r+1]);b=MX3(b,C1[r+2],C1[r+3]);} \
      float rm=__builtin_fmaxf(a,b); { auto rr=__builtin_amdgcn_permlane32_swap(__float_as_uint(rm),__float_as_uint(rm),false,false); rm=__builtin_fmaxf(__uint_as_float(rr[0]),__uint_as_float(rr[1])); } \
      resc=false; \
      if(__builtin_expect(__any(rm>(float)THRL),0)){ const float dl=__builtin_fmaxf(rm,0.f); mhat+=dl; \
        _Pragma("unroll") for(int r=0;r<16;++r){C0[r]-=dl;C1[r]-=dl;} \
        _Pragma("unroll") for(int r=0;r<16;++r)negm[r]=-mhat; asm volatile("":"+v"(negm)); \
        const float f=__builtin_amdgcn_exp2f(-dl); l_reg*=f; if(hi==0)wsf[r32]=f; resc=true; } } \
    SBAR(); \
    GAPB(o[0]=__builtin_amdgcn_mfma_f32_32x32x16_bf16(PAF(0),VFR(0),o[0],0,0,0), C0,0); \
    GAPB(o[1]=__builtin_amdgcn_mfma_f32_32x32x16_bf16(PAF(0),VFR(4),o[1],0,0,0), C0,4); \
    KRD(GL,0); GAPB(o[0]=__builtin_amdgcn_mfma_f32_32x32x16_bf16(PAF(1),VFR(1),o[0],0,0,0), C0,8); \
    KRD(GL,1); GAPB(o[1]=__builtin_amdgcn_mfma_f32_32x32x16_bf16(PAF(1),VFR(5),o[1],0,0,0), C0,12); \
    KRD(GL,2); GAPB(o[0]=__builtin_amdgcn_mfma_f32_32x32x16_bf16(PAF(2),VFR(2),o[0],0,0,0), C1,0); \
    KRD(GL,3); GAPB(o[1]=__builtin_amdgcn_mfma_f32_32x32x16_bf16(PAF(2),VFR(6),o[1],0,0,0), C1,4); \
    GAPB(o[0]=__builtin_amdgcn_mfma_f32_32x32x16_bf16(PAF(3),VFR(3),o[0],0,0,0), C1,8); \
    GAPB(o[1]=__builtin_amdgcn_mfma_f32_32x32x16_bf16(PAF(3),VFR(7),o[1],0,0,0), C1,12); \
    }while(0)
  int t=1;
  #undef CMASK
  #define CMASK(P0,P1,t) do{}while(0)
  for(;t+5<NT;t+=2){
    STEP(pB0,pB1,pA0,pA1,t,true,true,true);     WAIT_BAR(2); RESC(); ROT();
    STEP(pA0,pA1,pB0,pB1,t+1,true,true,true);   WAIT_BAR(2); RESC(); ROT();
  }
  #undef CMASK
  #define CMASK(P0,P1,t) do{}while(0)
  #define ENDW(tt) do{ if((tt)+3<NT){WAIT_BAR(2);} else if((tt)+2<NT){WAIT_BAR(1);} else {WAIT_BAR(0);} }while(0)
  for(;t+1<NT;t+=2){
    STEP(pB0,pB1,pA0,pA1,t,(t+3<NT),(t+1<NT),(t+1<NT));       ENDW(t);   RESC(); ROT();
    STEP(pA0,pA1,pB0,pB1,t+1,(t+4<NT),(t+2<NT),(t+2<NT));     ENDW(t+1); RESC(); ROT();
  }
  STEP(pB0,pB1,pA0,pA1,NT-1,false,false,false); RESC();
  { float sacc=pB0[0]+pB0[1]; _Pragma("unroll") for(int r=2;r<16;++r)sacc+=pB0[r]; _Pragma("unroll") for(int r=0;r<16;++r)sacc+=pB1[r]; l_reg+=sacc;
    pw0=(u32x4){PKW(pB0,0),PKW(pB0,2),PKW(pB0,4),PKW(pB0,6)};pw1=(u32x4){PKW(pB0,8),PKW(pB0,10),PKW(pB0,12),PKW(pB0,14)};pw2=(u32x4){PKW(pB1,0),PKW(pB1,2),PKW(pB1,4),PKW(pB1,6)};pw3=(u32x4){PKW(pB1,8),PKW(pB1,10),PKW(pB1,12),PKW(pB1,14)};
    SBAR(); pv(o,vb0+sl_cur,PAF(0),PAF(1),PAF(2),PAF(3)); }
  #undef PKW
  #undef PAF
  #undef VFR
  #undef PIN
  #undef MX3
  #undef GAPA
  #undef GAPB
  #undef EX
  #undef VRD
  #undef KRD
  #undef STEP
  #undef ENDW
  {auto rr=__builtin_amdgcn_permlane32_swap(__float_as_uint(l_reg),__float_as_uint(l_reg),false,false);l_reg=__uint_as_float(rr[0])+__uint_as_float(rr[1]);}
  if(hi==0)wsf[32+r32]=l_reg;asm volatile("s_waitcnt lgkmcnt(0)":::"memory");
  float rli[16];
  #pragma unroll
  for(int r=0;r<16;++r)rli[r]=__builtin_amdgcn_rcpf(wsf[32+crow(r,hi)]);
  bf16*Ow=Ou+(long)(wid*QBLK)*OP;
  { bf16*stg=(bf16*)(shm+LDS_OST)+wid*2048;
    #pragma unroll
    for(int r=0;r<16;++r){const int orow=crow(r,hi);
      #pragma unroll
      for(int d0=0;d0<2;++d0)stg[orow*64+d0*32+r32]=__float2bfloat16(o[d0][r]*rli[r]);}
    asm volatile("s_waitcnt lgkmcnt(0)":::"memory");
    #pragma unroll
    for(int i=0;i<4;++i){const int row=i*8+(lane>>3),ch=lane&7; const u32x4 v=*(const u32x4*)(stg+row*64+ch*8); ATTN_STORE16(Ow+(long)row*OP+ch*8,v);} }
  asm volatile("s_waitcnt lgkmcnt(0)\n\ts_barrier":::"memory");
  #undef DMA_K
  #undef DMA_V
  #undef CMASK
  #undef START
  #undef RESC
  #undef ROT
}
constexpr int ATTN_LDS_BYTES=LDS_BYTES;
#undef SBAR
#undef WAIT_BAR
}
#define LDS_WAIT() asm volatile("s_waitcnt lgkmcnt(0)" ::: "memory")

__device__ __forceinline__ void transpose_item(const float* W, int K, int N, bf16* WT, int k0, int n0, int dest_row0, LAS float* scr, int lane) {
    float t_[32];
#pragma unroll
    for (int i = 0; i < 32; ++i) t_[i] = W[(size_t)(k0 + 2 * i + (lane >> 5)) * N + n0 + (lane & 31)];
#pragma unroll
    for (int i = 0; i < 32; ++i) scr[(2 * i + (lane >> 5)) * 33 + (lane & 31)] = t_[i];
    LDS_WAIT(); asm volatile("" ::: "memory");
    const int c = lane & 7;
#pragma unroll
    for (int j = 0; j < 4; ++j) { const int n = (lane >> 3) + 8 * j; const LAS float* s = scr + (8 * c) * 33 + n;
        v4u o; o.x = pk2(s[0 * 33], s[1 * 33]); o.y = pk2(s[2 * 33], s[3 * 33]); o.z = pk2(s[4 * 33], s[5 * 33]); o.w = pk2(s[6 * 33], s[7 * 33]);
        *(GAS v4u*)(WT + (size_t)(dest_row0 + n) * K + k0 + 8 * c) = o; }
    LDS_WAIT(); asm volatile("" ::: "memory");
}

template <int KMODE>
__device__ __forceinline__ void transpose_item8(const float* W, int K, int N, unsigned char* WT, int k0, int n0, int dest_row0, float sc, LAS float* scr, int lane) {
    float t_[32];
#pragma unroll
    for (int i = 0; i < 32; ++i) t_[i] = W[(size_t)(k0 + 2 * i + (lane >> 5)) * N + n0 + (lane & 31)];
#pragma unroll
    for (int i = 0; i < 32; ++i) scr[(2 * i + (lane >> 5)) * 33 + (lane & 31)] = __builtin_amdgcn_fmed3f(t_[i] * sc, -448.f, 448.f);
    LDS_WAIT(); asm volatile("" ::: "memory");
    const int c = lane & 7, w = c >> 2, fq = c & 3, wh = (k0 >> 6) & 1;
    const int doff = KMODE == 1 ? (k0 & ~255) + 64 * (2 * wh + w) + 16 * fq + 8 * ((k0 >> 7) & 1) : KMODE == 2 ? (k0 & ~127) + 32 * (2 * wh + w) + 8 * fq : k0 + 8 * c;
#pragma unroll
    for (int j = 0; j < 4; ++j) { const int n = (lane >> 3) + 8 * j; const LAS float* s = scr + n;
        float v[8];
#pragma unroll
        for (int e = 0; e < 8; ++e) { const int kk = KMODE == 2 ? 32 * w + 16 * (e >> 2) + 4 * fq + (e & 3) : 8 * c + e; v[e] = s[kk * 33]; }
        unsigned w0 = 0, w1 = 0;
        w0 = __builtin_amdgcn_cvt_pk_fp8_f32(v[0], v[1], w0, false); w0 = __builtin_amdgcn_cvt_pk_fp8_f32(v[2], v[3], w0, true);
        w1 = __builtin_amdgcn_cvt_pk_fp8_f32(v[4], v[5], w1, false); w1 = __builtin_amdgcn_cvt_pk_fp8_f32(v[6], v[7], w1, true);
        *(GAS v2u*)(WT + (size_t)(dest_row0 + n) * K + doff) = (v2u){w0, w1}; }
    LDS_WAIT(); asm volatile("" ::: "memory");
}

struct ProIn { const float *hy_w_in, *at_w_in, *w_out, *w_mem_kv; };
__device__ __forceinline__ void phase_weights(const ProIn& P, unsigned char* ws, LAS unsigned char* lds, int gw, int NGW, int wave, int lane) {
    LAS float* scr = (LAS float*)(lds + wave * 16384);
    constexpr int I_HY = 16 * 80, I_AT = 16 * 48, I_OUT = 16 * 32, I_MKV = 16 * 16;
    constexpr int E0 = 2 * I_HY, E1 = E0 + 2 * I_AT, E2 = E1 + 4 * I_OUT, E3 = E2 + 4 * I_MKV;
    for (int it = gw; it < E3; it += NGW) {
        int r = it;
        if (r < E0) { const int j = r / I_HY, q = r % I_HY, kb = q / 80, nb = q % 80;
            transpose_item(P.hy_w_in + (size_t)j * DM * D_IN_HY, DM, D_IN_HY, (bf16*)(ws + WS_WHY) + (size_t)j * D_IN_HY * DM, 64 * kb, 32 * nb, 32 * nb, scr, lane); continue; }
        r -= E0;
        if (r < 2 * I_AT) { const int j = r / I_AT, q = r % I_AT, kb = q / 48, nb = q % 48;
            const int n0 = 32 * nb, o = n0 & 255;
            transpose_item(P.at_w_in + (size_t)j * DM * D_IN_AT, DM, D_IN_AT, (bf16*)(ws + WS_WAT) + (size_t)j * D_IN_AT * DM, 64 * kb, n0, (n0 & ~255) + 128 * ((o & 63) >> 5) + 32 * (o >> 6), scr, lane); continue; }
        r -= 2 * I_AT;
        if (r < 4 * I_OUT) { const int j = r / I_OUT, q = r % I_OUT, kb = q / 32, nb = q % 32;
            transpose_item(P.w_out + (size_t)j * DM * DM, DM, DM, (bf16*)(ws + WS_WOUT) + (size_t)j * DM * DM, 64 * kb, 32 * nb, 32 * nb, scr, lane); continue; }
        r -= 4 * I_OUT;
        { const int j = r / I_MKV, q = r % I_MKV, kb = q / 16, nb = q % 16;
            transpose_item(P.w_mem_kv + (size_t)j * DM * 512, DM, 512, (bf16*)(ws + WS_WMKV), 64 * kb, 32 * nb, j * 512 + 32 * nb, scr, lane); }
        (void)r;
    }
}

struct XwIn { const float *w_gate, *w_up, *w_down; unsigned char* ws; };
constexpr int XW_PER_EXPERT = 3 * 384, XW_PER_LAYER = NEXP * XW_PER_EXPERT;
constexpr int XW_QA_HY = 5, XW_QA_AT = 4, XW_QB = 3, XW_NA = 128 * NWAVES, XW_NB = 224 * NWAVES;
__host__ __device__ constexpr int xw_qa(int layer) { return (layer & 1) ? XW_QA_AT : XW_QA_HY; }
__host__ __device__ constexpr int xw_p0(int layer, bool sched) { return sched ? XW_PER_LAYER - xw_qa(layer) * XW_NA - XW_QB * XW_NB : XW_PER_LAYER; }
__device__ __forceinline__ void xw_item(const XwIn& B, int layer, int r, LAS float* scr, int lane) {
    const int j = layer * NEXP + r / XW_PER_EXPERT, q = r % XW_PER_EXPERT, kind = q / 384, qq = q % 384;
    if (kind < 2) { const int kb = qq / 24, nb = qq % 24, n0 = 32 * nb;
        transpose_item8<1>((kind == 0 ? B.w_gate : B.w_up) + (size_t)j * DM * EFF, DM, EFF, B.ws + WS_W1 + (size_t)j * 1536 * DM, 64 * kb, n0, (n0 >> 7) * 256 + 128 * kind + (n0 & 127), W8_SCALE, scr, lane); }
    else { const int kb = qq / 32, nb = qq % 32;
        transpose_item8<2>(B.w_down + (size_t)j * EFF * DM, EFF, DM, B.ws + WS_W2 + (size_t)j * DM * EFF, 64 * kb, 32 * nb, 32 * nb, W8_SCALE, scr, lane); }
}
__device__ __forceinline__ void phase_xw_p0(const XwIn& B, bool sched, LAS float* scr, int gw, int NGW, int lane) {
#pragma unroll 1
    for (int layer = 0; layer < DEPTH; ++layer) { const int n = xw_p0(layer, sched);
#pragma unroll 1
        for (int r = gw; r < n; r += NGW) xw_item(B, layer, r, scr, lane); }
}
__device__ __forceinline__ void xw_slice_a(const XwIn& B, int layer, LAS float* scr, int bx, int wave, int lane) {
    const int base = xw_p0(layer, true) + (bx - 128) * NWAVES + wave;
#pragma unroll 1
    for (int k = 0; k < xw_qa(layer); ++k) xw_item(B, layer, base + k * XW_NA, scr, lane);
}
__device__ __forceinline__ void xw_slice_b(const XwIn& B, int layer, LAS float* scr, int bx, int wave, int lane) {
    const int base = xw_p0(layer, true) + xw_qa(layer) * XW_NA + (bx - 32) * NWAVES + wave;
#pragma unroll 1
    for (int k = 0; k < XW_QB; ++k) xw_item(B, layer, base + k * XW_NB, scr, lane);
}

__device__ __forceinline__ void phase_wrg(const float* ffn_g, const float* router, float* WRG, int gtid, int nthreads) {
    for (int q = gtid; q < DEPTH * NEXP * DM; q += nthreads) { const int l = q / (NEXP * DM), e = (q / DM) % NEXP, d = q % DM; WRG[q] = ffn_g[l * DM + d] * router[((size_t)l * DM + d) * NEXP + e]; }
}

__device__ __forceinline__ void rms_row_bf16(const float* xrow, const float* g, bf16* orow, int lane) {
    const GAS f32x4* xr = (const GAS f32x4*)xrow + lane; const GAS f32x4* gr = (const GAS f32x4*)g + lane;
    f32x4 v[4]; float s = 0.f;
#pragma unroll
    for (int j = 0; j < 4; ++j) { v[j] = xr[64 * j]; s += (v[j].x * v[j].x + v[j].y * v[j].y) + (v[j].z * v[j].z + v[j].w * v[j].w); }
    const float rstd = 1.f / sqrtf(wave_sum(s) * (1.f / DM) + NORM_EPS);
    GAS v2u* o8 = (GAS v2u*)orow + lane;
#pragma unroll
    for (int j = 0; j < 4; ++j) { const f32x4 gg = gr[64 * j]; v2u w; w.x = pk2(v[j].x * rstd * gg.x, v[j].y * rstd * gg.y); w.y = pk2(v[j].z * rstd * gg.z, v[j].w * rstd * gg.w); o8[64 * j] = w; }
}

__device__ __forceinline__ void phase_mem_h2(const float* mem, const float* mem_g, const float* fw1, const float* fb1, const float* fw2, const float* fb2, const float* ffreq,
                                              unsigned char* ws, int gw, int NGW, int lane) {
    for (int m = gw; m < BATCH * MEM_LEN; m += NGW) rms_row_bf16(mem + (size_t)m * DM, mem_g, (bf16*)(ws + WS_MEMN) + (size_t)m * DM, lane);
    float* H2 = (float*)(ws + WS_H2);
    for (int it = gw; it < 2 * SEQ; it += NGW) {
        const int j = it / SEQ, n = it % SEQ;
        const float* w1 = fw1 + j * HY_EMB * HY_FILT; const float* w2 = fw2 + j * HY_FILT * HY_FILT;
        const float t = (float)n * (1.0f / (float)(SEQ - 1));
        const float w = (6.283185307179586f * (float)n) / (float)SEQ;
        float feat = 0.f;
        if (lane == 0) feat = t;
        else if (lane <= 16) { const float band = 1e-4f + (float)(lane - 1) * ((15.0f - 1e-4f) / 15.0f); feat = cosf(band * w); }
        else if (lane <= 32) { const float band = 1e-4f + (float)(lane - 17) * ((15.0f - 1e-4f) / 15.0f); feat = -sinf(band * w); }
        const float fr = ffreq[j * HY_FILT + lane];
        float a = fb1[j * HY_FILT + lane];
        for (int i = 0; i < HY_EMB; ++i) a += __shfl(feat, i) * w1[i * HY_FILT + lane];
        const float h1 = sinf(fr * a);
        float a2 = fb2[j * HY_FILT + lane];
        for (int i = 0; i < HY_FILT; ++i) a2 += __shfl(h1, i) * w2[i * HY_FILT + lane];
        H2[(size_t)it * HY_FILT + lane] = sinf(fr * a2);
    }
}

template <bool COMBINE, bool FINAL>
__device__ __forceinline__ void phase_norm(const float* hin, float* hout, const float* g, bf16* U, float* fout, const int* POS, const bf16* Y, int gw, int NGW, int lane) {
    int m = gw;
    if (m >= M_TOK) return;
    f32x4 cur[4]; int cpos = -1;
    { const GAS f32x4* xr = (const GAS f32x4*)(hin + (size_t)m * DM) + lane;
#pragma unroll
      for (int j = 0; j < 4; ++j) cur[j] = xr[64 * j];
      if (COMBINE) { const int b = m / SEQ, t = m % SEQ; if (lane < NEXP) cpos = POS[(size_t)(b * NEXP + lane) * SEQ + t]; } }
#pragma unroll 1
    for (; m < M_TOK; m += NGW) {
        const int mn = m + NGW; f32x4 nxt[4]; int npos = -1;
#pragma unroll
        for (int j = 0; j < 4; ++j) nxt[j] = cur[j];
        if (mn < M_TOK) { const GAS f32x4* xr = (const GAS f32x4*)(hin + (size_t)mn * DM) + lane;
#pragma unroll
            for (int j = 0; j < 4; ++j) nxt[j] = xr[64 * j];
            if (COMBINE) { const int b = mn / SEQ, t = mn % SEQ; if (lane < NEXP) npos = POS[(size_t)(b * NEXP + lane) * SEQ + t]; } }
        f32x4 v[4];
#pragma unroll
        for (int j = 0; j < 4; ++j) v[j] = cur[j];
        if (COMBINE) {
            const int b = m / SEQ;
            unsigned long long mask = __ballot(cpos >= 0);
            while (mask) {
                v2u y[4][4]; bool has[4];
#pragma unroll
                for (int k = 0; k < 4; ++k) { has[k] = mask != 0ull;
                    if (has[k]) { const int e = __builtin_amdgcn_readfirstlane(__builtin_ctzll(mask)); mask &= mask - 1ull; const int p = __builtin_amdgcn_readlane(cpos, e);
                        const GAS v2u* yr = (const GAS v2u*)(Y + ((size_t)(b * NEXP + e) * CAP + p) * DM) + lane;
#pragma unroll
                        for (int j = 0; j < 4; ++j) y[k][j] = yr[64 * j]; } }
#pragma unroll
                for (int k = 0; k < 4; ++k) if (has[k]) {
#pragma unroll
                    for (int j = 0; j < 4; ++j) { const v2u w = y[k][j]; v[j].x += bflo(w.x); v[j].y += bfhi(w.x); v[j].z += bflo(w.y); v[j].w += bfhi(w.y); } }
            }
            if (!FINAL) { GAS f32x4* ho = (GAS f32x4*)(hout + (size_t)m * DM) + lane;
#pragma unroll
                for (int j = 0; j < 4; ++j) ho[64 * j] = v[j]; }
        }
        float s = 0.f;
#pragma unroll
        for (int j = 0; j < 4; ++j) s += (v[j].x * v[j].x + v[j].y * v[j].y) + (v[j].z * v[j].z + v[j].w * v[j].w);
        const float rstd = 1.f / sqrtf(wave_sum(s) * (1.f / DM) + NORM_EPS);
        const GAS f32x4* gr = (const GAS f32x4*)g + lane;
        if (FINAL) { GAS f32x4* o = (GAS f32x4*)(fout + (size_t)m * DM) + lane;
#pragma unroll
            for (int j = 0; j < 4; ++j) o[64 * j] = v[j] * rstd * gr[64 * j]; }
        else { GAS v2u* o8 = (GAS v2u*)(U + (size_t)m * DM) + lane;
#pragma unroll
            for (int j = 0; j < 4; ++j) { const f32x4 gg = gr[64 * j]; v2u w; w.x = pk2(v[j].x * rstd * gg.x, v[j].y * rstd * gg.y); w.y = pk2(v[j].z * rstd * gg.z, v[j].w * rstd * gg.w); o8[64 * j] = w; } }
#pragma unroll
        for (int j = 0; j < 4; ++j) cur[j] = nxt[j];
        cpos = npos;
    }
}

__device__ __forceinline__ void phase_ffn_norm_router(const float* H, const float* g, const float* Wr, unsigned char* XN8, float* AFF, LAS unsigned char* lds, int gw, int NGW, int lane, int tid) {
    LAS f32x4* WL = (LAS f32x4*)lds;
    for (int q = tid; q < 64 * 64; q += NTHREADS) { const int ln = q & 63, s = q >> 6, e4 = s & 3, ji = s >> 2, i = ji & 3, j = ji >> 2; const int d = 4 * ln + i + 256 * j;
        WL[q] = *(const GAS f32x4*)(Wr + (size_t)d * NEXP + 4 * e4); }
    __syncthreads();
    constexpr int R = 4;
    const GAS f32x4* gr = (const GAS f32x4*)g + lane;
#pragma unroll 1
    for (int m0 = gw * R; m0 < M_TOK; m0 += NGW * R) {
        int lo_ = lane; asm volatile("" : "+v"(lo_));
        f32x4 v[R][4]; float rstd[R];
#pragma unroll
        for (int r = 0; r < R; ++r) { const GAS f32x4* xr = (const GAS f32x4*)(H + (size_t)(m0 + r) * DM) + lane;
#pragma unroll
            for (int j = 0; j < 4; ++j) v[r][j] = xr[64 * j]; }
#pragma unroll
        for (int r = 0; r < R; ++r) { float s = 0.f;
#pragma unroll
            for (int j = 0; j < 4; ++j) s += (v[r][j].x * v[r][j].x + v[r][j].y * v[r][j].y) + (v[r][j].z * v[r][j].z + v[r][j].w * v[r][j].w);
            rstd[r] = 1.f / sqrtf(wave_sum(s) * (1.f / DM) + NORM_EPS); }
        f32x4 lg[R][4];
#pragma unroll
        for (int r = 0; r < R; ++r)
#pragma unroll
            for (int e4 = 0; e4 < 4; ++e4) lg[r][e4] = (f32x4){0.f, 0.f, 0.f, 0.f};
#pragma unroll
        for (int j = 0; j < 4; ++j) { const f32x4 gg = gr[64 * j];
#pragma unroll
            for (int r = 0; r < R; ++r) { v[r][j] = v[r][j] * rstd[r] * gg;
                unsigned w = 0; w = __builtin_amdgcn_cvt_pk_fp8_f32(v[r][j].x, v[r][j].y, w, false); w = __builtin_amdgcn_cvt_pk_fp8_f32(v[r][j].z, v[r][j].w, w, true);
                ((GAS unsigned*)(XN8 + (size_t)(m0 + r) * DM) + lane)[64 * j] = w; }
#pragma unroll
            for (int i = 0; i < 4; ++i)
#pragma unroll
                for (int e4 = 0; e4 < 4; ++e4) { const f32x4 wv = WL[((j * 4 + i) * 4 + e4) * 64 + lo_];
#pragma unroll
                    for (int r = 0; r < R; ++r) { const float xs = v[r][j][i];
#pragma unroll
                        for (int c = 0; c < 4; ++c) asm("v_fmac_f32 %0, %1, %2" : "+v"(lg[r][e4][c]) : "v"(wv[c]), "v"(xs)); } }
            __builtin_amdgcn_sched_barrier(0); }
#pragma unroll
        for (int r = 0; r < R; ++r) {
            float l16[16];
#pragma unroll
            for (int e = 0; e < 16; ++e) l16[e] = wave_sum(lg[r][e >> 2][e & 3]);
            float mx = l16[0];
#pragma unroll
            for (int e = 1; e < 16; ++e) mx = fmaxf(mx, l16[e]);
            float den = 0.f;
#pragma unroll
            for (int e = 0; e < 16; ++e) { l16[e] = expf(l16[e] - mx); den += l16[e]; }
            float mine = 0.f;
#pragma unroll
            for (int e = 0; e < 16; ++e) mine = (lane == e) ? l16[e] : mine;
            const int m = m0 + r, b = m / SEQ, t = m % SEQ;
            if (lane < NEXP) AFF[(size_t)(b * NEXP + lane) * SEQ + t] = mine / den;
        }
    }
    __syncthreads();
}

__device__ __forceinline__ void phase_router_sum(const float* PLG, const float* PSS, float* RSTD, float* AFF, int gw, int NGW, int lane) {
    const int e = lane & 15, rq = lane >> 4;
    for (int m0 = gw * 4; m0 < M_TOK; m0 += NGW * 4) {
        const int m = m0 + rq;
        float lgt = 0.f;
#pragma unroll
        for (int slot = 0; slot < 16; ++slot) lgt += PLG[((size_t)slot * M_TOK + m) * 16 + e];
        float ss = PSS[(size_t)e * M_TOK + m];
#pragma unroll
        for (int o = 1; o < 16; o <<= 1) ss += __shfl_xor(ss, o);
        const float rstd = 1.f / sqrtf(ss * (1.f / DM) + NORM_EPS);
        lgt *= rstd;
        float mx = lgt;
#pragma unroll
        for (int o = 1; o < 16; o <<= 1) mx = fmaxf(mx, __shfl_xor(mx, o));
        const float ex = expf(lgt - mx); float den = ex;
#pragma unroll
        for (int o = 1; o < 16; o <<= 1) den += __shfl_xor(den, o);
        const int b = m / SEQ, t = m % SEQ;
        AFF[(size_t)(b * NEXP + e) * SEQ + t] = ex / den;
        if (e == 0) RSTD[m] = rstd;
    }
}

__device__ __forceinline__ int block_excl_scan(int v, LAS int* scr, int tid, int lane, int wave, int* tot) {
    int inc = v;
#pragma unroll
    for (int o = 1; o < 64; o <<= 1) { const int n = __shfl_up(inc, o); if (lane >= o) inc += n; }
    __syncthreads();
    if (lane == 63) scr[wave] = inc;
    __syncthreads();
    int base = 0, total = 0;
#pragma unroll
    for (int w = 0; w < NWAVES; ++w) { const int c = scr[w]; if (w < wave) base += c; total += c; }
    *tot = total;
    return base + inc - v;
}

__device__ __forceinline__ void phase_topk(const float* AFF, const float* RSTD, float* RS, int* IDX, float* GATE, int* POS, LAS unsigned char* ldsm, int blk, int nblk, int tid, int lane, int wave) {
    LAS int* hist = (LAS int*)ldsm;
    LAS int* sel = (LAS int*)(ldsm + 1024);
    LAS int* scr = (LAS int*)(ldsm + 1280);
    for (int g = blk; g < NGRP; g += nblk) {
        unsigned v[16];
        { const GAS v4u* src = (const GAS v4u*)(AFF + (size_t)g * SEQ) + tid * 4;
#pragma unroll
          for (int q = 0; q < 4; ++q) { const v4u w = src[q]; v[4 * q] = w.x; v[4 * q + 1] = w.y; v[4 * q + 2] = w.z; v[4 * q + 3] = w.w; } }
        unsigned prefix = 0u; int krem = CAP;
#pragma unroll 1
        for (int pass = 0; pass < 4; ++pass) {
            const int shift = 24 - 8 * pass;
            const unsigned himask = (pass == 0) ? 0u : (0xffffffffu << (shift + 8));
            __syncthreads();
            if (tid < 256) hist[tid] = 0;
            __syncthreads();
#pragma unroll
            for (int i = 0; i < 16; ++i) if ((v[i] & himask) == prefix) __hip_atomic_fetch_add(hist + ((v[i] >> shift) & 255u), 1, __ATOMIC_RELAXED, __HIP_MEMORY_SCOPE_WORKGROUP);
            __syncthreads();
            if (wave == 0) {
                int c[4]; int s = 0;
#pragma unroll
                for (int j = 0; j < 4; ++j) { c[j] = hist[255 - 4 * lane - j]; s += c[j]; }
                int inc = s;
#pragma unroll
                for (int o = 1; o < 64; o <<= 1) { const int n = __shfl_up(inc, o); if (lane >= o) inc += n; }
                int before = inc - s;
                if (before < krem && krem <= inc) {
                    int bin = 0, kk = krem - before; bool done = false;
#pragma unroll
                    for (int j = 0; j < 4; ++j) { if (!done) { if (kk <= c[j]) { bin = 255 - 4 * lane - j; done = true; } else kk -= c[j]; } }
                    sel[0] = bin; sel[1] = kk;
                }
            }
            __syncthreads();
            prefix |= ((unsigned)sel[0]) << shift; krem = sel[1];
        }
        int ceq = 0;
#pragma unroll
        for (int i = 0; i < 16; ++i) ceq += (v[i] == prefix) ? 1 : 0;
        int tot;
        int eqrank = block_excl_scan(ceq, scr, tid, lane, wave, &tot);
        int csel = 0; unsigned selmask = 0u;
#pragma unroll
        for (int i = 0; i < 16; ++i) { bool s = v[i] > prefix; if (v[i] == prefix) { s = eqrank < krem; ++eqrank; } if (s) { selmask |= 1u << i; ++csel; } }
        int slot = block_excl_scan(csel, scr, tid, lane, wave, &tot);
        const int b = g / NEXP;
        int pv[16];
#pragma unroll
        for (int i = 0; i < 16; ++i) {
            pv[i] = -1;
            if (selmask & (1u << i)) { pv[i] = slot; IDX[g * CAP + slot] = b * SEQ + tid * 16 + i; GATE[g * CAP + slot] = __builtin_bit_cast(float, v[i]); RS[g * CAP + slot] = RSTD[b * SEQ + tid * 16 + i]; ++slot; }
        }
        { GAS v4u* dst = (GAS v4u*)(POS + (size_t)g * SEQ) + tid * 4;
#pragma unroll
          for (int q = 0; q < 4; ++q) { v4u w; w.x = (unsigned)pv[4 * q]; w.y = (unsigned)pv[4 * q + 1]; w.z = (unsigned)pv[4 * q + 2]; w.w = (unsigned)pv[4 * q + 3]; dst[q] = w; } }
        __syncthreads();
    }
}

__device__ __forceinline__ void phase_gather(const bf16* XN, const int* IDX, bf16* XG, int gw, int NGW, int lane) {
    for (int r = gw; r < XROWS; r += NGW) {
        const int src = __builtin_amdgcn_readfirstlane(IDX[r]);
        const GAS v4u* s = (const GAS v4u*)(XN + (size_t)src * DM) + lane; GAS v4u* d = (GAS v4u*)(XG + (size_t)r * DM) + lane;
        const v4u a = s[0], b = s[64]; d[0] = a; d[64] = b;
    }
}

__device__ __forceinline__ void phase_qk_rope(bf16* P, const float* gq, const float* gk, int gw, int NGW, int lane) {
    const int hh = lane >> 2, part = lane & 3, axis = part >> 1, half = part & 1;
    const float* g = (hh < NQH ? gq : gk) + 16 * part;
    float gv[16], inv[16];
#pragma unroll
    for (int i = 0; i < 16; ++i) { gv[i] = g[i]; inv[i] = exp2f(-(float)i * (13.287712379549449f / 16.0f)); }
    const float osc = hh < NQH ? ATT_C2 : 1.0f;
    int m = gw; v4u c0 = (v4u){0u, 0u, 0u, 0u}, c1 = c0;
    if (m < M_TOK) { const GAS v4u* p = (const GAS v4u*)(P + (size_t)m * D_IN_AT + hh * HD + 16 * part); c0 = p[0]; c1 = p[1]; }
#pragma unroll 1
    for (; m < M_TOK; m += NGW) {
        const int t = m % SEQ; const float pos = (float)(axis == 0 ? (t >> 6) : (t & 63));
        GAS v4u* p = (GAS v4u*)(P + (size_t)m * D_IN_AT + hh * HD + 16 * part);
        const v4u w0 = c0, w1 = c1;
        if (m + NGW < M_TOK) { const GAS v4u* pn = (const GAS v4u*)(P + (size_t)(m + NGW) * D_IN_AT + hh * HD + 16 * part); c0 = pn[0]; c1 = pn[1]; }
        float x[16];
        x[0] = bflo(w0.x); x[1] = bfhi(w0.x); x[2] = bflo(w0.y); x[3] = bfhi(w0.y); x[4] = bflo(w0.z); x[5] = bfhi(w0.z); x[6] = bflo(w0.w); x[7] = bfhi(w0.w);
        x[8] = bflo(w1.x); x[9] = bfhi(w1.x); x[10] = bflo(w1.y); x[11] = bfhi(w1.y); x[12] = bflo(w1.z); x[13] = bfhi(w1.z); x[14] = bflo(w1.w); x[15] = bfhi(w1.w);
        float ss = 0.f;
#pragma unroll
        for (int i = 0; i < 16; ++i) ss += x[i] * x[i];
        ss += __shfl_xor(ss, 1); ss += __shfl_xor(ss, 2);
        const float rstd = 1.f / sqrtf(ss * (1.f / HD) + NORM_EPS);
        float o[16];
#pragma unroll
        for (int i = 0; i < 16; ++i) {
            const float xn = x[i] * rstd * gv[i]; const float xp = __shfl_xor(xn, 1);
            float sn, cs; sincosf(pos * inv[i], &sn, &cs);
            o[i] = (half == 0 ? (xn * cs - xp * sn) : (xp * sn + xn * cs)) * osc;
        }
        v4u r0, r1;
        r0.x = pk2(o[0], o[1]); r0.y = pk2(o[2], o[3]); r0.z = pk2(o[4], o[5]); r0.w = pk2(o[6], o[7]);
        r1.x = pk2(o[8], o[9]); r1.y = pk2(o[10], o[11]); r1.z = pk2(o[12], o[13]); r1.w = pk2(o[14], o[15]);
        p[0] = r0; p[1] = r1;
    }
}

__device__ __forceinline__ void phase_transpose_mix(const bf16* MIXT, bf16* MIX, LAS unsigned char* lds, int blk, int nblk, int tid) {
    constexpr int TP = 516;
    for (int it = blk; it < (D_MAIN / 64) * (M_TOK / 256); it += nblk) {
        const int cb = it % (D_MAIN / 64), mb = it / (D_MAIN / 64), c0 = cb * 64, m0 = mb * 256;
        __syncthreads();
#pragma unroll
        for (int k = 0; k < 4; ++k) { const int p = tid + NTHREADS * k, ch = p >> 5, seg = p & 31;
            const v4u w = *(const GAS v4u*)(MIXT + (size_t)(c0 + ch) * M_TOK + m0 + seg * 8);
            LAS unsigned* d = (LAS unsigned*)(lds + ch * TP + seg * 16); d[0] = w.x; d[1] = w.y; d[2] = w.z; d[3] = w.w; }
        __syncthreads();
#pragma unroll
        for (int k = 0; k < 4; ++k) { const int q = tid + NTHREADS * k, r = q >> 3, j = q & 7;
            const LAS bf16* s = (const LAS bf16*)(lds + (8 * j) * TP) + r;
            v4u o; o.x = (unsigned)s[0] | ((unsigned)s[TP / 2] << 16); o.y = (unsigned)s[2 * (TP / 2)] | ((unsigned)s[3 * (TP / 2)] << 16);
            o.z = (unsigned)s[4 * (TP / 2)] | ((unsigned)s[5 * (TP / 2)] << 16); o.w = (unsigned)s[6 * (TP / 2)] | ((unsigned)s[7 * (TP / 2)] << 16);
            *(GAS v4u*)(MIX + (size_t)(m0 + r) * DM + c0 + 8 * j) = o; }
    }
    __syncthreads();
}
__device__ __forceinline__ void phase_taps(const float* H2j, const float* w3, float* TAPS, int gw, int NGW, int lane) {
    typedef float f32x16 __attribute__((ext_vector_type(16))); typedef short bf16x8_t __attribute__((ext_vector_type(8)));
    const float min_decay = -4.605170185988091f / 1.5f, max_decay = -4.605170185988091f / 0.3f;
    const int li = lane & 31, hi = lane >> 5;
#pragma unroll 1
    for (int it = gw; it < (FCOLS / 32) * (SEQ / 128); it += NGW) {
        const int ct = it % (FCOLS / 32), ng = it / (FCOLS / 32), col0 = ct * 32;
        bf16x8_t a[4];
#pragma unroll
        for (int s = 0; s < 4; ++s) { float t[8];
#pragma unroll
            for (int j = 0; j < 8; ++j) t[j] = w3[(size_t)(16 * s + 8 * hi + j) * FCOLS + col0 + li];
            v4u p; p.x = pk2(t[0], t[1]); p.y = pk2(t[2], t[3]); p.z = pk2(t[4], t[5]); p.w = pk2(t[6], t[7]); a[s] = __builtin_bit_cast(bf16x8_t, p); }
        f32x4 hv[4][8];
#pragma unroll
        for (int nt = 0; nt < 4; ++nt) { const GAS f32x4* hp = (const GAS f32x4*)(H2j + (size_t)(ng * 128 + nt * 32 + li) * HY_FILT + 8 * hi);
#pragma unroll
            for (int s = 0; s < 4; ++s) { hv[nt][2 * s] = hp[4 * s]; hv[nt][2 * s + 1] = hp[4 * s + 1]; } }
#pragma unroll
        for (int nt = 0; nt < 4; ++nt) {
            const int n0 = ng * 128 + nt * 32;
            f32x16 acc;
#pragma unroll
            for (int r = 0; r < 16; ++r) acc[r] = 0.f;
#pragma unroll
            for (int s = 0; s < 4; ++s) { const f32x4 v0 = hv[nt][2 * s], v1 = hv[nt][2 * s + 1];
                v4u p; p.x = pk2(v0.x, v0.y); p.y = pk2(v0.z, v0.w); p.z = pk2(v1.x, v1.y); p.w = pk2(v1.z, v1.w);
                acc = __builtin_amdgcn_mfma_f32_32x32x16_bf16(a[s], __builtin_bit_cast(bf16x8_t, p), acc, 0, 0, 0); }
            const float t = (float)(n0 + li) * (1.0f / (float)(SEQ - 1));
#pragma unroll
            for (int r = 0; r < 16; ++r) { const int col = col0 + (r & 3) + 8 * (r >> 2) + 4 * hi, c = col % D_MAIN;
                const float ad = fabsf(min_decay + (float)c * ((max_decay - min_decay) / (float)(D_MAIN - 1)));
                TAPS[(size_t)col * SEQ + n0 + li] = acc[r] * expf(-t * ad); }
        }
    }
}

__device__ __forceinline__ constexpr float twc(int k) { constexpr float T[16] = {1.0f, 0.98078528040323043f, 0.92387953251128674f, 0.83146961230254524f, 0.70710678118654757f, 0.55557023301960218f, 0.38268343236508978f, 0.19509032201612825f,
    0.0f, -0.19509032201612825f, -0.38268343236508978f, -0.55557023301960218f, -0.70710678118654757f, -0.83146961230254524f, -0.92387953251128674f, -0.98078528040323043f}; return T[k]; }
__device__ __forceinline__ constexpr float tws(int k) { constexpr float T[16] = {0.0f, 0.19509032201612825f, 0.38268343236508978f, 0.55557023301960218f, 0.70710678118654757f, 0.83146961230254524f, 0.92387953251128674f, 0.98078528040323043f,
    1.0f, 0.98078528040323043f, 0.92387953251128674f, 0.83146961230254524f, 0.70710678118654757f, 0.55557023301960218f, 0.38268343236508978f, 0.19509032201612825f}; return T[k]; }
__device__ __forceinline__ constexpr int bitrev(int i, int bits) { int r = 0; for (int b = 0; b < bits; ++b) if (i & (1 << b)) r |= 1 << (bits - 1 - b); return r; }

template <int N, int LEN> struct FftStage {
    static __device__ __forceinline__ void run(float (&re)[N], float (&im)[N]) {
        constexpr int half = LEN / 2, step = 32 / LEN;
#pragma unroll
        for (int base = 0; base < N; base += LEN)
#pragma unroll
            for (int j = 0; j < half; ++j) {
                const int i0 = base + j, i1 = i0 + half, idx = j * step;
                const float ar = re[i0], ai = im[i0], br = re[i1], bi = im[i1];
                re[i0] = ar + br; im[i0] = ai + bi;
                const float dr = ar - br, di = ai - bi;
                if (idx == 0) { re[i1] = dr; im[i1] = di; }
                else if (idx == 8) { re[i1] = di; im[i1] = -dr; }
                else { const float c = twc(idx), s = tws(idx); re[i1] = dr * c + di * s; im[i1] = di * c - dr * s; }
            }
        if constexpr (LEN > 2) FftStage<N, LEN / 2>::run(re, im);
    }
};
template <int N, int BITS> __device__ __forceinline__ void fft_reg(float (&re)[N], float (&im)[N]) {
    FftStage<N, N>::run(re, im);
    float tr[N], ti[N];
#pragma unroll
    for (int i = 0; i < N; ++i) { tr[bitrev(i, BITS)] = re[i]; ti[bitrev(i, BITS)] = im[i]; }
#pragma unroll
    for (int i = 0; i < N; ++i) { re[i] = tr[i]; im[i] = ti[i]; }
}

template <int N, int LEN> struct FftStageC {
    static __device__ __forceinline__ void run(f32x2 (&x)[N]) {
        constexpr int half = LEN / 2, step = 32 / LEN;
#pragma unroll
        for (int base = 0; base < N; base += LEN)
#pragma unroll
            for (int j = 0; j < half; ++j) {
                const int i0 = base + j, i1 = i0 + half, idx = j * step;
                const f32x2 a = x[i0], b = x[i1];
                x[i0] = a + b;
                const f32x2 d = a - b;
                if (idx == 0) x[i1] = d;
                else if (idx == 8) x[i1] = (f32x2){d.y, -d.x};
                else { const float c = twc(idx), s = tws(idx); const f32x2 t = (f32x2){d.y, -d.x}; x[i1] = d * c + t * s; }
            }
        if constexpr (LEN > 2) FftStageC<N, LEN / 2>::run(x);
    }
};
template <int N, int BITS> __device__ __forceinline__ void fft_regc(f32x2 (&x)[N]) {
    FftStageC<N, N>::run(x);
    f32x2 t[N];
#pragma unroll
    for (int i = 0; i < N; ++i) t[bitrev(i, BITS)] = x[i];
#pragma unroll
    for (int i = 0; i < N; ++i) x[i] = t[i];
}
__device__ __forceinline__ void fft16k_c(f32x2 (&x)[32], LAS f32x2* L, int tid_in) {
    int tid = tid_in; asm volatile("" : "+v"(tid));
    fft_regc<32, 5>(x);
#pragma unroll
    for (int k1 = 1; k1 < 32; ++k1) { const float fr = (float)((tid * k1) & 16383) * (1.0f / 16384.0f); const float c = __builtin_amdgcn_cosf(fr), s = __builtin_amdgcn_sinf(fr);
        const f32x2 d = x[k1], t = (f32x2){d.y, -d.x}; x[k1] = d * c + t * s; if ((k1 & 3) == 3) __builtin_amdgcn_sched_barrier(0); }
#pragma unroll
    for (int k1 = 0; k1 < 32; ++k1) L[k1 * 513 + tid] = x[k1];
    __syncthreads();
    const int n3 = tid & 31, ka = tid >> 5;
    f32x2 a[16], b[16];
#pragma unroll
    for (int n2 = 0; n2 < 16; ++n2) { a[n2] = L[ka * 513 + n2 * 32 + n3]; b[n2] = L[(ka + 16) * 513 + n2 * 32 + n3]; }
    fft_regc<16, 4>(a); fft_regc<16, 4>(b);
#pragma unroll
    for (int k2 = 1; k2 < 16; ++k2) { const float fr = (float)((n3 * k2) & 511) * (1.0f / 512.0f); const float c = __builtin_amdgcn_cosf(fr), s = __builtin_amdgcn_sinf(fr);
        f32x2 d = a[k2], t = (f32x2){d.y, -d.x}; a[k2] = d * c + t * s; d = b[k2]; t = (f32x2){d.y, -d.x}; b[k2] = d * c + t * s; if ((k2 & 3) == 3) __builtin_amdgcn_sched_barrier(0); }
    __syncthreads();
#pragma unroll
    for (int k2 = 0; k2 < 16; ++k2) { L[n3 * 513 + k2 * 32 + ka] = a[k2]; L[n3 * 513 + k2 * 32 + ka + 16] = b[k2]; }
    __syncthreads();
#pragma unroll
    for (int q = 0; q < 32; ++q) x[q] = L[q * 513 + tid];
    fft_regc<32, 5>(x);
}
__device__ __forceinline__ void fft16k(float (&re)[32], float (&im)[32], LAS f32x2* L, int tid) {
    f32x2 x[32];
#pragma unroll
    for (int r = 0; r < 32; ++r) x[r] = (f32x2){re[r], im[r]};
    fft16k_c(x, L, tid);
#pragma unroll
    for (int r = 0; r < 32; ++r) { re[r] = x[r].x; im[r] = x[r].y; }
}

constexpr int HS_SP = SEQ + 16;
__device__ __forceinline__ void hy_stage(LAS bf16* S, int slot, const bf16* src, int tid) {
    LAS bf16* d = S + slot * HS_SP + 8;
    if (tid == 0) { d[-1] = 0; d[SEQ] = 0; }
#pragma unroll
    for (int q = 0; q < 2; ++q) { const int ch = q * NTHREADS + tid; *(LAS v4u*)(d + ch * 8) = *(const GAS v4u*)(src + ch * 8); }
}
__device__ __forceinline__ float hy_sc(const LAS bf16* S, int slot, int t, float w0, float w1, float w2) {
    const LAS bf16* p = S + slot * HS_SP + 8 + t;
    return bf2f(p[-1]) * w0 + bf2f(p[0]) * w1 + bf2f(p[1]) * w2;
}

#ifdef CSEL
#define CT(sec) do { const unsigned long long tn_ = __builtin_amdgcn_s_memrealtime(); if (csec_ == CSEL) ctime_ += tn_ - ct0_; ct0_ = tn_; csec_ = (sec); } while (0)
#else
#define CT(sec)
#endif
__device__ __forceinline__ void phase_hyena_conv(const bf16* PT, const float* TAPS, const float* shortw, const float* skip, f32x2* XSall, f32x2* ZSall, bf16* MIXT,
                                                 LAS unsigned char* lds, int blk, int nblk, int tid_in, int lane, int wave, int pmode = 0) {
    LAS f32x2* L = (LAS f32x2*)lds; LAS bf16* S = (LAS bf16*)lds; LAS float* red = (LAS float*)(lds + LDS_MISC);
    f32x2* XK0 = XSall + (size_t)blk * 16384;
    f32x2* XK1 = XK0 + 16384 * 256; f32x2* ZS = ZSall + (size_t)blk * 16384;
    constexpr int N = 16384;
#ifdef CSEL
    unsigned long long ctime_ = 0ull, ct0_ = __builtin_amdgcn_s_memrealtime(); int csec_ = -1;
#endif
#pragma unroll 1
    for (int c = blk; c < D_MAIN; c += nblk) {
        f32x2 x[32]; float vr[16], vi[16];
#pragma unroll 1
        for (int pass = 0; pass < 5; ++pass) {
            int tid = tid_in; asm volatile("" : "+v"(tid));
            CT(pass == 0 ? 0 : (pass == 1 ? 7 : 8));
            if (pass == 0) {
                const float* hf0 = TAPS + (size_t)c * SEQ; const float* hb0 = TAPS + (size_t)(D_MAIN + c) * SEQ;
                const float* hf1 = TAPS + (size_t)(2 * D_MAIN + c) * SEQ; const float* hb1 = TAPS + (size_t)(3 * D_MAIN + c) * SEQ;
#pragma unroll
                for (int r = 0; r < 16; ++r) { const int n = r * 512 + tid; x[r].x = hf0[n]; x[r].y = hf1[n]; }
#pragma unroll
                for (int r = 16; r < 32; ++r) { const int idx = (32 - r) * 512 - tid; const bool z = (idx == SEQ); const int ii = z ? 0 : idx; x[r].x = z ? 0.f : hb0[ii]; x[r].y = z ? 0.f : hb1[ii]; }
                float e0 = 0.f, e1 = 0.f;
                if (tid == 0) { e0 = hb0[0]; e1 = hb1[0]; }
                float s0 = fabsf(e0), s1 = fabsf(e1);
#pragma unroll
                for (int r = 0; r < 32; ++r) { s0 += fabsf(x[r].x); s1 += fabsf(x[r].y); }
                s0 = wave_sum(s0); s1 = wave_sum(s1);
                __syncthreads();
                if (lane == 0) { red[wave] = s0; red[8 + wave] = s1; }
                __syncthreads();
                float t0 = 0.f, t1 = 0.f;
#pragma unroll
                for (int w = 0; w < NWAVES; ++w) { t0 += red[w]; t1 += red[8 + w]; }
                const float sc0 = 1.0f / (t0 + 1e-6f), sc1 = 1.0f / (t1 + 1e-6f);
                x[0].x += e0; x[0].y += e1;
#pragma unroll
                for (int r = 0; r < 32; ++r) { x[r].x *= sc0; x[r].y *= sc1; }
            } else if (pass == 1) {
                __syncthreads();
                const bf16* pv = PT + (size_t)(2 * D_MAIN + c) * M_TOK; const float wv[3] = {shortw[2 * D_MAIN + c], shortw[2304 + 2 * D_MAIN + c], shortw[4608 + 2 * D_MAIN + c]};
                hy_stage(S, 0, pv, tid); hy_stage(S, 1, pv + SEQ, tid);
                __syncthreads();
#pragma unroll
                for (int r = 0; r < 16; ++r) { const int t = r * 512 + tid; x[r].x = hy_sc(S, 0, t, wv[0], wv[1], wv[2]); x[r].y = hy_sc(S, 1, t, wv[0], wv[1], wv[2]); vr[r] = x[r].x; vi[r] = x[r].y; }
#pragma unroll
                for (int r = 16; r < 32; ++r) { x[r].x = 0.f; x[r].y = 0.f; }
            }
            __syncthreads();
            CT(1);
            fft16k_c(x, L, tid);
            CT(2 + pass);
            if (pass == 0) {
                __syncthreads();
#pragma unroll
                for (int r = 0; r < 32; ++r) L[r * 513 + tid] = x[r];
                __syncthreads();
                const int tp = (512 - tid) & 511;
#pragma unroll
                for (int r = 0; r < 32; ++r) { const int rp = (tid == 0) ? ((32 - r) & 31) : (31 - r);
                    const f32x2 xa = x[r], xb = L[rp * 513 + tp]; const float sc_ = 0.5f / (float)N;
                    XK0[r * 512 + tid] = (f32x2){(xa.x + xb.x) * sc_, (xa.y - xb.y) * sc_};
                    XK1[r * 512 + tid] = (f32x2){(xa.y + xb.y) * sc_, (xb.x - xa.x) * sc_}; if ((r & 7) == 7) __builtin_amdgcn_sched_barrier(0); }
            } else if (pass == 1 || pass == 3) {
                const f32x2* XK = (pass == 1) ? XK0 : XK1;
#pragma unroll
                for (int r = 0; r < 32; ++r) { const f32x2 k = XK[r * 512 + tid]; const float zr_ = x[r].x, zi_ = x[r].y;
                    x[r].x = zr_ * k.x - zi_ * k.y; x[r].y = -(zr_ * k.y + zi_ * k.x); }
            } else if (pass == 2) {
                __syncthreads();
                const bf16* px1 = PT + (size_t)c * M_TOK; const float sk0 = skip[c]; const float wx1[3] = {shortw[c], shortw[2304 + c], shortw[4608 + c]};
                hy_stage(S, 2, px1, tid); hy_stage(S, 3, px1 + SEQ, tid);
                __syncthreads();
#pragma unroll
                for (int r = 0; r < 16; ++r) { const int t = r * 512 + tid;
                    const float v0 = vr[r], v1 = vi[r];
                    const float g0 = hy_sc(S, 2, t, wx1[0], wx1[1], wx1[2]), g1 = hy_sc(S, 3, t, wx1[0], wx1[1], wx1[2]);
                    x[r].x = g0 * (x[r].x + sk0 * v0); x[r].y = g1 * (-x[r].y + sk0 * v1); ZS[t] = (f32x2){x[r].x, x[r].y}; }
#pragma unroll
                for (int r = 16; r < 32; ++r) { x[r].x = 0.f; x[r].y = 0.f; }
            } else {
                __syncthreads();
                const bf16* px2 = PT + (size_t)(D_MAIN + c) * M_TOK; const float sk1 = skip[D_MAIN + c];
                const float wx2[3] = {shortw[D_MAIN + c], shortw[2304 + D_MAIN + c], shortw[4608 + D_MAIN + c]};
                hy_stage(S, 0, px2, tid); hy_stage(S, 1, px2 + SEQ, tid);
                __syncthreads();
#pragma unroll
                for (int r = 0; r < 16; ++r) { const int t = r * 512 + tid;
                    const float g0 = hy_sc(S, 0, t, wx2[0], wx2[1], wx2[2]), g1 = hy_sc(S, 1, t, wx2[0], wx2[1], wx2[2]);
                    const f32x2 z = ZS[t];
                    const float o0 = g0 * (x[r].x + sk1 * z.x), o1 = g1 * (-x[r].y + sk1 * z.y);
                    MIXT[(size_t)c * M_TOK + t] = (bf16)f2bf(o0); MIXT[(size_t)c * M_TOK + SEQ + t] = (bf16)f2bf(o1); }
            }
        }
        CT(-1);
        __syncthreads();
    }
#ifdef CSEL
    if (blk == 0 && tid_in == 0) *(unsigned long long*)((unsigned char*)XSall - WS_FFTX + 32768) += ctime_;
#endif
}
#ifndef MK_PER_PHASE
#define MK_PER_PHASE 0
#endif
#ifndef CONV_PMODE
#define CONV_PMODE 0
#endif
#ifndef REPMASK
#define REPMASK 0u
#endif
#define REP(kind) _Pragma("unroll 1") for (int r_ = 0; r_ < 1 + (int)((REPMASK >> (kind)) & 1u); ++r_)
struct Args {
    const float* in[24]; float* out; unsigned char* ws; int ph_lo, ph_hi;
};
constexpr int N_PHASES = 1 + (DEPTH - 1) + DEPTH * 8 - DEPTH / 2 + 1;

template <int QP, int KP, int THRL = 8>
__device__ __forceinline__ void run_attn(const bf16* Q, const bf16* K, const bf16* V, bf16* O, int NT, char* shm, int wave_s) {
    attn_body::attn_unit<THRL, QP, KP, DM>((const attn_body::bf16*)Q, (const attn_body::bf16*)K, (const attn_body::bf16*)V, (attn_body::bf16*)O, NT, shm, wave_s);
}

__global__ void __launch_bounds__(NTHREADS, 2) hybrid_fwd(Args args) {
    extern __shared__ __attribute__((aligned(16))) unsigned char lds_raw[];
    LAS unsigned char* lds = (LAS unsigned char*)lds_raw;
    const int G = gridDim.x, bx = blockIdx.x;
    const int wave0 = __builtin_amdgcn_readfirstlane((int)(threadIdx.x >> 6));
    const int vcu = (G % 8 == 0) ? (bx % 8) * (G / 8) + bx / 8 : bx;
    const int NGW = G * NWAVES;
    unsigned char* const ws0_ = args.ws;
    const float* x = args.in[0]; const float* mem = args.in[1]; const float* mix_g = args.in[2]; const float* ffn_g = args.in[3]; const float* mem_g = args.in[4]; const float* fin_g = args.in[5];
    const float* hy_short = args.in[9]; const float* f_w1 = args.in[10]; const float* f_b1 = args.in[11]; const float* f_w2 = args.in[12]; const float* f_b2 = args.in[13];
    const float* f_w3 = args.in[14]; const float* f_freq = args.in[15]; const float* hy_skip = args.in[16]; const float* qg = args.in[18]; const float* kg = args.in[19]; const float* router = args.in[20];
    float* H = args.out;
#define U ((bf16*)(ws + WS_U))
#define PROJ ((bf16*)(ws + WS_PROJ))
#define CQ ((bf16*)(ws + WS_CQ))
#define MIX ((bf16*)(ws + WS_MIX))
#define MIXT ((bf16*)(ws + WS_MIXT))
#define AFF ((float*)(ws + WS_AFF))
#define IDX ((int*)(ws + WS_IDX))
#define GATE ((float*)(ws + WS_GATE))
#define POS ((int*)(ws + WS_POS))
#define HID ((bf16*)(ws + WS_HID))
#define Y ((bf16*)(ws + WS_Y))
#define TAPS ((float*)(ws + WS_TAPS))
#define MKV ((const bf16*)(ws + WS_MKV))
    cg::grid_group grid = cg::this_grid();
    volatile LAS unsigned* bst = (volatile LAS unsigned*)(lds + LDS_MISC + 4096);
    if (threadIdx.x < 2) bst[threadIdx.x] = 0u;
    __syncthreads();
    XcdBarrier xbar = xcd_barrier_post((unsigned*)(ws0_ + WS_CTL) + 1024, bst);
    const int lo = args.ph_lo, hi = args.ph_hi;
#define XW (XwIn{args.in[21], args.in[22], args.in[23], ws})
    const bool xw_sched = (G == 256);
    int ph = 0;
#ifdef TSEL
    unsigned long long tacc_ = 0ull, t0_ = 0ull, t1_ = 0ull; int pk_ = 0, tpar_ = 0;
#endif
#ifdef TSEL
#ifndef TAMP
#define TAMP 10
#endif
#ifndef TBAR
#define TBAR 0
#endif
#define PH_T0(k) pk_ = (k); t0_ = __builtin_amdgcn_s_memrealtime();
#ifndef TPAR
#define TPAR -1
#endif
#define PH_T1 t1_ = __builtin_amdgcn_s_memrealtime(); if (!TBAR && (pk_ == TSEL || TSEL == 99) && (TPAR < 0 || tpar_ == TPAR)) tacc_ += t1_ - t0_;
#define PH_T2 if (TBAR && (pk_ == TSEL || TSEL == 99)) tacc_ += __builtin_amdgcn_s_memrealtime() - t1_;
#else
#define PH_T0(k)
#define PH_T1
#define PH_T2
#endif
#define PHASE_BEGINK(k) PH_T0(k) if (lo <= ph && ph < hi) { unsigned char* ws = ws0_; asm volatile("" : "+s"(ws)); const int tid = opaque_tid(wave0), lane = tid & 63, wave = __builtin_amdgcn_readfirstlane(tid >> 6), gw = vcu * NWAVES + wave; (void)lane; (void)gw;
#ifdef EXTRA_XBAR
#define PHASE_END   if (ph + 1 < hi) { if (ph == lo) grid.sync(); else { xcd_barrier(xbar); if (ph < EXTRA_XBAR) xcd_barrier(xbar); } } } ++ph;
#else
#define PHASE_END   PH_T1 if (ph + 1 < hi) { if (hi == 0x7fffffff) grid.sync(); else xcd_barrier(xbar); } PH_T2 } ++ph;
#endif

    PHASE_BEGINK(0)
        ProIn P{args.in[8], args.in[17], args.in[7], args.in[6]};
        REP(0) { phase_weights(P, ws, lds, gw, NGW, wave, lane); phase_xw_p0(XW, xw_sched, (LAS float*)(lds + wave * 16384), gw, NGW, lane); }
        phase_wrg(ffn_g, router, (float*)(ws + WS_WRG), (int)(bx * NTHREADS + tid), (int)(G * NTHREADS));
        REP(1) phase_mem_h2(mem, mem_g, f_w1, f_b1, f_w2, f_b2, f_freq, ws, gw, NGW, lane);
        REP(3) phase_norm<false, false>(x, nullptr, mix_g, U, nullptr, nullptr, nullptr, gw, NGW, lane);
    PHASE_END

#pragma unroll 1
    for (int i = 0; i < DEPTH; ++i) {
        const bool hy = (i & 1) == 0; const int j = i >> 1;
#ifdef TSEL
        tpar_ = i & 1;
#endif
        if (i > 0) {
        PHASE_BEGINK(1)
            phase_norm<true, false>(H, H, mix_g + i * DM, U, nullptr, POS, Y, gw, NGW, lane);
        PHASE_END
        }
        PHASE_BEGINK(2)
            if (i == 0) {
                pg8::Gemm g{(const bf16*)(ws + WS_MEMN), (const bf16*)(ws + WS_WMKV), BATCH * MEM_LEN, 2048, DM, 1 << 30, 1, 0};
                pg8::StaticOrder S; S.init(BATCH * MEM_LEN, 2048, G, bx);
                pg8::EpiRowBf16 E{(bf16*)(ws + WS_MKV), 2048, -1, 1.f};
                pg8::gemm_phase<pg8::EpiRowBf16, pg8::StaticOrder, true, true>(lds, g, S, E, wave);
            }
            if (hy) {
                REP(4) phase_taps((const float*)(ws + WS_H2) + (size_t)j * SEQ * HY_FILT, f_w3 + (size_t)j * HY_FILT * FCOLS, TAPS, gw, NGW, lane);
                pg8::Gemm g{U, (const bf16*)(ws + WS_WHY) + (size_t)j * D_IN_HY * DM, M_TOK, D_IN_HY, DM, 1 << 30, 1, 0};
                pg8::StaticOrder S; S.init(M_TOK, D_IN_HY, G, bx);
                pg8::EpiHyIn E{PROJ, M_TOK, 9, CQ, ATT_C2};
                REP(5) pg8::gemm_phase<pg8::EpiHyIn, pg8::StaticOrder, true, true>(lds, g, S, E, wave);
            } else {
                pg8::Gemm g{U, (const bf16*)(ws + WS_WAT) + (size_t)j * D_IN_AT * DM, M_TOK, D_IN_AT, DM, 1 << 30, 1, 0};
                pg8::StaticOrder S; S.init(M_TOK, D_IN_AT, G, bx);
                pg8::EpiAtIn E{PROJ, PROJ + (size_t)M_TOK * 768, PROJ + (size_t)M_TOK * 1024, PROJ + (size_t)M_TOK * 1280, qg + j * HD, kg + j * HD, ATT_C2, NORM_EPS, SEQ - 1};
                REP(6) pg8::gemm_phase<pg8::EpiAtIn, pg8::StaticOrder, true, true>(lds, g, S, E, wave);
            }
            if (xw_sched && bx >= 128) xw_slice_a(XW, i, (LAS float*)(lds + wave * 16384), bx, wave, lane);
        PHASE_END
        PHASE_BEGINK(3)
            if (hy) {
                REP(8) phase_hyena_conv(PROJ, TAPS, hy_short + (size_t)j * 3 * 2304, hy_skip + (size_t)j * 2 * D_MAIN, (f32x2*)(ws + WS_FFTX), (f32x2*)(ws + WS_ZS), MIXT, lds, bx, G, tid, lane, wave);
                REP(9) for (int u = vcu; u < 256; u += G) { const int b = u >> 7, h4 = (u >> 5) & 3, qb = u & 31; const size_t row = (size_t)b * SEQ + qb * 256;
                    run_attn<256, 2048>(CQ + row * 256 + h4 * HD, MKV + (size_t)b * MEM_LEN * 2048 + i * 512 + h4 * HD, MKV + (size_t)b * MEM_LEN * 2048 + i * 512 + 256 + h4 * HD,
                                        MIX + row * DM + D_MAIN + h4 * HD, MEM_LEN / 64, (char*)lds_raw, wave); }
            } else {
                REP(10) for (int u = vcu; u < 768; u += G) { const int bk = (u & 255) >> 5, qb = u & 31, hs = u >> 8, b = bk >> 2, kvh = bk & 3, h = kvh * 3 + hs; const size_t row = (size_t)b * SEQ + qb * 256;
                    run_attn<768, 256, -1>(PROJ + row * 768 + h * HD, PROJ + (size_t)M_TOK * 768 + (size_t)b * SEQ * 256 + kvh * HD, PROJ + (size_t)M_TOK * 1024 + (size_t)b * SEQ * 256 + kvh * HD,
                                       MIX + row * DM + h * HD, SEQ / 64, (char*)lds_raw, wave); }
                REP(9) for (int u = vcu; u < 256; u += G) { const int b = u >> 7, h4 = (u >> 5) & 3, qb = u & 31; const size_t row = (size_t)b * SEQ + qb * 256;
                    run_attn<256, 2048>(PROJ + (size_t)M_TOK * 1280 + row * 256 + h4 * HD, MKV + (size_t)b * MEM_LEN * 2048 + i * 512 + h4 * HD, MKV + (size_t)b * MEM_LEN * 2048 + i * 512 + 256 + h4 * HD,
                                        MIX + row * DM + D_MAIN + h4 * HD, MEM_LEN / 64, (char*)lds_raw, wave); }
            }
        PHASE_END
        if (hy) {
            PHASE_BEGINK(4)
                REP(11) phase_transpose_mix(MIXT, MIX, lds, bx, G, tid);
            PHASE_END
        }
        PHASE_BEGINK(5)
            pg8::Gemm g{MIX, (const bf16*)(ws + WS_WOUT) + (size_t)i * DM * DM, M_TOK, DM, DM, 1 << 30, 1, 0};
            pg8::StaticOrder S; S.init(M_TOK, DM, G, bx);
            pg8::EpiOutX E{i == 0 ? x : (const float*)H, H, DM, ffn_g + i * DM, (const float*)(ws + WS_WRG) + (size_t)i * NEXP * DM, (unsigned char*)U, (float*)(ws + WS_PART), (float*)(ws + WS_PSS), M_TOK};
            pg8::gemm_phase<pg8::EpiOutX, pg8::StaticOrder, true, true>(lds, g, S, E, wave);
        PHASE_END
        PHASE_BEGINK(6)
            REP(13) phase_router_sum((const float*)(ws + WS_PART), (const float*)(ws + WS_PSS), (float*)(ws + WS_RSTD), AFF, gw, NGW, lane);
        PHASE_END
        PHASE_BEGINK(7)
            REP(14) phase_topk(AFF, (const float*)(ws + WS_RSTD), (float*)(ws + WS_RS), IDX, GATE, POS, lds + LDS_MISC, bx, G, tid, lane, wave);
            if (xw_sched && bx >= 32) xw_slice_b(XW, i, (LAS float*)(lds + wave * 16384), bx, wave, lane);
        PHASE_END
        PHASE_BEGINK(8)
            pg8::Gemm g{U, (const bf16*)(ws + WS_W1 + (size_t)i * NEXP * 1536 * DM), XROWS, 1536, DM / 2, 4, NEXP, (size_t)1536 * DM};
            pg8::StaticOrder S; S.init(XROWS, 1536, G, bx);
            pg8::EpiSwiGLU8 E{(unsigned char*)HID, EFF, 1.0f / W8_SCALE, (const float*)(ws + WS_RS)};
            REP(16) pg8::gemm_phase<pg8::EpiSwiGLU8, pg8::StaticOrder, true, true, true, true>(lds, g, S, E, wave, IDX);
        PHASE_END
        PHASE_BEGINK(9)
            pg8::Gemm g{HID, (const bf16*)(ws + WS_W2 + (size_t)i * NEXP * DM * EFF), XROWS, DM, EFF / 2, 4, NEXP, (size_t)DM * EFF};
            pg8::StaticOrder S; S.init(XROWS, DM, G, bx);
            pg8::EpiDown E{Y, DM, GATE, 1.0f / W8_SCALE};
            REP(17) pg8::gemm_phase<pg8::EpiDown, pg8::StaticOrder, true, true, false, true>(lds, g, S, E, wave);
        PHASE_END
    }
    PHASE_BEGINK(10)
        phase_norm<true, true>(H, nullptr, fin_g, nullptr, args.out, POS, Y, gw, NGW, lane);
    PHASE_END
#ifdef TSEL
#ifdef CSEL
    if (bx == 0 && threadIdx.x == 0) tacc_ += *(unsigned long long*)(ws0_ + 32768);
#endif
    if (bx == 0 && threadIdx.x == 0 && hi - lo > 1) { const unsigned long long te_ = __builtin_amdgcn_s_memrealtime(); while (__builtin_amdgcn_s_memrealtime() - te_ < (unsigned long long)TAMP * tacc_) __builtin_amdgcn_s_sleep(8); }
#endif
#undef PHASE_BEGINK
#undef U
#undef PROJ
#undef CQ
#undef MIX
#undef MIXT
#undef AFF
#undef IDX
#undef GATE
#undef POS
#undef HID
#undef Y
#undef TAPS
#undef MKV
#undef XW
#undef PHASE_END
}

extern "C" void kernel_launch(void* const* d_in, const int* in_sizes, int n_in, void* d_out, int out_size, void* d_ws, size_t ws_size, hipStream_t stream) {
    static int grid = 0;
    if (grid == 0) {
        if (n_in != 24 || out_size != M_TOK * DM || ws_size < WS_END) { fprintf(stderr, "kernel_launch: unexpected shapes (n_in %d out %d ws %zu need %zu)\n", n_in, out_size, ws_size, (size_t)WS_END); grid = -1; return; }
        int dev = 0, cus = 0, per_cu = 0;
        if (hipGetDevice(&dev) != hipSuccess || hipDeviceGetAttribute(&cus, hipDeviceAttributeMultiprocessorCount, dev) != hipSuccess) { grid = -1; return; }
        if (hipFuncSetAttribute((const void*)hybrid_fwd, hipFuncAttributeMaxDynamicSharedMemorySize, LDS_BYTES) != hipSuccess) { fprintf(stderr, "kernel_launch: hipFuncSetAttribute failed\n"); grid = -1; return; }
        if (hipOccupancyMaxActiveBlocksPerMultiprocessor(&per_cu, (const void*)hybrid_fwd, NTHREADS, LDS_BYTES) != hipSuccess || per_cu < 1) { fprintf(stderr, "kernel_launch: occupancy query says %d blocks/CU\n", per_cu); per_cu = 1; }
        (void)hipGetLastError();
        grid = cus;
    }
    if (grid < 0) return;
    if (hipMemsetAsync((char*)d_ws + WS_CTL, 0, 64 * 1024, stream) != hipSuccess) { fprintf(stderr, "kernel_launch: memset failed\n"); return; }
    Args a{};
    for (int i = 0; i < 24; ++i) a.in[i] = (const float*)d_in[i];
    a.out = (float*)d_out; a.ws = (unsigned char*)d_ws;
#if MK_PER_PHASE
    for (int li = 0; li < N_PHASES; ++li) {
        a.ph_lo = li; a.ph_hi = li + 1;
        void* kargs[] = {&a};
        hipError_t e = hipLaunchCooperativeKernel((const void*)hybrid_fwd, dim3(grid), dim3(NTHREADS), kargs, LDS_BYTES, stream);
        if (e != hipSuccess) { fprintf(stderr, "kernel_launch: launch %d failed: %s\n", li, hipGetErrorString(e)); break; }
    }
#else
    a.ph_lo = 0; a.ph_hi = N_PHASES;
    void* kargs[] = {&a};
    hipError_t e = hipLaunchCooperativeKernel((const void*)hybrid_fwd, dim3(grid), dim3(NTHREADS), kargs, LDS_BYTES, stream);
    if (e != hipSuccess) fprintf(stderr, "kernel_launch: cooperative launch failed: %s (grid %d)\n", hipGetErrorString(e), grid);
#endif
}
```

```cpp
#include <hip/hip_runtime.h>
#include <hip/hip_cooperative_groups.h>
#include <hip/hip_bf16.h>
#include <cmath>
#include <cstdio>
#include <cstdint>
namespace cg = cooperative_groups;

constexpr int BATCH = 2, SEQ = 8192, DM = 1024, DEPTH = 4, M_TOK = BATCH * SEQ;
constexpr int HD = 64, MEM_LEN = 256, D_MEM = 256, D_MAIN = 768, NQH = 12, NKVH = 4;
constexpr int D_IN_HY = 2560, D_IN_AT = 1536;
constexpr int NEXP = 16, CAP = 1024, EFF = 768, NGRP = BATCH * NEXP, XROWS = NGRP * CAP;
constexpr int HY_EMB = 33, HY_FILT = 64, FCOLS = 4 * D_MAIN;
constexpr float NORM_EPS = 1e-6f;
constexpr float W8_SCALE = 32.0f;
constexpr float ATT_C2 = 0.125f * 1.4426950408889634f;

constexpr size_t MiB = 1u << 20;
constexpr size_t WS_CTL = 0;
constexpr size_t WS_WHY = 2 * MiB;
constexpr size_t WS_WAT = 12 * MiB;
constexpr size_t WS_WOUT = 18 * MiB;
constexpr size_t WS_WMKV = 26 * MiB;
constexpr size_t WS_W1 = 32 * MiB;
constexpr size_t WS_W2 = 224 * MiB;
constexpr size_t WS_U = 320 * MiB;
constexpr size_t WS_PROJ = 352 * MiB;
constexpr size_t WS_CQ = WS_PROJ + 72 * MiB;
constexpr size_t WS_MIX = 432 * MiB;
constexpr size_t WS_MIXT = 464 * MiB;
constexpr size_t WS_AFF = 488 * MiB;
constexpr size_t WS_IDX = 489 * MiB;
constexpr size_t WS_GATE = WS_IDX + 128 * 1024;
constexpr size_t WS_POS = 490 * MiB;
constexpr size_t WS_XG = 492 * MiB;
constexpr size_t WS_HID = 556 * MiB;
constexpr size_t WS_TAPS = WS_XG;
constexpr size_t WS_Y = 604 * MiB;
constexpr size_t WS_FFTX = WS_Y;
constexpr size_t WS_H2 = 668 * MiB;
constexpr size_t WS_MEMN = 672 * MiB;
constexpr size_t WS_MKV = 673 * MiB;
constexpr size_t WS_PART = 676 * MiB;
constexpr size_t WS_PSS = 692 * MiB;
constexpr size_t WS_RSTD = 697 * MiB;
constexpr size_t WS_RS = WS_RSTD + 128 * 1024;
constexpr size_t WS_WRG = 698 * MiB;
constexpr size_t WS_ZS = 700 * MiB;
constexpr size_t WS_HB = 732 * MiB;
constexpr size_t WS_END = 764 * MiB;

constexpr int LDS_RING = 0;
constexpr int LDS_MISC = 132 * 1024;
constexpr int LDS_BYTES = 140 * 1024;
constexpr int NTHREADS = 512, NWAVES = 8;

#define GAS __attribute__((address_space(1)))
#define LAS __attribute__((address_space(3)))
typedef unsigned short bf16;
typedef unsigned v4u __attribute__((ext_vector_type(4)));
typedef unsigned v2u __attribute__((ext_vector_type(2)));
typedef float f32x4 __attribute__((ext_vector_type(4)));
typedef float f32x2 __attribute__((ext_vector_type(2)));
__device__ __forceinline__ unsigned f2bf(float f) { unsigned u = __builtin_bit_cast(unsigned, f); return (u + 0x7fffu + ((u >> 16) & 1u)) >> 16; }
__device__ __forceinline__ unsigned pk2(float lo, float hi) { return f2bf(lo) | (f2bf(hi) << 16); }
__device__ __forceinline__ float bf2f(unsigned short h) { return __builtin_bit_cast(float, (unsigned)h << 16); }
__device__ __forceinline__ float bflo(unsigned w) { return __builtin_bit_cast(float, w << 16); }
__device__ __forceinline__ float bfhi(unsigned w) { return __builtin_bit_cast(float, w & 0xffff0000u); }
__device__ __forceinline__ float wave_sum(float v) {
#pragma unroll
    for (int o = 1; o < 64; o <<= 1) v += __shfl_xor(v, o);
    return v;
}
__device__ __forceinline__ int opaque_tid(int wave_s) { int l; asm volatile("v_mbcnt_lo_u32_b32 %0, -1, 0\n\tv_mbcnt_hi_u32_b32 %0, -1, %0" : "=v"(l)); return (wave_s << 6) | l; }
#define MK_PER_PHASE 0

#define XB_TMO      128
#define XB_XCNT(j)  (256  + 64 * (j))
#define XB_XSUB(j)  (1280 + 64 * (j))
#define XB_XGEN(j)  (2304 + 64 * (j))
#define XB_TOP      3328
#define XB_TOPGEN   3392
#define XCD_BAR_WORDS 3456
#define XB_SPIN_CAP (1u << 18)

__device__ __forceinline__ unsigned xb_ld(unsigned* p)              { return __hip_atomic_load(p, __ATOMIC_RELAXED, __HIP_MEMORY_SCOPE_AGENT); }
__device__ __forceinline__ unsigned xb_add(unsigned* p, unsigned v) { return __hip_atomic_fetch_add(p, v, __ATOMIC_RELAXED, __HIP_MEMORY_SCOPE_AGENT); }
__device__ __forceinline__ unsigned xb_xcc_id() { return (unsigned)__builtin_amdgcn_s_getreg((3 << 11) | 20) & 0xFu; }
#define XB_SPIN(cond, bar) do { unsigned _sp = 0; while (cond) { __builtin_amdgcn_s_sleep(1); \
    if ((++_sp & 255u) == 0u) { if (xb_ld(&(bar)[XB_TMO])) break; if (_sp > XB_SPIN_CAP) { atomicAdd(&(bar)[XB_TMO], 1u); break; } } } } while (0)

struct XcdBarrier {
    unsigned* bar; unsigned x;
    volatile LAS unsigned* st;
};

__device__ __forceinline__ XcdBarrier xcd_barrier_post(unsigned* bar, volatile LAS unsigned* st) {
    XcdBarrier b; b.bar = bar; b.x = xb_xcc_id(); b.st = st;
    if (threadIdx.x == 0) (void)xb_add(&bar[XB_XCNT(b.x)], 1u);
    return b;
}
__device__ __forceinline__ void xcd_barrier_complete(unsigned* bar, unsigned x, unsigned& nloc, unsigned& nx) {
    const unsigned G = gridDim.x * gridDim.y * gridDim.z;
    unsigned sum, cnt, mine, sp = 0u;
    for (;;) {
        sum = 0u; cnt = 0u; mine = 0u; unsigned cj[16];
#pragma unroll
        for (unsigned j = 0; j < 16; ++j) cj[j] = xb_ld(&bar[XB_XCNT(j)]);
#pragma unroll
        for (unsigned j = 0; j < 16; ++j) { const unsigned c = cj[j]; sum += c; cnt += (c > 0u) ? 1u : 0u; mine = (j == x) ? c : mine; }
        if (sum == G) break;
        __builtin_amdgcn_s_sleep(1);
        if ((++sp & 255u) == 0u) { if (xb_ld(&bar[XB_TMO])) break; if (sp > XB_SPIN_CAP) { atomicAdd(&bar[XB_TMO], 1u); break; } }
    }
    nloc = mine > 0u ? mine : 1u; nx = cnt > 0u ? cnt : 1u;
}

__device__ __forceinline__ void xcd_barrier(const XcdBarrier& b) {
    asm volatile("s_waitcnt vmcnt(0)" ::: "memory");
    __syncthreads();
    if (threadIdx.x == 0) {
        unsigned* bar = b.bar;
        __builtin_amdgcn_s_waitcnt(0);
        unsigned nloc = b.st[0], nx = b.st[1];
        if (nloc == 0u) { xcd_barrier_complete(bar, b.x, nloc, nx); b.st[0] = nloc; b.st[1] = nx; }
        const unsigned old = xb_add(&bar[XB_XSUB(b.x)], 1u);
        const unsigned gen = old / nloc;
        if (old + 1u == (gen + 1u) * nloc) {
            __builtin_amdgcn_fence(__ATOMIC_RELEASE, "agent");
            asm volatile("s_waitcnt vmcnt(0)" ::: "memory");
            const unsigned og = xb_add(&bar[XB_TOP], 1u);
            const unsigned tg = og / nx;
            if (og + 1u == (tg + 1u) * nx) xb_add(&bar[XB_TOPGEN], 1u);
            else XB_SPIN(xb_ld(&bar[XB_TOPGEN]) == tg, bar);
            __builtin_amdgcn_fence(__ATOMIC_ACQUIRE, "agent");
            xb_add(&bar[XB_XGEN(b.x)], 1u);
            asm volatile("s_waitcnt vmcnt(0)" ::: "memory");
        } else {
            XB_SPIN(xb_ld(&bar[XB_XGEN(b.x)]) == gen, bar);
            __builtin_amdgcn_fence(__ATOMIC_ACQUIRE, "agent");
            asm volatile("s_waitcnt vmcnt(0)" ::: "memory");
        }
    }
    __syncthreads();
}
namespace pg8 {
#define PG8_LAS __attribute__((address_space(3)))
typedef unsigned short bf16_t;
typedef short bf16x8 __attribute__((ext_vector_type(8)));
typedef float f32x4 __attribute__((ext_vector_type(4)));
typedef unsigned u32x4 __attribute__((ext_vector_type(4)));
constexpr int BM = 256, BK = 64, HALF = 128, HTB = HALF * BK * 2  , STAGE_BYTES = 8 * HTB, NXCD = 8, WGM = 8;

__host__ __device__ __forceinline__ int lds_byte(int r, int c) { const int st = (r >> 4) * 2 + (c >> 5), rr = r & 15, cc = c & 31, ob = rr * 64 + cc * 2; return st * 1024 + (ob ^ (((ob >> 9) & 1) << 5)); }
__host__ __device__ __forceinline__ void stage_rc(int b, int& R, int& C) { const int st = b / 1024, sb = b % 1024, swz = sb ^ (((sb >> 9) & 1) << 5); R = (st >> 1) * 16 + swz / 64; C = (st & 1) * 32 + (swz % 64) / 2; }
__host__ __device__ __forceinline__ int perm32(int rho) { const int n = rho >> 4, i = rho & 15; return 8 * (i >> 2) + 4 * n + (i & 3); }

struct Unit { int pm, pn; };
struct Gemm { const bf16_t* A; const bf16_t* Bt; int M, N, K; int gdiv, gmod; size_t gstride; };

struct StaticOrder {
    int nM, nN, nwg, G, c;
    __host__ __device__ void init(int M, int N, int G_, int c_) { nM = M / BM; nN = N / BM; nwg = nM * nN; G = G_; c = c_; }
    __host__ __device__ bool next(int i, Unit& u) const {
        const long L = (long)i * G + c; if (L >= nwg) return false;
        int wgid = (int)L; { const int q = nwg / NXCD, r = nwg % NXCD, xcd = wgid % NXCD, off = wgid / NXCD; wgid = (xcd < r ? xcd * (q + 1) : r * (q + 1) + (xcd - r) * q) + off; }
        const int nig = WGM * nN, gid = wgid / nig, fm = gid * WGM, gsz = (nM - fm) < WGM ? (nM - fm) : WGM;
        u.pm = fm + ((wgid % nig) % gsz); u.pn = (wgid % nig) / gsz; return true;
    }
    __device__ __forceinline__ void a_ready(const Unit&) const {}
    __device__ __forceinline__ void done(const Unit&) const {}
};


#define PG8_GAS __attribute__((address_space(1)))
__device__ __forceinline__ unsigned cvt_pk_bf16(float lo, float hi) { unsigned r; asm volatile("v_cvt_pk_bf16_f32 %0, %1, %2" : "=v"(r) : "v"(lo), "v"(hi)); return r; }
typedef unsigned u32x2 __attribute__((ext_vector_type(2)));
struct EpiRowBf16 {
    static constexpr bool PERM = false, AFTER_DRAIN = false;
    bf16_t* O; int ldc; int sc_pn; float sc;
    __device__ __forceinline__ void operator()(const f32x4 (&acc)[2][2][4][2], const Unit& u, int wr, int wc, int fr, int fq) const {
        const float s = (u.pn == sc_pn) ? sc : 1.f;
        const int row0 = u.pm * BM + wr * 64 + fr, col0 = u.pn * BM + wc * 32 + 4 * fq;
#pragma unroll
        for (int ai = 0; ai < 2; ++ai)
#pragma unroll
            for (int m = 0; m < 4; ++m) { bf16_t* rowp = O + (size_t)(row0 + ai * HALF + m * 16) * ldc + col0;
#pragma unroll
                for (int bj = 0; bj < 2; ++bj)
#pragma unroll
                    for (int n = 0; n < 2; ++n) { const f32x4 v = acc[ai][bj][m][n] * s; u32x2 w; w.x = cvt_pk_bf16(v[0], v[1]); w.y = cvt_pk_bf16(v[2], v[3]);
                        *(PG8_GAS u32x2*)(rowp + bj * HALF + n * 16) = w; } }
    }
};
struct EpiHyIn {
    static constexpr bool PERM = false, AFTER_DRAIN = false;
    bf16_t* OT; int ldt; int tp_tiles; bf16_t* CQ; float sc;
    __device__ __forceinline__ void operator()(const f32x4 (&acc)[2][2][4][2], const Unit& u, int wr, int wc, int fr, int fq) const {
        const int row0 = u.pm * BM + wr * 64 + fr;
        if (u.pn < tp_tiles) {
            const int col0 = u.pn * BM + wc * 32 + 4 * fq;
#pragma unroll
            for (int ai = 0; ai < 2; ++ai)
#pragma unroll
                for (int m = 0; m < 4; ++m) { const int row = row0 + ai * HALF + m * 16;
#pragma unroll
                    for (int bj = 0; bj < 2; ++bj)
#pragma unroll
                        for (int n = 0; n < 2; ++n) { const f32x4 v = acc[ai][bj][m][n]; const unsigned w0 = cvt_pk_bf16(v[0], v[1]), w1 = cvt_pk_bf16(v[2], v[3]);
                            PG8_GAS bf16_t* p = (PG8_GAS bf16_t*)(OT + (size_t)(col0 + bj * HALF + n * 16) * ldt + row);
                            p[0] = (bf16_t)(w0 & 0xffffu); p[(size_t)ldt] = (bf16_t)(w0 >> 16); p[(size_t)2 * ldt] = (bf16_t)(w1 & 0xffffu); p[(size_t)3 * ldt] = (bf16_t)(w1 >> 16); } }
        } else {
            const int col0 = wc * 32 + 4 * fq;
#pragma unroll
            for (int ai = 0; ai < 2; ++ai)
#pragma unroll
                for (int m = 0; m < 4; ++m) { bf16_t* rowp = CQ + (size_t)(row0 + ai * HALF + m * 16) * 256 + col0;
#pragma unroll
                    for (int bj = 0; bj < 2; ++bj)
#pragma unroll
                        for (int n = 0; n < 2; ++n) { const f32x4 v = acc[ai][bj][m][n] * sc; u32x2 w; w.x = cvt_pk_bf16(v[0], v[1]); w.y = cvt_pk_bf16(v[2], v[3]);
                            *(PG8_GAS u32x2*)(rowp + bj * HALF + n * 16) = w; } }
        }
    }
};
struct EpiAtIn {
    static constexpr bool PERM = false, AFTER_DRAIN = false;
    bf16_t* Oq; bf16_t* Ok; bf16_t* Ov; bf16_t* Oc; const float* gq; const float* gk; float csc; float eps; int seq_mask;
    __device__ __forceinline__ void operator()(const f32x4 (&acc)[2][2][4][2], const Unit& u, int wr, int wc, int fr, int fq) const {
        const int row0 = u.pm * BM + wr * 64 + fr, colb = (u.pn < 3 ? u.pn * BM : 0) + wc * 64 + 4 * fq; const int ldc = u.pn < 3 ? 768 : 256;
        bf16_t* O = u.pn < 3 ? Oq : (u.pn == 3 ? Ok : (u.pn == 4 ? Ov : Oc));
        if (u.pn <= 3) {
            const float* gp = (u.pn == 3 ? gk : gq) + 4 * fq; const float osc = (u.pn == 3) ? 1.f : csc;
            float invr[4];
#pragma unroll
            for (int q = 0; q < 4; ++q) invr[q] = exp2f(-(float)(4 * fq + q) * (13.287712379549449f / 16.0f)) * 0.15915494309189535f;
            f32x4 gg[2][2];
#pragma unroll
            for (int bj = 0; bj < 2; ++bj) { gg[bj][0] = *(const PG8_GAS f32x4*)(gp + 32 * bj); gg[bj][1] = *(const PG8_GAS f32x4*)(gp + 32 * bj + 16); }
#pragma unroll
            for (int ai = 0; ai < 2; ++ai)
#pragma unroll
                for (int m = 0; m < 4; ++m) {
                    const int row = row0 + ai * HALF + m * 16; int t = row & seq_mask; asm volatile("" : "+v"(t));
                    float ss = 0.f;
#pragma unroll
                    for (int bj = 0; bj < 2; ++bj)
#pragma unroll
                        for (int n = 0; n < 2; ++n) { const f32x4 x = acc[ai][bj][m][n]; ss += (x[0] * x[0] + x[1] * x[1]) + (x[2] * x[2] + x[3] * x[3]); }
                    ss += __shfl_xor(ss, 16); ss += __shfl_xor(ss, 32);
                    const float rs = osc * __builtin_amdgcn_rsqf(ss * (1.0f / 64.0f) + eps);
                    bf16_t* rowp = O + (size_t)row * ldc + colb;
#pragma unroll
                    for (int bj = 0; bj < 2; ++bj) {
                        const float pos = (float)(bj == 0 ? (t >> 6) : (t & 63));
                        const f32x4 xa = acc[ai][bj][m][0] * rs * gg[bj][0], xb = acc[ai][bj][m][1] * rs * gg[bj][1];
                        f32x4 oa, ob;
#pragma unroll
                        for (int q = 0; q < 4; ++q) { const float rev = pos * invr[q]; const float c = __builtin_amdgcn_cosf(rev), s = __builtin_amdgcn_sinf(rev);
                            oa[q] = xa[q] * c - xb[q] * s; ob[q] = xa[q] * s + xb[q] * c; }
                        u32x2 w; w.x = cvt_pk_bf16(oa[0], oa[1]); w.y = cvt_pk_bf16(oa[2], oa[3]); *(PG8_GAS u32x2*)(rowp + 32 * bj) = w;
                        w.x = cvt_pk_bf16(ob[0], ob[1]); w.y = cvt_pk_bf16(ob[2], ob[3]); *(PG8_GAS u32x2*)(rowp + 32 * bj + 16) = w;
                    }
                    asm volatile("" ::: "memory");
                }
        } else {
            const float s = (u.pn == 5) ? csc : 1.f;
#pragma unroll
            for (int ai = 0; ai < 2; ++ai)
#pragma unroll
                for (int m = 0; m < 4; ++m) { bf16_t* rowp = O + (size_t)(row0 + ai * HALF + m * 16) * ldc + colb;
#pragma unroll
                    for (int bj = 0; bj < 2; ++bj)
#pragma unroll
                        for (int n = 0; n < 2; ++n) { const f32x4 v = acc[ai][bj][m][n] * s; u32x2 w; w.x = cvt_pk_bf16(v[0], v[1]); w.y = cvt_pk_bf16(v[2], v[3]);
                            *(PG8_GAS u32x2*)(rowp + 32 * bj + 16 * n) = w; } }
        }
    }
};
struct EpiResF32 {
    static constexpr bool PERM = false, AFTER_DRAIN = false;
    const float* res; float* out; int ldc;
    __device__ __forceinline__ void operator()(const f32x4 (&acc)[2][2][4][2], const Unit& u, int wr, int wc, int fr, int fq) const {
        const int row0 = u.pm * BM + wr * 64 + fr, col0 = u.pn * BM + wc * 32 + 4 * fq;
#pragma unroll
        for (int ai = 0; ai < 2; ++ai)
#pragma unroll
            for (int m = 0; m < 4; ++m) { const size_t off = (size_t)(row0 + ai * HALF + m * 16) * ldc + col0;
#pragma unroll
                for (int bj = 0; bj < 2; ++bj)
#pragma unroll
                    for (int n = 0; n < 2; ++n) { const f32x4 r = *(const PG8_GAS f32x4*)(res + off + bj * HALF + n * 16); *(PG8_GAS f32x4*)(out + off + bj * HALF + n * 16) = r + acc[ai][bj][m][n]; } }
    }
};
__device__ __forceinline__ unsigned pk4_fp8_sat(const f32x4 x) {
    unsigned w = 0;
    w = __builtin_amdgcn_cvt_pk_fp8_f32(__builtin_amdgcn_fmed3f(x[0], -448.f, 448.f), __builtin_amdgcn_fmed3f(x[1], -448.f, 448.f), w, false);
    w = __builtin_amdgcn_cvt_pk_fp8_f32(__builtin_amdgcn_fmed3f(x[2], -448.f, 448.f), __builtin_amdgcn_fmed3f(x[3], -448.f, 448.f), w, true);
    return w;
}
struct EpiOutX {
    static constexpr bool PERM = true, AFTER_DRAIN = false;
    const bf16* res; bf16* out; int ldc; const float* gain; const float* WrG; unsigned char* XN8; float* PLG; float* PSS; int M;
    static __device__ __forceinline__ void split8(const f32x4 a, const f32x4 b, bf16x8& hi, bf16x8& lo) {
        u32x4 h, l; float r[8] = {a[0], a[1], a[2], a[3], b[0], b[1], b[2], b[3]};
#pragma unroll
        for (int k = 0; k < 4; ++k) { const unsigned p = cvt_pk_bf16(r[2 * k], r[2 * k + 1]); h[k] = p;
            const float d0 = r[2 * k] - __builtin_bit_cast(float, p << 16), d1 = r[2 * k + 1] - __builtin_bit_cast(float, p & 0xffff0000u); l[k] = cvt_pk_bf16(d0, d1); }
        hi = __builtin_bit_cast(bf16x8, h); lo = __builtin_bit_cast(bf16x8, l);
    }
    __device__ __forceinline__ void operator()(f32x4 (&acc)[2][2][4][2], const Unit& u, int wr, int wc, int fr, int fq) const {
        const int row0 = u.pm * BM + wr * 64 + fr, col0 = u.pn * BM + wc * 32 + 8 * fq, slot = u.pn * 4 + wc;
        bf16x8 whi[2], wlo[2]; f32x4 wt[2][2], gt[2][2];
#pragma unroll
        for (int bj = 0; bj < 2; ++bj) { const float* wp = WrG + (size_t)fr * ldc + col0 + bj * HALF; wt[bj][0] = *(const PG8_GAS f32x4*)wp; wt[bj][1] = *(const PG8_GAS f32x4*)(wp + 4); }
        unsigned gpk[2][2][2];
#pragma unroll
        for (int bj = 0; bj < 2; ++bj)
#pragma unroll
            for (int n = 0; n < 2; ++n) gt[bj][n] = *(const PG8_GAS f32x4*)(gain + col0 + bj * HALF + n * 4);
        u32x4 rc[2];
#pragma unroll
        for (int bj = 0; bj < 2; ++bj) rc[bj] = *(const PG8_GAS u32x4*)(res + (size_t)row0 * ldc + col0 + bj * HALF);
#pragma unroll
        for (int bj = 0; bj < 2; ++bj) split8(wt[bj][0], wt[bj][1], whi[bj], wlo[bj]);
#pragma unroll
        for (int bj = 0; bj < 2; ++bj)
#pragma unroll
            for (int n = 0; n < 2; ++n) { const f32x4 g4 = gt[bj][n]; gpk[bj][n][0] = cvt_pk_bf16(g4[0], g4[1]); gpk[bj][n][1] = cvt_pk_bf16(g4[2], g4[3]); }
#pragma unroll
        for (int idx = 0; idx < 8; ++idx) { const int ai = idx >> 2, m = idx & 3;
            const int row = row0 + ai * HALF + m * 16; const size_t off = (size_t)row * ldc + col0; float ss = 0.f; f32x4 lg = (f32x4){0.f, 0.f, 0.f, 0.f}; u32x4 xw;
            u32x4 rnx[2] = {rc[0], rc[1]};
            if (idx < 7) { const int rown = row0 + ((idx + 1) >> 2) * HALF + ((idx + 1) & 3) * 16;
#pragma unroll
                for (int bj = 0; bj < 2; ++bj) rnx[bj] = *(const PG8_GAS u32x4*)(res + (size_t)rown * ldc + col0 + bj * HALF); }
#pragma unroll
            for (int bj = 0; bj < 2; ++bj) {
                const u32x4 rr = rc[bj]; u32x4 ho;
#pragma unroll
                for (int n = 0; n < 2; ++n) { const int co = bj * HALF + n * 4;
                    const f32x4 r4 = (f32x4){__builtin_bit_cast(float, rr[2 * n] << 16), __builtin_bit_cast(float, rr[2 * n] & 0xffff0000u), __builtin_bit_cast(float, rr[2 * n + 1] << 16), __builtin_bit_cast(float, rr[2 * n + 1] & 0xffff0000u)};
                    const f32x4 h = r4 + acc[ai][bj][m][n]; acc[ai][bj][m][n] = h; ho[2 * n] = cvt_pk_bf16(h[0], h[1]); ho[2 * n + 1] = cvt_pk_bf16(h[2], h[3]);
                    ss += (h[0] * h[0] + h[1] * h[1]) + (h[2] * h[2] + h[3] * h[3]);
                    const unsigned g0_ = gpk[bj][n][0], g1_ = gpk[bj][n][1];
                    const f32x4 x = h * (f32x4){__builtin_bit_cast(float, g0_ << 16), __builtin_bit_cast(float, g0_ & 0xffff0000u), __builtin_bit_cast(float, g1_ << 16), __builtin_bit_cast(float, g1_ & 0xffff0000u)};
                    xw[bj * 2 + n] = pk4_fp8_sat(x); }
                *(PG8_GAS u32x4*)(out + off + bj * HALF) = ho;
                bf16x8 hhi, hlo; split8(acc[ai][bj][m][0], acc[ai][bj][m][1], hhi, hlo);
                lg = __builtin_amdgcn_mfma_f32_16x16x32_bf16(wlo[bj], hhi, lg, 0, 0, 0);
                lg = __builtin_amdgcn_mfma_f32_16x16x32_bf16(whi[bj], hlo, lg, 0, 0, 0);
                lg = __builtin_amdgcn_mfma_f32_16x16x32_bf16(whi[bj], hhi, lg, 0, 0, 0); }
            *(PG8_GAS u32x4*)(XN8 + (size_t)row * ldc + u.pn * BM + wc * 64 + fq * 16) = xw;
            ss += __shfl_xor(ss, 16); ss += __shfl_xor(ss, 32);
            if (fq == 0) ((PG8_GAS float*)PSS)[(size_t)slot * M + row] = ss;
            *(PG8_GAS f32x4*)(PLG + ((size_t)slot * M + row) * 16 + 4 * fq) = lg;
            asm volatile("" ::: "memory"); rc[0] = rnx[0]; rc[1] = rnx[1]; }
    }
};
struct EpiSwiGLU {
    static constexpr bool PERM = false, AFTER_DRAIN = false;
    bf16_t* O; int ldc;
    __device__ __forceinline__ void operator()(const f32x4 (&acc)[2][2][4][2], const Unit& u, int wr, int wc, int fr, int fq) const {
        const int row0 = u.pm * BM + wr * 64 + fr, col0 = u.pn * HALF + wc * 32 + 4 * fq;
#pragma unroll
        for (int ai = 0; ai < 2; ++ai)
#pragma unroll
            for (int m = 0; m < 4; ++m) { bf16_t* rowp = O + (size_t)(row0 + ai * HALF + m * 16) * ldc + col0;
#pragma unroll
                for (int n = 0; n < 2; ++n) { const f32x4 g = acc[ai][0][m][n], up = acc[ai][1][m][n]; f32x4 h;
#pragma unroll
                    for (int q = 0; q < 4; ++q) h[q] = g[q] * up[q] * __builtin_amdgcn_rcpf(1.f + __expf(-g[q]));
                    u32x2 w; w.x = cvt_pk_bf16(h[0], h[1]); w.y = cvt_pk_bf16(h[2], h[3]); *(PG8_GAS u32x2*)(rowp + n * 16) = w; } }
    }
};
struct EpiSwiGLU8 {
    static constexpr bool PERM = false, AFTER_DRAIN = false;
    unsigned char* O; int ldc; float wsc; const float* rs;
    __device__ __forceinline__ void operator()(const f32x4 (&acc)[2][2][4][2], const Unit& u, int wr, int wc, int fr, int fq) const {
        const int row0 = u.pm * BM + wr * 64 + fr, col0 = u.pn * HALF + wc * 32 + 4 * fq;
        float rsv[8];
#pragma unroll
        for (int k = 0; k < 8; ++k) rsv[k] = ((const PG8_GAS float*)rs)[row0 + (k >> 2) * HALF + (k & 3) * 16];
#pragma unroll
        for (int ai = 0; ai < 2; ++ai)
#pragma unroll
            for (int m = 0; m < 4; ++m) { const int row = row0 + ai * HALF + m * 16; const float sc = wsc * rsv[ai * 4 + m]; u32x2 hw;
#pragma unroll
                for (int n = 0; n < 2; ++n) { const f32x4 g = acc[ai][0][m][n] * sc, up = acc[ai][1][m][n] * sc; f32x4 h;
#pragma unroll
                    for (int q = 0; q < 4; ++q) h[q] = g[q] * up[q] * __builtin_amdgcn_rcpf(1.f + __expf(-g[q]));
                    hw[n] = pk4_fp8_sat(h); }
                *(PG8_GAS u32x2*)(O + (size_t)row * ldc + u.pn * HALF + wc * 32 + fq * 8) = hw; }
    }
};
struct EpiDown {
    static constexpr bool PERM = true, AFTER_DRAIN = false;
    bf16_t* O; int ldc; const float* gate; float wsc;
    __device__ __forceinline__ void operator()(const f32x4 (&acc)[2][2][4][2], const Unit& u, int wr, int wc, int fr, int fq) const {
        const int row0 = u.pm * BM + wr * 64 + fr, col0 = u.pn * BM + wc * 32 + 8 * fq;
        float gv[8];
#pragma unroll
        for (int k = 0; k < 8; ++k) gv[k] = ((const PG8_GAS float*)gate)[row0 + (k >> 2) * HALF + (k & 3) * 16];
#pragma unroll
        for (int ai = 0; ai < 2; ++ai)
#pragma unroll
            for (int m = 0; m < 4; ++m) { const int row = row0 + ai * HALF + m * 16; const float gs = gv[ai * 4 + m] * wsc; bf16_t* rowp = O + (size_t)row * ldc + col0;
#pragma unroll
                for (int bj = 0; bj < 2; ++bj) { const f32x4 v0 = acc[ai][bj][m][0] * gs, v1 = acc[ai][bj][m][1] * gs; u32x4 w;
                    w.x = cvt_pk_bf16(v0[0], v0[1]); w.y = cvt_pk_bf16(v0[2], v0[3]); w.z = cvt_pk_bf16(v1[0], v1[1]); w.w = cvt_pk_bf16(v1[2], v1[3]);
                    *(PG8_GAS u32x4*)(rowp + bj * HALF) = w; } }
    }
};
template <class Epi, class Sched, bool ALIGN_EPI = false, bool SP2 = false, bool GATHER = false, bool FP8 = false>
__device__ __forceinline__ void gemm_phase(PG8_LAS unsigned char* lds, const Gemm g, const Sched& S, const Epi& E, int wave_s, const int* gidx = nullptr) {
    const int tid = opaque_tid(wave_s), wid = __builtin_amdgcn_readfirstlane(tid >> 6), lane = tid & 63, wr = wid >> 2, wc = wid & 3, fr = lane & 15, fq = lane >> 4;
    const int K = g.K, nt = K / BK;
    unsigned voffA[2], voffB[2];
#pragma unroll
    for (int i = 0; i < 2; ++i) { int R, C; stage_rc(tid * 16 + i * 8192, R, C); const int Rb = Epi::PERM ? ((R & ~31) + perm32(R & 31)) : R;
        voffA[i] = (unsigned)(R * K + C) * 2u; voffB[i] = (unsigned)(Rb * K + C) * 2u; }
    const size_t kstep = (size_t)(BK * 2);
    const size_t hstep = (size_t)HALF * K * 2;
    const size_t tstep = 2 * hstep;
    const unsigned ldsw = (unsigned)wid * 1024u;
    const int aoff = lds_byte(wr * 64 + fr, fq * 8), boff = lds_byte(wc * 32 + fr, fq * 8);
#define PG8_SA(b, h) (((b) * 2 + (h)) * HTB)
#define PG8_SB(b, h) ((4 + (b) * 2 + (h)) * HTB)
#define PG8_STAGE(bufoff, gbase, voff) do { _Pragma("unroll") for (int _i = 0; _i < 2; ++_i) \
        __builtin_amdgcn_global_load_lds((const unsigned*)((const char*)(gbase) + (voff)[_i]), (PG8_LAS unsigned*)(lds + (bufoff) + ldsw + _i * 8192), 16, 0, 0); } while (0)
#define PG8_LDA(dst, b, h) do { _Pragma("unroll") for (int m = 0; m < 4; ++m) { if constexpr (FP8) { const v4i_ lo_ = *(const PG8_LAS v4i_*)(lds + PG8_SA(b, h) + aoff + m * 2048), hi_ = *(const PG8_LAS v4i_*)(lds + PG8_SA(b, h) + aoff + m * 2048 + 1024); \
        dst##8[m] = __builtin_shufflevector(lo_, hi_, 0, 1, 2, 3, 4, 5, 6, 7); } else { _Pragma("unroll") for (int k = 0; k < 2; ++k) dst[m][k] = *(const PG8_LAS bf16x8*)(lds + PG8_SA(b, h) + aoff + m * 2048 + k * 1024); } } } while (0)
#define PG8_LDB(dst, b, h) do { _Pragma("unroll") for (int n = 0; n < 2; ++n) { if constexpr (FP8) { const v4i_ lo_ = *(const PG8_LAS v4i_*)(lds + PG8_SB(b, h) + boff + n * 2048), hi_ = *(const PG8_LAS v4i_*)(lds + PG8_SB(b, h) + boff + n * 2048 + 1024); \
        dst##8[n] = __builtin_shufflevector(lo_, hi_, 0, 1, 2, 3, 4, 5, 6, 7); } else { _Pragma("unroll") for (int k = 0; k < 2; ++k) dst[n][k] = *(const PG8_LAS bf16x8*)(lds + PG8_SB(b, h) + boff + n * 2048 + k * 1024); } } } while (0)
#define PG8_MMA(ai, bj, At, Bt) do { __builtin_amdgcn_s_setprio(1); _Pragma("unroll") for (int m = 0; m < 4; ++m) _Pragma("unroll") for (int n = 0; n < 2; ++n) { \
        if constexpr (FP8) asm volatile("v_mfma_f32_16x16x128_f8f6f4 %0, %1, %2, %0" : "+v"(acc[ai][bj][m][n]) : "v"(Bt##8[n]), "v"(At##8[m]));   \
        else { _Pragma("unroll") for (int k = 0; k < 2; ++k) acc[ai][bj][m][n] = __builtin_amdgcn_mfma_f32_16x16x32_bf16(Bt[n][k], At[m][k], acc[ai][bj][m][n], 0, 0, 0); } } \
        __builtin_amdgcn_s_setprio(0); } while (0)
#define PG8_WAIT_V(n) asm volatile("s_waitcnt vmcnt(" #n ")" ::: "memory")
#define PG8_WAIT_L(n) asm volatile("s_waitcnt lgkmcnt(" #n ")" ::: "memory")
#define PG8_BAR __builtin_amdgcn_s_barrier()
#define PG8_SCHED __builtin_amdgcn_sched_barrier(0)
    Unit cur, nxt; int ui = 0;
    if (!S.next(0, cur)) return;
    f32x4 acc[2][2][4][2];
#pragma unroll
    for (int a = 0; a < 2; ++a)
#pragma unroll
        for (int b = 0; b < 2; ++b)
#pragma unroll
            for (int m = 0; m < 4; ++m)
#pragma unroll
                for (int n = 0; n < 2; ++n) acc[a][b][m][n] = (f32x4){0.f, 0.f, 0.f, 0.f};
    typedef int v8i_ __attribute__((ext_vector_type(8))); typedef int v4i_ __attribute__((ext_vector_type(4)));
    const int sc127_ = 127;
    bf16x8 At[4][2], B0[2][2], B1[2][2]; v8i_ At8[4], B08[2], B18[2];
    static_assert(SP2, "this copy of the body keeps only the SP2 K-loop up to date");
    int rA[2]; { int R_, C_; stage_rc(tid * 16, R_, C_); rA[0] = R_; stage_rc(tid * 16 + 8192, R_, C_); rA[1] = R_; }
    unsigned cvp[2], nvp[2], c2_[2]; c2_[0] = voffA[0] - (unsigned)(rA[0] * K) * 2u; c2_[1] = voffA[1] - (unsigned)(rA[1] * K) * 2u;
#define PG8_ROWOFF(dst, unit) do { _Pragma("unroll") for (int i_ = 0; i_ < 2; ++i_) dst[i_] = (unsigned)gidx[(unit).pm * BM + rA[i_]] | ((unsigned)gidx[(unit).pm * BM + HALF + rA[i_]] << 16); } while (0)
#define PG8_STAGE_A(bufoff, gbase, P, H) do { if constexpr (GATHER) { unsigned to_[2]; _Pragma("unroll") for (int i_ = 0; i_ < 2; ++i_) to_[i_] = ((P[i_] >> (16 * (H))) & 0xffffu) * (unsigned)(K * 2) + c2_[i_]; PG8_STAGE(bufoff, gbase, to_); } \
        else { PG8_STAGE(bufoff, (gbase) + ((H) ? hstep : (size_t)0), voffA); } } while (0)
    if constexpr (GATHER) PG8_ROWOFF(cvp, cur); else { cvp[0] = 0u; cvp[1] = 0u; }
    const char* cA = GATHER ? (const char*)g.A : (const char*)g.A + (size_t)cur.pm * tstep; const char* cB = (const char*)g.Bt + (size_t)((cur.pm / g.gdiv) % g.gmod) * g.gstride + (size_t)cur.pn * tstep;
    S.a_ready(cur);
    if constexpr (SP2) {
        PG8_STAGE(PG8_SB(0, 0), cB, voffB); PG8_STAGE(PG8_SB(0, 1), cB + hstep, voffB); PG8_STAGE_A(PG8_SA(0, 0), cA, cvp, 0); PG8_STAGE_A(PG8_SA(0, 1), cA, cvp, 1);
        if (wr == 1) PG8_BAR;
        PG8_WAIT_V(2); PG8_BAR;
        PG8_STAGE(PG8_SB(1, 0), cB + kstep, voffB); PG8_STAGE_A(PG8_SA(1, 0), cA + kstep, cvp, 0); PG8_STAGE(PG8_SB(1, 1), cB + hstep + kstep, voffB);
        PG8_WAIT_V(6); PG8_BAR;
    } else {
        PG8_STAGE(PG8_SB(0, 0), cB, voffB); PG8_STAGE(PG8_SA(0, 0), cA, voffA); PG8_STAGE(PG8_SB(0, 1), cB + hstep, voffB); PG8_STAGE(PG8_SA(0, 1), cA + hstep, voffA);
        if (wr == 1) PG8_BAR;
        PG8_WAIT_V(4); PG8_BAR;
        PG8_STAGE(PG8_SB(1, 0), cB + kstep, voffB); PG8_STAGE(PG8_SA(1, 0), cA + kstep, voffA); PG8_STAGE(PG8_SB(1, 1), cB + hstep + kstep, voffB);
        PG8_WAIT_V(6); PG8_BAR;
    }
    for (;;) {
        const bool has_next = S.next(ui + 1, nxt);
        if constexpr (GATHER) { if (has_next) PG8_ROWOFF(nvp, nxt); else { nvp[0] = cvp[0]; nvp[1] = cvp[1]; } } else { nvp[0] = 0u; nvp[1] = 0u; }
        const char* nA = GATHER ? (const char*)g.A : (has_next ? (const char*)g.A + (size_t)nxt.pm * tstep : cA); const char* nB = has_next ? (const char*)g.Bt + (size_t)((nxt.pm / g.gdiv) % g.gmod) * g.gstride + (size_t)nxt.pn * tstep : cB;
        for (int t = 0; t < nt; t += 2) {
            const bool last = (t == nt - 2);
            unsigned svp[2]; svp[0] = last ? nvp[0] : cvp[0]; svp[1] = last ? nvp[1] : cvp[1];
            const char* a1 = cA + (size_t)(t + 1) * kstep;
            const char* a2 = last ? nA : cA + (size_t)(t + 2) * kstep; const char* b2 = last ? nB : cB + (size_t)(t + 2) * kstep;
            const char* a3 = a2 + kstep; const char* b3 = b2 + kstep;
            if (last && has_next) S.a_ready(nxt);
            if constexpr (SP2) {
            PG8_LDB(B0, 0, 0); PG8_LDB(B1, 0, 1); PG8_SCHED; PG8_LDA(At, 0, 0); PG8_STAGE_A(PG8_SA(1, 1), a1, cvp, 1);
            PG8_WAIT_V(8); PG8_WAIT_L(0); PG8_BAR; PG8_MMA(0, 0, At, B0); PG8_MMA(0, 1, At, B1); PG8_BAR; PG8_SCHED;
            PG8_LDA(At, 0, 1); PG8_STAGE(PG8_SB(0, 0), b2, voffB); PG8_STAGE(PG8_SB(0, 1), b2 + hstep, voffB); PG8_STAGE_A(PG8_SA(0, 0), a2, svp, 0);
            PG8_WAIT_V(8); PG8_WAIT_L(0); PG8_BAR; PG8_MMA(1, 0, At, B0); PG8_MMA(1, 1, At, B1); PG8_BAR; PG8_SCHED;
            PG8_LDB(B0, 1, 0); PG8_LDB(B1, 1, 1); PG8_SCHED; PG8_LDA(At, 1, 0); PG8_STAGE_A(PG8_SA(0, 1), a2, svp, 1);
            PG8_WAIT_V(8); PG8_WAIT_L(0); PG8_BAR; PG8_MMA(0, 0, At, B0); PG8_MMA(0, 1, At, B1); PG8_BAR; PG8_SCHED;
            PG8_LDA(At, 1, 1); PG8_STAGE(PG8_SB(1, 0), b3, voffB); PG8_STAGE(PG8_SB(1, 1), b3 + hstep, voffB); PG8_STAGE_A(PG8_SA(1, 0), a3, svp, 0);
            PG8_WAIT_V(8); PG8_WAIT_L(0); PG8_BAR; PG8_MMA(1, 0, At, B0); PG8_MMA(1, 1, At, B1); PG8_BAR; PG8_SCHED;
            } else {
            PG8_LDB(B0, 0, 0); PG8_SCHED; PG8_LDA(At, 0, 0); PG8_STAGE(PG8_SA(1, 1), a1 + hstep, voffA);
            PG8_WAIT_L(8); PG8_BAR; PG8_WAIT_L(0); PG8_MMA(0, 0, At, B0); PG8_BAR; PG8_SCHED;
            PG8_LDB(B1, 0, 1); PG8_STAGE(PG8_SB(0, 0), b2, voffB);
            PG8_BAR; PG8_WAIT_L(0); PG8_MMA(0, 1, At, B1); PG8_BAR;
            PG8_LDA(At, 0, 1); PG8_STAGE(PG8_SA(0, 0), a2, voffA);
            PG8_BAR; PG8_WAIT_L(0); PG8_MMA(1, 0, At, B0); PG8_BAR; PG8_SCHED;
            PG8_STAGE(PG8_SB(0, 1), b2 + hstep, voffB);
            PG8_WAIT_V(6); PG8_BAR; PG8_MMA(1, 1, At, B1); PG8_BAR;
            PG8_LDB(B0, 1, 0); PG8_SCHED; PG8_LDA(At, 1, 0); PG8_STAGE(PG8_SA(0, 1), a2 + hstep, voffA);
            PG8_WAIT_L(8); PG8_BAR; PG8_WAIT_L(0); PG8_MMA(0, 0, At, B0); PG8_BAR; PG8_SCHED;
            PG8_LDB(B1, 1, 1); PG8_STAGE(PG8_SB(1, 0), b3, voffB);
            PG8_BAR; PG8_WAIT_L(0); PG8_MMA(0, 1, At, B1); PG8_BAR;
            PG8_LDA(At, 1, 1); PG8_STAGE(PG8_SA(1, 0), a3, voffA);
            PG8_BAR; PG8_WAIT_L(0); PG8_MMA(1, 0, At, B0); PG8_BAR; PG8_SCHED;
            PG8_STAGE(PG8_SB(1, 1), b3 + hstep, voffB);
            PG8_WAIT_V(6); PG8_BAR; PG8_MMA(1, 1, At, B1); PG8_BAR;
            }
        }
        if constexpr (ALIGN_EPI) { if (wr == 0) PG8_BAR; }
        if constexpr (!Epi::AFTER_DRAIN) { const int t_e = opaque_tid(wave_s); const int fr_e = t_e & 15, fq_e = (t_e & 63) >> 4;
            E(acc, cur, wr, wc, fr_e, fq_e); S.done(cur); }
        if (!has_next) break;
#pragma unroll
        for (int a = 0; a < 2; ++a)
#pragma unroll
            for (int b = 0; b < 2; ++b)
#pragma unroll
                for (int m = 0; m < 4; ++m)
#pragma unroll
                    for (int n = 0; n < 2; ++n) acc[a][b][m][n] = (f32x4){0.f, 0.f, 0.f, 0.f};
        cur = nxt; cA = nA; cB = nB; ++ui; if constexpr (GATHER) { cvp[0] = nvp[0]; cvp[1] = nvp[1]; }
        if constexpr (ALIGN_EPI) { if (wr == 1) PG8_BAR; }
    }
    PG8_WAIT_V(0);
    if constexpr (!ALIGN_EPI) { if (wr == 0) PG8_BAR; }
    PG8_BAR;
    if constexpr (Epi::AFTER_DRAIN) { E.fused(acc, cur, wr, wc, fr, fq, lds, wid, lane); S.done(cur); }
#undef PG8_ROWOFF
#undef PG8_STAGE_A
#undef PG8_SA
#undef PG8_SB
#undef PG8_STAGE
#undef PG8_LDA
#undef PG8_LDB
#undef PG8_MMA
#undef PG8_WAIT_V
#undef PG8_WAIT_L
#undef PG8_BAR
#undef PG8_SCHED
}
}
namespace attn_body {
using bf16=__hip_bfloat16;
using bf16x8=__attribute__((ext_vector_type(8)))short;
using s16x4=__attribute__((ext_vector_type(4)))short;
using f32x16=__attribute__((ext_vector_type(16)))float;
using u32x4=__attribute__((ext_vector_type(4)))unsigned;
constexpr int D=64;
constexpr int NW=8,QBLK=32,QB=QBLK*NW,KVBLK=64;
__device__ __forceinline__ int crow(int r,int hi){return (r&3)+8*(r>>2)+4*hi;}
#define SBAR() __builtin_amdgcn_sched_barrier(0)
__device__ __forceinline__ void cmask(f32x16&p0,f32x16&p1,int jb,int qrel,int hi){
  const float NEG=-INFINITY; int kb=64*jb+4*hi;
  #pragma unroll
  for(int r=0;r<16;++r){int kv=kb+(r&3)+8*(r>>2); if(kv>qrel)p0[r]=NEG; if(kv+32>qrel)p1[r]=NEG;}
}

constexpr int NSLOT=3, SLOTB=8192;
constexpr int LDS_K=0, LDS_V=NSLOT*SLOTB, LDS_WS=2*NSLOT*SLOTB, LDS_OST=LDS_WS+NW*64*4, LDS_BYTES=LDS_OST+NW*4096;
constexpr float C2=0.125f*1.4426950408889634f;
__device__ __forceinline__ void glds16(const void*gsrc,unsigned lds_dst){unsigned keep;
  asm volatile("s_mov_b32 %0, m0\n\ts_mov_b32 m0, %2\n\ts_nop 0\n\tglobal_load_lds_dwordx4 %1, off\n\ts_mov_b32 m0, %0":"=&s"(keep):"v"(gsrc),"s"(lds_dst):"memory");}
__device__ __forceinline__ float max3f(float a,float b,float c){float r;asm("v_max3_f32 %0, %1, %2, %3":"=v"(r):"v"(a),"v"(b),"v"(c));return r;}
__device__ __forceinline__ float max2f(float a,float b){float r;asm("v_max_f32_e32 %0, %1, %2":"=v"(r):"v"(a),"v"(b));return r;}
__device__ __forceinline__ float fadd_s(float a,float b){float r;asm("v_add_f32_e32 %0, %1, %2":"=v"(r):"v"(a),"v"(b));return r;}
__device__ __forceinline__ float fsub_s(float a,float b){float r;asm("v_sub_f32_e32 %0, %1, %2":"=v"(r):"v"(a),"v"(b));return r;}
typedef float f32x2_t __attribute__((ext_vector_type(2))); typedef __bf16 bf16x2_t __attribute__((ext_vector_type(2)));
__device__ __forceinline__ unsigned cvtpk_s(float lo,float hi){f32x2_t v={lo,hi};bf16x2_t b=__builtin_convertvector(v,bf16x2_t);return __builtin_bit_cast(unsigned,b);}
#define WAIT_BAR(N) asm volatile("s_waitcnt vmcnt(" #N ") lgkmcnt(0)\n\ts_barrier":::"memory")

__device__ __forceinline__ void qkt(f32x16&p0,f32x16&p1,const char*Kslot,const bf16x8*qr,const f32x16&negm,int r32,int hi){
  const char*kb=Kslot+hi*1024+r32*16;
  #pragma unroll
  for(int d0=0;d0<4;++d0){
    const bf16x8 b0=*reinterpret_cast<const bf16x8*>(kb+d0*2048);
    const bf16x8 b1=*reinterpret_cast<const bf16x8*>(kb+d0*2048+512);
    if(d0==0){p0=__builtin_amdgcn_mfma_f32_32x32x16_bf16(b0,qr[0],negm,0,0,0);p1=__builtin_amdgcn_mfma_f32_32x32x16_bf16(b1,qr[0],negm,0,0,0);}
    else{p0=__builtin_amdgcn_mfma_f32_32x32x16_bf16(b0,qr[d0],p0,0,0,0);p1=__builtin_amdgcn_mfma_f32_32x32x16_bf16(b1,qr[d0],p1,0,0,0);}}
}
typedef __attribute__((address_space(3))) const char* lds_cptr;
typedef short v4i16_t __attribute__((ext_vector_type(4)));
__device__ __forceinline__ void kload8(bf16x8*kf,lds_cptr kp){
  kf[0]=*(const __attribute__((address_space(3))) bf16x8*)(kp);      kf[1]=*(const __attribute__((address_space(3))) bf16x8*)(kp+512);
  kf[2]=*(const __attribute__((address_space(3))) bf16x8*)(kp+2048); kf[3]=*(const __attribute__((address_space(3))) bf16x8*)(kp+2560);
  kf[4]=*(const __attribute__((address_space(3))) bf16x8*)(kp+4096); kf[5]=*(const __attribute__((address_space(3))) bf16x8*)(kp+4608);
  kf[6]=*(const __attribute__((address_space(3))) bf16x8*)(kp+6144); kf[7]=*(const __attribute__((address_space(3))) bf16x8*)(kp+6656);
}
__device__ __forceinline__ void kload2(bf16x8*kf,lds_cptr kp,int j){ kf[2*j]=*(const __attribute__((address_space(3))) bf16x8*)(kp+j*2048); kf[2*j+1]=*(const __attribute__((address_space(3))) bf16x8*)(kp+j*2048+512); }
__device__ __forceinline__ s16x4 vtr(lds_cptr p){ return __builtin_bit_cast(s16x4,__builtin_amdgcn_ds_read_tr16_b64_v4i16((__attribute__((address_space(3))) v4i16_t*)p)); }
__device__ __forceinline__ float rowmax(const f32x16&p0,const f32x16&p1){
  float a=max3f(p0[0],p0[1],p1[0]),b=max3f(p0[2],p0[3],p1[1]);a=max3f(a,p1[2],p1[3]);
  #pragma unroll
  for(int r=4;r<16;r+=4){a=max3f(a,p0[r],p0[r+1]);b=max3f(b,p0[r+2],p0[r+3]);a=max3f(a,p1[r],p1[r+1]);b=max3f(b,p1[r+2],p1[r+3]);}
  const float m=max2f(a,b);
  auto rr=__builtin_amdgcn_permlane32_swap(__float_as_uint(m),__float_as_uint(m),false,false);
  return max2f(__uint_as_float(rr[0]),__uint_as_float(rr[1]));
}
__device__ __forceinline__ void pv(f32x16*o,int vb,bf16x8 pa0,bf16x8 pa1,bf16x8 pa2,bf16x8 pa3){
  #pragma unroll
  for(int d0=0;d0<2;++d0){s16x4 lo[4],hi[4];
    #pragma unroll
    for(int ks=0;ks<4;++ks){
      asm volatile("ds_read_b64_tr_b16 %0,%1 offset:%c2":"=&v"(lo[ks]):"v"(vb),"i"(d0*4096+ks*1024):"memory");
      asm volatile("ds_read_b64_tr_b16 %0,%1 offset:%c2":"=&v"(hi[ks]):"v"(vb),"i"(d0*4096+ks*1024+512):"memory");}
    asm volatile("s_waitcnt lgkmcnt(0)":::"memory");SBAR();
    #define PK(k) (bf16x8){lo[k][0],lo[k][1],lo[k][2],lo[k][3],hi[k][0],hi[k][1],hi[k][2],hi[k][3]}
    o[d0]=__builtin_amdgcn_mfma_f32_32x32x16_bf16(pa0,PK(0),o[d0],0,0,0);
    o[d0]=__builtin_amdgcn_mfma_f32_32x32x16_bf16(pa1,PK(1),o[d0],0,0,0);
    o[d0]=__builtin_amdgcn_mfma_f32_32x32x16_bf16(pa2,PK(2),o[d0],0,0,0);
    o[d0]=__builtin_amdgcn_mfma_f32_32x32x16_bf16(pa3,PK(3),o[d0],0,0,0);
    #undef PK
  }
}

#ifndef ATTN_STORE16
#define ATTN_STORE16(p,v) (*(GAS u32x4*)(p)=(v))
#endif
template<int THRL,int QP,int KP,int OP> __device__ __forceinline__ void attn_unit(const bf16*Qu,const bf16*__restrict__ Kh,const bf16*__restrict__ Vh,bf16*Ou,const int NT,char*shm,int wave_s){
  const int tid=opaque_tid(wave_s),lane=tid&63,r32=lane&31,hi=lane>>5; const int wid=__builtin_amdgcn_readfirstlane(tid>>6);
  const bf16*Qw=Qu+(long)(wid*QBLK)*QP;
  const unsigned lds0=(unsigned)(uintptr_t)shm;
  float*wsf=(float*)(shm+LDS_WS)+wid*64;
  const bf16*ksrc=Kh+(long)lane*KP+wid*8;
  const bf16*vsrc=Vh+(long)(16*(wid&3)+(lane>>2))*KP+(wid>>2)*32+(lane&3)*8;
  const unsigned kdst=lds0+LDS_K+wid*1024, vdst=lds0+LDS_V+wid*1024;
  #define DMA_K(t,slot) glds16(ksrc+(long)(t)*KVBLK*KP,(unsigned)__builtin_amdgcn_readfirstlane(kdst+(slot)))
  #define DMA_V(t,slot) glds16(vsrc+(long)(t)*KVBLK*KP,(unsigned)__builtin_amdgcn_readfirstlane(vdst+(slot)))
  const int vb0=(int)(lds0+LDS_V)+((lane>>4)&1)*32+(lane&3)*8+(4*hi+((lane&15)>>2))*64;
  const char*Kbase=shm+LDS_K; bf16x8 kf[8];
  const lds_cptr shm3=(lds_cptr)shm; const lds_cptr kp0=shm3+LDS_K+hi*1024+r32*16; const lds_cptr vp0=shm3+LDS_V+((lane>>4)&1)*32+(lane&3)*8+(4*hi+((lane&15)>>2))*64;
  DMA_K(0,0);DMA_V(0,0);DMA_K(1,SLOTB);
  bf16x8 qr[4];
  #pragma unroll
  for(int d0=0;d0<4;++d0)qr[d0]=*(const GAS bf16x8*)(&Qw[(long)r32*QP+d0*16+hi*8]);
  float mhat=0.f,l_reg=0.f;f32x16 o[2];o[0]=f32x16{};o[1]=f32x16{};f32x16 negm=f32x16{};asm volatile("":"+v"(negm));
  #define CMASK(P0,P1,t) do{}while(0)
  bool resc=false;
  #define START(P0,P1) do{ const float rm=(THRL<0)?14.0f:rowmax(P0,P1); resc=false; \
    { const float dl=rm; mhat=fadd_s(mhat,dl); \
      _Pragma("unroll") for(int r=0;r<16;++r){P0[r]=fsub_s(P0[r],dl);P1[r]=fsub_s(P1[r],dl);} \
      _Pragma("unroll") for(int r=0;r<16;++r)negm[r]=-mhat; asm volatile("":"+v"(negm)); } \
    _Pragma("unroll") for(int r=0;r<16;++r)P0[r]=__builtin_amdgcn_exp2f(P0[r]); }while(0)
  #define RESC() do{ if(resc){ asm volatile("s_waitcnt lgkmcnt(0)":::"memory"); \
      _Pragma("unroll") for(int d_=0;d_<2;++d_) _Pragma("unroll") for(int r=0;r<16;++r)o[d_][r]*=wsf[crow(r,hi)]; } }while(0)
  f32x16 pA0,pA1,pB0,pB1;
  int sl_prev=0,sl_cur=0,sl_next=SLOTB;
  #define ROT() do{sl_prev=sl_cur;sl_cur=sl_next;sl_next=(sl_next==(NSLOT-1)*SLOTB)?0:sl_next+SLOTB;}while(0)
  DMA_K(2,2*SLOTB);
  WAIT_BAR(3);
  qkt(pA0,pA1,Kbase,qr,negm,r32,hi);asm volatile("s_nop 15\n\ts_nop 7":"+v"(pA0),"+v"(pA1));CMASK(pA0,pA1,0);
  START(pA0,pA1);
  _Pragma("unroll") for(int r=0;r<16;++r)pA1[r]=__builtin_amdgcn_exp2f(pA1[r]);
  WAIT_BAR(0);
  DMA_K(3,0);DMA_V(1,SLOTB);
  ROT();
  kload8(kf,kp0+sl_cur);
  WAIT_BAR(2);
  s16x4 vlo[8],vhi[8]; u32x4 pw0,pw1,pw2,pw3;
  #define PKW(P,B) cvtpk_s(P[B],P[B+1])
  #define PAF(k) __builtin_bit_cast(bf16x8,pw##k)
  #define VFR(i) (bf16x8){vlo[i][0],vlo[i][1],vlo[i][2],vlo[i][3],vhi[i][0],vhi[i][1],vhi[i][2],vhi[i][3]}
  #define PIN(x) asm volatile("":"+v"(x))
  #define MX3(a,b,c) __builtin_fmaxf(__builtin_fmaxf((a),(b)),(c))
  #define GAPA(MF,A0,A1,A2,A3,W0,W1,PW) do{ MF; sacc2+=(f32x2_t){A0,A1}; sacc2+=(f32x2_t){A2,A3}; PIN(sacc2); W0; W1; PIN(PW); SBAR(); }while(0)
  #define EX(v) __builtin_amdgcn_exp2f(v)
  #define GAPB(MF,X,B) do{ MF; X[B]=EX(X[B]); X[B+1]=EX(X[B+1]); X[B+2]=EX(X[B+2]); X[B+3]=EX(X[B+3]); PIN(X); SBAR(); }while(0)
  #define VRD(i) do{ vlo[i]=vtr(vp_+(((i)>>2)*4096+((i)&3)*1024)); vhi[i]=vtr(vp_+(((i)>>2)*4096+((i)&3)*1024+512)); }while(0)
  #define KRD(G,j) do{ if(G){ kload2(kf,kp0+sl_next,j); SBAR(); } }while(0)
  #define STEP(C0,C1,P0,P1,t,GK,GV,GL) do{ SBAR(); \
    const lds_cptr vp_=vp0+sl_prev; \
    VRD(0); SBAR(); f32x2_t sacc2=(f32x2_t){P0[0],P0[1]}; \
    GAPA(C0=__builtin_amdgcn_mfma_f32_32x32x16_bf16(kf[0],qr[0],negm,0,0,0), P0[2],P0[3],P0[4],P0[5],     pw0[0]=PKW(P0,0), pw0[1]=PKW(P0,2), pw0); \
    VRD(4); SBAR(); GAPA(C1=__builtin_amdgcn_mfma_f32_32x32x16_bf16(kf[1],qr[0],negm,0,0,0), P0[6],P0[7],P0[8],P0[9],     pw0[2]=PKW(P0,4), pw0[3]=PKW(P0,6), pw0); \
    VRD(1); SBAR(); GAPA(C0=__builtin_amdgcn_mfma_f32_32x32x16_bf16(kf[2],qr[1],C0,0,0,0),   P0[10],P0[11],P0[12],P0[13], pw1[0]=PKW(P0,8), pw1[1]=PKW(P0,10), pw1); \
    VRD(5); SBAR(); GAPA(C1=__builtin_amdgcn_mfma_f32_32x32x16_bf16(kf[3],qr[1],C1,0,0,0),   P0[14],P0[15],P1[0],P1[1],   pw1[2]=PKW(P0,12),pw1[3]=PKW(P0,14), pw1); \
    VRD(2); SBAR(); GAPA(C0=__builtin_amdgcn_mfma_f32_32x32x16_bf16(kf[4],qr[2],C0,0,0,0),   P1[2],P1[3],P1[4],P1[5],     pw2[0]=PKW(P1,0), pw2[1]=PKW(P1,2), pw2); \
    VRD(6); SBAR(); GAPA(C1=__builtin_amdgcn_mfma_f32_32x32x16_bf16(kf[5],qr[2],C1,0,0,0),   P1[6],P1[7],P1[8],P1[9],     pw2[2]=PKW(P1,4), pw2[3]=PKW(P1,6), pw2); \
    VRD(3); SBAR(); GAPA(C0=__builtin_amdgcn_mfma_f32_32x32x16_bf16(kf[6],qr[3],C0,0,0,0),   P1[10],P1[11],P1[12],P1[13], pw3[0]=PKW(P1,8), pw3[1]=PKW(P1,10), pw3); \
    VRD(7); SBAR(); GAPA(C1=__builtin_amdgcn_mfma_f32_32x32x16_bf16(kf[7],qr[3],C1,0,0,0),   P1[14],P1[15],0.f,0.f,       pw3[2]=PKW(P1,12),pw3[3]=PKW(P1,14), pw3); \
    l_reg+=sacc2.x+sacc2.y; \
    if(GK){DMA_K((t)+3,sl_cur);} if(GV){DMA_V((t)+1,sl_next);} \
    CMASK(C0,C1,t); \
    if constexpr (THRL>=0) { float a=MX3(C0[0],C0[1],C1[0]),b=MX3(C0[2],C0[3],C1[1]); a=MX3(a,C1[2],C1[3]); \
      _Pragma("unroll") for(int r=4;r<16;r+=4){a=MX3(a,C0[r],C0[r+1]);b=MX3(b,C0[r+2],C0[r+3]);a=MX3(a,C1[r],C1[r+1]);b=MX3(b,C1[r+2],C1[r+3]);} \
      float rm=__builtin_fmaxf(a,b); { auto rr=__builtin_amdgcn_permlane32_swap(__float_as_uint(rm),__float_as_uint(rm),false,false); rm=__builtin_fmaxf(__uint_as_float(rr[0]),__uint_as_float(rr[1])); } \
      resc=false; \
      if(__builtin_expect(__any(rm>(float)THRL),0)){ const float dl=__builtin_fmaxf(rm,0.f); mhat+=dl; \
        _Pragma("unroll") for(int r=0;r<16;++r){C0[r]-=dl;C1[r]-=dl;} \
        _Pragma("unroll") for(int r=0;r<16;++r)negm[r]=-mhat; asm volatile("":"+v"(negm)); \
        const float f=__builtin_amdgcn_exp2f(-dl); l_reg*=f; if(hi==0)wsf[r32]=f; resc=true; } } \
    SBAR(); \
    GAPB(o[0]=__builtin_amdgcn_mfma_f32_32x32x16_bf16(PAF(0),VFR(0),o[0],0,0,0), C0,0); \
    GAPB(o[1]=__builtin_amdgcn_mfma_f32_32x32x16_bf16(PAF(0),VFR(4),o[1],0,0,0), C0,4); \
    KRD(GL,0); GAPB(o[0]=__builtin_amdgcn_mfma_f32_32x32x16_bf16(PAF(1),VFR(1),o[0],0,0,0), C0,8); \
    KRD(GL,1); GAPB(o[1]=__builtin_amdgcn_mfma_f32_32x32x16_bf16(PAF(1),VFR(5),o[1],0,0,0), C0,12); \
    KRD(GL,2); GAPB(o[0]=__builtin_amdgcn_mfma_f32_32x32x16_bf16(PAF(2),VFR(2),o[0],0,0,0), C1,0); \
    KRD(GL,3); GAPB(o[1]=__builtin_amdgcn_mfma_f32_32x32x16_bf16(PAF(2),VFR(6),o[1],0,0,0), C1,4); \
    GAPB(o[0]=__builtin_amdgcn_mfma_f32_32x32x16_bf16(PAF(3),VFR(3),o[0],0,0,0), C1,8); \
    GAPB(o[1]=__builtin_amdgcn_mfma_f32_32x32x16_bf16(PAF(3),VFR(7),o[1],0,0,0), C1,12); \
    }while(0)
  int t=1;
  #undef CMASK
  #define CMASK(P0,P1,t) do{}while(0)
  for(;t+5<NT;t+=2){
    STEP(pB0,pB1,pA0,pA1,t,true,true,true);     WAIT_BAR(2); RESC(); ROT();
    STEP(pA0,pA1,pB0,pB1,t+1,true,true,true);   WAIT_BAR(2); RESC(); ROT();
  }
  #undef CMASK
  #define CMASK(P0,P1,t) do{}while(0)
  #define ENDW(tt) do{ if((tt)+3<NT){WAIT_BAR(2);} else if((tt)+2<NT){WAIT_BAR(1);} else {WAIT_BAR(0);} }while(0)
  for(;t+1<NT;t+=2){
    STEP(pB0,pB1,pA0,pA1,t,(t+3<NT),(t+1<NT),(t+1<NT));       ENDW(t);   RESC(); ROT();
    STEP(pA0,pA1,pB0,pB1,t+1,(t+4<NT),(t+2<NT),(t+2<NT));     ENDW(t+1); RESC(); ROT();
  }
  STEP(pB0,pB1,pA0,pA1,NT-1,false,false,false); RESC();
  { float sacc=pB0[0]+pB0[1]; _Pragma("unroll") for(int r=2;r<16;++r)sacc+=pB0[r]; _Pragma("unroll") for(int r=0;r<16;++r)sacc+=pB1[r]; l_reg+=sacc;
    pw0=(u32x4){PKW(pB0,0),PKW(pB0,2),PKW(pB0,4),PKW(pB0,6)};pw1=(u32x4){PKW(pB0,8),PKW(pB0,10),PKW(pB0,12),PKW(pB0,14)};pw2=(u32x4){PKW(pB1,0),PKW(pB1,2),PKW(pB1,4),PKW(pB1,6)};pw3=(u32x4){PKW(pB1,8),PKW(pB1,10),PKW(pB1,12),PKW(pB1,14)};
    SBAR(); pv(o,vb0+sl_cur,PAF(0),PAF(1),PAF(2),PAF(3)); }
  #undef PKW
  #undef PAF
  #undef VFR
  #undef PIN
  #undef MX3
  #undef GAPA
  #undef GAPB
  #undef EX
  #undef VRD
  #undef KRD
  #undef STEP
  #undef ENDW
  {auto rr=__builtin_amdgcn_permlane32_swap(__float_as_uint(l_reg),__float_as_uint(l_reg),false,false);l_reg=__uint_as_float(rr[0])+__uint_as_float(rr[1]);}
  if(hi==0)wsf[32+r32]=l_reg;asm volatile("s_waitcnt lgkmcnt(0)":::"memory");
  float rli[16];
  #pragma unroll
  for(int r=0;r<16;++r)rli[r]=__builtin_amdgcn_rcpf(wsf[32+crow(r,hi)]);
  bf16*Ow=Ou+(long)(wid*QBLK)*OP;
  { bf16*stg=(bf16*)(shm+LDS_OST)+wid*2048;
    #pragma unroll
    for(int r=0;r<16;++r){const int orow=crow(r,hi);
      #pragma unroll
      for(int d0=0;d0<2;++d0)stg[orow*64+d0*32+r32]=__float2bfloat16(o[d0][r]*rli[r]);}
    asm volatile("s_waitcnt lgkmcnt(0)":::"memory");
    #pragma unroll
    for(int i=0;i<4;++i){const int row=i*8+(lane>>3),ch=lane&7; const u32x4 v=*(const u32x4*)(stg+row*64+ch*8); ATTN_STORE16(Ow+(long)row*OP+ch*8,v);} }
  asm volatile("s_waitcnt lgkmcnt(0)\n\ts_barrier":::"memory");
  #undef DMA_K
  #undef DMA_V
  #undef CMASK
  #undef START
  #undef RESC
  #undef ROT
}
constexpr int ATTN_LDS_BYTES=LDS_BYTES;
#undef SBAR
#undef WAIT_BAR
}
#define LDS_WAIT() asm volatile("s_waitcnt lgkmcnt(0)" ::: "memory")

__device__ __forceinline__ void transpose_item(const float* W, int K, int N, bf16* WT, int k0, int n0, int dest_row0, LAS float* scr, int lane) {
    float t_[32];
#pragma unroll
    for (int i = 0; i < 32; ++i) t_[i] = W[(size_t)(k0 + 2 * i + (lane >> 5)) * N + n0 + (lane & 31)];
#pragma unroll
    for (int i = 0; i < 32; ++i) scr[(2 * i + (lane >> 5)) * 33 + (lane & 31)] = t_[i];
    LDS_WAIT(); asm volatile("" ::: "memory");
    const int c = lane & 7;
#pragma unroll
    for (int j = 0; j < 4; ++j) { const int n = (lane >> 3) + 8 * j; const LAS float* s = scr + (8 * c) * 33 + n;
        v4u o; o.x = pk2(s[0 * 33], s[1 * 33]); o.y = pk2(s[2 * 33], s[3 * 33]); o.z = pk2(s[4 * 33], s[5 * 33]); o.w = pk2(s[6 * 33], s[7 * 33]);
        *(GAS v4u*)(WT + (size_t)(dest_row0 + n) * K + k0 + 8 * c) = o; }
    LDS_WAIT(); asm volatile("" ::: "memory");
}

template <int KMODE>
__device__ __forceinline__ void transpose_item8(const float* W, int K, int N, unsigned char* WT, int k0, int n0, int dest_row0, float sc, LAS float* scr, int lane) {
    float t_[32];
#pragma unroll
    for (int i = 0; i < 32; ++i) t_[i] = W[(size_t)(k0 + 2 * i + (lane >> 5)) * N + n0 + (lane & 31)];
#pragma unroll
    for (int i = 0; i < 32; ++i) scr[(2 * i + (lane >> 5)) * 33 + (lane & 31)] = __builtin_amdgcn_fmed3f(t_[i] * sc, -448.f, 448.f);
    LDS_WAIT(); asm volatile("" ::: "memory");
    const int c = lane & 7, w = c >> 2, fq = c & 3, wh = (k0 >> 6) & 1;
    const int doff = KMODE == 1 ? (k0 & ~255) + 64 * (2 * wh + w) + 16 * fq + 8 * ((k0 >> 7) & 1) : KMODE == 2 ? (k0 & ~127) + 32 * (2 * wh + w) + 8 * fq : k0 + 8 * c;
#pragma unroll
    for (int j = 0; j < 4; ++j) { const int n = (lane >> 3) + 8 * j; const LAS float* s = scr + n;
        float v[8];
#pragma unroll
        for (int e = 0; e < 8; ++e) { const int kk = KMODE == 2 ? 32 * w + 16 * (e >> 2) + 4 * fq + (e & 3) : 8 * c + e; v[e] = s[kk * 33]; }
        unsigned w0 = 0, w1 = 0;
        w0 = __builtin_amdgcn_cvt_pk_fp8_f32(v[0], v[1], w0, false); w0 = __builtin_amdgcn_cvt_pk_fp8_f32(v[2], v[3], w0, true);
        w1 = __builtin_amdgcn_cvt_pk_fp8_f32(v[4], v[5], w1, false); w1 = __builtin_amdgcn_cvt_pk_fp8_f32(v[6], v[7], w1, true);
        *(GAS v2u*)(WT + (size_t)(dest_row0 + n) * K + doff) = (v2u){w0, w1}; }
    LDS_WAIT(); asm volatile("" ::: "memory");
}

struct ProIn { const float *hy_w_in, *at_w_in, *w_out, *w_mem_kv; };
__device__ __forceinline__ void phase_weights(const ProIn& P, unsigned char* ws, LAS unsigned char* lds, int gw, int NGW, int wave, int lane) {
    LAS float* scr = (LAS float*)(lds + wave * 16384);
    constexpr int I_HY = 16 * 80, I_AT = 16 * 48, I_OUT = 16 * 32, I_MKV = 16 * 16;
    constexpr int E0 = 2 * I_HY, E1 = E0 + 2 * I_AT, E2 = E1 + 4 * I_OUT, E3 = E2 + 4 * I_MKV;
    for (int it = gw; it < E3; it += NGW) {
        int r = it;
        if (r < E0) { const int j = r / I_HY, q = r % I_HY, kb = q / 80, nb = q % 80;
            transpose_item(P.hy_w_in + (size_t)j * DM * D_IN_HY, DM, D_IN_HY, (bf16*)(ws + WS_WHY) + (size_t)j * D_IN_HY * DM, 64 * kb, 32 * nb, 32 * nb, scr, lane); continue; }
        r -= E0;
        if (r < 2 * I_AT) { const int j = r / I_AT, q = r % I_AT, kb = q / 48, nb = q % 48;
            const int n0 = 32 * nb, o = n0 & 255;
            transpose_item(P.at_w_in + (size_t)j * DM * D_IN_AT, DM, D_IN_AT, (bf16*)(ws + WS_WAT) + (size_t)j * D_IN_AT * DM, 64 * kb, n0, (n0 & ~255) + 128 * ((o & 63) >> 5) + 32 * (o >> 6), scr, lane); continue; }
        r -= 2 * I_AT;
        if (r < 4 * I_OUT) { const int j = r / I_OUT, q = r % I_OUT, kb = q / 32, nb = q % 32;
            transpose_item(P.w_out + (size_t)j * DM * DM, DM, DM, (bf16*)(ws + WS_WOUT) + (size_t)j * DM * DM, 64 * kb, 32 * nb, 32 * nb, scr, lane); continue; }
        r -= 4 * I_OUT;
        { const int j = r / I_MKV, q = r % I_MKV, kb = q / 16, nb = q % 16;
            transpose_item(P.w_mem_kv + (size_t)j * DM * 512, DM, 512, (bf16*)(ws + WS_WMKV), 64 * kb, 32 * nb, j * 512 + 32 * nb, scr, lane); }
        (void)r;
    }
}

struct XwIn { const float *w_gate, *w_up, *w_down; unsigned char* ws; };
constexpr int XW_PER_EXPERT = 3 * 384, XW_PER_LAYER = NEXP * XW_PER_EXPERT;
constexpr int XW_QA_HY = 5, XW_QA_AT = 4, XW_QB = 3, XW_NA = 128 * NWAVES, XW_NB = 224 * NWAVES;
__host__ __device__ constexpr int xw_qa(int layer) { return (layer & 1) ? XW_QA_AT : XW_QA_HY; }
__host__ __device__ constexpr int xw_p0(int layer, bool sched) { return sched ? XW_PER_LAYER - xw_qa(layer) * XW_NA - XW_QB * XW_NB : XW_PER_LAYER; }
__device__ __forceinline__ void xw_item(const XwIn& B, int layer, int r, LAS float* scr, int lane) {
    const int j = layer * NEXP + r / XW_PER_EXPERT, q = r % XW_PER_EXPERT, kind = q / 384, qq = q % 384;
    if (kind < 2) { const int kb = qq / 24, nb = qq % 24, n0 = 32 * nb;
        transpose_item8<1>((kind == 0 ? B.w_gate : B.w_up) + (size_t)j * DM * EFF, DM, EFF, B.ws + WS_W1 + (size_t)j * 1536 * DM, 64 * kb, n0, (n0 >> 7) * 256 + 128 * kind + (n0 & 127), W8_SCALE, scr, lane); }
    else { const int kb = qq / 32, nb = qq % 32;
        transpose_item8<2>(B.w_down + (size_t)j * EFF * DM, EFF, DM, B.ws + WS_W2 + (size_t)j * DM * EFF, 64 * kb, 32 * nb, 32 * nb, W8_SCALE, scr, lane); }
}
__device__ __forceinline__ void phase_xw_p0(const XwIn& B, bool sched, LAS float* scr, int gw, int NGW, int lane) {
#pragma unroll 1
    for (int layer = 0; layer < DEPTH; ++layer) { const int n = xw_p0(layer, sched);
#pragma unroll 1
        for (int r = gw; r < n; r += NGW) xw_item(B, layer, r, scr, lane); }
}
__device__ __forceinline__ void xw_slice_a(const XwIn& B, int layer, LAS float* scr, int bx, int wave, int lane) {
    const int base = xw_p0(layer, true) + (bx - 128) * NWAVES + wave;
#pragma unroll 1
    for (int k = 0; k < xw_qa(layer); ++k) xw_item(B, layer, base + k * XW_NA, scr, lane);
}
__device__ __forceinline__ void xw_slice_b(const XwIn& B, int layer, LAS float* scr, int bx, int wave, int lane) {
    const int base = xw_p0(layer, true) + xw_qa(layer) * XW_NA + (bx - 32) * NWAVES + wave;
#pragma unroll 1
    for (int k = 0; k < XW_QB; ++k) xw_item(B, layer, base + k * XW_NB, scr, lane);
}

__device__ __forceinline__ void phase_wrg(const float* ffn_g, const float* router, float* WRG, int gtid, int nthreads) {
    for (int q = gtid; q < DEPTH * NEXP * DM; q += nthreads) { const int l = q / (NEXP * DM), e = (q / DM) % NEXP, d = q % DM; WRG[q] = ffn_g[l * DM + d] * router[((size_t)l * DM + d) * NEXP + e]; }
}

__device__ __forceinline__ void rms_row_bf16(const float* xrow, const float* g, bf16* orow, int lane) {
    const GAS f32x4* xr = (const GAS f32x4*)xrow + lane; const GAS f32x4* gr = (const GAS f32x4*)g + lane;
    f32x4 v[4]; float s = 0.f;
#pragma unroll
    for (int j = 0; j < 4; ++j) { v[j] = xr[64 * j]; s += (v[j].x * v[j].x + v[j].y * v[j].y) + (v[j].z * v[j].z + v[j].w * v[j].w); }
    const float rstd = 1.f / sqrtf(wave_sum(s) * (1.f / DM) + NORM_EPS);
    GAS v2u* o8 = (GAS v2u*)orow + lane;
#pragma unroll
    for (int j = 0; j < 4; ++j) { const f32x4 gg = gr[64 * j]; v2u w; w.x = pk2(v[j].x * rstd * gg.x, v[j].y * rstd * gg.y); w.y = pk2(v[j].z * rstd * gg.z, v[j].w * rstd * gg.w); o8[64 * j] = w; }
}

__device__ __forceinline__ void phase_mem_h2(const float* mem, const float* mem_g, const float* fw1, const float* fb1, const float* fw2, const float* fb2, const float* ffreq,
                                              unsigned char* ws, int gw, int NGW, int lane) {
    for (int m = gw; m < BATCH * MEM_LEN; m += NGW) rms_row_bf16(mem + (size_t)m * DM, mem_g, (bf16*)(ws + WS_MEMN) + (size_t)m * DM, lane);
    float* H2 = (float*)(ws + WS_H2);
#pragma unroll 1
    for (int j = 0; j < 2; ++j) {
        const float* w1 = fw1 + j * HY_EMB * HY_FILT; const float* w2 = fw2 + j * HY_FILT * HY_FILT;
        const float fr = ffreq[j * HY_FILT + lane], b1 = fb1[j * HY_FILT + lane], b2 = fb2[j * HY_FILT + lane];
#pragma unroll 1
        for (int n0 = gw; n0 < SEQ; n0 += 4 * NGW) {
            float feat[4], a[4], h1[4], a2[4];
#pragma unroll
            for (int r = 0; r < 4; ++r) { const int n = min(n0 + r * NGW, SEQ - 1);
                const float t = (float)n * (1.0f / (float)(SEQ - 1));
                const float w = (6.283185307179586f * (float)n) / (float)SEQ;
                float f = 0.f;
                if (lane == 0) f = t;
                else if (lane <= 16) { const float band = 1e-4f + (float)(lane - 1) * ((15.0f - 1e-4f) / 15.0f); f = cosf(band * w); }
                else if (lane <= 32) { const float band = 1e-4f + (float)(lane - 17) * ((15.0f - 1e-4f) / 15.0f); f = -sinf(band * w); }
                feat[r] = f; a[r] = b1; }
            for (int i = 0; i < HY_EMB; ++i) { const float wv = w1[i * HY_FILT + lane];
#pragma unroll
                for (int r = 0; r < 4; ++r) a[r] += __shfl(feat[r], i) * wv; }
#pragma unroll
            for (int r = 0; r < 4; ++r) { h1[r] = sinf(fr * a[r]); a2[r] = b2; }
            for (int i = 0; i < HY_FILT; ++i) { const float wv = w2[i * HY_FILT + lane];
#pragma unroll
                for (int r = 0; r < 4; ++r) a2[r] += __shfl(h1[r], i) * wv; }
#pragma unroll
            for (int r = 0; r < 4; ++r) { const int n = n0 + r * NGW; if (n < SEQ) H2[((size_t)j * SEQ + n) * HY_FILT + lane] = sinf(fr * a2[r]); }
        }
    }
}

template <bool B> struct NormRaw { typedef f32x4 T; };
template <> struct NormRaw<true> { typedef v2u T; };
__device__ __forceinline__ f32x4 norm_cvt(const f32x4 v) { return v; }
__device__ __forceinline__ f32x4 norm_cvt(const v2u w) { return (f32x4){bflo(w.x), bfhi(w.x), bflo(w.y), bfhi(w.y)}; }
template <bool COMBINE, bool FINAL, bool INBF>
__device__ __forceinline__ void phase_norm(const void* hin, bf16* hout, const float* g, bf16* U, float* fout, const int* POS, const bf16* Y, int gw, int NGW, int lane) {
    typedef typename NormRaw<INBF>::T raw_t;
    int m = gw;
    if (m >= M_TOK) return;
    raw_t cur[4]; int cpos = -1;
    { const GAS raw_t* xr = (const GAS raw_t*)hin + (size_t)m * (DM / 4) + lane;
#pragma unroll
      for (int j = 0; j < 4; ++j) cur[j] = xr[64 * j];
      if (COMBINE) { const int b = m / SEQ, t = m % SEQ; if (lane < NEXP) cpos = POS[(size_t)(b * NEXP + lane) * SEQ + t]; } }
    f32x4 gq[4];
    { const GAS f32x4* gr = (const GAS f32x4*)g + lane;
#pragma unroll
      for (int j = 0; j < 4; ++j) gq[j] = gr[64 * j]; }
#pragma unroll 1
    for (; m < M_TOK; m += NGW) {
        const int mn = m + NGW; raw_t nxt[4]; int npos = -1;
#pragma unroll
        for (int j = 0; j < 4; ++j) nxt[j] = cur[j];
        if (mn < M_TOK) { const GAS raw_t* xr = (const GAS raw_t*)hin + (size_t)mn * (DM / 4) + lane;
#pragma unroll
            for (int j = 0; j < 4; ++j) nxt[j] = xr[64 * j];
            if (COMBINE) { const int b = mn / SEQ, t = mn % SEQ; if (lane < NEXP) npos = POS[(size_t)(b * NEXP + lane) * SEQ + t]; } }
        f32x4 v[4];
#pragma unroll
        for (int j = 0; j < 4; ++j) v[j] = norm_cvt(cur[j]);
        if (COMBINE) {
            const int b = m / SEQ;
            unsigned long long mask = __ballot(cpos >= 0);
            while (mask) {
                v2u y[4][4]; bool has[4];
#pragma unroll
                for (int k = 0; k < 4; ++k) { has[k] = mask != 0ull;
                    if (has[k]) { const int e = __builtin_amdgcn_readfirstlane(__builtin_ctzll(mask)); mask &= mask - 1ull; const int p = __builtin_amdgcn_readlane(cpos, e);
                        const GAS v2u* yr = (const GAS v2u*)(Y + ((size_t)(b * NEXP + e) * CAP + p) * DM) + lane;
#pragma unroll
                        for (int j = 0; j < 4; ++j) y[k][j] = yr[64 * j]; } }
#pragma unroll
                for (int k = 0; k < 4; ++k) if (has[k]) {
#pragma unroll
                    for (int j = 0; j < 4; ++j) { const v2u w = y[k][j]; v[j].x += bflo(w.x); v[j].y += bfhi(w.x); v[j].z += bflo(w.y); v[j].w += bfhi(w.y); } }
            }
        }
        if (!FINAL && (COMBINE || !INBF)) { GAS v2u* ho = (GAS v2u*)(hout + (size_t)m * DM) + lane;
#pragma unroll
            for (int j = 0; j < 4; ++j) { v2u w; w.x = pk2(v[j].x, v[j].y); w.y = pk2(v[j].z, v[j].w); ho[64 * j] = w; } }
        float s = 0.f;
#pragma unroll
        for (int j = 0; j < 4; ++j) s += (v[j].x * v[j].x + v[j].y * v[j].y) + (v[j].z * v[j].z + v[j].w * v[j].w);
        const float rstd = 1.f / sqrtf(wave_sum(s) * (1.f / DM) + NORM_EPS);
        if (FINAL) { GAS f32x4* o = (GAS f32x4*)(fout + (size_t)m * DM) + lane;
#pragma unroll
            for (int j = 0; j < 4; ++j) o[64 * j] = v[j] * rstd * gq[j]; }
        else { GAS v2u* o8 = (GAS v2u*)(U + (size_t)m * DM) + lane;
#pragma unroll
            for (int j = 0; j < 4; ++j) { const f32x4 gg = gq[j]; v2u w; w.x = pk2(v[j].x * rstd * gg.x, v[j].y * rstd * gg.y); w.y = pk2(v[j].z * rstd * gg.z, v[j].w * rstd * gg.w); o8[64 * j] = w; } }
#pragma unroll
        for (int j = 0; j < 4; ++j) cur[j] = nxt[j];
        cpos = npos;
    }
}

__device__ __forceinline__ void phase_ffn_norm_router(const float* H, const float* g, const float* Wr, unsigned char* XN8, float* AFF, LAS unsigned char* lds, int gw, int NGW, int lane, int tid) {
    LAS f32x4* WL = (LAS f32x4*)lds;
    for (int q = tid; q < 64 * 64; q += NTHREADS) { const int ln = q & 63, s = q >> 6, e4 = s & 3, ji = s >> 2, i = ji & 3, j = ji >> 2; const int d = 4 * ln + i + 256 * j;
        WL[q] = *(const GAS f32x4*)(Wr + (size_t)d * NEXP + 4 * e4); }
    __syncthreads();
    constexpr int R = 4;
    const GAS f32x4* gr = (const GAS f32x4*)g + lane;
#pragma unroll 1
    for (int m0 = gw * R; m0 < M_TOK; m0 += NGW * R) {
        int lo_ = lane; asm volatile("" : "+v"(lo_));
        f32x4 v[R][4]; float rstd[R];
#pragma unroll
        for (int r = 0; r < R; ++r) { const GAS f32x4* xr = (const GAS f32x4*)(H + (size_t)(m0 + r) * DM) + lane;
#pragma unroll
            for (int j = 0; j < 4; ++j) v[r][j] = xr[64 * j]; }
#pragma unroll
        for (int r = 0; r < R; ++r) { float s = 0.f;
#pragma unroll
            for (int j = 0; j < 4; ++j) s += (v[r][j].x * v[r][j].x + v[r][j].y * v[r][j].y) + (v[r][j].z * v[r][j].z + v[r][j].w * v[r][j].w);
            rstd[r] = 1.f / sqrtf(wave_sum(s) * (1.f / DM) + NORM_EPS); }
        f32x4 lg[R][4];
#pragma unroll
        for (int r = 0; r < R; ++r)
#pragma unroll
            for (int e4 = 0; e4 < 4; ++e4) lg[r][e4] = (f32x4){0.f, 0.f, 0.f, 0.f};
#pragma unroll
        for (int j = 0; j < 4; ++j) { const f32x4 gg = gr[64 * j];
#pragma unroll
            for (int r = 0; r < R; ++r) { v[r][j] = v[r][j] * rstd[r] * gg;
                unsigned w = 0; w = __builtin_amdgcn_cvt_pk_fp8_f32(v[r][j].x, v[r][j].y, w, false); w = __builtin_amdgcn_cvt_pk_fp8_f32(v[r][j].z, v[r][j].w, w, true);
                ((GAS unsigned*)(XN8 + (size_t)(m0 + r) * DM) + lane)[64 * j] = w; }
#pragma unroll
            for (int i = 0; i < 4; ++i)
#pragma unroll
                for (int e4 = 0; e4 < 4; ++e4) { const f32x4 wv = WL[((j * 4 + i) * 4 + e4) * 64 + lo_];
#pragma unroll
                    for (int r = 0; r < R; ++r) { const float xs = v[r][j][i];
#pragma unroll
                        for (int c = 0; c < 4; ++c) asm("v_fmac_f32 %0, %1, %2" : "+v"(lg[r][e4][c]) : "v"(wv[c]), "v"(xs)); } }
            __builtin_amdgcn_sched_barrier(0); }
#pragma unroll
        for (int r = 0; r < R; ++r) {
            float l16[16];
#pragma unroll
            for (int e = 0; e < 16; ++e) l16[e] = wave_sum(lg[r][e >> 2][e & 3]);
            float mx = l16[0];
#pragma unroll
            for (int e = 1; e < 16; ++e) mx = fmaxf(mx, l16[e]);
            float den = 0.f;
#pragma unroll
            for (int e = 0; e < 16; ++e) { l16[e] = expf(l16[e] - mx); den += l16[e]; }
            float mine = 0.f;
#pragma unroll
            for (int e = 0; e < 16; ++e) mine = (lane == e) ? l16[e] : mine;
            const int m = m0 + r, b = m / SEQ, t = m % SEQ;
            if (lane < NEXP) AFF[(size_t)(b * NEXP + lane) * SEQ + t] = mine / den;
        }
    }
    __syncthreads();
}

__device__ __forceinline__ void phase_router_sum(const float* PLG, const float* PSS, float* RSTD, float* AFF, int gw, int NGW, int lane) {
    const int e = lane & 15, rq = lane >> 4;
    for (int m0 = gw * 4; m0 < M_TOK; m0 += NGW * 4) {
        const int m = m0 + rq;
        float lgt = 0.f;
#pragma unroll
        for (int slot = 0; slot < 16; ++slot) lgt += ((const GAS float*)PLG)[((size_t)slot * M_TOK + m) * 16 + e];
        float ss = ((const GAS float*)PSS)[(size_t)e * M_TOK + m];
#pragma unroll
        for (int o = 1; o < 16; o <<= 1) ss += __shfl_xor(ss, o);
        const float rstd = 1.f / sqrtf(ss * (1.f / DM) + NORM_EPS);
        lgt *= rstd;
        float mx = lgt;
#pragma unroll
        for (int o = 1; o < 16; o <<= 1) mx = fmaxf(mx, __shfl_xor(mx, o));
        const float ex = expf(lgt - mx); float den = ex;
#pragma unroll
        for (int o = 1; o < 16; o <<= 1) den += __shfl_xor(den, o);
        const int b = m / SEQ, t = m % SEQ;
        ((GAS float*)AFF)[(size_t)(b * NEXP + e) * SEQ + t] = ex / den;
        if (e == 0) ((GAS float*)RSTD)[m] = rstd;
    }
}

__device__ __forceinline__ int block_excl_scan(int v, LAS int* scr, int tid, int lane, int wave, int* tot) {
    int inc = v;
#pragma unroll
    for (int o = 1; o < 64; o <<= 1) { const int n = __shfl_up(inc, o); if (lane >= o) inc += n; }
    __syncthreads();
    if (lane == 63) scr[wave] = inc;
    __syncthreads();
    int base = 0, total = 0;
#pragma unroll
    for (int w = 0; w < NWAVES; ++w) { const int c = scr[w]; if (w < wave) base += c; total += c; }
    *tot = total;
    return base + inc - v;
}

__device__ __forceinline__ void phase_topk(const float* AFF, const float* RSTD, float* RS, int* IDX, float* GATE, int* POS, LAS unsigned char* ldsm, int blk, int nblk, int tid, int lane, int wave) {
    LAS int* hist = (LAS int*)ldsm;
    LAS int* sel = (LAS int*)(ldsm + 1024);
    LAS int* scr = (LAS int*)(ldsm + 1280);
    for (int g = blk; g < NGRP; g += nblk) {
        unsigned v[16];
        { const GAS v4u* src = (const GAS v4u*)(AFF + (size_t)g * SEQ) + tid * 4;
#pragma unroll
          for (int q = 0; q < 4; ++q) { const v4u w = src[q]; v[4 * q] = w.x; v[4 * q + 1] = w.y; v[4 * q + 2] = w.z; v[4 * q + 3] = w.w; } }
        f32x4 rs4[4];
        { const GAS f32x4* rsrc = (const GAS f32x4*)(RSTD + (size_t)(g / NEXP) * SEQ) + tid * 4;
#pragma unroll
          for (int q = 0; q < 4; ++q) rs4[q] = rsrc[q]; }
        unsigned prefix = 0u; int krem = CAP;
#pragma unroll 1
        for (int pass = 0; pass < 4; ++pass) {
            const int shift = 24 - 8 * pass;
            const unsigned himask = (pass == 0) ? 0u : (0xffffffffu << (shift + 8));
            __syncthreads();
            if (tid < 256) hist[tid] = 0;
            __syncthreads();
#pragma unroll
            for (int i = 0; i < 16; ++i) if ((v[i] & himask) == prefix) __hip_atomic_fetch_add(hist + ((v[i] >> shift) & 255u), 1, __ATOMIC_RELAXED, __HIP_MEMORY_SCOPE_WORKGROUP);
            __syncthreads();
            if (wave == 0) {
                int c[4]; int s = 0;
#pragma unroll
                for (int j = 0; j < 4; ++j) { c[j] = hist[255 - 4 * lane - j]; s += c[j]; }
                int inc = s;
#pragma unroll
                for (int o = 1; o < 64; o <<= 1) { const int n = __shfl_up(inc, o); if (lane >= o) inc += n; }
                int before = inc - s;
                if (before < krem && krem <= inc) {
                    int bin = 0, kk = krem - before; bool done = false;
#pragma unroll
                    for (int j = 0; j < 4; ++j) { if (!done) { if (kk <= c[j]) { bin = 255 - 4 * lane - j; done = true; } else kk -= c[j]; } }
                    sel[0] = bin; sel[1] = kk;
                }
            }
            __syncthreads();
            prefix |= ((unsigned)sel[0]) << shift; krem = sel[1];
        }
        int ceq = 0;
#pragma unroll
        for (int i = 0; i < 16; ++i) ceq += (v[i] == prefix) ? 1 : 0;
        int tot;
        int eqrank = block_excl_scan(ceq, scr, tid, lane, wave, &tot);
        int csel = 0; unsigned selmask = 0u;
#pragma unroll
        for (int i = 0; i < 16; ++i) { bool s = v[i] > prefix; if (v[i] == prefix) { s = eqrank < krem; ++eqrank; } if (s) { selmask |= 1u << i; ++csel; } }
        int slot = block_excl_scan(csel, scr, tid, lane, wave, &tot);
        const int b = g / NEXP;
        int pv[16];
#pragma unroll
        for (int i = 0; i < 16; ++i) {
            pv[i] = -1;
            if (selmask & (1u << i)) { pv[i] = slot; ((GAS int*)IDX)[g * CAP + slot] = b * SEQ + tid * 16 + i; ((GAS float*)GATE)[g * CAP + slot] = __builtin_bit_cast(float, v[i]); ((GAS float*)RS)[g * CAP + slot] = rs4[i >> 2][i & 3]; ++slot; }
        }
        { GAS v4u* dst = (GAS v4u*)(POS + (size_t)g * SEQ) + tid * 4;
#pragma unroll
          for (int q = 0; q < 4; ++q) { v4u w; w.x = (unsigned)pv[4 * q]; w.y = (unsigned)pv[4 * q + 1]; w.z = (unsigned)pv[4 * q + 2]; w.w = (unsigned)pv[4 * q + 3]; dst[q] = w; } }
        __syncthreads();
    }
}

__device__ __forceinline__ void phase_gather(const bf16* XN, const int* IDX, bf16* XG, int gw, int NGW, int lane) {
    for (int r = gw; r < XROWS; r += NGW) {
        const int src = __builtin_amdgcn_readfirstlane(IDX[r]);
        const GAS v4u* s = (const GAS v4u*)(XN + (size_t)src * DM) + lane; GAS v4u* d = (GAS v4u*)(XG + (size_t)r * DM) + lane;
        const v4u a = s[0], b = s[64]; d[0] = a; d[64] = b;
    }
}

__device__ __forceinline__ void phase_qk_rope(bf16* P, const float* gq, const float* gk, int gw, int NGW, int lane) {
    const int hh = lane >> 2, part = lane & 3, axis = part >> 1, half = part & 1;
    const float* g = (hh < NQH ? gq : gk) + 16 * part;
    float gv[16], inv[16];
#pragma unroll
    for (int i = 0; i < 16; ++i) { gv[i] = g[i]; inv[i] = exp2f(-(float)i * (13.287712379549449f / 16.0f)); }
    const float osc = hh < NQH ? ATT_C2 : 1.0f;
    int m = gw; v4u c0 = (v4u){0u, 0u, 0u, 0u}, c1 = c0;
    if (m < M_TOK) { const GAS v4u* p = (const GAS v4u*)(P + (size_t)m * D_IN_AT + hh * HD + 16 * part); c0 = p[0]; c1 = p[1]; }
#pragma unroll 1
    for (; m < M_TOK; m += NGW) {
        const int t = m % SEQ; const float pos = (float)(axis == 0 ? (t >> 6) : (t & 63));
        GAS v4u* p = (GAS v4u*)(P + (size_t)m * D_IN_AT + hh * HD + 16 * part);
        const v4u w0 = c0, w1 = c1;
        if (m + NGW < M_TOK) { const GAS v4u* pn = (const GAS v4u*)(P + (size_t)(m + NGW) * D_IN_AT + hh * HD + 16 * part); c0 = pn[0]; c1 = pn[1]; }
        float x[16];
        x[0] = bflo(w0.x); x[1] = bfhi(w0.x); x[2] = bflo(w0.y); x[3] = bfhi(w0.y); x[4] = bflo(w0.z); x[5] = bfhi(w0.z); x[6] = bflo(w0.w); x[7] = bfhi(w0.w);
        x[8] = bflo(w1.x); x[9] = bfhi(w1.x); x[10] = bflo(w1.y); x[11] = bfhi(w1.y); x[12] = bflo(w1.z); x[13] = bfhi(w1.z); x[14] = bflo(w1.w); x[15] = bfhi(w1.w);
        float ss = 0.f;
#pragma unroll
        for (int i = 0; i < 16; ++i) ss += x[i] * x[i];
        ss += __shfl_xor(ss, 1); ss += __shfl_xor(ss, 2);
        const float rstd = 1.f / sqrtf(ss * (1.f / HD) + NORM_EPS);
        float o[16];
#pragma unroll
        for (int i = 0; i < 16; ++i) {
            const float xn = x[i] * rstd * gv[i]; const float xp = __shfl_xor(xn, 1);
            float sn, cs; sincosf(pos * inv[i], &sn, &cs);
            o[i] = (half == 0 ? (xn * cs - xp * sn) : (xp * sn + xn * cs)) * osc;
        }
        v4u r0, r1;
        r0.x = pk2(o[0], o[1]); r0.y = pk2(o[2], o[3]); r0.z = pk2(o[4], o[5]); r0.w = pk2(o[6], o[7]);
        r1.x = pk2(o[8], o[9]); r1.y = pk2(o[10], o[11]); r1.z = pk2(o[12], o[13]); r1.w = pk2(o[14], o[15]);
        p[0] = r0; p[1] = r1;
    }
}

__device__ __forceinline__ void phase_transpose_mix(const bf16* MIXT, bf16* MIX, LAS unsigned char* lds, int blk, int nblk, int tid) {
    constexpr int TP = 516;
    for (int it = blk; it < (D_MAIN / 64) * (M_TOK / 256); it += nblk) {
        const int cb = it % (D_MAIN / 64), mb = it / (D_MAIN / 64), c0 = cb * 64, m0 = mb * 256;
        v4u wq[4];
        __syncthreads();
#pragma unroll
        for (int k = 0; k < 4; ++k) { const int p = tid + NTHREADS * k, ch = p >> 5, seg = p & 31;
            wq[k] = *(const GAS v4u*)(MIXT + (size_t)(c0 + ch) * M_TOK + m0 + seg * 8); }
#pragma unroll
        for (int k = 0; k < 4; ++k) { const int p = tid + NTHREADS * k, ch = p >> 5, seg = p & 31; const v4u w = wq[k];
            LAS unsigned* d = (LAS unsigned*)(lds + ch * TP + seg * 16); d[0] = w.x; d[1] = w.y; d[2] = w.z; d[3] = w.w; }
        __syncthreads();
#pragma unroll
        for (int k = 0; k < 4; ++k) { const int q = tid + NTHREADS * k, r = q >> 3, j = q & 7;
            const LAS bf16* s = (const LAS bf16*)(lds + (8 * j) * TP) + r;
            v4u o; o.x = (unsigned)s[0] | ((unsigned)s[TP / 2] << 16); o.y = (unsigned)s[2 * (TP / 2)] | ((unsigned)s[3 * (TP / 2)] << 16);
            o.z = (unsigned)s[4 * (TP / 2)] | ((unsigned)s[5 * (TP / 2)] << 16); o.w = (unsigned)s[6 * (TP / 2)] | ((unsigned)s[7 * (TP / 2)] << 16);
            *(GAS v4u*)(MIX + (size_t)(m0 + r) * DM + c0 + 8 * j) = o; }
    }
    __syncthreads();
}
__device__ __forceinline__ void phase_taps(const float* H2j, const float* w3, float* TAPS, int gw, int NGW, int lane) {
    typedef float f32x16 __attribute__((ext_vector_type(16))); typedef short bf16x8_t __attribute__((ext_vector_type(8)));
    const float min_decay = -4.605170185988091f / 1.5f, max_decay = -4.605170185988091f / 0.3f;
    const int li = lane & 31, hi = lane >> 5;
#pragma unroll 1
    for (int it = gw; it < (FCOLS / 32) * (SEQ / 128); it += NGW) {
        const int ct = it % (FCOLS / 32), ng = it / (FCOLS / 32), col0 = ct * 32;
        bf16x8_t a[4]; float tw_[4][8];
#pragma unroll
        for (int s = 0; s < 4; ++s)
#pragma unroll
            for (int j = 0; j < 8; ++j) tw_[s][j] = ((const GAS float*)w3)[(size_t)(16 * s + 8 * hi + j) * FCOLS + col0 + li];
        f32x4 hv[4][8];
#pragma unroll
        for (int nt = 0; nt < 4; ++nt) { const GAS f32x4* hp = (const GAS f32x4*)(H2j + (size_t)(ng * 128 + nt * 32 + li) * HY_FILT + 8 * hi);
#pragma unroll
            for (int s = 0; s < 4; ++s) { hv[nt][2 * s] = hp[4 * s]; hv[nt][2 * s + 1] = hp[4 * s + 1]; } }
#pragma unroll
        for (int s = 0; s < 4; ++s) { const float* t = tw_[s];
            v4u p; p.x = pk2(t[0], t[1]); p.y = pk2(t[2], t[3]); p.z = pk2(t[4], t[5]); p.w = pk2(t[6], t[7]); a[s] = __builtin_bit_cast(bf16x8_t, p); }
#pragma unroll
        for (int nt = 0; nt < 4; ++nt) {
            const int n0 = ng * 128 + nt * 32;
            f32x16 acc;
#pragma unroll
            for (int r = 0; r < 16; ++r) acc[r] = 0.f;
#pragma unroll
            for (int s = 0; s < 4; ++s) { const f32x4 v0 = hv[nt][2 * s], v1 = hv[nt][2 * s + 1];
                v4u p; p.x = pk2(v0.x, v0.y); p.y = pk2(v0.z, v0.w); p.z = pk2(v1.x, v1.y); p.w = pk2(v1.z, v1.w);
                acc = __builtin_amdgcn_mfma_f32_32x32x16_bf16(a[s], __builtin_bit_cast(bf16x8_t, p), acc, 0, 0, 0); }
            const float t = (float)(n0 + li) * (1.0f / (float)(SEQ - 1));
#pragma unroll
            for (int r = 0; r < 16; ++r) { const int col = col0 + (r & 3) + 8 * (r >> 2) + 4 * hi, c = col % D_MAIN;
                const float ad = fabsf(min_decay + (float)c * ((max_decay - min_decay) / (float)(D_MAIN - 1)));
                ((GAS float*)TAPS)[(size_t)col * SEQ + n0 + li] = acc[r] * __builtin_amdgcn_exp2f(-t * ad * 1.4426950408889634f); }
        }
    }
}

__device__ __forceinline__ constexpr float twc(int k) { constexpr float T[16] = {1.0f, 0.98078528040323043f, 0.92387953251128674f, 0.83146961230254524f, 0.70710678118654757f, 0.55557023301960218f, 0.38268343236508978f, 0.19509032201612825f,
    0.0f, -0.19509032201612825f, -0.38268343236508978f, -0.55557023301960218f, -0.70710678118654757f, -0.83146961230254524f, -0.92387953251128674f, -0.98078528040323043f}; return T[k]; }
__device__ __forceinline__ constexpr float tws(int k) { constexpr float T[16] = {0.0f, 0.19509032201612825f, 0.38268343236508978f, 0.55557023301960218f, 0.70710678118654757f, 0.83146961230254524f, 0.92387953251128674f, 0.98078528040323043f,
    1.0f, 0.98078528040323043f, 0.92387953251128674f, 0.83146961230254524f, 0.70710678118654757f, 0.55557023301960218f, 0.38268343236508978f, 0.19509032201612825f}; return T[k]; }
__device__ __forceinline__ constexpr int bitrev(int i, int bits) { int r = 0; for (int b = 0; b < bits; ++b) if (i & (1 << b)) r |= 1 << (bits - 1 - b); return r; }

template <int N, int LEN> struct FftStage {
    static __device__ __forceinline__ void run(float (&re)[N], float (&im)[N]) {
        constexpr int half = LEN / 2, step = 32 / LEN;
#pragma unroll
        for (int base = 0; base < N; base += LEN)
#pragma unroll
            for (int j = 0; j < half; ++j) {
                const int i0 = base + j, i1 = i0 + half, idx = j * step;
                const float ar = re[i0], ai = im[i0], br = re[i1], bi = im[i1];
                re[i0] = ar + br; im[i0] = ai + bi;
                const float dr = ar - br, di = ai - bi;
                if (idx == 0) { re[i1] = dr; im[i1] = di; }
                else if (idx == 8) { re[i1] = di; im[i1] = -dr; }
                else { const float c = twc(idx), s = tws(idx); re[i1] = dr * c + di * s; im[i1] = di * c - dr * s; }
            }
        if constexpr (LEN > 2) FftStage<N, LEN / 2>::run(re, im);
    }
};
template <int N, int BITS> __device__ __forceinline__ void fft_reg(float (&re)[N], float (&im)[N]) {
    FftStage<N, N>::run(re, im);
    float tr[N], ti[N];
#pragma unroll
    for (int i = 0; i < N; ++i) { tr[bitrev(i, BITS)] = re[i]; ti[bitrev(i, BITS)] = im[i]; }
#pragma unroll
    for (int i = 0; i < N; ++i) { re[i] = tr[i]; im[i] = ti[i]; }
}

template <int CH, int NEGC> __device__ __forceinline__ void bfly_tw(f32x2& a, f32x2& b, const f32x2 P) {
    f32x2 sum, d, tmp;
#define BFLY_HEAD "v_pk_add_f32 %0, %3, %4\n\tv_pk_add_f32 %1, %3, %4 neg_lo:[0,1] neg_hi:[0,1]\n\t"
    if constexpr (CH == 0 && NEGC == 0) asm(BFLY_HEAD "v_pk_mul_f32 %2, %1, %5 op_sel:[1,1] op_sel_hi:[0,1] neg_hi:[1,0]\n\tv_pk_fma_f32 %1, %1, %5, %2 op_sel:[0,0,0] op_sel_hi:[1,0,1]" : "=&v"(sum), "=&v"(d), "=&v"(tmp) : "v"(a), "v"(b), "s"(P));
    if constexpr (CH == 1 && NEGC == 0) asm(BFLY_HEAD "v_pk_mul_f32 %2, %1, %5 op_sel:[1,0] op_sel_hi:[0,0] neg_hi:[1,0]\n\tv_pk_fma_f32 %1, %1, %5, %2 op_sel:[0,1,0] op_sel_hi:[1,1,1]" : "=&v"(sum), "=&v"(d), "=&v"(tmp) : "v"(a), "v"(b), "s"(P));
    if constexpr (CH == 0 && NEGC == 1) asm(BFLY_HEAD "v_pk_mul_f32 %2, %1, %5 op_sel:[1,1] op_sel_hi:[0,1] neg_hi:[1,0]\n\tv_pk_fma_f32 %1, %1, %5, %2 op_sel:[0,0,0] op_sel_hi:[1,0,1] neg_lo:[0,1,0] neg_hi:[0,1,0]" : "=&v"(sum), "=&v"(d), "=&v"(tmp) : "v"(a), "v"(b), "s"(P));
    if constexpr (CH == 1 && NEGC == 1) asm(BFLY_HEAD "v_pk_mul_f32 %2, %1, %5 op_sel:[1,0] op_sel_hi:[0,0] neg_hi:[1,0]\n\tv_pk_fma_f32 %1, %1, %5, %2 op_sel:[0,1,0] op_sel_hi:[1,1,1] neg_lo:[0,1,0] neg_hi:[0,1,0]" : "=&v"(sum), "=&v"(d), "=&v"(tmp) : "v"(a), "v"(b), "s"(P));
#undef BFLY_HEAD
    a = sum; b = d;
}
__device__ __forceinline__ void bfly_j(f32x2& a, f32x2& b) {
    f32x2 sum, o;
    asm("v_pk_add_f32 %0, %2, %3\n\tv_pk_add_f32 %1, %2, %3 op_sel:[1,1] op_sel_hi:[0,0] neg_lo:[0,1] neg_hi:[1,0]" : "=&v"(sum), "=&v"(o) : "v"(a), "v"(b));
    a = sum; b = o;
}
__device__ __forceinline__ void cmul_tw(f32x2& d, const f32x2 w) {
    f32x2 tmp;
    asm("v_pk_mul_f32 %1, %0, %2 op_sel:[1,1] op_sel_hi:[0,1] neg_hi:[1,0]\n\tv_pk_fma_f32 %0, %0, %2, %1 op_sel:[0,0,0] op_sel_hi:[1,0,1]" : "+v"(d), "=&v"(tmp) : "v"(w));
}
__device__ __forceinline__ void cmul_step(f32x2& w, const f32x2 w1) {
    f32x2 tmp;
    asm("v_pk_mul_f32 %1, %0, %2 op_sel:[1,1] op_sel_hi:[0,1] neg_lo:[1,0]\n\tv_pk_fma_f32 %0, %0, %2, %1 op_sel:[0,0,0] op_sel_hi:[1,0,1]" : "+v"(w), "=&v"(tmp) : "v"(w1));
}
#define TWX_(i) "v_pk_mul_f32 %[t1], %[x" #i "], %[w] op_sel:[1,1] op_sel_hi:[0,1] neg_hi:[1,0]\n\tv_pk_mul_f32 %[t2], %[w], %[w1] op_sel:[1,1] op_sel_hi:[0,1] neg_lo:[1,0]\n\t" \
                "v_pk_fma_f32 %[x" #i "], %[x" #i "], %[w], %[t1] op_sel:[0,0,0] op_sel_hi:[1,0,1]\n\tv_pk_fma_f32 %[w], %[w], %[w1], %[t2] op_sel:[0,0,0] op_sel_hi:[1,0,1]\n\t"
__device__ __forceinline__ void tw_chunk8(f32x2& x0, f32x2& x1, f32x2& x2, f32x2& x3, f32x2& x4, f32x2& x5, f32x2& x6, f32x2& x7, f32x2& w, const f32x2 w1) {
    f32x2 t1, t2;
    asm(TWX_(0) TWX_(1) TWX_(2) TWX_(3) TWX_(4) TWX_(5) TWX_(6) TWX_(7)
        : [x0] "+v"(x0), [x1] "+v"(x1), [x2] "+v"(x2), [x3] "+v"(x3), [x4] "+v"(x4), [x5] "+v"(x5), [x6] "+v"(x6), [x7] "+v"(x7), [w] "+v"(w), [t1] "=&v"(t1), [t2] "=&v"(t2) : [w1] "v"(w1));
}
__device__ __forceinline__ void tw_chunk7(f32x2& x0, f32x2& x1, f32x2& x2, f32x2& x3, f32x2& x4, f32x2& x5, f32x2& x6, f32x2& w, const f32x2 w1) {
    f32x2 t1, t2;
    asm(TWX_(0) TWX_(1) TWX_(2) TWX_(3) TWX_(4) TWX_(5) TWX_(6)
        : [x0] "+v"(x0), [x1] "+v"(x1), [x2] "+v"(x2), [x3] "+v"(x3), [x4] "+v"(x4), [x5] "+v"(x5), [x6] "+v"(x6), [w] "+v"(w), [t1] "=&v"(t1), [t2] "=&v"(t2) : [w1] "v"(w1));
}
#undef TWX_
#define TWAB_(i) "v_pk_mul_f32 %[t1], %[a" #i "], %[w] op_sel:[1,1] op_sel_hi:[0,1] neg_hi:[1,0]\n\tv_pk_mul_f32 %[t2], %[b" #i "], %[w] op_sel:[1,1] op_sel_hi:[0,1] neg_hi:[1,0]\n\t" \
                 "v_pk_mul_f32 %[t3], %[w], %[w1] op_sel:[1,1] op_sel_hi:[0,1] neg_lo:[1,0]\n\tv_pk_fma_f32 %[a" #i "], %[a" #i "], %[w], %[t1] op_sel:[0,0,0] op_sel_hi:[1,0,1]\n\t" \
                 "v_pk_fma_f32 %[b" #i "], %[b" #i "], %[w], %[t2] op_sel:[0,0,0] op_sel_hi:[1,0,1]\n\tv_pk_fma_f32 %[w], %[w], %[w1], %[t3] op_sel:[0,0,0] op_sel_hi:[1,0,1]\n\t"
__device__ __forceinline__ void tw_chunk5ab(f32x2& a0, f32x2& a1, f32x2& a2, f32x2& a3, f32x2& a4, f32x2& b0, f32x2& b1, f32x2& b2, f32x2& b3, f32x2& b4, f32x2& w, const f32x2 w1) {
    f32x2 t1, t2, t3;
    asm(TWAB_(0) TWAB_(1) TWAB_(2) TWAB_(3) TWAB_(4)
        : [a0] "+v"(a0), [a1] "+v"(a1), [a2] "+v"(a2), [a3] "+v"(a3), [a4] "+v"(a4), [b0] "+v"(b0), [b1] "+v"(b1), [b2] "+v"(b2), [b3] "+v"(b3), [b4] "+v"(b4), [w] "+v"(w),
          [t1] "=&v"(t1), [t2] "=&v"(t2), [t3] "=&v"(t3) : [w1] "v"(w1));
}
#undef TWAB_
template <int N, int LEN> struct FftStageC {
    static __device__ __forceinline__ void run(f32x2 (&x)[N]) {
        constexpr int half = LEN / 2, step = 32 / LEN;
#pragma unroll
        for (int base = 0; base < N; base += LEN)
#pragma unroll
            for (int j = 0; j < half; ++j) {
                const int i0 = base + j, i1 = i0 + half, idx = j * step;
                if (idx == 0) { const f32x2 a = x[i0], b = x[i1]; x[i0] = a + b; x[i1] = a - b; }
                else if (idx == 8) bfly_j(x[i0], x[i1]);
                else { const int m = idx < 8 ? idx : idx - 8, k = m <= 4 ? m : 8 - m; const bool sw = m > 4;
                    const f32x2 P = (f32x2){twc(k), tws(k)};
                    if (idx < 8) { if (!sw) bfly_tw<0, 0>(x[i0], x[i1], P); else bfly_tw<1, 0>(x[i0], x[i1], P); }
                    else { if (!sw) bfly_tw<1, 1>(x[i0], x[i1], P); else bfly_tw<0, 1>(x[i0], x[i1], P); } }
            }
        if constexpr (LEN > 2) FftStageC<N, LEN / 2>::run(x);
    }
};
template <int N, int BITS> __device__ __forceinline__ void fft_regc(f32x2 (&x)[N]) {
    FftStageC<N, N>::run(x);
    f32x2 t[N];
#pragma unroll
    for (int i = 0; i < N; ++i) t[bitrev(i, BITS)] = x[i];
#pragma unroll
    for (int i = 0; i < N; ++i) x[i] = t[i];
}
__device__ __forceinline__ void fft16k_c(f32x2 (&x)[32], LAS f32x2* L, int tid_in) {
    int tid = tid_in; asm volatile("" : "+v"(tid));
    fft_regc<32, 5>(x);
    { const float f1 = (float)tid * (1.0f / 16384.0f); const float c1 = __builtin_amdgcn_cosf(f1), s1 = __builtin_amdgcn_sinf(f1); f32x2 w = (f32x2){c1, s1};
      const f32x2 w1 = w;
      tw_chunk8(x[1], x[2], x[3], x[4], x[5], x[6], x[7], x[8], w, w1); tw_chunk8(x[9], x[10], x[11], x[12], x[13], x[14], x[15], x[16], w, w1);
      tw_chunk8(x[17], x[18], x[19], x[20], x[21], x[22], x[23], x[24], w, w1); tw_chunk7(x[25], x[26], x[27], x[28], x[29], x[30], x[31], w, w1); }
#pragma unroll
    for (int k1 = 0; k1 < 32; ++k1) L[k1 * 513 + tid] = x[k1];
    __syncthreads();
    const int n3 = tid & 31, ka = tid >> 5;
    f32x2 a[16], b[16];
#pragma unroll
    for (int n2 = 0; n2 < 16; ++n2) { a[n2] = L[ka * 513 + n2 * 32 + n3]; b[n2] = L[(ka + 16) * 513 + n2 * 32 + n3]; }
    fft_regc<16, 4>(a); fft_regc<16, 4>(b);
    { const float f1 = (float)n3 * (1.0f / 512.0f); const float c1 = __builtin_amdgcn_cosf(f1), s1 = __builtin_amdgcn_sinf(f1); f32x2 w = (f32x2){c1, s1};
      const f32x2 w1 = w;
      tw_chunk5ab(a[1], a[2], a[3], a[4], a[5], b[1], b[2], b[3], b[4], b[5], w, w1); tw_chunk5ab(a[6], a[7], a[8], a[9], a[10], b[6], b[7], b[8], b[9], b[10], w, w1);
      tw_chunk5ab(a[11], a[12], a[13], a[14], a[15], b[11], b[12], b[13], b[14], b[15], w, w1); }
    __syncthreads();
#pragma unroll
    for (int k2 = 0; k2 < 16; ++k2) { L[n3 * 513 + k2 * 32 + ka] = a[k2]; L[n3 * 513 + k2 * 32 + ka + 16] = b[k2]; }
    __syncthreads();
#pragma unroll
    for (int q = 0; q < 32; ++q) x[q] = L[q * 513 + tid];
    fft_regc<32, 5>(x);
}
__device__ __forceinline__ void fft16k(float (&re)[32], float (&im)[32], LAS f32x2* L, int tid) {
    f32x2 x[32];
#pragma unroll
    for (int r = 0; r < 32; ++r) x[r] = (f32x2){re[r], im[r]};
    fft16k_c(x, L, tid);
#pragma unroll
    for (int r = 0; r < 32; ++r) { re[r] = x[r].x; im[r] = x[r].y; }
}

constexpr int HS_SP = SEQ + 16;
__device__ __forceinline__ void hy_stage(LAS bf16* S, int slot, const bf16* src, int tid) {
    LAS bf16* d = S + slot * HS_SP + 8;
    if (tid == 0) { d[-1] = 0; d[SEQ] = 0; }
#pragma unroll
    for (int q = 0; q < 2; ++q) { const int ch = q * NTHREADS + tid; *(LAS v4u*)(d + ch * 8) = *(const GAS v4u*)(src + ch * 8); }
}
__device__ __forceinline__ void hy_stage2(LAS bf16* S, int slot0, const bf16* src, int tid) {
    v4u r[4];
#pragma unroll
    for (int q = 0; q < 2; ++q) { const int ch = q * NTHREADS + tid; r[q] = *(const GAS v4u*)(src + ch * 8); r[2 + q] = *(const GAS v4u*)(src + SEQ + ch * 8); }
#pragma unroll
    for (int b = 0; b < 2; ++b) { LAS bf16* d = S + (slot0 + b) * HS_SP + 8;
        if (tid == 0) { d[-1] = 0; d[SEQ] = 0; }
#pragma unroll
        for (int q = 0; q < 2; ++q) { const int ch = q * NTHREADS + tid; *(LAS v4u*)(d + ch * 8) = r[2 * b + q]; } }
}
struct HySel { unsigned a, b, c; };
__device__ __forceinline__ HySel hy_sel(int tid) { const bool odd = tid & 1; HySel q; q.a = odd ? 0x01000c0cu : 0x03020c0cu; q.b = odd ? 0x03020c0cu : 0x05040c0cu; q.c = odd ? 0x05040c0cu : 0x07060c0cu; return q; }
__device__ __forceinline__ float hy_sc(const LAS bf16* S, int slot, int t, const HySel q, float w0, float w1, float w2) {
    const LAS unsigned* W = (const LAS unsigned*)(S + slot * HS_SP + 8);
    const int kp = (t - 1) >> 1;
    const unsigned d0 = W[kp], d1 = W[kp + 1];
    const float a = __builtin_bit_cast(float, __builtin_amdgcn_perm(d1, d0, q.a)), b = __builtin_bit_cast(float, __builtin_amdgcn_perm(d1, d0, q.b)), c = __builtin_bit_cast(float, __builtin_amdgcn_perm(d1, d0, q.c));
    return a * w0 + b * w1 + c * w2;
}
__device__ __forceinline__ void cmul_kconj(f32x2& z, const f32x2 k) {
    f32x2 tmp;
    asm("v_pk_mul_f32 %1, %0, %2 op_sel:[1,1] op_sel_hi:[0,1] neg_lo:[1,0] neg_hi:[1,0]\n\tv_pk_fma_f32 %0, %0, %2, %1 op_sel:[0,0,0] op_sel_hi:[1,0,1] neg_hi:[1,0,0]" : "+v"(z), "=&v"(tmp) : "v"(k));
}

#ifdef CSEL
#define CT(sec) do { const unsigned long long tn_ = __builtin_amdgcn_s_memrealtime(); if (csec_ == CSEL) ctime_ += tn_ - ct0_; ct0_ = tn_; csec_ = (sec); } while (0)
#else
#define CT(sec)
#endif
__device__ __forceinline__ void phase_hyena_conv(const bf16* PT, const float* TAPS, const float* shortw, const float* skip, f32x2* XSall, f32x2* ZSall, bf16* MIXT,
                                                 LAS unsigned char* lds, int blk, int nblk, int tid_in, int lane, int wave, int pmode = 0) {
    LAS f32x2* L = (LAS f32x2*)lds; LAS bf16* S = (LAS bf16*)lds; LAS float* red = (LAS float*)(lds + LDS_MISC);
    GAS f32x2* XK0 = (GAS f32x2*)XSall + (size_t)blk * 16384;
    GAS f32x2* XK1 = XK0 + 16384 * 256; GAS f32x2* ZS = (GAS f32x2*)ZSall + (size_t)blk * 16384;
    constexpr int N = 16384;
#ifdef CSEL
    unsigned long long ctime_ = 0ull, ct0_ = __builtin_amdgcn_s_memrealtime(); int csec_ = -1;
#endif
#pragma unroll 1
    for (int c = blk; c < D_MAIN; c += nblk) {
        f32x2 x[32]; float vr[16], vi[16];
#pragma unroll 1
        for (int pass = 0; pass < 5; ++pass) {
            int tid = tid_in; asm volatile("" : "+v"(tid));
            const HySel hq = hy_sel(tid);
            CT(pass == 0 ? 0 : (pass == 1 ? 7 : 8));
            if (pass == 0) {
                const GAS float* hf0 = (const GAS float*)TAPS + (size_t)c * SEQ; const GAS float* hb0 = (const GAS float*)TAPS + (size_t)(D_MAIN + c) * SEQ;
                const GAS float* hf1 = (const GAS float*)TAPS + (size_t)(2 * D_MAIN + c) * SEQ; const GAS float* hb1 = (const GAS float*)TAPS + (size_t)(3 * D_MAIN + c) * SEQ;
#pragma unroll
                for (int r = 0; r < 16; ++r) { const int n = r * 512 + tid; x[r].x = hf0[n]; x[r].y = hf1[n]; }
#pragma unroll
                for (int r = 16; r < 32; ++r) { const int idx = (32 - r) * 512 - tid; const bool z = (idx == SEQ); const int ii = z ? 0 : idx; const float h0_ = hb0[ii], h1_ = hb1[ii]; x[r].x = z ? 0.f : h0_; x[r].y = z ? 0.f : h1_; }
                float e0 = 0.f, e1 = 0.f;
                if (tid == 0) { e0 = hb0[0]; e1 = hb1[0]; }
                float s0 = fabsf(e0), s1 = fabsf(e1);
#pragma unroll
                for (int r = 0; r < 32; ++r) { s0 += fabsf(x[r].x); s1 += fabsf(x[r].y); }
                s0 = wave_sum(s0); s1 = wave_sum(s1);
                __syncthreads();
                if (lane == 0) { red[wave] = s0; red[8 + wave] = s1; }
                __syncthreads();
                float t0 = 0.f, t1 = 0.f;
#pragma unroll
                for (int w = 0; w < NWAVES; ++w) { t0 += red[w]; t1 += red[8 + w]; }
                const float sc0 = 1.0f / (t0 + 1e-6f), sc1 = 1.0f / (t1 + 1e-6f);
                x[0].x += e0; x[0].y += e1;
#pragma unroll
                for (int r = 0; r < 32; ++r) { x[r].x *= sc0; x[r].y *= sc1; }
            } else if (pass == 1) {
                __syncthreads();
                const bf16* pv = PT + (size_t)(2 * D_MAIN + c) * M_TOK; const float wv[3] = {shortw[2 * D_MAIN + c], shortw[2304 + 2 * D_MAIN + c], shortw[4608 + 2 * D_MAIN + c]};
                hy_stage2(S, 0, pv, tid);
                __syncthreads();
#pragma unroll
                for (int r = 0; r < 16; ++r) { const int t = r * 512 + tid; x[r].x = hy_sc(S, 0, t, hq, wv[0], wv[1], wv[2]); x[r].y = hy_sc(S, 1, t, hq, wv[0], wv[1], wv[2]); vr[r] = x[r].x; vi[r] = x[r].y; }
#pragma unroll
                for (int r = 16; r < 32; ++r) { x[r].x = 0.f; x[r].y = 0.f; }
            }
            __syncthreads();
            CT(1);
            fft16k_c(x, L, tid);
            CT(2 + pass);
            if (pass == 0) {
                __syncthreads();
#pragma unroll
                for (int r = 0; r < 32; ++r) L[r * 513 + tid] = x[r];
                __syncthreads();
                const int tp = (512 - tid) & 511;
#pragma unroll
                for (int r = 0; r < 32; ++r) { const int rp = (tid == 0) ? ((32 - r) & 31) : (31 - r);
                    const f32x2 xa = x[r], xb = L[rp * 513 + tp]; const float sc_ = 0.5f / (float)N;
                    XK0[r * 512 + tid] = (f32x2){(xa.x + xb.x) * sc_, (xa.y - xb.y) * sc_};
                    XK1[r * 512 + tid] = (f32x2){(xa.y + xb.y) * sc_, (xb.x - xa.x) * sc_}; if ((r & 7) == 7) __builtin_amdgcn_sched_barrier(0); }
            } else if (pass == 1 || pass == 3) {
                const GAS f32x2* XK = (pass == 1) ? XK0 : XK1;
#pragma unroll
                for (int r = 0; r < 32; ++r) cmul_kconj(x[r], XK[r * 512 + tid]);
            } else if (pass == 2) {
                __syncthreads();
                const bf16* px1 = PT + (size_t)c * M_TOK; const float sk0 = skip[c]; const float wx1[3] = {shortw[c], shortw[2304 + c], shortw[4608 + c]};
                hy_stage2(S, 2, px1, tid);
                __syncthreads();
#pragma unroll
                for (int r = 0; r < 16; ++r) { const int t = r * 512 + tid;
                    const float v0 = vr[r], v1 = vi[r];
                    const float g0 = hy_sc(S, 2, t, hq, wx1[0], wx1[1], wx1[2]), g1 = hy_sc(S, 3, t, hq, wx1[0], wx1[1], wx1[2]);
                    x[r].x = g0 * (x[r].x + sk0 * v0); x[r].y = g1 * (-x[r].y + sk0 * v1); ZS[t] = (f32x2){x[r].x, x[r].y}; }
#pragma unroll
                for (int r = 16; r < 32; ++r) { x[r].x = 0.f; x[r].y = 0.f; }
            } else {
                __syncthreads();
                const bf16* px2 = PT + (size_t)(D_MAIN + c) * M_TOK; const float sk1 = skip[D_MAIN + c];
                const float wx2[3] = {shortw[D_MAIN + c], shortw[2304 + D_MAIN + c], shortw[4608 + D_MAIN + c]};
                f32x2 zs[16];
#pragma unroll
                for (int r = 0; r < 16; ++r) zs[r] = ZS[r * 512 + tid];
                hy_stage2(S, 0, px2, tid);
                __syncthreads();
#pragma unroll
                for (int r = 0; r < 16; ++r) { const int t = r * 512 + tid;
                    const float g0 = hy_sc(S, 0, t, hq, wx2[0], wx2[1], wx2[2]), g1 = hy_sc(S, 1, t, hq, wx2[0], wx2[1], wx2[2]);
                    const f32x2 z = zs[r];
                    const float o0 = g0 * (x[r].x + sk1 * z.x), o1 = g1 * (-x[r].y + sk1 * z.y);
                    const unsigned op_ = pg8::cvt_pk_bf16(o0, o1); (S + 2 * HS_SP + 8)[t] = (bf16)op_; (S + 3 * HS_SP + 8)[t] = (bf16)(op_ >> 16); }
                __syncthreads();
#pragma unroll
                for (int q = 0; q < 2; ++q) { const int ch = q * NTHREADS + tid;
                    *(GAS v4u*)(MIXT + (size_t)c * M_TOK + ch * 8) = *(const LAS v4u*)(S + 2 * HS_SP + 8 + ch * 8);
                    *(GAS v4u*)(MIXT + (size_t)c * M_TOK + SEQ + ch * 8) = *(const LAS v4u*)(S + 3 * HS_SP + 8 + ch * 8); }
            }
        }
        CT(-1);
        __syncthreads();
    }
#ifdef CSEL
    if (blk == 0 && tid_in == 0) *(unsigned long long*)((unsigned char*)XSall - WS_FFTX + 32768) += ctime_;
#endif
}
#ifndef MK_PER_PHASE
#define MK_PER_PHASE 0
#endif
#ifndef CONV_PMODE
#define CONV_PMODE 0
#endif
#ifndef REPMASK
#define REPMASK 0u
#endif
#define REP(kind) _Pragma("unroll 1") for (int r_ = 0; r_ < 1 + (int)((REPMASK >> (kind)) & 1u); ++r_)
struct Args {
    const float* in[24]; float* out; unsigned char* ws; int ph_lo, ph_hi;
};
constexpr int N_PHASES = 1 + (DEPTH - 1) + DEPTH * 8 - DEPTH / 2 + 1;

template <int QP, int KP, int THRL = 8>
__device__ __forceinline__ void run_attn(const bf16* Q, const bf16* K, const bf16* V, bf16* O, int NT, char* shm, int wave_s) {
    attn_body::attn_unit<THRL, QP, KP, DM>((const attn_body::bf16*)Q, (const attn_body::bf16*)K, (const attn_body::bf16*)V, (attn_body::bf16*)O, NT, shm, wave_s);
}

__global__ void __launch_bounds__(NTHREADS, 2) hybrid_fwd(Args args) {
    extern __shared__ __attribute__((aligned(16))) unsigned char lds_raw[];
    LAS unsigned char* lds = (LAS unsigned char*)lds_raw;
    const int G = gridDim.x, bx = blockIdx.x;
    const int wave0 = __builtin_amdgcn_readfirstlane((int)(threadIdx.x >> 6));
    const int vcu = (G % 8 == 0) ? (bx % 8) * (G / 8) + bx / 8 : bx;
    const int NGW = G * NWAVES;
    unsigned char* const ws0_ = (unsigned char*)(GAS unsigned char*)args.ws;
#define INP(k) ((const float*)(const GAS float*)args.in[k])
    const float* x = INP(0); const float* mem = INP(1); const float* mix_g = INP(2); const float* ffn_g = INP(3); const float* mem_g = INP(4); const float* fin_g = INP(5);
    const float* hy_short = INP(9); const float* f_w1 = INP(10); const float* f_b1 = INP(11); const float* f_w2 = INP(12); const float* f_b2 = INP(13);
    const float* f_w3 = INP(14); const float* f_freq = INP(15); const float* hy_skip = INP(16); const float* qg = INP(18); const float* kg = INP(19); const float* router = INP(20);
    float* OUTF = (float*)(GAS float*)args.out;
#define U ((bf16*)(ws + WS_U))
#define HB ((bf16*)(ws + WS_HB))
#define PROJ ((bf16*)(ws + WS_PROJ))
#define CQ ((bf16*)(ws + WS_CQ))
#define MIX ((bf16*)(ws + WS_MIX))
#define MIXT ((bf16*)(ws + WS_MIXT))
#define AFF ((float*)(ws + WS_AFF))
#define IDX ((int*)(ws + WS_IDX))
#define GATE ((float*)(ws + WS_GATE))
#define POS ((int*)(ws + WS_POS))
#define HID ((bf16*)(ws + WS_HID))
#define Y ((bf16*)(ws + WS_Y))
#define TAPS ((float*)(ws + WS_TAPS))
#define MKV ((const bf16*)(ws + WS_MKV))
    cg::grid_group grid = cg::this_grid();
    volatile LAS unsigned* bst = (volatile LAS unsigned*)(lds + LDS_MISC + 4096);
    if (threadIdx.x < 2) bst[threadIdx.x] = 0u;
    __syncthreads();
    XcdBarrier xbar = xcd_barrier_post((unsigned*)(ws0_ + WS_CTL) + 1024, bst);
    const int lo = args.ph_lo, hi = args.ph_hi;
#define XW (XwIn{INP(21), INP(22), INP(23), ws})
    const bool xw_sched = (G == 256);
    int ph = 0;
#ifdef TSEL
    unsigned long long tacc_ = 0ull, t0_ = 0ull, t1_ = 0ull; int pk_ = 0, tpar_ = 0;
#endif
#ifdef TSEL
#ifndef TAMP
#define TAMP 10
#endif
#ifndef TBAR
#define TBAR 0
#endif
#define PH_T0(k) pk_ = (k); t0_ = __builtin_amdgcn_s_memrealtime();
#ifndef TPAR
#define TPAR -1
#endif
#define PH_T1 t1_ = __builtin_amdgcn_s_memrealtime(); if (!TBAR && (pk_ == TSEL || TSEL == 99) && (TPAR < 0 || tpar_ == TPAR)) tacc_ += t1_ - t0_;
#define PH_T2 if (TBAR && (pk_ == TSEL || TSEL == 99)) tacc_ += __builtin_amdgcn_s_memrealtime() - t1_;
#else
#define PH_T0(k)
#define PH_T1
#define PH_T2
#endif
#define PHASE_BEGINK(k) PH_T0(k) if (lo <= ph && ph < hi) { unsigned char* ws; { unsigned char* w_ = ws0_; asm volatile("" : "+s"(w_)); ws = (unsigned char*)(GAS unsigned char*)w_; } const int tid = opaque_tid(wave0), lane = tid & 63, wave = __builtin_amdgcn_readfirstlane(tid >> 6), gw = vcu * NWAVES + wave; (void)lane; (void)gw;
#ifdef EXTRA_XBAR
#define PHASE_END   if (ph + 1 < hi) { if (ph == lo) grid.sync(); else { xcd_barrier(xbar); if (ph < EXTRA_XBAR) xcd_barrier(xbar); } } } ++ph;
#else
#define PHASE_END   PH_T1 if (ph + 1 < hi) { if (hi == 0x7fffffff) grid.sync(); else xcd_barrier(xbar); } PH_T2 } ++ph;
#endif

    PHASE_BEGINK(0)
        ProIn P{INP(8), INP(17), INP(7), INP(6)};
        REP(0) { phase_weights(P, ws, lds, gw, NGW, wave, lane); phase_xw_p0(XW, xw_sched, (LAS float*)(lds + wave * 16384), gw, NGW, lane); }
        phase_wrg(ffn_g, router, (float*)(ws + WS_WRG), (int)(bx * NTHREADS + tid), (int)(G * NTHREADS));
        REP(1) phase_mem_h2(mem, mem_g, f_w1, f_b1, f_w2, f_b2, f_freq, ws, gw, NGW, lane);
        REP(3) phase_norm<false, false, false>(x, HB, mix_g, U, nullptr, nullptr, nullptr, gw, NGW, lane);
    PHASE_END

#pragma unroll 1
    for (int i = 0; i < DEPTH; ++i) {
        const bool hy = (i & 1) == 0; const int j = i >> 1;
#ifdef TSEL
        tpar_ = i & 1;
#endif
        if (i > 0) {
        PHASE_BEGINK(1)
            phase_norm<true, false, true>(HB, HB, mix_g + i * DM, U, nullptr, POS, Y, gw, NGW, lane);
        PHASE_END
        }
        PHASE_BEGINK(2)
            if (i == 0) {
                pg8::Gemm g{(const bf16*)(ws + WS_MEMN), (const bf16*)(ws + WS_WMKV), BATCH * MEM_LEN, 2048, DM, 1 << 30, 1, 0};
                pg8::StaticOrder S; S.init(BATCH * MEM_LEN, 2048, G, bx);
                pg8::EpiRowBf16 E{(bf16*)(ws + WS_MKV), 2048, -1, 1.f};
                pg8::gemm_phase<pg8::EpiRowBf16, pg8::StaticOrder, true, true>(lds, g, S, E, wave);
            }
            if (hy) {
                REP(4) phase_taps((const float*)(ws + WS_H2) + (size_t)j * SEQ * HY_FILT, f_w3 + (size_t)j * HY_FILT * FCOLS, TAPS, gw, NGW, lane);
                pg8::Gemm g{U, (const bf16*)(ws + WS_WHY) + (size_t)j * D_IN_HY * DM, M_TOK, D_IN_HY, DM, 1 << 30, 1, 0};
                pg8::StaticOrder S; S.init(M_TOK, D_IN_HY, G, bx);
                pg8::EpiHyIn E{PROJ, M_TOK, 9, CQ, ATT_C2};
                REP(5) pg8::gemm_phase<pg8::EpiHyIn, pg8::StaticOrder, true, true>(lds, g, S, E, wave);
            } else {
                pg8::Gemm g{U, (const bf16*)(ws + WS_WAT) + (size_t)j * D_IN_AT * DM, M_TOK, D_IN_AT, DM, 1 << 30, 1, 0};
                pg8::StaticOrder S; S.init(M_TOK, D_IN_AT, G, bx);
                pg8::EpiAtIn E{PROJ, PROJ + (size_t)M_TOK * 768, PROJ + (size_t)M_TOK * 1024, PROJ + (size_t)M_TOK * 1280, qg + j * HD, kg + j * HD, ATT_C2, NORM_EPS, SEQ - 1};
                REP(6) pg8::gemm_phase<pg8::EpiAtIn, pg8::StaticOrder, true, true>(lds, g, S, E, wave);
            }
            if (xw_sched && bx >= 128) xw_slice_a(XW, i, (LAS float*)(lds + wave * 16384), bx, wave, lane);
        PHASE_END
        PHASE_BEGINK(3)
            if (hy) {
                REP(8) phase_hyena_conv(PROJ, TAPS, hy_short + (size_t)j * 3 * 2304, hy_skip + (size_t)j * 2 * D_MAIN, (f32x2*)(ws + WS_FFTX), (f32x2*)(ws + WS_ZS), MIXT, lds, bx, G, tid, lane, wave);
                REP(9) for (int u = vcu; u < 256; u += G) { const int b = u >> 7, h4 = (u >> 5) & 3, qb = u & 31; const size_t row = (size_t)b * SEQ + qb * 256;
                    run_attn<256, 2048>(CQ + row * 256 + h4 * HD, MKV + (size_t)b * MEM_LEN * 2048 + i * 512 + h4 * HD, MKV + (size_t)b * MEM_LEN * 2048 + i * 512 + 256 + h4 * HD,
                                        MIX + row * DM + D_MAIN + h4 * HD, MEM_LEN / 64, (char*)lds_raw, wave); }
            } else {
                REP(10) for (int u = vcu; u < 768; u += G) { const int bk = (u & 255) >> 5, qb = u & 31, hs = u >> 8, b = bk >> 2, kvh = bk & 3, h = kvh * 3 + hs; const size_t row = (size_t)b * SEQ + qb * 256;
                    run_attn<768, 256, -1>(PROJ + row * 768 + h * HD, PROJ + (size_t)M_TOK * 768 + (size_t)b * SEQ * 256 + kvh * HD, PROJ + (size_t)M_TOK * 1024 + (size_t)b * SEQ * 256 + kvh * HD,
                                       MIX + row * DM + h * HD, SEQ / 64, (char*)lds_raw, wave); }
                REP(9) for (int u = vcu; u < 256; u += G) { const int b = u >> 7, h4 = (u >> 5) & 3, qb = u & 31; const size_t row = (size_t)b * SEQ + qb * 256;
                    run_attn<256, 2048>(PROJ + (size_t)M_TOK * 1280 + row * 256 + h4 * HD, MKV + (size_t)b * MEM_LEN * 2048 + i * 512 + h4 * HD, MKV + (size_t)b * MEM_LEN * 2048 + i * 512 + 256 + h4 * HD,
                                        MIX + row * DM + D_MAIN + h4 * HD, MEM_LEN / 64, (char*)lds_raw, wave); }
            }
        PHASE_END
        if (hy) {
            PHASE_BEGINK(4)
                REP(11) phase_transpose_mix(MIXT, MIX, lds, bx, G, tid);
            PHASE_END
        }
        PHASE_BEGINK(5)
            pg8::Gemm g{MIX, (const bf16*)(ws + WS_WOUT) + (size_t)i * DM * DM, M_TOK, DM, DM, 1 << 30, 1, 0};
            pg8::StaticOrder S; S.init(M_TOK, DM, G, bx);
            pg8::EpiOutX E{HB, HB, DM, ffn_g + i * DM, (const float*)(ws + WS_WRG) + (size_t)i * NEXP * DM, (unsigned char*)U, (float*)(ws + WS_PART), (float*)(ws + WS_PSS), M_TOK};
            pg8::gemm_phase<pg8::EpiOutX, pg8::StaticOrder, true, true>(lds, g, S, E, wave);
        PHASE_END
        PHASE_BEGINK(6)
            REP(13) phase_router_sum((const float*)(ws + WS_PART), (const float*)(ws + WS_PSS), (float*)(ws + WS_RSTD), AFF, gw, NGW, lane);
        PHASE_END
        PHASE_BEGINK(7)
            REP(14) phase_topk(AFF, (const float*)(ws + WS_RSTD), (float*)(ws + WS_RS), IDX, GATE, POS, lds + LDS_MISC, bx, G, tid, lane, wave);
            if (xw_sched && bx >= 32) xw_slice_b(XW, i, (LAS float*)(lds + wave * 16384), bx, wave, lane);
        PHASE_END
        PHASE_BEGINK(8)
            pg8::Gemm g{U, (const bf16*)(ws + WS_W1 + (size_t)i * NEXP * 1536 * DM), XROWS, 1536, DM / 2, 4, NEXP, (size_t)1536 * DM};
            pg8::StaticOrder S; S.init(XROWS, 1536, G, bx);
            pg8::EpiSwiGLU8 E{(unsigned char*)HID, EFF, 1.0f / W8_SCALE, (const float*)(ws + WS_RS)};
            REP(16) pg8::gemm_phase<pg8::EpiSwiGLU8, pg8::StaticOrder, true, true, true, true>(lds, g, S, E, wave, IDX);
        PHASE_END
        PHASE_BEGINK(9)
            pg8::Gemm g{HID, (const bf16*)(ws + WS_W2 + (size_t)i * NEXP * DM * EFF), XROWS, DM, EFF / 2, 4, NEXP, (size_t)DM * EFF};
            pg8::StaticOrder S; S.init(XROWS, DM, G, bx);
            pg8::EpiDown E{Y, DM, GATE, 1.0f / W8_SCALE};
            REP(17) pg8::gemm_phase<pg8::EpiDown, pg8::StaticOrder, true, true, false, true>(lds, g, S, E, wave);
        PHASE_END
    }
    PHASE_BEGINK(10)
        phase_norm<true, true, true>(HB, nullptr, fin_g, nullptr, OUTF, POS, Y, gw, NGW, lane);
    PHASE_END
#ifdef TSEL
#ifdef CSEL
    if (bx == 0 && threadIdx.x == 0) tacc_ += *(unsigned long long*)(ws0_ + 32768);
#endif
    if (bx == 0 && threadIdx.x == 0 && hi - lo > 1) { const unsigned long long te_ = __builtin_amdgcn_s_memrealtime(); while (__builtin_amdgcn_s_memrealtime() - te_ < (unsigned long long)TAMP * tacc_) __builtin_amdgcn_s_sleep(8); }
#endif
#undef PHASE_BEGINK
#undef U
#undef HB
#undef PROJ
#undef CQ
#undef MIX
#undef MIXT
#undef AFF
#undef IDX
#undef GATE
#undef POS
#undef HID
#undef Y
#undef TAPS
#undef MKV
#undef XW
#undef PHASE_END
}

extern "C" void kernel_launch(void* const* d_in, const int* in_sizes, int n_in, void* d_out, int out_size, void* d_ws, size_t ws_size, hipStream_t stream) {
    static int grid = 0;
    if (grid == 0) {
        if (n_in != 24 || out_size != M_TOK * DM || ws_size < WS_END) { fprintf(stderr, "kernel_launch: unexpected shapes (n_in %d out %d ws %zu need %zu)\n", n_in, out_size, ws_size, (size_t)WS_END); grid = -1; return; }
        int dev = 0, cus = 0, per_cu = 0;
        if (hipGetDevice(&dev) != hipSuccess || hipDeviceGetAttribute(&cus, hipDeviceAttributeMultiprocessorCount, dev) != hipSuccess) { grid = -1; return; }
        if (hipFuncSetAttribute((const void*)hybrid_fwd, hipFuncAttributeMaxDynamicSharedMemorySize, LDS_BYTES) != hipSuccess) { fprintf(stderr, "kernel_launch: hipFuncSetAttribute failed\n"); grid = -1; return; }
        if (hipOccupancyMaxActiveBlocksPerMultiprocessor(&per_cu, (const void*)hybrid_fwd, NTHREADS, LDS_BYTES) != hipSuccess || per_cu < 1) { fprintf(stderr, "kernel_launch: occupancy query says %d blocks/CU\n", per_cu); per_cu = 1; }
        (void)hipGetLastError();
        grid = cus;
    }
    if (grid < 0) return;
    if (hipMemsetAsync((char*)d_ws + WS_CTL, 0, 64 * 1024, stream) != hipSuccess) { fprintf(stderr, "kernel_launch: memset failed\n"); return; }
    Args a{};
    for (int i = 0; i < 24; ++i) a.in[i] = (const float*)d_in[i];
    a.out = (float*)d_out; a.ws = (unsigned char*)d_ws;
#if MK_PER_PHASE
    for (int li = 0; li < N_PHASES; ++li) {
        a.ph_lo = li; a.ph_hi = li + 1;
        void* kargs[] = {&a};
        hipError_t e = hipLaunchCooperativeKernel((const void*)hybrid_fwd, dim3(grid), dim3(NTHREADS), kargs, LDS_BYTES, stream);
        if (e != hipSuccess) { fprintf(stderr, "kernel_launch: launch %d failed: %s\n", li, hipGetErrorString(e)); break; }
    }
#else
    a.ph_lo = 0; a.ph_hi = N_PHASES;
    void* kargs[] = {&a};
    hipError_t e = hipLaunchCooperativeKernel((const void*)hybrid_fwd, dim3(grid), dim3(NTHREADS), kargs, LDS_BYTES, stream);
    if (e != hipSuccess) fprintf(stderr, "kernel_launch: cooperative launch failed: %s (grid %d)\n", hipGetErrorString(e), grid);
#endif
}
```
